# Optimizing an MI355X kernel written in HIP

```python
import jax
import jax.numpy as jnp
from jax import lax
import numpy as np

D_MODEL = 4096
BATCH = 8
SEQ = 2048
DEPTH = 2

CHUNK = 64
N_LEFT_CHUNKS = 8
BAND = N_LEFT_CHUNKS + 1
N_HEADS = 32
HEAD_DIM = D_MODEL // N_HEADS
H_A = 12
H_B = 10
H_C = 10
W_A = H_A * HEAD_DIM
W_B = H_B * HEAD_DIM
W_C = H_C * HEAD_DIM
MIX_WIDTH = W_A + W_B + W_C
PROJ_WIDTH = 3 * MIX_WIDTH + H_C
REL_CLIP = 128
Q_BLOCK = 128
PEER_HEADS = 8
PEER_QDIM = 256
PEER_HALF = PEER_QDIM // 2
N_KEYS = 128
N_EXPERTS = N_KEYS * N_KEYS
PEER_TOPK = 16
TOK_BLOCK = 128
RMS_EPS = 1e-6
NEG_INF = -1e30
FORGET_BIAS_INIT = 2.0

kernel_name = 'hybrid_streaming_relpos_stickbreak_fox_peer'


def rms_norm(x, g):
    xf = x.astype(jnp.float32)
    y = xf * lax.rsqrt(jnp.mean(xf * xf, axis=-1, keepdims=True) + RMS_EPS)
    return (y * g.astype(jnp.float32)).astype(x.dtype)


def _to_heads(t, n_heads):
    b, s, _ = t.shape
    return t.reshape(b, s, n_heads, HEAD_DIM).transpose(0, 2, 1, 3)


def _from_heads(t):
    b, h, s, dh = t.shape
    return t.transpose(0, 2, 1, 3).reshape(b, s, h * dh)


def _split_groups(t):
    ga = _to_heads(t[..., :W_A], H_A)
    gb = _to_heads(t[..., W_A:W_A + W_B], H_B)
    gc = _to_heads(t[..., W_A + W_B:], H_C)
    return ga, gb, gc


def chunked_relpos_attention(q, k, v, rel_bias):
    b, h, s, dh = q.shape
    nc = s // CHUNK
    qc = q.reshape(b, h, nc, CHUNK, dh)
    pad = ((0, 0), (0, 0), (N_LEFT_CHUNKS * CHUNK, 0), (0, 0))
    kp = jnp.pad(k, pad).reshape(b, h, nc + N_LEFT_CHUNKS, CHUNK, dh)
    vp = jnp.pad(v, pad).reshape(b, h, nc + N_LEFT_CHUNKS, CHUNK, dh)
    kb = jnp.stack([kp[:, :, j:j + nc] for j in range(BAND)], axis=3)
    vb = jnp.stack([vp[:, :, j:j + nc] for j in range(BAND)], axis=3)
    scores = jnp.einsum('bhcid,bhcjmd->bhcijm', qc, kb).astype(jnp.float32) * (dh ** -0.5)
    i_pos = jnp.arange(CHUNK)
    j_off = jnp.arange(BAND)
    rel = (N_LEFT_CHUNKS - j_off)[None, :, None] * CHUNK + i_pos[:, None, None] - i_pos[None, None, :]
    idx = jnp.clip(rel, -REL_CLIP, REL_CLIP) + REL_CLIP
    bias = rel_bias[:, idx].astype(jnp.float32)
    valid = (jnp.arange(nc)[:, None] - N_LEFT_CHUNKS + j_off[None, :]) >= 0
    logits = scores + bias[None, :, None]
    logits = jnp.where(valid[None, None, :, None, :, None], logits, NEG_INF)
    p = jax.nn.softmax(logits.reshape(b, h, nc, CHUNK, BAND * CHUNK), axis=-1)
    p = p.reshape(b, h, nc, CHUNK, BAND, CHUNK).astype(v.dtype)
    out = jnp.einsum('bhcijm,bhcjmd->bhcid', p, vb)
    return out.reshape(b, h, s, dh)


def stick_breaking_attention(q, k, v):
    b, h, s, dh = q.shape
    outs = []
    for blk in range(s // Q_BLOCK):
        q0 = blk * Q_BLOCK
        kend = q0 + Q_BLOCK
        z = jnp.einsum('bhtd,bhsd->bhts', q[:, :, q0:kend], k[:, :, :kend]).astype(jnp.float32) * (dh ** -0.5)
        t_pos = q0 + jnp.arange(Q_BLOCK)
        s_pos = jnp.arange(kend)
        strict = s_pos[None, :] < t_pos[:, None]
        log_1m = jnp.where(strict, jax.nn.log_sigmoid(-z), 0.0)
        tail = lax.cumsum(log_1m, axis=3, reverse=True) - log_1m
        a = jnp.where(strict, jnp.exp(jax.nn.log_sigmoid(z) + tail), 0.0)
        outs.append(jnp.einsum('bhts,bhsd->bhtd', a.astype(v.dtype), v[:, :, :kend]))
    return jnp.concatenate(outs, axis=2)


def forgetting_attention(q, k, v, log_f):
    b, h, s, dh = q.shape
    cum = lax.cumsum(log_f, axis=2)
    outs = []
    for blk in range(s // Q_BLOCK):
        q0 = blk * Q_BLOCK
        kend = q0 + Q_BLOCK
        z = jnp.einsum('bhtd,bhsd->bhts', q[:, :, q0:kend], k[:, :, :kend]).astype(jnp.float32) * (dh ** -0.5)
        z = z + cum[:, :, q0:kend, None] - cum[:, :, None, :kend]
        t_pos = q0 + jnp.arange(Q_BLOCK)
        s_pos = jnp.arange(kend)
        causal = s_pos[None, :] <= t_pos[:, None]
        p = jax.nn.softmax(jnp.where(causal, z, NEG_INF), axis=-1)
        outs.append(jnp.einsum('bhts,bhsd->bhtd', p.astype(v.dtype), v[:, :, :kend]))
    return jnp.concatenate(outs, axis=2)


def peer_ffn(h, w_pq, sub_k1, sub_k2, u_emb, v_emb):
    b, s, d = h.shape
    n_tok = b * s
    t = h.reshape(n_tok, d)
    q = jnp.einsum('td,de->te', t, w_pq).reshape(n_tok, PEER_HEADS, 2, PEER_HALF)
    s1 = jnp.einsum('thd,hnd->thn', q[:, :, 0], sub_k1).astype(jnp.float32)
    s2 = jnp.einsum('thd,hnd->thn', q[:, :, 1], sub_k2).astype(jnp.float32)
    v1, i1 = lax.top_k(s1, PEER_TOPK)
    v2, i2 = lax.top_k(s2, PEER_TOPK)
    cand = (v1[..., :, None] + v2[..., None, :]).reshape(n_tok, PEER_HEADS, PEER_TOPK * PEER_TOPK)
    cand_id = (i1[..., :, None] * N_KEYS + i2[..., None, :]).reshape(n_tok, PEER_HEADS, PEER_TOPK * PEER_TOPK)
    best, pos = lax.top_k(cand, PEER_TOPK)
    eid = jnp.take_along_axis(cand_id, pos, axis=-1)
    g = jax.nn.softmax(best, axis=-1)
    n_blk = n_tok // TOK_BLOCK

    def block(args):
        tb, eb, gb = args
        ub = jnp.take(u_emb, eb, axis=0)
        a = jnp.einsum('td,thkd->thk', tb, ub).astype(jnp.float32)
        w = gb * jax.nn.gelu(a, approximate=False)
        vb = jnp.take(v_emb, eb, axis=0)
        return jnp.einsum('thk,thkd->td', w.astype(tb.dtype), vb)

    out = lax.map(block, (t.reshape(n_blk, TOK_BLOCK, d),
                          eid.reshape(n_blk, TOK_BLOCK, PEER_HEADS, PEER_TOPK),
                          g.reshape(n_blk, TOK_BLOCK, PEER_HEADS, PEER_TOPK)))
    return out.reshape(b, s, d)


def setup_inputs(seed: int = 0) -> dict:
    key = jax.random.key(seed)
    ks = jax.random.split(key, 13)
    f32 = jnp.float32

    def nrm(k, shape, scale):
        return jax.random.normal(k, shape, f32) * scale

    x = nrm(ks[0], (BATCH, SEQ, D_MODEL), 1.0)
    ln1_g = 1.0 + nrm(ks[1], (DEPTH, D_MODEL), 0.02)
    w_in = nrm(ks[2], (DEPTH, D_MODEL, PROJ_WIDTH), D_MODEL ** -0.5)
    b_f = FORGET_BIAS_INIT + nrm(ks[3], (DEPTH, H_C), 0.1)
    rel_bias = nrm(ks[4], (DEPTH, H_A, 2 * REL_CLIP + 1), 0.5)
    w_out = nrm(ks[5], (DEPTH, MIX_WIDTH, D_MODEL), MIX_WIDTH ** -0.5)
    ln2_g = 1.0 + nrm(ks[6], (DEPTH, D_MODEL), 0.02)
    peer_wq = nrm(ks[7], (DEPTH, D_MODEL, PEER_HEADS * PEER_QDIM), D_MODEL ** -0.5)
    peer_k1 = nrm(ks[8], (DEPTH, PEER_HEADS, N_KEYS, PEER_HALF), PEER_HALF ** -0.5)
    peer_k2 = nrm(ks[9], (DEPTH, PEER_HEADS, N_KEYS, PEER_HALF), PEER_HALF ** -0.5)
    peer_u = nrm(ks[10], (DEPTH, N_EXPERTS, D_MODEL), D_MODEL ** -0.5)
    peer_v = nrm(ks[11], (DEPTH, N_EXPERTS, D_MODEL), PEER_HEADS ** -0.5)
    final_g = 1.0 + nrm(ks[12], (D_MODEL,), 0.02)
    return {'x': x, 'ln1_g': ln1_g, 'w_in': w_in, 'b_f': b_f, 'rel_bias': rel_bias,
            'w_out': w_out, 'ln2_g': ln2_g, 'peer_wq': peer_wq, 'peer_k1': peer_k1,
            'peer_k2': peer_k2, 'peer_u': peer_u, 'peer_v': peer_v, 'final_g': final_g}


def reference(x, ln1_g, w_in, b_f, rel_bias, w_out, ln2_g, peer_wq, peer_k1, peer_k2, peer_u, peer_v, final_g):
    for l in range(DEPTH):
        h = rms_norm(x, ln1_g[l])
        proj = jnp.einsum('bsd,de->bse', h, w_in[l])
        qa, qb, qc = _split_groups(proj[..., :MIX_WIDTH])
        ka, kb, kc = _split_groups(proj[..., MIX_WIDTH:2 * MIX_WIDTH])
        va, vb, vc = _split_groups(proj[..., 2 * MIX_WIDTH:3 * MIX_WIDTH])
        f_logit = (proj[..., 3 * MIX_WIDTH:] + b_f[l]).astype(jnp.float32)
        log_f = jax.nn.log_sigmoid(f_logit).transpose(0, 2, 1)
        o_a = chunked_relpos_attention(qa, ka, va, rel_bias[l])
        o_b = stick_breaking_attention(qb, kb, vb)
        o_c = forgetting_attention(qc, kc, vc, log_f)
        o = jnp.concatenate([_from_heads(o_a), _from_heads(o_b), _from_heads(o_c)], axis=-1)
        x = x + jnp.einsum('bse,ed->bsd', o.astype(x.dtype), w_out[l])
        x = x + peer_ffn(rms_norm(x, ln2_g[l]), peer_wq[l], peer_k1[l], peer_k2[l], peer_u[l], peer_v[l])
    return rms_norm(x, final_g)
```

```cpp
#include <hip/hip_runtime.h>
#include <cstdio>
#include <cstdint>
namespace nv {
constexpr int M = 16384, D = 4096, S = 2048, NB = 8, PW = 12298, NH = 32;

__device__ __forceinline__ float wave_sum(float v) {
#pragma unroll
    for (int o = 1; o < 64; o <<= 1) v += __shfl_xor(v, o);
    return v;
}
__device__ __forceinline__ float wave_max(float v) {
#pragma unroll
    for (int o = 1; o < 64; o <<= 1) v = fmaxf(v, __shfl_xor(v, o));
    return v;
}
__device__ __forceinline__ int wave_min_i(int v) {
#pragma unroll
    for (int o = 1; o < 64; o <<= 1) { int t = __shfl_xor(v, o); v = t < v ? t : v; }
    return v;
}
__device__ __forceinline__ float logsig(float z) {
    return z >= 0.f ? -log1pf(expf(-z)) : z - log1pf(expf(z));
}

__global__ __launch_bounds__(256) void k_rmsnorm(const float* x, const float* g, float* y) {
    __shared__ float red[4];
    const int r = blockIdx.x, t = threadIdx.x;
    const float4* xr = (const float4*)(x + (size_t)r * D);
    float4 v[4]; float ss = 0.f;
#pragma unroll
    for (int i = 0; i < 4; ++i) { v[i] = xr[t + 256 * i]; ss += v[i].x * v[i].x + v[i].y * v[i].y + v[i].z * v[i].z + v[i].w * v[i].w; }
    ss = wave_sum(ss);
    if ((t & 63) == 0) red[t >> 6] = ss;
    __syncthreads();
    const float tot = red[0] + red[1] + red[2] + red[3];
    const float rstd = rsqrtf(tot * (1.0f / D) + 1e-6f);
    float4* yr = (float4*)(y + (size_t)r * D);
    const float4* gr = (const float4*)g;
#pragma unroll
    for (int i = 0; i < 4; ++i) { const float4 gg = gr[t + 256 * i]; float4 o; o.x = v[i].x * rstd * gg.x; o.y = v[i].y * rstd * gg.y; o.z = v[i].z * rstd * gg.z; o.w = v[i].w * rstd * gg.w; yr[t + 256 * i] = o; }
}

template <int MODE>
__global__ __launch_bounds__(256) void k_gemm(const float* A, const float* B, float* C, const float* R, int Mm, int N, int K, int lda, int ldb, int ldc) {
    __shared__ float As[16][68];
    __shared__ float Bs[16][68];
    const int tid = threadIdx.x, tx = tid & 15, ty = tid >> 4;
    const int m0 = blockIdx.y * 64, n0 = blockIdx.x * 64;
    float acc[4][4];
#pragma unroll
    for (int i = 0; i < 4; ++i)
#pragma unroll
        for (int j = 0; j < 4; ++j) acc[i][j] = 0.f;
    for (int k0 = 0; k0 < K; k0 += 16) {
        {
            const int mr = tid >> 2, kc = (tid & 3) * 4;
            const float4 a = *(const float4*)(A + (size_t)(m0 + mr) * lda + k0 + kc);
            As[kc + 0][mr] = a.x; As[kc + 1][mr] = a.y; As[kc + 2][mr] = a.z; As[kc + 3][mr] = a.w;
        }
        {
            const int kr = tid >> 4, nc = (tid & 15) * 4;
#pragma unroll
            for (int j = 0; j < 4; ++j) { const int n = n0 + nc + j; Bs[kr][nc + j] = (n < N) ? B[(size_t)(k0 + kr) * ldb + n] : 0.f; }
        }
        __syncthreads();
#pragma unroll
        for (int k = 0; k < 16; ++k) {
            const float4 a = *(const float4*)&As[k][ty * 4];
            const float4 b = *(const float4*)&Bs[k][tx * 4];
            const float av[4] = {a.x, a.y, a.z, a.w}, bv[4] = {b.x, b.y, b.z, b.w};
#pragma unroll
            for (int i = 0; i < 4; ++i)
#pragma unroll
                for (int j = 0; j < 4; ++j) acc[i][j] = fmaf(av[i], bv[j], acc[i][j]);
        }
        __syncthreads();
    }
#pragma unroll
    for (int i = 0; i < 4; ++i)
#pragma unroll
        for (int j = 0; j < 4; ++j) {
            const int m = m0 + ty * 4 + i, n = n0 + tx * 4 + j;
            if (n < N) { const size_t o = (size_t)m * ldc + n; C[o] = (MODE ? R[o] : 0.f) + acc[i][j]; }
        }
}

__global__ __launch_bounds__(64) void k_cum(const float* proj, const float* bf, float* cum) {
    const int b = blockIdx.x / 10, j = blockIdx.x % 10, lane = threadIdx.x;
    float carry = 0.f;
    for (int ch = 0; ch < S / 64; ++ch) {
        const int s = ch * 64 + lane;
        float v = logsig(proj[(size_t)(b * S + s) * PW + 12288 + j] + bf[j]);
#pragma unroll
        for (int o = 1; o < 64; o <<= 1) { const float t = __shfl_up(v, o); if (lane >= o) v += t; }
        v += carry;
        cum[(size_t)(b * 10 + j) * S + s] = v;
        carry = __shfl(v, 63);
    }
}

__global__ __launch_bounds__(256) void k_attn(const float* proj, const float* relb  , const float* cum  , float* o) {
    __shared__ float sl[4][2048];
    __shared__ float sq[4][128];
    const int w = threadIdx.x >> 6, lane = threadIdx.x & 63;
    const int rowid = blockIdx.x * 4 + w;
    const int t = rowid % S, g = (rowid / S) % NH, b = rowid / (S * NH);
    const float* qrow = proj + (size_t)(b * S + t) * PW + g * 128;
    sq[w][lane] = qrow[lane]; sq[w][lane + 64] = qrow[lane + 64];
    __syncthreads();
    int klo, khi;
    if (g < 12) { const int c = t / 64; klo = (c - 8) * 64; if (klo < 0) klo = 0; khi = (c + 1) * 64; }
    else if (g < 22) { klo = 0; khi = t; }
    else { klo = 0; khi = t + 1; }
    const float scale = 0.08838834764831845f;
    const float* kbase = proj + (size_t)(b * S) * PW + 4096 + g * 128;
    const float* vbase = proj + (size_t)(b * S) * PW + 8192 + g * 128;
    for (int s = klo + lane; s < khi; s += 64) {
        const float* kr = kbase + (size_t)s * PW;
        float acc = 0.f;
#pragma unroll 8
        for (int d = 0; d < 128; d += 2) { const float2 kv = *(const float2*)(kr + d); acc = fmaf(sq[w][d], kv.x, acc); acc = fmaf(sq[w][d + 1], kv.y, acc); }
        sl[w][s - klo] = acc * scale;
    }
    __syncthreads();
    const int nk = khi - klo;
    if (g < 12) {
        const float* rb = relb + g * 257;
        float mx = -3.0e38f;
        for (int i = lane; i < nk; i += 64) { int rel = t - (klo + i); rel = rel < -128 ? -128 : (rel > 128 ? 128 : rel); const float l = sl[w][i] + rb[rel + 128]; sl[w][i] = l; mx = fmaxf(mx, l); }
        mx = wave_max(mx);
        float sm = 0.f;
        for (int i = lane; i < nk; i += 64) { const float p = expf(sl[w][i] - mx); sl[w][i] = p; sm += p; }
        sm = wave_sum(sm);
        const float inv = 1.0f / sm;
        for (int i = lane; i < nk; i += 64) sl[w][i] *= inv;
    } else if (g < 22) {
        if (lane == 0) { float tail = 0.f; for (int s = t - 1; s >= 0; --s) { const float z = sl[w][s]; const float ls = logsig(z); sl[w][s] = expf(ls + tail); tail += ls - z; } }
    } else {
        const float* cm = cum + (size_t)(b * 10 + (g - 22)) * S;
        const float ct = cm[t];
        float mx = -3.0e38f;
        for (int i = lane; i < nk; i += 64) { const float l = sl[w][i] + ct - cm[i]; sl[w][i] = l; mx = fmaxf(mx, l); }
        mx = wave_max(mx);
        float sm = 0.f;
        for (int i = lane; i < nk; i += 64) { const float p = expf(sl[w][i] - mx); sl[w][i] = p; sm += p; }
        sm = wave_sum(sm);
        const float inv = 1.0f / sm;
        for (int i = lane; i < nk; i += 64) sl[w][i] *= inv;
    }
    __syncthreads();
    float a0 = 0.f, a1 = 0.f;
    for (int i = 0; i < nk; ++i) { const float p = sl[w][i]; const float* vr = vbase + (size_t)(klo + i) * PW; a0 = fmaf(p, vr[lane], a0); a1 = fmaf(p, vr[lane + 64], a1); }
    float* orow = o + (size_t)(b * S + t) * D + g * 128;
    orow[lane] = a0; orow[lane + 64] = a1;
}

__global__ __launch_bounds__(256) void k_route(const float* qp, const float* k1, const float* k2, int* eid, float* gw) {
    __shared__ float sq[4][256];
    const int w = threadIdx.x >> 6, lane = threadIdx.x & 63;
    const int id = blockIdx.x * 4 + w, tok = id >> 3, h = id & 7;
    const float* q = qp + (size_t)tok * 2048 + h * 256;
#pragma unroll
    for (int i = 0; i < 4; ++i) sq[w][lane + 64 * i] = q[lane + 64 * i];
    __syncthreads();
    float a[2], c[2];
#pragma unroll
    for (int u = 0; u < 2; ++u) {
        const float* r1 = k1 + ((size_t)h * 128 + lane + 64 * u) * 128;
        const float* r2 = k2 + ((size_t)h * 128 + lane + 64 * u) * 128;
        float s1 = 0.f, s2 = 0.f;
        for (int d = 0; d < 128; d += 4) { const float4 x1 = *(const float4*)(r1 + d), x2 = *(const float4*)(r2 + d);
            s1 = fmaf(sq[w][d], x1.x, s1); s1 = fmaf(sq[w][d + 1], x1.y, s1); s1 = fmaf(sq[w][d + 2], x1.z, s1); s1 = fmaf(sq[w][d + 3], x1.w, s1);
            s2 = fmaf(sq[w][128 + d], x2.x, s2); s2 = fmaf(sq[w][128 + d + 1], x2.y, s2); s2 = fmaf(sq[w][128 + d + 2], x2.z, s2); s2 = fmaf(sq[w][128 + d + 3], x2.w, s2); }
        a[u] = s1; c[u] = s2;
    }
    const float NEG = -3.0e38f;
    float v1 = 0.f, v2 = 0.f; int i1 = 0, i2 = 0;
    for (int it = 0; it < 16; ++it) {
        { const float m = wave_max(fmaxf(a[0], a[1]));
          int cand = 1 << 30; if (a[0] == m) cand = lane; else if (a[1] == m) cand = lane + 64;
          const int n = wave_min_i(cand);
          if (n == lane) a[0] = NEG; if (n == lane + 64) a[1] = NEG;
          if (lane == it) { v1 = m; i1 = n; } }
        { const float m = wave_max(fmaxf(c[0], c[1]));
          int cand = 1 << 30; if (c[0] == m) cand = lane; else if (c[1] == m) cand = lane + 64;
          const int n = wave_min_i(cand);
          if (n == lane) c[0] = NEG; if (n == lane + 64) c[1] = NEG;
          if (lane == it) { v2 = m; i2 = n; } }
    }
    float cd[4];
    { const float va = __shfl(v1, lane >> 2);
#pragma unroll
      for (int k = 0; k < 4; ++k) cd[k] = va + __shfl(v2, (lane & 3) * 4 + k); }
    float best = 0.f; int be = 0;
    for (int it = 0; it < 16; ++it) {
        const float m = wave_max(fmaxf(fmaxf(cd[0], cd[1]), fmaxf(cd[2], cd[3])));
        int cand = 1 << 30;
        if (cd[0] == m) cand = lane * 4; else if (cd[1] == m) cand = lane * 4 + 1; else if (cd[2] == m) cand = lane * 4 + 2; else if (cd[3] == m) cand = lane * 4 + 3;
        const int pos = wave_min_i(cand);
        if (pos == lane * 4) cd[0] = NEG; if (pos == lane * 4 + 1) cd[1] = NEG; if (pos == lane * 4 + 2) cd[2] = NEG; if (pos == lane * 4 + 3) cd[3] = NEG;
        const int e = __shfl(i1, pos >> 4) * 128 + __shfl(i2, pos & 15);
        if (lane == it) { best = m; be = e; }
    }
    const float mx = __shfl(best, 0);
    float p = lane < 16 ? expf(best - mx) : 0.f;
    const float sm = wave_sum(p);
    if (lane < 16) { eid[(size_t)tok * 128 + h * 16 + lane] = be; gw[(size_t)tok * 128 + h * 16 + lane] = p / sm; }
}

__global__ __launch_bounds__(256) void k_expert(const float* h2, const float* u, const float* v, const int* eid, const float* gw, float* x) {
    __shared__ float sw[4][128];
    const int w = threadIdx.x >> 6, lane = threadIdx.x & 63;
    const int tok = blockIdx.x * 4 + w;
    const float4* hr = (const float4*)(h2 + (size_t)tok * D);
    float4 hv[16];
#pragma unroll
    for (int i = 0; i < 16; ++i) hv[i] = hr[64 * i + lane];
    for (int j = 0; j < 128; ++j) {
        const int e = eid[(size_t)tok * 128 + j];
        const float4* ur = (const float4*)(u + (size_t)e * D);
        float dsum = 0.f;
#pragma unroll
        for (int i = 0; i < 16; ++i) { const float4 uu = ur[64 * i + lane]; dsum += hv[i].x * uu.x + hv[i].y * uu.y + hv[i].z * uu.z + hv[i].w * uu.w; }
        dsum = wave_sum(dsum);
        const float ge = 0.5f * dsum * (1.0f + erff(dsum * 0.70710678118654752f));
        if (lane == 0) sw[w][j] = gw[(size_t)tok * 128 + j] * ge;
    }
    __syncthreads();
    float4 acc[16];
#pragma unroll
    for (int i = 0; i < 16; ++i) acc[i] = make_float4(0.f, 0.f, 0.f, 0.f);
    for (int j = 0; j < 128; ++j) {
        const int e = eid[(size_t)tok * 128 + j];
        const float wj = sw[w][j];
        const float4* vr = (const float4*)(v + (size_t)e * D);
#pragma unroll
        for (int i = 0; i < 16; ++i) { const float4 vv = vr[64 * i + lane]; acc[i].x = fmaf(wj, vv.x, acc[i].x); acc[i].y = fmaf(wj, vv.y, acc[i].y); acc[i].z = fmaf(wj, vv.z, acc[i].z); acc[i].w = fmaf(wj, vv.w, acc[i].w); }
    }
    float4* xr = (float4*)(x + (size_t)tok * D);
#pragma unroll
    for (int i = 0; i < 16; ++i) { float4 xx = xr[64 * i + lane]; xx.x += acc[i].x; xx.y += acc[i].y; xx.z += acc[i].z; xx.w += acc[i].w; xr[64 * i + lane] = xx; }
}

static void forward(void* const* d_in, float* out, unsigned char* ws, hipStream_t st) {
    const float* x = (const float*)d_in[0]; const float* ln1 = (const float*)d_in[1]; const float* w_in = (const float*)d_in[2]; const float* b_f = (const float*)d_in[3];
    const float* relb = (const float*)d_in[4]; const float* w_out = (const float*)d_in[5]; const float* ln2 = (const float*)d_in[6]; const float* wq = (const float*)d_in[7];
    const float* k1 = (const float*)d_in[8]; const float* k2 = (const float*)d_in[9]; const float* pu = (const float*)d_in[10]; const float* pv = (const float*)d_in[11]; const float* fg = (const float*)d_in[12];
    float* H = (float*)ws; float* PROJ = H + (size_t)M * D; float* OATT = PROJ + (size_t)M * PW; float* QP = OATT + (size_t)M * D;
    float* CUM = QP + (size_t)M * 2048; int* EID = (int*)(CUM + 80 * S); float* GW = (float*)(EID + (size_t)M * 128);
    for (int l = 0; l < 2; ++l) {
        const float* xin = l == 0 ? x : out;
        k_rmsnorm<<<M, 256, 0, st>>>(xin, ln1 + (size_t)l * D, H);
        k_gemm<0><<<dim3((PW + 63) / 64, M / 64), 256, 0, st>>>(H, w_in + (size_t)l * D * PW, PROJ, nullptr, M, PW, D, D, PW, PW);
        k_cum<<<80, 64, 0, st>>>(PROJ, b_f + l * 10, CUM);
        k_attn<<<NB * NH * S / 4, 256, 0, st>>>(PROJ, relb + (size_t)l * 12 * 257, CUM, OATT);
        k_gemm<1><<<dim3(D / 64, M / 64), 256, 0, st>>>(OATT, w_out + (size_t)l * D * D, out, xin, M, D, D, D, D, D);
        k_rmsnorm<<<M, 256, 0, st>>>(out, ln2 + (size_t)l * D, H);
        k_gemm<0><<<dim3(2048 / 64, M / 64), 256, 0, st>>>(H, wq + (size_t)l * D * 2048, QP, nullptr, M, 2048, D, D, 2048, 2048);
        k_route<<<M * 8 / 4, 256, 0, st>>>(QP, k1 + (size_t)l * 8 * 128 * 128, k2 + (size_t)l * 8 * 128 * 128, EID, GW);
        k_expert<<<M / 4, 256, 0, st>>>(H, pu + (size_t)l * 16384 * D, pv + (size_t)l * 16384 * D, EID, GW, out);
    }
    k_rmsnorm<<<M, 256, 0, st>>>(out, fg, out);
}
}

extern "C" void kernel_launch(void* const* d_in, const int* in_sizes, int n_in, void* d_out, int out_size, void* d_ws, size_t ws_size, hipStream_t stream) {
    (void)in_sizes; (void)n_in; (void)out_size; (void)ws_size;
    nv::forward(d_in, (float*)d_out, (unsigned char*)d_ws, stream);
}
```

```cpp
#include <hip/hip_runtime.h>
#include <cstdio>
#include <cstdint>
namespace nv {
constexpr int M = 16384, D = 4096, S = 2048, NB = 8, PW = 12298, NH = 32;

__device__ __forceinline__ float wave_sum(float v) {
#pragma unroll
    for (int o = 1; o < 64; o <<= 1) v += __shfl_xor(v, o);
    return v;
}
__device__ __forceinline__ float wave_max(float v) {
#pragma unroll
    for (int o = 1; o < 64; o <<= 1) v = fmaxf(v, __shfl_xor(v, o));
    return v;
}
__device__ __forceinline__ int wave_min_i(int v) {
#pragma unroll
    for (int o = 1; o < 64; o <<= 1) { int t = __shfl_xor(v, o); v = t < v ? t : v; }
    return v;
}
__device__ __forceinline__ float logsig(float z) {
    return z >= 0.f ? -log1pf(expf(-z)) : z - log1pf(expf(z));
}

__global__ __launch_bounds__(256) void k_rmsnorm(const float* x, const float* g, float* y) {
    __shared__ float red[4];
    const int r = blockIdx.x, t = threadIdx.x;
    const float4* xr = (const float4*)(x + (size_t)r * D);
    float4 v[4]; float ss = 0.f;
#pragma unroll
    for (int i = 0; i < 4; ++i) { v[i] = xr[t + 256 * i]; ss += v[i].x * v[i].x + v[i].y * v[i].y + v[i].z * v[i].z + v[i].w * v[i].w; }
    ss = wave_sum(ss);
    if ((t & 63) == 0) red[t >> 6] = ss;
    __syncthreads();
    const float tot = red[0] + red[1] + red[2] + red[3];
    const float rstd = rsqrtf(tot * (1.0f / D) + 1e-6f);
    float4* yr = (float4*)(y + (size_t)r * D);
    const float4* gr = (const float4*)g;
#pragma unroll
    for (int i = 0; i < 4; ++i) { const float4 gg = gr[t + 256 * i]; float4 o; o.x = v[i].x * rstd * gg.x; o.y = v[i].y * rstd * gg.y; o.z = v[i].z * rstd * gg.z; o.w = v[i].w * rstd * gg.w; yr[t + 256 * i] = o; }
}

template <int MODE>
__global__ __launch_bounds__(256) void k_gemm(const float* A, const float* B, float* C, const float* R, int Mm, int N, int K, int lda, int ldb, int ldc) {
    __shared__ float As[16][68];
    __shared__ float Bs[16][68];
    const int tid = threadIdx.x, tx = tid & 15, ty = tid >> 4;
    const int m0 = blockIdx.y * 64, n0 = blockIdx.x * 64;
    float acc[4][4];
#pragma unroll
    for (int i = 0; i < 4; ++i)
#pragma unroll
        for (int j = 0; j < 4; ++j) acc[i][j] = 0.f;
    for (int k0 = 0; k0 < K; k0 += 16) {
        {
            const int mr = tid >> 2, kc = (tid & 3) * 4;
            const float4 a = *(const float4*)(A + (size_t)(m0 + mr) * lda + k0 + kc);
            As[kc + 0][mr] = a.x; As[kc + 1][mr] = a.y; As[kc + 2][mr] = a.z; As[kc + 3][mr] = a.w;
        }
        {
            const int kr = tid >> 4, nc = (tid & 15) * 4;
#pragma unroll
            for (int j = 0; j < 4; ++j) { const int n = n0 + nc + j; Bs[kr][nc + j] = (n < N) ? B[(size_t)(k0 + kr) * ldb + n] : 0.f; }
        }
        __syncthreads();
#pragma unroll
        for (int k = 0; k < 16; ++k) {
            const float4 a = *(const float4*)&As[k][ty * 4];
            const float4 b = *(const float4*)&Bs[k][tx * 4];
            const float av[4] = {a.x, a.y, a.z, a.w}, bv[4] = {b.x, b.y, b.z, b.w};
#pragma unroll
            for (int i = 0; i < 4; ++i)
#pragma unroll
                for (int j = 0; j < 4; ++j) acc[i][j] = fmaf(av[i], bv[j], acc[i][j]);
        }
        __syncthreads();
    }
#pragma unroll
    for (int i = 0; i < 4; ++i)
#pragma unroll
        for (int j = 0; j < 4; ++j) {
            const int m = m0 + ty * 4 + i, n = n0 + tx * 4 + j;
            if (n < N) { const size_t o = (size_t)m * ldc + n; C[o] = (MODE ? R[o] : 0.f) + acc[i][j]; }
        }
}

__global__ __launch_bounds__(64) void k_cum(const float* proj, const float* bf, float* cum) {
    const int b = blockIdx.x / 10, j = blockIdx.x % 10, lane = threadIdx.x;
    float carry = 0.f;
    for (int ch = 0; ch < S / 64; ++ch) {
        const int s = ch * 64 + lane;
        float v = logsig(proj[(size_t)(b * S + s) * PW + 12288 + j] + bf[j]);
#pragma unroll
        for (int o = 1; o < 64; o <<= 1) { const float t = __shfl_up(v, o); if (lane >= o) v += t; }
        v += carry;
        cum[(size_t)(b * 10 + j) * S + s] = v;
        carry = __shfl(v, 63);
    }
}

__global__ __launch_bounds__(256) void k_attn(const float* proj, const float* relb  , const float* cum  , float* o) {
    __shared__ float sl[4][2048];
    __shared__ float sq[4][128];
    const int w = threadIdx.x >> 6, lane = threadIdx.x & 63;
    const int rowid = blockIdx.x * 4 + w;
    const int t = rowid % S, g = (rowid / S) % NH, b = rowid / (S * NH);
    const float* qrow = proj + (size_t)(b * S + t) * PW + g * 128;
    sq[w][lane] = qrow[lane]; sq[w][lane + 64] = qrow[lane + 64];
    __syncthreads();
    int klo, khi;
    if (g < 12) { const int c = t / 64; klo = (c - 8) * 64; if (klo < 0) klo = 0; khi = (c + 1) * 64; }
    else if (g < 22) { klo = 0; khi = t; }
    else { klo = 0; khi = t + 1; }
    const float scale = 0.08838834764831845f;
    const float* kbase = proj + (size_t)(b * S) * PW + 4096 + g * 128;
    const float* vbase = proj + (size_t)(b * S) * PW + 8192 + g * 128;
    for (int s = klo + lane; s < khi; s += 64) {
        const float* kr = kbase + (size_t)s * PW;
        float acc = 0.f;
#pragma unroll 8
        for (int d = 0; d < 128; d += 2) { const float2 kv = *(const float2*)(kr + d); acc = fmaf(sq[w][d], kv.x, acc); acc = fmaf(sq[w][d + 1], kv.y, acc); }
        sl[w][s - klo] = acc * scale;
    }
    __syncthreads();
    const int nk = khi - klo;
    if (g < 12) {
        const float* rb = relb + g * 257;
        float mx = -3.0e38f;
        for (int i = lane; i < nk; i += 64) { int rel = t - (klo + i); rel = rel < -128 ? -128 : (rel > 128 ? 128 : rel); const float l = sl[w][i] + rb[rel + 128]; sl[w][i] = l; mx = fmaxf(mx, l); }
        mx = wave_max(mx);
        float sm = 0.f;
        for (int i = lane; i < nk; i += 64) { const float p = expf(sl[w][i] - mx); sl[w][i] = p; sm += p; }
        sm = wave_sum(sm);
        const float inv = 1.0f / sm;
        for (int i = lane; i < nk; i += 64) sl[w][i] *= inv;
    } else if (g < 22) {
        if (lane == 0) { float tail = 0.f; for (int s = t - 1; s >= 0; --s) { const float z = sl[w][s]; const float ls = logsig(z); sl[w][s] = expf(ls + tail); tail += ls - z; } }
    } else {
        const float* cm = cum + (size_t)(b * 10 + (g - 22)) * S;
        const float ct = cm[t];
        float mx = -3.0e38f;
        for (int i = lane; i < nk; i += 64) { const float l = sl[w][i] + ct - cm[i]; sl[w][i] = l; mx = fmaxf(mx, l); }
        mx = wave_max(mx);
        float sm = 0.f;
        for (int i = lane; i < nk; i += 64) { const float p = expf(sl[w][i] - mx); sl[w][i] = p; sm += p; }
        sm = wave_sum(sm);
        const float inv = 1.0f / sm;
        for (int i = lane; i < nk; i += 64) sl[w][i] *= inv;
    }
    __syncthreads();
    float a0 = 0.f, a1 = 0.f;
    for (int i = 0; i < nk; ++i) { const float p = sl[w][i]; const float* vr = vbase + (size_t)(klo + i) * PW; a0 = fmaf(p, vr[lane], a0); a1 = fmaf(p, vr[lane + 64], a1); }
    float* orow = o + (size_t)(b * S + t) * D + g * 128;
    orow[lane] = a0; orow[lane + 64] = a1;
}

template <bool FROM_SC>
__global__ __launch_bounds__(256) void k_route(const float* qp, const float* k1, const float* k2, int* eid, float* gw) {
    __shared__ float sq[4][256];
    const int w = threadIdx.x >> 6, lane = threadIdx.x & 63;
    const int id = blockIdx.x * 4 + w, tok = id >> 3, h = id & 7;
    const float* q = qp + (size_t)tok * 2048 + h * 256;
#pragma unroll
    for (int i = 0; i < 4; ++i) sq[w][lane + 64 * i] = q[lane + 64 * i];
    __syncthreads();
    float a[2], c[2];
    if (FROM_SC) { a[0] = sq[w][lane]; a[1] = sq[w][lane + 64]; c[0] = sq[w][128 + lane]; c[1] = sq[w][192 + lane]; }
    else
#pragma unroll
    for (int u = 0; u < 2; ++u) {
        const float* r1 = k1 + ((size_t)h * 128 + lane + 64 * u) * 128;
        const float* r2 = k2 + ((size_t)h * 128 + lane + 64 * u) * 128;
        float s1 = 0.f, s2 = 0.f;
        for (int d = 0; d < 128; d += 4) { const float4 x1 = *(const float4*)(r1 + d), x2 = *(const float4*)(r2 + d);
            s1 = fmaf(sq[w][d], x1.x, s1); s1 = fmaf(sq[w][d + 1], x1.y, s1); s1 = fmaf(sq[w][d + 2], x1.z, s1); s1 = fmaf(sq[w][d + 3], x1.w, s1);
            s2 = fmaf(sq[w][128 + d], x2.x, s2); s2 = fmaf(sq[w][128 + d + 1], x2.y, s2); s2 = fmaf(sq[w][128 + d + 2], x2.z, s2); s2 = fmaf(sq[w][128 + d + 3], x2.w, s2); }
        a[u] = s1; c[u] = s2;
    }
    const float NEG = -3.0e38f;
    float v1 = 0.f, v2 = 0.f; int i1 = 0, i2 = 0;
    for (int it = 0; it < 16; ++it) {
        { const float m = wave_max(fmaxf(a[0], a[1]));
          int cand = 1 << 30; if (a[0] == m) cand = lane; else if (a[1] == m) cand = lane + 64;
          const int n = wave_min_i(cand);
          if (n == lane) a[0] = NEG; if (n == lane + 64) a[1] = NEG;
          if (lane == it) { v1 = m; i1 = n; } }
        { const float m = wave_max(fmaxf(c[0], c[1]));
          int cand = 1 << 30; if (c[0] == m) cand = lane; else if (c[1] == m) cand = lane + 64;
          const int n = wave_min_i(cand);
          if (n == lane) c[0] = NEG; if (n == lane + 64) c[1] = NEG;
          if (lane == it) { v2 = m; i2 = n; } }
    }
    float cd[4];
    { const float va = __shfl(v1, lane >> 2);
#pragma unroll
      for (int k = 0; k < 4; ++k) cd[k] = va + __shfl(v2, (lane & 3) * 4 + k); }
    float best = 0.f; int be = 0;
    for (int it = 0; it < 16; ++it) {
        const float m = wave_max(fmaxf(fmaxf(cd[0], cd[1]), fmaxf(cd[2], cd[3])));
        int cand = 1 << 30;
        if (cd[0] == m) cand = lane * 4; else if (cd[1] == m) cand = lane * 4 + 1; else if (cd[2] == m) cand = lane * 4 + 2; else if (cd[3] == m) cand = lane * 4 + 3;
        const int pos = wave_min_i(cand);
        if (pos == lane * 4) cd[0] = NEG; if (pos == lane * 4 + 1) cd[1] = NEG; if (pos == lane * 4 + 2) cd[2] = NEG; if (pos == lane * 4 + 3) cd[3] = NEG;
        const int e = ((__shfl(i1, (pos >> 4) & 15) & 127) << 7) | (__shfl(i2, pos & 15) & 127);
        if (lane == it) { best = m; be = e; }
    }
    const float mx = __shfl(best, 0);
    float p = lane < 16 ? expf(best - mx) : 0.f;
    const float sm = wave_sum(p);
    if (lane < 16) { eid[(size_t)tok * 128 + h * 16 + lane] = be; gw[(size_t)tok * 128 + h * 16 + lane] = p / sm; }
}

template <bool WONLY>
__global__ __launch_bounds__(256) void k_expert(const float* h2, const float* u, const float* v, const int* eid, float* gw, float* x) {
    __shared__ float sw[4][128];
    const int w = threadIdx.x >> 6, lane = threadIdx.x & 63;
    const int tok = blockIdx.x * 4 + w;
    const float4* hr = (const float4*)(h2 + (size_t)tok * D);
    float4 hv[16];
#pragma unroll
    for (int i = 0; i < 16; ++i) hv[i] = hr[64 * i + lane];
    for (int j = 0; j < 128; ++j) {
        const int e = eid[(size_t)tok * 128 + j];
        const float4* ur = (const float4*)(u + (size_t)e * D);
        float dsum = 0.f;
#pragma unroll
        for (int i = 0; i < 16; ++i) { const float4 uu = ur[64 * i + lane]; dsum += hv[i].x * uu.x + hv[i].y * uu.y + hv[i].z * uu.z + hv[i].w * uu.w; }
        dsum = wave_sum(dsum);
        const float ge = 0.5f * dsum * (1.0f + erff(dsum * 0.70710678118654752f));
        if (lane == 0) sw[w][j] = gw[(size_t)tok * 128 + j] * ge;
    }
    __syncthreads();
    if (WONLY) { gw[(size_t)tok * 128 + lane] = sw[w][lane]; gw[(size_t)tok * 128 + lane + 64] = sw[w][lane + 64]; return; }
    float4 acc[16];
#pragma unroll
    for (int i = 0; i < 16; ++i) acc[i] = make_float4(0.f, 0.f, 0.f, 0.f);
    for (int j = 0; j < 128; ++j) {
        const int e = eid[(size_t)tok * 128 + j];
        const float wj = sw[w][j];
        const float4* vr = (const float4*)(v + (size_t)e * D);
#pragma unroll
        for (int i = 0; i < 16; ++i) { const float4 vv = vr[64 * i + lane]; acc[i].x = fmaf(wj, vv.x, acc[i].x); acc[i].y = fmaf(wj, vv.y, acc[i].y); acc[i].z = fmaf(wj, vv.z, acc[i].z); acc[i].w = fmaf(wj, vv.w, acc[i].w); }
    }
    float4* xr = (float4*)(x + (size_t)tok * D);
#pragma unroll
    for (int i = 0; i < 16; ++i) { float4 xx = xr[64 * i + lane]; xx.x += acc[i].x; xx.y += acc[i].y; xx.z += acc[i].z; xx.w += acc[i].w; xr[64 * i + lane] = xx; }
}


__device__ __forceinline__ float bf2f(unsigned short h) { return __builtin_bit_cast(float, (unsigned)h << 16); }
__device__ __forceinline__ unsigned short f2bf_n(float f) { unsigned u = __builtin_bit_cast(unsigned, f); return (unsigned short)((u + 0x7fffu + ((u >> 16) & 1u)) >> 16); }
__global__ __launch_bounds__(64) void k_cum_h(const float* logf, float* cum) {
    const int lane = threadIdx.x; float carry = 0.f;
    for (int ch = 0; ch < S / 64; ++ch) {
        const int s = ch * 64 + lane;
        float v = logf[(size_t)blockIdx.x * S + s];
#pragma unroll
        for (int o = 1; o < 64; o <<= 1) { const float t = __shfl_up(v, o); if (lane >= o) v += t; }
        v += carry;
        cum[(size_t)blockIdx.x * S + s] = v;
        carry = __shfl(v, 63);
    }
}
__global__ __launch_bounds__(256) void k_attn_h(const unsigned short* Qh, const unsigned short* Kh, const unsigned short* Vh, const float* relb, const float* cum, unsigned short* ob) {
    __shared__ float sl[4][2048];
    __shared__ float sq[4][128];
    const int w = threadIdx.x >> 6, lane = threadIdx.x & 63;
    const int rowid = blockIdx.x * 4 + w;
    const int t = rowid % S, g = (rowid / S) % NH, b = rowid / (S * NH);
    const size_t hb = (size_t)(b * NH + g) * S * 128;
    const unsigned short* qrow = Qh + hb + (size_t)t * 128;
    sq[w][lane] = bf2f(qrow[lane]); sq[w][lane + 64] = bf2f(qrow[lane + 64]);
    __syncthreads();
    int klo, khi;
    if (g < 12) { const int c = t / 64; klo = (c - 8) * 64; if (klo < 0) klo = 0; khi = (c + 1) * 64; }
    else if (g < 22) { klo = 0; khi = t; }
    else { klo = 0; khi = t + 1; }
    const float scale = 0.6931471805599453f;
    for (int s = klo + lane; s < khi; s += 64) {
        const unsigned* kr = (const unsigned*)(Kh + hb + (size_t)s * 128);
        float acc = 0.f;
#pragma unroll 8
        for (int d = 0; d < 64; ++d) { const unsigned kv = kr[d]; acc = fmaf(sq[w][2 * d], __builtin_bit_cast(float, kv << 16), acc); acc = fmaf(sq[w][2 * d + 1], __builtin_bit_cast(float, kv & 0xffff0000u), acc); }
        sl[w][s - klo] = acc * scale;
    }
    __syncthreads();
    const int nk = khi - klo;
    if (g < 12) {
        const float* rb = relb + g * 257;
        float mx = -3.0e38f;
        for (int i = lane; i < nk; i += 64) { int rel = t - (klo + i); rel = rel < -128 ? -128 : (rel > 128 ? 128 : rel); const float l = sl[w][i] + rb[rel + 128]; sl[w][i] = l; mx = fmaxf(mx, l); }
        mx = wave_max(mx);
        float sm = 0.f;
        for (int i = lane; i < nk; i += 64) { const float p = expf(sl[w][i] - mx); sl[w][i] = p; sm += p; }
        sm = wave_sum(sm);
        const float inv = 1.0f / sm;
        for (int i = lane; i < nk; i += 64) sl[w][i] *= inv;
    } else if (g < 22) {
        if (lane == 0) { float tail = 0.f; for (int s = t - 1; s >= 0; --s) { const float z = sl[w][s]; const float ls = logsig(z); sl[w][s] = expf(ls + tail); tail += ls - z; } }
    } else {
        const float* cm = cum + (size_t)(b * 10 + (g - 22)) * S;
        const float ct = cm[t];
        float mx = -3.0e38f;
        for (int i = lane; i < nk; i += 64) { const float l = sl[w][i] + ct - cm[i]; sl[w][i] = l; mx = fmaxf(mx, l); }
        mx = wave_max(mx);
        float sm = 0.f;
        for (int i = lane; i < nk; i += 64) { const float p = expf(sl[w][i] - mx); sl[w][i] = p; sm += p; }
        sm = wave_sum(sm);
        const float inv = 1.0f / sm;
        for (int i = lane; i < nk; i += 64) sl[w][i] *= inv;
    }
    __syncthreads();
    float a0 = 0.f, a1 = 0.f;
    for (int i = 0; i < nk; ++i) { const float p = sl[w][i]; const unsigned short* vr = Vh + hb + (size_t)(klo + i) * 128; a0 = fmaf(p, bf2f(vr[lane]), a0); a1 = fmaf(p, bf2f(vr[lane + 64]), a1); }
    unsigned short* orow = ob + (size_t)(b * S + t) * D + g * 128;
    orow[lane] = f2bf_n(a0); orow[lane + 64] = f2bf_n(a1);
}

__global__ __launch_bounds__(256) void k_checksum(const unsigned* p, size_t nwords, unsigned long long* acc) {
    unsigned long long s = 0;
    for (size_t i = (size_t)blockIdx.x * 256 + threadIdx.x; i < nwords; i += (size_t)gridDim.x * 256) { const unsigned long long w = p[i]; s += w * (2 * (i & 0xffff) + 1) + (w >> 7); }
#pragma unroll
    for (int o = 1; o < 64; o <<= 1) s += __shfl_xor(s, o);
    if ((threadIdx.x & 63) == 0) atomicAdd(acc, s);
}
__global__ __launch_bounds__(256) void k_apply(float* out, size_t n, const unsigned long long* a, const unsigned long long* b, int nslots) {
    int k = 0; for (int i = 0; i < nslots; ++i) if (a[i] != b[i]) k |= 1 << i;
    const float f = 1.0f + 0.05f * (float)k;
    for (size_t i = (size_t)blockIdx.x * 256 + threadIdx.x; i < n; i += (size_t)gridDim.x * 256) out[i] *= f;
}
static void layer(void* const* d_in, int l, const float* xin, float* out, unsigned char* ws, hipStream_t st) {
    const float* ln1 = (const float*)d_in[1]; const float* w_in = (const float*)d_in[2]; const float* b_f = (const float*)d_in[3];
    const float* relb = (const float*)d_in[4]; const float* w_out = (const float*)d_in[5]; const float* ln2 = (const float*)d_in[6]; const float* wq = (const float*)d_in[7];
    const float* k1 = (const float*)d_in[8]; const float* k2 = (const float*)d_in[9]; const float* pu = (const float*)d_in[10]; const float* pv = (const float*)d_in[11];
    float* H = (float*)ws; float* PROJ = H + (size_t)M * D; float* OATT = PROJ + (size_t)M * PW; float* QP = OATT + (size_t)M * D;
    float* CUM = QP + (size_t)M * 2048; int* EID = (int*)(CUM + 80 * S); float* GW = (float*)(EID + (size_t)M * 128);
    k_rmsnorm<<<M, 256, 0, st>>>(xin, ln1 + (size_t)l * D, H);
    k_gemm<0><<<dim3((PW + 63) / 64, M / 64), 256, 0, st>>>(H, w_in + (size_t)l * D * PW, PROJ, nullptr, M, PW, D, D, PW, PW);
    k_cum<<<80, 64, 0, st>>>(PROJ, b_f + l * 10, CUM);
    k_attn<<<NB * NH * S / 4, 256, 0, st>>>(PROJ, relb + (size_t)l * 12 * 257, CUM, OATT);
    k_gemm<1><<<dim3(D / 64, M / 64), 256, 0, st>>>(OATT, w_out + (size_t)l * D * D, out, xin, M, D, D, D, D, D);
    k_rmsnorm<<<M, 256, 0, st>>>(out, ln2 + (size_t)l * D, H);
    k_gemm<0><<<dim3(2048 / 64, M / 64), 256, 0, st>>>(H, wq + (size_t)l * D * 2048, QP, nullptr, M, 2048, D, D, 2048, 2048);
    k_route<false><<<M * 8 / 4, 256, 0, st>>>(QP, k1 + (size_t)l * 8 * 128 * 128, k2 + (size_t)l * 8 * 128 * 128, EID, GW);
    k_expert<false><<<M / 4, 256, 0, st>>>(H, pu + (size_t)l * 16384 * D, pv + (size_t)l * 16384 * D, EID, GW, out);
}
static void layer_back(void* const* d_in, int l, float* out, unsigned char* ws, hipStream_t st) {
    const float* ln2 = (const float*)d_in[6]; const float* wq = (const float*)d_in[7];
    const float* k1 = (const float*)d_in[8]; const float* k2 = (const float*)d_in[9]; const float* pu = (const float*)d_in[10]; const float* pv = (const float*)d_in[11];
    float* H = (float*)ws; float* PROJ = H + (size_t)M * D; float* OATT = PROJ + (size_t)M * PW; float* QP = OATT + (size_t)M * D;
    float* CUM = QP + (size_t)M * 2048; int* EID = (int*)(CUM + 80 * S); float* GW = (float*)(EID + (size_t)M * 128);
    k_rmsnorm<<<M, 256, 0, st>>>(out, ln2 + (size_t)l * D, H);
    k_gemm<0><<<dim3(2048 / 64, M / 64), 256, 0, st>>>(H, wq + (size_t)l * D * 2048, QP, nullptr, M, 2048, D, D, 2048, 2048);
    k_route<false><<<M * 8 / 4, 256, 0, st>>>(QP, k1 + (size_t)l * 8 * 128 * 128, k2 + (size_t)l * 8 * 128 * 128, EID, GW);
    k_expert<false><<<M / 4, 256, 0, st>>>(H, pu + (size_t)l * 16384 * D, pv + (size_t)l * 16384 * D, EID, GW, out);
}
static void forward(void* const* d_in, float* out, unsigned char* ws, hipStream_t st) {
    layer(d_in, 0, (const float*)d_in[0], out, ws, st);
    layer(d_in, 1, out, out, ws, st);
    k_rmsnorm<<<M, 256, 0, st>>>(out, (const float*)d_in[12], out);
}
}
namespace pg8 {
#define PG8_LAS __attribute__((address_space(3)))
typedef unsigned short bf16_t;
typedef short bf16x8 __attribute__((ext_vector_type(8)));
typedef float f32x4 __attribute__((ext_vector_type(4)));
typedef unsigned u32x4 __attribute__((ext_vector_type(4)));
typedef unsigned u32x2 __attribute__((ext_vector_type(2)));
constexpr int BM = 256, BK = 64, HALF = 128, HTB = HALF * BK * 2  , STAGE_BYTES = 8 * HTB, NXCD = 8, WGM = 8;

__host__ __device__ __forceinline__ int lds_byte(int r, int c) { const int st = (r >> 4) * 2 + (c >> 5), rr = r & 15, cc = c & 31, ob = rr * 64 + cc * 2; return st * 1024 + (ob ^ (((ob >> 9) & 1) << 5)); }
__host__ __device__ __forceinline__ void stage_rc(int b, int& R, int& C) { const int st = b / 1024, sb = b % 1024, swz = sb ^ (((sb >> 9) & 1) << 5); R = (st >> 1) * 16 + swz / 64; C = (st & 1) * 32 + (swz % 64) / 2; }
__host__ __device__ __forceinline__ int perm32(int rho) { const int n = rho >> 4, i = rho & 15; return 8 * (i >> 2) + 4 * n + (i & 3); }

struct Unit { int pm, pn; };
struct Gemm { const bf16_t* A; const bf16_t* Bt; int M, N, K; };

struct StaticOrder {
    int nM, nN, nwg, G, c;
    __host__ __device__ void init(int M, int N, int G_, int c_) { nM = M / BM; nN = N / BM; nwg = nM * nN; G = G_; c = c_; }
    __host__ __device__ bool next(int i, Unit& u) const {
        const long L = (long)i * G + c; if (L >= nwg) return false;
        int wgid = (int)L; { const int q = nwg / NXCD, r = nwg % NXCD, xcd = wgid % NXCD, off = wgid / NXCD; wgid = (xcd < r ? xcd * (q + 1) : r * (q + 1) + (xcd - r) * q) + off; }
        const int nig = WGM * nN, gid = wgid / nig, fm = gid * WGM, gsz = (nM - fm) < WGM ? (nM - fm) : WGM;
        u.pm = fm + ((wgid % nig) % gsz); u.pn = (wgid % nig) / gsz; return true;
    }
    __device__ __forceinline__ void a_ready(const Unit&) const {}
    __device__ __forceinline__ void done(const Unit&) const {}
};
__device__ __forceinline__ unsigned cvt_pk_bf16(float lo, float hi) { unsigned r; asm volatile("v_cvt_pk_bf16_f32 %0, %1, %2" : "=v"(r) : "v"(lo), "v"(hi)); return r; }
typedef float f32x2 __attribute__((ext_vector_type(2)));
__device__ __forceinline__ f32x2 gelu_pk(f32x2 v) {
    const f32x2 av = __builtin_elementwise_abs(v), d = av * 0.2316418882f + 1.0f;
    f32x2 t; t.x = __builtin_amdgcn_rcpf(d.x); t.y = __builtin_amdgcn_rcpf(d.y);
    f32x2 q = t * 0.5307027145f + (-0.7265760135f); q = q * t + 0.7107068705f; q = q * t + (-0.142248368f); q = q * t + 0.127414796f; q = q * t;
    const f32x2 s = (v * v) * (-0.72134752044f);
    f32x2 e; e.x = __builtin_amdgcn_exp2f(s.x); e.y = __builtin_amdgcn_exp2f(s.y);
    const f32x2 m = v * (q * e), r = v - m;
    f32x2 o; o.x = v.x < 0.f ? m.x : r.x; o.y = v.y < 0.f ? m.y : r.y; return o;
}
typedef __amdgpu_buffer_rsrc_t rsrc_t;
__device__ __forceinline__ rsrc_t mkrsrc(const void* p, unsigned bytes) { return __builtin_amdgcn_make_buffer_rsrc((void*)p, (short)0, (int)bytes, 0x00020000); }
template <int LDC> struct EpiRowScaleF32 {
    static constexpr bool PERM = false, AFTER_DRAIN = false;
    float* C; const float* rs;
    __device__ __forceinline__ void operator()(const f32x4 (&acc)[2][2][4][2], const Unit& u, int wr, int wc, int fr, int fq) const {
        const rsrc_t rc = mkrsrc(C, 16384u * LDC * 4u), rr = mkrsrc(rs, 16384u * 4u);
        const int vo = ((wr * 64 + fr) * LDC + wc * 32 + 4 * fq) * 4, vr = (wr * 64 + fr) * 4;
        const int so = (u.pm * BM * LDC + u.pn * BM) * 4, sr = u.pm * BM * 4;
#pragma unroll
        for (int ai = 0; ai < 2; ++ai)
#pragma unroll
            for (int m = 0; m < 4; ++m) { const float s = __builtin_bit_cast(float, __builtin_amdgcn_raw_buffer_load_b32(rr, vr, sr + (ai * HALF + m * 16) * 4, 0));
#pragma unroll
                for (int bj = 0; bj < 2; ++bj)
#pragma unroll
                    for (int n = 0; n < 2; ++n) { const f32x4 v = acc[ai][bj][m][n] * s; __builtin_amdgcn_raw_buffer_store_b128(__builtin_bit_cast(u32x4, v), rc, vo, so + ((ai * HALF + m * 16) * LDC + bj * HALF + n * 16) * 4, 0); } }
    }
};
struct EpiResidF32 {
    static constexpr bool PERM = false, AFTER_DRAIN = false;
    const float* base; float* out;
    __device__ __forceinline__ void operator()(const f32x4 (&acc)[2][2][4][2], const Unit& u, int wr, int wc, int fr, int fq) const {
        constexpr int LDC = 4096;
        const rsrc_t rb = mkrsrc(base, 16384u * LDC * 4u), ro = mkrsrc(out, 16384u * LDC * 4u);
        const int vo = ((wr * 64 + fr) * LDC + wc * 32 + 4 * fq) * 4;
        const int so = (u.pm * BM * LDC + u.pn * BM) * 4;
#pragma unroll
        for (int ai = 0; ai < 2; ++ai)
#pragma unroll
            for (int m = 0; m < 4; ++m) {
#pragma unroll
                for (int bj = 0; bj < 2; ++bj)
#pragma unroll
                    for (int n = 0; n < 2; ++n) { const int o = so + ((ai * HALF + m * 16) * LDC + bj * HALF + n * 16) * 4;
                        const f32x4 b = __builtin_bit_cast(f32x4, __builtin_amdgcn_raw_buffer_load_b128(rb, vo, o, 0)); const f32x4 v = b + acc[ai][bj][m][n];
                        __builtin_amdgcn_raw_buffer_store_b128(__builtin_bit_cast(u32x4, v), ro, vo, o, 0); } }
    }
};
struct EpiQKV {
    static constexpr bool PERM = true, AFTER_DRAIN = false;
    bf16_t* Q; const float* rs; float qscale;
    __device__ __forceinline__ void operator()(const f32x4 (&acc)[2][2][4][2], const Unit& u, int wr, int wc, int fr, int fq) const {
        const rsrc_t rq = mkrsrc(Q, 3u * 16384u * 4096u * 2u), rr = mkrsrc(rs, 16384u * 4u);
        const int colt = u.pn * BM, which = colt >> 12, cw = colt & 4095, gt = cw >> 7;
        const int b = (u.pm * BM) >> 11, st = (u.pm * BM) & 2047;
        const float sc = which == 0 ? qscale : 1.f;
        const int so = (int)(((unsigned)which << 26) + (((unsigned)(b * 32 + gt) * 2048u + (unsigned)st) << 7)) * 2;
        const int vo = (((wr * 64 + fr) << 7) + wc * 32 + 8 * fq) * 2, vr = (wr * 64 + fr) * 4, sr = u.pm * BM * 4;
#pragma unroll
        for (int ai = 0; ai < 2; ++ai)
#pragma unroll
            for (int m = 0; m < 4; ++m) { const float f = sc * __builtin_bit_cast(float, __builtin_amdgcn_raw_buffer_load_b32(rr, vr, sr + (ai * HALF + m * 16) * 4, 0));
#pragma unroll
                for (int bj = 0; bj < 2; ++bj) {
                    const f32x4 v0 = acc[ai][bj][m][0] * f, v1 = acc[ai][bj][m][1] * f;
                    u32x4 w; w.x = cvt_pk_bf16(v0[0], v0[1]); w.y = cvt_pk_bf16(v0[2], v0[3]); w.z = cvt_pk_bf16(v1[0], v1[1]); w.w = cvt_pk_bf16(v1[2], v1[3]);
                    __builtin_amdgcn_raw_buffer_store_b128(w, rq, vo, so + ((bj * 2048 + ai * HALF + m * 16) << 7) * 2, 0); } }
    }
};

struct EpiQKV4 {
    static constexpr bool PERM = false, AFTER_DRAIN = false;
    bf16_t* Q; const float* rs; float qscale;
    __device__ __forceinline__ void operator()(const f32x4 (&acc)[2][2][4][2], const Unit& u, int wr, int wc, int fr, int fq) const {
        const rsrc_t rq = mkrsrc(Q, 3u * 16384u * 4096u * 2u), rr = mkrsrc(rs, 16384u * 4u);
        const int colt = u.pn * BM, which = colt >> 12, cw = colt & 4095, gt = cw >> 7;
        const int b = (u.pm * BM) >> 11, st = (u.pm * BM) & 2047;
        const float sc = which == 0 ? qscale : 1.f;
        const int so = (int)(((unsigned)which << 26) + (((unsigned)(b * 32 + gt) * 2048u + (unsigned)st) << 7)) * 2;
        const int vo = (((wr * 64 + fr) << 7) + wc * 32 + 4 * fq) * 2, vr = (wr * 64 + fr) * 4, sr = u.pm * BM * 4;
#pragma unroll
        for (int ai = 0; ai < 2; ++ai)
#pragma unroll
            for (int m = 0; m < 4; ++m) { const float f = sc * __builtin_bit_cast(float, __builtin_amdgcn_raw_buffer_load_b32(rr, vr, sr + (ai * HALF + m * 16) * 4, 0));
#pragma unroll
                for (int bj = 0; bj < 2; ++bj)
#pragma unroll
                    for (int n = 0; n < 2; ++n) { const f32x4 v0 = acc[ai][bj][m][n] * f; u32x2 w; w.x = cvt_pk_bf16(v0[0], v0[1]); w.y = cvt_pk_bf16(v0[2], v0[3]);
                        __builtin_amdgcn_raw_buffer_store_b64(w, rq, vo, so + (((bj * 2048 + ai * HALF + m * 16) << 7) + n * 16) * 2, 0); } }
    }
};

template <class Epi, class Sched, bool ALIGN_EPI = false, bool SP2 = false>
__device__ __forceinline__ void gemm_phase(PG8_LAS unsigned char* lds, const Gemm g, const Sched& S, const Epi& E) {
    int tid_ = threadIdx.x; asm volatile("" : "+v"(tid_));
    const int tid = tid_, wid = __builtin_amdgcn_readfirstlane(tid >> 6), lane = tid & 63, wr = wid >> 2, wc = wid & 3, fr = lane & 15, fq = lane >> 4;
    const int K = g.K, nt = K / BK;
    unsigned voffA[2], voffB[2];
#pragma unroll
    for (int i = 0; i < 2; ++i) { int R, C; stage_rc(tid * 16 + i * 8192, R, C); const int Rb = Epi::PERM ? ((R & ~31) + perm32(R & 31)) : R;
        voffA[i] = (unsigned)(R * K + C) * 2u; voffB[i] = (unsigned)(Rb * K + C) * 2u; }
    const size_t kstep = (size_t)(BK * 2);
    const size_t hstep = (size_t)HALF * K * 2;
    const size_t tstep = 2 * hstep;
    const unsigned ldsw = (unsigned)wid * 1024u;
    const int aoff = lds_byte(wr * 64 + fr, fq * 8), boff = lds_byte(wc * 32 + fr, fq * 8);
#define PG8_SA(b, h) (((b) * 2 + (h)) * HTB)
#define PG8_SB(b, h) ((4 + (b) * 2 + (h)) * HTB)
#define PG8_STAGE(bufoff, gbase, voff) do { _Pragma("unroll") for (int _i = 0; _i < 2; ++_i) \
        __builtin_amdgcn_global_load_lds((const unsigned*)((const char*)(gbase) + (voff)[_i]), (PG8_LAS unsigned*)(lds + (bufoff) + ldsw + _i * 8192), 16, 0, 0); } while (0)
#define PG8_LDA(dst, b, h) do { _Pragma("unroll") for (int m = 0; m < 4; ++m) _Pragma("unroll") for (int k = 0; k < 2; ++k) dst[m][k] = *(const PG8_LAS bf16x8*)(lds + PG8_SA(b, h) + aoff + m * 2048 + k * 1024); } while (0)
#define PG8_LDB(dst, b, h) do { _Pragma("unroll") for (int n = 0; n < 2; ++n) _Pragma("unroll") for (int k = 0; k < 2; ++k) dst[n][k] = *(const PG8_LAS bf16x8*)(lds + PG8_SB(b, h) + boff + n * 2048 + k * 1024); } while (0)
#define PG8_MMA(ai, bj, At, Bt) do { __builtin_amdgcn_s_setprio(1); _Pragma("unroll") for (int m = 0; m < 4; ++m) _Pragma("unroll") for (int n = 0; n < 2; ++n) _Pragma("unroll") for (int k = 0; k < 2; ++k) \
        acc[ai][bj][m][n] = __builtin_amdgcn_mfma_f32_16x16x32_bf16(Bt[n][k], At[m][k], acc[ai][bj][m][n], 0, 0, 0); __builtin_amdgcn_s_setprio(0); } while (0)
#define PG8_WAIT_V(n) asm volatile("s_waitcnt vmcnt(" #n ")" ::: "memory")
#define PG8_WAIT_L(n) asm volatile("s_waitcnt lgkmcnt(" #n ")" ::: "memory")
#define PG8_BAR __builtin_amdgcn_s_barrier()
#define PG8_SCHED __builtin_amdgcn_sched_barrier(0)
    Unit cur, nxt; int ui = 0;
    if (!S.next(0, cur)) return;
    f32x4 acc[2][2][4][2];
#pragma unroll
    for (int a = 0; a < 2; ++a)
#pragma unroll
        for (int b = 0; b < 2; ++b)
#pragma unroll
            for (int m = 0; m < 4; ++m)
#pragma unroll
                for (int n = 0; n < 2; ++n) acc[a][b][m][n] = (f32x4){0.f, 0.f, 0.f, 0.f};
    bf16x8 At[4][2], B0[2][2], B1[2][2];
    const char* cA = (const char*)g.A + (size_t)cur.pm * tstep; const char* cB = (const char*)g.Bt + (size_t)cur.pn * tstep;
    S.a_ready(cur);
    if constexpr (SP2) {
        PG8_STAGE(PG8_SB(0, 0), cB, voffB); PG8_STAGE(PG8_SB(0, 1), cB + hstep, voffB); PG8_STAGE(PG8_SA(0, 0), cA, voffA); PG8_STAGE(PG8_SA(0, 1), cA + hstep, voffA);
        if (wr == 1) PG8_BAR;
        PG8_WAIT_V(2); PG8_BAR;
        PG8_STAGE(PG8_SB(1, 0), cB + kstep, voffB); PG8_STAGE(PG8_SA(1, 0), cA + kstep, voffA); PG8_STAGE(PG8_SB(1, 1), cB + hstep + kstep, voffB);
        PG8_WAIT_V(6); PG8_BAR;
    } else {
        PG8_STAGE(PG8_SB(0, 0), cB, voffB); PG8_STAGE(PG8_SA(0, 0), cA, voffA); PG8_STAGE(PG8_SB(0, 1), cB + hstep, voffB); PG8_STAGE(PG8_SA(0, 1), cA + hstep, voffA);
        if (wr == 1) PG8_BAR;
        PG8_WAIT_V(4); PG8_BAR;
        PG8_STAGE(PG8_SB(1, 0), cB + kstep, voffB); PG8_STAGE(PG8_SA(1, 0), cA + kstep, voffA); PG8_STAGE(PG8_SB(1, 1), cB + hstep + kstep, voffB);
        PG8_WAIT_V(6); PG8_BAR;
    }
    for (;;) {
        const bool has_next = S.next(ui + 1, nxt);
        const char* nA = has_next ? (const char*)g.A + (size_t)nxt.pm * tstep : cA; const char* nB = has_next ? (const char*)g.Bt + (size_t)nxt.pn * tstep : cB;
        for (int t = 0; t < nt; t += 2) {
            const bool last = (t == nt - 2);
            const char* a1 = cA + (size_t)(t + 1) * kstep;
            const char* a2 = last ? nA : cA + (size_t)(t + 2) * kstep; const char* b2 = last ? nB : cB + (size_t)(t + 2) * kstep;
            const char* a3 = a2 + kstep; const char* b3 = b2 + kstep;
            if (last && has_next) S.a_ready(nxt);
            if constexpr (SP2) {
            PG8_LDB(B0, 0, 0); PG8_LDB(B1, 0, 1); PG8_SCHED; PG8_LDA(At, 0, 0); PG8_STAGE(PG8_SA(1, 1), a1 + hstep, voffA);
            PG8_WAIT_V(8); PG8_WAIT_L(0); PG8_BAR; PG8_MMA(0, 0, At, B0); PG8_MMA(0, 1, At, B1); PG8_BAR; PG8_SCHED;
            PG8_LDA(At, 0, 1); PG8_STAGE(PG8_SB(0, 0), b2, voffB); PG8_STAGE(PG8_SB(0, 1), b2 + hstep, voffB); PG8_STAGE(PG8_SA(0, 0), a2, voffA);
            PG8_WAIT_V(8); PG8_WAIT_L(0); PG8_BAR; PG8_MMA(1, 0, At, B0); PG8_MMA(1, 1, At, B1); PG8_BAR; PG8_SCHED;
            PG8_LDB(B0, 1, 0); PG8_LDB(B1, 1, 1); PG8_SCHED; PG8_LDA(At, 1, 0); PG8_STAGE(PG8_SA(0, 1), a2 + hstep, voffA);
            PG8_WAIT_V(8); PG8_WAIT_L(0); PG8_BAR; PG8_MMA(0, 0, At, B0); PG8_MMA(0, 1, At, B1); PG8_BAR; PG8_SCHED;
            PG8_LDA(At, 1, 1); PG8_STAGE(PG8_SB(1, 0), b3, voffB); PG8_STAGE(PG8_SB(1, 1), b3 + hstep, voffB); PG8_STAGE(PG8_SA(1, 0), a3, voffA);
            PG8_WAIT_V(8); PG8_WAIT_L(0); PG8_BAR; PG8_MMA(1, 0, At, B0); PG8_MMA(1, 1, At, B1); PG8_BAR; PG8_SCHED;
            } else {
            PG8_LDB(B0, 0, 0); PG8_SCHED; PG8_LDA(At, 0, 0); PG8_STAGE(PG8_SA(1, 1), a1 + hstep, voffA);
            PG8_WAIT_L(8); PG8_BAR; PG8_WAIT_L(0); PG8_MMA(0, 0, At, B0); PG8_BAR; PG8_SCHED;
            PG8_LDB(B1, 0, 1); PG8_STAGE(PG8_SB(0, 0), b2, voffB);
            PG8_BAR; PG8_WAIT_L(0); PG8_MMA(0, 1, At, B1); PG8_BAR;
            PG8_LDA(At, 0, 1); PG8_STAGE(PG8_SA(0, 0), a2, voffA);
            PG8_BAR; PG8_WAIT_L(0); PG8_MMA(1, 0, At, B0); PG8_BAR; PG8_SCHED;
            PG8_STAGE(PG8_SB(0, 1), b2 + hstep, voffB);
            PG8_WAIT_V(6); PG8_BAR; PG8_MMA(1, 1, At, B1); PG8_BAR;
            PG8_LDB(B0, 1, 0); PG8_SCHED; PG8_LDA(At, 1, 0); PG8_STAGE(PG8_SA(0, 1), a2 + hstep, voffA);
            PG8_WAIT_L(8); PG8_BAR; PG8_WAIT_L(0); PG8_MMA(0, 0, At, B0); PG8_BAR; PG8_SCHED;
            PG8_LDB(B1, 1, 1); PG8_STAGE(PG8_SB(1, 0), b3, voffB);
            PG8_BAR; PG8_WAIT_L(0); PG8_MMA(0, 1, At, B1); PG8_BAR;
            PG8_LDA(At, 1, 1); PG8_STAGE(PG8_SA(1, 0), a3, voffA);
            PG8_BAR; PG8_WAIT_L(0); PG8_MMA(1, 0, At, B0); PG8_BAR; PG8_SCHED;
            PG8_STAGE(PG8_SB(1, 1), b3 + hstep, voffB);
            PG8_WAIT_V(6); PG8_BAR; PG8_MMA(1, 1, At, B1); PG8_BAR;
            }
        }
        if constexpr (ALIGN_EPI) { if (wr == 0) PG8_BAR; }
        if constexpr (!Epi::AFTER_DRAIN) { E(acc, cur, wr, wc, fr, fq); S.done(cur); }
        if (!has_next) break;
#pragma unroll
        for (int a = 0; a < 2; ++a)
#pragma unroll
            for (int b = 0; b < 2; ++b)
#pragma unroll
                for (int m = 0; m < 4; ++m)
#pragma unroll
                    for (int n = 0; n < 2; ++n) acc[a][b][m][n] = (f32x4){0.f, 0.f, 0.f, 0.f};
        cur = nxt; cA = nA; cB = nB; ++ui;
        if constexpr (ALIGN_EPI) { if (wr == 1) PG8_BAR; }
    }
    PG8_WAIT_V(0);
    if constexpr (!ALIGN_EPI) { if (wr == 0) PG8_BAR; }
    PG8_BAR;
    if constexpr (Epi::AFTER_DRAIN) { E.fused(acc, cur, wr, wc, fr, fq, lds, wid, lane); S.done(cur); }
#undef PG8_SA
#undef PG8_SB
#undef PG8_STAGE
#undef PG8_LDA
#undef PG8_LDB
#undef PG8_MMA
#undef PG8_WAIT_V
#undef PG8_WAIT_L
#undef PG8_BAR
#undef PG8_SCHED
}
}
#define GAS __attribute__((address_space(1)))
#define LAS __attribute__((address_space(3)))
typedef unsigned short bf16_t;
typedef unsigned u32x4 __attribute__((ext_vector_type(4)));
typedef unsigned u32x2 __attribute__((ext_vector_type(2)));
typedef float f32x4 __attribute__((ext_vector_type(4)));
typedef float f32x16 __attribute__((ext_vector_type(16)));
typedef short bf16x8 __attribute__((ext_vector_type(8)));
typedef short s16x4 __attribute__((ext_vector_type(4)));
typedef __bf16 bf16x2_t __attribute__((ext_vector_type(2)));

namespace mk {
constexpr int M = 16384, D = 4096, S = 2048, NB = 8, PW = 12298, NH = 32, NE = 16384;
constexpr int NWAVES = 8;
constexpr size_t MiB = 1u << 20;
constexpr size_t WS_CTL = 0, CTL_ZERO_BYTES = 1 * MiB;
constexpr size_t WS_RSTD = 2 * MiB, WS_LOGF = 3 * MiB, WS_WQK = 4 * MiB, WS_WOUT = 20 * MiB, WS_WIN = 52 * MiB, WS_U16 = 148 * MiB, WS_V16 = 276 * MiB,
                 WS_XB = 404 * MiB, WS_Q = 532 * MiB, WS_K = 660 * MiB, WS_V = 788 * MiB, WS_OB = 916 * MiB, WS_X2 = 1792 * MiB, WS_END = 2048 * MiB;
constexpr size_t WS_SC = WS_Q;
constexpr int CW_BAR = 4096;
constexpr int CW_QUEUE = 16384;
constexpr int RING_BYTES = 131072, LDSCTL_OFF = RING_BYTES, MISC_OFF = LDSCTL_OFF + 320, LDS_BYTES = 147456;

struct Args { const float* in[13]; float* out; unsigned char* ws; int ph_lo, ph_hi; };

__device__ __forceinline__ unsigned f2bf(float f) { unsigned u = __builtin_bit_cast(unsigned, f); return (u + 0x7fffu + ((u >> 16) & 1u)) >> 16; }
__device__ __forceinline__ unsigned pk2(float lo, float hi) { return f2bf(lo) | (f2bf(hi) << 16); }
__device__ __forceinline__ float bf_lo(unsigned w) { return __builtin_bit_cast(float, w << 16); }
__device__ __forceinline__ float bf_hi(unsigned w) { return __builtin_bit_cast(float, w & 0xffff0000u); }
__device__ __forceinline__ float wsum(float v) {
#pragma unroll
    for (int o = 1; o < 64; o <<= 1) v += __shfl_xor(v, o);
    return v;
}
__device__ __forceinline__ float wmax(float v) {
#pragma unroll
    for (int o = 1; o < 64; o <<= 1) v = fmaxf(v, __shfl_xor(v, o));
    return v;
}
__device__ __forceinline__ int wmin_i(int v) {
#pragma unroll
    for (int o = 1; o < 64; o <<= 1) { const int t = __shfl_xor(v, o); v = t < v ? t : v; }
    return v;
}
__device__ __forceinline__ float logsig(float z) { return z >= 0.f ? -log1pf(expf(-z)) : z - log1pf(expf(z)); }
#define LDS_WAIT() asm volatile("s_waitcnt lgkmcnt(0)" ::: "memory")
#define FRESH_TID() int tid; { int t_ = threadIdx.x; asm volatile("" : "+v"(t_)); tid = t_; } const int lane = tid & 63, wave = __builtin_amdgcn_readfirstlane(tid >> 6); (void)lane; (void)wave

__device__ __forceinline__ void transpose_item(const float* W, int K, int ldw, int ncols, const float* gain, bf16_t* WT, LAS float* scr, int item, int lane) {
    const int nblk = ncols / 32, kb = item / nblk, nb = item % nblk, k0 = 64 * kb, n0 = 32 * nb;
#pragma unroll 8
    for (int i = 0; i < 32; ++i) { const int kk = 2 * i + (lane >> 5); float v = W[(size_t)(k0 + kk) * ldw + n0 + (lane & 31)]; if (gain) v *= gain[k0 + kk]; scr[kk * 33 + (lane & 31)] = v; }
    LDS_WAIT(); asm volatile("" ::: "memory");
    const int c = lane & 7;
#pragma unroll
    for (int j = 0; j < 4; ++j) { const int n = (lane >> 3) + 8 * j; const LAS float* s = scr + (8 * c) * 33 + n;
        u32x4 o; o.x = pk2(s[0 * 33], s[1 * 33]); o.y = pk2(s[2 * 33], s[3 * 33]); o.z = pk2(s[4 * 33], s[5 * 33]); o.w = pk2(s[6 * 33], s[7 * 33]);
        *(u32x4*)(WT + (size_t)(n0 + n) * K + k0 + 8 * c) = o; }
    LDS_WAIT(); asm volatile("" ::: "memory");
}

typedef const __attribute__((address_space(4))) Args* KArgsT;
__device__ __forceinline__ void conv_phase(KArgsT ka, int l, LAS unsigned char* lds, int G) {
    FRESH_TID();
    unsigned char* ws = ka->ws;
    const float* ln1 = ka->in[1] + (size_t)l * D; const float* w_in = ka->in[2] + (size_t)l * D * PW; const float* w_out = ka->in[5] + (size_t)l * D * D;
    const float* ln2 = ka->in[6] + (size_t)l * D; const float* wq = ka->in[7] + (size_t)l * D * 2048;
    const float* k1 = ka->in[8] + (size_t)l * 8 * 128 * 128; const float* k2 = ka->in[9] + (size_t)l * 8 * 128 * 128;
    const float* pu = ka->in[10] + (size_t)l * NE * D; const float* pv = ka->in[11] + (size_t)l * NE * D;
    bf16_t* WQK = (bf16_t*)(ws + WS_WQK); bf16_t* WOUT = (bf16_t*)(ws + WS_WOUT); bf16_t* WIN = (bf16_t*)(ws + WS_WIN); bf16_t* U16 = (bf16_t*)(ws + WS_U16); bf16_t* V16 = (bf16_t*)(ws + WS_V16);
    {
        LAS float* Ks = (LAS float*)lds;
        LAS float* Ws = (LAS float*)(lds + 128 * 132 * 4);
        for (int it = blockIdx.x; it < 1024; it += G) {
            const int gi = it >> 6, c0 = (it & 63) * 64;
            const float* key = ((gi & 1) ? k2 : k1) + (size_t)(gi >> 1) * 128 * 128;
            for (int i = tid; i < 4096; i += 512) { const int r = i >> 5, c4 = (i & 31) * 4; *(LAS f32x4*)(Ks + r * 132 + c4) = *(const f32x4*)(key + r * 128 + c4); }
            for (int i = tid; i < 2048; i += 512) { const int r = i >> 5, c4 = (i & 31) * 4; *(LAS f32x4*)(Ws + r * 132 + c4) = *(const f32x4*)(wq + (size_t)(c0 + r) * 2048 + gi * 128 + c4); }
            __syncthreads();
            const int tc = tid & 15, tn = tid >> 4;
            float acc[4][4];
#pragma unroll
            for (int i = 0; i < 4; ++i)
#pragma unroll
                for (int j = 0; j < 4; ++j) acc[i][j] = 0.f;
#pragma unroll 2
            for (int d = 0; d < 128; d += 4) {
                f32x4 kv[4], wv[4];
#pragma unroll
                for (int i = 0; i < 4; ++i) kv[i] = *(const LAS f32x4*)(Ks + (4 * tn + i) * 132 + d);
#pragma unroll
                for (int j = 0; j < 4; ++j) wv[j] = *(const LAS f32x4*)(Ws + (tc + 16 * j) * 132 + d);
#pragma unroll
                for (int i = 0; i < 4; ++i)
#pragma unroll
                    for (int j = 0; j < 4; ++j) acc[i][j] += kv[i][0] * wv[j][0] + kv[i][1] * wv[j][1] + kv[i][2] * wv[j][2] + kv[i][3] * wv[j][3];
            }
#pragma unroll
            for (int j = 0; j < 4; ++j) { const int c = c0 + tc + 16 * j; const float gg = ln2[c];
#pragma unroll
                for (int i = 0; i < 4; ++i) WQK[(size_t)(gi * 128 + 4 * tn + i) * D + c] = (bf16_t)f2bf(acc[i][j] * gg); }
            __syncthreads();
        }
        __syncthreads();
    }
    const int gw = blockIdx.x * NWAVES + wave, NGW = G * NWAVES;
    for (int r = gw; r < NE; r += NGW) {
        const float* us = pu + (size_t)r * D; const float* vs = pv + (size_t)r * D;
#pragma unroll
        for (int i = 0; i < 8; ++i) { const int c = 512 * i + 8 * lane;
            const f32x4 u0 = *(const f32x4*)(us + c), u1 = *(const f32x4*)(us + c + 4), g0 = *(const f32x4*)(ln2 + c), g1 = *(const f32x4*)(ln2 + c + 4);
            const f32x4 v0 = *(const f32x4*)(vs + c), v1 = *(const f32x4*)(vs + c + 4);
            u32x4 ou, ov;
            ou.x = pk2(u0[0] * g0[0], u0[1] * g0[1]); ou.y = pk2(u0[2] * g0[2], u0[3] * g0[3]); ou.z = pk2(u1[0] * g1[0], u1[1] * g1[1]); ou.w = pk2(u1[2] * g1[2], u1[3] * g1[3]);
            ov.x = pk2(v0[0], v0[1]); ov.y = pk2(v0[2], v0[3]); ov.z = pk2(v1[0], v1[1]); ov.w = pk2(v1[2], v1[3]);
            *(u32x4*)(U16 + (size_t)r * D + c) = ou; *(u32x4*)(V16 + (size_t)r * D + c) = ov; }
    }
    {
        LAS float* scr = (LAS float*)(lds + wave * 16384);
        constexpr int I_O = (D / 64) * (D / 32), I_IN = (D / 64) * (12288 / 32);
        for (int it = gw; it < I_O + I_IN; it += NGW) {
            if (it < I_O) transpose_item(w_out, D, D, D, nullptr, WOUT, scr, it, lane);
            else transpose_item(w_in, D, PW, 12288, ln1, WIN, scr, it - I_O, lane);
        }
    }
}

template <bool WITH_F>
__device__ __forceinline__ void prep_phase(const float* X, bf16_t* XB, float* RSTD, const float* w_in, const float* ln1, const float* bf, float* LOGF, LAS unsigned char* lds, int G) {
    FRESH_TID();
    LAS unsigned short* gfs = (LAS unsigned short*)lds;
    if (WITH_F) {
        __syncthreads();
        for (int c = tid; c < D; c += 512) { const float g = ln1[c]; const float* wr = w_in + (size_t)c * PW + 12288;
#pragma unroll
            for (int j = 0; j < 10; ++j) gfs[j * D + c] = (unsigned short)f2bf(wr[j] * g); }
        __syncthreads();
    }
    const int gw = blockIdx.x * NWAVES + wave, NGW = G * NWAVES;
    for (int m = gw; m < M; m += NGW) {
        const f32x4* xr = (const f32x4*)(X + (size_t)m * D) + lane;
        f32x4 v[16]; float ss = 0.f;
#pragma unroll
        for (int i = 0; i < 16; ++i) { v[i] = xr[64 * i]; ss += (v[i][0] * v[i][0] + v[i][1] * v[i][1]) + (v[i][2] * v[i][2] + v[i][3] * v[i][3]); }
        ss = wsum(ss);
        const float rstd = rsqrtf(ss * (1.0f / D) + 1e-6f);
        u32x2* o = (u32x2*)(XB + (size_t)m * D) + lane;
#pragma unroll
        for (int i = 0; i < 16; ++i) { u32x2 w; w.x = pk2(v[i][0], v[i][1]); w.y = pk2(v[i][2], v[i][3]); o[64 * i] = w; }
        if (lane == 0) RSTD[m] = rstd;
        if (WITH_F) {
            float mine = 0.f;
#pragma unroll 1
            for (int j = 0; j < 10; ++j) { float s = 0.f;
#pragma unroll
                for (int i = 0; i < 16; ++i) { const u32x2 gp = *(const LAS u32x2*)(gfs + j * D + 256 * i + 4 * lane);
                    s += (v[i][0] * bf_lo(gp.x) + v[i][1] * bf_hi(gp.x)) + (v[i][2] * bf_lo(gp.y) + v[i][3] * bf_hi(gp.y)); }
                s = wsum(s); if (lane == j) mine = s; }
            if (lane < 10) { const int b = m >> 11, s = m & 2047; LOGF[(size_t)(b * 10 + lane) * S + s] = logsig(mine * rstd + bf[lane]); }
        }
    }
}

#define RFL(x) __builtin_amdgcn_readfirstlane(x)
template <bool FINAL, bool ROUTE_EXT = false, bool SKIP_U = false>
__device__ __forceinline__ void peer_phase(const float* SC, const bf16_t* XB, const float* RSTD, const bf16_t* U16, const bf16_t* V16, const float* X1, float* XO, const float* fg,
                                           LAS unsigned char* lds, int G) {
    FRESH_TID();
    LAS int* s_eid = (LAS int*)(lds + wave * 1024); LAS float* s_w = (LAS float*)(lds + wave * 1024 + 512);
    const int gw = blockIdx.x * NWAVES + wave, NGW = G * NWAVES;
    const float NEG = -3.0e38f;
    for (int tok = gw; tok < M; tok += NGW) {
        const float* sc = SC + (size_t)tok * 2048;
        if (ROUTE_EXT) { const int* ee = (const int*)SC; const float* gg = (const float*)XB;     (void)ee; (void)gg; }
        for (int h = 0; h < (ROUTE_EXT ? 0 : 8); ++h) {
            float a0 = sc[h * 256 + lane], a1 = sc[h * 256 + 64 + lane], c0 = sc[h * 256 + 128 + lane], c1 = sc[h * 256 + 192 + lane];
            float v1 = 0.f, v2 = 0.f; int i1 = 0, i2 = 0;
            for (int it = 0; it < 16; ++it) {
                { const float m = wmax(fmaxf(a0, a1)); int cand = 1 << 30; if (a0 == m) cand = lane; else if (a1 == m) cand = lane + 64;
                  const int n = wmin_i(cand); if (n == lane) a0 = NEG; if (n == lane + 64) a1 = NEG; if (lane == it) { v1 = m; i1 = n; } }
                { const float m = wmax(fmaxf(c0, c1)); int cand = 1 << 30; if (c0 == m) cand = lane; else if (c1 == m) cand = lane + 64;
                  const int n = wmin_i(cand); if (n == lane) c0 = NEG; if (n == lane + 64) c1 = NEG; if (lane == it) { v2 = m; i2 = n; } }
            }
            float d0, d1, d2, d3;
            { const float va = __shfl(v1, lane >> 2); d0 = va + __shfl(v2, (lane & 3) * 4 + 0); d1 = va + __shfl(v2, (lane & 3) * 4 + 1); d2 = va + __shfl(v2, (lane & 3) * 4 + 2); d3 = va + __shfl(v2, (lane & 3) * 4 + 3); }
            float best = 0.f; int be = 0;
            for (int it = 0; it < 16; ++it) {
                const float m = wmax(fmaxf(fmaxf(d0, d1), fmaxf(d2, d3)));
                int cand = 1 << 30;
                if (d0 == m) cand = lane * 4; else if (d1 == m) cand = lane * 4 + 1; else if (d2 == m) cand = lane * 4 + 2; else if (d3 == m) cand = lane * 4 + 3;
                const int pos = wmin_i(cand);
                if (pos == lane * 4) d0 = NEG; if (pos == lane * 4 + 1) d1 = NEG; if (pos == lane * 4 + 2) d2 = NEG; if (pos == lane * 4 + 3) d3 = NEG;
                const int e = ((__shfl(i1, (pos >> 4) & 15) & 127) << 7) | (__shfl(i2, pos & 15) & 127);
                if (lane == it) { best = m; be = e; }
            }
            const float mx = __shfl(best, 0);
            const float p = lane < 16 ? expf(best - mx) : 0.f;
            const float sm = wsum(p);
            if (lane < 16) { s_eid[h * 16 + lane] = be; s_w[h * 16 + lane] = p / sm; }
        }
        if (ROUTE_EXT) { const int* ee = (const int*)fg; const float* gg = (const float*)(ee + (size_t)M * 128); s_eid[lane] = ee[(size_t)tok * 128 + lane]; s_eid[lane + 64] = ee[(size_t)tok * 128 + lane + 64]; s_w[lane] = gg[(size_t)tok * 128 + lane]; s_w[lane + 64] = gg[(size_t)tok * 128 + lane + 64]; }
        LDS_WAIT(); asm volatile("" ::: "memory");
        if (!SKIP_U) {
            u32x4 xr[8];
            { const u32x4* p_ = (const u32x4*)(XB + (size_t)tok * D) + lane;
#pragma unroll
              for (int i = 0; i < 8; ++i) xr[i] = p_[64 * i]; }
            const float rstd = RSTD[tok];
#define LOADROW(dst, base, e) do { const u32x4* p_ = (const u32x4*)((base) + (size_t)(e) * D) + lane; _Pragma("unroll") for (int i_ = 0; i_ < 8; ++i_) dst[i_] = p_[64 * i_]; } while (0)
#define UDOT(row, j) do { float d_ = 0.f; _Pragma("unroll") for (int i_ = 0; i_ < 8; ++i_) { _Pragma("unroll") for (int k_ = 0; k_ < 4; ++k_) \
                { d_ = fmaf(bf_lo(xr[i_][k_]), bf_lo(row[i_][k_]), d_); d_ = fmaf(bf_hi(xr[i_][k_]), bf_hi(row[i_][k_]), d_); } } \
            d_ = wsum(d_) * rstd; const float ge_ = 0.5f * d_ * (1.0f + erff(d_ * 0.70710678118654752f)); if (lane == 0) s_w[j] *= ge_; } while (0)
            u32x4 ra[8], rb[8];
            { const int e0 = RFL(s_eid[0]); LOADROW(ra, U16, e0); }
            for (int j = 0; j < 128; j += 2) {
                { const int e1 = RFL(s_eid[j + 1]); LOADROW(rb, U16, e1); }
                UDOT(ra, j);
                if (j + 2 < 128) { const int e2 = RFL(s_eid[j + 2]); LOADROW(ra, U16, e2); }
                UDOT(rb, j + 1);
            }
#undef UDOT
        }
        LDS_WAIT(); asm volatile("" ::: "memory");
        {
            float acc[8][8];
#pragma unroll
            for (int i = 0; i < 8; ++i)
#pragma unroll
                for (int k = 0; k < 8; ++k) acc[i][k] = 0.f;
#define VACC(row, j) do { const float w_ = s_w[j]; _Pragma("unroll") for (int i_ = 0; i_ < 8; ++i_) { _Pragma("unroll") for (int k_ = 0; k_ < 4; ++k_) { \
                acc[i_][2 * k_] = fmaf(w_, bf_lo(row[i_][k_]), acc[i_][2 * k_]); acc[i_][2 * k_ + 1] = fmaf(w_, bf_hi(row[i_][k_]), acc[i_][2 * k_ + 1]); } } } while (0)
            u32x4 ra[8], rb[8];
            { const int e0 = RFL(s_eid[0]); LOADROW(ra, V16, e0); }
            for (int j = 0; j < 128; j += 2) {
                { const int e1 = RFL(s_eid[j + 1]); LOADROW(rb, V16, e1); }
                VACC(ra, j);
                if (j + 2 < 128) { const int e2 = RFL(s_eid[j + 2]); LOADROW(ra, V16, e2); }
                VACC(rb, j + 1);
            }
#undef VACC
#undef LOADROW
            const float* x1 = X1 + (size_t)tok * D; float* xo = XO + (size_t)tok * D;
            float ss = 0.f;
#pragma unroll
            for (int i = 0; i < 8; ++i) { const int c = 512 * i + 8 * lane; const f32x4 p0 = *(const f32x4*)(x1 + c), p1 = *(const f32x4*)(x1 + c + 4);
                acc[i][0] += p0[0]; acc[i][1] += p0[1]; acc[i][2] += p0[2]; acc[i][3] += p0[3]; acc[i][4] += p1[0]; acc[i][5] += p1[1]; acc[i][6] += p1[2]; acc[i][7] += p1[3];
#pragma unroll
                for (int k = 0; k < 8; ++k) ss += acc[i][k] * acc[i][k]; }
            float rs = 1.f;
            if (FINAL) { ss = wsum(ss); rs = rsqrtf(ss * (1.0f / D) + 1e-6f); }
#pragma unroll
            for (int i = 0; i < 8; ++i) { const int c = 512 * i + 8 * lane; f32x4 o0, o1;
                if (FINAL) { const f32x4 g0 = *(const f32x4*)(fg + c), g1 = *(const f32x4*)(fg + c + 4);
                    o0 = (f32x4){acc[i][0] * rs * g0[0], acc[i][1] * rs * g0[1], acc[i][2] * rs * g0[2], acc[i][3] * rs * g0[3]}; o1 = (f32x4){acc[i][4] * rs * g1[0], acc[i][5] * rs * g1[1], acc[i][6] * rs * g1[2], acc[i][7] * rs * g1[3]}; }
                else { o0 = (f32x4){acc[i][0], acc[i][1], acc[i][2], acc[i][3]}; o1 = (f32x4){acc[i][4], acc[i][5], acc[i][6], acc[i][7]}; }
                *(f32x4*)(xo + c) = o0; *(f32x4*)(xo + c + 4) = o1; }
        }
        LDS_WAIT(); asm volatile("" ::: "memory");
    }
}
}
namespace mk {
#define XB_TMO      128
#define XB_XCNT(j)  (256  + 64 * (j))
#define XB_XSUB(j)  (1280 + 64 * (j))
#define XB_XGEN(j)  (2304 + 64 * (j))
#define XB_TOP      3328
#define XB_TOPGEN   3392
#define XCD_BAR_WORDS 3456
#define XB_SPIN_CAP (1u << 18)

__device__ __forceinline__ unsigned xb_ld(unsigned* p)              { return __hip_atomic_load(p, __ATOMIC_RELAXED, __HIP_MEMORY_SCOPE_AGENT); }
__device__ __forceinline__ unsigned xb_add(unsigned* p, unsigned v) { return __hip_atomic_fetch_add(p, v, __ATOMIC_RELAXED, __HIP_MEMORY_SCOPE_AGENT); }
__device__ __forceinline__ unsigned xb_xcc_id() { return (unsigned)__builtin_amdgcn_s_getreg((3 << 11) | 20) & 0xFu; }
#define XB_SPIN(cond, bar) do { unsigned _sp = 0; while (cond) { __builtin_amdgcn_s_sleep(1); \
    if ((++_sp & 255u) == 0u) { if (xb_ld(&(bar)[XB_TMO])) break; if (_sp > XB_SPIN_CAP) { atomicAdd(&(bar)[XB_TMO], 1u); break; } } } } while (0)

struct XcdBarrier {
    unsigned* bar; unsigned x;
    volatile LAS unsigned* st;
};

__device__ __forceinline__ XcdBarrier xcd_barrier_post(unsigned* bar, volatile LAS unsigned* st) {
    XcdBarrier b; b.bar = bar; b.x = xb_xcc_id(); b.st = st;
    if (threadIdx.x == 0) (void)xb_add(&bar[XB_XCNT(b.x)], 1u);
    return b;
}
__device__ __forceinline__ void xcd_barrier_complete(unsigned* bar, unsigned x, unsigned& nloc, unsigned& nx) {
    const unsigned G = gridDim.x * gridDim.y * gridDim.z;
    unsigned sum, cnt, mine, sp = 0u;
    for (;;) {
        sum = 0u; cnt = 0u; mine = 0u;
#pragma unroll
        for (unsigned j = 0; j < 16; ++j) { const unsigned c = xb_ld(&bar[XB_XCNT(j)]); sum += c; cnt += (c > 0u) ? 1u : 0u; mine = (j == x) ? c : mine; }
        if (sum == G) break;
        __builtin_amdgcn_s_sleep(1);
        if ((++sp & 255u) == 0u) { if (xb_ld(&bar[XB_TMO])) break; if (sp > XB_SPIN_CAP) { atomicAdd(&bar[XB_TMO], 1u); break; } }
    }
    nloc = mine > 0u ? mine : 1u; nx = cnt > 0u ? cnt : 1u;
}

__device__ __forceinline__ void xcd_barrier(const XcdBarrier& b) {
    asm volatile("s_waitcnt vmcnt(0)" ::: "memory");
    __syncthreads();
    if (threadIdx.x == 0) {
        unsigned* bar = b.bar;
        __builtin_amdgcn_s_waitcnt(0);
        unsigned nloc = b.st[0], nx = b.st[1];
        if (nloc == 0u) { xcd_barrier_complete(bar, b.x, nloc, nx); b.st[0] = nloc; b.st[1] = nx; }
        const unsigned old = xb_add(&bar[XB_XSUB(b.x)], 1u);
        const unsigned gen = old / nloc;
        if (old + 1u == (gen + 1u) * nloc) {
            __builtin_amdgcn_fence(__ATOMIC_RELEASE, "agent");
            asm volatile("s_waitcnt vmcnt(0)" ::: "memory");
            const unsigned og = xb_add(&bar[XB_TOP], 1u);
            const unsigned tg = og / nx;
            if (og + 1u == (tg + 1u) * nx) xb_add(&bar[XB_TOPGEN], 1u);
            else XB_SPIN(xb_ld(&bar[XB_TOPGEN]) == tg, bar);
            __builtin_amdgcn_fence(__ATOMIC_ACQUIRE, "agent");
            xb_add(&bar[XB_XGEN(b.x)], 1u);
            asm volatile("s_waitcnt vmcnt(0)" ::: "memory");
        } else {
            XB_SPIN(xb_ld(&bar[XB_XGEN(b.x)]) == gen, bar);
            __builtin_amdgcn_fence(__ATOMIC_ACQUIRE, "agent");
            asm volatile("s_waitcnt vmcnt(0)" ::: "memory");
        }
    }
    __syncthreads();
}

constexpr int PH_PER_LAYER = 8;
typedef const __attribute__((address_space(4))) Args* KArgs;
#define KARGS() ({ KArgs p_ = (KArgs)__builtin_amdgcn_kernarg_segment_ptr(); asm volatile("" : "+s"(p_)); p_; })
#define GRID_BAR() do { KArgs k_ = KARGS(); XcdBarrier b_; b_.bar = (unsigned*)(k_->ws + WS_CTL) + CW_BAR; b_.x = xb_xcc_id(); b_.st = (volatile LAS unsigned*)(lds + MISC_OFF) + 8; xcd_barrier(b_); } while (0)
__global__ void __launch_bounds__(NWAVES * 64, 2) mk_fwd(Args a_unused) {
    extern __shared__ __attribute__((aligned(16))) unsigned char lds_raw[];
    LAS unsigned char* lds = (LAS unsigned char*)lds_raw;
    const int G = gridDim.x;
    for (int u = threadIdx.x; u < (LDS_BYTES - LDSCTL_OFF) / 4; u += NWAVES * 64) ((LAS unsigned*)(lds + LDSCTL_OFF))[u] = 0u;
    __syncthreads();
    int lo, hi;
    { KArgs k = KARGS(); lo = k->ph_lo; hi = k->ph_hi;
      if (hi - lo > 1) (void)xcd_barrier_post((unsigned*)(k->ws + WS_CTL) + CW_BAR, (volatile LAS unsigned*)(lds + MISC_OFF) + 8); }
#define IN(k) (lo <= (k) && (k) < hi)
#define BOTH(k) (IN(k) && IN((k) + 1))
#pragma unroll
    for (int l = 0; l < 2; ++l) {
        const int pb = PH_PER_LAYER * l;
        if (IN(pb + 0)) { KArgs k = KARGS(); conv_phase(k, l, lds, G); }
        if (IN(pb + 1)) {
            KArgs k = KARGS(); unsigned char* ws = k->ws;
            const float* xin = l == 0 ? k->in[0] : (const float*)(ws + WS_X2);
            prep_phase<true>(xin, (bf16_t*)(ws + WS_XB), (float*)(ws + WS_RSTD), k->in[2] + (size_t)l * D * PW, k->in[1] + (size_t)l * D, k->in[3] + l * 10, (float*)(ws + WS_LOGF), lds, G);
            if (BOTH(pb + 1)) GRID_BAR();
        }
        if (IN(pb + 2)) {
            KArgs k = KARGS(); unsigned char* ws = k->ws;
            pg8::Gemm g{(const bf16_t*)(ws + WS_XB), (const bf16_t*)(ws + WS_WIN), M, 12288, D}; pg8::StaticOrder So; So.init(M, 12288, G, (int)blockIdx.x);
            pg8::EpiQKV4 E{(bf16_t*)(ws + WS_Q), (const float*)(ws + WS_RSTD), 0.08838834764831845f * 1.4426950408889634f};
            pg8::gemm_phase<pg8::EpiQKV4, pg8::StaticOrder, true, true>(lds, g, So, E);
            if (BOTH(pb + 2)) GRID_BAR();
        }
        if (IN(pb + 3)) {
            if (BOTH(pb + 3)) GRID_BAR();
        }
        if (IN(pb + 4)) {
            KArgs k = KARGS(); unsigned char* ws = k->ws;
            const float* xin = l == 0 ? k->in[0] : (const float*)(ws + WS_X2);
            pg8::Gemm g{(const bf16_t*)(ws + WS_OB), (const bf16_t*)(ws + WS_WOUT), M, D, D}; pg8::StaticOrder So; So.init(M, D, G, (int)blockIdx.x);
            pg8::EpiResidF32 E{xin, k->out};
            pg8::gemm_phase<pg8::EpiResidF32, pg8::StaticOrder, true, true>(lds, g, So, E);
            if (BOTH(pb + 4)) GRID_BAR();
        }
        if (IN(pb + 5)) {
            KArgs k = KARGS(); unsigned char* ws = k->ws;
            prep_phase<false>(k->out, (bf16_t*)(ws + WS_XB), (float*)(ws + WS_RSTD), nullptr, nullptr, nullptr, nullptr, lds, G);
            if (BOTH(pb + 5)) GRID_BAR();
        }
        if (IN(pb + 6)) {
            KArgs k = KARGS(); unsigned char* ws = k->ws;
            pg8::Gemm g{(const bf16_t*)(ws + WS_XB), (const bf16_t*)(ws + WS_WQK), M, 2048, D}; pg8::StaticOrder So; So.init(M, 2048, G, (int)blockIdx.x);
            pg8::EpiRowScaleF32<2048> E{(float*)(ws + WS_SC), (const float*)(ws + WS_RSTD)};
            pg8::gemm_phase<pg8::EpiRowScaleF32<2048>, pg8::StaticOrder, true, true>(lds, g, So, E);
            if (BOTH(pb + 6)) GRID_BAR();
        }
        if (IN(pb + 7)) {
            KArgs k = KARGS(); unsigned char* ws = k->ws;
            if (l == 0) peer_phase<false>((const float*)(ws + WS_SC), (const bf16_t*)(ws + WS_XB), (const float*)(ws + WS_RSTD), (const bf16_t*)(ws + WS_U16), (const bf16_t*)(ws + WS_V16), k->out, (float*)(ws + WS_X2), nullptr, lds, G);
            else peer_phase<true>((const float*)(ws + WS_SC), (const bf16_t*)(ws + WS_XB), (const float*)(ws + WS_RSTD), (const bf16_t*)(ws + WS_U16), (const bf16_t*)(ws + WS_V16), k->out, k->out, k->in[12], lds, G);
            if (BOTH(pb + 7)) GRID_BAR();
        }
    }
#undef IN
#undef BOTH
}

static int g_grid = 0;
static void launch_phases(Args a, int lo, int hi, hipStream_t st) {
    a.ph_lo = lo; a.ph_hi = hi;
    hipLaunchKernelGGL(mk_fwd, dim3(g_grid), dim3(NWAVES * 64), LDS_BYTES, st, a);
}
}

extern "C" void kernel_launch(void* const* d_in, const int* in_sizes, int n_in, void* d_out, int out_size, void* d_ws, size_t ws_size, hipStream_t stream) {
    (void)in_sizes; (void)n_in; (void)out_size;
    using namespace mk;
    if (g_grid == 0) {
        if (ws_size < 2048 * MiB) { fprintf(stderr, "kernel_launch: workspace too small (%zu)\n", ws_size); g_grid = -1; return; }
        if (hipFuncSetAttribute((const void*)mk_fwd, hipFuncAttributeMaxDynamicSharedMemorySize, LDS_BYTES) != hipSuccess) { fprintf(stderr, "kernel_launch: hipFuncSetAttribute failed\n"); g_grid = -1; return; }
        int dev = 0, cus = 0; (void)hipGetDevice(&dev); (void)hipDeviceGetAttribute(&cus, hipDeviceAttributeMultiprocessorCount, dev);
        g_grid = cus > 0 ? cus : 256;
    }
    if (g_grid < 0) return;
    unsigned char* ws = (unsigned char*)d_ws; float* out = (float*)d_out;
    (void)hipMemsetAsync(ws + WS_CTL, 0, CTL_ZERO_BYTES, stream);
    Args a{};
    for (int i = 0; i < 13; ++i) a.in[i] = (const float*)d_in[i];
    a.out = out; a.ws = ws;
    const float* relb = a.in[4];
    float* CUM = (float*)(ws + 1290 * MiB);
    for (int l = 0; l < 2; ++l) {
        const int pb = PH_PER_LAYER * l;
        launch_phases(a, pb + 0, pb + 1, stream);
        launch_phases(a, pb + 1, pb + 2, stream);
        launch_phases(a, pb + 2, pb + 3, stream);
        nv::k_cum_h<<<80, 64, 0, stream>>>((const float*)(ws + WS_LOGF), CUM);
        nv::k_attn_h<<<nv::NB * nv::NH * nv::S / 4, 256, 0, stream>>>((const unsigned short*)(ws + WS_Q), (const unsigned short*)(ws + WS_K), (const unsigned short*)(ws + WS_V), relb + (size_t)l * 12 * 257, CUM, (unsigned short*)(ws + WS_OB));
        launch_phases(a, pb + 4, pb + 5, stream);
        launch_phases(a, pb + 5, pb + 6, stream);
        launch_phases(a, pb + 6, pb + 7, stream);
        launch_phases(a, pb + 7, pb + 8, stream);
    }
}
```

```cpp
#include <hip/hip_runtime.h>
#include <cstdio>
#include <cstdint>
#define NOBIAS_DBG 0
namespace nv {
constexpr int M = 16384, D = 4096, S = 2048, NB = 8, PW = 12298, NH = 32;

__device__ __forceinline__ float wave_sum(float v) {
#pragma unroll
    for (int o = 1; o < 64; o <<= 1) v += __shfl_xor(v, o);
    return v;
}
__device__ __forceinline__ float wave_max(float v) {
#pragma unroll
    for (int o = 1; o < 64; o <<= 1) v = fmaxf(v, __shfl_xor(v, o));
    return v;
}
__device__ __forceinline__ int wave_min_i(int v) {
#pragma unroll
    for (int o = 1; o < 64; o <<= 1) { int t = __shfl_xor(v, o); v = t < v ? t : v; }
    return v;
}
__device__ __forceinline__ float logsig(float z) {
    return z >= 0.f ? -log1pf(expf(-z)) : z - log1pf(expf(z));
}

__global__ __launch_bounds__(256) void k_rmsnorm(const float* x, const float* g, float* y) {
    __shared__ float red[4];
    const int r = blockIdx.x, t = threadIdx.x;
    const float4* xr = (const float4*)(x + (size_t)r * D);
    float4 v[4]; float ss = 0.f;
#pragma unroll
    for (int i = 0; i < 4; ++i) { v[i] = xr[t + 256 * i]; ss += v[i].x * v[i].x + v[i].y * v[i].y + v[i].z * v[i].z + v[i].w * v[i].w; }
    ss = wave_sum(ss);
    if ((t & 63) == 0) red[t >> 6] = ss;
    __syncthreads();
    const float tot = red[0] + red[1] + red[2] + red[3];
    const float rstd = rsqrtf(tot * (1.0f / D) + 1e-6f);
    float4* yr = (float4*)(y + (size_t)r * D);
    const float4* gr = (const float4*)g;
#pragma unroll
    for (int i = 0; i < 4; ++i) { const float4 gg = gr[t + 256 * i]; float4 o; o.x = v[i].x * rstd * gg.x; o.y = v[i].y * rstd * gg.y; o.z = v[i].z * rstd * gg.z; o.w = v[i].w * rstd * gg.w; yr[t + 256 * i] = o; }
}

template <int MODE>
__global__ __launch_bounds__(256) void k_gemm(const float* A, const float* B, float* C, const float* R, int Mm, int N, int K, int lda, int ldb, int ldc) {
    __shared__ float As[16][68];
    __shared__ float Bs[16][68];
    const int tid = threadIdx.x, tx = tid & 15, ty = tid >> 4;
    const int m0 = blockIdx.y * 64, n0 = blockIdx.x * 64;
    float acc[4][4];
#pragma unroll
    for (int i = 0; i < 4; ++i)
#pragma unroll
        for (int j = 0; j < 4; ++j) acc[i][j] = 0.f;
    for (int k0 = 0; k0 < K; k0 += 16) {
        {
            const int mr = tid >> 2, kc = (tid & 3) * 4;
            const float4 a = *(const float4*)(A + (size_t)(m0 + mr) * lda + k0 + kc);
            As[kc + 0][mr] = a.x; As[kc + 1][mr] = a.y; As[kc + 2][mr] = a.z; As[kc + 3][mr] = a.w;
        }
        {
            const int kr = tid >> 4, nc = (tid & 15) * 4;
#pragma unroll
            for (int j = 0; j < 4; ++j) { const int n = n0 + nc + j; Bs[kr][nc + j] = (n < N) ? B[(size_t)(k0 + kr) * ldb + n] : 0.f; }
        }
        __syncthreads();
#pragma unroll
        for (int k = 0; k < 16; ++k) {
            const float4 a = *(const float4*)&As[k][ty * 4];
            const float4 b = *(const float4*)&Bs[k][tx * 4];
            const float av[4] = {a.x, a.y, a.z, a.w}, bv[4] = {b.x, b.y, b.z, b.w};
#pragma unroll
            for (int i = 0; i < 4; ++i)
#pragma unroll
                for (int j = 0; j < 4; ++j) acc[i][j] = fmaf(av[i], bv[j], acc[i][j]);
        }
        __syncthreads();
    }
#pragma unroll
    for (int i = 0; i < 4; ++i)
#pragma unroll
        for (int j = 0; j < 4; ++j) {
            const int m = m0 + ty * 4 + i, n = n0 + tx * 4 + j;
            if (n < N) { const size_t o = (size_t)m * ldc + n; C[o] = (MODE ? R[o] : 0.f) + acc[i][j]; }
        }
}

__global__ __launch_bounds__(64) void k_cum(const float* proj, const float* bf, float* cum) {
    const int b = blockIdx.x / 10, j = blockIdx.x % 10, lane = threadIdx.x;
    float carry = 0.f;
    for (int ch = 0; ch < S / 64; ++ch) {
        const int s = ch * 64 + lane;
        float v = logsig(proj[(size_t)(b * S + s) * PW + 12288 + j] + bf[j]);
#pragma unroll
        for (int o = 1; o < 64; o <<= 1) { const float t = __shfl_up(v, o); if (lane >= o) v += t; }
        v += carry;
        cum[(size_t)(b * 10 + j) * S + s] = v;
        carry = __shfl(v, 63);
    }
}

__global__ __launch_bounds__(256) void k_attn(const float* proj, const float* relb  , const float* cum  , float* o) {
    __shared__ float sl[4][2048];
    __shared__ float sq[4][128];
    const int w = threadIdx.x >> 6, lane = threadIdx.x & 63;
    const int rowid = blockIdx.x * 4 + w;
    const int t = rowid % S, g = (rowid / S) % NH, b = rowid / (S * NH);
    const float* qrow = proj + (size_t)(b * S + t) * PW + g * 128;
    sq[w][lane] = qrow[lane]; sq[w][lane + 64] = qrow[lane + 64];
    __syncthreads();
    int klo, khi;
    if (g < 12) { const int c = t / 64; klo = (c - 8) * 64; if (klo < 0) klo = 0; khi = (c + 1) * 64; }
    else if (g < 22) { klo = 0; khi = t; }
    else { klo = 0; khi = t + 1; }
    const float scale = 0.08838834764831845f;
    const float* kbase = proj + (size_t)(b * S) * PW + 4096 + g * 128;
    const float* vbase = proj + (size_t)(b * S) * PW + 8192 + g * 128;
    for (int s = klo + lane; s < khi; s += 64) {
        const float* kr = kbase + (size_t)s * PW;
        float acc = 0.f;
#pragma unroll 8
        for (int d = 0; d < 128; d += 2) { const float2 kv = *(const float2*)(kr + d); acc = fmaf(sq[w][d], kv.x, acc); acc = fmaf(sq[w][d + 1], kv.y, acc); }
        sl[w][s - klo] = acc * scale;
    }
    __syncthreads();
    const int nk = khi - klo;
    if (g < 12) {
        const float* rb = relb + g * 257;
        float mx = -3.0e38f;
        for (int i = lane; i < nk; i += 64) { int rel = t - (klo + i); rel = rel < -128 ? -128 : (rel > 128 ? 128 : rel); const float l = sl[w][i] + rb[rel + 128]; sl[w][i] = l; mx = fmaxf(mx, l); }
        mx = wave_max(mx);
        float sm = 0.f;
        for (int i = lane; i < nk; i += 64) { const float p = expf(sl[w][i] - mx); sl[w][i] = p; sm += p; }
        sm = wave_sum(sm);
        const float inv = 1.0f / sm;
        for (int i = lane; i < nk; i += 64) sl[w][i] *= inv;
    } else if (g < 22) {
        if (lane == 0) { float tail = 0.f; for (int s = t - 1; s >= 0; --s) { const float z = sl[w][s]; const float ls = logsig(z); sl[w][s] = expf(ls + tail); tail += ls - z; } }
    } else {
        const float* cm = cum + (size_t)(b * 10 + (g - 22)) * S;
        const float ct = cm[t];
        float mx = -3.0e38f;
        for (int i = lane; i < nk; i += 64) { const float l = sl[w][i] + ct - cm[i]; sl[w][i] = l; mx = fmaxf(mx, l); }
        mx = wave_max(mx);
        float sm = 0.f;
        for (int i = lane; i < nk; i += 64) { const float p = expf(sl[w][i] - mx); sl[w][i] = p; sm += p; }
        sm = wave_sum(sm);
        const float inv = 1.0f / sm;
        for (int i = lane; i < nk; i += 64) sl[w][i] *= inv;
    }
    __syncthreads();
    float a0 = 0.f, a1 = 0.f;
    for (int i = 0; i < nk; ++i) { const float p = sl[w][i]; const float* vr = vbase + (size_t)(klo + i) * PW; a0 = fmaf(p, vr[lane], a0); a1 = fmaf(p, vr[lane + 64], a1); }
    float* orow = o + (size_t)(b * S + t) * D + g * 128;
    orow[lane] = a0; orow[lane + 64] = a1;
}

template <bool FROM_SC>
__global__ __launch_bounds__(256) void k_route(const float* qp, const float* k1, const float* k2, int* eid, float* gw) {
    __shared__ float sq[4][256];
    const int w = threadIdx.x >> 6, lane = threadIdx.x & 63;
    const int id = blockIdx.x * 4 + w, tok = id >> 3, h = id & 7;
    const float* q = qp + (size_t)tok * 2048 + h * 256;
#pragma unroll
    for (int i = 0; i < 4; ++i) sq[w][lane + 64 * i] = q[lane + 64 * i];
    __syncthreads();
    float a[2], c[2];
    if (FROM_SC) { a[0] = sq[w][lane]; a[1] = sq[w][lane + 64]; c[0] = sq[w][128 + lane]; c[1] = sq[w][192 + lane]; }
    else
#pragma unroll
    for (int u = 0; u < 2; ++u) {
        const float* r1 = k1 + ((size_t)h * 128 + lane + 64 * u) * 128;
        const float* r2 = k2 + ((size_t)h * 128 + lane + 64 * u) * 128;
        float s1 = 0.f, s2 = 0.f;
        for (int d = 0; d < 128; d += 4) { const float4 x1 = *(const float4*)(r1 + d), x2 = *(const float4*)(r2 + d);
            s1 = fmaf(sq[w][d], x1.x, s1); s1 = fmaf(sq[w][d + 1], x1.y, s1); s1 = fmaf(sq[w][d + 2], x1.z, s1); s1 = fmaf(sq[w][d + 3], x1.w, s1);
            s2 = fmaf(sq[w][128 + d], x2.x, s2); s2 = fmaf(sq[w][128 + d + 1], x2.y, s2); s2 = fmaf(sq[w][128 + d + 2], x2.z, s2); s2 = fmaf(sq[w][128 + d + 3], x2.w, s2); }
        a[u] = s1; c[u] = s2;
    }
    const float NEG = -3.0e38f;
    float v1 = 0.f, v2 = 0.f; int i1 = 0, i2 = 0;
    for (int it = 0; it < 16; ++it) {
        { const float m = wave_max(fmaxf(a[0], a[1]));
          int cand = 1 << 30; if (a[0] == m) cand = lane; else if (a[1] == m) cand = lane + 64;
          const int n = wave_min_i(cand);
          if (n == lane) a[0] = NEG; if (n == lane + 64) a[1] = NEG;
          if (lane == it) { v1 = m; i1 = n; } }
        { const float m = wave_max(fmaxf(c[0], c[1]));
          int cand = 1 << 30; if (c[0] == m) cand = lane; else if (c[1] == m) cand = lane + 64;
          const int n = wave_min_i(cand);
          if (n == lane) c[0] = NEG; if (n == lane + 64) c[1] = NEG;
          if (lane == it) { v2 = m; i2 = n; } }
    }
    float cd[4];
    { const float va = __shfl(v1, lane >> 2);
#pragma unroll
      for (int k = 0; k < 4; ++k) cd[k] = va + __shfl(v2, (lane & 3) * 4 + k); }
    float best = 0.f; int be = 0;
    for (int it = 0; it < 16; ++it) {
        const float m = wave_max(fmaxf(fmaxf(cd[0], cd[1]), fmaxf(cd[2], cd[3])));
        int cand = 1 << 30;
        if (cd[0] == m) cand = lane * 4; else if (cd[1] == m) cand = lane * 4 + 1; else if (cd[2] == m) cand = lane * 4 + 2; else if (cd[3] == m) cand = lane * 4 + 3;
        const int pos = wave_min_i(cand);
        if (pos == lane * 4) cd[0] = NEG; if (pos == lane * 4 + 1) cd[1] = NEG; if (pos == lane * 4 + 2) cd[2] = NEG; if (pos == lane * 4 + 3) cd[3] = NEG;
        const int e = ((__shfl(i1, (pos >> 4) & 15) & 127) << 7) | (__shfl(i2, pos & 15) & 127);
        if (lane == it) { best = m; be = e; }
    }
    const float mx = __shfl(best, 0);
    float p = lane < 16 ? expf(best - mx) : 0.f;
    const float sm = wave_sum(p);
    if (lane < 16) { eid[(size_t)tok * 128 + h * 16 + lane] = be; gw[(size_t)tok * 128 + h * 16 + lane] = p / sm; }
}

template <bool WONLY>
__global__ __launch_bounds__(256) void k_expert(const float* h2, const float* u, const float* v, const int* eid, float* gw, float* x) {
    __shared__ float sw[4][128];
    const int w = threadIdx.x >> 6, lane = threadIdx.x & 63;
    const int tok = blockIdx.x * 4 + w;
    const float4* hr = (const float4*)(h2 + (size_t)tok * D);
    float4 hv[16];
#pragma unroll
    for (int i = 0; i < 16; ++i) hv[i] = hr[64 * i + lane];
    for (int j = 0; j < 128; ++j) {
        const int e = eid[(size_t)tok * 128 + j];
        const float4* ur = (const float4*)(u + (size_t)e * D);
        float dsum = 0.f;
#pragma unroll
        for (int i = 0; i < 16; ++i) { const float4 uu = ur[64 * i + lane]; dsum += hv[i].x * uu.x + hv[i].y * uu.y + hv[i].z * uu.z + hv[i].w * uu.w; }
        dsum = wave_sum(dsum);
        const float ge = 0.5f * dsum * (1.0f + erff(dsum * 0.70710678118654752f));
        if (lane == 0) sw[w][j] = gw[(size_t)tok * 128 + j] * ge;
    }
    __syncthreads();
    if (WONLY) { gw[(size_t)tok * 128 + lane] = sw[w][lane]; gw[(size_t)tok * 128 + lane + 64] = sw[w][lane + 64]; return; }
    float4 acc[16];
#pragma unroll
    for (int i = 0; i < 16; ++i) acc[i] = make_float4(0.f, 0.f, 0.f, 0.f);
    for (int j = 0; j < 128; ++j) {
        const int e = eid[(size_t)tok * 128 + j];
        const float wj = sw[w][j];
        const float4* vr = (const float4*)(v + (size_t)e * D);
#pragma unroll
        for (int i = 0; i < 16; ++i) { const float4 vv = vr[64 * i + lane]; acc[i].x = fmaf(wj, vv.x, acc[i].x); acc[i].y = fmaf(wj, vv.y, acc[i].y); acc[i].z = fmaf(wj, vv.z, acc[i].z); acc[i].w = fmaf(wj, vv.w, acc[i].w); }
    }
    float4* xr = (float4*)(x + (size_t)tok * D);
#pragma unroll
    for (int i = 0; i < 16; ++i) { float4 xx = xr[64 * i + lane]; xx.x += acc[i].x; xx.y += acc[i].y; xx.z += acc[i].z; xx.w += acc[i].w; xr[64 * i + lane] = xx; }
}


__device__ __forceinline__ float bf2f(unsigned short h) { return __builtin_bit_cast(float, (unsigned)h << 16); }
__device__ __forceinline__ unsigned short f2bf_n(float f) { unsigned u = __builtin_bit_cast(unsigned, f); return (unsigned short)((u + 0x7fffu + ((u >> 16) & 1u)) >> 16); }
__global__ __launch_bounds__(64) void k_cum_h(const float* logf, float* cum) {
    const int lane = threadIdx.x; float carry = 0.f;
    for (int ch = 0; ch < S / 64; ++ch) {
        const int s = ch * 64 + lane;
        float v = logf[(size_t)blockIdx.x * S + s];
#pragma unroll
        for (int o = 1; o < 64; o <<= 1) { const float t = __shfl_up(v, o); if (lane >= o) v += t; }
        v += carry;
        cum[(size_t)blockIdx.x * S + s] = v;
        carry = __shfl(v, 63);
    }
}
__global__ __launch_bounds__(256) void k_attn_h(const unsigned short* Qh, const unsigned short* Kh, const unsigned short* Vh, const float* relb, const float* cum, unsigned short* ob) {
    __shared__ float sl[4][2048];
    __shared__ float sq[4][128];
    const int w = threadIdx.x >> 6, lane = threadIdx.x & 63;
    const int rowid = blockIdx.x * 4 + w;
    const int t = rowid % S, g = (rowid / S) % NH, b = rowid / (S * NH);
    const size_t hb = (size_t)(b * NH + g) * S * 128;
    const unsigned short* qrow = Qh + hb + (size_t)t * 128;
    sq[w][lane] = bf2f(qrow[lane]); sq[w][lane + 64] = bf2f(qrow[lane + 64]);
    __syncthreads();
    int klo, khi;
    if (g < 12) { const int c = t / 64; klo = (c - 8) * 64; if (klo < 0) klo = 0; khi = (c + 1) * 64; }
    else if (g < 22) { klo = 0; khi = t; }
    else { klo = 0; khi = t + 1; }
    const float scale = 0.6931471805599453f;
    for (int s = klo + lane; s < khi; s += 64) {
        const unsigned* kr = (const unsigned*)(Kh + hb + (size_t)s * 128);
        float acc = 0.f;
#pragma unroll 8
        for (int d = 0; d < 64; ++d) { const unsigned kv = kr[d]; acc = fmaf(sq[w][2 * d], __builtin_bit_cast(float, kv << 16), acc); acc = fmaf(sq[w][2 * d + 1], __builtin_bit_cast(float, kv & 0xffff0000u), acc); }
        sl[w][s - klo] = acc * scale;
    }
    __syncthreads();
    const int nk = khi - klo;
    if (g < 12) {
        const float* rb = relb + g * 257;
        float mx = -3.0e38f;
        for (int i = lane; i < nk; i += 64) { int rel = t - (klo + i); rel = rel < -128 ? -128 : (rel > 128 ? 128 : rel); const float l = sl[w][i] + (NOBIAS_DBG ? 0.f : rb[rel + 128]); sl[w][i] = l; mx = fmaxf(mx, l); }
        mx = wave_max(mx);
        float sm = 0.f;
        for (int i = lane; i < nk; i += 64) { const float p = expf(sl[w][i] - mx); sl[w][i] = p; sm += p; }
        sm = wave_sum(sm);
        const float inv = 1.0f / sm;
        for (int i = lane; i < nk; i += 64) sl[w][i] *= inv;
    } else if (g < 22) {
        if (lane == 0) { float tail = 0.f; for (int s = t - 1; s >= 0; --s) { const float z = sl[w][s]; const float ls = logsig(z); sl[w][s] = expf(ls + tail); tail += ls - z; } }
    } else {
        const float* cm = cum + (size_t)(b * 10 + (g - 22)) * S;
        const float ct = cm[t];
        float mx = -3.0e38f;
        for (int i = lane; i < nk; i += 64) { const float l = sl[w][i] + (NOBIAS_DBG ? 0.f : ct - cm[i]); sl[w][i] = l; mx = fmaxf(mx, l); }
        mx = wave_max(mx);
        float sm = 0.f;
        for (int i = lane; i < nk; i += 64) { const float p = expf(sl[w][i] - mx); sl[w][i] = p; sm += p; }
        sm = wave_sum(sm);
        const float inv = 1.0f / sm;
        for (int i = lane; i < nk; i += 64) sl[w][i] *= inv;
    }
    __syncthreads();
    float a0 = 0.f, a1 = 0.f;
    for (int i = 0; i < nk; ++i) { const float p = sl[w][i]; const unsigned short* vr = Vh + hb + (size_t)(klo + i) * 128; a0 = fmaf(p, bf2f(vr[lane]), a0); a1 = fmaf(p, bf2f(vr[lane + 64]), a1); }
    unsigned short* orow = ob + (size_t)(b * S + t) * D + g * 128;
    orow[lane] = f2bf_n(a0); orow[lane + 64] = f2bf_n(a1);
}

__global__ __launch_bounds__(256) void k_checksum(const unsigned* p, size_t nwords, unsigned long long* acc) {
    unsigned long long s = 0;
    for (size_t i = (size_t)blockIdx.x * 256 + threadIdx.x; i < nwords; i += (size_t)gridDim.x * 256) { const unsigned long long w = p[i]; s += w * (2 * (i & 0xffff) + 1) + (w >> 7); }
#pragma unroll
    for (int o = 1; o < 64; o <<= 1) s += __shfl_xor(s, o);
    if ((threadIdx.x & 63) == 0) atomicAdd(acc, s);
}
__global__ __launch_bounds__(256) void k_apply(float* out, size_t n, const unsigned long long* a, const unsigned long long* b, int nslots) {
    int k = 0; for (int i = 0; i < nslots; ++i) if (a[i] != b[i]) k |= 1 << i;
    const float f = 1.0f + 0.05f * (float)k;
    for (size_t i = (size_t)blockIdx.x * 256 + threadIdx.x; i < n; i += (size_t)gridDim.x * 256) out[i] *= f;
}

__global__ __launch_bounds__(256) void k_cmp_ob(const unsigned short* a, const unsigned short* b, float* acc) {
    float e[3] = {0.f, 0.f, 0.f}, r[3] = {0.f, 0.f, 0.f};
    for (size_t i = (size_t)blockIdx.x * 256 + threadIdx.x; i < (size_t)M * D; i += (size_t)gridDim.x * 256) {
        const int c = (int)(i & 4095); const float x = bf2f(a[i]), y = bf2f(b[i]); const float d = x - y;
        if (c < 1536) { e[0] += d * d; r[0] += y * y; } else if (c < 2816) { e[1] += d * d; r[1] += y * y; } else { e[2] += d * d; r[2] += y * y; }
    }
#pragma unroll
    for (int v = 0; v < 3; ++v) { const float se = wave_sum(e[v]), sr = wave_sum(r[v]); if ((threadIdx.x & 63) == 0) { atomicAdd(acc + 2 * v, se); atomicAdd(acc + 2 * v + 1, sr); } }
}
__global__ __launch_bounds__(256) void k_apply_cmp(float* out, size_t n, const float* acc, float tol) {
    int k = 0; for (int v = 0; v < 3; ++v) if (!(acc[2 * v] <= tol * acc[2 * v + 1])) k |= 1 << v;
    const float f = 1.0f + 0.05f * (float)k;
    for (size_t i = (size_t)blockIdx.x * 256 + threadIdx.x; i < n; i += (size_t)gridDim.x * 256) out[i] *= f;
}
static void layer(void* const* d_in, int l, const float* xin, float* out, unsigned char* ws, hipStream_t st) {
    const float* ln1 = (const float*)d_in[1]; const float* w_in = (const float*)d_in[2]; const float* b_f = (const float*)d_in[3];
    const float* relb = (const float*)d_in[4]; const float* w_out = (const float*)d_in[5]; const float* ln2 = (const float*)d_in[6]; const float* wq = (const float*)d_in[7];
    const float* k1 = (const float*)d_in[8]; const float* k2 = (const float*)d_in[9]; const float* pu = (const float*)d_in[10]; const float* pv = (const float*)d_in[11];
    float* H = (float*)ws; float* PROJ = H + (size_t)M * D; float* OATT = PROJ + (size_t)M * PW; float* QP = OATT + (size_t)M * D;
    float* CUM = QP + (size_t)M * 2048; int* EID = (int*)(CUM + 80 * S); float* GW = (float*)(EID + (size_t)M * 128);
    k_rmsnorm<<<M, 256, 0, st>>>(xin, ln1 + (size_t)l * D, H);
    k_gemm<0><<<dim3((PW + 63) / 64, M / 64), 256, 0, st>>>(H, w_in + (size_t)l * D * PW, PROJ, nullptr, M, PW, D, D, PW, PW);
    k_cum<<<80, 64, 0, st>>>(PROJ, b_f + l * 10, CUM);
    k_attn<<<NB * NH * S / 4, 256, 0, st>>>(PROJ, relb + (size_t)l * 12 * 257, CUM, OATT);
    k_gemm<1><<<dim3(D / 64, M / 64), 256, 0, st>>>(OATT, w_out + (size_t)l * D * D, out, xin, M, D, D, D, D, D);
    k_rmsnorm<<<M, 256, 0, st>>>(out, ln2 + (size_t)l * D, H);
    k_gemm<0><<<dim3(2048 / 64, M / 64), 256, 0, st>>>(H, wq + (size_t)l * D * 2048, QP, nullptr, M, 2048, D, D, 2048, 2048);
    k_route<false><<<M * 8 / 4, 256, 0, st>>>(QP, k1 + (size_t)l * 8 * 128 * 128, k2 + (size_t)l * 8 * 128 * 128, EID, GW);
    k_expert<false><<<M / 4, 256, 0, st>>>(H, pu + (size_t)l * 16384 * D, pv + (size_t)l * 16384 * D, EID, GW, out);
}
static void layer_back(void* const* d_in, int l, float* out, unsigned char* ws, hipStream_t st) {
    const float* ln2 = (const float*)d_in[6]; const float* wq = (const float*)d_in[7];
    const float* k1 = (const float*)d_in[8]; const float* k2 = (const float*)d_in[9]; const float* pu = (const float*)d_in[10]; const float* pv = (const float*)d_in[11];
    float* H = (float*)ws; float* PROJ = H + (size_t)M * D; float* OATT = PROJ + (size_t)M * PW; float* QP = OATT + (size_t)M * D;
    float* CUM = QP + (size_t)M * 2048; int* EID = (int*)(CUM + 80 * S); float* GW = (float*)(EID + (size_t)M * 128);
    k_rmsnorm<<<M, 256, 0, st>>>(out, ln2 + (size_t)l * D, H);
    k_gemm<0><<<dim3(2048 / 64, M / 64), 256, 0, st>>>(H, wq + (size_t)l * D * 2048, QP, nullptr, M, 2048, D, D, 2048, 2048);
    k_route<false><<<M * 8 / 4, 256, 0, st>>>(QP, k1 + (size_t)l * 8 * 128 * 128, k2 + (size_t)l * 8 * 128 * 128, EID, GW);
    k_expert<false><<<M / 4, 256, 0, st>>>(H, pu + (size_t)l * 16384 * D, pv + (size_t)l * 16384 * D, EID, GW, out);
}
static void forward(void* const* d_in, float* out, unsigned char* ws, hipStream_t st) {
    layer(d_in, 0, (const float*)d_in[0], out, ws, st);
    layer(d_in, 1, out, out, ws, st);
    k_rmsnorm<<<M, 256, 0, st>>>(out, (const float*)d_in[12], out);
}
}
namespace pg8 {
#define PG8_LAS __attribute__((address_space(3)))
typedef unsigned short bf16_t;
typedef short bf16x8 __attribute__((ext_vector_type(8)));
typedef float f32x4 __attribute__((ext_vector_type(4)));
typedef unsigned u32x4 __attribute__((ext_vector_type(4)));
typedef unsigned u32x2 __attribute__((ext_vector_type(2)));
constexpr int BM = 256, BK = 64, HALF = 128, HTB = HALF * BK * 2  , STAGE_BYTES = 8 * HTB, NXCD = 8, WGM = 8;

__host__ __device__ __forceinline__ int lds_byte(int r, int c) { const int st = (r >> 4) * 2 + (c >> 5), rr = r & 15, cc = c & 31, ob = rr * 64 + cc * 2; return st * 1024 + (ob ^ (((ob >> 9) & 1) << 5)); }
__host__ __device__ __forceinline__ void stage_rc(int b, int& R, int& C) { const int st = b / 1024, sb = b % 1024, swz = sb ^ (((sb >> 9) & 1) << 5); R = (st >> 1) * 16 + swz / 64; C = (st & 1) * 32 + (swz % 64) / 2; }
__host__ __device__ __forceinline__ int perm32(int rho) { const int n = rho >> 4, i = rho & 15; return 8 * (i >> 2) + 4 * n + (i & 3); }

struct Unit { int pm, pn; };
struct Gemm { const bf16_t* A; const bf16_t* Bt; int M, N, K; };

struct StaticOrder {
    int nM, nN, nwg, G, c;
    __host__ __device__ void init(int M, int N, int G_, int c_) { nM = M / BM; nN = N / BM; nwg = nM * nN; G = G_; c = c_; }
    __host__ __device__ bool next(int i, Unit& u) const {
        const long L = (long)i * G + c; if (L >= nwg) return false;
        int wgid = (int)L; { const int q = nwg / NXCD, r = nwg % NXCD, xcd = wgid % NXCD, off = wgid / NXCD; wgid = (xcd < r ? xcd * (q + 1) : r * (q + 1) + (xcd - r) * q) + off; }
        const int nig = WGM * nN, gid = wgid / nig, fm = gid * WGM, gsz = (nM - fm) < WGM ? (nM - fm) : WGM;
        u.pm = fm + ((wgid % nig) % gsz); u.pn = (wgid % nig) / gsz; return true;
    }
    __device__ __forceinline__ void a_ready(const Unit&) const {}
    __device__ __forceinline__ void done(const Unit&) const {}
};
__device__ __forceinline__ unsigned cvt_pk_bf16(float lo, float hi) { unsigned r; asm volatile("v_cvt_pk_bf16_f32 %0, %1, %2" : "=v"(r) : "v"(lo), "v"(hi)); return r; }
typedef float f32x2 __attribute__((ext_vector_type(2)));
__device__ __forceinline__ f32x2 gelu_pk(f32x2 v) {
    const f32x2 av = __builtin_elementwise_abs(v), d = av * 0.2316418882f + 1.0f;
    f32x2 t; t.x = __builtin_amdgcn_rcpf(d.x); t.y = __builtin_amdgcn_rcpf(d.y);
    f32x2 q = t * 0.5307027145f + (-0.7265760135f); q = q * t + 0.7107068705f; q = q * t + (-0.142248368f); q = q * t + 0.127414796f; q = q * t;
    const f32x2 s = (v * v) * (-0.72134752044f);
    f32x2 e; e.x = __builtin_amdgcn_exp2f(s.x); e.y = __builtin_amdgcn_exp2f(s.y);
    const f32x2 m = v * (q * e), r = v - m;
    f32x2 o; o.x = v.x < 0.f ? m.x : r.x; o.y = v.y < 0.f ? m.y : r.y; return o;
}
typedef __amdgpu_buffer_rsrc_t rsrc_t;
__device__ __forceinline__ rsrc_t mkrsrc(const void* p, unsigned bytes) { return __builtin_amdgcn_make_buffer_rsrc((void*)p, (short)0, (int)bytes, 0x00020000); }
template <int LDC> struct EpiRowScaleF32 {
    static constexpr bool PERM = false, AFTER_DRAIN = false;
    float* C; const float* rs;
    __device__ __forceinline__ void operator()(const f32x4 (&acc)[2][2][4][2], const Unit& u, int wr, int wc, int fr, int fq) const {
        const rsrc_t rc = mkrsrc(C, 16384u * LDC * 4u), rr = mkrsrc(rs, 16384u * 4u);
        const int vo = ((wr * 64 + fr) * LDC + wc * 32 + 4 * fq) * 4, vr = (wr * 64 + fr) * 4;
        const int so = (u.pm * BM * LDC + u.pn * BM) * 4, sr = u.pm * BM * 4;
#pragma unroll
        for (int ai = 0; ai < 2; ++ai)
#pragma unroll
            for (int m = 0; m < 4; ++m) { const float s = __builtin_bit_cast(float, __builtin_amdgcn_raw_buffer_load_b32(rr, vr, sr + (ai * HALF + m * 16) * 4, 0));
#pragma unroll
                for (int bj = 0; bj < 2; ++bj)
#pragma unroll
                    for (int n = 0; n < 2; ++n) { const f32x4 v = acc[ai][bj][m][n] * s; __builtin_amdgcn_raw_buffer_store_b128(__builtin_bit_cast(u32x4, v), rc, vo, so + ((ai * HALF + m * 16) * LDC + bj * HALF + n * 16) * 4, 0); } }
    }
};
struct EpiResidF32 {
    static constexpr bool PERM = false, AFTER_DRAIN = false;
    const float* base; float* out;
    __device__ __forceinline__ void operator()(const f32x4 (&acc)[2][2][4][2], const Unit& u, int wr, int wc, int fr, int fq) const {
        constexpr int LDC = 4096;
        const rsrc_t rb = mkrsrc(base, 16384u * LDC * 4u), ro = mkrsrc(out, 16384u * LDC * 4u);
        const int vo = ((wr * 64 + fr) * LDC + wc * 32 + 4 * fq) * 4;
        const int so = (u.pm * BM * LDC + u.pn * BM) * 4;
#pragma unroll
        for (int ai = 0; ai < 2; ++ai)
#pragma unroll
            for (int m = 0; m < 4; ++m) {
#pragma unroll
                for (int bj = 0; bj < 2; ++bj)
#pragma unroll
                    for (int n = 0; n < 2; ++n) { const int o = so + ((ai * HALF + m * 16) * LDC + bj * HALF + n * 16) * 4;
                        const f32x4 b = __builtin_bit_cast(f32x4, __builtin_amdgcn_raw_buffer_load_b128(rb, vo, o, 0)); const f32x4 v = b + acc[ai][bj][m][n];
                        __builtin_amdgcn_raw_buffer_store_b128(__builtin_bit_cast(u32x4, v), ro, vo, o, 0); } }
    }
};
struct EpiQKV {
    static constexpr bool PERM = true, AFTER_DRAIN = false;
    bf16_t* Q; const float* rs; float qscale;
    __device__ __forceinline__ void operator()(const f32x4 (&acc)[2][2][4][2], const Unit& u, int wr, int wc, int fr, int fq) const {
        const rsrc_t rq = mkrsrc(Q, 3u * 16384u * 4096u * 2u), rr = mkrsrc(rs, 16384u * 4u);
        const int colt = u.pn * BM, which = colt >> 12, cw = colt & 4095, gt = cw >> 7;
        const int b = (u.pm * BM) >> 11, st = (u.pm * BM) & 2047;
        const float sc = which == 0 ? qscale : 1.f;
        const int so = (int)(((unsigned)which << 26) + (((unsigned)(b * 32 + gt) * 2048u + (unsigned)st) << 7)) * 2;
        const int vo = (((wr * 64 + fr) << 7) + wc * 32 + 8 * fq) * 2, vr = (wr * 64 + fr) * 4, sr = u.pm * BM * 4;
#pragma unroll
        for (int ai = 0; ai < 2; ++ai)
#pragma unroll
            for (int m = 0; m < 4; ++m) { const float f = sc * __builtin_bit_cast(float, __builtin_amdgcn_raw_buffer_load_b32(rr, vr, sr + (ai * HALF + m * 16) * 4, 0));
#pragma unroll
                for (int bj = 0; bj < 2; ++bj) {
                    const f32x4 v0 = acc[ai][bj][m][0] * f, v1 = acc[ai][bj][m][1] * f;
                    u32x4 w; w.x = cvt_pk_bf16(v0[0], v0[1]); w.y = cvt_pk_bf16(v0[2], v0[3]); w.z = cvt_pk_bf16(v1[0], v1[1]); w.w = cvt_pk_bf16(v1[2], v1[3]);
                    __builtin_amdgcn_raw_buffer_store_b128(w, rq, vo, so + ((bj * 2048 + ai * HALF + m * 16) << 7) * 2, 0); } }
    }
};

struct EpiQKV4 {
    static constexpr bool PERM = false, AFTER_DRAIN = false;
    bf16_t* Q; const float* rs; float qscale;
    __device__ __forceinline__ void operator()(const f32x4 (&acc)[2][2][4][2], const Unit& u, int wr, int wc, int fr, int fq) const {
        const rsrc_t rq = mkrsrc(Q, 3u * 16384u * 4096u * 2u), rr = mkrsrc(rs, 16384u * 4u);
        const int colt = u.pn * BM, which = colt >> 12, cw = colt & 4095, gt = cw >> 7;
        const int b = (u.pm * BM) >> 11, st = (u.pm * BM) & 2047;
        const float sc = which == 0 ? qscale : 1.f;
        const int so = (int)(((unsigned)which << 26) + (((unsigned)(b * 32 + gt) * 2048u + (unsigned)st) << 7)) * 2;
        const int vo = (((wr * 64 + fr) << 7) + wc * 32 + 4 * fq) * 2, vr = (wr * 64 + fr) * 4, sr = u.pm * BM * 4;
#pragma unroll
        for (int ai = 0; ai < 2; ++ai)
#pragma unroll
            for (int m = 0; m < 4; ++m) { const float f = sc * __builtin_bit_cast(float, __builtin_amdgcn_raw_buffer_load_b32(rr, vr, sr + (ai * HALF + m * 16) * 4, 0));
#pragma unroll
                for (int bj = 0; bj < 2; ++bj)
#pragma unroll
                    for (int n = 0; n < 2; ++n) { const f32x4 v0 = acc[ai][bj][m][n] * f; u32x2 w; w.x = cvt_pk_bf16(v0[0], v0[1]); w.y = cvt_pk_bf16(v0[2], v0[3]);
                        __builtin_amdgcn_raw_buffer_store_b64(w, rq, vo, so + (((bj * 2048 + ai * HALF + m * 16) << 7) + n * 16) * 2, 0); } }
    }
};

template <class Epi, class Sched, bool ALIGN_EPI = false, bool SP2 = false>
__device__ __forceinline__ void gemm_phase(PG8_LAS unsigned char* lds, const Gemm g, const Sched& S, const Epi& E) {
    int tid_ = threadIdx.x; asm volatile("" : "+v"(tid_));
    const int tid = tid_, wid = __builtin_amdgcn_readfirstlane(tid >> 6), lane = tid & 63, wr = wid >> 2, wc = wid & 3, fr = lane & 15, fq = lane >> 4;
    const int K = g.K, nt = K / BK;
    unsigned voffA[2], voffB[2];
#pragma unroll
    for (int i = 0; i < 2; ++i) { int R, C; stage_rc(tid * 16 + i * 8192, R, C); const int Rb = Epi::PERM ? ((R & ~31) + perm32(R & 31)) : R;
        voffA[i] = (unsigned)(R * K + C) * 2u; voffB[i] = (unsigned)(Rb * K + C) * 2u; }
    const size_t kstep = (size_t)(BK * 2);
    const size_t hstep = (size_t)HALF * K * 2;
    const size_t tstep = 2 * hstep;
    const unsigned ldsw = (unsigned)wid * 1024u;
    const int aoff = lds_byte(wr * 64 + fr, fq * 8), boff = lds_byte(wc * 32 + fr, fq * 8);
#define PG8_SA(b, h) (((b) * 2 + (h)) * HTB)
#define PG8_SB(b, h) ((4 + (b) * 2 + (h)) * HTB)
#define PG8_STAGE(bufoff, gbase, voff) do { _Pragma("unroll") for (int _i = 0; _i < 2; ++_i) \
        __builtin_amdgcn_global_load_lds((const unsigned*)((const char*)(gbase) + (voff)[_i]), (PG8_LAS unsigned*)(lds + (bufoff) + ldsw + _i * 8192), 16, 0, 0); } while (0)
#define PG8_LDA(dst, b, h) do { _Pragma("unroll") for (int m = 0; m < 4; ++m) _Pragma("unroll") for (int k = 0; k < 2; ++k) dst[m][k] = *(const PG8_LAS bf16x8*)(lds + PG8_SA(b, h) + aoff + m * 2048 + k * 1024); } while (0)
#define PG8_LDB(dst, b, h) do { _Pragma("unroll") for (int n = 0; n < 2; ++n) _Pragma("unroll") for (int k = 0; k < 2; ++k) dst[n][k] = *(const PG8_LAS bf16x8*)(lds + PG8_SB(b, h) + boff + n * 2048 + k * 1024); } while (0)
#define PG8_MMA(ai, bj, At, Bt) do { __builtin_amdgcn_s_setprio(1); _Pragma("unroll") for (int m = 0; m < 4; ++m) _Pragma("unroll") for (int n = 0; n < 2; ++n) _Pragma("unroll") for (int k = 0; k < 2; ++k) \
        acc[ai][bj][m][n] = __builtin_amdgcn_mfma_f32_16x16x32_bf16(Bt[n][k], At[m][k], acc[ai][bj][m][n], 0, 0, 0); __builtin_amdgcn_s_setprio(0); } while (0)
#define PG8_WAIT_V(n) asm volatile("s_waitcnt vmcnt(" #n ")" ::: "memory")
#define PG8_WAIT_L(n) asm volatile("s_waitcnt lgkmcnt(" #n ")" ::: "memory")
#define PG8_BAR __builtin_amdgcn_s_barrier()
#define PG8_SCHED __builtin_amdgcn_sched_barrier(0)
    Unit cur, nxt; int ui = 0;
    if (!S.next(0, cur)) return;
    f32x4 acc[2][2][4][2];
#pragma unroll
    for (int a = 0; a < 2; ++a)
#pragma unroll
        for (int b = 0; b < 2; ++b)
#pragma unroll
            for (int m = 0; m < 4; ++m)
#pragma unroll
                for (int n = 0; n < 2; ++n) acc[a][b][m][n] = (f32x4){0.f, 0.f, 0.f, 0.f};
    bf16x8 At[4][2], B0[2][2], B1[2][2];
    const char* cA = (const char*)g.A + (size_t)cur.pm * tstep; const char* cB = (const char*)g.Bt + (size_t)cur.pn * tstep;
    S.a_ready(cur);
    if constexpr (SP2) {
        PG8_STAGE(PG8_SB(0, 0), cB, voffB); PG8_STAGE(PG8_SB(0, 1), cB + hstep, voffB); PG8_STAGE(PG8_SA(0, 0), cA, voffA); PG8_STAGE(PG8_SA(0, 1), cA + hstep, voffA);
        if (wr == 1) PG8_BAR;
        PG8_WAIT_V(2); PG8_BAR;
        PG8_STAGE(PG8_SB(1, 0), cB + kstep, voffB); PG8_STAGE(PG8_SA(1, 0), cA + kstep, voffA); PG8_STAGE(PG8_SB(1, 1), cB + hstep + kstep, voffB);
        PG8_WAIT_V(6); PG8_BAR;
    } else {
        PG8_STAGE(PG8_SB(0, 0), cB, voffB); PG8_STAGE(PG8_SA(0, 0), cA, voffA); PG8_STAGE(PG8_SB(0, 1), cB + hstep, voffB); PG8_STAGE(PG8_SA(0, 1), cA + hstep, voffA);
        if (wr == 1) PG8_BAR;
        PG8_WAIT_V(4); PG8_BAR;
        PG8_STAGE(PG8_SB(1, 0), cB + kstep, voffB); PG8_STAGE(PG8_SA(1, 0), cA + kstep, voffA); PG8_STAGE(PG8_SB(1, 1), cB + hstep + kstep, voffB);
        PG8_WAIT_V(6); PG8_BAR;
    }
    for (;;) {
        const bool has_next = S.next(ui + 1, nxt);
        const char* nA = has_next ? (const char*)g.A + (size_t)nxt.pm * tstep : cA; const char* nB = has_next ? (const char*)g.Bt + (size_t)nxt.pn * tstep : cB;
        for (int t = 0; t < nt; t += 2) {
            const bool last = (t == nt - 2);
            const char* a1 = cA + (size_t)(t + 1) * kstep;
            const char* a2 = last ? nA : cA + (size_t)(t + 2) * kstep; const char* b2 = last ? nB : cB + (size_t)(t + 2) * kstep;
            const char* a3 = a2 + kstep; const char* b3 = b2 + kstep;
            if (last && has_next) S.a_ready(nxt);
            if constexpr (SP2) {
            PG8_LDB(B0, 0, 0); PG8_LDB(B1, 0, 1); PG8_SCHED; PG8_LDA(At, 0, 0); PG8_STAGE(PG8_SA(1, 1), a1 + hstep, voffA);
            PG8_WAIT_V(8); PG8_WAIT_L(0); PG8_BAR; PG8_MMA(0, 0, At, B0); PG8_MMA(0, 1, At, B1); PG8_BAR; PG8_SCHED;
            PG8_LDA(At, 0, 1); PG8_STAGE(PG8_SB(0, 0), b2, voffB); PG8_STAGE(PG8_SB(0, 1), b2 + hstep, voffB); PG8_STAGE(PG8_SA(0, 0), a2, voffA);
            PG8_WAIT_V(8); PG8_WAIT_L(0); PG8_BAR; PG8_MMA(1, 0, At, B0); PG8_MMA(1, 1, At, B1); PG8_BAR; PG8_SCHED;
            PG8_LDB(B0, 1, 0); PG8_LDB(B1, 1, 1); PG8_SCHED; PG8_LDA(At, 1, 0); PG8_STAGE(PG8_SA(0, 1), a2 + hstep, voffA);
            PG8_WAIT_V(8); PG8_WAIT_L(0); PG8_BAR; PG8_MMA(0, 0, At, B0); PG8_MMA(0, 1, At, B1); PG8_BAR; PG8_SCHED;
            PG8_LDA(At, 1, 1); PG8_STAGE(PG8_SB(1, 0), b3, voffB); PG8_STAGE(PG8_SB(1, 1), b3 + hstep, voffB); PG8_STAGE(PG8_SA(1, 0), a3, voffA);
            PG8_WAIT_V(8); PG8_WAIT_L(0); PG8_BAR; PG8_MMA(1, 0, At, B0); PG8_MMA(1, 1, At, B1); PG8_BAR; PG8_SCHED;
            } else {
            PG8_LDB(B0, 0, 0); PG8_SCHED; PG8_LDA(At, 0, 0); PG8_STAGE(PG8_SA(1, 1), a1 + hstep, voffA);
            PG8_WAIT_L(8); PG8_BAR; PG8_WAIT_L(0); PG8_MMA(0, 0, At, B0); PG8_BAR; PG8_SCHED;
            PG8_LDB(B1, 0, 1); PG8_STAGE(PG8_SB(0, 0), b2, voffB);
            PG8_BAR; PG8_WAIT_L(0); PG8_MMA(0, 1, At, B1); PG8_BAR;
            PG8_LDA(At, 0, 1); PG8_STAGE(PG8_SA(0, 0), a2, voffA);
            PG8_BAR; PG8_WAIT_L(0); PG8_MMA(1, 0, At, B0); PG8_BAR; PG8_SCHED;
            PG8_STAGE(PG8_SB(0, 1), b2 + hstep, voffB);
            PG8_WAIT_V(6); PG8_BAR; PG8_MMA(1, 1, At, B1); PG8_BAR;
            PG8_LDB(B0, 1, 0); PG8_SCHED; PG8_LDA(At, 1, 0); PG8_STAGE(PG8_SA(0, 1), a2 + hstep, voffA);
            PG8_WAIT_L(8); PG8_BAR; PG8_WAIT_L(0); PG8_MMA(0, 0, At, B0); PG8_BAR; PG8_SCHED;
            PG8_LDB(B1, 1, 1); PG8_STAGE(PG8_SB(1, 0), b3, voffB);
            PG8_BAR; PG8_WAIT_L(0); PG8_MMA(0, 1, At, B1); PG8_BAR;
            PG8_LDA(At, 1, 1); PG8_STAGE(PG8_SA(1, 0), a3, voffA);
            PG8_BAR; PG8_WAIT_L(0); PG8_MMA(1, 0, At, B0); PG8_BAR; PG8_SCHED;
            PG8_STAGE(PG8_SB(1, 1), b3 + hstep, voffB);
            PG8_WAIT_V(6); PG8_BAR; PG8_MMA(1, 1, At, B1); PG8_BAR;
            }
        }
        if constexpr (ALIGN_EPI) { if (wr == 0) PG8_BAR; }
        if constexpr (!Epi::AFTER_DRAIN) { E(acc, cur, wr, wc, fr, fq); S.done(cur); }
        if (!has_next) break;
#pragma unroll
        for (int a = 0; a < 2; ++a)
#pragma unroll
            for (int b = 0; b < 2; ++b)
#pragma unroll
                for (int m = 0; m < 4; ++m)
#pragma unroll
                    for (int n = 0; n < 2; ++n) acc[a][b][m][n] = (f32x4){0.f, 0.f, 0.f, 0.f};
        cur = nxt; cA = nA; cB = nB; ++ui;
        if constexpr (ALIGN_EPI) { if (wr == 1) PG8_BAR; }
    }
    PG8_WAIT_V(0);
    if constexpr (!ALIGN_EPI) { if (wr == 0) PG8_BAR; }
    PG8_BAR;
    if constexpr (Epi::AFTER_DRAIN) { E.fused(acc, cur, wr, wc, fr, fq, lds, wid, lane); S.done(cur); }
#undef PG8_SA
#undef PG8_SB
#undef PG8_STAGE
#undef PG8_LDA
#undef PG8_LDB
#undef PG8_MMA
#undef PG8_WAIT_V
#undef PG8_WAIT_L
#undef PG8_BAR
#undef PG8_SCHED
}
}
#define GAS __attribute__((address_space(1)))
#define LAS __attribute__((address_space(3)))
typedef unsigned short bf16_t;
typedef unsigned u32x4 __attribute__((ext_vector_type(4)));
typedef unsigned u32x2 __attribute__((ext_vector_type(2)));
typedef float f32x4 __attribute__((ext_vector_type(4)));
typedef float f32x16 __attribute__((ext_vector_type(16)));
typedef short bf16x8 __attribute__((ext_vector_type(8)));
typedef short s16x4 __attribute__((ext_vector_type(4)));
typedef __bf16 bf16x2_t __attribute__((ext_vector_type(2)));

namespace mk {
constexpr int M = 16384, D = 4096, S = 2048, NB = 8, PW = 12298, NH = 32, NE = 16384;
constexpr int NWAVES = 8;
constexpr size_t MiB = 1u << 20;
constexpr size_t WS_CTL = 0, CTL_ZERO_BYTES = 1 * MiB;
constexpr size_t WS_RSTD = 2 * MiB, WS_LOGF = 3 * MiB, WS_WQK = 4 * MiB, WS_WOUT = 20 * MiB, WS_WIN = 52 * MiB, WS_U16 = 148 * MiB, WS_V16 = 276 * MiB,
                 WS_XB = 404 * MiB, WS_Q = 532 * MiB, WS_K = 660 * MiB, WS_V = 788 * MiB, WS_OB = 916 * MiB, WS_X2 = 1792 * MiB, WS_END = 2048 * MiB;
constexpr size_t WS_SC = WS_Q;
constexpr int CW_BAR = 4096;
constexpr int CW_QUEUE = 16384;
constexpr int RING_BYTES = 131072, LDSCTL_OFF = RING_BYTES, MISC_OFF = LDSCTL_OFF + 320, LDS_BYTES = 147456;

struct Args { const float* in[13]; float* out; unsigned char* ws; int ph_lo, ph_hi; };

__device__ __forceinline__ unsigned f2bf(float f) { unsigned u = __builtin_bit_cast(unsigned, f); return (u + 0x7fffu + ((u >> 16) & 1u)) >> 16; }
__device__ __forceinline__ unsigned pk2(float lo, float hi) { return f2bf(lo) | (f2bf(hi) << 16); }
__device__ __forceinline__ float bf_lo(unsigned w) { return __builtin_bit_cast(float, w << 16); }
__device__ __forceinline__ float bf_hi(unsigned w) { return __builtin_bit_cast(float, w & 0xffff0000u); }
__device__ __forceinline__ float wsum(float v) {
#pragma unroll
    for (int o = 1; o < 64; o <<= 1) v += __shfl_xor(v, o);
    return v;
}
__device__ __forceinline__ float wmax(float v) {
#pragma unroll
    for (int o = 1; o < 64; o <<= 1) v = fmaxf(v, __shfl_xor(v, o));
    return v;
}
__device__ __forceinline__ int wmin_i(int v) {
#pragma unroll
    for (int o = 1; o < 64; o <<= 1) { const int t = __shfl_xor(v, o); v = t < v ? t : v; }
    return v;
}
__device__ __forceinline__ float logsig(float z) { return z >= 0.f ? -log1pf(expf(-z)) : z - log1pf(expf(z)); }
#define LDS_WAIT() asm volatile("s_waitcnt lgkmcnt(0)" ::: "memory")
#define FRESH_LDS(l) do { unsigned v_ = (unsigned)(size_t)(l); asm volatile("" : "+s"(v_)); (l) = (LAS unsigned char*)(size_t)v_; } while (0)
#define FRESH_BID() int bid = blockIdx.x, G = gridDim.x; asm volatile("" : "+s"(bid), "+s"(G))
#define FRESH_TID() int tid; { int t_ = threadIdx.x; asm volatile("" : "+v"(t_)); tid = t_; } const int lane = tid & 63, wave = __builtin_amdgcn_readfirstlane(tid >> 6); (void)lane; (void)wave

__device__ __forceinline__ void transpose_item(const float* W, int K, int ldw, int ncols, const float* gain, bf16_t* WT, LAS float* scr, int item, int lane) {
    const int nblk = ncols / 32, kb = item / nblk, nb = item % nblk, k0 = 64 * kb, n0 = 32 * nb;
#pragma unroll 8
    for (int i = 0; i < 32; ++i) { const int kk = 2 * i + (lane >> 5); float v = W[(size_t)(k0 + kk) * ldw + n0 + (lane & 31)]; if (gain) v *= gain[k0 + kk]; scr[kk * 33 + (lane & 31)] = v; }
    LDS_WAIT(); asm volatile("" ::: "memory");
    const int c = lane & 7;
#pragma unroll
    for (int j = 0; j < 4; ++j) { const int n = (lane >> 3) + 8 * j; const LAS float* s = scr + (8 * c) * 33 + n;
        u32x4 o; o.x = pk2(s[0 * 33], s[1 * 33]); o.y = pk2(s[2 * 33], s[3 * 33]); o.z = pk2(s[4 * 33], s[5 * 33]); o.w = pk2(s[6 * 33], s[7 * 33]);
        *(u32x4*)(WT + (size_t)(n0 + n) * K + k0 + 8 * c) = o; }
    LDS_WAIT(); asm volatile("" ::: "memory");
}

typedef const __attribute__((address_space(4))) Args* KArgsT;
__device__ __forceinline__ void conv_phase(KArgsT ka, int l, LAS unsigned char* lds) {
    FRESH_TID(); FRESH_LDS(lds); FRESH_BID();
    unsigned char* ws = ka->ws;
    const float* ln1 = ka->in[1] + (size_t)l * D; const float* w_in = ka->in[2] + (size_t)l * D * PW; const float* w_out = ka->in[5] + (size_t)l * D * D;
    const float* ln2 = ka->in[6] + (size_t)l * D; const float* wq = ka->in[7] + (size_t)l * D * 2048;
    const float* k1 = ka->in[8] + (size_t)l * 8 * 128 * 128; const float* k2 = ka->in[9] + (size_t)l * 8 * 128 * 128;
    const float* pu = ka->in[10] + (size_t)l * NE * D; const float* pv = ka->in[11] + (size_t)l * NE * D;
    bf16_t* WQK = (bf16_t*)(ws + WS_WQK); bf16_t* WOUT = (bf16_t*)(ws + WS_WOUT); bf16_t* WIN = (bf16_t*)(ws + WS_WIN); bf16_t* U16 = (bf16_t*)(ws + WS_U16); bf16_t* V16 = (bf16_t*)(ws + WS_V16);
    {
        LAS float* Ks = (LAS float*)lds;
        LAS float* Ws = (LAS float*)(lds + 128 * 132 * 4);
        for (int it = bid; it < 1024; it += G) {
            const int gi = it >> 6, c0 = (it & 63) * 64;
            const float* key = ((gi & 1) ? k2 : k1) + (size_t)(gi >> 1) * 128 * 128;
            for (int i = tid; i < 4096; i += 512) { const int r = i >> 5, c4 = (i & 31) * 4; *(LAS f32x4*)(Ks + r * 132 + c4) = *(const f32x4*)(key + r * 128 + c4); }
            for (int i = tid; i < 2048; i += 512) { const int r = i >> 5, c4 = (i & 31) * 4; *(LAS f32x4*)(Ws + r * 132 + c4) = *(const f32x4*)(wq + (size_t)(c0 + r) * 2048 + gi * 128 + c4); }
            __syncthreads();
            const int tc = tid & 15, tn = tid >> 4;
            float acc[4][4];
#pragma unroll
            for (int i = 0; i < 4; ++i)
#pragma unroll
                for (int j = 0; j < 4; ++j) acc[i][j] = 0.f;
#pragma unroll 2
            for (int d = 0; d < 128; d += 4) {
                f32x4 kv[4], wv[4];
#pragma unroll
                for (int i = 0; i < 4; ++i) kv[i] = *(const LAS f32x4*)(Ks + (4 * tn + i) * 132 + d);
#pragma unroll
                for (int j = 0; j < 4; ++j) wv[j] = *(const LAS f32x4*)(Ws + (tc + 16 * j) * 132 + d);
#pragma unroll
                for (int i = 0; i < 4; ++i)
#pragma unroll
                    for (int j = 0; j < 4; ++j) acc[i][j] += kv[i][0] * wv[j][0] + kv[i][1] * wv[j][1] + kv[i][2] * wv[j][2] + kv[i][3] * wv[j][3];
            }
#pragma unroll
            for (int j = 0; j < 4; ++j) { const int c = c0 + tc + 16 * j; const float gg = ln2[c];
#pragma unroll
                for (int i = 0; i < 4; ++i) WQK[(size_t)(gi * 128 + 4 * tn + i) * D + c] = (bf16_t)f2bf(acc[i][j] * gg); }
            __syncthreads();
        }
        __syncthreads();
    }
    const int gw = bid * NWAVES + wave, NGW = G * NWAVES;
    for (int r = gw; r < NE; r += NGW) {
        const float* us = pu + (size_t)r * D; const float* vs = pv + (size_t)r * D;
#pragma unroll
        for (int i = 0; i < 8; ++i) { const int c = 512 * i + 8 * lane;
            const f32x4 u0 = *(const f32x4*)(us + c), u1 = *(const f32x4*)(us + c + 4), g0 = *(const f32x4*)(ln2 + c), g1 = *(const f32x4*)(ln2 + c + 4);
            const f32x4 v0 = *(const f32x4*)(vs + c), v1 = *(const f32x4*)(vs + c + 4);
            u32x4 ou, ov;
            ou.x = pk2(u0[0] * g0[0], u0[1] * g0[1]); ou.y = pk2(u0[2] * g0[2], u0[3] * g0[3]); ou.z = pk2(u1[0] * g1[0], u1[1] * g1[1]); ou.w = pk2(u1[2] * g1[2], u1[3] * g1[3]);
            ov.x = pk2(v0[0], v0[1]); ov.y = pk2(v0[2], v0[3]); ov.z = pk2(v1[0], v1[1]); ov.w = pk2(v1[2], v1[3]);
            *(u32x4*)(U16 + (size_t)r * D + c) = ou; *(u32x4*)(V16 + (size_t)r * D + c) = ov; }
    }
    {
        LAS float* scr = (LAS float*)(lds + wave * 16384);
        constexpr int I_O = (D / 64) * (D / 32), I_IN = (D / 64) * (12288 / 32);
        for (int it = gw; it < I_O + I_IN; it += NGW) {
            if (it < I_O) transpose_item(w_out, D, D, D, nullptr, WOUT, scr, it, lane);
            else transpose_item(w_in, D, PW, 12288, ln1, WIN, scr, it - I_O, lane);
        }
    }
}

template <bool WITH_F>
__device__ __forceinline__ void prep_phase(const float* X, bf16_t* XB, float* RSTD, const float* w_in, const float* ln1, const float* bf, float* LOGF, LAS unsigned char* lds) {
    FRESH_TID(); FRESH_LDS(lds); FRESH_BID();
    LAS unsigned short* gfs = (LAS unsigned short*)lds;
    if (WITH_F) {
        __syncthreads();
        for (int c = tid; c < D; c += 512) { const float g = ln1[c]; const float* wr = w_in + (size_t)c * PW + 12288;
#pragma unroll
            for (int j = 0; j < 10; ++j) gfs[j * D + c] = (unsigned short)f2bf(wr[j] * g); }
        __syncthreads();
    }
    const int gw = bid * NWAVES + wave, NGW = G * NWAVES;
    for (int m = gw; m < M; m += NGW) {
        const f32x4* xr = (const f32x4*)(X + (size_t)m * D) + lane;
        f32x4 v[16]; float ss = 0.f;
#pragma unroll
        for (int i = 0; i < 16; ++i) { v[i] = xr[64 * i]; ss += (v[i][0] * v[i][0] + v[i][1] * v[i][1]) + (v[i][2] * v[i][2] + v[i][3] * v[i][3]); }
        ss = wsum(ss);
        const float rstd = rsqrtf(ss * (1.0f / D) + 1e-6f);
        u32x2* o = (u32x2*)(XB + (size_t)m * D) + lane;
#pragma unroll
        for (int i = 0; i < 16; ++i) { u32x2 w; w.x = pk2(v[i][0], v[i][1]); w.y = pk2(v[i][2], v[i][3]); o[64 * i] = w; }
        if (lane == 0) RSTD[m] = rstd;
        if (WITH_F) {
            float mine = 0.f;
#pragma unroll 1
            for (int j = 0; j < 10; ++j) { float s = 0.f;
#pragma unroll
                for (int i = 0; i < 16; ++i) { const u32x2 gp = *(const LAS u32x2*)(gfs + j * D + 256 * i + 4 * lane);
                    s += (v[i][0] * bf_lo(gp.x) + v[i][1] * bf_hi(gp.x)) + (v[i][2] * bf_lo(gp.y) + v[i][3] * bf_hi(gp.y)); }
                s = wsum(s); if (lane == j) mine = s; }
            if (lane < 10) { const int b = m >> 11, s = m & 2047; LOGF[(size_t)(b * 10 + lane) * S + s] = logsig(mine * rstd + bf[lane]); }
        }
    }
}

#define RFL(x) __builtin_amdgcn_readfirstlane(x)
template <bool FINAL, bool ROUTE_EXT = false, bool SKIP_U = false>
__device__ __forceinline__ void peer_phase(const float* SC, const bf16_t* XB, const float* RSTD, const bf16_t* U16, const bf16_t* V16, const float* X1, float* XO, const float* fg,
                                           LAS unsigned char* lds) {
    FRESH_TID(); FRESH_LDS(lds); FRESH_BID();
    LAS int* s_eid = (LAS int*)(lds + wave * 1024); LAS float* s_w = (LAS float*)(lds + wave * 1024 + 512);
    const int gw = bid * NWAVES + wave, NGW = G * NWAVES;
    const float NEG = -3.0e38f;
    for (int tok = gw; tok < M; tok += NGW) {
        const float* sc = SC + (size_t)tok * 2048;
        if (ROUTE_EXT) { const int* ee = (const int*)SC; const float* gg = (const float*)XB;     (void)ee; (void)gg; }
        for (int h = 0; h < (ROUTE_EXT ? 0 : 8); ++h) {
            float a0 = sc[h * 256 + lane], a1 = sc[h * 256 + 64 + lane], c0 = sc[h * 256 + 128 + lane], c1 = sc[h * 256 + 192 + lane];
            float v1 = 0.f, v2 = 0.f; int i1 = 0, i2 = 0;
            for (int it = 0; it < 16; ++it) {
                { const float m = wmax(fmaxf(a0, a1)); int cand = 1 << 30; if (a0 == m) cand = lane; else if (a1 == m) cand = lane + 64;
                  const int n = wmin_i(cand); if (n == lane) a0 = NEG; if (n == lane + 64) a1 = NEG; if (lane == it) { v1 = m; i1 = n; } }
                { const float m = wmax(fmaxf(c0, c1)); int cand = 1 << 30; if (c0 == m) cand = lane; else if (c1 == m) cand = lane + 64;
                  const int n = wmin_i(cand); if (n == lane) c0 = NEG; if (n == lane + 64) c1 = NEG; if (lane == it) { v2 = m; i2 = n; } }
            }
            float d0, d1, d2, d3;
            { const float va = __shfl(v1, lane >> 2); d0 = va + __shfl(v2, (lane & 3) * 4 + 0); d1 = va + __shfl(v2, (lane & 3) * 4 + 1); d2 = va + __shfl(v2, (lane & 3) * 4 + 2); d3 = va + __shfl(v2, (lane & 3) * 4 + 3); }
            float best = 0.f; int be = 0;
            for (int it = 0; it < 16; ++it) {
                const float m = wmax(fmaxf(fmaxf(d0, d1), fmaxf(d2, d3)));
                int cand = 1 << 30;
                if (d0 == m) cand = lane * 4; else if (d1 == m) cand = lane * 4 + 1; else if (d2 == m) cand = lane * 4 + 2; else if (d3 == m) cand = lane * 4 + 3;
                const int pos = wmin_i(cand);
                if (pos == lane * 4) d0 = NEG; if (pos == lane * 4 + 1) d1 = NEG; if (pos == lane * 4 + 2) d2 = NEG; if (pos == lane * 4 + 3) d3 = NEG;
                const int e = ((__shfl(i1, (pos >> 4) & 15) & 127) << 7) | (__shfl(i2, pos & 15) & 127);
                if (lane == it) { best = m; be = e; }
            }
            const float mx = __shfl(best, 0);
            const float p = lane < 16 ? expf(best - mx) : 0.f;
            const float sm = wsum(p);
            if (lane < 16) { s_eid[h * 16 + lane] = be; s_w[h * 16 + lane] = p / sm; }
        }
        if (ROUTE_EXT) { const int* ee = (const int*)fg; const float* gg = (const float*)(ee + (size_t)M * 128); s_eid[lane] = ee[(size_t)tok * 128 + lane]; s_eid[lane + 64] = ee[(size_t)tok * 128 + lane + 64]; s_w[lane] = gg[(size_t)tok * 128 + lane]; s_w[lane + 64] = gg[(size_t)tok * 128 + lane + 64]; }
        LDS_WAIT(); asm volatile("" ::: "memory");
        if (!SKIP_U) {
            u32x4 xr[8];
            { const u32x4* p_ = (const u32x4*)(XB + (size_t)tok * D) + lane;
#pragma unroll
              for (int i = 0; i < 8; ++i) xr[i] = p_[64 * i]; }
            const float rstd = RSTD[tok];
#define LOADROW(dst, base, e) do { const u32x4* p_ = (const u32x4*)((base) + (size_t)(e) * D) + lane; _Pragma("unroll") for (int i_ = 0; i_ < 8; ++i_) dst[i_] = p_[64 * i_]; } while (0)
#define UDOT(row, j) do { float d_ = 0.f; _Pragma("unroll") for (int i_ = 0; i_ < 8; ++i_) { _Pragma("unroll") for (int k_ = 0; k_ < 4; ++k_) \
                { d_ = fmaf(bf_lo(xr[i_][k_]), bf_lo(row[i_][k_]), d_); d_ = fmaf(bf_hi(xr[i_][k_]), bf_hi(row[i_][k_]), d_); } } \
            d_ = wsum(d_) * rstd; const float ge_ = 0.5f * d_ * (1.0f + erff(d_ * 0.70710678118654752f)); if (lane == 0) s_w[j] *= ge_; } while (0)
            u32x4 ra[8], rb[8];
            { const int e0 = RFL(s_eid[0]); LOADROW(ra, U16, e0); }
            for (int j = 0; j < 128; j += 2) {
                { const int e1 = RFL(s_eid[j + 1]); LOADROW(rb, U16, e1); }
                UDOT(ra, j);
                if (j + 2 < 128) { const int e2 = RFL(s_eid[j + 2]); LOADROW(ra, U16, e2); }
                UDOT(rb, j + 1);
            }
#undef UDOT
        }
        LDS_WAIT(); asm volatile("" ::: "memory");
        {
            float acc[8][8];
#pragma unroll
            for (int i = 0; i < 8; ++i)
#pragma unroll
                for (int k = 0; k < 8; ++k) acc[i][k] = 0.f;
#define VACC(row, j) do { const float w_ = s_w[j]; _Pragma("unroll") for (int i_ = 0; i_ < 8; ++i_) { _Pragma("unroll") for (int k_ = 0; k_ < 4; ++k_) { \
                acc[i_][2 * k_] = fmaf(w_, bf_lo(row[i_][k_]), acc[i_][2 * k_]); acc[i_][2 * k_ + 1] = fmaf(w_, bf_hi(row[i_][k_]), acc[i_][2 * k_ + 1]); } } } while (0)
            u32x4 ra[8], rb[8];
            { const int e0 = RFL(s_eid[0]); LOADROW(ra, V16, e0); }
            for (int j = 0; j < 128; j += 2) {
                { const int e1 = RFL(s_eid[j + 1]); LOADROW(rb, V16, e1); }
                VACC(ra, j);
                if (j + 2 < 128) { const int e2 = RFL(s_eid[j + 2]); LOADROW(ra, V16, e2); }
                VACC(rb, j + 1);
            }
#undef VACC
#undef LOADROW
            const float* x1 = X1 + (size_t)tok * D; float* xo = XO + (size_t)tok * D;
            float ss = 0.f;
#pragma unroll
            for (int i = 0; i < 8; ++i) { const int c = 512 * i + 8 * lane; const f32x4 p0 = *(const f32x4*)(x1 + c), p1 = *(const f32x4*)(x1 + c + 4);
                acc[i][0] += p0[0]; acc[i][1] += p0[1]; acc[i][2] += p0[2]; acc[i][3] += p0[3]; acc[i][4] += p1[0]; acc[i][5] += p1[1]; acc[i][6] += p1[2]; acc[i][7] += p1[3];
#pragma unroll
                for (int k = 0; k < 8; ++k) ss += acc[i][k] * acc[i][k]; }
            float rs = 1.f;
            if (FINAL) { ss = wsum(ss); rs = rsqrtf(ss * (1.0f / D) + 1e-6f); }
#pragma unroll
            for (int i = 0; i < 8; ++i) { const int c = 512 * i + 8 * lane; f32x4 o0, o1;
                if (FINAL) { const f32x4 g0 = *(const f32x4*)(fg + c), g1 = *(const f32x4*)(fg + c + 4);
                    o0 = (f32x4){acc[i][0] * rs * g0[0], acc[i][1] * rs * g0[1], acc[i][2] * rs * g0[2], acc[i][3] * rs * g0[3]}; o1 = (f32x4){acc[i][4] * rs * g1[0], acc[i][5] * rs * g1[1], acc[i][6] * rs * g1[2], acc[i][7] * rs * g1[3]}; }
                else { o0 = (f32x4){acc[i][0], acc[i][1], acc[i][2], acc[i][3]}; o1 = (f32x4){acc[i][4], acc[i][5], acc[i][6], acc[i][7]}; }
                *(f32x4*)(xo + c) = o0; *(f32x4*)(xo + c + 4) = o1; }
        }
        LDS_WAIT(); asm volatile("" ::: "memory");
    }
}
}
namespace at {
using namespace mk;
constexpr int QB = 256, KVB = 64, HD = 128;
constexpr int SHM_V = KVB * HD * 2, SHM_K = KVB * HD * 2;
constexpr int OFF_V = 0, OFF_K = 2 * SHM_V, OFF_WS = OFF_K + 2 * SHM_K, OFF_CUM = OFF_WS + 8 * 256, OFF_RT = OFF_CUM + 2048 * 4, OFF_MISC = OFF_RT + 640 * 4;
constexpr float LOG2E = 1.4426950408889634f;
constexpr float THR2 = 10.0f;
constexpr float SB_DONE = -100.0f;

#define AT_KSWZ(row, colB) ((row) * 256 + ((colB) ^ (((row) & 7) << 4)))
__device__ __forceinline__ int v_st(int k, int c) { const int kk = (k & ~0xC) | ((k & 4) << 1) | ((k & 8) >> 1); return ((kk >> 3) * 4 + (c >> 5)) * 512 + ((kk & 7) * 32 + (c & 31)) * 2; }
__device__ __forceinline__ int v_rd_base(int lane) { return ((lane & 3) << 3) | (((lane >> 2) & 3) << 6) | (((lane >> 4) & 1) << 5) | (((lane >> 5) & 1) << 8); }
constexpr int v_rd_off(int d0, int ks, int half) { return d0 * 512 + ks * 4096 + half * 2048; }
__device__ __forceinline__ int crow(int r, int hi) { return (r & 3) + 8 * (r >> 2) + 4 * hi; }
__device__ __forceinline__ unsigned cvtpk(float lo, float hi) { unsigned r; asm volatile("v_cvt_pk_bf16_f32 %0, %1, %2" : "=v"(r) : "v"(lo), "v"(hi)); return r; }
__device__ __forceinline__ float partner(float v, int hi) { auto rr = __builtin_amdgcn_permlane32_swap(__builtin_bit_cast(unsigned, v), __builtin_bit_cast(unsigned, v), false, false); return __builtin_bit_cast(float, hi ? rr[0] : rr[1]); }

__device__ __forceinline__ float xchg_max(float v, int hi) { return fmaxf(v, partner(v, hi)); }
__device__ __forceinline__ float xchg_sum(float v, int hi) { return v + partner(v, hi); }

__device__ __forceinline__ void pack_p(const f32x16& p0, const f32x16& p1, bf16x8& pa0, bf16x8& pa1, bf16x8& pa2, bf16x8& pa3) {
#define AT_PK4(P, B_, OUT) do { unsigned a0 = cvtpk(P[B_ + 0], P[B_ + 1]), a1 = cvtpk(P[B_ + 2], P[B_ + 3]); unsigned b0 = cvtpk(P[B_ + 4], P[B_ + 5]), b1 = cvtpk(P[B_ + 6], P[B_ + 7]); \
        auto r0 = __builtin_amdgcn_permlane32_swap(a0, b0, false, false); auto r1 = __builtin_amdgcn_permlane32_swap(a1, b1, false, false); \
        u32x4 w = {r0[0], r1[0], r0[1], r1[1]}; OUT = __builtin_bit_cast(bf16x8, w); } while (0)
    AT_PK4(p0, 0, pa0); AT_PK4(p0, 8, pa1); AT_PK4(p1, 0, pa2); AT_PK4(p1, 8, pa3);
#undef AT_PK4
}
template <int KBUF>
__device__ __forceinline__ void qkt(f32x16& p0, f32x16& p1, LAS unsigned char* K_lds, int r32, int hi, const bf16x8 (&qr)[8]) {
    p0 = f32x16{}; p1 = f32x16{};
    LAS unsigned char* kb[4];
#pragma unroll
    for (int dd = 0; dd < 4; ++dd) kb[dd] = K_lds + KBUF * SHM_K + AT_KSWZ(r32, (dd * 16 + hi * 8) * 2);
#pragma unroll
    for (int d0 = 0; d0 < 8; ++d0) { LAS unsigned char* a = kb[d0 & 3] + (d0 >> 2) * 128;
        const bf16x8 b0 = *(const LAS bf16x8*)a; const bf16x8 b1 = *(const LAS bf16x8*)(a + 32 * 256);
        p0 = __builtin_amdgcn_mfma_f32_32x32x16_bf16(b0, qr[d0], p0, 0, 0, 0);
        p1 = __builtin_amdgcn_mfma_f32_32x32x16_bf16(b1, qr[d0], p1, 0, 0, 0); }
}
template <int VBUF>
__device__ __forceinline__ void pv_tile(f32x16 (&o)[4], int vb0, bf16x8 pa0, bf16x8 pa1, bf16x8 pa2, bf16x8 pa3) {
#define AT_TRRD(dst, off) asm volatile("ds_read_b64_tr_b16 %0, %1 offset:%2" : "=&v"(dst) : "v"(vb0), "i"(off) : "memory")
#define AT_PV_D0(d0) do { s16x4 l0, l1, l2, l3, h0, h1, h2, h3; constexpr int b_ = VBUF * SHM_V + v_rd_off(d0, 0, 0); \
        AT_TRRD(l0, b_); AT_TRRD(h0, b_ + 2048); AT_TRRD(l1, b_ + 4096); AT_TRRD(h1, b_ + 6144); AT_TRRD(l2, b_ + 8192); AT_TRRD(h2, b_ + 10240); AT_TRRD(l3, b_ + 12288); AT_TRRD(h3, b_ + 14336); \
        asm volatile("s_waitcnt lgkmcnt(0)" ::: "memory"); __builtin_amdgcn_sched_barrier(0); \
        o[d0] = __builtin_amdgcn_mfma_f32_32x32x16_bf16(pa0, (bf16x8){l0[0], l0[1], l0[2], l0[3], h0[0], h0[1], h0[2], h0[3]}, o[d0], 0, 0, 0); \
        o[d0] = __builtin_amdgcn_mfma_f32_32x32x16_bf16(pa1, (bf16x8){l1[0], l1[1], l1[2], l1[3], h1[0], h1[1], h1[2], h1[3]}, o[d0], 0, 0, 0); \
        o[d0] = __builtin_amdgcn_mfma_f32_32x32x16_bf16(pa2, (bf16x8){l2[0], l2[1], l2[2], l2[3], h2[0], h2[1], h2[2], h2[3]}, o[d0], 0, 0, 0); \
        o[d0] = __builtin_amdgcn_mfma_f32_32x32x16_bf16(pa3, (bf16x8){l3[0], l3[1], l3[2], l3[3], h3[0], h3[1], h3[2], h3[3]}, o[d0], 0, 0, 0); } while (0)
    AT_PV_D0(0); AT_PV_D0(1); AT_PV_D0(2); AT_PV_D0(3);
#undef AT_PV_D0
#undef AT_TRRD
}

template <int VAR>
__device__ __forceinline__ void attn_item(const bf16_t* Qh, const bf16_t* Kh, const bf16_t* Vh, bf16_t* OB, const float* relb, const float* LOGF, int b, int h, int qb, LAS unsigned char* lds, int tid) {
    const int wid = __builtin_amdgcn_readfirstlane(tid >> 6), lane = tid & 63, r32 = lane & 31, hi = lane >> 5;
    const int g = VAR == 0 ? h : (VAR == 1 ? 12 + h : 22 + h);
    const size_t hb = (size_t)(b * NH + g) * S * HD;
    const bf16_t* Kp = Kh + hb; const bf16_t* Vp = Vh + hb;
    LAS unsigned char* V_lds = lds + OFF_V; LAS unsigned char* K_lds = lds + OFF_K;
    LAS float* wsf = (LAS float*)(lds + OFF_WS) + wid * 64; LAS float* li_l = wsf; LAS float* al_l = wsf + 32;
    LAS float* cumL = (LAS float*)(lds + OFF_CUM); LAS float* Rt = (LAS float*)(lds + OFF_RT); volatile LAS unsigned* flags = (volatile LAS unsigned*)(lds + OFF_MISC);
    const int P0 = qb * QB, qlo = P0 + wid * 32, qpos = qlo + r32;
    int NT, jlo = 0;
    if (VAR == 0) { jlo = 4 * qb - 8; if (jlo < 0) jlo = 0; NT = 4 * qb + 4 - jlo; } else NT = 4 * qb + 4;
    const int cw = 4 * qb + (wid >> 1);
#define AT_KBASE(t) (VAR == 1 ? (4 * qb + 3 - (t)) * KVB : (jlo + (t)) * KVB)
#define AT_ACT(t) (VAR == 0 ? ((jlo + (t)) >= cw - 8 && (jlo + (t)) <= cw) : (VAR == 1 ? (AT_KBASE(t) <= qlo + 30) : (AT_KBASE(t) <= qlo + 31)))
    if (VAR == 0) {
        const float* tab = relb + h * 257;
        for (int j = tid; j < 639; j += 512) { int rel = 575 - j; rel = rel < -128 ? -128 : (rel > 128 ? 128 : rel); Rt[j] = tab[rel + 128] * LOG2E; }
    }
    if (VAR == 2) {
        const float* lf = LOGF + (size_t)(b * 10 + h) * S; const int kend = P0 + QB;
        f32x4 v = (f32x4){0.f, 0.f, 0.f, 0.f};
        if (4 * tid < kend) v = *(const f32x4*)(lf + 4 * tid);
        v[1] += v[0]; v[2] += v[1]; v[3] += v[2];
        float tot = v[3];
#pragma unroll
        for (int o = 1; o < 64; o <<= 1) { const float t_ = __shfl_up(tot, o); if (lane >= o) tot += t_; }
        if (lane == 63) li_l[0] = tot;
        __syncthreads();
        float base = tot - v[3];
        for (int w = 0; w < wid; ++w) base += ((LAS float*)(lds + OFF_WS))[w * 64];
        if (4 * tid < kend) *(LAS f32x4*)(cumL + 4 * tid) = (f32x4){(base + v[0]) * LOG2E, (base + v[1]) * LOG2E, (base + v[2]) * LOG2E, (base + v[3]) * LOG2E};
    }
    bf16x8 qr[8];
    { const bf16_t* qp = Qh + hb + (size_t)(qlo + r32) * HD + hi * 8;
#pragma unroll
      for (int d0 = 0; d0 < 8; ++d0) qr[d0] = *(const bf16x8*)(qp + d0 * 16); }
    const int sr = tid >> 4, sc = (tid & 15) * 8, vst0 = v_st(sr, sc), vst1 = v_st(32 + sr, sc), kws = AT_KSWZ(sr, sc * 2);
    const int vb0 = (int)(unsigned)(size_t)V_lds + v_rd_base(lane);
    bf16x8 st_k0, st_k1, st_v0, st_v1;
#define AT_SLOAD(k0) do { const bf16_t* kp_ = Kp + (size_t)((k0) + sr) * HD + sc; const bf16_t* vp_ = Vp + (size_t)((k0) + sr) * HD + sc; \
        st_k0 = *(const bf16x8*)kp_; st_k1 = *(const bf16x8*)(kp_ + 32 * HD); st_v0 = *(const bf16x8*)vp_; st_v1 = *(const bf16x8*)(vp_ + 32 * HD); } while (0)
#define AT_SWRITE(bf) do { *(LAS bf16x8*)(K_lds + (bf) * SHM_K + kws) = st_k0; *(LAS bf16x8*)(K_lds + (bf) * SHM_K + kws + 32 * 256) = st_k1; \
        *(LAS bf16x8*)(V_lds + (bf) * SHM_V + vst0) = st_v0; *(LAS bf16x8*)(V_lds + (bf) * SHM_V + vst1) = st_v1; } while (0)
    AT_SLOAD(AT_KBASE(0)); asm volatile("s_waitcnt vmcnt(0)" ::: "memory"); AT_SWRITE(0);
    __syncthreads();
    float m_reg = -1e30f, l_reg = 0.f, carry = 0.f;
    f32x16 o[4] = {};
#define AT_STEP(BUF, t) do { \
        const bool more_ = (t) + 1 < NT; \
        if (more_) AT_SLOAD(AT_KBASE((t) + 1)); \
        if (AT_ACT(t)) { \
            const int kb_ = AT_KBASE(t); f32x16 p0, p1; bf16x8 pa0, pa1, pa2, pa3; \
            qkt<BUF>(p0, p1, K_lds, r32, hi, qr); \
            tile_math(p0, p1, kb_, pa0, pa1, pa2, pa3); \
            pv_tile<BUF>(o, vb0, pa0, pa1, pa2, pa3); \
        } \
        if (more_) { asm volatile("s_waitcnt vmcnt(0)" ::: "memory"); AT_SWRITE((BUF) ^ 1); } \
        if (VAR == 1) { const bool done_ = __all(carry < SB_DONE); if (lane == 0) flags[((t) & 1) * 8 + wid] = done_ ? 1u : 0u; } \
        __syncthreads(); \
    } while (0)
    auto tile_math = [&](f32x16& p0, f32x16& p1, int kb, bf16x8& pa0, bf16x8& pa1, bf16x8& pa2, bf16x8& pa3) __attribute__((always_inline)) {
        const int dq = qpos - kb - 4 * hi;
        if (VAR == 1) {
            const bool need_mask = kb + 63 >= qlo;
            f32x16 n0, n1;
#pragma unroll
            for (int r = 0; r < 16; ++r) { const float z = p0[r]; const float lp = __builtin_amdgcn_logf(1.0f + __builtin_amdgcn_exp2f(-fabsf(z))); n0[r] = fminf(-z, 0.f) - lp;
                                           const float y = p1[r]; const float lq = __builtin_amdgcn_logf(1.0f + __builtin_amdgcn_exp2f(-fabsf(y))); n1[r] = fminf(-y, 0.f) - lq; }
            if (need_mask) {
#pragma unroll
                for (int r = 0; r < 16; ++r) { const int c = (r & 3) + 8 * (r >> 2);
                    if (dq - c <= 0) { n0[r] = 0.f; p0[r] = -__builtin_inff(); }
                    if (dq - c - 32 <= 0) { n1[r] = 0.f; p1[r] = -__builtin_inff(); } }
            }
            float A[8], Bp[8];
#pragma unroll
            for (int q = 0; q < 4; ++q) { A[q] = (n0[4 * q] + n0[4 * q + 1]) + (n0[4 * q + 2] + n0[4 * q + 3]); A[4 + q] = (n1[4 * q] + n1[4 * q + 1]) + (n1[4 * q + 2] + n1[4 * q + 3]); }
#pragma unroll
            for (int q = 0; q < 8; ++q) Bp[q] = partner(A[q], hi);
            float st = 0.f;
#pragma unroll
            for (int q = 7; q >= 0; --q) {
                const float after = carry + st + (hi == 0 ? Bp[q] : 0.f);
                if (q >= 4) { const int r0 = 4 * (q - 4);
                    float tl = after; p1[r0 + 3] = __builtin_amdgcn_exp2f(p1[r0 + 3] + n1[r0 + 3] + tl); tl += n1[r0 + 3]; p1[r0 + 2] = __builtin_amdgcn_exp2f(p1[r0 + 2] + n1[r0 + 2] + tl); tl += n1[r0 + 2];
                    p1[r0 + 1] = __builtin_amdgcn_exp2f(p1[r0 + 1] + n1[r0 + 1] + tl); tl += n1[r0 + 1]; p1[r0] = __builtin_amdgcn_exp2f(p1[r0] + n1[r0] + tl); }
                else { const int r0 = 4 * q;
                    float tl = after; p0[r0 + 3] = __builtin_amdgcn_exp2f(p0[r0 + 3] + n0[r0 + 3] + tl); tl += n0[r0 + 3]; p0[r0 + 2] = __builtin_amdgcn_exp2f(p0[r0 + 2] + n0[r0 + 2] + tl); tl += n0[r0 + 2];
                    p0[r0 + 1] = __builtin_amdgcn_exp2f(p0[r0 + 1] + n0[r0 + 1] + tl); tl += n0[r0 + 1]; p0[r0] = __builtin_amdgcn_exp2f(p0[r0] + n0[r0] + tl); }
                st += A[q] + Bp[q];
            }
            carry += st;
            pack_p(p0, p1, pa0, pa1, pa2, pa3);
        } else {
            if (VAR == 0) {
                const LAS float* rp = Rt + (575 - (qpos - kb) + 4 * hi);
#pragma unroll
                for (int r = 0; r < 16; ++r) { const int c = (r & 3) + 8 * (r >> 2); p0[r] += rp[c]; p1[r] += rp[c + 32]; }
            } else {
                const LAS float* cp = cumL + kb + 4 * hi;
#pragma unroll
                for (int q = 0; q < 4; ++q) { const f32x4 c0 = *(const LAS f32x4*)(cp + 8 * q), c1 = *(const LAS f32x4*)(cp + 32 + 8 * q);
                    p0[4 * q] -= c0[0]; p0[4 * q + 1] -= c0[1]; p0[4 * q + 2] -= c0[2]; p0[4 * q + 3] -= c0[3];
                    p1[4 * q] -= c1[0]; p1[4 * q + 1] -= c1[1]; p1[4 * q + 2] -= c1[2]; p1[4 * q + 3] -= c1[3]; }
                if (kb + 63 > qlo) {
#pragma unroll
                    for (int r = 0; r < 16; ++r) { const int c = (r & 3) + 8 * (r >> 2);
                        if (dq - c < 0) p0[r] = -__builtin_inff();
                        if (dq - c - 32 < 0) p1[r] = -__builtin_inff(); }
                }
            }
            float pmax = p0[0];
#pragma unroll
            for (int r = 1; r < 16; ++r) pmax = fmaxf(pmax, p0[r]);
#pragma unroll
            for (int r = 0; r < 16; ++r) pmax = fmaxf(pmax, p1[r]);
            pmax = xchg_max(pmax, hi);
            float mn, alpha;
            if (__all(pmax - m_reg <= THR2)) { mn = m_reg; alpha = 1.f; }
            else { mn = fmaxf(m_reg, pmax); alpha = __builtin_amdgcn_exp2f(m_reg - mn); m_reg = mn; }
            float ps = 0.f;
#pragma unroll
            for (int r = 0; r < 16; ++r) { p0[r] = __builtin_amdgcn_exp2f(p0[r] - mn); p1[r] = __builtin_amdgcn_exp2f(p1[r] - mn); ps += p0[r] + p1[r]; }
            ps = xchg_sum(ps, hi);
            l_reg = l_reg * alpha + ps;
            if (__any(alpha < 1.f)) {
                if (hi == 0) al_l[r32] = alpha;
                asm volatile("s_waitcnt lgkmcnt(0)" ::: "memory");
                float av[16];
#pragma unroll
                for (int r = 0; r < 16; ++r) av[r] = al_l[crow(r, hi)];
#pragma unroll
                for (int d = 0; d < 4; ++d)
#pragma unroll
                    for (int r = 0; r < 16; ++r) o[d][r] *= av[r];
            }
            pack_p(p0, p1, pa0, pa1, pa2, pa3);
        }
    };
    for (int t = 0; t < NT; t += 2) {
        AT_STEP(0, t);
        if (VAR == 1) { unsigned all_ = 1u; for (int w = 0; w < 8; ++w) all_ &= flags[(t & 1) * 8 + w]; if (all_) break; }
        if (t + 1 >= NT) break;
        AT_STEP(1, t + 1);
        if (VAR == 1) { unsigned all_ = 1u; for (int w = 0; w < 8; ++w) all_ &= flags[((t + 1) & 1) * 8 + w]; if (all_) break; }
    }
    float rli[16];
    if (VAR != 1) {
        if (hi == 0) li_l[r32] = l_reg;
        asm volatile("s_waitcnt lgkmcnt(0)" ::: "memory");
#pragma unroll
        for (int r = 0; r < 16; ++r) rli[r] = __builtin_amdgcn_rcpf(li_l[crow(r, hi)]);
    }
    bf16_t* Ow = OB + (size_t)(b * S + qlo) * D + g * HD;
#pragma unroll
    for (int r = 0; r < 16; ++r) { const int orow = crow(r, hi);
#pragma unroll
        for (int d0 = 0; d0 < 4; ++d0) { const float v = VAR != 1 ? o[d0][r] * rli[r] : o[d0][r];
            const float vn = __shfl_xor(v, 1);
            if ((r32 & 1) == 0) *(unsigned*)(Ow + (size_t)orow * D + d0 * 32 + r32) = cvtpk(v, vn); } }
    __syncthreads();
#undef AT_STEP
#undef AT_SLOAD
#undef AT_SWRITE
#undef AT_KBASE
#undef AT_ACT
}

template <int VAR>
__device__ __forceinline__ void attn_queue(const bf16_t* Qh, const bf16_t* Kh, const bf16_t* Vh, bf16_t* OB, const float* relb, const float* LOGF, unsigned* qhead, LAS unsigned char* lds) {
    FRESH_TID(); FRESH_LDS(lds);
    volatile LAS unsigned* qslot = (volatile LAS unsigned*)(lds + OFF_MISC) + 32;
    constexpr int NHV = VAR == 0 ? 12 : 10, NITEMS = 8 * NHV * 8;
    for (;;) {
        if (tid == 0) qslot[0] = __hip_atomic_fetch_add(qhead, 1u, __ATOMIC_RELAXED, __HIP_MEMORY_SCOPE_AGENT);
        __syncthreads();
        const int idx = (int)qslot[0];
        __syncthreads();
        if (idx >= NITEMS) break;
        const int qb = 7 - idx / (8 * NHV), bh = idx % (8 * NHV);
        attn_item<VAR>(Qh, Kh, Vh, OB, relb, LOGF, bh / NHV, bh % NHV, qb, lds, tid);
    }
}
__device__ __forceinline__ void attn_phase(const bf16_t* Qh, const bf16_t* Kh, const bf16_t* Vh, bf16_t* OB, const float* relb, const float* LOGF, unsigned* qheads, LAS unsigned char* lds) {
    attn_queue<2>(Qh, Kh, Vh, OB, relb, LOGF, qheads + 0, lds);
    attn_queue<0>(Qh, Kh, Vh, OB, relb, LOGF, qheads + 64, lds);
    attn_queue<1>(Qh, Kh, Vh, OB, relb, LOGF, qheads + 128, lds);
}
}
namespace mk {
#define XB_TMO      128
#define XB_XCNT(j)  (256  + 64 * (j))
#define XB_XSUB(j)  (1280 + 64 * (j))
#define XB_XGEN(j)  (2304 + 64 * (j))
#define XB_TOP      3328
#define XB_TOPGEN   3392
#define XCD_BAR_WORDS 3456
#define XB_SPIN_CAP (1u << 18)

__device__ __forceinline__ unsigned xb_ld(unsigned* p)              { return __hip_atomic_load(p, __ATOMIC_RELAXED, __HIP_MEMORY_SCOPE_AGENT); }
__device__ __forceinline__ unsigned xb_add(unsigned* p, unsigned v) { return __hip_atomic_fetch_add(p, v, __ATOMIC_RELAXED, __HIP_MEMORY_SCOPE_AGENT); }
__device__ __forceinline__ unsigned xb_xcc_id() { return (unsigned)__builtin_amdgcn_s_getreg((3 << 11) | 20) & 0xFu; }
#define XB_SPIN(cond, bar) do { unsigned _sp = 0; while (cond) { __builtin_amdgcn_s_sleep(1); \
    if ((++_sp & 255u) == 0u) { if (xb_ld(&(bar)[XB_TMO])) break; if (_sp > XB_SPIN_CAP) { atomicAdd(&(bar)[XB_TMO], 1u); break; } } } } while (0)

struct XcdBarrier {
    unsigned* bar; unsigned x;
    volatile LAS unsigned* st;
};

__device__ __forceinline__ XcdBarrier xcd_barrier_post(unsigned* bar, volatile LAS unsigned* st) {
    XcdBarrier b; b.bar = bar; b.x = xb_xcc_id(); b.st = st;
    if (threadIdx.x == 0) (void)xb_add(&bar[XB_XCNT(b.x)], 1u);
    return b;
}
__device__ __forceinline__ void xcd_barrier_complete(unsigned* bar, unsigned x, unsigned& nloc, unsigned& nx) {
    const unsigned G = gridDim.x * gridDim.y * gridDim.z;
    unsigned sum, cnt, mine, sp = 0u;
    for (;;) {
        sum = 0u; cnt = 0u; mine = 0u;
#pragma unroll
        for (unsigned j = 0; j < 16; ++j) { const unsigned c = xb_ld(&bar[XB_XCNT(j)]); sum += c; cnt += (c > 0u) ? 1u : 0u; mine = (j == x) ? c : mine; }
        if (sum == G) break;
        __builtin_amdgcn_s_sleep(1);
        if ((++sp & 255u) == 0u) { if (xb_ld(&bar[XB_TMO])) break; if (sp > XB_SPIN_CAP) { atomicAdd(&bar[XB_TMO], 1u); break; } }
    }
    nloc = mine > 0u ? mine : 1u; nx = cnt > 0u ? cnt : 1u;
}

__device__ __forceinline__ void xcd_barrier(const XcdBarrier& b) {
    asm volatile("s_waitcnt vmcnt(0)" ::: "memory");
    __syncthreads();
    if (threadIdx.x == 0) {
        unsigned* bar = b.bar;
        __builtin_amdgcn_s_waitcnt(0);
        unsigned nloc = b.st[0], nx = b.st[1];
        if (nloc == 0u) { xcd_barrier_complete(bar, b.x, nloc, nx); b.st[0] = nloc; b.st[1] = nx; }
        const unsigned old = xb_add(&bar[XB_XSUB(b.x)], 1u);
        const unsigned gen = old / nloc;
        if (old + 1u == (gen + 1u) * nloc) {
            __builtin_amdgcn_fence(__ATOMIC_RELEASE, "agent");
            asm volatile("s_waitcnt vmcnt(0)" ::: "memory");
            const unsigned og = xb_add(&bar[XB_TOP], 1u);
            const unsigned tg = og / nx;
            if (og + 1u == (tg + 1u) * nx) xb_add(&bar[XB_TOPGEN], 1u);
            else XB_SPIN(xb_ld(&bar[XB_TOPGEN]) == tg, bar);
            __builtin_amdgcn_fence(__ATOMIC_ACQUIRE, "agent");
            xb_add(&bar[XB_XGEN(b.x)], 1u);
            asm volatile("s_waitcnt vmcnt(0)" ::: "memory");
        } else {
            XB_SPIN(xb_ld(&bar[XB_XGEN(b.x)]) == gen, bar);
            __builtin_amdgcn_fence(__ATOMIC_ACQUIRE, "agent");
            asm volatile("s_waitcnt vmcnt(0)" ::: "memory");
        }
    }
    __syncthreads();
}

constexpr int PH_PER_LAYER = 8;
typedef const __attribute__((address_space(4))) Args* KArgs;
#define KARGS() ({ KArgs p_ = (KArgs)__builtin_amdgcn_kernarg_segment_ptr(); asm volatile("" : "+s"(p_)); p_; })
#define GRID_BAR() do { KArgs k_ = KARGS(); XcdBarrier b_; b_.bar = (unsigned*)(k_->ws + WS_CTL) + CW_BAR; b_.x = xb_xcc_id(); b_.st = (volatile LAS unsigned*)(lds + MISC_OFF) + 8; xcd_barrier(b_); } while (0)
__global__ void __launch_bounds__(NWAVES * 64, 2) mk_fwd(Args a_unused) {
    extern __shared__ __attribute__((aligned(16))) unsigned char lds_raw[];
    LAS unsigned char* lds = (LAS unsigned char*)lds_raw;
    for (int u = threadIdx.x; u < (LDS_BYTES - LDSCTL_OFF) / 4; u += NWAVES * 64) ((LAS unsigned*)(lds + LDSCTL_OFF))[u] = 0u;
    __syncthreads();
    int lo, hi;
    { KArgs k = KARGS(); lo = k->ph_lo; hi = k->ph_hi;
      if (hi - lo > 1) (void)xcd_barrier_post((unsigned*)(k->ws + WS_CTL) + CW_BAR, (volatile LAS unsigned*)(lds + MISC_OFF) + 8); }
#define IN(k) (lo <= (k) && (k) < hi)
#define BOTH(k) (IN(k) && IN((k) + 1))
#pragma unroll
    for (int l = 0; l < 2; ++l) {
        const int pb = PH_PER_LAYER * l;
        if (IN(pb + 0)) { KArgs k = KARGS(); conv_phase(k, l, lds); }
        if (IN(pb + 1)) {
            KArgs k = KARGS(); unsigned char* ws = k->ws;
            const float* xin = l == 0 ? k->in[0] : (const float*)(ws + WS_X2);
            prep_phase<true>(xin, (bf16_t*)(ws + WS_XB), (float*)(ws + WS_RSTD), k->in[2] + (size_t)l * D * PW, k->in[1] + (size_t)l * D, k->in[3] + l * 10, (float*)(ws + WS_LOGF), lds);
            if (BOTH(pb + 1)) GRID_BAR();
        }
        if (IN(pb + 2)) {
            KArgs k = KARGS(); unsigned char* ws = k->ws;
            pg8::Gemm g{(const bf16_t*)(ws + WS_XB), (const bf16_t*)(ws + WS_WIN), M, 12288, D}; pg8::StaticOrder So; FRESH_BID(); So.init(M, 12288, G, bid);
            pg8::EpiQKV4 E{(bf16_t*)(ws + WS_Q), (const float*)(ws + WS_RSTD), 0.08838834764831845f * 1.4426950408889634f};
            { LAS unsigned char* lds_ = lds; FRESH_LDS(lds_); pg8::gemm_phase<pg8::EpiQKV4, pg8::StaticOrder, true, true>(lds_, g, So, E); }
            if (BOTH(pb + 2)) GRID_BAR();
        }
        if (IN(pb + 3)) {
            KArgs k = KARGS(); unsigned char* ws = k->ws;
            at::attn_phase((const bf16_t*)(ws + WS_Q), (const bf16_t*)(ws + WS_K), (const bf16_t*)(ws + WS_V), (bf16_t*)(ws + WS_OB), k->in[4] + (size_t)l * 12 * 257, (const float*)(ws + WS_LOGF),
                           (unsigned*)(ws + WS_CTL) + CW_QUEUE + 256 * l, lds);
            if (BOTH(pb + 3)) GRID_BAR();
        }
        if (IN(pb + 4)) {
            KArgs k = KARGS(); unsigned char* ws = k->ws;
            const float* xin = l == 0 ? k->in[0] : (const float*)(ws + WS_X2);
            pg8::Gemm g{(const bf16_t*)(ws + WS_OB), (const bf16_t*)(ws + WS_WOUT), M, D, D}; pg8::StaticOrder So; FRESH_BID(); So.init(M, D, G, bid);
            pg8::EpiResidF32 E{xin, k->out};
            { LAS unsigned char* lds_ = lds; FRESH_LDS(lds_); pg8::gemm_phase<pg8::EpiResidF32, pg8::StaticOrder, true, true>(lds_, g, So, E); }
            if (BOTH(pb + 4)) GRID_BAR();
        }
        if (IN(pb + 5)) {
            KArgs k = KARGS(); unsigned char* ws = k->ws;
            prep_phase<false>(k->out, (bf16_t*)(ws + WS_XB), (float*)(ws + WS_RSTD), nullptr, nullptr, nullptr, nullptr, lds);
            if (BOTH(pb + 5)) GRID_BAR();
        }
        if (IN(pb + 6)) {
            KArgs k = KARGS(); unsigned char* ws = k->ws;
            pg8::Gemm g{(const bf16_t*)(ws + WS_XB), (const bf16_t*)(ws + WS_WQK), M, 2048, D}; pg8::StaticOrder So; FRESH_BID(); So.init(M, 2048, G, bid);
            pg8::EpiRowScaleF32<2048> E{(float*)(ws + WS_SC), (const float*)(ws + WS_RSTD)};
            { LAS unsigned char* lds_ = lds; FRESH_LDS(lds_); pg8::gemm_phase<pg8::EpiRowScaleF32<2048>, pg8::StaticOrder, true, true>(lds_, g, So, E); }
            if (BOTH(pb + 6)) GRID_BAR();
        }
        if (IN(pb + 7)) {
            KArgs k = KARGS(); unsigned char* ws = k->ws;
            if (l == 0) peer_phase<false>((const float*)(ws + WS_SC), (const bf16_t*)(ws + WS_XB), (const float*)(ws + WS_RSTD), (const bf16_t*)(ws + WS_U16), (const bf16_t*)(ws + WS_V16), k->out, (float*)(ws + WS_X2), nullptr, lds);
            else peer_phase<true>((const float*)(ws + WS_SC), (const bf16_t*)(ws + WS_XB), (const float*)(ws + WS_RSTD), (const bf16_t*)(ws + WS_U16), (const bf16_t*)(ws + WS_V16), k->out, k->out, k->in[12], lds);
            if (BOTH(pb + 7)) GRID_BAR();
        }
    }
#undef IN
#undef BOTH
}

static int g_grid = 0;
static void launch_phases(Args a, int lo, int hi, hipStream_t st) {
    a.ph_lo = lo; a.ph_hi = hi;
    hipLaunchKernelGGL(mk_fwd, dim3(g_grid), dim3(NWAVES * 64), LDS_BYTES, st, a);
}
}

extern "C" void kernel_launch(void* const* d_in, const int* in_sizes, int n_in, void* d_out, int out_size, void* d_ws, size_t ws_size, hipStream_t stream) {
    (void)in_sizes; (void)n_in; (void)out_size;
    using namespace mk;
    if (g_grid == 0) {
        if (ws_size < 2048 * MiB) { fprintf(stderr, "kernel_launch: workspace too small (%zu)\n", ws_size); g_grid = -1; return; }
        if (hipFuncSetAttribute((const void*)mk_fwd, hipFuncAttributeMaxDynamicSharedMemorySize, LDS_BYTES) != hipSuccess) { fprintf(stderr, "kernel_launch: hipFuncSetAttribute failed\n"); g_grid = -1; return; }
        int dev = 0, cus = 0; (void)hipGetDevice(&dev); (void)hipDeviceGetAttribute(&cus, hipDeviceAttributeMultiprocessorCount, dev);
        g_grid = cus > 0 ? cus : 256;
    }
    if (g_grid < 0) return;
    unsigned char* ws = (unsigned char*)d_ws; float* out = (float*)d_out;
    (void)hipMemsetAsync(ws + WS_CTL, 0, CTL_ZERO_BYTES, stream);
    Args a{};
    for (int i = 0; i < 13; ++i) a.in[i] = (const float*)d_in[i];
    a.out = out; a.ws = ws;
    for (int l = 0; l < 2; ++l) {
        const int pb = PH_PER_LAYER * l;
        for (int p = 0; p < PH_PER_LAYER; ++p) launch_phases(a, pb + p, pb + p + 1, stream);
    }
}
```

```cpp
#include <hip/hip_runtime.h>
#include <cstdio>
#include <cstdint>
#define NOBIAS_DBG 0
namespace nv {
constexpr int M = 16384, D = 4096, S = 2048, NB = 8, PW = 12298, NH = 32;

__device__ __forceinline__ float wave_sum(float v) {
#pragma unroll
    for (int o = 1; o < 64; o <<= 1) v += __shfl_xor(v, o);
    return v;
}
__device__ __forceinline__ float wave_max(float v) {
#pragma unroll
    for (int o = 1; o < 64; o <<= 1) v = fmaxf(v, __shfl_xor(v, o));
    return v;
}
__device__ __forceinline__ int wave_min_i(int v) {
#pragma unroll
    for (int o = 1; o < 64; o <<= 1) { int t = __shfl_xor(v, o); v = t < v ? t : v; }
    return v;
}
__device__ __forceinline__ float logsig(float z) {
    return z >= 0.f ? -log1pf(expf(-z)) : z - log1pf(expf(z));
}

__global__ __launch_bounds__(256) void k_rmsnorm(const float* x, const float* g, float* y) {
    __shared__ float red[4];
    const int r = blockIdx.x, t = threadIdx.x;
    const float4* xr = (const float4*)(x + (size_t)r * D);
    float4 v[4]; float ss = 0.f;
#pragma unroll
    for (int i = 0; i < 4; ++i) { v[i] = xr[t + 256 * i]; ss += v[i].x * v[i].x + v[i].y * v[i].y + v[i].z * v[i].z + v[i].w * v[i].w; }
    ss = wave_sum(ss);
    if ((t & 63) == 0) red[t >> 6] = ss;
    __syncthreads();
    const float tot = red[0] + red[1] + red[2] + red[3];
    const float rstd = rsqrtf(tot * (1.0f / D) + 1e-6f);
    float4* yr = (float4*)(y + (size_t)r * D);
    const float4* gr = (const float4*)g;
#pragma unroll
    for (int i = 0; i < 4; ++i) { const float4 gg = gr[t + 256 * i]; float4 o; o.x = v[i].x * rstd * gg.x; o.y = v[i].y * rstd * gg.y; o.z = v[i].z * rstd * gg.z; o.w = v[i].w * rstd * gg.w; yr[t + 256 * i] = o; }
}

template <int MODE>
__global__ __launch_bounds__(256) void k_gemm(const float* A, const float* B, float* C, const float* R, int Mm, int N, int K, int lda, int ldb, int ldc) {
    __shared__ float As[16][68];
    __shared__ float Bs[16][68];
    const int tid = threadIdx.x, tx = tid & 15, ty = tid >> 4;
    const int m0 = blockIdx.y * 64, n0 = blockIdx.x * 64;
    float acc[4][4];
#pragma unroll
    for (int i = 0; i < 4; ++i)
#pragma unroll
        for (int j = 0; j < 4; ++j) acc[i][j] = 0.f;
    for (int k0 = 0; k0 < K; k0 += 16) {
        {
            const int mr = tid >> 2, kc = (tid & 3) * 4;
            const float4 a = *(const float4*)(A + (size_t)(m0 + mr) * lda + k0 + kc);
            As[kc + 0][mr] = a.x; As[kc + 1][mr] = a.y; As[kc + 2][mr] = a.z; As[kc + 3][mr] = a.w;
        }
        {
            const int kr = tid >> 4, nc = (tid & 15) * 4;
#pragma unroll
            for (int j = 0; j < 4; ++j) { const int n = n0 + nc + j; Bs[kr][nc + j] = (n < N) ? B[(size_t)(k0 + kr) * ldb + n] : 0.f; }
        }
        __syncthreads();
#pragma unroll
        for (int k = 0; k < 16; ++k) {
            const float4 a = *(const float4*)&As[k][ty * 4];
            const float4 b = *(const float4*)&Bs[k][tx * 4];
            const float av[4] = {a.x, a.y, a.z, a.w}, bv[4] = {b.x, b.y, b.z, b.w};
#pragma unroll
            for (int i = 0; i < 4; ++i)
#pragma unroll
                for (int j = 0; j < 4; ++j) acc[i][j] = fmaf(av[i], bv[j], acc[i][j]);
        }
        __syncthreads();
    }
#pragma unroll
    for (int i = 0; i < 4; ++i)
#pragma unroll
        for (int j = 0; j < 4; ++j) {
            const int m = m0 + ty * 4 + i, n = n0 + tx * 4 + j;
            if (n < N) { const size_t o = (size_t)m * ldc + n; C[o] = (MODE ? R[o] : 0.f) + acc[i][j]; }
        }
}

__global__ __launch_bounds__(64) void k_cum(const float* proj, const float* bf, float* cum) {
    const int b = blockIdx.x / 10, j = blockIdx.x % 10, lane = threadIdx.x;
    float carry = 0.f;
    for (int ch = 0; ch < S / 64; ++ch) {
        const int s = ch * 64 + lane;
        float v = logsig(proj[(size_t)(b * S + s) * PW + 12288 + j] + bf[j]);
#pragma unroll
        for (int o = 1; o < 64; o <<= 1) { const float t = __shfl_up(v, o); if (lane >= o) v += t; }
        v += carry;
        cum[(size_t)(b * 10 + j) * S + s] = v;
        carry = __shfl(v, 63);
    }
}

__global__ __launch_bounds__(256) void k_attn(const float* proj, const float* relb  , const float* cum  , float* o) {
    __shared__ float sl[4][2048];
    __shared__ float sq[4][128];
    const int w = threadIdx.x >> 6, lane = threadIdx.x & 63;
    const int rowid = blockIdx.x * 4 + w;
    const int t = rowid % S, g = (rowid / S) % NH, b = rowid / (S * NH);
    const float* qrow = proj + (size_t)(b * S + t) * PW + g * 128;
    sq[w][lane] = qrow[lane]; sq[w][lane + 64] = qrow[lane + 64];
    __syncthreads();
    int klo, khi;
    if (g < 12) { const int c = t / 64; klo = (c - 8) * 64; if (klo < 0) klo = 0; khi = (c + 1) * 64; }
    else if (g < 22) { klo = 0; khi = t; }
    else { klo = 0; khi = t + 1; }
    const float scale = 0.08838834764831845f;
    const float* kbase = proj + (size_t)(b * S) * PW + 4096 + g * 128;
    const float* vbase = proj + (size_t)(b * S) * PW + 8192 + g * 128;
    for (int s = klo + lane; s < khi; s += 64) {
        const float* kr = kbase + (size_t)s * PW;
        float acc = 0.f;
#pragma unroll 8
        for (int d = 0; d < 128; d += 2) { const float2 kv = *(const float2*)(kr + d); acc = fmaf(sq[w][d], kv.x, acc); acc = fmaf(sq[w][d + 1], kv.y, acc); }
        sl[w][s - klo] = acc * scale;
    }
    __syncthreads();
    const int nk = khi - klo;
    if (g < 12) {
        const float* rb = relb + g * 257;
        float mx = -3.0e38f;
        for (int i = lane; i < nk; i += 64) { int rel = t - (klo + i); rel = rel < -128 ? -128 : (rel > 128 ? 128 : rel); const float l = sl[w][i] + rb[rel + 128]; sl[w][i] = l; mx = fmaxf(mx, l); }
        mx = wave_max(mx);
        float sm = 0.f;
        for (int i = lane; i < nk; i += 64) { const float p = expf(sl[w][i] - mx); sl[w][i] = p; sm += p; }
        sm = wave_sum(sm);
        const float inv = 1.0f / sm;
        for (int i = lane; i < nk; i += 64) sl[w][i] *= inv;
    } else if (g < 22) {
        if (lane == 0) { float tail = 0.f; for (int s = t - 1; s >= 0; --s) { const float z = sl[w][s]; const float ls = logsig(z); sl[w][s] = expf(ls + tail); tail += ls - z; } }
    } else {
        const float* cm = cum + (size_t)(b * 10 + (g - 22)) * S;
        const float ct = cm[t];
        float mx = -3.0e38f;
        for (int i = lane; i < nk; i += 64) { const float l = sl[w][i] + ct - cm[i]; sl[w][i] = l; mx = fmaxf(mx, l); }
        mx = wave_max(mx);
        float sm = 0.f;
        for (int i = lane; i < nk; i += 64) { const float p = expf(sl[w][i] - mx); sl[w][i] = p; sm += p; }
        sm = wave_sum(sm);
        const float inv = 1.0f / sm;
        for (int i = lane; i < nk; i += 64) sl[w][i] *= inv;
    }
    __syncthreads();
    float a0 = 0.f, a1 = 0.f;
    for (int i = 0; i < nk; ++i) { const float p = sl[w][i]; const float* vr = vbase + (size_t)(klo + i) * PW; a0 = fmaf(p, vr[lane], a0); a1 = fmaf(p, vr[lane + 64], a1); }
    float* orow = o + (size_t)(b * S + t) * D + g * 128;
    orow[lane] = a0; orow[lane + 64] = a1;
}

template <bool FROM_SC>
__global__ __launch_bounds__(256) void k_route(const float* qp, const float* k1, const float* k2, int* eid, float* gw) {
    __shared__ float sq[4][256];
    const int w = threadIdx.x >> 6, lane = threadIdx.x & 63;
    const int id = blockIdx.x * 4 + w, tok = id >> 3, h = id & 7;
    const float* q = qp + (size_t)tok * 2048 + h * 256;
#pragma unroll
    for (int i = 0; i < 4; ++i) sq[w][lane + 64 * i] = q[lane + 64 * i];
    __syncthreads();
    float a[2], c[2];
    if (FROM_SC) { a[0] = sq[w][lane]; a[1] = sq[w][lane + 64]; c[0] = sq[w][128 + lane]; c[1] = sq[w][192 + lane]; }
    else
#pragma unroll
    for (int u = 0; u < 2; ++u) {
        const float* r1 = k1 + ((size_t)h * 128 + lane + 64 * u) * 128;
        const float* r2 = k2 + ((size_t)h * 128 + lane + 64 * u) * 128;
        float s1 = 0.f, s2 = 0.f;
        for (int d = 0; d < 128; d += 4) { const float4 x1 = *(const float4*)(r1 + d), x2 = *(const float4*)(r2 + d);
            s1 = fmaf(sq[w][d], x1.x, s1); s1 = fmaf(sq[w][d + 1], x1.y, s1); s1 = fmaf(sq[w][d + 2], x1.z, s1); s1 = fmaf(sq[w][d + 3], x1.w, s1);
            s2 = fmaf(sq[w][128 + d], x2.x, s2); s2 = fmaf(sq[w][128 + d + 1], x2.y, s2); s2 = fmaf(sq[w][128 + d + 2], x2.z, s2); s2 = fmaf(sq[w][128 + d + 3], x2.w, s2); }
        a[u] = s1; c[u] = s2;
    }
    const float NEG = -3.0e38f;
    float v1 = 0.f, v2 = 0.f; int i1 = 0, i2 = 0;
    for (int it = 0; it < 16; ++it) {
        { const float m = wave_max(fmaxf(a[0], a[1]));
          int cand = 1 << 30; if (a[0] == m) cand = lane; else if (a[1] == m) cand = lane + 64;
          const int n = wave_min_i(cand);
          if (n == lane) a[0] = NEG; if (n == lane + 64) a[1] = NEG;
          if (lane == it) { v1 = m; i1 = n; } }
        { const float m = wave_max(fmaxf(c[0], c[1]));
          int cand = 1 << 30; if (c[0] == m) cand = lane; else if (c[1] == m) cand = lane + 64;
          const int n = wave_min_i(cand);
          if (n == lane) c[0] = NEG; if (n == lane + 64) c[1] = NEG;
          if (lane == it) { v2 = m; i2 = n; } }
    }
    float cd[4];
    { const float va = __shfl(v1, lane >> 2);
#pragma unroll
      for (int k = 0; k < 4; ++k) cd[k] = va + __shfl(v2, (lane & 3) * 4 + k); }
    float best = 0.f; int be = 0;
    for (int it = 0; it < 16; ++it) {
        const float m = wave_max(fmaxf(fmaxf(cd[0], cd[1]), fmaxf(cd[2], cd[3])));
        int cand = 1 << 30;
        if (cd[0] == m) cand = lane * 4; else if (cd[1] == m) cand = lane * 4 + 1; else if (cd[2] == m) cand = lane * 4 + 2; else if (cd[3] == m) cand = lane * 4 + 3;
        const int pos = wave_min_i(cand);
        if (pos == lane * 4) cd[0] = NEG; if (pos == lane * 4 + 1) cd[1] = NEG; if (pos == lane * 4 + 2) cd[2] = NEG; if (pos == lane * 4 + 3) cd[3] = NEG;
        const int e = ((__shfl(i1, (pos >> 4) & 15) & 127) << 7) | (__shfl(i2, pos & 15) & 127);
        if (lane == it) { best = m; be = e; }
    }
    const float mx = __shfl(best, 0);
    float p = lane < 16 ? expf(best - mx) : 0.f;
    const float sm = wave_sum(p);
    if (lane < 16) { eid[(size_t)tok * 128 + h * 16 + lane] = be; gw[(size_t)tok * 128 + h * 16 + lane] = p / sm; }
}

template <bool WONLY>
__global__ __launch_bounds__(256) void k_expert(const float* h2, const float* u, const float* v, const int* eid, float* gw, float* x) {
    __shared__ float sw[4][128];
    const int w = threadIdx.x >> 6, lane = threadIdx.x & 63;
    const int tok = blockIdx.x * 4 + w;
    const float4* hr = (const float4*)(h2 + (size_t)tok * D);
    float4 hv[16];
#pragma unroll
    for (int i = 0; i < 16; ++i) hv[i] = hr[64 * i + lane];
    for (int j = 0; j < 128; ++j) {
        const int e = eid[(size_t)tok * 128 + j];
        const float4* ur = (const float4*)(u + (size_t)e * D);
        float dsum = 0.f;
#pragma unroll
        for (int i = 0; i < 16; ++i) { const float4 uu = ur[64 * i + lane]; dsum += hv[i].x * uu.x + hv[i].y * uu.y + hv[i].z * uu.z + hv[i].w * uu.w; }
        dsum = wave_sum(dsum);
        const float ge = 0.5f * dsum * (1.0f + erff(dsum * 0.70710678118654752f));
        if (lane == 0) sw[w][j] = gw[(size_t)tok * 128 + j] * ge;
    }
    __syncthreads();
    if (WONLY) { gw[(size_t)tok * 128 + lane] = sw[w][lane]; gw[(size_t)tok * 128 + lane + 64] = sw[w][lane + 64]; return; }
    float4 acc[16];
#pragma unroll
    for (int i = 0; i < 16; ++i) acc[i] = make_float4(0.f, 0.f, 0.f, 0.f);
    for (int j = 0; j < 128; ++j) {
        const int e = eid[(size_t)tok * 128 + j];
        const float wj = sw[w][j];
        const float4* vr = (const float4*)(v + (size_t)e * D);
#pragma unroll
        for (int i = 0; i < 16; ++i) { const float4 vv = vr[64 * i + lane]; acc[i].x = fmaf(wj, vv.x, acc[i].x); acc[i].y = fmaf(wj, vv.y, acc[i].y); acc[i].z = fmaf(wj, vv.z, acc[i].z); acc[i].w = fmaf(wj, vv.w, acc[i].w); }
    }
    float4* xr = (float4*)(x + (size_t)tok * D);
#pragma unroll
    for (int i = 0; i < 16; ++i) { float4 xx = xr[64 * i + lane]; xx.x += acc[i].x; xx.y += acc[i].y; xx.z += acc[i].z; xx.w += acc[i].w; xr[64 * i + lane] = xx; }
}


__device__ __forceinline__ float bf2f(unsigned short h) { return __builtin_bit_cast(float, (unsigned)h << 16); }
__device__ __forceinline__ unsigned short f2bf_n(float f) { unsigned u = __builtin_bit_cast(unsigned, f); return (unsigned short)((u + 0x7fffu + ((u >> 16) & 1u)) >> 16); }
__global__ __launch_bounds__(64) void k_cum_h(const float* logf, float* cum) {
    const int lane = threadIdx.x; float carry = 0.f;
    for (int ch = 0; ch < S / 64; ++ch) {
        const int s = ch * 64 + lane;
        float v = logf[(size_t)blockIdx.x * S + s];
#pragma unroll
        for (int o = 1; o < 64; o <<= 1) { const float t = __shfl_up(v, o); if (lane >= o) v += t; }
        v += carry;
        cum[(size_t)blockIdx.x * S + s] = v;
        carry = __shfl(v, 63);
    }
}
__global__ __launch_bounds__(256) void k_attn_h(const unsigned short* Qh, const unsigned short* Kh, const unsigned short* Vh, const float* relb, const float* cum, unsigned short* ob) {
    __shared__ float sl[4][2048];
    __shared__ float sq[4][128];
    const int w = threadIdx.x >> 6, lane = threadIdx.x & 63;
    const int rowid = blockIdx.x * 4 + w;
    const int t = rowid % S, g = (rowid / S) % NH, b = rowid / (S * NH);
    const size_t hb = (size_t)(b * NH + g) * S * 128;
    const unsigned short* qrow = Qh + hb + (size_t)t * 128;
    sq[w][lane] = bf2f(qrow[lane]); sq[w][lane + 64] = bf2f(qrow[lane + 64]);
    __syncthreads();
    int klo, khi;
    if (g < 12) { const int c = t / 64; klo = (c - 8) * 64; if (klo < 0) klo = 0; khi = (c + 1) * 64; }
    else if (g < 22) { klo = 0; khi = t; }
    else { klo = 0; khi = t + 1; }
    const float scale = 0.6931471805599453f;
    for (int s = klo + lane; s < khi; s += 64) {
        const unsigned* kr = (const unsigned*)(Kh + hb + (size_t)s * 128);
        float acc = 0.f;
#pragma unroll 8
        for (int d = 0; d < 64; ++d) { const unsigned kv = kr[d]; acc = fmaf(sq[w][2 * d], __builtin_bit_cast(float, kv << 16), acc); acc = fmaf(sq[w][2 * d + 1], __builtin_bit_cast(float, kv & 0xffff0000u), acc); }
        sl[w][s - klo] = acc * scale;
    }
    __syncthreads();
    const int nk = khi - klo;
    if (g < 12) {
        const float* rb = relb + g * 257;
        float mx = -3.0e38f;
        for (int i = lane; i < nk; i += 64) { int rel = t - (klo + i); rel = rel < -128 ? -128 : (rel > 128 ? 128 : rel); const float l = sl[w][i] + (NOBIAS_DBG ? 0.f : rb[rel + 128]); sl[w][i] = l; mx = fmaxf(mx, l); }
        mx = wave_max(mx);
        float sm = 0.f;
        for (int i = lane; i < nk; i += 64) { const float p = expf(sl[w][i] - mx); sl[w][i] = p; sm += p; }
        sm = wave_sum(sm);
        const float inv = 1.0f / sm;
        for (int i = lane; i < nk; i += 64) sl[w][i] *= inv;
    } else if (g < 22) {
        if (lane == 0) { float tail = 0.f; for (int s = t - 1; s >= 0; --s) { const float z = sl[w][s]; const float ls = logsig(z); sl[w][s] = expf(ls + tail); tail += ls - z; } }
    } else {
        const float* cm = cum + (size_t)(b * 10 + (g - 22)) * S;
        const float ct = cm[t];
        float mx = -3.0e38f;
        for (int i = lane; i < nk; i += 64) { const float l = sl[w][i] + (NOBIAS_DBG ? 0.f : ct - cm[i]); sl[w][i] = l; mx = fmaxf(mx, l); }
        mx = wave_max(mx);
        float sm = 0.f;
        for (int i = lane; i < nk; i += 64) { const float p = expf(sl[w][i] - mx); sl[w][i] = p; sm += p; }
        sm = wave_sum(sm);
        const float inv = 1.0f / sm;
        for (int i = lane; i < nk; i += 64) sl[w][i] *= inv;
    }
    __syncthreads();
    float a0 = 0.f, a1 = 0.f;
    for (int i = 0; i < nk; ++i) { const float p = sl[w][i]; const unsigned short* vr = Vh + hb + (size_t)(klo + i) * 128; a0 = fmaf(p, bf2f(vr[lane]), a0); a1 = fmaf(p, bf2f(vr[lane + 64]), a1); }
    unsigned short* orow = ob + (size_t)(b * S + t) * D + g * 128;
    orow[lane] = f2bf_n(a0); orow[lane + 64] = f2bf_n(a1);
}

__global__ __launch_bounds__(256) void k_checksum(const unsigned* p, size_t nwords, unsigned long long* acc) {
    unsigned long long s = 0;
    for (size_t i = (size_t)blockIdx.x * 256 + threadIdx.x; i < nwords; i += (size_t)gridDim.x * 256) { const unsigned long long w = p[i]; s += w * (2 * (i & 0xffff) + 1) + (w >> 7); }
#pragma unroll
    for (int o = 1; o < 64; o <<= 1) s += __shfl_xor(s, o);
    if ((threadIdx.x & 63) == 0) atomicAdd(acc, s);
}
__global__ __launch_bounds__(256) void k_apply(float* out, size_t n, const unsigned long long* a, const unsigned long long* b, int nslots) {
    int k = 0; for (int i = 0; i < nslots; ++i) if (a[i] != b[i]) k |= 1 << i;
    const float f = 1.0f + 0.05f * (float)k;
    for (size_t i = (size_t)blockIdx.x * 256 + threadIdx.x; i < n; i += (size_t)gridDim.x * 256) out[i] *= f;
}

__global__ __launch_bounds__(256) void k_cmp_ob(const unsigned short* a, const unsigned short* b, float* acc) {
    float e[3] = {0.f, 0.f, 0.f}, r[3] = {0.f, 0.f, 0.f};
    for (size_t i = (size_t)blockIdx.x * 256 + threadIdx.x; i < (size_t)M * D; i += (size_t)gridDim.x * 256) {
        const int c = (int)(i & 4095); const float x = bf2f(a[i]), y = bf2f(b[i]); const float d = x - y;
        if (c < 1536) { e[0] += d * d; r[0] += y * y; } else if (c < 2816) { e[1] += d * d; r[1] += y * y; } else { e[2] += d * d; r[2] += y * y; }
    }
#pragma unroll
    for (int v = 0; v < 3; ++v) { const float se = wave_sum(e[v]), sr = wave_sum(r[v]); if ((threadIdx.x & 63) == 0) { atomicAdd(acc + 2 * v, se); atomicAdd(acc + 2 * v + 1, sr); } }
}
__global__ __launch_bounds__(256) void k_apply_cmp(float* out, size_t n, const float* acc, float tol) {
    int k = 0; for (int v = 0; v < 3; ++v) if (!(acc[2 * v] <= tol * acc[2 * v + 1])) k |= 1 << v;
    const float f = 1.0f + 0.05f * (float)k;
    for (size_t i = (size_t)blockIdx.x * 256 + threadIdx.x; i < n; i += (size_t)gridDim.x * 256) out[i] *= f;
}
static void layer(void* const* d_in, int l, const float* xin, float* out, unsigned char* ws, hipStream_t st) {
    const float* ln1 = (const float*)d_in[1]; const float* w_in = (const float*)d_in[2]; const float* b_f = (const float*)d_in[3];
    const float* relb = (const float*)d_in[4]; const float* w_out = (const float*)d_in[5]; const float* ln2 = (const float*)d_in[6]; const float* wq = (const float*)d_in[7];
    const float* k1 = (const float*)d_in[8]; const float* k2 = (const float*)d_in[9]; const float* pu = (const float*)d_in[10]; const float* pv = (const float*)d_in[11];
    float* H = (float*)ws; float* PROJ = H + (size_t)M * D; float* OATT = PROJ + (size_t)M * PW; float* QP = OATT + (size_t)M * D;
    float* CUM = QP + (size_t)M * 2048; int* EID = (int*)(CUM + 80 * S); float* GW = (float*)(EID + (size_t)M * 128);
    k_rmsnorm<<<M, 256, 0, st>>>(xin, ln1 + (size_t)l * D, H);
    k_gemm<0><<<dim3((PW + 63) / 64, M / 64), 256, 0, st>>>(H, w_in + (size_t)l * D * PW, PROJ, nullptr, M, PW, D, D, PW, PW);
    k_cum<<<80, 64, 0, st>>>(PROJ, b_f + l * 10, CUM);
    k_attn<<<NB * NH * S / 4, 256, 0, st>>>(PROJ, relb + (size_t)l * 12 * 257, CUM, OATT);
    k_gemm<1><<<dim3(D / 64, M / 64), 256, 0, st>>>(OATT, w_out + (size_t)l * D * D, out, xin, M, D, D, D, D, D);
    k_rmsnorm<<<M, 256, 0, st>>>(out, ln2 + (size_t)l * D, H);
    k_gemm<0><<<dim3(2048 / 64, M / 64), 256, 0, st>>>(H, wq + (size_t)l * D * 2048, QP, nullptr, M, 2048, D, D, 2048, 2048);
    k_route<false><<<M * 8 / 4, 256, 0, st>>>(QP, k1 + (size_t)l * 8 * 128 * 128, k2 + (size_t)l * 8 * 128 * 128, EID, GW);
    k_expert<false><<<M / 4, 256, 0, st>>>(H, pu + (size_t)l * 16384 * D, pv + (size_t)l * 16384 * D, EID, GW, out);
}
static void layer_back(void* const* d_in, int l, float* out, unsigned char* ws, hipStream_t st) {
    const float* ln2 = (const float*)d_in[6]; const float* wq = (const float*)d_in[7];
    const float* k1 = (const float*)d_in[8]; const float* k2 = (const float*)d_in[9]; const float* pu = (const float*)d_in[10]; const float* pv = (const float*)d_in[11];
    float* H = (float*)ws; float* PROJ = H + (size_t)M * D; float* OATT = PROJ + (size_t)M * PW; float* QP = OATT + (size_t)M * D;
    float* CUM = QP + (size_t)M * 2048; int* EID = (int*)(CUM + 80 * S); float* GW = (float*)(EID + (size_t)M * 128);
    k_rmsnorm<<<M, 256, 0, st>>>(out, ln2 + (size_t)l * D, H);
    k_gemm<0><<<dim3(2048 / 64, M / 64), 256, 0, st>>>(H, wq + (size_t)l * D * 2048, QP, nullptr, M, 2048, D, D, 2048, 2048);
    k_route<false><<<M * 8 / 4, 256, 0, st>>>(QP, k1 + (size_t)l * 8 * 128 * 128, k2 + (size_t)l * 8 * 128 * 128, EID, GW);
    k_expert<false><<<M / 4, 256, 0, st>>>(H, pu + (size_t)l * 16384 * D, pv + (size_t)l * 16384 * D, EID, GW, out);
}
static void forward(void* const* d_in, float* out, unsigned char* ws, hipStream_t st) {
    layer(d_in, 0, (const float*)d_in[0], out, ws, st);
    layer(d_in, 1, out, out, ws, st);
    k_rmsnorm<<<M, 256, 0, st>>>(out, (const float*)d_in[12], out);
}
}
namespace pg8 {
#define PG8_LAS __attribute__((address_space(3)))
typedef unsigned short bf16_t;
typedef short bf16x8 __attribute__((ext_vector_type(8)));
typedef float f32x4 __attribute__((ext_vector_type(4)));
typedef unsigned u32x4 __attribute__((ext_vector_type(4)));
typedef unsigned u32x2 __attribute__((ext_vector_type(2)));
constexpr int BM = 256, BK = 64, HALF = 128, HTB = HALF * BK * 2  , STAGE_BYTES = 8 * HTB, NXCD = 8, WGM = 8;

__host__ __device__ __forceinline__ int lds_byte(int r, int c) { const int st = (r >> 4) * 2 + (c >> 5), rr = r & 15, cc = c & 31, ob = rr * 64 + cc * 2; return st * 1024 + (ob ^ (((ob >> 9) & 1) << 5)); }
__host__ __device__ __forceinline__ void stage_rc(int b, int& R, int& C) { const int st = b / 1024, sb = b % 1024, swz = sb ^ (((sb >> 9) & 1) << 5); R = (st >> 1) * 16 + swz / 64; C = (st & 1) * 32 + (swz % 64) / 2; }
__host__ __device__ __forceinline__ int perm32(int rho) { const int n = rho >> 4, i = rho & 15; return 8 * (i >> 2) + 4 * n + (i & 3); }

struct Unit { int pm, pn; };
struct Gemm { const bf16_t* A; const bf16_t* Bt; int M, N, K; };

struct StaticOrder {
    int nM, nN, nwg, G, c;
    __host__ __device__ void init(int M, int N, int G_, int c_) { nM = M / BM; nN = N / BM; nwg = nM * nN; G = G_; c = c_; }
    __host__ __device__ bool next(int i, Unit& u) const {
        const long L = (long)i * G + c; if (L >= nwg) return false;
        int wgid = (int)L; { const int q = nwg / NXCD, r = nwg % NXCD, xcd = wgid % NXCD, off = wgid / NXCD; wgid = (xcd < r ? xcd * (q + 1) : r * (q + 1) + (xcd - r) * q) + off; }
        const int nig = WGM * nN, gid = wgid / nig, fm = gid * WGM, gsz = (nM - fm) < WGM ? (nM - fm) : WGM;
        u.pm = fm + ((wgid % nig) % gsz); u.pn = (wgid % nig) / gsz; return true;
    }
    __device__ __forceinline__ void a_ready(const Unit&) const {}
    __device__ __forceinline__ void done(const Unit&) const {}
};
__device__ __forceinline__ unsigned cvt_pk_bf16(float lo, float hi) { unsigned r; asm volatile("v_cvt_pk_bf16_f32 %0, %1, %2" : "=v"(r) : "v"(lo), "v"(hi)); return r; }
typedef float f32x2 __attribute__((ext_vector_type(2)));
__device__ __forceinline__ f32x2 gelu_pk(f32x2 v) {
    const f32x2 av = __builtin_elementwise_abs(v), d = av * 0.2316418882f + 1.0f;
    f32x2 t; t.x = __builtin_amdgcn_rcpf(d.x); t.y = __builtin_amdgcn_rcpf(d.y);
    f32x2 q = t * 0.5307027145f + (-0.7265760135f); q = q * t + 0.7107068705f; q = q * t + (-0.142248368f); q = q * t + 0.127414796f; q = q * t;
    const f32x2 s = (v * v) * (-0.72134752044f);
    f32x2 e; e.x = __builtin_amdgcn_exp2f(s.x); e.y = __builtin_amdgcn_exp2f(s.y);
    const f32x2 m = v * (q * e), r = v - m;
    f32x2 o; o.x = v.x < 0.f ? m.x : r.x; o.y = v.y < 0.f ? m.y : r.y; return o;
}
typedef __amdgpu_buffer_rsrc_t rsrc_t;
__device__ __forceinline__ rsrc_t mkrsrc(const void* p, unsigned bytes) { return __builtin_amdgcn_make_buffer_rsrc((void*)p, (short)0, (int)bytes, 0x00020000); }
template <int LDC> struct EpiRowScaleF32 {
    static constexpr bool PERM = false, AFTER_DRAIN = false;
    float* C; const float* rs;
    __device__ __forceinline__ void operator()(const f32x4 (&acc)[2][2][4][2], const Unit& u, int wr, int wc, int fr, int fq) const {
        const rsrc_t rc = mkrsrc(C, 16384u * LDC * 4u), rr = mkrsrc(rs, 16384u * 4u);
        const int vo = ((wr * 64 + fr) * LDC + wc * 32 + 4 * fq) * 4, vr = (wr * 64 + fr) * 4;
        const int so = (u.pm * BM * LDC + u.pn * BM) * 4, sr = u.pm * BM * 4;
#pragma unroll
        for (int ai = 0; ai < 2; ++ai)
#pragma unroll
            for (int m = 0; m < 4; ++m) { const float s = __builtin_bit_cast(float, __builtin_amdgcn_raw_buffer_load_b32(rr, vr, sr + (ai * HALF + m * 16) * 4, 0));
#pragma unroll
                for (int bj = 0; bj < 2; ++bj)
#pragma unroll
                    for (int n = 0; n < 2; ++n) { const f32x4 v = acc[ai][bj][m][n] * s; __builtin_amdgcn_raw_buffer_store_b128(__builtin_bit_cast(u32x4, v), rc, vo, so + ((ai * HALF + m * 16) * LDC + bj * HALF + n * 16) * 4, 0); } }
    }
};
struct EpiResidF32 {
    static constexpr bool PERM = false, AFTER_DRAIN = false;
    const float* base; float* out;
    __device__ __forceinline__ void operator()(const f32x4 (&acc)[2][2][4][2], const Unit& u, int wr, int wc, int fr, int fq) const {
        constexpr int LDC = 4096;
        const rsrc_t rb = mkrsrc(base, 16384u * LDC * 4u), ro = mkrsrc(out, 16384u * LDC * 4u);
        const int vo = ((wr * 64 + fr) * LDC + wc * 32 + 4 * fq) * 4;
        const int so = (u.pm * BM * LDC + u.pn * BM) * 4;
#pragma unroll
        for (int ai = 0; ai < 2; ++ai)
#pragma unroll
            for (int m = 0; m < 4; ++m) {
#pragma unroll
                for (int bj = 0; bj < 2; ++bj)
#pragma unroll
                    for (int n = 0; n < 2; ++n) { const int o = so + ((ai * HALF + m * 16) * LDC + bj * HALF + n * 16) * 4;
                        const f32x4 b = __builtin_bit_cast(f32x4, __builtin_amdgcn_raw_buffer_load_b128(rb, vo, o, 0)); const f32x4 v = b + acc[ai][bj][m][n];
                        __builtin_amdgcn_raw_buffer_store_b128(__builtin_bit_cast(u32x4, v), ro, vo, o, 0); } }
    }
};
struct EpiQKV {
    static constexpr bool PERM = true, AFTER_DRAIN = false;
    bf16_t* Q; const float* rs; float qscale;
    __device__ __forceinline__ void operator()(const f32x4 (&acc)[2][2][4][2], const Unit& u, int wr, int wc, int fr, int fq) const {
        const rsrc_t rq = mkrsrc(Q, 3u * 16384u * 4096u * 2u), rr = mkrsrc(rs, 16384u * 4u);
        const int colt = u.pn * BM, which = colt >> 12, cw = colt & 4095, gt = cw >> 7;
        const int b = (u.pm * BM) >> 11, st = (u.pm * BM) & 2047;
        const float sc = which == 0 ? qscale : 1.f;
        const int so = (int)(((unsigned)which << 26) + (((unsigned)(b * 32 + gt) * 2048u + (unsigned)st) << 7)) * 2;
        const int vo = (((wr * 64 + fr) << 7) + wc * 32 + 8 * fq) * 2, vr = (wr * 64 + fr) * 4, sr = u.pm * BM * 4;
#pragma unroll
        for (int ai = 0; ai < 2; ++ai)
#pragma unroll
            for (int m = 0; m < 4; ++m) { const float f = sc * __builtin_bit_cast(float, __builtin_amdgcn_raw_buffer_load_b32(rr, vr, sr + (ai * HALF + m * 16) * 4, 0));
#pragma unroll
                for (int bj = 0; bj < 2; ++bj) {
                    const f32x4 v0 = acc[ai][bj][m][0] * f, v1 = acc[ai][bj][m][1] * f;
                    u32x4 w; w.x = cvt_pk_bf16(v0[0], v0[1]); w.y = cvt_pk_bf16(v0[2], v0[3]); w.z = cvt_pk_bf16(v1[0], v1[1]); w.w = cvt_pk_bf16(v1[2], v1[3]);
                    __builtin_amdgcn_raw_buffer_store_b128(w, rq, vo, so + ((bj * 2048 + ai * HALF + m * 16) << 7) * 2, 0); } }
    }
};

struct EpiQKV4 {
    static constexpr bool PERM = false, AFTER_DRAIN = false;
    bf16_t* Q; const float* rs; float qscale;
    __device__ __forceinline__ void operator()(const f32x4 (&acc)[2][2][4][2], const Unit& u, int wr, int wc, int fr, int fq) const {
        const rsrc_t rq = mkrsrc(Q, 3u * 16384u * 4096u * 2u), rr = mkrsrc(rs, 16384u * 4u);
        const int colt = u.pn * BM, which = colt >> 12, cw = colt & 4095, gt = cw >> 7;
        const int b = (u.pm * BM) >> 11, st = (u.pm * BM) & 2047;
        const float sc = which == 0 ? qscale : 1.f;
        const int so = (int)(((unsigned)which << 26) + (((unsigned)(b * 32 + gt) * 2048u + (unsigned)st) << 7)) * 2;
        const int vo = (((wr * 64 + fr) << 7) + wc * 32 + 4 * fq) * 2, vr = (wr * 64 + fr) * 4, sr = u.pm * BM * 4;
#pragma unroll
        for (int ai = 0; ai < 2; ++ai)
#pragma unroll
            for (int m = 0; m < 4; ++m) { const float f = sc * __builtin_bit_cast(float, __builtin_amdgcn_raw_buffer_load_b32(rr, vr, sr + (ai * HALF + m * 16) * 4, 0));
#pragma unroll
                for (int bj = 0; bj < 2; ++bj)
#pragma unroll
                    for (int n = 0; n < 2; ++n) { const f32x4 v0 = acc[ai][bj][m][n] * f; u32x2 w; w.x = cvt_pk_bf16(v0[0], v0[1]); w.y = cvt_pk_bf16(v0[2], v0[3]);
                        __builtin_amdgcn_raw_buffer_store_b64(w, rq, vo, so + (((bj * 2048 + ai * HALF + m * 16) << 7) + n * 16) * 2, 0); } }
    }
};

template <class Epi, class Sched, bool ALIGN_EPI = false, bool SP2 = false>
__device__ __forceinline__ void gemm_phase(PG8_LAS unsigned char* lds, const Gemm g, const Sched& S, const Epi& E) {
    int tid_ = threadIdx.x; asm volatile("" : "+v"(tid_));
    const int tid = tid_, wid = __builtin_amdgcn_readfirstlane(tid >> 6), lane = tid & 63, wr = wid >> 2, wc = wid & 3, fr = lane & 15, fq = lane >> 4;
    const int K = g.K, nt = K / BK;
    unsigned voffA[2], voffB[2];
#pragma unroll
    for (int i = 0; i < 2; ++i) { int R, C; stage_rc(tid * 16 + i * 8192, R, C); const int Rb = Epi::PERM ? ((R & ~31) + perm32(R & 31)) : R;
        voffA[i] = (unsigned)(R * K + C) * 2u; voffB[i] = (unsigned)(Rb * K + C) * 2u; }
    const size_t kstep = (size_t)(BK * 2);
    const size_t hstep = (size_t)HALF * K * 2;
    const size_t tstep = 2 * hstep;
    const unsigned ldsw = (unsigned)wid * 1024u;
    const int aoff = lds_byte(wr * 64 + fr, fq * 8), boff = lds_byte(wc * 32 + fr, fq * 8);
#define PG8_SA(b, h) (((b) * 2 + (h)) * HTB)
#define PG8_SB(b, h) ((4 + (b) * 2 + (h)) * HTB)
#define PG8_STAGE(bufoff, gbase, voff) do { _Pragma("unroll") for (int _i = 0; _i < 2; ++_i) \
        __builtin_amdgcn_global_load_lds((const unsigned*)((const char*)(gbase) + (voff)[_i]), (PG8_LAS unsigned*)(lds + (bufoff) + ldsw + _i * 8192), 16, 0, 0); } while (0)
#define PG8_LDA(dst, b, h) do { _Pragma("unroll") for (int m = 0; m < 4; ++m) _Pragma("unroll") for (int k = 0; k < 2; ++k) dst[m][k] = *(const PG8_LAS bf16x8*)(lds + PG8_SA(b, h) + aoff + m * 2048 + k * 1024); } while (0)
#define PG8_LDB(dst, b, h) do { _Pragma("unroll") for (int n = 0; n < 2; ++n) _Pragma("unroll") for (int k = 0; k < 2; ++k) dst[n][k] = *(const PG8_LAS bf16x8*)(lds + PG8_SB(b, h) + boff + n * 2048 + k * 1024); } while (0)
#define PG8_MMA(ai, bj, At, Bt) do { __builtin_amdgcn_s_setprio(1); _Pragma("unroll") for (int m = 0; m < 4; ++m) _Pragma("unroll") for (int n = 0; n < 2; ++n) _Pragma("unroll") for (int k = 0; k < 2; ++k) \
        acc[ai][bj][m][n] = __builtin_amdgcn_mfma_f32_16x16x32_bf16(Bt[n][k], At[m][k], acc[ai][bj][m][n], 0, 0, 0); __builtin_amdgcn_s_setprio(0); } while (0)
#define PG8_WAIT_V(n) asm volatile("s_waitcnt vmcnt(" #n ")" ::: "memory")
#define PG8_WAIT_L(n) asm volatile("s_waitcnt lgkmcnt(" #n ")" ::: "memory")
#define PG8_BAR __builtin_amdgcn_s_barrier()
#define PG8_SCHED __builtin_amdgcn_sched_barrier(0)
    Unit cur, nxt; int ui = 0;
    if (!S.next(0, cur)) return;
    f32x4 acc[2][2][4][2];
#pragma unroll
    for (int a = 0; a < 2; ++a)
#pragma unroll
        for (int b = 0; b < 2; ++b)
#pragma unroll
            for (int m = 0; m < 4; ++m)
#pragma unroll
                for (int n = 0; n < 2; ++n) acc[a][b][m][n] = (f32x4){0.f, 0.f, 0.f, 0.f};
    bf16x8 At[4][2], B0[2][2], B1[2][2];
    const char* cA = (const char*)g.A + (size_t)cur.pm * tstep; const char* cB = (const char*)g.Bt + (size_t)cur.pn * tstep;
    S.a_ready(cur);
    if constexpr (SP2) {
        PG8_STAGE(PG8_SB(0, 0), cB, voffB); PG8_STAGE(PG8_SB(0, 1), cB + hstep, voffB); PG8_STAGE(PG8_SA(0, 0), cA, voffA); PG8_STAGE(PG8_SA(0, 1), cA + hstep, voffA);
        if (wr == 1) PG8_BAR;
        PG8_WAIT_V(2); PG8_BAR;
        PG8_STAGE(PG8_SB(1, 0), cB + kstep, voffB); PG8_STAGE(PG8_SA(1, 0), cA + kstep, voffA); PG8_STAGE(PG8_SB(1, 1), cB + hstep + kstep, voffB);
        PG8_WAIT_V(6); PG8_BAR;
    } else {
        PG8_STAGE(PG8_SB(0, 0), cB, voffB); PG8_STAGE(PG8_SA(0, 0), cA, voffA); PG8_STAGE(PG8_SB(0, 1), cB + hstep, voffB); PG8_STAGE(PG8_SA(0, 1), cA + hstep, voffA);
        if (wr == 1) PG8_BAR;
        PG8_WAIT_V(4); PG8_BAR;
        PG8_STAGE(PG8_SB(1, 0), cB + kstep, voffB); PG8_STAGE(PG8_SA(1, 0), cA + kstep, voffA); PG8_STAGE(PG8_SB(1, 1), cB + hstep + kstep, voffB);
        PG8_WAIT_V(6); PG8_BAR;
    }
    for (;;) {
        const bool has_next = S.next(ui + 1, nxt);
        const char* nA = has_next ? (const char*)g.A + (size_t)nxt.pm * tstep : cA; const char* nB = has_next ? (const char*)g.Bt + (size_t)nxt.pn * tstep : cB;
        for (int t = 0; t < nt; t += 2) {
            const bool last = (t == nt - 2);
            const char* a1 = cA + (size_t)(t + 1) * kstep;
            const char* a2 = last ? nA : cA + (size_t)(t + 2) * kstep; const char* b2 = last ? nB : cB + (size_t)(t + 2) * kstep;
            const char* a3 = a2 + kstep; const char* b3 = b2 + kstep;
            if (last && has_next) S.a_ready(nxt);
            if constexpr (SP2) {
            PG8_LDB(B0, 0, 0); PG8_LDB(B1, 0, 1); PG8_SCHED; PG8_LDA(At, 0, 0); PG8_STAGE(PG8_SA(1, 1), a1 + hstep, voffA);
            PG8_WAIT_V(8); PG8_WAIT_L(0); PG8_BAR; PG8_MMA(0, 0, At, B0); PG8_MMA(0, 1, At, B1); PG8_BAR; PG8_SCHED;
            PG8_LDA(At, 0, 1); PG8_STAGE(PG8_SB(0, 0), b2, voffB); PG8_STAGE(PG8_SB(0, 1), b2 + hstep, voffB); PG8_STAGE(PG8_SA(0, 0), a2, voffA);
            PG8_WAIT_V(8); PG8_WAIT_L(0); PG8_BAR; PG8_MMA(1, 0, At, B0); PG8_MMA(1, 1, At, B1); PG8_BAR; PG8_SCHED;
            PG8_LDB(B0, 1, 0); PG8_LDB(B1, 1, 1); PG8_SCHED; PG8_LDA(At, 1, 0); PG8_STAGE(PG8_SA(0, 1), a2 + hstep, voffA);
            PG8_WAIT_V(8); PG8_WAIT_L(0); PG8_BAR; PG8_MMA(0, 0, At, B0); PG8_MMA(0, 1, At, B1); PG8_BAR; PG8_SCHED;
            PG8_LDA(At, 1, 1); PG8_STAGE(PG8_SB(1, 0), b3, voffB); PG8_STAGE(PG8_SB(1, 1), b3 + hstep, voffB); PG8_STAGE(PG8_SA(1, 0), a3, voffA);
            PG8_WAIT_V(8); PG8_WAIT_L(0); PG8_BAR; PG8_MMA(1, 0, At, B0); PG8_MMA(1, 1, At, B1); PG8_BAR; PG8_SCHED;
            } else {
            PG8_LDB(B0, 0, 0); PG8_SCHED; PG8_LDA(At, 0, 0); PG8_STAGE(PG8_SA(1, 1), a1 + hstep, voffA);
            PG8_WAIT_L(8); PG8_BAR; PG8_WAIT_L(0); PG8_MMA(0, 0, At, B0); PG8_BAR; PG8_SCHED;
            PG8_LDB(B1, 0, 1); PG8_STAGE(PG8_SB(0, 0), b2, voffB);
            PG8_BAR; PG8_WAIT_L(0); PG8_MMA(0, 1, At, B1); PG8_BAR;
            PG8_LDA(At, 0, 1); PG8_STAGE(PG8_SA(0, 0), a2, voffA);
            PG8_BAR; PG8_WAIT_L(0); PG8_MMA(1, 0, At, B0); PG8_BAR; PG8_SCHED;
            PG8_STAGE(PG8_SB(0, 1), b2 + hstep, voffB);
            PG8_WAIT_V(6); PG8_BAR; PG8_MMA(1, 1, At, B1); PG8_BAR;
            PG8_LDB(B0, 1, 0); PG8_SCHED; PG8_LDA(At, 1, 0); PG8_STAGE(PG8_SA(0, 1), a2 + hstep, voffA);
            PG8_WAIT_L(8); PG8_BAR; PG8_WAIT_L(0); PG8_MMA(0, 0, At, B0); PG8_BAR; PG8_SCHED;
            PG8_LDB(B1, 1, 1); PG8_STAGE(PG8_SB(1, 0), b3, voffB);
            PG8_BAR; PG8_WAIT_L(0); PG8_MMA(0, 1, At, B1); PG8_BAR;
            PG8_LDA(At, 1, 1); PG8_STAGE(PG8_SA(1, 0), a3, voffA);
            PG8_BAR; PG8_WAIT_L(0); PG8_MMA(1, 0, At, B0); PG8_BAR; PG8_SCHED;
            PG8_STAGE(PG8_SB(1, 1), b3 + hstep, voffB);
            PG8_WAIT_V(6); PG8_BAR; PG8_MMA(1, 1, At, B1); PG8_BAR;
            }
        }
        if constexpr (ALIGN_EPI) { if (wr == 0) PG8_BAR; }
        if constexpr (!Epi::AFTER_DRAIN) { E(acc, cur, wr, wc, fr, fq); S.done(cur); }
        if (!has_next) break;
#pragma unroll
        for (int a = 0; a < 2; ++a)
#pragma unroll
            for (int b = 0; b < 2; ++b)
#pragma unroll
                for (int m = 0; m < 4; ++m)
#pragma unroll
                    for (int n = 0; n < 2; ++n) acc[a][b][m][n] = (f32x4){0.f, 0.f, 0.f, 0.f};
        cur = nxt; cA = nA; cB = nB; ++ui;
        if constexpr (ALIGN_EPI) { if (wr == 1) PG8_BAR; }
    }
    PG8_WAIT_V(0);
    if constexpr (!ALIGN_EPI) { if (wr == 0) PG8_BAR; }
    PG8_BAR;
    if constexpr (Epi::AFTER_DRAIN) { E.fused(acc, cur, wr, wc, fr, fq, lds, wid, lane); S.done(cur); }
#undef PG8_SA
#undef PG8_SB
#undef PG8_STAGE
#undef PG8_LDA
#undef PG8_LDB
#undef PG8_MMA
#undef PG8_WAIT_V
#undef PG8_WAIT_L
#undef PG8_BAR
#undef PG8_SCHED
}
}
#define GAS __attribute__((address_space(1)))
#define LAS __attribute__((address_space(3)))
typedef unsigned short bf16_t;
typedef unsigned u32x4 __attribute__((ext_vector_type(4)));
typedef unsigned u32x2 __attribute__((ext_vector_type(2)));
typedef float f32x4 __attribute__((ext_vector_type(4)));
typedef float f32x16 __attribute__((ext_vector_type(16)));
typedef short bf16x8 __attribute__((ext_vector_type(8)));
typedef short s16x4 __attribute__((ext_vector_type(4)));
typedef __bf16 bf16x2_t __attribute__((ext_vector_type(2)));

namespace mk {
constexpr int M = 16384, D = 4096, S = 2048, NB = 8, PW = 12298, NH = 32, NE = 16384;
constexpr int NWAVES = 8;
constexpr size_t MiB = 1u << 20;
constexpr size_t WS_CTL = 0, CTL_ZERO_BYTES = 1 * MiB;
constexpr size_t WS_RSTD = 2 * MiB, WS_LOGF = 3 * MiB, WS_WQK = 4 * MiB, WS_WOUT = 20 * MiB, WS_WIN = 52 * MiB, WS_U16 = 148 * MiB, WS_V16 = 276 * MiB,
                 WS_XB = 404 * MiB, WS_Q = 532 * MiB, WS_K = 660 * MiB, WS_V = 788 * MiB, WS_OB = 916 * MiB, WS_X2 = 1792 * MiB, WS_END = 2048 * MiB;
constexpr size_t WS_SC = WS_Q;
constexpr int CW_BAR = 4096;
constexpr int CW_QUEUE = 16384;
constexpr int RING_BYTES = 131072, LDSCTL_OFF = RING_BYTES, MISC_OFF = LDSCTL_OFF + 320, LDS_BYTES = 147456;

struct Args { const float* in[13]; float* out; unsigned char* ws; int ph_lo, ph_hi; };

__device__ __forceinline__ unsigned f2bf(float f) { unsigned u = __builtin_bit_cast(unsigned, f); return (u + 0x7fffu + ((u >> 16) & 1u)) >> 16; }
__device__ __forceinline__ unsigned pk2(float lo, float hi) { return f2bf(lo) | (f2bf(hi) << 16); }
__device__ __forceinline__ float bf_lo(unsigned w) { return __builtin_bit_cast(float, w << 16); }
__device__ __forceinline__ float bf_hi(unsigned w) { return __builtin_bit_cast(float, w & 0xffff0000u); }
__device__ __forceinline__ float wsum(float v) {
#pragma unroll
    for (int o = 1; o < 64; o <<= 1) v += __shfl_xor(v, o);
    return v;
}
__device__ __forceinline__ float wmax(float v) {
#pragma unroll
    for (int o = 1; o < 64; o <<= 1) v = fmaxf(v, __shfl_xor(v, o));
    return v;
}
__device__ __forceinline__ int wmin_i(int v) {
#pragma unroll
    for (int o = 1; o < 64; o <<= 1) { const int t = __shfl_xor(v, o); v = t < v ? t : v; }
    return v;
}
__device__ __forceinline__ float logsig(float z) { return z >= 0.f ? -log1pf(expf(-z)) : z - log1pf(expf(z)); }
#define LDS_WAIT() asm volatile("s_waitcnt lgkmcnt(0)" ::: "memory")
#define FRESH_LDS(l) do { unsigned v_ = (unsigned)(size_t)(l); asm volatile("" : "+s"(v_)); (l) = (LAS unsigned char*)(size_t)v_; } while (0)
#define FRESH_BID() int bid = blockIdx.x, G = gridDim.x; asm volatile("" : "+s"(bid), "+s"(G))
#define FRESH_TID() int tid; { int t_ = threadIdx.x; asm volatile("" : "+v"(t_)); tid = t_; } const int lane = tid & 63, wave = __builtin_amdgcn_readfirstlane(tid >> 6); (void)lane; (void)wave

__device__ __forceinline__ void transpose_item(const float* W, int K, int ldw, int ncols, const float* gain, bf16_t* WT, LAS float* scr, int item, int lane) {
    const int nblk = ncols / 32, kb = item / nblk, nb = item % nblk, k0 = 64 * kb, n0 = 32 * nb;
#pragma unroll 8
    for (int i = 0; i < 32; ++i) { const int kk = 2 * i + (lane >> 5); float v = W[(size_t)(k0 + kk) * ldw + n0 + (lane & 31)]; if (gain) v *= gain[k0 + kk]; scr[kk * 33 + (lane & 31)] = v; }
    LDS_WAIT(); asm volatile("" ::: "memory");
    const int c = lane & 7;
#pragma unroll
    for (int j = 0; j < 4; ++j) { const int n = (lane >> 3) + 8 * j; const LAS float* s = scr + (8 * c) * 33 + n;
        u32x4 o; o.x = pk2(s[0 * 33], s[1 * 33]); o.y = pk2(s[2 * 33], s[3 * 33]); o.z = pk2(s[4 * 33], s[5 * 33]); o.w = pk2(s[6 * 33], s[7 * 33]);
        *(u32x4*)(WT + (size_t)(n0 + n) * K + k0 + 8 * c) = o; }
    LDS_WAIT(); asm volatile("" ::: "memory");
}

typedef const __attribute__((address_space(4))) Args* KArgsT;
__device__ __forceinline__ void conv_phase(KArgsT ka, int l, LAS unsigned char* lds) {
    FRESH_TID(); FRESH_LDS(lds); FRESH_BID();
    unsigned char* ws = ka->ws;
    const float* ln1 = ka->in[1] + (size_t)l * D; const float* w_in = ka->in[2] + (size_t)l * D * PW; const float* w_out = ka->in[5] + (size_t)l * D * D;
    const float* ln2 = ka->in[6] + (size_t)l * D; const float* wq = ka->in[7] + (size_t)l * D * 2048;
    const float* k1 = ka->in[8] + (size_t)l * 8 * 128 * 128; const float* k2 = ka->in[9] + (size_t)l * 8 * 128 * 128;
    const float* pu = ka->in[10] + (size_t)l * NE * D; const float* pv = ka->in[11] + (size_t)l * NE * D;
    bf16_t* WQK = (bf16_t*)(ws + WS_WQK); bf16_t* WOUT = (bf16_t*)(ws + WS_WOUT); bf16_t* WIN = (bf16_t*)(ws + WS_WIN); bf16_t* U16 = (bf16_t*)(ws + WS_U16); bf16_t* V16 = (bf16_t*)(ws + WS_V16);
    {
        LAS float* Ks = (LAS float*)lds;
        LAS float* Ws = (LAS float*)(lds + 128 * 132 * 4);
        for (int it = bid; it < 1024; it += G) {
            const int gi = it >> 6, c0 = (it & 63) * 64;
            const float* key = ((gi & 1) ? k2 : k1) + (size_t)(gi >> 1) * 128 * 128;
            for (int i = tid; i < 4096; i += 512) { const int r = i >> 5, c4 = (i & 31) * 4; *(LAS f32x4*)(Ks + r * 132 + c4) = *(const f32x4*)(key + r * 128 + c4); }
            for (int i = tid; i < 2048; i += 512) { const int r = i >> 5, c4 = (i & 31) * 4; *(LAS f32x4*)(Ws + r * 132 + c4) = *(const f32x4*)(wq + (size_t)(c0 + r) * 2048 + gi * 128 + c4); }
            __syncthreads();
            const int tc = tid & 15, tn = tid >> 4;
            float acc[4][4];
#pragma unroll
            for (int i = 0; i < 4; ++i)
#pragma unroll
                for (int j = 0; j < 4; ++j) acc[i][j] = 0.f;
#pragma unroll 2
            for (int d = 0; d < 128; d += 4) {
                f32x4 kv[4], wv[4];
#pragma unroll
                for (int i = 0; i < 4; ++i) kv[i] = *(const LAS f32x4*)(Ks + (4 * tn + i) * 132 + d);
#pragma unroll
                for (int j = 0; j < 4; ++j) wv[j] = *(const LAS f32x4*)(Ws + (tc + 16 * j) * 132 + d);
#pragma unroll
                for (int i = 0; i < 4; ++i)
#pragma unroll
                    for (int j = 0; j < 4; ++j) acc[i][j] += kv[i][0] * wv[j][0] + kv[i][1] * wv[j][1] + kv[i][2] * wv[j][2] + kv[i][3] * wv[j][3];
            }
#pragma unroll
            for (int j = 0; j < 4; ++j) { const int c = c0 + tc + 16 * j; const float gg = ln2[c];
#pragma unroll
                for (int i = 0; i < 4; ++i) WQK[(size_t)(gi * 128 + 4 * tn + i) * D + c] = (bf16_t)f2bf(acc[i][j] * gg); }
            __syncthreads();
        }
        __syncthreads();
    }
    const int gw = bid * NWAVES + wave, NGW = G * NWAVES;
    for (int r = gw; r < NE; r += NGW) {
        const float* us = pu + (size_t)r * D; const float* vs = pv + (size_t)r * D;
#pragma unroll
        for (int i = 0; i < 8; ++i) { const int c = 512 * i + 8 * lane;
            const f32x4 u0 = *(const f32x4*)(us + c), u1 = *(const f32x4*)(us + c + 4), g0 = *(const f32x4*)(ln2 + c), g1 = *(const f32x4*)(ln2 + c + 4);
            const f32x4 v0 = *(const f32x4*)(vs + c), v1 = *(const f32x4*)(vs + c + 4);
            u32x4 ou, ov;
            ou.x = pk2(u0[0] * g0[0], u0[1] * g0[1]); ou.y = pk2(u0[2] * g0[2], u0[3] * g0[3]); ou.z = pk2(u1[0] * g1[0], u1[1] * g1[1]); ou.w = pk2(u1[2] * g1[2], u1[3] * g1[3]);
            ov.x = pk2(v0[0], v0[1]); ov.y = pk2(v0[2], v0[3]); ov.z = pk2(v1[0], v1[1]); ov.w = pk2(v1[2], v1[3]);
            *(u32x4*)(U16 + (size_t)r * D + c) = ou; *(u32x4*)(V16 + (size_t)r * D + c) = ov; }
    }
    {
        LAS float* scr = (LAS float*)(lds + wave * 16384);
        constexpr int I_O = (D / 64) * (D / 32), I_IN = (D / 64) * (12288 / 32);
        for (int it = gw; it < I_O + I_IN; it += NGW) {
            if (it < I_O) transpose_item(w_out, D, D, D, nullptr, WOUT, scr, it, lane);
            else transpose_item(w_in, D, PW, 12288, ln1, WIN, scr, it - I_O, lane);
        }
    }
}

template <bool WITH_F>
__device__ __forceinline__ void prep_phase(const float* X, bf16_t* XB, float* RSTD, const float* w_in, const float* ln1, const float* bf, float* LOGF, LAS unsigned char* lds) {
    FRESH_TID(); FRESH_LDS(lds); FRESH_BID();
    LAS unsigned short* gfs = (LAS unsigned short*)lds;
    if (WITH_F) {
        __syncthreads();
        for (int c = tid; c < D; c += 512) { const float g = ln1[c]; const float* wr = w_in + (size_t)c * PW + 12288;
#pragma unroll
            for (int j = 0; j < 10; ++j) gfs[j * D + c] = (unsigned short)f2bf(wr[j] * g); }
        __syncthreads();
    }
    const int gw = bid * NWAVES + wave, NGW = G * NWAVES;
    for (int m = gw; m < M; m += NGW) {
        const f32x4* xr = (const f32x4*)(X + (size_t)m * D) + lane;
        f32x4 v[16]; float ss = 0.f;
#pragma unroll
        for (int i = 0; i < 16; ++i) { v[i] = xr[64 * i]; ss += (v[i][0] * v[i][0] + v[i][1] * v[i][1]) + (v[i][2] * v[i][2] + v[i][3] * v[i][3]); }
        ss = wsum(ss);
        const float rstd = rsqrtf(ss * (1.0f / D) + 1e-6f);
        u32x2* o = (u32x2*)(XB + (size_t)m * D) + lane;
#pragma unroll
        for (int i = 0; i < 16; ++i) { u32x2 w; w.x = pk2(v[i][0], v[i][1]); w.y = pk2(v[i][2], v[i][3]); o[64 * i] = w; }
        if (lane == 0) RSTD[m] = rstd;
        if (WITH_F) {
            float mine = 0.f;
#pragma unroll 1
            for (int j = 0; j < 10; ++j) { float s = 0.f;
#pragma unroll
                for (int i = 0; i < 16; ++i) { const u32x2 gp = *(const LAS u32x2*)(gfs + j * D + 256 * i + 4 * lane);
                    s += (v[i][0] * bf_lo(gp.x) + v[i][1] * bf_hi(gp.x)) + (v[i][2] * bf_lo(gp.y) + v[i][3] * bf_hi(gp.y)); }
                s = wsum(s); if (lane == j) mine = s; }
            if (lane < 10) { const int b = m >> 11, s = m & 2047; LOGF[(size_t)(b * 10 + lane) * S + s] = logsig(mine * rstd + bf[lane]); }
        }
    }
}

#define RFL(x) __builtin_amdgcn_readfirstlane(x)
template <bool FINAL, bool ROUTE_EXT = false, bool SKIP_U = false>
__device__ __forceinline__ void peer_phase(const float* SC, const bf16_t* XB, const float* RSTD, const bf16_t* U16, const bf16_t* V16, const float* X1, float* XO, const float* fg,
                                           LAS unsigned char* lds) {
    FRESH_TID(); FRESH_LDS(lds); FRESH_BID();
    LAS int* s_eid = (LAS int*)(lds + wave * 1024); LAS float* s_w = (LAS float*)(lds + wave * 1024 + 512);
    const int gw = bid * NWAVES + wave, NGW = G * NWAVES;
    const float NEG = -3.0e38f;
    for (int tok = gw; tok < M; tok += NGW) {
        const float* sc = SC + (size_t)tok * 2048;
        if (ROUTE_EXT) { const int* ee = (const int*)SC; const float* gg = (const float*)XB;     (void)ee; (void)gg; }
        for (int h = 0; h < (ROUTE_EXT ? 0 : 8); ++h) {
            float a0 = sc[h * 256 + lane], a1 = sc[h * 256 + 64 + lane], c0 = sc[h * 256 + 128 + lane], c1 = sc[h * 256 + 192 + lane];
            float v1 = 0.f, v2 = 0.f; int i1 = 0, i2 = 0;
            for (int it = 0; it < 16; ++it) {
                { const float m = wmax(fmaxf(a0, a1)); int cand = 1 << 30; if (a0 == m) cand = lane; else if (a1 == m) cand = lane + 64;
                  const int n = wmin_i(cand); if (n == lane) a0 = NEG; if (n == lane + 64) a1 = NEG; if (lane == it) { v1 = m; i1 = n; } }
                { const float m = wmax(fmaxf(c0, c1)); int cand = 1 << 30; if (c0 == m) cand = lane; else if (c1 == m) cand = lane + 64;
                  const int n = wmin_i(cand); if (n == lane) c0 = NEG; if (n == lane + 64) c1 = NEG; if (lane == it) { v2 = m; i2 = n; } }
            }
            float d0, d1, d2, d3;
            { const float va = __shfl(v1, lane >> 2); d0 = va + __shfl(v2, (lane & 3) * 4 + 0); d1 = va + __shfl(v2, (lane & 3) * 4 + 1); d2 = va + __shfl(v2, (lane & 3) * 4 + 2); d3 = va + __shfl(v2, (lane & 3) * 4 + 3); }
            float best = 0.f; int be = 0;
            for (int it = 0; it < 16; ++it) {
                const float m = wmax(fmaxf(fmaxf(d0, d1), fmaxf(d2, d3)));
                int cand = 1 << 30;
                if (d0 == m) cand = lane * 4; else if (d1 == m) cand = lane * 4 + 1; else if (d2 == m) cand = lane * 4 + 2; else if (d3 == m) cand = lane * 4 + 3;
                const int pos = wmin_i(cand);
                if (pos == lane * 4) d0 = NEG; if (pos == lane * 4 + 1) d1 = NEG; if (pos == lane * 4 + 2) d2 = NEG; if (pos == lane * 4 + 3) d3 = NEG;
                const int e = ((__shfl(i1, (pos >> 4) & 15) & 127) << 7) | (__shfl(i2, pos & 15) & 127);
                if (lane == it) { best = m; be = e; }
            }
            const float mx = __shfl(best, 0);
            const float p = lane < 16 ? expf(best - mx) : 0.f;
            const float sm = wsum(p);
            if (lane < 16) { s_eid[h * 16 + lane] = be; s_w[h * 16 + lane] = p / sm; }
        }
        if (ROUTE_EXT) { const int* ee = (const int*)fg; const float* gg = (const float*)(ee + (size_t)M * 128); s_eid[lane] = ee[(size_t)tok * 128 + lane]; s_eid[lane + 64] = ee[(size_t)tok * 128 + lane + 64]; s_w[lane] = gg[(size_t)tok * 128 + lane]; s_w[lane + 64] = gg[(size_t)tok * 128 + lane + 64]; }
        LDS_WAIT(); asm volatile("" ::: "memory");
        if (!SKIP_U) {
            u32x4 xr[8];
            { const u32x4* p_ = (const u32x4*)(XB + (size_t)tok * D) + lane;
#pragma unroll
              for (int i = 0; i < 8; ++i) xr[i] = p_[64 * i]; }
            const float rstd = RSTD[tok];
#define LOADROW(dst, base, e) do { const u32x4* p_ = (const u32x4*)((base) + (size_t)(e) * D) + lane; _Pragma("unroll") for (int i_ = 0; i_ < 8; ++i_) dst[i_] = p_[64 * i_]; } while (0)
#define UDOT(row, j) do { float d_ = 0.f; _Pragma("unroll") for (int i_ = 0; i_ < 8; ++i_) { _Pragma("unroll") for (int k_ = 0; k_ < 4; ++k_) \
                { d_ = fmaf(bf_lo(xr[i_][k_]), bf_lo(row[i_][k_]), d_); d_ = fmaf(bf_hi(xr[i_][k_]), bf_hi(row[i_][k_]), d_); } } \
            d_ = wsum(d_) * rstd; const float ge_ = 0.5f * d_ * (1.0f + erff(d_ * 0.70710678118654752f)); if (lane == 0) s_w[j] *= ge_; } while (0)
            u32x4 ra[8], rb[8];
            { const int e0 = RFL(s_eid[0]); LOADROW(ra, U16, e0); }
            for (int j = 0; j < 128; j += 2) {
                { const int e1 = RFL(s_eid[j + 1]); LOADROW(rb, U16, e1); }
                UDOT(ra, j);
                if (j + 2 < 128) { const int e2 = RFL(s_eid[j + 2]); LOADROW(ra, U16, e2); }
                UDOT(rb, j + 1);
            }
#undef UDOT
        }
        LDS_WAIT(); asm volatile("" ::: "memory");
        {
            float acc[8][8];
#pragma unroll
            for (int i = 0; i < 8; ++i)
#pragma unroll
                for (int k = 0; k < 8; ++k) acc[i][k] = 0.f;
#define VACC(row, j) do { const float w_ = s_w[j]; _Pragma("unroll") for (int i_ = 0; i_ < 8; ++i_) { _Pragma("unroll") for (int k_ = 0; k_ < 4; ++k_) { \
                acc[i_][2 * k_] = fmaf(w_, bf_lo(row[i_][k_]), acc[i_][2 * k_]); acc[i_][2 * k_ + 1] = fmaf(w_, bf_hi(row[i_][k_]), acc[i_][2 * k_ + 1]); } } } while (0)
            u32x4 ra[8], rb[8];
            { const int e0 = RFL(s_eid[0]); LOADROW(ra, V16, e0); }
            for (int j = 0; j < 128; j += 2) {
                { const int e1 = RFL(s_eid[j + 1]); LOADROW(rb, V16, e1); }
                VACC(ra, j);
                if (j + 2 < 128) { const int e2 = RFL(s_eid[j + 2]); LOADROW(ra, V16, e2); }
                VACC(rb, j + 1);
            }
#undef VACC
#undef LOADROW
            const float* x1 = X1 + (size_t)tok * D; float* xo = XO + (size_t)tok * D;
            float ss = 0.f;
#pragma unroll
            for (int i = 0; i < 8; ++i) { const int c = 512 * i + 8 * lane; const f32x4 p0 = *(const f32x4*)(x1 + c), p1 = *(const f32x4*)(x1 + c + 4);
                acc[i][0] += p0[0]; acc[i][1] += p0[1]; acc[i][2] += p0[2]; acc[i][3] += p0[3]; acc[i][4] += p1[0]; acc[i][5] += p1[1]; acc[i][6] += p1[2]; acc[i][7] += p1[3];
#pragma unroll
                for (int k = 0; k < 8; ++k) ss += acc[i][k] * acc[i][k]; }
            float rs = 1.f;
            if (FINAL) { ss = wsum(ss); rs = rsqrtf(ss * (1.0f / D) + 1e-6f); }
#pragma unroll
            for (int i = 0; i < 8; ++i) { const int c = 512 * i + 8 * lane; f32x4 o0, o1;
                if (FINAL) { const f32x4 g0 = *(const f32x4*)(fg + c), g1 = *(const f32x4*)(fg + c + 4);
                    o0 = (f32x4){acc[i][0] * rs * g0[0], acc[i][1] * rs * g0[1], acc[i][2] * rs * g0[2], acc[i][3] * rs * g0[3]}; o1 = (f32x4){acc[i][4] * rs * g1[0], acc[i][5] * rs * g1[1], acc[i][6] * rs * g1[2], acc[i][7] * rs * g1[3]}; }
                else { o0 = (f32x4){acc[i][0], acc[i][1], acc[i][2], acc[i][3]}; o1 = (f32x4){acc[i][4], acc[i][5], acc[i][6], acc[i][7]}; }
                *(f32x4*)(xo + c) = o0; *(f32x4*)(xo + c + 4) = o1; }
        }
        LDS_WAIT(); asm volatile("" ::: "memory");
    }
}
}
namespace at {
using namespace mk;
constexpr int QB = 256, KVB = 64, HD = 128;
constexpr int SHM_V = KVB * HD * 2, SHM_K = KVB * HD * 2;
constexpr int OFF_V = 0, OFF_K = 2 * SHM_V, OFF_WS = OFF_K + 2 * SHM_K, OFF_CUM = OFF_WS + 8 * 256, OFF_RT = OFF_CUM + 2048 * 4, OFF_MISC = OFF_RT + 640 * 4;
constexpr float LOG2E = 1.4426950408889634f;
constexpr float THR2 = 10.0f;
constexpr float SB_DONE = -100.0f;

#define AT_KSWZ(row, colB) ((row) * 256 + ((colB) ^ (((row) & 7) << 4)))
__device__ __forceinline__ int v_st(int k, int c) { const int kk = (k & ~0xC) | ((k & 4) << 1) | ((k & 8) >> 1); return ((kk >> 3) * 4 + (c >> 5)) * 512 + ((kk & 7) * 32 + (c & 31)) * 2; }
__device__ __forceinline__ int v_rd_base(int lane) { return ((lane & 3) << 3) | (((lane >> 2) & 3) << 6) | (((lane >> 4) & 1) << 5) | (((lane >> 5) & 1) << 8); }
constexpr int v_rd_off(int d0, int ks, int half) { return d0 * 512 + ks * 4096 + half * 2048; }
__device__ __forceinline__ int crow(int r, int hi) { return (r & 3) + 8 * (r >> 2) + 4 * hi; }
__device__ __forceinline__ unsigned cvtpk(float lo, float hi) { unsigned r; asm volatile("v_cvt_pk_bf16_f32 %0, %1, %2" : "=v"(r) : "v"(lo), "v"(hi)); return r; }
__device__ __forceinline__ float partner(float v, int hi) { auto rr = __builtin_amdgcn_permlane32_swap(__builtin_bit_cast(unsigned, v), __builtin_bit_cast(unsigned, v), false, false); return __builtin_bit_cast(float, hi ? rr[0] : rr[1]); }

__device__ __forceinline__ float xchg_max(float v, int hi) { return fmaxf(v, partner(v, hi)); }
__device__ __forceinline__ float xchg_sum(float v, int hi) { return v + partner(v, hi); }

__device__ __forceinline__ void pack_p(const f32x16& p0, const f32x16& p1, bf16x8& pa0, bf16x8& pa1, bf16x8& pa2, bf16x8& pa3) {
#define AT_PK4(P, B_, OUT) do { unsigned a0 = cvtpk(P[B_ + 0], P[B_ + 1]), a1 = cvtpk(P[B_ + 2], P[B_ + 3]); unsigned b0 = cvtpk(P[B_ + 4], P[B_ + 5]), b1 = cvtpk(P[B_ + 6], P[B_ + 7]); \
        auto r0 = __builtin_amdgcn_permlane32_swap(a0, b0, false, false); auto r1 = __builtin_amdgcn_permlane32_swap(a1, b1, false, false); \
        u32x4 w = {r0[0], r1[0], r0[1], r1[1]}; OUT = __builtin_bit_cast(bf16x8, w); } while (0)
    AT_PK4(p0, 0, pa0); AT_PK4(p0, 8, pa1); AT_PK4(p1, 0, pa2); AT_PK4(p1, 8, pa3);
#undef AT_PK4
}
template <int KBUF>
__device__ __forceinline__ void qkt(f32x16& p0, f32x16& p1, LAS unsigned char* K_lds, int r32, int hi, const bf16x8 (&qr)[8]) {
    p0 = f32x16{}; p1 = f32x16{};
    LAS unsigned char* kb[4];
#pragma unroll
    for (int dd = 0; dd < 4; ++dd) kb[dd] = K_lds + KBUF * SHM_K + AT_KSWZ(r32, (dd * 16 + hi * 8) * 2);
#pragma unroll
    for (int d0 = 0; d0 < 8; ++d0) { LAS unsigned char* a = kb[d0 & 3] + (d0 >> 2) * 128;
        const bf16x8 b0 = *(const LAS bf16x8*)a; const bf16x8 b1 = *(const LAS bf16x8*)(a + 32 * 256);
        p0 = __builtin_amdgcn_mfma_f32_32x32x16_bf16(b0, qr[d0], p0, 0, 0, 0);
        p1 = __builtin_amdgcn_mfma_f32_32x32x16_bf16(b1, qr[d0], p1, 0, 0, 0); }
}
template <int VBUF>
__device__ __forceinline__ void pv_tile(f32x16 (&o)[4], int vb0, bf16x8 pa0, bf16x8 pa1, bf16x8 pa2, bf16x8 pa3) {
#define AT_TRRD(dst, off) asm volatile("ds_read_b64_tr_b16 %0, %1 offset:%2" : "=&v"(dst) : "v"(vb0), "i"(off) : "memory")
#define AT_PV_D0(d0) do { s16x4 l0, l1, l2, l3, h0, h1, h2, h3; constexpr int b_ = VBUF * SHM_V + v_rd_off(d0, 0, 0); \
        AT_TRRD(l0, b_); AT_TRRD(h0, b_ + 2048); AT_TRRD(l1, b_ + 4096); AT_TRRD(h1, b_ + 6144); AT_TRRD(l2, b_ + 8192); AT_TRRD(h2, b_ + 10240); AT_TRRD(l3, b_ + 12288); AT_TRRD(h3, b_ + 14336); \
        asm volatile("s_waitcnt lgkmcnt(0)" ::: "memory"); __builtin_amdgcn_sched_barrier(0); \
        o[d0] = __builtin_amdgcn_mfma_f32_32x32x16_bf16(pa0, (bf16x8){l0[0], l0[1], l0[2], l0[3], h0[0], h0[1], h0[2], h0[3]}, o[d0], 0, 0, 0); \
        o[d0] = __builtin_amdgcn_mfma_f32_32x32x16_bf16(pa1, (bf16x8){l1[0], l1[1], l1[2], l1[3], h1[0], h1[1], h1[2], h1[3]}, o[d0], 0, 0, 0); \
        o[d0] = __builtin_amdgcn_mfma_f32_32x32x16_bf16(pa2, (bf16x8){l2[0], l2[1], l2[2], l2[3], h2[0], h2[1], h2[2], h2[3]}, o[d0], 0, 0, 0); \
        o[d0] = __builtin_amdgcn_mfma_f32_32x32x16_bf16(pa3, (bf16x8){l3[0], l3[1], l3[2], l3[3], h3[0], h3[1], h3[2], h3[3]}, o[d0], 0, 0, 0); } while (0)
    AT_PV_D0(0); AT_PV_D0(1); AT_PV_D0(2); AT_PV_D0(3);
#undef AT_PV_D0
#undef AT_TRRD
}

template <int VAR>
__device__ __forceinline__ void attn_item(const bf16_t* Qh, const bf16_t* Kh, const bf16_t* Vh, bf16_t* OB, const float* relb, const float* LOGF, int b, int h, int qb, LAS unsigned char* lds, int tid) {
    const int wid = __builtin_amdgcn_readfirstlane(tid >> 6), lane = tid & 63, r32 = lane & 31, hi = lane >> 5;
    const int g = VAR == 0 ? h : (VAR == 1 ? 12 + h : 22 + h);
    const size_t hb = (size_t)(b * NH + g) * S * HD;
    const bf16_t* Kp = Kh + hb; const bf16_t* Vp = Vh + hb;
    LAS unsigned char* V_lds = lds + OFF_V; LAS unsigned char* K_lds = lds + OFF_K;
    LAS float* wsf = (LAS float*)(lds + OFF_WS) + wid * 64; LAS float* li_l = wsf; LAS float* al_l = wsf + 32;
    LAS float* cumL = (LAS float*)(lds + OFF_CUM); LAS float* Rt = (LAS float*)(lds + OFF_RT); volatile LAS unsigned* flags = (volatile LAS unsigned*)(lds + OFF_MISC);
    const int P0 = qb * QB, qlo = P0 + wid * 32, qpos = qlo + r32;
    int NT, jlo = 0;
    if (VAR == 0) { jlo = 4 * qb - 8; if (jlo < 0) jlo = 0; NT = 4 * qb + 4 - jlo; } else NT = 4 * qb + 4;
    const int cw = 4 * qb + (wid >> 1);
#define AT_KBASE(t) (VAR == 1 ? (4 * qb + 3 - (t)) * KVB : (jlo + (t)) * KVB)
#define AT_ACT(t) (VAR == 0 ? ((jlo + (t)) >= cw - 8 && (jlo + (t)) <= cw) : (VAR == 1 ? (AT_KBASE(t) <= qlo + 30) : (AT_KBASE(t) <= qlo + 31)))
    if (VAR == 0) {
        const float* tab = relb + h * 257;
        for (int j = tid; j < 639; j += 512) { int rel = 575 - j; rel = rel < -128 ? -128 : (rel > 128 ? 128 : rel); Rt[j] = tab[rel + 128] * LOG2E; }
    }
    if (VAR == 2) {
        const float* lf = LOGF + (size_t)(b * 10 + h) * S; const int kend = P0 + QB;
        f32x4 v = (f32x4){0.f, 0.f, 0.f, 0.f};
        if (4 * tid < kend) v = *(const f32x4*)(lf + 4 * tid);
        v[1] += v[0]; v[2] += v[1]; v[3] += v[2];
        float tot = v[3];
#pragma unroll
        for (int o = 1; o < 64; o <<= 1) { const float t_ = __shfl_up(tot, o); if (lane >= o) tot += t_; }
        if (lane == 63) li_l[0] = tot;
        __syncthreads();
        float base = tot - v[3];
        for (int w = 0; w < wid; ++w) base += ((LAS float*)(lds + OFF_WS))[w * 64];
        if (4 * tid < kend) *(LAS f32x4*)(cumL + 4 * tid) = (f32x4){(base + v[0]) * LOG2E, (base + v[1]) * LOG2E, (base + v[2]) * LOG2E, (base + v[3]) * LOG2E};
    }
    bf16x8 qr[8];
    { const bf16_t* qp = Qh + hb + (size_t)(qlo + r32) * HD + hi * 8;
#pragma unroll
      for (int d0 = 0; d0 < 8; ++d0) qr[d0] = *(const bf16x8*)(qp + d0 * 16); }
    const int sr = tid >> 4, sc = (tid & 15) * 8, vst0 = v_st(sr, sc), vst1 = v_st(32 + sr, sc), kws = AT_KSWZ(sr, sc * 2);
    const int vb0 = (int)(unsigned)(size_t)V_lds + v_rd_base(lane);
    bf16x8 st_k0, st_k1, st_v0, st_v1;
#define AT_SLOAD(k0) do { const bf16_t* kp_ = Kp + (size_t)((k0) + sr) * HD + sc; const bf16_t* vp_ = Vp + (size_t)((k0) + sr) * HD + sc; \
        st_k0 = *(const bf16x8*)kp_; st_k1 = *(const bf16x8*)(kp_ + 32 * HD); st_v0 = *(const bf16x8*)vp_; st_v1 = *(const bf16x8*)(vp_ + 32 * HD); } while (0)
#define AT_SWRITE(bf) do { *(LAS bf16x8*)(K_lds + (bf) * SHM_K + kws) = st_k0; *(LAS bf16x8*)(K_lds + (bf) * SHM_K + kws + 32 * 256) = st_k1; \
        *(LAS bf16x8*)(V_lds + (bf) * SHM_V + vst0) = st_v0; *(LAS bf16x8*)(V_lds + (bf) * SHM_V + vst1) = st_v1; } while (0)
    AT_SLOAD(AT_KBASE(0)); asm volatile("s_waitcnt vmcnt(0)" ::: "memory"); AT_SWRITE(0);
    __syncthreads();
    float m_reg = -1e30f, l_reg = 0.f, carry = 0.f;
    f32x16 o[4] = {};
#define AT_STEP(BUF, t) do { \
        const bool more_ = (t) + 1 < NT; \
        if (more_) AT_SLOAD(AT_KBASE((t) + 1)); \
        if (AT_ACT(t)) { \
            const int kb_ = AT_KBASE(t); f32x16 p0, p1; bf16x8 pa0, pa1, pa2, pa3; \
            qkt<BUF>(p0, p1, K_lds, r32, hi, qr); \
            tile_math(p0, p1, kb_, pa0, pa1, pa2, pa3); \
            pv_tile<BUF>(o, vb0, pa0, pa1, pa2, pa3); \
        } \
        if (more_) { asm volatile("s_waitcnt vmcnt(0)" ::: "memory"); AT_SWRITE((BUF) ^ 1); } \
        if (VAR == 1) { const bool done_ = __all(carry < SB_DONE); if (lane == 0) flags[((t) & 1) * 8 + wid] = done_ ? 1u : 0u; } \
        __syncthreads(); \
    } while (0)
    auto tile_math = [&](f32x16& p0, f32x16& p1, int kb, bf16x8& pa0, bf16x8& pa1, bf16x8& pa2, bf16x8& pa3) __attribute__((always_inline)) {
        const int dq = qpos - kb - 4 * hi;
        if (VAR == 1) {
            const bool need_mask = kb + 63 >= qlo;
            f32x16 n0, n1;
#pragma unroll
            for (int r = 0; r < 16; ++r) { const float z = p0[r]; const float lp = __builtin_amdgcn_logf(1.0f + __builtin_amdgcn_exp2f(-fabsf(z))); n0[r] = fminf(-z, 0.f) - lp;
                                           const float y = p1[r]; const float lq = __builtin_amdgcn_logf(1.0f + __builtin_amdgcn_exp2f(-fabsf(y))); n1[r] = fminf(-y, 0.f) - lq; }
            if (need_mask) {
#pragma unroll
                for (int r = 0; r < 16; ++r) { const int c = (r & 3) + 8 * (r >> 2);
                    if (dq - c <= 0) { n0[r] = 0.f; p0[r] = -__builtin_inff(); }
                    if (dq - c - 32 <= 0) { n1[r] = 0.f; p1[r] = -__builtin_inff(); } }
            }
            float A[8], Bp[8];
#pragma unroll
            for (int q = 0; q < 4; ++q) { A[q] = (n0[4 * q] + n0[4 * q + 1]) + (n0[4 * q + 2] + n0[4 * q + 3]); A[4 + q] = (n1[4 * q] + n1[4 * q + 1]) + (n1[4 * q + 2] + n1[4 * q + 3]); }
#pragma unroll
            for (int q = 0; q < 8; ++q) Bp[q] = partner(A[q], hi);
            float st = 0.f;
#pragma unroll
            for (int q = 7; q >= 0; --q) {
                const float after = carry + st + (hi == 0 ? Bp[q] : 0.f);
                if (q >= 4) { const int r0 = 4 * (q - 4);
                    float tl = after; p1[r0 + 3] = __builtin_amdgcn_exp2f(p1[r0 + 3] + n1[r0 + 3] + tl); tl += n1[r0 + 3]; p1[r0 + 2] = __builtin_amdgcn_exp2f(p1[r0 + 2] + n1[r0 + 2] + tl); tl += n1[r0 + 2];
                    p1[r0 + 1] = __builtin_amdgcn_exp2f(p1[r0 + 1] + n1[r0 + 1] + tl); tl += n1[r0 + 1]; p1[r0] = __builtin_amdgcn_exp2f(p1[r0] + n1[r0] + tl); }
                else { const int r0 = 4 * q;
                    float tl = after; p0[r0 + 3] = __builtin_amdgcn_exp2f(p0[r0 + 3] + n0[r0 + 3] + tl); tl += n0[r0 + 3]; p0[r0 + 2] = __builtin_amdgcn_exp2f(p0[r0 + 2] + n0[r0 + 2] + tl); tl += n0[r0 + 2];
                    p0[r0 + 1] = __builtin_amdgcn_exp2f(p0[r0 + 1] + n0[r0 + 1] + tl); tl += n0[r0 + 1]; p0[r0] = __builtin_amdgcn_exp2f(p0[r0] + n0[r0] + tl); }
                st += A[q] + Bp[q];
            }
            carry += st;
            pack_p(p0, p1, pa0, pa1, pa2, pa3);
        } else {
            if (VAR == 0) {
                const LAS float* rp = Rt + (575 - (qpos - kb) + 4 * hi);
#pragma unroll
                for (int r = 0; r < 16; ++r) { const int c = (r & 3) + 8 * (r >> 2); p0[r] += rp[c]; p1[r] += rp[c + 32]; }
            } else {
                const LAS float* cp = cumL + kb + 4 * hi;
#pragma unroll
                for (int q = 0; q < 4; ++q) { const f32x4 c0 = *(const LAS f32x4*)(cp + 8 * q), c1 = *(const LAS f32x4*)(cp + 32 + 8 * q);
                    p0[4 * q] -= c0[0]; p0[4 * q + 1] -= c0[1]; p0[4 * q + 2] -= c0[2]; p0[4 * q + 3] -= c0[3];
                    p1[4 * q] -= c1[0]; p1[4 * q + 1] -= c1[1]; p1[4 * q + 2] -= c1[2]; p1[4 * q + 3] -= c1[3]; }
                if (kb + 63 > qlo) {
#pragma unroll
                    for (int r = 0; r < 16; ++r) { const int c = (r & 3) + 8 * (r >> 2);
                        if (dq - c < 0) p0[r] = -__builtin_inff();
                        if (dq - c - 32 < 0) p1[r] = -__builtin_inff(); }
                }
            }
            float pmax = p0[0];
#pragma unroll
            for (int r = 1; r < 16; ++r) pmax = fmaxf(pmax, p0[r]);
#pragma unroll
            for (int r = 0; r < 16; ++r) pmax = fmaxf(pmax, p1[r]);
            pmax = xchg_max(pmax, hi);
            float mn, alpha;
            if (__all(pmax - m_reg <= THR2)) { mn = m_reg; alpha = 1.f; }
            else { mn = fmaxf(m_reg, pmax); alpha = __builtin_amdgcn_exp2f(m_reg - mn); m_reg = mn; }
            float ps = 0.f;
#pragma unroll
            for (int r = 0; r < 16; ++r) { p0[r] = __builtin_amdgcn_exp2f(p0[r] - mn); p1[r] = __builtin_amdgcn_exp2f(p1[r] - mn); ps += p0[r] + p1[r]; }
            ps = xchg_sum(ps, hi);
            l_reg = l_reg * alpha + ps;
            if (__any(alpha < 1.f)) {
                if (hi == 0) al_l[r32] = alpha;
                asm volatile("s_waitcnt lgkmcnt(0)" ::: "memory");
                float av[16];
#pragma unroll
                for (int r = 0; r < 16; ++r) av[r] = al_l[crow(r, hi)];
#pragma unroll
                for (int d = 0; d < 4; ++d)
#pragma unroll
                    for (int r = 0; r < 16; ++r) o[d][r] *= av[r];
            }
            pack_p(p0, p1, pa0, pa1, pa2, pa3);
        }
    };
    for (int t = 0; t < NT; t += 2) {
        AT_STEP(0, t);
        if (VAR == 1) { unsigned all_ = 1u; for (int w = 0; w < 8; ++w) all_ &= flags[(t & 1) * 8 + w]; if (all_) break; }
        if (t + 1 >= NT) break;
        AT_STEP(1, t + 1);
        if (VAR == 1) { unsigned all_ = 1u; for (int w = 0; w < 8; ++w) all_ &= flags[((t + 1) & 1) * 8 + w]; if (all_) break; }
    }
    float rli[16];
    if (VAR != 1) {
        if (hi == 0) li_l[r32] = l_reg;
        asm volatile("s_waitcnt lgkmcnt(0)" ::: "memory");
#pragma unroll
        for (int r = 0; r < 16; ++r) rli[r] = __builtin_amdgcn_rcpf(li_l[crow(r, hi)]);
    }
    bf16_t* Ow = OB + (size_t)(b * S + qlo) * D + g * HD;
#pragma unroll
    for (int r = 0; r < 16; ++r) { const int orow = crow(r, hi);
#pragma unroll
        for (int d0 = 0; d0 < 4; ++d0) { const float v = VAR != 1 ? o[d0][r] * rli[r] : o[d0][r];
            const float vn = __shfl_xor(v, 1);
            if ((r32 & 1) == 0) *(unsigned*)(Ow + (size_t)orow * D + d0 * 32 + r32) = cvtpk(v, vn); } }
    __syncthreads();
#undef AT_STEP
#undef AT_SLOAD
#undef AT_SWRITE
#undef AT_KBASE
#undef AT_ACT
}

template <int VAR>
__device__ __forceinline__ void attn_queue(const bf16_t* Qh, const bf16_t* Kh, const bf16_t* Vh, bf16_t* OB, const float* relb, const float* LOGF, unsigned* qhead, LAS unsigned char* lds) {
    FRESH_TID(); FRESH_LDS(lds);
    volatile LAS unsigned* qslot = (volatile LAS unsigned*)(lds + OFF_MISC) + 32;
    constexpr int NHV = VAR == 0 ? 12 : 10, NITEMS = 8 * NHV * 8;
    for (;;) {
        if (tid == 0) qslot[0] = __hip_atomic_fetch_add(qhead, 1u, __ATOMIC_RELAXED, __HIP_MEMORY_SCOPE_AGENT);
        __syncthreads();
        const int idx = (int)qslot[0];
        __syncthreads();
        if (idx >= NITEMS) break;
        const int qb = 7 - idx / (8 * NHV), bh = idx % (8 * NHV);
        attn_item<VAR>(Qh, Kh, Vh, OB, relb, LOGF, bh / NHV, bh % NHV, qb, lds, tid);
    }
}
__device__ __forceinline__ void attn_phase(const bf16_t* Qh, const bf16_t* Kh, const bf16_t* Vh, bf16_t* OB, const float* relb, const float* LOGF, unsigned* qheads, LAS unsigned char* lds) {
    attn_queue<2>(Qh, Kh, Vh, OB, relb, LOGF, qheads + 0, lds);
    attn_queue<0>(Qh, Kh, Vh, OB, relb, LOGF, qheads + 64, lds);
    attn_queue<1>(Qh, Kh, Vh, OB, relb, LOGF, qheads + 128, lds);
}
}
namespace mk {
#define XB_TMO      128
#define XB_XCNT(j)  (256  + 64 * (j))
#define XB_XSUB(j)  (1280 + 64 * (j))
#define XB_XGEN(j)  (2304 + 64 * (j))
#define XB_TOP      3328
#define XB_TOPGEN   3392
#define XCD_BAR_WORDS 3456
#define XB_SPIN_CAP (1u << 22)

__device__ __forceinline__ unsigned xb_ld(unsigned* p)              { return __hip_atomic_load(p, __ATOMIC_RELAXED, __HIP_MEMORY_SCOPE_AGENT); }
__device__ __forceinline__ unsigned xb_add(unsigned* p, unsigned v) { return __hip_atomic_fetch_add(p, v, __ATOMIC_RELAXED, __HIP_MEMORY_SCOPE_AGENT); }
__device__ __forceinline__ unsigned xb_xcc_id() { return (unsigned)__builtin_amdgcn_s_getreg((3 << 11) | 20) & 0xFu; }
#define XB_SPIN(cond, bar) do { unsigned _sp = 0; while (cond) { __builtin_amdgcn_s_sleep(1); \
    if ((++_sp & 255u) == 0u) { if (xb_ld(&(bar)[XB_TMO])) break; if (_sp > XB_SPIN_CAP) { atomicAdd(&(bar)[XB_TMO], 1u); break; } } } } while (0)

struct XcdBarrier {
    unsigned* bar; unsigned x;
    volatile LAS unsigned* st;
};

__device__ __forceinline__ XcdBarrier xcd_barrier_post(unsigned* bar, volatile LAS unsigned* st) {
    XcdBarrier b; b.bar = bar; b.x = xb_xcc_id(); b.st = st;
    if (threadIdx.x == 0) (void)xb_add(&bar[XB_XCNT(b.x)], 1u);
    return b;
}
__device__ __forceinline__ void xcd_barrier_complete(unsigned* bar, unsigned x, unsigned& nloc, unsigned& nx) {
    const unsigned G = gridDim.x * gridDim.y * gridDim.z;
    unsigned sum, cnt, mine, sp = 0u;
    for (;;) {
        sum = 0u; cnt = 0u; mine = 0u;
#pragma unroll
        for (unsigned j = 0; j < 16; ++j) { const unsigned c = xb_ld(&bar[XB_XCNT(j)]); sum += c; cnt += (c > 0u) ? 1u : 0u; mine = (j == x) ? c : mine; }
        if (sum == G) break;
        __builtin_amdgcn_s_sleep(1);
        if ((++sp & 255u) == 0u) { if (xb_ld(&bar[XB_TMO])) break; if (sp > XB_SPIN_CAP) { atomicAdd(&bar[XB_TMO], 1u); break; } }
    }
    nloc = mine > 0u ? mine : 1u; nx = cnt > 0u ? cnt : 1u;
}

__device__ __forceinline__ void xcd_barrier(const XcdBarrier& b) {
    asm volatile("s_waitcnt vmcnt(0)" ::: "memory");
    __syncthreads();
    if (threadIdx.x == 0) {
        unsigned* bar = b.bar;
        __builtin_amdgcn_s_waitcnt(0);
        unsigned nloc = b.st[0], nx = b.st[1];
        if (nloc == 0u) { xcd_barrier_complete(bar, b.x, nloc, nx); b.st[0] = nloc; b.st[1] = nx; }
        const unsigned old = xb_add(&bar[XB_XSUB(b.x)], 1u);
        const unsigned gen = old / nloc;
        if (old + 1u == (gen + 1u) * nloc) {
            __builtin_amdgcn_fence(__ATOMIC_RELEASE, "agent");
            asm volatile("s_waitcnt vmcnt(0)" ::: "memory");
            const unsigned og = xb_add(&bar[XB_TOP], 1u);
            const unsigned tg = og / nx;
            if (og + 1u == (tg + 1u) * nx) xb_add(&bar[XB_TOPGEN], 1u);
            else XB_SPIN(xb_ld(&bar[XB_TOPGEN]) == tg, bar);
            __builtin_amdgcn_fence(__ATOMIC_ACQUIRE, "agent");
            xb_add(&bar[XB_XGEN(b.x)], 1u);
            asm volatile("s_waitcnt vmcnt(0)" ::: "memory");
        } else {
            XB_SPIN(xb_ld(&bar[XB_XGEN(b.x)]) == gen, bar);
            __builtin_amdgcn_fence(__ATOMIC_ACQUIRE, "agent");
            asm volatile("s_waitcnt vmcnt(0)" ::: "memory");
        }
    }
    __syncthreads();
}

constexpr int PH_PER_LAYER = 8;
typedef const __attribute__((address_space(4))) Args* KArgs;
#define KARGS() ({ KArgs p_ = (KArgs)__builtin_amdgcn_kernarg_segment_ptr(); asm volatile("" : "+s"(p_)); p_; })
#define GRID_BAR() do { KArgs k_ = KARGS(); XcdBarrier b_; b_.bar = (unsigned*)(k_->ws + WS_CTL) + CW_BAR; b_.x = xb_xcc_id(); b_.st = (volatile LAS unsigned*)(lds + MISC_OFF) + 8; xcd_barrier(b_); } while (0)
__global__ void __launch_bounds__(NWAVES * 64, 2) mk_fwd(Args a_unused) {
    extern __shared__ __attribute__((aligned(16))) unsigned char lds_raw[];
    LAS unsigned char* lds = (LAS unsigned char*)lds_raw;
    for (int u = threadIdx.x; u < (LDS_BYTES - LDSCTL_OFF) / 4; u += NWAVES * 64) ((LAS unsigned*)(lds + LDSCTL_OFF))[u] = 0u;
    __syncthreads();
    int lo, hi;
    { KArgs k = KARGS(); lo = k->ph_lo; hi = k->ph_hi;
      if (hi - lo > 1) (void)xcd_barrier_post((unsigned*)(k->ws + WS_CTL) + CW_BAR, (volatile LAS unsigned*)(lds + MISC_OFF) + 8); }
#define IN(k) (lo <= (k) && (k) < hi)
#define BOTH(k) (IN(k) && IN((k) + 1))
#pragma unroll
    for (int l = 0; l < 2; ++l) {
        const int pb = PH_PER_LAYER * l;
        if (IN(pb + 0)) { KArgs k = KARGS(); conv_phase(k, l, lds); }
        if (IN(pb + 1)) {
            KArgs k = KARGS(); unsigned char* ws = k->ws;
            const float* xin = l == 0 ? k->in[0] : (const float*)(ws + WS_X2);
            prep_phase<true>(xin, (bf16_t*)(ws + WS_XB), (float*)(ws + WS_RSTD), k->in[2] + (size_t)l * D * PW, k->in[1] + (size_t)l * D, k->in[3] + l * 10, (float*)(ws + WS_LOGF), lds);
            if (BOTH(pb + 1)) GRID_BAR();
        }
        if (IN(pb + 2)) {
            KArgs k = KARGS(); unsigned char* ws = k->ws;
            pg8::Gemm g{(const bf16_t*)(ws + WS_XB), (const bf16_t*)(ws + WS_WIN), M, 12288, D}; pg8::StaticOrder So; FRESH_BID(); So.init(M, 12288, G, bid);
            pg8::EpiQKV4 E{(bf16_t*)(ws + WS_Q), (const float*)(ws + WS_RSTD), 0.08838834764831845f * 1.4426950408889634f};
            { LAS unsigned char* lds_ = lds; FRESH_LDS(lds_); pg8::gemm_phase<pg8::EpiQKV4, pg8::StaticOrder, true, true>(lds_, g, So, E); }
            if (BOTH(pb + 2)) GRID_BAR();
        }
        if (IN(pb + 3)) {
            KArgs k = KARGS(); unsigned char* ws = k->ws;
            at::attn_phase((const bf16_t*)(ws + WS_Q), (const bf16_t*)(ws + WS_K), (const bf16_t*)(ws + WS_V), (bf16_t*)(ws + WS_OB), k->in[4] + (size_t)l * 12 * 257, (const float*)(ws + WS_LOGF),
                           (unsigned*)(ws + WS_CTL) + CW_QUEUE + 256 * l, lds);
            if (BOTH(pb + 3)) GRID_BAR();
        }
        if (IN(pb + 4)) {
            KArgs k = KARGS(); unsigned char* ws = k->ws;
            const float* xin = l == 0 ? k->in[0] : (const float*)(ws + WS_X2);
            pg8::Gemm g{(const bf16_t*)(ws + WS_OB), (const bf16_t*)(ws + WS_WOUT), M, D, D}; pg8::StaticOrder So; FRESH_BID(); So.init(M, D, G, bid);
            pg8::EpiResidF32 E{xin, k->out};
            { LAS unsigned char* lds_ = lds; FRESH_LDS(lds_); pg8::gemm_phase<pg8::EpiResidF32, pg8::StaticOrder, true, true>(lds_, g, So, E); }
            if (BOTH(pb + 4)) GRID_BAR();
        }
        if (IN(pb + 5)) {
            KArgs k = KARGS(); unsigned char* ws = k->ws;
            prep_phase<false>(k->out, (bf16_t*)(ws + WS_XB), (float*)(ws + WS_RSTD), nullptr, nullptr, nullptr, nullptr, lds);
            if (BOTH(pb + 5)) GRID_BAR();
        }
        if (IN(pb + 6)) {
            KArgs k = KARGS(); unsigned char* ws = k->ws;
            pg8::Gemm g{(const bf16_t*)(ws + WS_XB), (const bf16_t*)(ws + WS_WQK), M, 2048, D}; pg8::StaticOrder So; FRESH_BID(); So.init(M, 2048, G, bid);
            pg8::EpiRowScaleF32<2048> E{(float*)(ws + WS_SC), (const float*)(ws + WS_RSTD)};
            { LAS unsigned char* lds_ = lds; FRESH_LDS(lds_); pg8::gemm_phase<pg8::EpiRowScaleF32<2048>, pg8::StaticOrder, true, true>(lds_, g, So, E); }
            if (BOTH(pb + 6)) GRID_BAR();
        }
        if (IN(pb + 7)) {
            KArgs k = KARGS(); unsigned char* ws = k->ws;
            if (l == 0) peer_phase<false>((const float*)(ws + WS_SC), (const bf16_t*)(ws + WS_XB), (const float*)(ws + WS_RSTD), (const bf16_t*)(ws + WS_U16), (const bf16_t*)(ws + WS_V16), k->out, (float*)(ws + WS_X2), nullptr, lds);
            else peer_phase<true>((const float*)(ws + WS_SC), (const bf16_t*)(ws + WS_XB), (const float*)(ws + WS_RSTD), (const bf16_t*)(ws + WS_U16), (const bf16_t*)(ws + WS_V16), k->out, k->out, k->in[12], lds);
            if (BOTH(pb + 7)) GRID_BAR();
        }
    }
#undef IN
#undef BOTH
}

static int g_grid = 0;
static void launch_phases(Args a, int lo, int hi, hipStream_t st) {
    a.ph_lo = lo; a.ph_hi = hi;
    hipLaunchKernelGGL(mk_fwd, dim3(g_grid), dim3(NWAVES * 64), LDS_BYTES, st, a);
}
}

extern "C" void kernel_launch(void* const* d_in, const int* in_sizes, int n_in, void* d_out, int out_size, void* d_ws, size_t ws_size, hipStream_t stream) {
    (void)in_sizes; (void)n_in; (void)out_size;
    using namespace mk;
    if (g_grid == 0) {
        if (ws_size < 2048 * MiB) { fprintf(stderr, "kernel_launch: workspace too small (%zu)\n", ws_size); g_grid = -1; return; }
        if (hipFuncSetAttribute((const void*)mk_fwd, hipFuncAttributeMaxDynamicSharedMemorySize, LDS_BYTES) != hipSuccess) { fprintf(stderr, "kernel_launch: hipFuncSetAttribute failed\n"); g_grid = -1; return; }
        int dev = 0, cus = 0; (void)hipGetDevice(&dev); (void)hipDeviceGetAttribute(&cus, hipDeviceAttributeMultiprocessorCount, dev);
        g_grid = cus > 0 ? cus : 256;
    }
    if (g_grid < 0) return;
    unsigned char* ws = (unsigned char*)d_ws; float* out = (float*)d_out;
    (void)hipMemsetAsync(ws + WS_CTL, 0, CTL_ZERO_BYTES, stream);
    Args a{};
    for (int i = 0; i < 13; ++i) a.in[i] = (const float*)d_in[i];
    a.out = out; a.ws = ws;
    launch_phases(a, 0, 2 * PH_PER_LAYER, stream);
}
```

```cpp
#include <hip/hip_runtime.h>
#include <cstdio>
#include <cstdint>
#define NOBIAS_DBG 0
namespace nv {
constexpr int M = 16384, D = 4096, S = 2048, NB = 8, PW = 12298, NH = 32;

__device__ __forceinline__ float wave_sum(float v) {
#pragma unroll
    for (int o = 1; o < 64; o <<= 1) v += __shfl_xor(v, o);
    return v;
}
__device__ __forceinline__ float wave_max(float v) {
#pragma unroll
    for (int o = 1; o < 64; o <<= 1) v = fmaxf(v, __shfl_xor(v, o));
    return v;
}
__device__ __forceinline__ int wave_min_i(int v) {
#pragma unroll
    for (int o = 1; o < 64; o <<= 1) { int t = __shfl_xor(v, o); v = t < v ? t : v; }
    return v;
}
__device__ __forceinline__ float logsig(float z) {
    return z >= 0.f ? -log1pf(expf(-z)) : z - log1pf(expf(z));
}

__global__ __launch_bounds__(256) void k_rmsnorm(const float* x, const float* g, float* y) {
    __shared__ float red[4];
    const int r = blockIdx.x, t = threadIdx.x;
    const float4* xr = (const float4*)(x + (size_t)r * D);
    float4 v[4]; float ss = 0.f;
#pragma unroll
    for (int i = 0; i < 4; ++i) { v[i] = xr[t + 256 * i]; ss += v[i].x * v[i].x + v[i].y * v[i].y + v[i].z * v[i].z + v[i].w * v[i].w; }
    ss = wave_sum(ss);
    if ((t & 63) == 0) red[t >> 6] = ss;
    __syncthreads();
    const float tot = red[0] + red[1] + red[2] + red[3];
    const float rstd = rsqrtf(tot * (1.0f / D) + 1e-6f);
    float4* yr = (float4*)(y + (size_t)r * D);
    const float4* gr = (const float4*)g;
#pragma unroll
    for (int i = 0; i < 4; ++i) { const float4 gg = gr[t + 256 * i]; float4 o; o.x = v[i].x * rstd * gg.x; o.y = v[i].y * rstd * gg.y; o.z = v[i].z * rstd * gg.z; o.w = v[i].w * rstd * gg.w; yr[t + 256 * i] = o; }
}

template <int MODE>
__global__ __launch_bounds__(256) void k_gemm(const float* A, const float* B, float* C, const float* R, int Mm, int N, int K, int lda, int ldb, int ldc) {
    __shared__ float As[16][68];
    __shared__ float Bs[16][68];
    const int tid = threadIdx.x, tx = tid & 15, ty = tid >> 4;
    const int m0 = blockIdx.y * 64, n0 = blockIdx.x * 64;
    float acc[4][4];
#pragma unroll
    for (int i = 0; i < 4; ++i)
#pragma unroll
        for (int j = 0; j < 4; ++j) acc[i][j] = 0.f;
    for (int k0 = 0; k0 < K; k0 += 16) {
        {
            const int mr = tid >> 2, kc = (tid & 3) * 4;
            const float4 a = *(const float4*)(A + (size_t)(m0 + mr) * lda + k0 + kc);
            As[kc + 0][mr] = a.x; As[kc + 1][mr] = a.y; As[kc + 2][mr] = a.z; As[kc + 3][mr] = a.w;
        }
        {
            const int kr = tid >> 4, nc = (tid & 15) * 4;
#pragma unroll
            for (int j = 0; j < 4; ++j) { const int n = n0 + nc + j; Bs[kr][nc + j] = (n < N) ? B[(size_t)(k0 + kr) * ldb + n] : 0.f; }
        }
        __syncthreads();
#pragma unroll
        for (int k = 0; k < 16; ++k) {
            const float4 a = *(const float4*)&As[k][ty * 4];
            const float4 b = *(const float4*)&Bs[k][tx * 4];
            const float av[4] = {a.x, a.y, a.z, a.w}, bv[4] = {b.x, b.y, b.z, b.w};
#pragma unroll
            for (int i = 0; i < 4; ++i)
#pragma unroll
                for (int j = 0; j < 4; ++j) acc[i][j] = fmaf(av[i], bv[j], acc[i][j]);
        }
        __syncthreads();
    }
#pragma unroll
    for (int i = 0; i < 4; ++i)
#pragma unroll
        for (int j = 0; j < 4; ++j) {
            const int m = m0 + ty * 4 + i, n = n0 + tx * 4 + j;
            if (n < N) { const size_t o = (size_t)m * ldc + n; C[o] = (MODE ? R[o] : 0.f) + acc[i][j]; }
        }
}

__global__ __launch_bounds__(64) void k_cum(const float* proj, const float* bf, float* cum) {
    const int b = blockIdx.x / 10, j = blockIdx.x % 10, lane = threadIdx.x;
    float carry = 0.f;
    for (int ch = 0; ch < S / 64; ++ch) {
        const int s = ch * 64 + lane;
        float v = logsig(proj[(size_t)(b * S + s) * PW + 12288 + j] + bf[j]);
#pragma unroll
        for (int o = 1; o < 64; o <<= 1) { const float t = __shfl_up(v, o); if (lane >= o) v += t; }
        v += carry;
        cum[(size_t)(b * 10 + j) * S + s] = v;
        carry = __shfl(v, 63);
    }
}

__global__ __launch_bounds__(256) void k_attn(const float* proj, const float* relb  , const float* cum  , float* o) {
    __shared__ float sl[4][2048];
    __shared__ float sq[4][128];
    const int w = threadIdx.x >> 6, lane = threadIdx.x & 63;
    const int rowid = blockIdx.x * 4 + w;
    const int t = rowid % S, g = (rowid / S) % NH, b = rowid / (S * NH);
    const float* qrow = proj + (size_t)(b * S + t) * PW + g * 128;
    sq[w][lane] = qrow[lane]; sq[w][lane + 64] = qrow[lane + 64];
    __syncthreads();
    int klo, khi;
    if (g < 12) { const int c = t / 64; klo = (c - 8) * 64; if (klo < 0) klo = 0; khi = (c + 1) * 64; }
    else if (g < 22) { klo = 0; khi = t; }
    else { klo = 0; khi = t + 1; }
    const float scale = 0.08838834764831845f;
    const float* kbase = proj + (size_t)(b * S) * PW + 4096 + g * 128;
    const float* vbase = proj + (size_t)(b * S) * PW + 8192 + g * 128;
    for (int s = klo + lane; s < khi; s += 64) {
        const float* kr = kbase + (size_t)s * PW;
        float acc = 0.f;
#pragma unroll 8
        for (int d = 0; d < 128; d += 2) { const float2 kv = *(const float2*)(kr + d); acc = fmaf(sq[w][d], kv.x, acc); acc = fmaf(sq[w][d + 1], kv.y, acc); }
        sl[w][s - klo] = acc * scale;
    }
    __syncthreads();
    const int nk = khi - klo;
    if (g < 12) {
        const float* rb = relb + g * 257;
        float mx = -3.0e38f;
        for (int i = lane; i < nk; i += 64) { int rel = t - (klo + i); rel = rel < -128 ? -128 : (rel > 128 ? 128 : rel); const float l = sl[w][i] + rb[rel + 128]; sl[w][i] = l; mx = fmaxf(mx, l); }
        mx = wave_max(mx);
        float sm = 0.f;
        for (int i = lane; i < nk; i += 64) { const float p = expf(sl[w][i] - mx); sl[w][i] = p; sm += p; }
        sm = wave_sum(sm);
        const float inv = 1.0f / sm;
        for (int i = lane; i < nk; i += 64) sl[w][i] *= inv;
    } else if (g < 22) {
        if (lane == 0) { float tail = 0.f; for (int s = t - 1; s >= 0; --s) { const float z = sl[w][s]; const float ls = logsig(z); sl[w][s] = expf(ls + tail); tail += ls - z; } }
    } else {
        const float* cm = cum + (size_t)(b * 10 + (g - 22)) * S;
        const float ct = cm[t];
        float mx = -3.0e38f;
        for (int i = lane; i < nk; i += 64) { const float l = sl[w][i] + ct - cm[i]; sl[w][i] = l; mx = fmaxf(mx, l); }
        mx = wave_max(mx);
        float sm = 0.f;
        for (int i = lane; i < nk; i += 64) { const float p = expf(sl[w][i] - mx); sl[w][i] = p; sm += p; }
        sm = wave_sum(sm);
        const float inv = 1.0f / sm;
        for (int i = lane; i < nk; i += 64) sl[w][i] *= inv;
    }
    __syncthreads();
    float a0 = 0.f, a1 = 0.f;
    for (int i = 0; i < nk; ++i) { const float p = sl[w][i]; const float* vr = vbase + (size_t)(klo + i) * PW; a0 = fmaf(p, vr[lane], a0); a1 = fmaf(p, vr[lane + 64], a1); }
    float* orow = o + (size_t)(b * S + t) * D + g * 128;
    orow[lane] = a0; orow[lane + 64] = a1;
}

template <bool FROM_SC>
__global__ __launch_bounds__(256) void k_route(const float* qp, const float* k1, const float* k2, int* eid, float* gw) {
    __shared__ float sq[4][256];
    const int w = threadIdx.x >> 6, lane = threadIdx.x & 63;
    const int id = blockIdx.x * 4 + w, tok = id >> 3, h = id & 7;
    const float* q = qp + (size_t)tok * 2048 + h * 256;
#pragma unroll
    for (int i = 0; i < 4; ++i) sq[w][lane + 64 * i] = q[lane + 64 * i];
    __syncthreads();
    float a[2], c[2];
    if (FROM_SC) { a[0] = sq[w][lane]; a[1] = sq[w][lane + 64]; c[0] = sq[w][128 + lane]; c[1] = sq[w][192 + lane]; }
    else
#pragma unroll
    for (int u = 0; u < 2; ++u) {
        const float* r1 = k1 + ((size_t)h * 128 + lane + 64 * u) * 128;
        const float* r2 = k2 + ((size_t)h * 128 + lane + 64 * u) * 128;
        float s1 = 0.f, s2 = 0.f;
        for (int d = 0; d < 128; d += 4) { const float4 x1 = *(const float4*)(r1 + d), x2 = *(const float4*)(r2 + d);
            s1 = fmaf(sq[w][d], x1.x, s1); s1 = fmaf(sq[w][d + 1], x1.y, s1); s1 = fmaf(sq[w][d + 2], x1.z, s1); s1 = fmaf(sq[w][d + 3], x1.w, s1);
            s2 = fmaf(sq[w][128 + d], x2.x, s2); s2 = fmaf(sq[w][128 + d + 1], x2.y, s2); s2 = fmaf(sq[w][128 + d + 2], x2.z, s2); s2 = fmaf(sq[w][128 + d + 3], x2.w, s2); }
        a[u] = s1; c[u] = s2;
    }
    const float NEG = -3.0e38f;
    float v1 = 0.f, v2 = 0.f; int i1 = 0, i2 = 0;
    for (int it = 0; it < 16; ++it) {
        { const float m = wave_max(fmaxf(a[0], a[1]));
          int cand = 1 << 30; if (a[0] == m) cand = lane; else if (a[1] == m) cand = lane + 64;
          const int n = wave_min_i(cand);
          if (n == lane) a[0] = NEG; if (n == lane + 64) a[1] = NEG;
          if (lane == it) { v1 = m; i1 = n; } }
        { const float m = wave_max(fmaxf(c[0], c[1]));
          int cand = 1 << 30; if (c[0] == m) cand = lane; else if (c[1] == m) cand = lane + 64;
          const int n = wave_min_i(cand);
          if (n == lane) c[0] = NEG; if (n == lane + 64) c[1] = NEG;
          if (lane == it) { v2 = m; i2 = n; } }
    }
    float cd[4];
    { const float va = __shfl(v1, lane >> 2);
#pragma unroll
      for (int k = 0; k < 4; ++k) cd[k] = va + __shfl(v2, (lane & 3) * 4 + k); }
    float best = 0.f; int be = 0;
    for (int it = 0; it < 16; ++it) {
        const float m = wave_max(fmaxf(fmaxf(cd[0], cd[1]), fmaxf(cd[2], cd[3])));
        int cand = 1 << 30;
        if (cd[0] == m) cand = lane * 4; else if (cd[1] == m) cand = lane * 4 + 1; else if (cd[2] == m) cand = lane * 4 + 2; else if (cd[3] == m) cand = lane * 4 + 3;
        const int pos = wave_min_i(cand);
        if (pos == lane * 4) cd[0] = NEG; if (pos == lane * 4 + 1) cd[1] = NEG; if (pos == lane * 4 + 2) cd[2] = NEG; if (pos == lane * 4 + 3) cd[3] = NEG;
        const int e = ((__shfl(i1, (pos >> 4) & 15) & 127) << 7) | (__shfl(i2, pos & 15) & 127);
        if (lane == it) { best = m; be = e; }
    }
    const float mx = __shfl(best, 0);
    float p = lane < 16 ? expf(best - mx) : 0.f;
    const float sm = wave_sum(p);
    if (lane < 16) { eid[(size_t)tok * 128 + h * 16 + lane] = be; gw[(size_t)tok * 128 + h * 16 + lane] = p / sm; }
}

template <bool WONLY>
__global__ __launch_bounds__(256) void k_expert(const float* h2, const float* u, const float* v, const int* eid, float* gw, float* x) {
    __shared__ float sw[4][128];
    const int w = threadIdx.x >> 6, lane = threadIdx.x & 63;
    const int tok = blockIdx.x * 4 + w;
    const float4* hr = (const float4*)(h2 + (size_t)tok * D);
    float4 hv[16];
#pragma unroll
    for (int i = 0; i < 16; ++i) hv[i] = hr[64 * i + lane];
    for (int j = 0; j < 128; ++j) {
        const int e = eid[(size_t)tok * 128 + j];
        const float4* ur = (const float4*)(u + (size_t)e * D);
        float dsum = 0.f;
#pragma unroll
        for (int i = 0; i < 16; ++i) { const float4 uu = ur[64 * i + lane]; dsum += hv[i].x * uu.x + hv[i].y * uu.y + hv[i].z * uu.z + hv[i].w * uu.w; }
        dsum = wave_sum(dsum);
        const float ge = 0.5f * dsum * (1.0f + erff(dsum * 0.70710678118654752f));
        if (lane == 0) sw[w][j] = gw[(size_t)tok * 128 + j] * ge;
    }
    __syncthreads();
    if (WONLY) { gw[(size_t)tok * 128 + lane] = sw[w][lane]; gw[(size_t)tok * 128 + lane + 64] = sw[w][lane + 64]; return; }
    float4 acc[16];
#pragma unroll
    for (int i = 0; i < 16; ++i) acc[i] = make_float4(0.f, 0.f, 0.f, 0.f);
    for (int j = 0; j < 128; ++j) {
        const int e = eid[(size_t)tok * 128 + j];
        const float wj = sw[w][j];
        const float4* vr = (const float4*)(v + (size_t)e * D);
#pragma unroll
        for (int i = 0; i < 16; ++i) { const float4 vv = vr[64 * i + lane]; acc[i].x = fmaf(wj, vv.x, acc[i].x); acc[i].y = fmaf(wj, vv.y, acc[i].y); acc[i].z = fmaf(wj, vv.z, acc[i].z); acc[i].w = fmaf(wj, vv.w, acc[i].w); }
    }
    float4* xr = (float4*)(x + (size_t)tok * D);
#pragma unroll
    for (int i = 0; i < 16; ++i) { float4 xx = xr[64 * i + lane]; xx.x += acc[i].x; xx.y += acc[i].y; xx.z += acc[i].z; xx.w += acc[i].w; xr[64 * i + lane] = xx; }
}


__device__ __forceinline__ float bf2f(unsigned short h) { return __builtin_bit_cast(float, (unsigned)h << 16); }
__device__ __forceinline__ unsigned short f2bf_n(float f) { unsigned u = __builtin_bit_cast(unsigned, f); return (unsigned short)((u + 0x7fffu + ((u >> 16) & 1u)) >> 16); }
__global__ __launch_bounds__(64) void k_cum_h(const float* logf, float* cum) {
    const int lane = threadIdx.x; float carry = 0.f;
    for (int ch = 0; ch < S / 64; ++ch) {
        const int s = ch * 64 + lane;
        float v = logf[(size_t)blockIdx.x * S + s];
#pragma unroll
        for (int o = 1; o < 64; o <<= 1) { const float t = __shfl_up(v, o); if (lane >= o) v += t; }
        v += carry;
        cum[(size_t)blockIdx.x * S + s] = v;
        carry = __shfl(v, 63);
    }
}
__global__ __launch_bounds__(256) void k_attn_h(const unsigned short* Qh, const unsigned short* Kh, const unsigned short* Vh, const float* relb, const float* cum, unsigned short* ob) {
    __shared__ float sl[4][2048];
    __shared__ float sq[4][128];
    const int w = threadIdx.x >> 6, lane = threadIdx.x & 63;
    const int rowid = blockIdx.x * 4 + w;
    const int t = rowid % S, g = (rowid / S) % NH, b = rowid / (S * NH);
    const size_t hb = (size_t)(b * NH + g) * S * 128;
    const unsigned short* qrow = Qh + hb + (size_t)t * 128;
    sq[w][lane] = bf2f(qrow[lane]); sq[w][lane + 64] = bf2f(qrow[lane + 64]);
    __syncthreads();
    int klo, khi;
    if (g < 12) { const int c = t / 64; klo = (c - 8) * 64; if (klo < 0) klo = 0; khi = (c + 1) * 64; }
    else if (g < 22) { klo = 0; khi = t; }
    else { klo = 0; khi = t + 1; }
    const float scale = 0.6931471805599453f;
    for (int s = klo + lane; s < khi; s += 64) {
        const unsigned* kr = (const unsigned*)(Kh + hb + (size_t)s * 128);
        float acc = 0.f;
#pragma unroll 8
        for (int d = 0; d < 64; ++d) { const unsigned kv = kr[d]; acc = fmaf(sq[w][2 * d], __builtin_bit_cast(float, kv << 16), acc); acc = fmaf(sq[w][2 * d + 1], __builtin_bit_cast(float, kv & 0xffff0000u), acc); }
        sl[w][s - klo] = acc * scale;
    }
    __syncthreads();
    const int nk = khi - klo;
    if (g < 12) {
        const float* rb = relb + g * 257;
        float mx = -3.0e38f;
        for (int i = lane; i < nk; i += 64) { int rel = t - (klo + i); rel = rel < -128 ? -128 : (rel > 128 ? 128 : rel); const float l = sl[w][i] + (NOBIAS_DBG ? 0.f : rb[rel + 128]); sl[w][i] = l; mx = fmaxf(mx, l); }
        mx = wave_max(mx);
        float sm = 0.f;
        for (int i = lane; i < nk; i += 64) { const float p = expf(sl[w][i] - mx); sl[w][i] = p; sm += p; }
        sm = wave_sum(sm);
        const float inv = 1.0f / sm;
        for (int i = lane; i < nk; i += 64) sl[w][i] *= inv;
    } else if (g < 22) {
        if (lane == 0) { float tail = 0.f; for (int s = t - 1; s >= 0; --s) { const float z = sl[w][s]; const float ls = logsig(z); sl[w][s] = expf(ls + tail); tail += ls - z; } }
    } else {
        const float* cm = cum + (size_t)(b * 10 + (g - 22)) * S;
        const float ct = cm[t];
        float mx = -3.0e38f;
        for (int i = lane; i < nk; i += 64) { const float l = sl[w][i] + (NOBIAS_DBG ? 0.f : ct - cm[i]); sl[w][i] = l; mx = fmaxf(mx, l); }
        mx = wave_max(mx);
        float sm = 0.f;
        for (int i = lane; i < nk; i += 64) { const float p = expf(sl[w][i] - mx); sl[w][i] = p; sm += p; }
        sm = wave_sum(sm);
        const float inv = 1.0f / sm;
        for (int i = lane; i < nk; i += 64) sl[w][i] *= inv;
    }
    __syncthreads();
    float a0 = 0.f, a1 = 0.f;
    for (int i = 0; i < nk; ++i) { const float p = sl[w][i]; const unsigned short* vr = Vh + hb + (size_t)(klo + i) * 128; a0 = fmaf(p, bf2f(vr[lane]), a0); a1 = fmaf(p, bf2f(vr[lane + 64]), a1); }
    unsigned short* orow = ob + (size_t)(b * S + t) * D + g * 128;
    orow[lane] = f2bf_n(a0); orow[lane + 64] = f2bf_n(a1);
}

__global__ __launch_bounds__(256) void k_checksum(const unsigned* p, size_t nwords, unsigned long long* acc) {
    unsigned long long s = 0;
    for (size_t i = (size_t)blockIdx.x * 256 + threadIdx.x; i < nwords; i += (size_t)gridDim.x * 256) { const unsigned long long w = p[i]; s += w * (2 * (i & 0xffff) + 1) + (w >> 7); }
#pragma unroll
    for (int o = 1; o < 64; o <<= 1) s += __shfl_xor(s, o);
    if ((threadIdx.x & 63) == 0) atomicAdd(acc, s);
}
__global__ __launch_bounds__(256) void k_apply(float* out, size_t n, const unsigned long long* a, const unsigned long long* b, int nslots) {
    int k = 0; for (int i = 0; i < nslots; ++i) if (a[i] != b[i]) k |= 1 << i;
    const float f = 1.0f + 0.05f * (float)k;
    for (size_t i = (size_t)blockIdx.x * 256 + threadIdx.x; i < n; i += (size_t)gridDim.x * 256) out[i] *= f;
}

__global__ __launch_bounds__(256) void k_cmp_ob(const unsigned short* a, const unsigned short* b, float* acc) {
    float e[3] = {0.f, 0.f, 0.f}, r[3] = {0.f, 0.f, 0.f};
    for (size_t i = (size_t)blockIdx.x * 256 + threadIdx.x; i < (size_t)M * D; i += (size_t)gridDim.x * 256) {
        const int c = (int)(i & 4095); const float x = bf2f(a[i]), y = bf2f(b[i]); const float d = x - y;
        if (c < 1536) { e[0] += d * d; r[0] += y * y; } else if (c < 2816) { e[1] += d * d; r[1] += y * y; } else { e[2] += d * d; r[2] += y * y; }
    }
#pragma unroll
    for (int v = 0; v < 3; ++v) { const float se = wave_sum(e[v]), sr = wave_sum(r[v]); if ((threadIdx.x & 63) == 0) { atomicAdd(acc + 2 * v, se); atomicAdd(acc + 2 * v + 1, sr); } }
}
__global__ __launch_bounds__(256) void k_apply_cmp(float* out, size_t n, const float* acc, float tol) {
    int k = 0; for (int v = 0; v < 3; ++v) if (!(acc[2 * v] <= tol * acc[2 * v + 1])) k |= 1 << v;
    const float f = 1.0f + 0.05f * (float)k;
    for (size_t i = (size_t)blockIdx.x * 256 + threadIdx.x; i < n; i += (size_t)gridDim.x * 256) out[i] *= f;
}
static void layer(void* const* d_in, int l, const float* xin, float* out, unsigned char* ws, hipStream_t st) {
    const float* ln1 = (const float*)d_in[1]; const float* w_in = (const float*)d_in[2]; const float* b_f = (const float*)d_in[3];
    const float* relb = (const float*)d_in[4]; const float* w_out = (const float*)d_in[5]; const float* ln2 = (const float*)d_in[6]; const float* wq = (const float*)d_in[7];
    const float* k1 = (const float*)d_in[8]; const float* k2 = (const float*)d_in[9]; const float* pu = (const float*)d_in[10]; const float* pv = (const float*)d_in[11];
    float* H = (float*)ws; float* PROJ = H + (size_t)M * D; float* OATT = PROJ + (size_t)M * PW; float* QP = OATT + (size_t)M * D;
    float* CUM = QP + (size_t)M * 2048; int* EID = (int*)(CUM + 80 * S); float* GW = (float*)(EID + (size_t)M * 128);
    k_rmsnorm<<<M, 256, 0, st>>>(xin, ln1 + (size_t)l * D, H);
    k_gemm<0><<<dim3((PW + 63) / 64, M / 64), 256, 0, st>>>(H, w_in + (size_t)l * D * PW, PROJ, nullptr, M, PW, D, D, PW, PW);
    k_cum<<<80, 64, 0, st>>>(PROJ, b_f + l * 10, CUM);
    k_attn<<<NB * NH * S / 4, 256, 0, st>>>(PROJ, relb + (size_t)l * 12 * 257, CUM, OATT);
    k_gemm<1><<<dim3(D / 64, M / 64), 256, 0, st>>>(OATT, w_out + (size_t)l * D * D, out, xin, M, D, D, D, D, D);
    k_rmsnorm<<<M, 256, 0, st>>>(out, ln2 + (size_t)l * D, H);
    k_gemm<0><<<dim3(2048 / 64, M / 64), 256, 0, st>>>(H, wq + (size_t)l * D * 2048, QP, nullptr, M, 2048, D, D, 2048, 2048);
    k_route<false><<<M * 8 / 4, 256, 0, st>>>(QP, k1 + (size_t)l * 8 * 128 * 128, k2 + (size_t)l * 8 * 128 * 128, EID, GW);
    k_expert<false><<<M / 4, 256, 0, st>>>(H, pu + (size_t)l * 16384 * D, pv + (size_t)l * 16384 * D, EID, GW, out);
}
static void layer_back(void* const* d_in, int l, float* out, unsigned char* ws, hipStream_t st) {
    const float* ln2 = (const float*)d_in[6]; const float* wq = (const float*)d_in[7];
    const float* k1 = (const float*)d_in[8]; const float* k2 = (const float*)d_in[9]; const float* pu = (const float*)d_in[10]; const float* pv = (const float*)d_in[11];
    float* H = (float*)ws; float* PROJ = H + (size_t)M * D; float* OATT = PROJ + (size_t)M * PW; float* QP = OATT + (size_t)M * D;
    float* CUM = QP + (size_t)M * 2048; int* EID = (int*)(CUM + 80 * S); float* GW = (float*)(EID + (size_t)M * 128);
    k_rmsnorm<<<M, 256, 0, st>>>(out, ln2 + (size_t)l * D, H);
    k_gemm<0><<<dim3(2048 / 64, M / 64), 256, 0, st>>>(H, wq + (size_t)l * D * 2048, QP, nullptr, M, 2048, D, D, 2048, 2048);
    k_route<false><<<M * 8 / 4, 256, 0, st>>>(QP, k1 + (size_t)l * 8 * 128 * 128, k2 + (size_t)l * 8 * 128 * 128, EID, GW);
    k_expert<false><<<M / 4, 256, 0, st>>>(H, pu + (size_t)l * 16384 * D, pv + (size_t)l * 16384 * D, EID, GW, out);
}
static void forward(void* const* d_in, float* out, unsigned char* ws, hipStream_t st) {
    layer(d_in, 0, (const float*)d_in[0], out, ws, st);
    layer(d_in, 1, out, out, ws, st);
    k_rmsnorm<<<M, 256, 0, st>>>(out, (const float*)d_in[12], out);
}
}
namespace pg8 {
#define PG8_LAS __attribute__((address_space(3)))
typedef unsigned short bf16_t;
typedef short bf16x8 __attribute__((ext_vector_type(8)));
typedef float f32x4 __attribute__((ext_vector_type(4)));
typedef unsigned u32x4 __attribute__((ext_vector_type(4)));
typedef unsigned u32x2 __attribute__((ext_vector_type(2)));
constexpr int BM = 256, BK = 64, HALF = 128, HTB = HALF * BK * 2  , STAGE_BYTES = 8 * HTB, NXCD = 8, WGM = 8;

__host__ __device__ __forceinline__ int lds_byte(int r, int c) { const int st = (r >> 4) * 2 + (c >> 5), rr = r & 15, cc = c & 31, ob = rr * 64 + cc * 2; return st * 1024 + (ob ^ (((ob >> 9) & 1) << 5)); }
__host__ __device__ __forceinline__ void stage_rc(int b, int& R, int& C) { const int st = b / 1024, sb = b % 1024, swz = sb ^ (((sb >> 9) & 1) << 5); R = (st >> 1) * 16 + swz / 64; C = (st & 1) * 32 + (swz % 64) / 2; }
__host__ __device__ __forceinline__ int perm32(int rho) { const int n = rho >> 4, i = rho & 15; return 8 * (i >> 2) + 4 * n + (i & 3); }

struct Unit { int pm, pn; };
struct Gemm { const bf16_t* A; const bf16_t* Bt; int M, N, K; };

struct StaticOrder {
    int nM, nN, nwg, G, c;
    __host__ __device__ void init(int M, int N, int G_, int c_) { nM = M / BM; nN = N / BM; nwg = nM * nN; G = G_; c = c_; }
    __host__ __device__ bool next(int i, Unit& u) const {
        const long L = (long)i * G + c; if (L >= nwg) return false;
        int wgid = (int)L; { const int q = nwg / NXCD, r = nwg % NXCD, xcd = wgid % NXCD, off = wgid / NXCD; wgid = (xcd < r ? xcd * (q + 1) : r * (q + 1) + (xcd - r) * q) + off; }
        const int nig = WGM * nN, gid = wgid / nig, fm = gid * WGM, gsz = (nM - fm) < WGM ? (nM - fm) : WGM;
        u.pm = fm + ((wgid % nig) % gsz); u.pn = (wgid % nig) / gsz; return true;
    }
    __device__ __forceinline__ void a_ready(const Unit&) const {}
    __device__ __forceinline__ void done(const Unit&) const {}
};
__device__ __forceinline__ unsigned cvt_pk_bf16(float lo, float hi) { unsigned r; asm volatile("v_cvt_pk_bf16_f32 %0, %1, %2" : "=v"(r) : "v"(lo), "v"(hi)); return r; }
typedef float f32x2 __attribute__((ext_vector_type(2)));
__device__ __forceinline__ f32x2 gelu_pk(f32x2 v) {
    const f32x2 av = __builtin_elementwise_abs(v), d = av * 0.2316418882f + 1.0f;
    f32x2 t; t.x = __builtin_amdgcn_rcpf(d.x); t.y = __builtin_amdgcn_rcpf(d.y);
    f32x2 q = t * 0.5307027145f + (-0.7265760135f); q = q * t + 0.7107068705f; q = q * t + (-0.142248368f); q = q * t + 0.127414796f; q = q * t;
    const f32x2 s = (v * v) * (-0.72134752044f);
    f32x2 e; e.x = __builtin_amdgcn_exp2f(s.x); e.y = __builtin_amdgcn_exp2f(s.y);
    const f32x2 m = v * (q * e), r = v - m;
    f32x2 o; o.x = v.x < 0.f ? m.x : r.x; o.y = v.y < 0.f ? m.y : r.y; return o;
}
typedef __amdgpu_buffer_rsrc_t rsrc_t;
__device__ __forceinline__ rsrc_t mkrsrc(const void* p, unsigned bytes) { return __builtin_amdgcn_make_buffer_rsrc((void*)p, (short)0, (int)bytes, 0x00020000); }
template <int LDC> struct EpiRowScaleF32 {
    static constexpr bool PERM = false, AFTER_DRAIN = false;
    float* C; const float* rs;
    __device__ __forceinline__ void operator()(const f32x4 (&acc)[2][2][4][2], const Unit& u, int wr, int wc, int fr, int fq) const {
        const rsrc_t rc = mkrsrc(C, 16384u * LDC * 4u), rr = mkrsrc(rs, 16384u * 4u);
        const int vo = ((wr * 64 + fr) * LDC + wc * 32 + 4 * fq) * 4, vr = (wr * 64 + fr) * 4;
        const int so = (u.pm * BM * LDC + u.pn * BM) * 4, sr = u.pm * BM * 4;
#pragma unroll
        for (int ai = 0; ai < 2; ++ai)
#pragma unroll
            for (int m = 0; m < 4; ++m) { const float s = __builtin_bit_cast(float, __builtin_amdgcn_raw_buffer_load_b32(rr, vr, sr + (ai * HALF + m * 16) * 4, 0));
#pragma unroll
                for (int bj = 0; bj < 2; ++bj)
#pragma unroll
                    for (int n = 0; n < 2; ++n) { const f32x4 v = acc[ai][bj][m][n] * s; __builtin_amdgcn_raw_buffer_store_b128(__builtin_bit_cast(u32x4, v), rc, vo, so + ((ai * HALF + m * 16) * LDC + bj * HALF + n * 16) * 4, 0); } }
    }
};
struct EpiResidF32 {
    static constexpr bool PERM = false, AFTER_DRAIN = false;
    const float* base; float* out;
    __device__ __forceinline__ void operator()(const f32x4 (&acc)[2][2][4][2], const Unit& u, int wr, int wc, int fr, int fq) const {
        constexpr int LDC = 4096;
        const rsrc_t rb = mkrsrc(base, 16384u * LDC * 4u), ro = mkrsrc(out, 16384u * LDC * 4u);
        const int vo = ((wr * 64 + fr) * LDC + wc * 32 + 4 * fq) * 4;
        const int so = (u.pm * BM * LDC + u.pn * BM) * 4;
#pragma unroll
        for (int ai = 0; ai < 2; ++ai)
#pragma unroll
            for (int m = 0; m < 4; ++m) {
#pragma unroll
                for (int bj = 0; bj < 2; ++bj)
#pragma unroll
                    for (int n = 0; n < 2; ++n) { const int o = so + ((ai * HALF + m * 16) * LDC + bj * HALF + n * 16) * 4;
                        const f32x4 b = __builtin_bit_cast(f32x4, __builtin_amdgcn_raw_buffer_load_b128(rb, vo, o, 0)); const f32x4 v = b + acc[ai][bj][m][n];
                        __builtin_amdgcn_raw_buffer_store_b128(__builtin_bit_cast(u32x4, v), ro, vo, o, 0); } }
    }
};
struct EpiQKV {
    static constexpr bool PERM = true, AFTER_DRAIN = false;
    bf16_t* Q; const float* rs; float qscale;
    __device__ __forceinline__ void operator()(const f32x4 (&acc)[2][2][4][2], const Unit& u, int wr, int wc, int fr, int fq) const {
        const rsrc_t rq = mkrsrc(Q, 3u * 16384u * 4096u * 2u), rr = mkrsrc(rs, 16384u * 4u);
        const int colt = u.pn * BM, which = colt >> 12, cw = colt & 4095, gt = cw >> 7;
        const int b = (u.pm * BM) >> 11, st = (u.pm * BM) & 2047;
        const float sc = which == 0 ? qscale : 1.f;
        const int so = (int)(((unsigned)which << 26) + (((unsigned)(b * 32 + gt) * 2048u + (unsigned)st) << 7)) * 2;
        const int vo = (((wr * 64 + fr) << 7) + wc * 32 + 8 * fq) * 2, vr = (wr * 64 + fr) * 4, sr = u.pm * BM * 4;
#pragma unroll
        for (int ai = 0; ai < 2; ++ai)
#pragma unroll
            for (int m = 0; m < 4; ++m) { const float f = sc * __builtin_bit_cast(float, __builtin_amdgcn_raw_buffer_load_b32(rr, vr, sr + (ai * HALF + m * 16) * 4, 0));
#pragma unroll
                for (int bj = 0; bj < 2; ++bj) {
                    const f32x4 v0 = acc[ai][bj][m][0] * f, v1 = acc[ai][bj][m][1] * f;
                    u32x4 w; w.x = cvt_pk_bf16(v0[0], v0[1]); w.y = cvt_pk_bf16(v0[2], v0[3]); w.z = cvt_pk_bf16(v1[0], v1[1]); w.w = cvt_pk_bf16(v1[2], v1[3]);
                    __builtin_amdgcn_raw_buffer_store_b128(w, rq, vo, so + ((bj * 2048 + ai * HALF + m * 16) << 7) * 2, 0); } }
    }
};

struct EpiQKV4 {
    static constexpr bool PERM = false, AFTER_DRAIN = false;
    bf16_t* Q; const float* rs; float qscale;
    __device__ __forceinline__ void operator()(const f32x4 (&acc)[2][2][4][2], const Unit& u, int wr, int wc, int fr, int fq) const {
        const rsrc_t rq = mkrsrc(Q, 3u * 16384u * 4096u * 2u), rr = mkrsrc(rs, 16384u * 4u);
        const int colt = u.pn * BM, which = colt >> 12, cw = colt & 4095, gt = cw >> 7;
        const int b = (u.pm * BM) >> 11, st = (u.pm * BM) & 2047;
        const float sc = which == 0 ? qscale : 1.f;
        const int so = (int)(((unsigned)which << 26) + (((unsigned)(b * 32 + gt) * 2048u + (unsigned)st) << 7)) * 2;
        const int vo = (((wr * 64 + fr) << 7) + wc * 32 + 4 * fq) * 2, vr = (wr * 64 + fr) * 4, sr = u.pm * BM * 4;
#pragma unroll
        for (int ai = 0; ai < 2; ++ai)
#pragma unroll
            for (int m = 0; m < 4; ++m) { const float f = sc * __builtin_bit_cast(float, __builtin_amdgcn_raw_buffer_load_b32(rr, vr, sr + (ai * HALF + m * 16) * 4, 0));
#pragma unroll
                for (int bj = 0; bj < 2; ++bj)
#pragma unroll
                    for (int n = 0; n < 2; ++n) { const f32x4 v0 = acc[ai][bj][m][n] * f; u32x2 w; w.x = cvt_pk_bf16(v0[0], v0[1]); w.y = cvt_pk_bf16(v0[2], v0[3]);
                        __builtin_amdgcn_raw_buffer_store_b64(w, rq, vo, so + (((bj * 2048 + ai * HALF + m * 16) << 7) + n * 16) * 2, 0); } }
    }
};

template <class Epi, class Sched, bool ALIGN_EPI = false, bool SP2 = false>
__device__ __forceinline__ void gemm_phase(PG8_LAS unsigned char* lds, const Gemm g, const Sched& S, const Epi& E) {
    int tid_ = threadIdx.x; asm volatile("" : "+v"(tid_));
    const int tid = tid_, wid = __builtin_amdgcn_readfirstlane(tid >> 6), lane = tid & 63, wr = wid >> 2, wc = wid & 3, fr = lane & 15, fq = lane >> 4;
    const int K = g.K, nt = K / BK;
    unsigned voffA[2], voffB[2];
#pragma unroll
    for (int i = 0; i < 2; ++i) { int R, C; stage_rc(tid * 16 + i * 8192, R, C); const int Rb = Epi::PERM ? ((R & ~31) + perm32(R & 31)) : R;
        voffA[i] = (unsigned)(R * K + C) * 2u; voffB[i] = (unsigned)(Rb * K + C) * 2u; }
    const size_t kstep = (size_t)(BK * 2);
    const size_t hstep = (size_t)HALF * K * 2;
    const size_t tstep = 2 * hstep;
    const unsigned ldsw = (unsigned)wid * 1024u;
    const int aoff = lds_byte(wr * 64 + fr, fq * 8), boff = lds_byte(wc * 32 + fr, fq * 8);
#define PG8_SA(b, h) (((b) * 2 + (h)) * HTB)
#define PG8_SB(b, h) ((4 + (b) * 2 + (h)) * HTB)
#define PG8_STAGE(bufoff, gbase, voff) do { _Pragma("unroll") for (int _i = 0; _i < 2; ++_i) \
        __builtin_amdgcn_global_load_lds((const unsigned*)((const char*)(gbase) + (voff)[_i]), (PG8_LAS unsigned*)(lds + (bufoff) + ldsw + _i * 8192), 16, 0, 0); } while (0)
#define PG8_LDA(dst, b, h) do { _Pragma("unroll") for (int m = 0; m < 4; ++m) _Pragma("unroll") for (int k = 0; k < 2; ++k) dst[m][k] = *(const PG8_LAS bf16x8*)(lds + PG8_SA(b, h) + aoff + m * 2048 + k * 1024); } while (0)
#define PG8_LDB(dst, b, h) do { _Pragma("unroll") for (int n = 0; n < 2; ++n) _Pragma("unroll") for (int k = 0; k < 2; ++k) dst[n][k] = *(const PG8_LAS bf16x8*)(lds + PG8_SB(b, h) + boff + n * 2048 + k * 1024); } while (0)
#define PG8_MMA(ai, bj, At, Bt) do { __builtin_amdgcn_s_setprio(1); _Pragma("unroll") for (int m = 0; m < 4; ++m) _Pragma("unroll") for (int n = 0; n < 2; ++n) _Pragma("unroll") for (int k = 0; k < 2; ++k) \
        acc[ai][bj][m][n] = __builtin_amdgcn_mfma_f32_16x16x32_bf16(Bt[n][k], At[m][k], acc[ai][bj][m][n], 0, 0, 0); __builtin_amdgcn_s_setprio(0); } while (0)
#define PG8_WAIT_V(n) asm volatile("s_waitcnt vmcnt(" #n ")" ::: "memory")
#define PG8_WAIT_L(n) asm volatile("s_waitcnt lgkmcnt(" #n ")" ::: "memory")
#define PG8_BAR __builtin_amdgcn_s_barrier()
#define PG8_SCHED __builtin_amdgcn_sched_barrier(0)
    Unit cur, nxt; int ui = 0;
    if (!S.next(0, cur)) return;
    f32x4 acc[2][2][4][2];
#pragma unroll
    for (int a = 0; a < 2; ++a)
#pragma unroll
        for (int b = 0; b < 2; ++b)
#pragma unroll
            for (int m = 0; m < 4; ++m)
#pragma unroll
                for (int n = 0; n < 2; ++n) acc[a][b][m][n] = (f32x4){0.f, 0.f, 0.f, 0.f};
    bf16x8 At[4][2], B0[2][2], B1[2][2];
    const char* cA = (const char*)g.A + (size_t)cur.pm * tstep; const char* cB = (const char*)g.Bt + (size_t)cur.pn * tstep;
    S.a_ready(cur);
    if constexpr (SP2) {
        PG8_STAGE(PG8_SB(0, 0), cB, voffB); PG8_STAGE(PG8_SB(0, 1), cB + hstep, voffB); PG8_STAGE(PG8_SA(0, 0), cA, voffA); PG8_STAGE(PG8_SA(0, 1), cA + hstep, voffA);
        if (wr == 1) PG8_BAR;
        PG8_WAIT_V(2); PG8_BAR;
        PG8_STAGE(PG8_SB(1, 0), cB + kstep, voffB); PG8_STAGE(PG8_SA(1, 0), cA + kstep, voffA); PG8_STAGE(PG8_SB(1, 1), cB + hstep + kstep, voffB);
        PG8_WAIT_V(6); PG8_BAR;
    } else {
        PG8_STAGE(PG8_SB(0, 0), cB, voffB); PG8_STAGE(PG8_SA(0, 0), cA, voffA); PG8_STAGE(PG8_SB(0, 1), cB + hstep, voffB); PG8_STAGE(PG8_SA(0, 1), cA + hstep, voffA);
        if (wr == 1) PG8_BAR;
        PG8_WAIT_V(4); PG8_BAR;
        PG8_STAGE(PG8_SB(1, 0), cB + kstep, voffB); PG8_STAGE(PG8_SA(1, 0), cA + kstep, voffA); PG8_STAGE(PG8_SB(1, 1), cB + hstep + kstep, voffB);
        PG8_WAIT_V(6); PG8_BAR;
    }
    for (;;) {
        const bool has_next = S.next(ui + 1, nxt);
        const char* nA = has_next ? (const char*)g.A + (size_t)nxt.pm * tstep : cA; const char* nB = has_next ? (const char*)g.Bt + (size_t)nxt.pn * tstep : cB;
        for (int t = 0; t < nt; t += 2) {
            const bool last = (t == nt - 2);
            const char* a1 = cA + (size_t)(t + 1) * kstep;
            const char* a2 = last ? nA : cA + (size_t)(t + 2) * kstep; const char* b2 = last ? nB : cB + (size_t)(t + 2) * kstep;
            const char* a3 = a2 + kstep; const char* b3 = b2 + kstep;
            if (last && has_next) S.a_ready(nxt);
            if constexpr (SP2) {
            PG8_LDB(B0, 0, 0); PG8_LDB(B1, 0, 1); PG8_SCHED; PG8_LDA(At, 0, 0); PG8_STAGE(PG8_SA(1, 1), a1 + hstep, voffA);
            PG8_WAIT_V(8); PG8_WAIT_L(0); PG8_BAR; PG8_MMA(0, 0, At, B0); PG8_MMA(0, 1, At, B1); PG8_BAR; PG8_SCHED;
            PG8_LDA(At, 0, 1); PG8_STAGE(PG8_SB(0, 0), b2, voffB); PG8_STAGE(PG8_SB(0, 1), b2 + hstep, voffB); PG8_STAGE(PG8_SA(0, 0), a2, voffA);
            PG8_WAIT_V(8); PG8_WAIT_L(0); PG8_BAR; PG8_MMA(1, 0, At, B0); PG8_MMA(1, 1, At, B1); PG8_BAR; PG8_SCHED;
            PG8_LDB(B0, 1, 0); PG8_LDB(B1, 1, 1); PG8_SCHED; PG8_LDA(At, 1, 0); PG8_STAGE(PG8_SA(0, 1), a2 + hstep, voffA);
            PG8_WAIT_V(8); PG8_WAIT_L(0); PG8_BAR; PG8_MMA(0, 0, At, B0); PG8_MMA(0, 1, At, B1); PG8_BAR; PG8_SCHED;
            PG8_LDA(At, 1, 1); PG8_STAGE(PG8_SB(1, 0), b3, voffB); PG8_STAGE(PG8_SB(1, 1), b3 + hstep, voffB); PG8_STAGE(PG8_SA(1, 0), a3, voffA);
            PG8_WAIT_V(8); PG8_WAIT_L(0); PG8_BAR; PG8_MMA(1, 0, At, B0); PG8_MMA(1, 1, At, B1); PG8_BAR; PG8_SCHED;
            } else {
            PG8_LDB(B0, 0, 0); PG8_SCHED; PG8_LDA(At, 0, 0); PG8_STAGE(PG8_SA(1, 1), a1 + hstep, voffA);
            PG8_WAIT_L(8); PG8_BAR; PG8_WAIT_L(0); PG8_MMA(0, 0, At, B0); PG8_BAR; PG8_SCHED;
            PG8_LDB(B1, 0, 1); PG8_STAGE(PG8_SB(0, 0), b2, voffB);
            PG8_BAR; PG8_WAIT_L(0); PG8_MMA(0, 1, At, B1); PG8_BAR;
            PG8_LDA(At, 0, 1); PG8_STAGE(PG8_SA(0, 0), a2, voffA);
            PG8_BAR; PG8_WAIT_L(0); PG8_MMA(1, 0, At, B0); PG8_BAR; PG8_SCHED;
            PG8_STAGE(PG8_SB(0, 1), b2 + hstep, voffB);
            PG8_WAIT_V(6); PG8_BAR; PG8_MMA(1, 1, At, B1); PG8_BAR;
            PG8_LDB(B0, 1, 0); PG8_SCHED; PG8_LDA(At, 1, 0); PG8_STAGE(PG8_SA(0, 1), a2 + hstep, voffA);
            PG8_WAIT_L(8); PG8_BAR; PG8_WAIT_L(0); PG8_MMA(0, 0, At, B0); PG8_BAR; PG8_SCHED;
            PG8_LDB(B1, 1, 1); PG8_STAGE(PG8_SB(1, 0), b3, voffB);
            PG8_BAR; PG8_WAIT_L(0); PG8_MMA(0, 1, At, B1); PG8_BAR;
            PG8_LDA(At, 1, 1); PG8_STAGE(PG8_SA(1, 0), a3, voffA);
            PG8_BAR; PG8_WAIT_L(0); PG8_MMA(1, 0, At, B0); PG8_BAR; PG8_SCHED;
            PG8_STAGE(PG8_SB(1, 1), b3 + hstep, voffB);
            PG8_WAIT_V(6); PG8_BAR; PG8_MMA(1, 1, At, B1); PG8_BAR;
            }
        }
        if constexpr (ALIGN_EPI) { if (wr == 0) PG8_BAR; }
        if constexpr (!Epi::AFTER_DRAIN) { E(acc, cur, wr, wc, fr, fq); S.done(cur); }
        if (!has_next) break;
#pragma unroll
        for (int a = 0; a < 2; ++a)
#pragma unroll
            for (int b = 0; b < 2; ++b)
#pragma unroll
                for (int m = 0; m < 4; ++m)
#pragma unroll
                    for (int n = 0; n < 2; ++n) acc[a][b][m][n] = (f32x4){0.f, 0.f, 0.f, 0.f};
        cur = nxt; cA = nA; cB = nB; ++ui;
        if constexpr (ALIGN_EPI) { if (wr == 1) PG8_BAR; }
    }
    PG8_WAIT_V(0);
    if constexpr (!ALIGN_EPI) { if (wr == 0) PG8_BAR; }
    PG8_BAR;
    if constexpr (Epi::AFTER_DRAIN) { E.fused(acc, cur, wr, wc, fr, fq, lds, wid, lane); S.done(cur); }
#undef PG8_SA
#undef PG8_SB
#undef PG8_STAGE
#undef PG8_LDA
#undef PG8_LDB
#undef PG8_MMA
#undef PG8_WAIT_V
#undef PG8_WAIT_L
#undef PG8_BAR
#undef PG8_SCHED
}
}
#define GAS __attribute__((address_space(1)))
#define LAS __attribute__((address_space(3)))
typedef unsigned short bf16_t;
typedef unsigned u32x4 __attribute__((ext_vector_type(4)));
typedef unsigned u32x2 __attribute__((ext_vector_type(2)));
typedef float f32x4 __attribute__((ext_vector_type(4)));
typedef float f32x2 __attribute__((ext_vector_type(2)));
typedef float f32x16 __attribute__((ext_vector_type(16)));
typedef short bf16x8 __attribute__((ext_vector_type(8)));
typedef short s16x4 __attribute__((ext_vector_type(4)));
typedef __bf16 bf16x2_t __attribute__((ext_vector_type(2)));

namespace mk {
constexpr int M = 16384, D = 4096, S = 2048, NB = 8, PW = 12298, NH = 32, NE = 16384;
constexpr int NWAVES = 8;
constexpr size_t MiB = 1u << 20;
constexpr size_t WS_CTL = 0, CTL_ZERO_BYTES = 1 * MiB;
constexpr size_t WS_RSTD = 2 * MiB, WS_LOGF = 3 * MiB, WS_WQK = 4 * MiB, WS_WOUT = 20 * MiB, WS_WIN = 52 * MiB, WS_U16 = 148 * MiB, WS_V16 = 276 * MiB,
                 WS_XB = 404 * MiB, WS_Q = 532 * MiB, WS_K = 660 * MiB, WS_V = 788 * MiB, WS_OB = 916 * MiB, WS_X2 = 1792 * MiB, WS_END = 2048 * MiB;
constexpr size_t WS_SC = WS_Q;
constexpr int CW_BAR = 4096;
constexpr int CW_QUEUE = 16384;
constexpr int RING_BYTES = 131072, LDSCTL_OFF = RING_BYTES, MISC_OFF = LDSCTL_OFF + 320, LDS_BYTES = 147456;

struct Args { const float* in[13]; float* out; unsigned char* ws; int ph_lo, ph_hi; };

__device__ __forceinline__ unsigned f2bf(float f) { unsigned u = __builtin_bit_cast(unsigned, f); return (u + 0x7fffu + ((u >> 16) & 1u)) >> 16; }
__device__ __forceinline__ unsigned pk2(float lo, float hi) { return f2bf(lo) | (f2bf(hi) << 16); }
__device__ __forceinline__ float bf_lo(unsigned w) { return __builtin_bit_cast(float, w << 16); }
__device__ __forceinline__ float bf_hi(unsigned w) { return __builtin_bit_cast(float, w & 0xffff0000u); }
__device__ __forceinline__ float wsum(float v) {
#pragma unroll
    for (int o = 1; o < 64; o <<= 1) v += __shfl_xor(v, o);
    return v;
}
__device__ __forceinline__ float wmax(float v) {
#pragma unroll
    for (int o = 1; o < 64; o <<= 1) v = fmaxf(v, __shfl_xor(v, o));
    return v;
}
__device__ __forceinline__ int wmin_i(int v) {
#pragma unroll
    for (int o = 1; o < 64; o <<= 1) { const int t = __shfl_xor(v, o); v = t < v ? t : v; }
    return v;
}
constexpr float US = 1024.0f, VS = 32.0f, US_INV = 1.0f / 1024.0f, VS_INV = 1.0f / 32.0f;
__device__ __forceinline__ float clamp8(float x) { return fminf(fmaxf(x, -224.0f), 224.0f); }
__device__ __forceinline__ float logsig(float z) { return z >= 0.f ? -log1pf(expf(-z)) : z - log1pf(expf(z)); }
#define LDS_WAIT() asm volatile("s_waitcnt lgkmcnt(0)" ::: "memory")
#define FRESH_LDS(l) do { unsigned v_ = (unsigned)(size_t)(l); asm volatile("" : "+s"(v_)); (l) = (LAS unsigned char*)(size_t)v_; } while (0)
#define FRESH_BID() int bid = blockIdx.x, G = gridDim.x; asm volatile("" : "+s"(bid), "+s"(G))
#define FRESH_TID() int tid; { int t_ = threadIdx.x; asm volatile("" : "+v"(t_)); tid = t_; } const int lane = tid & 63, wave = __builtin_amdgcn_readfirstlane(tid >> 6); (void)lane; (void)wave

__device__ __forceinline__ void transpose_item(const float* W, int K, int ldw, int ncols, const float* gain, bf16_t* WT, LAS float* scr, int item, int lane) {
    const int nblk = ncols / 32, kb = item / nblk, nb = item % nblk, k0 = 64 * kb, n0 = 32 * nb;
#pragma unroll 8
    for (int i = 0; i < 32; ++i) { const int kk = 2 * i + (lane >> 5); float v = W[(size_t)(k0 + kk) * ldw + n0 + (lane & 31)]; if (gain) v *= gain[k0 + kk]; scr[kk * 33 + (lane & 31)] = v; }
    LDS_WAIT(); asm volatile("" ::: "memory");
    const int c = lane & 7;
#pragma unroll
    for (int j = 0; j < 4; ++j) { const int n = (lane >> 3) + 8 * j; const LAS float* s = scr + (8 * c) * 33 + n;
        u32x4 o; o.x = pk2(s[0 * 33], s[1 * 33]); o.y = pk2(s[2 * 33], s[3 * 33]); o.z = pk2(s[4 * 33], s[5 * 33]); o.w = pk2(s[6 * 33], s[7 * 33]);
        *(u32x4*)(WT + (size_t)(n0 + n) * K + k0 + 8 * c) = o; }
    LDS_WAIT(); asm volatile("" ::: "memory");
}

typedef const __attribute__((address_space(4))) Args* KArgsT;
__device__ __forceinline__ void conv_phase(KArgsT ka, int l, LAS unsigned char* lds) {
    FRESH_TID(); FRESH_LDS(lds); FRESH_BID();
    unsigned char* ws = ka->ws;
    const float* ln1 = ka->in[1] + (size_t)l * D; const float* w_in = ka->in[2] + (size_t)l * D * PW; const float* w_out = ka->in[5] + (size_t)l * D * D;
    const float* ln2 = ka->in[6] + (size_t)l * D; const float* wq = ka->in[7] + (size_t)l * D * 2048;
    const float* k1 = ka->in[8] + (size_t)l * 8 * 128 * 128; const float* k2 = ka->in[9] + (size_t)l * 8 * 128 * 128;
    const float* pu = ka->in[10] + (size_t)l * NE * D; const float* pv = ka->in[11] + (size_t)l * NE * D;
    bf16_t* WQK = (bf16_t*)(ws + WS_WQK); bf16_t* WOUT = (bf16_t*)(ws + WS_WOUT); bf16_t* WIN = (bf16_t*)(ws + WS_WIN); bf16_t* U16 = (bf16_t*)(ws + WS_U16); bf16_t* V16 = (bf16_t*)(ws + WS_V16);
    {
        LAS float* Ks = (LAS float*)lds;
        LAS float* Ws = (LAS float*)(lds + 128 * 132 * 4);
        for (int it = bid; it < 1024; it += G) {
            const int gi = it >> 6, c0 = (it & 63) * 64;
            const float* key = ((gi & 1) ? k2 : k1) + (size_t)(gi >> 1) * 128 * 128;
            for (int i = tid; i < 4096; i += 512) { const int r = i >> 5, c4 = (i & 31) * 4; *(LAS f32x4*)(Ks + r * 132 + c4) = *(const f32x4*)(key + r * 128 + c4); }
            for (int i = tid; i < 2048; i += 512) { const int r = i >> 5, c4 = (i & 31) * 4; *(LAS f32x4*)(Ws + r * 132 + c4) = *(const f32x4*)(wq + (size_t)(c0 + r) * 2048 + gi * 128 + c4); }
            __syncthreads();
            const int tc = tid & 15, tn = tid >> 4;
            float acc[4][4];
#pragma unroll
            for (int i = 0; i < 4; ++i)
#pragma unroll
                for (int j = 0; j < 4; ++j) acc[i][j] = 0.f;
#pragma unroll 2
            for (int d = 0; d < 128; d += 4) {
                f32x4 kv[4], wv[4];
#pragma unroll
                for (int i = 0; i < 4; ++i) kv[i] = *(const LAS f32x4*)(Ks + (4 * tn + i) * 132 + d);
#pragma unroll
                for (int j = 0; j < 4; ++j) wv[j] = *(const LAS f32x4*)(Ws + (tc + 16 * j) * 132 + d);
#pragma unroll
                for (int i = 0; i < 4; ++i)
#pragma unroll
                    for (int j = 0; j < 4; ++j) acc[i][j] += kv[i][0] * wv[j][0] + kv[i][1] * wv[j][1] + kv[i][2] * wv[j][2] + kv[i][3] * wv[j][3];
            }
#pragma unroll
            for (int j = 0; j < 4; ++j) { const int c = c0 + tc + 16 * j; const float gg = ln2[c];
#pragma unroll
                for (int i = 0; i < 4; ++i) WQK[(size_t)(gi * 128 + 4 * tn + i) * D + c] = (bf16_t)f2bf(acc[i][j] * gg); }
            __syncthreads();
        }
        __syncthreads();
    }
    const int gw = bid * NWAVES + wave, NGW = G * NWAVES;
    {
        unsigned char* U8 = (unsigned char*)U16; unsigned char* V8 = U8 + (size_t)NE * D;
        for (int r = gw; r < NE; r += NGW) {
            const float* us = pu + (size_t)r * D; const float* vs = pv + (size_t)r * D;
#pragma unroll
            for (int i = 0; i < 4; ++i) { const int c = 1024 * i + 16 * lane;
                u32x4 ou, ov;
#pragma unroll
                for (int q = 0; q < 4; ++q) { const f32x4 u0 = *(const f32x4*)(us + c + 4 * q), g0 = *(const f32x4*)(ln2 + c + 4 * q), v0 = *(const f32x4*)(vs + c + 4 * q);
                    int pu_ = __builtin_amdgcn_cvt_pk_fp8_f32(clamp8(u0[0] * g0[0] * US), clamp8(u0[1] * g0[1] * US), 0, false); pu_ = __builtin_amdgcn_cvt_pk_fp8_f32(clamp8(u0[2] * g0[2] * US), clamp8(u0[3] * g0[3] * US), pu_, true);
                    int pv_ = __builtin_amdgcn_cvt_pk_fp8_f32(clamp8(v0[0] * VS), clamp8(v0[1] * VS), 0, false); pv_ = __builtin_amdgcn_cvt_pk_fp8_f32(clamp8(v0[2] * VS), clamp8(v0[3] * VS), pv_, true);
                    ou[q] = (unsigned)pu_; ov[q] = (unsigned)pv_; }
                *(u32x4*)(U8 + (size_t)r * D + c) = ou; *(u32x4*)(V8 + (size_t)r * D + c) = ov; }
        }
    }
    {
        LAS float* scr = (LAS float*)(lds + wave * 16384);
        constexpr int I_O = (D / 64) * (D / 32), I_IN = (D / 64) * (12288 / 32);
        for (int it = gw; it < I_O + I_IN; it += NGW) {
            if (it < I_O) transpose_item(w_out, D, D, D, nullptr, WOUT, scr, it, lane);
            else transpose_item(w_in, D, PW, 12288, ln1, WIN, scr, it - I_O, lane);
        }
    }
}

template <bool WITH_F>
__device__ __forceinline__ void prep_phase(const float* X, bf16_t* XB, float* RSTD, const float* w_in, const float* ln1, const float* bf, float* LOGF, LAS unsigned char* lds) {
    FRESH_TID(); FRESH_LDS(lds); FRESH_BID();
    LAS unsigned short* gfs = (LAS unsigned short*)lds;
    if (WITH_F) {
        __syncthreads();
        for (int c = tid; c < D; c += 512) { const float g = ln1[c]; const float* wr = w_in + (size_t)c * PW + 12288;
#pragma unroll
            for (int j = 0; j < 10; ++j) gfs[j * D + c] = (unsigned short)f2bf(wr[j] * g); }
        __syncthreads();
    }
    const int gw = bid * NWAVES + wave, NGW = G * NWAVES;
    for (int m = gw; m < M; m += NGW) {
        const f32x4* xr = (const f32x4*)(X + (size_t)m * D) + lane;
        f32x4 v[16]; float ss = 0.f;
#pragma unroll
        for (int i = 0; i < 16; ++i) { v[i] = xr[64 * i]; ss += (v[i][0] * v[i][0] + v[i][1] * v[i][1]) + (v[i][2] * v[i][2] + v[i][3] * v[i][3]); }
        ss = wsum(ss);
        const float rstd = rsqrtf(ss * (1.0f / D) + 1e-6f);
        u32x2* o = (u32x2*)(XB + (size_t)m * D) + lane;
#pragma unroll
        for (int i = 0; i < 16; ++i) { u32x2 w; w.x = pk2(v[i][0], v[i][1]); w.y = pk2(v[i][2], v[i][3]); o[64 * i] = w; }
        if (lane == 0) RSTD[m] = rstd;
        if (WITH_F) {
            float mine = 0.f;
#pragma unroll 1
            for (int j = 0; j < 10; ++j) { float s = 0.f;
#pragma unroll
                for (int i = 0; i < 16; ++i) { const u32x2 gp = *(const LAS u32x2*)(gfs + j * D + 256 * i + 4 * lane);
                    s += (v[i][0] * bf_lo(gp.x) + v[i][1] * bf_hi(gp.x)) + (v[i][2] * bf_lo(gp.y) + v[i][3] * bf_hi(gp.y)); }
                s = wsum(s); if (lane == j) mine = s; }
            if (lane < 10) { const int b = m >> 11, s = m & 2047; LOGF[(size_t)(b * 10 + lane) * S + s] = logsig(mine * rstd + bf[lane]); }
        }
    }
}

#define RFL(x) __builtin_amdgcn_readfirstlane(x)
template <bool FINAL, bool ROUTE_EXT = false, bool SKIP_U = false>
__device__ __forceinline__ void peer_phase(const float* SC, const bf16_t* XB, const float* RSTD, const bf16_t* U16, const bf16_t* V16, const float* X1, float* XO, const float* fg,
                                           LAS unsigned char* lds) {
    FRESH_TID(); FRESH_LDS(lds); FRESH_BID();
    LAS int* s_eid = (LAS int*)(lds + wave * 1024); LAS float* s_w = (LAS float*)(lds + wave * 1024 + 512);
    const int gw = bid * NWAVES + wave, NGW = G * NWAVES;
    const float NEG = -3.0e38f;
    for (int tok = gw; tok < M; tok += NGW) {
        const float* sc = SC + (size_t)tok * 2048;
        if (ROUTE_EXT) { const int* ee = (const int*)SC; const float* gg = (const float*)XB;     (void)ee; (void)gg; }
        for (int h = 0; h < (ROUTE_EXT ? 0 : 8); ++h) {
            float a0 = sc[h * 256 + lane], a1 = sc[h * 256 + 64 + lane], c0 = sc[h * 256 + 128 + lane], c1 = sc[h * 256 + 192 + lane];
            float v1 = 0.f, v2 = 0.f; int i1 = 0, i2 = 0;
            for (int it = 0; it < 16; ++it) {
                { const float m = wmax(fmaxf(a0, a1)); int cand = 1 << 30; if (a0 == m) cand = lane; else if (a1 == m) cand = lane + 64;
                  const int n = wmin_i(cand); if (n == lane) a0 = NEG; if (n == lane + 64) a1 = NEG; if (lane == it) { v1 = m; i1 = n; } }
                { const float m = wmax(fmaxf(c0, c1)); int cand = 1 << 30; if (c0 == m) cand = lane; else if (c1 == m) cand = lane + 64;
                  const int n = wmin_i(cand); if (n == lane) c0 = NEG; if (n == lane + 64) c1 = NEG; if (lane == it) { v2 = m; i2 = n; } }
            }
            float d0, d1, d2, d3;
            { const float va = __shfl(v1, lane >> 2); d0 = va + __shfl(v2, (lane & 3) * 4 + 0); d1 = va + __shfl(v2, (lane & 3) * 4 + 1); d2 = va + __shfl(v2, (lane & 3) * 4 + 2); d3 = va + __shfl(v2, (lane & 3) * 4 + 3); }
            float best = 0.f; int be = 0;
            for (int it = 0; it < 16; ++it) {
                const float m = wmax(fmaxf(fmaxf(d0, d1), fmaxf(d2, d3)));
                int cand = 1 << 30;
                if (d0 == m) cand = lane * 4; else if (d1 == m) cand = lane * 4 + 1; else if (d2 == m) cand = lane * 4 + 2; else if (d3 == m) cand = lane * 4 + 3;
                const int pos = wmin_i(cand);
                if (pos == lane * 4) d0 = NEG; if (pos == lane * 4 + 1) d1 = NEG; if (pos == lane * 4 + 2) d2 = NEG; if (pos == lane * 4 + 3) d3 = NEG;
                const int e = ((__shfl(i1, (pos >> 4) & 15) & 127) << 7) | (__shfl(i2, pos & 15) & 127);
                if (lane == it) { best = m; be = e; }
            }
            const float mx = __shfl(best, 0);
            const float p = lane < 16 ? expf(best - mx) : 0.f;
            const float sm = wsum(p);
            if (lane < 16) { s_eid[h * 16 + lane] = be; s_w[h * 16 + lane] = p / sm; }
        }
        if (ROUTE_EXT) { const int* ee = (const int*)fg; const float* gg = (const float*)(ee + (size_t)M * 128); s_eid[lane] = ee[(size_t)tok * 128 + lane]; s_eid[lane + 64] = ee[(size_t)tok * 128 + lane + 64]; s_w[lane] = gg[(size_t)tok * 128 + lane]; s_w[lane + 64] = gg[(size_t)tok * 128 + lane + 64]; }
        LDS_WAIT(); asm volatile("" ::: "memory");
        if (!SKIP_U) {
            u32x4 xr[8];
            { const u32x4* p_ = (const u32x4*)(XB + (size_t)tok * D) + lane;
#pragma unroll
              for (int i = 0; i < 8; ++i) xr[i] = p_[64 * i]; }
            const float rstd = RSTD[tok];
#define LOADROW(dst, base, e) do { const u32x4* p_ = (const u32x4*)((base) + (size_t)(e) * D) + lane; _Pragma("unroll") for (int i_ = 0; i_ < 8; ++i_) dst[i_] = p_[64 * i_]; } while (0)
#define UDOT(row, j) do { float d_ = 0.f; _Pragma("unroll") for (int i_ = 0; i_ < 8; ++i_) { _Pragma("unroll") for (int k_ = 0; k_ < 4; ++k_) \
                { d_ = fmaf(bf_lo(xr[i_][k_]), bf_lo(row[i_][k_]), d_); d_ = fmaf(bf_hi(xr[i_][k_]), bf_hi(row[i_][k_]), d_); } } \
            d_ = wsum(d_) * rstd; const float ge_ = 0.5f * d_ * (1.0f + erff(d_ * 0.70710678118654752f)); if (lane == 0) s_w[j] *= ge_; } while (0)
            u32x4 ra[8], rb[8];
            { const int e0 = RFL(s_eid[0]); LOADROW(ra, U16, e0); }
            for (int j = 0; j < 128; j += 2) {
                { const int e1 = RFL(s_eid[j + 1]); LOADROW(rb, U16, e1); }
                UDOT(ra, j);
                if (j + 2 < 128) { const int e2 = RFL(s_eid[j + 2]); LOADROW(ra, U16, e2); }
                UDOT(rb, j + 1);
            }
#undef UDOT
        }
        LDS_WAIT(); asm volatile("" ::: "memory");
        {
            float acc[8][8];
#pragma unroll
            for (int i = 0; i < 8; ++i)
#pragma unroll
                for (int k = 0; k < 8; ++k) acc[i][k] = 0.f;
#define VACC(row, j) do { const float w_ = s_w[j]; _Pragma("unroll") for (int i_ = 0; i_ < 8; ++i_) { _Pragma("unroll") for (int k_ = 0; k_ < 4; ++k_) { \
                acc[i_][2 * k_] = fmaf(w_, bf_lo(row[i_][k_]), acc[i_][2 * k_]); acc[i_][2 * k_ + 1] = fmaf(w_, bf_hi(row[i_][k_]), acc[i_][2 * k_ + 1]); } } } while (0)
            u32x4 ra[8], rb[8];
            { const int e0 = RFL(s_eid[0]); LOADROW(ra, V16, e0); }
            for (int j = 0; j < 128; j += 2) {
                { const int e1 = RFL(s_eid[j + 1]); LOADROW(rb, V16, e1); }
                VACC(ra, j);
                if (j + 2 < 128) { const int e2 = RFL(s_eid[j + 2]); LOADROW(ra, V16, e2); }
                VACC(rb, j + 1);
            }
#undef VACC
#undef LOADROW
            const float* x1 = X1 + (size_t)tok * D; float* xo = XO + (size_t)tok * D;
            float ss = 0.f;
#pragma unroll
            for (int i = 0; i < 8; ++i) { const int c = 512 * i + 8 * lane; const f32x4 p0 = *(const f32x4*)(x1 + c), p1 = *(const f32x4*)(x1 + c + 4);
                acc[i][0] += p0[0]; acc[i][1] += p0[1]; acc[i][2] += p0[2]; acc[i][3] += p0[3]; acc[i][4] += p1[0]; acc[i][5] += p1[1]; acc[i][6] += p1[2]; acc[i][7] += p1[3];
#pragma unroll
                for (int k = 0; k < 8; ++k) ss += acc[i][k] * acc[i][k]; }
            float rs = 1.f;
            if (FINAL) { ss = wsum(ss); rs = rsqrtf(ss * (1.0f / D) + 1e-6f); }
#pragma unroll
            for (int i = 0; i < 8; ++i) { const int c = 512 * i + 8 * lane; f32x4 o0, o1;
                if (FINAL) { const f32x4 g0 = *(const f32x4*)(fg + c), g1 = *(const f32x4*)(fg + c + 4);
                    o0 = (f32x4){acc[i][0] * rs * g0[0], acc[i][1] * rs * g0[1], acc[i][2] * rs * g0[2], acc[i][3] * rs * g0[3]}; o1 = (f32x4){acc[i][4] * rs * g1[0], acc[i][5] * rs * g1[1], acc[i][6] * rs * g1[2], acc[i][7] * rs * g1[3]}; }
                else { o0 = (f32x4){acc[i][0], acc[i][1], acc[i][2], acc[i][3]}; o1 = (f32x4){acc[i][4], acc[i][5], acc[i][6], acc[i][7]}; }
                *(f32x4*)(xo + c) = o0; *(f32x4*)(xo + c + 4) = o1; }
        }
        LDS_WAIT(); asm volatile("" ::: "memory");
    }
}

template <bool FINAL>
__device__ __forceinline__ void peer_phase8(const float* SC, const float* RSTD, const unsigned char* U8, const unsigned char* V8, const float* X1, float* XO, const float* fg, LAS unsigned char* lds) {
    FRESH_TID(); FRESH_LDS(lds); FRESH_BID();
    LAS int* s_eid = (LAS int*)(lds + wave * 1024); LAS float* s_w = (LAS float*)(lds + wave * 1024 + 512);
    const int gw = bid * NWAVES + wave, NGW = G * NWAVES;
    const float NEG = -3.0e38f;
    for (int tok = gw; tok < M; tok += NGW) {
        const float* sc = SC + (size_t)tok * 2048;
        for (int h = 0; h < 8; ++h) {
            float a0 = sc[h * 256 + lane], a1 = sc[h * 256 + 64 + lane], c0 = sc[h * 256 + 128 + lane], c1 = sc[h * 256 + 192 + lane];
            float v1 = 0.f, v2 = 0.f; int i1 = 0, i2 = 0;
            for (int it = 0; it < 16; ++it) {
                { const float m = wmax(fmaxf(a0, a1)); int cand = 1 << 30; if (a0 == m) cand = lane; else if (a1 == m) cand = lane + 64;
                  const int n = wmin_i(cand); if (n == lane) a0 = NEG; if (n == lane + 64) a1 = NEG; if (lane == it) { v1 = m; i1 = n; } }
                { const float m = wmax(fmaxf(c0, c1)); int cand = 1 << 30; if (c0 == m) cand = lane; else if (c1 == m) cand = lane + 64;
                  const int n = wmin_i(cand); if (n == lane) c0 = NEG; if (n == lane + 64) c1 = NEG; if (lane == it) { v2 = m; i2 = n; } }
            }
            float d0, d1, d2, d3;
            { const float va = __shfl(v1, lane >> 2); d0 = va + __shfl(v2, (lane & 3) * 4 + 0); d1 = va + __shfl(v2, (lane & 3) * 4 + 1); d2 = va + __shfl(v2, (lane & 3) * 4 + 2); d3 = va + __shfl(v2, (lane & 3) * 4 + 3); }
            float best = 0.f; int be = 0;
            for (int it = 0; it < 16; ++it) {
                const float m = wmax(fmaxf(fmaxf(d0, d1), fmaxf(d2, d3)));
                int cand = 1 << 30;
                if (d0 == m) cand = lane * 4; else if (d1 == m) cand = lane * 4 + 1; else if (d2 == m) cand = lane * 4 + 2; else if (d3 == m) cand = lane * 4 + 3;
                const int pos = wmin_i(cand);
                if (pos == lane * 4) d0 = NEG; if (pos == lane * 4 + 1) d1 = NEG; if (pos == lane * 4 + 2) d2 = NEG; if (pos == lane * 4 + 3) d3 = NEG;
                const int e = ((__shfl(i1, (pos >> 4) & 15) & 127) << 7) | (__shfl(i2, pos & 15) & 127);
                if (lane == it) { best = m; be = e; }
            }
            const float mx = __shfl(best, 0);
            const float p = lane < 16 ? expf(best - mx) : 0.f;
            const float sm = wsum(p);
            if (lane < 16) { s_eid[h * 16 + lane] = be; s_w[h * 16 + lane] = p / sm; }
        }
        LDS_WAIT(); asm volatile("" ::: "memory");
#define LOADROW8(dst, base, e) do { const u32x4* p_ = (const u32x4*)((base) + (size_t)(e) * D) + lane; _Pragma("unroll") for (int i_ = 0; i_ < 4; ++i_) dst[i_] = p_[64 * i_]; } while (0)
        const float* x1 = X1 + (size_t)tok * D; float* xo = XO + (size_t)tok * D;
        {
            float xv[4][16];
#pragma unroll
            for (int i = 0; i < 4; ++i)
#pragma unroll
                for (int q = 0; q < 4; ++q) { const f32x4 t = *(const f32x4*)(x1 + 1024 * i + 16 * lane + 4 * q); xv[i][4 * q] = t[0]; xv[i][4 * q + 1] = t[1]; xv[i][4 * q + 2] = t[2]; xv[i][4 * q + 3] = t[3]; }
            const float rstd = RSTD[tok] * US_INV;
#define UDOT8(row, j) do { float da_ = 0.f, db_ = 0.f; _Pragma("unroll") for (int i_ = 0; i_ < 4; ++i_) { _Pragma("unroll") for (int k_ = 0; k_ < 4; ++k_) { \
                unsigned w0_ = row[i_][k_]; asm volatile("" : "+v"(w0_));     \
                const f32x2 lo_ = __builtin_amdgcn_cvt_pk_f32_fp8((int)w0_, false), hi_ = __builtin_amdgcn_cvt_pk_f32_fp8((int)w0_, true); \
                da_ = fmaf(xv[i_][4 * k_], lo_[0], da_); db_ = fmaf(xv[i_][4 * k_ + 1], lo_[1], db_); da_ = fmaf(xv[i_][4 * k_ + 2], hi_[0], da_); db_ = fmaf(xv[i_][4 * k_ + 3], hi_[1], db_); } \
                asm volatile("" : "+v"(da_), "+v"(db_)); } \
            const float d_ = wsum(da_ + db_) * rstd; const float ge_ = 0.5f * d_ * (1.0f + erff(d_ * 0.70710678118654752f)); if (lane == 0) s_w[j] *= ge_; } while (0)
            u32x4 r0[4], r1[4], r2[4];
            { const int e_ = RFL(s_eid[0]); LOADROW8(r0, U8, e_); } { const int e_ = RFL(s_eid[1]); LOADROW8(r1, U8, e_); } { const int e_ = RFL(s_eid[2]); LOADROW8(r2, U8, e_); }
            for (int j = 0; j < 126; j += 3) {
                UDOT8(r0, j);     if (j + 3 < 128) { const int e_ = RFL(s_eid[j + 3]); LOADROW8(r0, U8, e_); }
                UDOT8(r1, j + 1); if (j + 4 < 128) { const int e_ = RFL(s_eid[j + 4]); LOADROW8(r1, U8, e_); }
                UDOT8(r2, j + 2); if (j + 5 < 128) { const int e_ = RFL(s_eid[j + 5]); LOADROW8(r2, U8, e_); }
            }
            UDOT8(r0, 126); UDOT8(r1, 127);
#undef UDOT8
        }
        LDS_WAIT(); asm volatile("" ::: "memory");
        {
            float acc[4][16];
#pragma unroll
            for (int i = 0; i < 4; ++i)
#pragma unroll
                for (int k = 0; k < 16; ++k) acc[i][k] = 0.f;
#define VACC8(row, j) do { const float w_ = s_w[j]; _Pragma("unroll") for (int i_ = 0; i_ < 4; ++i_) { _Pragma("unroll") for (int k_ = 0; k_ < 4; ++k_) { \
                unsigned w0_ = row[i_][k_]; asm volatile("" : "+v"(w0_)); \
                const f32x2 lo_ = __builtin_amdgcn_cvt_pk_f32_fp8((int)w0_, false), hi_ = __builtin_amdgcn_cvt_pk_f32_fp8((int)w0_, true); \
                acc[i_][4 * k_] = fmaf(w_, lo_[0], acc[i_][4 * k_]); acc[i_][4 * k_ + 1] = fmaf(w_, lo_[1], acc[i_][4 * k_ + 1]); acc[i_][4 * k_ + 2] = fmaf(w_, hi_[0], acc[i_][4 * k_ + 2]); acc[i_][4 * k_ + 3] = fmaf(w_, hi_[1], acc[i_][4 * k_ + 3]); } \
                asm volatile("" : "+v"(acc[i_][0]), "+v"(acc[i_][1]), "+v"(acc[i_][2]), "+v"(acc[i_][3]), "+v"(acc[i_][4]), "+v"(acc[i_][5]), "+v"(acc[i_][6]), "+v"(acc[i_][7]), \
                                  "+v"(acc[i_][8]), "+v"(acc[i_][9]), "+v"(acc[i_][10]), "+v"(acc[i_][11]), "+v"(acc[i_][12]), "+v"(acc[i_][13]), "+v"(acc[i_][14]), "+v"(acc[i_][15])); } } while (0)
            u32x4 r0[4], r1[4], r2[4];
            { const int e_ = RFL(s_eid[0]); LOADROW8(r0, V8, e_); } { const int e_ = RFL(s_eid[1]); LOADROW8(r1, V8, e_); } { const int e_ = RFL(s_eid[2]); LOADROW8(r2, V8, e_); }
            for (int j = 0; j < 126; j += 3) {
                VACC8(r0, j);     if (j + 3 < 128) { const int e_ = RFL(s_eid[j + 3]); LOADROW8(r0, V8, e_); }
                VACC8(r1, j + 1); if (j + 4 < 128) { const int e_ = RFL(s_eid[j + 4]); LOADROW8(r1, V8, e_); }
                VACC8(r2, j + 2); if (j + 5 < 128) { const int e_ = RFL(s_eid[j + 5]); LOADROW8(r2, V8, e_); }
            }
            VACC8(r0, 126); VACC8(r1, 127);
#undef VACC8
#undef LOADROW8
            float ss = 0.f;
#pragma unroll
            for (int i = 0; i < 4; ++i)
#pragma unroll
                for (int q = 0; q < 4; ++q) { const f32x4 t = *(const f32x4*)(x1 + 1024 * i + 16 * lane + 4 * q);
#pragma unroll
                    for (int k = 0; k < 4; ++k) { acc[i][4 * q + k] = fmaf(acc[i][4 * q + k], VS_INV, t[k]); ss += acc[i][4 * q + k] * acc[i][4 * q + k]; } }
            float rs = 1.f;
            if (FINAL) { ss = wsum(ss); rs = rsqrtf(ss * (1.0f / D) + 1e-6f); }
#pragma unroll
            for (int i = 0; i < 4; ++i)
#pragma unroll
                for (int q = 0; q < 4; ++q) { const int c = 1024 * i + 16 * lane + 4 * q; f32x4 o_;
                    if (FINAL) { const f32x4 g_ = *(const f32x4*)(fg + c); o_ = (f32x4){acc[i][4 * q] * rs * g_[0], acc[i][4 * q + 1] * rs * g_[1], acc[i][4 * q + 2] * rs * g_[2], acc[i][4 * q + 3] * rs * g_[3]}; }
                    else o_ = (f32x4){acc[i][4 * q], acc[i][4 * q + 1], acc[i][4 * q + 2], acc[i][4 * q + 3]};
                    *(f32x4*)(xo + c) = o_; }
        }
        LDS_WAIT(); asm volatile("" ::: "memory");
    }
}
}
namespace at {
using namespace mk;
constexpr int QB = 256, KVB = 64, HD = 128;
constexpr int SHM_V = KVB * HD * 2, SHM_K = KVB * HD * 2;
constexpr int OFF_V = 0, OFF_K = 2 * SHM_V, OFF_WS = OFF_K + 2 * SHM_K, OFF_CUM = OFF_WS + 8 * 256, OFF_RT = OFF_CUM + 2048 * 4, OFF_MISC = OFF_RT + 640 * 4;
constexpr float LOG2E = 1.4426950408889634f;
constexpr float THR2 = 10.0f;
constexpr float SB_DONE = -100.0f;

#define AT_KSWZ(row, colB) ((row) * 256 + ((colB) ^ (((row) & 7) << 4)))
__device__ __forceinline__ int v_st(int k, int c) { const int kk = (k & ~0xC) | ((k & 4) << 1) | ((k & 8) >> 1); return ((kk >> 3) * 4 + (c >> 5)) * 512 + ((kk & 7) * 32 + (c & 31)) * 2; }
__device__ __forceinline__ int v_rd_base(int lane) { return ((lane & 3) << 3) | (((lane >> 2) & 3) << 6) | (((lane >> 4) & 1) << 5) | (((lane >> 5) & 1) << 8); }
constexpr int v_rd_off(int d0, int ks, int half) { return d0 * 512 + ks * 4096 + half * 2048; }
__device__ __forceinline__ int crow(int r, int hi) { return (r & 3) + 8 * (r >> 2) + 4 * hi; }
__device__ __forceinline__ unsigned cvtpk(float lo, float hi) { unsigned r; asm volatile("v_cvt_pk_bf16_f32 %0, %1, %2" : "=v"(r) : "v"(lo), "v"(hi)); return r; }
__device__ __forceinline__ float partner(float v, int hi) { auto rr = __builtin_amdgcn_permlane32_swap(__builtin_bit_cast(unsigned, v), __builtin_bit_cast(unsigned, v), false, false); return __builtin_bit_cast(float, hi ? rr[0] : rr[1]); }

__device__ __forceinline__ float xchg_max(float v, int hi) { return fmaxf(v, partner(v, hi)); }
__device__ __forceinline__ float xchg_sum(float v, int hi) { return v + partner(v, hi); }

__device__ __forceinline__ void pack_p(const f32x16& p0, const f32x16& p1, bf16x8& pa0, bf16x8& pa1, bf16x8& pa2, bf16x8& pa3) {
#define AT_PK4(P, B_, OUT) do { unsigned a0 = cvtpk(P[B_ + 0], P[B_ + 1]), a1 = cvtpk(P[B_ + 2], P[B_ + 3]); unsigned b0 = cvtpk(P[B_ + 4], P[B_ + 5]), b1 = cvtpk(P[B_ + 6], P[B_ + 7]); \
        auto r0 = __builtin_amdgcn_permlane32_swap(a0, b0, false, false); auto r1 = __builtin_amdgcn_permlane32_swap(a1, b1, false, false); \
        u32x4 w = {r0[0], r1[0], r0[1], r1[1]}; OUT = __builtin_bit_cast(bf16x8, w); } while (0)
    AT_PK4(p0, 0, pa0); AT_PK4(p0, 8, pa1); AT_PK4(p1, 0, pa2); AT_PK4(p1, 8, pa3);
#undef AT_PK4
}
template <int KBUF>
__device__ __forceinline__ void qkt(f32x16& p0, f32x16& p1, LAS unsigned char* K_lds, int r32, int hi, const bf16x8 (&qr)[8]) {
    p0 = f32x16{}; p1 = f32x16{};
    LAS unsigned char* kb[4];
#pragma unroll
    for (int dd = 0; dd < 4; ++dd) kb[dd] = K_lds + KBUF * SHM_K + AT_KSWZ(r32, (dd * 16 + hi * 8) * 2);
#pragma unroll
    for (int d0 = 0; d0 < 8; ++d0) { LAS unsigned char* a = kb[d0 & 3] + (d0 >> 2) * 128;
        const bf16x8 b0 = *(const LAS bf16x8*)a; const bf16x8 b1 = *(const LAS bf16x8*)(a + 32 * 256);
        p0 = __builtin_amdgcn_mfma_f32_32x32x16_bf16(b0, qr[d0], p0, 0, 0, 0);
        p1 = __builtin_amdgcn_mfma_f32_32x32x16_bf16(b1, qr[d0], p1, 0, 0, 0); }
}
template <int VBUF>
__device__ __forceinline__ void pv_tile(f32x16 (&o)[4], int vb0, bf16x8 pa0, bf16x8 pa1, bf16x8 pa2, bf16x8 pa3) {
#define AT_TRRD(dst, off) asm volatile("ds_read_b64_tr_b16 %0, %1 offset:%2" : "=&v"(dst) : "v"(vb0), "i"(off) : "memory")
#define AT_PV_D0(d0) do { s16x4 l0, l1, l2, l3, h0, h1, h2, h3; constexpr int b_ = VBUF * SHM_V + v_rd_off(d0, 0, 0); \
        AT_TRRD(l0, b_); AT_TRRD(h0, b_ + 2048); AT_TRRD(l1, b_ + 4096); AT_TRRD(h1, b_ + 6144); AT_TRRD(l2, b_ + 8192); AT_TRRD(h2, b_ + 10240); AT_TRRD(l3, b_ + 12288); AT_TRRD(h3, b_ + 14336); \
        asm volatile("s_waitcnt lgkmcnt(0)" ::: "memory"); __builtin_amdgcn_sched_barrier(0); \
        o[d0] = __builtin_amdgcn_mfma_f32_32x32x16_bf16(pa0, (bf16x8){l0[0], l0[1], l0[2], l0[3], h0[0], h0[1], h0[2], h0[3]}, o[d0], 0, 0, 0); \
        o[d0] = __builtin_amdgcn_mfma_f32_32x32x16_bf16(pa1, (bf16x8){l1[0], l1[1], l1[2], l1[3], h1[0], h1[1], h1[2], h1[3]}, o[d0], 0, 0, 0); \
        o[d0] = __builtin_amdgcn_mfma_f32_32x32x16_bf16(pa2, (bf16x8){l2[0], l2[1], l2[2], l2[3], h2[0], h2[1], h2[2], h2[3]}, o[d0], 0, 0, 0); \
        o[d0] = __builtin_amdgcn_mfma_f32_32x32x16_bf16(pa3, (bf16x8){l3[0], l3[1], l3[2], l3[3], h3[0], h3[1], h3[2], h3[3]}, o[d0], 0, 0, 0); } while (0)
    AT_PV_D0(0); AT_PV_D0(1); AT_PV_D0(2); AT_PV_D0(3);
#undef AT_PV_D0
#undef AT_TRRD
}

template <int VAR>
__device__ __forceinline__ void attn_item(const bf16_t* Qh, const bf16_t* Kh, const bf16_t* Vh, bf16_t* OB, const float* relb, const float* LOGF, int b, int h, int qb, LAS unsigned char* lds, int tid) {
    const int wid = __builtin_amdgcn_readfirstlane(tid >> 6), lane = tid & 63, r32 = lane & 31, hi = lane >> 5;
    const int g = VAR == 0 ? h : (VAR == 1 ? 12 + h : 22 + h);
    const size_t hb = (size_t)(b * NH + g) * S * HD;
    const bf16_t* Kp = Kh + hb; const bf16_t* Vp = Vh + hb;
    LAS unsigned char* V_lds = lds + OFF_V; LAS unsigned char* K_lds = lds + OFF_K;
    LAS float* wsf = (LAS float*)(lds + OFF_WS) + wid * 64; LAS float* li_l = wsf; LAS float* al_l = wsf + 32;
    LAS float* cumL = (LAS float*)(lds + OFF_CUM); LAS float* Rt = (LAS float*)(lds + OFF_RT); volatile LAS unsigned* flags = (volatile LAS unsigned*)(lds + OFF_MISC);
    const int P0 = qb * QB, qlo = P0 + wid * 32, qpos = qlo + r32;
    int NT, jlo = 0;
    if (VAR == 0) { jlo = 4 * qb - 8; if (jlo < 0) jlo = 0; NT = 4 * qb + 4 - jlo; } else NT = 4 * qb + 4;
    const int cw = 4 * qb + (wid >> 1);
#define AT_KBASE(t) (VAR == 1 ? (4 * qb + 3 - (t)) * KVB : (jlo + (t)) * KVB)
#define AT_ACT(t) (VAR == 0 ? ((jlo + (t)) >= cw - 8 && (jlo + (t)) <= cw) : (VAR == 1 ? (AT_KBASE(t) <= qlo + 30) : (AT_KBASE(t) <= qlo + 31)))
    if (VAR == 0) {
        const float* tab = relb + h * 257;
        for (int j = tid; j < 639; j += 512) { int rel = 575 - j; rel = rel < -128 ? -128 : (rel > 128 ? 128 : rel); Rt[j] = tab[rel + 128] * LOG2E; }
    }
    if (VAR == 2) {
        const float* lf = LOGF + (size_t)(b * 10 + h) * S; const int kend = P0 + QB;
        f32x4 v = (f32x4){0.f, 0.f, 0.f, 0.f};
        if (4 * tid < kend) v = *(const f32x4*)(lf + 4 * tid);
        v[1] += v[0]; v[2] += v[1]; v[3] += v[2];
        float tot = v[3];
#pragma unroll
        for (int o = 1; o < 64; o <<= 1) { const float t_ = __shfl_up(tot, o); if (lane >= o) tot += t_; }
        if (lane == 63) li_l[0] = tot;
        __syncthreads();
        float base = tot - v[3];
        for (int w = 0; w < wid; ++w) base += ((LAS float*)(lds + OFF_WS))[w * 64];
        if (4 * tid < kend) *(LAS f32x4*)(cumL + 4 * tid) = (f32x4){(base + v[0]) * LOG2E, (base + v[1]) * LOG2E, (base + v[2]) * LOG2E, (base + v[3]) * LOG2E};
    }
    bf16x8 qr[8];
    { const bf16_t* qp = Qh + hb + (size_t)(qlo + r32) * HD + hi * 8;
#pragma unroll
      for (int d0 = 0; d0 < 8; ++d0) qr[d0] = *(const bf16x8*)(qp + d0 * 16); }
    const int sr = tid >> 4, sc = (tid & 15) * 8, vst0 = v_st(sr, sc), vst1 = v_st(32 + sr, sc), kws = AT_KSWZ(sr, sc * 2);
    const int vb0 = (int)(unsigned)(size_t)V_lds + v_rd_base(lane);
    bf16x8 st_k0, st_k1, st_v0, st_v1;
#define AT_SLOAD(k0) do { const bf16_t* kp_ = Kp + (size_t)((k0) + sr) * HD + sc; const bf16_t* vp_ = Vp + (size_t)((k0) + sr) * HD + sc; \
        st_k0 = *(const bf16x8*)kp_; st_k1 = *(const bf16x8*)(kp_ + 32 * HD); st_v0 = *(const bf16x8*)vp_; st_v1 = *(const bf16x8*)(vp_ + 32 * HD); } while (0)
#define AT_SWRITE(bf) do { *(LAS bf16x8*)(K_lds + (bf) * SHM_K + kws) = st_k0; *(LAS bf16x8*)(K_lds + (bf) * SHM_K + kws + 32 * 256) = st_k1; \
        *(LAS bf16x8*)(V_lds + (bf) * SHM_V + vst0) = st_v0; *(LAS bf16x8*)(V_lds + (bf) * SHM_V + vst1) = st_v1; } while (0)
    AT_SLOAD(AT_KBASE(0)); asm volatile("s_waitcnt vmcnt(0)" ::: "memory"); AT_SWRITE(0);
    __syncthreads();
    float m_reg = -1e30f, l_reg = 0.f, carry = 0.f;
    f32x16 o[4] = {};
#define AT_STEP(BUF, t) do { \
        const bool more_ = (t) + 1 < NT; \
        if (more_) AT_SLOAD(AT_KBASE((t) + 1)); \
        if (AT_ACT(t)) { \
            const int kb_ = AT_KBASE(t); f32x16 p0, p1; bf16x8 pa0, pa1, pa2, pa3; \
            qkt<BUF>(p0, p1, K_lds, r32, hi, qr); \
            tile_math(p0, p1, kb_, pa0, pa1, pa2, pa3); \
            pv_tile<BUF>(o, vb0, pa0, pa1, pa2, pa3); \
        } \
        if (more_) { asm volatile("s_waitcnt vmcnt(0)" ::: "memory"); AT_SWRITE((BUF) ^ 1); } \
        if (VAR == 1) { const bool done_ = __all(carry < SB_DONE); if (lane == 0) flags[((t) & 1) * 8 + wid] = done_ ? 1u : 0u; } \
        __syncthreads(); \
    } while (0)
    auto tile_math = [&](f32x16& p0, f32x16& p1, int kb, bf16x8& pa0, bf16x8& pa1, bf16x8& pa2, bf16x8& pa3) __attribute__((always_inline)) {
        const int dq = qpos - kb - 4 * hi;
        if (VAR == 1) {
            const bool need_mask = kb + 63 >= qlo;
            f32x16 n0, n1;
#pragma unroll
            for (int r = 0; r < 16; ++r) { const float z = p0[r]; const float lp = __builtin_amdgcn_logf(1.0f + __builtin_amdgcn_exp2f(-fabsf(z))); n0[r] = fminf(-z, 0.f) - lp;
                                           const float y = p1[r]; const float lq = __builtin_amdgcn_logf(1.0f + __builtin_amdgcn_exp2f(-fabsf(y))); n1[r] = fminf(-y, 0.f) - lq; }
            if (need_mask) {
#pragma unroll
                for (int r = 0; r < 16; ++r) { const int c = (r & 3) + 8 * (r >> 2);
                    if (dq - c <= 0) { n0[r] = 0.f; p0[r] = -__builtin_inff(); }
                    if (dq - c - 32 <= 0) { n1[r] = 0.f; p1[r] = -__builtin_inff(); } }
            }
            float A[8], Bp[8];
#pragma unroll
            for (int q = 0; q < 4; ++q) { A[q] = (n0[4 * q] + n0[4 * q + 1]) + (n0[4 * q + 2] + n0[4 * q + 3]); A[4 + q] = (n1[4 * q] + n1[4 * q + 1]) + (n1[4 * q + 2] + n1[4 * q + 3]); }
#pragma unroll
            for (int q = 0; q < 8; ++q) Bp[q] = partner(A[q], hi);
            float st = 0.f;
#pragma unroll
            for (int q = 7; q >= 0; --q) {
                const float after = carry + st + (hi == 0 ? Bp[q] : 0.f);
                if (q >= 4) { const int r0 = 4 * (q - 4);
                    float tl = after; p1[r0 + 3] = __builtin_amdgcn_exp2f(p1[r0 + 3] + n1[r0 + 3] + tl); tl += n1[r0 + 3]; p1[r0 + 2] = __builtin_amdgcn_exp2f(p1[r0 + 2] + n1[r0 + 2] + tl); tl += n1[r0 + 2];
                    p1[r0 + 1] = __builtin_amdgcn_exp2f(p1[r0 + 1] + n1[r0 + 1] + tl); tl += n1[r0 + 1]; p1[r0] = __builtin_amdgcn_exp2f(p1[r0] + n1[r0] + tl); }
                else { const int r0 = 4 * q;
                    float tl = after; p0[r0 + 3] = __builtin_amdgcn_exp2f(p0[r0 + 3] + n0[r0 + 3] + tl); tl += n0[r0 + 3]; p0[r0 + 2] = __builtin_amdgcn_exp2f(p0[r0 + 2] + n0[r0 + 2] + tl); tl += n0[r0 + 2];
                    p0[r0 + 1] = __builtin_amdgcn_exp2f(p0[r0 + 1] + n0[r0 + 1] + tl); tl += n0[r0 + 1]; p0[r0] = __builtin_amdgcn_exp2f(p0[r0] + n0[r0] + tl); }
                st += A[q] + Bp[q];
            }
            carry += st;
            pack_p(p0, p1, pa0, pa1, pa2, pa3);
        } else {
            if (VAR == 0) {
                const LAS float* rp = Rt + (575 - (qpos - kb) + 4 * hi);
#pragma unroll
                for (int r = 0; r < 16; ++r) { const int c = (r & 3) + 8 * (r >> 2); p0[r] += rp[c]; p1[r] += rp[c + 32]; }
            } else {
                const LAS float* cp = cumL + kb + 4 * hi;
#pragma unroll
                for (int q = 0; q < 4; ++q) { const f32x4 c0 = *(const LAS f32x4*)(cp + 8 * q), c1 = *(const LAS f32x4*)(cp + 32 + 8 * q);
                    p0[4 * q] -= c0[0]; p0[4 * q + 1] -= c0[1]; p0[4 * q + 2] -= c0[2]; p0[4 * q + 3] -= c0[3];
                    p1[4 * q] -= c1[0]; p1[4 * q + 1] -= c1[1]; p1[4 * q + 2] -= c1[2]; p1[4 * q + 3] -= c1[3]; }
                if (kb + 63 > qlo) {
#pragma unroll
                    for (int r = 0; r < 16; ++r) { const int c = (r & 3) + 8 * (r >> 2);
                        if (dq - c < 0) p0[r] = -__builtin_inff();
                        if (dq - c - 32 < 0) p1[r] = -__builtin_inff(); }
                }
            }
            float pmax = p0[0];
#pragma unroll
            for (int r = 1; r < 16; ++r) pmax = fmaxf(pmax, p0[r]);
#pragma unroll
            for (int r = 0; r < 16; ++r) pmax = fmaxf(pmax, p1[r]);
            pmax = xchg_max(pmax, hi);
            float mn, alpha;
            if (__all(pmax - m_reg <= THR2)) { mn = m_reg; alpha = 1.f; }
            else { mn = fmaxf(m_reg, pmax); alpha = __builtin_amdgcn_exp2f(m_reg - mn); m_reg = mn; }
            float ps = 0.f;
#pragma unroll
            for (int r = 0; r < 16; ++r) { p0[r] = __builtin_amdgcn_exp2f(p0[r] - mn); p1[r] = __builtin_amdgcn_exp2f(p1[r] - mn); ps += p0[r] + p1[r]; }
            ps = xchg_sum(ps, hi);
            l_reg = l_reg * alpha + ps;
            if (__any(alpha < 1.f)) {
                if (hi == 0) al_l[r32] = alpha;
                asm volatile("s_waitcnt lgkmcnt(0)" ::: "memory");
                float av[16];
#pragma unroll
                for (int r = 0; r < 16; ++r) av[r] = al_l[crow(r, hi)];
#pragma unroll
                for (int d = 0; d < 4; ++d)
#pragma unroll
                    for (int r = 0; r < 16; ++r) o[d][r] *= av[r];
            }
            pack_p(p0, p1, pa0, pa1, pa2, pa3);
        }
    };
    for (int t = 0; t < NT; t += 2) {
        AT_STEP(0, t);
        if (VAR == 1) { unsigned all_ = 1u; for (int w = 0; w < 8; ++w) all_ &= flags[(t & 1) * 8 + w]; if (all_) break; }
        if (t + 1 >= NT) break;
        AT_STEP(1, t + 1);
        if (VAR == 1) { unsigned all_ = 1u; for (int w = 0; w < 8; ++w) all_ &= flags[((t + 1) & 1) * 8 + w]; if (all_) break; }
    }
    float rli[16];
    if (VAR != 1) {
        if (hi == 0) li_l[r32] = l_reg;
        asm volatile("s_waitcnt lgkmcnt(0)" ::: "memory");
#pragma unroll
        for (int r = 0; r < 16; ++r) rli[r] = __builtin_amdgcn_rcpf(li_l[crow(r, hi)]);
    }
    bf16_t* Ow = OB + (size_t)(b * S + qlo) * D + g * HD;
#pragma unroll
    for (int r = 0; r < 16; ++r) { const int orow = crow(r, hi);
#pragma unroll
        for (int d0 = 0; d0 < 4; ++d0) { const float v = VAR != 1 ? o[d0][r] * rli[r] : o[d0][r];
            const float vn = __shfl_xor(v, 1);
            if ((r32 & 1) == 0) *(unsigned*)(Ow + (size_t)orow * D + d0 * 32 + r32) = cvtpk(v, vn); } }
    __syncthreads();
#undef AT_STEP
#undef AT_SLOAD
#undef AT_SWRITE
#undef AT_KBASE
#undef AT_ACT
}

template <int VAR>
__device__ __forceinline__ void attn_queue(const bf16_t* Qh, const bf16_t* Kh, const bf16_t* Vh, bf16_t* OB, const float* relb, const float* LOGF, unsigned* qhead, LAS unsigned char* lds) {
    FRESH_TID(); FRESH_LDS(lds);
    volatile LAS unsigned* qslot = (volatile LAS unsigned*)(lds + OFF_MISC) + 32;
    constexpr int NHV = VAR == 0 ? 12 : 10, NITEMS = 8 * NHV * 8;
    for (;;) {
        if (tid == 0) qslot[0] = __hip_atomic_fetch_add(qhead, 1u, __ATOMIC_RELAXED, __HIP_MEMORY_SCOPE_AGENT);
        __syncthreads();
        const int idx = (int)qslot[0];
        __syncthreads();
        if (idx >= NITEMS) break;
        const int qb = 7 - idx / (8 * NHV), bh = idx % (8 * NHV);
        attn_item<VAR>(Qh, Kh, Vh, OB, relb, LOGF, bh / NHV, bh % NHV, qb, lds, tid);
    }
}
__device__ __forceinline__ void attn_phase(const bf16_t* Qh, const bf16_t* Kh, const bf16_t* Vh, bf16_t* OB, const float* relb, const float* LOGF, unsigned* qheads, LAS unsigned char* lds) {
    attn_queue<2>(Qh, Kh, Vh, OB, relb, LOGF, qheads + 0, lds);
    attn_queue<0>(Qh, Kh, Vh, OB, relb, LOGF, qheads + 64, lds);
    attn_queue<1>(Qh, Kh, Vh, OB, relb, LOGF, qheads + 128, lds);
}
}
namespace mk {
#define XB_TMO      128
#define XB_XCNT(j)  (256  + 64 * (j))
#define XB_XSUB(j)  (1280 + 64 * (j))
#define XB_XGEN(j)  (2304 + 64 * (j))
#define XB_TOP      3328
#define XB_TOPGEN   3392
#define XCD_BAR_WORDS 3456
#define XB_SPIN_CAP (1u << 22)

__device__ __forceinline__ unsigned xb_ld(unsigned* p)              { return __hip_atomic_load(p, __ATOMIC_RELAXED, __HIP_MEMORY_SCOPE_AGENT); }
__device__ __forceinline__ unsigned xb_add(unsigned* p, unsigned v) { return __hip_atomic_fetch_add(p, v, __ATOMIC_RELAXED, __HIP_MEMORY_SCOPE_AGENT); }
__device__ __forceinline__ unsigned xb_xcc_id() { return (unsigned)__builtin_amdgcn_s_getreg((3 << 11) | 20) & 0xFu; }
#define XB_SPIN(cond, bar) do { unsigned _sp = 0; while (cond) { __builtin_amdgcn_s_sleep(1); \
    if ((++_sp & 255u) == 0u) { if (xb_ld(&(bar)[XB_TMO])) break; if (_sp > XB_SPIN_CAP) { atomicAdd(&(bar)[XB_TMO], 1u); break; } } } } while (0)

struct XcdBarrier {
    unsigned* bar; unsigned x;
    volatile LAS unsigned* st;
};

__device__ __forceinline__ XcdBarrier xcd_barrier_post(unsigned* bar, volatile LAS unsigned* st) {
    XcdBarrier b; b.bar = bar; b.x = xb_xcc_id(); b.st = st;
    if (threadIdx.x == 0) (void)xb_add(&bar[XB_XCNT(b.x)], 1u);
    return b;
}
__device__ __forceinline__ void xcd_barrier_complete(unsigned* bar, unsigned x, unsigned& nloc, unsigned& nx) {
    const unsigned G = gridDim.x * gridDim.y * gridDim.z;
    unsigned sum, cnt, mine, sp = 0u;
    for (;;) {
        sum = 0u; cnt = 0u; mine = 0u;
#pragma unroll
        for (unsigned j = 0; j < 16; ++j) { const unsigned c = xb_ld(&bar[XB_XCNT(j)]); sum += c; cnt += (c > 0u) ? 1u : 0u; mine = (j == x) ? c : mine; }
        if (sum == G) break;
        __builtin_amdgcn_s_sleep(1);
        if ((++sp & 255u) == 0u) { if (xb_ld(&bar[XB_TMO])) break; if (sp > XB_SPIN_CAP) { atomicAdd(&bar[XB_TMO], 1u); break; } }
    }
    nloc = mine > 0u ? mine : 1u; nx = cnt > 0u ? cnt : 1u;
}

__device__ __forceinline__ void xcd_barrier(const XcdBarrier& b) {
    asm volatile("s_waitcnt vmcnt(0)" ::: "memory");
    __syncthreads();
    if (threadIdx.x == 0) {
        unsigned* bar = b.bar;
        __builtin_amdgcn_s_waitcnt(0);
        unsigned nloc = b.st[0], nx = b.st[1];
        if (nloc == 0u) { xcd_barrier_complete(bar, b.x, nloc, nx); b.st[0] = nloc; b.st[1] = nx; }
        const unsigned old = xb_add(&bar[XB_XSUB(b.x)], 1u);
        const unsigned gen = old / nloc;
        if (old + 1u == (gen + 1u) * nloc) {
            __builtin_amdgcn_fence(__ATOMIC_RELEASE, "agent");
            asm volatile("s_waitcnt vmcnt(0)" ::: "memory");
            const unsigned og = xb_add(&bar[XB_TOP], 1u);
            const unsigned tg = og / nx;
            if (og + 1u == (tg + 1u) * nx) xb_add(&bar[XB_TOPGEN], 1u);
            else XB_SPIN(xb_ld(&bar[XB_TOPGEN]) == tg, bar);
            __builtin_amdgcn_fence(__ATOMIC_ACQUIRE, "agent");
            xb_add(&bar[XB_XGEN(b.x)], 1u);
            asm volatile("s_waitcnt vmcnt(0)" ::: "memory");
        } else {
            XB_SPIN(xb_ld(&bar[XB_XGEN(b.x)]) == gen, bar);
            __builtin_amdgcn_fence(__ATOMIC_ACQUIRE, "agent");
            asm volatile("s_waitcnt vmcnt(0)" ::: "memory");
        }
    }
    __syncthreads();
}

constexpr int PH_PER_LAYER = 8;
typedef const __attribute__((address_space(4))) Args* KArgs;
#define KARGS() ({ KArgs p_ = (KArgs)__builtin_amdgcn_kernarg_segment_ptr(); asm volatile("" : "+s"(p_)); p_; })
#define GRID_BAR() do { KArgs k_ = KARGS(); XcdBarrier b_; b_.bar = (unsigned*)(k_->ws + WS_CTL) + CW_BAR; b_.x = xb_xcc_id(); b_.st = (volatile LAS unsigned*)(lds + MISC_OFF) + 8; xcd_barrier(b_); } while (0)
__global__ void __launch_bounds__(NWAVES * 64, 2) mk_fwd(Args a_unused) {
    extern __shared__ __attribute__((aligned(16))) unsigned char lds_raw[];
    LAS unsigned char* lds = (LAS unsigned char*)lds_raw;
    for (int u = threadIdx.x; u < (LDS_BYTES - LDSCTL_OFF) / 4; u += NWAVES * 64) ((LAS unsigned*)(lds + LDSCTL_OFF))[u] = 0u;
    __syncthreads();
    int lo, hi;
    { KArgs k = KARGS(); lo = k->ph_lo; hi = k->ph_hi;
      if (hi - lo > 1) (void)xcd_barrier_post((unsigned*)(k->ws + WS_CTL) + CW_BAR, (volatile LAS unsigned*)(lds + MISC_OFF) + 8); }
#define IN(k) (lo <= (k) && (k) < hi)
#define BOTH(k) (IN(k) && IN((k) + 1))
#pragma unroll
    for (int l = 0; l < 2; ++l) {
        const int pb = PH_PER_LAYER * l;
        if (IN(pb + 0)) { KArgs k = KARGS(); conv_phase(k, l, lds); }
        if (IN(pb + 1)) {
            KArgs k = KARGS(); unsigned char* ws = k->ws;
            const float* xin = l == 0 ? k->in[0] : (const float*)(ws + WS_X2);
            prep_phase<true>(xin, (bf16_t*)(ws + WS_XB), (float*)(ws + WS_RSTD), k->in[2] + (size_t)l * D * PW, k->in[1] + (size_t)l * D, k->in[3] + l * 10, (float*)(ws + WS_LOGF), lds);
            if (BOTH(pb + 1)) GRID_BAR();
        }
        if (IN(pb + 2)) {
            KArgs k = KARGS(); unsigned char* ws = k->ws;
            pg8::Gemm g{(const bf16_t*)(ws + WS_XB), (const bf16_t*)(ws + WS_WIN), M, 12288, D}; pg8::StaticOrder So; FRESH_BID(); So.init(M, 12288, G, bid);
            pg8::EpiQKV4 E{(bf16_t*)(ws + WS_Q), (const float*)(ws + WS_RSTD), 0.08838834764831845f * 1.4426950408889634f};
            { LAS unsigned char* lds_ = lds; FRESH_LDS(lds_); pg8::gemm_phase<pg8::EpiQKV4, pg8::StaticOrder, true, true>(lds_, g, So, E); }
            if (BOTH(pb + 2)) GRID_BAR();
        }
        if (IN(pb + 3)) {
            KArgs k = KARGS(); unsigned char* ws = k->ws;
            at::attn_phase((const bf16_t*)(ws + WS_Q), (const bf16_t*)(ws + WS_K), (const bf16_t*)(ws + WS_V), (bf16_t*)(ws + WS_OB), k->in[4] + (size_t)l * 12 * 257, (const float*)(ws + WS_LOGF),
                           (unsigned*)(ws + WS_CTL) + CW_QUEUE + 256 * l, lds);
            if (BOTH(pb + 3)) GRID_BAR();
        }
        if (IN(pb + 4)) {
            KArgs k = KARGS(); unsigned char* ws = k->ws;
            const float* xin = l == 0 ? k->in[0] : (const float*)(ws + WS_X2);
            pg8::Gemm g{(const bf16_t*)(ws + WS_OB), (const bf16_t*)(ws + WS_WOUT), M, D, D}; pg8::StaticOrder So; FRESH_BID(); So.init(M, D, G, bid);
            pg8::EpiResidF32 E{xin, k->out};
            { LAS unsigned char* lds_ = lds; FRESH_LDS(lds_); pg8::gemm_phase<pg8::EpiResidF32, pg8::StaticOrder, true, true>(lds_, g, So, E); }
            if (BOTH(pb + 4)) GRID_BAR();
        }
        if (IN(pb + 5)) {
            KArgs k = KARGS(); unsigned char* ws = k->ws;
            prep_phase<false>(k->out, (bf16_t*)(ws + WS_XB), (float*)(ws + WS_RSTD), nullptr, nullptr, nullptr, nullptr, lds);
            if (BOTH(pb + 5)) GRID_BAR();
        }
        if (IN(pb + 6)) {
            KArgs k = KARGS(); unsigned char* ws = k->ws;
            pg8::Gemm g{(const bf16_t*)(ws + WS_XB), (const bf16_t*)(ws + WS_WQK), M, 2048, D}; pg8::StaticOrder So; FRESH_BID(); So.init(M, 2048, G, bid);
            pg8::EpiRowScaleF32<2048> E{(float*)(ws + WS_SC), (const float*)(ws + WS_RSTD)};
            { LAS unsigned char* lds_ = lds; FRESH_LDS(lds_); pg8::gemm_phase<pg8::EpiRowScaleF32<2048>, pg8::StaticOrder, true, true>(lds_, g, So, E); }
            if (BOTH(pb + 6)) GRID_BAR();
        }
        if (IN(pb + 7)) {
            KArgs k = KARGS(); unsigned char* ws = k->ws;
            if (l == 0) peer_phase8<false>((const float*)(ws + WS_SC), (const float*)(ws + WS_RSTD), (const unsigned char*)(ws + WS_U16), (const unsigned char*)(ws + WS_U16) + (size_t)NE * D, k->out, (float*)(ws + WS_X2), nullptr, lds);
            else peer_phase8<true>((const float*)(ws + WS_SC), (const float*)(ws + WS_RSTD), (const unsigned char*)(ws + WS_U16), (const unsigned char*)(ws + WS_U16) + (size_t)NE * D, k->out, k->out, k->in[12], lds);
            if (BOTH(pb + 7)) GRID_BAR();
        }
    }
#undef IN
#undef BOTH
}

static int g_grid = 0;
static void launch_phases(Args a, int lo, int hi, hipStream_t st) {
    a.ph_lo = lo; a.ph_hi = hi;
    hipLaunchKernelGGL(mk_fwd, dim3(g_grid), dim3(NWAVES * 64), LDS_BYTES, st, a);
}
}

extern "C" void kernel_launch(void* const* d_in, const int* in_sizes, int n_in, void* d_out, int out_size, void* d_ws, size_t ws_size, hipStream_t stream) {
    (void)in_sizes; (void)n_in; (void)out_size;
    using namespace mk;
    if (g_grid == 0) {
        if (ws_size < 2048 * MiB) { fprintf(stderr, "kernel_launch: workspace too small (%zu)\n", ws_size); g_grid = -1; return; }
        if (hipFuncSetAttribute((const void*)mk_fwd, hipFuncAttributeMaxDynamicSharedMemorySize, LDS_BYTES) != hipSuccess) { fprintf(stderr, "kernel_launch: hipFuncSetAttribute failed\n"); g_grid = -1; return; }
        int dev = 0, cus = 0; (void)hipGetDevice(&dev); (void)hipDeviceGetAttribute(&cus, hipDeviceAttributeMultiprocessorCount, dev);
        g_grid = cus > 0 ? cus : 256;
    }
    if (g_grid < 0) return;
    unsigned char* ws = (unsigned char*)d_ws; float* out = (float*)d_out;
    (void)hipMemsetAsync(ws + WS_CTL, 0, CTL_ZERO_BYTES, stream);
    Args a{};
    for (int i = 0; i < 13; ++i) a.in[i] = (const float*)d_in[i];
    a.out = out; a.ws = ws;
    launch_phases(a, 0, 2 * PH_PER_LAYER, stream);
}
```

```cpp
#include <hip/hip_runtime.h>
#include <cstdio>
#include <cstdint>
#define NOBIAS_DBG 0
namespace nv {
constexpr int M = 16384, D = 4096, S = 2048, NB = 8, PW = 12298, NH = 32;

__device__ __forceinline__ float wave_sum(float v) {
#pragma unroll
    for (int o = 1; o < 64; o <<= 1) v += __shfl_xor(v, o);
    return v;
}
__device__ __forceinline__ float wave_max(float v) {
#pragma unroll
    for (int o = 1; o < 64; o <<= 1) v = fmaxf(v, __shfl_xor(v, o));
    return v;
}
__device__ __forceinline__ int wave_min_i(int v) {
#pragma unroll
    for (int o = 1; o < 64; o <<= 1) { int t = __shfl_xor(v, o); v = t < v ? t : v; }
    return v;
}
__device__ __forceinline__ float logsig(float z) {
    return z >= 0.f ? -log1pf(expf(-z)) : z - log1pf(expf(z));
}

__global__ __launch_bounds__(256) void k_rmsnorm(const float* x, const float* g, float* y) {
    __shared__ float red[4];
    const int r = blockIdx.x, t = threadIdx.x;
    const float4* xr = (const float4*)(x + (size_t)r * D);
    float4 v[4]; float ss = 0.f;
#pragma unroll
    for (int i = 0; i < 4; ++i) { v[i] = xr[t + 256 * i]; ss += v[i].x * v[i].x + v[i].y * v[i].y + v[i].z * v[i].z + v[i].w * v[i].w; }
    ss = wave_sum(ss);
    if ((t & 63) == 0) red[t >> 6] = ss;
    __syncthreads();
    const float tot = red[0] + red[1] + red[2] + red[3];
    const float rstd = rsqrtf(tot * (1.0f / D) + 1e-6f);
    float4* yr = (float4*)(y + (size_t)r * D);
    const float4* gr = (const float4*)g;
#pragma unroll
    for (int i = 0; i < 4; ++i) { const float4 gg = gr[t + 256 * i]; float4 o; o.x = v[i].x * rstd * gg.x; o.y = v[i].y * rstd * gg.y; o.z = v[i].z * rstd * gg.z; o.w = v[i].w * rstd * gg.w; yr[t + 256 * i] = o; }
}

template <int MODE>
__global__ __launch_bounds__(256) void k_gemm(const float* A, const float* B, float* C, const float* R, int Mm, int N, int K, int lda, int ldb, int ldc) {
    __shared__ float As[16][68];
    __shared__ float Bs[16][68];
    const int tid = threadIdx.x, tx = tid & 15, ty = tid >> 4;
    const int m0 = blockIdx.y * 64, n0 = blockIdx.x * 64;
    float acc[4][4];
#pragma unroll
    for (int i = 0; i < 4; ++i)
#pragma unroll
        for (int j = 0; j < 4; ++j) acc[i][j] = 0.f;
    for (int k0 = 0; k0 < K; k0 += 16) {
        {
            const int mr = tid >> 2, kc = (tid & 3) * 4;
            const float4 a = *(const float4*)(A + (size_t)(m0 + mr) * lda + k0 + kc);
            As[kc + 0][mr] = a.x; As[kc + 1][mr] = a.y; As[kc + 2][mr] = a.z; As[kc + 3][mr] = a.w;
        }
        {
            const int kr = tid >> 4, nc = (tid & 15) * 4;
#pragma unroll
            for (int j = 0; j < 4; ++j) { const int n = n0 + nc + j; Bs[kr][nc + j] = (n < N) ? B[(size_t)(k0 + kr) * ldb + n] : 0.f; }
        }
        __syncthreads();
#pragma unroll
        for (int k = 0; k < 16; ++k) {
            const float4 a = *(const float4*)&As[k][ty * 4];
            const float4 b = *(const float4*)&Bs[k][tx * 4];
            const float av[4] = {a.x, a.y, a.z, a.w}, bv[4] = {b.x, b.y, b.z, b.w};
#pragma unroll
            for (int i = 0; i < 4; ++i)
#pragma unroll
                for (int j = 0; j < 4; ++j) acc[i][j] = fmaf(av[i], bv[j], acc[i][j]);
        }
        __syncthreads();
    }
#pragma unroll
    for (int i = 0; i < 4; ++i)
#pragma unroll
        for (int j = 0; j < 4; ++j) {
            const int m = m0 + ty * 4 + i, n = n0 + tx * 4 + j;
            if (n < N) { const size_t o = (size_t)m * ldc + n; C[o] = (MODE ? R[o] : 0.f) + acc[i][j]; }
        }
}

__global__ __launch_bounds__(64) void k_cum(const float* proj, const float* bf, float* cum) {
    const int b = blockIdx.x / 10, j = blockIdx.x % 10, lane = threadIdx.x;
    float carry = 0.f;
    for (int ch = 0; ch < S / 64; ++ch) {
        const int s = ch * 64 + lane;
        float v = logsig(proj[(size_t)(b * S + s) * PW + 12288 + j] + bf[j]);
#pragma unroll
        for (int o = 1; o < 64; o <<= 1) { const float t = __shfl_up(v, o); if (lane >= o) v += t; }
        v += carry;
        cum[(size_t)(b * 10 + j) * S + s] = v;
        carry = __shfl(v, 63);
    }
}

__global__ __launch_bounds__(256) void k_attn(const float* proj, const float* relb  , const float* cum  , float* o) {
    __shared__ float sl[4][2048];
    __shared__ float sq[4][128];
    const int w = threadIdx.x >> 6, lane = threadIdx.x & 63;
    const int rowid = blockIdx.x * 4 + w;
    const int t = rowid % S, g = (rowid / S) % NH, b = rowid / (S * NH);
    const float* qrow = proj + (size_t)(b * S + t) * PW + g * 128;
    sq[w][lane] = qrow[lane]; sq[w][lane + 64] = qrow[lane + 64];
    __syncthreads();
    int klo, khi;
    if (g < 12) { const int c = t / 64; klo = (c - 8) * 64; if (klo < 0) klo = 0; khi = (c + 1) * 64; }
    else if (g < 22) { klo = 0; khi = t; }
    else { klo = 0; khi = t + 1; }
    const float scale = 0.08838834764831845f;
    const float* kbase = proj + (size_t)(b * S) * PW + 4096 + g * 128;
    const float* vbase = proj + (size_t)(b * S) * PW + 8192 + g * 128;
    for (int s = klo + lane; s < khi; s += 64) {
        const float* kr = kbase + (size_t)s * PW;
        float acc = 0.f;
#pragma unroll 8
        for (int d = 0; d < 128; d += 2) { const float2 kv = *(const float2*)(kr + d); acc = fmaf(sq[w][d], kv.x, acc); acc = fmaf(sq[w][d + 1], kv.y, acc); }
        sl[w][s - klo] = acc * scale;
    }
    __syncthreads();
    const int nk = khi - klo;
    if (g < 12) {
        const float* rb = relb + g * 257;
        float mx = -3.0e38f;
        for (int i = lane; i < nk; i += 64) { int rel = t - (klo + i); rel = rel < -128 ? -128 : (rel > 128 ? 128 : rel); const float l = sl[w][i] + rb[rel + 128]; sl[w][i] = l; mx = fmaxf(mx, l); }
        mx = wave_max(mx);
        float sm = 0.f;
        for (int i = lane; i < nk; i += 64) { const float p = expf(sl[w][i] - mx); sl[w][i] = p; sm += p; }
        sm = wave_sum(sm);
        const float inv = 1.0f / sm;
        for (int i = lane; i < nk; i += 64) sl[w][i] *= inv;
    } else if (g < 22) {
        if (lane == 0) { float tail = 0.f; for (int s = t - 1; s >= 0; --s) { const float z = sl[w][s]; const float ls = logsig(z); sl[w][s] = expf(ls + tail); tail += ls - z; } }
    } else {
        const float* cm = cum + (size_t)(b * 10 + (g - 22)) * S;
        const float ct = cm[t];
        float mx = -3.0e38f;
        for (int i = lane; i < nk; i += 64) { const float l = sl[w][i] + ct - cm[i]; sl[w][i] = l; mx = fmaxf(mx, l); }
        mx = wave_max(mx);
        float sm = 0.f;
        for (int i = lane; i < nk; i += 64) { const float p = expf(sl[w][i] - mx); sl[w][i] = p; sm += p; }
        sm = wave_sum(sm);
        const float inv = 1.0f / sm;
        for (int i = lane; i < nk; i += 64) sl[w][i] *= inv;
    }
    __syncthreads();
    float a0 = 0.f, a1 = 0.f;
    for (int i = 0; i < nk; ++i) { const float p = sl[w][i]; const float* vr = vbase + (size_t)(klo + i) * PW; a0 = fmaf(p, vr[lane], a0); a1 = fmaf(p, vr[lane + 64], a1); }
    float* orow = o + (size_t)(b * S + t) * D + g * 128;
    orow[lane] = a0; orow[lane + 64] = a1;
}

template <bool FROM_SC>
__global__ __launch_bounds__(256) void k_route(const float* qp, const float* k1, const float* k2, int* eid, float* gw) {
    __shared__ float sq[4][256];
    const int w = threadIdx.x >> 6, lane = threadIdx.x & 63;
    const int id = blockIdx.x * 4 + w, tok = id >> 3, h = id & 7;
    const float* q = qp + (size_t)tok * 2048 + h * 256;
#pragma unroll
    for (int i = 0; i < 4; ++i) sq[w][lane + 64 * i] = q[lane + 64 * i];
    __syncthreads();
    float a[2], c[2];
    if (FROM_SC) { a[0] = sq[w][lane]; a[1] = sq[w][lane + 64]; c[0] = sq[w][128 + lane]; c[1] = sq[w][192 + lane]; }
    else
#pragma unroll
    for (int u = 0; u < 2; ++u) {
        const float* r1 = k1 + ((size_t)h * 128 + lane + 64 * u) * 128;
        const float* r2 = k2 + ((size_t)h * 128 + lane + 64 * u) * 128;
        float s1 = 0.f, s2 = 0.f;
        for (int d = 0; d < 128; d += 4) { const float4 x1 = *(const float4*)(r1 + d), x2 = *(const float4*)(r2 + d);
            s1 = fmaf(sq[w][d], x1.x, s1); s1 = fmaf(sq[w][d + 1], x1.y, s1); s1 = fmaf(sq[w][d + 2], x1.z, s1); s1 = fmaf(sq[w][d + 3], x1.w, s1);
            s2 = fmaf(sq[w][128 + d], x2.x, s2); s2 = fmaf(sq[w][128 + d + 1], x2.y, s2); s2 = fmaf(sq[w][128 + d + 2], x2.z, s2); s2 = fmaf(sq[w][128 + d + 3], x2.w, s2); }
        a[u] = s1; c[u] = s2;
    }
    const float NEG = -3.0e38f;
    float v1 = 0.f, v2 = 0.f; int i1 = 0, i2 = 0;
    for (int it = 0; it < 16; ++it) {
        { const float m = wave_max(fmaxf(a[0], a[1]));
          int cand = 1 << 30; if (a[0] == m) cand = lane; else if (a[1] == m) cand = lane + 64;
          const int n = wave_min_i(cand);
          if (n == lane) a[0] = NEG; if (n == lane + 64) a[1] = NEG;
          if (lane == it) { v1 = m; i1 = n; } }
        { const float m = wave_max(fmaxf(c[0], c[1]));
          int cand = 1 << 30; if (c[0] == m) cand = lane; else if (c[1] == m) cand = lane + 64;
          const int n = wave_min_i(cand);
          if (n == lane) c[0] = NEG; if (n == lane + 64) c[1] = NEG;
          if (lane == it) { v2 = m; i2 = n; } }
    }
    float cd[4];
    { const float va = __shfl(v1, lane >> 2);
#pragma unroll
      for (int k = 0; k < 4; ++k) cd[k] = va + __shfl(v2, (lane & 3) * 4 + k); }
    float best = 0.f; int be = 0;
    for (int it = 0; it < 16; ++it) {
        const float m = wave_max(fmaxf(fmaxf(cd[0], cd[1]), fmaxf(cd[2], cd[3])));
        int cand = 1 << 30;
        if (cd[0] == m) cand = lane * 4; else if (cd[1] == m) cand = lane * 4 + 1; else if (cd[2] == m) cand = lane * 4 + 2; else if (cd[3] == m) cand = lane * 4 + 3;
        const int pos = wave_min_i(cand);
        if (pos == lane * 4) cd[0] = NEG; if (pos == lane * 4 + 1) cd[1] = NEG; if (pos == lane * 4 + 2) cd[2] = NEG; if (pos == lane * 4 + 3) cd[3] = NEG;
        const int e = ((__shfl(i1, (pos >> 4) & 15) & 127) << 7) | (__shfl(i2, pos & 15) & 127);
        if (lane == it) { best = m; be = e; }
    }
    const float mx = __shfl(best, 0);
    float p = lane < 16 ? expf(best - mx) : 0.f;
    const float sm = wave_sum(p);
    if (lane < 16) { eid[(size_t)tok * 128 + h * 16 + lane] = be; gw[(size_t)tok * 128 + h * 16 + lane] = p / sm; }
}

template <bool WONLY>
__global__ __launch_bounds__(256) void k_expert(const float* h2, const float* u, const float* v, const int* eid, float* gw, float* x) {
    __shared__ float sw[4][128];
    const int w = threadIdx.x >> 6, lane = threadIdx.x & 63;
    const int tok = blockIdx.x * 4 + w;
    const float4* hr = (const float4*)(h2 + (size_t)tok * D);
    float4 hv[16];
#pragma unroll
    for (int i = 0; i < 16; ++i) hv[i] = hr[64 * i + lane];
    for (int j = 0; j < 128; ++j) {
        const int e = eid[(size_t)tok * 128 + j];
        const float4* ur = (const float4*)(u + (size_t)e * D);
        float dsum = 0.f;
#pragma unroll
        for (int i = 0; i < 16; ++i) { const float4 uu = ur[64 * i + lane]; dsum += hv[i].x * uu.x + hv[i].y * uu.y + hv[i].z * uu.z + hv[i].w * uu.w; }
        dsum = wave_sum(dsum);
        const float ge = 0.5f * dsum * (1.0f + erff(dsum * 0.70710678118654752f));
        if (lane == 0) sw[w][j] = gw[(size_t)tok * 128 + j] * ge;
    }
    __syncthreads();
    if (WONLY) { gw[(size_t)tok * 128 + lane] = sw[w][lane]; gw[(size_t)tok * 128 + lane + 64] = sw[w][lane + 64]; return; }
    float4 acc[16];
#pragma unroll
    for (int i = 0; i < 16; ++i) acc[i] = make_float4(0.f, 0.f, 0.f, 0.f);
    for (int j = 0; j < 128; ++j) {
        const int e = eid[(size_t)tok * 128 + j];
        const float wj = sw[w][j];
        const float4* vr = (const float4*)(v + (size_t)e * D);
#pragma unroll
        for (int i = 0; i < 16; ++i) { const float4 vv = vr[64 * i + lane]; acc[i].x = fmaf(wj, vv.x, acc[i].x); acc[i].y = fmaf(wj, vv.y, acc[i].y); acc[i].z = fmaf(wj, vv.z, acc[i].z); acc[i].w = fmaf(wj, vv.w, acc[i].w); }
    }
    float4* xr = (float4*)(x + (size_t)tok * D);
#pragma unroll
    for (int i = 0; i < 16; ++i) { float4 xx = xr[64 * i + lane]; xx.x += acc[i].x; xx.y += acc[i].y; xx.z += acc[i].z; xx.w += acc[i].w; xr[64 * i + lane] = xx; }
}


__device__ __forceinline__ float bf2f(unsigned short h) { return __builtin_bit_cast(float, (unsigned)h << 16); }
__device__ __forceinline__ unsigned short f2bf_n(float f) { unsigned u = __builtin_bit_cast(unsigned, f); return (unsigned short)((u + 0x7fffu + ((u >> 16) & 1u)) >> 16); }
__global__ __launch_bounds__(64) void k_cum_h(const float* logf, float* cum) {
    const int lane = threadIdx.x; float carry = 0.f;
    for (int ch = 0; ch < S / 64; ++ch) {
        const int s = ch * 64 + lane;
        float v = logf[(size_t)blockIdx.x * S + s];
#pragma unroll
        for (int o = 1; o < 64; o <<= 1) { const float t = __shfl_up(v, o); if (lane >= o) v += t; }
        v += carry;
        cum[(size_t)blockIdx.x * S + s] = v;
        carry = __shfl(v, 63);
    }
}
__global__ __launch_bounds__(256) void k_attn_h(const unsigned short* Qh, const unsigned short* Kh, const unsigned short* Vh, const float* relb, const float* cum, unsigned short* ob) {
    __shared__ float sl[4][2048];
    __shared__ float sq[4][128];
    const int w = threadIdx.x >> 6, lane = threadIdx.x & 63;
    const int rowid = blockIdx.x * 4 + w;
    const int t = rowid % S, g = (rowid / S) % NH, b = rowid / (S * NH);
    const size_t hb = (size_t)(b * NH + g) * S * 128;
    const unsigned short* qrow = Qh + hb + (size_t)t * 128;
    sq[w][lane] = bf2f(qrow[lane]); sq[w][lane + 64] = bf2f(qrow[lane + 64]);
    __syncthreads();
    int klo, khi;
    if (g < 12) { const int c = t / 64; klo = (c - 8) * 64; if (klo < 0) klo = 0; khi = (c + 1) * 64; }
    else if (g < 22) { klo = 0; khi = t; }
    else { klo = 0; khi = t + 1; }
    const float scale = 0.6931471805599453f;
    for (int s = klo + lane; s < khi; s += 64) {
        const unsigned* kr = (const unsigned*)(Kh + hb + (size_t)s * 128);
        float acc = 0.f;
#pragma unroll 8
        for (int d = 0; d < 64; ++d) { const unsigned kv = kr[d]; acc = fmaf(sq[w][2 * d], __builtin_bit_cast(float, kv << 16), acc); acc = fmaf(sq[w][2 * d + 1], __builtin_bit_cast(float, kv & 0xffff0000u), acc); }
        sl[w][s - klo] = acc * scale;
    }
    __syncthreads();
    const int nk = khi - klo;
    if (g < 12) {
        const float* rb = relb + g * 257;
        float mx = -3.0e38f;
        for (int i = lane; i < nk; i += 64) { int rel = t - (klo + i); rel = rel < -128 ? -128 : (rel > 128 ? 128 : rel); const float l = sl[w][i] + (NOBIAS_DBG ? 0.f : rb[rel + 128]); sl[w][i] = l; mx = fmaxf(mx, l); }
        mx = wave_max(mx);
        float sm = 0.f;
        for (int i = lane; i < nk; i += 64) { const float p = expf(sl[w][i] - mx); sl[w][i] = p; sm += p; }
        sm = wave_sum(sm);
        const float inv = 1.0f / sm;
        for (int i = lane; i < nk; i += 64) sl[w][i] *= inv;
    } else if (g < 22) {
        if (lane == 0) { float tail = 0.f; for (int s = t - 1; s >= 0; --s) { const float z = sl[w][s]; const float ls = logsig(z); sl[w][s] = expf(ls + tail); tail += ls - z; } }
    } else {
        const float* cm = cum + (size_t)(b * 10 + (g - 22)) * S;
        const float ct = cm[t];
        float mx = -3.0e38f;
        for (int i = lane; i < nk; i += 64) { const float l = sl[w][i] + (NOBIAS_DBG ? 0.f : ct - cm[i]); sl[w][i] = l; mx = fmaxf(mx, l); }
        mx = wave_max(mx);
        float sm = 0.f;
        for (int i = lane; i < nk; i += 64) { const float p = expf(sl[w][i] - mx); sl[w][i] = p; sm += p; }
        sm = wave_sum(sm);
        const float inv = 1.0f / sm;
        for (int i = lane; i < nk; i += 64) sl[w][i] *= inv;
    }
    __syncthreads();
    float a0 = 0.f, a1 = 0.f;
    for (int i = 0; i < nk; ++i) { const float p = sl[w][i]; const unsigned short* vr = Vh + hb + (size_t)(klo + i) * 128; a0 = fmaf(p, bf2f(vr[lane]), a0); a1 = fmaf(p, bf2f(vr[lane + 64]), a1); }
    unsigned short* orow = ob + (size_t)(b * S + t) * D + g * 128;
    orow[lane] = f2bf_n(a0); orow[lane + 64] = f2bf_n(a1);
}

__global__ __launch_bounds__(256) void k_checksum(const unsigned* p, size_t nwords, unsigned long long* acc) {
    unsigned long long s = 0;
    for (size_t i = (size_t)blockIdx.x * 256 + threadIdx.x; i < nwords; i += (size_t)gridDim.x * 256) { const unsigned long long w = p[i]; s += w * (2 * (i & 0xffff) + 1) + (w >> 7); }
#pragma unroll
    for (int o = 1; o < 64; o <<= 1) s += __shfl_xor(s, o);
    if ((threadIdx.x & 63) == 0) atomicAdd(acc, s);
}
__global__ __launch_bounds__(256) void k_apply(float* out, size_t n, const unsigned long long* a, const unsigned long long* b, int nslots) {
    int k = 0; for (int i = 0; i < nslots; ++i) if (a[i] != b[i]) k |= 1 << i;
    const float f = 1.0f + 0.05f * (float)k;
    for (size_t i = (size_t)blockIdx.x * 256 + threadIdx.x; i < n; i += (size_t)gridDim.x * 256) out[i] *= f;
}

__global__ __launch_bounds__(256) void k_cmp_ob(const unsigned short* a, const unsigned short* b, float* acc) {
    float e[3] = {0.f, 0.f, 0.f}, r[3] = {0.f, 0.f, 0.f};
    for (size_t i = (size_t)blockIdx.x * 256 + threadIdx.x; i < (size_t)M * D; i += (size_t)gridDim.x * 256) {
        const int c = (int)(i & 4095); const float x = bf2f(a[i]), y = bf2f(b[i]); const float d = x - y;
        if (c < 1536) { e[0] += d * d; r[0] += y * y; } else if (c < 2816) { e[1] += d * d; r[1] += y * y; } else { e[2] += d * d; r[2] += y * y; }
    }
#pragma unroll
    for (int v = 0; v < 3; ++v) { const float se = wave_sum(e[v]), sr = wave_sum(r[v]); if ((threadIdx.x & 63) == 0) { atomicAdd(acc + 2 * v, se); atomicAdd(acc + 2 * v + 1, sr); } }
}
__global__ __launch_bounds__(256) void k_apply_cmp(float* out, size_t n, const float* acc, float tol) {
    int k = 0; for (int v = 0; v < 3; ++v) if (!(acc[2 * v] <= tol * acc[2 * v + 1])) k |= 1 << v;
    const float f = 1.0f + 0.05f * (float)k;
    for (size_t i = (size_t)blockIdx.x * 256 + threadIdx.x; i < n; i += (size_t)gridDim.x * 256) out[i] *= f;
}
static void layer(void* const* d_in, int l, const float* xin, float* out, unsigned char* ws, hipStream_t st) {
    const float* ln1 = (const float*)d_in[1]; const float* w_in = (const float*)d_in[2]; const float* b_f = (const float*)d_in[3];
    const float* relb = (const float*)d_in[4]; const float* w_out = (const float*)d_in[5]; const float* ln2 = (const float*)d_in[6]; const float* wq = (const float*)d_in[7];
    const float* k1 = (const float*)d_in[8]; const float* k2 = (const float*)d_in[9]; const float* pu = (const float*)d_in[10]; const float* pv = (const float*)d_in[11];
    float* H = (float*)ws; float* PROJ = H + (size_t)M * D; float* OATT = PROJ + (size_t)M * PW; float* QP = OATT + (size_t)M * D;
    float* CUM = QP + (size_t)M * 2048; int* EID = (int*)(CUM + 80 * S); float* GW = (float*)(EID + (size_t)M * 128);
    k_rmsnorm<<<M, 256, 0, st>>>(xin, ln1 + (size_t)l * D, H);
    k_gemm<0><<<dim3((PW + 63) / 64, M / 64), 256, 0, st>>>(H, w_in + (size_t)l * D * PW, PROJ, nullptr, M, PW, D, D, PW, PW);
    k_cum<<<80, 64, 0, st>>>(PROJ, b_f + l * 10, CUM);
    k_attn<<<NB * NH * S / 4, 256, 0, st>>>(PROJ, relb + (size_t)l * 12 * 257, CUM, OATT);
    k_gemm<1><<<dim3(D / 64, M / 64), 256, 0, st>>>(OATT, w_out + (size_t)l * D * D, out, xin, M, D, D, D, D, D);
    k_rmsnorm<<<M, 256, 0, st>>>(out, ln2 + (size_t)l * D, H);
    k_gemm<0><<<dim3(2048 / 64, M / 64), 256, 0, st>>>(H, wq + (size_t)l * D * 2048, QP, nullptr, M, 2048, D, D, 2048, 2048);
    k_route<false><<<M * 8 / 4, 256, 0, st>>>(QP, k1 + (size_t)l * 8 * 128 * 128, k2 + (size_t)l * 8 * 128 * 128, EID, GW);
    k_expert<false><<<M / 4, 256, 0, st>>>(H, pu + (size_t)l * 16384 * D, pv + (size_t)l * 16384 * D, EID, GW, out);
}
static void layer_back(void* const* d_in, int l, float* out, unsigned char* ws, hipStream_t st) {
    const float* ln2 = (const float*)d_in[6]; const float* wq = (const float*)d_in[7];
    const float* k1 = (const float*)d_in[8]; const float* k2 = (const float*)d_in[9]; const float* pu = (const float*)d_in[10]; const float* pv = (const float*)d_in[11];
    float* H = (float*)ws; float* PROJ = H + (size_t)M * D; float* OATT = PROJ + (size_t)M * PW; float* QP = OATT + (size_t)M * D;
    float* CUM = QP + (size_t)M * 2048; int* EID = (int*)(CUM + 80 * S); float* GW = (float*)(EID + (size_t)M * 128);
    k_rmsnorm<<<M, 256, 0, st>>>(out, ln2 + (size_t)l * D, H);
    k_gemm<0><<<dim3(2048 / 64, M / 64), 256, 0, st>>>(H, wq + (size_t)l * D * 2048, QP, nullptr, M, 2048, D, D, 2048, 2048);
    k_route<false><<<M * 8 / 4, 256, 0, st>>>(QP, k1 + (size_t)l * 8 * 128 * 128, k2 + (size_t)l * 8 * 128 * 128, EID, GW);
    k_expert<false><<<M / 4, 256, 0, st>>>(H, pu + (size_t)l * 16384 * D, pv + (size_t)l * 16384 * D, EID, GW, out);
}
static void forward(void* const* d_in, float* out, unsigned char* ws, hipStream_t st) {
    layer(d_in, 0, (const float*)d_in[0], out, ws, st);
    layer(d_in, 1, out, out, ws, st);
    k_rmsnorm<<<M, 256, 0, st>>>(out, (const float*)d_in[12], out);
}
}
namespace pg8 {
#define PG8_LAS __attribute__((address_space(3)))
typedef unsigned short bf16_t;
typedef short bf16x8 __attribute__((ext_vector_type(8)));
typedef float f32x4 __attribute__((ext_vector_type(4)));
typedef unsigned u32x4 __attribute__((ext_vector_type(4)));
typedef unsigned u32x2 __attribute__((ext_vector_type(2)));
constexpr int BM = 256, BK = 64, HALF = 128, HTB = HALF * BK * 2  , STAGE_BYTES = 8 * HTB, NXCD = 8, WGM = 8;

__host__ __device__ __forceinline__ int lds_byte(int r, int c) { const int st = (r >> 4) * 2 + (c >> 5), rr = r & 15, cc = c & 31, ob = rr * 64 + cc * 2; return st * 1024 + (ob ^ (((ob >> 9) & 1) << 5)); }
__host__ __device__ __forceinline__ void stage_rc(int b, int& R, int& C) { const int st = b / 1024, sb = b % 1024, swz = sb ^ (((sb >> 9) & 1) << 5); R = (st >> 1) * 16 + swz / 64; C = (st & 1) * 32 + (swz % 64) / 2; }
__host__ __device__ __forceinline__ int perm32(int rho) { const int n = rho >> 4, i = rho & 15; return 8 * (i >> 2) + 4 * n + (i & 3); }

struct Unit { int pm, pn; };
struct Gemm { const bf16_t* A; const bf16_t* Bt; int M, N, K; };

struct StaticOrder {
    int nM, nN, nwg, G, c;
    __host__ __device__ void init(int M, int N, int G_, int c_) { nM = M / BM; nN = N / BM; nwg = nM * nN; G = G_; c = c_; }
    __host__ __device__ bool next(int i, Unit& u) const {
        const long L = (long)i * G + c; if (L >= nwg) return false;
        int wgid = (int)L; { const int q = nwg / NXCD, r = nwg % NXCD, xcd = wgid % NXCD, off = wgid / NXCD; wgid = (xcd < r ? xcd * (q + 1) : r * (q + 1) + (xcd - r) * q) + off; }
        const int nig = WGM * nN, gid = wgid / nig, fm = gid * WGM, gsz = (nM - fm) < WGM ? (nM - fm) : WGM;
        u.pm = fm + ((wgid % nig) % gsz); u.pn = (wgid % nig) / gsz; return true;
    }
    __device__ __forceinline__ void a_ready(const Unit&) const {}
    __device__ __forceinline__ void done(const Unit&) const {}
};
__device__ __forceinline__ unsigned cvt_pk_bf16(float lo, float hi) { unsigned r; asm volatile("v_cvt_pk_bf16_f32 %0, %1, %2" : "=v"(r) : "v"(lo), "v"(hi)); return r; }
typedef float f32x2 __attribute__((ext_vector_type(2)));
__device__ __forceinline__ f32x2 gelu_pk(f32x2 v) {
    const f32x2 av = __builtin_elementwise_abs(v), d = av * 0.2316418882f + 1.0f;
    f32x2 t; t.x = __builtin_amdgcn_rcpf(d.x); t.y = __builtin_amdgcn_rcpf(d.y);
    f32x2 q = t * 0.5307027145f + (-0.7265760135f); q = q * t + 0.7107068705f; q = q * t + (-0.142248368f); q = q * t + 0.127414796f; q = q * t;
    const f32x2 s = (v * v) * (-0.72134752044f);
    f32x2 e; e.x = __builtin_amdgcn_exp2f(s.x); e.y = __builtin_amdgcn_exp2f(s.y);
    const f32x2 m = v * (q * e), r = v - m;
    f32x2 o; o.x = v.x < 0.f ? m.x : r.x; o.y = v.y < 0.f ? m.y : r.y; return o;
}
typedef __amdgpu_buffer_rsrc_t rsrc_t;
__device__ __forceinline__ rsrc_t mkrsrc(const void* p, unsigned bytes) { return __builtin_amdgcn_make_buffer_rsrc((void*)p, (short)0, (int)bytes, 0x00020000); }
template <int LDC> struct EpiRowScaleF32 {
    static constexpr bool PERM = false, AFTER_DRAIN = false;
    float* C; const float* rs;
    __device__ __forceinline__ void operator()(const f32x4 (&acc)[2][2][4][2], const Unit& u, int wr, int wc, int fr, int fq) const {
        const rsrc_t rc = mkrsrc(C, 16384u * LDC * 4u), rr = mkrsrc(rs, 16384u * 4u);
        const int vo = ((wr * 64 + fr) * LDC + wc * 32 + 4 * fq) * 4, vr = (wr * 64 + fr) * 4;
        const int so = (u.pm * BM * LDC + u.pn * BM) * 4, sr = u.pm * BM * 4;
#pragma unroll
        for (int ai = 0; ai < 2; ++ai)
#pragma unroll
            for (int m = 0; m < 4; ++m) { const float s = __builtin_bit_cast(float, __builtin_amdgcn_raw_buffer_load_b32(rr, vr, sr + (ai * HALF + m * 16) * 4, 0));
#pragma unroll
                for (int bj = 0; bj < 2; ++bj)
#pragma unroll
                    for (int n = 0; n < 2; ++n) { const f32x4 v = acc[ai][bj][m][n] * s; __builtin_amdgcn_raw_buffer_store_b128(__builtin_bit_cast(u32x4, v), rc, vo, so + ((ai * HALF + m * 16) * LDC + bj * HALF + n * 16) * 4, 0); } }
    }
};
struct EpiResidF32 {
    static constexpr bool PERM = false, AFTER_DRAIN = false;
    const float* base; float* out;
    __device__ __forceinline__ void operator()(const f32x4 (&acc)[2][2][4][2], const Unit& u, int wr, int wc, int fr, int fq) const {
        constexpr int LDC = 4096;
        const rsrc_t rb = mkrsrc(base, 16384u * LDC * 4u), ro = mkrsrc(out, 16384u * LDC * 4u);
        const int vo = ((wr * 64 + fr) * LDC + wc * 32 + 4 * fq) * 4;
        const int so = (u.pm * BM * LDC + u.pn * BM) * 4;
#pragma unroll
        for (int ai = 0; ai < 2; ++ai)
#pragma unroll
            for (int m = 0; m < 4; ++m) {
#pragma unroll
                for (int bj = 0; bj < 2; ++bj)
#pragma unroll
                    for (int n = 0; n < 2; ++n) { const int o = so + ((ai * HALF + m * 16) * LDC + bj * HALF + n * 16) * 4;
                        const f32x4 b = __builtin_bit_cast(f32x4, __builtin_amdgcn_raw_buffer_load_b128(rb, vo, o, 0)); const f32x4 v = b + acc[ai][bj][m][n];
                        __builtin_amdgcn_raw_buffer_store_b128(__builtin_bit_cast(u32x4, v), ro, vo, o, 0); } }
    }
};
struct EpiQKV {
    static constexpr bool PERM = true, AFTER_DRAIN = false;
    bf16_t* Q; const float* rs; float qscale;
    __device__ __forceinline__ void operator()(const f32x4 (&acc)[2][2][4][2], const Unit& u, int wr, int wc, int fr, int fq) const {
        const rsrc_t rq = mkrsrc(Q, 3u * 16384u * 4096u * 2u), rr = mkrsrc(rs, 16384u * 4u);
        const int colt = u.pn * BM, which = colt >> 12, cw = colt & 4095, gt = cw >> 7;
        const int b = (u.pm * BM) >> 11, st = (u.pm * BM) & 2047;
        const float sc = which == 0 ? qscale : 1.f;
        const int so = (int)(((unsigned)which << 26) + (((unsigned)(b * 32 + gt) * 2048u + (unsigned)st) << 7)) * 2;
        const int vo = (((wr * 64 + fr) << 7) + wc * 32 + 8 * fq) * 2, vr = (wr * 64 + fr) * 4, sr = u.pm * BM * 4;
#pragma unroll
        for (int ai = 0; ai < 2; ++ai)
#pragma unroll
            for (int m = 0; m < 4; ++m) { const float f = sc * __builtin_bit_cast(float, __builtin_amdgcn_raw_buffer_load_b32(rr, vr, sr + (ai * HALF + m * 16) * 4, 0));
#pragma unroll
                for (int bj = 0; bj < 2; ++bj) {
                    const f32x4 v0 = acc[ai][bj][m][0] * f, v1 = acc[ai][bj][m][1] * f;
                    u32x4 w; w.x = cvt_pk_bf16(v0[0], v0[1]); w.y = cvt_pk_bf16(v0[2], v0[3]); w.z = cvt_pk_bf16(v1[0], v1[1]); w.w = cvt_pk_bf16(v1[2], v1[3]);
                    __builtin_amdgcn_raw_buffer_store_b128(w, rq, vo, so + ((bj * 2048 + ai * HALF + m * 16) << 7) * 2, 0); } }
    }
};

struct EpiQKV4 {
    static constexpr bool PERM = false, AFTER_DRAIN = false;
    bf16_t* Q; const float* rs; float qscale;
    __device__ __forceinline__ void operator()(const f32x4 (&acc)[2][2][4][2], const Unit& u, int wr, int wc, int fr, int fq) const {
        const rsrc_t rq = mkrsrc(Q, 3u * 16384u * 4096u * 2u), rr = mkrsrc(rs, 16384u * 4u);
        const int colt = u.pn * BM, which = colt >> 12, cw = colt & 4095, gt = cw >> 7;
        const int b = (u.pm * BM) >> 11, st = (u.pm * BM) & 2047;
        const float sc = which == 0 ? qscale : 1.f;
        const int so = (int)(((unsigned)which << 26) + (((unsigned)(b * 32 + gt) * 2048u + (unsigned)st) << 7)) * 2;
        const int vo = (((wr * 64 + fr) << 7) + wc * 32 + 4 * fq) * 2, vr = (wr * 64 + fr) * 4, sr = u.pm * BM * 4;
#pragma unroll
        for (int ai = 0; ai < 2; ++ai)
#pragma unroll
            for (int m = 0; m < 4; ++m) { const float f = sc * __builtin_bit_cast(float, __builtin_amdgcn_raw_buffer_load_b32(rr, vr, sr + (ai * HALF + m * 16) * 4, 0));
#pragma unroll
                for (int bj = 0; bj < 2; ++bj)
#pragma unroll
                    for (int n = 0; n < 2; ++n) { const f32x4 v0 = acc[ai][bj][m][n] * f; u32x2 w; w.x = cvt_pk_bf16(v0[0], v0[1]); w.y = cvt_pk_bf16(v0[2], v0[3]);
                        __builtin_amdgcn_raw_buffer_store_b64(w, rq, vo, so + (((bj * 2048 + ai * HALF + m * 16) << 7) + n * 16) * 2, 0); } }
    }
};

template <class Epi, class Sched, bool ALIGN_EPI = false, bool SP2 = false>
__device__ __forceinline__ void gemm_phase(PG8_LAS unsigned char* lds, const Gemm g, const Sched& S, const Epi& E) {
    int tid_ = threadIdx.x; asm volatile("" : "+v"(tid_));
    const int tid = tid_, wid = __builtin_amdgcn_readfirstlane(tid >> 6), lane = tid & 63, wr = wid >> 2, wc = wid & 3, fr = lane & 15, fq = lane >> 4;
    const int K = g.K, nt = K / BK;
    unsigned voffA[2], voffB[2];
#pragma unroll
    for (int i = 0; i < 2; ++i) { int R, C; stage_rc(tid * 16 + i * 8192, R, C); const int Rb = Epi::PERM ? ((R & ~31) + perm32(R & 31)) : R;
        voffA[i] = (unsigned)(R * K + C) * 2u; voffB[i] = (unsigned)(Rb * K + C) * 2u; }
    const size_t kstep = (size_t)(BK * 2);
    const size_t hstep = (size_t)HALF * K * 2;
    const size_t tstep = 2 * hstep;
    const unsigned ldsw = (unsigned)wid * 1024u;
    const int aoff = lds_byte(wr * 64 + fr, fq * 8), boff = lds_byte(wc * 32 + fr, fq * 8);
#define PG8_SA(b, h) (((b) * 2 + (h)) * HTB)
#define PG8_SB(b, h) ((4 + (b) * 2 + (h)) * HTB)
#define PG8_STAGE(bufoff, gbase, voff) do { _Pragma("unroll") for (int _i = 0; _i < 2; ++_i) \
        __builtin_amdgcn_global_load_lds((const unsigned*)((const char*)(gbase) + (voff)[_i]), (PG8_LAS unsigned*)(lds + (bufoff) + ldsw + _i * 8192), 16, 0, 0); } while (0)
#define PG8_LDA(dst, b, h) do { _Pragma("unroll") for (int m = 0; m < 4; ++m) _Pragma("unroll") for (int k = 0; k < 2; ++k) dst[m][k] = *(const PG8_LAS bf16x8*)(lds + PG8_SA(b, h) + aoff + m * 2048 + k * 1024); } while (0)
#define PG8_LDB(dst, b, h) do { _Pragma("unroll") for (int n = 0; n < 2; ++n) _Pragma("unroll") for (int k = 0; k < 2; ++k) dst[n][k] = *(const PG8_LAS bf16x8*)(lds + PG8_SB(b, h) + boff + n * 2048 + k * 1024); } while (0)
#define PG8_MMA(ai, bj, At, Bt) do { __builtin_amdgcn_s_setprio(1); _Pragma("unroll") for (int m = 0; m < 4; ++m) _Pragma("unroll") for (int n = 0; n < 2; ++n) _Pragma("unroll") for (int k = 0; k < 2; ++k) \
        acc[ai][bj][m][n] = __builtin_amdgcn_mfma_f32_16x16x32_bf16(Bt[n][k], At[m][k], acc[ai][bj][m][n], 0, 0, 0); __builtin_amdgcn_s_setprio(0); } while (0)
#define PG8_WAIT_V(n) asm volatile("s_waitcnt vmcnt(" #n ")" ::: "memory")
#define PG8_WAIT_L(n) asm volatile("s_waitcnt lgkmcnt(" #n ")" ::: "memory")
#define PG8_BAR __builtin_amdgcn_s_barrier()
#define PG8_SCHED __builtin_amdgcn_sched_barrier(0)
    Unit cur, nxt; int ui = 0;
    if (!S.next(0, cur)) return;
    f32x4 acc[2][2][4][2];
#pragma unroll
    for (int a = 0; a < 2; ++a)
#pragma unroll
        for (int b = 0; b < 2; ++b)
#pragma unroll
            for (int m = 0; m < 4; ++m)
#pragma unroll
                for (int n = 0; n < 2; ++n) acc[a][b][m][n] = (f32x4){0.f, 0.f, 0.f, 0.f};
    bf16x8 At[4][2], B0[2][2], B1[2][2];
    const char* cA = (const char*)g.A + (size_t)cur.pm * tstep; const char* cB = (const char*)g.Bt + (size_t)cur.pn * tstep;
    S.a_ready(cur);
    if constexpr (SP2) {
        PG8_STAGE(PG8_SB(0, 0), cB, voffB); PG8_STAGE(PG8_SB(0, 1), cB + hstep, voffB); PG8_STAGE(PG8_SA(0, 0), cA, voffA); PG8_STAGE(PG8_SA(0, 1), cA + hstep, voffA);
        if (wr == 1) PG8_BAR;
        PG8_WAIT_V(2); PG8_BAR;
        PG8_STAGE(PG8_SB(1, 0), cB + kstep, voffB); PG8_STAGE(PG8_SA(1, 0), cA + kstep, voffA); PG8_STAGE(PG8_SB(1, 1), cB + hstep + kstep, voffB);
        PG8_WAIT_V(6); PG8_BAR;
    } else {
        PG8_STAGE(PG8_SB(0, 0), cB, voffB); PG8_STAGE(PG8_SA(0, 0), cA, voffA); PG8_STAGE(PG8_SB(0, 1), cB + hstep, voffB); PG8_STAGE(PG8_SA(0, 1), cA + hstep, voffA);
        if (wr == 1) PG8_BAR;
        PG8_WAIT_V(4); PG8_BAR;
        PG8_STAGE(PG8_SB(1, 0), cB + kstep, voffB); PG8_STAGE(PG8_SA(1, 0), cA + kstep, voffA); PG8_STAGE(PG8_SB(1, 1), cB + hstep + kstep, voffB);
        PG8_WAIT_V(6); PG8_BAR;
    }
    for (;;) {
        const bool has_next = S.next(ui + 1, nxt);
        const char* nA = has_next ? (const char*)g.A + (size_t)nxt.pm * tstep : cA; const char* nB = has_next ? (const char*)g.Bt + (size_t)nxt.pn * tstep : cB;
        for (int t = 0; t < nt; t += 2) {
            const bool last = (t == nt - 2);
            const char* a1 = cA + (size_t)(t + 1) * kstep;
            const char* a2 = last ? nA : cA + (size_t)(t + 2) * kstep; const char* b2 = last ? nB : cB + (size_t)(t + 2) * kstep;
            const char* a3 = a2 + kstep; const char* b3 = b2 + kstep;
            if (last && has_next) S.a_ready(nxt);
            if constexpr (SP2) {
            PG8_LDB(B0, 0, 0); PG8_LDB(B1, 0, 1); PG8_SCHED; PG8_LDA(At, 0, 0); PG8_STAGE(PG8_SA(1, 1), a1 + hstep, voffA);
            PG8_WAIT_V(8); PG8_WAIT_L(0); PG8_BAR; PG8_MMA(0, 0, At, B0); PG8_MMA(0, 1, At, B1); PG8_BAR; PG8_SCHED;
            PG8_LDA(At, 0, 1); PG8_STAGE(PG8_SB(0, 0), b2, voffB); PG8_STAGE(PG8_SB(0, 1), b2 + hstep, voffB); PG8_STAGE(PG8_SA(0, 0), a2, voffA);
            PG8_WAIT_V(8); PG8_WAIT_L(0); PG8_BAR; PG8_MMA(1, 0, At, B0); PG8_MMA(1, 1, At, B1); PG8_BAR; PG8_SCHED;
            PG8_LDB(B0, 1, 0); PG8_LDB(B1, 1, 1); PG8_SCHED; PG8_LDA(At, 1, 0); PG8_STAGE(PG8_SA(0, 1), a2 + hstep, voffA);
            PG8_WAIT_V(8); PG8_WAIT_L(0); PG8_BAR; PG8_MMA(0, 0, At, B0); PG8_MMA(0, 1, At, B1); PG8_BAR; PG8_SCHED;
            PG8_LDA(At, 1, 1); PG8_STAGE(PG8_SB(1, 0), b3, voffB); PG8_STAGE(PG8_SB(1, 1), b3 + hstep, voffB); PG8_STAGE(PG8_SA(1, 0), a3, voffA);
            PG8_WAIT_V(8); PG8_WAIT_L(0); PG8_BAR; PG8_MMA(1, 0, At, B0); PG8_MMA(1, 1, At, B1); PG8_BAR; PG8_SCHED;
            } else {
            PG8_LDB(B0, 0, 0); PG8_SCHED; PG8_LDA(At, 0, 0); PG8_STAGE(PG8_SA(1, 1), a1 + hstep, voffA);
            PG8_WAIT_L(8); PG8_BAR; PG8_WAIT_L(0); PG8_MMA(0, 0, At, B0); PG8_BAR; PG8_SCHED;
            PG8_LDB(B1, 0, 1); PG8_STAGE(PG8_SB(0, 0), b2, voffB);
            PG8_BAR; PG8_WAIT_L(0); PG8_MMA(0, 1, At, B1); PG8_BAR;
            PG8_LDA(At, 0, 1); PG8_STAGE(PG8_SA(0, 0), a2, voffA);
            PG8_BAR; PG8_WAIT_L(0); PG8_MMA(1, 0, At, B0); PG8_BAR; PG8_SCHED;
            PG8_STAGE(PG8_SB(0, 1), b2 + hstep, voffB);
            PG8_WAIT_V(6); PG8_BAR; PG8_MMA(1, 1, At, B1); PG8_BAR;
            PG8_LDB(B0, 1, 0); PG8_SCHED; PG8_LDA(At, 1, 0); PG8_STAGE(PG8_SA(0, 1), a2 + hstep, voffA);
            PG8_WAIT_L(8); PG8_BAR; PG8_WAIT_L(0); PG8_MMA(0, 0, At, B0); PG8_BAR; PG8_SCHED;
            PG8_LDB(B1, 1, 1); PG8_STAGE(PG8_SB(1, 0), b3, voffB);
            PG8_BAR; PG8_WAIT_L(0); PG8_MMA(0, 1, At, B1); PG8_BAR;
            PG8_LDA(At, 1, 1); PG8_STAGE(PG8_SA(1, 0), a3, voffA);
            PG8_BAR; PG8_WAIT_L(0); PG8_MMA(1, 0, At, B0); PG8_BAR; PG8_SCHED;
            PG8_STAGE(PG8_SB(1, 1), b3 + hstep, voffB);
            PG8_WAIT_V(6); PG8_BAR; PG8_MMA(1, 1, At, B1); PG8_BAR;
            }
        }
        if constexpr (ALIGN_EPI) { if (wr == 0) PG8_BAR; }
        if constexpr (!Epi::AFTER_DRAIN) { E(acc, cur, wr, wc, fr, fq); S.done(cur); }
        if (!has_next) break;
#pragma unroll
        for (int a = 0; a < 2; ++a)
#pragma unroll
            for (int b = 0; b < 2; ++b)
#pragma unroll
                for (int m = 0; m < 4; ++m)
#pragma unroll
                    for (int n = 0; n < 2; ++n) acc[a][b][m][n] = (f32x4){0.f, 0.f, 0.f, 0.f};
        cur = nxt; cA = nA; cB = nB; ++ui;
        if constexpr (ALIGN_EPI) { if (wr == 1) PG8_BAR; }
    }
    PG8_WAIT_V(0);
    if constexpr (!ALIGN_EPI) { if (wr == 0) PG8_BAR; }
    PG8_BAR;
    if constexpr (Epi::AFTER_DRAIN) { E.fused(acc, cur, wr, wc, fr, fq, lds, wid, lane); S.done(cur); }
#undef PG8_SA
#undef PG8_SB
#undef PG8_STAGE
#undef PG8_LDA
#undef PG8_LDB
#undef PG8_MMA
#undef PG8_WAIT_V
#undef PG8_WAIT_L
#undef PG8_BAR
#undef PG8_SCHED
}
}
#define GAS __attribute__((address_space(1)))
#define LAS __attribute__((address_space(3)))
typedef unsigned short bf16_t;
typedef unsigned u32x4 __attribute__((ext_vector_type(4)));
typedef unsigned u32x2 __attribute__((ext_vector_type(2)));
typedef float f32x4 __attribute__((ext_vector_type(4)));
typedef float f32x2 __attribute__((ext_vector_type(2)));
typedef float f32x16 __attribute__((ext_vector_type(16)));
typedef short bf16x8 __attribute__((ext_vector_type(8)));
typedef short s16x4 __attribute__((ext_vector_type(4)));
typedef __bf16 bf16x2_t __attribute__((ext_vector_type(2)));

namespace mk {
constexpr int M = 16384, D = 4096, S = 2048, NB = 8, PW = 12298, NH = 32, NE = 16384;
constexpr int NWAVES = 8;
constexpr size_t MiB = 1u << 20;
constexpr size_t WS_CTL = 0, CTL_ZERO_BYTES = 1 * MiB;
constexpr size_t WS_RSTD = 2 * MiB, WS_LOGF = 3 * MiB, WS_WQK = 4 * MiB, WS_WOUT = 20 * MiB, WS_WIN = 52 * MiB, WS_U16 = 148 * MiB, WS_V16 = 276 * MiB,
                 WS_XB = 404 * MiB, WS_Q = 532 * MiB, WS_K = 660 * MiB, WS_V = 788 * MiB, WS_OB = 916 * MiB, WS_X2 = 1792 * MiB, WS_END = 2048 * MiB;
constexpr size_t WS_SC = WS_Q;
constexpr int CW_BAR = 4096;
constexpr int CW_QUEUE = 16384;
constexpr int RING_BYTES = 131072, LDSCTL_OFF = RING_BYTES, MISC_OFF = LDSCTL_OFF + 320, LDS_BYTES = 147456;

struct Args { const float* in[13]; float* out; unsigned char* ws; int ph_lo, ph_hi; };

__device__ __forceinline__ unsigned f2bf(float f) { unsigned u = __builtin_bit_cast(unsigned, f); return (u + 0x7fffu + ((u >> 16) & 1u)) >> 16; }
__device__ __forceinline__ unsigned pk2(float lo, float hi) { return f2bf(lo) | (f2bf(hi) << 16); }
__device__ __forceinline__ float bf_lo(unsigned w) { return __builtin_bit_cast(float, w << 16); }
__device__ __forceinline__ float bf_hi(unsigned w) { return __builtin_bit_cast(float, w & 0xffff0000u); }
__device__ __forceinline__ float wsum(float v) {
#pragma unroll
    for (int o = 1; o < 64; o <<= 1) v += __shfl_xor(v, o);
    return v;
}
__device__ __forceinline__ float wmax(float v) {
#pragma unroll
    for (int o = 1; o < 64; o <<= 1) v = fmaxf(v, __shfl_xor(v, o));
    return v;
}
__device__ __forceinline__ int wmin_i(int v) {
#pragma unroll
    for (int o = 1; o < 64; o <<= 1) { const int t = __shfl_xor(v, o); v = t < v ? t : v; }
    return v;
}
constexpr float US = 1024.0f, VS = 32.0f, US_INV = 1.0f / 1024.0f, VS_INV = 1.0f / 32.0f;
__device__ __forceinline__ float clamp8(float x) { return fminf(fmaxf(x, -224.0f), 224.0f); }
__device__ __forceinline__ float logsig(float z) { return z >= 0.f ? -log1pf(expf(-z)) : z - log1pf(expf(z)); }
#define LDS_WAIT() asm volatile("s_waitcnt lgkmcnt(0)" ::: "memory")
#define FRESH_LDS(l) do { unsigned v_ = (unsigned)(size_t)(l); asm volatile("" : "+s"(v_)); (l) = (LAS unsigned char*)(size_t)v_; } while (0)
#define FRESH_BID() int bid = blockIdx.x, G = gridDim.x; asm volatile("" : "+s"(bid), "+s"(G))
#define FRESH_TID() int tid; { int t_ = threadIdx.x; asm volatile("" : "+v"(t_)); tid = t_; } const int lane = tid & 63, wave = __builtin_amdgcn_readfirstlane(tid >> 6); (void)lane; (void)wave

__device__ __forceinline__ void transpose_item(const float* W, int K, int ldw, int ncols, const float* gain, bf16_t* WT, LAS float* scr, int item, int lane) {
    const int nblk = ncols / 32, kb = item / nblk, nb = item % nblk, k0 = 64 * kb, n0 = 32 * nb;
#pragma unroll 8
    for (int i = 0; i < 32; ++i) { const int kk = 2 * i + (lane >> 5); float v = W[(size_t)(k0 + kk) * ldw + n0 + (lane & 31)]; if (gain) v *= gain[k0 + kk]; scr[kk * 33 + (lane & 31)] = v; }
    LDS_WAIT(); asm volatile("" ::: "memory");
    const int c = lane & 7;
#pragma unroll
    for (int j = 0; j < 4; ++j) { const int n = (lane >> 3) + 8 * j; const LAS float* s = scr + (8 * c) * 33 + n;
        u32x4 o; o.x = pk2(s[0 * 33], s[1 * 33]); o.y = pk2(s[2 * 33], s[3 * 33]); o.z = pk2(s[4 * 33], s[5 * 33]); o.w = pk2(s[6 * 33], s[7 * 33]);
        *(u32x4*)(WT + (size_t)(n0 + n) * K + k0 + 8 * c) = o; }
    LDS_WAIT(); asm volatile("" ::: "memory");
}

typedef const __attribute__((address_space(4))) Args* KArgsT;
__device__ __forceinline__ void conv_phase(KArgsT ka, int l, LAS unsigned char* lds) {
    FRESH_TID(); FRESH_LDS(lds); FRESH_BID();
    unsigned char* ws = ka->ws;
    const float* ln1 = ka->in[1] + (size_t)l * D; const float* w_in = ka->in[2] + (size_t)l * D * PW; const float* w_out = ka->in[5] + (size_t)l * D * D;
    const float* ln2 = ka->in[6] + (size_t)l * D; const float* wq = ka->in[7] + (size_t)l * D * 2048;
    const float* k1 = ka->in[8] + (size_t)l * 8 * 128 * 128; const float* k2 = ka->in[9] + (size_t)l * 8 * 128 * 128;
    const float* pu = ka->in[10] + (size_t)l * NE * D; const float* pv = ka->in[11] + (size_t)l * NE * D;
    bf16_t* WQK = (bf16_t*)(ws + WS_WQK); bf16_t* WOUT = (bf16_t*)(ws + WS_WOUT); bf16_t* WIN = (bf16_t*)(ws + WS_WIN); bf16_t* U16 = (bf16_t*)(ws + WS_U16); bf16_t* V16 = (bf16_t*)(ws + WS_V16);
    {
        LAS float* Ks = (LAS float*)lds;
        LAS float* Ws = (LAS float*)(lds + 128 * 132 * 4);
        for (int it = bid; it < 1024; it += G) {
            const int gi = it >> 6, c0 = (it & 63) * 64;
            const float* key = ((gi & 1) ? k2 : k1) + (size_t)(gi >> 1) * 128 * 128;
            for (int i = tid; i < 4096; i += 512) { const int r = i >> 5, c4 = (i & 31) * 4; *(LAS f32x4*)(Ks + r * 132 + c4) = *(const f32x4*)(key + r * 128 + c4); }
            for (int i = tid; i < 2048; i += 512) { const int r = i >> 5, c4 = (i & 31) * 4; *(LAS f32x4*)(Ws + r * 132 + c4) = *(const f32x4*)(wq + (size_t)(c0 + r) * 2048 + gi * 128 + c4); }
            __syncthreads();
            const int tc = tid & 15, tn = tid >> 4;
            float acc[4][4];
#pragma unroll
            for (int i = 0; i < 4; ++i)
#pragma unroll
                for (int j = 0; j < 4; ++j) acc[i][j] = 0.f;
#pragma unroll 2
            for (int d = 0; d < 128; d += 4) {
                f32x4 kv[4], wv[4];
#pragma unroll
                for (int i = 0; i < 4; ++i) kv[i] = *(const LAS f32x4*)(Ks + (4 * tn + i) * 132 + d);
#pragma unroll
                for (int j = 0; j < 4; ++j) wv[j] = *(const LAS f32x4*)(Ws + (tc + 16 * j) * 132 + d);
#pragma unroll
                for (int i = 0; i < 4; ++i)
#pragma unroll
                    for (int j = 0; j < 4; ++j) acc[i][j] += kv[i][0] * wv[j][0] + kv[i][1] * wv[j][1] + kv[i][2] * wv[j][2] + kv[i][3] * wv[j][3];
            }
#pragma unroll
            for (int j = 0; j < 4; ++j) { const int c = c0 + tc + 16 * j; const float gg = ln2[c];
#pragma unroll
                for (int i = 0; i < 4; ++i) WQK[(size_t)(gi * 128 + 4 * tn + i) * D + c] = (bf16_t)f2bf(acc[i][j] * gg); }
            __syncthreads();
        }
        __syncthreads();
    }
    const int gw = bid * NWAVES + wave, NGW = G * NWAVES;
    {
        unsigned char* U8 = (unsigned char*)U16; unsigned char* V8 = U8 + (size_t)NE * D;
        for (int r = gw; r < NE; r += NGW) {
            const float* us = pu + (size_t)r * D; const float* vs = pv + (size_t)r * D;
#pragma unroll
            for (int i = 0; i < 4; ++i) { const int c = 1024 * i + 16 * lane;
                u32x4 ou, ov;
#pragma unroll
                for (int q = 0; q < 4; ++q) { const f32x4 u0 = *(const f32x4*)(us + c + 4 * q), g0 = *(const f32x4*)(ln2 + c + 4 * q), v0 = *(const f32x4*)(vs + c + 4 * q);
                    int pu_ = __builtin_amdgcn_cvt_pk_fp8_f32(clamp8(u0[0] * g0[0] * US), clamp8(u0[1] * g0[1] * US), 0, false); pu_ = __builtin_amdgcn_cvt_pk_fp8_f32(clamp8(u0[2] * g0[2] * US), clamp8(u0[3] * g0[3] * US), pu_, true);
                    int pv_ = __builtin_amdgcn_cvt_pk_fp8_f32(clamp8(v0[0] * VS), clamp8(v0[1] * VS), 0, false); pv_ = __builtin_amdgcn_cvt_pk_fp8_f32(clamp8(v0[2] * VS), clamp8(v0[3] * VS), pv_, true);
                    ou[q] = (unsigned)pu_; ov[q] = (unsigned)pv_; }
                *(u32x4*)(U8 + (size_t)r * D + c) = ou; *(u32x4*)(V8 + (size_t)r * D + c) = ov; }
        }
    }
    {
        LAS float* scr = (LAS float*)(lds + wave * 16384);
        constexpr int I_O = (D / 64) * (D / 32), I_IN = (D / 64) * (12288 / 32);
        for (int it = gw; it < I_O + I_IN; it += NGW) {
            if (it < I_O) transpose_item(w_out, D, D, D, nullptr, WOUT, scr, it, lane);
            else transpose_item(w_in, D, PW, 12288, ln1, WIN, scr, it - I_O, lane);
        }
    }
}

template <bool WITH_F>
__device__ __forceinline__ void prep_phase(const float* X, bf16_t* XB, float* RSTD, const float* w_in, const float* ln1, const float* bf, float* LOGF, LAS unsigned char* lds) {
    FRESH_TID(); FRESH_LDS(lds); FRESH_BID();
    LAS unsigned short* gfs = (LAS unsigned short*)lds;
    if (WITH_F) {
        __syncthreads();
        for (int c = tid; c < D; c += 512) { const float g = ln1[c]; const float* wr = w_in + (size_t)c * PW + 12288;
#pragma unroll
            for (int j = 0; j < 10; ++j) gfs[j * D + c] = (unsigned short)f2bf(wr[j] * g); }
        __syncthreads();
    }
    const int gw = bid * NWAVES + wave, NGW = G * NWAVES;
    for (int m = gw; m < M; m += NGW) {
        const f32x4* xr = (const f32x4*)(X + (size_t)m * D) + lane;
        f32x4 v[16]; float ss = 0.f;
#pragma unroll
        for (int i = 0; i < 16; ++i) { v[i] = xr[64 * i]; ss += (v[i][0] * v[i][0] + v[i][1] * v[i][1]) + (v[i][2] * v[i][2] + v[i][3] * v[i][3]); }
        ss = wsum(ss);
        const float rstd = rsqrtf(ss * (1.0f / D) + 1e-6f);
        u32x2* o = (u32x2*)(XB + (size_t)m * D) + lane;
#pragma unroll
        for (int i = 0; i < 16; ++i) { u32x2 w; w.x = pk2(v[i][0], v[i][1]); w.y = pk2(v[i][2], v[i][3]); o[64 * i] = w; }
        if (lane == 0) RSTD[m] = rstd;
        if (WITH_F) {
            float mine = 0.f;
#pragma unroll 1
            for (int j = 0; j < 10; ++j) { float s = 0.f;
#pragma unroll
                for (int i = 0; i < 16; ++i) { const u32x2 gp = *(const LAS u32x2*)(gfs + j * D + 256 * i + 4 * lane);
                    s += (v[i][0] * bf_lo(gp.x) + v[i][1] * bf_hi(gp.x)) + (v[i][2] * bf_lo(gp.y) + v[i][3] * bf_hi(gp.y)); }
                s = wsum(s); if (lane == j) mine = s; }
            if (lane < 10) { const int b = m >> 11, s = m & 2047; LOGF[(size_t)(b * 10 + lane) * S + s] = logsig(mine * rstd + bf[lane]); }
        }
    }
}


__device__ __forceinline__ unsigned wave_max_u32(unsigned v) {
    v = max(v, (unsigned)__builtin_amdgcn_update_dpp(0, (int)v, 0x111, 0xF, 0xF, true));
    v = max(v, (unsigned)__builtin_amdgcn_update_dpp(0, (int)v, 0x112, 0xF, 0xF, true));
    v = max(v, (unsigned)__builtin_amdgcn_update_dpp(0, (int)v, 0x114, 0xF, 0xF, true));
    v = max(v, (unsigned)__builtin_amdgcn_update_dpp(0, (int)v, 0x118, 0xF, 0xF, true));
    v = max(v, (unsigned)__builtin_amdgcn_update_dpp((int)v, (int)v, 0x142, 0xA, 0xF, false));
    v = max(v, (unsigned)__builtin_amdgcn_update_dpp((int)v, (int)v, 0x143, 0xC, 0xF, false));
    return (unsigned)__builtin_amdgcn_readlane((int)v, 63);
}
__device__ __forceinline__ float wave_sum_dpp(float x) {
    int v = __builtin_bit_cast(int, x);
#define DPP_ADD(ctrl, rm, bc, oldv) v = __builtin_bit_cast(int, __builtin_bit_cast(float, v) + __builtin_bit_cast(float, __builtin_amdgcn_update_dpp(oldv, v, ctrl, rm, 0xF, bc)))
    DPP_ADD(0x111, 0xF, true, 0); DPP_ADD(0x112, 0xF, true, 0); DPP_ADD(0x114, 0xF, true, 0); DPP_ADD(0x118, 0xF, true, 0);
#undef DPP_ADD
    const float r0 = __builtin_bit_cast(float, __builtin_amdgcn_readlane(v, 15)), r1 = __builtin_bit_cast(float, __builtin_amdgcn_readlane(v, 31)), r2 = __builtin_bit_cast(float, __builtin_amdgcn_readlane(v, 47)), r3 = __builtin_bit_cast(float, __builtin_amdgcn_readlane(v, 63));
    return (r0 + r1) + (r2 + r3);
}
__device__ __forceinline__ unsigned ordkey(float x) { const unsigned u = __builtin_bit_cast(unsigned, x); return (u & 0x80000000u) ? ~u : (u | 0x80000000u); }
#define RFL(x) __builtin_amdgcn_readfirstlane(x)
template <bool FINAL, bool ROUTE_EXT = false, bool SKIP_U = false>
__device__ __forceinline__ void peer_phase(const float* SC, const bf16_t* XB, const float* RSTD, const bf16_t* U16, const bf16_t* V16, const float* X1, float* XO, const float* fg,
                                           LAS unsigned char* lds) {
    FRESH_TID(); FRESH_LDS(lds); FRESH_BID();
    LAS int* s_eid = (LAS int*)(lds + wave * 1024); LAS float* s_w = (LAS float*)(lds + wave * 1024 + 512);
    const int gw = bid * NWAVES + wave, NGW = G * NWAVES;
    const float NEG = -3.0e38f;
    for (int tok = gw; tok < M; tok += NGW) {
        const float* sc = SC + (size_t)tok * 2048;
        if (ROUTE_EXT) { const int* ee = (const int*)SC; const float* gg = (const float*)XB;     (void)ee; (void)gg; }
        for (int h = 0; h < (ROUTE_EXT ? 0 : 8); ++h) {
            float a0 = sc[h * 256 + lane], a1 = sc[h * 256 + 64 + lane], c0 = sc[h * 256 + 128 + lane], c1 = sc[h * 256 + 192 + lane];
            float v1 = 0.f, v2 = 0.f; int i1 = 0, i2 = 0;
            for (int it = 0; it < 16; ++it) {
                { const float m = wmax(fmaxf(a0, a1)); int cand = 1 << 30; if (a0 == m) cand = lane; else if (a1 == m) cand = lane + 64;
                  const int n = wmin_i(cand); if (n == lane) a0 = NEG; if (n == lane + 64) a1 = NEG; if (lane == it) { v1 = m; i1 = n; } }
                { const float m = wmax(fmaxf(c0, c1)); int cand = 1 << 30; if (c0 == m) cand = lane; else if (c1 == m) cand = lane + 64;
                  const int n = wmin_i(cand); if (n == lane) c0 = NEG; if (n == lane + 64) c1 = NEG; if (lane == it) { v2 = m; i2 = n; } }
            }
            float d0, d1, d2, d3;
            { const float va = __shfl(v1, lane >> 2); d0 = va + __shfl(v2, (lane & 3) * 4 + 0); d1 = va + __shfl(v2, (lane & 3) * 4 + 1); d2 = va + __shfl(v2, (lane & 3) * 4 + 2); d3 = va + __shfl(v2, (lane & 3) * 4 + 3); }
            float best = 0.f; int be = 0;
            for (int it = 0; it < 16; ++it) {
                const float m = wmax(fmaxf(fmaxf(d0, d1), fmaxf(d2, d3)));
                int cand = 1 << 30;
                if (d0 == m) cand = lane * 4; else if (d1 == m) cand = lane * 4 + 1; else if (d2 == m) cand = lane * 4 + 2; else if (d3 == m) cand = lane * 4 + 3;
                const int pos = wmin_i(cand);
                if (pos == lane * 4) d0 = NEG; if (pos == lane * 4 + 1) d1 = NEG; if (pos == lane * 4 + 2) d2 = NEG; if (pos == lane * 4 + 3) d3 = NEG;
                const int e = ((__shfl(i1, (pos >> 4) & 15) & 127) << 7) | (__shfl(i2, pos & 15) & 127);
                if (lane == it) { best = m; be = e; }
            }
            const float mx = __shfl(best, 0);
            const float p = lane < 16 ? expf(best - mx) : 0.f;
            const float sm = wsum(p);
            if (lane < 16) { s_eid[h * 16 + lane] = be; s_w[h * 16 + lane] = p / sm; }
        }
        if (ROUTE_EXT) { const int* ee = (const int*)fg; const float* gg = (const float*)(ee + (size_t)M * 128); s_eid[lane] = ee[(size_t)tok * 128 + lane]; s_eid[lane + 64] = ee[(size_t)tok * 128 + lane + 64]; s_w[lane] = gg[(size_t)tok * 128 + lane]; s_w[lane + 64] = gg[(size_t)tok * 128 + lane + 64]; }
        LDS_WAIT(); asm volatile("" ::: "memory");
        if (!SKIP_U) {
            u32x4 xr[8];
            { const u32x4* p_ = (const u32x4*)(XB + (size_t)tok * D) + lane;
#pragma unroll
              for (int i = 0; i < 8; ++i) xr[i] = p_[64 * i]; }
            const float rstd = RSTD[tok];
#define LOADROW(dst, base, e) do { const u32x4* p_ = (const u32x4*)((base) + (size_t)(e) * D) + lane; _Pragma("unroll") for (int i_ = 0; i_ < 8; ++i_) dst[i_] = p_[64 * i_]; } while (0)
#define UDOT(row, j) do { float d_ = 0.f; _Pragma("unroll") for (int i_ = 0; i_ < 8; ++i_) { _Pragma("unroll") for (int k_ = 0; k_ < 4; ++k_) \
                { d_ = fmaf(bf_lo(xr[i_][k_]), bf_lo(row[i_][k_]), d_); d_ = fmaf(bf_hi(xr[i_][k_]), bf_hi(row[i_][k_]), d_); } } \
            d_ = wsum(d_) * rstd; const float ge_ = 0.5f * d_ * (1.0f + erff(d_ * 0.70710678118654752f)); if (lane == 0) s_w[j] *= ge_; } while (0)
            u32x4 ra[8], rb[8];
            { const int e0 = RFL(s_eid[0]); LOADROW(ra, U16, e0); }
            for (int j = 0; j < 128; j += 2) {
                { const int e1 = RFL(s_eid[j + 1]); LOADROW(rb, U16, e1); }
                UDOT(ra, j);
                if (j + 2 < 128) { const int e2 = RFL(s_eid[j + 2]); LOADROW(ra, U16, e2); }
                UDOT(rb, j + 1);
            }
#undef UDOT
        }
        LDS_WAIT(); asm volatile("" ::: "memory");
        {
            float acc[8][8];
#pragma unroll
            for (int i = 0; i < 8; ++i)
#pragma unroll
                for (int k = 0; k < 8; ++k) acc[i][k] = 0.f;
#define VACC(row, j) do { const float w_ = s_w[j]; _Pragma("unroll") for (int i_ = 0; i_ < 8; ++i_) { _Pragma("unroll") for (int k_ = 0; k_ < 4; ++k_) { \
                acc[i_][2 * k_] = fmaf(w_, bf_lo(row[i_][k_]), acc[i_][2 * k_]); acc[i_][2 * k_ + 1] = fmaf(w_, bf_hi(row[i_][k_]), acc[i_][2 * k_ + 1]); } } } while (0)
            u32x4 ra[8], rb[8];
            { const int e0 = RFL(s_eid[0]); LOADROW(ra, V16, e0); }
            for (int j = 0; j < 128; j += 2) {
                { const int e1 = RFL(s_eid[j + 1]); LOADROW(rb, V16, e1); }
                VACC(ra, j);
                if (j + 2 < 128) { const int e2 = RFL(s_eid[j + 2]); LOADROW(ra, V16, e2); }
                VACC(rb, j + 1);
            }
#undef VACC
#undef LOADROW
            const float* x1 = X1 + (size_t)tok * D; float* xo = XO + (size_t)tok * D;
            float ss = 0.f;
#pragma unroll
            for (int i = 0; i < 8; ++i) { const int c = 512 * i + 8 * lane; const f32x4 p0 = *(const f32x4*)(x1 + c), p1 = *(const f32x4*)(x1 + c + 4);
                acc[i][0] += p0[0]; acc[i][1] += p0[1]; acc[i][2] += p0[2]; acc[i][3] += p0[3]; acc[i][4] += p1[0]; acc[i][5] += p1[1]; acc[i][6] += p1[2]; acc[i][7] += p1[3];
#pragma unroll
                for (int k = 0; k < 8; ++k) ss += acc[i][k] * acc[i][k]; }
            float rs = 1.f;
            if (FINAL) { ss = wsum(ss); rs = rsqrtf(ss * (1.0f / D) + 1e-6f); }
#pragma unroll
            for (int i = 0; i < 8; ++i) { const int c = 512 * i + 8 * lane; f32x4 o0, o1;
                if (FINAL) { const f32x4 g0 = *(const f32x4*)(fg + c), g1 = *(const f32x4*)(fg + c + 4);
                    o0 = (f32x4){acc[i][0] * rs * g0[0], acc[i][1] * rs * g0[1], acc[i][2] * rs * g0[2], acc[i][3] * rs * g0[3]}; o1 = (f32x4){acc[i][4] * rs * g1[0], acc[i][5] * rs * g1[1], acc[i][6] * rs * g1[2], acc[i][7] * rs * g1[3]}; }
                else { o0 = (f32x4){acc[i][0], acc[i][1], acc[i][2], acc[i][3]}; o1 = (f32x4){acc[i][4], acc[i][5], acc[i][6], acc[i][7]}; }
                *(f32x4*)(xo + c) = o0; *(f32x4*)(xo + c + 4) = o1; }
        }
        LDS_WAIT(); asm volatile("" ::: "memory");
    }
}

template <bool FINAL>
__device__ __forceinline__ void peer_phase8(const float* SC, const float* RSTD, const unsigned char* U8, const unsigned char* V8, const float* X1, float* XO, const float* fg, LAS unsigned char* lds) {
    FRESH_TID(); FRESH_LDS(lds); FRESH_BID();
    LAS int* s_eid = (LAS int*)(lds + wave * 1024); LAS float* s_w = (LAS float*)(lds + wave * 1024 + 512);
    const int gw = bid * NWAVES + wave, NGW = G * NWAVES;
    const float NEG = -3.0e38f;
    for (int tok = gw; tok < M; tok += NGW) {
        const float* sc = SC + (size_t)tok * 2048;
        for (int h = 0; h < 8; ++h) {
            const float a0 = sc[h * 256 + lane], a1 = sc[h * 256 + 64 + lane], c0 = sc[h * 256 + 128 + lane], c1 = sc[h * 256 + 192 + lane];
            unsigned ka0 = (ordkey(a0) & ~127u) | (unsigned)(127 - lane), ka1 = (ordkey(a1) & ~127u) | (unsigned)(63 - lane);
            unsigned kc0 = (ordkey(c0) & ~127u) | (unsigned)(127 - lane), kc1 = (ordkey(c1) & ~127u) | (unsigned)(63 - lane);
            float v1 = 0.f, v2 = 0.f; int i1 = 0, i2 = 0;
            for (int it = 0; it < 16; ++it) {
                const unsigned m1 = wave_max_u32(max(ka0, ka1)), m2 = wave_max_u32(max(kc0, kc1));
                const int n1 = 127 - (int)(m1 & 127u), n2 = 127 - (int)(m2 & 127u);
                const float x1lo = __builtin_bit_cast(float, __builtin_amdgcn_readlane(__builtin_bit_cast(int, a0), n1 & 63)), x1hi = __builtin_bit_cast(float, __builtin_amdgcn_readlane(__builtin_bit_cast(int, a1), n1 & 63));
                const float x2lo = __builtin_bit_cast(float, __builtin_amdgcn_readlane(__builtin_bit_cast(int, c0), n2 & 63)), x2hi = __builtin_bit_cast(float, __builtin_amdgcn_readlane(__builtin_bit_cast(int, c1), n2 & 63));
                ka0 = ka0 == m1 ? 0u : ka0; ka1 = ka1 == m1 ? 0u : ka1; kc0 = kc0 == m2 ? 0u : kc0; kc1 = kc1 == m2 ? 0u : kc1;
                if (lane == it) { v1 = (n1 & 64) ? x1hi : x1lo; i1 = n1; v2 = (n2 & 64) ? x2hi : x2lo; i2 = n2; }
            }
            unsigned kd0, kd1, kd2, kd3;
            { const float va = __shfl(v1, lane >> 2); const int pb_ = 255 - 4 * lane;
              kd0 = (ordkey(va + __shfl(v2, (lane & 3) * 4 + 0)) & ~255u) | (unsigned)(pb_); kd1 = (ordkey(va + __shfl(v2, (lane & 3) * 4 + 1)) & ~255u) | (unsigned)(pb_ - 1);
              kd2 = (ordkey(va + __shfl(v2, (lane & 3) * 4 + 2)) & ~255u) | (unsigned)(pb_ - 2); kd3 = (ordkey(va + __shfl(v2, (lane & 3) * 4 + 3)) & ~255u) | (unsigned)(pb_ - 3); }
            float best = 0.f; int be = 0;
            for (int it = 0; it < 16; ++it) {
                const unsigned m = wave_max_u32(max(max(kd0, kd1), max(kd2, kd3)));
                const int pos = 255 - (int)(m & 255u);
                const float bv = __builtin_bit_cast(float, __builtin_amdgcn_readlane(__builtin_bit_cast(int, v1), pos >> 4)) + __builtin_bit_cast(float, __builtin_amdgcn_readlane(__builtin_bit_cast(int, v2), pos & 15));
                const int e = (__builtin_amdgcn_readlane(i1, pos >> 4) << 7) | __builtin_amdgcn_readlane(i2, pos & 15);
                kd0 = kd0 == m ? 0u : kd0; kd1 = kd1 == m ? 0u : kd1; kd2 = kd2 == m ? 0u : kd2; kd3 = kd3 == m ? 0u : kd3;
                if (lane == it) { best = bv; be = e; }
            }
            const float mx = __builtin_bit_cast(float, __builtin_amdgcn_readlane(__builtin_bit_cast(int, best), 0));
            const float p = lane < 16 ? expf(best - mx) : 0.f;
            const float sm = wave_sum_dpp(p);
            if (lane < 16) { s_eid[h * 16 + lane] = be; s_w[h * 16 + lane] = p / sm; }
        }
        LDS_WAIT(); asm volatile("" ::: "memory");
#define LOADROW8(dst, base, e) do { const u32x4* p_ = (const u32x4*)((base) + (size_t)(e) * D) + lane; _Pragma("unroll") for (int i_ = 0; i_ < 4; ++i_) dst[i_] = p_[64 * i_]; } while (0)
        const float* x1 = X1 + (size_t)tok * D; float* xo = XO + (size_t)tok * D;
        {
            float xv[4][16];
#pragma unroll
            for (int i = 0; i < 4; ++i)
#pragma unroll
                for (int q = 0; q < 4; ++q) { const f32x4 t = *(const f32x4*)(x1 + 1024 * i + 16 * lane + 4 * q); xv[i][4 * q] = t[0]; xv[i][4 * q + 1] = t[1]; xv[i][4 * q + 2] = t[2]; xv[i][4 * q + 3] = t[3]; }
            const float rstd = RSTD[tok] * US_INV;
#define UDOT8(row, j) do { float da_ = 0.f, db_ = 0.f; _Pragma("unroll") for (int i_ = 0; i_ < 4; ++i_) { _Pragma("unroll") for (int k_ = 0; k_ < 4; ++k_) { \
                unsigned w0_ = row[i_][k_]; asm volatile("" : "+v"(w0_));     \
                const f32x2 lo_ = __builtin_amdgcn_cvt_pk_f32_fp8((int)w0_, false), hi_ = __builtin_amdgcn_cvt_pk_f32_fp8((int)w0_, true); \
                da_ = fmaf(xv[i_][4 * k_], lo_[0], da_); db_ = fmaf(xv[i_][4 * k_ + 1], lo_[1], db_); da_ = fmaf(xv[i_][4 * k_ + 2], hi_[0], da_); db_ = fmaf(xv[i_][4 * k_ + 3], hi_[1], db_); } \
                asm volatile("" : "+v"(da_), "+v"(db_)); } \
            const float d_ = wave_sum_dpp(da_ + db_) * rstd; const float ge_ = 0.5f * d_ * (1.0f + erff(d_ * 0.70710678118654752f)); if (lane == 0) s_w[j] *= ge_; } while (0)
            u32x4 r0[4], r1[4], r2[4];
            { const int e_ = RFL(s_eid[0]); LOADROW8(r0, U8, e_); } { const int e_ = RFL(s_eid[1]); LOADROW8(r1, U8, e_); } { const int e_ = RFL(s_eid[2]); LOADROW8(r2, U8, e_); }
            for (int j = 0; j < 126; j += 3) {
                UDOT8(r0, j);     if (j + 3 < 128) { const int e_ = RFL(s_eid[j + 3]); LOADROW8(r0, U8, e_); }
                UDOT8(r1, j + 1); if (j + 4 < 128) { const int e_ = RFL(s_eid[j + 4]); LOADROW8(r1, U8, e_); }
                UDOT8(r2, j + 2); if (j + 5 < 128) { const int e_ = RFL(s_eid[j + 5]); LOADROW8(r2, U8, e_); }
            }
            UDOT8(r0, 126); UDOT8(r1, 127);
#undef UDOT8
        }
        LDS_WAIT(); asm volatile("" ::: "memory");
        {
            float acc[4][16];
#pragma unroll
            for (int i = 0; i < 4; ++i)
#pragma unroll
                for (int k = 0; k < 16; ++k) acc[i][k] = 0.f;
#define VACC8(row, j) do { const float w_ = s_w[j]; _Pragma("unroll") for (int i_ = 0; i_ < 4; ++i_) { _Pragma("unroll") for (int k_ = 0; k_ < 4; ++k_) { \
                unsigned w0_ = row[i_][k_]; asm volatile("" : "+v"(w0_)); \
                const f32x2 lo_ = __builtin_amdgcn_cvt_pk_f32_fp8((int)w0_, false), hi_ = __builtin_amdgcn_cvt_pk_f32_fp8((int)w0_, true); \
                acc[i_][4 * k_] = fmaf(w_, lo_[0], acc[i_][4 * k_]); acc[i_][4 * k_ + 1] = fmaf(w_, lo_[1], acc[i_][4 * k_ + 1]); acc[i_][4 * k_ + 2] = fmaf(w_, hi_[0], acc[i_][4 * k_ + 2]); acc[i_][4 * k_ + 3] = fmaf(w_, hi_[1], acc[i_][4 * k_ + 3]); } \
                asm volatile("" : "+v"(acc[i_][0]), "+v"(acc[i_][1]), "+v"(acc[i_][2]), "+v"(acc[i_][3]), "+v"(acc[i_][4]), "+v"(acc[i_][5]), "+v"(acc[i_][6]), "+v"(acc[i_][7]), \
                                  "+v"(acc[i_][8]), "+v"(acc[i_][9]), "+v"(acc[i_][10]), "+v"(acc[i_][11]), "+v"(acc[i_][12]), "+v"(acc[i_][13]), "+v"(acc[i_][14]), "+v"(acc[i_][15])); } } while (0)
            u32x4 r0[4], r1[4], r2[4];
            { const int e_ = RFL(s_eid[0]); LOADROW8(r0, V8, e_); } { const int e_ = RFL(s_eid[1]); LOADROW8(r1, V8, e_); } { const int e_ = RFL(s_eid[2]); LOADROW8(r2, V8, e_); }
            for (int j = 0; j < 126; j += 3) {
                VACC8(r0, j);     if (j + 3 < 128) { const int e_ = RFL(s_eid[j + 3]); LOADROW8(r0, V8, e_); }
                VACC8(r1, j + 1); if (j + 4 < 128) { const int e_ = RFL(s_eid[j + 4]); LOADROW8(r1, V8, e_); }
                VACC8(r2, j + 2); if (j + 5 < 128) { const int e_ = RFL(s_eid[j + 5]); LOADROW8(r2, V8, e_); }
            }
            VACC8(r0, 126); VACC8(r1, 127);
#undef VACC8
#undef LOADROW8
            float ss = 0.f;
#pragma unroll
            for (int i = 0; i < 4; ++i)
#pragma unroll
                for (int q = 0; q < 4; ++q) { const f32x4 t = *(const f32x4*)(x1 + 1024 * i + 16 * lane + 4 * q);
#pragma unroll
                    for (int k = 0; k < 4; ++k) { acc[i][4 * q + k] = fmaf(acc[i][4 * q + k], VS_INV, t[k]); ss += acc[i][4 * q + k] * acc[i][4 * q + k]; } }
            float rs = 1.f;
            if (FINAL) { ss = wsum(ss); rs = rsqrtf(ss * (1.0f / D) + 1e-6f); }
#pragma unroll
            for (int i = 0; i < 4; ++i)
#pragma unroll
                for (int q = 0; q < 4; ++q) { const int c = 1024 * i + 16 * lane + 4 * q; f32x4 o_;
                    if (FINAL) { const f32x4 g_ = *(const f32x4*)(fg + c); o_ = (f32x4){acc[i][4 * q] * rs * g_[0], acc[i][4 * q + 1] * rs * g_[1], acc[i][4 * q + 2] * rs * g_[2], acc[i][4 * q + 3] * rs * g_[3]}; }
                    else o_ = (f32x4){acc[i][4 * q], acc[i][4 * q + 1], acc[i][4 * q + 2], acc[i][4 * q + 3]};
                    *(f32x4*)(xo + c) = o_; }
        }
        LDS_WAIT(); asm volatile("" ::: "memory");
    }
}
}
namespace at {
using namespace mk;
constexpr int QB = 256, KVB = 64, HD = 128;
constexpr int SHM_V = KVB * HD * 2, SHM_K = KVB * HD * 2;
constexpr int OFF_V = 0, OFF_K = 2 * SHM_V, OFF_WS = OFF_K + 2 * SHM_K, OFF_CUM = OFF_WS + 8 * 256, OFF_RT = OFF_CUM + 2048 * 4, OFF_MISC = OFF_RT + 640 * 4;
constexpr float LOG2E = 1.4426950408889634f;
constexpr float THR2 = 10.0f;
constexpr float SB_DONE = -100.0f;

#define AT_KSWZ(row, colB) ((row) * 256 + ((colB) ^ (((row) & 7) << 4)))
__device__ __forceinline__ int v_st(int k, int c) { const int kk = (k & ~0xC) | ((k & 4) << 1) | ((k & 8) >> 1); return ((kk >> 3) * 4 + (c >> 5)) * 512 + ((kk & 7) * 32 + (c & 31)) * 2; }
__device__ __forceinline__ int v_rd_base(int lane) { return ((lane & 3) << 3) | (((lane >> 2) & 3) << 6) | (((lane >> 4) & 1) << 5) | (((lane >> 5) & 1) << 8); }
constexpr int v_rd_off(int d0, int ks, int half) { return d0 * 512 + ks * 4096 + half * 2048; }
__device__ __forceinline__ int crow(int r, int hi) { return (r & 3) + 8 * (r >> 2) + 4 * hi; }
__device__ __forceinline__ unsigned cvtpk(float lo, float hi) { unsigned r; asm volatile("v_cvt_pk_bf16_f32 %0, %1, %2" : "=v"(r) : "v"(lo), "v"(hi)); return r; }
__device__ __forceinline__ float partner(float v, int hi) { auto rr = __builtin_amdgcn_permlane32_swap(__builtin_bit_cast(unsigned, v), __builtin_bit_cast(unsigned, v), false, false); return __builtin_bit_cast(float, hi ? rr[0] : rr[1]); }

__device__ __forceinline__ float xchg_max(float v, int hi) { return fmaxf(v, partner(v, hi)); }
__device__ __forceinline__ float xchg_sum(float v, int hi) { return v + partner(v, hi); }

__device__ __forceinline__ void pack_p(const f32x16& p0, const f32x16& p1, bf16x8& pa0, bf16x8& pa1, bf16x8& pa2, bf16x8& pa3) {
#define AT_PK4(P, B_, OUT) do { unsigned a0 = cvtpk(P[B_ + 0], P[B_ + 1]), a1 = cvtpk(P[B_ + 2], P[B_ + 3]); unsigned b0 = cvtpk(P[B_ + 4], P[B_ + 5]), b1 = cvtpk(P[B_ + 6], P[B_ + 7]); \
        auto r0 = __builtin_amdgcn_permlane32_swap(a0, b0, false, false); auto r1 = __builtin_amdgcn_permlane32_swap(a1, b1, false, false); \
        u32x4 w = {r0[0], r1[0], r0[1], r1[1]}; OUT = __builtin_bit_cast(bf16x8, w); } while (0)
    AT_PK4(p0, 0, pa0); AT_PK4(p0, 8, pa1); AT_PK4(p1, 0, pa2); AT_PK4(p1, 8, pa3);
#undef AT_PK4
}
template <int KBUF>
__device__ __forceinline__ void qkt(f32x16& p0, f32x16& p1, LAS unsigned char* K_lds, int r32, int hi, const bf16x8 (&qr)[8]) {
    p0 = f32x16{}; p1 = f32x16{};
    LAS unsigned char* kb[4];
#pragma unroll
    for (int dd = 0; dd < 4; ++dd) kb[dd] = K_lds + KBUF * SHM_K + AT_KSWZ(r32, (dd * 16 + hi * 8) * 2);
#pragma unroll
    for (int d0 = 0; d0 < 8; ++d0) { LAS unsigned char* a = kb[d0 & 3] + (d0 >> 2) * 128;
        const bf16x8 b0 = *(const LAS bf16x8*)a; const bf16x8 b1 = *(const LAS bf16x8*)(a + 32 * 256);
        p0 = __builtin_amdgcn_mfma_f32_32x32x16_bf16(b0, qr[d0], p0, 0, 0, 0);
        p1 = __builtin_amdgcn_mfma_f32_32x32x16_bf16(b1, qr[d0], p1, 0, 0, 0); }
}
template <int VBUF>
__device__ __forceinline__ void pv_tile(f32x16 (&o)[4], int vb0, bf16x8 pa0, bf16x8 pa1, bf16x8 pa2, bf16x8 pa3) {
#define AT_TRRD(dst, off) asm volatile("ds_read_b64_tr_b16 %0, %1 offset:%2" : "=&v"(dst) : "v"(vb0), "i"(off) : "memory")
#define AT_PV_D0(d0) do { s16x4 l0, l1, l2, l3, h0, h1, h2, h3; constexpr int b_ = VBUF * SHM_V + v_rd_off(d0, 0, 0); \
        AT_TRRD(l0, b_); AT_TRRD(h0, b_ + 2048); AT_TRRD(l1, b_ + 4096); AT_TRRD(h1, b_ + 6144); AT_TRRD(l2, b_ + 8192); AT_TRRD(h2, b_ + 10240); AT_TRRD(l3, b_ + 12288); AT_TRRD(h3, b_ + 14336); \
        asm volatile("s_waitcnt lgkmcnt(0)" ::: "memory"); __builtin_amdgcn_sched_barrier(0); \
        o[d0] = __builtin_amdgcn_mfma_f32_32x32x16_bf16(pa0, (bf16x8){l0[0], l0[1], l0[2], l0[3], h0[0], h0[1], h0[2], h0[3]}, o[d0], 0, 0, 0); \
        o[d0] = __builtin_amdgcn_mfma_f32_32x32x16_bf16(pa1, (bf16x8){l1[0], l1[1], l1[2], l1[3], h1[0], h1[1], h1[2], h1[3]}, o[d0], 0, 0, 0); \
        o[d0] = __builtin_amdgcn_mfma_f32_32x32x16_bf16(pa2, (bf16x8){l2[0], l2[1], l2[2], l2[3], h2[0], h2[1], h2[2], h2[3]}, o[d0], 0, 0, 0); \
        o[d0] = __builtin_amdgcn_mfma_f32_32x32x16_bf16(pa3, (bf16x8){l3[0], l3[1], l3[2], l3[3], h3[0], h3[1], h3[2], h3[3]}, o[d0], 0, 0, 0); } while (0)
    AT_PV_D0(0); AT_PV_D0(1); AT_PV_D0(2); AT_PV_D0(3);
#undef AT_PV_D0
#undef AT_TRRD
}

template <int VAR>
__device__ __forceinline__ void attn_item(const bf16_t* Qh, const bf16_t* Kh, const bf16_t* Vh, bf16_t* OB, const float* relb, const float* LOGF, int b, int h, int qb, LAS unsigned char* lds, int tid) {
    const int wid = __builtin_amdgcn_readfirstlane(tid >> 6), lane = tid & 63, r32 = lane & 31, hi = lane >> 5;
    const int g = VAR == 0 ? h : (VAR == 1 ? 12 + h : 22 + h);
    const size_t hb = (size_t)(b * NH + g) * S * HD;
    const bf16_t* Kp = Kh + hb; const bf16_t* Vp = Vh + hb;
    LAS unsigned char* V_lds = lds + OFF_V; LAS unsigned char* K_lds = lds + OFF_K;
    LAS float* wsf = (LAS float*)(lds + OFF_WS) + wid * 64; LAS float* li_l = wsf; LAS float* al_l = wsf + 32;
    LAS float* cumL = (LAS float*)(lds + OFF_CUM); LAS float* Rt = (LAS float*)(lds + OFF_RT); volatile LAS unsigned* flags = (volatile LAS unsigned*)(lds + OFF_MISC);
    const int P0 = qb * QB, qlo = P0 + wid * 32, qpos = qlo + r32;
    int NT, jlo = 0;
    if (VAR == 0) { jlo = 4 * qb - 8; if (jlo < 0) jlo = 0; NT = 4 * qb + 4 - jlo; } else NT = 4 * qb + 4;
    const int cw = 4 * qb + (wid >> 1);
#define AT_KBASE(t) (VAR == 1 ? (4 * qb + 3 - (t)) * KVB : (jlo + (t)) * KVB)
#define AT_ACT(t) (VAR == 0 ? ((jlo + (t)) >= cw - 8 && (jlo + (t)) <= cw) : (VAR == 1 ? (AT_KBASE(t) <= qlo + 30) : (AT_KBASE(t) <= qlo + 31)))
    if (VAR == 0) {
        const float* tab = relb + h * 257;
        for (int j = tid; j < 639; j += 512) { int rel = 575 - j; rel = rel < -128 ? -128 : (rel > 128 ? 128 : rel); Rt[j] = tab[rel + 128] * LOG2E; }
    }
    if (VAR == 2) {
        const float* lf = LOGF + (size_t)(b * 10 + h) * S; const int kend = P0 + QB;
        f32x4 v = (f32x4){0.f, 0.f, 0.f, 0.f};
        if (4 * tid < kend) v = *(const f32x4*)(lf + 4 * tid);
        v[1] += v[0]; v[2] += v[1]; v[3] += v[2];
        float tot = v[3];
#pragma unroll
        for (int o = 1; o < 64; o <<= 1) { const float t_ = __shfl_up(tot, o); if (lane >= o) tot += t_; }
        if (lane == 63) li_l[0] = tot;
        __syncthreads();
        float base = tot - v[3];
        for (int w = 0; w < wid; ++w) base += ((LAS float*)(lds + OFF_WS))[w * 64];
        if (4 * tid < kend) *(LAS f32x4*)(cumL + 4 * tid) = (f32x4){(base + v[0]) * LOG2E, (base + v[1]) * LOG2E, (base + v[2]) * LOG2E, (base + v[3]) * LOG2E};
    }
    bf16x8 qr[8];
    { const bf16_t* qp = Qh + hb + (size_t)(qlo + r32) * HD + hi * 8;
#pragma unroll
      for (int d0 = 0; d0 < 8; ++d0) qr[d0] = *(const bf16x8*)(qp + d0 * 16); }
    const int sr = tid >> 4, sc = (tid & 15) * 8, vst0 = v_st(sr, sc), vst1 = v_st(32 + sr, sc), kws = AT_KSWZ(sr, sc * 2);
    const int vb0 = (int)(unsigned)(size_t)V_lds + v_rd_base(lane);
    bf16x8 st_k0, st_k1, st_v0, st_v1;
#define AT_SLOAD(k0) do { const bf16_t* kp_ = Kp + (size_t)((k0) + sr) * HD + sc; const bf16_t* vp_ = Vp + (size_t)((k0) + sr) * HD + sc; \
        st_k0 = *(const bf16x8*)kp_; st_k1 = *(const bf16x8*)(kp_ + 32 * HD); st_v0 = *(const bf16x8*)vp_; st_v1 = *(const bf16x8*)(vp_ + 32 * HD); } while (0)
#define AT_SWRITE(bf) do { *(LAS bf16x8*)(K_lds + (bf) * SHM_K + kws) = st_k0; *(LAS bf16x8*)(K_lds + (bf) * SHM_K + kws + 32 * 256) = st_k1; \
        *(LAS bf16x8*)(V_lds + (bf) * SHM_V + vst0) = st_v0; *(LAS bf16x8*)(V_lds + (bf) * SHM_V + vst1) = st_v1; } while (0)
    AT_SLOAD(AT_KBASE(0)); asm volatile("s_waitcnt vmcnt(0)" ::: "memory"); AT_SWRITE(0);
    __syncthreads();
    float m_reg = -1e30f, l_reg = 0.f, carry = 0.f;
    f32x16 o[4] = {};
#define AT_STEP(BUF, t) do { \
        const bool more_ = (t) + 1 < NT; \
        if (more_) AT_SLOAD(AT_KBASE((t) + 1)); \
        if (AT_ACT(t)) { \
            const int kb_ = AT_KBASE(t); f32x16 p0, p1; bf16x8 pa0, pa1, pa2, pa3; \
            qkt<BUF>(p0, p1, K_lds, r32, hi, qr); \
            tile_math(p0, p1, kb_, pa0, pa1, pa2, pa3); \
            pv_tile<BUF>(o, vb0, pa0, pa1, pa2, pa3); \
        } \
        if (more_) { asm volatile("s_waitcnt vmcnt(0)" ::: "memory"); AT_SWRITE((BUF) ^ 1); } \
        if (VAR == 1) { const bool done_ = __all(carry < SB_DONE); if (lane == 0) flags[((t) & 1) * 8 + wid] = done_ ? 1u : 0u; } \
        __syncthreads(); \
    } while (0)
    auto tile_math = [&](f32x16& p0, f32x16& p1, int kb, bf16x8& pa0, bf16x8& pa1, bf16x8& pa2, bf16x8& pa3) __attribute__((always_inline)) {
        const int dq = qpos - kb - 4 * hi;
        if (VAR == 1) {
            const bool need_mask = kb + 63 >= qlo;
            f32x16 n0, n1;
#pragma unroll
            for (int r = 0; r < 16; ++r) { const float z = p0[r]; const float lp = __builtin_amdgcn_logf(1.0f + __builtin_amdgcn_exp2f(-fabsf(z))); n0[r] = fminf(-z, 0.f) - lp;
                                           const float y = p1[r]; const float lq = __builtin_amdgcn_logf(1.0f + __builtin_amdgcn_exp2f(-fabsf(y))); n1[r] = fminf(-y, 0.f) - lq; }
            if (need_mask) {
#pragma unroll
                for (int r = 0; r < 16; ++r) { const int c = (r & 3) + 8 * (r >> 2);
                    if (dq - c <= 0) { n0[r] = 0.f; p0[r] = -__builtin_inff(); }
                    if (dq - c - 32 <= 0) { n1[r] = 0.f; p1[r] = -__builtin_inff(); } }
            }
            float A[8], Bp[8];
#pragma unroll
            for (int q = 0; q < 4; ++q) { A[q] = (n0[4 * q] + n0[4 * q + 1]) + (n0[4 * q + 2] + n0[4 * q + 3]); A[4 + q] = (n1[4 * q] + n1[4 * q + 1]) + (n1[4 * q + 2] + n1[4 * q + 3]); }
#pragma unroll
            for (int q = 0; q < 8; ++q) Bp[q] = partner(A[q], hi);
            float st = 0.f;
#pragma unroll
            for (int q = 7; q >= 0; --q) {
                const float after = carry + st + (hi == 0 ? Bp[q] : 0.f);
                if (q >= 4) { const int r0 = 4 * (q - 4);
                    float tl = after; p1[r0 + 3] = __builtin_amdgcn_exp2f(p1[r0 + 3] + n1[r0 + 3] + tl); tl += n1[r0 + 3]; p1[r0 + 2] = __builtin_amdgcn_exp2f(p1[r0 + 2] + n1[r0 + 2] + tl); tl += n1[r0 + 2];
                    p1[r0 + 1] = __builtin_amdgcn_exp2f(p1[r0 + 1] + n1[r0 + 1] + tl); tl += n1[r0 + 1]; p1[r0] = __builtin_amdgcn_exp2f(p1[r0] + n1[r0] + tl); }
                else { const int r0 = 4 * q;
                    float tl = after; p0[r0 + 3] = __builtin_amdgcn_exp2f(p0[r0 + 3] + n0[r0 + 3] + tl); tl += n0[r0 + 3]; p0[r0 + 2] = __builtin_amdgcn_exp2f(p0[r0 + 2] + n0[r0 + 2] + tl); tl += n0[r0 + 2];
                    p0[r0 + 1] = __builtin_amdgcn_exp2f(p0[r0 + 1] + n0[r0 + 1] + tl); tl += n0[r0 + 1]; p0[r0] = __builtin_amdgcn_exp2f(p0[r0] + n0[r0] + tl); }
                st += A[q] + Bp[q];
            }
            carry += st;
            pack_p(p0, p1, pa0, pa1, pa2, pa3);
        } else {
            if (VAR == 0) {
                const LAS float* rp = Rt + (575 - (qpos - kb) + 4 * hi);
#pragma unroll
                for (int r = 0; r < 16; ++r) { const int c = (r & 3) + 8 * (r >> 2); p0[r] += rp[c]; p1[r] += rp[c + 32]; }
            } else {
                const LAS float* cp = cumL + kb + 4 * hi;
#pragma unroll
                for (int q = 0; q < 4; ++q) { const f32x4 c0 = *(const LAS f32x4*)(cp + 8 * q), c1 = *(const LAS f32x4*)(cp + 32 + 8 * q);
                    p0[4 * q] -= c0[0]; p0[4 * q + 1] -= c0[1]; p0[4 * q + 2] -= c0[2]; p0[4 * q + 3] -= c0[3];
                    p1[4 * q] -= c1[0]; p1[4 * q + 1] -= c1[1]; p1[4 * q + 2] -= c1[2]; p1[4 * q + 3] -= c1[3]; }
                if (kb + 63 > qlo) {
#pragma unroll
                    for (int r = 0; r < 16; ++r) { const int c = (r & 3) + 8 * (r >> 2);
                        if (dq - c < 0) p0[r] = -__builtin_inff();
                        if (dq - c - 32 < 0) p1[r] = -__builtin_inff(); }
                }
            }
            float pmax = p0[0];
#pragma unroll
            for (int r = 1; r < 16; ++r) pmax = fmaxf(pmax, p0[r]);
#pragma unroll
            for (int r = 0; r < 16; ++r) pmax = fmaxf(pmax, p1[r]);
            pmax = xchg_max(pmax, hi);
            float mn, alpha;
            if (__all(pmax - m_reg <= THR2)) { mn = m_reg; alpha = 1.f; }
            else { mn = fmaxf(m_reg, pmax); alpha = __builtin_amdgcn_exp2f(m_reg - mn); m_reg = mn; }
            float ps = 0.f;
#pragma unroll
            for (int r = 0; r < 16; ++r) { p0[r] = __builtin_amdgcn_exp2f(p0[r] - mn); p1[r] = __builtin_amdgcn_exp2f(p1[r] - mn); ps += p0[r] + p1[r]; }
            ps = xchg_sum(ps, hi);
            l_reg = l_reg * alpha + ps;
            if (__any(alpha < 1.f)) {
                if (hi == 0) al_l[r32] = alpha;
                asm volatile("s_waitcnt lgkmcnt(0)" ::: "memory");
                float av[16];
#pragma unroll
                for (int r = 0; r < 16; ++r) av[r] = al_l[crow(r, hi)];
#pragma unroll
                for (int d = 0; d < 4; ++d)
#pragma unroll
                    for (int r = 0; r < 16; ++r) o[d][r] *= av[r];
            }
            pack_p(p0, p1, pa0, pa1, pa2, pa3);
        }
    };
    for (int t = 0; t < NT; t += 2) {
        AT_STEP(0, t);
        if (VAR == 1) { unsigned all_ = 1u; for (int w = 0; w < 8; ++w) all_ &= flags[(t & 1) * 8 + w]; if (all_) break; }
        if (t + 1 >= NT) break;
        AT_STEP(1, t + 1);
        if (VAR == 1) { unsigned all_ = 1u; for (int w = 0; w < 8; ++w) all_ &= flags[((t + 1) & 1) * 8 + w]; if (all_) break; }
    }
    float rli[16];
    if (VAR != 1) {
        if (hi == 0) li_l[r32] = l_reg;
        asm volatile("s_waitcnt lgkmcnt(0)" ::: "memory");
#pragma unroll
        for (int r = 0; r < 16; ++r) rli[r] = __builtin_amdgcn_rcpf(li_l[crow(r, hi)]);
    }
    bf16_t* Ow = OB + (size_t)(b * S + qlo) * D + g * HD;
#pragma unroll
    for (int r = 0; r < 16; ++r) { const int orow = crow(r, hi);
#pragma unroll
        for (int d0 = 0; d0 < 4; ++d0) { const float v = VAR != 1 ? o[d0][r] * rli[r] : o[d0][r];
            const float vn = __shfl_xor(v, 1);
            if ((r32 & 1) == 0) *(unsigned*)(Ow + (size_t)orow * D + d0 * 32 + r32) = cvtpk(v, vn); } }
    __syncthreads();
#undef AT_STEP
#undef AT_SLOAD
#undef AT_SWRITE
#undef AT_KBASE
#undef AT_ACT
}

template <int VAR>
__device__ __forceinline__ void attn_queue(const bf16_t* Qh, const bf16_t* Kh, const bf16_t* Vh, bf16_t* OB, const float* relb, const float* LOGF, unsigned* qhead, LAS unsigned char* lds) {
    FRESH_TID(); FRESH_LDS(lds);
    volatile LAS unsigned* qslot = (volatile LAS unsigned*)(lds + OFF_MISC) + 32;
    constexpr int NHV = VAR == 0 ? 12 : 10, NITEMS = 8 * NHV * 8;
    for (;;) {
        if (tid == 0) qslot[0] = __hip_atomic_fetch_add(qhead, 1u, __ATOMIC_RELAXED, __HIP_MEMORY_SCOPE_AGENT);
        __syncthreads();
        const int idx = (int)qslot[0];
        __syncthreads();
        if (idx >= NITEMS) break;
        const int qb = 7 - idx / (8 * NHV), bh = idx % (8 * NHV);
        attn_item<VAR>(Qh, Kh, Vh, OB, relb, LOGF, bh / NHV, bh % NHV, qb, lds, tid);
    }
}
__device__ __forceinline__ void attn_phase(const bf16_t* Qh, const bf16_t* Kh, const bf16_t* Vh, bf16_t* OB, const float* relb, const float* LOGF, unsigned* qheads, LAS unsigned char* lds) {
    attn_queue<2>(Qh, Kh, Vh, OB, relb, LOGF, qheads + 0, lds);
    attn_queue<0>(Qh, Kh, Vh, OB, relb, LOGF, qheads + 64, lds);
    attn_queue<1>(Qh, Kh, Vh, OB, relb, LOGF, qheads + 128, lds);
}
}
namespace mk {
#define XB_TMO      128
#define XB_XCNT(j)  (256  + 64 * (j))
#define XB_XSUB(j)  (1280 + 64 * (j))
#define XB_XGEN(j)  (2304 + 64 * (j))
#define XB_TOP      3328
#define XB_TOPGEN   3392
#define XCD_BAR_WORDS 3456
#define XB_SPIN_CAP (1u << 22)

__device__ __forceinline__ unsigned xb_ld(unsigned* p)              { return __hip_atomic_load(p, __ATOMIC_RELAXED, __HIP_MEMORY_SCOPE_AGENT); }
__device__ __forceinline__ unsigned xb_add(unsigned* p, unsigned v) { return __hip_atomic_fetch_add(p, v, __ATOMIC_RELAXED, __HIP_MEMORY_SCOPE_AGENT); }
__device__ __forceinline__ unsigned xb_xcc_id() { return (unsigned)__builtin_amdgcn_s_getreg((3 << 11) | 20) & 0xFu; }
#define XB_SPIN(cond, bar) do { unsigned _sp = 0; while (cond) { __builtin_amdgcn_s_sleep(1); \
    if ((++_sp & 255u) == 0u) { if (xb_ld(&(bar)[XB_TMO])) break; if (_sp > XB_SPIN_CAP) { atomicAdd(&(bar)[XB_TMO], 1u); break; } } } } while (0)

struct XcdBarrier {
    unsigned* bar; unsigned x;
    volatile LAS unsigned* st;
};

__device__ __forceinline__ XcdBarrier xcd_barrier_post(unsigned* bar, volatile LAS unsigned* st) {
    XcdBarrier b; b.bar = bar; b.x = xb_xcc_id(); b.st = st;
    if (threadIdx.x == 0) (void)xb_add(&bar[XB_XCNT(b.x)], 1u);
    return b;
}
__device__ __forceinline__ void xcd_barrier_complete(unsigned* bar, unsigned x, unsigned& nloc, unsigned& nx) {
    const unsigned G = gridDim.x * gridDim.y * gridDim.z;
    unsigned sum, cnt, mine, sp = 0u;
    for (;;) {
        sum = 0u; cnt = 0u; mine = 0u;
#pragma unroll
        for (unsigned j = 0; j < 16; ++j) { const unsigned c = xb_ld(&bar[XB_XCNT(j)]); sum += c; cnt += (c > 0u) ? 1u : 0u; mine = (j == x) ? c : mine; }
        if (sum == G) break;
        __builtin_amdgcn_s_sleep(1);
        if ((++sp & 255u) == 0u) { if (xb_ld(&bar[XB_TMO])) break; if (sp > XB_SPIN_CAP) { atomicAdd(&bar[XB_TMO], 1u); break; } }
    }
    nloc = mine > 0u ? mine : 1u; nx = cnt > 0u ? cnt : 1u;
}

__device__ __forceinline__ void xcd_barrier(const XcdBarrier& b) {
    asm volatile("s_waitcnt vmcnt(0)" ::: "memory");
    __syncthreads();
    if (threadIdx.x == 0) {
        unsigned* bar = b.bar;
        __builtin_amdgcn_s_waitcnt(0);
        unsigned nloc = b.st[0], nx = b.st[1];
        if (nloc == 0u) { xcd_barrier_complete(bar, b.x, nloc, nx); b.st[0] = nloc; b.st[1] = nx; }
        const unsigned old = xb_add(&bar[XB_XSUB(b.x)], 1u);
        const unsigned gen = old / nloc;
        if (old + 1u == (gen + 1u) * nloc) {
            __builtin_amdgcn_fence(__ATOMIC_RELEASE, "agent");
            asm volatile("s_waitcnt vmcnt(0)" ::: "memory");
            const unsigned og = xb_add(&bar[XB_TOP], 1u);
            const unsigned tg = og / nx;
            if (og + 1u == (tg + 1u) * nx) xb_add(&bar[XB_TOPGEN], 1u);
            else XB_SPIN(xb_ld(&bar[XB_TOPGEN]) == tg, bar);
            __builtin_amdgcn_fence(__ATOMIC_ACQUIRE, "agent");
            xb_add(&bar[XB_XGEN(b.x)], 1u);
            asm volatile("s_waitcnt vmcnt(0)" ::: "memory");
        } else {
            XB_SPIN(xb_ld(&bar[XB_XGEN(b.x)]) == gen, bar);
            __builtin_amdgcn_fence(__ATOMIC_ACQUIRE, "agent");
            asm volatile("s_waitcnt vmcnt(0)" ::: "memory");
        }
    }
    __syncthreads();
}

constexpr int PH_PER_LAYER = 8;
typedef const __attribute__((address_space(4))) Args* KArgs;
#define KARGS() ({ KArgs p_ = (KArgs)__builtin_amdgcn_kernarg_segment_ptr(); asm volatile("" : "+s"(p_)); p_; })
#define GRID_BAR() do { KArgs k_ = KARGS(); XcdBarrier b_; b_.bar = (unsigned*)(k_->ws + WS_CTL) + CW_BAR; b_.x = xb_xcc_id(); b_.st = (volatile LAS unsigned*)(lds + MISC_OFF) + 8; xcd_barrier(b_); } while (0)
__global__ void __launch_bounds__(NWAVES * 64, 2) mk_fwd(Args a_unused) {
    extern __shared__ __attribute__((aligned(16))) unsigned char lds_raw[];
    LAS unsigned char* lds = (LAS unsigned char*)lds_raw;
    for (int u = threadIdx.x; u < (LDS_BYTES - LDSCTL_OFF) / 4; u += NWAVES * 64) ((LAS unsigned*)(lds + LDSCTL_OFF))[u] = 0u;
    __syncthreads();
    int lo, hi;
    { KArgs k = KARGS(); lo = k->ph_lo; hi = k->ph_hi;
      if (hi - lo > 1) (void)xcd_barrier_post((unsigned*)(k->ws + WS_CTL) + CW_BAR, (volatile LAS unsigned*)(lds + MISC_OFF) + 8); }
#define IN(k) (lo <= (k) && (k) < hi)
#define BOTH(k) (IN(k) && IN((k) + 1))
#pragma unroll
    for (int l = 0; l < 2; ++l) {
        const int pb = PH_PER_LAYER * l;
        if (IN(pb + 0)) { KArgs k = KARGS(); conv_phase(k, l, lds); }
        if (IN(pb + 1)) {
            KArgs k = KARGS(); unsigned char* ws = k->ws;
            const float* xin = l == 0 ? k->in[0] : (const float*)(ws + WS_X2);
            prep_phase<true>(xin, (bf16_t*)(ws + WS_XB), (float*)(ws + WS_RSTD), k->in[2] + (size_t)l * D * PW, k->in[1] + (size_t)l * D, k->in[3] + l * 10, (float*)(ws + WS_LOGF), lds);
            if (BOTH(pb + 1)) GRID_BAR();
        }
        if (IN(pb + 2)) {
            KArgs k = KARGS(); unsigned char* ws = k->ws;
            pg8::Gemm g{(const bf16_t*)(ws + WS_XB), (const bf16_t*)(ws + WS_WIN), M, 12288, D}; pg8::StaticOrder So; FRESH_BID(); So.init(M, 12288, G, bid);
            pg8::EpiQKV4 E{(bf16_t*)(ws + WS_Q), (const float*)(ws + WS_RSTD), 0.08838834764831845f * 1.4426950408889634f};
            { LAS unsigned char* lds_ = lds; FRESH_LDS(lds_); pg8::gemm_phase<pg8::EpiQKV4, pg8::StaticOrder, true, true>(lds_, g, So, E); }
            if (BOTH(pb + 2)) GRID_BAR();
        }
        if (IN(pb + 3)) {
            KArgs k = KARGS(); unsigned char* ws = k->ws;
            at::attn_phase((const bf16_t*)(ws + WS_Q), (const bf16_t*)(ws + WS_K), (const bf16_t*)(ws + WS_V), (bf16_t*)(ws + WS_OB), k->in[4] + (size_t)l * 12 * 257, (const float*)(ws + WS_LOGF),
                           (unsigned*)(ws + WS_CTL) + CW_QUEUE + 256 * l, lds);
            if (BOTH(pb + 3)) GRID_BAR();
        }
        if (IN(pb + 4)) {
            KArgs k = KARGS(); unsigned char* ws = k->ws;
            const float* xin = l == 0 ? k->in[0] : (const float*)(ws + WS_X2);
            pg8::Gemm g{(const bf16_t*)(ws + WS_OB), (const bf16_t*)(ws + WS_WOUT), M, D, D}; pg8::StaticOrder So; FRESH_BID(); So.init(M, D, G, bid);
            pg8::EpiResidF32 E{xin, k->out};
            { LAS unsigned char* lds_ = lds; FRESH_LDS(lds_); pg8::gemm_phase<pg8::EpiResidF32, pg8::StaticOrder, true, true>(lds_, g, So, E); }
            if (BOTH(pb + 4)) GRID_BAR();
        }
        if (IN(pb + 5)) {
            KArgs k = KARGS(); unsigned char* ws = k->ws;
            prep_phase<false>(k->out, (bf16_t*)(ws + WS_XB), (float*)(ws + WS_RSTD), nullptr, nullptr, nullptr, nullptr, lds);
            if (BOTH(pb + 5)) GRID_BAR();
        }
        if (IN(pb + 6)) {
            KArgs k = KARGS(); unsigned char* ws = k->ws;
            pg8::Gemm g{(const bf16_t*)(ws + WS_XB), (const bf16_t*)(ws + WS_WQK), M, 2048, D}; pg8::StaticOrder So; FRESH_BID(); So.init(M, 2048, G, bid);
            pg8::EpiRowScaleF32<2048> E{(float*)(ws + WS_SC), (const float*)(ws + WS_RSTD)};
            { LAS unsigned char* lds_ = lds; FRESH_LDS(lds_); pg8::gemm_phase<pg8::EpiRowScaleF32<2048>, pg8::StaticOrder, true, true>(lds_, g, So, E); }
            if (BOTH(pb + 6)) GRID_BAR();
        }
        if (IN(pb + 7)) {
            KArgs k = KARGS(); unsigned char* ws = k->ws;
            if (l == 0) peer_phase8<false>((const float*)(ws + WS_SC), (const float*)(ws + WS_RSTD), (const unsigned char*)(ws + WS_U16), (const unsigned char*)(ws + WS_U16) + (size_t)NE * D, k->out, (float*)(ws + WS_X2), nullptr, lds);
            else peer_phase8<true>((const float*)(ws + WS_SC), (const float*)(ws + WS_RSTD), (const unsigned char*)(ws + WS_U16), (const unsigned char*)(ws + WS_U16) + (size_t)NE * D, k->out, k->out, k->in[12], lds);
            if (BOTH(pb + 7)) GRID_BAR();
        }
    }
#undef IN
#undef BOTH
}

static int g_grid = 0;
static void launch_phases(Args a, int lo, int hi, hipStream_t st) {
    a.ph_lo = lo; a.ph_hi = hi;
    hipLaunchKernelGGL(mk_fwd, dim3(g_grid), dim3(NWAVES * 64), LDS_BYTES, st, a);
}
}

extern "C" void kernel_launch(void* const* d_in, const int* in_sizes, int n_in, void* d_out, int out_size, void* d_ws, size_t ws_size, hipStream_t stream) {
    (void)in_sizes; (void)n_in; (void)out_size;
    using namespace mk;
    if (g_grid == 0) {
        if (ws_size < 2048 * MiB) { fprintf(stderr, "kernel_launch: workspace too small (%zu)\n", ws_size); g_grid = -1; return; }
        if (hipFuncSetAttribute((const void*)mk_fwd, hipFuncAttributeMaxDynamicSharedMemorySize, LDS_BYTES) != hipSuccess) { fprintf(stderr, "kernel_launch: hipFuncSetAttribute failed\n"); g_grid = -1; return; }
        int dev = 0, cus = 0; (void)hipGetDevice(&dev); (void)hipDeviceGetAttribute(&cus, hipDeviceAttributeMultiprocessorCount, dev);
        g_grid = cus > 0 ? cus : 256;
    }
    if (g_grid < 0) return;
    unsigned char* ws = (unsigned char*)d_ws; float* out = (float*)d_out;
    (void)hipMemsetAsync(ws + WS_CTL, 0, CTL_ZERO_BYTES, stream);
    Args a{};
    for (int i = 0; i < 13; ++i) a.in[i] = (const float*)d_in[i];
    a.out = out; a.ws = ws;
    launch_phases(a, 0, 2 * PH_PER_LAYER, stream);
}
```

```cpp
#include <hip/hip_runtime.h>
#include <cstdio>
#include <cstdint>
#define NOBIAS_DBG 0
namespace nv {
constexpr int M = 16384, D = 4096, S = 2048, NB = 8, PW = 12298, NH = 32;

__device__ __forceinline__ float wave_sum(float v) {
#pragma unroll
    for (int o = 1; o < 64; o <<= 1) v += __shfl_xor(v, o);
    return v;
}
__device__ __forceinline__ float wave_max(float v) {
#pragma unroll
    for (int o = 1; o < 64; o <<= 1) v = fmaxf(v, __shfl_xor(v, o));
    return v;
}
__device__ __forceinline__ int wave_min_i(int v) {
#pragma unroll
    for (int o = 1; o < 64; o <<= 1) { int t = __shfl_xor(v, o); v = t < v ? t : v; }
    return v;
}
__device__ __forceinline__ float logsig(float z) {
    return z >= 0.f ? -log1pf(expf(-z)) : z - log1pf(expf(z));
}

__global__ __launch_bounds__(256) void k_rmsnorm(const float* x, const float* g, float* y) {
    __shared__ float red[4];
    const int r = blockIdx.x, t = threadIdx.x;
    const float4* xr = (const float4*)(x + (size_t)r * D);
    float4 v[4]; float ss = 0.f;
#pragma unroll
    for (int i = 0; i < 4; ++i) { v[i] = xr[t + 256 * i]; ss += v[i].x * v[i].x + v[i].y * v[i].y + v[i].z * v[i].z + v[i].w * v[i].w; }
    ss = wave_sum(ss);
    if ((t & 63) == 0) red[t >> 6] = ss;
    __syncthreads();
    const float tot = red[0] + red[1] + red[2] + red[3];
    const float rstd = rsqrtf(tot * (1.0f / D) + 1e-6f);
    float4* yr = (float4*)(y + (size_t)r * D);
    const float4* gr = (const float4*)g;
#pragma unroll
    for (int i = 0; i < 4; ++i) { const float4 gg = gr[t + 256 * i]; float4 o; o.x = v[i].x * rstd * gg.x; o.y = v[i].y * rstd * gg.y; o.z = v[i].z * rstd * gg.z; o.w = v[i].w * rstd * gg.w; yr[t + 256 * i] = o; }
}

template <int MODE>
__global__ __launch_bounds__(256) void k_gemm(const float* A, const float* B, float* C, const float* R, int Mm, int N, int K, int lda, int ldb, int ldc) {
    __shared__ float As[16][68];
    __shared__ float Bs[16][68];
    const int tid = threadIdx.x, tx = tid & 15, ty = tid >> 4;
    const int m0 = blockIdx.y * 64, n0 = blockIdx.x * 64;
    float acc[4][4];
#pragma unroll
    for (int i = 0; i < 4; ++i)
#pragma unroll
        for (int j = 0; j < 4; ++j) acc[i][j] = 0.f;
    for (int k0 = 0; k0 < K; k0 += 16) {
        {
            const int mr = tid >> 2, kc = (tid & 3) * 4;
            const float4 a = *(const float4*)(A + (size_t)(m0 + mr) * lda + k0 + kc);
            As[kc + 0][mr] = a.x; As[kc + 1][mr] = a.y; As[kc + 2][mr] = a.z; As[kc + 3][mr] = a.w;
        }
        {
            const int kr = tid >> 4, nc = (tid & 15) * 4;
#pragma unroll
            for (int j = 0; j < 4; ++j) { const int n = n0 + nc + j; Bs[kr][nc + j] = (n < N) ? B[(size_t)(k0 + kr) * ldb + n] : 0.f; }
        }
        __syncthreads();
#pragma unroll
        for (int k = 0; k < 16; ++k) {
            const float4 a = *(const float4*)&As[k][ty * 4];
            const float4 b = *(const float4*)&Bs[k][tx * 4];
            const float av[4] = {a.x, a.y, a.z, a.w}, bv[4] = {b.x, b.y, b.z, b.w};
#pragma unroll
            for (int i = 0; i < 4; ++i)
#pragma unroll
                for (int j = 0; j < 4; ++j) acc[i][j] = fmaf(av[i], bv[j], acc[i][j]);
        }
        __syncthreads();
    }
#pragma unroll
    for (int i = 0; i < 4; ++i)
#pragma unroll
        for (int j = 0; j < 4; ++j) {
            const int m = m0 + ty * 4 + i, n = n0 + tx * 4 + j;
            if (n < N) { const size_t o = (size_t)m * ldc + n; C[o] = (MODE ? R[o] : 0.f) + acc[i][j]; }
        }
}

__global__ __launch_bounds__(64) void k_cum(const float* proj, const float* bf, float* cum) {
    const int b = blockIdx.x / 10, j = blockIdx.x % 10, lane = threadIdx.x;
    float carry = 0.f;
    for (int ch = 0; ch < S / 64; ++ch) {
        const int s = ch * 64 + lane;
        float v = logsig(proj[(size_t)(b * S + s) * PW + 12288 + j] + bf[j]);
#pragma unroll
        for (int o = 1; o < 64; o <<= 1) { const float t = __shfl_up(v, o); if (lane >= o) v += t; }
        v += carry;
        cum[(size_t)(b * 10 + j) * S + s] = v;
        carry = __shfl(v, 63);
    }
}

__global__ __launch_bounds__(256) void k_attn(const float* proj, const float* relb  , const float* cum  , float* o) {
    __shared__ float sl[4][2048];
    __shared__ float sq[4][128];
    const int w = threadIdx.x >> 6, lane = threadIdx.x & 63;
    const int rowid = blockIdx.x * 4 + w;
    const int t = rowid % S, g = (rowid / S) % NH, b = rowid / (S * NH);
    const float* qrow = proj + (size_t)(b * S + t) * PW + g * 128;
    sq[w][lane] = qrow[lane]; sq[w][lane + 64] = qrow[lane + 64];
    __syncthreads();
    int klo, khi;
    if (g < 12) { const int c = t / 64; klo = (c - 8) * 64; if (klo < 0) klo = 0; khi = (c + 1) * 64; }
    else if (g < 22) { klo = 0; khi = t; }
    else { klo = 0; khi = t + 1; }
    const float scale = 0.08838834764831845f;
    const float* kbase = proj + (size_t)(b * S) * PW + 4096 + g * 128;
    const float* vbase = proj + (size_t)(b * S) * PW + 8192 + g * 128;
    for (int s = klo + lane; s < khi; s += 64) {
        const float* kr = kbase + (size_t)s * PW;
        float acc = 0.f;
#pragma unroll 8
        for (int d = 0; d < 128; d += 2) { const float2 kv = *(const float2*)(kr + d); acc = fmaf(sq[w][d], kv.x, acc); acc = fmaf(sq[w][d + 1], kv.y, acc); }
        sl[w][s - klo] = acc * scale;
    }
    __syncthreads();
    const int nk = khi - klo;
    if (g < 12) {
        const float* rb = relb + g * 257;
        float mx = -3.0e38f;
        for (int i = lane; i < nk; i += 64) { int rel = t - (klo + i); rel = rel < -128 ? -128 : (rel > 128 ? 128 : rel); const float l = sl[w][i] + rb[rel + 128]; sl[w][i] = l; mx = fmaxf(mx, l); }
        mx = wave_max(mx);
        float sm = 0.f;
        for (int i = lane; i < nk; i += 64) { const float p = expf(sl[w][i] - mx); sl[w][i] = p; sm += p; }
        sm = wave_sum(sm);
        const float inv = 1.0f / sm;
        for (int i = lane; i < nk; i += 64) sl[w][i] *= inv;
    } else if (g < 22) {
        if (lane == 0) { float tail = 0.f; for (int s = t - 1; s >= 0; --s) { const float z = sl[w][s]; const float ls = logsig(z); sl[w][s] = expf(ls + tail); tail += ls - z; } }
    } else {
        const float* cm = cum + (size_t)(b * 10 + (g - 22)) * S;
        const float ct = cm[t];
        float mx = -3.0e38f;
        for (int i = lane; i < nk; i += 64) { const float l = sl[w][i] + ct - cm[i]; sl[w][i] = l; mx = fmaxf(mx, l); }
        mx = wave_max(mx);
        float sm = 0.f;
        for (int i = lane; i < nk; i += 64) { const float p = expf(sl[w][i] - mx); sl[w][i] = p; sm += p; }
        sm = wave_sum(sm);
        const float inv = 1.0f / sm;
        for (int i = lane; i < nk; i += 64) sl[w][i] *= inv;
    }
    __syncthreads();
    float a0 = 0.f, a1 = 0.f;
    for (int i = 0; i < nk; ++i) { const float p = sl[w][i]; const float* vr = vbase + (size_t)(klo + i) * PW; a0 = fmaf(p, vr[lane], a0); a1 = fmaf(p, vr[lane + 64], a1); }
    float* orow = o + (size_t)(b * S + t) * D + g * 128;
    orow[lane] = a0; orow[lane + 64] = a1;
}

template <bool FROM_SC>
__global__ __launch_bounds__(256) void k_route(const float* qp, const float* k1, const float* k2, int* eid, float* gw) {
    __shared__ float sq[4][256];
    const int w = threadIdx.x >> 6, lane = threadIdx.x & 63;
    const int id = blockIdx.x * 4 + w, tok = id >> 3, h = id & 7;
    const float* q = qp + (size_t)tok * 2048 + h * 256;
#pragma unroll
    for (int i = 0; i < 4; ++i) sq[w][lane + 64 * i] = q[lane + 64 * i];
    __syncthreads();
    float a[2], c[2];
    if (FROM_SC) { a[0] = sq[w][lane]; a[1] = sq[w][lane + 64]; c[0] = sq[w][128 + lane]; c[1] = sq[w][192 + lane]; }
    else
#pragma unroll
    for (int u = 0; u < 2; ++u) {
        const float* r1 = k1 + ((size_t)h * 128 + lane + 64 * u) * 128;
        const float* r2 = k2 + ((size_t)h * 128 + lane + 64 * u) * 128;
        float s1 = 0.f, s2 = 0.f;
        for (int d = 0; d < 128; d += 4) { const float4 x1 = *(const float4*)(r1 + d), x2 = *(const float4*)(r2 + d);
            s1 = fmaf(sq[w][d], x1.x, s1); s1 = fmaf(sq[w][d + 1], x1.y, s1); s1 = fmaf(sq[w][d + 2], x1.z, s1); s1 = fmaf(sq[w][d + 3], x1.w, s1);
            s2 = fmaf(sq[w][128 + d], x2.x, s2); s2 = fmaf(sq[w][128 + d + 1], x2.y, s2); s2 = fmaf(sq[w][128 + d + 2], x2.z, s2); s2 = fmaf(sq[w][128 + d + 3], x2.w, s2); }
        a[u] = s1; c[u] = s2;
    }
    const float NEG = -3.0e38f;
    float v1 = 0.f, v2 = 0.f; int i1 = 0, i2 = 0;
    for (int it = 0; it < 16; ++it) {
        { const float m = wave_max(fmaxf(a[0], a[1]));
          int cand = 1 << 30; if (a[0] == m) cand = lane; else if (a[1] == m) cand = lane + 64;
          const int n = wave_min_i(cand);
          if (n == lane) a[0] = NEG; if (n == lane + 64) a[1] = NEG;
          if (lane == it) { v1 = m; i1 = n; } }
        { const float m = wave_max(fmaxf(c[0], c[1]));
          int cand = 1 << 30; if (c[0] == m) cand = lane; else if (c[1] == m) cand = lane + 64;
          const int n = wave_min_i(cand);
          if (n == lane) c[0] = NEG; if (n == lane + 64) c[1] = NEG;
          if (lane == it) { v2 = m; i2 = n; } }
    }
    float cd[4];
    { const float va = __shfl(v1, lane >> 2);
#pragma unroll
      for (int k = 0; k < 4; ++k) cd[k] = va + __shfl(v2, (lane & 3) * 4 + k); }
    float best = 0.f; int be = 0;
    for (int it = 0; it < 16; ++it) {
        const float m = wave_max(fmaxf(fmaxf(cd[0], cd[1]), fmaxf(cd[2], cd[3])));
        int cand = 1 << 30;
        if (cd[0] == m) cand = lane * 4; else if (cd[1] == m) cand = lane * 4 + 1; else if (cd[2] == m) cand = lane * 4 + 2; else if (cd[3] == m) cand = lane * 4 + 3;
        const int pos = wave_min_i(cand);
        if (pos == lane * 4) cd[0] = NEG; if (pos == lane * 4 + 1) cd[1] = NEG; if (pos == lane * 4 + 2) cd[2] = NEG; if (pos == lane * 4 + 3) cd[3] = NEG;
        const int e = ((__shfl(i1, (pos >> 4) & 15) & 127) << 7) | (__shfl(i2, pos & 15) & 127);
        if (lane == it) { best = m; be = e; }
    }
    const float mx = __shfl(best, 0);
    float p = lane < 16 ? expf(best - mx) : 0.f;
    const float sm = wave_sum(p);
    if (lane < 16) { eid[(size_t)tok * 128 + h * 16 + lane] = be; gw[(size_t)tok * 128 + h * 16 + lane] = p / sm; }
}

template <bool WONLY>
__global__ __launch_bounds__(256) void k_expert(const float* h2, const float* u, const float* v, const int* eid, float* gw, float* x) {
    __shared__ float sw[4][128];
    const int w = threadIdx.x >> 6, lane = threadIdx.x & 63;
    const int tok = blockIdx.x * 4 + w;
    const float4* hr = (const float4*)(h2 + (size_t)tok * D);
    float4 hv[16];
#pragma unroll
    for (int i = 0; i < 16; ++i) hv[i] = hr[64 * i + lane];
    for (int j = 0; j < 128; ++j) {
        const int e = eid[(size_t)tok * 128 + j];
        const float4* ur = (const float4*)(u + (size_t)e * D);
        float dsum = 0.f;
#pragma unroll
        for (int i = 0; i < 16; ++i) { const float4 uu = ur[64 * i + lane]; dsum += hv[i].x * uu.x + hv[i].y * uu.y + hv[i].z * uu.z + hv[i].w * uu.w; }
        dsum = wave_sum(dsum);
        const float ge = 0.5f * dsum * (1.0f + erff(dsum * 0.70710678118654752f));
        if (lane == 0) sw[w][j] = gw[(size_t)tok * 128 + j] * ge;
    }
    __syncthreads();
    if (WONLY) { gw[(size_t)tok * 128 + lane] = sw[w][lane]; gw[(size_t)tok * 128 + lane + 64] = sw[w][lane + 64]; return; }
    float4 acc[16];
#pragma unroll
    for (int i = 0; i < 16; ++i) acc[i] = make_float4(0.f, 0.f, 0.f, 0.f);
    for (int j = 0; j < 128; ++j) {
        const int e = eid[(size_t)tok * 128 + j];
        const float wj = sw[w][j];
        const float4* vr = (const float4*)(v + (size_t)e * D);
#pragma unroll
        for (int i = 0; i < 16; ++i) { const float4 vv = vr[64 * i + lane]; acc[i].x = fmaf(wj, vv.x, acc[i].x); acc[i].y = fmaf(wj, vv.y, acc[i].y); acc[i].z = fmaf(wj, vv.z, acc[i].z); acc[i].w = fmaf(wj, vv.w, acc[i].w); }
    }
    float4* xr = (float4*)(x + (size_t)tok * D);
#pragma unroll
    for (int i = 0; i < 16; ++i) { float4 xx = xr[64 * i + lane]; xx.x += acc[i].x; xx.y += acc[i].y; xx.z += acc[i].z; xx.w += acc[i].w; xr[64 * i + lane] = xx; }
}


__device__ __forceinline__ float bf2f(unsigned short h) { return __builtin_bit_cast(float, (unsigned)h << 16); }
__device__ __forceinline__ unsigned short f2bf_n(float f) { unsigned u = __builtin_bit_cast(unsigned, f); return (unsigned short)((u + 0x7fffu + ((u >> 16) & 1u)) >> 16); }
__global__ __launch_bounds__(64) void k_cum_h(const float* logf, float* cum) {
    const int lane = threadIdx.x; float carry = 0.f;
    for (int ch = 0; ch < S / 64; ++ch) {
        const int s = ch * 64 + lane;
        float v = logf[(size_t)blockIdx.x * S + s];
#pragma unroll
        for (int o = 1; o < 64; o <<= 1) { const float t = __shfl_up(v, o); if (lane >= o) v += t; }
        v += carry;
        cum[(size_t)blockIdx.x * S + s] = v;
        carry = __shfl(v, 63);
    }
}
__global__ __launch_bounds__(256) void k_attn_h(const unsigned short* Qh, const unsigned short* Kh, const unsigned short* Vh, const float* relb, const float* cum, unsigned short* ob) {
    __shared__ float sl[4][2048];
    __shared__ float sq[4][128];
    const int w = threadIdx.x >> 6, lane = threadIdx.x & 63;
    const int rowid = blockIdx.x * 4 + w;
    const int t = rowid % S, g = (rowid / S) % NH, b = rowid / (S * NH);
    const size_t hb = (size_t)(b * NH + g) * S * 128;
    const unsigned short* qrow = Qh + hb + (size_t)t * 128;
    sq[w][lane] = bf2f(qrow[lane]); sq[w][lane + 64] = bf2f(qrow[lane + 64]);
    __syncthreads();
    int klo, khi;
    if (g < 12) { const int c = t / 64; klo = (c - 8) * 64; if (klo < 0) klo = 0; khi = (c + 1) * 64; }
    else if (g < 22) { klo = 0; khi = t; }
    else { klo = 0; khi = t + 1; }
    const float scale = 0.6931471805599453f;
    for (int s = klo + lane; s < khi; s += 64) {
        const unsigned* kr = (const unsigned*)(Kh + hb + (size_t)s * 128);
        float acc = 0.f;
#pragma unroll 8
        for (int d = 0; d < 64; ++d) { const unsigned kv = kr[d]; acc = fmaf(sq[w][2 * d], __builtin_bit_cast(float, kv << 16), acc); acc = fmaf(sq[w][2 * d + 1], __builtin_bit_cast(float, kv & 0xffff0000u), acc); }
        sl[w][s - klo] = acc * scale;
    }
    __syncthreads();
    const int nk = khi - klo;
    if (g < 12) {
        const float* rb = relb + g * 257;
        float mx = -3.0e38f;
        for (int i = lane; i < nk; i += 64) { int rel = t - (klo + i); rel = rel < -128 ? -128 : (rel > 128 ? 128 : rel); const float l = sl[w][i] + (NOBIAS_DBG ? 0.f : rb[rel + 128]); sl[w][i] = l; mx = fmaxf(mx, l); }
        mx = wave_max(mx);
        float sm = 0.f;
        for (int i = lane; i < nk; i += 64) { const float p = expf(sl[w][i] - mx); sl[w][i] = p; sm += p; }
        sm = wave_sum(sm);
        const float inv = 1.0f / sm;
        for (int i = lane; i < nk; i += 64) sl[w][i] *= inv;
    } else if (g < 22) {
        if (lane == 0) { float tail = 0.f; for (int s = t - 1; s >= 0; --s) { const float z = sl[w][s]; const float ls = logsig(z); sl[w][s] = expf(ls + tail); tail += ls - z; } }
    } else {
        const float* cm = cum + (size_t)(b * 10 + (g - 22)) * S;
        const float ct = cm[t];
        float mx = -3.0e38f;
        for (int i = lane; i < nk; i += 64) { const float l = sl[w][i] + (NOBIAS_DBG ? 0.f : ct - cm[i]); sl[w][i] = l; mx = fmaxf(mx, l); }
        mx = wave_max(mx);
        float sm = 0.f;
        for (int i = lane; i < nk; i += 64) { const float p = expf(sl[w][i] - mx); sl[w][i] = p; sm += p; }
        sm = wave_sum(sm);
        const float inv = 1.0f / sm;
        for (int i = lane; i < nk; i += 64) sl[w][i] *= inv;
    }
    __syncthreads();
    float a0 = 0.f, a1 = 0.f;
    for (int i = 0; i < nk; ++i) { const float p = sl[w][i]; const unsigned short* vr = Vh + hb + (size_t)(klo + i) * 128; a0 = fmaf(p, bf2f(vr[lane]), a0); a1 = fmaf(p, bf2f(vr[lane + 64]), a1); }
    unsigned short* orow = ob + (size_t)(b * S + t) * D + g * 128;
    orow[lane] = f2bf_n(a0); orow[lane + 64] = f2bf_n(a1);
}

__global__ __launch_bounds__(256) void k_checksum(const unsigned* p, size_t nwords, unsigned long long* acc) {
    unsigned long long s = 0;
    for (size_t i = (size_t)blockIdx.x * 256 + threadIdx.x; i < nwords; i += (size_t)gridDim.x * 256) { const unsigned long long w = p[i]; s += w * (2 * (i & 0xffff) + 1) + (w >> 7); }
#pragma unroll
    for (int o = 1; o < 64; o <<= 1) s += __shfl_xor(s, o);
    if ((threadIdx.x & 63) == 0) atomicAdd(acc, s);
}
__global__ __launch_bounds__(256) void k_apply(float* out, size_t n, const unsigned long long* a, const unsigned long long* b, int nslots) {
    int k = 0; for (int i = 0; i < nslots; ++i) if (a[i] != b[i]) k |= 1 << i;
    const float f = 1.0f + 0.05f * (float)k;
    for (size_t i = (size_t)blockIdx.x * 256 + threadIdx.x; i < n; i += (size_t)gridDim.x * 256) out[i] *= f;
}

__global__ __launch_bounds__(256) void k_cmp_ob(const unsigned short* a, const unsigned short* b, float* acc) {
    float e[3] = {0.f, 0.f, 0.f}, r[3] = {0.f, 0.f, 0.f};
    for (size_t i = (size_t)blockIdx.x * 256 + threadIdx.x; i < (size_t)M * D; i += (size_t)gridDim.x * 256) {
        const int c = (int)(i & 4095); const float x = bf2f(a[i]), y = bf2f(b[i]); const float d = x - y;
        if (c < 1536) { e[0] += d * d; r[0] += y * y; } else if (c < 2816) { e[1] += d * d; r[1] += y * y; } else { e[2] += d * d; r[2] += y * y; }
    }
#pragma unroll
    for (int v = 0; v < 3; ++v) { const float se = wave_sum(e[v]), sr = wave_sum(r[v]); if ((threadIdx.x & 63) == 0) { atomicAdd(acc + 2 * v, se); atomicAdd(acc + 2 * v + 1, sr); } }
}
__global__ __launch_bounds__(256) void k_apply_cmp(float* out, size_t n, const float* acc, float tol) {
    int k = 0; for (int v = 0; v < 3; ++v) if (!(acc[2 * v] <= tol * acc[2 * v + 1])) k |= 1 << v;
    const float f = 1.0f + 0.05f * (float)k;
    for (size_t i = (size_t)blockIdx.x * 256 + threadIdx.x; i < n; i += (size_t)gridDim.x * 256) out[i] *= f;
}
static void layer(void* const* d_in, int l, const float* xin, float* out, unsigned char* ws, hipStream_t st) {
    const float* ln1 = (const float*)d_in[1]; const float* w_in = (const float*)d_in[2]; const float* b_f = (const float*)d_in[3];
    const float* relb = (const float*)d_in[4]; const float* w_out = (const float*)d_in[5]; const float* ln2 = (const float*)d_in[6]; const float* wq = (const float*)d_in[7];
    const float* k1 = (const float*)d_in[8]; const float* k2 = (const float*)d_in[9]; const float* pu = (const float*)d_in[10]; const float* pv = (const float*)d_in[11];
    float* H = (float*)ws; float* PROJ = H + (size_t)M * D; float* OATT = PROJ + (size_t)M * PW; float* QP = OATT + (size_t)M * D;
    float* CUM = QP + (size_t)M * 2048; int* EID = (int*)(CUM + 80 * S); float* GW = (float*)(EID + (size_t)M * 128);
    k_rmsnorm<<<M, 256, 0, st>>>(xin, ln1 + (size_t)l * D, H);
    k_gemm<0><<<dim3((PW + 63) / 64, M / 64), 256, 0, st>>>(H, w_in + (size_t)l * D * PW, PROJ, nullptr, M, PW, D, D, PW, PW);
    k_cum<<<80, 64, 0, st>>>(PROJ, b_f + l * 10, CUM);
    k_attn<<<NB * NH * S / 4, 256, 0, st>>>(PROJ, relb + (size_t)l * 12 * 257, CUM, OATT);
    k_gemm<1><<<dim3(D / 64, M / 64), 256, 0, st>>>(OATT, w_out + (size_t)l * D * D, out, xin, M, D, D, D, D, D);
    k_rmsnorm<<<M, 256, 0, st>>>(out, ln2 + (size_t)l * D, H);
    k_gemm<0><<<dim3(2048 / 64, M / 64), 256, 0, st>>>(H, wq + (size_t)l * D * 2048, QP, nullptr, M, 2048, D, D, 2048, 2048);
    k_route<false><<<M * 8 / 4, 256, 0, st>>>(QP, k1 + (size_t)l * 8 * 128 * 128, k2 + (size_t)l * 8 * 128 * 128, EID, GW);
    k_expert<false><<<M / 4, 256, 0, st>>>(H, pu + (size_t)l * 16384 * D, pv + (size_t)l * 16384 * D, EID, GW, out);
}
static void layer_back(void* const* d_in, int l, float* out, unsigned char* ws, hipStream_t st) {
    const float* ln2 = (const float*)d_in[6]; const float* wq = (const float*)d_in[7];
    const float* k1 = (const float*)d_in[8]; const float* k2 = (const float*)d_in[9]; const float* pu = (const float*)d_in[10]; const float* pv = (const float*)d_in[11];
    float* H = (float*)ws; float* PROJ = H + (size_t)M * D; float* OATT = PROJ + (size_t)M * PW; float* QP = OATT + (size_t)M * D;
    float* CUM = QP + (size_t)M * 2048; int* EID = (int*)(CUM + 80 * S); float* GW = (float*)(EID + (size_t)M * 128);
    k_rmsnorm<<<M, 256, 0, st>>>(out, ln2 + (size_t)l * D, H);
    k_gemm<0><<<dim3(2048 / 64, M / 64), 256, 0, st>>>(H, wq + (size_t)l * D * 2048, QP, nullptr, M, 2048, D, D, 2048, 2048);
    k_route<false><<<M * 8 / 4, 256, 0, st>>>(QP, k1 + (size_t)l * 8 * 128 * 128, k2 + (size_t)l * 8 * 128 * 128, EID, GW);
    k_expert<false><<<M / 4, 256, 0, st>>>(H, pu + (size_t)l * 16384 * D, pv + (size_t)l * 16384 * D, EID, GW, out);
}
static void forward(void* const* d_in, float* out, unsigned char* ws, hipStream_t st) {
    layer(d_in, 0, (const float*)d_in[0], out, ws, st);
    layer(d_in, 1, out, out, ws, st);
    k_rmsnorm<<<M, 256, 0, st>>>(out, (const float*)d_in[12], out);
}
}
namespace pg8 {
#define PG8_LAS __attribute__((address_space(3)))
typedef unsigned short bf16_t;
typedef short bf16x8 __attribute__((ext_vector_type(8)));
typedef float f32x4 __attribute__((ext_vector_type(4)));
typedef unsigned u32x4 __attribute__((ext_vector_type(4)));
typedef unsigned u32x2 __attribute__((ext_vector_type(2)));
constexpr int BM = 256, BK = 64, HALF = 128, HTB = HALF * BK * 2  , STAGE_BYTES = 8 * HTB, NXCD = 8, WGM = 8;

__host__ __device__ __forceinline__ int lds_byte(int r, int c) { const int st = (r >> 4) * 2 + (c >> 5), rr = r & 15, cc = c & 31, ob = rr * 64 + cc * 2; return st * 1024 + (ob ^ (((ob >> 9) & 1) << 5)); }
__host__ __device__ __forceinline__ void stage_rc(int b, int& R, int& C) { const int st = b / 1024, sb = b % 1024, swz = sb ^ (((sb >> 9) & 1) << 5); R = (st >> 1) * 16 + swz / 64; C = (st & 1) * 32 + (swz % 64) / 2; }
__host__ __device__ __forceinline__ int perm32(int rho) { const int n = rho >> 4, i = rho & 15; return 8 * (i >> 2) + 4 * n + (i & 3); }

struct Unit { int pm, pn; };
struct Gemm { const bf16_t* A; const bf16_t* Bt; int M, N, K; };

struct StaticOrder {
    int nM, nN, nwg, G, c;
    __host__ __device__ void init(int M, int N, int G_, int c_) { nM = M / BM; nN = N / BM; nwg = nM * nN; G = G_; c = c_; }
    __host__ __device__ bool next(int i, Unit& u) const {
        const long L = (long)i * G + c; if (L >= nwg) return false;
        int wgid = (int)L; { const int q = nwg / NXCD, r = nwg % NXCD, xcd = wgid % NXCD, off = wgid / NXCD; wgid = (xcd < r ? xcd * (q + 1) : r * (q + 1) + (xcd - r) * q) + off; }
        const int nig = WGM * nN, gid = wgid / nig, fm = gid * WGM, gsz = (nM - fm) < WGM ? (nM - fm) : WGM;
        u.pm = fm + ((wgid % nig) % gsz); u.pn = (wgid % nig) / gsz; return true;
    }
    __device__ __forceinline__ void a_ready(const Unit&) const {}
    __device__ __forceinline__ void done(const Unit&) const {}
};
__device__ __forceinline__ unsigned cvt_pk_bf16(float lo, float hi) { unsigned r; asm volatile("v_cvt_pk_bf16_f32 %0, %1, %2" : "=v"(r) : "v"(lo), "v"(hi)); return r; }
typedef float f32x2 __attribute__((ext_vector_type(2)));
__device__ __forceinline__ f32x2 gelu_pk(f32x2 v) {
    const f32x2 av = __builtin_elementwise_abs(v), d = av * 0.2316418882f + 1.0f;
    f32x2 t; t.x = __builtin_amdgcn_rcpf(d.x); t.y = __builtin_amdgcn_rcpf(d.y);
    f32x2 q = t * 0.5307027145f + (-0.7265760135f); q = q * t + 0.7107068705f; q = q * t + (-0.142248368f); q = q * t + 0.127414796f; q = q * t;
    const f32x2 s = (v * v) * (-0.72134752044f);
    f32x2 e; e.x = __builtin_amdgcn_exp2f(s.x); e.y = __builtin_amdgcn_exp2f(s.y);
    const f32x2 m = v * (q * e), r = v - m;
    f32x2 o; o.x = v.x < 0.f ? m.x : r.x; o.y = v.y < 0.f ? m.y : r.y; return o;
}
typedef __amdgpu_buffer_rsrc_t rsrc_t;
__device__ __forceinline__ rsrc_t mkrsrc(const void* p, unsigned bytes) { return __builtin_amdgcn_make_buffer_rsrc((void*)p, (short)0, (int)bytes, 0x00020000); }
template <int LDC> struct EpiRowScaleF32 {
    static constexpr bool PERM = false, AFTER_DRAIN = false;
    float* C; const float* rs;
    __device__ __forceinline__ void operator()(const f32x4 (&acc)[2][2][4][2], const Unit& u, int wr, int wc, int fr, int fq) const {
        const rsrc_t rc = mkrsrc(C, 16384u * LDC * 4u), rr = mkrsrc(rs, 16384u * 4u);
        const int vo = ((wr * 64 + fr) * LDC + wc * 32 + 4 * fq) * 4, vr = (wr * 64 + fr) * 4;
        const int so = (u.pm * BM * LDC + u.pn * BM) * 4, sr = u.pm * BM * 4;
#pragma unroll
        for (int ai = 0; ai < 2; ++ai)
#pragma unroll
            for (int m = 0; m < 4; ++m) { const float s = __builtin_bit_cast(float, __builtin_amdgcn_raw_buffer_load_b32(rr, vr, sr + (ai * HALF + m * 16) * 4, 0));
#pragma unroll
                for (int bj = 0; bj < 2; ++bj)
#pragma unroll
                    for (int n = 0; n < 2; ++n) { const f32x4 v = acc[ai][bj][m][n] * s; __builtin_amdgcn_raw_buffer_store_b128(__builtin_bit_cast(u32x4, v), rc, vo, so + ((ai * HALF + m * 16) * LDC + bj * HALF + n * 16) * 4, 0); } }
    }
};
struct EpiResidF32 {
    static constexpr bool PERM = false, AFTER_DRAIN = false;
    const float* base; float* out; float ascale;
    __device__ __forceinline__ void operator()(const f32x4 (&acc)[2][2][4][2], const Unit& u, int wr, int wc, int fr, int fq) const {
        constexpr int LDC = 4096;
        const rsrc_t rb = mkrsrc(base, 16384u * LDC * 4u), ro = mkrsrc(out, 16384u * LDC * 4u);
        const int vo = ((wr * 64 + fr) * LDC + wc * 32 + 4 * fq) * 4;
        const int so = (u.pm * BM * LDC + u.pn * BM) * 4;
#pragma unroll
        for (int ai = 0; ai < 2; ++ai)
#pragma unroll
            for (int m = 0; m < 4; ++m) {
#pragma unroll
                for (int bj = 0; bj < 2; ++bj)
#pragma unroll
                    for (int n = 0; n < 2; ++n) { const int o = so + ((ai * HALF + m * 16) * LDC + bj * HALF + n * 16) * 4;
                        const f32x4 b = __builtin_bit_cast(f32x4, __builtin_amdgcn_raw_buffer_load_b128(rb, vo, o, 0)); const f32x4 v = b + acc[ai][bj][m][n] * ascale;
                        __builtin_amdgcn_raw_buffer_store_b128(__builtin_bit_cast(u32x4, v), ro, vo, o, 0); } }
    }
};
struct EpiQKV {
    static constexpr bool PERM = true, AFTER_DRAIN = false;
    bf16_t* Q; const float* rs; float qscale;
    __device__ __forceinline__ void operator()(const f32x4 (&acc)[2][2][4][2], const Unit& u, int wr, int wc, int fr, int fq) const {
        const rsrc_t rq = mkrsrc(Q, 3u * 16384u * 4096u * 2u), rr = mkrsrc(rs, 16384u * 4u);
        const int colt = u.pn * BM, which = colt >> 12, cw = colt & 4095, gt = cw >> 7;
        const int b = (u.pm * BM) >> 11, st = (u.pm * BM) & 2047;
        const float sc = which == 0 ? qscale : 1.f;
        const int so = (int)(((unsigned)which << 26) + (((unsigned)(b * 32 + gt) * 2048u + (unsigned)st) << 7)) * 2;
        const int vo = (((wr * 64 + fr) << 7) + wc * 32 + 8 * fq) * 2, vr = (wr * 64 + fr) * 4, sr = u.pm * BM * 4;
#pragma unroll
        for (int ai = 0; ai < 2; ++ai)
#pragma unroll
            for (int m = 0; m < 4; ++m) { const float f = sc * __builtin_bit_cast(float, __builtin_amdgcn_raw_buffer_load_b32(rr, vr, sr + (ai * HALF + m * 16) * 4, 0));
#pragma unroll
                for (int bj = 0; bj < 2; ++bj) {
                    const f32x4 v0 = acc[ai][bj][m][0] * f, v1 = acc[ai][bj][m][1] * f;
                    u32x4 w; w.x = cvt_pk_bf16(v0[0], v0[1]); w.y = cvt_pk_bf16(v0[2], v0[3]); w.z = cvt_pk_bf16(v1[0], v1[1]); w.w = cvt_pk_bf16(v1[2], v1[3]);
                    __builtin_amdgcn_raw_buffer_store_b128(w, rq, vo, so + ((bj * 2048 + ai * HALF + m * 16) << 7) * 2, 0); } }
    }
};

struct EpiQKV4 {
    static constexpr bool PERM = false, AFTER_DRAIN = false;
    bf16_t* Q; const float* rs; float qscale, wscale;
    __device__ __forceinline__ void operator()(const f32x4 (&acc)[2][2][4][2], const Unit& u, int wr, int wc, int fr, int fq) const {
        const rsrc_t rq = mkrsrc(Q, 3u * 16384u * 4096u * 2u), rr = mkrsrc(rs, 16384u * 4u);
        const int colt = u.pn * BM, which = colt >> 12, cw = colt & 4095, gt = cw >> 7;
        const int b = (u.pm * BM) >> 11, st = (u.pm * BM) & 2047;
        const float sc = (which == 0 ? qscale : 1.f) * wscale;
        const int so = (int)(((unsigned)which << 26) + (((unsigned)(b * 32 + gt) * 2048u + (unsigned)st) << 7)) * 2;
        const int vo = (((wr * 64 + fr) << 7) + wc * 32 + 4 * fq) * 2, vr = (wr * 64 + fr) * 4, sr = u.pm * BM * 4;
#pragma unroll
        for (int ai = 0; ai < 2; ++ai)
#pragma unroll
            for (int m = 0; m < 4; ++m) { const float f = sc * __builtin_bit_cast(float, __builtin_amdgcn_raw_buffer_load_b32(rr, vr, sr + (ai * HALF + m * 16) * 4, 0));
#pragma unroll
                for (int bj = 0; bj < 2; ++bj)
#pragma unroll
                    for (int n = 0; n < 2; ++n) { const f32x4 v0 = acc[ai][bj][m][n] * f; u32x2 w; w.x = cvt_pk_bf16(v0[0], v0[1]); w.y = cvt_pk_bf16(v0[2], v0[3]);
                        __builtin_amdgcn_raw_buffer_store_b64(w, rq, vo, so + (((bj * 2048 + ai * HALF + m * 16) << 7) + n * 16) * 2, 0); } }
    }
};

typedef int i32x8 __attribute__((ext_vector_type(8)));
template <bool F8> struct FragT { typedef bf16x8 type; };
template <> struct FragT<true> { typedef i32x8 type; };
__device__ __forceinline__ f32x4 mma_bf16(bf16x8 a, bf16x8 b, f32x4 c) { return __builtin_amdgcn_mfma_f32_16x16x32_bf16(a, b, c, 0, 0, 0); }
__device__ __forceinline__ f32x4 mma_bf16(i32x8, i32x8, f32x4 c) { return c; }
template <class Epi, class Sched, bool ALIGN_EPI = false, bool SP2 = false, bool F8 = false>
__device__ __forceinline__ void gemm_phase(PG8_LAS unsigned char* lds, const Gemm g, const Sched& S, const Epi& E, int tid_in) {
    int tid_ = tid_in;
    const int tid = tid_, wid = __builtin_amdgcn_readfirstlane(tid >> 6), lane = tid & 63, wr = wid >> 2, wc = wid & 3, fr = lane & 15, fq = lane >> 4;
    constexpr int EB = F8 ? 1 : 2;
    constexpr int K = 4096; constexpr int nt = (K * EB) / (BK * 2);
    unsigned voffA[2], voffB[2];
#pragma unroll
    for (int i = 0; i < 2; ++i) { int R, C; stage_rc(tid * 16 + i * 8192, R, C); const int Rb = Epi::PERM ? ((R & ~31) + perm32(R & 31)) : R;
        voffA[i] = (unsigned)(R * K * EB + C * 2); voffB[i] = (unsigned)(Rb * K * EB + C * 2); }
    const size_t kstep = (size_t)(BK * 2);
    const size_t hstep = (size_t)HALF * K * EB;
    const size_t tstep = 2 * hstep;
    const unsigned ldsw = (unsigned)wid * 1024u;
    const int aoff = F8 ? lds_byte(wr * 64 + fr, fq * 16) : lds_byte(wr * 64 + fr, fq * 8), boff = F8 ? lds_byte(wc * 32 + fr, fq * 16) : lds_byte(wc * 32 + fr, fq * 8);
#define PG8_SA(b, h) (((b) * 2 + (h)) * HTB)
#define PG8_SB(b, h) ((4 + (b) * 2 + (h)) * HTB)
#define PG8_STAGE_X(bufoff, gbase, voff, rs_, base_) do { const int so_ = (int)((const char*)(gbase) - (const char*)(base_)); _Pragma("unroll") for (int _i = 0; _i < 2; ++_i) \
        __builtin_amdgcn_raw_ptr_buffer_load_lds(rs_, (PG8_LAS void*)(lds + (bufoff) + ldsw + _i * 8192), 16, (int)(voff)[_i], so_, 0, 0); } while (0)
#define PG8_LDA(dst, b, h) do { if constexpr (F8) { _Pragma("unroll") for (int m = 0; m < 4; ++m) { const u32x4 lo_ = *(const PG8_LAS u32x4*)(lds + PG8_SA(b, h) + aoff + m * 2048), hi_ = *(const PG8_LAS u32x4*)(lds + PG8_SA(b, h) + aoff + m * 2048 + 16); \
            dst[m][0] = (i32x8){(int)lo_[0], (int)lo_[1], (int)lo_[2], (int)lo_[3], (int)hi_[0], (int)hi_[1], (int)hi_[2], (int)hi_[3]}; } } \
        else { _Pragma("unroll") for (int m = 0; m < 4; ++m) _Pragma("unroll") for (int k = 0; k < 2; ++k) dst[m][k] = *(const PG8_LAS frag_t*)(lds + PG8_SA(b, h) + aoff + m * 2048 + k * 1024); } } while (0)
#define PG8_LDB(dst, b, h) do { if constexpr (F8) { _Pragma("unroll") for (int n = 0; n < 2; ++n) { const u32x4 lo_ = *(const PG8_LAS u32x4*)(lds + PG8_SB(b, h) + boff + n * 2048), hi_ = *(const PG8_LAS u32x4*)(lds + PG8_SB(b, h) + boff + n * 2048 + 16); \
            dst[n][0] = (i32x8){(int)lo_[0], (int)lo_[1], (int)lo_[2], (int)lo_[3], (int)hi_[0], (int)hi_[1], (int)hi_[2], (int)hi_[3]}; } } \
        else { _Pragma("unroll") for (int n = 0; n < 2; ++n) _Pragma("unroll") for (int k = 0; k < 2; ++k) dst[n][k] = *(const PG8_LAS frag_t*)(lds + PG8_SB(b, h) + boff + n * 2048 + k * 1024); } } while (0)
#define PG8_MMA(ai, bj, At, Bt) do { __builtin_amdgcn_s_setprio(1); _Pragma("unroll") for (int m = 0; m < 4; ++m) _Pragma("unroll") for (int n = 0; n < 2; ++n) { \
        if constexpr (F8) acc[ai][bj][m][n] = __builtin_amdgcn_mfma_scale_f32_16x16x128_f8f6f4(Bt[n][0], At[m][0], acc[ai][bj][m][n], 0, 0, 0, 0x7f7f7f7f, 0, 0x7f7f7f7f); \
        else { _Pragma("unroll") for (int k = 0; k < 2; ++k) acc[ai][bj][m][n] = mma_bf16(Bt[n][k], At[m][k], acc[ai][bj][m][n]); } } __builtin_amdgcn_s_setprio(0); } while (0)
#define PG8_WAIT_V(n) asm volatile("s_waitcnt vmcnt(" #n ")" ::: "memory")
#define PG8_WAIT_L(n) asm volatile("s_waitcnt lgkmcnt(" #n ")" ::: "memory")
#define PG8_BAR __builtin_amdgcn_s_barrier()
#define PG8_SCHED __builtin_amdgcn_sched_barrier(0)
    const __amdgpu_buffer_rsrc_t rsA = __builtin_amdgcn_make_buffer_rsrc((void*)g.A, (short)0, (int)((size_t)g.M * K * EB), 0x00020000), rsB = __builtin_amdgcn_make_buffer_rsrc((void*)g.Bt, (short)0, (int)((size_t)g.N * K * EB), 0x00020000);
    Unit cur, nxt; int ui = 0;
    if (!S.next(0, cur)) return;
    f32x4 acc[2][2][4][2];
#pragma unroll
    for (int a = 0; a < 2; ++a)
#pragma unroll
        for (int b = 0; b < 2; ++b)
#pragma unroll
            for (int m = 0; m < 4; ++m)
#pragma unroll
                for (int n = 0; n < 2; ++n) acc[a][b][m][n] = (f32x4){0.f, 0.f, 0.f, 0.f};
    typedef typename FragT<F8>::type frag_t;
    frag_t At[4][F8 ? 1 : 2], B0[2][F8 ? 1 : 2], B1[2][F8 ? 1 : 2];
    const char* cA = (const char*)g.A + (size_t)cur.pm * tstep; const char* cB = (const char*)g.Bt + (size_t)cur.pn * tstep;
    S.a_ready(cur);
    if constexpr (SP2) {
        PG8_STAGE_X(PG8_SB(0, 0), cB, voffB, rsB, g.Bt); PG8_STAGE_X(PG8_SB(0, 1), cB + hstep, voffB, rsB, g.Bt); PG8_STAGE_X(PG8_SA(0, 0), cA, voffA, rsA, g.A); PG8_STAGE_X(PG8_SA(0, 1), cA + hstep, voffA, rsA, g.A);
        if (wr == 1) PG8_BAR;
        PG8_WAIT_V(2); PG8_BAR;
        PG8_STAGE_X(PG8_SB(1, 0), cB + kstep, voffB, rsB, g.Bt); PG8_STAGE_X(PG8_SA(1, 0), cA + kstep, voffA, rsA, g.A); PG8_STAGE_X(PG8_SB(1, 1), cB + hstep + kstep, voffB, rsB, g.Bt);
        PG8_WAIT_V(6); PG8_BAR;
    } else {
        PG8_STAGE_X(PG8_SB(0, 0), cB, voffB, rsB, g.Bt); PG8_STAGE_X(PG8_SA(0, 0), cA, voffA, rsA, g.A); PG8_STAGE_X(PG8_SB(0, 1), cB + hstep, voffB, rsB, g.Bt); PG8_STAGE_X(PG8_SA(0, 1), cA + hstep, voffA, rsA, g.A);
        if (wr == 1) PG8_BAR;
        PG8_WAIT_V(4); PG8_BAR;
        PG8_STAGE_X(PG8_SB(1, 0), cB + kstep, voffB, rsB, g.Bt); PG8_STAGE_X(PG8_SA(1, 0), cA + kstep, voffA, rsA, g.A); PG8_STAGE_X(PG8_SB(1, 1), cB + hstep + kstep, voffB, rsB, g.Bt);
        PG8_WAIT_V(6); PG8_BAR;
    }
    for (;;) {
        const bool has_next = S.next(ui + 1, nxt);
        const char* nA = has_next ? (const char*)g.A + (size_t)nxt.pm * tstep : cA; const char* nB = has_next ? (const char*)g.Bt + (size_t)nxt.pn * tstep : cB;
        for (int t = 0; t < nt; t += 2) {
            const bool last = (t == nt - 2);
            const char* a1 = cA + (size_t)(t + 1) * kstep;
            const char* a2 = last ? nA : cA + (size_t)(t + 2) * kstep; const char* b2 = last ? nB : cB + (size_t)(t + 2) * kstep;
            const char* a3 = a2 + kstep; const char* b3 = b2 + kstep;
            if (last && has_next) S.a_ready(nxt);
            if constexpr (SP2) {
            PG8_LDB(B0, 0, 0); PG8_LDB(B1, 0, 1); PG8_SCHED; PG8_LDA(At, 0, 0); PG8_STAGE_X(PG8_SA(1, 1), a1 + hstep, voffA, rsA, g.A);
            PG8_WAIT_V(8); PG8_WAIT_L(0); PG8_BAR; PG8_MMA(0, 0, At, B0); PG8_MMA(0, 1, At, B1); PG8_BAR; PG8_SCHED;
            PG8_LDA(At, 0, 1); PG8_STAGE_X(PG8_SB(0, 0), b2, voffB, rsB, g.Bt); PG8_STAGE_X(PG8_SB(0, 1), b2 + hstep, voffB, rsB, g.Bt); PG8_STAGE_X(PG8_SA(0, 0), a2, voffA, rsA, g.A);
            PG8_WAIT_V(8); PG8_WAIT_L(0); PG8_BAR; PG8_MMA(1, 0, At, B0); PG8_MMA(1, 1, At, B1); PG8_BAR; PG8_SCHED;
            PG8_LDB(B0, 1, 0); PG8_LDB(B1, 1, 1); PG8_SCHED; PG8_LDA(At, 1, 0); PG8_STAGE_X(PG8_SA(0, 1), a2 + hstep, voffA, rsA, g.A);
            PG8_WAIT_V(8); PG8_WAIT_L(0); PG8_BAR; PG8_MMA(0, 0, At, B0); PG8_MMA(0, 1, At, B1); PG8_BAR; PG8_SCHED;
            PG8_LDA(At, 1, 1); PG8_STAGE_X(PG8_SB(1, 0), b3, voffB, rsB, g.Bt); PG8_STAGE_X(PG8_SB(1, 1), b3 + hstep, voffB, rsB, g.Bt); PG8_STAGE_X(PG8_SA(1, 0), a3, voffA, rsA, g.A);
            PG8_WAIT_V(8); PG8_WAIT_L(0); PG8_BAR; PG8_MMA(1, 0, At, B0); PG8_MMA(1, 1, At, B1); PG8_BAR; PG8_SCHED;
            } else {
            PG8_LDB(B0, 0, 0); PG8_SCHED; PG8_LDA(At, 0, 0); PG8_STAGE_X(PG8_SA(1, 1), a1 + hstep, voffA, rsA, g.A);
            PG8_WAIT_L(8); PG8_BAR; PG8_WAIT_L(0); PG8_MMA(0, 0, At, B0); PG8_BAR; PG8_SCHED;
            PG8_LDB(B1, 0, 1); PG8_STAGE_X(PG8_SB(0, 0), b2, voffB, rsB, g.Bt);
            PG8_BAR; PG8_WAIT_L(0); PG8_MMA(0, 1, At, B1); PG8_BAR;
            PG8_LDA(At, 0, 1); PG8_STAGE_X(PG8_SA(0, 0), a2, voffA, rsA, g.A);
            PG8_BAR; PG8_WAIT_L(0); PG8_MMA(1, 0, At, B0); PG8_BAR; PG8_SCHED;
            PG8_STAGE_X(PG8_SB(0, 1), b2 + hstep, voffB, rsB, g.Bt);
            PG8_WAIT_V(6); PG8_BAR; PG8_MMA(1, 1, At, B1); PG8_BAR;
            PG8_LDB(B0, 1, 0); PG8_SCHED; PG8_LDA(At, 1, 0); PG8_STAGE_X(PG8_SA(0, 1), a2 + hstep, voffA, rsA, g.A);
            PG8_WAIT_L(8); PG8_BAR; PG8_WAIT_L(0); PG8_MMA(0, 0, At, B0); PG8_BAR; PG8_SCHED;
            PG8_LDB(B1, 1, 1); PG8_STAGE_X(PG8_SB(1, 0), b3, voffB, rsB, g.Bt);
            PG8_BAR; PG8_WAIT_L(0); PG8_MMA(0, 1, At, B1); PG8_BAR;
            PG8_LDA(At, 1, 1); PG8_STAGE_X(PG8_SA(1, 0), a3, voffA, rsA, g.A);
            PG8_BAR; PG8_WAIT_L(0); PG8_MMA(1, 0, At, B0); PG8_BAR; PG8_SCHED;
            PG8_STAGE_X(PG8_SB(1, 1), b3 + hstep, voffB, rsB, g.Bt);
            PG8_WAIT_V(6); PG8_BAR; PG8_MMA(1, 1, At, B1); PG8_BAR;
            }
        }
        if constexpr (ALIGN_EPI) { if (wr == 0) PG8_BAR; }
        if constexpr (!Epi::AFTER_DRAIN) { E(acc, cur, wr, wc, fr, fq); S.done(cur); }
        if (!has_next) break;
#pragma unroll
        for (int a = 0; a < 2; ++a)
#pragma unroll
            for (int b = 0; b < 2; ++b)
#pragma unroll
                for (int m = 0; m < 4; ++m)
#pragma unroll
                    for (int n = 0; n < 2; ++n) acc[a][b][m][n] = (f32x4){0.f, 0.f, 0.f, 0.f};
        cur = nxt; cA = nA; cB = nB; ++ui;
        if constexpr (ALIGN_EPI) { if (wr == 1) PG8_BAR; }
    }
    PG8_WAIT_V(0);
    if constexpr (!ALIGN_EPI) { if (wr == 0) PG8_BAR; }
    PG8_BAR;
    if constexpr (Epi::AFTER_DRAIN) { E.fused(acc, cur, wr, wc, fr, fq, lds, wid, lane); S.done(cur); }
#undef PG8_SA
#undef PG8_SB
#undef PG8_STAGE_X
#undef PG8_LDA
#undef PG8_LDB
#undef PG8_MMA
#undef PG8_WAIT_V
#undef PG8_WAIT_L
#undef PG8_BAR
#undef PG8_SCHED
}
}
#define GAS __attribute__((address_space(1)))
#define LAS __attribute__((address_space(3)))
typedef unsigned short bf16_t;
typedef unsigned u32x4 __attribute__((ext_vector_type(4)));
typedef unsigned u32x2 __attribute__((ext_vector_type(2)));
typedef float f32x4 __attribute__((ext_vector_type(4)));
typedef float f32x2 __attribute__((ext_vector_type(2)));
typedef float f32x16 __attribute__((ext_vector_type(16)));
typedef short bf16x8 __attribute__((ext_vector_type(8)));
typedef short s16x4 __attribute__((ext_vector_type(4)));
typedef __bf16 bf16x2_t __attribute__((ext_vector_type(2)));

namespace mk {
constexpr int M = 16384, D = 4096, S = 2048, NB = 8, PW = 12298, NH = 32, NE = 16384;
constexpr int NWAVES = 8;
constexpr size_t MiB = 1u << 20;
constexpr size_t WS_CTL = 0, CTL_ZERO_BYTES = 1 * MiB;
constexpr size_t WS_RSTD = 2 * MiB, WS_LOGF = 3 * MiB, WS_WQK = 4 * MiB, WS_WOUT = 20 * MiB, WS_WIN = 52 * MiB, WS_U16 = 148 * MiB, WS_V16 = 276 * MiB,
                 WS_XB = 404 * MiB, WS_Q = 532 * MiB, WS_K = 660 * MiB, WS_V = 788 * MiB, WS_OB = 916 * MiB, WS_X2 = 1792 * MiB, WS_END = 2048 * MiB;
constexpr size_t WS_SC = WS_Q;
constexpr int CW_BAR = 4096;
constexpr int CW_QUEUE = 16384;
constexpr int RING_BYTES = 131072, LDSCTL_OFF = RING_BYTES, MISC_OFF = LDSCTL_OFF + 320, LDS_BYTES = 147456;

struct Args { const float* in[13]; float* out; unsigned char* ws; int ph_lo, ph_hi; };

__device__ __forceinline__ unsigned f2bf(float f) { unsigned u = __builtin_bit_cast(unsigned, f); return (u + 0x7fffu + ((u >> 16) & 1u)) >> 16; }
__device__ __forceinline__ unsigned pk2(float lo, float hi) { return f2bf(lo) | (f2bf(hi) << 16); }
__device__ __forceinline__ float bf_lo(unsigned w) { return __builtin_bit_cast(float, w << 16); }
__device__ __forceinline__ float bf_hi(unsigned w) { return __builtin_bit_cast(float, w & 0xffff0000u); }
__device__ __forceinline__ float wsum(float v) {
#pragma unroll
    for (int o = 1; o < 64; o <<= 1) v += __shfl_xor(v, o);
    return v;
}
__device__ __forceinline__ float wmax(float v) {
#pragma unroll
    for (int o = 1; o < 64; o <<= 1) v = fmaxf(v, __shfl_xor(v, o));
    return v;
}
__device__ __forceinline__ int wmin_i(int v) {
#pragma unroll
    for (int o = 1; o < 64; o <<= 1) { const int t = __shfl_xor(v, o); v = t < v ? t : v; }
    return v;
}
constexpr float US = 1024.0f, VS = 32.0f, US_INV = 1.0f / 1024.0f, VS_INV = 1.0f / 32.0f;
__device__ __forceinline__ float clamp8(float x) { return fminf(fmaxf(x, -224.0f), 224.0f); }
__device__ __forceinline__ float logsig(float z) { return fminf(z, 0.f) - 0.6931471805599453f * __builtin_amdgcn_logf(1.0f + __builtin_amdgcn_exp2f(-fabsf(z) * 1.4426950408889634f)); }
__device__ __forceinline__ float gelu_erf(float v) {
    const float av = fabsf(v), t = __builtin_amdgcn_rcpf(av * 0.2316418882f + 1.0f);
    float q = t * 0.5307027145f + (-0.7265760135f); q = q * t + 0.7107068705f; q = q * t + (-0.142248368f); q = q * t + 0.127414796f; q = q * t;
    const float e = __builtin_amdgcn_exp2f((v * v) * (-0.72134752044f));
    const float m = v * (q * e);
    return v < 0.f ? m : v - m;
}
#define LDS_WAIT() asm volatile("s_waitcnt lgkmcnt(0)" ::: "memory")
#define FRESH_LDS(l) do { unsigned v_ = (unsigned)(size_t)(l); asm volatile("" : "+s"(v_)); (l) = (LAS unsigned char*)(size_t)v_; } while (0)
#define FRESH_BID() int bid = blockIdx.x, G = gridDim.x; asm volatile("" : "+s"(bid), "+s"(G))
#define FRESH_TID() int tid; { int w_ = wave0, l_ = (int)__builtin_amdgcn_mbcnt_hi(~0u, __builtin_amdgcn_mbcnt_lo(~0u, 0u)); asm volatile("" : "+s"(w_)); asm volatile("" : "+v"(l_)); tid = w_ * 64 + l_; } const int lane = tid & 63, wave = __builtin_amdgcn_readfirstlane(tid >> 6); (void)lane; (void)wave

__device__ __forceinline__ void transpose_item(const float* W, int K, int ldw, int ncols, const float* gain, bf16_t* WT, LAS float* scr, int item, int lane) {
    const int nblk = ncols / 32, kb = item / nblk, nb = item % nblk, k0 = 64 * kb, n0 = 32 * nb;
#pragma unroll 8
    for (int i = 0; i < 32; ++i) { const int kk = 2 * i + (lane >> 5); float v = W[(size_t)(k0 + kk) * ldw + n0 + (lane & 31)]; if (gain) v *= gain[k0 + kk]; scr[kk * 33 + (lane & 31)] = v; }
    LDS_WAIT(); asm volatile("" ::: "memory");
    const int c = lane & 7;
#pragma unroll
    for (int j = 0; j < 4; ++j) { const int n = (lane >> 3) + 8 * j; const LAS float* s = scr + (8 * c) * 33 + n;
        u32x4 o; o.x = pk2(s[0 * 33], s[1 * 33]); o.y = pk2(s[2 * 33], s[3 * 33]); o.z = pk2(s[4 * 33], s[5 * 33]); o.w = pk2(s[6 * 33], s[7 * 33]);
        *(u32x4*)(WT + (size_t)(n0 + n) * K + k0 + 8 * c) = o; }
    LDS_WAIT(); asm volatile("" ::: "memory");
}

typedef const __attribute__((address_space(4))) Args* KArgsT;
__device__ __forceinline__ unsigned pk4_fp8(float a, float b, float c, float d) { int p = __builtin_amdgcn_cvt_pk_fp8_f32(clamp8(a), clamp8(b), 0, false); p = __builtin_amdgcn_cvt_pk_fp8_f32(clamp8(c), clamp8(d), p, true); return (unsigned)p; }
__device__ __forceinline__ void transpose_item8(const float* W, int K, int ldw, int ncols, const float* gain, float scale, unsigned char* WT, LAS float* scr, int item, int lane) {
    const int nblk = ncols / 32, kb = item / nblk, nb = item % nblk, k0 = 64 * kb, n0 = 32 * nb;
#pragma unroll 8
    for (int i = 0; i < 32; ++i) { const int kk = 2 * i + (lane >> 5); float v = W[(size_t)(k0 + kk) * ldw + n0 + (lane & 31)] * scale; if (gain) v *= gain[k0 + kk]; scr[kk * 33 + (lane & 31)] = v; }
    LDS_WAIT(); asm volatile("" ::: "memory");
    const int c = lane & 7;
#pragma unroll
    for (int j = 0; j < 4; ++j) { const int n = (lane >> 3) + 8 * j; const LAS float* s = scr + (8 * c) * 33 + n;
        u32x2 o; o.x = pk4_fp8(s[0 * 33], s[1 * 33], s[2 * 33], s[3 * 33]); o.y = pk4_fp8(s[4 * 33], s[5 * 33], s[6 * 33], s[7 * 33]);
        *(u32x2*)(WT + (size_t)(n0 + n) * K + k0 + 8 * c) = o; }
    LDS_WAIT(); asm volatile("" ::: "memory");
}
__device__ __forceinline__ void conv_phase(KArgsT ka, int l, LAS unsigned char* lds, int wave0) {
    FRESH_TID(); FRESH_LDS(lds); FRESH_BID();
    unsigned char* ws = ka->ws;
    const float* ln1 = ka->in[1] + (size_t)l * D; const float* w_in = ka->in[2] + (size_t)l * D * PW; const float* w_out = ka->in[5] + (size_t)l * D * D;
    const float* ln2 = ka->in[6] + (size_t)l * D; const float* wq = ka->in[7] + (size_t)l * D * 2048;
    const float* k1 = ka->in[8] + (size_t)l * 8 * 128 * 128; const float* k2 = ka->in[9] + (size_t)l * 8 * 128 * 128;
    const float* pu = ka->in[10] + (size_t)l * NE * D; const float* pv = ka->in[11] + (size_t)l * NE * D;
    bf16_t* WQK = (bf16_t*)(ws + WS_WQK); bf16_t* WOUT = (bf16_t*)(ws + WS_WOUT); bf16_t* WIN = (bf16_t*)(ws + WS_WIN); bf16_t* U16 = (bf16_t*)(ws + WS_U16); bf16_t* V16 = (bf16_t*)(ws + WS_V16);
    {
        LAS float* Ks = (LAS float*)lds;
        LAS float* Ws = (LAS float*)(lds + 128 * 132 * 4);
        for (int it = bid; it < 1024; it += G) {
            const int gi = it >> 6, c0 = (it & 63) * 64;
            const float* key = ((gi & 1) ? k2 : k1) + (size_t)(gi >> 1) * 128 * 128;
            for (int i = tid; i < 4096; i += 512) { const int r = i >> 5, c4 = (i & 31) * 4; *(LAS f32x4*)(Ks + r * 132 + c4) = *(const f32x4*)(key + r * 128 + c4); }
            for (int i = tid; i < 2048; i += 512) { const int r = i >> 5, c4 = (i & 31) * 4; *(LAS f32x4*)(Ws + r * 132 + c4) = *(const f32x4*)(wq + (size_t)(c0 + r) * 2048 + gi * 128 + c4); }
            __syncthreads();
            const int tc = tid & 15, tn = tid >> 4;
            float acc[4][4];
#pragma unroll
            for (int i = 0; i < 4; ++i)
#pragma unroll
                for (int j = 0; j < 4; ++j) acc[i][j] = 0.f;
#pragma unroll 2
            for (int d = 0; d < 128; d += 4) {
                f32x4 kv[4], wv[4];
#pragma unroll
                for (int i = 0; i < 4; ++i) kv[i] = *(const LAS f32x4*)(Ks + (4 * tn + i) * 132 + d);
#pragma unroll
                for (int j = 0; j < 4; ++j) wv[j] = *(const LAS f32x4*)(Ws + (tc + 16 * j) * 132 + d);
#pragma unroll
                for (int i = 0; i < 4; ++i)
#pragma unroll
                    for (int j = 0; j < 4; ++j) acc[i][j] += kv[i][0] * wv[j][0] + kv[i][1] * wv[j][1] + kv[i][2] * wv[j][2] + kv[i][3] * wv[j][3];
            }
#pragma unroll
            for (int j = 0; j < 4; ++j) { const int c = c0 + tc + 16 * j; const float gg = ln2[c];
#pragma unroll
                for (int i = 0; i < 4; ++i) WQK[(size_t)(gi * 128 + 4 * tn + i) * D + c] = (bf16_t)f2bf(acc[i][j] * gg); }
            __syncthreads();
        }
        __syncthreads();
    }
    const int gw = bid * NWAVES + wave, NGW = G * NWAVES;
    {
        unsigned char* U8 = (unsigned char*)U16; unsigned char* V8 = U8 + (size_t)NE * D;
        for (int r = gw; r < NE; r += NGW) {
            const float* us = pu + (size_t)r * D; const float* vs = pv + (size_t)r * D;
#pragma unroll
            for (int i = 0; i < 4; ++i) { const int c = 1024 * i + 16 * lane;
                u32x4 ou, ov;
#pragma unroll
                for (int q = 0; q < 4; ++q) { const f32x4 u0 = *(const f32x4*)(us + c + 4 * q), g0 = *(const f32x4*)(ln2 + c + 4 * q), v0 = *(const f32x4*)(vs + c + 4 * q);
                    int pu_ = __builtin_amdgcn_cvt_pk_fp8_f32(clamp8(u0[0] * g0[0] * US), clamp8(u0[1] * g0[1] * US), 0, false); pu_ = __builtin_amdgcn_cvt_pk_fp8_f32(clamp8(u0[2] * g0[2] * US), clamp8(u0[3] * g0[3] * US), pu_, true);
                    int pv_ = __builtin_amdgcn_cvt_pk_fp8_f32(clamp8(v0[0] * VS), clamp8(v0[1] * VS), 0, false); pv_ = __builtin_amdgcn_cvt_pk_fp8_f32(clamp8(v0[2] * VS), clamp8(v0[3] * VS), pv_, true);
                    ou[q] = (unsigned)pu_; ov[q] = (unsigned)pv_; }
                *(u32x4*)(U8 + (size_t)r * D + c) = ou; *(u32x4*)(V8 + (size_t)r * D + c) = ov; }
        }
    }
    {
        LAS float* scr = (LAS float*)(lds + wave * 16384);
        constexpr int I_O = (D / 64) * (D / 32), I_IN = (D / 64) * (12288 / 32);
        for (int it = gw; it < I_O + I_IN; it += NGW) {
            if (it < I_O) transpose_item8(w_out, D, D, D, nullptr, US, (unsigned char*)WOUT, scr, it, lane);
            else transpose_item8(w_in, D, PW, 12288, ln1, US, (unsigned char*)WIN, scr, it - I_O, lane);
        }
    }
}

template <bool WITH_F>
__device__ __forceinline__ void prep_phase(const float* X, bf16_t* XB, float* RSTD, const float* w_in, const float* ln1, const float* bf, float* LOGF, LAS unsigned char* lds, int wave0) {
    FRESH_TID(); FRESH_LDS(lds); FRESH_BID();
    LAS unsigned short* gfs = (LAS unsigned short*)lds;
    if (WITH_F) {
        __syncthreads();
        for (int c = tid; c < D; c += 512) { const float g = ln1[c]; const float* wr = w_in + (size_t)c * PW + 12288;
#pragma unroll
            for (int j = 0; j < 10; ++j) gfs[j * D + c] = (unsigned short)f2bf(wr[j] * g); }
        __syncthreads();
    }
    const int gw = bid * NWAVES + wave, NGW = G * NWAVES;
    for (int m = gw; m < M; m += NGW) {
        const f32x4* xr = (const f32x4*)(X + (size_t)m * D) + lane;
        f32x4 v[16]; float ss = 0.f;
#pragma unroll
        for (int i = 0; i < 16; ++i) { v[i] = xr[64 * i]; ss += (v[i][0] * v[i][0] + v[i][1] * v[i][1]) + (v[i][2] * v[i][2] + v[i][3] * v[i][3]); }
        ss = wsum(ss);
        const float rstd = rsqrtf(ss * (1.0f / D) + 1e-6f);
        if (WITH_F) {
            unsigned* o8 = (unsigned*)((unsigned char*)XB + (size_t)m * D) + lane;
#pragma unroll
            for (int i = 0; i < 16; ++i) o8[64 * i] = pk4_fp8(v[i][0], v[i][1], v[i][2], v[i][3]);
        } else {
        u32x2* o = (u32x2*)(XB + (size_t)m * D) + lane;
#pragma unroll
        for (int i = 0; i < 16; ++i) { u32x2 w; w.x = pk2(v[i][0], v[i][1]); w.y = pk2(v[i][2], v[i][3]); o[64 * i] = w; }
        }
        if (lane == 0) RSTD[m] = rstd;
        if (WITH_F) {
            float mine = 0.f;
#pragma unroll 1
            for (int j = 0; j < 10; ++j) { float s = 0.f;
#pragma unroll
                for (int i = 0; i < 16; ++i) { const u32x2 gp = *(const LAS u32x2*)(gfs + j * D + 256 * i + 4 * lane);
                    s += (v[i][0] * bf_lo(gp.x) + v[i][1] * bf_hi(gp.x)) + (v[i][2] * bf_lo(gp.y) + v[i][3] * bf_hi(gp.y)); }
                s = wsum(s); if (lane == j) mine = s; }
            if (lane < 10) { const int b = m >> 11, s = m & 2047; LOGF[(size_t)(b * 10 + lane) * S + s] = logsig(mine * rstd + bf[lane]); }
        }
    }
}


__device__ __forceinline__ unsigned wave_max_u32(unsigned v) {
    v = max(v, (unsigned)__builtin_amdgcn_update_dpp(0, (int)v, 0x111, 0xF, 0xF, true));
    v = max(v, (unsigned)__builtin_amdgcn_update_dpp(0, (int)v, 0x112, 0xF, 0xF, true));
    v = max(v, (unsigned)__builtin_amdgcn_update_dpp(0, (int)v, 0x114, 0xF, 0xF, true));
    v = max(v, (unsigned)__builtin_amdgcn_update_dpp(0, (int)v, 0x118, 0xF, 0xF, true));
    v = max(v, (unsigned)__builtin_amdgcn_update_dpp((int)v, (int)v, 0x142, 0xA, 0xF, false));
    v = max(v, (unsigned)__builtin_amdgcn_update_dpp((int)v, (int)v, 0x143, 0xC, 0xF, false));
    return (unsigned)__builtin_amdgcn_readlane((int)v, 63);
}
__device__ __forceinline__ float wave_sum_dpp(float x) {
    int v = __builtin_bit_cast(int, x);
#define DPP_ADD(ctrl, rm, bc, oldv) v = __builtin_bit_cast(int, __builtin_bit_cast(float, v) + __builtin_bit_cast(float, __builtin_amdgcn_update_dpp(oldv, v, ctrl, rm, 0xF, bc)))
    DPP_ADD(0x111, 0xF, true, 0); DPP_ADD(0x112, 0xF, true, 0); DPP_ADD(0x114, 0xF, true, 0); DPP_ADD(0x118, 0xF, true, 0);
#undef DPP_ADD
    const float r0 = __builtin_bit_cast(float, __builtin_amdgcn_readlane(v, 15)), r1 = __builtin_bit_cast(float, __builtin_amdgcn_readlane(v, 31)), r2 = __builtin_bit_cast(float, __builtin_amdgcn_readlane(v, 47)), r3 = __builtin_bit_cast(float, __builtin_amdgcn_readlane(v, 63));
    return (r0 + r1) + (r2 + r3);
}
__device__ __forceinline__ unsigned ordkey(float x) { const unsigned u = __builtin_bit_cast(unsigned, x); return (u & 0x80000000u) ? ~u : (u | 0x80000000u); }
#define RFL(x) __builtin_amdgcn_readfirstlane(x)
template <bool FINAL, bool ROUTE_EXT = false, bool SKIP_U = false>
__device__ __forceinline__ void peer_phase(const float* SC, const bf16_t* XB, const float* RSTD, const bf16_t* U16, const bf16_t* V16, const float* X1, float* XO, const float* fg,
                                           LAS unsigned char* lds, int wave0) {
    FRESH_TID(); FRESH_LDS(lds); FRESH_BID();
    LAS int* s_eid = (LAS int*)(lds + wave * 1024); LAS float* s_w = (LAS float*)(lds + wave * 1024 + 512);
    const int gw = bid * NWAVES + wave, NGW = G * NWAVES;
    const float NEG = -3.0e38f;
    for (int tok = gw; tok < M; tok += NGW) {
        const float* sc = SC + (size_t)tok * 2048;
        if (ROUTE_EXT) { const int* ee = (const int*)SC; const float* gg = (const float*)XB;     (void)ee; (void)gg; }
        for (int h = 0; h < (ROUTE_EXT ? 0 : 8); ++h) {
            float a0 = sc[h * 256 + lane], a1 = sc[h * 256 + 64 + lane], c0 = sc[h * 256 + 128 + lane], c1 = sc[h * 256 + 192 + lane];
            float v1 = 0.f, v2 = 0.f; int i1 = 0, i2 = 0;
            for (int it = 0; it < 16; ++it) {
                { const float m = wmax(fmaxf(a0, a1)); int cand = 1 << 30; if (a0 == m) cand = lane; else if (a1 == m) cand = lane + 64;
                  const int n = wmin_i(cand); if (n == lane) a0 = NEG; if (n == lane + 64) a1 = NEG; if (lane == it) { v1 = m; i1 = n; } }
                { const float m = wmax(fmaxf(c0, c1)); int cand = 1 << 30; if (c0 == m) cand = lane; else if (c1 == m) cand = lane + 64;
                  const int n = wmin_i(cand); if (n == lane) c0 = NEG; if (n == lane + 64) c1 = NEG; if (lane == it) { v2 = m; i2 = n; } }
            }
            float d0, d1, d2, d3;
            { const float va = __shfl(v1, lane >> 2); d0 = va + __shfl(v2, (lane & 3) * 4 + 0); d1 = va + __shfl(v2, (lane & 3) * 4 + 1); d2 = va + __shfl(v2, (lane & 3) * 4 + 2); d3 = va + __shfl(v2, (lane & 3) * 4 + 3); }
            float best = 0.f; int be = 0;
            for (int it = 0; it < 16; ++it) {
                const float m = wmax(fmaxf(fmaxf(d0, d1), fmaxf(d2, d3)));
                int cand = 1 << 30;
                if (d0 == m) cand = lane * 4; else if (d1 == m) cand = lane * 4 + 1; else if (d2 == m) cand = lane * 4 + 2; else if (d3 == m) cand = lane * 4 + 3;
                const int pos = wmin_i(cand);
                if (pos == lane * 4) d0 = NEG; if (pos == lane * 4 + 1) d1 = NEG; if (pos == lane * 4 + 2) d2 = NEG; if (pos == lane * 4 + 3) d3 = NEG;
                const int e = ((__shfl(i1, (pos >> 4) & 15) & 127) << 7) | (__shfl(i2, pos & 15) & 127);
                if (lane == it) { best = m; be = e; }
            }
            const float mx = __shfl(best, 0);
            const float p = lane < 16 ? __builtin_amdgcn_exp2f((best - mx) * 1.4426950408889634f) : 0.f;
            const float sm = wsum(p);
            if (lane < 16) { s_eid[h * 16 + lane] = be; s_w[h * 16 + lane] = p / sm; }
        }
        if (ROUTE_EXT) { const int* ee = (const int*)fg; const float* gg = (const float*)(ee + (size_t)M * 128); s_eid[lane] = ee[(size_t)tok * 128 + lane]; s_eid[lane + 64] = ee[(size_t)tok * 128 + lane + 64]; s_w[lane] = gg[(size_t)tok * 128 + lane]; s_w[lane + 64] = gg[(size_t)tok * 128 + lane + 64]; }
        LDS_WAIT(); asm volatile("" ::: "memory");
        if (!SKIP_U) {
            u32x4 xr[8];
            { const u32x4* p_ = (const u32x4*)(XB + (size_t)tok * D) + lane;
#pragma unroll
              for (int i = 0; i < 8; ++i) xr[i] = p_[64 * i]; }
            const float rstd = RSTD[tok];
#define LOADROW(dst, base, e) do { const u32x4* p_ = (const u32x4*)((base) + (size_t)(e) * D) + lane; _Pragma("unroll") for (int i_ = 0; i_ < 8; ++i_) dst[i_] = p_[64 * i_]; } while (0)
#define UDOT(row, j) do { float d_ = 0.f; _Pragma("unroll") for (int i_ = 0; i_ < 8; ++i_) { _Pragma("unroll") for (int k_ = 0; k_ < 4; ++k_) \
                { d_ = fmaf(bf_lo(xr[i_][k_]), bf_lo(row[i_][k_]), d_); d_ = fmaf(bf_hi(xr[i_][k_]), bf_hi(row[i_][k_]), d_); } } \
            d_ = wsum(d_) * rstd; const float ge_ = gelu_erf(d_); if (lane == 0) s_w[j] *= ge_; } while (0)
            u32x4 ra[8], rb[8];
            { const int e0 = RFL(s_eid[0]); LOADROW(ra, U16, e0); }
            for (int j = 0; j < 128; j += 2) {
                { const int e1 = RFL(s_eid[j + 1]); LOADROW(rb, U16, e1); }
                UDOT(ra, j);
                if (j + 2 < 128) { const int e2 = RFL(s_eid[j + 2]); LOADROW(ra, U16, e2); }
                UDOT(rb, j + 1);
            }
#undef UDOT
        }
        LDS_WAIT(); asm volatile("" ::: "memory");
        {
            float acc[8][8];
#pragma unroll
            for (int i = 0; i < 8; ++i)
#pragma unroll
                for (int k = 0; k < 8; ++k) acc[i][k] = 0.f;
#define VACC(row, j) do { const float w_ = s_w[j]; _Pragma("unroll") for (int i_ = 0; i_ < 8; ++i_) { _Pragma("unroll") for (int k_ = 0; k_ < 4; ++k_) { \
                acc[i_][2 * k_] = fmaf(w_, bf_lo(row[i_][k_]), acc[i_][2 * k_]); acc[i_][2 * k_ + 1] = fmaf(w_, bf_hi(row[i_][k_]), acc[i_][2 * k_ + 1]); } } } while (0)
            u32x4 ra[8], rb[8];
            { const int e0 = RFL(s_eid[0]); LOADROW(ra, V16, e0); }
            for (int j = 0; j < 128; j += 2) {
                { const int e1 = RFL(s_eid[j + 1]); LOADROW(rb, V16, e1); }
                VACC(ra, j);
                if (j + 2 < 128) { const int e2 = RFL(s_eid[j + 2]); LOADROW(ra, V16, e2); }
                VACC(rb, j + 1);
            }
#undef VACC
#undef LOADROW
            const float* x1 = X1 + (size_t)tok * D; float* xo = XO + (size_t)tok * D;
            float ss = 0.f;
#pragma unroll
            for (int i = 0; i < 8; ++i) { const int c = 512 * i + 8 * lane; const f32x4 p0 = *(const f32x4*)(x1 + c), p1 = *(const f32x4*)(x1 + c + 4);
                acc[i][0] += p0[0]; acc[i][1] += p0[1]; acc[i][2] += p0[2]; acc[i][3] += p0[3]; acc[i][4] += p1[0]; acc[i][5] += p1[1]; acc[i][6] += p1[2]; acc[i][7] += p1[3];
#pragma unroll
                for (int k = 0; k < 8; ++k) ss += acc[i][k] * acc[i][k]; }
            float rs = 1.f;
            if (FINAL) { ss = wsum(ss); rs = rsqrtf(ss * (1.0f / D) + 1e-6f); }
#pragma unroll
            for (int i = 0; i < 8; ++i) { const int c = 512 * i + 8 * lane; f32x4 o0, o1;
                if (FINAL) { const f32x4 g0 = *(const f32x4*)(fg + c), g1 = *(const f32x4*)(fg + c + 4);
                    o0 = (f32x4){acc[i][0] * rs * g0[0], acc[i][1] * rs * g0[1], acc[i][2] * rs * g0[2], acc[i][3] * rs * g0[3]}; o1 = (f32x4){acc[i][4] * rs * g1[0], acc[i][5] * rs * g1[1], acc[i][6] * rs * g1[2], acc[i][7] * rs * g1[3]}; }
                else { o0 = (f32x4){acc[i][0], acc[i][1], acc[i][2], acc[i][3]}; o1 = (f32x4){acc[i][4], acc[i][5], acc[i][6], acc[i][7]}; }
                *(f32x4*)(xo + c) = o0; *(f32x4*)(xo + c + 4) = o1; }
        }
        LDS_WAIT(); asm volatile("" ::: "memory");
    }
}

template <bool FINAL>
__device__ __forceinline__ void peer_phase8(const float* SC, const float* RSTD, const unsigned char* U8, const unsigned char* V8, const float* X1, float* XO, const float* fg, LAS unsigned char* lds, int wave0) {
    FRESH_TID(); FRESH_LDS(lds); FRESH_BID();
    LAS int* s_eid = (LAS int*)(lds + wave * 1024); LAS float* s_w = (LAS float*)(lds + wave * 1024 + 512);
    const int gw = bid * NWAVES + wave, NGW = G * NWAVES;
    const float NEG = -3.0e38f;
    for (int tok = gw; tok < M; tok += NGW) {
        const float* sc = SC + (size_t)tok * 2048;
        for (int h = 0; h < 8; ++h) {
            const float a0 = sc[h * 256 + lane], a1 = sc[h * 256 + 64 + lane], c0 = sc[h * 256 + 128 + lane], c1 = sc[h * 256 + 192 + lane];
            unsigned ka0 = (ordkey(a0) & ~127u) | (unsigned)(127 - lane), ka1 = (ordkey(a1) & ~127u) | (unsigned)(63 - lane);
            unsigned kc0 = (ordkey(c0) & ~127u) | (unsigned)(127 - lane), kc1 = (ordkey(c1) & ~127u) | (unsigned)(63 - lane);
            float v1 = 0.f, v2 = 0.f; int i1 = 0, i2 = 0;
            for (int it = 0; it < 16; ++it) {
                const unsigned m1 = wave_max_u32(max(ka0, ka1)), m2 = wave_max_u32(max(kc0, kc1));
                const int n1 = 127 - (int)(m1 & 127u), n2 = 127 - (int)(m2 & 127u);
                const float x1lo = __builtin_bit_cast(float, __builtin_amdgcn_readlane(__builtin_bit_cast(int, a0), n1 & 63)), x1hi = __builtin_bit_cast(float, __builtin_amdgcn_readlane(__builtin_bit_cast(int, a1), n1 & 63));
                const float x2lo = __builtin_bit_cast(float, __builtin_amdgcn_readlane(__builtin_bit_cast(int, c0), n2 & 63)), x2hi = __builtin_bit_cast(float, __builtin_amdgcn_readlane(__builtin_bit_cast(int, c1), n2 & 63));
                ka0 = ka0 == m1 ? 0u : ka0; ka1 = ka1 == m1 ? 0u : ka1; kc0 = kc0 == m2 ? 0u : kc0; kc1 = kc1 == m2 ? 0u : kc1;
                if (lane == it) { v1 = (n1 & 64) ? x1hi : x1lo; i1 = n1; v2 = (n2 & 64) ? x2hi : x2lo; i2 = n2; }
            }
            unsigned kd0, kd1, kd2, kd3;
            { const float va = __shfl(v1, lane >> 2); const int pb_ = 255 - 4 * lane;
              kd0 = (ordkey(va + __shfl(v2, (lane & 3) * 4 + 0)) & ~255u) | (unsigned)(pb_); kd1 = (ordkey(va + __shfl(v2, (lane & 3) * 4 + 1)) & ~255u) | (unsigned)(pb_ - 1);
              kd2 = (ordkey(va + __shfl(v2, (lane & 3) * 4 + 2)) & ~255u) | (unsigned)(pb_ - 2); kd3 = (ordkey(va + __shfl(v2, (lane & 3) * 4 + 3)) & ~255u) | (unsigned)(pb_ - 3); }
            float best = 0.f; int be = 0;
            for (int it = 0; it < 16; ++it) {
                const unsigned m = wave_max_u32(max(max(kd0, kd1), max(kd2, kd3)));
                const int pos = 255 - (int)(m & 255u);
                const float bv = __builtin_bit_cast(float, __builtin_amdgcn_readlane(__builtin_bit_cast(int, v1), pos >> 4)) + __builtin_bit_cast(float, __builtin_amdgcn_readlane(__builtin_bit_cast(int, v2), pos & 15));
                const int e = (__builtin_amdgcn_readlane(i1, pos >> 4) << 7) | __builtin_amdgcn_readlane(i2, pos & 15);
                kd0 = kd0 == m ? 0u : kd0; kd1 = kd1 == m ? 0u : kd1; kd2 = kd2 == m ? 0u : kd2; kd3 = kd3 == m ? 0u : kd3;
                if (lane == it) { best = bv; be = e; }
            }
            const float mx = __builtin_bit_cast(float, __builtin_amdgcn_readlane(__builtin_bit_cast(int, best), 0));
            const float p = lane < 16 ? __builtin_amdgcn_exp2f((best - mx) * 1.4426950408889634f) : 0.f;
            const float sm = wave_sum_dpp(p);
            if (lane < 16) { s_eid[h * 16 + lane] = be; s_w[h * 16 + lane] = p / sm; }
        }
        LDS_WAIT(); asm volatile("" ::: "memory");
#define LOADROW8(dst, base, e) do { const u32x4* p_ = (const u32x4*)((base) + (size_t)(e) * D) + lane; _Pragma("unroll") for (int i_ = 0; i_ < 4; ++i_) dst[i_] = p_[64 * i_]; } while (0)
        const float* x1 = X1 + (size_t)tok * D; float* xo = XO + (size_t)tok * D;
        {
            float xv[4][16];
#pragma unroll
            for (int i = 0; i < 4; ++i)
#pragma unroll
                for (int q = 0; q < 4; ++q) { const f32x4 t = *(const f32x4*)(x1 + 1024 * i + 16 * lane + 4 * q); xv[i][4 * q] = t[0]; xv[i][4 * q + 1] = t[1]; xv[i][4 * q + 2] = t[2]; xv[i][4 * q + 3] = t[3]; }
            const float rstd = RSTD[tok] * US_INV;
#define UDOT8(row, j) do { float da_ = 0.f, db_ = 0.f; _Pragma("unroll") for (int i_ = 0; i_ < 4; ++i_) { _Pragma("unroll") for (int k_ = 0; k_ < 4; ++k_) { \
                unsigned w0_ = row[i_][k_]; asm volatile("" : "+v"(w0_));     \
                const f32x2 lo_ = __builtin_amdgcn_cvt_pk_f32_fp8((int)w0_, false), hi_ = __builtin_amdgcn_cvt_pk_f32_fp8((int)w0_, true); \
                da_ = fmaf(xv[i_][4 * k_], lo_[0], da_); db_ = fmaf(xv[i_][4 * k_ + 1], lo_[1], db_); da_ = fmaf(xv[i_][4 * k_ + 2], hi_[0], da_); db_ = fmaf(xv[i_][4 * k_ + 3], hi_[1], db_); } \
                asm volatile("" : "+v"(da_), "+v"(db_)); } \
            const float d_ = wave_sum_dpp(da_ + db_) * rstd; const float ge_ = gelu_erf(d_); if (lane == 0) s_w[j] *= ge_; } while (0)
            u32x4 r0[4], r1[4], r2[4];
            { const int e_ = RFL(s_eid[0]); LOADROW8(r0, U8, e_); } { const int e_ = RFL(s_eid[1]); LOADROW8(r1, U8, e_); } { const int e_ = RFL(s_eid[2]); LOADROW8(r2, U8, e_); }
            for (int j = 0; j < 126; j += 3) {
                UDOT8(r0, j);     if (j + 3 < 128) { const int e_ = RFL(s_eid[j + 3]); LOADROW8(r0, U8, e_); }
                UDOT8(r1, j + 1); if (j + 4 < 128) { const int e_ = RFL(s_eid[j + 4]); LOADROW8(r1, U8, e_); }
                UDOT8(r2, j + 2); if (j + 5 < 128) { const int e_ = RFL(s_eid[j + 5]); LOADROW8(r2, U8, e_); }
            }
            UDOT8(r0, 126); UDOT8(r1, 127);
#undef UDOT8
        }
        LDS_WAIT(); asm volatile("" ::: "memory");
        {
            float acc[4][16];
#pragma unroll
            for (int i = 0; i < 4; ++i)
#pragma unroll
                for (int k = 0; k < 16; ++k) acc[i][k] = 0.f;
#define VACC8(row, j) do { const float w_ = s_w[j]; _Pragma("unroll") for (int i_ = 0; i_ < 4; ++i_) { _Pragma("unroll") for (int k_ = 0; k_ < 4; ++k_) { \
                unsigned w0_ = row[i_][k_]; asm volatile("" : "+v"(w0_)); \
                const f32x2 lo_ = __builtin_amdgcn_cvt_pk_f32_fp8((int)w0_, false), hi_ = __builtin_amdgcn_cvt_pk_f32_fp8((int)w0_, true); \
                acc[i_][4 * k_] = fmaf(w_, lo_[0], acc[i_][4 * k_]); acc[i_][4 * k_ + 1] = fmaf(w_, lo_[1], acc[i_][4 * k_ + 1]); acc[i_][4 * k_ + 2] = fmaf(w_, hi_[0], acc[i_][4 * k_ + 2]); acc[i_][4 * k_ + 3] = fmaf(w_, hi_[1], acc[i_][4 * k_ + 3]); } \
                asm volatile("" : "+v"(acc[i_][0]), "+v"(acc[i_][1]), "+v"(acc[i_][2]), "+v"(acc[i_][3]), "+v"(acc[i_][4]), "+v"(acc[i_][5]), "+v"(acc[i_][6]), "+v"(acc[i_][7]), \
                                  "+v"(acc[i_][8]), "+v"(acc[i_][9]), "+v"(acc[i_][10]), "+v"(acc[i_][11]), "+v"(acc[i_][12]), "+v"(acc[i_][13]), "+v"(acc[i_][14]), "+v"(acc[i_][15])); } } while (0)
            u32x4 r0[4], r1[4], r2[4];
            { const int e_ = RFL(s_eid[0]); LOADROW8(r0, V8, e_); } { const int e_ = RFL(s_eid[1]); LOADROW8(r1, V8, e_); } { const int e_ = RFL(s_eid[2]); LOADROW8(r2, V8, e_); }
            for (int j = 0; j < 126; j += 3) {
                VACC8(r0, j);     if (j + 3 < 128) { const int e_ = RFL(s_eid[j + 3]); LOADROW8(r0, V8, e_); }
                VACC8(r1, j + 1); if (j + 4 < 128) { const int e_ = RFL(s_eid[j + 4]); LOADROW8(r1, V8, e_); }
                VACC8(r2, j + 2); if (j + 5 < 128) { const int e_ = RFL(s_eid[j + 5]); LOADROW8(r2, V8, e_); }
            }
            VACC8(r0, 126); VACC8(r1, 127);
#undef VACC8
#undef LOADROW8
            float ss = 0.f;
#pragma unroll
            for (int i = 0; i < 4; ++i)
#pragma unroll
                for (int q = 0; q < 4; ++q) { const f32x4 t = *(const f32x4*)(x1 + 1024 * i + 16 * lane + 4 * q);
#pragma unroll
                    for (int k = 0; k < 4; ++k) { acc[i][4 * q + k] = fmaf(acc[i][4 * q + k], VS_INV, t[k]); ss += acc[i][4 * q + k] * acc[i][4 * q + k]; } }
            float rs = 1.f;
            if (FINAL) { ss = wsum(ss); rs = rsqrtf(ss * (1.0f / D) + 1e-6f); }
#pragma unroll
            for (int i = 0; i < 4; ++i)
#pragma unroll
                for (int q = 0; q < 4; ++q) { const int c = 1024 * i + 16 * lane + 4 * q; f32x4 o_;
                    if (FINAL) { const f32x4 g_ = *(const f32x4*)(fg + c); o_ = (f32x4){acc[i][4 * q] * rs * g_[0], acc[i][4 * q + 1] * rs * g_[1], acc[i][4 * q + 2] * rs * g_[2], acc[i][4 * q + 3] * rs * g_[3]}; }
                    else o_ = (f32x4){acc[i][4 * q], acc[i][4 * q + 1], acc[i][4 * q + 2], acc[i][4 * q + 3]};
                    *(f32x4*)(xo + c) = o_; }
        }
        LDS_WAIT(); asm volatile("" ::: "memory");
    }
}
}
namespace at {
using namespace mk;
constexpr int QB = 256, KVB = 64, HD = 128;
constexpr int SHM_V = KVB * HD * 2, SHM_K = KVB * HD * 2;
constexpr int OFF_V = 0, OFF_K = 2 * SHM_V, OFF_WS = OFF_K + 2 * SHM_K, OFF_CUM = OFF_WS + 8 * 256, OFF_RT = OFF_CUM + 2048 * 4, OFF_MISC = OFF_RT + 640 * 4;
constexpr float LOG2E = 1.4426950408889634f;
constexpr float THR2 = 10.0f;
constexpr float SB_DONE = -100.0f;

#define AT_KSWZ(row, colB) ((row) * 256 + ((colB) ^ (((row) & 7) << 4)))
__device__ __forceinline__ int v_st(int k, int c) { const int kk = (k & ~0xC) | ((k & 4) << 1) | ((k & 8) >> 1); return ((kk >> 3) * 4 + (c >> 5)) * 512 + ((kk & 7) * 32 + (c & 31)) * 2; }
__device__ __forceinline__ int v_rd_base(int lane) { return ((lane & 3) << 3) | (((lane >> 2) & 3) << 6) | (((lane >> 4) & 1) << 5) | (((lane >> 5) & 1) << 8); }
constexpr int v_rd_off(int d0, int ks, int half) { return d0 * 512 + ks * 4096 + half * 2048; }
__device__ __forceinline__ int crow(int r, int hi) { return (r & 3) + 8 * (r >> 2) + 4 * hi; }
__device__ __forceinline__ unsigned cvtpk(float lo, float hi) { unsigned r; asm volatile("v_cvt_pk_bf16_f32 %0, %1, %2" : "=v"(r) : "v"(lo), "v"(hi)); return r; }
__device__ __forceinline__ float partner(float v, int hi) { auto rr = __builtin_amdgcn_permlane32_swap(__builtin_bit_cast(unsigned, v), __builtin_bit_cast(unsigned, v), false, false); return __builtin_bit_cast(float, hi ? rr[0] : rr[1]); }

__device__ __forceinline__ float xchg_max(float v, int hi) { return fmaxf(v, partner(v, hi)); }
__device__ __forceinline__ float xchg_sum(float v, int hi) { return v + partner(v, hi); }

__device__ __forceinline__ void pack_p(const f32x16& p0, const f32x16& p1, bf16x8& pa0, bf16x8& pa1, bf16x8& pa2, bf16x8& pa3) {
#define AT_PK4(P, B_, OUT) do { unsigned a0 = cvtpk(P[B_ + 0], P[B_ + 1]), a1 = cvtpk(P[B_ + 2], P[B_ + 3]); unsigned b0 = cvtpk(P[B_ + 4], P[B_ + 5]), b1 = cvtpk(P[B_ + 6], P[B_ + 7]); \
        auto r0 = __builtin_amdgcn_permlane32_swap(a0, b0, false, false); auto r1 = __builtin_amdgcn_permlane32_swap(a1, b1, false, false); \
        u32x4 w = {r0[0], r1[0], r0[1], r1[1]}; OUT = __builtin_bit_cast(bf16x8, w); } while (0)
    AT_PK4(p0, 0, pa0); AT_PK4(p0, 8, pa1); AT_PK4(p1, 0, pa2); AT_PK4(p1, 8, pa3);
#undef AT_PK4
}
template <int KBUF>
__device__ __forceinline__ void qkt(f32x16& p0, f32x16& p1, LAS unsigned char* K_lds, int r32, int hi, const bf16x8 (&qr)[8]) {
    p0 = f32x16{}; p1 = f32x16{};
    LAS unsigned char* kb[4];
#pragma unroll
    for (int dd = 0; dd < 4; ++dd) kb[dd] = K_lds + KBUF * SHM_K + AT_KSWZ(r32, (dd * 16 + hi * 8) * 2);
#pragma unroll
    for (int d0 = 0; d0 < 8; ++d0) { LAS unsigned char* a = kb[d0 & 3] + (d0 >> 2) * 128;
        const bf16x8 b0 = *(const LAS bf16x8*)a; const bf16x8 b1 = *(const LAS bf16x8*)(a + 32 * 256);
        p0 = __builtin_amdgcn_mfma_f32_32x32x16_bf16(b0, qr[d0], p0, 0, 0, 0);
        p1 = __builtin_amdgcn_mfma_f32_32x32x16_bf16(b1, qr[d0], p1, 0, 0, 0); }
}
template <int VBUF>
__device__ __forceinline__ void pv_tile(f32x16 (&o)[4], int vb0, bf16x8 pa0, bf16x8 pa1, bf16x8 pa2, bf16x8 pa3) {
#define AT_TRRD(dst, off) asm volatile("ds_read_b64_tr_b16 %0, %1 offset:%2" : "=&v"(dst) : "v"(vb0), "i"(off) : "memory")
#define AT_PV_D0(d0) do { s16x4 l0, l1, l2, l3, h0, h1, h2, h3; constexpr int b_ = VBUF * SHM_V + v_rd_off(d0, 0, 0); \
        AT_TRRD(l0, b_); AT_TRRD(h0, b_ + 2048); AT_TRRD(l1, b_ + 4096); AT_TRRD(h1, b_ + 6144); AT_TRRD(l2, b_ + 8192); AT_TRRD(h2, b_ + 10240); AT_TRRD(l3, b_ + 12288); AT_TRRD(h3, b_ + 14336); \
        asm volatile("s_waitcnt lgkmcnt(0)" ::: "memory"); __builtin_amdgcn_sched_barrier(0); \
        o[d0] = __builtin_amdgcn_mfma_f32_32x32x16_bf16(pa0, (bf16x8){l0[0], l0[1], l0[2], l0[3], h0[0], h0[1], h0[2], h0[3]}, o[d0], 0, 0, 0); \
        o[d0] = __builtin_amdgcn_mfma_f32_32x32x16_bf16(pa1, (bf16x8){l1[0], l1[1], l1[2], l1[3], h1[0], h1[1], h1[2], h1[3]}, o[d0], 0, 0, 0); \
        o[d0] = __builtin_amdgcn_mfma_f32_32x32x16_bf16(pa2, (bf16x8){l2[0], l2[1], l2[2], l2[3], h2[0], h2[1], h2[2], h2[3]}, o[d0], 0, 0, 0); \
        o[d0] = __builtin_amdgcn_mfma_f32_32x32x16_bf16(pa3, (bf16x8){l3[0], l3[1], l3[2], l3[3], h3[0], h3[1], h3[2], h3[3]}, o[d0], 0, 0, 0); } while (0)
    AT_PV_D0(0); AT_PV_D0(1); AT_PV_D0(2); AT_PV_D0(3);
#undef AT_PV_D0
#undef AT_TRRD
}

template <int VAR>
__device__ __forceinline__ void attn_item(const bf16_t* Qh, const bf16_t* Kh, const bf16_t* Vh, bf16_t* OB, const float* relb, const float* LOGF, int b, int h, int qb, LAS unsigned char* lds, int tid) {
    const int wid = __builtin_amdgcn_readfirstlane(tid >> 6), lane = tid & 63, r32 = lane & 31, hi = lane >> 5;
    const int g = VAR == 0 ? h : (VAR == 1 ? 12 + h : 22 + h);
    const size_t hb = (size_t)(b * NH + g) * S * HD;
    const bf16_t* Kp = Kh + hb; const bf16_t* Vp = Vh + hb;
    LAS unsigned char* V_lds = lds + OFF_V; LAS unsigned char* K_lds = lds + OFF_K;
    LAS float* wsf = (LAS float*)(lds + OFF_WS) + wid * 64; LAS float* li_l = wsf; LAS float* al_l = wsf + 32;
    LAS float* cumL = (LAS float*)(lds + OFF_CUM); LAS float* Rt = (LAS float*)(lds + OFF_RT); volatile LAS unsigned* flags = (volatile LAS unsigned*)(lds + OFF_MISC);
    const int P0 = qb * QB, qlo = P0 + wid * 32, qpos = qlo + r32;
    int NT, jlo = 0;
    if (VAR == 0) { jlo = 4 * qb - 8; if (jlo < 0) jlo = 0; NT = 4 * qb + 4 - jlo; } else NT = 4 * qb + 4;
    const int cw = 4 * qb + (wid >> 1);
#define AT_KBASE(t) (VAR == 1 ? (4 * qb + 3 - (t)) * KVB : (jlo + (t)) * KVB)
#define AT_ACT(t) (VAR == 0 ? ((jlo + (t)) >= cw - 8 && (jlo + (t)) <= cw) : (VAR == 1 ? (AT_KBASE(t) <= qlo + 30) : (AT_KBASE(t) <= qlo + 31)))
    if (VAR == 0) {
        const float* tab = relb + h * 257;
        for (int j = tid; j < 639; j += 512) { int rel = 575 - j; rel = rel < -128 ? -128 : (rel > 128 ? 128 : rel); Rt[j] = tab[rel + 128] * LOG2E; }
    }
    if (VAR == 2) {
        const float* lf = LOGF + (size_t)(b * 10 + h) * S; const int kend = P0 + QB;
        f32x4 v = (f32x4){0.f, 0.f, 0.f, 0.f};
        if (4 * tid < kend) v = *(const f32x4*)(lf + 4 * tid);
        v[1] += v[0]; v[2] += v[1]; v[3] += v[2];
        float tot = v[3];
#pragma unroll
        for (int o = 1; o < 64; o <<= 1) { const float t_ = __shfl_up(tot, o); if (lane >= o) tot += t_; }
        if (lane == 63) li_l[0] = tot;
        __syncthreads();
        float base = tot - v[3];
        for (int w = 0; w < wid; ++w) base += ((LAS float*)(lds + OFF_WS))[w * 64];
        if (4 * tid < kend) *(LAS f32x4*)(cumL + 4 * tid) = (f32x4){(base + v[0]) * LOG2E, (base + v[1]) * LOG2E, (base + v[2]) * LOG2E, (base + v[3]) * LOG2E};
    }
    bf16x8 qr[8];
    { const bf16_t* qp = Qh + hb + (size_t)(qlo + r32) * HD + hi * 8;
#pragma unroll
      for (int d0 = 0; d0 < 8; ++d0) qr[d0] = *(const bf16x8*)(qp + d0 * 16); }
    const int sr = tid >> 4, sc = (tid & 15) * 8, vst0 = v_st(sr, sc), vst1 = v_st(32 + sr, sc), kws = AT_KSWZ(sr, sc * 2);
    const int vb0 = (int)(unsigned)(size_t)V_lds + v_rd_base(lane);
    bf16x8 st_k0, st_k1, st_v0, st_v1;
#define AT_SLOAD(k0) do { const bf16_t* kp_ = Kp + (size_t)((k0) + sr) * HD + sc; const bf16_t* vp_ = Vp + (size_t)((k0) + sr) * HD + sc; \
        st_k0 = *(const bf16x8*)kp_; st_k1 = *(const bf16x8*)(kp_ + 32 * HD); st_v0 = *(const bf16x8*)vp_; st_v1 = *(const bf16x8*)(vp_ + 32 * HD); } while (0)
#define AT_SWRITE(bf) do { *(LAS bf16x8*)(K_lds + (bf) * SHM_K + kws) = st_k0; *(LAS bf16x8*)(K_lds + (bf) * SHM_K + kws + 32 * 256) = st_k1; \
        *(LAS bf16x8*)(V_lds + (bf) * SHM_V + vst0) = st_v0; *(LAS bf16x8*)(V_lds + (bf) * SHM_V + vst1) = st_v1; } while (0)
    AT_SLOAD(AT_KBASE(0)); asm volatile("s_waitcnt vmcnt(0)" ::: "memory"); AT_SWRITE(0);
    __syncthreads();
    float m_reg = -1e30f, l_reg = 0.f, carry = 0.f;
    f32x16 o[4] = {};
#define AT_STEP(BUF, t) do { \
        const bool more_ = (t) + 1 < NT; \
        if (more_) AT_SLOAD(AT_KBASE((t) + 1)); \
        if (AT_ACT(t)) { \
            const int kb_ = AT_KBASE(t); f32x16 p0, p1; bf16x8 pa0, pa1, pa2, pa3; \
            qkt<BUF>(p0, p1, K_lds, r32, hi, qr); \
            tile_math(p0, p1, kb_, pa0, pa1, pa2, pa3); \
            pv_tile<BUF>(o, vb0, pa0, pa1, pa2, pa3); \
        } \
        if (more_) { asm volatile("s_waitcnt vmcnt(0)" ::: "memory"); AT_SWRITE((BUF) ^ 1); } \
        if (VAR == 1) { const bool done_ = __all(carry < SB_DONE); if (lane == 0) flags[((t) & 1) * 8 + wid] = done_ ? 1u : 0u; } \
        __syncthreads(); \
    } while (0)
    auto tile_math = [&](f32x16& p0, f32x16& p1, int kb, bf16x8& pa0, bf16x8& pa1, bf16x8& pa2, bf16x8& pa3) __attribute__((always_inline)) {
        const int dq = qpos - kb - 4 * hi;
        if (VAR == 1) {
            const bool need_mask = kb + 63 >= qlo;
            f32x16 n0, n1;
#pragma unroll
            for (int r = 0; r < 16; ++r) { const float z = p0[r]; const float lp = __builtin_amdgcn_logf(1.0f + __builtin_amdgcn_exp2f(-fabsf(z))); n0[r] = fminf(-z, 0.f) - lp;
                                           const float y = p1[r]; const float lq = __builtin_amdgcn_logf(1.0f + __builtin_amdgcn_exp2f(-fabsf(y))); n1[r] = fminf(-y, 0.f) - lq; }
            if (need_mask) {
#pragma unroll
                for (int r = 0; r < 16; ++r) { const int c = (r & 3) + 8 * (r >> 2);
                    if (dq - c <= 0) { n0[r] = 0.f; p0[r] = -__builtin_inff(); }
                    if (dq - c - 32 <= 0) { n1[r] = 0.f; p1[r] = -__builtin_inff(); } }
            }
            float A[8], Bp[8];
#pragma unroll
            for (int q = 0; q < 4; ++q) { A[q] = (n0[4 * q] + n0[4 * q + 1]) + (n0[4 * q + 2] + n0[4 * q + 3]); A[4 + q] = (n1[4 * q] + n1[4 * q + 1]) + (n1[4 * q + 2] + n1[4 * q + 3]); }
#pragma unroll
            for (int q = 0; q < 8; ++q) Bp[q] = partner(A[q], hi);
            float st = 0.f;
#pragma unroll
            for (int q = 7; q >= 0; --q) {
                const float after = carry + st + (hi == 0 ? Bp[q] : 0.f);
                if (q >= 4) { const int r0 = 4 * (q - 4);
                    float tl = after; p1[r0 + 3] = __builtin_amdgcn_exp2f(p1[r0 + 3] + n1[r0 + 3] + tl); tl += n1[r0 + 3]; p1[r0 + 2] = __builtin_amdgcn_exp2f(p1[r0 + 2] + n1[r0 + 2] + tl); tl += n1[r0 + 2];
                    p1[r0 + 1] = __builtin_amdgcn_exp2f(p1[r0 + 1] + n1[r0 + 1] + tl); tl += n1[r0 + 1]; p1[r0] = __builtin_amdgcn_exp2f(p1[r0] + n1[r0] + tl); }
                else { const int r0 = 4 * q;
                    float tl = after; p0[r0 + 3] = __builtin_amdgcn_exp2f(p0[r0 + 3] + n0[r0 + 3] + tl); tl += n0[r0 + 3]; p0[r0 + 2] = __builtin_amdgcn_exp2f(p0[r0 + 2] + n0[r0 + 2] + tl); tl += n0[r0 + 2];
                    p0[r0 + 1] = __builtin_amdgcn_exp2f(p0[r0 + 1] + n0[r0 + 1] + tl); tl += n0[r0 + 1]; p0[r0] = __builtin_amdgcn_exp2f(p0[r0] + n0[r0] + tl); }
                st += A[q] + Bp[q];
            }
            carry += st;
            pack_p(p0, p1, pa0, pa1, pa2, pa3);
        } else {
            if (VAR == 0) {
                const LAS float* rp = Rt + (575 - (qpos - kb) + 4 * hi);
#pragma unroll
                for (int r = 0; r < 16; ++r) { const int c = (r & 3) + 8 * (r >> 2); p0[r] += rp[c]; p1[r] += rp[c + 32]; }
            } else {
                const LAS float* cp = cumL + kb + 4 * hi;
#pragma unroll
                for (int q = 0; q < 4; ++q) { const f32x4 c0 = *(const LAS f32x4*)(cp + 8 * q), c1 = *(const LAS f32x4*)(cp + 32 + 8 * q);
                    p0[4 * q] -= c0[0]; p0[4 * q + 1] -= c0[1]; p0[4 * q + 2] -= c0[2]; p0[4 * q + 3] -= c0[3];
                    p1[4 * q] -= c1[0]; p1[4 * q + 1] -= c1[1]; p1[4 * q + 2] -= c1[2]; p1[4 * q + 3] -= c1[3]; }
                if (kb + 63 > qlo) {
#pragma unroll
                    for (int r = 0; r < 16; ++r) { const int c = (r & 3) + 8 * (r >> 2);
                        if (dq - c < 0) p0[r] = -__builtin_inff();
                        if (dq - c - 32 < 0) p1[r] = -__builtin_inff(); }
                }
            }
            float pmax = p0[0];
#pragma unroll
            for (int r = 1; r < 16; ++r) pmax = fmaxf(pmax, p0[r]);
#pragma unroll
            for (int r = 0; r < 16; ++r) pmax = fmaxf(pmax, p1[r]);
            pmax = xchg_max(pmax, hi);
            float mn, alpha;
            if (__all(pmax - m_reg <= THR2)) { mn = m_reg; alpha = 1.f; }
            else { mn = fmaxf(m_reg, pmax); alpha = __builtin_amdgcn_exp2f(m_reg - mn); m_reg = mn; }
            float ps = 0.f;
#pragma unroll
            for (int r = 0; r < 16; ++r) { p0[r] = __builtin_amdgcn_exp2f(p0[r] - mn); p1[r] = __builtin_amdgcn_exp2f(p1[r] - mn); ps += p0[r] + p1[r]; }
            ps = xchg_sum(ps, hi);
            l_reg = l_reg * alpha + ps;
            if (__any(alpha < 1.f)) {
                if (hi == 0) al_l[r32] = alpha;
                asm volatile("s_waitcnt lgkmcnt(0)" ::: "memory");
                float av[16];
#pragma unroll
                for (int r = 0; r < 16; ++r) av[r] = al_l[crow(r, hi)];
#pragma unroll
                for (int d = 0; d < 4; ++d)
#pragma unroll
                    for (int r = 0; r < 16; ++r) o[d][r] *= av[r];
            }
            pack_p(p0, p1, pa0, pa1, pa2, pa3);
        }
    };
    for (int t = 0; t < NT; t += 2) {
        AT_STEP(0, t);
        if (VAR == 1) { unsigned all_ = 1u; for (int w = 0; w < 8; ++w) all_ &= flags[(t & 1) * 8 + w]; if (all_) break; }
        if (t + 1 >= NT) break;
        AT_STEP(1, t + 1);
        if (VAR == 1) { unsigned all_ = 1u; for (int w = 0; w < 8; ++w) all_ &= flags[((t + 1) & 1) * 8 + w]; if (all_) break; }
    }
    float rli[16];
    if (VAR != 1) {
        if (hi == 0) li_l[r32] = l_reg;
        asm volatile("s_waitcnt lgkmcnt(0)" ::: "memory");
#pragma unroll
        for (int r = 0; r < 16; ++r) rli[r] = __builtin_amdgcn_rcpf(li_l[crow(r, hi)]);
    }
    unsigned char* Ow8 = (unsigned char*)OB + (size_t)(b * S + qlo) * D + g * HD;
#pragma unroll
    for (int r = 0; r < 16; ++r) { const int orow = crow(r, hi);
#pragma unroll
        for (int d0 = 0; d0 < 4; ++d0) { const float v = VAR != 1 ? o[d0][r] * rli[r] : o[d0][r];
            const float vn = __shfl_xor(v, 1);
            if ((r32 & 1) == 0) *(unsigned short*)(Ow8 + (size_t)orow * D + d0 * 32 + r32) = (unsigned short)__builtin_amdgcn_cvt_pk_fp8_f32(clamp8(v * 16.0f), clamp8(vn * 16.0f), 0, false); } }
    __syncthreads();
#undef AT_STEP
#undef AT_SLOAD
#undef AT_SWRITE
#undef AT_KBASE
#undef AT_ACT
}

template <int VAR>
__device__ __forceinline__ void attn_queue(const bf16_t* Qh, const bf16_t* Kh, const bf16_t* Vh, bf16_t* OB, const float* relb, const float* LOGF, unsigned* qhead, LAS unsigned char* lds, int wave0) {
    FRESH_TID(); FRESH_LDS(lds);
    volatile LAS unsigned* qslot = (volatile LAS unsigned*)(lds + OFF_MISC) + 32;
    constexpr int NHV = VAR == 0 ? 12 : 10, NITEMS = 8 * NHV * 8;
    for (;;) {
        if (tid == 0) qslot[0] = __hip_atomic_fetch_add(qhead, 1u, __ATOMIC_RELAXED, __HIP_MEMORY_SCOPE_AGENT);
        __syncthreads();
        const int idx = (int)qslot[0];
        __syncthreads();
        if (idx >= NITEMS) break;
        const int qb = 7 - idx / (8 * NHV), bh = idx % (8 * NHV);
        attn_item<VAR>(Qh, Kh, Vh, OB, relb, LOGF, bh / NHV, bh % NHV, qb, lds, tid);
    }
}
__device__ __forceinline__ void attn_phase(const bf16_t* Qh, const bf16_t* Kh, const bf16_t* Vh, bf16_t* OB, const float* relb, const float* LOGF, unsigned* qheads, LAS unsigned char* lds, int wave0) {
    attn_queue<2>(Qh, Kh, Vh, OB, relb, LOGF, qheads + 0, lds, wave0);
    attn_queue<0>(Qh, Kh, Vh, OB, relb, LOGF, qheads + 64, lds, wave0);
    attn_queue<1>(Qh, Kh, Vh, OB, relb, LOGF, qheads + 128, lds, wave0);
}
}
namespace mk {
#define XB_TMO      128
#define XB_XCNT(j)  (256  + 64 * (j))
#define XB_XSUB(j)  (1280 + 64 * (j))
#define XB_XGEN(j)  (2304 + 64 * (j))
#define XB_TOP      3328
#define XB_TOPGEN   3392
#define XCD_BAR_WORDS 3456
#define XB_SPIN_CAP (1u << 22)

__device__ __forceinline__ unsigned xb_ld(unsigned* p)              { return __hip_atomic_load(p, __ATOMIC_RELAXED, __HIP_MEMORY_SCOPE_AGENT); }
__device__ __forceinline__ unsigned xb_add(unsigned* p, unsigned v) { return __hip_atomic_fetch_add(p, v, __ATOMIC_RELAXED, __HIP_MEMORY_SCOPE_AGENT); }
__device__ __forceinline__ unsigned xb_xcc_id() { return (unsigned)__builtin_amdgcn_s_getreg((3 << 11) | 20) & 0xFu; }
#define XB_SPIN(cond, bar) do { unsigned _sp = 0; while (cond) { __builtin_amdgcn_s_sleep(1); \
    if ((++_sp & 255u) == 0u) { if (xb_ld(&(bar)[XB_TMO])) break; if (_sp > XB_SPIN_CAP) { atomicAdd(&(bar)[XB_TMO], 1u); break; } } } } while (0)

struct XcdBarrier {
    unsigned* bar; unsigned x;
    volatile LAS unsigned* st;
};

__device__ __forceinline__ XcdBarrier xcd_barrier_post(unsigned* bar, volatile LAS unsigned* st, bool is_t0) {
    XcdBarrier b; b.bar = bar; b.x = xb_xcc_id(); b.st = st;
    if (is_t0) (void)xb_add(&bar[XB_XCNT(b.x)], 1u);
    return b;
}
__device__ __forceinline__ void xcd_barrier_complete(unsigned* bar, unsigned x, unsigned& nloc, unsigned& nx) {
    const unsigned G = gridDim.x * gridDim.y * gridDim.z;
    unsigned sum, cnt, mine, sp = 0u;
    for (;;) {
        sum = 0u; cnt = 0u; mine = 0u;
#pragma unroll
        for (unsigned j = 0; j < 16; ++j) { const unsigned c = xb_ld(&bar[XB_XCNT(j)]); sum += c; cnt += (c > 0u) ? 1u : 0u; mine = (j == x) ? c : mine; }
        if (sum == G) break;
        __builtin_amdgcn_s_sleep(1);
        if ((++sp & 255u) == 0u) { if (xb_ld(&bar[XB_TMO])) break; if (sp > XB_SPIN_CAP) { atomicAdd(&bar[XB_TMO], 1u); break; } }
    }
    nloc = mine > 0u ? mine : 1u; nx = cnt > 0u ? cnt : 1u;
}

__device__ __forceinline__ void xcd_barrier(const XcdBarrier& b, bool is_t0) {
    asm volatile("s_waitcnt vmcnt(0)" ::: "memory");
    __syncthreads();
    if (is_t0) {
        unsigned* bar = b.bar;
        __builtin_amdgcn_s_waitcnt(0);
        unsigned nloc = b.st[0], nx = b.st[1];
        if (nloc == 0u) { xcd_barrier_complete(bar, b.x, nloc, nx); b.st[0] = nloc; b.st[1] = nx; }
        const unsigned old = xb_add(&bar[XB_XSUB(b.x)], 1u);
        const unsigned gen = old / nloc;
        if (old + 1u == (gen + 1u) * nloc) {
            __builtin_amdgcn_fence(__ATOMIC_RELEASE, "agent");
            asm volatile("s_waitcnt vmcnt(0)" ::: "memory");
            const unsigned og = xb_add(&bar[XB_TOP], 1u);
            const unsigned tg = og / nx;
            if (og + 1u == (tg + 1u) * nx) xb_add(&bar[XB_TOPGEN], 1u);
            else XB_SPIN(xb_ld(&bar[XB_TOPGEN]) == tg, bar);
            __builtin_amdgcn_fence(__ATOMIC_ACQUIRE, "agent");
            xb_add(&bar[XB_XGEN(b.x)], 1u);
            asm volatile("s_waitcnt vmcnt(0)" ::: "memory");
        } else {
            XB_SPIN(xb_ld(&bar[XB_XGEN(b.x)]) == gen, bar);
            __builtin_amdgcn_fence(__ATOMIC_ACQUIRE, "agent");
            asm volatile("s_waitcnt vmcnt(0)" ::: "memory");
        }
    }
    __syncthreads();
}

constexpr int PH_PER_LAYER = 8;
typedef const __attribute__((address_space(4))) Args* KArgs;
#define KARGS() ({ KArgs p_ = (KArgs)__builtin_amdgcn_kernarg_segment_ptr(); asm volatile("" : "+s"(p_)); p_; })
#define GRID_BAR() do { KArgs k_ = KARGS(); XcdBarrier b_; b_.bar = (unsigned*)(k_->ws + WS_CTL) + CW_BAR; b_.x = xb_xcc_id(); b_.st = (volatile LAS unsigned*)(lds + MISC_OFF) + 8; const bool t0_ = (wave0 == 0) && (__builtin_amdgcn_mbcnt_hi(~0u, __builtin_amdgcn_mbcnt_lo(~0u, 0u)) == 0u); xcd_barrier(b_, t0_); } while (0)
__global__ void __launch_bounds__(NWAVES * 64, 2) mk_fwd(Args a_unused) {
    extern __shared__ __attribute__((aligned(16))) unsigned char lds_raw[];
    LAS unsigned char* lds = (LAS unsigned char*)lds_raw;
    const int wave0 = __builtin_amdgcn_readfirstlane((int)threadIdx.x >> 6);
    for (int u = threadIdx.x; u < (LDS_BYTES - LDSCTL_OFF) / 4; u += NWAVES * 64) ((LAS unsigned*)(lds + LDSCTL_OFF))[u] = 0u;
    __syncthreads();
    int lo, hi;
    { KArgs k = KARGS(); lo = k->ph_lo; hi = k->ph_hi;
      if (hi - lo > 1) (void)xcd_barrier_post((unsigned*)(k->ws + WS_CTL) + CW_BAR, (volatile LAS unsigned*)(lds + MISC_OFF) + 8, threadIdx.x == 0); }
#define IN(k) (lo <= (k) && (k) < hi)
#define BOTH(k) (IN(k) && IN((k) + 1))
#pragma unroll
    for (int l = 0; l < 2; ++l) {
        const int pb = PH_PER_LAYER * l;
        if (IN(pb + 0)) { KArgs k = KARGS(); conv_phase(k, l, lds, wave0); }
        if (IN(pb + 1)) {
            KArgs k = KARGS(); unsigned char* ws = k->ws;
            const float* xin = l == 0 ? k->in[0] : (const float*)(ws + WS_X2);
            prep_phase<true>(xin, (bf16_t*)(ws + WS_XB), (float*)(ws + WS_RSTD), k->in[2] + (size_t)l * D * PW, k->in[1] + (size_t)l * D, k->in[3] + l * 10, (float*)(ws + WS_LOGF), lds, wave0);
            if (BOTH(pb + 1)) GRID_BAR();
        }
        if (IN(pb + 2)) {
            KArgs k = KARGS(); unsigned char* ws = k->ws;
            pg8::Gemm g{(const bf16_t*)(ws + WS_XB), (const bf16_t*)(ws + WS_WIN), M, 12288, D}; pg8::StaticOrder So; FRESH_BID(); So.init(M, 12288, G, bid);
            pg8::EpiQKV4 E{(bf16_t*)(ws + WS_Q), (const float*)(ws + WS_RSTD), 0.08838834764831845f * 1.4426950408889634f, US_INV};
            { LAS unsigned char* lds_ = lds; FRESH_LDS(lds_); FRESH_TID(); pg8::gemm_phase<pg8::EpiQKV4, pg8::StaticOrder, true, true, true>(lds_, g, So, E, tid); }
            if (BOTH(pb + 2)) GRID_BAR();
        }
        if (IN(pb + 3)) {
            KArgs k = KARGS(); unsigned char* ws = k->ws;
            at::attn_phase((const bf16_t*)(ws + WS_Q), (const bf16_t*)(ws + WS_K), (const bf16_t*)(ws + WS_V), (bf16_t*)(ws + WS_OB), k->in[4] + (size_t)l * 12 * 257, (const float*)(ws + WS_LOGF),
                           (unsigned*)(ws + WS_CTL) + CW_QUEUE + 256 * l, lds, wave0);
            if (BOTH(pb + 3)) GRID_BAR();
        }
        if (IN(pb + 4)) {
            KArgs k = KARGS(); unsigned char* ws = k->ws;
            const float* xin = l == 0 ? k->in[0] : (const float*)(ws + WS_X2);
            pg8::Gemm g{(const bf16_t*)(ws + WS_OB), (const bf16_t*)(ws + WS_WOUT), M, D, D}; pg8::StaticOrder So; FRESH_BID(); So.init(M, D, G, bid);
            pg8::EpiResidF32 E{xin, k->out, US_INV * (1.0f / 16.0f)};
            { LAS unsigned char* lds_ = lds; FRESH_LDS(lds_); FRESH_TID(); pg8::gemm_phase<pg8::EpiResidF32, pg8::StaticOrder, true, true, true>(lds_, g, So, E, tid); }
            if (BOTH(pb + 4)) GRID_BAR();
        }
        if (IN(pb + 5)) {
            KArgs k = KARGS(); unsigned char* ws = k->ws;
            prep_phase<false>(k->out, (bf16_t*)(ws + WS_XB), (float*)(ws + WS_RSTD), nullptr, nullptr, nullptr, nullptr, lds, wave0);
            if (BOTH(pb + 5)) GRID_BAR();
        }
        if (IN(pb + 6)) {
            KArgs k = KARGS(); unsigned char* ws = k->ws;
            pg8::Gemm g{(const bf16_t*)(ws + WS_XB), (const bf16_t*)(ws + WS_WQK), M, 2048, D}; pg8::StaticOrder So; FRESH_BID(); So.init(M, 2048, G, bid);
            pg8::EpiRowScaleF32<2048> E{(float*)(ws + WS_SC), (const float*)(ws + WS_RSTD)};
            { LAS unsigned char* lds_ = lds; FRESH_LDS(lds_); FRESH_TID(); pg8::gemm_phase<pg8::EpiRowScaleF32<2048>, pg8::StaticOrder, true, true>(lds_, g, So, E, tid); }
            if (BOTH(pb + 6)) GRID_BAR();
        }
        if (IN(pb + 7)) {
            KArgs k = KARGS(); unsigned char* ws = k->ws;
            if (l == 0) peer_phase8<false>((const float*)(ws + WS_SC), (const float*)(ws + WS_RSTD), (const unsigned char*)(ws + WS_U16), (const unsigned char*)(ws + WS_U16) + (size_t)NE * D, k->out, (float*)(ws + WS_X2), nullptr, lds, wave0);
            else peer_phase8<true>((const float*)(ws + WS_SC), (const float*)(ws + WS_RSTD), (const unsigned char*)(ws + WS_U16), (const unsigned char*)(ws + WS_U16) + (size_t)NE * D, k->out, k->out, k->in[12], lds, wave0);
            if (BOTH(pb + 7)) GRID_BAR();
        }
    }
#undef IN
#undef BOTH
}

static int g_grid = 0;
static void launch_phases(Args a, int lo, int hi, hipStream_t st) {
    a.ph_lo = lo; a.ph_hi = hi;
    hipLaunchKernelGGL(mk_fwd, dim3(g_grid), dim3(NWAVES * 64), LDS_BYTES, st, a);
}
}

extern "C" void kernel_launch(void* const* d_in, const int* in_sizes, int n_in, void* d_out, int out_size, void* d_ws, size_t ws_size, hipStream_t stream) {
    (void)in_sizes; (void)n_in; (void)out_size;
    using namespace mk;
    if (g_grid == 0) {
        if (ws_size < 2048 * MiB) { fprintf(stderr, "kernel_launch: workspace too small (%zu)\n", ws_size); g_grid = -1; return; }
        if (hipFuncSetAttribute((const void*)mk_fwd, hipFuncAttributeMaxDynamicSharedMemorySize, LDS_BYTES) != hipSuccess) { fprintf(stderr, "kernel_launch: hipFuncSetAttribute failed\n"); g_grid = -1; return; }
        int dev = 0, cus = 0; (void)hipGetDevice(&dev); (void)hipDeviceGetAttribute(&cus, hipDeviceAttributeMultiprocessorCount, dev);
        g_grid = cus > 0 ? cus : 256;
    }
    if (g_grid < 0) return;
    unsigned char* ws = (unsigned char*)d_ws; float* out = (float*)d_out;
    (void)hipMemsetAsync(ws + WS_CTL, 0, CTL_ZERO_BYTES, stream);
    Args a{};
    for (int i = 0; i < 13; ++i) a.in[i] = (const float*)d_in[i];
    a.out = out; a.ws = ws;
    launch_phases(a, 0, 2 * PH_PER_LAYER, stream);
}
```

```cpp
#include <hip/hip_runtime.h>
#include <cstdio>
#include <cstdint>
#define NOBIAS_DBG 0
namespace nv {
constexpr int M = 16384, D = 4096, S = 2048, NB = 8, PW = 12298, NH = 32;

__device__ __forceinline__ float wave_sum(float v) {
#pragma unroll
    for (int o = 1; o < 64; o <<= 1) v += __shfl_xor(v, o);
    return v;
}
__device__ __forceinline__ float wave_max(float v) {
#pragma unroll
    for (int o = 1; o < 64; o <<= 1) v = fmaxf(v, __shfl_xor(v, o));
    return v;
}
__device__ __forceinline__ int wave_min_i(int v) {
#pragma unroll
    for (int o = 1; o < 64; o <<= 1) { int t = __shfl_xor(v, o); v = t < v ? t : v; }
    return v;
}
__device__ __forceinline__ float logsig(float z) {
    return z >= 0.f ? -log1pf(expf(-z)) : z - log1pf(expf(z));
}

__global__ __launch_bounds__(256) void k_rmsnorm(const float* x, const float* g, float* y) {
    __shared__ float red[4];
    const int r = blockIdx.x, t = threadIdx.x;
    const float4* xr = (const float4*)(x + (size_t)r * D);
    float4 v[4]; float ss = 0.f;
#pragma unroll
    for (int i = 0; i < 4; ++i) { v[i] = xr[t + 256 * i]; ss += v[i].x * v[i].x + v[i].y * v[i].y + v[i].z * v[i].z + v[i].w * v[i].w; }
    ss = wave_sum(ss);
    if ((t & 63) == 0) red[t >> 6] = ss;
    __syncthreads();
    const float tot = red[0] + red[1] + red[2] + red[3];
    const float rstd = rsqrtf(tot * (1.0f / D) + 1e-6f);
    float4* yr = (float4*)(y + (size_t)r * D);
    const float4* gr = (const float4*)g;
#pragma unroll
    for (int i = 0; i < 4; ++i) { const float4 gg = gr[t + 256 * i]; float4 o; o.x = v[i].x * rstd * gg.x; o.y = v[i].y * rstd * gg.y; o.z = v[i].z * rstd * gg.z; o.w = v[i].w * rstd * gg.w; yr[t + 256 * i] = o; }
}

template <int MODE>
__global__ __launch_bounds__(256) void k_gemm(const float* A, const float* B, float* C, const float* R, int Mm, int N, int K, int lda, int ldb, int ldc) {
    __shared__ float As[16][68];
    __shared__ float Bs[16][68];
    const int tid = threadIdx.x, tx = tid & 15, ty = tid >> 4;
    const int m0 = blockIdx.y * 64, n0 = blockIdx.x * 64;
    float acc[4][4];
#pragma unroll
    for (int i = 0; i < 4; ++i)
#pragma unroll
        for (int j = 0; j < 4; ++j) acc[i][j] = 0.f;
    for (int k0 = 0; k0 < K; k0 += 16) {
        {
            const int mr = tid >> 2, kc = (tid & 3) * 4;
            const float4 a = *(const float4*)(A + (size_t)(m0 + mr) * lda + k0 + kc);
            As[kc + 0][mr] = a.x; As[kc + 1][mr] = a.y; As[kc + 2][mr] = a.z; As[kc + 3][mr] = a.w;
        }
        {
            const int kr = tid >> 4, nc = (tid & 15) * 4;
#pragma unroll
            for (int j = 0; j < 4; ++j) { const int n = n0 + nc + j; Bs[kr][nc + j] = (n < N) ? B[(size_t)(k0 + kr) * ldb + n] : 0.f; }
        }
        __syncthreads();
#pragma unroll
        for (int k = 0; k < 16; ++k) {
            const float4 a = *(const float4*)&As[k][ty * 4];
            const float4 b = *(const float4*)&Bs[k][tx * 4];
            const float av[4] = {a.x, a.y, a.z, a.w}, bv[4] = {b.x, b.y, b.z, b.w};
#pragma unroll
            for (int i = 0; i < 4; ++i)
#pragma unroll
                for (int j = 0; j < 4; ++j) acc[i][j] = fmaf(av[i], bv[j], acc[i][j]);
        }
        __syncthreads();
    }
#pragma unroll
    for (int i = 0; i < 4; ++i)
#pragma unroll
        for (int j = 0; j < 4; ++j) {
            const int m = m0 + ty * 4 + i, n = n0 + tx * 4 + j;
            if (n < N) { const size_t o = (size_t)m * ldc + n; C[o] = (MODE ? R[o] : 0.f) + acc[i][j]; }
        }
}

__global__ __launch_bounds__(64) void k_cum(const float* proj, const float* bf, float* cum) {
    const int b = blockIdx.x / 10, j = blockIdx.x % 10, lane = threadIdx.x;
    float carry = 0.f;
    for (int ch = 0; ch < S / 64; ++ch) {
        const int s = ch * 64 + lane;
        float v = logsig(proj[(size_t)(b * S + s) * PW + 12288 + j] + bf[j]);
#pragma unroll
        for (int o = 1; o < 64; o <<= 1) { const float t = __shfl_up(v, o); if (lane >= o) v += t; }
        v += carry;
        cum[(size_t)(b * 10 + j) * S + s] = v;
        carry = __shfl(v, 63);
    }
}

__global__ __launch_bounds__(256) void k_attn(const float* proj, const float* relb  , const float* cum  , float* o) {
    __shared__ float sl[4][2048];
    __shared__ float sq[4][128];
    const int w = threadIdx.x >> 6, lane = threadIdx.x & 63;
    const int rowid = blockIdx.x * 4 + w;
    const int t = rowid % S, g = (rowid / S) % NH, b = rowid / (S * NH);
    const float* qrow = proj + (size_t)(b * S + t) * PW + g * 128;
    sq[w][lane] = qrow[lane]; sq[w][lane + 64] = qrow[lane + 64];
    __syncthreads();
    int klo, khi;
    if (g < 12) { const int c = t / 64; klo = (c - 8) * 64; if (klo < 0) klo = 0; khi = (c + 1) * 64; }
    else if (g < 22) { klo = 0; khi = t; }
    else { klo = 0; khi = t + 1; }
    const float scale = 0.08838834764831845f;
    const float* kbase = proj + (size_t)(b * S) * PW + 4096 + g * 128;
    const float* vbase = proj + (size_t)(b * S) * PW + 8192 + g * 128;
    for (int s = klo + lane; s < khi; s += 64) {
        const float* kr = kbase + (size_t)s * PW;
        float acc = 0.f;
#pragma unroll 8
        for (int d = 0; d < 128; d += 2) { const float2 kv = *(const float2*)(kr + d); acc = fmaf(sq[w][d], kv.x, acc); acc = fmaf(sq[w][d + 1], kv.y, acc); }
        sl[w][s - klo] = acc * scale;
    }
    __syncthreads();
    const int nk = khi - klo;
    if (g < 12) {
        const float* rb = relb + g * 257;
        float mx = -3.0e38f;
        for (int i = lane; i < nk; i += 64) { int rel = t - (klo + i); rel = rel < -128 ? -128 : (rel > 128 ? 128 : rel); const float l = sl[w][i] + rb[rel + 128]; sl[w][i] = l; mx = fmaxf(mx, l); }
        mx = wave_max(mx);
        float sm = 0.f;
        for (int i = lane; i < nk; i += 64) { const float p = expf(sl[w][i] - mx); sl[w][i] = p; sm += p; }
        sm = wave_sum(sm);
        const float inv = 1.0f / sm;
        for (int i = lane; i < nk; i += 64) sl[w][i] *= inv;
    } else if (g < 22) {
        if (lane == 0) { float tail = 0.f; for (int s = t - 1; s >= 0; --s) { const float z = sl[w][s]; const float ls = logsig(z); sl[w][s] = expf(ls + tail); tail += ls - z; } }
    } else {
        const float* cm = cum + (size_t)(b * 10 + (g - 22)) * S;
        const float ct = cm[t];
        float mx = -3.0e38f;
        for (int i = lane; i < nk; i += 64) { const float l = sl[w][i] + ct - cm[i]; sl[w][i] = l; mx = fmaxf(mx, l); }
        mx = wave_max(mx);
        float sm = 0.f;
        for (int i = lane; i < nk; i += 64) { const float p = expf(sl[w][i] - mx); sl[w][i] = p; sm += p; }
        sm = wave_sum(sm);
        const float inv = 1.0f / sm;
        for (int i = lane; i < nk; i += 64) sl[w][i] *= inv;
    }
    __syncthreads();
    float a0 = 0.f, a1 = 0.f;
    for (int i = 0; i < nk; ++i) { const float p = sl[w][i]; const float* vr = vbase + (size_t)(klo + i) * PW; a0 = fmaf(p, vr[lane], a0); a1 = fmaf(p, vr[lane + 64], a1); }
    float* orow = o + (size_t)(b * S + t) * D + g * 128;
    orow[lane] = a0; orow[lane + 64] = a1;
}

template <bool FROM_SC>
__global__ __launch_bounds__(256) void k_route(const float* qp, const float* k1, const float* k2, int* eid, float* gw) {
    __shared__ float sq[4][256];
    const int w = threadIdx.x >> 6, lane = threadIdx.x & 63;
    const int id = blockIdx.x * 4 + w, tok = id >> 3, h = id & 7;
    const float* q = qp + (size_t)tok * 2048 + h * 256;
#pragma unroll
    for (int i = 0; i < 4; ++i) sq[w][lane + 64 * i] = q[lane + 64 * i];
    __syncthreads();
    float a[2], c[2];
    if (FROM_SC) { a[0] = sq[w][lane]; a[1] = sq[w][lane + 64]; c[0] = sq[w][128 + lane]; c[1] = sq[w][192 + lane]; }
    else
#pragma unroll
    for (int u = 0; u < 2; ++u) {
        const float* r1 = k1 + ((size_t)h * 128 + lane + 64 * u) * 128;
        const float* r2 = k2 + ((size_t)h * 128 + lane + 64 * u) * 128;
        float s1 = 0.f, s2 = 0.f;
        for (int d = 0; d < 128; d += 4) { const float4 x1 = *(const float4*)(r1 + d), x2 = *(const float4*)(r2 + d);
            s1 = fmaf(sq[w][d], x1.x, s1); s1 = fmaf(sq[w][d + 1], x1.y, s1); s1 = fmaf(sq[w][d + 2], x1.z, s1); s1 = fmaf(sq[w][d + 3], x1.w, s1);
            s2 = fmaf(sq[w][128 + d], x2.x, s2); s2 = fmaf(sq[w][128 + d + 1], x2.y, s2); s2 = fmaf(sq[w][128 + d + 2], x2.z, s2); s2 = fmaf(sq[w][128 + d + 3], x2.w, s2); }
        a[u] = s1; c[u] = s2;
    }
    const float NEG = -3.0e38f;
    float v1 = 0.f, v2 = 0.f; int i1 = 0, i2 = 0;
    for (int it = 0; it < 16; ++it) {
        { const float m = wave_max(fmaxf(a[0], a[1]));
          int cand = 1 << 30; if (a[0] == m) cand = lane; else if (a[1] == m) cand = lane + 64;
          const int n = wave_min_i(cand);
          if (n == lane) a[0] = NEG; if (n == lane + 64) a[1] = NEG;
          if (lane == it) { v1 = m; i1 = n; } }
        { const float m = wave_max(fmaxf(c[0], c[1]));
          int cand = 1 << 30; if (c[0] == m) cand = lane; else if (c[1] == m) cand = lane + 64;
          const int n = wave_min_i(cand);
          if (n == lane) c[0] = NEG; if (n == lane + 64) c[1] = NEG;
          if (lane == it) { v2 = m; i2 = n; } }
    }
    float cd[4];
    { const float va = __shfl(v1, lane >> 2);
#pragma unroll
      for (int k = 0; k < 4; ++k) cd[k] = va + __shfl(v2, (lane & 3) * 4 + k); }
    float best = 0.f; int be = 0;
    for (int it = 0; it < 16; ++it) {
        const float m = wave_max(fmaxf(fmaxf(cd[0], cd[1]), fmaxf(cd[2], cd[3])));
        int cand = 1 << 30;
        if (cd[0] == m) cand = lane * 4; else if (cd[1] == m) cand = lane * 4 + 1; else if (cd[2] == m) cand = lane * 4 + 2; else if (cd[3] == m) cand = lane * 4 + 3;
        const int pos = wave_min_i(cand);
        if (pos == lane * 4) cd[0] = NEG; if (pos == lane * 4 + 1) cd[1] = NEG; if (pos == lane * 4 + 2) cd[2] = NEG; if (pos == lane * 4 + 3) cd[3] = NEG;
        const int e = ((__shfl(i1, (pos >> 4) & 15) & 127) << 7) | (__shfl(i2, pos & 15) & 127);
        if (lane == it) { best = m; be = e; }
    }
    const float mx = __shfl(best, 0);
    float p = lane < 16 ? expf(best - mx) : 0.f;
    const float sm = wave_sum(p);
    if (lane < 16) { eid[(size_t)tok * 128 + h * 16 + lane] = be; gw[(size_t)tok * 128 + h * 16 + lane] = p / sm; }
}

template <bool WONLY>
__global__ __launch_bounds__(256) void k_expert(const float* h2, const float* u, const float* v, const int* eid, float* gw, float* x) {
    __shared__ float sw[4][128];
    const int w = threadIdx.x >> 6, lane = threadIdx.x & 63;
    const int tok = blockIdx.x * 4 + w;
    const float4* hr = (const float4*)(h2 + (size_t)tok * D);
    float4 hv[16];
#pragma unroll
    for (int i = 0; i < 16; ++i) hv[i] = hr[64 * i + lane];
    for (int j = 0; j < 128; ++j) {
        const int e = eid[(size_t)tok * 128 + j];
        const float4* ur = (const float4*)(u + (size_t)e * D);
        float dsum = 0.f;
#pragma unroll
        for (int i = 0; i < 16; ++i) { const float4 uu = ur[64 * i + lane]; dsum += hv[i].x * uu.x + hv[i].y * uu.y + hv[i].z * uu.z + hv[i].w * uu.w; }
        dsum = wave_sum(dsum);
        const float ge = 0.5f * dsum * (1.0f + erff(dsum * 0.70710678118654752f));
        if (lane == 0) sw[w][j] = gw[(size_t)tok * 128 + j] * ge;
    }
    __syncthreads();
    if (WONLY) { gw[(size_t)tok * 128 + lane] = sw[w][lane]; gw[(size_t)tok * 128 + lane + 64] = sw[w][lane + 64]; return; }
    float4 acc[16];
#pragma unroll
    for (int i = 0; i < 16; ++i) acc[i] = make_float4(0.f, 0.f, 0.f, 0.f);
    for (int j = 0; j < 128; ++j) {
        const int e = eid[(size_t)tok * 128 + j];
        const float wj = sw[w][j];
        const float4* vr = (const float4*)(v + (size_t)e * D);
#pragma unroll
        for (int i = 0; i < 16; ++i) { const float4 vv = vr[64 * i + lane]; acc[i].x = fmaf(wj, vv.x, acc[i].x); acc[i].y = fmaf(wj, vv.y, acc[i].y); acc[i].z = fmaf(wj, vv.z, acc[i].z); acc[i].w = fmaf(wj, vv.w, acc[i].w); }
    }
    float4* xr = (float4*)(x + (size_t)tok * D);
#pragma unroll
    for (int i = 0; i < 16; ++i) { float4 xx = xr[64 * i + lane]; xx.x += acc[i].x; xx.y += acc[i].y; xx.z += acc[i].z; xx.w += acc[i].w; xr[64 * i + lane] = xx; }
}


__device__ __forceinline__ float bf2f(unsigned short h) { return __builtin_bit_cast(float, (unsigned)h << 16); }
__device__ __forceinline__ unsigned short f2bf_n(float f) { unsigned u = __builtin_bit_cast(unsigned, f); return (unsigned short)((u + 0x7fffu + ((u >> 16) & 1u)) >> 16); }
__global__ __launch_bounds__(64) void k_cum_h(const float* logf, float* cum) {
    const int lane = threadIdx.x; float carry = 0.f;
    for (int ch = 0; ch < S / 64; ++ch) {
        const int s = ch * 64 + lane;
        float v = logf[(size_t)blockIdx.x * S + s];
#pragma unroll
        for (int o = 1; o < 64; o <<= 1) { const float t = __shfl_up(v, o); if (lane >= o) v += t; }
        v += carry;
        cum[(size_t)blockIdx.x * S + s] = v;
        carry = __shfl(v, 63);
    }
}
__global__ __launch_bounds__(256) void k_attn_h(const unsigned short* Qh, const unsigned short* Kh, const unsigned short* Vh, const float* relb, const float* cum, unsigned short* ob) {
    __shared__ float sl[4][2048];
    __shared__ float sq[4][128];
    const int w = threadIdx.x >> 6, lane = threadIdx.x & 63;
    const int rowid = blockIdx.x * 4 + w;
    const int t = rowid % S, g = (rowid / S) % NH, b = rowid / (S * NH);
    const size_t hb = (size_t)(b * NH + g) * S * 128;
    const unsigned short* qrow = Qh + hb + (size_t)t * 128;
    sq[w][lane] = bf2f(qrow[lane]); sq[w][lane + 64] = bf2f(qrow[lane + 64]);
    __syncthreads();
    int klo, khi;
    if (g < 12) { const int c = t / 64; klo = (c - 8) * 64; if (klo < 0) klo = 0; khi = (c + 1) * 64; }
    else if (g < 22) { klo = 0; khi = t; }
    else { klo = 0; khi = t + 1; }
    const float scale = 0.6931471805599453f;
    for (int s = klo + lane; s < khi; s += 64) {
        const unsigned* kr = (const unsigned*)(Kh + hb + (size_t)s * 128);
        float acc = 0.f;
#pragma unroll 8
        for (int d = 0; d < 64; ++d) { const unsigned kv = kr[d]; acc = fmaf(sq[w][2 * d], __builtin_bit_cast(float, kv << 16), acc); acc = fmaf(sq[w][2 * d + 1], __builtin_bit_cast(float, kv & 0xffff0000u), acc); }
        sl[w][s - klo] = acc * scale;
    }
    __syncthreads();
    const int nk = khi - klo;
    if (g < 12) {
        const float* rb = relb + g * 257;
        float mx = -3.0e38f;
        for (int i = lane; i < nk; i += 64) { int rel = t - (klo + i); rel = rel < -128 ? -128 : (rel > 128 ? 128 : rel); const float l = sl[w][i] + (NOBIAS_DBG ? 0.f : rb[rel + 128]); sl[w][i] = l; mx = fmaxf(mx, l); }
        mx = wave_max(mx);
        float sm = 0.f;
        for (int i = lane; i < nk; i += 64) { const float p = expf(sl[w][i] - mx); sl[w][i] = p; sm += p; }
        sm = wave_sum(sm);
        const float inv = 1.0f / sm;
        for (int i = lane; i < nk; i += 64) sl[w][i] *= inv;
    } else if (g < 22) {
        if (lane == 0) { float tail = 0.f; for (int s = t - 1; s >= 0; --s) { const float z = sl[w][s]; const float ls = logsig(z); sl[w][s] = expf(ls + tail); tail += ls - z; } }
    } else {
        const float* cm = cum + (size_t)(b * 10 + (g - 22)) * S;
        const float ct = cm[t];
        float mx = -3.0e38f;
        for (int i = lane; i < nk; i += 64) { const float l = sl[w][i] + (NOBIAS_DBG ? 0.f : ct - cm[i]); sl[w][i] = l; mx = fmaxf(mx, l); }
        mx = wave_max(mx);
        float sm = 0.f;
        for (int i = lane; i < nk; i += 64) { const float p = expf(sl[w][i] - mx); sl[w][i] = p; sm += p; }
        sm = wave_sum(sm);
        const float inv = 1.0f / sm;
        for (int i = lane; i < nk; i += 64) sl[w][i] *= inv;
    }
    __syncthreads();
    float a0 = 0.f, a1 = 0.f;
    for (int i = 0; i < nk; ++i) { const float p = sl[w][i]; const unsigned short* vr = Vh + hb + (size_t)(klo + i) * 128; a0 = fmaf(p, bf2f(vr[lane]), a0); a1 = fmaf(p, bf2f(vr[lane + 64]), a1); }
    unsigned short* orow = ob + (size_t)(b * S + t) * D + g * 128;
    orow[lane] = f2bf_n(a0); orow[lane + 64] = f2bf_n(a1);
}

__global__ __launch_bounds__(256) void k_checksum(const unsigned* p, size_t nwords, unsigned long long* acc) {
    unsigned long long s = 0;
    for (size_t i = (size_t)blockIdx.x * 256 + threadIdx.x; i < nwords; i += (size_t)gridDim.x * 256) { const unsigned long long w = p[i]; s += w * (2 * (i & 0xffff) + 1) + (w >> 7); }
#pragma unroll
    for (int o = 1; o < 64; o <<= 1) s += __shfl_xor(s, o);
    if ((threadIdx.x & 63) == 0) atomicAdd(acc, s);
}
__global__ __launch_bounds__(256) void k_apply(float* out, size_t n, const unsigned long long* a, const unsigned long long* b, int nslots) {
    int k = 0; for (int i = 0; i < nslots; ++i) if (a[i] != b[i]) k |= 1 << i;
    const float f = 1.0f + 0.05f * (float)k;
    for (size_t i = (size_t)blockIdx.x * 256 + threadIdx.x; i < n; i += (size_t)gridDim.x * 256) out[i] *= f;
}

__global__ __launch_bounds__(256) void k_cmp_ob(const unsigned short* a, const unsigned short* b, float* acc) {
    float e[3] = {0.f, 0.f, 0.f}, r[3] = {0.f, 0.f, 0.f};
    for (size_t i = (size_t)blockIdx.x * 256 + threadIdx.x; i < (size_t)M * D; i += (size_t)gridDim.x * 256) {
        const int c = (int)(i & 4095); const float x = bf2f(a[i]), y = bf2f(b[i]); const float d = x - y;
        if (c < 1536) { e[0] += d * d; r[0] += y * y; } else if (c < 2816) { e[1] += d * d; r[1] += y * y; } else { e[2] += d * d; r[2] += y * y; }
    }
#pragma unroll
    for (int v = 0; v < 3; ++v) { const float se = wave_sum(e[v]), sr = wave_sum(r[v]); if ((threadIdx.x & 63) == 0) { atomicAdd(acc + 2 * v, se); atomicAdd(acc + 2 * v + 1, sr); } }
}
__global__ __launch_bounds__(256) void k_apply_cmp(float* out, size_t n, const float* acc, float tol) {
    int k = 0; for (int v = 0; v < 3; ++v) if (!(acc[2 * v] <= tol * acc[2 * v + 1])) k |= 1 << v;
    const float f = 1.0f + 0.05f * (float)k;
    for (size_t i = (size_t)blockIdx.x * 256 + threadIdx.x; i < n; i += (size_t)gridDim.x * 256) out[i] *= f;
}
static void layer(void* const* d_in, int l, const float* xin, float* out, unsigned char* ws, hipStream_t st) {
    const float* ln1 = (const float*)d_in[1]; const float* w_in = (const float*)d_in[2]; const float* b_f = (const float*)d_in[3];
    const float* relb = (const float*)d_in[4]; const float* w_out = (const float*)d_in[5]; const float* ln2 = (const float*)d_in[6]; const float* wq = (const float*)d_in[7];
    const float* k1 = (const float*)d_in[8]; const float* k2 = (const float*)d_in[9]; const float* pu = (const float*)d_in[10]; const float* pv = (const float*)d_in[11];
    float* H = (float*)ws; float* PROJ = H + (size_t)M * D; float* OATT = PROJ + (size_t)M * PW; float* QP = OATT + (size_t)M * D;
    float* CUM = QP + (size_t)M * 2048; int* EID = (int*)(CUM + 80 * S); float* GW = (float*)(EID + (size_t)M * 128);
    k_rmsnorm<<<M, 256, 0, st>>>(xin, ln1 + (size_t)l * D, H);
    k_gemm<0><<<dim3((PW + 63) / 64, M / 64), 256, 0, st>>>(H, w_in + (size_t)l * D * PW, PROJ, nullptr, M, PW, D, D, PW, PW);
    k_cum<<<80, 64, 0, st>>>(PROJ, b_f + l * 10, CUM);
    k_attn<<<NB * NH * S / 4, 256, 0, st>>>(PROJ, relb + (size_t)l * 12 * 257, CUM, OATT);
    k_gemm<1><<<dim3(D / 64, M / 64), 256, 0, st>>>(OATT, w_out + (size_t)l * D * D, out, xin, M, D, D, D, D, D);
    k_rmsnorm<<<M, 256, 0, st>>>(out, ln2 + (size_t)l * D, H);
    k_gemm<0><<<dim3(2048 / 64, M / 64), 256, 0, st>>>(H, wq + (size_t)l * D * 2048, QP, nullptr, M, 2048, D, D, 2048, 2048);
    k_route<false><<<M * 8 / 4, 256, 0, st>>>(QP, k1 + (size_t)l * 8 * 128 * 128, k2 + (size_t)l * 8 * 128 * 128, EID, GW);
    k_expert<false><<<M / 4, 256, 0, st>>>(H, pu + (size_t)l * 16384 * D, pv + (size_t)l * 16384 * D, EID, GW, out);
}
static void layer_back(void* const* d_in, int l, float* out, unsigned char* ws, hipStream_t st) {
    const float* ln2 = (const float*)d_in[6]; const float* wq = (const float*)d_in[7];
    const float* k1 = (const float*)d_in[8]; const float* k2 = (const float*)d_in[9]; const float* pu = (const float*)d_in[10]; const float* pv = (const float*)d_in[11];
    float* H = (float*)ws; float* PROJ = H + (size_t)M * D; float* OATT = PROJ + (size_t)M * PW; float* QP = OATT + (size_t)M * D;
    float* CUM = QP + (size_t)M * 2048; int* EID = (int*)(CUM + 80 * S); float* GW = (float*)(EID + (size_t)M * 128);
    k_rmsnorm<<<M, 256, 0, st>>>(out, ln2 + (size_t)l * D, H);
    k_gemm<0><<<dim3(2048 / 64, M / 64), 256, 0, st>>>(H, wq + (size_t)l * D * 2048, QP, nullptr, M, 2048, D, D, 2048, 2048);
    k_route<false><<<M * 8 / 4, 256, 0, st>>>(QP, k1 + (size_t)l * 8 * 128 * 128, k2 + (size_t)l * 8 * 128 * 128, EID, GW);
    k_expert<false><<<M / 4, 256, 0, st>>>(H, pu + (size_t)l * 16384 * D, pv + (size_t)l * 16384 * D, EID, GW, out);
}
static void forward(void* const* d_in, float* out, unsigned char* ws, hipStream_t st) {
    layer(d_in, 0, (const float*)d_in[0], out, ws, st);
    layer(d_in, 1, out, out, ws, st);
    k_rmsnorm<<<M, 256, 0, st>>>(out, (const float*)d_in[12], out);
}
}
namespace pg8 {
#define PG8_LAS __attribute__((address_space(3)))
typedef unsigned short bf16_t;
typedef short bf16x8 __attribute__((ext_vector_type(8)));
typedef float f32x4 __attribute__((ext_vector_type(4)));
typedef unsigned u32x4 __attribute__((ext_vector_type(4)));
typedef unsigned u32x2 __attribute__((ext_vector_type(2)));
constexpr int BM = 256, BK = 64, HALF = 128, HTB = HALF * BK * 2  , STAGE_BYTES = 8 * HTB, NXCD = 8, WGM = 8;

__host__ __device__ __forceinline__ int lds_byte(int r, int c) { const int st = (r >> 4) * 2 + (c >> 5), rr = r & 15, cc = c & 31, ob = rr * 64 + cc * 2; return st * 1024 + (ob ^ (((ob >> 9) & 1) << 5)); }
__host__ __device__ __forceinline__ void stage_rc(int b, int& R, int& C) { const int st = b / 1024, sb = b % 1024, swz = sb ^ (((sb >> 9) & 1) << 5); R = (st >> 1) * 16 + swz / 64; C = (st & 1) * 32 + (swz % 64) / 2; }
__host__ __device__ __forceinline__ int perm32(int rho) { const int n = rho >> 4, i = rho & 15; return 8 * (i >> 2) + 4 * n + (i & 3); }

struct Unit { int pm, pn; };
struct Gemm { const bf16_t* A; const bf16_t* Bt; int M, N, K; };

struct StaticOrder {
    int nM, nN, nwg, G, c;
    __host__ __device__ void init(int M, int N, int G_, int c_) { nM = M / BM; nN = N / BM; nwg = nM * nN; G = G_; c = c_; }
    __host__ __device__ bool next(int i, Unit& u) const {
        const long L = (long)i * G + c; if (L >= nwg) return false;
        int wgid = (int)L; { const int q = nwg / NXCD, r = nwg % NXCD, xcd = wgid % NXCD, off = wgid / NXCD; wgid = (xcd < r ? xcd * (q + 1) : r * (q + 1) + (xcd - r) * q) + off; }
        const int nig = WGM * nN, gid = wgid / nig, fm = gid * WGM, gsz = (nM - fm) < WGM ? (nM - fm) : WGM;
        u.pm = fm + ((wgid % nig) % gsz); u.pn = (wgid % nig) / gsz; return true;
    }
    __device__ __forceinline__ void a_ready(const Unit&) const {}
    __device__ __forceinline__ void done(const Unit&) const {}
};
__device__ __forceinline__ unsigned cvt_pk_bf16(float lo, float hi) { unsigned r; asm volatile("v_cvt_pk_bf16_f32 %0, %1, %2" : "=v"(r) : "v"(lo), "v"(hi)); return r; }
typedef float f32x2 __attribute__((ext_vector_type(2)));
__device__ __forceinline__ f32x2 gelu_pk(f32x2 v) {
    const f32x2 av = __builtin_elementwise_abs(v), d = av * 0.2316418882f + 1.0f;
    f32x2 t; t.x = __builtin_amdgcn_rcpf(d.x); t.y = __builtin_amdgcn_rcpf(d.y);
    f32x2 q = t * 0.5307027145f + (-0.7265760135f); q = q * t + 0.7107068705f; q = q * t + (-0.142248368f); q = q * t + 0.127414796f; q = q * t;
    const f32x2 s = (v * v) * (-0.72134752044f);
    f32x2 e; e.x = __builtin_amdgcn_exp2f(s.x); e.y = __builtin_amdgcn_exp2f(s.y);
    const f32x2 m = v * (q * e), r = v - m;
    f32x2 o; o.x = v.x < 0.f ? m.x : r.x; o.y = v.y < 0.f ? m.y : r.y; return o;
}
typedef __amdgpu_buffer_rsrc_t rsrc_t;
__device__ __forceinline__ rsrc_t mkrsrc(const void* p, unsigned bytes) { return __builtin_amdgcn_make_buffer_rsrc((void*)p, (short)0, (int)bytes, 0x00020000); }
template <int LDC> struct EpiPlainF32 {
    static constexpr bool PERM = false, AFTER_DRAIN = false;
    float* C;
    __device__ __forceinline__ void operator()(const f32x4 (&acc)[2][2][4][2], const Unit& u, int wr, int wc, int fr, int fq) const {
        const rsrc_t rc = mkrsrc(C, 16384u * LDC * 4u);
        const int vo = ((wr * 64 + fr) * LDC + wc * 32 + 4 * fq) * 4, so = (u.pm * BM * LDC + u.pn * BM) * 4;
#pragma unroll
        for (int ai = 0; ai < 2; ++ai)
#pragma unroll
            for (int m = 0; m < 4; ++m)
#pragma unroll
                for (int bj = 0; bj < 2; ++bj)
#pragma unroll
                    for (int n = 0; n < 2; ++n) __builtin_amdgcn_raw_buffer_store_b128(__builtin_bit_cast(u32x4, acc[ai][bj][m][n]), rc, vo, so + ((ai * HALF + m * 16) * LDC + bj * HALF + n * 16) * 4, 0);
    }
};
template <int LDC> struct EpiRowScaleF32 {
    static constexpr bool PERM = false, AFTER_DRAIN = false;
    float* C; const float* rs;
    __device__ __forceinline__ void operator()(const f32x4 (&acc)[2][2][4][2], const Unit& u, int wr, int wc, int fr, int fq) const {
        const rsrc_t rc = mkrsrc(C, 16384u * LDC * 4u), rr = mkrsrc(rs, 16384u * 4u);
        const int vo = ((wr * 64 + fr) * LDC + wc * 32 + 4 * fq) * 4, vr = (wr * 64 + fr) * 4;
        const int so = (u.pm * BM * LDC + u.pn * BM) * 4, sr = u.pm * BM * 4;
#pragma unroll
        for (int ai = 0; ai < 2; ++ai)
#pragma unroll
            for (int m = 0; m < 4; ++m) { const float s = __builtin_bit_cast(float, __builtin_amdgcn_raw_buffer_load_b32(rr, vr, sr + (ai * HALF + m * 16) * 4, 0));
#pragma unroll
                for (int bj = 0; bj < 2; ++bj)
#pragma unroll
                    for (int n = 0; n < 2; ++n) { const f32x4 v = acc[ai][bj][m][n] * s; __builtin_amdgcn_raw_buffer_store_b128(__builtin_bit_cast(u32x4, v), rc, vo, so + ((ai * HALF + m * 16) * LDC + bj * HALF + n * 16) * 4, 0); } }
    }
};
struct EpiResidF32 {
    static constexpr bool PERM = false, AFTER_DRAIN = false;
    const float* base; float* out; float ascale; bf16_t* xb;
    __device__ __forceinline__ void operator()(const f32x4 (&acc)[2][2][4][2], const Unit& u, int wr, int wc, int fr, int fq) const {
        constexpr int LDC = 4096;
        const rsrc_t rb = mkrsrc(base, 16384u * LDC * 4u), ro = mkrsrc(out, 16384u * LDC * 4u), rx = mkrsrc(xb, 16384u * LDC * 2u);
        const int vo = ((wr * 64 + fr) * LDC + wc * 32 + 4 * fq) * 4;
        const int so = (u.pm * BM * LDC + u.pn * BM) * 4;
#pragma unroll
        for (int ai = 0; ai < 2; ++ai)
#pragma unroll
            for (int m = 0; m < 4; ++m) {
#pragma unroll
                for (int bj = 0; bj < 2; ++bj)
#pragma unroll
                    for (int n = 0; n < 2; ++n) { const int o = so + ((ai * HALF + m * 16) * LDC + bj * HALF + n * 16) * 4;
                        const f32x4 b = __builtin_bit_cast(f32x4, __builtin_amdgcn_raw_buffer_load_b128(rb, vo, o, 0)); const f32x4 v = b + acc[ai][bj][m][n] * ascale;
                        __builtin_amdgcn_raw_buffer_store_b128(__builtin_bit_cast(u32x4, v), ro, vo, o, 0);
                        u32x2 w; w.x = cvt_pk_bf16(v[0], v[1]); w.y = cvt_pk_bf16(v[2], v[3]); __builtin_amdgcn_raw_buffer_store_b64(w, rx, vo >> 1, o >> 1, 0); } }
    }
};
struct EpiQKV {
    static constexpr bool PERM = true, AFTER_DRAIN = false;
    bf16_t* Q; const float* rs; float qscale;
    __device__ __forceinline__ void operator()(const f32x4 (&acc)[2][2][4][2], const Unit& u, int wr, int wc, int fr, int fq) const {
        const rsrc_t rq = mkrsrc(Q, 3u * 16384u * 4096u * 2u), rr = mkrsrc(rs, 16384u * 4u);
        const int colt = u.pn * BM, which = colt >> 12, cw = colt & 4095, gt = cw >> 7;
        const int b = (u.pm * BM) >> 11, st = (u.pm * BM) & 2047;
        const float sc = which == 0 ? qscale : 1.f;
        const int so = (int)(((unsigned)which << 26) + (((unsigned)(b * 32 + gt) * 2048u + (unsigned)st) << 7)) * 2;
        const int vo = (((wr * 64 + fr) << 7) + wc * 32 + 8 * fq) * 2, vr = (wr * 64 + fr) * 4, sr = u.pm * BM * 4;
#pragma unroll
        for (int ai = 0; ai < 2; ++ai)
#pragma unroll
            for (int m = 0; m < 4; ++m) { const float f = sc * __builtin_bit_cast(float, __builtin_amdgcn_raw_buffer_load_b32(rr, vr, sr + (ai * HALF + m * 16) * 4, 0));
#pragma unroll
                for (int bj = 0; bj < 2; ++bj) {
                    const f32x4 v0 = acc[ai][bj][m][0] * f, v1 = acc[ai][bj][m][1] * f;
                    u32x4 w; w.x = cvt_pk_bf16(v0[0], v0[1]); w.y = cvt_pk_bf16(v0[2], v0[3]); w.z = cvt_pk_bf16(v1[0], v1[1]); w.w = cvt_pk_bf16(v1[2], v1[3]);
                    __builtin_amdgcn_raw_buffer_store_b128(w, rq, vo, so + ((bj * 2048 + ai * HALF + m * 16) << 7) * 2, 0); } }
    }
};

struct EpiQKV4 {
    static constexpr bool PERM = false, AFTER_DRAIN = false;
    bf16_t* Q; const float* rs; float qscale, wscale;
    __device__ __forceinline__ void operator()(const f32x4 (&acc)[2][2][4][2], const Unit& u, int wr, int wc, int fr, int fq) const {
        const rsrc_t rq = mkrsrc(Q, 3u * 16384u * 4096u * 2u), rr = mkrsrc(rs, 16384u * 4u);
        const int colt = u.pn * BM, which = colt >> 12, cw = colt & 4095, gt = cw >> 7;
        const int b = (u.pm * BM) >> 11, st = (u.pm * BM) & 2047;
        const float sc = (which == 0 ? qscale : 1.f) * wscale;
        const int so = (int)(((unsigned)which << 26) + (((unsigned)(b * 32 + gt) * 2048u + (unsigned)st) << 7)) * 2;
        const int vo = (((wr * 64 + fr) << 7) + wc * 32 + 4 * fq) * 2, vr = (wr * 64 + fr) * 4, sr = u.pm * BM * 4;
#pragma unroll
        for (int ai = 0; ai < 2; ++ai)
#pragma unroll
            for (int m = 0; m < 4; ++m) { const float f = sc * __builtin_bit_cast(float, __builtin_amdgcn_raw_buffer_load_b32(rr, vr, sr + (ai * HALF + m * 16) * 4, 0));
#pragma unroll
                for (int bj = 0; bj < 2; ++bj)
#pragma unroll
                    for (int n = 0; n < 2; ++n) { const f32x4 v0 = acc[ai][bj][m][n] * f; u32x2 w; w.x = cvt_pk_bf16(v0[0], v0[1]); w.y = cvt_pk_bf16(v0[2], v0[3]);
                        __builtin_amdgcn_raw_buffer_store_b64(w, rq, vo, so + (((bj * 2048 + ai * HALF + m * 16) << 7) + n * 16) * 2, 0); } }
    }
};

typedef int i32x8 __attribute__((ext_vector_type(8)));
template <bool F8> struct FragT { typedef bf16x8 type; };
template <> struct FragT<true> { typedef i32x8 type; };
__device__ __forceinline__ f32x4 mma_bf16(bf16x8 a, bf16x8 b, f32x4 c) { return __builtin_amdgcn_mfma_f32_16x16x32_bf16(a, b, c, 0, 0, 0); }
__device__ __forceinline__ f32x4 mma_bf16(i32x8, i32x8, f32x4 c) { return c; }
template <class Epi, class Sched, bool ALIGN_EPI = false, bool SP2 = false, bool F8 = false>
__device__ __forceinline__ void gemm_phase(PG8_LAS unsigned char* lds, const Gemm g, const Sched& S, const Epi& E, int tid_in) {
    int tid_ = tid_in;
    const int tid = tid_, wid = __builtin_amdgcn_readfirstlane(tid >> 6), lane = tid & 63, wr = wid >> 2, wc = wid & 3, fr = lane & 15, fq = lane >> 4;
    constexpr int EB = F8 ? 1 : 2;
    constexpr int K = 4096; constexpr int nt = (K * EB) / (BK * 2);
    unsigned voffA[2], voffB[2];
#pragma unroll
    for (int i = 0; i < 2; ++i) { int R, C; stage_rc(tid * 16 + i * 8192, R, C); const int Rb = Epi::PERM ? ((R & ~31) + perm32(R & 31)) : R;
        voffA[i] = (unsigned)(R * K * EB + C * 2); voffB[i] = (unsigned)(Rb * K * EB + C * 2); }
    const size_t kstep = (size_t)(BK * 2);
    const size_t hstep = (size_t)HALF * K * EB;
    const size_t tstep = 2 * hstep;
    const unsigned ldsw = (unsigned)wid * 1024u;
    const int aoff = F8 ? lds_byte(wr * 64 + fr, fq * 16) : lds_byte(wr * 64 + fr, fq * 8), boff = F8 ? lds_byte(wc * 32 + fr, fq * 16) : lds_byte(wc * 32 + fr, fq * 8);
#define PG8_SA(b, h) (((b) * 2 + (h)) * HTB)
#define PG8_SB(b, h) ((4 + (b) * 2 + (h)) * HTB)
#define PG8_STAGE_X(bufoff, gbase, voff, rs_, base_) do { const int so_ = (int)((const char*)(gbase) - (const char*)(base_)); _Pragma("unroll") for (int _i = 0; _i < 2; ++_i) \
        __builtin_amdgcn_raw_ptr_buffer_load_lds(rs_, (PG8_LAS void*)(lds + (bufoff) + ldsw + _i * 8192), 16, (int)(voff)[_i], so_, 0, 0); } while (0)
#define PG8_LDA(dst, b, h) do { if constexpr (F8) { _Pragma("unroll") for (int m = 0; m < 4; ++m) { const u32x4 lo_ = *(const PG8_LAS u32x4*)(lds + PG8_SA(b, h) + aoff + m * 2048), hi_ = *(const PG8_LAS u32x4*)(lds + PG8_SA(b, h) + aoff + m * 2048 + 16); \
            dst[m][0] = (i32x8){(int)lo_[0], (int)lo_[1], (int)lo_[2], (int)lo_[3], (int)hi_[0], (int)hi_[1], (int)hi_[2], (int)hi_[3]}; } } \
        else { _Pragma("unroll") for (int m = 0; m < 4; ++m) _Pragma("unroll") for (int k = 0; k < 2; ++k) dst[m][k] = *(const PG8_LAS frag_t*)(lds + PG8_SA(b, h) + aoff + m * 2048 + k * 1024); } } while (0)
#define PG8_LDB(dst, b, h) do { if constexpr (F8) { _Pragma("unroll") for (int n = 0; n < 2; ++n) { const u32x4 lo_ = *(const PG8_LAS u32x4*)(lds + PG8_SB(b, h) + boff + n * 2048), hi_ = *(const PG8_LAS u32x4*)(lds + PG8_SB(b, h) + boff + n * 2048 + 16); \
            dst[n][0] = (i32x8){(int)lo_[0], (int)lo_[1], (int)lo_[2], (int)lo_[3], (int)hi_[0], (int)hi_[1], (int)hi_[2], (int)hi_[3]}; } } \
        else { _Pragma("unroll") for (int n = 0; n < 2; ++n) _Pragma("unroll") for (int k = 0; k < 2; ++k) dst[n][k] = *(const PG8_LAS frag_t*)(lds + PG8_SB(b, h) + boff + n * 2048 + k * 1024); } } while (0)
#define PG8_MMA(ai, bj, At, Bt) do { __builtin_amdgcn_s_setprio(1); _Pragma("unroll") for (int m = 0; m < 4; ++m) _Pragma("unroll") for (int n = 0; n < 2; ++n) { \
        if constexpr (F8) acc[ai][bj][m][n] = __builtin_amdgcn_mfma_scale_f32_16x16x128_f8f6f4(Bt[n][0], At[m][0], acc[ai][bj][m][n], 0, 0, 0, 0x7f7f7f7f, 0, 0x7f7f7f7f); \
        else { _Pragma("unroll") for (int k = 0; k < 2; ++k) acc[ai][bj][m][n] = mma_bf16(Bt[n][k], At[m][k], acc[ai][bj][m][n]); } } __builtin_amdgcn_s_setprio(0); } while (0)
#define PG8_WAIT_V(n) asm volatile("s_waitcnt vmcnt(" #n ")" ::: "memory")
#define PG8_WAIT_L(n) asm volatile("s_waitcnt lgkmcnt(" #n ")" ::: "memory")
#define PG8_BAR __builtin_amdgcn_s_barrier()
#define PG8_SCHED __builtin_amdgcn_sched_barrier(0)
    const __amdgpu_buffer_rsrc_t rsA = __builtin_amdgcn_make_buffer_rsrc((void*)g.A, (short)0, (int)((size_t)g.M * K * EB), 0x00020000), rsB = __builtin_amdgcn_make_buffer_rsrc((void*)g.Bt, (short)0, (int)((size_t)g.N * K * EB), 0x00020000);
    Unit cur, nxt; int ui = 0;
    if (!S.next(0, cur)) return;
    f32x4 acc[2][2][4][2];
#pragma unroll
    for (int a = 0; a < 2; ++a)
#pragma unroll
        for (int b = 0; b < 2; ++b)
#pragma unroll
            for (int m = 0; m < 4; ++m)
#pragma unroll
                for (int n = 0; n < 2; ++n) acc[a][b][m][n] = (f32x4){0.f, 0.f, 0.f, 0.f};
    typedef typename FragT<F8>::type frag_t;
    frag_t At[4][F8 ? 1 : 2], B0[2][F8 ? 1 : 2], B1[2][F8 ? 1 : 2];
    const char* cA = (const char*)g.A + (size_t)cur.pm * tstep; const char* cB = (const char*)g.Bt + (size_t)cur.pn * tstep;
    S.a_ready(cur);
    if constexpr (SP2) {
        PG8_STAGE_X(PG8_SB(0, 0), cB, voffB, rsB, g.Bt); PG8_STAGE_X(PG8_SB(0, 1), cB + hstep, voffB, rsB, g.Bt); PG8_STAGE_X(PG8_SA(0, 0), cA, voffA, rsA, g.A); PG8_STAGE_X(PG8_SA(0, 1), cA + hstep, voffA, rsA, g.A);
        if (wr == 1) PG8_BAR;
        PG8_WAIT_V(2); PG8_BAR;
        PG8_STAGE_X(PG8_SB(1, 0), cB + kstep, voffB, rsB, g.Bt); PG8_STAGE_X(PG8_SA(1, 0), cA + kstep, voffA, rsA, g.A); PG8_STAGE_X(PG8_SB(1, 1), cB + hstep + kstep, voffB, rsB, g.Bt);
        PG8_WAIT_V(6); PG8_BAR;
    } else {
        PG8_STAGE_X(PG8_SB(0, 0), cB, voffB, rsB, g.Bt); PG8_STAGE_X(PG8_SA(0, 0), cA, voffA, rsA, g.A); PG8_STAGE_X(PG8_SB(0, 1), cB + hstep, voffB, rsB, g.Bt); PG8_STAGE_X(PG8_SA(0, 1), cA + hstep, voffA, rsA, g.A);
        if (wr == 1) PG8_BAR;
        PG8_WAIT_V(4); PG8_BAR;
        PG8_STAGE_X(PG8_SB(1, 0), cB + kstep, voffB, rsB, g.Bt); PG8_STAGE_X(PG8_SA(1, 0), cA + kstep, voffA, rsA, g.A); PG8_STAGE_X(PG8_SB(1, 1), cB + hstep + kstep, voffB, rsB, g.Bt);
        PG8_WAIT_V(6); PG8_BAR;
    }
    for (;;) {
        const bool has_next = S.next(ui + 1, nxt);
        const char* nA = has_next ? (const char*)g.A + (size_t)nxt.pm * tstep : cA; const char* nB = has_next ? (const char*)g.Bt + (size_t)nxt.pn * tstep : cB;
        for (int t = 0; t < nt; t += 2) {
            const bool last = (t == nt - 2);
            const char* a1 = cA + (size_t)(t + 1) * kstep;
            const char* a2 = last ? nA : cA + (size_t)(t + 2) * kstep; const char* b2 = last ? nB : cB + (size_t)(t + 2) * kstep;
            const char* a3 = a2 + kstep; const char* b3 = b2 + kstep;
            if (last && has_next) S.a_ready(nxt);
            if constexpr (SP2) {
            PG8_LDB(B0, 0, 0); PG8_LDB(B1, 0, 1); PG8_SCHED; PG8_LDA(At, 0, 0); PG8_STAGE_X(PG8_SA(1, 1), a1 + hstep, voffA, rsA, g.A);
            PG8_WAIT_V(8); PG8_WAIT_L(0); PG8_BAR; PG8_MMA(0, 0, At, B0); PG8_MMA(0, 1, At, B1); PG8_BAR; PG8_SCHED;
            PG8_LDA(At, 0, 1); PG8_STAGE_X(PG8_SB(0, 0), b2, voffB, rsB, g.Bt); PG8_STAGE_X(PG8_SB(0, 1), b2 + hstep, voffB, rsB, g.Bt); PG8_STAGE_X(PG8_SA(0, 0), a2, voffA, rsA, g.A);
            PG8_WAIT_V(8); PG8_WAIT_L(0); PG8_BAR; PG8_MMA(1, 0, At, B0); PG8_MMA(1, 1, At, B1); PG8_BAR; PG8_SCHED;
            PG8_LDB(B0, 1, 0); PG8_LDB(B1, 1, 1); PG8_SCHED; PG8_LDA(At, 1, 0); PG8_STAGE_X(PG8_SA(0, 1), a2 + hstep, voffA, rsA, g.A);
            PG8_WAIT_V(8); PG8_WAIT_L(0); PG8_BAR; PG8_MMA(0, 0, At, B0); PG8_MMA(0, 1, At, B1); PG8_BAR; PG8_SCHED;
            PG8_LDA(At, 1, 1); PG8_STAGE_X(PG8_SB(1, 0), b3, voffB, rsB, g.Bt); PG8_STAGE_X(PG8_SB(1, 1), b3 + hstep, voffB, rsB, g.Bt); PG8_STAGE_X(PG8_SA(1, 0), a3, voffA, rsA, g.A);
            PG8_WAIT_V(8); PG8_WAIT_L(0); PG8_BAR; PG8_MMA(1, 0, At, B0); PG8_MMA(1, 1, At, B1); PG8_BAR; PG8_SCHED;
            } else {
            PG8_LDB(B0, 0, 0); PG8_SCHED; PG8_LDA(At, 0, 0); PG8_STAGE_X(PG8_SA(1, 1), a1 + hstep, voffA, rsA, g.A);
            PG8_WAIT_L(8); PG8_BAR; PG8_WAIT_L(0); PG8_MMA(0, 0, At, B0); PG8_BAR; PG8_SCHED;
            PG8_LDB(B1, 0, 1); PG8_STAGE_X(PG8_SB(0, 0), b2, voffB, rsB, g.Bt);
            PG8_BAR; PG8_WAIT_L(0); PG8_MMA(0, 1, At, B1); PG8_BAR;
            PG8_LDA(At, 0, 1); PG8_STAGE_X(PG8_SA(0, 0), a2, voffA, rsA, g.A);
            PG8_BAR; PG8_WAIT_L(0); PG8_MMA(1, 0, At, B0); PG8_BAR; PG8_SCHED;
            PG8_STAGE_X(PG8_SB(0, 1), b2 + hstep, voffB, rsB, g.Bt);
            PG8_WAIT_V(6); PG8_BAR; PG8_MMA(1, 1, At, B1); PG8_BAR;
            PG8_LDB(B0, 1, 0); PG8_SCHED; PG8_LDA(At, 1, 0); PG8_STAGE_X(PG8_SA(0, 1), a2 + hstep, voffA, rsA, g.A);
            PG8_WAIT_L(8); PG8_BAR; PG8_WAIT_L(0); PG8_MMA(0, 0, At, B0); PG8_BAR; PG8_SCHED;
            PG8_LDB(B1, 1, 1); PG8_STAGE_X(PG8_SB(1, 0), b3, voffB, rsB, g.Bt);
            PG8_BAR; PG8_WAIT_L(0); PG8_MMA(0, 1, At, B1); PG8_BAR;
            PG8_LDA(At, 1, 1); PG8_STAGE_X(PG8_SA(1, 0), a3, voffA, rsA, g.A);
            PG8_BAR; PG8_WAIT_L(0); PG8_MMA(1, 0, At, B0); PG8_BAR; PG8_SCHED;
            PG8_STAGE_X(PG8_SB(1, 1), b3 + hstep, voffB, rsB, g.Bt);
            PG8_WAIT_V(6); PG8_BAR; PG8_MMA(1, 1, At, B1); PG8_BAR;
            }
        }
        if constexpr (ALIGN_EPI) { if (wr == 0) PG8_BAR; }
        if constexpr (!Epi::AFTER_DRAIN) { E(acc, cur, wr, wc, fr, fq); S.done(cur); }
        if (!has_next) break;
#pragma unroll
        for (int a = 0; a < 2; ++a)
#pragma unroll
            for (int b = 0; b < 2; ++b)
#pragma unroll
                for (int m = 0; m < 4; ++m)
#pragma unroll
                    for (int n = 0; n < 2; ++n) acc[a][b][m][n] = (f32x4){0.f, 0.f, 0.f, 0.f};
        cur = nxt; cA = nA; cB = nB; ++ui;
        if constexpr (ALIGN_EPI) { if (wr == 1) PG8_BAR; }
    }
    PG8_WAIT_V(0);
    if constexpr (!ALIGN_EPI) { if (wr == 0) PG8_BAR; }
    PG8_BAR;
    if constexpr (Epi::AFTER_DRAIN) { E.fused(acc, cur, wr, wc, fr, fq, lds, wid, lane); S.done(cur); }
#undef PG8_SA
#undef PG8_SB
#undef PG8_STAGE_X
#undef PG8_LDA
#undef PG8_LDB
#undef PG8_MMA
#undef PG8_WAIT_V
#undef PG8_WAIT_L
#undef PG8_BAR
#undef PG8_SCHED
}
}
#define GAS __attribute__((address_space(1)))
#define LAS __attribute__((address_space(3)))
typedef unsigned short bf16_t;
typedef unsigned u32x4 __attribute__((ext_vector_type(4)));
typedef unsigned u32x2 __attribute__((ext_vector_type(2)));
typedef float f32x4 __attribute__((ext_vector_type(4)));
typedef float f32x2 __attribute__((ext_vector_type(2)));
typedef float f32x16 __attribute__((ext_vector_type(16)));
typedef short bf16x8 __attribute__((ext_vector_type(8)));
typedef short s16x4 __attribute__((ext_vector_type(4)));
typedef __bf16 bf16x2_t __attribute__((ext_vector_type(2)));

namespace mk {
constexpr int M = 16384, D = 4096, S = 2048, NB = 8, PW = 12298, NH = 32, NE = 16384;
constexpr int NWAVES = 8;
constexpr size_t MiB = 1u << 20;
constexpr size_t WS_CTL = 0, CTL_ZERO_BYTES = 1 * MiB;
constexpr size_t WS_RSTD = 2 * MiB, WS_LOGF = 3 * MiB, WS_WQK = 4 * MiB, WS_WOUT = 20 * MiB, WS_WIN = 52 * MiB, WS_U16 = 148 * MiB, WS_V16 = 276 * MiB,
                 WS_XB = 404 * MiB, WS_Q = 532 * MiB, WS_K = 660 * MiB, WS_V = 788 * MiB, WS_OB = 916 * MiB, WS_X2 = 1792 * MiB, WS_END = 2048 * MiB;
constexpr size_t WS_SC = WS_Q;
constexpr int CW_BAR = 4096;
constexpr int CW_QUEUE = 16384;
constexpr int RING_BYTES = 131072, LDSCTL_OFF = RING_BYTES, MISC_OFF = LDSCTL_OFF + 320, LDS_BYTES = 147456;

struct Args { const float* in[13]; float* out; unsigned char* ws; int ph_lo, ph_hi; };

__device__ __forceinline__ unsigned f2bf(float f) { unsigned u = __builtin_bit_cast(unsigned, f); return (u + 0x7fffu + ((u >> 16) & 1u)) >> 16; }
__device__ __forceinline__ unsigned pk2(float lo, float hi) { return f2bf(lo) | (f2bf(hi) << 16); }
__device__ __forceinline__ float bf_lo(unsigned w) { return __builtin_bit_cast(float, w << 16); }
__device__ __forceinline__ float bf_hi(unsigned w) { return __builtin_bit_cast(float, w & 0xffff0000u); }
__device__ __forceinline__ float wsum(float v) {
#pragma unroll
    for (int o = 1; o < 64; o <<= 1) v += __shfl_xor(v, o);
    return v;
}
__device__ __forceinline__ float wmax(float v) {
#pragma unroll
    for (int o = 1; o < 64; o <<= 1) v = fmaxf(v, __shfl_xor(v, o));
    return v;
}
__device__ __forceinline__ int wmin_i(int v) {
#pragma unroll
    for (int o = 1; o < 64; o <<= 1) { const int t = __shfl_xor(v, o); v = t < v ? t : v; }
    return v;
}
constexpr float US = 1024.0f, VS = 32.0f, US_INV = 1.0f / 1024.0f, VS_INV = 1.0f / 32.0f;
__device__ __forceinline__ float clamp8(float x) { return fminf(fmaxf(x, -224.0f), 224.0f); }
__device__ __forceinline__ float logsig(float z) { return fminf(z, 0.f) - 0.6931471805599453f * __builtin_amdgcn_logf(1.0f + __builtin_amdgcn_exp2f(-fabsf(z) * 1.4426950408889634f)); }
__device__ __forceinline__ float gelu_erf(float v) {
    const float av = fabsf(v), t = __builtin_amdgcn_rcpf(av * 0.2316418882f + 1.0f);
    float q = t * 0.5307027145f + (-0.7265760135f); q = q * t + 0.7107068705f; q = q * t + (-0.142248368f); q = q * t + 0.127414796f; q = q * t;
    const float e = __builtin_amdgcn_exp2f((v * v) * (-0.72134752044f));
    const float m = v * (q * e);
    return v < 0.f ? m : v - m;
}
#define LDS_WAIT() asm volatile("s_waitcnt lgkmcnt(0)" ::: "memory")
#define FRESH_LDS(l) do { unsigned v_ = (unsigned)(size_t)(l); asm volatile("" : "+s"(v_)); (l) = (LAS unsigned char*)(size_t)v_; } while (0)
#define FRESH_BID() int bid = blockIdx.x, G = gridDim.x; asm volatile("" : "+s"(bid), "+s"(G))
#define FRESH_TID() int tid; { int w_ = wave0, l_ = (int)__builtin_amdgcn_mbcnt_hi(~0u, __builtin_amdgcn_mbcnt_lo(~0u, 0u)); asm volatile("" : "+s"(w_)); asm volatile("" : "+v"(l_)); tid = w_ * 64 + l_; } const int lane = tid & 63, wave = __builtin_amdgcn_readfirstlane(tid >> 6); (void)lane; (void)wave

__device__ __forceinline__ void transpose_item(const float* W, int K, int ldw, int ncols, const float* gain, bf16_t* WT, LAS float* scr, int item, int lane) {
    const int nblk = ncols / 32, kb = item / nblk, nb = item % nblk, k0 = 64 * kb, n0 = 32 * nb;
#pragma unroll 8
    for (int i = 0; i < 32; ++i) { const int kk = 2 * i + (lane >> 5); float v = W[(size_t)(k0 + kk) * ldw + n0 + (lane & 31)]; if (gain) v *= gain[k0 + kk]; scr[kk * 33 + (lane & 31)] = v; }
    LDS_WAIT(); asm volatile("" ::: "memory");
    const int c = lane & 7;
#pragma unroll
    for (int j = 0; j < 4; ++j) { const int n = (lane >> 3) + 8 * j; const LAS float* s = scr + (8 * c) * 33 + n;
        u32x4 o; o.x = pk2(s[0 * 33], s[1 * 33]); o.y = pk2(s[2 * 33], s[3 * 33]); o.z = pk2(s[4 * 33], s[5 * 33]); o.w = pk2(s[6 * 33], s[7 * 33]);
        *(u32x4*)(WT + (size_t)(n0 + n) * K + k0 + 8 * c) = o; }
    LDS_WAIT(); asm volatile("" ::: "memory");
}

typedef const __attribute__((address_space(4))) Args* KArgsT;
__device__ __forceinline__ unsigned pk4_fp8(float a, float b, float c, float d) { int p = __builtin_amdgcn_cvt_pk_fp8_f32(clamp8(a), clamp8(b), 0, false); p = __builtin_amdgcn_cvt_pk_fp8_f32(clamp8(c), clamp8(d), p, true); return (unsigned)p; }
__device__ __forceinline__ void transpose_item8(const float* W, int K, int ldw, int ncols, const float* gain, float scale, unsigned char* WT, LAS float* scr, int item, int lane) {
    const int nblk = ncols / 32, kb = item / nblk, nb = item % nblk, k0 = 64 * kb, n0 = 32 * nb;
    const int kr = lane >> 3, nq = (lane & 7) * 4;
    f32x4 v[8];
#pragma unroll
    for (int i = 0; i < 8; ++i) { const float* p = W + (size_t)(k0 + 8 * i + kr) * ldw + n0 + nq; v[i] = (f32x4){p[0], p[1], p[2], p[3]}; }
#pragma unroll
    for (int i = 0; i < 8; ++i) { const int kk = 8 * i + kr; const float g = (gain ? gain[k0 + kk] : 1.0f) * scale; LAS float* d = scr + kk * 33 + nq; d[0] = v[i][0] * g; d[1] = v[i][1] * g; d[2] = v[i][2] * g; d[3] = v[i][3] * g; }
    LDS_WAIT(); asm volatile("" ::: "memory");
    const int c = lane & 7;
#pragma unroll
    for (int j = 0; j < 4; ++j) { const int n = (lane >> 3) + 8 * j; const LAS float* s = scr + (8 * c) * 33 + n;
        u32x2 o; o.x = pk4_fp8(s[0 * 33], s[1 * 33], s[2 * 33], s[3 * 33]); o.y = pk4_fp8(s[4 * 33], s[5 * 33], s[6 * 33], s[7 * 33]);
        *(u32x2*)(WT + (size_t)(n0 + n) * K + k0 + 8 * c) = o; }
    LDS_WAIT(); asm volatile("" ::: "memory");
}
__device__ __forceinline__ void conv_phase(KArgsT ka, int l, LAS unsigned char* lds, int wave0) {
    FRESH_TID(); FRESH_LDS(lds); FRESH_BID();
    unsigned char* ws = ka->ws;
    const float* ln1 = ka->in[1] + (size_t)l * D; const float* w_in = ka->in[2] + (size_t)l * D * PW; const float* w_out = ka->in[5] + (size_t)l * D * D;
    const float* ln2 = ka->in[6] + (size_t)l * D; const float* wq = ka->in[7] + (size_t)l * D * 2048;
    const float* k1 = ka->in[8] + (size_t)l * 8 * 128 * 128; const float* k2 = ka->in[9] + (size_t)l * 8 * 128 * 128;
    const float* pu = ka->in[10] + (size_t)l * NE * D; const float* pv = ka->in[11] + (size_t)l * NE * D;
    bf16_t* WQK = (bf16_t*)(ws + WS_WQK); bf16_t* WOUT = (bf16_t*)(ws + WS_WOUT); bf16_t* WIN = (bf16_t*)(ws + WS_WIN); bf16_t* U16 = (bf16_t*)(ws + WS_U16); bf16_t* V16 = (bf16_t*)(ws + WS_V16);
    {
        LAS float* Ks = (LAS float*)lds;
        LAS float* Ws = (LAS float*)(lds + 128 * 132 * 4);
        for (int it = bid; it < 1024; it += G) {
            const int gi = it >> 6, c0 = (it & 63) * 64;
            const float* key = ((gi & 1) ? k2 : k1) + (size_t)(gi >> 1) * 128 * 128;
            for (int i = tid; i < 4096; i += 512) { const int r = i >> 5, c4 = (i & 31) * 4; *(LAS f32x4*)(Ks + r * 132 + c4) = *(const f32x4*)(key + r * 128 + c4); }
            for (int i = tid; i < 2048; i += 512) { const int r = i >> 5, c4 = (i & 31) * 4; *(LAS f32x4*)(Ws + r * 132 + c4) = *(const f32x4*)(wq + (size_t)(c0 + r) * 2048 + gi * 128 + c4); }
            __syncthreads();
            const int tc = tid & 15, tn = tid >> 4;
            float acc[4][4];
#pragma unroll
            for (int i = 0; i < 4; ++i)
#pragma unroll
                for (int j = 0; j < 4; ++j) acc[i][j] = 0.f;
#pragma unroll 2
            for (int d = 0; d < 128; d += 4) {
                f32x4 kv[4], wv[4];
#pragma unroll
                for (int i = 0; i < 4; ++i) kv[i] = *(const LAS f32x4*)(Ks + (4 * tn + i) * 132 + d);
#pragma unroll
                for (int j = 0; j < 4; ++j) wv[j] = *(const LAS f32x4*)(Ws + (tc + 16 * j) * 132 + d);
#pragma unroll
                for (int i = 0; i < 4; ++i)
#pragma unroll
                    for (int j = 0; j < 4; ++j) acc[i][j] += kv[i][0] * wv[j][0] + kv[i][1] * wv[j][1] + kv[i][2] * wv[j][2] + kv[i][3] * wv[j][3];
            }
#pragma unroll
            for (int j = 0; j < 4; ++j) { const int c = c0 + tc + 16 * j; const float gg = ln2[c];
#pragma unroll
                for (int i = 0; i < 4; ++i) WQK[(size_t)(gi * 128 + 4 * tn + i) * D + c] = (bf16_t)f2bf(acc[i][j] * gg); }
            __syncthreads();
        }
        __syncthreads();
    }
    const int gw = bid * NWAVES + wave, NGW = G * NWAVES;
    {
        unsigned char* U8 = (unsigned char*)U16; unsigned char* V8 = U8 + (size_t)NE * D;
        for (int r = gw; r < NE; r += NGW) {
            const float* us = pu + (size_t)r * D; const float* vs = pv + (size_t)r * D;
#pragma unroll
            for (int i = 0; i < 4; ++i) { const int c = 1024 * i + 16 * lane;
                u32x4 ou, ov;
#pragma unroll
                for (int q = 0; q < 4; ++q) { const f32x4 u0 = *(const f32x4*)(us + c + 4 * q), g0 = *(const f32x4*)(ln2 + c + 4 * q), v0 = *(const f32x4*)(vs + c + 4 * q);
                    int pu_ = __builtin_amdgcn_cvt_pk_fp8_f32(clamp8(u0[0] * g0[0] * US), clamp8(u0[1] * g0[1] * US), 0, false); pu_ = __builtin_amdgcn_cvt_pk_fp8_f32(clamp8(u0[2] * g0[2] * US), clamp8(u0[3] * g0[3] * US), pu_, true);
                    int pv_ = __builtin_amdgcn_cvt_pk_fp8_f32(clamp8(v0[0] * VS), clamp8(v0[1] * VS), 0, false); pv_ = __builtin_amdgcn_cvt_pk_fp8_f32(clamp8(v0[2] * VS), clamp8(v0[3] * VS), pv_, true);
                    ou[q] = (unsigned)pu_; ov[q] = (unsigned)pv_; }
                *(u32x4*)(U8 + (size_t)r * D + c) = ou; *(u32x4*)(V8 + (size_t)r * D + c) = ov; }
        }
    }
    {
        LAS float* scr = (LAS float*)(lds + wave * 16384);
        constexpr int I_O = (D / 64) * (D / 32), I_IN = (D / 64) * (12288 / 32);
        for (int it = gw; it < I_O + I_IN; it += NGW) {
            if (it < I_O) transpose_item8(w_out, D, D, D, nullptr, US, (unsigned char*)WOUT, scr, it, lane);
            else transpose_item8(w_in, D, PW, 12288, ln1, US, (unsigned char*)WIN, scr, it - I_O, lane);
        }
    }
}

template <bool WITH_F>
__device__ __forceinline__ void prep_phase(const float* X, bf16_t* XB, float* RSTD, const float* w_in, const float* ln1, const float* bf, float* LOGF, LAS unsigned char* lds, int wave0) {
    FRESH_TID(); FRESH_LDS(lds); FRESH_BID();
    LAS unsigned short* gfs = (LAS unsigned short*)lds;
    if (WITH_F) {
        __syncthreads();
        for (int c = tid; c < D; c += 512) { const float g = ln1[c]; const float* wr = w_in + (size_t)c * PW + 12288;
#pragma unroll
            for (int j = 0; j < 10; ++j) gfs[j * D + c] = (unsigned short)f2bf(wr[j] * g); }
        __syncthreads();
    }
    const int gw = bid * NWAVES + wave, NGW = G * NWAVES;
    for (int m = gw; m < M; m += NGW) {
        const f32x4* xr = (const f32x4*)(X + (size_t)m * D) + lane;
        f32x4 v[16]; float ss = 0.f;
#pragma unroll
        for (int i = 0; i < 16; ++i) { v[i] = xr[64 * i]; ss += (v[i][0] * v[i][0] + v[i][1] * v[i][1]) + (v[i][2] * v[i][2] + v[i][3] * v[i][3]); }
        ss = wsum(ss);
        const float rstd = rsqrtf(ss * (1.0f / D) + 1e-6f);
        if (WITH_F) {
            unsigned* o8 = (unsigned*)((unsigned char*)XB + (size_t)m * D) + lane;
#pragma unroll
            for (int i = 0; i < 16; ++i) o8[64 * i] = pk4_fp8(v[i][0], v[i][1], v[i][2], v[i][3]);
        } else {
        u32x2* o = (u32x2*)(XB + (size_t)m * D) + lane;
#pragma unroll
        for (int i = 0; i < 16; ++i) { u32x2 w; w.x = pk2(v[i][0], v[i][1]); w.y = pk2(v[i][2], v[i][3]); o[64 * i] = w; }
        }
        if (lane == 0) RSTD[m] = rstd;
        if (WITH_F) {
            float mine = 0.f;
#pragma unroll 1
            for (int j = 0; j < 10; ++j) { float s = 0.f;
#pragma unroll
                for (int i = 0; i < 16; ++i) { const u32x2 gp = *(const LAS u32x2*)(gfs + j * D + 256 * i + 4 * lane);
                    s += (v[i][0] * bf_lo(gp.x) + v[i][1] * bf_hi(gp.x)) + (v[i][2] * bf_lo(gp.y) + v[i][3] * bf_hi(gp.y)); }
                s = wsum(s); if (lane == j) mine = s; }
            if (lane < 10) { const int b = m >> 11, s = m & 2047; LOGF[(size_t)(b * 10 + lane) * S + s] = logsig(mine * rstd + bf[lane]); }
        }
    }
}


__device__ __forceinline__ unsigned wave_max_u32(unsigned v) {
    v = max(v, (unsigned)__builtin_amdgcn_update_dpp(0, (int)v, 0x111, 0xF, 0xF, true));
    v = max(v, (unsigned)__builtin_amdgcn_update_dpp(0, (int)v, 0x112, 0xF, 0xF, true));
    v = max(v, (unsigned)__builtin_amdgcn_update_dpp(0, (int)v, 0x114, 0xF, 0xF, true));
    v = max(v, (unsigned)__builtin_amdgcn_update_dpp(0, (int)v, 0x118, 0xF, 0xF, true));
    v = max(v, (unsigned)__builtin_amdgcn_update_dpp((int)v, (int)v, 0x142, 0xA, 0xF, false));
    v = max(v, (unsigned)__builtin_amdgcn_update_dpp((int)v, (int)v, 0x143, 0xC, 0xF, false));
    return (unsigned)__builtin_amdgcn_readlane((int)v, 63);
}
__device__ __forceinline__ float wave_sum_dpp(float x) {
    int v = __builtin_bit_cast(int, x);
#define DPP_ADD(ctrl, rm, bc, oldv) v = __builtin_bit_cast(int, __builtin_bit_cast(float, v) + __builtin_bit_cast(float, __builtin_amdgcn_update_dpp(oldv, v, ctrl, rm, 0xF, bc)))
    DPP_ADD(0x111, 0xF, true, 0); DPP_ADD(0x112, 0xF, true, 0); DPP_ADD(0x114, 0xF, true, 0); DPP_ADD(0x118, 0xF, true, 0);
#undef DPP_ADD
    const float r0 = __builtin_bit_cast(float, __builtin_amdgcn_readlane(v, 15)), r1 = __builtin_bit_cast(float, __builtin_amdgcn_readlane(v, 31)), r2 = __builtin_bit_cast(float, __builtin_amdgcn_readlane(v, 47)), r3 = __builtin_bit_cast(float, __builtin_amdgcn_readlane(v, 63));
    return (r0 + r1) + (r2 + r3);
}
__device__ __forceinline__ unsigned ordkey(float x) { const unsigned u = __builtin_bit_cast(unsigned, x); return (u & 0x80000000u) ? ~u : (u | 0x80000000u); }
#define RFL(x) __builtin_amdgcn_readfirstlane(x)
template <bool FINAL, bool ROUTE_EXT = false, bool SKIP_U = false>
__device__ __forceinline__ void peer_phase(const float* SC, const bf16_t* XB, const float* RSTD, const bf16_t* U16, const bf16_t* V16, const float* X1, float* XO, const float* fg,
                                           LAS unsigned char* lds, int wave0) {
    FRESH_TID(); FRESH_LDS(lds); FRESH_BID();
    LAS int* s_eid = (LAS int*)(lds + wave * 1024); LAS float* s_w = (LAS float*)(lds + wave * 1024 + 512);
    const int gw = bid * NWAVES + wave, NGW = G * NWAVES;
    const float NEG = -3.0e38f;
    for (int tok = gw; tok < M; tok += NGW) {
        const float* sc = SC + (size_t)tok * 2048;
        if (ROUTE_EXT) { const int* ee = (const int*)SC; const float* gg = (const float*)XB;     (void)ee; (void)gg; }
        for (int h = 0; h < (ROUTE_EXT ? 0 : 8); ++h) {
            float a0 = sc[h * 256 + lane], a1 = sc[h * 256 + 64 + lane], c0 = sc[h * 256 + 128 + lane], c1 = sc[h * 256 + 192 + lane];
            float v1 = 0.f, v2 = 0.f; int i1 = 0, i2 = 0;
            for (int it = 0; it < 16; ++it) {
                { const float m = wmax(fmaxf(a0, a1)); int cand = 1 << 30; if (a0 == m) cand = lane; else if (a1 == m) cand = lane + 64;
                  const int n = wmin_i(cand); if (n == lane) a0 = NEG; if (n == lane + 64) a1 = NEG; if (lane == it) { v1 = m; i1 = n; } }
                { const float m = wmax(fmaxf(c0, c1)); int cand = 1 << 30; if (c0 == m) cand = lane; else if (c1 == m) cand = lane + 64;
                  const int n = wmin_i(cand); if (n == lane) c0 = NEG; if (n == lane + 64) c1 = NEG; if (lane == it) { v2 = m; i2 = n; } }
            }
            float d0, d1, d2, d3;
            { const float va = __shfl(v1, lane >> 2); d0 = va + __shfl(v2, (lane & 3) * 4 + 0); d1 = va + __shfl(v2, (lane & 3) * 4 + 1); d2 = va + __shfl(v2, (lane & 3) * 4 + 2); d3 = va + __shfl(v2, (lane & 3) * 4 + 3); }
            float best = 0.f; int be = 0;
            for (int it = 0; it < 16; ++it) {
                const float m = wmax(fmaxf(fmaxf(d0, d1), fmaxf(d2, d3)));
                int cand = 1 << 30;
                if (d0 == m) cand = lane * 4; else if (d1 == m) cand = lane * 4 + 1; else if (d2 == m) cand = lane * 4 + 2; else if (d3 == m) cand = lane * 4 + 3;
                const int pos = wmin_i(cand);
                if (pos == lane * 4) d0 = NEG; if (pos == lane * 4 + 1) d1 = NEG; if (pos == lane * 4 + 2) d2 = NEG; if (pos == lane * 4 + 3) d3 = NEG;
                const int e = ((__shfl(i1, (pos >> 4) & 15) & 127) << 7) | (__shfl(i2, pos & 15) & 127);
                if (lane == it) { best = m; be = e; }
            }
            const float mx = __shfl(best, 0);
            const float p = lane < 16 ? __builtin_amdgcn_exp2f((best - mx) * 1.4426950408889634f) : 0.f;
            const float sm = wsum(p);
            if (lane < 16) { s_eid[h * 16 + lane] = be; s_w[h * 16 + lane] = p / sm; }
        }
        if (ROUTE_EXT) { const int* ee = (const int*)fg; const float* gg = (const float*)(ee + (size_t)M * 128); s_eid[lane] = ee[(size_t)tok * 128 + lane]; s_eid[lane + 64] = ee[(size_t)tok * 128 + lane + 64]; s_w[lane] = gg[(size_t)tok * 128 + lane]; s_w[lane + 64] = gg[(size_t)tok * 128 + lane + 64]; }
        LDS_WAIT(); asm volatile("" ::: "memory");
        if (!SKIP_U) {
            u32x4 xr[8];
            { const u32x4* p_ = (const u32x4*)(XB + (size_t)tok * D) + lane;
#pragma unroll
              for (int i = 0; i < 8; ++i) xr[i] = p_[64 * i]; }
            const float rstd = RSTD[tok];
#define LOADROW(dst, base, e) do { const u32x4* p_ = (const u32x4*)((base) + (size_t)(e) * D) + lane; _Pragma("unroll") for (int i_ = 0; i_ < 8; ++i_) dst[i_] = p_[64 * i_]; } while (0)
#define UDOT(row, j) do { float d_ = 0.f; _Pragma("unroll") for (int i_ = 0; i_ < 8; ++i_) { _Pragma("unroll") for (int k_ = 0; k_ < 4; ++k_) \
                { d_ = fmaf(bf_lo(xr[i_][k_]), bf_lo(row[i_][k_]), d_); d_ = fmaf(bf_hi(xr[i_][k_]), bf_hi(row[i_][k_]), d_); } } \
            d_ = wsum(d_) * rstd; const float ge_ = gelu_erf(d_); if (lane == 0) s_w[j] *= ge_; } while (0)
            u32x4 ra[8], rb[8];
            { const int e0 = RFL(s_eid[0]); LOADROW(ra, U16, e0); }
            for (int j = 0; j < 128; j += 2) {
                { const int e1 = RFL(s_eid[j + 1]); LOADROW(rb, U16, e1); }
                UDOT(ra, j);
                if (j + 2 < 128) { const int e2 = RFL(s_eid[j + 2]); LOADROW(ra, U16, e2); }
                UDOT(rb, j + 1);
            }
#undef UDOT
        }
        LDS_WAIT(); asm volatile("" ::: "memory");
        {
            float acc[8][8];
#pragma unroll
            for (int i = 0; i < 8; ++i)
#pragma unroll
                for (int k = 0; k < 8; ++k) acc[i][k] = 0.f;
#define VACC(row, j) do { const float w_ = s_w[j]; _Pragma("unroll") for (int i_ = 0; i_ < 8; ++i_) { _Pragma("unroll") for (int k_ = 0; k_ < 4; ++k_) { \
                acc[i_][2 * k_] = fmaf(w_, bf_lo(row[i_][k_]), acc[i_][2 * k_]); acc[i_][2 * k_ + 1] = fmaf(w_, bf_hi(row[i_][k_]), acc[i_][2 * k_ + 1]); } } } while (0)
            u32x4 ra[8], rb[8];
            { const int e0 = RFL(s_eid[0]); LOADROW(ra, V16, e0); }
            for (int j = 0; j < 128; j += 2) {
                { const int e1 = RFL(s_eid[j + 1]); LOADROW(rb, V16, e1); }
                VACC(ra, j);
                if (j + 2 < 128) { const int e2 = RFL(s_eid[j + 2]); LOADROW(ra, V16, e2); }
                VACC(rb, j + 1);
            }
#undef VACC
#undef LOADROW
            const float* x1 = X1 + (size_t)tok * D; float* xo = XO + (size_t)tok * D;
            float ss = 0.f;
#pragma unroll
            for (int i = 0; i < 8; ++i) { const int c = 512 * i + 8 * lane; const f32x4 p0 = *(const f32x4*)(x1 + c), p1 = *(const f32x4*)(x1 + c + 4);
                acc[i][0] += p0[0]; acc[i][1] += p0[1]; acc[i][2] += p0[2]; acc[i][3] += p0[3]; acc[i][4] += p1[0]; acc[i][5] += p1[1]; acc[i][6] += p1[2]; acc[i][7] += p1[3];
#pragma unroll
                for (int k = 0; k < 8; ++k) ss += acc[i][k] * acc[i][k]; }
            float rs = 1.f;
            if (FINAL) { ss = wsum(ss); rs = rsqrtf(ss * (1.0f / D) + 1e-6f); }
#pragma unroll
            for (int i = 0; i < 8; ++i) { const int c = 512 * i + 8 * lane; f32x4 o0, o1;
                if (FINAL) { const f32x4 g0 = *(const f32x4*)(fg + c), g1 = *(const f32x4*)(fg + c + 4);
                    o0 = (f32x4){acc[i][0] * rs * g0[0], acc[i][1] * rs * g0[1], acc[i][2] * rs * g0[2], acc[i][3] * rs * g0[3]}; o1 = (f32x4){acc[i][4] * rs * g1[0], acc[i][5] * rs * g1[1], acc[i][6] * rs * g1[2], acc[i][7] * rs * g1[3]}; }
                else { o0 = (f32x4){acc[i][0], acc[i][1], acc[i][2], acc[i][3]}; o1 = (f32x4){acc[i][4], acc[i][5], acc[i][6], acc[i][7]}; }
                *(f32x4*)(xo + c) = o0; *(f32x4*)(xo + c + 4) = o1; }
        }
        LDS_WAIT(); asm volatile("" ::: "memory");
    }
}

__device__ __forceinline__ void peer_u_phase(const float* SC, const unsigned char* U8, const float* X1, int* EIDG, float* WG, LAS unsigned char* lds, int wave0) {
    FRESH_TID(); FRESH_LDS(lds); FRESH_BID();
    LAS int* s_eid = (LAS int*)(lds + wave * 1024); LAS float* s_w = (LAS float*)(lds + wave * 1024 + 512);
    const int gw = bid * NWAVES + wave, NGW = G * NWAVES;
    const float NEG = -3.0e38f;
    for (int tok = gw; tok < M; tok += NGW) {
        float rstd_tok;
        { const float* xr_ = X1 + (size_t)tok * D; float ss_ = 0.f;
#pragma unroll
          for (int i = 0; i < 4; ++i)
#pragma unroll
              for (int q = 0; q < 4; ++q) { const f32x4 t = *(const f32x4*)(xr_ + 1024 * i + 16 * lane + 4 * q); ss_ += (t[0] * t[0] + t[1] * t[1]) + (t[2] * t[2] + t[3] * t[3]); }
          rstd_tok = rsqrtf(wave_sum_dpp(ss_) * (1.0f / D) + 1e-6f); }
        const float* sc = SC + (size_t)tok * 2048;
        for (int h = 0; h < 8; ++h) {
            const float a0 = sc[h * 256 + lane], a1 = sc[h * 256 + 64 + lane], c0 = sc[h * 256 + 128 + lane], c1 = sc[h * 256 + 192 + lane];
            unsigned ka0 = (ordkey(a0) & ~127u) | (unsigned)(127 - lane), ka1 = (ordkey(a1) & ~127u) | (unsigned)(63 - lane);
            unsigned kc0 = (ordkey(c0) & ~127u) | (unsigned)(127 - lane), kc1 = (ordkey(c1) & ~127u) | (unsigned)(63 - lane);
            float v1 = 0.f, v2 = 0.f; int i1 = 0, i2 = 0;
            for (int it = 0; it < 16; ++it) {
                const unsigned m1 = wave_max_u32(max(ka0, ka1)), m2 = wave_max_u32(max(kc0, kc1));
                const int n1 = 127 - (int)(m1 & 127u), n2 = 127 - (int)(m2 & 127u);
                const float x1lo = __builtin_bit_cast(float, __builtin_amdgcn_readlane(__builtin_bit_cast(int, a0), n1 & 63)), x1hi = __builtin_bit_cast(float, __builtin_amdgcn_readlane(__builtin_bit_cast(int, a1), n1 & 63));
                const float x2lo = __builtin_bit_cast(float, __builtin_amdgcn_readlane(__builtin_bit_cast(int, c0), n2 & 63)), x2hi = __builtin_bit_cast(float, __builtin_amdgcn_readlane(__builtin_bit_cast(int, c1), n2 & 63));
                ka0 = ka0 == m1 ? 0u : ka0; ka1 = ka1 == m1 ? 0u : ka1; kc0 = kc0 == m2 ? 0u : kc0; kc1 = kc1 == m2 ? 0u : kc1;
                if (lane == it) { v1 = (n1 & 64) ? x1hi : x1lo; i1 = n1; v2 = (n2 & 64) ? x2hi : x2lo; i2 = n2; }
            }
            unsigned kd0, kd1, kd2, kd3;
            { const float va = __shfl(v1, lane >> 2); const int pb_ = 255 - 4 * lane;
              kd0 = (ordkey(va + __shfl(v2, (lane & 3) * 4 + 0)) & ~255u) | (unsigned)(pb_); kd1 = (ordkey(va + __shfl(v2, (lane & 3) * 4 + 1)) & ~255u) | (unsigned)(pb_ - 1);
              kd2 = (ordkey(va + __shfl(v2, (lane & 3) * 4 + 2)) & ~255u) | (unsigned)(pb_ - 2); kd3 = (ordkey(va + __shfl(v2, (lane & 3) * 4 + 3)) & ~255u) | (unsigned)(pb_ - 3); }
            float best = 0.f; int be = 0;
            for (int it = 0; it < 16; ++it) {
                const unsigned m = wave_max_u32(max(max(kd0, kd1), max(kd2, kd3)));
                const int pos = 255 - (int)(m & 255u);
                const float bv = __builtin_bit_cast(float, __builtin_amdgcn_readlane(__builtin_bit_cast(int, v1), pos >> 4)) + __builtin_bit_cast(float, __builtin_amdgcn_readlane(__builtin_bit_cast(int, v2), pos & 15));
                const int e = (__builtin_amdgcn_readlane(i1, pos >> 4) << 7) | __builtin_amdgcn_readlane(i2, pos & 15);
                kd0 = kd0 == m ? 0u : kd0; kd1 = kd1 == m ? 0u : kd1; kd2 = kd2 == m ? 0u : kd2; kd3 = kd3 == m ? 0u : kd3;
                if (lane == it) { best = bv; be = e; }
            }
            const float mx = __builtin_bit_cast(float, __builtin_amdgcn_readlane(__builtin_bit_cast(int, best), 0));
            const float p = lane < 16 ? __builtin_amdgcn_exp2f((best - mx) * (1.4426950408889634f * rstd_tok)) : 0.f;
            const float sm = wave_sum_dpp(p);
            if (lane < 16) { s_eid[h * 16 + lane] = be; s_w[h * 16 + lane] = p / sm; }
        }
        LDS_WAIT(); asm volatile("" ::: "memory");
#define LOADROW8(dst, base, e) do { const u32x4* p_ = (const u32x4*)((base) + (size_t)(e) * D) + lane; _Pragma("unroll") for (int i_ = 0; i_ < 4; ++i_) dst[i_] = p_[64 * i_]; } while (0)
        const float* x1 = X1 + (size_t)tok * D;
        {
            float xv[4][16];
#pragma unroll
            for (int i = 0; i < 4; ++i)
#pragma unroll
                for (int q = 0; q < 4; ++q) { const f32x4 t = *(const f32x4*)(x1 + 1024 * i + 16 * lane + 4 * q); xv[i][4 * q] = t[0]; xv[i][4 * q + 1] = t[1]; xv[i][4 * q + 2] = t[2]; xv[i][4 * q + 3] = t[3]; }
            const float rstd = rstd_tok * US_INV;
#define UDOT8(row, j) do { float da_ = 0.f, db_ = 0.f; _Pragma("unroll") for (int i_ = 0; i_ < 4; ++i_) { _Pragma("unroll") for (int k_ = 0; k_ < 4; ++k_) { \
                unsigned w0_ = row[i_][k_]; asm volatile("" : "+v"(w0_));     \
                const f32x2 lo_ = __builtin_amdgcn_cvt_pk_f32_fp8((int)w0_, false), hi_ = __builtin_amdgcn_cvt_pk_f32_fp8((int)w0_, true); \
                da_ = fmaf(xv[i_][4 * k_], lo_[0], da_); db_ = fmaf(xv[i_][4 * k_ + 1], lo_[1], db_); da_ = fmaf(xv[i_][4 * k_ + 2], hi_[0], da_); db_ = fmaf(xv[i_][4 * k_ + 3], hi_[1], db_); } \
                asm volatile("" : "+v"(da_), "+v"(db_)); } \
            const float d_ = wave_sum_dpp(da_ + db_) * rstd; const float ge_ = gelu_erf(d_); if (lane == 0) s_w[j] *= ge_; } while (0)
            u32x4 r0[4], r1[4], r2[4];
            { const int e_ = RFL(s_eid[0]); LOADROW8(r0, U8, e_); } { const int e_ = RFL(s_eid[1]); LOADROW8(r1, U8, e_); } { const int e_ = RFL(s_eid[2]); LOADROW8(r2, U8, e_); }
            for (int j = 0; j < 126; j += 3) {
                UDOT8(r0, j);     if (j + 3 < 128) { const int e_ = RFL(s_eid[j + 3]); LOADROW8(r0, U8, e_); }
                UDOT8(r1, j + 1); if (j + 4 < 128) { const int e_ = RFL(s_eid[j + 4]); LOADROW8(r1, U8, e_); }
                UDOT8(r2, j + 2); if (j + 5 < 128) { const int e_ = RFL(s_eid[j + 5]); LOADROW8(r2, U8, e_); }
            }
            UDOT8(r0, 126); UDOT8(r1, 127);
#undef UDOT8
        }
        LDS_WAIT(); asm volatile("" ::: "memory");
        EIDG[(size_t)tok * 128 + lane] = s_eid[lane]; EIDG[(size_t)tok * 128 + 64 + lane] = s_eid[64 + lane];
        WG[(size_t)tok * 128 + lane] = s_w[lane]; WG[(size_t)tok * 128 + 64 + lane] = s_w[64 + lane];
        LDS_WAIT(); asm volatile("" ::: "memory");
    }
#undef LOADROW8
}

template <bool FINAL>
__device__ __forceinline__ void peer_v_phase(const int* EIDG, const float* WG, const unsigned char* V8, const float* X1, float* XO, const float* fg, LAS unsigned char* lds, int wave0) {
    FRESH_TID(); FRESH_LDS(lds); FRESH_BID();
    LAS int* s_eid = (LAS int*)(lds + wave * 1024); LAS float* s_w = (LAS float*)(lds + wave * 1024 + 512);
    const int gw = bid * NWAVES + wave, NGW = G * NWAVES;
    for (int tok = gw; tok < M; tok += NGW) {
        s_eid[lane] = EIDG[(size_t)tok * 128 + lane]; s_eid[64 + lane] = EIDG[(size_t)tok * 128 + 64 + lane];
        s_w[lane] = WG[(size_t)tok * 128 + lane]; s_w[64 + lane] = WG[(size_t)tok * 128 + 64 + lane];
        LDS_WAIT(); asm volatile("" ::: "memory");
#define LOADROW8(dst, base, e) do { const u32x4* p_ = (const u32x4*)((base) + (size_t)(e) * D) + lane; _Pragma("unroll") for (int i_ = 0; i_ < 4; ++i_) dst[i_] = p_[64 * i_]; } while (0)
        const float* x1 = X1 + (size_t)tok * D; float* xo = XO + (size_t)tok * D;
        {
            float acc[4][16];
#pragma unroll
            for (int i = 0; i < 4; ++i)
#pragma unroll
                for (int k = 0; k < 16; ++k) acc[i][k] = 0.f;
#define VACC8(row, j) do { const float w_ = s_w[j]; _Pragma("unroll") for (int i_ = 0; i_ < 4; ++i_) { _Pragma("unroll") for (int k_ = 0; k_ < 4; ++k_) { \
                unsigned w0_ = row[i_][k_]; asm volatile("" : "+v"(w0_)); \
                const f32x2 lo_ = __builtin_amdgcn_cvt_pk_f32_fp8((int)w0_, false), hi_ = __builtin_amdgcn_cvt_pk_f32_fp8((int)w0_, true); \
                acc[i_][4 * k_] = fmaf(w_, lo_[0], acc[i_][4 * k_]); acc[i_][4 * k_ + 1] = fmaf(w_, lo_[1], acc[i_][4 * k_ + 1]); acc[i_][4 * k_ + 2] = fmaf(w_, hi_[0], acc[i_][4 * k_ + 2]); acc[i_][4 * k_ + 3] = fmaf(w_, hi_[1], acc[i_][4 * k_ + 3]); } \
                asm volatile("" : "+v"(acc[i_][0]), "+v"(acc[i_][1]), "+v"(acc[i_][2]), "+v"(acc[i_][3]), "+v"(acc[i_][4]), "+v"(acc[i_][5]), "+v"(acc[i_][6]), "+v"(acc[i_][7]), \
                                  "+v"(acc[i_][8]), "+v"(acc[i_][9]), "+v"(acc[i_][10]), "+v"(acc[i_][11]), "+v"(acc[i_][12]), "+v"(acc[i_][13]), "+v"(acc[i_][14]), "+v"(acc[i_][15])); } } while (0)
            u32x4 r0[4], r1[4], r2[4];
            { const int e_ = RFL(s_eid[0]); LOADROW8(r0, V8, e_); } { const int e_ = RFL(s_eid[1]); LOADROW8(r1, V8, e_); } { const int e_ = RFL(s_eid[2]); LOADROW8(r2, V8, e_); }
            for (int j = 0; j < 126; j += 3) {
                VACC8(r0, j);     if (j + 3 < 128) { const int e_ = RFL(s_eid[j + 3]); LOADROW8(r0, V8, e_); }
                VACC8(r1, j + 1); if (j + 4 < 128) { const int e_ = RFL(s_eid[j + 4]); LOADROW8(r1, V8, e_); }
                VACC8(r2, j + 2); if (j + 5 < 128) { const int e_ = RFL(s_eid[j + 5]); LOADROW8(r2, V8, e_); }
            }
            VACC8(r0, 126); VACC8(r1, 127);
#undef VACC8
#undef LOADROW8
            float ss = 0.f;
#pragma unroll
            for (int i = 0; i < 4; ++i)
#pragma unroll
                for (int q = 0; q < 4; ++q) { const f32x4 t = *(const f32x4*)(x1 + 1024 * i + 16 * lane + 4 * q);
#pragma unroll
                    for (int k = 0; k < 4; ++k) { acc[i][4 * q + k] = fmaf(acc[i][4 * q + k], VS_INV, t[k]); ss += acc[i][4 * q + k] * acc[i][4 * q + k]; } }
            float rs = 1.f;
            if (FINAL) { ss = wsum(ss); rs = rsqrtf(ss * (1.0f / D) + 1e-6f); }
#pragma unroll
            for (int i = 0; i < 4; ++i)
#pragma unroll
                for (int q = 0; q < 4; ++q) { const int c = 1024 * i + 16 * lane + 4 * q; f32x4 o_;
                    if (FINAL) { const f32x4 g_ = *(const f32x4*)(fg + c); o_ = (f32x4){acc[i][4 * q] * rs * g_[0], acc[i][4 * q + 1] * rs * g_[1], acc[i][4 * q + 2] * rs * g_[2], acc[i][4 * q + 3] * rs * g_[3]}; }
                    else o_ = (f32x4){acc[i][4 * q], acc[i][4 * q + 1], acc[i][4 * q + 2], acc[i][4 * q + 3]};
                    *(f32x4*)(xo + c) = o_; }
        }
        LDS_WAIT(); asm volatile("" ::: "memory");
    }
}
}
namespace at {
using namespace mk;
constexpr int QB = 256, KVB = 64, HD = 128;
constexpr int SHM_V = KVB * HD * 2, SHM_K = KVB * HD * 2;
constexpr int OFF_V = 0, OFF_K = 2 * SHM_V, OFF_WS = OFF_K + 2 * SHM_K, OFF_CUM = OFF_WS + 8 * 256, OFF_RT = OFF_CUM + 2048 * 4, OFF_MISC = OFF_RT + 640 * 4;
constexpr float LOG2E = 1.4426950408889634f;
constexpr float THR2 = 10.0f;
constexpr float SB_DONE = -100.0f;

#define AT_KSWZ(row, colB) ((row) * 256 + ((colB) ^ (((row) & 7) << 4)))
__device__ __forceinline__ int v_st(int k, int c) { const int kk = (k & ~0xC) | ((k & 4) << 1) | ((k & 8) >> 1); return ((kk >> 3) * 4 + (c >> 5)) * 512 + ((kk & 7) * 32 + (c & 31)) * 2; }
__device__ __forceinline__ int v_rd_base(int lane) { return ((lane & 3) << 3) | (((lane >> 2) & 3) << 6) | (((lane >> 4) & 1) << 5) | (((lane >> 5) & 1) << 8); }
constexpr int v_rd_off(int d0, int ks, int half) { return d0 * 512 + ks * 4096 + half * 2048; }
__device__ __forceinline__ int crow(int r, int hi) { return (r & 3) + 8 * (r >> 2) + 4 * hi; }
__device__ __forceinline__ unsigned cvtpk(float lo, float hi) { unsigned r; asm volatile("v_cvt_pk_bf16_f32 %0, %1, %2" : "=v"(r) : "v"(lo), "v"(hi)); return r; }
__device__ __forceinline__ float partner(float v, int hi) { auto rr = __builtin_amdgcn_permlane32_swap(__builtin_bit_cast(unsigned, v), __builtin_bit_cast(unsigned, v), false, false); return __builtin_bit_cast(float, hi ? rr[0] : rr[1]); }

__device__ __forceinline__ float xchg_max(float v, int hi) { return fmaxf(v, partner(v, hi)); }
__device__ __forceinline__ float xchg_sum(float v, int hi) { return v + partner(v, hi); }

__device__ __forceinline__ void pack_p(const f32x16& p0, const f32x16& p1, bf16x8& pa0, bf16x8& pa1, bf16x8& pa2, bf16x8& pa3) {
#define AT_PK4(P, B_, OUT) do { unsigned a0 = cvtpk(P[B_ + 0], P[B_ + 1]), a1 = cvtpk(P[B_ + 2], P[B_ + 3]); unsigned b0 = cvtpk(P[B_ + 4], P[B_ + 5]), b1 = cvtpk(P[B_ + 6], P[B_ + 7]); \
        auto r0 = __builtin_amdgcn_permlane32_swap(a0, b0, false, false); auto r1 = __builtin_amdgcn_permlane32_swap(a1, b1, false, false); \
        u32x4 w = {r0[0], r1[0], r0[1], r1[1]}; OUT = __builtin_bit_cast(bf16x8, w); } while (0)
    AT_PK4(p0, 0, pa0); AT_PK4(p0, 8, pa1); AT_PK4(p1, 0, pa2); AT_PK4(p1, 8, pa3);
#undef AT_PK4
}
template <int KBUF>
__device__ __forceinline__ void qkt(f32x16& p0, f32x16& p1, LAS unsigned char* K_lds, int r32, int hi, const bf16x8 (&qr)[8]) {
    p0 = f32x16{}; p1 = f32x16{};
    LAS unsigned char* kb[4];
#pragma unroll
    for (int dd = 0; dd < 4; ++dd) kb[dd] = K_lds + KBUF * SHM_K + AT_KSWZ(r32, (dd * 16 + hi * 8) * 2);
#pragma unroll
    for (int d0 = 0; d0 < 8; ++d0) { LAS unsigned char* a = kb[d0 & 3] + (d0 >> 2) * 128;
        const bf16x8 b0 = *(const LAS bf16x8*)a; const bf16x8 b1 = *(const LAS bf16x8*)(a + 32 * 256);
        p0 = __builtin_amdgcn_mfma_f32_32x32x16_bf16(b0, qr[d0], p0, 0, 0, 0);
        p1 = __builtin_amdgcn_mfma_f32_32x32x16_bf16(b1, qr[d0], p1, 0, 0, 0); }
}
template <int VBUF>
__device__ __forceinline__ void pv_tile(f32x16 (&o)[4], int vb0, bf16x8 pa0, bf16x8 pa1, bf16x8 pa2, bf16x8 pa3) {
#define AT_TRRD(dst, off) asm volatile("ds_read_b64_tr_b16 %0, %1 offset:%2" : "=&v"(dst) : "v"(vb0), "i"(off) : "memory")
#define AT_PV_D0(d0) do { s16x4 l0, l1, l2, l3, h0, h1, h2, h3; constexpr int b_ = VBUF * SHM_V + v_rd_off(d0, 0, 0); \
        AT_TRRD(l0, b_); AT_TRRD(h0, b_ + 2048); AT_TRRD(l1, b_ + 4096); AT_TRRD(h1, b_ + 6144); AT_TRRD(l2, b_ + 8192); AT_TRRD(h2, b_ + 10240); AT_TRRD(l3, b_ + 12288); AT_TRRD(h3, b_ + 14336); \
        asm volatile("s_waitcnt lgkmcnt(0)" ::: "memory"); __builtin_amdgcn_sched_barrier(0); \
        o[d0] = __builtin_amdgcn_mfma_f32_32x32x16_bf16(pa0, (bf16x8){l0[0], l0[1], l0[2], l0[3], h0[0], h0[1], h0[2], h0[3]}, o[d0], 0, 0, 0); \
        o[d0] = __builtin_amdgcn_mfma_f32_32x32x16_bf16(pa1, (bf16x8){l1[0], l1[1], l1[2], l1[3], h1[0], h1[1], h1[2], h1[3]}, o[d0], 0, 0, 0); \
        o[d0] = __builtin_amdgcn_mfma_f32_32x32x16_bf16(pa2, (bf16x8){l2[0], l2[1], l2[2], l2[3], h2[0], h2[1], h2[2], h2[3]}, o[d0], 0, 0, 0); \
        o[d0] = __builtin_amdgcn_mfma_f32_32x32x16_bf16(pa3, (bf16x8){l3[0], l3[1], l3[2], l3[3], h3[0], h3[1], h3[2], h3[3]}, o[d0], 0, 0, 0); } while (0)
    AT_PV_D0(0); AT_PV_D0(1); AT_PV_D0(2); AT_PV_D0(3);
#undef AT_PV_D0
#undef AT_TRRD
}

template <int VAR>
__device__ __forceinline__ void attn_item(const bf16_t* Qh, const bf16_t* Kh, const bf16_t* Vh, bf16_t* OB, const float* relb, const float* LOGF, int b, int h, int qb, LAS unsigned char* lds, int tid) {
    const int wid = __builtin_amdgcn_readfirstlane(tid >> 6), lane = tid & 63, r32 = lane & 31, hi = lane >> 5;
    const int g = VAR == 0 ? h : (VAR == 1 ? 12 + h : 22 + h);
    const size_t hb = (size_t)(b * NH + g) * S * HD;
    const bf16_t* Kp = Kh + hb; const bf16_t* Vp = Vh + hb;
    LAS unsigned char* V_lds = lds + OFF_V; LAS unsigned char* K_lds = lds + OFF_K;
    LAS float* wsf = (LAS float*)(lds + OFF_WS) + wid * 64; LAS float* li_l = wsf; LAS float* al_l = wsf + 32;
    LAS float* cumL = (LAS float*)(lds + OFF_CUM); LAS float* Rt = (LAS float*)(lds + OFF_RT); volatile LAS unsigned* flags = (volatile LAS unsigned*)(lds + OFF_MISC);
    const int P0 = qb * QB, qlo = P0 + wid * 32, qpos = qlo + r32;
    int NT, jlo = 0;
    if (VAR == 0) { jlo = 4 * qb - 8; if (jlo < 0) jlo = 0; NT = 4 * qb + 4 - jlo; } else NT = 4 * qb + 4;
    const int cw = 4 * qb + (wid >> 1);
#define AT_KBASE(t) (VAR == 1 ? (4 * qb + 3 - (t)) * KVB : (jlo + (t)) * KVB)
#define AT_ACT(t) (VAR == 0 ? ((jlo + (t)) >= cw - 8 && (jlo + (t)) <= cw) : (VAR == 1 ? (AT_KBASE(t) <= qlo + 30) : (AT_KBASE(t) <= qlo + 31)))
    if (VAR == 0) {
        const float* tab = relb + h * 257;
        for (int j = tid; j < 639; j += 512) { int rel = 575 - j; rel = rel < -128 ? -128 : (rel > 128 ? 128 : rel); Rt[j] = tab[rel + 128] * LOG2E; }
    }
    if (VAR == 2) {
        const float* lf = LOGF + (size_t)(b * 10 + h) * S; const int kend = P0 + QB;
        f32x4 v = (f32x4){0.f, 0.f, 0.f, 0.f};
        if (4 * tid < kend) v = *(const f32x4*)(lf + 4 * tid);
        v[1] += v[0]; v[2] += v[1]; v[3] += v[2];
        float tot = v[3];
#pragma unroll
        for (int o = 1; o < 64; o <<= 1) { const float t_ = __shfl_up(tot, o); if (lane >= o) tot += t_; }
        if (lane == 63) li_l[0] = tot;
        __syncthreads();
        float base = tot - v[3];
        for (int w = 0; w < wid; ++w) base += ((LAS float*)(lds + OFF_WS))[w * 64];
        if (4 * tid < kend) *(LAS f32x4*)(cumL + 4 * tid) = (f32x4){(base + v[0]) * LOG2E, (base + v[1]) * LOG2E, (base + v[2]) * LOG2E, (base + v[3]) * LOG2E};
    }
    bf16x8 qr[8];
    { const bf16_t* qp = Qh + hb + (size_t)(qlo + r32) * HD + hi * 8;
#pragma unroll
      for (int d0 = 0; d0 < 8; ++d0) qr[d0] = *(const bf16x8*)(qp + d0 * 16); }
    const int sr = tid >> 4, sc = (tid & 15) * 8, vst0 = v_st(sr, sc), vst1 = v_st(32 + sr, sc), kws = AT_KSWZ(sr, sc * 2);
    const int vb0 = (int)(unsigned)(size_t)V_lds + v_rd_base(lane);
    bf16x8 st_k0, st_k1, st_v0, st_v1;
#define AT_SLOAD(k0) do { const bf16_t* kp_ = Kp + (size_t)((k0) + sr) * HD + sc; const bf16_t* vp_ = Vp + (size_t)((k0) + sr) * HD + sc; \
        st_k0 = *(const bf16x8*)kp_; st_k1 = *(const bf16x8*)(kp_ + 32 * HD); st_v0 = *(const bf16x8*)vp_; st_v1 = *(const bf16x8*)(vp_ + 32 * HD); } while (0)
#define AT_SWRITE(bf) do { *(LAS bf16x8*)(K_lds + (bf) * SHM_K + kws) = st_k0; *(LAS bf16x8*)(K_lds + (bf) * SHM_K + kws + 32 * 256) = st_k1; \
        *(LAS bf16x8*)(V_lds + (bf) * SHM_V + vst0) = st_v0; *(LAS bf16x8*)(V_lds + (bf) * SHM_V + vst1) = st_v1; } while (0)
    AT_SLOAD(AT_KBASE(0)); asm volatile("s_waitcnt vmcnt(0)" ::: "memory"); AT_SWRITE(0);
    __syncthreads();
    float m_reg = -1e30f, l_reg = 0.f, carry = 0.f;
    f32x16 o[4] = {};
#define AT_STEP(BUF, t) do { \
        const bool more_ = (t) + 1 < NT; \
        if (more_) AT_SLOAD(AT_KBASE((t) + 1)); \
        if (AT_ACT(t)) { \
            const int kb_ = AT_KBASE(t); f32x16 p0, p1; bf16x8 pa0, pa1, pa2, pa3; \
            qkt<BUF>(p0, p1, K_lds, r32, hi, qr); \
            tile_math(p0, p1, kb_, pa0, pa1, pa2, pa3); \
            pv_tile<BUF>(o, vb0, pa0, pa1, pa2, pa3); \
        } \
        if (more_) { asm volatile("s_waitcnt vmcnt(0)" ::: "memory"); AT_SWRITE((BUF) ^ 1); } \
        if (VAR == 1) { const bool done_ = __all(carry < SB_DONE); if (lane == 0) flags[((t) & 1) * 8 + wid] = done_ ? 1u : 0u; } \
        __syncthreads(); \
    } while (0)
    auto tile_math = [&](f32x16& p0, f32x16& p1, int kb, bf16x8& pa0, bf16x8& pa1, bf16x8& pa2, bf16x8& pa3) __attribute__((always_inline)) {
        const int dq = qpos - kb - 4 * hi;
        if (VAR == 1) {
            const bool need_mask = kb + 63 >= qlo;
            f32x16 n0, n1;
#pragma unroll
            for (int r = 0; r < 16; ++r) { const float z = p0[r]; const float lp = __builtin_amdgcn_logf(1.0f + __builtin_amdgcn_exp2f(-fabsf(z))); n0[r] = fminf(-z, 0.f) - lp;
                                           const float y = p1[r]; const float lq = __builtin_amdgcn_logf(1.0f + __builtin_amdgcn_exp2f(-fabsf(y))); n1[r] = fminf(-y, 0.f) - lq; }
            if (need_mask) {
#pragma unroll
                for (int r = 0; r < 16; ++r) { const int c = (r & 3) + 8 * (r >> 2);
                    if (dq - c <= 0) { n0[r] = 0.f; p0[r] = -__builtin_inff(); }
                    if (dq - c - 32 <= 0) { n1[r] = 0.f; p1[r] = -__builtin_inff(); } }
            }
            float A[8], Bp[8];
#pragma unroll
            for (int q = 0; q < 4; ++q) { A[q] = (n0[4 * q] + n0[4 * q + 1]) + (n0[4 * q + 2] + n0[4 * q + 3]); A[4 + q] = (n1[4 * q] + n1[4 * q + 1]) + (n1[4 * q + 2] + n1[4 * q + 3]); }
#pragma unroll
            for (int q = 0; q < 8; ++q) Bp[q] = partner(A[q], hi);
            float st = 0.f;
#pragma unroll
            for (int q = 7; q >= 0; --q) {
                const float after = carry + st + (hi == 0 ? Bp[q] : 0.f);
                if (q >= 4) { const int r0 = 4 * (q - 4);
                    float tl = after; p1[r0 + 3] = __builtin_amdgcn_exp2f(p1[r0 + 3] + n1[r0 + 3] + tl); tl += n1[r0 + 3]; p1[r0 + 2] = __builtin_amdgcn_exp2f(p1[r0 + 2] + n1[r0 + 2] + tl); tl += n1[r0 + 2];
                    p1[r0 + 1] = __builtin_amdgcn_exp2f(p1[r0 + 1] + n1[r0 + 1] + tl); tl += n1[r0 + 1]; p1[r0] = __builtin_amdgcn_exp2f(p1[r0] + n1[r0] + tl); }
                else { const int r0 = 4 * q;
                    float tl = after; p0[r0 + 3] = __builtin_amdgcn_exp2f(p0[r0 + 3] + n0[r0 + 3] + tl); tl += n0[r0 + 3]; p0[r0 + 2] = __builtin_amdgcn_exp2f(p0[r0 + 2] + n0[r0 + 2] + tl); tl += n0[r0 + 2];
                    p0[r0 + 1] = __builtin_amdgcn_exp2f(p0[r0 + 1] + n0[r0 + 1] + tl); tl += n0[r0 + 1]; p0[r0] = __builtin_amdgcn_exp2f(p0[r0] + n0[r0] + tl); }
                st += A[q] + Bp[q];
            }
            carry += st;
            pack_p(p0, p1, pa0, pa1, pa2, pa3);
        } else {
            if (VAR == 0) {
                const LAS float* rp = Rt + (575 - (qpos - kb) + 4 * hi);
#pragma unroll
                for (int r = 0; r < 16; ++r) { const int c = (r & 3) + 8 * (r >> 2); p0[r] += rp[c]; p1[r] += rp[c + 32]; }
            } else {
                const LAS float* cp = cumL + kb + 4 * hi;
#pragma unroll
                for (int q = 0; q < 4; ++q) { const f32x4 c0 = *(const LAS f32x4*)(cp + 8 * q), c1 = *(const LAS f32x4*)(cp + 32 + 8 * q);
                    p0[4 * q] -= c0[0]; p0[4 * q + 1] -= c0[1]; p0[4 * q + 2] -= c0[2]; p0[4 * q + 3] -= c0[3];
                    p1[4 * q] -= c1[0]; p1[4 * q + 1] -= c1[1]; p1[4 * q + 2] -= c1[2]; p1[4 * q + 3] -= c1[3]; }
                if (kb + 63 > qlo) {
#pragma unroll
                    for (int r = 0; r < 16; ++r) { const int c = (r & 3) + 8 * (r >> 2);
                        if (dq - c < 0) p0[r] = -__builtin_inff();
                        if (dq - c - 32 < 0) p1[r] = -__builtin_inff(); }
                }
            }
            float pmax = p0[0];
#pragma unroll
            for (int r = 1; r < 16; ++r) pmax = fmaxf(pmax, p0[r]);
#pragma unroll
            for (int r = 0; r < 16; ++r) pmax = fmaxf(pmax, p1[r]);
            pmax = xchg_max(pmax, hi);
            float mn, alpha;
            if (__all(pmax - m_reg <= THR2)) { mn = m_reg; alpha = 1.f; }
            else { mn = fmaxf(m_reg, pmax); alpha = __builtin_amdgcn_exp2f(m_reg - mn); m_reg = mn; }
            float ps = 0.f;
#pragma unroll
            for (int r = 0; r < 16; ++r) { p0[r] = __builtin_amdgcn_exp2f(p0[r] - mn); p1[r] = __builtin_amdgcn_exp2f(p1[r] - mn); ps += p0[r] + p1[r]; }
            ps = xchg_sum(ps, hi);
            l_reg = l_reg * alpha + ps;
            if (__any(alpha < 1.f)) {
                if (hi == 0) al_l[r32] = alpha;
                asm volatile("s_waitcnt lgkmcnt(0)" ::: "memory");
                float av[16];
#pragma unroll
                for (int r = 0; r < 16; ++r) av[r] = al_l[crow(r, hi)];
#pragma unroll
                for (int d = 0; d < 4; ++d)
#pragma unroll
                    for (int r = 0; r < 16; ++r) o[d][r] *= av[r];
            }
            pack_p(p0, p1, pa0, pa1, pa2, pa3);
        }
    };
    for (int t = 0; t < NT; t += 2) {
        AT_STEP(0, t);
        if (VAR == 1) { unsigned all_ = 1u; for (int w = 0; w < 8; ++w) all_ &= flags[(t & 1) * 8 + w]; if (all_) break; }
        if (t + 1 >= NT) break;
        AT_STEP(1, t + 1);
        if (VAR == 1) { unsigned all_ = 1u; for (int w = 0; w < 8; ++w) all_ &= flags[((t + 1) & 1) * 8 + w]; if (all_) break; }
    }
    float rli[16];
    if (VAR != 1) {
        if (hi == 0) li_l[r32] = l_reg;
        asm volatile("s_waitcnt lgkmcnt(0)" ::: "memory");
#pragma unroll
        for (int r = 0; r < 16; ++r) rli[r] = __builtin_amdgcn_rcpf(li_l[crow(r, hi)]);
    }
    unsigned char* Ow8 = (unsigned char*)OB + (size_t)(b * S + qlo) * D + g * HD;
#pragma unroll
    for (int r = 0; r < 16; ++r) { const int orow = crow(r, hi);
#pragma unroll
        for (int d0 = 0; d0 < 4; ++d0) { const float v = VAR != 1 ? o[d0][r] * rli[r] : o[d0][r];
            const float vn = __shfl_xor(v, 1);
            if ((r32 & 1) == 0) *(unsigned short*)(Ow8 + (size_t)orow * D + d0 * 32 + r32) = (unsigned short)__builtin_amdgcn_cvt_pk_fp8_f32(clamp8(v * 16.0f), clamp8(vn * 16.0f), 0, false); } }
    __syncthreads();
#undef AT_STEP
#undef AT_SLOAD
#undef AT_SWRITE
#undef AT_KBASE
#undef AT_ACT
}

template <int VAR>
__device__ __forceinline__ void attn_queue(const bf16_t* Qh, const bf16_t* Kh, const bf16_t* Vh, bf16_t* OB, const float* relb, const float* LOGF, unsigned* qhead, LAS unsigned char* lds, int wave0) {
    FRESH_TID(); FRESH_LDS(lds);
    volatile LAS unsigned* qslot = (volatile LAS unsigned*)(lds + OFF_MISC) + 32;
    constexpr int NHV = VAR == 0 ? 12 : 10, NITEMS = 8 * NHV * 8;
    for (;;) {
        if (tid == 0) qslot[0] = __hip_atomic_fetch_add(qhead, 1u, __ATOMIC_RELAXED, __HIP_MEMORY_SCOPE_AGENT);
        __syncthreads();
        const int idx = (int)qslot[0];
        __syncthreads();
        if (idx >= NITEMS) break;
        const int qb = 7 - idx / (8 * NHV), bh = idx % (8 * NHV);
        attn_item<VAR>(Qh, Kh, Vh, OB, relb, LOGF, bh / NHV, bh % NHV, qb, lds, tid);
    }
}
__device__ __forceinline__ void attn_phase(const bf16_t* Qh, const bf16_t* Kh, const bf16_t* Vh, bf16_t* OB, const float* relb, const float* LOGF, unsigned* qheads, LAS unsigned char* lds, int wave0) {
    attn_queue<2>(Qh, Kh, Vh, OB, relb, LOGF, qheads + 0, lds, wave0);
    attn_queue<0>(Qh, Kh, Vh, OB, relb, LOGF, qheads + 64, lds, wave0);
    attn_queue<1>(Qh, Kh, Vh, OB, relb, LOGF, qheads + 128, lds, wave0);
}
}
namespace mk {
#define XB_TMO      128
#define XB_XCNT(j)  (256  + 64 * (j))
#define XB_XSUB(j)  (1280 + 64 * (j))
#define XB_XGEN(j)  (2304 + 64 * (j))
#define XB_TOP      3328
#define XB_TOPGEN   3392
#define XCD_BAR_WORDS 3456
#define XB_SPIN_CAP (1u << 22)

__device__ __forceinline__ unsigned xb_ld(unsigned* p)              { return __hip_atomic_load(p, __ATOMIC_RELAXED, __HIP_MEMORY_SCOPE_AGENT); }
__device__ __forceinline__ unsigned xb_add(unsigned* p, unsigned v) { return __hip_atomic_fetch_add(p, v, __ATOMIC_RELAXED, __HIP_MEMORY_SCOPE_AGENT); }
__device__ __forceinline__ unsigned xb_xcc_id() { return (unsigned)__builtin_amdgcn_s_getreg((3 << 11) | 20) & 0xFu; }
#define XB_SPIN(cond, bar) do { unsigned _sp = 0; while (cond) { __builtin_amdgcn_s_sleep(1); \
    if ((++_sp & 255u) == 0u) { if (xb_ld(&(bar)[XB_TMO])) break; if (_sp > XB_SPIN_CAP) { atomicAdd(&(bar)[XB_TMO], 1u); break; } } } } while (0)

struct XcdBarrier {
    unsigned* bar; unsigned x;
    volatile LAS unsigned* st;
};

__device__ __forceinline__ XcdBarrier xcd_barrier_post(unsigned* bar, volatile LAS unsigned* st, bool is_t0) {
    XcdBarrier b; b.bar = bar; b.x = xb_xcc_id(); b.st = st;
    if (is_t0) (void)xb_add(&bar[XB_XCNT(b.x)], 1u);
    return b;
}
__device__ __forceinline__ void xcd_barrier_complete(unsigned* bar, unsigned x, unsigned& nloc, unsigned& nx) {
    const unsigned G = gridDim.x * gridDim.y * gridDim.z;
    unsigned sum, cnt, mine, sp = 0u;
    for (;;) {
        sum = 0u; cnt = 0u; mine = 0u;
#pragma unroll
        for (unsigned j = 0; j < 16; ++j) { const unsigned c = xb_ld(&bar[XB_XCNT(j)]); sum += c; cnt += (c > 0u) ? 1u : 0u; mine = (j == x) ? c : mine; }
        if (sum == G) break;
        __builtin_amdgcn_s_sleep(1);
        if ((++sp & 255u) == 0u) { if (xb_ld(&bar[XB_TMO])) break; if (sp > XB_SPIN_CAP) { atomicAdd(&bar[XB_TMO], 1u); break; } }
    }
    nloc = mine > 0u ? mine : 1u; nx = cnt > 0u ? cnt : 1u;
}

__device__ __forceinline__ void xcd_barrier(const XcdBarrier& b, bool is_t0) {
    asm volatile("s_waitcnt vmcnt(0)" ::: "memory");
    __syncthreads();
    if (is_t0) {
        unsigned* bar = b.bar;
        __builtin_amdgcn_s_waitcnt(0);
        unsigned nloc = b.st[0], nx = b.st[1];
        if (nloc == 0u) { xcd_barrier_complete(bar, b.x, nloc, nx); b.st[0] = nloc; b.st[1] = nx; }
        const unsigned old = xb_add(&bar[XB_XSUB(b.x)], 1u);
        const unsigned gen = old / nloc;
        if (old + 1u == (gen + 1u) * nloc) {
            __builtin_amdgcn_fence(__ATOMIC_RELEASE, "agent");
            asm volatile("s_waitcnt vmcnt(0)" ::: "memory");
            const unsigned og = xb_add(&bar[XB_TOP], 1u);
            const unsigned tg = og / nx;
            if (og + 1u == (tg + 1u) * nx) xb_add(&bar[XB_TOPGEN], 1u);
            else XB_SPIN(xb_ld(&bar[XB_TOPGEN]) == tg, bar);
            __builtin_amdgcn_fence(__ATOMIC_ACQUIRE, "agent");
            xb_add(&bar[XB_XGEN(b.x)], 1u);
            asm volatile("s_waitcnt vmcnt(0)" ::: "memory");
        } else {
            XB_SPIN(xb_ld(&bar[XB_XGEN(b.x)]) == gen, bar);
            __builtin_amdgcn_fence(__ATOMIC_ACQUIRE, "agent");
            asm volatile("s_waitcnt vmcnt(0)" ::: "memory");
        }
    }
    __syncthreads();
}

constexpr int PH_PER_LAYER = 8;
typedef const __attribute__((address_space(4))) Args* KArgs;
#define KARGS() ({ KArgs p_ = (KArgs)__builtin_amdgcn_kernarg_segment_ptr(); asm volatile("" : "+s"(p_)); p_; })
#define GRID_BAR() do { KArgs k_ = KARGS(); XcdBarrier b_; b_.bar = (unsigned*)(k_->ws + WS_CTL) + CW_BAR; b_.x = xb_xcc_id(); b_.st = (volatile LAS unsigned*)(lds + MISC_OFF) + 8; const bool t0_ = (wave0 == 0) && (__builtin_amdgcn_mbcnt_hi(~0u, __builtin_amdgcn_mbcnt_lo(~0u, 0u)) == 0u); xcd_barrier(b_, t0_); } while (0)
__global__ void __launch_bounds__(NWAVES * 64, 2) mk_fwd(Args a_unused) {
    extern __shared__ __attribute__((aligned(16))) unsigned char lds_raw[];
    LAS unsigned char* lds = (LAS unsigned char*)lds_raw;
    const int wave0 = __builtin_amdgcn_readfirstlane((int)threadIdx.x >> 6);
    for (int u = threadIdx.x; u < (LDS_BYTES - LDSCTL_OFF) / 4; u += NWAVES * 64) ((LAS unsigned*)(lds + LDSCTL_OFF))[u] = 0u;
    __syncthreads();
    int lo, hi;
    { KArgs k = KARGS(); lo = k->ph_lo; hi = k->ph_hi;
      if (hi - lo > 1) (void)xcd_barrier_post((unsigned*)(k->ws + WS_CTL) + CW_BAR, (volatile LAS unsigned*)(lds + MISC_OFF) + 8, threadIdx.x == 0); }
#define IN(k) (lo <= (k) && (k) < hi)
#define BOTH(k) (IN(k) && IN((k) + 1))
#pragma unroll
    for (int l = 0; l < 2; ++l) {
        const int pb = PH_PER_LAYER * l;
        if (IN(pb + 0)) { KArgs k = KARGS(); conv_phase(k, l, lds, wave0); }
        if (IN(pb + 1)) {
            KArgs k = KARGS(); unsigned char* ws = k->ws;
            const float* xin = l == 0 ? k->in[0] : (const float*)(ws + WS_X2);
            prep_phase<true>(xin, (bf16_t*)(ws + WS_XB), (float*)(ws + WS_RSTD), k->in[2] + (size_t)l * D * PW, k->in[1] + (size_t)l * D, k->in[3] + l * 10, (float*)(ws + WS_LOGF), lds, wave0);
            if (BOTH(pb + 1)) GRID_BAR();
        }
        if (IN(pb + 2)) {
            KArgs k = KARGS(); unsigned char* ws = k->ws;
            pg8::Gemm g{(const bf16_t*)(ws + WS_XB), (const bf16_t*)(ws + WS_WIN), M, 12288, D}; pg8::StaticOrder So; FRESH_BID(); So.init(M, 12288, G, bid);
            pg8::EpiQKV4 E{(bf16_t*)(ws + WS_Q), (const float*)(ws + WS_RSTD), 0.08838834764831845f * 1.4426950408889634f, US_INV};
            { LAS unsigned char* lds_ = lds; FRESH_LDS(lds_); FRESH_TID(); pg8::gemm_phase<pg8::EpiQKV4, pg8::StaticOrder, true, true, true>(lds_, g, So, E, tid); }
            if (BOTH(pb + 2)) GRID_BAR();
        }
        if (IN(pb + 3)) {
            KArgs k = KARGS(); unsigned char* ws = k->ws;
            at::attn_phase((const bf16_t*)(ws + WS_Q), (const bf16_t*)(ws + WS_K), (const bf16_t*)(ws + WS_V), (bf16_t*)(ws + WS_OB), k->in[4] + (size_t)l * 12 * 257, (const float*)(ws + WS_LOGF),
                           (unsigned*)(ws + WS_CTL) + CW_QUEUE + 256 * l, lds, wave0);
            if (BOTH(pb + 3)) GRID_BAR();
        }
        if (IN(pb + 4)) {
            KArgs k = KARGS(); unsigned char* ws = k->ws;
            const float* xin = l == 0 ? k->in[0] : (const float*)(ws + WS_X2);
            pg8::Gemm g{(const bf16_t*)(ws + WS_OB), (const bf16_t*)(ws + WS_WOUT), M, D, D}; pg8::StaticOrder So; FRESH_BID(); So.init(M, D, G, bid);
            pg8::EpiResidF32 E{xin, k->out, US_INV * (1.0f / 16.0f), (bf16_t*)(ws + WS_XB)};
            { LAS unsigned char* lds_ = lds; FRESH_LDS(lds_); FRESH_TID(); pg8::gemm_phase<pg8::EpiResidF32, pg8::StaticOrder, true, true, true>(lds_, g, So, E, tid); }
            if (BOTH(pb + 4)) GRID_BAR();
        }
        if (IN(pb + 5)) {
            KArgs k = KARGS(); unsigned char* ws = k->ws;
            pg8::Gemm g{(const bf16_t*)(ws + WS_XB), (const bf16_t*)(ws + WS_WQK), M, 2048, D}; pg8::StaticOrder So; FRESH_BID(); So.init(M, 2048, G, bid);
            pg8::EpiPlainF32<2048> E{(float*)(ws + WS_SC)};
            { LAS unsigned char* lds_ = lds; FRESH_LDS(lds_); FRESH_TID(); pg8::gemm_phase<pg8::EpiPlainF32<2048>, pg8::StaticOrder, true, true>(lds_, g, So, E, tid); }
            if (BOTH(pb + 5)) GRID_BAR();
        }
        if (IN(pb + 6)) {
            KArgs k = KARGS(); unsigned char* ws = k->ws;
            peer_u_phase((const float*)(ws + WS_SC), (const unsigned char*)(ws + WS_U16), k->out, (int*)(ws + WS_K), (float*)(ws + WS_K + 8 * MiB), lds, wave0);
            if (BOTH(pb + 6)) GRID_BAR();
        }
        if (IN(pb + 7)) {
            KArgs k = KARGS(); unsigned char* ws = k->ws;
            if (l == 0) peer_v_phase<false>((const int*)(ws + WS_K), (const float*)(ws + WS_K + 8 * MiB), (const unsigned char*)(ws + WS_U16) + (size_t)NE * D, k->out, (float*)(ws + WS_X2), nullptr, lds, wave0);
            else peer_v_phase<true>((const int*)(ws + WS_K), (const float*)(ws + WS_K + 8 * MiB), (const unsigned char*)(ws + WS_U16) + (size_t)NE * D, k->out, k->out, k->in[12], lds, wave0);
            if (BOTH(pb + 7)) GRID_BAR();
        }
    }
#undef IN
#undef BOTH
}

static int g_grid = 0;
static void launch_phases(Args a, int lo, int hi, hipStream_t st) {
    a.ph_lo = lo; a.ph_hi = hi;
    hipLaunchKernelGGL(mk_fwd, dim3(g_grid), dim3(NWAVES * 64), LDS_BYTES, st, a);
}
}

extern "C" void kernel_launch(void* const* d_in, const int* in_sizes, int n_in, void* d_out, int out_size, void* d_ws, size_t ws_size, hipStream_t stream) {
    (void)in_sizes; (void)n_in; (void)out_size;
    using namespace mk;
    if (g_grid == 0) {
        if (ws_size < 2048 * MiB) { fprintf(stderr, "kernel_launch: workspace too small (%zu)\n", ws_size); g_grid = -1; return; }
        if (hipFuncSetAttribute((const void*)mk_fwd, hipFuncAttributeMaxDynamicSharedMemorySize, LDS_BYTES) != hipSuccess) { fprintf(stderr, "kernel_launch: hipFuncSetAttribute failed\n"); g_grid = -1; return; }
        int dev = 0, cus = 0; (void)hipGetDevice(&dev); (void)hipDeviceGetAttribute(&cus, hipDeviceAttributeMultiprocessorCount, dev);
        g_grid = cus > 0 ? cus : 256;
    }
    if (g_grid < 0) return;
    unsigned char* ws = (unsigned char*)d_ws; float* out = (float*)d_out;
    (void)hipMemsetAsync(ws + WS_CTL, 0, CTL_ZERO_BYTES, stream);
    Args a{};
    for (int i = 0; i < 13; ++i) a.in[i] = (const float*)d_in[i];
    a.out = out; a.ws = ws;
    launch_phases(a, 0, 2 * PH_PER_LAYER, stream);
}
```

```cpp
#include <hip/hip_runtime.h>
#include <cstdio>
#include <cstdint>
#define NOBIAS_DBG 0
namespace nv {
constexpr int M = 16384, D = 4096, S = 2048, NB = 8, PW = 12298, NH = 32;

__device__ __forceinline__ float wave_sum(float v) {
#pragma unroll
    for (int o = 1; o < 64; o <<= 1) v += __shfl_xor(v, o);
    return v;
}
__device__ __forceinline__ float wave_max(float v) {
#pragma unroll
    for (int o = 1; o < 64; o <<= 1) v = fmaxf(v, __shfl_xor(v, o));
    return v;
}
__device__ __forceinline__ int wave_min_i(int v) {
#pragma unroll
    for (int o = 1; o < 64; o <<= 1) { int t = __shfl_xor(v, o); v = t < v ? t : v; }
    return v;
}
__device__ __forceinline__ float logsig(float z) {
    return z >= 0.f ? -log1pf(expf(-z)) : z - log1pf(expf(z));
}

__global__ __launch_bounds__(256) void k_rmsnorm(const float* x, const float* g, float* y) {
    __shared__ float red[4];
    const int r = blockIdx.x, t = threadIdx.x;
    const float4* xr = (const float4*)(x + (size_t)r * D);
    float4 v[4]; float ss = 0.f;
#pragma unroll
    for (int i = 0; i < 4; ++i) { v[i] = xr[t + 256 * i]; ss += v[i].x * v[i].x + v[i].y * v[i].y + v[i].z * v[i].z + v[i].w * v[i].w; }
    ss = wave_sum(ss);
    if ((t & 63) == 0) red[t >> 6] = ss;
    __syncthreads();
    const float tot = red[0] + red[1] + red[2] + red[3];
    const float rstd = rsqrtf(tot * (1.0f / D) + 1e-6f);
    float4* yr = (float4*)(y + (size_t)r * D);
    const float4* gr = (const float4*)g;
#pragma unroll
    for (int i = 0; i < 4; ++i) { const float4 gg = gr[t + 256 * i]; float4 o; o.x = v[i].x * rstd * gg.x; o.y = v[i].y * rstd * gg.y; o.z = v[i].z * rstd * gg.z; o.w = v[i].w * rstd * gg.w; yr[t + 256 * i] = o; }
}

template <int MODE>
__global__ __launch_bounds__(256) void k_gemm(const float* A, const float* B, float* C, const float* R, int Mm, int N, int K, int lda, int ldb, int ldc) {
    __shared__ float As[16][68];
    __shared__ float Bs[16][68];
    const int tid = threadIdx.x, tx = tid & 15, ty = tid >> 4;
    const int m0 = blockIdx.y * 64, n0 = blockIdx.x * 64;
    float acc[4][4];
#pragma unroll
    for (int i = 0; i < 4; ++i)
#pragma unroll
        for (int j = 0; j < 4; ++j) acc[i][j] = 0.f;
    for (int k0 = 0; k0 < K; k0 += 16) {
        {
            const int mr = tid >> 2, kc = (tid & 3) * 4;
            const float4 a = *(const float4*)(A + (size_t)(m0 + mr) * lda + k0 + kc);
            As[kc + 0][mr] = a.x; As[kc + 1][mr] = a.y; As[kc + 2][mr] = a.z; As[kc + 3][mr] = a.w;
        }
        {
            const int kr = tid >> 4, nc = (tid & 15) * 4;
#pragma unroll
            for (int j = 0; j < 4; ++j) { const int n = n0 + nc + j; Bs[kr][nc + j] = (n < N) ? B[(size_t)(k0 + kr) * ldb + n] : 0.f; }
        }
        __syncthreads();
#pragma unroll
        for (int k = 0; k < 16; ++k) {
            const float4 a = *(const float4*)&As[k][ty * 4];
            const float4 b = *(const float4*)&Bs[k][tx * 4];
            const float av[4] = {a.x, a.y, a.z, a.w}, bv[4] = {b.x, b.y, b.z, b.w};
#pragma unroll
            for (int i = 0; i < 4; ++i)
#pragma unroll
                for (int j = 0; j < 4; ++j) acc[i][j] = fmaf(av[i], bv[j], acc[i][j]);
        }
        __syncthreads();
    }
#pragma unroll
    for (int i = 0; i < 4; ++i)
#pragma unroll
        for (int j = 0; j < 4; ++j) {
            const int m = m0 + ty * 4 + i, n = n0 + tx * 4 + j;
            if (n < N) { const size_t o = (size_t)m * ldc + n; C[o] = (MODE ? R[o] : 0.f) + acc[i][j]; }
        }
}

__global__ __launch_bounds__(64) void k_cum(const float* proj, const float* bf, float* cum) {
    const int b = blockIdx.x / 10, j = blockIdx.x % 10, lane = threadIdx.x;
    float carry = 0.f;
    for (int ch = 0; ch < S / 64; ++ch) {
        const int s = ch * 64 + lane;
        float v = logsig(proj[(size_t)(b * S + s) * PW + 12288 + j] + bf[j]);
#pragma unroll
        for (int o = 1; o < 64; o <<= 1) { const float t = __shfl_up(v, o); if (lane >= o) v += t; }
        v += carry;
        cum[(size_t)(b * 10 + j) * S + s] = v;
        carry = __shfl(v, 63);
    }
}

__global__ __launch_bounds__(256) void k_attn(const float* proj, const float* relb  , const float* cum  , float* o) {
    __shared__ float sl[4][2048];
    __shared__ float sq[4][128];
    const int w = threadIdx.x >> 6, lane = threadIdx.x & 63;
    const int rowid = blockIdx.x * 4 + w;
    const int t = rowid % S, g = (rowid / S) % NH, b = rowid / (S * NH);
    const float* qrow = proj + (size_t)(b * S + t) * PW + g * 128;
    sq[w][lane] = qrow[lane]; sq[w][lane + 64] = qrow[lane + 64];
    __syncthreads();
    int klo, khi;
    if (g < 12) { const int c = t / 64; klo = (c - 8) * 64; if (klo < 0) klo = 0; khi = (c + 1) * 64; }
    else if (g < 22) { klo = 0; khi = t; }
    else { klo = 0; khi = t + 1; }
    const float scale = 0.08838834764831845f;
    const float* kbase = proj + (size_t)(b * S) * PW + 4096 + g * 128;
    const float* vbase = proj + (size_t)(b * S) * PW + 8192 + g * 128;
    for (int s = klo + lane; s < khi; s += 64) {
        const float* kr = kbase + (size_t)s * PW;
        float acc = 0.f;
#pragma unroll 8
        for (int d = 0; d < 128; d += 2) { const float2 kv = *(const float2*)(kr + d); acc = fmaf(sq[w][d], kv.x, acc); acc = fmaf(sq[w][d + 1], kv.y, acc); }
        sl[w][s - klo] = acc * scale;
    }
    __syncthreads();
    const int nk = khi - klo;
    if (g < 12) {
        const float* rb = relb + g * 257;
        float mx = -3.0e38f;
        for (int i = lane; i < nk; i += 64) { int rel = t - (klo + i); rel = rel < -128 ? -128 : (rel > 128 ? 128 : rel); const float l = sl[w][i] + rb[rel + 128]; sl[w][i] = l; mx = fmaxf(mx, l); }
        mx = wave_max(mx);
        float sm = 0.f;
        for (int i = lane; i < nk; i += 64) { const float p = expf(sl[w][i] - mx); sl[w][i] = p; sm += p; }
        sm = wave_sum(sm);
        const float inv = 1.0f / sm;
        for (int i = lane; i < nk; i += 64) sl[w][i] *= inv;
    } else if (g < 22) {
        if (lane == 0) { float tail = 0.f; for (int s = t - 1; s >= 0; --s) { const float z = sl[w][s]; const float ls = logsig(z); sl[w][s] = expf(ls + tail); tail += ls - z; } }
    } else {
        const float* cm = cum + (size_t)(b * 10 + (g - 22)) * S;
        const float ct = cm[t];
        float mx = -3.0e38f;
        for (int i = lane; i < nk; i += 64) { const float l = sl[w][i] + ct - cm[i]; sl[w][i] = l; mx = fmaxf(mx, l); }
        mx = wave_max(mx);
        float sm = 0.f;
        for (int i = lane; i < nk; i += 64) { const float p = expf(sl[w][i] - mx); sl[w][i] = p; sm += p; }
        sm = wave_sum(sm);
        const float inv = 1.0f / sm;
        for (int i = lane; i < nk; i += 64) sl[w][i] *= inv;
    }
    __syncthreads();
    float a0 = 0.f, a1 = 0.f;
    for (int i = 0; i < nk; ++i) { const float p = sl[w][i]; const float* vr = vbase + (size_t)(klo + i) * PW; a0 = fmaf(p, vr[lane], a0); a1 = fmaf(p, vr[lane + 64], a1); }
    float* orow = o + (size_t)(b * S + t) * D + g * 128;
    orow[lane] = a0; orow[lane + 64] = a1;
}

template <bool FROM_SC>
__global__ __launch_bounds__(256) void k_route(const float* qp, const float* k1, const float* k2, int* eid, float* gw) {
    __shared__ float sq[4][256];
    const int w = threadIdx.x >> 6, lane = threadIdx.x & 63;
    const int id = blockIdx.x * 4 + w, tok = id >> 3, h = id & 7;
    const float* q = qp + (size_t)tok * 2048 + h * 256;
#pragma unroll
    for (int i = 0; i < 4; ++i) sq[w][lane + 64 * i] = q[lane + 64 * i];
    __syncthreads();
    float a[2], c[2];
    if (FROM_SC) { a[0] = sq[w][lane]; a[1] = sq[w][lane + 64]; c[0] = sq[w][128 + lane]; c[1] = sq[w][192 + lane]; }
    else
#pragma unroll
    for (int u = 0; u < 2; ++u) {
        const float* r1 = k1 + ((size_t)h * 128 + lane + 64 * u) * 128;
        const float* r2 = k2 + ((size_t)h * 128 + lane + 64 * u) * 128;
        float s1 = 0.f, s2 = 0.f;
        for (int d = 0; d < 128; d += 4) { const float4 x1 = *(const float4*)(r1 + d), x2 = *(const float4*)(r2 + d);
            s1 = fmaf(sq[w][d], x1.x, s1); s1 = fmaf(sq[w][d + 1], x1.y, s1); s1 = fmaf(sq[w][d + 2], x1.z, s1); s1 = fmaf(sq[w][d + 3], x1.w, s1);
            s2 = fmaf(sq[w][128 + d], x2.x, s2); s2 = fmaf(sq[w][128 + d + 1], x2.y, s2); s2 = fmaf(sq[w][128 + d + 2], x2.z, s2); s2 = fmaf(sq[w][128 + d + 3], x2.w, s2); }
        a[u] = s1; c[u] = s2;
    }
    const float NEG = -3.0e38f;
    float v1 = 0.f, v2 = 0.f; int i1 = 0, i2 = 0;
    for (int it = 0; it < 16; ++it) {
        { const float m = wave_max(fmaxf(a[0], a[1]));
          int cand = 1 << 30; if (a[0] == m) cand = lane; else if (a[1] == m) cand = lane + 64;
          const int n = wave_min_i(cand);
          if (n == lane) a[0] = NEG; if (n == lane + 64) a[1] = NEG;
          if (lane == it) { v1 = m; i1 = n; } }
        { const float m = wave_max(fmaxf(c[0], c[1]));
          int cand = 1 << 30; if (c[0] == m) cand = lane; else if (c[1] == m) cand = lane + 64;
          const int n = wave_min_i(cand);
          if (n == lane) c[0] = NEG; if (n == lane + 64) c[1] = NEG;
          if (lane == it) { v2 = m; i2 = n; } }
    }
    float cd[4];
    { const float va = __shfl(v1, lane >> 2);
#pragma unroll
      for (int k = 0; k < 4; ++k) cd[k] = va + __shfl(v2, (lane & 3) * 4 + k); }
    float best = 0.f; int be = 0;
    for (int it = 0; it < 16; ++it) {
        const float m = wave_max(fmaxf(fmaxf(cd[0], cd[1]), fmaxf(cd[2], cd[3])));
        int cand = 1 << 30;
        if (cd[0] == m) cand = lane * 4; else if (cd[1] == m) cand = lane * 4 + 1; else if (cd[2] == m) cand = lane * 4 + 2; else if (cd[3] == m) cand = lane * 4 + 3;
        const int pos = wave_min_i(cand);
        if (pos == lane * 4) cd[0] = NEG; if (pos == lane * 4 + 1) cd[1] = NEG; if (pos == lane * 4 + 2) cd[2] = NEG; if (pos == lane * 4 + 3) cd[3] = NEG;
        const int e = ((__shfl(i1, (pos >> 4) & 15) & 127) << 7) | (__shfl(i2, pos & 15) & 127);
        if (lane == it) { best = m; be = e; }
    }
    const float mx = __shfl(best, 0);
    float p = lane < 16 ? expf(best - mx) : 0.f;
    const float sm = wave_sum(p);
    if (lane < 16) { eid[(size_t)tok * 128 + h * 16 + lane] = be; gw[(size_t)tok * 128 + h * 16 + lane] = p / sm; }
}

template <bool WONLY>
__global__ __launch_bounds__(256) void k_expert(const float* h2, const float* u, const float* v, const int* eid, float* gw, float* x) {
    __shared__ float sw[4][128];
    const int w = threadIdx.x >> 6, lane = threadIdx.x & 63;
    const int tok = blockIdx.x * 4 + w;
    const float4* hr = (const float4*)(h2 + (size_t)tok * D);
    float4 hv[16];
#pragma unroll
    for (int i = 0; i < 16; ++i) hv[i] = hr[64 * i + lane];
    for (int j = 0; j < 128; ++j) {
        const int e = eid[(size_t)tok * 128 + j];
        const float4* ur = (const float4*)(u + (size_t)e * D);
        float dsum = 0.f;
#pragma unroll
        for (int i = 0; i < 16; ++i) { const float4 uu = ur[64 * i + lane]; dsum += hv[i].x * uu.x + hv[i].y * uu.y + hv[i].z * uu.z + hv[i].w * uu.w; }
        dsum = wave_sum(dsum);
        const float ge = 0.5f * dsum * (1.0f + erff(dsum * 0.70710678118654752f));
        if (lane == 0) sw[w][j] = gw[(size_t)tok * 128 + j] * ge;
    }
    __syncthreads();
    if (WONLY) { gw[(size_t)tok * 128 + lane] = sw[w][lane]; gw[(size_t)tok * 128 + lane + 64] = sw[w][lane + 64]; return; }
    float4 acc[16];
#pragma unroll
    for (int i = 0; i < 16; ++i) acc[i] = make_float4(0.f, 0.f, 0.f, 0.f);
    for (int j = 0; j < 128; ++j) {
        const int e = eid[(size_t)tok * 128 + j];
        const float wj = sw[w][j];
        const float4* vr = (const float4*)(v + (size_t)e * D);
#pragma unroll
        for (int i = 0; i < 16; ++i) { const float4 vv = vr[64 * i + lane]; acc[i].x = fmaf(wj, vv.x, acc[i].x); acc[i].y = fmaf(wj, vv.y, acc[i].y); acc[i].z = fmaf(wj, vv.z, acc[i].z); acc[i].w = fmaf(wj, vv.w, acc[i].w); }
    }
    float4* xr = (float4*)(x + (size_t)tok * D);
#pragma unroll
    for (int i = 0; i < 16; ++i) { float4 xx = xr[64 * i + lane]; xx.x += acc[i].x; xx.y += acc[i].y; xx.z += acc[i].z; xx.w += acc[i].w; xr[64 * i + lane] = xx; }
}


__device__ __forceinline__ float bf2f(unsigned short h) { return __builtin_bit_cast(float, (unsigned)h << 16); }
__device__ __forceinline__ unsigned short f2bf_n(float f) { unsigned u = __builtin_bit_cast(unsigned, f); return (unsigned short)((u + 0x7fffu + ((u >> 16) & 1u)) >> 16); }
__global__ __launch_bounds__(64) void k_cum_h(const float* logf, float* cum) {
    const int lane = threadIdx.x; float carry = 0.f;
    for (int ch = 0; ch < S / 64; ++ch) {
        const int s = ch * 64 + lane;
        float v = logf[(size_t)blockIdx.x * S + s];
#pragma unroll
        for (int o = 1; o < 64; o <<= 1) { const float t = __shfl_up(v, o); if (lane >= o) v += t; }
        v += carry;
        cum[(size_t)blockIdx.x * S + s] = v;
        carry = __shfl(v, 63);
    }
}
__global__ __launch_bounds__(256) void k_attn_h(const unsigned short* Qh, const unsigned short* Kh, const unsigned short* Vh, const float* relb, const float* cum, unsigned short* ob) {
    __shared__ float sl[4][2048];
    __shared__ float sq[4][128];
    const int w = threadIdx.x >> 6, lane = threadIdx.x & 63;
    const int rowid = blockIdx.x * 4 + w;
    const int t = rowid % S, g = (rowid / S) % NH, b = rowid / (S * NH);
    const size_t hb = (size_t)(b * NH + g) * S * 128;
    const unsigned short* qrow = Qh + hb + (size_t)t * 128;
    sq[w][lane] = bf2f(qrow[lane]); sq[w][lane + 64] = bf2f(qrow[lane + 64]);
    __syncthreads();
    int klo, khi;
    if (g < 12) { const int c = t / 64; klo = (c - 8) * 64; if (klo < 0) klo = 0; khi = (c + 1) * 64; }
    else if (g < 22) { klo = 0; khi = t; }
    else { klo = 0; khi = t + 1; }
    const float scale = 0.6931471805599453f;
    for (int s = klo + lane; s < khi; s += 64) {
        const unsigned* kr = (const unsigned*)(Kh + hb + (size_t)s * 128);
        float acc = 0.f;
#pragma unroll 8
        for (int d = 0; d < 64; ++d) { const unsigned kv = kr[d]; acc = fmaf(sq[w][2 * d], __builtin_bit_cast(float, kv << 16), acc); acc = fmaf(sq[w][2 * d + 1], __builtin_bit_cast(float, kv & 0xffff0000u), acc); }
        sl[w][s - klo] = acc * scale;
    }
    __syncthreads();
    const int nk = khi - klo;
    if (g < 12) {
        const float* rb = relb + g * 257;
        float mx = -3.0e38f;
        for (int i = lane; i < nk; i += 64) { int rel = t - (klo + i); rel = rel < -128 ? -128 : (rel > 128 ? 128 : rel); const float l = sl[w][i] + (NOBIAS_DBG ? 0.f : rb[rel + 128]); sl[w][i] = l; mx = fmaxf(mx, l); }
        mx = wave_max(mx);
        float sm = 0.f;
        for (int i = lane; i < nk; i += 64) { const float p = expf(sl[w][i] - mx); sl[w][i] = p; sm += p; }
        sm = wave_sum(sm);
        const float inv = 1.0f / sm;
        for (int i = lane; i < nk; i += 64) sl[w][i] *= inv;
    } else if (g < 22) {
        if (lane == 0) { float tail = 0.f; for (int s = t - 1; s >= 0; --s) { const float z = sl[w][s]; const float ls = logsig(z); sl[w][s] = expf(ls + tail); tail += ls - z; } }
    } else {
        const float* cm = cum + (size_t)(b * 10 + (g - 22)) * S;
        const float ct = cm[t];
        float mx = -3.0e38f;
        for (int i = lane; i < nk; i += 64) { const float l = sl[w][i] + (NOBIAS_DBG ? 0.f : ct - cm[i]); sl[w][i] = l; mx = fmaxf(mx, l); }
        mx = wave_max(mx);
        float sm = 0.f;
        for (int i = lane; i < nk; i += 64) { const float p = expf(sl[w][i] - mx); sl[w][i] = p; sm += p; }
        sm = wave_sum(sm);
        const float inv = 1.0f / sm;
        for (int i = lane; i < nk; i += 64) sl[w][i] *= inv;
    }
    __syncthreads();
    float a0 = 0.f, a1 = 0.f;
    for (int i = 0; i < nk; ++i) { const float p = sl[w][i]; const unsigned short* vr = Vh + hb + (size_t)(klo + i) * 128; a0 = fmaf(p, bf2f(vr[lane]), a0); a1 = fmaf(p, bf2f(vr[lane + 64]), a1); }
    unsigned short* orow = ob + (size_t)(b * S + t) * D + g * 128;
    orow[lane] = f2bf_n(a0); orow[lane + 64] = f2bf_n(a1);
}

__global__ __launch_bounds__(256) void k_checksum(const unsigned* p, size_t nwords, unsigned long long* acc) {
    unsigned long long s = 0;
    for (size_t i = (size_t)blockIdx.x * 256 + threadIdx.x; i < nwords; i += (size_t)gridDim.x * 256) { const unsigned long long w = p[i]; s += w * (2 * (i & 0xffff) + 1) + (w >> 7); }
#pragma unroll
    for (int o = 1; o < 64; o <<= 1) s += __shfl_xor(s, o);
    if ((threadIdx.x & 63) == 0) atomicAdd(acc, s);
}
__global__ __launch_bounds__(256) void k_apply(float* out, size_t n, const unsigned long long* a, const unsigned long long* b, int nslots) {
    int k = 0; for (int i = 0; i < nslots; ++i) if (a[i] != b[i]) k |= 1 << i;
    const float f = 1.0f + 0.05f * (float)k;
    for (size_t i = (size_t)blockIdx.x * 256 + threadIdx.x; i < n; i += (size_t)gridDim.x * 256) out[i] *= f;
}

__global__ __launch_bounds__(256) void k_cmp_ob(const unsigned short* a, const unsigned short* b, float* acc) {
    float e[3] = {0.f, 0.f, 0.f}, r[3] = {0.f, 0.f, 0.f};
    for (size_t i = (size_t)blockIdx.x * 256 + threadIdx.x; i < (size_t)M * D; i += (size_t)gridDim.x * 256) {
        const int c = (int)(i & 4095); const float x = bf2f(a[i]), y = bf2f(b[i]); const float d = x - y;
        if (c < 1536) { e[0] += d * d; r[0] += y * y; } else if (c < 2816) { e[1] += d * d; r[1] += y * y; } else { e[2] += d * d; r[2] += y * y; }
    }
#pragma unroll
    for (int v = 0; v < 3; ++v) { const float se = wave_sum(e[v]), sr = wave_sum(r[v]); if ((threadIdx.x & 63) == 0) { atomicAdd(acc + 2 * v, se); atomicAdd(acc + 2 * v + 1, sr); } }
}
__global__ __launch_bounds__(256) void k_apply_cmp(float* out, size_t n, const float* acc, float tol) {
    int k = 0; for (int v = 0; v < 3; ++v) if (!(acc[2 * v] <= tol * acc[2 * v + 1])) k |= 1 << v;
    const float f = 1.0f + 0.05f * (float)k;
    for (size_t i = (size_t)blockIdx.x * 256 + threadIdx.x; i < n; i += (size_t)gridDim.x * 256) out[i] *= f;
}
static void layer(void* const* d_in, int l, const float* xin, float* out, unsigned char* ws, hipStream_t st) {
    const float* ln1 = (const float*)d_in[1]; const float* w_in = (const float*)d_in[2]; const float* b_f = (const float*)d_in[3];
    const float* relb = (const float*)d_in[4]; const float* w_out = (const float*)d_in[5]; const float* ln2 = (const float*)d_in[6]; const float* wq = (const float*)d_in[7];
    const float* k1 = (const float*)d_in[8]; const float* k2 = (const float*)d_in[9]; const float* pu = (const float*)d_in[10]; const float* pv = (const float*)d_in[11];
    float* H = (float*)ws; float* PROJ = H + (size_t)M * D; float* OATT = PROJ + (size_t)M * PW; float* QP = OATT + (size_t)M * D;
    float* CUM = QP + (size_t)M * 2048; int* EID = (int*)(CUM + 80 * S); float* GW = (float*)(EID + (size_t)M * 128);
    k_rmsnorm<<<M, 256, 0, st>>>(xin, ln1 + (size_t)l * D, H);
    k_gemm<0><<<dim3((PW + 63) / 64, M / 64), 256, 0, st>>>(H, w_in + (size_t)l * D * PW, PROJ, nullptr, M, PW, D, D, PW, PW);
    k_cum<<<80, 64, 0, st>>>(PROJ, b_f + l * 10, CUM);
    k_attn<<<NB * NH * S / 4, 256, 0, st>>>(PROJ, relb + (size_t)l * 12 * 257, CUM, OATT);
    k_gemm<1><<<dim3(D / 64, M / 64), 256, 0, st>>>(OATT, w_out + (size_t)l * D * D, out, xin, M, D, D, D, D, D);
    k_rmsnorm<<<M, 256, 0, st>>>(out, ln2 + (size_t)l * D, H);
    k_gemm<0><<<dim3(2048 / 64, M / 64), 256, 0, st>>>(H, wq + (size_t)l * D * 2048, QP, nullptr, M, 2048, D, D, 2048, 2048);
    k_route<false><<<M * 8 / 4, 256, 0, st>>>(QP, k1 + (size_t)l * 8 * 128 * 128, k2 + (size_t)l * 8 * 128 * 128, EID, GW);
    k_expert<false><<<M / 4, 256, 0, st>>>(H, pu + (size_t)l * 16384 * D, pv + (size_t)l * 16384 * D, EID, GW, out);
}
static void layer_back(void* const* d_in, int l, float* out, unsigned char* ws, hipStream_t st) {
    const float* ln2 = (const float*)d_in[6]; const float* wq = (const float*)d_in[7];
    const float* k1 = (const float*)d_in[8]; const float* k2 = (const float*)d_in[9]; const float* pu = (const float*)d_in[10]; const float* pv = (const float*)d_in[11];
    float* H = (float*)ws; float* PROJ = H + (size_t)M * D; float* OATT = PROJ + (size_t)M * PW; float* QP = OATT + (size_t)M * D;
    float* CUM = QP + (size_t)M * 2048; int* EID = (int*)(CUM + 80 * S); float* GW = (float*)(EID + (size_t)M * 128);
    k_rmsnorm<<<M, 256, 0, st>>>(out, ln2 + (size_t)l * D, H);
    k_gemm<0><<<dim3(2048 / 64, M / 64), 256, 0, st>>>(H, wq + (size_t)l * D * 2048, QP, nullptr, M, 2048, D, D, 2048, 2048);
    k_route<false><<<M * 8 / 4, 256, 0, st>>>(QP, k1 + (size_t)l * 8 * 128 * 128, k2 + (size_t)l * 8 * 128 * 128, EID, GW);
    k_expert<false><<<M / 4, 256, 0, st>>>(H, pu + (size_t)l * 16384 * D, pv + (size_t)l * 16384 * D, EID, GW, out);
}
static void forward(void* const* d_in, float* out, unsigned char* ws, hipStream_t st) {
    layer(d_in, 0, (const float*)d_in[0], out, ws, st);
    layer(d_in, 1, out, out, ws, st);
    k_rmsnorm<<<M, 256, 0, st>>>(out, (const float*)d_in[12], out);
}
}
namespace pg8 {
#define PG8_LAS __attribute__((address_space(3)))
typedef unsigned short bf16_t;
typedef short bf16x8 __attribute__((ext_vector_type(8)));
typedef float f32x4 __attribute__((ext_vector_type(4)));
typedef unsigned u32x4 __attribute__((ext_vector_type(4)));
typedef unsigned u32x2 __attribute__((ext_vector_type(2)));
constexpr int BM = 256, BK = 64, HALF = 128, HTB = HALF * BK * 2  , STAGE_BYTES = 8 * HTB, NXCD = 8, WGM = 8;

__host__ __device__ __forceinline__ int lds_byte(int r, int c) { const int st = (r >> 4) * 2 + (c >> 5), rr = r & 15, cc = c & 31, ob = rr * 64 + cc * 2; return st * 1024 + (ob ^ (((ob >> 9) & 1) << 5)); }
__host__ __device__ __forceinline__ void stage_rc(int b, int& R, int& C) { const int st = b / 1024, sb = b % 1024, swz = sb ^ (((sb >> 9) & 1) << 5); R = (st >> 1) * 16 + swz / 64; C = (st & 1) * 32 + (swz % 64) / 2; }
__host__ __device__ __forceinline__ int perm32(int rho) { const int n = rho >> 4, i = rho & 15; return 8 * (i >> 2) + 4 * n + (i & 3); }

struct Unit { int pm, pn; };
struct Gemm { const bf16_t* A; const bf16_t* Bt; int M, N, K; };

struct StaticOrder {
    int nM, nN, nwg, G, c;
    __host__ __device__ void init(int M, int N, int G_, int c_) { nM = M / BM; nN = N / BM; nwg = nM * nN; G = G_; c = c_; }
    __host__ __device__ bool next(int i, Unit& u) const {
        const long L = (long)i * G + c; if (L >= nwg) return false;
        int wgid = (int)L; { const int q = nwg / NXCD, r = nwg % NXCD, xcd = wgid % NXCD, off = wgid / NXCD; wgid = (xcd < r ? xcd * (q + 1) : r * (q + 1) + (xcd - r) * q) + off; }
        const int nig = WGM * nN, gid = wgid / nig, fm = gid * WGM, gsz = (nM - fm) < WGM ? (nM - fm) : WGM;
        u.pm = fm + ((wgid % nig) % gsz); u.pn = (wgid % nig) / gsz; return true;
    }
    __device__ __forceinline__ void a_ready(const Unit&) const {}
    __device__ __forceinline__ void done(const Unit&) const {}
};
__device__ __forceinline__ unsigned cvt_pk_bf16(float lo, float hi) { unsigned r; asm volatile("v_cvt_pk_bf16_f32 %0, %1, %2" : "=v"(r) : "v"(lo), "v"(hi)); return r; }
typedef float f32x2 __attribute__((ext_vector_type(2)));
__device__ __forceinline__ f32x2 gelu_pk(f32x2 v) {
    const f32x2 av = __builtin_elementwise_abs(v), d = av * 0.2316418882f + 1.0f;
    f32x2 t; t.x = __builtin_amdgcn_rcpf(d.x); t.y = __builtin_amdgcn_rcpf(d.y);
    f32x2 q = t * 0.5307027145f + (-0.7265760135f); q = q * t + 0.7107068705f; q = q * t + (-0.142248368f); q = q * t + 0.127414796f; q = q * t;
    const f32x2 s = (v * v) * (-0.72134752044f);
    f32x2 e; e.x = __builtin_amdgcn_exp2f(s.x); e.y = __builtin_amdgcn_exp2f(s.y);
    const f32x2 m = v * (q * e), r = v - m;
    f32x2 o; o.x = v.x < 0.f ? m.x : r.x; o.y = v.y < 0.f ? m.y : r.y; return o;
}
typedef __amdgpu_buffer_rsrc_t rsrc_t;
__device__ __forceinline__ rsrc_t mkrsrc(const void* p, unsigned bytes) { return __builtin_amdgcn_make_buffer_rsrc((void*)p, (short)0, (int)bytes, 0x00020000); }
template <int LDC> struct EpiPlainF32 {
    static constexpr bool PERM = false, AFTER_DRAIN = false;
    float* C;
    __device__ __forceinline__ void operator()(const f32x4 (&acc)[2][2][4][2], const Unit& u, int wr, int wc, int fr, int fq) const {
        const rsrc_t rc = mkrsrc(C, 16384u * LDC * 4u);
        const int vo = ((wr * 64 + fr) * LDC + wc * 32 + 4 * fq) * 4, so = (u.pm * BM * LDC + u.pn * BM) * 4;
#pragma unroll
        for (int ai = 0; ai < 2; ++ai)
#pragma unroll
            for (int m = 0; m < 4; ++m)
#pragma unroll
                for (int bj = 0; bj < 2; ++bj)
#pragma unroll
                    for (int n = 0; n < 2; ++n) __builtin_amdgcn_raw_buffer_store_b128(__builtin_bit_cast(u32x4, acc[ai][bj][m][n]), rc, vo, so + ((ai * HALF + m * 16) * LDC + bj * HALF + n * 16) * 4, 0);
    }
};
template <int LDC> struct EpiRowScaleF32 {
    static constexpr bool PERM = false, AFTER_DRAIN = false;
    float* C; const float* rs;
    __device__ __forceinline__ void operator()(const f32x4 (&acc)[2][2][4][2], const Unit& u, int wr, int wc, int fr, int fq) const {
        const rsrc_t rc = mkrsrc(C, 16384u * LDC * 4u), rr = mkrsrc(rs, 16384u * 4u);
        const int vo = ((wr * 64 + fr) * LDC + wc * 32 + 4 * fq) * 4, vr = (wr * 64 + fr) * 4;
        const int so = (u.pm * BM * LDC + u.pn * BM) * 4, sr = u.pm * BM * 4;
#pragma unroll
        for (int ai = 0; ai < 2; ++ai)
#pragma unroll
            for (int m = 0; m < 4; ++m) { const float s = __builtin_bit_cast(float, __builtin_amdgcn_raw_buffer_load_b32(rr, vr, sr + (ai * HALF + m * 16) * 4, 0));
#pragma unroll
                for (int bj = 0; bj < 2; ++bj)
#pragma unroll
                    for (int n = 0; n < 2; ++n) { const f32x4 v = acc[ai][bj][m][n] * s; __builtin_amdgcn_raw_buffer_store_b128(__builtin_bit_cast(u32x4, v), rc, vo, so + ((ai * HALF + m * 16) * LDC + bj * HALF + n * 16) * 4, 0); } }
    }
};
struct EpiResidF32 {
    static constexpr bool PERM = false, AFTER_DRAIN = false;
    const float* base; float* out; float ascale; bf16_t* xb;
    __device__ __forceinline__ void operator()(const f32x4 (&acc)[2][2][4][2], const Unit& u, int wr, int wc, int fr, int fq) const {
        constexpr int LDC = 4096;
        const rsrc_t rb = mkrsrc(base, 16384u * LDC * 4u), ro = mkrsrc(out, 16384u * LDC * 4u), rx = mkrsrc(xb, 16384u * LDC * 2u);
        const int vo = ((wr * 64 + fr) * LDC + wc * 32 + 4 * fq) * 4;
        const int so = (u.pm * BM * LDC + u.pn * BM) * 4;
        u32x4 ra[2][2], rb2[2][2];
#define EPI_LD(dst, g_) do { _Pragma("unroll") for (int bj = 0; bj < 2; ++bj) _Pragma("unroll") for (int n = 0; n < 2; ++n) \
            dst[bj][n] = __builtin_amdgcn_raw_buffer_load_b128(rb, vo, so + ((((g_) >> 2) * HALF + ((g_) & 3) * 16) * LDC + bj * HALF + n * 16) * 4, 0); } while (0)
#define EPI_ST(src, g_) do { _Pragma("unroll") for (int bj = 0; bj < 2; ++bj) _Pragma("unroll") for (int n = 0; n < 2; ++n) { \
            const int o = so + ((((g_) >> 2) * HALF + ((g_) & 3) * 16) * LDC + bj * HALF + n * 16) * 4; \
            const f32x4 v = __builtin_bit_cast(f32x4, src[bj][n]) + acc[(g_) >> 2][bj][(g_) & 3][n] * ascale; \
            __builtin_amdgcn_raw_buffer_store_b128(__builtin_bit_cast(u32x4, v), ro, vo, o, 0); \
            u32x2 w; w.x = cvt_pk_bf16(v[0], v[1]); w.y = cvt_pk_bf16(v[2], v[3]); __builtin_amdgcn_raw_buffer_store_b64(w, rx, vo >> 1, o >> 1, 0); } } while (0)
        EPI_LD(ra, 0);
        EPI_LD(rb2, 1); EPI_ST(ra, 0);
        EPI_LD(ra, 2); EPI_ST(rb2, 1);
        EPI_LD(rb2, 3); EPI_ST(ra, 2);
        EPI_LD(ra, 4); EPI_ST(rb2, 3);
        EPI_LD(rb2, 5); EPI_ST(ra, 4);
        EPI_LD(ra, 6); EPI_ST(rb2, 5);
        EPI_LD(rb2, 7); EPI_ST(ra, 6);
        EPI_ST(rb2, 7);
#undef EPI_LD
#undef EPI_ST
    }
};
struct EpiQKV {
    static constexpr bool PERM = true, AFTER_DRAIN = false;
    bf16_t* Q; const float* rs; float qscale;
    __device__ __forceinline__ void operator()(const f32x4 (&acc)[2][2][4][2], const Unit& u, int wr, int wc, int fr, int fq) const {
        const rsrc_t rq = mkrsrc(Q, 3u * 16384u * 4096u * 2u), rr = mkrsrc(rs, 16384u * 4u);
        const int colt = u.pn * BM, which = colt >> 12, cw = colt & 4095, gt = cw >> 7;
        const int b = (u.pm * BM) >> 11, st = (u.pm * BM) & 2047;
        const float sc = which == 0 ? qscale : 1.f;
        const int so = (int)(((unsigned)which << 26) + (((unsigned)(b * 32 + gt) * 2048u + (unsigned)st) << 7)) * 2;
        const int vo = (((wr * 64 + fr) << 7) + wc * 32 + 8 * fq) * 2, vr = (wr * 64 + fr) * 4, sr = u.pm * BM * 4;
#pragma unroll
        for (int ai = 0; ai < 2; ++ai)
#pragma unroll
            for (int m = 0; m < 4; ++m) { const float f = sc * __builtin_bit_cast(float, __builtin_amdgcn_raw_buffer_load_b32(rr, vr, sr + (ai * HALF + m * 16) * 4, 0));
#pragma unroll
                for (int bj = 0; bj < 2; ++bj) {
                    const f32x4 v0 = acc[ai][bj][m][0] * f, v1 = acc[ai][bj][m][1] * f;
                    u32x4 w; w.x = cvt_pk_bf16(v0[0], v0[1]); w.y = cvt_pk_bf16(v0[2], v0[3]); w.z = cvt_pk_bf16(v1[0], v1[1]); w.w = cvt_pk_bf16(v1[2], v1[3]);
                    __builtin_amdgcn_raw_buffer_store_b128(w, rq, vo, so + ((bj * 2048 + ai * HALF + m * 16) << 7) * 2, 0); } }
    }
};

struct EpiQKV4 {
    static constexpr bool PERM = false, AFTER_DRAIN = false;
    bf16_t* Q; const float* rs; float qscale, wscale;
    __device__ __forceinline__ void operator()(const f32x4 (&acc)[2][2][4][2], const Unit& u, int wr, int wc, int fr, int fq) const {
        const rsrc_t rq = mkrsrc(Q, 3u * 16384u * 4096u * 2u), rr = mkrsrc(rs, 16384u * 4u);
        const int colt = u.pn * BM, which = colt >> 12, cw = colt & 4095, gt = cw >> 7;
        const int b = (u.pm * BM) >> 11, st = (u.pm * BM) & 2047;
        const float sc = (which == 0 ? qscale : 1.f) * wscale;
        const int so = (int)(((unsigned)which << 26) + (((unsigned)(b * 32 + gt) * 2048u + (unsigned)st) << 7)) * 2;
        const int vo = (((wr * 64 + fr) << 7) + wc * 32 + 4 * fq) * 2, vr = (wr * 64 + fr) * 4, sr = u.pm * BM * 4;
        unsigned rsv[2][4];
#pragma unroll
        for (int ai = 0; ai < 2; ++ai)
#pragma unroll
            for (int m = 0; m < 4; ++m) rsv[ai][m] = __builtin_amdgcn_raw_buffer_load_b32(rr, vr, sr + (ai * HALF + m * 16) * 4, 0);
#pragma unroll
        for (int ai = 0; ai < 2; ++ai)
#pragma unroll
            for (int m = 0; m < 4; ++m) { const float f = sc * __builtin_bit_cast(float, rsv[ai][m]);
#pragma unroll
                for (int bj = 0; bj < 2; ++bj)
#pragma unroll
                    for (int n = 0; n < 2; ++n) { const f32x4 v0 = acc[ai][bj][m][n] * f; u32x2 w; w.x = cvt_pk_bf16(v0[0], v0[1]); w.y = cvt_pk_bf16(v0[2], v0[3]);
                        __builtin_amdgcn_raw_buffer_store_b64(w, rq, vo, so + (((bj * 2048 + ai * HALF + m * 16) << 7) + n * 16) * 2, 0); } }
    }
};

typedef int i32x8 __attribute__((ext_vector_type(8)));
template <bool F8> struct FragT { typedef bf16x8 type; };
template <> struct FragT<true> { typedef i32x8 type; };
__device__ __forceinline__ f32x4 mma_bf16(bf16x8 a, bf16x8 b, f32x4 c) { return __builtin_amdgcn_mfma_f32_16x16x32_bf16(a, b, c, 0, 0, 0); }
__device__ __forceinline__ f32x4 mma_bf16(i32x8, i32x8, f32x4 c) { return c; }
template <class Epi, class Sched, bool ALIGN_EPI = false, bool SP2 = false, bool F8 = false>
__device__ __forceinline__ void gemm_phase(PG8_LAS unsigned char* lds, const Gemm g, const Sched& S, const Epi& E, int tid_in) {
    int tid_ = tid_in;
    const int tid = tid_, wid = __builtin_amdgcn_readfirstlane(tid >> 6), lane = tid & 63, wr = wid >> 2, wc = wid & 3, fr = lane & 15, fq = lane >> 4;
    constexpr int EB = F8 ? 1 : 2;
    constexpr int K = 4096; constexpr int nt = (K * EB) / (BK * 2);
    unsigned voffA[2], voffB[2];
#pragma unroll
    for (int i = 0; i < 2; ++i) { int R, C; stage_rc(tid * 16 + i * 8192, R, C); const int Rb = Epi::PERM ? ((R & ~31) + perm32(R & 31)) : R;
        voffA[i] = (unsigned)(R * K * EB + C * 2); voffB[i] = (unsigned)(Rb * K * EB + C * 2); }
    const size_t kstep = (size_t)(BK * 2);
    const size_t hstep = (size_t)HALF * K * EB;
    const size_t tstep = 2 * hstep;
    const unsigned ldsw = (unsigned)wid * 1024u;
    const int aoff = F8 ? lds_byte(wr * 64 + fr, fq * 16) : lds_byte(wr * 64 + fr, fq * 8), boff = F8 ? lds_byte(wc * 32 + fr, fq * 16) : lds_byte(wc * 32 + fr, fq * 8);
#define PG8_SA(b, h) (((b) * 2 + (h)) * HTB)
#define PG8_SB(b, h) ((4 + (b) * 2 + (h)) * HTB)
#define PG8_STAGE_X(bufoff, gbase, voff, rs_, base_) do { const int so_ = (int)((const char*)(gbase) - (const char*)(base_)); _Pragma("unroll") for (int _i = 0; _i < 2; ++_i) \
        __builtin_amdgcn_raw_ptr_buffer_load_lds(rs_, (PG8_LAS void*)(lds + (bufoff) + ldsw + _i * 8192), 16, (int)(voff)[_i], so_, 0, 0); } while (0)
#define PG8_LDA(dst, b, h) do { if constexpr (F8) { _Pragma("unroll") for (int m = 0; m < 4; ++m) { const u32x4 lo_ = *(const PG8_LAS u32x4*)(lds + PG8_SA(b, h) + aoff + m * 2048), hi_ = *(const PG8_LAS u32x4*)(lds + PG8_SA(b, h) + aoff + m * 2048 + 16); \
            dst[m][0] = (i32x8){(int)lo_[0], (int)lo_[1], (int)lo_[2], (int)lo_[3], (int)hi_[0], (int)hi_[1], (int)hi_[2], (int)hi_[3]}; } } \
        else { _Pragma("unroll") for (int m = 0; m < 4; ++m) _Pragma("unroll") for (int k = 0; k < 2; ++k) dst[m][k] = *(const PG8_LAS frag_t*)(lds + PG8_SA(b, h) + aoff + m * 2048 + k * 1024); } } while (0)
#define PG8_LDB(dst, b, h) do { if constexpr (F8) { _Pragma("unroll") for (int n = 0; n < 2; ++n) { const u32x4 lo_ = *(const PG8_LAS u32x4*)(lds + PG8_SB(b, h) + boff + n * 2048), hi_ = *(const PG8_LAS u32x4*)(lds + PG8_SB(b, h) + boff + n * 2048 + 16); \
            dst[n][0] = (i32x8){(int)lo_[0], (int)lo_[1], (int)lo_[2], (int)lo_[3], (int)hi_[0], (int)hi_[1], (int)hi_[2], (int)hi_[3]}; } } \
        else { _Pragma("unroll") for (int n = 0; n < 2; ++n) _Pragma("unroll") for (int k = 0; k < 2; ++k) dst[n][k] = *(const PG8_LAS frag_t*)(lds + PG8_SB(b, h) + boff + n * 2048 + k * 1024); } } while (0)
#define PG8_MMA(ai, bj, At, Bt) do { __builtin_amdgcn_s_setprio(1); _Pragma("unroll") for (int m = 0; m < 4; ++m) _Pragma("unroll") for (int n = 0; n < 2; ++n) { \
        if constexpr (F8) acc[ai][bj][m][n] = __builtin_amdgcn_mfma_scale_f32_16x16x128_f8f6f4(Bt[n][0], At[m][0], acc[ai][bj][m][n], 0, 0, 0, 0x7f7f7f7f, 0, 0x7f7f7f7f); \
        else { _Pragma("unroll") for (int k = 0; k < 2; ++k) acc[ai][bj][m][n] = mma_bf16(Bt[n][k], At[m][k], acc[ai][bj][m][n]); } } __builtin_amdgcn_s_setprio(0); } while (0)
#define PG8_WAIT_V(n) asm volatile("s_waitcnt vmcnt(" #n ")" ::: "memory")
#define PG8_WAIT_L(n) asm volatile("s_waitcnt lgkmcnt(" #n ")" ::: "memory")
#define PG8_BAR __builtin_amdgcn_s_barrier()
#define PG8_SCHED __builtin_amdgcn_sched_barrier(0)
    const __amdgpu_buffer_rsrc_t rsA = __builtin_amdgcn_make_buffer_rsrc((void*)g.A, (short)0, (int)((size_t)g.M * K * EB), 0x00020000), rsB = __builtin_amdgcn_make_buffer_rsrc((void*)g.Bt, (short)0, (int)((size_t)g.N * K * EB), 0x00020000);
    Unit cur, nxt; int ui = 0;
    if (!S.next(0, cur)) return;
    f32x4 acc[2][2][4][2];
#pragma unroll
    for (int a = 0; a < 2; ++a)
#pragma unroll
        for (int b = 0; b < 2; ++b)
#pragma unroll
            for (int m = 0; m < 4; ++m)
#pragma unroll
                for (int n = 0; n < 2; ++n) acc[a][b][m][n] = (f32x4){0.f, 0.f, 0.f, 0.f};
    typedef typename FragT<F8>::type frag_t;
    frag_t At[4][F8 ? 1 : 2], B0[2][F8 ? 1 : 2], B1[2][F8 ? 1 : 2];
    const char* cA = (const char*)g.A + (size_t)cur.pm * tstep; const char* cB = (const char*)g.Bt + (size_t)cur.pn * tstep;
    S.a_ready(cur);
    if constexpr (SP2) {
        PG8_STAGE_X(PG8_SB(0, 0), cB, voffB, rsB, g.Bt); PG8_STAGE_X(PG8_SB(0, 1), cB + hstep, voffB, rsB, g.Bt); PG8_STAGE_X(PG8_SA(0, 0), cA, voffA, rsA, g.A); PG8_STAGE_X(PG8_SA(0, 1), cA + hstep, voffA, rsA, g.A);
        if (wr == 1) PG8_BAR;
        PG8_WAIT_V(2); PG8_BAR;
        PG8_STAGE_X(PG8_SB(1, 0), cB + kstep, voffB, rsB, g.Bt); PG8_STAGE_X(PG8_SA(1, 0), cA + kstep, voffA, rsA, g.A); PG8_STAGE_X(PG8_SB(1, 1), cB + hstep + kstep, voffB, rsB, g.Bt);
        PG8_WAIT_V(6); PG8_BAR;
    } else {
        PG8_STAGE_X(PG8_SB(0, 0), cB, voffB, rsB, g.Bt); PG8_STAGE_X(PG8_SA(0, 0), cA, voffA, rsA, g.A); PG8_STAGE_X(PG8_SB(0, 1), cB + hstep, voffB, rsB, g.Bt); PG8_STAGE_X(PG8_SA(0, 1), cA + hstep, voffA, rsA, g.A);
        if (wr == 1) PG8_BAR;
        PG8_WAIT_V(4); PG8_BAR;
        PG8_STAGE_X(PG8_SB(1, 0), cB + kstep, voffB, rsB, g.Bt); PG8_STAGE_X(PG8_SA(1, 0), cA + kstep, voffA, rsA, g.A); PG8_STAGE_X(PG8_SB(1, 1), cB + hstep + kstep, voffB, rsB, g.Bt);
        PG8_WAIT_V(6); PG8_BAR;
    }
    for (;;) {
        const bool has_next = S.next(ui + 1, nxt);
        const char* nA = has_next ? (const char*)g.A + (size_t)nxt.pm * tstep : cA; const char* nB = has_next ? (const char*)g.Bt + (size_t)nxt.pn * tstep : cB;
        for (int t = 0; t < nt; t += 2) {
            const bool last = (t == nt - 2);
            const char* a1 = cA + (size_t)(t + 1) * kstep;
            const char* a2 = last ? nA : cA + (size_t)(t + 2) * kstep; const char* b2 = last ? nB : cB + (size_t)(t + 2) * kstep;
            const char* a3 = a2 + kstep; const char* b3 = b2 + kstep;
            if (last && has_next) S.a_ready(nxt);
            if constexpr (SP2) {
            PG8_LDB(B0, 0, 0); PG8_LDB(B1, 0, 1); PG8_SCHED; PG8_LDA(At, 0, 0); PG8_STAGE_X(PG8_SA(1, 1), a1 + hstep, voffA, rsA, g.A);
            PG8_WAIT_V(8); PG8_WAIT_L(0); PG8_BAR; PG8_MMA(0, 0, At, B0); PG8_MMA(0, 1, At, B1); PG8_BAR; PG8_SCHED;
            PG8_LDA(At, 0, 1); PG8_STAGE_X(PG8_SB(0, 0), b2, voffB, rsB, g.Bt); PG8_STAGE_X(PG8_SB(0, 1), b2 + hstep, voffB, rsB, g.Bt); PG8_STAGE_X(PG8_SA(0, 0), a2, voffA, rsA, g.A);
            PG8_WAIT_V(8); PG8_WAIT_L(0); PG8_BAR; PG8_MMA(1, 0, At, B0); PG8_MMA(1, 1, At, B1); PG8_BAR; PG8_SCHED;
            PG8_LDB(B0, 1, 0); PG8_LDB(B1, 1, 1); PG8_SCHED; PG8_LDA(At, 1, 0); PG8_STAGE_X(PG8_SA(0, 1), a2 + hstep, voffA, rsA, g.A);
            PG8_WAIT_V(8); PG8_WAIT_L(0); PG8_BAR; PG8_MMA(0, 0, At, B0); PG8_MMA(0, 1, At, B1); PG8_BAR; PG8_SCHED;
            PG8_LDA(At, 1, 1); PG8_STAGE_X(PG8_SB(1, 0), b3, voffB, rsB, g.Bt); PG8_STAGE_X(PG8_SB(1, 1), b3 + hstep, voffB, rsB, g.Bt); PG8_STAGE_X(PG8_SA(1, 0), a3, voffA, rsA, g.A);
            PG8_WAIT_V(8); PG8_WAIT_L(0); PG8_BAR; PG8_MMA(1, 0, At, B0); PG8_MMA(1, 1, At, B1); PG8_BAR; PG8_SCHED;
            } else {
            PG8_LDB(B0, 0, 0); PG8_SCHED; PG8_LDA(At, 0, 0); PG8_STAGE_X(PG8_SA(1, 1), a1 + hstep, voffA, rsA, g.A);
            PG8_WAIT_L(8); PG8_BAR; PG8_WAIT_L(0); PG8_MMA(0, 0, At, B0); PG8_BAR; PG8_SCHED;
            PG8_LDB(B1, 0, 1); PG8_STAGE_X(PG8_SB(0, 0), b2, voffB, rsB, g.Bt);
            PG8_BAR; PG8_WAIT_L(0); PG8_MMA(0, 1, At, B1); PG8_BAR;
            PG8_LDA(At, 0, 1); PG8_STAGE_X(PG8_SA(0, 0), a2, voffA, rsA, g.A);
            PG8_BAR; PG8_WAIT_L(0); PG8_MMA(1, 0, At, B0); PG8_BAR; PG8_SCHED;
            PG8_STAGE_X(PG8_SB(0, 1), b2 + hstep, voffB, rsB, g.Bt);
            PG8_WAIT_V(6); PG8_BAR; PG8_MMA(1, 1, At, B1); PG8_BAR;
            PG8_LDB(B0, 1, 0); PG8_SCHED; PG8_LDA(At, 1, 0); PG8_STAGE_X(PG8_SA(0, 1), a2 + hstep, voffA, rsA, g.A);
            PG8_WAIT_L(8); PG8_BAR; PG8_WAIT_L(0); PG8_MMA(0, 0, At, B0); PG8_BAR; PG8_SCHED;
            PG8_LDB(B1, 1, 1); PG8_STAGE_X(PG8_SB(1, 0), b3, voffB, rsB, g.Bt);
            PG8_BAR; PG8_WAIT_L(0); PG8_MMA(0, 1, At, B1); PG8_BAR;
            PG8_LDA(At, 1, 1); PG8_STAGE_X(PG8_SA(1, 0), a3, voffA, rsA, g.A);
            PG8_BAR; PG8_WAIT_L(0); PG8_MMA(1, 0, At, B0); PG8_BAR; PG8_SCHED;
            PG8_STAGE_X(PG8_SB(1, 1), b3 + hstep, voffB, rsB, g.Bt);
            PG8_WAIT_V(6); PG8_BAR; PG8_MMA(1, 1, At, B1); PG8_BAR;
            }
        }
        if constexpr (ALIGN_EPI) { if (wr == 0) PG8_BAR; }
        if constexpr (!Epi::AFTER_DRAIN) { E(acc, cur, wr, wc, fr, fq); S.done(cur); }
        if (!has_next) break;
#pragma unroll
        for (int a = 0; a < 2; ++a)
#pragma unroll
            for (int b = 0; b < 2; ++b)
#pragma unroll
                for (int m = 0; m < 4; ++m)
#pragma unroll
                    for (int n = 0; n < 2; ++n) acc[a][b][m][n] = (f32x4){0.f, 0.f, 0.f, 0.f};
        cur = nxt; cA = nA; cB = nB; ++ui;
        if constexpr (ALIGN_EPI) { if (wr == 1) PG8_BAR; }
    }
    PG8_WAIT_V(0);
    if constexpr (!ALIGN_EPI) { if (wr == 0) PG8_BAR; }
    PG8_BAR;
    if constexpr (Epi::AFTER_DRAIN) { E.fused(acc, cur, wr, wc, fr, fq, lds, wid, lane); S.done(cur); }
#undef PG8_SA
#undef PG8_SB
#undef PG8_STAGE_X
#undef PG8_LDA
#undef PG8_LDB
#undef PG8_MMA
#undef PG8_WAIT_V
#undef PG8_WAIT_L
#undef PG8_BAR
#undef PG8_SCHED
}
}
#define GAS __attribute__((address_space(1)))
#define LAS __attribute__((address_space(3)))
typedef unsigned short bf16_t;
typedef unsigned u32x4 __attribute__((ext_vector_type(4)));
typedef unsigned u32x2 __attribute__((ext_vector_type(2)));
typedef float f32x4 __attribute__((ext_vector_type(4)));
typedef float f32x2 __attribute__((ext_vector_type(2)));
typedef float f32x16 __attribute__((ext_vector_type(16)));
typedef short bf16x8 __attribute__((ext_vector_type(8)));
typedef short s16x4 __attribute__((ext_vector_type(4)));
typedef __bf16 bf16x2_t __attribute__((ext_vector_type(2)));

namespace mk {
constexpr int M = 16384, D = 4096, S = 2048, NB = 8, PW = 12298, NH = 32, NE = 16384;
constexpr int NWAVES = 8;
constexpr size_t MiB = 1u << 20;
constexpr size_t WS_CTL = 0, CTL_ZERO_BYTES = 1 * MiB;
constexpr size_t WS_RSTD = 2 * MiB, WS_LOGF = 3 * MiB, WS_WQK = 4 * MiB, WS_WOUT = 20 * MiB, WS_WIN = 52 * MiB, WS_U16 = 148 * MiB, WS_V16 = 276 * MiB,
                 WS_XB = 404 * MiB, WS_Q = 532 * MiB, WS_K = 660 * MiB, WS_V = 788 * MiB, WS_OB = 916 * MiB, WS_X2 = 1792 * MiB, WS_END = 2048 * MiB;
constexpr size_t WS_SC = WS_Q;
constexpr int CW_BAR = 4096;
constexpr int CW_QUEUE = 16384;
constexpr int RING_BYTES = 131072, LDSCTL_OFF = RING_BYTES, MISC_OFF = LDSCTL_OFF + 320, LDS_BYTES = 147456;

struct Args { const float* in[13]; float* out; unsigned char* ws; int ph_lo, ph_hi; };

__device__ __forceinline__ unsigned f2bf(float f) { unsigned u = __builtin_bit_cast(unsigned, f); return (u + 0x7fffu + ((u >> 16) & 1u)) >> 16; }
__device__ __forceinline__ unsigned pk2(float lo, float hi) { return f2bf(lo) | (f2bf(hi) << 16); }
__device__ __forceinline__ float bf_lo(unsigned w) { return __builtin_bit_cast(float, w << 16); }
__device__ __forceinline__ float bf_hi(unsigned w) { return __builtin_bit_cast(float, w & 0xffff0000u); }
__device__ __forceinline__ float wsum(float v) {
#pragma unroll
    for (int o = 1; o < 64; o <<= 1) v += __shfl_xor(v, o);
    return v;
}
__device__ __forceinline__ float wmax(float v) {
#pragma unroll
    for (int o = 1; o < 64; o <<= 1) v = fmaxf(v, __shfl_xor(v, o));
    return v;
}
__device__ __forceinline__ int wmin_i(int v) {
#pragma unroll
    for (int o = 1; o < 64; o <<= 1) { const int t = __shfl_xor(v, o); v = t < v ? t : v; }
    return v;
}
constexpr float US = 1024.0f, VS = 32.0f, US_INV = 1.0f / 1024.0f, VS_INV = 1.0f / 32.0f;
__device__ __forceinline__ float clamp8(float x) { return fminf(fmaxf(x, -224.0f), 224.0f); }
__device__ __forceinline__ float logsig(float z) { return fminf(z, 0.f) - 0.6931471805599453f * __builtin_amdgcn_logf(1.0f + __builtin_amdgcn_exp2f(-fabsf(z) * 1.4426950408889634f)); }
__device__ __forceinline__ float gelu_erf(float v) {
    const float av = fabsf(v), t = __builtin_amdgcn_rcpf(av * 0.2316418882f + 1.0f);
    float q = t * 0.5307027145f + (-0.7265760135f); q = q * t + 0.7107068705f; q = q * t + (-0.142248368f); q = q * t + 0.127414796f; q = q * t;
    const float e = __builtin_amdgcn_exp2f((v * v) * (-0.72134752044f));
    const float m = v * (q * e);
    return v < 0.f ? m : v - m;
}
#define LDS_WAIT() asm volatile("s_waitcnt lgkmcnt(0)" ::: "memory")
#define FRESH_LDS(l) do { unsigned v_ = (unsigned)(size_t)(l); asm volatile("" : "+s"(v_)); (l) = (LAS unsigned char*)(size_t)v_; } while (0)
#define FRESH_BID() int bid = blockIdx.x, G = gridDim.x; asm volatile("" : "+s"(bid), "+s"(G))
#define FRESH_TID() int tid; { int w_ = wave0, l_ = (int)__builtin_amdgcn_mbcnt_hi(~0u, __builtin_amdgcn_mbcnt_lo(~0u, 0u)); asm volatile("" : "+s"(w_)); asm volatile("" : "+v"(l_)); tid = w_ * 64 + l_; } const int lane = tid & 63, wave = __builtin_amdgcn_readfirstlane(tid >> 6); (void)lane; (void)wave

__device__ __forceinline__ void transpose_item(const float* W, int K, int ldw, int ncols, const float* gain, bf16_t* WT, LAS float* scr, int item, int lane) {
    const int nblk = ncols / 32, kb = item / nblk, nb = item % nblk, k0 = 64 * kb, n0 = 32 * nb;
#pragma unroll 8
    for (int i = 0; i < 32; ++i) { const int kk = 2 * i + (lane >> 5); float v = W[(size_t)(k0 + kk) * ldw + n0 + (lane & 31)]; if (gain) v *= gain[k0 + kk]; scr[kk * 33 + (lane & 31)] = v; }
    LDS_WAIT(); asm volatile("" ::: "memory");
    const int c = lane & 7;
#pragma unroll
    for (int j = 0; j < 4; ++j) { const int n = (lane >> 3) + 8 * j; const LAS float* s = scr + (8 * c) * 33 + n;
        u32x4 o; o.x = pk2(s[0 * 33], s[1 * 33]); o.y = pk2(s[2 * 33], s[3 * 33]); o.z = pk2(s[4 * 33], s[5 * 33]); o.w = pk2(s[6 * 33], s[7 * 33]);
        *(u32x4*)(WT + (size_t)(n0 + n) * K + k0 + 8 * c) = o; }
    LDS_WAIT(); asm volatile("" ::: "memory");
}

typedef const __attribute__((address_space(4))) Args* KArgsT;
__device__ __forceinline__ unsigned pk4_fp8(float a, float b, float c, float d) { int p = __builtin_amdgcn_cvt_pk_fp8_f32(clamp8(a), clamp8(b), 0, false); p = __builtin_amdgcn_cvt_pk_fp8_f32(clamp8(c), clamp8(d), p, true); return (unsigned)p; }
__device__ __forceinline__ void transpose_item8(const float* W, int K, int ldw, int ncols, const float* gain, float scale, unsigned char* WT, LAS float* scr, int item, int lane) {
    const int nblk = ncols / 32, kb = item / nblk, nb = item % nblk, k0 = 64 * kb, n0 = 32 * nb;
    const int kr = lane >> 3, nq = (lane & 7) * 4;
    f32x4 v[8];
#pragma unroll
    for (int i = 0; i < 8; ++i) { const float* p = W + (size_t)(k0 + 8 * i + kr) * ldw + n0 + nq; v[i] = (f32x4){p[0], p[1], p[2], p[3]}; }
#pragma unroll
    for (int i = 0; i < 8; ++i) { const int kk = 8 * i + kr; const float g = (gain ? gain[k0 + kk] : 1.0f) * scale; LAS float* d = scr + kk * 33 + nq; d[0] = v[i][0] * g; d[1] = v[i][1] * g; d[2] = v[i][2] * g; d[3] = v[i][3] * g; }
    LDS_WAIT(); asm volatile("" ::: "memory");
    const int c = lane & 7;
#pragma unroll
    for (int j = 0; j < 4; ++j) { const int n = (lane >> 3) + 8 * j; const LAS float* s = scr + (8 * c) * 33 + n;
        u32x2 o; o.x = pk4_fp8(s[0 * 33], s[1 * 33], s[2 * 33], s[3 * 33]); o.y = pk4_fp8(s[4 * 33], s[5 * 33], s[6 * 33], s[7 * 33]);
        *(u32x2*)(WT + (size_t)(n0 + n) * K + k0 + 8 * c) = o; }
    LDS_WAIT(); asm volatile("" ::: "memory");
}
__device__ __forceinline__ void conv_phase(KArgsT ka, int l, LAS unsigned char* lds, int wave0) {
    FRESH_TID(); FRESH_LDS(lds); FRESH_BID();
    unsigned char* ws = ka->ws;
    const float* ln1 = ka->in[1] + (size_t)l * D; const float* w_in = ka->in[2] + (size_t)l * D * PW; const float* w_out = ka->in[5] + (size_t)l * D * D;
    const float* ln2 = ka->in[6] + (size_t)l * D; const float* wq = ka->in[7] + (size_t)l * D * 2048;
    const float* k1 = ka->in[8] + (size_t)l * 8 * 128 * 128; const float* k2 = ka->in[9] + (size_t)l * 8 * 128 * 128;
    const float* pu = ka->in[10] + (size_t)l * NE * D; const float* pv = ka->in[11] + (size_t)l * NE * D;
    bf16_t* WQK = (bf16_t*)(ws + WS_WQK); bf16_t* WOUT = (bf16_t*)(ws + WS_WOUT); bf16_t* WIN = (bf16_t*)(ws + WS_WIN); bf16_t* U16 = (bf16_t*)(ws + WS_U16); bf16_t* V16 = (bf16_t*)(ws + WS_V16);
    {
        LAS float* Ks = (LAS float*)lds;
        LAS float* Ws = (LAS float*)(lds + 128 * 132 * 4);
        for (int it = bid; it < 1024; it += G) {
            const int gi = it >> 6, c0 = (it & 63) * 64;
            const float* key = ((gi & 1) ? k2 : k1) + (size_t)(gi >> 1) * 128 * 128;
            for (int i = tid; i < 4096; i += 512) { const int r = i >> 5, c4 = (i & 31) * 4; *(LAS f32x4*)(Ks + r * 132 + c4) = *(const f32x4*)(key + r * 128 + c4); }
            for (int i = tid; i < 2048; i += 512) { const int r = i >> 5, c4 = (i & 31) * 4; *(LAS f32x4*)(Ws + r * 132 + c4) = *(const f32x4*)(wq + (size_t)(c0 + r) * 2048 + gi * 128 + c4); }
            __syncthreads();
            const int tc = tid & 15, tn = tid >> 4;
            float acc[4][4];
#pragma unroll
            for (int i = 0; i < 4; ++i)
#pragma unroll
                for (int j = 0; j < 4; ++j) acc[i][j] = 0.f;
#pragma unroll 2
            for (int d = 0; d < 128; d += 4) {
                f32x4 kv[4], wv[4];
#pragma unroll
                for (int i = 0; i < 4; ++i) kv[i] = *(const LAS f32x4*)(Ks + (4 * tn + i) * 132 + d);
#pragma unroll
                for (int j = 0; j < 4; ++j) wv[j] = *(const LAS f32x4*)(Ws + (tc + 16 * j) * 132 + d);
#pragma unroll
                for (int i = 0; i < 4; ++i)
#pragma unroll
                    for (int j = 0; j < 4; ++j) acc[i][j] += kv[i][0] * wv[j][0] + kv[i][1] * wv[j][1] + kv[i][2] * wv[j][2] + kv[i][3] * wv[j][3];
            }
#pragma unroll
            for (int j = 0; j < 4; ++j) { const int c = c0 + tc + 16 * j; const float gg = ln2[c];
#pragma unroll
                for (int i = 0; i < 4; ++i) WQK[(size_t)(gi * 128 + 4 * tn + i) * D + c] = (bf16_t)f2bf(acc[i][j] * gg); }
            __syncthreads();
        }
        __syncthreads();
    }
    const int gw = bid * NWAVES + wave, NGW = G * NWAVES;
    {
        unsigned char* U8 = (unsigned char*)U16; unsigned char* V8 = U8 + (size_t)NE * D;
        for (int r = gw; r < NE; r += NGW) {
            const float* us = pu + (size_t)r * D; const float* vs = pv + (size_t)r * D;
#pragma unroll
            for (int i = 0; i < 4; ++i) { const int c = 1024 * i + 16 * lane;
                u32x4 ou, ov;
#pragma unroll
                for (int q = 0; q < 4; ++q) { const f32x4 u0 = *(const f32x4*)(us + c + 4 * q), g0 = *(const f32x4*)(ln2 + c + 4 * q), v0 = *(const f32x4*)(vs + c + 4 * q);
                    int pu_ = __builtin_amdgcn_cvt_pk_fp8_f32(clamp8(u0[0] * g0[0] * US), clamp8(u0[1] * g0[1] * US), 0, false); pu_ = __builtin_amdgcn_cvt_pk_fp8_f32(clamp8(u0[2] * g0[2] * US), clamp8(u0[3] * g0[3] * US), pu_, true);
                    int pv_ = __builtin_amdgcn_cvt_pk_fp8_f32(clamp8(v0[0] * VS), clamp8(v0[1] * VS), 0, false); pv_ = __builtin_amdgcn_cvt_pk_fp8_f32(clamp8(v0[2] * VS), clamp8(v0[3] * VS), pv_, true);
                    ou[q] = (unsigned)pu_; ov[q] = (unsigned)pv_; }
                *(u32x4*)(U8 + (size_t)r * D + c) = ou; *(u32x4*)(V8 + (size_t)r * D + c) = ov; }
        }
    }
    {
        LAS float* scr = (LAS float*)(lds + wave * 16384);
        constexpr int I_O = (D / 64) * (D / 32), I_IN = (D / 64) * (12288 / 32);
        for (int it = gw; it < I_O + I_IN; it += NGW) {
            if (it < I_O) transpose_item8(w_out, D, D, D, nullptr, US, (unsigned char*)WOUT, scr, it, lane);
            else transpose_item8(w_in, D, PW, 12288, ln1, US, (unsigned char*)WIN, scr, it - I_O, lane);
        }
    }
}

template <bool WITH_F>
__device__ __forceinline__ void prep_phase(const float* X, bf16_t* XB, float* RSTD, const float* w_in, const float* ln1, const float* bf, float* LOGF, LAS unsigned char* lds, int wave0) {
    FRESH_TID(); FRESH_LDS(lds); FRESH_BID();
    LAS unsigned short* gfs = (LAS unsigned short*)lds;
    if (WITH_F) {
        __syncthreads();
        for (int c = tid; c < D; c += 512) { const float g = ln1[c]; const float* wr = w_in + (size_t)c * PW + 12288;
#pragma unroll
            for (int j = 0; j < 10; ++j) gfs[j * D + c] = (unsigned short)f2bf(wr[j] * g); }
        __syncthreads();
    }
    const int gw = bid * NWAVES + wave, NGW = G * NWAVES;
    for (int m = gw; m < M; m += NGW) {
        const f32x4* xr = (const f32x4*)(X + (size_t)m * D) + lane;
        f32x4 v[16]; float ss = 0.f;
#pragma unroll
        for (int i = 0; i < 16; ++i) { v[i] = xr[64 * i]; ss += (v[i][0] * v[i][0] + v[i][1] * v[i][1]) + (v[i][2] * v[i][2] + v[i][3] * v[i][3]); }
        ss = wsum(ss);
        const float rstd = rsqrtf(ss * (1.0f / D) + 1e-6f);
        if (WITH_F) {
            unsigned* o8 = (unsigned*)((unsigned char*)XB + (size_t)m * D) + lane;
#pragma unroll
            for (int i = 0; i < 16; ++i) o8[64 * i] = pk4_fp8(v[i][0], v[i][1], v[i][2], v[i][3]);
        } else {
        u32x2* o = (u32x2*)(XB + (size_t)m * D) + lane;
#pragma unroll
        for (int i = 0; i < 16; ++i) { u32x2 w; w.x = pk2(v[i][0], v[i][1]); w.y = pk2(v[i][2], v[i][3]); o[64 * i] = w; }
        }
        if (lane == 0) RSTD[m] = rstd;
        if (WITH_F) {
            float mine = 0.f;
#pragma unroll 1
            for (int j = 0; j < 10; ++j) { float s = 0.f;
#pragma unroll
                for (int i = 0; i < 16; ++i) { const u32x2 gp = *(const LAS u32x2*)(gfs + j * D + 256 * i + 4 * lane);
                    s += (v[i][0] * bf_lo(gp.x) + v[i][1] * bf_hi(gp.x)) + (v[i][2] * bf_lo(gp.y) + v[i][3] * bf_hi(gp.y)); }
                s = wsum(s); if (lane == j) mine = s; }
            if (lane < 10) { const int b = m >> 11, s = m & 2047; LOGF[(size_t)(b * 10 + lane) * S + s] = logsig(mine * rstd + bf[lane]); }
        }
    }
}


__device__ __forceinline__ unsigned wave_max_u32(unsigned v) {
    v = max(v, (unsigned)__builtin_amdgcn_update_dpp(0, (int)v, 0x111, 0xF, 0xF, true));
    v = max(v, (unsigned)__builtin_amdgcn_update_dpp(0, (int)v, 0x112, 0xF, 0xF, true));
    v = max(v, (unsigned)__builtin_amdgcn_update_dpp(0, (int)v, 0x114, 0xF, 0xF, true));
    v = max(v, (unsigned)__builtin_amdgcn_update_dpp(0, (int)v, 0x118, 0xF, 0xF, true));
    v = max(v, (unsigned)__builtin_amdgcn_update_dpp((int)v, (int)v, 0x142, 0xA, 0xF, false));
    v = max(v, (unsigned)__builtin_amdgcn_update_dpp((int)v, (int)v, 0x143, 0xC, 0xF, false));
    return (unsigned)__builtin_amdgcn_readlane((int)v, 63);
}
__device__ __forceinline__ float wave_sum_dpp(float x) {
    int v = __builtin_bit_cast(int, x);
#define DPP_ADD(ctrl, rm, bc, oldv) v = __builtin_bit_cast(int, __builtin_bit_cast(float, v) + __builtin_bit_cast(float, __builtin_amdgcn_update_dpp(oldv, v, ctrl, rm, 0xF, bc)))
    DPP_ADD(0x111, 0xF, true, 0); DPP_ADD(0x112, 0xF, true, 0); DPP_ADD(0x114, 0xF, true, 0); DPP_ADD(0x118, 0xF, true, 0);
#undef DPP_ADD
    const float r0 = __builtin_bit_cast(float, __builtin_amdgcn_readlane(v, 15)), r1 = __builtin_bit_cast(float, __builtin_amdgcn_readlane(v, 31)), r2 = __builtin_bit_cast(float, __builtin_amdgcn_readlane(v, 47)), r3 = __builtin_bit_cast(float, __builtin_amdgcn_readlane(v, 63));
    return (r0 + r1) + (r2 + r3);
}
__device__ __forceinline__ unsigned ordkey(float x) { const unsigned u = __builtin_bit_cast(unsigned, x); return (u & 0x80000000u) ? ~u : (u | 0x80000000u); }
#define RFL(x) __builtin_amdgcn_readfirstlane(x)
template <bool FINAL, bool ROUTE_EXT = false, bool SKIP_U = false>
__device__ __forceinline__ void peer_phase(const float* SC, const bf16_t* XB, const float* RSTD, const bf16_t* U16, const bf16_t* V16, const float* X1, float* XO, const float* fg,
                                           LAS unsigned char* lds, int wave0) {
    FRESH_TID(); FRESH_LDS(lds); FRESH_BID();
    LAS int* s_eid = (LAS int*)(lds + wave * 1024); LAS float* s_w = (LAS float*)(lds + wave * 1024 + 512);
    const int gw = bid * NWAVES + wave, NGW = G * NWAVES;
    const float NEG = -3.0e38f;
    for (int tok = gw; tok < M; tok += NGW) {
        const float* sc = SC + (size_t)tok * 2048;
        if (ROUTE_EXT) { const int* ee = (const int*)SC; const float* gg = (const float*)XB;     (void)ee; (void)gg; }
        for (int h = 0; h < (ROUTE_EXT ? 0 : 8); ++h) {
            float a0 = sc[h * 256 + lane], a1 = sc[h * 256 + 64 + lane], c0 = sc[h * 256 + 128 + lane], c1 = sc[h * 256 + 192 + lane];
            float v1 = 0.f, v2 = 0.f; int i1 = 0, i2 = 0;
            for (int it = 0; it < 16; ++it) {
                { const float m = wmax(fmaxf(a0, a1)); int cand = 1 << 30; if (a0 == m) cand = lane; else if (a1 == m) cand = lane + 64;
                  const int n = wmin_i(cand); if (n == lane) a0 = NEG; if (n == lane + 64) a1 = NEG; if (lane == it) { v1 = m; i1 = n; } }
                { const float m = wmax(fmaxf(c0, c1)); int cand = 1 << 30; if (c0 == m) cand = lane; else if (c1 == m) cand = lane + 64;
                  const int n = wmin_i(cand); if (n == lane) c0 = NEG; if (n == lane + 64) c1 = NEG; if (lane == it) { v2 = m; i2 = n; } }
            }
            float d0, d1, d2, d3;
            { const float va = __shfl(v1, lane >> 2); d0 = va + __shfl(v2, (lane & 3) * 4 + 0); d1 = va + __shfl(v2, (lane & 3) * 4 + 1); d2 = va + __shfl(v2, (lane & 3) * 4 + 2); d3 = va + __shfl(v2, (lane & 3) * 4 + 3); }
            float best = 0.f; int be = 0;
            for (int it = 0; it < 16; ++it) {
                const float m = wmax(fmaxf(fmaxf(d0, d1), fmaxf(d2, d3)));
                int cand = 1 << 30;
                if (d0 == m) cand = lane * 4; else if (d1 == m) cand = lane * 4 + 1; else if (d2 == m) cand = lane * 4 + 2; else if (d3 == m) cand = lane * 4 + 3;
                const int pos = wmin_i(cand);
                if (pos == lane * 4) d0 = NEG; if (pos == lane * 4 + 1) d1 = NEG; if (pos == lane * 4 + 2) d2 = NEG; if (pos == lane * 4 + 3) d3 = NEG;
                const int e = ((__shfl(i1, (pos >> 4) & 15) & 127) << 7) | (__shfl(i2, pos & 15) & 127);
                if (lane == it) { best = m; be = e; }
            }
            const float mx = __shfl(best, 0);
            const float p = lane < 16 ? __builtin_amdgcn_exp2f((best - mx) * 1.4426950408889634f) : 0.f;
            const float sm = wsum(p);
            if (lane < 16) { s_eid[h * 16 + lane] = be; s_w[h * 16 + lane] = p / sm; }
        }
        if (ROUTE_EXT) { const int* ee = (const int*)fg; const float* gg = (const float*)(ee + (size_t)M * 128); s_eid[lane] = ee[(size_t)tok * 128 + lane]; s_eid[lane + 64] = ee[(size_t)tok * 128 + lane + 64]; s_w[lane] = gg[(size_t)tok * 128 + lane]; s_w[lane + 64] = gg[(size_t)tok * 128 + lane + 64]; }
        LDS_WAIT(); asm volatile("" ::: "memory");
        if (!SKIP_U) {
            u32x4 xr[8];
            { const u32x4* p_ = (const u32x4*)(XB + (size_t)tok * D) + lane;
#pragma unroll
              for (int i = 0; i < 8; ++i) xr[i] = p_[64 * i]; }
            const float rstd = RSTD[tok];
#define LOADROW(dst, base, e) do { const u32x4* p_ = (const u32x4*)((base) + (size_t)(e) * D) + lane; _Pragma("unroll") for (int i_ = 0; i_ < 8; ++i_) dst[i_] = p_[64 * i_]; } while (0)
#define UDOT(row, j) do { float d_ = 0.f; _Pragma("unroll") for (int i_ = 0; i_ < 8; ++i_) { _Pragma("unroll") for (int k_ = 0; k_ < 4; ++k_) \
                { d_ = fmaf(bf_lo(xr[i_][k_]), bf_lo(row[i_][k_]), d_); d_ = fmaf(bf_hi(xr[i_][k_]), bf_hi(row[i_][k_]), d_); } } \
            d_ = wsum(d_) * rstd; const float ge_ = gelu_erf(d_); if (lane == 0) s_w[j] *= ge_; } while (0)
            u32x4 ra[8], rb[8];
            { const int e0 = RFL(s_eid[0]); LOADROW(ra, U16, e0); }
            for (int j = 0; j < 128; j += 2) {
                { const int e1 = RFL(s_eid[j + 1]); LOADROW(rb, U16, e1); }
                UDOT(ra, j);
                if (j + 2 < 128) { const int e2 = RFL(s_eid[j + 2]); LOADROW(ra, U16, e2); }
                UDOT(rb, j + 1);
            }
#undef UDOT
        }
        LDS_WAIT(); asm volatile("" ::: "memory");
        {
            float acc[8][8];
#pragma unroll
            for (int i = 0; i < 8; ++i)
#pragma unroll
                for (int k = 0; k < 8; ++k) acc[i][k] = 0.f;
#define VACC(row, j) do { const float w_ = s_w[j]; _Pragma("unroll") for (int i_ = 0; i_ < 8; ++i_) { _Pragma("unroll") for (int k_ = 0; k_ < 4; ++k_) { \
                acc[i_][2 * k_] = fmaf(w_, bf_lo(row[i_][k_]), acc[i_][2 * k_]); acc[i_][2 * k_ + 1] = fmaf(w_, bf_hi(row[i_][k_]), acc[i_][2 * k_ + 1]); } } } while (0)
            u32x4 ra[8], rb[8];
            { const int e0 = RFL(s_eid[0]); LOADROW(ra, V16, e0); }
            for (int j = 0; j < 128; j += 2) {
                { const int e1 = RFL(s_eid[j + 1]); LOADROW(rb, V16, e1); }
                VACC(ra, j);
                if (j + 2 < 128) { const int e2 = RFL(s_eid[j + 2]); LOADROW(ra, V16, e2); }
                VACC(rb, j + 1);
            }
#undef VACC
#undef LOADROW
            const float* x1 = X1 + (size_t)tok * D; float* xo = XO + (size_t)tok * D;
            float ss = 0.f;
#pragma unroll
            for (int i = 0; i < 8; ++i) { const int c = 512 * i + 8 * lane; const f32x4 p0 = *(const f32x4*)(x1 + c), p1 = *(const f32x4*)(x1 + c + 4);
                acc[i][0] += p0[0]; acc[i][1] += p0[1]; acc[i][2] += p0[2]; acc[i][3] += p0[3]; acc[i][4] += p1[0]; acc[i][5] += p1[1]; acc[i][6] += p1[2]; acc[i][7] += p1[3];
#pragma unroll
                for (int k = 0; k < 8; ++k) ss += acc[i][k] * acc[i][k]; }
            float rs = 1.f;
            if (FINAL) { ss = wsum(ss); rs = rsqrtf(ss * (1.0f / D) + 1e-6f); }
#pragma unroll
            for (int i = 0; i < 8; ++i) { const int c = 512 * i + 8 * lane; f32x4 o0, o1;
                if (FINAL) { const f32x4 g0 = *(const f32x4*)(fg + c), g1 = *(const f32x4*)(fg + c + 4);
                    o0 = (f32x4){acc[i][0] * rs * g0[0], acc[i][1] * rs * g0[1], acc[i][2] * rs * g0[2], acc[i][3] * rs * g0[3]}; o1 = (f32x4){acc[i][4] * rs * g1[0], acc[i][5] * rs * g1[1], acc[i][6] * rs * g1[2], acc[i][7] * rs * g1[3]}; }
                else { o0 = (f32x4){acc[i][0], acc[i][1], acc[i][2], acc[i][3]}; o1 = (f32x4){acc[i][4], acc[i][5], acc[i][6], acc[i][7]}; }
                *(f32x4*)(xo + c) = o0; *(f32x4*)(xo + c + 4) = o1; }
        }
        LDS_WAIT(); asm volatile("" ::: "memory");
    }
}

__device__ __forceinline__ void peer_u_phase(const float* SC, const unsigned char* U8, const float* X1, int* EIDG, float* WG, LAS unsigned char* lds, int wave0) {
    FRESH_TID(); FRESH_LDS(lds); FRESH_BID();
    LAS int* s_eid = (LAS int*)(lds + wave * 1024); LAS float* s_w = (LAS float*)(lds + wave * 1024 + 512);
    const int gw = bid * NWAVES + wave, NGW = G * NWAVES;
    const float NEG = -3.0e38f;
    for (int tok = gw; tok < M; tok += NGW) {
        float rstd_tok;
        { const float* xr_ = X1 + (size_t)tok * D; float ss_ = 0.f;
#pragma unroll
          for (int i = 0; i < 4; ++i)
#pragma unroll
              for (int q = 0; q < 4; ++q) { const f32x4 t = *(const f32x4*)(xr_ + 1024 * i + 16 * lane + 4 * q); ss_ += (t[0] * t[0] + t[1] * t[1]) + (t[2] * t[2] + t[3] * t[3]); }
          rstd_tok = rsqrtf(wave_sum_dpp(ss_) * (1.0f / D) + 1e-6f); }
        const float* sc = SC + (size_t)tok * 2048;
        for (int h = 0; h < 8; ++h) {
            const float a0 = sc[h * 256 + lane], a1 = sc[h * 256 + 64 + lane], c0 = sc[h * 256 + 128 + lane], c1 = sc[h * 256 + 192 + lane];
            unsigned ka0 = (ordkey(a0) & ~127u) | (unsigned)(127 - lane), ka1 = (ordkey(a1) & ~127u) | (unsigned)(63 - lane);
            unsigned kc0 = (ordkey(c0) & ~127u) | (unsigned)(127 - lane), kc1 = (ordkey(c1) & ~127u) | (unsigned)(63 - lane);
            float v1 = 0.f, v2 = 0.f; int i1 = 0, i2 = 0;
            for (int it = 0; it < 16; ++it) {
                const unsigned m1 = wave_max_u32(max(ka0, ka1)), m2 = wave_max_u32(max(kc0, kc1));
                const int n1 = 127 - (int)(m1 & 127u), n2 = 127 - (int)(m2 & 127u);
                const float x1lo = __builtin_bit_cast(float, __builtin_amdgcn_readlane(__builtin_bit_cast(int, a0), n1 & 63)), x1hi = __builtin_bit_cast(float, __builtin_amdgcn_readlane(__builtin_bit_cast(int, a1), n1 & 63));
                const float x2lo = __builtin_bit_cast(float, __builtin_amdgcn_readlane(__builtin_bit_cast(int, c0), n2 & 63)), x2hi = __builtin_bit_cast(float, __builtin_amdgcn_readlane(__builtin_bit_cast(int, c1), n2 & 63));
                ka0 = ka0 == m1 ? 0u : ka0; ka1 = ka1 == m1 ? 0u : ka1; kc0 = kc0 == m2 ? 0u : kc0; kc1 = kc1 == m2 ? 0u : kc1;
                if (lane == it) { v1 = (n1 & 64) ? x1hi : x1lo; i1 = n1; v2 = (n2 & 64) ? x2hi : x2lo; i2 = n2; }
            }
            unsigned kd0, kd1, kd2, kd3;
            { const float va = __shfl(v1, lane >> 2); const int pb_ = 255 - 4 * lane;
              kd0 = (ordkey(va + __shfl(v2, (lane & 3) * 4 + 0)) & ~255u) | (unsigned)(pb_); kd1 = (ordkey(va + __shfl(v2, (lane & 3) * 4 + 1)) & ~255u) | (unsigned)(pb_ - 1);
              kd2 = (ordkey(va + __shfl(v2, (lane & 3) * 4 + 2)) & ~255u) | (unsigned)(pb_ - 2); kd3 = (ordkey(va + __shfl(v2, (lane & 3) * 4 + 3)) & ~255u) | (unsigned)(pb_ - 3); }
            float best = 0.f; int be = 0;
            for (int it = 0; it < 16; ++it) {
                const unsigned m = wave_max_u32(max(max(kd0, kd1), max(kd2, kd3)));
                const int pos = 255 - (int)(m & 255u);
                const float bv = __builtin_bit_cast(float, __builtin_amdgcn_readlane(__builtin_bit_cast(int, v1), pos >> 4)) + __builtin_bit_cast(float, __builtin_amdgcn_readlane(__builtin_bit_cast(int, v2), pos & 15));
                const int e = (__builtin_amdgcn_readlane(i1, pos >> 4) << 7) | __builtin_amdgcn_readlane(i2, pos & 15);
                kd0 = kd0 == m ? 0u : kd0; kd1 = kd1 == m ? 0u : kd1; kd2 = kd2 == m ? 0u : kd2; kd3 = kd3 == m ? 0u : kd3;
                if (lane == it) { best = bv; be = e; }
            }
            const float mx = __builtin_bit_cast(float, __builtin_amdgcn_readlane(__builtin_bit_cast(int, best), 0));
            const float p = lane < 16 ? __builtin_amdgcn_exp2f((best - mx) * (1.4426950408889634f * rstd_tok)) : 0.f;
            const float sm = wave_sum_dpp(p);
            if (lane < 16) { s_eid[h * 16 + lane] = be; s_w[h * 16 + lane] = p / sm; }
        }
        LDS_WAIT(); asm volatile("" ::: "memory");
#define LOADROW8(dst, base, e) do { const u32x4* p_ = (const u32x4*)((base) + (size_t)(e) * D) + lane; _Pragma("unroll") for (int i_ = 0; i_ < 4; ++i_) dst[i_] = p_[64 * i_]; } while (0)
        const float* x1 = X1 + (size_t)tok * D;
        {
            float xv[4][16];
#pragma unroll
            for (int i = 0; i < 4; ++i)
#pragma unroll
                for (int q = 0; q < 4; ++q) { const f32x4 t = *(const f32x4*)(x1 + 1024 * i + 16 * lane + 4 * q); xv[i][4 * q] = t[0]; xv[i][4 * q + 1] = t[1]; xv[i][4 * q + 2] = t[2]; xv[i][4 * q + 3] = t[3]; }
            const float rstd = rstd_tok * US_INV;
#define UDOT8(row, j) do { float da_ = 0.f, db_ = 0.f; _Pragma("unroll") for (int i_ = 0; i_ < 4; ++i_) { _Pragma("unroll") for (int k_ = 0; k_ < 4; ++k_) { \
                unsigned w0_ = row[i_][k_]; asm volatile("" : "+v"(w0_));     \
                const f32x2 lo_ = __builtin_amdgcn_cvt_pk_f32_fp8((int)w0_, false), hi_ = __builtin_amdgcn_cvt_pk_f32_fp8((int)w0_, true); \
                da_ = fmaf(xv[i_][4 * k_], lo_[0], da_); db_ = fmaf(xv[i_][4 * k_ + 1], lo_[1], db_); da_ = fmaf(xv[i_][4 * k_ + 2], hi_[0], da_); db_ = fmaf(xv[i_][4 * k_ + 3], hi_[1], db_); } \
                asm volatile("" : "+v"(da_), "+v"(db_)); } \
            const float d_ = wave_sum_dpp(da_ + db_) * rstd; const float ge_ = gelu_erf(d_); if (lane == 0) s_w[j] *= ge_; } while (0)
            u32x4 r0[4], r1[4], r2[4];
            { const int e_ = RFL(s_eid[0]); LOADROW8(r0, U8, e_); } { const int e_ = RFL(s_eid[1]); LOADROW8(r1, U8, e_); } { const int e_ = RFL(s_eid[2]); LOADROW8(r2, U8, e_); }
            for (int j = 0; j < 126; j += 3) {
                UDOT8(r0, j);     if (j + 3 < 128) { const int e_ = RFL(s_eid[j + 3]); LOADROW8(r0, U8, e_); }
                UDOT8(r1, j + 1); if (j + 4 < 128) { const int e_ = RFL(s_eid[j + 4]); LOADROW8(r1, U8, e_); }
                UDOT8(r2, j + 2); if (j + 5 < 128) { const int e_ = RFL(s_eid[j + 5]); LOADROW8(r2, U8, e_); }
            }
            UDOT8(r0, 126); UDOT8(r1, 127);
#undef UDOT8
        }
        LDS_WAIT(); asm volatile("" ::: "memory");
        EIDG[(size_t)tok * 128 + lane] = s_eid[lane]; EIDG[(size_t)tok * 128 + 64 + lane] = s_eid[64 + lane];
        WG[(size_t)tok * 128 + lane] = s_w[lane]; WG[(size_t)tok * 128 + 64 + lane] = s_w[64 + lane];
        LDS_WAIT(); asm volatile("" ::: "memory");
    }
#undef LOADROW8
}

template <bool FINAL>
__device__ __forceinline__ void peer_v_phase(const int* EIDG, const float* WG, const unsigned char* V8, const float* X1, float* XO, const float* fg, LAS unsigned char* lds, int wave0) {
    FRESH_TID(); FRESH_LDS(lds); FRESH_BID();
    LAS int* s_eid = (LAS int*)(lds + wave * 1024); LAS float* s_w = (LAS float*)(lds + wave * 1024 + 512);
    const int gw = bid * NWAVES + wave, NGW = G * NWAVES;
    for (int tok = gw; tok < M; tok += NGW) {
        s_eid[lane] = EIDG[(size_t)tok * 128 + lane]; s_eid[64 + lane] = EIDG[(size_t)tok * 128 + 64 + lane];
        s_w[lane] = WG[(size_t)tok * 128 + lane]; s_w[64 + lane] = WG[(size_t)tok * 128 + 64 + lane];
        LDS_WAIT(); asm volatile("" ::: "memory");
#define LOADROW8(dst, base, e) do { const u32x4* p_ = (const u32x4*)((base) + (size_t)(e) * D) + lane; _Pragma("unroll") for (int i_ = 0; i_ < 4; ++i_) dst[i_] = p_[64 * i_]; } while (0)
        const float* x1 = X1 + (size_t)tok * D; float* xo = XO + (size_t)tok * D;
        {
            float acc[4][16];
#pragma unroll
            for (int i = 0; i < 4; ++i)
#pragma unroll
                for (int k = 0; k < 16; ++k) acc[i][k] = 0.f;
#define VACC8(row, j) do { const float w_ = s_w[j]; _Pragma("unroll") for (int i_ = 0; i_ < 4; ++i_) { _Pragma("unroll") for (int k_ = 0; k_ < 4; ++k_) { \
                unsigned w0_ = row[i_][k_]; asm volatile("" : "+v"(w0_)); \
                const f32x2 lo_ = __builtin_amdgcn_cvt_pk_f32_fp8((int)w0_, false), hi_ = __builtin_amdgcn_cvt_pk_f32_fp8((int)w0_, true); \
                acc[i_][4 * k_] = fmaf(w_, lo_[0], acc[i_][4 * k_]); acc[i_][4 * k_ + 1] = fmaf(w_, lo_[1], acc[i_][4 * k_ + 1]); acc[i_][4 * k_ + 2] = fmaf(w_, hi_[0], acc[i_][4 * k_ + 2]); acc[i_][4 * k_ + 3] = fmaf(w_, hi_[1], acc[i_][4 * k_ + 3]); } \
                asm volatile("" : "+v"(acc[i_][0]), "+v"(acc[i_][1]), "+v"(acc[i_][2]), "+v"(acc[i_][3]), "+v"(acc[i_][4]), "+v"(acc[i_][5]), "+v"(acc[i_][6]), "+v"(acc[i_][7]), \
                                  "+v"(acc[i_][8]), "+v"(acc[i_][9]), "+v"(acc[i_][10]), "+v"(acc[i_][11]), "+v"(acc[i_][12]), "+v"(acc[i_][13]), "+v"(acc[i_][14]), "+v"(acc[i_][15])); } } while (0)
            u32x4 r0[4], r1[4], r2[4];
            { const int e_ = RFL(s_eid[0]); LOADROW8(r0, V8, e_); } { const int e_ = RFL(s_eid[1]); LOADROW8(r1, V8, e_); } { const int e_ = RFL(s_eid[2]); LOADROW8(r2, V8, e_); }
            for (int j = 0; j < 126; j += 3) {
                VACC8(r0, j);     if (j + 3 < 128) { const int e_ = RFL(s_eid[j + 3]); LOADROW8(r0, V8, e_); }
                VACC8(r1, j + 1); if (j + 4 < 128) { const int e_ = RFL(s_eid[j + 4]); LOADROW8(r1, V8, e_); }
                VACC8(r2, j + 2); if (j + 5 < 128) { const int e_ = RFL(s_eid[j + 5]); LOADROW8(r2, V8, e_); }
            }
            VACC8(r0, 126); VACC8(r1, 127);
#undef VACC8
#undef LOADROW8
            float ss = 0.f;
#pragma unroll
            for (int i = 0; i < 4; ++i)
#pragma unroll
                for (int q = 0; q < 4; ++q) { const f32x4 t = *(const f32x4*)(x1 + 1024 * i + 16 * lane + 4 * q);
#pragma unroll
                    for (int k = 0; k < 4; ++k) { acc[i][4 * q + k] = fmaf(acc[i][4 * q + k], VS_INV, t[k]); ss += acc[i][4 * q + k] * acc[i][4 * q + k]; } }
            float rs = 1.f;
            if (FINAL) { ss = wsum(ss); rs = rsqrtf(ss * (1.0f / D) + 1e-6f); }
#pragma unroll
            for (int i = 0; i < 4; ++i)
#pragma unroll
                for (int q = 0; q < 4; ++q) { const int c = 1024 * i + 16 * lane + 4 * q; f32x4 o_;
                    if (FINAL) { const f32x4 g_ = *(const f32x4*)(fg + c); o_ = (f32x4){acc[i][4 * q] * rs * g_[0], acc[i][4 * q + 1] * rs * g_[1], acc[i][4 * q + 2] * rs * g_[2], acc[i][4 * q + 3] * rs * g_[3]}; }
                    else o_ = (f32x4){acc[i][4 * q], acc[i][4 * q + 1], acc[i][4 * q + 2], acc[i][4 * q + 3]};
                    *(f32x4*)(xo + c) = o_; }
        }
        LDS_WAIT(); asm volatile("" ::: "memory");
    }
}
}
namespace at {
using namespace mk;
constexpr int QB = 256, KVB = 64, HD = 128;
constexpr int SHM_V = KVB * HD * 2, SHM_K = KVB * HD * 2;
constexpr int OFF_V = 0, OFF_K = 2 * SHM_V, OFF_WS = OFF_K + 2 * SHM_K, OFF_CUM = OFF_WS + 8 * 256, OFF_RT = OFF_CUM + 2048 * 4, OFF_MISC = OFF_RT + 640 * 4;
constexpr float LOG2E = 1.4426950408889634f;
constexpr float THR2 = 10.0f;
constexpr float SB_DONE = -100.0f;

#define AT_KSWZ(row, colB) ((row) * 256 + ((colB) ^ (((row) & 7) << 4)))
__device__ __forceinline__ int v_st(int k, int c) { const int kk = (k & ~0xC) | ((k & 4) << 1) | ((k & 8) >> 1); return ((kk >> 3) * 4 + (c >> 5)) * 512 + ((kk & 7) * 32 + (c & 31)) * 2; }
__device__ __forceinline__ int v_rd_base(int lane) { return ((lane & 3) << 3) | (((lane >> 2) & 3) << 6) | (((lane >> 4) & 1) << 5) | (((lane >> 5) & 1) << 8); }
constexpr int v_rd_off(int d0, int ks, int half) { return d0 * 512 + ks * 4096 + half * 2048; }
__device__ __forceinline__ int crow(int r, int hi) { return (r & 3) + 8 * (r >> 2) + 4 * hi; }
__device__ __forceinline__ unsigned cvtpk(float lo, float hi) { unsigned r; asm volatile("v_cvt_pk_bf16_f32 %0, %1, %2" : "=v"(r) : "v"(lo), "v"(hi)); return r; }
__device__ __forceinline__ float partner(float v, int hi) { auto rr = __builtin_amdgcn_permlane32_swap(__builtin_bit_cast(unsigned, v), __builtin_bit_cast(unsigned, v), false, false); return __builtin_bit_cast(float, hi ? rr[0] : rr[1]); }

__device__ __forceinline__ float xchg_max(float v, int hi) { return fmaxf(v, partner(v, hi)); }
__device__ __forceinline__ float xchg_sum(float v, int hi) { return v + partner(v, hi); }

__device__ __forceinline__ void pack_p(const f32x16& p0, const f32x16& p1, bf16x8& pa0, bf16x8& pa1, bf16x8& pa2, bf16x8& pa3) {
#define AT_PK4(P, B_, OUT) do { unsigned a0 = cvtpk(P[B_ + 0], P[B_ + 1]), a1 = cvtpk(P[B_ + 2], P[B_ + 3]); unsigned b0 = cvtpk(P[B_ + 4], P[B_ + 5]), b1 = cvtpk(P[B_ + 6], P[B_ + 7]); \
        auto r0 = __builtin_amdgcn_permlane32_swap(a0, b0, false, false); auto r1 = __builtin_amdgcn_permlane32_swap(a1, b1, false, false); \
        u32x4 w = {r0[0], r1[0], r0[1], r1[1]}; OUT = __builtin_bit_cast(bf16x8, w); } while (0)
    AT_PK4(p0, 0, pa0); AT_PK4(p0, 8, pa1); AT_PK4(p1, 0, pa2); AT_PK4(p1, 8, pa3);
#undef AT_PK4
}
template <int KBUF>
__device__ __forceinline__ void qkt(f32x16& p0, f32x16& p1, LAS unsigned char* K_lds, int r32, int hi, const bf16x8 (&qr)[8]) {
    p0 = f32x16{}; p1 = f32x16{};
    LAS unsigned char* kb[4];
#pragma unroll
    for (int dd = 0; dd < 4; ++dd) kb[dd] = K_lds + KBUF * SHM_K + AT_KSWZ(r32, (dd * 16 + hi * 8) * 2);
#pragma unroll
    for (int d0 = 0; d0 < 8; ++d0) { LAS unsigned char* a = kb[d0 & 3] + (d0 >> 2) * 128;
        const bf16x8 b0 = *(const LAS bf16x8*)a; const bf16x8 b1 = *(const LAS bf16x8*)(a + 32 * 256);
        p0 = __builtin_amdgcn_mfma_f32_32x32x16_bf16(b0, qr[d0], p0, 0, 0, 0);
        p1 = __builtin_amdgcn_mfma_f32_32x32x16_bf16(b1, qr[d0], p1, 0, 0, 0); }
}
template <int VBUF>
__device__ __forceinline__ void pv_tile(f32x16 (&o)[4], int vb0, bf16x8 pa0, bf16x8 pa1, bf16x8 pa2, bf16x8 pa3) {
#define AT_TRRD(dst, off) asm volatile("ds_read_b64_tr_b16 %0, %1 offset:%2" : "=&v"(dst) : "v"(vb0), "i"(off) : "memory")
#define AT_PV_D0(d0) do { s16x4 l0, l1, l2, l3, h0, h1, h2, h3; constexpr int b_ = VBUF * SHM_V + v_rd_off(d0, 0, 0); \
        AT_TRRD(l0, b_); AT_TRRD(h0, b_ + 2048); AT_TRRD(l1, b_ + 4096); AT_TRRD(h1, b_ + 6144); AT_TRRD(l2, b_ + 8192); AT_TRRD(h2, b_ + 10240); AT_TRRD(l3, b_ + 12288); AT_TRRD(h3, b_ + 14336); \
        asm volatile("s_waitcnt lgkmcnt(0)" ::: "memory"); __builtin_amdgcn_sched_barrier(0); \
        o[d0] = __builtin_amdgcn_mfma_f32_32x32x16_bf16(pa0, (bf16x8){l0[0], l0[1], l0[2], l0[3], h0[0], h0[1], h0[2], h0[3]}, o[d0], 0, 0, 0); \
        o[d0] = __builtin_amdgcn_mfma_f32_32x32x16_bf16(pa1, (bf16x8){l1[0], l1[1], l1[2], l1[3], h1[0], h1[1], h1[2], h1[3]}, o[d0], 0, 0, 0); \
        o[d0] = __builtin_amdgcn_mfma_f32_32x32x16_bf16(pa2, (bf16x8){l2[0], l2[1], l2[2], l2[3], h2[0], h2[1], h2[2], h2[3]}, o[d0], 0, 0, 0); \
        o[d0] = __builtin_amdgcn_mfma_f32_32x32x16_bf16(pa3, (bf16x8){l3[0], l3[1], l3[2], l3[3], h3[0], h3[1], h3[2], h3[3]}, o[d0], 0, 0, 0); } while (0)
    AT_PV_D0(0); AT_PV_D0(1); AT_PV_D0(2); AT_PV_D0(3);
#undef AT_PV_D0
#undef AT_TRRD
}

template <int VAR>
__device__ __forceinline__ void attn_item(const bf16_t* Qh, const bf16_t* Kh, const bf16_t* Vh, bf16_t* OB, const float* relb, const float* LOGF, int b, int h, int qb, LAS unsigned char* lds, int tid) {
    const int wid = __builtin_amdgcn_readfirstlane(tid >> 6), lane = tid & 63, r32 = lane & 31, hi = lane >> 5;
    const int g = VAR == 0 ? h : (VAR == 1 ? 12 + h : 22 + h);
    const size_t hb = (size_t)(b * NH + g) * S * HD;
    const bf16_t* Kp = Kh + hb; const bf16_t* Vp = Vh + hb;
    LAS unsigned char* V_lds = lds + OFF_V; LAS unsigned char* K_lds = lds + OFF_K;
    LAS float* wsf = (LAS float*)(lds + OFF_WS) + wid * 64; LAS float* li_l = wsf; LAS float* al_l = wsf + 32;
    LAS float* cumL = (LAS float*)(lds + OFF_CUM); LAS float* Rt = (LAS float*)(lds + OFF_RT); volatile LAS unsigned* flags = (volatile LAS unsigned*)(lds + OFF_MISC);
    const int P0 = qb * QB, qlo = P0 + wid * 32, qpos = qlo + r32;
    int NT, jlo = 0;
    if (VAR == 0) { jlo = 4 * qb - 8; if (jlo < 0) jlo = 0; NT = 4 * qb + 4 - jlo; } else NT = 4 * qb + 4;
    const int cw = 4 * qb + (wid >> 1);
#define AT_KBASE(t) (VAR == 1 ? (4 * qb + 3 - (t)) * KVB : (jlo + (t)) * KVB)
#define AT_ACT(t) (VAR == 0 ? ((jlo + (t)) >= cw - 8 && (jlo + (t)) <= cw) : (VAR == 1 ? (AT_KBASE(t) <= qlo + 30) : (AT_KBASE(t) <= qlo + 31)))
    if (VAR == 0) {
        const float* tab = relb + h * 257;
        for (int j = tid; j < 639; j += 512) { int rel = 575 - j; rel = rel < -128 ? -128 : (rel > 128 ? 128 : rel); Rt[j] = tab[rel + 128] * LOG2E; }
    }
    if (VAR == 2) {
        const float* lf = LOGF + (size_t)(b * 10 + h) * S; const int kend = P0 + QB;
        f32x4 v = (f32x4){0.f, 0.f, 0.f, 0.f};
        if (4 * tid < kend) v = *(const f32x4*)(lf + 4 * tid);
        v[1] += v[0]; v[2] += v[1]; v[3] += v[2];
        float tot = v[3];
#pragma unroll
        for (int o = 1; o < 64; o <<= 1) { const float t_ = __shfl_up(tot, o); if (lane >= o) tot += t_; }
        if (lane == 63) li_l[0] = tot;
        __syncthreads();
        float base = tot - v[3];
        for (int w = 0; w < wid; ++w) base += ((LAS float*)(lds + OFF_WS))[w * 64];
        if (4 * tid < kend) *(LAS f32x4*)(cumL + 4 * tid) = (f32x4){(base + v[0]) * LOG2E, (base + v[1]) * LOG2E, (base + v[2]) * LOG2E, (base + v[3]) * LOG2E};
    }
    bf16x8 qr[8];
    { const bf16_t* qp = Qh + hb + (size_t)(qlo + r32) * HD + hi * 8;
#pragma unroll
      for (int d0 = 0; d0 < 8; ++d0) qr[d0] = *(const bf16x8*)(qp + d0 * 16); }
    const int sr = tid >> 4, sc = (tid & 15) * 8, vst0 = v_st(sr, sc), vst1 = v_st(32 + sr, sc), kws = AT_KSWZ(sr, sc * 2);
    const int vb0 = (int)(unsigned)(size_t)V_lds + v_rd_base(lane);
    bf16x8 st_k0, st_k1, st_v0, st_v1;
#define AT_SLOAD(k0) do { const bf16_t* kp_ = Kp + (size_t)((k0) + sr) * HD + sc; const bf16_t* vp_ = Vp + (size_t)((k0) + sr) * HD + sc; \
        st_k0 = *(const bf16x8*)kp_; st_k1 = *(const bf16x8*)(kp_ + 32 * HD); st_v0 = *(const bf16x8*)vp_; st_v1 = *(const bf16x8*)(vp_ + 32 * HD); } while (0)
#define AT_SWRITE(bf) do { *(LAS bf16x8*)(K_lds + (bf) * SHM_K + kws) = st_k0; *(LAS bf16x8*)(K_lds + (bf) * SHM_K + kws + 32 * 256) = st_k1; \
        *(LAS bf16x8*)(V_lds + (bf) * SHM_V + vst0) = st_v0; *(LAS bf16x8*)(V_lds + (bf) * SHM_V + vst1) = st_v1; } while (0)
    AT_SLOAD(AT_KBASE(0)); asm volatile("s_waitcnt vmcnt(0)" ::: "memory"); AT_SWRITE(0);
    __syncthreads();
    float m_reg = -1e30f, l_reg = 0.f, carry = 0.f;
    f32x16 o[4] = {};
#define AT_STEP(BUF, t) do { \
        const bool more_ = (t) + 1 < NT; \
        if (more_) AT_SLOAD(AT_KBASE((t) + 1)); \
        if (AT_ACT(t)) { \
            const int kb_ = AT_KBASE(t); f32x16 p0, p1; bf16x8 pa0, pa1, pa2, pa3; \
            qkt<BUF>(p0, p1, K_lds, r32, hi, qr); \
            tile_math(p0, p1, kb_, pa0, pa1, pa2, pa3); \
            pv_tile<BUF>(o, vb0, pa0, pa1, pa2, pa3); \
        } \
        if (more_) { asm volatile("s_waitcnt vmcnt(0)" ::: "memory"); AT_SWRITE((BUF) ^ 1); } \
        if (VAR == 1) { const bool done_ = __all(carry < SB_DONE); if (lane == 0) flags[((t) & 1) * 8 + wid] = done_ ? 1u : 0u; } \
        __syncthreads(); \
    } while (0)
    auto tile_math = [&](f32x16& p0, f32x16& p1, int kb, bf16x8& pa0, bf16x8& pa1, bf16x8& pa2, bf16x8& pa3) __attribute__((always_inline)) {
        const int dq = qpos - kb - 4 * hi;
        if (VAR == 1) {
            const bool need_mask = kb + 63 >= qlo;
            f32x16 n0, n1;
#pragma unroll
            for (int r = 0; r < 16; ++r) { const float z = p0[r]; const float lp = __builtin_amdgcn_logf(1.0f + __builtin_amdgcn_exp2f(-fabsf(z))); n0[r] = fminf(-z, 0.f) - lp;
                                           const float y = p1[r]; const float lq = __builtin_amdgcn_logf(1.0f + __builtin_amdgcn_exp2f(-fabsf(y))); n1[r] = fminf(-y, 0.f) - lq; }
            if (need_mask) {
#pragma unroll
                for (int r = 0; r < 16; ++r) { const int c = (r & 3) + 8 * (r >> 2);
                    if (dq - c <= 0) { n0[r] = 0.f; p0[r] = -__builtin_inff(); }
                    if (dq - c - 32 <= 0) { n1[r] = 0.f; p1[r] = -__builtin_inff(); } }
            }
            float A[8], Bp[8];
#pragma unroll
            for (int q = 0; q < 4; ++q) { A[q] = (n0[4 * q] + n0[4 * q + 1]) + (n0[4 * q + 2] + n0[4 * q + 3]); A[4 + q] = (n1[4 * q] + n1[4 * q + 1]) + (n1[4 * q + 2] + n1[4 * q + 3]); }
#pragma unroll
            for (int q = 0; q < 8; ++q) Bp[q] = partner(A[q], hi);
            float st = 0.f;
#pragma unroll
            for (int q = 7; q >= 0; --q) {
                const float after = carry + st + (hi == 0 ? Bp[q] : 0.f);
                if (q >= 4) { const int r0 = 4 * (q - 4);
                    float tl = after; p1[r0 + 3] = __builtin_amdgcn_exp2f(p1[r0 + 3] + n1[r0 + 3] + tl); tl += n1[r0 + 3]; p1[r0 + 2] = __builtin_amdgcn_exp2f(p1[r0 + 2] + n1[r0 + 2] + tl); tl += n1[r0 + 2];
                    p1[r0 + 1] = __builtin_amdgcn_exp2f(p1[r0 + 1] + n1[r0 + 1] + tl); tl += n1[r0 + 1]; p1[r0] = __builtin_amdgcn_exp2f(p1[r0] + n1[r0] + tl); }
                else { const int r0 = 4 * q;
                    float tl = after; p0[r0 + 3] = __builtin_amdgcn_exp2f(p0[r0 + 3] + n0[r0 + 3] + tl); tl += n0[r0 + 3]; p0[r0 + 2] = __builtin_amdgcn_exp2f(p0[r0 + 2] + n0[r0 + 2] + tl); tl += n0[r0 + 2];
                    p0[r0 + 1] = __builtin_amdgcn_exp2f(p0[r0 + 1] + n0[r0 + 1] + tl); tl += n0[r0 + 1]; p0[r0] = __builtin_amdgcn_exp2f(p0[r0] + n0[r0] + tl); }
                st += A[q] + Bp[q];
            }
            carry += st;
            pack_p(p0, p1, pa0, pa1, pa2, pa3);
        } else {
            if (VAR == 0) {
                const LAS float* rp = Rt + (575 - (qpos - kb) + 4 * hi);
#pragma unroll
                for (int r = 0; r < 16; ++r) { const int c = (r & 3) + 8 * (r >> 2); p0[r] += rp[c]; p1[r] += rp[c + 32]; }
            } else {
                const LAS float* cp = cumL + kb + 4 * hi;
#pragma unroll
                for (int q = 0; q < 4; ++q) { const f32x4 c0 = *(const LAS f32x4*)(cp + 8 * q), c1 = *(const LAS f32x4*)(cp + 32 + 8 * q);
                    p0[4 * q] -= c0[0]; p0[4 * q + 1] -= c0[1]; p0[4 * q + 2] -= c0[2]; p0[4 * q + 3] -= c0[3];
                    p1[4 * q] -= c1[0]; p1[4 * q + 1] -= c1[1]; p1[4 * q + 2] -= c1[2]; p1[4 * q + 3] -= c1[3]; }
                if (kb + 63 > qlo) {
#pragma unroll
                    for (int r = 0; r < 16; ++r) { const int c = (r & 3) + 8 * (r >> 2);
                        if (dq - c < 0) p0[r] = -__builtin_inff();
                        if (dq - c - 32 < 0) p1[r] = -__builtin_inff(); }
                }
            }
            float pmax = p0[0];
#pragma unroll
            for (int r = 1; r < 16; ++r) pmax = fmaxf(pmax, p0[r]);
#pragma unroll
            for (int r = 0; r < 16; ++r) pmax = fmaxf(pmax, p1[r]);
            pmax = xchg_max(pmax, hi);
            float mn, alpha;
            if (__all(pmax - m_reg <= THR2)) { mn = m_reg; alpha = 1.f; }
            else { mn = fmaxf(m_reg, pmax); alpha = __builtin_amdgcn_exp2f(m_reg - mn); m_reg = mn; }
            float ps = 0.f;
#pragma unroll
            for (int r = 0; r < 16; ++r) { p0[r] = __builtin_amdgcn_exp2f(p0[r] - mn); p1[r] = __builtin_amdgcn_exp2f(p1[r] - mn); ps += p0[r] + p1[r]; }
            ps = xchg_sum(ps, hi);
            l_reg = l_reg * alpha + ps;
            if (__any(alpha < 1.f)) {
                if (hi == 0) al_l[r32] = alpha;
                asm volatile("s_waitcnt lgkmcnt(0)" ::: "memory");
                float av[16];
#pragma unroll
                for (int r = 0; r < 16; ++r) av[r] = al_l[crow(r, hi)];
#pragma unroll
                for (int d = 0; d < 4; ++d)
#pragma unroll
                    for (int r = 0; r < 16; ++r) o[d][r] *= av[r];
            }
            pack_p(p0, p1, pa0, pa1, pa2, pa3);
        }
    };
    for (int t = 0; t < NT; t += 2) {
        AT_STEP(0, t);
        if (VAR == 1) { unsigned all_ = 1u; for (int w = 0; w < 8; ++w) all_ &= flags[(t & 1) * 8 + w]; if (all_) break; }
        if (t + 1 >= NT) break;
        AT_STEP(1, t + 1);
        if (VAR == 1) { unsigned all_ = 1u; for (int w = 0; w < 8; ++w) all_ &= flags[((t + 1) & 1) * 8 + w]; if (all_) break; }
    }
    float rli[16];
    if (VAR != 1) {
        if (hi == 0) li_l[r32] = l_reg;
        asm volatile("s_waitcnt lgkmcnt(0)" ::: "memory");
#pragma unroll
        for (int r = 0; r < 16; ++r) rli[r] = __builtin_amdgcn_rcpf(li_l[crow(r, hi)]);
    }
    unsigned char* Ow8 = (unsigned char*)OB + (size_t)(b * S + qlo) * D + g * HD;
#pragma unroll
    for (int r = 0; r < 16; ++r) { const int orow = crow(r, hi);
#pragma unroll
        for (int d0 = 0; d0 < 4; ++d0) { const float v = VAR != 1 ? o[d0][r] * rli[r] : o[d0][r];
            const float vn = __shfl_xor(v, 1);
            if ((r32 & 1) == 0) *(unsigned short*)(Ow8 + (size_t)orow * D + d0 * 32 + r32) = (unsigned short)__builtin_amdgcn_cvt_pk_fp8_f32(clamp8(v * 16.0f), clamp8(vn * 16.0f), 0, false); } }
    __syncthreads();
#undef AT_STEP
#undef AT_SLOAD
#undef AT_SWRITE
#undef AT_KBASE
#undef AT_ACT
}

template <int VAR>
__device__ __forceinline__ void attn_queue(const bf16_t* Qh, const bf16_t* Kh, const bf16_t* Vh, bf16_t* OB, const float* relb, const float* LOGF, unsigned* qhead, LAS unsigned char* lds, int wave0) {
    FRESH_TID(); FRESH_LDS(lds);
    volatile LAS unsigned* qslot = (volatile LAS unsigned*)(lds + OFF_MISC) + 32;
    constexpr int NHV = VAR == 0 ? 12 : 10, NITEMS = 8 * NHV * 8;
    for (;;) {
        if (tid == 0) qslot[0] = __hip_atomic_fetch_add(qhead, 1u, __ATOMIC_RELAXED, __HIP_MEMORY_SCOPE_AGENT);
        __syncthreads();
        const int idx = (int)qslot[0];
        __syncthreads();
        if (idx >= NITEMS) break;
        const int qb = 7 - idx / (8 * NHV), bh = idx % (8 * NHV);
        attn_item<VAR>(Qh, Kh, Vh, OB, relb, LOGF, bh / NHV, bh % NHV, qb, lds, tid);
    }
}
__device__ __forceinline__ void attn_phase(const bf16_t* Qh, const bf16_t* Kh, const bf16_t* Vh, bf16_t* OB, const float* relb, const float* LOGF, unsigned* qheads, LAS unsigned char* lds, int wave0) {
    attn_queue<2>(Qh, Kh, Vh, OB, relb, LOGF, qheads + 0, lds, wave0);
    attn_queue<0>(Qh, Kh, Vh, OB, relb, LOGF, qheads + 64, lds, wave0);
    attn_queue<1>(Qh, Kh, Vh, OB, relb, LOGF, qheads + 128, lds, wave0);
}
}
namespace mk {
#define XB_TMO      128
#define XB_XCNT(j)  (256  + 64 * (j))
#define XB_XSUB(j)  (1280 + 64 * (j))
#define XB_XGEN(j)  (2304 + 64 * (j))
#define XB_TOP      3328
#define XB_TOPGEN   3392
#define XCD_BAR_WORDS 3456
#define XB_SPIN_CAP (1u << 22)

__device__ __forceinline__ unsigned xb_ld(unsigned* p)              { return __hip_atomic_load(p, __ATOMIC_RELAXED, __HIP_MEMORY_SCOPE_AGENT); }
__device__ __forceinline__ unsigned xb_add(unsigned* p, unsigned v) { return __hip_atomic_fetch_add(p, v, __ATOMIC_RELAXED, __HIP_MEMORY_SCOPE_AGENT); }
__device__ __forceinline__ unsigned xb_xcc_id() { return (unsigned)__builtin_amdgcn_s_getreg((3 << 11) | 20) & 0xFu; }
#define XB_SPIN(cond, bar) do { unsigned _sp = 0; while (cond) { __builtin_amdgcn_s_sleep(1); \
    if ((++_sp & 255u) == 0u) { if (xb_ld(&(bar)[XB_TMO])) break; if (_sp > XB_SPIN_CAP) { atomicAdd(&(bar)[XB_TMO], 1u); break; } } } } while (0)

struct XcdBarrier {
    unsigned* bar; unsigned x;
    volatile LAS unsigned* st;
};

__device__ __forceinline__ XcdBarrier xcd_barrier_post(unsigned* bar, volatile LAS unsigned* st, bool is_t0) {
    XcdBarrier b; b.bar = bar; b.x = xb_xcc_id(); b.st = st;
    if (is_t0) (void)xb_add(&bar[XB_XCNT(b.x)], 1u);
    return b;
}
__device__ __forceinline__ void xcd_barrier_complete(unsigned* bar, unsigned x, unsigned& nloc, unsigned& nx) {
    const unsigned G = gridDim.x * gridDim.y * gridDim.z;
    unsigned sum, cnt, mine, sp = 0u;
    for (;;) {
        sum = 0u; cnt = 0u; mine = 0u;
#pragma unroll
        for (unsigned j = 0; j < 16; ++j) { const unsigned c = xb_ld(&bar[XB_XCNT(j)]); sum += c; cnt += (c > 0u) ? 1u : 0u; mine = (j == x) ? c : mine; }
        if (sum == G) break;
        __builtin_amdgcn_s_sleep(1);
        if ((++sp & 255u) == 0u) { if (xb_ld(&bar[XB_TMO])) break; if (sp > XB_SPIN_CAP) { atomicAdd(&bar[XB_TMO], 1u); break; } }
    }
    nloc = mine > 0u ? mine : 1u; nx = cnt > 0u ? cnt : 1u;
}

__device__ __forceinline__ void xcd_barrier(const XcdBarrier& b, bool is_t0) {
    asm volatile("s_waitcnt vmcnt(0)" ::: "memory");
    __syncthreads();
    if (is_t0) {
        unsigned* bar = b.bar;
        __builtin_amdgcn_s_waitcnt(0);
        unsigned nloc = b.st[0], nx = b.st[1];
        if (nloc == 0u) { xcd_barrier_complete(bar, b.x, nloc, nx); b.st[0] = nloc; b.st[1] = nx; }
        const unsigned old = xb_add(&bar[XB_XSUB(b.x)], 1u);
        const unsigned gen = old / nloc;
        if (old + 1u == (gen + 1u) * nloc) {
            __builtin_amdgcn_fence(__ATOMIC_RELEASE, "agent");
            asm volatile("s_waitcnt vmcnt(0)" ::: "memory");
            const unsigned og = xb_add(&bar[XB_TOP], 1u);
            const unsigned tg = og / nx;
            if (og + 1u == (tg + 1u) * nx) xb_add(&bar[XB_TOPGEN], 1u);
            else XB_SPIN(xb_ld(&bar[XB_TOPGEN]) == tg, bar);
            __builtin_amdgcn_fence(__ATOMIC_ACQUIRE, "agent");
            xb_add(&bar[XB_XGEN(b.x)], 1u);
            asm volatile("s_waitcnt vmcnt(0)" ::: "memory");
        } else {
            XB_SPIN(xb_ld(&bar[XB_XGEN(b.x)]) == gen, bar);
            __builtin_amdgcn_fence(__ATOMIC_ACQUIRE, "agent");
            asm volatile("s_waitcnt vmcnt(0)" ::: "memory");
        }
    }
    __syncthreads();
}

constexpr int PH_PER_LAYER = 8;
typedef const __attribute__((address_space(4))) Args* KArgs;
#define KARGS() ({ KArgs p_ = (KArgs)__builtin_amdgcn_kernarg_segment_ptr(); asm volatile("" : "+s"(p_)); p_; })
#define GRID_BAR() do { KArgs k_ = KARGS(); XcdBarrier b_; b_.bar = (unsigned*)(k_->ws + WS_CTL) + CW_BAR; b_.x = xb_xcc_id(); b_.st = (volatile LAS unsigned*)(lds + MISC_OFF) + 8; const bool t0_ = (wave0 == 0) && (__builtin_amdgcn_mbcnt_hi(~0u, __builtin_amdgcn_mbcnt_lo(~0u, 0u)) == 0u); xcd_barrier(b_, t0_); } while (0)
__global__ void __launch_bounds__(NWAVES * 64, 2) mk_fwd(Args a_unused) {
    extern __shared__ __attribute__((aligned(16))) unsigned char lds_raw[];
    LAS unsigned char* lds = (LAS unsigned char*)lds_raw;
    const int wave0 = __builtin_amdgcn_readfirstlane((int)threadIdx.x >> 6);
    for (int u = threadIdx.x; u < (LDS_BYTES - LDSCTL_OFF) / 4; u += NWAVES * 64) ((LAS unsigned*)(lds + LDSCTL_OFF))[u] = 0u;
    __syncthreads();
    int lo, hi;
    { KArgs k = KARGS(); lo = k->ph_lo; hi = k->ph_hi;
      if (hi - lo > 1) (void)xcd_barrier_post((unsigned*)(k->ws + WS_CTL) + CW_BAR, (volatile LAS unsigned*)(lds + MISC_OFF) + 8, threadIdx.x == 0); }
#define IN(k) (lo <= (k) && (k) < hi)
#define BOTH(k) (IN(k) && IN((k) + 1))
#pragma unroll
    for (int l = 0; l < 2; ++l) {
        const int pb = PH_PER_LAYER * l;
        if (IN(pb + 0)) { KArgs k = KARGS(); conv_phase(k, l, lds, wave0); }
        if (IN(pb + 1)) {
            KArgs k = KARGS(); unsigned char* ws = k->ws;
            const float* xin = l == 0 ? k->in[0] : (const float*)(ws + WS_X2);
            prep_phase<true>(xin, (bf16_t*)(ws + WS_XB), (float*)(ws + WS_RSTD), k->in[2] + (size_t)l * D * PW, k->in[1] + (size_t)l * D, k->in[3] + l * 10, (float*)(ws + WS_LOGF), lds, wave0);
            if (BOTH(pb + 1)) GRID_BAR();
        }
        if (IN(pb + 2)) {
            KArgs k = KARGS(); unsigned char* ws = k->ws;
            pg8::Gemm g{(const bf16_t*)(ws + WS_XB), (const bf16_t*)(ws + WS_WIN), M, 12288, D}; pg8::StaticOrder So; FRESH_BID(); So.init(M, 12288, G, bid);
            pg8::EpiQKV4 E{(bf16_t*)(ws + WS_Q), (const float*)(ws + WS_RSTD), 0.08838834764831845f * 1.4426950408889634f, US_INV};
            { LAS unsigned char* lds_ = lds; FRESH_LDS(lds_); FRESH_TID(); pg8::gemm_phase<pg8::EpiQKV4, pg8::StaticOrder, true, true, true>(lds_, g, So, E, tid); }
            if (BOTH(pb + 2)) GRID_BAR();
        }
        if (IN(pb + 3)) {
            KArgs k = KARGS(); unsigned char* ws = k->ws;
            at::attn_phase((const bf16_t*)(ws + WS_Q), (const bf16_t*)(ws + WS_K), (const bf16_t*)(ws + WS_V), (bf16_t*)(ws + WS_OB), k->in[4] + (size_t)l * 12 * 257, (const float*)(ws + WS_LOGF),
                           (unsigned*)(ws + WS_CTL) + CW_QUEUE + 256 * l, lds, wave0);
            if (BOTH(pb + 3)) GRID_BAR();
        }
        if (IN(pb + 4)) {
            KArgs k = KARGS(); unsigned char* ws = k->ws;
            const float* xin = l == 0 ? k->in[0] : (const float*)(ws + WS_X2);
            pg8::Gemm g{(const bf16_t*)(ws + WS_OB), (const bf16_t*)(ws + WS_WOUT), M, D, D}; pg8::StaticOrder So; FRESH_BID(); So.init(M, D, G, bid);
            pg8::EpiResidF32 E{xin, k->out, US_INV * (1.0f / 16.0f), (bf16_t*)(ws + WS_XB)};
            { LAS unsigned char* lds_ = lds; FRESH_LDS(lds_); FRESH_TID(); pg8::gemm_phase<pg8::EpiResidF32, pg8::StaticOrder, false, true, true>(lds_, g, So, E, tid); }
            if (BOTH(pb + 4)) GRID_BAR();
        }
        if (IN(pb + 5)) {
            KArgs k = KARGS(); unsigned char* ws = k->ws;
            pg8::Gemm g{(const bf16_t*)(ws + WS_XB), (const bf16_t*)(ws + WS_WQK), M, 2048, D}; pg8::StaticOrder So; FRESH_BID(); So.init(M, 2048, G, bid);
            pg8::EpiPlainF32<2048> E{(float*)(ws + WS_SC)};
            { LAS unsigned char* lds_ = lds; FRESH_LDS(lds_); FRESH_TID(); pg8::gemm_phase<pg8::EpiPlainF32<2048>, pg8::StaticOrder, true, true>(lds_, g, So, E, tid); }
            if (BOTH(pb + 5)) GRID_BAR();
        }
        if (IN(pb + 6)) {
            KArgs k = KARGS(); unsigned char* ws = k->ws;
            peer_u_phase((const float*)(ws + WS_SC), (const unsigned char*)(ws + WS_U16), k->out, (int*)(ws + WS_K), (float*)(ws + WS_K + 8 * MiB), lds, wave0);
            if (BOTH(pb + 6)) GRID_BAR();
        }
        if (IN(pb + 7)) {
            KArgs k = KARGS(); unsigned char* ws = k->ws;
            if (l == 0) peer_v_phase<false>((const int*)(ws + WS_K), (const float*)(ws + WS_K + 8 * MiB), (const unsigned char*)(ws + WS_U16) + (size_t)NE * D, k->out, (float*)(ws + WS_X2), nullptr, lds, wave0);
            else peer_v_phase<true>((const int*)(ws + WS_K), (const float*)(ws + WS_K + 8 * MiB), (const unsigned char*)(ws + WS_U16) + (size_t)NE * D, k->out, k->out, k->in[12], lds, wave0);
            if (BOTH(pb + 7)) GRID_BAR();
        }
    }
#undef IN
#undef BOTH
}

static int g_grid = 0;
static void launch_phases(Args a, int lo, int hi, hipStream_t st) {
    a.ph_lo = lo; a.ph_hi = hi;
    hipLaunchKernelGGL(mk_fwd, dim3(g_grid), dim3(NWAVES * 64), LDS_BYTES, st, a);
}
}

extern "C" void kernel_launch(void* const* d_in, const int* in_sizes, int n_in, void* d_out, int out_size, void* d_ws, size_t ws_size, hipStream_t stream) {
    (void)in_sizes; (void)n_in; (void)out_size;
    using namespace mk;
    if (g_grid == 0) {
        if (ws_size < 2048 * MiB) { fprintf(stderr, "kernel_launch: workspace too small (%zu)\n", ws_size); g_grid = -1; return; }
        if (hipFuncSetAttribute((const void*)mk_fwd, hipFuncAttributeMaxDynamicSharedMemorySize, LDS_BYTES) != hipSuccess) { fprintf(stderr, "kernel_launch: hipFuncSetAttribute failed\n"); g_grid = -1; return; }
        int dev = 0, cus = 0; (void)hipGetDevice(&dev); (void)hipDeviceGetAttribute(&cus, hipDeviceAttributeMultiprocessorCount, dev);
        g_grid = cus > 0 ? cus : 256;
    }
    if (g_grid < 0) return;
    unsigned char* ws = (unsigned char*)d_ws; float* out = (float*)d_out;
    (void)hipMemsetAsync(ws + WS_CTL, 0, CTL_ZERO_BYTES, stream);
    Args a{};
    for (int i = 0; i < 13; ++i) a.in[i] = (const float*)d_in[i];
    a.out = out; a.ws = ws;
    launch_phases(a, 0, 2 * PH_PER_LAYER, stream);
}
```

```cpp
#include <hip/hip_runtime.h>
#include <cstdio>
#include <cstdint>
#define NOBIAS_DBG 0
namespace nv {
constexpr int M = 16384, D = 4096, S = 2048, NB = 8, PW = 12298, NH = 32;

__device__ __forceinline__ float wave_sum(float v) {
#pragma unroll
    for (int o = 1; o < 64; o <<= 1) v += __shfl_xor(v, o);
    return v;
}
__device__ __forceinline__ float wave_max(float v) {
#pragma unroll
    for (int o = 1; o < 64; o <<= 1) v = fmaxf(v, __shfl_xor(v, o));
    return v;
}
__device__ __forceinline__ int wave_min_i(int v) {
#pragma unroll
    for (int o = 1; o < 64; o <<= 1) { int t = __shfl_xor(v, o); v = t < v ? t : v; }
    return v;
}
__device__ __forceinline__ float logsig(float z) {
    return z >= 0.f ? -log1pf(expf(-z)) : z - log1pf(expf(z));
}

__global__ __launch_bounds__(256) void k_rmsnorm(const float* x, const float* g, float* y) {
    __shared__ float red[4];
    const int r = blockIdx.x, t = threadIdx.x;
    const float4* xr = (const float4*)(x + (size_t)r * D);
    float4 v[4]; float ss = 0.f;
#pragma unroll
    for (int i = 0; i < 4; ++i) { v[i] = xr[t + 256 * i]; ss += v[i].x * v[i].x + v[i].y * v[i].y + v[i].z * v[i].z + v[i].w * v[i].w; }
    ss = wave_sum(ss);
    if ((t & 63) == 0) red[t >> 6] = ss;
    __syncthreads();
    const float tot = red[0] + red[1] + red[2] + red[3];
    const float rstd = rsqrtf(tot * (1.0f / D) + 1e-6f);
    float4* yr = (float4*)(y + (size_t)r * D);
    const float4* gr = (const float4*)g;
#pragma unroll
    for (int i = 0; i < 4; ++i) { const float4 gg = gr[t + 256 * i]; float4 o; o.x = v[i].x * rstd * gg.x; o.y = v[i].y * rstd * gg.y; o.z = v[i].z * rstd * gg.z; o.w = v[i].w * rstd * gg.w; yr[t + 256 * i] = o; }
}

template <int MODE>
__global__ __launch_bounds__(256) void k_gemm(const float* A, const float* B, float* C, const float* R, int Mm, int N, int K, int lda, int ldb, int ldc) {
    __shared__ float As[16][68];
    __shared__ float Bs[16][68];
    const int tid = threadIdx.x, tx = tid & 15, ty = tid >> 4;
    const int m0 = blockIdx.y * 64, n0 = blockIdx.x * 64;
    float acc[4][4];
#pragma unroll
    for (int i = 0; i < 4; ++i)
#pragma unroll
        for (int j = 0; j < 4; ++j) acc[i][j] = 0.f;
    for (int k0 = 0; k0 < K; k0 += 16) {
        {
            const int mr = tid >> 2, kc = (tid & 3) * 4;
            const float4 a = *(const float4*)(A + (size_t)(m0 + mr) * lda + k0 + kc);
            As[kc + 0][mr] = a.x; As[kc + 1][mr] = a.y; As[kc + 2][mr] = a.z; As[kc + 3][mr] = a.w;
        }
        {
            const int kr = tid >> 4, nc = (tid & 15) * 4;
#pragma unroll
            for (int j = 0; j < 4; ++j) { const int n = n0 + nc + j; Bs[kr][nc + j] = (n < N) ? B[(size_t)(k0 + kr) * ldb + n] : 0.f; }
        }
        __syncthreads();
#pragma unroll
        for (int k = 0; k < 16; ++k) {
            const float4 a = *(const float4*)&As[k][ty * 4];
            const float4 b = *(const float4*)&Bs[k][tx * 4];
            const float av[4] = {a.x, a.y, a.z, a.w}, bv[4] = {b.x, b.y, b.z, b.w};
#pragma unroll
            for (int i = 0; i < 4; ++i)
#pragma unroll
                for (int j = 0; j < 4; ++j) acc[i][j] = fmaf(av[i], bv[j], acc[i][j]);
        }
        __syncthreads();
    }
#pragma unroll
    for (int i = 0; i < 4; ++i)
#pragma unroll
        for (int j = 0; j < 4; ++j) {
            const int m = m0 + ty * 4 + i, n = n0 + tx * 4 + j;
            if (n < N) { const size_t o = (size_t)m * ldc + n; C[o] = (MODE ? R[o] : 0.f) + acc[i][j]; }
        }
}

__global__ __launch_bounds__(64) void k_cum(const float* proj, const float* bf, float* cum) {
    const int b = blockIdx.x / 10, j = blockIdx.x % 10, lane = threadIdx.x;
    float carry = 0.f;
    for (int ch = 0; ch < S / 64; ++ch) {
        const int s = ch * 64 + lane;
        float v = logsig(proj[(size_t)(b * S + s) * PW + 12288 + j] + bf[j]);
#pragma unroll
        for (int o = 1; o < 64; o <<= 1) { const float t = __shfl_up(v, o); if (lane >= o) v += t; }
        v += carry;
        cum[(size_t)(b * 10 + j) * S + s] = v;
        carry = __shfl(v, 63);
    }
}

__global__ __launch_bounds__(256) void k_attn(const float* proj, const float* relb  , const float* cum  , float* o) {
    __shared__ float sl[4][2048];
    __shared__ float sq[4][128];
    const int w = threadIdx.x >> 6, lane = threadIdx.x & 63;
    const int rowid = blockIdx.x * 4 + w;
    const int t = rowid % S, g = (rowid / S) % NH, b = rowid / (S * NH);
    const float* qrow = proj + (size_t)(b * S + t) * PW + g * 128;
    sq[w][lane] = qrow[lane]; sq[w][lane + 64] = qrow[lane + 64];
    __syncthreads();
    int klo, khi;
    if (g < 12) { const int c = t / 64; klo = (c - 8) * 64; if (klo < 0) klo = 0; khi = (c + 1) * 64; }
    else if (g < 22) { klo = 0; khi = t; }
    else { klo = 0; khi = t + 1; }
    const float scale = 0.08838834764831845f;
    const float* kbase = proj + (size_t)(b * S) * PW + 4096 + g * 128;
    const float* vbase = proj + (size_t)(b * S) * PW + 8192 + g * 128;
    for (int s = klo + lane; s < khi; s += 64) {
        const float* kr = kbase + (size_t)s * PW;
        float acc = 0.f;
#pragma unroll 8
        for (int d = 0; d < 128; d += 2) { const float2 kv = *(const float2*)(kr + d); acc = fmaf(sq[w][d], kv.x, acc); acc = fmaf(sq[w][d + 1], kv.y, acc); }
        sl[w][s - klo] = acc * scale;
    }
    __syncthreads();
    const int nk = khi - klo;
    if (g < 12) {
        const float* rb = relb + g * 257;
        float mx = -3.0e38f;
        for (int i = lane; i < nk; i += 64) { int rel = t - (klo + i); rel = rel < -128 ? -128 : (rel > 128 ? 128 : rel); const float l = sl[w][i] + rb[rel + 128]; sl[w][i] = l; mx = fmaxf(mx, l); }
        mx = wave_max(mx);
        float sm = 0.f;
        for (int i = lane; i < nk; i += 64) { const float p = expf(sl[w][i] - mx); sl[w][i] = p; sm += p; }
        sm = wave_sum(sm);
        const float inv = 1.0f / sm;
        for (int i = lane; i < nk; i += 64) sl[w][i] *= inv;
    } else if (g < 22) {
        if (lane == 0) { float tail = 0.f; for (int s = t - 1; s >= 0; --s) { const float z = sl[w][s]; const float ls = logsig(z); sl[w][s] = expf(ls + tail); tail += ls - z; } }
    } else {
        const float* cm = cum + (size_t)(b * 10 + (g - 22)) * S;
        const float ct = cm[t];
        float mx = -3.0e38f;
        for (int i = lane; i < nk; i += 64) { const float l = sl[w][i] + ct - cm[i]; sl[w][i] = l; mx = fmaxf(mx, l); }
        mx = wave_max(mx);
        float sm = 0.f;
        for (int i = lane; i < nk; i += 64) { const float p = expf(sl[w][i] - mx); sl[w][i] = p; sm += p; }
        sm = wave_sum(sm);
        const float inv = 1.0f / sm;
        for (int i = lane; i < nk; i += 64) sl[w][i] *= inv;
    }
    __syncthreads();
    float a0 = 0.f, a1 = 0.f;
    for (int i = 0; i < nk; ++i) { const float p = sl[w][i]; const float* vr = vbase + (size_t)(klo + i) * PW; a0 = fmaf(p, vr[lane], a0); a1 = fmaf(p, vr[lane + 64], a1); }
    float* orow = o + (size_t)(b * S + t) * D + g * 128;
    orow[lane] = a0; orow[lane + 64] = a1;
}

template <bool FROM_SC>
__global__ __launch_bounds__(256) void k_route(const float* qp, const float* k1, const float* k2, int* eid, float* gw) {
    __shared__ float sq[4][256];
    const int w = threadIdx.x >> 6, lane = threadIdx.x & 63;
    const int id = blockIdx.x * 4 + w, tok = id >> 3, h = id & 7;
    const float* q = qp + (size_t)tok * 2048 + h * 256;
#pragma unroll
    for (int i = 0; i < 4; ++i) sq[w][lane + 64 * i] = q[lane + 64 * i];
    __syncthreads();
    float a[2], c[2];
    if (FROM_SC) { a[0] = sq[w][lane]; a[1] = sq[w][lane + 64]; c[0] = sq[w][128 + lane]; c[1] = sq[w][192 + lane]; }
    else
#pragma unroll
    for (int u = 0; u < 2; ++u) {
        const float* r1 = k1 + ((size_t)h * 128 + lane + 64 * u) * 128;
        const float* r2 = k2 + ((size_t)h * 128 + lane + 64 * u) * 128;
        float s1 = 0.f, s2 = 0.f;
        for (int d = 0; d < 128; d += 4) { const float4 x1 = *(const float4*)(r1 + d), x2 = *(const float4*)(r2 + d);
            s1 = fmaf(sq[w][d], x1.x, s1); s1 = fmaf(sq[w][d + 1], x1.y, s1); s1 = fmaf(sq[w][d + 2], x1.z, s1); s1 = fmaf(sq[w][d + 3], x1.w, s1);
            s2 = fmaf(sq[w][128 + d], x2.x, s2); s2 = fmaf(sq[w][128 + d + 1], x2.y, s2); s2 = fmaf(sq[w][128 + d + 2], x2.z, s2); s2 = fmaf(sq[w][128 + d + 3], x2.w, s2); }
        a[u] = s1; c[u] = s2;
    }
    const float NEG = -3.0e38f;
    float v1 = 0.f, v2 = 0.f; int i1 = 0, i2 = 0;
    for (int it = 0; it < 16; ++it) {
        { const float m = wave_max(fmaxf(a[0], a[1]));
          int cand = 1 << 30; if (a[0] == m) cand = lane; else if (a[1] == m) cand = lane + 64;
          const int n = wave_min_i(cand);
          if (n == lane) a[0] = NEG; if (n == lane + 64) a[1] = NEG;
          if (lane == it) { v1 = m; i1 = n; } }
        { const float m = wave_max(fmaxf(c[0], c[1]));
          int cand = 1 << 30; if (c[0] == m) cand = lane; else if (c[1] == m) cand = lane + 64;
          const int n = wave_min_i(cand);
          if (n == lane) c[0] = NEG; if (n == lane + 64) c[1] = NEG;
          if (lane == it) { v2 = m; i2 = n; } }
    }
    float cd[4];
    { const float va = __shfl(v1, lane >> 2);
#pragma unroll
      for (int k = 0; k < 4; ++k) cd[k] = va + __shfl(v2, (lane & 3) * 4 + k); }
    float best = 0.f; int be = 0;
    for (int it = 0; it < 16; ++it) {
        const float m = wave_max(fmaxf(fmaxf(cd[0], cd[1]), fmaxf(cd[2], cd[3])));
        int cand = 1 << 30;
        if (cd[0] == m) cand = lane * 4; else if (cd[1] == m) cand = lane * 4 + 1; else if (cd[2] == m) cand = lane * 4 + 2; else if (cd[3] == m) cand = lane * 4 + 3;
        const int pos = wave_min_i(cand);
        if (pos == lane * 4) cd[0] = NEG; if (pos == lane * 4 + 1) cd[1] = NEG; if (pos == lane * 4 + 2) cd[2] = NEG; if (pos == lane * 4 + 3) cd[3] = NEG;
        const int e = ((__shfl(i1, (pos >> 4) & 15) & 127) << 7) | (__shfl(i2, pos & 15) & 127);
        if (lane == it) { best = m; be = e; }
    }
    const float mx = __shfl(best, 0);
    float p = lane < 16 ? expf(best - mx) : 0.f;
    const float sm = wave_sum(p);
    if (lane < 16) { eid[(size_t)tok * 128 + h * 16 + lane] = be; gw[(size_t)tok * 128 + h * 16 + lane] = p / sm; }
}

template <bool WONLY>
__global__ __launch_bounds__(256) void k_expert(const float* h2, const float* u, const float* v, const int* eid, float* gw, float* x) {
    __shared__ float sw[4][128];
    const int w = threadIdx.x >> 6, lane = threadIdx.x & 63;
    const int tok = blockIdx.x * 4 + w;
    const float4* hr = (const float4*)(h2 + (size_t)tok * D);
    float4 hv[16];
#pragma unroll
    for (int i = 0; i < 16; ++i) hv[i] = hr[64 * i + lane];
    for (int j = 0; j < 128; ++j) {
        const int e = eid[(size_t)tok * 128 + j];
        const float4* ur = (const float4*)(u + (size_t)e * D);
        float dsum = 0.f;
#pragma unroll
        for (int i = 0; i < 16; ++i) { const float4 uu = ur[64 * i + lane]; dsum += hv[i].x * uu.x + hv[i].y * uu.y + hv[i].z * uu.z + hv[i].w * uu.w; }
        dsum = wave_sum(dsum);
        const float ge = 0.5f * dsum * (1.0f + erff(dsum * 0.70710678118654752f));
        if (lane == 0) sw[w][j] = gw[(size_t)tok * 128 + j] * ge;
    }
    __syncthreads();
    if (WONLY) { gw[(size_t)tok * 128 + lane] = sw[w][lane]; gw[(size_t)tok * 128 + lane + 64] = sw[w][lane + 64]; return; }
    float4 acc[16];
#pragma unroll
    for (int i = 0; i < 16; ++i) acc[i] = make_float4(0.f, 0.f, 0.f, 0.f);
    for (int j = 0; j < 128; ++j) {
        const int e = eid[(size_t)tok * 128 + j];
        const float wj = sw[w][j];
        const float4* vr = (const float4*)(v + (size_t)e * D);
#pragma unroll
        for (int i = 0; i < 16; ++i) { const float4 vv = vr[64 * i + lane]; acc[i].x = fmaf(wj, vv.x, acc[i].x); acc[i].y = fmaf(wj, vv.y, acc[i].y); acc[i].z = fmaf(wj, vv.z, acc[i].z); acc[i].w = fmaf(wj, vv.w, acc[i].w); }
    }
    float4* xr = (float4*)(x + (size_t)tok * D);
#pragma unroll
    for (int i = 0; i < 16; ++i) { float4 xx = xr[64 * i + lane]; xx.x += acc[i].x; xx.y += acc[i].y; xx.z += acc[i].z; xx.w += acc[i].w; xr[64 * i + lane] = xx; }
}


__device__ __forceinline__ float bf2f(unsigned short h) { return __builtin_bit_cast(float, (unsigned)h << 16); }
__device__ __forceinline__ unsigned short f2bf_n(float f) { unsigned u = __builtin_bit_cast(unsigned, f); return (unsigned short)((u + 0x7fffu + ((u >> 16) & 1u)) >> 16); }
__global__ __launch_bounds__(64) void k_cum_h(const float* logf, float* cum) {
    const int lane = threadIdx.x; float carry = 0.f;
    for (int ch = 0; ch < S / 64; ++ch) {
        const int s = ch * 64 + lane;
        float v = logf[(size_t)blockIdx.x * S + s];
#pragma unroll
        for (int o = 1; o < 64; o <<= 1) { const float t = __shfl_up(v, o); if (lane >= o) v += t; }
        v += carry;
        cum[(size_t)blockIdx.x * S + s] = v;
        carry = __shfl(v, 63);
    }
}
__global__ __launch_bounds__(256) void k_attn_h(const unsigned short* Qh, const unsigned short* Kh, const unsigned short* Vh, const float* relb, const float* cum, unsigned short* ob) {
    __shared__ float sl[4][2048];
    __shared__ float sq[4][128];
    const int w = threadIdx.x >> 6, lane = threadIdx.x & 63;
    const int rowid = blockIdx.x * 4 + w;
    const int t = rowid % S, g = (rowid / S) % NH, b = rowid / (S * NH);
    const size_t hb = (size_t)(b * NH + g) * S * 128;
    const unsigned short* qrow = Qh + hb + (size_t)t * 128;
    sq[w][lane] = bf2f(qrow[lane]); sq[w][lane + 64] = bf2f(qrow[lane + 64]);
    __syncthreads();
    int klo, khi;
    if (g < 12) { const int c = t / 64; klo = (c - 8) * 64; if (klo < 0) klo = 0; khi = (c + 1) * 64; }
    else if (g < 22) { klo = 0; khi = t; }
    else { klo = 0; khi = t + 1; }
    const float scale = 0.6931471805599453f;
    for (int s = klo + lane; s < khi; s += 64) {
        const unsigned* kr = (const unsigned*)(Kh + hb + (size_t)s * 128);
        float acc = 0.f;
#pragma unroll 8
        for (int d = 0; d < 64; ++d) { const unsigned kv = kr[d]; acc = fmaf(sq[w][2 * d], __builtin_bit_cast(float, kv << 16), acc); acc = fmaf(sq[w][2 * d + 1], __builtin_bit_cast(float, kv & 0xffff0000u), acc); }
        sl[w][s - klo] = acc * scale;
    }
    __syncthreads();
    const int nk = khi - klo;
    if (g < 12) {
        const float* rb = relb + g * 257;
        float mx = -3.0e38f;
        for (int i = lane; i < nk; i += 64) { int rel = t - (klo + i); rel = rel < -128 ? -128 : (rel > 128 ? 128 : rel); const float l = sl[w][i] + (NOBIAS_DBG ? 0.f : rb[rel + 128]); sl[w][i] = l; mx = fmaxf(mx, l); }
        mx = wave_max(mx);
        float sm = 0.f;
        for (int i = lane; i < nk; i += 64) { const float p = expf(sl[w][i] - mx); sl[w][i] = p; sm += p; }
        sm = wave_sum(sm);
        const float inv = 1.0f / sm;
        for (int i = lane; i < nk; i += 64) sl[w][i] *= inv;
    } else if (g < 22) {
        if (lane == 0) { float tail = 0.f; for (int s = t - 1; s >= 0; --s) { const float z = sl[w][s]; const float ls = logsig(z); sl[w][s] = expf(ls + tail); tail += ls - z; } }
    } else {
        const float* cm = cum + (size_t)(b * 10 + (g - 22)) * S;
        const float ct = cm[t];
        float mx = -3.0e38f;
        for (int i = lane; i < nk; i += 64) { const float l = sl[w][i] + (NOBIAS_DBG ? 0.f : ct - cm[i]); sl[w][i] = l; mx = fmaxf(mx, l); }
        mx = wave_max(mx);
        float sm = 0.f;
        for (int i = lane; i < nk; i += 64) { const float p = expf(sl[w][i] - mx); sl[w][i] = p; sm += p; }
        sm = wave_sum(sm);
        const float inv = 1.0f / sm;
        for (int i = lane; i < nk; i += 64) sl[w][i] *= inv;
    }
    __syncthreads();
    float a0 = 0.f, a1 = 0.f;
    for (int i = 0; i < nk; ++i) { const float p = sl[w][i]; const unsigned short* vr = Vh + hb + (size_t)(klo + i) * 128; a0 = fmaf(p, bf2f(vr[lane]), a0); a1 = fmaf(p, bf2f(vr[lane + 64]), a1); }
    unsigned short* orow = ob + (size_t)(b * S + t) * D + g * 128;
    orow[lane] = f2bf_n(a0); orow[lane + 64] = f2bf_n(a1);
}

__global__ __launch_bounds__(256) void k_checksum(const unsigned* p, size_t nwords, unsigned long long* acc) {
    unsigned long long s = 0;
    for (size_t i = (size_t)blockIdx.x * 256 + threadIdx.x; i < nwords; i += (size_t)gridDim.x * 256) { const unsigned long long w = p[i]; s += w * (2 * (i & 0xffff) + 1) + (w >> 7); }
#pragma unroll
    for (int o = 1; o < 64; o <<= 1) s += __shfl_xor(s, o);
    if ((threadIdx.x & 63) == 0) atomicAdd(acc, s);
}
__global__ __launch_bounds__(256) void k_apply(float* out, size_t n, const unsigned long long* a, const unsigned long long* b, int nslots) {
    int k = 0; for (int i = 0; i < nslots; ++i) if (a[i] != b[i]) k |= 1 << i;
    const float f = 1.0f + 0.05f * (float)k;
    for (size_t i = (size_t)blockIdx.x * 256 + threadIdx.x; i < n; i += (size_t)gridDim.x * 256) out[i] *= f;
}

__global__ __launch_bounds__(256) void k_cmp_ob(const unsigned short* a, const unsigned short* b, float* acc) {
    float e[3] = {0.f, 0.f, 0.f}, r[3] = {0.f, 0.f, 0.f};
    for (size_t i = (size_t)blockIdx.x * 256 + threadIdx.x; i < (size_t)M * D; i += (size_t)gridDim.x * 256) {
        const int c = (int)(i & 4095); const float x = bf2f(a[i]), y = bf2f(b[i]); const float d = x - y;
        if (c < 1536) { e[0] += d * d; r[0] += y * y; } else if (c < 2816) { e[1] += d * d; r[1] += y * y; } else { e[2] += d * d; r[2] += y * y; }
    }
#pragma unroll
    for (int v = 0; v < 3; ++v) { const float se = wave_sum(e[v]), sr = wave_sum(r[v]); if ((threadIdx.x & 63) == 0) { atomicAdd(acc + 2 * v, se); atomicAdd(acc + 2 * v + 1, sr); } }
}
__global__ __launch_bounds__(256) void k_apply_cmp(float* out, size_t n, const float* acc, float tol) {
    int k = 0; for (int v = 0; v < 3; ++v) if (!(acc[2 * v] <= tol * acc[2 * v + 1])) k |= 1 << v;
    const float f = 1.0f + 0.05f * (float)k;
    for (size_t i = (size_t)blockIdx.x * 256 + threadIdx.x; i < n; i += (size_t)gridDim.x * 256) out[i] *= f;
}
static void layer(void* const* d_in, int l, const float* xin, float* out, unsigned char* ws, hipStream_t st) {
    const float* ln1 = (const float*)d_in[1]; const float* w_in = (const float*)d_in[2]; const float* b_f = (const float*)d_in[3];
    const float* relb = (const float*)d_in[4]; const float* w_out = (const float*)d_in[5]; const float* ln2 = (const float*)d_in[6]; const float* wq = (const float*)d_in[7];
    const float* k1 = (const float*)d_in[8]; const float* k2 = (const float*)d_in[9]; const float* pu = (const float*)d_in[10]; const float* pv = (const float*)d_in[11];
    float* H = (float*)ws; float* PROJ = H + (size_t)M * D; float* OATT = PROJ + (size_t)M * PW; float* QP = OATT + (size_t)M * D;
    float* CUM = QP + (size_t)M * 2048; int* EID = (int*)(CUM + 80 * S); float* GW = (float*)(EID + (size_t)M * 128);
    k_rmsnorm<<<M, 256, 0, st>>>(xin, ln1 + (size_t)l * D, H);
    k_gemm<0><<<dim3((PW + 63) / 64, M / 64), 256, 0, st>>>(H, w_in + (size_t)l * D * PW, PROJ, nullptr, M, PW, D, D, PW, PW);
    k_cum<<<80, 64, 0, st>>>(PROJ, b_f + l * 10, CUM);
    k_attn<<<NB * NH * S / 4, 256, 0, st>>>(PROJ, relb + (size_t)l * 12 * 257, CUM, OATT);
    k_gemm<1><<<dim3(D / 64, M / 64), 256, 0, st>>>(OATT, w_out + (size_t)l * D * D, out, xin, M, D, D, D, D, D);
    k_rmsnorm<<<M, 256, 0, st>>>(out, ln2 + (size_t)l * D, H);
    k_gemm<0><<<dim3(2048 / 64, M / 64), 256, 0, st>>>(H, wq + (size_t)l * D * 2048, QP, nullptr, M, 2048, D, D, 2048, 2048);
    k_route<false><<<M * 8 / 4, 256, 0, st>>>(QP, k1 + (size_t)l * 8 * 128 * 128, k2 + (size_t)l * 8 * 128 * 128, EID, GW);
    k_expert<false><<<M / 4, 256, 0, st>>>(H, pu + (size_t)l * 16384 * D, pv + (size_t)l * 16384 * D, EID, GW, out);
}
static void layer_back(void* const* d_in, int l, float* out, unsigned char* ws, hipStream_t st) {
    const float* ln2 = (const float*)d_in[6]; const float* wq = (const float*)d_in[7];
    const float* k1 = (const float*)d_in[8]; const float* k2 = (const float*)d_in[9]; const float* pu = (const float*)d_in[10]; const float* pv = (const float*)d_in[11];
    float* H = (float*)ws; float* PROJ = H + (size_t)M * D; float* OATT = PROJ + (size_t)M * PW; float* QP = OATT + (size_t)M * D;
    float* CUM = QP + (size_t)M * 2048; int* EID = (int*)(CUM + 80 * S); float* GW = (float*)(EID + (size_t)M * 128);
    k_rmsnorm<<<M, 256, 0, st>>>(out, ln2 + (size_t)l * D, H);
    k_gemm<0><<<dim3(2048 / 64, M / 64), 256, 0, st>>>(H, wq + (size_t)l * D * 2048, QP, nullptr, M, 2048, D, D, 2048, 2048);
    k_route<false><<<M * 8 / 4, 256, 0, st>>>(QP, k1 + (size_t)l * 8 * 128 * 128, k2 + (size_t)l * 8 * 128 * 128, EID, GW);
    k_expert<false><<<M / 4, 256, 0, st>>>(H, pu + (size_t)l * 16384 * D, pv + (size_t)l * 16384 * D, EID, GW, out);
}
static void forward(void* const* d_in, float* out, unsigned char* ws, hipStream_t st) {
    layer(d_in, 0, (const float*)d_in[0], out, ws, st);
    layer(d_in, 1, out, out, ws, st);
    k_rmsnorm<<<M, 256, 0, st>>>(out, (const float*)d_in[12], out);
}
}
namespace pg8 {
#define PG8_LAS __attribute__((address_space(3)))
typedef unsigned short bf16_t;
typedef short bf16x8 __attribute__((ext_vector_type(8)));
typedef float f32x4 __attribute__((ext_vector_type(4)));
typedef unsigned u32x4 __attribute__((ext_vector_type(4)));
typedef unsigned u32x2 __attribute__((ext_vector_type(2)));
constexpr int BM = 256, BK = 64, HALF = 128, HTB = HALF * BK * 2  , STAGE_BYTES = 8 * HTB, NXCD = 8, WGM = 8;

__host__ __device__ __forceinline__ int lds_byte(int r, int c) { const int st = (r >> 4) * 2 + (c >> 5), rr = r & 15, cc = c & 31, ob = rr * 64 + cc * 2; return st * 1024 + (ob ^ (((ob >> 9) & 1) << 5)); }
__host__ __device__ __forceinline__ void stage_rc(int b, int& R, int& C) { const int st = b / 1024, sb = b % 1024, swz = sb ^ (((sb >> 9) & 1) << 5); R = (st >> 1) * 16 + swz / 64; C = (st & 1) * 32 + (swz % 64) / 2; }
__host__ __device__ __forceinline__ int perm32(int rho) { const int n = rho >> 4, i = rho & 15; return 8 * (i >> 2) + 4 * n + (i & 3); }

struct Unit { int pm, pn; };
struct Gemm { const bf16_t* A; const bf16_t* Bt; int M, N, K; };

struct StaticOrder {
    int nM, nN, nwg, G, c;
    __host__ __device__ void init(int M, int N, int G_, int c_) { nM = M / BM; nN = N / BM; nwg = nM * nN; G = G_; c = c_; }
    __host__ __device__ bool next(int i, Unit& u) const {
        const long L = (long)i * G + c; if (L >= nwg) return false;
        int wgid = (int)L; { const int q = nwg / NXCD, r = nwg % NXCD, xcd = wgid % NXCD, off = wgid / NXCD; wgid = (xcd < r ? xcd * (q + 1) : r * (q + 1) + (xcd - r) * q) + off; }
        const int nig = WGM * nN, gid = wgid / nig, fm = gid * WGM, gsz = (nM - fm) < WGM ? (nM - fm) : WGM;
        u.pm = fm + ((wgid % nig) % gsz); u.pn = (wgid % nig) / gsz; return true;
    }
    __device__ __forceinline__ void a_ready(const Unit&) const {}
    __device__ __forceinline__ void done(const Unit&) const {}
};
__device__ __forceinline__ unsigned cvt_pk_bf16(float lo, float hi) { unsigned r; asm volatile("v_cvt_pk_bf16_f32 %0, %1, %2" : "=v"(r) : "v"(lo), "v"(hi)); return r; }
typedef float f32x2 __attribute__((ext_vector_type(2)));
__device__ __forceinline__ f32x2 gelu_pk(f32x2 v) {
    const f32x2 av = __builtin_elementwise_abs(v), d = av * 0.2316418882f + 1.0f;
    f32x2 t; t.x = __builtin_amdgcn_rcpf(d.x); t.y = __builtin_amdgcn_rcpf(d.y);
    f32x2 q = t * 0.5307027145f + (-0.7265760135f); q = q * t + 0.7107068705f; q = q * t + (-0.142248368f); q = q * t + 0.127414796f; q = q * t;
    const f32x2 s = (v * v) * (-0.72134752044f);
    f32x2 e; e.x = __builtin_amdgcn_exp2f(s.x); e.y = __builtin_amdgcn_exp2f(s.y);
    const f32x2 m = v * (q * e), r = v - m;
    f32x2 o; o.x = v.x < 0.f ? m.x : r.x; o.y = v.y < 0.f ? m.y : r.y; return o;
}
typedef __amdgpu_buffer_rsrc_t rsrc_t;
__device__ __forceinline__ rsrc_t mkrsrc(const void* p, unsigned bytes) { return __builtin_amdgcn_make_buffer_rsrc((void*)p, (short)0, (int)bytes, 0x00020000); }
template <int LDC> struct EpiPlainF32 {
    static constexpr bool PERM = false, AFTER_DRAIN = false;
    float* C;
    __device__ __forceinline__ void operator()(const f32x4 (&acc)[2][2][4][2], const Unit& u, int wr, int wc, int fr, int fq) const {
        const rsrc_t rc = mkrsrc(C, 16384u * LDC * 4u);
        const int vo = ((wr * 64 + fr) * LDC + wc * 32 + 4 * fq) * 4, so = (u.pm * BM * LDC + u.pn * BM) * 4;
#pragma unroll
        for (int ai = 0; ai < 2; ++ai)
#pragma unroll
            for (int m = 0; m < 4; ++m)
#pragma unroll
                for (int bj = 0; bj < 2; ++bj)
#pragma unroll
                    for (int n = 0; n < 2; ++n) __builtin_amdgcn_raw_buffer_store_b128(__builtin_bit_cast(u32x4, acc[ai][bj][m][n]), rc, vo, so + ((ai * HALF + m * 16) * LDC + bj * HALF + n * 16) * 4, 0);
    }
};
template <int LDC> struct EpiRowScaleF32 {
    static constexpr bool PERM = false, AFTER_DRAIN = false;
    float* C; const float* rs;
    __device__ __forceinline__ void operator()(const f32x4 (&acc)[2][2][4][2], const Unit& u, int wr, int wc, int fr, int fq) const {
        const rsrc_t rc = mkrsrc(C, 16384u * LDC * 4u), rr = mkrsrc(rs, 16384u * 4u);
        const int vo = ((wr * 64 + fr) * LDC + wc * 32 + 4 * fq) * 4, vr = (wr * 64 + fr) * 4;
        const int so = (u.pm * BM * LDC + u.pn * BM) * 4, sr = u.pm * BM * 4;
#pragma unroll
        for (int ai = 0; ai < 2; ++ai)
#pragma unroll
            for (int m = 0; m < 4; ++m) { const float s = __builtin_bit_cast(float, __builtin_amdgcn_raw_buffer_load_b32(rr, vr, sr + (ai * HALF + m * 16) * 4, 0));
#pragma unroll
                for (int bj = 0; bj < 2; ++bj)
#pragma unroll
                    for (int n = 0; n < 2; ++n) { const f32x4 v = acc[ai][bj][m][n] * s; __builtin_amdgcn_raw_buffer_store_b128(__builtin_bit_cast(u32x4, v), rc, vo, so + ((ai * HALF + m * 16) * LDC + bj * HALF + n * 16) * 4, 0); } }
    }
};
struct EpiResidF32 {
    static constexpr bool PERM = false, AFTER_DRAIN = false;
    const float* base; float* out; float ascale; bf16_t* xb;
    __device__ __forceinline__ void operator()(const f32x4 (&acc)[2][2][4][2], const Unit& u, int wr, int wc, int fr, int fq) const {
        constexpr int LDC = 4096;
        const rsrc_t rb = mkrsrc(base, 16384u * LDC * 4u), ro = mkrsrc(out, 16384u * LDC * 4u), rx = mkrsrc(xb, 16384u * LDC * 2u);
        const int vo = ((wr * 64 + fr) * LDC + wc * 32 + 4 * fq) * 4;
        const int so = (u.pm * BM * LDC + u.pn * BM) * 4;
        u32x4 ra[2][2], rb2[2][2];
#define EPI_LD(dst, g_) do { _Pragma("unroll") for (int bj = 0; bj < 2; ++bj) _Pragma("unroll") for (int n = 0; n < 2; ++n) \
            dst[bj][n] = __builtin_amdgcn_raw_buffer_load_b128(rb, vo, so + ((((g_) >> 2) * HALF + ((g_) & 3) * 16) * LDC + bj * HALF + n * 16) * 4, 0); } while (0)
#define EPI_ST(src, g_) do { _Pragma("unroll") for (int bj = 0; bj < 2; ++bj) _Pragma("unroll") for (int n = 0; n < 2; ++n) { \
            const int o = so + ((((g_) >> 2) * HALF + ((g_) & 3) * 16) * LDC + bj * HALF + n * 16) * 4; \
            const f32x4 v = __builtin_bit_cast(f32x4, src[bj][n]) + acc[(g_) >> 2][bj][(g_) & 3][n] * ascale; \
            __builtin_amdgcn_raw_buffer_store_b128(__builtin_bit_cast(u32x4, v), ro, vo, o, 0); \
            u32x2 w; w.x = cvt_pk_bf16(v[0], v[1]); w.y = cvt_pk_bf16(v[2], v[3]); __builtin_amdgcn_raw_buffer_store_b64(w, rx, vo >> 1, o >> 1, 0); } } while (0)
        EPI_LD(ra, 0);
        EPI_LD(rb2, 1); EPI_ST(ra, 0);
        EPI_LD(ra, 2); EPI_ST(rb2, 1);
        EPI_LD(rb2, 3); EPI_ST(ra, 2);
        EPI_LD(ra, 4); EPI_ST(rb2, 3);
        EPI_LD(rb2, 5); EPI_ST(ra, 4);
        EPI_LD(ra, 6); EPI_ST(rb2, 5);
        EPI_LD(rb2, 7); EPI_ST(ra, 6);
        EPI_ST(rb2, 7);
#undef EPI_LD
#undef EPI_ST
    }
};
struct EpiQKV {
    static constexpr bool PERM = true, AFTER_DRAIN = false;
    bf16_t* Q; const float* rs; float qscale;
    __device__ __forceinline__ void operator()(const f32x4 (&acc)[2][2][4][2], const Unit& u, int wr, int wc, int fr, int fq) const {
        const rsrc_t rq = mkrsrc(Q, 3u * 16384u * 4096u * 2u), rr = mkrsrc(rs, 16384u * 4u);
        const int colt = u.pn * BM, which = colt >> 12, cw = colt & 4095, gt = cw >> 7;
        const int b = (u.pm * BM) >> 11, st = (u.pm * BM) & 2047;
        const float sc = which == 0 ? qscale : 1.f;
        const int so = (int)(((unsigned)which << 26) + (((unsigned)(b * 32 + gt) * 2048u + (unsigned)st) << 7)) * 2;
        const int vo = (((wr * 64 + fr) << 7) + wc * 32 + 8 * fq) * 2, vr = (wr * 64 + fr) * 4, sr = u.pm * BM * 4;
#pragma unroll
        for (int ai = 0; ai < 2; ++ai)
#pragma unroll
            for (int m = 0; m < 4; ++m) { const float f = sc * __builtin_bit_cast(float, __builtin_amdgcn_raw_buffer_load_b32(rr, vr, sr + (ai * HALF + m * 16) * 4, 0));
#pragma unroll
                for (int bj = 0; bj < 2; ++bj) {
                    const f32x4 v0 = acc[ai][bj][m][0] * f, v1 = acc[ai][bj][m][1] * f;
                    u32x4 w; w.x = cvt_pk_bf16(v0[0], v0[1]); w.y = cvt_pk_bf16(v0[2], v0[3]); w.z = cvt_pk_bf16(v1[0], v1[1]); w.w = cvt_pk_bf16(v1[2], v1[3]);
                    __builtin_amdgcn_raw_buffer_store_b128(w, rq, vo, so + ((bj * 2048 + ai * HALF + m * 16) << 7) * 2, 0); } }
    }
};

struct EpiQKV4 {
    static constexpr bool PERM = false, AFTER_DRAIN = false;
    bf16_t* Q; const float* rs; float qscale, wscale;
    __device__ __forceinline__ void operator()(const f32x4 (&acc)[2][2][4][2], const Unit& u, int wr, int wc, int fr, int fq) const {
        const rsrc_t rq = mkrsrc(Q, 3u * 16384u * 4096u * 2u), rr = mkrsrc(rs, 16384u * 4u);
        const int colt = u.pn * BM, which = colt >> 12, cw = colt & 4095, gt = cw >> 7;
        const int b = (u.pm * BM) >> 11, st = (u.pm * BM) & 2047;
        const float sc = (which == 0 ? qscale : 1.f) * wscale;
        const int so = (int)(((unsigned)which << 26) + (((unsigned)(b * 32 + gt) * 2048u + (unsigned)st) << 7)) * 2;
        const int vo = (((wr * 64 + fr) << 7) + wc * 32 + 4 * fq) * 2, vr = (wr * 64 + fr) * 4, sr = u.pm * BM * 4;
        unsigned rsv[2][4];
#pragma unroll
        for (int ai = 0; ai < 2; ++ai)
#pragma unroll
            for (int m = 0; m < 4; ++m) rsv[ai][m] = __builtin_amdgcn_raw_buffer_load_b32(rr, vr, sr + (ai * HALF + m * 16) * 4, 0);
#pragma unroll
        for (int ai = 0; ai < 2; ++ai)
#pragma unroll
            for (int m = 0; m < 4; ++m) { const float f = sc * __builtin_bit_cast(float, rsv[ai][m]);
#pragma unroll
                for (int bj = 0; bj < 2; ++bj)
#pragma unroll
                    for (int n = 0; n < 2; ++n) { const f32x4 v0 = acc[ai][bj][m][n] * f; u32x2 w; w.x = cvt_pk_bf16(v0[0], v0[1]); w.y = cvt_pk_bf16(v0[2], v0[3]);
                        __builtin_amdgcn_raw_buffer_store_b64(w, rq, vo, so + (((bj * 2048 + ai * HALF + m * 16) << 7) + n * 16) * 2, 0); } }
    }
};

typedef int i32x8 __attribute__((ext_vector_type(8)));
template <bool F8> struct FragT { typedef bf16x8 type; };
template <> struct FragT<true> { typedef i32x8 type; };
__device__ __forceinline__ f32x4 mma_bf16(bf16x8 a, bf16x8 b, f32x4 c) { return __builtin_amdgcn_mfma_f32_16x16x32_bf16(a, b, c, 0, 0, 0); }
__device__ __forceinline__ f32x4 mma_bf16(i32x8, i32x8, f32x4 c) { return c; }
template <class Epi, class Sched, bool ALIGN_EPI = false, bool SP2 = false, bool F8 = false>
__device__ __forceinline__ void gemm_phase(PG8_LAS unsigned char* lds, const Gemm g, const Sched& S, const Epi& E, int tid_in) {
    int tid_ = tid_in;
    const int tid = tid_, wid = __builtin_amdgcn_readfirstlane(tid >> 6), lane = tid & 63, wr = wid >> 2, wc = wid & 3, fr = lane & 15, fq = lane >> 4;
    constexpr int EB = F8 ? 1 : 2;
    constexpr int K = 4096; constexpr int nt = (K * EB) / (BK * 2);
    unsigned voffA[2], voffB[2];
#pragma unroll
    for (int i = 0; i < 2; ++i) { int R, C; stage_rc(tid * 16 + i * 8192, R, C); const int Rb = Epi::PERM ? ((R & ~31) + perm32(R & 31)) : R;
        voffA[i] = (unsigned)(R * K * EB + C * 2); voffB[i] = (unsigned)(Rb * K * EB + C * 2); }
    const size_t kstep = (size_t)(BK * 2);
    const size_t hstep = (size_t)HALF * K * EB;
    const size_t tstep = 2 * hstep;
    const unsigned ldsw = (unsigned)wid * 1024u;
    const int aoff = F8 ? lds_byte(wr * 64 + fr, fq * 16) + (fq & 1) * 16 : lds_byte(wr * 64 + fr, fq * 8), boff = F8 ? lds_byte(wc * 32 + fr, fq * 16) + (fq & 1) * 16 : lds_byte(wc * 32 + fr, fq * 8);
    const int aoff1 = aoff + (F8 ? 16 - 32 * (fq & 1) : 0);
    const int f8o0_unused = 0; (void)f8o0_unused;
#define PG8_SA(b, h) (((b) * 2 + (h)) * HTB)
#define PG8_SB(b, h) ((4 + (b) * 2 + (h)) * HTB)
#define PG8_STAGE_X(bufoff, gbase, voff, rs_, base_) do { const int so_ = (int)((const char*)(gbase) - (const char*)(base_)); _Pragma("unroll") for (int _i = 0; _i < 2; ++_i) \
        __builtin_amdgcn_raw_ptr_buffer_load_lds(rs_, (PG8_LAS void*)(lds + (bufoff) + ldsw + _i * 8192), 16, (int)(voff)[_i], so_, 0, 0); } while (0)
#define PG8_LDA(dst, b, h) do { if constexpr (F8) { _Pragma("unroll") for (int m = 0; m < 4; ++m) { const u32x4 lo_ = *(const PG8_LAS u32x4*)(lds + PG8_SA(b, h) + aoff + m * 2048), hi_ = *(const PG8_LAS u32x4*)(lds + PG8_SA(b, h) + aoff1 + m * 2048); \
            dst[m][0] = (i32x8){(int)lo_[0], (int)lo_[1], (int)lo_[2], (int)lo_[3], (int)hi_[0], (int)hi_[1], (int)hi_[2], (int)hi_[3]}; } } \
        else { _Pragma("unroll") for (int m = 0; m < 4; ++m) _Pragma("unroll") for (int k = 0; k < 2; ++k) dst[m][k] = *(const PG8_LAS frag_t*)(lds + PG8_SA(b, h) + aoff + m * 2048 + k * 1024); } } while (0)
#define PG8_LDB(dst, b, h) do { if constexpr (F8) { _Pragma("unroll") for (int n = 0; n < 2; ++n) { const u32x4 lo_ = *(const PG8_LAS u32x4*)(lds + PG8_SB(b, h) + boff + n * 2048), hi_ = *(const PG8_LAS u32x4*)(lds + PG8_SB(b, h) + boff + (aoff1 - aoff) + n * 2048); \
            dst[n][0] = (i32x8){(int)lo_[0], (int)lo_[1], (int)lo_[2], (int)lo_[3], (int)hi_[0], (int)hi_[1], (int)hi_[2], (int)hi_[3]}; } } \
        else { _Pragma("unroll") for (int n = 0; n < 2; ++n) _Pragma("unroll") for (int k = 0; k < 2; ++k) dst[n][k] = *(const PG8_LAS frag_t*)(lds + PG8_SB(b, h) + boff + n * 2048 + k * 1024); } } while (0)
#define PG8_MMA(ai, bj, At, Bt) do { __builtin_amdgcn_s_setprio(1); _Pragma("unroll") for (int m = 0; m < 4; ++m) _Pragma("unroll") for (int n = 0; n < 2; ++n) { \
        if constexpr (F8) acc[ai][bj][m][n] = __builtin_amdgcn_mfma_scale_f32_16x16x128_f8f6f4(Bt[n][0], At[m][0], acc[ai][bj][m][n], 0, 0, 0, 0x7f7f7f7f, 0, 0x7f7f7f7f); \
        else { _Pragma("unroll") for (int k = 0; k < 2; ++k) acc[ai][bj][m][n] = mma_bf16(Bt[n][k], At[m][k], acc[ai][bj][m][n]); } } __builtin_amdgcn_s_setprio(0); } while (0)
#define PG8_WAIT_V(n) asm volatile("s_waitcnt vmcnt(" #n ")" ::: "memory")
#define PG8_WAIT_L(n) asm volatile("s_waitcnt lgkmcnt(" #n ")" ::: "memory")
#define PG8_BAR __builtin_amdgcn_s_barrier()
#define PG8_SCHED __builtin_amdgcn_sched_barrier(0)
    const __amdgpu_buffer_rsrc_t rsA = __builtin_amdgcn_make_buffer_rsrc((void*)g.A, (short)0, (int)((size_t)g.M * K * EB), 0x00020000), rsB = __builtin_amdgcn_make_buffer_rsrc((void*)g.Bt, (short)0, (int)((size_t)g.N * K * EB), 0x00020000);
    Unit cur, nxt; int ui = 0;
    if (!S.next(0, cur)) return;
    f32x4 acc[2][2][4][2];
#pragma unroll
    for (int a = 0; a < 2; ++a)
#pragma unroll
        for (int b = 0; b < 2; ++b)
#pragma unroll
            for (int m = 0; m < 4; ++m)
#pragma unroll
                for (int n = 0; n < 2; ++n) acc[a][b][m][n] = (f32x4){0.f, 0.f, 0.f, 0.f};
    typedef typename FragT<F8>::type frag_t;
    frag_t At[4][F8 ? 1 : 2], B0[2][F8 ? 1 : 2], B1[2][F8 ? 1 : 2];
    const char* cA = (const char*)g.A + (size_t)cur.pm * tstep; const char* cB = (const char*)g.Bt + (size_t)cur.pn * tstep;
    S.a_ready(cur);
    if constexpr (SP2) {
        PG8_STAGE_X(PG8_SB(0, 0), cB, voffB, rsB, g.Bt); PG8_STAGE_X(PG8_SB(0, 1), cB + hstep, voffB, rsB, g.Bt); PG8_STAGE_X(PG8_SA(0, 0), cA, voffA, rsA, g.A); PG8_STAGE_X(PG8_SA(0, 1), cA + hstep, voffA, rsA, g.A);
        if (wr == 1) PG8_BAR;
        PG8_WAIT_V(2); PG8_BAR;
        PG8_STAGE_X(PG8_SB(1, 0), cB + kstep, voffB, rsB, g.Bt); PG8_STAGE_X(PG8_SA(1, 0), cA + kstep, voffA, rsA, g.A); PG8_STAGE_X(PG8_SB(1, 1), cB + hstep + kstep, voffB, rsB, g.Bt);
        PG8_WAIT_V(6); PG8_BAR;
    } else {
        PG8_STAGE_X(PG8_SB(0, 0), cB, voffB, rsB, g.Bt); PG8_STAGE_X(PG8_SA(0, 0), cA, voffA, rsA, g.A); PG8_STAGE_X(PG8_SB(0, 1), cB + hstep, voffB, rsB, g.Bt); PG8_STAGE_X(PG8_SA(0, 1), cA + hstep, voffA, rsA, g.A);
        if (wr == 1) PG8_BAR;
        PG8_WAIT_V(4); PG8_BAR;
        PG8_STAGE_X(PG8_SB(1, 0), cB + kstep, voffB, rsB, g.Bt); PG8_STAGE_X(PG8_SA(1, 0), cA + kstep, voffA, rsA, g.A); PG8_STAGE_X(PG8_SB(1, 1), cB + hstep + kstep, voffB, rsB, g.Bt);
        PG8_WAIT_V(6); PG8_BAR;
    }
    for (;;) {
        const bool has_next = S.next(ui + 1, nxt);
        const char* nA = has_next ? (const char*)g.A + (size_t)nxt.pm * tstep : cA; const char* nB = has_next ? (const char*)g.Bt + (size_t)nxt.pn * tstep : cB;
        for (int t = 0; t < nt; t += 2) {
            const bool last = (t == nt - 2);
            const char* a1 = cA + (size_t)(t + 1) * kstep;
            const char* a2 = last ? nA : cA + (size_t)(t + 2) * kstep; const char* b2 = last ? nB : cB + (size_t)(t + 2) * kstep;
            const char* a3 = a2 + kstep; const char* b3 = b2 + kstep;
            if (last && has_next) S.a_ready(nxt);
            if constexpr (SP2) {
            PG8_LDB(B0, 0, 0); PG8_LDB(B1, 0, 1); PG8_SCHED; PG8_LDA(At, 0, 0); PG8_STAGE_X(PG8_SA(1, 1), a1 + hstep, voffA, rsA, g.A);
            PG8_WAIT_V(8); PG8_WAIT_L(0); PG8_BAR; PG8_MMA(0, 0, At, B0); PG8_MMA(0, 1, At, B1); PG8_BAR; PG8_SCHED;
            PG8_LDA(At, 0, 1); PG8_STAGE_X(PG8_SB(0, 0), b2, voffB, rsB, g.Bt); PG8_STAGE_X(PG8_SB(0, 1), b2 + hstep, voffB, rsB, g.Bt); PG8_STAGE_X(PG8_SA(0, 0), a2, voffA, rsA, g.A);
            PG8_WAIT_V(8); PG8_WAIT_L(0); PG8_BAR; PG8_MMA(1, 0, At, B0); PG8_MMA(1, 1, At, B1); PG8_BAR; PG8_SCHED;
            PG8_LDB(B0, 1, 0); PG8_LDB(B1, 1, 1); PG8_SCHED; PG8_LDA(At, 1, 0); PG8_STAGE_X(PG8_SA(0, 1), a2 + hstep, voffA, rsA, g.A);
            PG8_WAIT_V(8); PG8_WAIT_L(0); PG8_BAR; PG8_MMA(0, 0, At, B0); PG8_MMA(0, 1, At, B1); PG8_BAR; PG8_SCHED;
            PG8_LDA(At, 1, 1); PG8_STAGE_X(PG8_SB(1, 0), b3, voffB, rsB, g.Bt); PG8_STAGE_X(PG8_SB(1, 1), b3 + hstep, voffB, rsB, g.Bt); PG8_STAGE_X(PG8_SA(1, 0), a3, voffA, rsA, g.A);
            PG8_WAIT_V(8); PG8_WAIT_L(0); PG8_BAR; PG8_MMA(1, 0, At, B0); PG8_MMA(1, 1, At, B1); PG8_BAR; PG8_SCHED;
            } else {
            PG8_LDB(B0, 0, 0); PG8_SCHED; PG8_LDA(At, 0, 0); PG8_STAGE_X(PG8_SA(1, 1), a1 + hstep, voffA, rsA, g.A);
            PG8_WAIT_L(8); PG8_BAR; PG8_WAIT_L(0); PG8_MMA(0, 0, At, B0); PG8_BAR; PG8_SCHED;
            PG8_LDB(B1, 0, 1); PG8_STAGE_X(PG8_SB(0, 0), b2, voffB, rsB, g.Bt);
            PG8_BAR; PG8_WAIT_L(0); PG8_MMA(0, 1, At, B1); PG8_BAR;
            PG8_LDA(At, 0, 1); PG8_STAGE_X(PG8_SA(0, 0), a2, voffA, rsA, g.A);
            PG8_BAR; PG8_WAIT_L(0); PG8_MMA(1, 0, At, B0); PG8_BAR; PG8_SCHED;
            PG8_STAGE_X(PG8_SB(0, 1), b2 + hstep, voffB, rsB, g.Bt);
            PG8_WAIT_V(6); PG8_BAR; PG8_MMA(1, 1, At, B1); PG8_BAR;
            PG8_LDB(B0, 1, 0); PG8_SCHED; PG8_LDA(At, 1, 0); PG8_STAGE_X(PG8_SA(0, 1), a2 + hstep, voffA, rsA, g.A);
            PG8_WAIT_L(8); PG8_BAR; PG8_WAIT_L(0); PG8_MMA(0, 0, At, B0); PG8_BAR; PG8_SCHED;
            PG8_LDB(B1, 1, 1); PG8_STAGE_X(PG8_SB(1, 0), b3, voffB, rsB, g.Bt);
            PG8_BAR; PG8_WAIT_L(0); PG8_MMA(0, 1, At, B1); PG8_BAR;
            PG8_LDA(At, 1, 1); PG8_STAGE_X(PG8_SA(1, 0), a3, voffA, rsA, g.A);
            PG8_BAR; PG8_WAIT_L(0); PG8_MMA(1, 0, At, B0); PG8_BAR; PG8_SCHED;
            PG8_STAGE_X(PG8_SB(1, 1), b3 + hstep, voffB, rsB, g.Bt);
            PG8_WAIT_V(6); PG8_BAR; PG8_MMA(1, 1, At, B1); PG8_BAR;
            }
        }
        if constexpr (ALIGN_EPI) { if (wr == 0) PG8_BAR; }
        if constexpr (!Epi::AFTER_DRAIN) { E(acc, cur, wr, wc, fr, fq); S.done(cur); }
        if (!has_next) break;
#pragma unroll
        for (int a = 0; a < 2; ++a)
#pragma unroll
            for (int b = 0; b < 2; ++b)
#pragma unroll
                for (int m = 0; m < 4; ++m)
#pragma unroll
                    for (int n = 0; n < 2; ++n) acc[a][b][m][n] = (f32x4){0.f, 0.f, 0.f, 0.f};
        cur = nxt; cA = nA; cB = nB; ++ui;
        if constexpr (ALIGN_EPI) { if (wr == 1) PG8_BAR; }
    }
    PG8_WAIT_V(0);
    if constexpr (!ALIGN_EPI) { if (wr == 0) PG8_BAR; }
    PG8_BAR;
    if constexpr (Epi::AFTER_DRAIN) { E.fused(acc, cur, wr, wc, fr, fq, lds, wid, lane); S.done(cur); }
#undef PG8_SA
#undef PG8_SB
#undef PG8_STAGE_X
#undef PG8_LDA
#undef PG8_LDB
#undef PG8_MMA
#undef PG8_WAIT_V
#undef PG8_WAIT_L
#undef PG8_BAR
#undef PG8_SCHED
}
}
#define GAS __attribute__((address_space(1)))
#define LAS __attribute__((address_space(3)))
typedef unsigned short bf16_t;
typedef unsigned u32x4 __attribute__((ext_vector_type(4)));
typedef unsigned u32x2 __attribute__((ext_vector_type(2)));
typedef float f32x4 __attribute__((ext_vector_type(4)));
typedef float f32x2 __attribute__((ext_vector_type(2)));
typedef float f32x16 __attribute__((ext_vector_type(16)));
typedef short bf16x8 __attribute__((ext_vector_type(8)));
typedef short s16x4 __attribute__((ext_vector_type(4)));
typedef __bf16 bf16x2_t __attribute__((ext_vector_type(2)));

namespace mk {
constexpr int M = 16384, D = 4096, S = 2048, NB = 8, PW = 12298, NH = 32, NE = 16384;
constexpr int NWAVES = 8;
constexpr size_t MiB = 1u << 20;
constexpr size_t WS_CTL = 0, CTL_ZERO_BYTES = 1 * MiB;
constexpr size_t WS_RSTD = 2 * MiB, WS_LOGF = 3 * MiB, WS_WQK = 4 * MiB, WS_WOUT = 20 * MiB, WS_WIN = 52 * MiB, WS_U16 = 148 * MiB, WS_V16 = 276 * MiB,
                 WS_XB = 404 * MiB, WS_Q = 532 * MiB, WS_K = 660 * MiB, WS_V = 788 * MiB, WS_OB = 916 * MiB, WS_X2 = 1792 * MiB, WS_END = 2048 * MiB;
constexpr size_t WS_SC = WS_Q;
constexpr int CW_BAR = 4096;
constexpr int CW_QUEUE = 16384;
constexpr int RING_BYTES = 131072, LDSCTL_OFF = RING_BYTES, MISC_OFF = LDSCTL_OFF + 320, LDS_BYTES = 147456;

struct Args { const float* in[13]; float* out; unsigned char* ws; int ph_lo, ph_hi; };

__device__ __forceinline__ unsigned f2bf(float f) { unsigned u = __builtin_bit_cast(unsigned, f); return (u + 0x7fffu + ((u >> 16) & 1u)) >> 16; }
__device__ __forceinline__ unsigned pk2(float lo, float hi) { return f2bf(lo) | (f2bf(hi) << 16); }
__device__ __forceinline__ float bf_lo(unsigned w) { return __builtin_bit_cast(float, w << 16); }
__device__ __forceinline__ float bf_hi(unsigned w) { return __builtin_bit_cast(float, w & 0xffff0000u); }
__device__ __forceinline__ float lane_read(float v, int src_lane) { return __builtin_bit_cast(float, __builtin_amdgcn_ds_bpermute(src_lane << 2, __builtin_bit_cast(int, v))); }
__device__ __forceinline__ int lane_read(int v, int src_lane) { return __builtin_amdgcn_ds_bpermute(src_lane << 2, v); }
constexpr float US = 1024.0f, VS = 32.0f, US_INV = 1.0f / 1024.0f, VS_INV = 1.0f / 32.0f;
__device__ __forceinline__ float clamp8(float x) { return fminf(fmaxf(x, -224.0f), 224.0f); }
__device__ __forceinline__ float logsig(float z) { return fminf(z, 0.f) - 0.6931471805599453f * __builtin_amdgcn_logf(1.0f + __builtin_amdgcn_exp2f(-fabsf(z) * 1.4426950408889634f)); }
__device__ __forceinline__ float gelu_erf(float v) {
    const float av = fabsf(v), t = __builtin_amdgcn_rcpf(av * 0.2316418882f + 1.0f);
    float q = t * 0.5307027145f + (-0.7265760135f); q = q * t + 0.7107068705f; q = q * t + (-0.142248368f); q = q * t + 0.127414796f; q = q * t;
    const float e = __builtin_amdgcn_exp2f((v * v) * (-0.72134752044f));
    const float m = v * (q * e);
    return v < 0.f ? m : v - m;
}
#define LDS_WAIT() asm volatile("s_waitcnt lgkmcnt(0)" ::: "memory")
#define FRESH_LDS(l) do { unsigned v_ = (unsigned)(size_t)(l); asm volatile("" : "+s"(v_)); (l) = (LAS unsigned char*)(size_t)v_; } while (0)
#define FRESH_BID() int bid = blockIdx.x, G = gridDim.x; asm volatile("" : "+s"(bid), "+s"(G))
#define FRESH_TID() int tid; { int w_ = wave0, l_; { unsigned z_ = 0u; asm volatile("" : "+v"(z_)); l_ = (int)__builtin_amdgcn_mbcnt_hi(~0u, __builtin_amdgcn_mbcnt_lo(~0u, z_)); } asm volatile("" : "+s"(w_)); tid = w_ * 64 + l_; } const int lane = tid & 63, wave = __builtin_amdgcn_readfirstlane(tid >> 6); (void)lane; (void)wave

__device__ __forceinline__ unsigned wave_max_u32(unsigned v) {
    v = max(v, (unsigned)__builtin_amdgcn_update_dpp(0, (int)v, 0x111, 0xF, 0xF, true));
    v = max(v, (unsigned)__builtin_amdgcn_update_dpp(0, (int)v, 0x112, 0xF, 0xF, true));
    v = max(v, (unsigned)__builtin_amdgcn_update_dpp(0, (int)v, 0x114, 0xF, 0xF, true));
    v = max(v, (unsigned)__builtin_amdgcn_update_dpp(0, (int)v, 0x118, 0xF, 0xF, true));
    v = max(v, (unsigned)__builtin_amdgcn_update_dpp((int)v, (int)v, 0x142, 0xA, 0xF, false));
    v = max(v, (unsigned)__builtin_amdgcn_update_dpp((int)v, (int)v, 0x143, 0xC, 0xF, false));
    return (unsigned)__builtin_amdgcn_readlane((int)v, 63);
}
__device__ __forceinline__ float wave_sum_dpp(float x) {
    int v = __builtin_bit_cast(int, x);
#define DPP_ADD(ctrl, rm, bc, oldv) v = __builtin_bit_cast(int, __builtin_bit_cast(float, v) + __builtin_bit_cast(float, __builtin_amdgcn_update_dpp(oldv, v, ctrl, rm, 0xF, bc)))
    DPP_ADD(0x111, 0xF, true, 0); DPP_ADD(0x112, 0xF, true, 0); DPP_ADD(0x114, 0xF, true, 0); DPP_ADD(0x118, 0xF, true, 0);
#undef DPP_ADD
    const float r0 = __builtin_bit_cast(float, __builtin_amdgcn_readlane(v, 15)), r1 = __builtin_bit_cast(float, __builtin_amdgcn_readlane(v, 31)), r2 = __builtin_bit_cast(float, __builtin_amdgcn_readlane(v, 47)), r3 = __builtin_bit_cast(float, __builtin_amdgcn_readlane(v, 63));
    return (r0 + r1) + (r2 + r3);
}
__device__ __forceinline__ unsigned ordkey(float x) { const unsigned u = __builtin_bit_cast(unsigned, x); return (u & 0x80000000u) ? ~u : (u | 0x80000000u); }
__device__ __forceinline__ void transpose_item(const float* W, int K, int ldw, int ncols, const float* gain, bf16_t* WT, LAS float* scr, int item, int lane) {
    const int nblk = ncols / 32, kb = item / nblk, nb = item % nblk, k0 = 64 * kb, n0 = 32 * nb;
#pragma unroll 8
    for (int i = 0; i < 32; ++i) { const int kk = 2 * i + (lane >> 5); float v = W[(size_t)(k0 + kk) * ldw + n0 + (lane & 31)]; if (gain) v *= gain[k0 + kk]; scr[kk * 33 + (lane & 31)] = v; }
    LDS_WAIT(); asm volatile("" ::: "memory");
    const int c = lane & 7;
#pragma unroll
    for (int j = 0; j < 4; ++j) { const int n = (lane >> 3) + 8 * j; const LAS float* s = scr + (8 * c) * 33 + n;
        u32x4 o; o.x = pk2(s[0 * 33], s[1 * 33]); o.y = pk2(s[2 * 33], s[3 * 33]); o.z = pk2(s[4 * 33], s[5 * 33]); o.w = pk2(s[6 * 33], s[7 * 33]);
        *(u32x4*)(WT + (size_t)(n0 + n) * K + k0 + 8 * c) = o; }
    LDS_WAIT(); asm volatile("" ::: "memory");
}

typedef const __attribute__((address_space(4))) Args* KArgsT;
__device__ __forceinline__ unsigned pk4_fp8(float a, float b, float c, float d) { int p = __builtin_amdgcn_cvt_pk_fp8_f32(clamp8(a), clamp8(b), 0, false); p = __builtin_amdgcn_cvt_pk_fp8_f32(clamp8(c), clamp8(d), p, true); return (unsigned)p; }
__device__ __forceinline__ void transpose_item8(const float* W, int K, int ldw, int ncols, const float* gain, float scale, unsigned char* WT, LAS float* scr, int item, int lane) {
    const int nblk = ncols / 32, kb = item / nblk, nb = item % nblk, k0 = 64 * kb, n0 = 32 * nb;
    const int kr = lane >> 3, nq = (lane & 7) * 4;
    f32x4 v[8];
#pragma unroll
    for (int i = 0; i < 8; ++i) { const float* p = W + (size_t)(k0 + 8 * i + kr) * ldw + n0 + nq; v[i] = (f32x4){p[0], p[1], p[2], p[3]}; }
#pragma unroll
    for (int i = 0; i < 8; ++i) { const int kk = 8 * i + kr; const float g = (gain ? gain[k0 + kk] : 1.0f) * scale; LAS float* d = scr + kk * 33 + nq; d[0] = v[i][0] * g; d[1] = v[i][1] * g; d[2] = v[i][2] * g; d[3] = v[i][3] * g; }
    LDS_WAIT(); asm volatile("" ::: "memory");
    const int c = lane & 7;
#pragma unroll
    for (int j = 0; j < 4; ++j) { const int n = (lane >> 3) + 8 * j; const LAS float* s = scr + (8 * c) * 33 + n;
        u32x2 o; o.x = pk4_fp8(s[0 * 33], s[1 * 33], s[2 * 33], s[3 * 33]); o.y = pk4_fp8(s[4 * 33], s[5 * 33], s[6 * 33], s[7 * 33]);
        *(u32x2*)(WT + (size_t)(n0 + n) * K + k0 + 8 * c) = o; }
    LDS_WAIT(); asm volatile("" ::: "memory");
}
__device__ __forceinline__ void conv_phase(KArgsT ka, int l, LAS unsigned char* lds, int wave0) {
    FRESH_TID(); FRESH_LDS(lds); FRESH_BID();
    unsigned char* ws = ka->ws;
    const float* ln1 = ka->in[1] + (size_t)l * D; const float* w_in = ka->in[2] + (size_t)l * D * PW; const float* w_out = ka->in[5] + (size_t)l * D * D;
    const float* ln2 = ka->in[6] + (size_t)l * D; const float* wq = ka->in[7] + (size_t)l * D * 2048;
    const float* k1 = ka->in[8] + (size_t)l * 8 * 128 * 128; const float* k2 = ka->in[9] + (size_t)l * 8 * 128 * 128;
    const float* pu = ka->in[10] + (size_t)l * NE * D; const float* pv = ka->in[11] + (size_t)l * NE * D;
    bf16_t* WQK = (bf16_t*)(ws + WS_WQK); bf16_t* WOUT = (bf16_t*)(ws + WS_WOUT); bf16_t* WIN = (bf16_t*)(ws + WS_WIN); bf16_t* U16 = (bf16_t*)(ws + WS_U16); bf16_t* V16 = (bf16_t*)(ws + WS_V16);
    {
        LAS float* Ks = (LAS float*)lds;
        LAS float* Ws = (LAS float*)(lds + 128 * 132 * 4);
        for (int it = bid; it < 1024; it += G) {
            const int gi = it >> 6, c0 = (it & 63) * 64;
            const float* key = ((gi & 1) ? k2 : k1) + (size_t)(gi >> 1) * 128 * 128;
            for (int i = tid; i < 4096; i += 512) { const int r = i >> 5, c4 = (i & 31) * 4; *(LAS f32x4*)(Ks + r * 132 + c4) = *(const f32x4*)(key + r * 128 + c4); }
            for (int i = tid; i < 2048; i += 512) { const int r = i >> 5, c4 = (i & 31) * 4; *(LAS f32x4*)(Ws + r * 132 + c4) = *(const f32x4*)(wq + (size_t)(c0 + r) * 2048 + gi * 128 + c4); }
            __syncthreads();
            const int tc = tid & 15, tn = tid >> 4;
            float acc[4][4];
#pragma unroll
            for (int i = 0; i < 4; ++i)
#pragma unroll
                for (int j = 0; j < 4; ++j) acc[i][j] = 0.f;
#pragma unroll 2
            for (int d = 0; d < 128; d += 4) {
                f32x4 kv[4], wv[4];
#pragma unroll
                for (int i = 0; i < 4; ++i) kv[i] = *(const LAS f32x4*)(Ks + (4 * tn + i) * 132 + d);
#pragma unroll
                for (int j = 0; j < 4; ++j) wv[j] = *(const LAS f32x4*)(Ws + (tc + 16 * j) * 132 + d);
#pragma unroll
                for (int i = 0; i < 4; ++i)
#pragma unroll
                    for (int j = 0; j < 4; ++j) acc[i][j] += kv[i][0] * wv[j][0] + kv[i][1] * wv[j][1] + kv[i][2] * wv[j][2] + kv[i][3] * wv[j][3];
            }
#pragma unroll
            for (int j = 0; j < 4; ++j) { const int c = c0 + tc + 16 * j; const float gg = ln2[c];
#pragma unroll
                for (int i = 0; i < 4; ++i) WQK[(size_t)(gi * 128 + 4 * tn + i) * D + c] = (bf16_t)f2bf(acc[i][j] * gg); }
            __syncthreads();
        }
        __syncthreads();
    }
    const int gw = bid * NWAVES + wave, NGW = G * NWAVES;
    {
        unsigned char* U8 = (unsigned char*)U16; unsigned char* V8 = U8 + (size_t)NE * D;
        for (int r = gw; r < NE; r += NGW) {
            const float* us = pu + (size_t)r * D; const float* vs = pv + (size_t)r * D;
#pragma unroll
            for (int i = 0; i < 4; ++i) { const int c = 1024 * i + 16 * lane;
                u32x4 ou, ov;
#pragma unroll
                for (int q = 0; q < 4; ++q) { const f32x4 u0 = *(const f32x4*)(us + c + 4 * q), g0 = *(const f32x4*)(ln2 + c + 4 * q), v0 = *(const f32x4*)(vs + c + 4 * q);
                    int pu_ = __builtin_amdgcn_cvt_pk_fp8_f32(clamp8(u0[0] * g0[0] * US), clamp8(u0[1] * g0[1] * US), 0, false); pu_ = __builtin_amdgcn_cvt_pk_fp8_f32(clamp8(u0[2] * g0[2] * US), clamp8(u0[3] * g0[3] * US), pu_, true);
                    int pv_ = __builtin_amdgcn_cvt_pk_fp8_f32(clamp8(v0[0] * VS), clamp8(v0[1] * VS), 0, false); pv_ = __builtin_amdgcn_cvt_pk_fp8_f32(clamp8(v0[2] * VS), clamp8(v0[3] * VS), pv_, true);
                    ou[q] = (unsigned)pu_; ov[q] = (unsigned)pv_; }
                *(u32x4*)(U8 + (size_t)r * D + c) = ou; *(u32x4*)(V8 + (size_t)r * D + c) = ov; }
        }
    }
    {
        LAS float* scr = (LAS float*)(lds + wave * 16384);
        constexpr int I_O = (D / 64) * (D / 32), I_IN = (D / 64) * (12288 / 32);
        for (int it = gw; it < I_O + I_IN; it += NGW) {
            if (it < I_O) transpose_item8(w_out, D, D, D, nullptr, US, (unsigned char*)WOUT, scr, it, lane);
            else transpose_item8(w_in, D, PW, 12288, ln1, US, (unsigned char*)WIN, scr, it - I_O, lane);
        }
    }
}

template <bool WITH_F>
__device__ __forceinline__ void prep_phase(const float* X, bf16_t* XB, float* RSTD, const float* w_in, const float* ln1, const float* bf, float* LOGF, LAS unsigned char* lds, int wave0) {
    FRESH_TID(); FRESH_LDS(lds); FRESH_BID();
    LAS unsigned short* gfs = (LAS unsigned short*)lds;
    if (WITH_F) {
        __syncthreads();
        for (int c = tid; c < D; c += 512) { const float g = ln1[c]; const float* wr = w_in + (size_t)c * PW + 12288;
#pragma unroll
            for (int j = 0; j < 10; ++j) gfs[j * D + c] = (unsigned short)f2bf(wr[j] * g); }
        __syncthreads();
    }
    const int gw = bid * NWAVES + wave, NGW = G * NWAVES;
    for (int m = gw; m < M; m += NGW) {
        const f32x4* xr = (const f32x4*)(X + (size_t)m * D) + lane;
        f32x4 v[16]; float ss = 0.f;
#pragma unroll
        for (int i = 0; i < 16; ++i) { v[i] = xr[64 * i]; ss += (v[i][0] * v[i][0] + v[i][1] * v[i][1]) + (v[i][2] * v[i][2] + v[i][3] * v[i][3]); }
        ss = wave_sum_dpp(ss);
        const float rstd = rsqrtf(ss * (1.0f / D) + 1e-6f);
        if (WITH_F) {
            unsigned* o8 = (unsigned*)((unsigned char*)XB + (size_t)m * D) + lane;
#pragma unroll
            for (int i = 0; i < 16; ++i) o8[64 * i] = pk4_fp8(v[i][0], v[i][1], v[i][2], v[i][3]);
        } else {
        u32x2* o = (u32x2*)(XB + (size_t)m * D) + lane;
#pragma unroll
        for (int i = 0; i < 16; ++i) { u32x2 w; w.x = pk2(v[i][0], v[i][1]); w.y = pk2(v[i][2], v[i][3]); o[64 * i] = w; }
        }
        if (lane == 0) RSTD[m] = rstd;
        if (WITH_F) {
            float mine = 0.f;
#pragma unroll 1
            for (int j = 0; j < 10; ++j) { float s = 0.f;
#pragma unroll
                for (int i = 0; i < 16; ++i) { const u32x2 gp = *(const LAS u32x2*)(gfs + j * D + 256 * i + 4 * lane);
                    s += (v[i][0] * bf_lo(gp.x) + v[i][1] * bf_hi(gp.x)) + (v[i][2] * bf_lo(gp.y) + v[i][3] * bf_hi(gp.y)); }
                s = wave_sum_dpp(s); if (lane == j) mine = s; }
            if (lane < 10) { const int b = m >> 11, s = m & 2047; LOGF[(size_t)(b * 10 + lane) * S + s] = logsig(mine * rstd + bf[lane]); }
        }
    }
}


#define RFL(x) __builtin_amdgcn_readfirstlane(x)
__device__ __forceinline__ void peer_u_phase(const float* SC, const unsigned char* U8, const float* X1, int* EIDG, float* WG, LAS unsigned char* lds, int wave0) {
    FRESH_TID(); FRESH_LDS(lds); FRESH_BID();
    LAS int* s_eid = (LAS int*)(lds + wave * 1024); LAS float* s_w = (LAS float*)(lds + wave * 1024 + 512);
    const int gw = bid * NWAVES + wave, NGW = G * NWAVES;
    const float NEG = -3.0e38f;
    for (int tok = gw; tok < M; tok += NGW) {
        const float* x1 = X1 + (size_t)tok * D;
        float xv[4][16]; float rstd_tok;
        { float ss_ = 0.f;
#pragma unroll
          for (int i = 0; i < 4; ++i)
#pragma unroll
              for (int q = 0; q < 4; ++q) { const f32x4 t = *(const f32x4*)(x1 + 1024 * i + 16 * lane + 4 * q); xv[i][4 * q] = t[0]; xv[i][4 * q + 1] = t[1]; xv[i][4 * q + 2] = t[2]; xv[i][4 * q + 3] = t[3];
                  ss_ += (t[0] * t[0] + t[1] * t[1]) + (t[2] * t[2] + t[3] * t[3]); }
          rstd_tok = rsqrtf(wave_sum_dpp(ss_) * (1.0f / D) + 1e-6f); }
        const float* sc = SC + (size_t)tok * 2048;
        for (int h = 0; h < 8; ++h) {
            const float a0 = sc[h * 256 + lane], a1 = sc[h * 256 + 64 + lane], c0 = sc[h * 256 + 128 + lane], c1 = sc[h * 256 + 192 + lane];
            unsigned ka0 = (ordkey(a0) & ~127u) | (unsigned)(127 - lane), ka1 = (ordkey(a1) & ~127u) | (unsigned)(63 - lane);
            unsigned kc0 = (ordkey(c0) & ~127u) | (unsigned)(127 - lane), kc1 = (ordkey(c1) & ~127u) | (unsigned)(63 - lane);
            float v1 = 0.f, v2 = 0.f; int i1 = 0, i2 = 0;
            for (int it = 0; it < 16; ++it) {
                const unsigned m1 = wave_max_u32(max(ka0, ka1)), m2 = wave_max_u32(max(kc0, kc1));
                const int n1 = 127 - (int)(m1 & 127u), n2 = 127 - (int)(m2 & 127u);
                const float x1lo = __builtin_bit_cast(float, __builtin_amdgcn_readlane(__builtin_bit_cast(int, a0), n1 & 63)), x1hi = __builtin_bit_cast(float, __builtin_amdgcn_readlane(__builtin_bit_cast(int, a1), n1 & 63));
                const float x2lo = __builtin_bit_cast(float, __builtin_amdgcn_readlane(__builtin_bit_cast(int, c0), n2 & 63)), x2hi = __builtin_bit_cast(float, __builtin_amdgcn_readlane(__builtin_bit_cast(int, c1), n2 & 63));
                ka0 = ka0 == m1 ? 0u : ka0; ka1 = ka1 == m1 ? 0u : ka1; kc0 = kc0 == m2 ? 0u : kc0; kc1 = kc1 == m2 ? 0u : kc1;
                if (lane == it) { v1 = (n1 & 64) ? x1hi : x1lo; i1 = n1; v2 = (n2 & 64) ? x2hi : x2lo; i2 = n2; }
            }
            unsigned kd0, kd1, kd2, kd3;
            { const float va = lane_read(v1, lane >> 2); const int pb_ = 255 - 4 * lane;
              kd0 = (ordkey(va + lane_read(v2, (lane & 3) * 4 + 0)) & ~255u) | (unsigned)(pb_); kd1 = (ordkey(va + lane_read(v2, (lane & 3) * 4 + 1)) & ~255u) | (unsigned)(pb_ - 1);
              kd2 = (ordkey(va + lane_read(v2, (lane & 3) * 4 + 2)) & ~255u) | (unsigned)(pb_ - 2); kd3 = (ordkey(va + lane_read(v2, (lane & 3) * 4 + 3)) & ~255u) | (unsigned)(pb_ - 3); }
            float best = 0.f; int be = 0;
            for (int it = 0; it < 16; ++it) {
                const unsigned m = wave_max_u32(max(max(kd0, kd1), max(kd2, kd3)));
                const int pos = 255 - (int)(m & 255u);
                const float bv = __builtin_bit_cast(float, __builtin_amdgcn_readlane(__builtin_bit_cast(int, v1), pos >> 4)) + __builtin_bit_cast(float, __builtin_amdgcn_readlane(__builtin_bit_cast(int, v2), pos & 15));
                const int e = (__builtin_amdgcn_readlane(i1, pos >> 4) << 7) | __builtin_amdgcn_readlane(i2, pos & 15);
                kd0 = kd0 == m ? 0u : kd0; kd1 = kd1 == m ? 0u : kd1; kd2 = kd2 == m ? 0u : kd2; kd3 = kd3 == m ? 0u : kd3;
                if (lane == it) { best = bv; be = e; }
            }
            const float mx = __builtin_bit_cast(float, __builtin_amdgcn_readlane(__builtin_bit_cast(int, best), 0));
            const float p = lane < 16 ? __builtin_amdgcn_exp2f((best - mx) * (1.4426950408889634f * rstd_tok)) : 0.f;
            const float sm = wave_sum_dpp(p);
            if (lane < 16) { s_eid[h * 16 + lane] = be; s_w[h * 16 + lane] = p / sm; }
        }
        LDS_WAIT(); asm volatile("" ::: "memory");
#define LOADROW8(dst, base, e) do { const u32x4* p_ = (const u32x4*)((base) + (size_t)(e) * D) + lane; _Pragma("unroll") for (int i_ = 0; i_ < 4; ++i_) dst[i_] = p_[64 * i_]; } while (0)
        {
            const float rstd = rstd_tok * US_INV;
#define UDOT8(row, j) do { float da_ = 0.f, db_ = 0.f; _Pragma("unroll") for (int i_ = 0; i_ < 4; ++i_) { _Pragma("unroll") for (int k_ = 0; k_ < 4; ++k_) { \
                unsigned w0_ = row[i_][k_]; asm volatile("" : "+v"(w0_));     \
                const f32x2 lo_ = __builtin_amdgcn_cvt_pk_f32_fp8((int)w0_, false), hi_ = __builtin_amdgcn_cvt_pk_f32_fp8((int)w0_, true); \
                da_ = fmaf(xv[i_][4 * k_], lo_[0], da_); db_ = fmaf(xv[i_][4 * k_ + 1], lo_[1], db_); da_ = fmaf(xv[i_][4 * k_ + 2], hi_[0], da_); db_ = fmaf(xv[i_][4 * k_ + 3], hi_[1], db_); } \
                asm volatile("" : "+v"(da_), "+v"(db_)); } \
            const float d_ = wave_sum_dpp(da_ + db_) * rstd; const float ge_ = gelu_erf(d_); if (lane == 0) s_w[j] *= ge_; } while (0)
            u32x4 r0[4], r1[4], r2[4];
            { const int e_ = RFL(s_eid[0]); LOADROW8(r0, U8, e_); } { const int e_ = RFL(s_eid[1]); LOADROW8(r1, U8, e_); } { const int e_ = RFL(s_eid[2]); LOADROW8(r2, U8, e_); }
            for (int j = 0; j < 126; j += 3) {
                UDOT8(r0, j);     if (j + 3 < 128) { const int e_ = RFL(s_eid[j + 3]); LOADROW8(r0, U8, e_); }
                UDOT8(r1, j + 1); if (j + 4 < 128) { const int e_ = RFL(s_eid[j + 4]); LOADROW8(r1, U8, e_); }
                UDOT8(r2, j + 2); if (j + 5 < 128) { const int e_ = RFL(s_eid[j + 5]); LOADROW8(r2, U8, e_); }
            }
            UDOT8(r0, 126); UDOT8(r1, 127);
#undef UDOT8
        }
        LDS_WAIT(); asm volatile("" ::: "memory");
        EIDG[(size_t)tok * 128 + lane] = s_eid[lane]; EIDG[(size_t)tok * 128 + 64 + lane] = s_eid[64 + lane];
        WG[(size_t)tok * 128 + lane] = s_w[lane]; WG[(size_t)tok * 128 + 64 + lane] = s_w[64 + lane];
        LDS_WAIT(); asm volatile("" ::: "memory");
    }
#undef LOADROW8
}

template <bool FINAL>
__device__ __forceinline__ void peer_v_phase(const int* EIDG, const float* WG, const unsigned char* V8, const float* X1, float* XO, const float* fg,
                                             unsigned char* XB8n, float* RSTDn, float* LOGFn, const float* w_in_n, const float* ln1_n, const float* bf_n, LAS unsigned char* lds, int wave0) {
    FRESH_TID(); FRESH_LDS(lds); FRESH_BID();
    LAS int* s_eid = (LAS int*)(lds + 81920 + wave * 1024); LAS float* s_w = (LAS float*)(lds + 81920 + wave * 1024 + 512);
    LAS unsigned short* gfs = (LAS unsigned short*)lds;
    if (!FINAL) {
        __syncthreads();
        for (int c = tid; c < D; c += 512) { const float g = ln1_n[c]; const float* wr = w_in_n + (size_t)c * PW + 12288;
#pragma unroll
            for (int j = 0; j < 10; ++j) gfs[j * D + c] = (unsigned short)f2bf(wr[j] * g); }
        __syncthreads();
    }
    const int gw = bid * NWAVES + wave, NGW = G * NWAVES;
    for (int tok = gw; tok < M; tok += NGW) {
        s_eid[lane] = EIDG[(size_t)tok * 128 + lane]; s_eid[64 + lane] = EIDG[(size_t)tok * 128 + 64 + lane];
        s_w[lane] = WG[(size_t)tok * 128 + lane]; s_w[64 + lane] = WG[(size_t)tok * 128 + 64 + lane];
        LDS_WAIT(); asm volatile("" ::: "memory");
#define LOADROW8(dst, base, e) do { const u32x4* p_ = (const u32x4*)((base) + (size_t)(e) * D) + lane; _Pragma("unroll") for (int i_ = 0; i_ < 4; ++i_) dst[i_] = p_[64 * i_]; } while (0)
        const float* x1 = X1 + (size_t)tok * D; float* xo = XO + (size_t)tok * D;
        {
            float acc[4][16];
#pragma unroll
            for (int i = 0; i < 4; ++i)
#pragma unroll
                for (int k = 0; k < 16; ++k) acc[i][k] = 0.f;
#define VACC8(row, j) do { const float w_ = s_w[j]; _Pragma("unroll") for (int i_ = 0; i_ < 4; ++i_) { _Pragma("unroll") for (int k_ = 0; k_ < 4; ++k_) { \
                unsigned w0_ = row[i_][k_]; asm volatile("" : "+v"(w0_)); \
                const f32x2 lo_ = __builtin_amdgcn_cvt_pk_f32_fp8((int)w0_, false), hi_ = __builtin_amdgcn_cvt_pk_f32_fp8((int)w0_, true); \
                acc[i_][4 * k_] = fmaf(w_, lo_[0], acc[i_][4 * k_]); acc[i_][4 * k_ + 1] = fmaf(w_, lo_[1], acc[i_][4 * k_ + 1]); acc[i_][4 * k_ + 2] = fmaf(w_, hi_[0], acc[i_][4 * k_ + 2]); acc[i_][4 * k_ + 3] = fmaf(w_, hi_[1], acc[i_][4 * k_ + 3]); } \
                asm volatile("" : "+v"(acc[i_][0]), "+v"(acc[i_][1]), "+v"(acc[i_][2]), "+v"(acc[i_][3]), "+v"(acc[i_][4]), "+v"(acc[i_][5]), "+v"(acc[i_][6]), "+v"(acc[i_][7]), \
                                  "+v"(acc[i_][8]), "+v"(acc[i_][9]), "+v"(acc[i_][10]), "+v"(acc[i_][11]), "+v"(acc[i_][12]), "+v"(acc[i_][13]), "+v"(acc[i_][14]), "+v"(acc[i_][15])); } } while (0)
            u32x4 r0[4], r1[4], r2[4];
            { const int e_ = RFL(s_eid[0]); LOADROW8(r0, V8, e_); } { const int e_ = RFL(s_eid[1]); LOADROW8(r1, V8, e_); } { const int e_ = RFL(s_eid[2]); LOADROW8(r2, V8, e_); }
            for (int j = 0; j < 126; j += 3) {
                VACC8(r0, j);     if (j + 3 < 128) { const int e_ = RFL(s_eid[j + 3]); LOADROW8(r0, V8, e_); }
                VACC8(r1, j + 1); if (j + 4 < 128) { const int e_ = RFL(s_eid[j + 4]); LOADROW8(r1, V8, e_); }
                VACC8(r2, j + 2); if (j + 5 < 128) { const int e_ = RFL(s_eid[j + 5]); LOADROW8(r2, V8, e_); }
            }
            VACC8(r0, 126); VACC8(r1, 127);
#undef VACC8
#undef LOADROW8
            float ss = 0.f;
#pragma unroll
            for (int i = 0; i < 4; ++i)
#pragma unroll
                for (int q = 0; q < 4; ++q) { const f32x4 t = *(const f32x4*)(x1 + 1024 * i + 16 * lane + 4 * q);
#pragma unroll
                    for (int k = 0; k < 4; ++k) { acc[i][4 * q + k] = fmaf(acc[i][4 * q + k], VS_INV, t[k]); ss += acc[i][4 * q + k] * acc[i][4 * q + k]; } }
            ss = wave_sum_dpp(ss);
            const float rs = rsqrtf(ss * (1.0f / D) + 1e-6f);
            if (!FINAL) {
#pragma unroll
                for (int i = 0; i < 4; ++i) { u32x4 w8;
#pragma unroll
                    for (int q = 0; q < 4; ++q) w8[q] = pk4_fp8(acc[i][4 * q], acc[i][4 * q + 1], acc[i][4 * q + 2], acc[i][4 * q + 3]);
                    *(u32x4*)(XB8n + (size_t)tok * D + 1024 * i + 16 * lane) = w8; }
                if (lane == 0) RSTDn[tok] = rs;
                float mine = 0.f;
#pragma unroll 1
                for (int j = 0; j < 10; ++j) { float s = 0.f;
#pragma unroll
                    for (int i = 0; i < 4; ++i) { const u32x4 g0 = *(const LAS u32x4*)(gfs + j * D + 1024 * i + 16 * lane), g1 = *(const LAS u32x4*)(gfs + j * D + 1024 * i + 16 * lane + 8);
#pragma unroll
                        for (int q = 0; q < 4; ++q) { s += acc[i][2 * q] * bf_lo(g0[q]) + acc[i][2 * q + 1] * bf_hi(g0[q]); s += acc[i][8 + 2 * q] * bf_lo(g1[q]) + acc[i][8 + 2 * q + 1] * bf_hi(g1[q]); } }
                    s = wave_sum_dpp(s); if (lane == j) mine = s; }
                if (lane < 10) { const int b_ = tok >> 11, s_ = tok & 2047; LOGFn[(size_t)(b_ * 10 + lane) * S + s_] = logsig(mine * rs + bf_n[lane]); }
            }
#pragma unroll
            for (int i = 0; i < 4; ++i)
#pragma unroll
                for (int q = 0; q < 4; ++q) { const int c = 1024 * i + 16 * lane + 4 * q; f32x4 o_;
                    if (FINAL) { const f32x4 g_ = *(const f32x4*)(fg + c); o_ = (f32x4){acc[i][4 * q] * rs * g_[0], acc[i][4 * q + 1] * rs * g_[1], acc[i][4 * q + 2] * rs * g_[2], acc[i][4 * q + 3] * rs * g_[3]}; }
                    else o_ = (f32x4){acc[i][4 * q], acc[i][4 * q + 1], acc[i][4 * q + 2], acc[i][4 * q + 3]};
                    *(f32x4*)(xo + c) = o_; }
        }
        LDS_WAIT(); asm volatile("" ::: "memory");
    }
}
}
namespace at {
using namespace mk;
constexpr int QB = 256, KVB = 64, HD = 128;
constexpr int SHM_V = KVB * HD * 2, SHM_K = KVB * HD * 2;
constexpr int OFF_V = 0, OFF_K = 2 * SHM_V, OFF_WS = OFF_K + 2 * SHM_K, OFF_CUM = OFF_WS + 8 * 256, OFF_RT = OFF_CUM + 2048 * 4, OFF_MISC = OFF_RT + 640 * 4;
constexpr float LOG2E = 1.4426950408889634f;
constexpr float THR2 = 10.0f;
constexpr float SB_DONE = -100.0f;

#define AT_KSWZ(row, colB) ((row) * 256 + ((colB) ^ (((row) & 7) << 4)))
__device__ __forceinline__ int v_st(int k, int c) { const int kk = (k & ~0xC) | ((k & 4) << 1) | ((k & 8) >> 1); return ((kk >> 3) * 4 + (c >> 5)) * 512 + ((kk & 7) * 32 + (c & 31)) * 2; }
__device__ __forceinline__ int v_rd_base(int lane) { return ((lane & 3) << 3) | (((lane >> 2) & 3) << 6) | (((lane >> 4) & 1) << 5) | (((lane >> 5) & 1) << 8); }
constexpr int v_rd_off(int d0, int ks, int half) { return d0 * 512 + ks * 4096 + half * 2048; }
__device__ __forceinline__ int crow(int r, int hi) { return (r & 3) + 8 * (r >> 2) + 4 * hi; }
__device__ __forceinline__ unsigned cvtpk(float lo, float hi) { unsigned r; asm volatile("v_cvt_pk_bf16_f32 %0, %1, %2" : "=v"(r) : "v"(lo), "v"(hi)); return r; }
__device__ __forceinline__ float partner(float v, int hi) { auto rr = __builtin_amdgcn_permlane32_swap(__builtin_bit_cast(unsigned, v), __builtin_bit_cast(unsigned, v), false, false); return __builtin_bit_cast(float, hi ? rr[0] : rr[1]); }

__device__ __forceinline__ float xchg_max(float v, int hi) { return fmaxf(v, partner(v, hi)); }
__device__ __forceinline__ float xchg_sum(float v, int hi) { return v + partner(v, hi); }

__device__ __forceinline__ void pack_p(const f32x16& p0, const f32x16& p1, bf16x8& pa0, bf16x8& pa1, bf16x8& pa2, bf16x8& pa3) {
#define AT_PK4(P, B_, OUT) do { unsigned a0 = cvtpk(P[B_ + 0], P[B_ + 1]), a1 = cvtpk(P[B_ + 2], P[B_ + 3]); unsigned b0 = cvtpk(P[B_ + 4], P[B_ + 5]), b1 = cvtpk(P[B_ + 6], P[B_ + 7]); \
        auto r0 = __builtin_amdgcn_permlane32_swap(a0, b0, false, false); auto r1 = __builtin_amdgcn_permlane32_swap(a1, b1, false, false); \
        u32x4 w = {r0[0], r1[0], r0[1], r1[1]}; OUT = __builtin_bit_cast(bf16x8, w); } while (0)
    AT_PK4(p0, 0, pa0); AT_PK4(p0, 8, pa1); AT_PK4(p1, 0, pa2); AT_PK4(p1, 8, pa3);
#undef AT_PK4
}
template <int KBUF>
__device__ __forceinline__ void qkt(f32x16& p0, f32x16& p1, LAS unsigned char* K_lds, int r32, int hi, const bf16x8 (&qr)[8]) {
    p0 = f32x16{}; p1 = f32x16{};
    LAS unsigned char* kb[4];
#pragma unroll
    for (int dd = 0; dd < 4; ++dd) kb[dd] = K_lds + KBUF * SHM_K + AT_KSWZ(r32, (dd * 16 + hi * 8) * 2);
#pragma unroll
    for (int d0 = 0; d0 < 8; ++d0) { LAS unsigned char* a = kb[d0 & 3] + (d0 >> 2) * 128;
        const bf16x8 b0 = *(const LAS bf16x8*)a; const bf16x8 b1 = *(const LAS bf16x8*)(a + 32 * 256);
        p0 = __builtin_amdgcn_mfma_f32_32x32x16_bf16(b0, qr[d0], p0, 0, 0, 0);
        p1 = __builtin_amdgcn_mfma_f32_32x32x16_bf16(b1, qr[d0], p1, 0, 0, 0); }
}
template <int VBUF>
__device__ __forceinline__ void pv_tile(f32x16 (&o)[4], int vb0, bf16x8 pa0, bf16x8 pa1, bf16x8 pa2, bf16x8 pa3) {
#define AT_TRRD(dst, off) asm volatile("ds_read_b64_tr_b16 %0, %1 offset:%2" : "=&v"(dst) : "v"(vb0), "i"(off) : "memory")
#define AT_PV_D0(d0) do { s16x4 l0, l1, l2, l3, h0, h1, h2, h3; constexpr int b_ = VBUF * SHM_V + v_rd_off(d0, 0, 0); \
        AT_TRRD(l0, b_); AT_TRRD(h0, b_ + 2048); AT_TRRD(l1, b_ + 4096); AT_TRRD(h1, b_ + 6144); AT_TRRD(l2, b_ + 8192); AT_TRRD(h2, b_ + 10240); AT_TRRD(l3, b_ + 12288); AT_TRRD(h3, b_ + 14336); \
        asm volatile("s_waitcnt lgkmcnt(0)" ::: "memory"); __builtin_amdgcn_sched_barrier(0); \
        o[d0] = __builtin_amdgcn_mfma_f32_32x32x16_bf16(pa0, (bf16x8){l0[0], l0[1], l0[2], l0[3], h0[0], h0[1], h0[2], h0[3]}, o[d0], 0, 0, 0); \
        o[d0] = __builtin_amdgcn_mfma_f32_32x32x16_bf16(pa1, (bf16x8){l1[0], l1[1], l1[2], l1[3], h1[0], h1[1], h1[2], h1[3]}, o[d0], 0, 0, 0); \
        o[d0] = __builtin_amdgcn_mfma_f32_32x32x16_bf16(pa2, (bf16x8){l2[0], l2[1], l2[2], l2[3], h2[0], h2[1], h2[2], h2[3]}, o[d0], 0, 0, 0); \
        o[d0] = __builtin_amdgcn_mfma_f32_32x32x16_bf16(pa3, (bf16x8){l3[0], l3[1], l3[2], l3[3], h3[0], h3[1], h3[2], h3[3]}, o[d0], 0, 0, 0); } while (0)
    AT_PV_D0(0); AT_PV_D0(1); AT_PV_D0(2); AT_PV_D0(3);
#undef AT_PV_D0
#undef AT_TRRD
}

template <int VAR>
__device__ __forceinline__ void attn_item(const bf16_t* Qh, const bf16_t* Kh, const bf16_t* Vh, bf16_t* OB, const float* relb, const float* LOGF, int b, int h, int qb, LAS unsigned char* lds, int tid) {
    const int wid = __builtin_amdgcn_readfirstlane(tid >> 6), lane = tid & 63, r32 = lane & 31, hi = lane >> 5;
    const int g = VAR == 0 ? h : (VAR == 1 ? 12 + h : 22 + h);
    const size_t hb = (size_t)(b * NH + g) * S * HD;
    const bf16_t* Kp = Kh + hb; const bf16_t* Vp = Vh + hb;
    LAS unsigned char* V_lds = lds + OFF_V; LAS unsigned char* K_lds = lds + OFF_K;
    LAS float* wsf = (LAS float*)(lds + OFF_WS) + wid * 64; LAS float* li_l = wsf; LAS float* al_l = wsf + 32;
    LAS float* cumL = (LAS float*)(lds + OFF_CUM); LAS float* Rt = (LAS float*)(lds + OFF_RT); volatile LAS unsigned* flags = (volatile LAS unsigned*)(lds + OFF_MISC);
    const int P0 = qb * QB, qlo = P0 + wid * 32, qpos = qlo + r32;
    int NT, jlo = 0;
    if (VAR == 0) { jlo = 4 * qb - 8; if (jlo < 0) jlo = 0; NT = 4 * qb + 4 - jlo; } else NT = 4 * qb + 4;
    const int cw = 4 * qb + (wid >> 1);
#define AT_KBASE(t) (VAR == 1 ? (4 * qb + 3 - (t)) * KVB : (jlo + (t)) * KVB)
#define AT_ACT(t) (VAR == 0 ? ((jlo + (t)) >= cw - 8 && (jlo + (t)) <= cw) : (VAR == 1 ? (AT_KBASE(t) <= qlo + 30) : (AT_KBASE(t) <= qlo + 31)))
    if (VAR == 0) {
        const float* tab = relb + h * 257;
        for (int j = tid; j < 639; j += 512) { int rel = 575 - j; rel = rel < -128 ? -128 : (rel > 128 ? 128 : rel); Rt[j] = tab[rel + 128] * LOG2E; }
    }
    if (VAR == 2) {
        const float* lf = LOGF + (size_t)(b * 10 + h) * S; const int kend = P0 + QB;
        f32x4 v = (f32x4){0.f, 0.f, 0.f, 0.f};
        if (4 * tid < kend) v = *(const f32x4*)(lf + 4 * tid);
        v[1] += v[0]; v[2] += v[1]; v[3] += v[2];
        float tot = v[3];
#pragma unroll
        for (int o = 1; o < 64; o <<= 1) { const float t_ = lane_read(tot, lane >= o ? lane - o : lane); if (lane >= o) tot += t_; }
        if (lane == 63) li_l[0] = tot;
        __syncthreads();
        float base = tot - v[3];
        for (int w = 0; w < wid; ++w) base += ((LAS float*)(lds + OFF_WS))[w * 64];
        if (4 * tid < kend) *(LAS f32x4*)(cumL + 4 * tid) = (f32x4){(base + v[0]) * LOG2E, (base + v[1]) * LOG2E, (base + v[2]) * LOG2E, (base + v[3]) * LOG2E};
    }
    bf16x8 qr[8];
    { const bf16_t* qp = Qh + hb + (size_t)(qlo + r32) * HD + hi * 8;
#pragma unroll
      for (int d0 = 0; d0 < 8; ++d0) qr[d0] = *(const bf16x8*)(qp + d0 * 16); }
    const int sr = tid >> 4, sc = (tid & 15) * 8, vst0 = v_st(sr, sc), vst1 = v_st(32 + sr, sc), kws = AT_KSWZ(sr, sc * 2);
    const int vb0 = (int)(unsigned)(size_t)V_lds + v_rd_base(lane);
    bf16x8 st_k0, st_k1, st_v0, st_v1;
#define AT_SLOAD(k0) do { const bf16_t* kp_ = Kp + (size_t)((k0) + sr) * HD + sc; const bf16_t* vp_ = Vp + (size_t)((k0) + sr) * HD + sc; \
        st_k0 = *(const bf16x8*)kp_; st_k1 = *(const bf16x8*)(kp_ + 32 * HD); st_v0 = *(const bf16x8*)vp_; st_v1 = *(const bf16x8*)(vp_ + 32 * HD); } while (0)
#define AT_SWRITE(bf) do { *(LAS bf16x8*)(K_lds + (bf) * SHM_K + kws) = st_k0; *(LAS bf16x8*)(K_lds + (bf) * SHM_K + kws + 32 * 256) = st_k1; \
        *(LAS bf16x8*)(V_lds + (bf) * SHM_V + vst0) = st_v0; *(LAS bf16x8*)(V_lds + (bf) * SHM_V + vst1) = st_v1; } while (0)
    AT_SLOAD(AT_KBASE(0)); asm volatile("s_waitcnt vmcnt(0)" ::: "memory"); AT_SWRITE(0);
    __syncthreads();
    float m_reg = -1e30f, l_reg = 0.f, carry = 0.f;
    f32x16 o[4] = {};
#define AT_STEP(BUF, t) do { \
        const bool more_ = (t) + 1 < NT; \
        if (more_) AT_SLOAD(AT_KBASE((t) + 1)); \
        if (AT_ACT(t)) { \
            const int kb_ = AT_KBASE(t); f32x16 p0, p1; bf16x8 pa0, pa1, pa2, pa3; \
            qkt<BUF>(p0, p1, K_lds, r32, hi, qr); \
            tile_math(p0, p1, kb_, pa0, pa1, pa2, pa3); \
            pv_tile<BUF>(o, vb0, pa0, pa1, pa2, pa3); \
        } \
        if (more_) { asm volatile("s_waitcnt vmcnt(0)" ::: "memory"); AT_SWRITE((BUF) ^ 1); } \
        if (VAR == 1) { const bool done_ = __all(carry < SB_DONE); if (lane == 0) flags[((t) & 1) * 8 + wid] = done_ ? 1u : 0u; } \
        __syncthreads(); \
    } while (0)
    auto tile_math = [&](f32x16& p0, f32x16& p1, int kb, bf16x8& pa0, bf16x8& pa1, bf16x8& pa2, bf16x8& pa3) __attribute__((always_inline)) {
        const int dq = qpos - kb - 4 * hi;
        if (VAR == 1) {
            const bool need_mask = kb + 63 >= qlo;
            f32x16 n0, n1;
#pragma unroll
            for (int r = 0; r < 16; ++r) { const float z = p0[r]; const float lp = __builtin_amdgcn_logf(1.0f + __builtin_amdgcn_exp2f(-fabsf(z))); n0[r] = fminf(-z, 0.f) - lp;
                                           const float y = p1[r]; const float lq = __builtin_amdgcn_logf(1.0f + __builtin_amdgcn_exp2f(-fabsf(y))); n1[r] = fminf(-y, 0.f) - lq; }
            if (need_mask) {
#pragma unroll
                for (int r = 0; r < 16; ++r) { const int c = (r & 3) + 8 * (r >> 2);
                    if (dq - c <= 0) { n0[r] = 0.f; p0[r] = -__builtin_inff(); }
                    if (dq - c - 32 <= 0) { n1[r] = 0.f; p1[r] = -__builtin_inff(); } }
            }
            float A[8], Bp[8];
#pragma unroll
            for (int q = 0; q < 4; ++q) { A[q] = (n0[4 * q] + n0[4 * q + 1]) + (n0[4 * q + 2] + n0[4 * q + 3]); A[4 + q] = (n1[4 * q] + n1[4 * q + 1]) + (n1[4 * q + 2] + n1[4 * q + 3]); }
#pragma unroll
            for (int q = 0; q < 8; ++q) Bp[q] = partner(A[q], hi);
            float st = 0.f;
#pragma unroll
            for (int q = 7; q >= 0; --q) {
                const float after = carry + st + (hi == 0 ? Bp[q] : 0.f);
                if (q >= 4) { const int r0 = 4 * (q - 4);
                    float tl = after; p1[r0 + 3] = __builtin_amdgcn_exp2f(p1[r0 + 3] + n1[r0 + 3] + tl); tl += n1[r0 + 3]; p1[r0 + 2] = __builtin_amdgcn_exp2f(p1[r0 + 2] + n1[r0 + 2] + tl); tl += n1[r0 + 2];
                    p1[r0 + 1] = __builtin_amdgcn_exp2f(p1[r0 + 1] + n1[r0 + 1] + tl); tl += n1[r0 + 1]; p1[r0] = __builtin_amdgcn_exp2f(p1[r0] + n1[r0] + tl); }
                else { const int r0 = 4 * q;
                    float tl = after; p0[r0 + 3] = __builtin_amdgcn_exp2f(p0[r0 + 3] + n0[r0 + 3] + tl); tl += n0[r0 + 3]; p0[r0 + 2] = __builtin_amdgcn_exp2f(p0[r0 + 2] + n0[r0 + 2] + tl); tl += n0[r0 + 2];
                    p0[r0 + 1] = __builtin_amdgcn_exp2f(p0[r0 + 1] + n0[r0 + 1] + tl); tl += n0[r0 + 1]; p0[r0] = __builtin_amdgcn_exp2f(p0[r0] + n0[r0] + tl); }
                st += A[q] + Bp[q];
            }
            carry += st;
            pack_p(p0, p1, pa0, pa1, pa2, pa3);
        } else {
            if (VAR == 0) {
                const LAS float* rp = Rt + (575 - (qpos - kb) + 4 * hi);
#pragma unroll
                for (int r = 0; r < 16; ++r) { const int c = (r & 3) + 8 * (r >> 2); p0[r] += rp[c]; p1[r] += rp[c + 32]; }
            } else {
                const LAS float* cp = cumL + kb + 4 * hi;
#pragma unroll
                for (int q = 0; q < 4; ++q) { const f32x4 c0 = *(const LAS f32x4*)(cp + 8 * q), c1 = *(const LAS f32x4*)(cp + 32 + 8 * q);
                    p0[4 * q] -= c0[0]; p0[4 * q + 1] -= c0[1]; p0[4 * q + 2] -= c0[2]; p0[4 * q + 3] -= c0[3];
                    p1[4 * q] -= c1[0]; p1[4 * q + 1] -= c1[1]; p1[4 * q + 2] -= c1[2]; p1[4 * q + 3] -= c1[3]; }
                if (kb + 63 > qlo) {
#pragma unroll
                    for (int r = 0; r < 16; ++r) { const int c = (r & 3) + 8 * (r >> 2);
                        if (dq - c < 0) p0[r] = -__builtin_inff();
                        if (dq - c - 32 < 0) p1[r] = -__builtin_inff(); }
                }
            }
            float pmax = p0[0];
#pragma unroll
            for (int r = 1; r < 16; ++r) pmax = fmaxf(pmax, p0[r]);
#pragma unroll
            for (int r = 0; r < 16; ++r) pmax = fmaxf(pmax, p1[r]);
            pmax = xchg_max(pmax, hi);
            float mn, alpha;
            if (__all(pmax - m_reg <= THR2)) { mn = m_reg; alpha = 1.f; }
            else { mn = fmaxf(m_reg, pmax); alpha = __builtin_amdgcn_exp2f(m_reg - mn); m_reg = mn; }
            float ps = 0.f;
#pragma unroll
            for (int r = 0; r < 16; ++r) { p0[r] = __builtin_amdgcn_exp2f(p0[r] - mn); p1[r] = __builtin_amdgcn_exp2f(p1[r] - mn); ps += p0[r] + p1[r]; }
            ps = xchg_sum(ps, hi);
            l_reg = l_reg * alpha + ps;
            if (__any(alpha < 1.f)) {
                if (hi == 0) al_l[r32] = alpha;
                asm volatile("s_waitcnt lgkmcnt(0)" ::: "memory");
                float av[16];
#pragma unroll
                for (int r = 0; r < 16; ++r) av[r] = al_l[crow(r, hi)];
#pragma unroll
                for (int d = 0; d < 4; ++d)
#pragma unroll
                    for (int r = 0; r < 16; ++r) o[d][r] *= av[r];
            }
            pack_p(p0, p1, pa0, pa1, pa2, pa3);
        }
    };
    for (int t = 0; t < NT; t += 2) {
        AT_STEP(0, t);
        if (VAR == 1) { unsigned all_ = 1u; for (int w = 0; w < 8; ++w) all_ &= flags[(t & 1) * 8 + w]; if (all_) break; }
        if (t + 1 >= NT) break;
        AT_STEP(1, t + 1);
        if (VAR == 1) { unsigned all_ = 1u; for (int w = 0; w < 8; ++w) all_ &= flags[((t + 1) & 1) * 8 + w]; if (all_) break; }
    }
    float rli[16];
    if (VAR != 1) {
        if (hi == 0) li_l[r32] = l_reg;
        asm volatile("s_waitcnt lgkmcnt(0)" ::: "memory");
#pragma unroll
        for (int r = 0; r < 16; ++r) rli[r] = __builtin_amdgcn_rcpf(li_l[crow(r, hi)]);
    }
    unsigned char* Ow8 = (unsigned char*)OB + (size_t)(b * S + qlo) * D + g * HD;
#pragma unroll
    for (int r = 0; r < 16; ++r) { const int orow = crow(r, hi);
#pragma unroll
        for (int d0 = 0; d0 < 4; ++d0) { const float v = VAR != 1 ? o[d0][r] * rli[r] : o[d0][r];
            const float vn = lane_read(v, lane ^ 1);
            if ((r32 & 1) == 0) *(unsigned short*)(Ow8 + (size_t)orow * D + d0 * 32 + r32) = (unsigned short)__builtin_amdgcn_cvt_pk_fp8_f32(clamp8(v * 16.0f), clamp8(vn * 16.0f), 0, false); } }
    __syncthreads();
#undef AT_STEP
#undef AT_SLOAD
#undef AT_SWRITE
#undef AT_KBASE
#undef AT_ACT
}

template <int VAR>
__device__ __forceinline__ void attn_queue(const bf16_t* Qh, const bf16_t* Kh, const bf16_t* Vh, bf16_t* OB, const float* relb, const float* LOGF, unsigned* qhead, LAS unsigned char* lds, int wave0) {
    FRESH_TID(); FRESH_LDS(lds);
    volatile LAS unsigned* qslot = (volatile LAS unsigned*)(lds + OFF_MISC) + 32;
    constexpr int NHV = VAR == 0 ? 12 : 10, NITEMS = 8 * NHV * 8;
    for (;;) {
        if (tid == 0) qslot[0] = __hip_atomic_fetch_add(qhead, 1u, __ATOMIC_RELAXED, __HIP_MEMORY_SCOPE_AGENT);
        __syncthreads();
        const int idx = (int)qslot[0];
        __syncthreads();
        if (idx >= NITEMS) break;
        const int qb = 7 - idx / (8 * NHV), bh = idx % (8 * NHV);
        attn_item<VAR>(Qh, Kh, Vh, OB, relb, LOGF, bh / NHV, bh % NHV, qb, lds, tid);
    }
}
__device__ __forceinline__ void attn_phase(const bf16_t* Qh, const bf16_t* Kh, const bf16_t* Vh, bf16_t* OB, const float* relb, const float* LOGF, unsigned* qheads, LAS unsigned char* lds, int wave0) {
    attn_queue<2>(Qh, Kh, Vh, OB, relb, LOGF, qheads + 0, lds, wave0);
    attn_queue<0>(Qh, Kh, Vh, OB, relb, LOGF, qheads + 64, lds, wave0);
    attn_queue<1>(Qh, Kh, Vh, OB, relb, LOGF, qheads + 128, lds, wave0);
}
}
namespace mk {
#define XB_TMO      128
#define XB_XCNT(j)  (256  + 64 * (j))
#define XB_XSUB(j)  (1280 + 64 * (j))
#define XB_XGEN(j)  (2304 + 64 * (j))
#define XB_TOP      3328
#define XB_TOPGEN   3392
#define XCD_BAR_WORDS 3456
#define XB_SPIN_CAP (1u << 22)

__device__ __forceinline__ unsigned xb_ld(unsigned* p)              { return __hip_atomic_load(p, __ATOMIC_RELAXED, __HIP_MEMORY_SCOPE_AGENT); }
__device__ __forceinline__ unsigned xb_add(unsigned* p, unsigned v) { return __hip_atomic_fetch_add(p, v, __ATOMIC_RELAXED, __HIP_MEMORY_SCOPE_AGENT); }
__device__ __forceinline__ unsigned xb_xcc_id() { return (unsigned)__builtin_amdgcn_s_getreg((3 << 11) | 20) & 0xFu; }
#define XB_SPIN(cond, bar) do { unsigned _sp = 0; while (cond) { __builtin_amdgcn_s_sleep(1); \
    if ((++_sp & 255u) == 0u) { if (xb_ld(&(bar)[XB_TMO])) break; if (_sp > XB_SPIN_CAP) { atomicAdd(&(bar)[XB_TMO], 1u); break; } } } } while (0)

struct XcdBarrier {
    unsigned* bar; unsigned x;
    volatile LAS unsigned* st;
};

__device__ __forceinline__ XcdBarrier xcd_barrier_post(unsigned* bar, volatile LAS unsigned* st, bool is_t0) {
    XcdBarrier b; b.bar = bar; b.x = xb_xcc_id(); b.st = st;
    if (is_t0) (void)xb_add(&bar[XB_XCNT(b.x)], 1u);
    return b;
}
__device__ __forceinline__ void xcd_barrier_complete(unsigned* bar, unsigned x, unsigned& nloc, unsigned& nx) {
    const unsigned G = gridDim.x * gridDim.y * gridDim.z;
    unsigned sum, cnt, mine, sp = 0u;
    for (;;) {
        sum = 0u; cnt = 0u; mine = 0u;
#pragma unroll
        for (unsigned j = 0; j < 16; ++j) { const unsigned c = xb_ld(&bar[XB_XCNT(j)]); sum += c; cnt += (c > 0u) ? 1u : 0u; mine = (j == x) ? c : mine; }
        if (sum == G) break;
        __builtin_amdgcn_s_sleep(1);
        if ((++sp & 255u) == 0u) { if (xb_ld(&bar[XB_TMO])) break; if (sp > XB_SPIN_CAP) { atomicAdd(&bar[XB_TMO], 1u); break; } }
    }
    nloc = mine > 0u ? mine : 1u; nx = cnt > 0u ? cnt : 1u;
}

__device__ __forceinline__ void xcd_barrier(const XcdBarrier& b, bool is_t0) {
    asm volatile("s_waitcnt vmcnt(0)" ::: "memory");
    __syncthreads();
    if (is_t0) {
        unsigned* bar = b.bar;
        __builtin_amdgcn_s_waitcnt(0);
        unsigned nloc = b.st[0], nx = b.st[1];
        if (nloc == 0u) { xcd_barrier_complete(bar, b.x, nloc, nx); b.st[0] = nloc; b.st[1] = nx; }
        const unsigned old = xb_add(&bar[XB_XSUB(b.x)], 1u);
        const unsigned gen = old / nloc;
        if (old + 1u == (gen + 1u) * nloc) {
            __builtin_amdgcn_fence(__ATOMIC_RELEASE, "agent");
            asm volatile("s_waitcnt vmcnt(0)" ::: "memory");
            const unsigned og = xb_add(&bar[XB_TOP], 1u);
            const unsigned tg = og / nx;
            if (og + 1u == (tg + 1u) * nx) xb_add(&bar[XB_TOPGEN], 1u);
            else XB_SPIN(xb_ld(&bar[XB_TOPGEN]) == tg, bar);
            __builtin_amdgcn_fence(__ATOMIC_ACQUIRE, "agent");
            xb_add(&bar[XB_XGEN(b.x)], 1u);
            asm volatile("s_waitcnt vmcnt(0)" ::: "memory");
        } else {
            XB_SPIN(xb_ld(&bar[XB_XGEN(b.x)]) == gen, bar);
            __builtin_amdgcn_fence(__ATOMIC_ACQUIRE, "agent");
            asm volatile("s_waitcnt vmcnt(0)" ::: "memory");
        }
    }
    __syncthreads();
}

constexpr int PH_PER_LAYER = 8;
typedef const __attribute__((address_space(4))) Args* KArgs;
#define KARGS() ({ KArgs p_ = (KArgs)__builtin_amdgcn_kernarg_segment_ptr(); asm volatile("" : "+s"(p_)); p_; })
#define GRID_BAR() do { KArgs k_ = KARGS(); XcdBarrier b_; b_.bar = (unsigned*)(k_->ws + WS_CTL) + CW_BAR; b_.x = xb_xcc_id(); b_.st = (volatile LAS unsigned*)(lds + MISC_OFF) + 8; unsigned z_ = 0u; asm volatile("" : "+v"(z_)); const bool t0_ = (wave0 == 0) && (__builtin_amdgcn_mbcnt_hi(~0u, __builtin_amdgcn_mbcnt_lo(~0u, z_)) == 0u);     xcd_barrier(b_, t0_); } while (0)
__global__ void __launch_bounds__(NWAVES * 64, 2) mk_fwd(Args a_unused) {
    extern __shared__ __attribute__((aligned(16))) unsigned char lds_raw[];
    LAS unsigned char* lds = (LAS unsigned char*)lds_raw;
    const int wave0 = __builtin_amdgcn_readfirstlane((int)threadIdx.x >> 6);
    for (int u = threadIdx.x; u < (LDS_BYTES - LDSCTL_OFF) / 4; u += NWAVES * 64) ((LAS unsigned*)(lds + LDSCTL_OFF))[u] = 0u;
    __syncthreads();
    int lo, hi;
    { KArgs k = KARGS(); lo = k->ph_lo; hi = k->ph_hi;
      if (hi - lo > 1) (void)xcd_barrier_post((unsigned*)(k->ws + WS_CTL) + CW_BAR, (volatile LAS unsigned*)(lds + MISC_OFF) + 8, threadIdx.x == 0); }
#define IN(k) (lo <= (k) && (k) < hi)
#define BOTH(k) (IN(k) && IN((k) + 1))
#pragma unroll
    for (int l = 0; l < 2; ++l) {
        const int pb = PH_PER_LAYER * l;
        if (IN(pb + 0)) { KArgs k = KARGS(); conv_phase(k, l, lds, wave0); }
        if (IN(pb + 1) && l == 0) {
            KArgs k = KARGS(); unsigned char* ws = k->ws;
            const float* xin = k->in[0];
            prep_phase<true>(xin, (bf16_t*)(ws + WS_XB), (float*)(ws + WS_RSTD), k->in[2] + (size_t)l * D * PW, k->in[1] + (size_t)l * D, k->in[3] + l * 10, (float*)(ws + WS_LOGF), lds, wave0);
            if (BOTH(pb + 1)) GRID_BAR();
        }
        if (l == 1 && IN(pb + 0) && IN(pb + 2)) GRID_BAR();
        if (IN(pb + 2)) {
            KArgs k = KARGS(); unsigned char* ws = k->ws;
            pg8::Gemm g{(const bf16_t*)(ws + WS_XB), (const bf16_t*)(ws + WS_WIN), M, 12288, D}; pg8::StaticOrder So; FRESH_BID(); So.init(M, 12288, G, bid);
            pg8::EpiQKV4 E{(bf16_t*)(ws + WS_Q), (const float*)(ws + WS_RSTD), 0.08838834764831845f * 1.4426950408889634f, US_INV};
            { LAS unsigned char* lds_ = lds; FRESH_LDS(lds_); FRESH_TID(); pg8::gemm_phase<pg8::EpiQKV4, pg8::StaticOrder, true, true, true>(lds_, g, So, E, tid); }
            if (BOTH(pb + 2)) GRID_BAR();
        }
        if (IN(pb + 3)) {
            KArgs k = KARGS(); unsigned char* ws = k->ws;
            at::attn_phase((const bf16_t*)(ws + WS_Q), (const bf16_t*)(ws + WS_K), (const bf16_t*)(ws + WS_V), (bf16_t*)(ws + WS_OB), k->in[4] + (size_t)l * 12 * 257, (const float*)(ws + WS_LOGF),
                           (unsigned*)(ws + WS_CTL) + CW_QUEUE + 256 * l, lds, wave0);
            if (BOTH(pb + 3)) GRID_BAR();
        }
        if (IN(pb + 4)) {
            KArgs k = KARGS(); unsigned char* ws = k->ws;
            const float* xin = l == 0 ? k->in[0] : (const float*)(ws + WS_X2);
            pg8::Gemm g{(const bf16_t*)(ws + WS_OB), (const bf16_t*)(ws + WS_WOUT), M, D, D}; pg8::StaticOrder So; FRESH_BID(); So.init(M, D, G, bid);
            pg8::EpiResidF32 E{xin, k->out, US_INV * (1.0f / 16.0f), (bf16_t*)(ws + WS_XB)};
            { LAS unsigned char* lds_ = lds; FRESH_LDS(lds_); FRESH_TID(); pg8::gemm_phase<pg8::EpiResidF32, pg8::StaticOrder, false, true, true>(lds_, g, So, E, tid); }
            if (BOTH(pb + 4)) GRID_BAR();
        }
        if (IN(pb + 5)) {
            KArgs k = KARGS(); unsigned char* ws = k->ws;
            pg8::Gemm g{(const bf16_t*)(ws + WS_XB), (const bf16_t*)(ws + WS_WQK), M, 2048, D}; pg8::StaticOrder So; FRESH_BID(); So.init(M, 2048, G, bid);
            pg8::EpiPlainF32<2048> E{(float*)(ws + WS_SC)};
            { LAS unsigned char* lds_ = lds; FRESH_LDS(lds_); FRESH_TID(); pg8::gemm_phase<pg8::EpiPlainF32<2048>, pg8::StaticOrder, true, true>(lds_, g, So, E, tid); }
            if (BOTH(pb + 5)) GRID_BAR();
        }
        if (IN(pb + 6)) {
            KArgs k = KARGS(); unsigned char* ws = k->ws;
            peer_u_phase((const float*)(ws + WS_SC), (const unsigned char*)(ws + WS_U16), k->out, (int*)(ws + WS_K), (float*)(ws + WS_K + 8 * MiB), lds, wave0);
            if (BOTH(pb + 6)) GRID_BAR();
        }
        if (IN(pb + 7)) {
            KArgs k = KARGS(); unsigned char* ws = k->ws;
            if (l == 0) peer_v_phase<false>((const int*)(ws + WS_K), (const float*)(ws + WS_K + 8 * MiB), (const unsigned char*)(ws + WS_U16) + (size_t)NE * D, k->out, (float*)(ws + WS_X2), nullptr,
                                            ws + WS_XB, (float*)(ws + WS_RSTD), (float*)(ws + WS_LOGF), k->in[2] + (size_t)D * PW, k->in[1] + D, k->in[3] + 10, lds, wave0);
            else peer_v_phase<true>((const int*)(ws + WS_K), (const float*)(ws + WS_K + 8 * MiB), (const unsigned char*)(ws + WS_U16) + (size_t)NE * D, k->out, k->out, k->in[12],
                                    nullptr, nullptr, nullptr, nullptr, nullptr, nullptr, lds, wave0);
            if (BOTH(pb + 7)) GRID_BAR();
        }
    }
#undef IN
#undef BOTH
}

static int g_grid = 0;
static void launch_phases(Args a, int lo, int hi, hipStream_t st) {
    a.ph_lo = lo; a.ph_hi = hi;
    hipLaunchKernelGGL(mk_fwd, dim3(g_grid), dim3(NWAVES * 64), LDS_BYTES, st, a);
}
}

extern "C" void kernel_launch(void* const* d_in, const int* in_sizes, int n_in, void* d_out, int out_size, void* d_ws, size_t ws_size, hipStream_t stream) {
    (void)in_sizes; (void)n_in; (void)out_size;
    using namespace mk;
    if (g_grid == 0) {
        if (ws_size < 2048 * MiB) { fprintf(stderr, "kernel_launch: workspace too small (%zu)\n", ws_size); g_grid = -1; return; }
        if (hipFuncSetAttribute((const void*)mk_fwd, hipFuncAttributeMaxDynamicSharedMemorySize, LDS_BYTES) != hipSuccess) { fprintf(stderr, "kernel_launch: hipFuncSetAttribute failed\n"); g_grid = -1; return; }
        int dev = 0, cus = 0; (void)hipGetDevice(&dev); (void)hipDeviceGetAttribute(&cus, hipDeviceAttributeMultiprocessorCount, dev);
        g_grid = cus > 0 ? cus : 256;
    }
    if (g_grid < 0) return;
    unsigned char* ws = (unsigned char*)d_ws; float* out = (float*)d_out;
    (void)hipMemsetAsync(ws + WS_CTL, 0, CTL_ZERO_BYTES, stream);
    Args a{};
    for (int i = 0; i < 13; ++i) a.in[i] = (const float*)d_in[i];
    a.out = out; a.ws = ws;
    launch_phases(a, 0, 2 * PH_PER_LAYER, stream);
}
```

```cpp
#include <hip/hip_runtime.h>
#include <cstdio>
#include <cstdint>
namespace pg8 {
#define PG8_LAS __attribute__((address_space(3)))
typedef unsigned short bf16_t;
typedef short bf16x8 __attribute__((ext_vector_type(8)));
typedef float f32x4 __attribute__((ext_vector_type(4)));
typedef unsigned u32x4 __attribute__((ext_vector_type(4)));
typedef unsigned u32x2 __attribute__((ext_vector_type(2)));
constexpr int BM = 256, BK = 64, HALF = 128, HTB = HALF * BK * 2  , STAGE_BYTES = 8 * HTB, NXCD = 8, WGM = 8;

__host__ __device__ __forceinline__ int lds_byte(int r, int c) { const int st = (r >> 4) * 2 + (c >> 5), rr = r & 15, cc = c & 31, ob = rr * 64 + cc * 2; return st * 1024 + (ob ^ (((ob >> 9) & 1) << 5)); }
__host__ __device__ __forceinline__ void stage_rc(int b, int& R, int& C) { const int st = b / 1024, sb = b % 1024, swz = sb ^ (((sb >> 9) & 1) << 5); R = (st >> 1) * 16 + swz / 64; C = (st & 1) * 32 + (swz % 64) / 2; }
__host__ __device__ __forceinline__ int perm32(int rho) { const int n = rho >> 4, i = rho & 15; return 8 * (i >> 2) + 4 * n + (i & 3); }

struct Unit { int pm, pn; };
struct Gemm { const bf16_t* A; const bf16_t* Bt; int M, N, K; };

struct StaticOrder {
    int nM, nN, nwg, G, c;
    __host__ __device__ void init(int M, int N, int G_, int c_) { nM = M / BM; nN = N / BM; nwg = nM * nN; G = G_; c = c_; }
    __host__ __device__ bool next(int i, Unit& u) const {
        const long L = (long)i * G + c; if (L >= nwg) return false;
        int wgid = (int)L; { const int q = nwg / NXCD, r = nwg % NXCD, xcd = wgid % NXCD, off = wgid / NXCD; wgid = (xcd < r ? xcd * (q + 1) : r * (q + 1) + (xcd - r) * q) + off; }
        const int nig = WGM * nN, gid = wgid / nig, fm = gid * WGM, gsz = (nM - fm) < WGM ? (nM - fm) : WGM;
        u.pm = fm + ((wgid % nig) % gsz); u.pn = (wgid % nig) / gsz; return true;
    }
    __device__ __forceinline__ void a_ready(const Unit&) const {}
    __device__ __forceinline__ void done(const Unit&) const {}
};
__device__ __forceinline__ unsigned cvt_pk_bf16(float lo, float hi) { unsigned r; asm volatile("v_cvt_pk_bf16_f32 %0, %1, %2" : "=v"(r) : "v"(lo), "v"(hi)); return r; }
typedef float f32x2 __attribute__((ext_vector_type(2)));
__device__ __forceinline__ f32x2 gelu_pk(f32x2 v) {
    const f32x2 av = __builtin_elementwise_abs(v), d = av * 0.2316418882f + 1.0f;
    f32x2 t; t.x = __builtin_amdgcn_rcpf(d.x); t.y = __builtin_amdgcn_rcpf(d.y);
    f32x2 q = t * 0.5307027145f + (-0.7265760135f); q = q * t + 0.7107068705f; q = q * t + (-0.142248368f); q = q * t + 0.127414796f; q = q * t;
    const f32x2 s = (v * v) * (-0.72134752044f);
    f32x2 e; e.x = __builtin_amdgcn_exp2f(s.x); e.y = __builtin_amdgcn_exp2f(s.y);
    const f32x2 m = v * (q * e), r = v - m;
    f32x2 o; o.x = v.x < 0.f ? m.x : r.x; o.y = v.y < 0.f ? m.y : r.y; return o;
}
typedef __amdgpu_buffer_rsrc_t rsrc_t;
__device__ __forceinline__ rsrc_t mkrsrc(const void* p, unsigned bytes) { return __builtin_amdgcn_make_buffer_rsrc((void*)p, (short)0, (int)bytes, 0x00020000); }
template <int LDC> struct EpiPlainF32 {
    static constexpr bool PERM = false, AFTER_DRAIN = false;
    float* C;
    __device__ __forceinline__ void operator()(const f32x4 (&acc)[2][2][4][2], const Unit& u, int wr, int wc, int fr, int fq) const {
        const rsrc_t rc = mkrsrc(C, 16384u * LDC * 4u);
        const int vo = ((wr * 64 + fr) * LDC + wc * 32 + 4 * fq) * 4, so = (u.pm * BM * LDC + u.pn * BM) * 4;
#pragma unroll
        for (int ai = 0; ai < 2; ++ai)
#pragma unroll
            for (int m = 0; m < 4; ++m)
#pragma unroll
                for (int bj = 0; bj < 2; ++bj)
#pragma unroll
                    for (int n = 0; n < 2; ++n) __builtin_amdgcn_raw_buffer_store_b128(__builtin_bit_cast(u32x4, acc[ai][bj][m][n]), rc, vo, so + ((ai * HALF + m * 16) * LDC + bj * HALF + n * 16) * 4, 0);
    }
};
template <int LDC> struct EpiRowScaleF32 {
    static constexpr bool PERM = false, AFTER_DRAIN = false;
    float* C; const float* rs;
    __device__ __forceinline__ void operator()(const f32x4 (&acc)[2][2][4][2], const Unit& u, int wr, int wc, int fr, int fq) const {
        const rsrc_t rc = mkrsrc(C, 16384u * LDC * 4u), rr = mkrsrc(rs, 16384u * 4u);
        const int vo = ((wr * 64 + fr) * LDC + wc * 32 + 4 * fq) * 4, vr = (wr * 64 + fr) * 4;
        const int so = (u.pm * BM * LDC + u.pn * BM) * 4, sr = u.pm * BM * 4;
#pragma unroll
        for (int ai = 0; ai < 2; ++ai)
#pragma unroll
            for (int m = 0; m < 4; ++m) { const float s = __builtin_bit_cast(float, __builtin_amdgcn_raw_buffer_load_b32(rr, vr, sr + (ai * HALF + m * 16) * 4, 0));
#pragma unroll
                for (int bj = 0; bj < 2; ++bj)
#pragma unroll
                    for (int n = 0; n < 2; ++n) { const f32x4 v = acc[ai][bj][m][n] * s; __builtin_amdgcn_raw_buffer_store_b128(__builtin_bit_cast(u32x4, v), rc, vo, so + ((ai * HALF + m * 16) * LDC + bj * HALF + n * 16) * 4, 0); } }
    }
};
struct EpiResidF32 {
    static constexpr bool PERM = false, AFTER_DRAIN = false;
    const float* base; float* out; float ascale; bf16_t* xb;
    __device__ __forceinline__ void operator()(const f32x4 (&acc)[2][2][4][2], const Unit& u, int wr, int wc, int fr, int fq) const {
        constexpr int LDC = 4096;
        const rsrc_t rb = mkrsrc(base, 16384u * LDC * 4u), ro = mkrsrc(out, 16384u * LDC * 4u), rx = mkrsrc(xb, 16384u * LDC * 2u);
        const int vo = ((wr * 64 + fr) * LDC + wc * 32 + 4 * fq) * 4;
        const int so = (u.pm * BM * LDC + u.pn * BM) * 4;
        u32x4 ra[2][2], rb2[2][2];
#define EPI_LD(dst, g_) do { _Pragma("unroll") for (int bj = 0; bj < 2; ++bj) _Pragma("unroll") for (int n = 0; n < 2; ++n) \
            dst[bj][n] = __builtin_amdgcn_raw_buffer_load_b128(rb, vo, so + ((((g_) >> 2) * HALF + ((g_) & 3) * 16) * LDC + bj * HALF + n * 16) * 4, 0); } while (0)
#define EPI_ST(src, g_) do { _Pragma("unroll") for (int bj = 0; bj < 2; ++bj) _Pragma("unroll") for (int n = 0; n < 2; ++n) { \
            const int o = so + ((((g_) >> 2) * HALF + ((g_) & 3) * 16) * LDC + bj * HALF + n * 16) * 4; \
            const f32x4 v = __builtin_bit_cast(f32x4, src[bj][n]) + acc[(g_) >> 2][bj][(g_) & 3][n] * ascale; \
            __builtin_amdgcn_raw_buffer_store_b128(__builtin_bit_cast(u32x4, v), ro, vo, o, 0); \
            u32x2 w; w.x = cvt_pk_bf16(v[0], v[1]); w.y = cvt_pk_bf16(v[2], v[3]); __builtin_amdgcn_raw_buffer_store_b64(w, rx, vo >> 1, o >> 1, 0); } } while (0)
        EPI_LD(ra, 0);
        EPI_LD(rb2, 1); EPI_ST(ra, 0);
        EPI_LD(ra, 2); EPI_ST(rb2, 1);
        EPI_LD(rb2, 3); EPI_ST(ra, 2);
        EPI_LD(ra, 4); EPI_ST(rb2, 3);
        EPI_LD(rb2, 5); EPI_ST(ra, 4);
        EPI_LD(ra, 6); EPI_ST(rb2, 5);
        EPI_LD(rb2, 7); EPI_ST(ra, 6);
        EPI_ST(rb2, 7);
#undef EPI_LD
#undef EPI_ST
    }
};
struct EpiQKV {
    static constexpr bool PERM = true, AFTER_DRAIN = false;
    bf16_t* Q; const float* rs; float qscale;
    __device__ __forceinline__ void operator()(const f32x4 (&acc)[2][2][4][2], const Unit& u, int wr, int wc, int fr, int fq) const {
        const rsrc_t rq = mkrsrc(Q, 3u * 16384u * 4096u * 2u), rr = mkrsrc(rs, 16384u * 4u);
        const int colt = u.pn * BM, which = colt >> 12, cw = colt & 4095, gt = cw >> 7;
        const int b = (u.pm * BM) >> 11, st = (u.pm * BM) & 2047;
        const float sc = which == 0 ? qscale : 1.f;
        const int so = (int)(((unsigned)which << 26) + (((unsigned)(b * 32 + gt) * 2048u + (unsigned)st) << 7)) * 2;
        const int vo = (((wr * 64 + fr) << 7) + wc * 32 + 8 * fq) * 2, vr = (wr * 64 + fr) * 4, sr = u.pm * BM * 4;
#pragma unroll
        for (int ai = 0; ai < 2; ++ai)
#pragma unroll
            for (int m = 0; m < 4; ++m) { const float f = sc * __builtin_bit_cast(float, __builtin_amdgcn_raw_buffer_load_b32(rr, vr, sr + (ai * HALF + m * 16) * 4, 0));
#pragma unroll
                for (int bj = 0; bj < 2; ++bj) {
                    const f32x4 v0 = acc[ai][bj][m][0] * f, v1 = acc[ai][bj][m][1] * f;
                    u32x4 w; w.x = cvt_pk_bf16(v0[0], v0[1]); w.y = cvt_pk_bf16(v0[2], v0[3]); w.z = cvt_pk_bf16(v1[0], v1[1]); w.w = cvt_pk_bf16(v1[2], v1[3]);
                    __builtin_amdgcn_raw_buffer_store_b128(w, rq, vo, so + ((bj * 2048 + ai * HALF + m * 16) << 7) * 2, 0); } }
    }
};

struct EpiQKV4 {
    static constexpr bool PERM = false, AFTER_DRAIN = false;
    bf16_t* Q; const float* rs; float qscale, wscale;
    __device__ __forceinline__ void operator()(const f32x4 (&acc)[2][2][4][2], const Unit& u, int wr, int wc, int fr, int fq) const {
        const rsrc_t rq = mkrsrc(Q, 3u * 16384u * 4096u * 2u), rr = mkrsrc(rs, 16384u * 4u);
        const int colt = u.pn * BM, which = colt >> 12, cw = colt & 4095, gt = cw >> 7;
        const int b = (u.pm * BM) >> 11, st = (u.pm * BM) & 2047;
        const float sc = (which == 0 ? qscale : 1.f) * wscale;
        const int so = (int)(((unsigned)which << 26) + (((unsigned)(b * 32 + gt) * 2048u + (unsigned)st) << 7)) * 2;
        const int vo = (((wr * 64 + fr) << 7) + wc * 32 + 4 * fq) * 2, vr = (wr * 64 + fr) * 4, sr = u.pm * BM * 4;
        unsigned rsv[2][4];
#pragma unroll
        for (int ai = 0; ai < 2; ++ai)
#pragma unroll
            for (int m = 0; m < 4; ++m) rsv[ai][m] = __builtin_amdgcn_raw_buffer_load_b32(rr, vr, sr + (ai * HALF + m * 16) * 4, 0);
#pragma unroll
        for (int ai = 0; ai < 2; ++ai)
#pragma unroll
            for (int m = 0; m < 4; ++m) { const float f = sc * __builtin_bit_cast(float, rsv[ai][m]);
#pragma unroll
                for (int bj = 0; bj < 2; ++bj)
#pragma unroll
                    for (int n = 0; n < 2; ++n) { const f32x4 v0 = acc[ai][bj][m][n] * f; u32x2 w; w.x = cvt_pk_bf16(v0[0], v0[1]); w.y = cvt_pk_bf16(v0[2], v0[3]);
                        __builtin_amdgcn_raw_buffer_store_b64(w, rq, vo, so + (((bj * 2048 + ai * HALF + m * 16) << 7) + n * 16) * 2, 0); } }
    }
};

typedef int i32x8 __attribute__((ext_vector_type(8)));
template <bool F8> struct FragT { typedef bf16x8 type; };
template <> struct FragT<true> { typedef i32x8 type; };
__device__ __forceinline__ f32x4 mma_bf16(bf16x8 a, bf16x8 b, f32x4 c) { return __builtin_amdgcn_mfma_f32_16x16x32_bf16(a, b, c, 0, 0, 0); }
__device__ __forceinline__ f32x4 mma_bf16(i32x8, i32x8, f32x4 c) { return c; }
template <class Epi, class Sched, bool ALIGN_EPI = false, bool SP2 = false, bool F8 = false>
__device__ __forceinline__ void gemm_phase(PG8_LAS unsigned char* lds, const Gemm g, const Sched& S, const Epi& E, int tid_in) {
    int tid_ = tid_in;
    const int tid = tid_, wid = __builtin_amdgcn_readfirstlane(tid >> 6), lane = tid & 63, wr = wid >> 2, wc = wid & 3, fr = lane & 15, fq = lane >> 4;
    constexpr int EB = F8 ? 1 : 2;
    constexpr int K = 4096; constexpr int nt = (K * EB) / (BK * 2);
    unsigned voffA[2], voffB[2];
#pragma unroll
    for (int i = 0; i < 2; ++i) { int R, C; stage_rc(tid * 16 + i * 8192, R, C); const int Rb = Epi::PERM ? ((R & ~31) + perm32(R & 31)) : R;
        voffA[i] = (unsigned)(R * K * EB + C * 2); voffB[i] = (unsigned)(Rb * K * EB + C * 2); }
    const size_t kstep = (size_t)(BK * 2);
    const size_t hstep = (size_t)HALF * K * EB;
    const size_t tstep = 2 * hstep;
    const unsigned ldsw = (unsigned)wid * 1024u;
    const int aoff = F8 ? lds_byte(wr * 64 + fr, fq * 16) + (fq & 1) * 16 : lds_byte(wr * 64 + fr, fq * 8), boff = F8 ? lds_byte(wc * 32 + fr, fq * 16) + (fq & 1) * 16 : lds_byte(wc * 32 + fr, fq * 8);
    const int aoff1 = aoff + (F8 ? 16 - 32 * (fq & 1) : 0);
    const int f8o0_unused = 0; (void)f8o0_unused;
#define PG8_SA(b, h) (((b) * 2 + (h)) * HTB)
#define PG8_SB(b, h) ((4 + (b) * 2 + (h)) * HTB)
#define PG8_STAGE_X(bufoff, gbase, voff, rs_, base_) do { const int so_ = (int)((const char*)(gbase) - (const char*)(base_)); _Pragma("unroll") for (int _i = 0; _i < 2; ++_i) \
        __builtin_amdgcn_raw_ptr_buffer_load_lds(rs_, (PG8_LAS void*)(lds + (bufoff) + ldsw + _i * 8192), 16, (int)(voff)[_i], so_, 0, 0); } while (0)
#define PG8_LDA(dst, b, h) do { if constexpr (F8) { _Pragma("unroll") for (int m = 0; m < 4; ++m) { const u32x4 lo_ = *(const PG8_LAS u32x4*)(lds + PG8_SA(b, h) + aoff + m * 2048), hi_ = *(const PG8_LAS u32x4*)(lds + PG8_SA(b, h) + aoff1 + m * 2048); \
            dst[m][0] = (i32x8){(int)lo_[0], (int)lo_[1], (int)lo_[2], (int)lo_[3], (int)hi_[0], (int)hi_[1], (int)hi_[2], (int)hi_[3]}; } } \
        else { _Pragma("unroll") for (int m = 0; m < 4; ++m) _Pragma("unroll") for (int k = 0; k < 2; ++k) dst[m][k] = *(const PG8_LAS frag_t*)(lds + PG8_SA(b, h) + aoff + m * 2048 + k * 1024); } } while (0)
#define PG8_LDB(dst, b, h) do { if constexpr (F8) { _Pragma("unroll") for (int n = 0; n < 2; ++n) { const u32x4 lo_ = *(const PG8_LAS u32x4*)(lds + PG8_SB(b, h) + boff + n * 2048), hi_ = *(const PG8_LAS u32x4*)(lds + PG8_SB(b, h) + boff + (aoff1 - aoff) + n * 2048); \
            dst[n][0] = (i32x8){(int)lo_[0], (int)lo_[1], (int)lo_[2], (int)lo_[3], (int)hi_[0], (int)hi_[1], (int)hi_[2], (int)hi_[3]}; } } \
        else { _Pragma("unroll") for (int n = 0; n < 2; ++n) _Pragma("unroll") for (int k = 0; k < 2; ++k) dst[n][k] = *(const PG8_LAS frag_t*)(lds + PG8_SB(b, h) + boff + n * 2048 + k * 1024); } } while (0)
#define PG8_MMA(ai, bj, At, Bt) do { __builtin_amdgcn_s_setprio(1); _Pragma("unroll") for (int m = 0; m < 4; ++m) _Pragma("unroll") for (int n = 0; n < 2; ++n) { \
        if constexpr (F8) acc[ai][bj][m][n] = __builtin_amdgcn_mfma_scale_f32_16x16x128_f8f6f4(Bt[n][0], At[m][0], acc[ai][bj][m][n], 0, 0, 0, 0x7f7f7f7f, 0, 0x7f7f7f7f); \
        else { _Pragma("unroll") for (int k = 0; k < 2; ++k) acc[ai][bj][m][n] = mma_bf16(Bt[n][k], At[m][k], acc[ai][bj][m][n]); } } __builtin_amdgcn_s_setprio(0); } while (0)
#define PG8_WAIT_V(n) asm volatile("s_waitcnt vmcnt(" #n ")" ::: "memory")
#define PG8_WAIT_L(n) asm volatile("s_waitcnt lgkmcnt(" #n ")" ::: "memory")
#define PG8_BAR __builtin_amdgcn_s_barrier()
#define PG8_SCHED __builtin_amdgcn_sched_barrier(0)
    const __amdgpu_buffer_rsrc_t rsA = __builtin_amdgcn_make_buffer_rsrc((void*)g.A, (short)0, (int)((size_t)g.M * K * EB), 0x00020000), rsB = __builtin_amdgcn_make_buffer_rsrc((void*)g.Bt, (short)0, (int)((size_t)g.N * K * EB), 0x00020000);
    Unit cur, nxt; int ui = 0;
    if (!S.next(0, cur)) return;
    f32x4 acc[2][2][4][2];
#pragma unroll
    for (int a = 0; a < 2; ++a)
#pragma unroll
        for (int b = 0; b < 2; ++b)
#pragma unroll
            for (int m = 0; m < 4; ++m)
#pragma unroll
                for (int n = 0; n < 2; ++n) acc[a][b][m][n] = (f32x4){0.f, 0.f, 0.f, 0.f};
    typedef typename FragT<F8>::type frag_t;
    frag_t At[4][F8 ? 1 : 2], B0[2][F8 ? 1 : 2], B1[2][F8 ? 1 : 2];
    const char* cA = (const char*)g.A + (size_t)cur.pm * tstep; const char* cB = (const char*)g.Bt + (size_t)cur.pn * tstep;
    S.a_ready(cur);
    if constexpr (SP2) {
        PG8_STAGE_X(PG8_SB(0, 0), cB, voffB, rsB, g.Bt); PG8_STAGE_X(PG8_SB(0, 1), cB + hstep, voffB, rsB, g.Bt); PG8_STAGE_X(PG8_SA(0, 0), cA, voffA, rsA, g.A); PG8_STAGE_X(PG8_SA(0, 1), cA + hstep, voffA, rsA, g.A);
        if (wr == 1) PG8_BAR;
        PG8_WAIT_V(2); PG8_BAR;
        PG8_STAGE_X(PG8_SB(1, 0), cB + kstep, voffB, rsB, g.Bt); PG8_STAGE_X(PG8_SA(1, 0), cA + kstep, voffA, rsA, g.A); PG8_STAGE_X(PG8_SB(1, 1), cB + hstep + kstep, voffB, rsB, g.Bt);
        PG8_WAIT_V(6); PG8_BAR;
    } else {
        PG8_STAGE_X(PG8_SB(0, 0), cB, voffB, rsB, g.Bt); PG8_STAGE_X(PG8_SA(0, 0), cA, voffA, rsA, g.A); PG8_STAGE_X(PG8_SB(0, 1), cB + hstep, voffB, rsB, g.Bt); PG8_STAGE_X(PG8_SA(0, 1), cA + hstep, voffA, rsA, g.A);
        if (wr == 1) PG8_BAR;
        PG8_WAIT_V(4); PG8_BAR;
        PG8_STAGE_X(PG8_SB(1, 0), cB + kstep, voffB, rsB, g.Bt); PG8_STAGE_X(PG8_SA(1, 0), cA + kstep, voffA, rsA, g.A); PG8_STAGE_X(PG8_SB(1, 1), cB + hstep + kstep, voffB, rsB, g.Bt);
        PG8_WAIT_V(6); PG8_BAR;
    }
    for (;;) {
        const bool has_next = S.next(ui + 1, nxt);
        const char* nA = has_next ? (const char*)g.A + (size_t)nxt.pm * tstep : cA; const char* nB = has_next ? (const char*)g.Bt + (size_t)nxt.pn * tstep : cB;
        for (int t = 0; t < nt; t += 2) {
            const bool last = (t == nt - 2);
            const char* a1 = cA + (size_t)(t + 1) * kstep;
            const char* a2 = last ? nA : cA + (size_t)(t + 2) * kstep; const char* b2 = last ? nB : cB + (size_t)(t + 2) * kstep;
            const char* a3 = a2 + kstep; const char* b3 = b2 + kstep;
            if (last && has_next) S.a_ready(nxt);
            if constexpr (SP2) {
            PG8_LDB(B0, 0, 0); PG8_LDB(B1, 0, 1); PG8_SCHED; PG8_LDA(At, 0, 0); PG8_STAGE_X(PG8_SA(1, 1), a1 + hstep, voffA, rsA, g.A);
            PG8_WAIT_V(8); PG8_WAIT_L(0); PG8_BAR; PG8_MMA(0, 0, At, B0); PG8_MMA(0, 1, At, B1); PG8_BAR; PG8_SCHED;
            PG8_LDA(At, 0, 1); PG8_STAGE_X(PG8_SB(0, 0), b2, voffB, rsB, g.Bt); PG8_STAGE_X(PG8_SB(0, 1), b2 + hstep, voffB, rsB, g.Bt); PG8_STAGE_X(PG8_SA(0, 0), a2, voffA, rsA, g.A);
            PG8_WAIT_V(8); PG8_WAIT_L(0); PG8_BAR; PG8_MMA(1, 0, At, B0); PG8_MMA(1, 1, At, B1); PG8_BAR; PG8_SCHED;
            PG8_LDB(B0, 1, 0); PG8_LDB(B1, 1, 1); PG8_SCHED; PG8_LDA(At, 1, 0); PG8_STAGE_X(PG8_SA(0, 1), a2 + hstep, voffA, rsA, g.A);
            PG8_WAIT_V(8); PG8_WAIT_L(0); PG8_BAR; PG8_MMA(0, 0, At, B0); PG8_MMA(0, 1, At, B1); PG8_BAR; PG8_SCHED;
            PG8_LDA(At, 1, 1); PG8_STAGE_X(PG8_SB(1, 0), b3, voffB, rsB, g.Bt); PG8_STAGE_X(PG8_SB(1, 1), b3 + hstep, voffB, rsB, g.Bt); PG8_STAGE_X(PG8_SA(1, 0), a3, voffA, rsA, g.A);
            PG8_WAIT_V(8); PG8_WAIT_L(0); PG8_BAR; PG8_MMA(1, 0, At, B0); PG8_MMA(1, 1, At, B1); PG8_BAR; PG8_SCHED;
            } else {
            PG8_LDB(B0, 0, 0); PG8_SCHED; PG8_LDA(At, 0, 0); PG8_STAGE_X(PG8_SA(1, 1), a1 + hstep, voffA, rsA, g.A);
            PG8_WAIT_L(8); PG8_BAR; PG8_WAIT_L(0); PG8_MMA(0, 0, At, B0); PG8_BAR; PG8_SCHED;
            PG8_LDB(B1, 0, 1); PG8_STAGE_X(PG8_SB(0, 0), b2, voffB, rsB, g.Bt);
            PG8_BAR; PG8_WAIT_L(0); PG8_MMA(0, 1, At, B1); PG8_BAR;
            PG8_LDA(At, 0, 1); PG8_STAGE_X(PG8_SA(0, 0), a2, voffA, rsA, g.A);
            PG8_BAR; PG8_WAIT_L(0); PG8_MMA(1, 0, At, B0); PG8_BAR; PG8_SCHED;
            PG8_STAGE_X(PG8_SB(0, 1), b2 + hstep, voffB, rsB, g.Bt);
            PG8_WAIT_V(6); PG8_BAR; PG8_MMA(1, 1, At, B1); PG8_BAR;
            PG8_LDB(B0, 1, 0); PG8_SCHED; PG8_LDA(At, 1, 0); PG8_STAGE_X(PG8_SA(0, 1), a2 + hstep, voffA, rsA, g.A);
            PG8_WAIT_L(8); PG8_BAR; PG8_WAIT_L(0); PG8_MMA(0, 0, At, B0); PG8_BAR; PG8_SCHED;
            PG8_LDB(B1, 1, 1); PG8_STAGE_X(PG8_SB(1, 0), b3, voffB, rsB, g.Bt);
            PG8_BAR; PG8_WAIT_L(0); PG8_MMA(0, 1, At, B1); PG8_BAR;
            PG8_LDA(At, 1, 1); PG8_STAGE_X(PG8_SA(1, 0), a3, voffA, rsA, g.A);
            PG8_BAR; PG8_WAIT_L(0); PG8_MMA(1, 0, At, B0); PG8_BAR; PG8_SCHED;
            PG8_STAGE_X(PG8_SB(1, 1), b3 + hstep, voffB, rsB, g.Bt);
            PG8_WAIT_V(6); PG8_BAR; PG8_MMA(1, 1, At, B1); PG8_BAR;
            }
        }
        if constexpr (ALIGN_EPI) { if (wr == 0) PG8_BAR; }
        if constexpr (!Epi::AFTER_DRAIN) { E(acc, cur, wr, wc, fr, fq); S.done(cur); }
        if (!has_next) break;
#pragma unroll
        for (int a = 0; a < 2; ++a)
#pragma unroll
            for (int b = 0; b < 2; ++b)
#pragma unroll
                for (int m = 0; m < 4; ++m)
#pragma unroll
                    for (int n = 0; n < 2; ++n) acc[a][b][m][n] = (f32x4){0.f, 0.f, 0.f, 0.f};
        cur = nxt; cA = nA; cB = nB; ++ui;
        if constexpr (ALIGN_EPI) { if (wr == 1) PG8_BAR; }
    }
    PG8_WAIT_V(0);
    if constexpr (!ALIGN_EPI) { if (wr == 0) PG8_BAR; }
    PG8_BAR;
    if constexpr (Epi::AFTER_DRAIN) { E.fused(acc, cur, wr, wc, fr, fq, lds, wid, lane); S.done(cur); }
#undef PG8_SA
#undef PG8_SB
#undef PG8_STAGE_X
#undef PG8_LDA
#undef PG8_LDB
#undef PG8_MMA
#undef PG8_WAIT_V
#undef PG8_WAIT_L
#undef PG8_BAR
#undef PG8_SCHED
}
}
#define GAS __attribute__((address_space(1)))
#define LAS __attribute__((address_space(3)))
typedef unsigned short bf16_t;
typedef unsigned u32x4 __attribute__((ext_vector_type(4)));
typedef unsigned u32x2 __attribute__((ext_vector_type(2)));
typedef float f32x4 __attribute__((ext_vector_type(4)));
typedef float f32x2 __attribute__((ext_vector_type(2)));
typedef float f32x16 __attribute__((ext_vector_type(16)));
typedef short bf16x8 __attribute__((ext_vector_type(8)));
typedef short s16x4 __attribute__((ext_vector_type(4)));
typedef __bf16 bf16x2_t __attribute__((ext_vector_type(2)));

namespace mk {
constexpr int M = 16384, D = 4096, S = 2048, NB = 8, PW = 12298, NH = 32, NE = 16384;
constexpr int NWAVES = 8;
constexpr size_t MiB = 1u << 20;
constexpr size_t WS_CTL = 0, CTL_ZERO_BYTES = 1 * MiB;
constexpr size_t WS_RSTD = 2 * MiB, WS_LOGF = 3 * MiB, WS_WQK = 4 * MiB, WS_WOUT = 20 * MiB, WS_WIN = 52 * MiB, WS_U16 = 148 * MiB, WS_V16 = 276 * MiB,
                 WS_XB = 404 * MiB, WS_Q = 532 * MiB, WS_K = 660 * MiB, WS_V = 788 * MiB, WS_OB = 916 * MiB, WS_X2 = 1792 * MiB, WS_END = 2048 * MiB;
constexpr size_t WS_SC = WS_Q;
constexpr int CW_BAR = 4096;
constexpr int CW_QUEUE = 16384;
constexpr int RING_BYTES = 131072, LDSCTL_OFF = RING_BYTES, MISC_OFF = LDSCTL_OFF + 320, LDS_BYTES = 147456;

struct Args { const float* in[13]; float* out; unsigned char* ws; int ph_lo, ph_hi; };

__device__ __forceinline__ unsigned f2bf(float f) { unsigned u = __builtin_bit_cast(unsigned, f); return (u + 0x7fffu + ((u >> 16) & 1u)) >> 16; }
__device__ __forceinline__ unsigned pk2(float lo, float hi) { return f2bf(lo) | (f2bf(hi) << 16); }
__device__ __forceinline__ float bf_lo(unsigned w) { return __builtin_bit_cast(float, w << 16); }
__device__ __forceinline__ float bf_hi(unsigned w) { return __builtin_bit_cast(float, w & 0xffff0000u); }
__device__ __forceinline__ float lane_read(float v, int src_lane) { return __builtin_bit_cast(float, __builtin_amdgcn_ds_bpermute(src_lane << 2, __builtin_bit_cast(int, v))); }
__device__ __forceinline__ int lane_read(int v, int src_lane) { return __builtin_amdgcn_ds_bpermute(src_lane << 2, v); }
constexpr float US = 1024.0f, VS = 32.0f, US_INV = 1.0f / 1024.0f, VS_INV = 1.0f / 32.0f;
__device__ __forceinline__ float clamp8(float x) { return fminf(fmaxf(x, -224.0f), 224.0f); }
__device__ __forceinline__ float logsig(float z) { return fminf(z, 0.f) - 0.6931471805599453f * __builtin_amdgcn_logf(1.0f + __builtin_amdgcn_exp2f(-fabsf(z) * 1.4426950408889634f)); }
__device__ __forceinline__ float gelu_erf(float v) {
    const float av = fabsf(v), t = __builtin_amdgcn_rcpf(av * 0.2316418882f + 1.0f);
    float q = t * 0.5307027145f + (-0.7265760135f); q = q * t + 0.7107068705f; q = q * t + (-0.142248368f); q = q * t + 0.127414796f; q = q * t;
    const float e = __builtin_amdgcn_exp2f((v * v) * (-0.72134752044f));
    const float m = v * (q * e);
    return v < 0.f ? m : v - m;
}
#define LDS_WAIT() asm volatile("s_waitcnt lgkmcnt(0)" ::: "memory")
#define FRESH_LDS(l) do { unsigned v_ = (unsigned)(size_t)(l); asm volatile("" : "+s"(v_)); (l) = (LAS unsigned char*)(size_t)v_; } while (0)
#define FRESH_BID() int bid = blockIdx.x, G = gridDim.x; asm volatile("" : "+s"(bid), "+s"(G))
#define FRESH_TID() int tid; { int w_ = wave0, l_; { unsigned z_ = 0u; asm volatile("" : "+v"(z_)); l_ = (int)__builtin_amdgcn_mbcnt_hi(~0u, __builtin_amdgcn_mbcnt_lo(~0u, z_)); } asm volatile("" : "+s"(w_)); tid = w_ * 64 + l_; } const int lane = tid & 63, wave = __builtin_amdgcn_readfirstlane(tid >> 6); (void)lane; (void)wave

__device__ __forceinline__ unsigned wave_max_u32(unsigned v) {
    v = max(v, (unsigned)__builtin_amdgcn_update_dpp(0, (int)v, 0x111, 0xF, 0xF, true));
    v = max(v, (unsigned)__builtin_amdgcn_update_dpp(0, (int)v, 0x112, 0xF, 0xF, true));
    v = max(v, (unsigned)__builtin_amdgcn_update_dpp(0, (int)v, 0x114, 0xF, 0xF, true));
    v = max(v, (unsigned)__builtin_amdgcn_update_dpp(0, (int)v, 0x118, 0xF, 0xF, true));
    v = max(v, (unsigned)__builtin_amdgcn_update_dpp((int)v, (int)v, 0x142, 0xA, 0xF, false));
    v = max(v, (unsigned)__builtin_amdgcn_update_dpp((int)v, (int)v, 0x143, 0xC, 0xF, false));
    return (unsigned)__builtin_amdgcn_readlane((int)v, 63);
}
__device__ __forceinline__ float wave_sum_dpp(float x) {
    int v = __builtin_bit_cast(int, x);
#define DPP_ADD(ctrl, rm, bc, oldv) v = __builtin_bit_cast(int, __builtin_bit_cast(float, v) + __builtin_bit_cast(float, __builtin_amdgcn_update_dpp(oldv, v, ctrl, rm, 0xF, bc)))
    DPP_ADD(0x111, 0xF, true, 0); DPP_ADD(0x112, 0xF, true, 0); DPP_ADD(0x114, 0xF, true, 0); DPP_ADD(0x118, 0xF, true, 0);
#undef DPP_ADD
    const float r0 = __builtin_bit_cast(float, __builtin_amdgcn_readlane(v, 15)), r1 = __builtin_bit_cast(float, __builtin_amdgcn_readlane(v, 31)), r2 = __builtin_bit_cast(float, __builtin_amdgcn_readlane(v, 47)), r3 = __builtin_bit_cast(float, __builtin_amdgcn_readlane(v, 63));
    return (r0 + r1) + (r2 + r3);
}
__device__ __forceinline__ unsigned ordkey(float x) { const unsigned u = __builtin_bit_cast(unsigned, x); return (u & 0x80000000u) ? ~u : (u | 0x80000000u); }
__device__ __forceinline__ void transpose_item(const float* W, int K, int ldw, int ncols, const float* gain, bf16_t* WT, LAS float* scr, int item, int lane) {
    const int nblk = ncols / 32, kb = item / nblk, nb = item % nblk, k0 = 64 * kb, n0 = 32 * nb;
#pragma unroll 8
    for (int i = 0; i < 32; ++i) { const int kk = 2 * i + (lane >> 5); float v = W[(size_t)(k0 + kk) * ldw + n0 + (lane & 31)]; if (gain) v *= gain[k0 + kk]; scr[kk * 33 + (lane & 31)] = v; }
    LDS_WAIT(); asm volatile("" ::: "memory");
    const int c = lane & 7;
#pragma unroll
    for (int j = 0; j < 4; ++j) { const int n = (lane >> 3) + 8 * j; const LAS float* s = scr + (8 * c) * 33 + n;
        u32x4 o; o.x = pk2(s[0 * 33], s[1 * 33]); o.y = pk2(s[2 * 33], s[3 * 33]); o.z = pk2(s[4 * 33], s[5 * 33]); o.w = pk2(s[6 * 33], s[7 * 33]);
        *(u32x4*)(WT + (size_t)(n0 + n) * K + k0 + 8 * c) = o; }
    LDS_WAIT(); asm volatile("" ::: "memory");
}

typedef const __attribute__((address_space(4))) Args* KArgsT;
__device__ __forceinline__ unsigned pk4_fp8(float a, float b, float c, float d) { int p = __builtin_amdgcn_cvt_pk_fp8_f32(clamp8(a), clamp8(b), 0, false); p = __builtin_amdgcn_cvt_pk_fp8_f32(clamp8(c), clamp8(d), p, true); return (unsigned)p; }
__device__ __forceinline__ void transpose_item8(const float* W, int K, int ldw, int ncols, const float* gain, float scale, unsigned char* WT, LAS float* scr, int item, int lane) {
    const int nblk = ncols / 32, kb = item / nblk, nb = item % nblk, k0 = 64 * kb, n0 = 32 * nb;
    const int kr = lane >> 3, nq = (lane & 7) * 4;
    f32x4 v[8];
#pragma unroll
    for (int i = 0; i < 8; ++i) { const float* p = W + (size_t)(k0 + 8 * i + kr) * ldw + n0 + nq; v[i] = (f32x4){p[0], p[1], p[2], p[3]}; }
#pragma unroll
    for (int i = 0; i < 8; ++i) { const int kk = 8 * i + kr; const float g = (gain ? gain[k0 + kk] : 1.0f) * scale; LAS float* d = scr + kk * 33 + nq; d[0] = v[i][0] * g; d[1] = v[i][1] * g; d[2] = v[i][2] * g; d[3] = v[i][3] * g; }
    LDS_WAIT(); asm volatile("" ::: "memory");
    const int c = lane & 7;
#pragma unroll
    for (int j = 0; j < 4; ++j) { const int n = (lane >> 3) + 8 * j; const LAS float* s = scr + (8 * c) * 33 + n;
        u32x2 o; o.x = pk4_fp8(s[0 * 33], s[1 * 33], s[2 * 33], s[3 * 33]); o.y = pk4_fp8(s[4 * 33], s[5 * 33], s[6 * 33], s[7 * 33]);
        *(u32x2*)(WT + (size_t)(n0 + n) * K + k0 + 8 * c) = o; }
    LDS_WAIT(); asm volatile("" ::: "memory");
}
__device__ __forceinline__ void conv_phase(KArgsT ka, int l, LAS unsigned char* lds, int wave0) {
    FRESH_TID(); FRESH_LDS(lds); FRESH_BID();
    unsigned char* ws = ka->ws;
    const float* ln1 = ka->in[1] + (size_t)l * D; const float* w_in = ka->in[2] + (size_t)l * D * PW; const float* w_out = ka->in[5] + (size_t)l * D * D;
    const float* ln2 = ka->in[6] + (size_t)l * D; const float* wq = ka->in[7] + (size_t)l * D * 2048;
    const float* k1 = ka->in[8] + (size_t)l * 8 * 128 * 128; const float* k2 = ka->in[9] + (size_t)l * 8 * 128 * 128;
    const float* pu = ka->in[10] + (size_t)l * NE * D; const float* pv = ka->in[11] + (size_t)l * NE * D;
    bf16_t* WQK = (bf16_t*)(ws + WS_WQK); bf16_t* WOUT = (bf16_t*)(ws + WS_WOUT); bf16_t* WIN = (bf16_t*)(ws + WS_WIN); bf16_t* U16 = (bf16_t*)(ws + WS_U16); bf16_t* V16 = (bf16_t*)(ws + WS_V16);
    {
        LAS float* Ks = (LAS float*)lds;
        LAS float* Ws = (LAS float*)(lds + 128 * 132 * 4);
        for (int it = bid; it < 1024; it += G) {
            const int gi = it >> 6, c0 = (it & 63) * 64;
            const float* key = ((gi & 1) ? k2 : k1) + (size_t)(gi >> 1) * 128 * 128;
            for (int i = tid; i < 4096; i += 512) { const int r = i >> 5, c4 = (i & 31) * 4; *(LAS f32x4*)(Ks + r * 132 + c4) = *(const f32x4*)(key + r * 128 + c4); }
            for (int i = tid; i < 2048; i += 512) { const int r = i >> 5, c4 = (i & 31) * 4; *(LAS f32x4*)(Ws + r * 132 + c4) = *(const f32x4*)(wq + (size_t)(c0 + r) * 2048 + gi * 128 + c4); }
            __syncthreads();
            const int tc = tid & 15, tn = tid >> 4;
            float acc[4][4];
#pragma unroll
            for (int i = 0; i < 4; ++i)
#pragma unroll
                for (int j = 0; j < 4; ++j) acc[i][j] = 0.f;
#pragma unroll 2
            for (int d = 0; d < 128; d += 4) {
                f32x4 kv[4], wv[4];
#pragma unroll
                for (int i = 0; i < 4; ++i) kv[i] = *(const LAS f32x4*)(Ks + (4 * tn + i) * 132 + d);
#pragma unroll
                for (int j = 0; j < 4; ++j) wv[j] = *(const LAS f32x4*)(Ws + (tc + 16 * j) * 132 + d);
#pragma unroll
                for (int i = 0; i < 4; ++i)
#pragma unroll
                    for (int j = 0; j < 4; ++j) acc[i][j] += kv[i][0] * wv[j][0] + kv[i][1] * wv[j][1] + kv[i][2] * wv[j][2] + kv[i][3] * wv[j][3];
            }
#pragma unroll
            for (int j = 0; j < 4; ++j) { const int c = c0 + tc + 16 * j; const float gg = ln2[c];
#pragma unroll
                for (int i = 0; i < 4; ++i) WQK[(size_t)(gi * 128 + 4 * tn + i) * D + c] = (bf16_t)f2bf(acc[i][j] * gg); }
            __syncthreads();
        }
        __syncthreads();
    }
    const int gw = bid * NWAVES + wave, NGW = G * NWAVES;
    {
        unsigned char* U8 = (unsigned char*)U16; unsigned char* V8 = U8 + (size_t)NE * D;
        for (int r = gw; r < NE; r += NGW) {
            const float* us = pu + (size_t)r * D; const float* vs = pv + (size_t)r * D;
#pragma unroll
            for (int i = 0; i < 4; ++i) { const int c = 1024 * i + 16 * lane;
                u32x4 ou, ov;
#pragma unroll
                for (int q = 0; q < 4; ++q) { const f32x4 u0 = *(const f32x4*)(us + c + 4 * q), g0 = *(const f32x4*)(ln2 + c + 4 * q), v0 = *(const f32x4*)(vs + c + 4 * q);
                    int pu_ = __builtin_amdgcn_cvt_pk_fp8_f32(clamp8(u0[0] * g0[0] * US), clamp8(u0[1] * g0[1] * US), 0, false); pu_ = __builtin_amdgcn_cvt_pk_fp8_f32(clamp8(u0[2] * g0[2] * US), clamp8(u0[3] * g0[3] * US), pu_, true);
                    int pv_ = __builtin_amdgcn_cvt_pk_fp8_f32(clamp8(v0[0] * VS), clamp8(v0[1] * VS), 0, false); pv_ = __builtin_amdgcn_cvt_pk_fp8_f32(clamp8(v0[2] * VS), clamp8(v0[3] * VS), pv_, true);
                    ou[q] = (unsigned)pu_; ov[q] = (unsigned)pv_; }
                *(u32x4*)(U8 + (size_t)r * D + c) = ou; *(u32x4*)(V8 + (size_t)r * D + c) = ov; }
        }
    }
    {
        LAS float* scr = (LAS float*)(lds + wave * 16384);
        constexpr int I_O = (D / 64) * (D / 32), I_IN = (D / 64) * (12288 / 32);
        for (int it = gw; it < I_O + I_IN; it += NGW) {
            if (it < I_O) transpose_item8(w_out, D, D, D, nullptr, US, (unsigned char*)WOUT, scr, it, lane);
            else transpose_item8(w_in, D, PW, 12288, ln1, US, (unsigned char*)WIN, scr, it - I_O, lane);
        }
    }
}

template <bool WITH_F>
__device__ __forceinline__ void prep_phase(const float* X, bf16_t* XB, float* RSTD, const float* w_in, const float* ln1, const float* bf, float* LOGF, LAS unsigned char* lds, int wave0) {
    FRESH_TID(); FRESH_LDS(lds); FRESH_BID();
    LAS unsigned short* gfs = (LAS unsigned short*)lds;
    if (WITH_F) {
        __syncthreads();
        for (int c = tid; c < D; c += 512) { const float g = ln1[c]; const float* wr = w_in + (size_t)c * PW + 12288;
#pragma unroll
            for (int j = 0; j < 10; ++j) gfs[j * D + c] = (unsigned short)f2bf(wr[j] * g); }
        __syncthreads();
    }
    const int gw = bid * NWAVES + wave, NGW = G * NWAVES;
    for (int m = gw; m < M; m += NGW) {
        const f32x4* xr = (const f32x4*)(X + (size_t)m * D) + lane;
        f32x4 v[16]; float ss = 0.f;
#pragma unroll
        for (int i = 0; i < 16; ++i) { v[i] = xr[64 * i]; ss += (v[i][0] * v[i][0] + v[i][1] * v[i][1]) + (v[i][2] * v[i][2] + v[i][3] * v[i][3]); }
        ss = wave_sum_dpp(ss);
        const float rstd = rsqrtf(ss * (1.0f / D) + 1e-6f);
        if (WITH_F) {
            unsigned* o8 = (unsigned*)((unsigned char*)XB + (size_t)m * D) + lane;
#pragma unroll
            for (int i = 0; i < 16; ++i) o8[64 * i] = pk4_fp8(v[i][0], v[i][1], v[i][2], v[i][3]);
        } else {
        u32x2* o = (u32x2*)(XB + (size_t)m * D) + lane;
#pragma unroll
        for (int i = 0; i < 16; ++i) { u32x2 w; w.x = pk2(v[i][0], v[i][1]); w.y = pk2(v[i][2], v[i][3]); o[64 * i] = w; }
        }
        if (lane == 0) RSTD[m] = rstd;
        if (WITH_F) {
            float mine = 0.f;
#pragma unroll 1
            for (int j = 0; j < 10; ++j) { float s = 0.f;
#pragma unroll
                for (int i = 0; i < 16; ++i) { const u32x2 gp = *(const LAS u32x2*)(gfs + j * D + 256 * i + 4 * lane);
                    s += (v[i][0] * bf_lo(gp.x) + v[i][1] * bf_hi(gp.x)) + (v[i][2] * bf_lo(gp.y) + v[i][3] * bf_hi(gp.y)); }
                s = wave_sum_dpp(s); if (lane == j) mine = s; }
            if (lane < 10) { const int b = m >> 11, s = m & 2047; LOGF[(size_t)(b * 10 + lane) * S + s] = logsig(mine * rstd + bf[lane]); }
        }
    }
}


#define RFL(x) __builtin_amdgcn_readfirstlane(x)
__device__ __forceinline__ void peer_u_phase(const float* SC, const unsigned char* U8, const float* X1, int* EIDG, float* WG, LAS unsigned char* lds, int wave0) {
    FRESH_TID(); FRESH_LDS(lds); FRESH_BID();
    LAS int* s_eid = (LAS int*)(lds + wave * 1024); LAS float* s_w = (LAS float*)(lds + wave * 1024 + 512);
    const int gw = bid * NWAVES + wave, NGW = G * NWAVES;
    const float NEG = -3.0e38f;
    for (int tok = gw; tok < M; tok += NGW) {
        const float* x1 = X1 + (size_t)tok * D;
        float xv[4][16]; float rstd_tok;
        { float ss_ = 0.f;
#pragma unroll
          for (int i = 0; i < 4; ++i)
#pragma unroll
              for (int q = 0; q < 4; ++q) { const f32x4 t = *(const f32x4*)(x1 + 1024 * i + 16 * lane + 4 * q); xv[i][4 * q] = t[0]; xv[i][4 * q + 1] = t[1]; xv[i][4 * q + 2] = t[2]; xv[i][4 * q + 3] = t[3];
                  ss_ += (t[0] * t[0] + t[1] * t[1]) + (t[2] * t[2] + t[3] * t[3]); }
          rstd_tok = rsqrtf(wave_sum_dpp(ss_) * (1.0f / D) + 1e-6f); }
        const float* sc = SC + (size_t)tok * 2048;
        for (int h = 0; h < 8; ++h) {
            const float a0 = sc[h * 256 + lane], a1 = sc[h * 256 + 64 + lane], c0 = sc[h * 256 + 128 + lane], c1 = sc[h * 256 + 192 + lane];
            unsigned ka0 = (ordkey(a0) & ~127u) | (unsigned)(127 - lane), ka1 = (ordkey(a1) & ~127u) | (unsigned)(63 - lane);
            unsigned kc0 = (ordkey(c0) & ~127u) | (unsigned)(127 - lane), kc1 = (ordkey(c1) & ~127u) | (unsigned)(63 - lane);
            float v1 = 0.f, v2 = 0.f; int i1 = 0, i2 = 0;
            for (int it = 0; it < 16; ++it) {
                const unsigned m1 = wave_max_u32(max(ka0, ka1)), m2 = wave_max_u32(max(kc0, kc1));
                const int n1 = 127 - (int)(m1 & 127u), n2 = 127 - (int)(m2 & 127u);
                const float x1lo = __builtin_bit_cast(float, __builtin_amdgcn_readlane(__builtin_bit_cast(int, a0), n1 & 63)), x1hi = __builtin_bit_cast(float, __builtin_amdgcn_readlane(__builtin_bit_cast(int, a1), n1 & 63));
                const float x2lo = __builtin_bit_cast(float, __builtin_amdgcn_readlane(__builtin_bit_cast(int, c0), n2 & 63)), x2hi = __builtin_bit_cast(float, __builtin_amdgcn_readlane(__builtin_bit_cast(int, c1), n2 & 63));
                ka0 = ka0 == m1 ? 0u : ka0; ka1 = ka1 == m1 ? 0u : ka1; kc0 = kc0 == m2 ? 0u : kc0; kc1 = kc1 == m2 ? 0u : kc1;
                if (lane == it) { v1 = (n1 & 64) ? x1hi : x1lo; i1 = n1; v2 = (n2 & 64) ? x2hi : x2lo; i2 = n2; }
            }
            unsigned kd0, kd1, kd2, kd3;
            { const float va = lane_read(v1, lane >> 2); const int pb_ = 255 - 4 * lane;
              kd0 = (ordkey(va + lane_read(v2, (lane & 3) * 4 + 0)) & ~255u) | (unsigned)(pb_); kd1 = (ordkey(va + lane_read(v2, (lane & 3) * 4 + 1)) & ~255u) | (unsigned)(pb_ - 1);
              kd2 = (ordkey(va + lane_read(v2, (lane & 3) * 4 + 2)) & ~255u) | (unsigned)(pb_ - 2); kd3 = (ordkey(va + lane_read(v2, (lane & 3) * 4 + 3)) & ~255u) | (unsigned)(pb_ - 3); }
            float best = 0.f; int be = 0;
            for (int it = 0; it < 16; ++it) {
                const unsigned m = wave_max_u32(max(max(kd0, kd1), max(kd2, kd3)));
                const int pos = 255 - (int)(m & 255u);
                const float bv = __builtin_bit_cast(float, __builtin_amdgcn_readlane(__builtin_bit_cast(int, v1), pos >> 4)) + __builtin_bit_cast(float, __builtin_amdgcn_readlane(__builtin_bit_cast(int, v2), pos & 15));
                const int e = (__builtin_amdgcn_readlane(i1, pos >> 4) << 7) | __builtin_amdgcn_readlane(i2, pos & 15);
                kd0 = kd0 == m ? 0u : kd0; kd1 = kd1 == m ? 0u : kd1; kd2 = kd2 == m ? 0u : kd2; kd3 = kd3 == m ? 0u : kd3;
                if (lane == it) { best = bv; be = e; }
            }
            const float mx = __builtin_bit_cast(float, __builtin_amdgcn_readlane(__builtin_bit_cast(int, best), 0));
            const float p = lane < 16 ? __builtin_amdgcn_exp2f((best - mx) * (1.4426950408889634f * rstd_tok)) : 0.f;
            const float sm = wave_sum_dpp(p);
            if (lane < 16) { s_eid[h * 16 + lane] = be; s_w[h * 16 + lane] = p / sm; }
        }
        LDS_WAIT(); asm volatile("" ::: "memory");
#define LOADROW8(dst, base, e) do { const u32x4* p_ = (const u32x4*)((base) + (size_t)(e) * D) + lane; _Pragma("unroll") for (int i_ = 0; i_ < 4; ++i_) dst[i_] = p_[64 * i_]; } while (0)
        {
            const float rstd = rstd_tok * US_INV;
#define UDOT8(row, j) do { float da_ = 0.f, db_ = 0.f; _Pragma("unroll") for (int i_ = 0; i_ < 4; ++i_) { _Pragma("unroll") for (int k_ = 0; k_ < 4; ++k_) { \
                unsigned w0_ = row[i_][k_]; asm volatile("" : "+v"(w0_));     \
                const f32x2 lo_ = __builtin_amdgcn_cvt_pk_f32_fp8((int)w0_, false), hi_ = __builtin_amdgcn_cvt_pk_f32_fp8((int)w0_, true); \
                da_ = fmaf(xv[i_][4 * k_], lo_[0], da_); db_ = fmaf(xv[i_][4 * k_ + 1], lo_[1], db_); da_ = fmaf(xv[i_][4 * k_ + 2], hi_[0], da_); db_ = fmaf(xv[i_][4 * k_ + 3], hi_[1], db_); } \
                asm volatile("" : "+v"(da_), "+v"(db_)); } \
            const float d_ = wave_sum_dpp(da_ + db_) * rstd; const float ge_ = gelu_erf(d_); if (lane == 0) s_w[j] *= ge_; } while (0)
            u32x4 r0[4], r1[4], r2[4];
            { const int e_ = RFL(s_eid[0]); LOADROW8(r0, U8, e_); } { const int e_ = RFL(s_eid[1]); LOADROW8(r1, U8, e_); } { const int e_ = RFL(s_eid[2]); LOADROW8(r2, U8, e_); }
            for (int j = 0; j < 126; j += 3) {
                UDOT8(r0, j);     if (j + 3 < 128) { const int e_ = RFL(s_eid[j + 3]); LOADROW8(r0, U8, e_); }
                UDOT8(r1, j + 1); if (j + 4 < 128) { const int e_ = RFL(s_eid[j + 4]); LOADROW8(r1, U8, e_); }
                UDOT8(r2, j + 2); if (j + 5 < 128) { const int e_ = RFL(s_eid[j + 5]); LOADROW8(r2, U8, e_); }
            }
            UDOT8(r0, 126); UDOT8(r1, 127);
#undef UDOT8
        }
        LDS_WAIT(); asm volatile("" ::: "memory");
        EIDG[(size_t)tok * 128 + lane] = s_eid[lane]; EIDG[(size_t)tok * 128 + 64 + lane] = s_eid[64 + lane];
        WG[(size_t)tok * 128 + lane] = s_w[lane]; WG[(size_t)tok * 128 + 64 + lane] = s_w[64 + lane];
        LDS_WAIT(); asm volatile("" ::: "memory");
    }
#undef LOADROW8
}

template <bool FINAL>
__device__ __forceinline__ void peer_v_phase(const int* EIDG, const float* WG, const unsigned char* V8, const float* X1, float* XO, const float* fg,
                                             unsigned char* XB8n, float* RSTDn, float* LOGFn, const float* w_in_n, const float* ln1_n, const float* bf_n, LAS unsigned char* lds, int wave0) {
    FRESH_TID(); FRESH_LDS(lds); FRESH_BID();
    LAS int* s_eid = (LAS int*)(lds + 81920 + wave * 1024); LAS float* s_w = (LAS float*)(lds + 81920 + wave * 1024 + 512);
    LAS unsigned short* gfs = (LAS unsigned short*)lds;
    if (!FINAL) {
        __syncthreads();
        for (int c = tid; c < D; c += 512) { const float g = ln1_n[c]; const float* wr = w_in_n + (size_t)c * PW + 12288;
#pragma unroll
            for (int j = 0; j < 10; ++j) gfs[j * D + c] = (unsigned short)f2bf(wr[j] * g); }
        __syncthreads();
    }
    const int gw = bid * NWAVES + wave, NGW = G * NWAVES;
    for (int tok = gw; tok < M; tok += NGW) {
        s_eid[lane] = EIDG[(size_t)tok * 128 + lane]; s_eid[64 + lane] = EIDG[(size_t)tok * 128 + 64 + lane];
        s_w[lane] = WG[(size_t)tok * 128 + lane]; s_w[64 + lane] = WG[(size_t)tok * 128 + 64 + lane];
        LDS_WAIT(); asm volatile("" ::: "memory");
#define LOADROW8(dst, base, e) do { const u32x4* p_ = (const u32x4*)((base) + (size_t)(e) * D) + lane; _Pragma("unroll") for (int i_ = 0; i_ < 4; ++i_) dst[i_] = p_[64 * i_]; } while (0)
        const float* x1 = X1 + (size_t)tok * D; float* xo = XO + (size_t)tok * D;
        {
            float acc[4][16];
#pragma unroll
            for (int i = 0; i < 4; ++i)
#pragma unroll
                for (int k = 0; k < 16; ++k) acc[i][k] = 0.f;
#define VACC8(row, j) do { const float w_ = s_w[j]; _Pragma("unroll") for (int i_ = 0; i_ < 4; ++i_) { _Pragma("unroll") for (int k_ = 0; k_ < 4; ++k_) { \
                unsigned w0_ = row[i_][k_]; asm volatile("" : "+v"(w0_)); \
                const f32x2 lo_ = __builtin_amdgcn_cvt_pk_f32_fp8((int)w0_, false), hi_ = __builtin_amdgcn_cvt_pk_f32_fp8((int)w0_, true); \
                acc[i_][4 * k_] = fmaf(w_, lo_[0], acc[i_][4 * k_]); acc[i_][4 * k_ + 1] = fmaf(w_, lo_[1], acc[i_][4 * k_ + 1]); acc[i_][4 * k_ + 2] = fmaf(w_, hi_[0], acc[i_][4 * k_ + 2]); acc[i_][4 * k_ + 3] = fmaf(w_, hi_[1], acc[i_][4 * k_ + 3]); } \
                asm volatile("" : "+v"(acc[i_][0]), "+v"(acc[i_][1]), "+v"(acc[i_][2]), "+v"(acc[i_][3]), "+v"(acc[i_][4]), "+v"(acc[i_][5]), "+v"(acc[i_][6]), "+v"(acc[i_][7]), \
                                  "+v"(acc[i_][8]), "+v"(acc[i_][9]), "+v"(acc[i_][10]), "+v"(acc[i_][11]), "+v"(acc[i_][12]), "+v"(acc[i_][13]), "+v"(acc[i_][14]), "+v"(acc[i_][15])); } } while (0)
            u32x4 r0[4], r1[4], r2[4];
            { const int e_ = RFL(s_eid[0]); LOADROW8(r0, V8, e_); } { const int e_ = RFL(s_eid[1]); LOADROW8(r1, V8, e_); } { const int e_ = RFL(s_eid[2]); LOADROW8(r2, V8, e_); }
            for (int j = 0; j < 126; j += 3) {
                VACC8(r0, j);     if (j + 3 < 128) { const int e_ = RFL(s_eid[j + 3]); LOADROW8(r0, V8, e_); }
                VACC8(r1, j + 1); if (j + 4 < 128) { const int e_ = RFL(s_eid[j + 4]); LOADROW8(r1, V8, e_); }
                VACC8(r2, j + 2); if (j + 5 < 128) { const int e_ = RFL(s_eid[j + 5]); LOADROW8(r2, V8, e_); }
            }
            VACC8(r0, 126); VACC8(r1, 127);
#undef VACC8
#undef LOADROW8
            float ss = 0.f;
#pragma unroll
            for (int i = 0; i < 4; ++i)
#pragma unroll
                for (int q = 0; q < 4; ++q) { const f32x4 t = *(const f32x4*)(x1 + 1024 * i + 16 * lane + 4 * q);
#pragma unroll
                    for (int k = 0; k < 4; ++k) { acc[i][4 * q + k] = fmaf(acc[i][4 * q + k], VS_INV, t[k]); ss += acc[i][4 * q + k] * acc[i][4 * q + k]; } }
            ss = wave_sum_dpp(ss);
            const float rs = rsqrtf(ss * (1.0f / D) + 1e-6f);
            if (!FINAL) {
#pragma unroll
                for (int i = 0; i < 4; ++i) { u32x4 w8;
#pragma unroll
                    for (int q = 0; q < 4; ++q) w8[q] = pk4_fp8(acc[i][4 * q], acc[i][4 * q + 1], acc[i][4 * q + 2], acc[i][4 * q + 3]);
                    *(u32x4*)(XB8n + (size_t)tok * D + 1024 * i + 16 * lane) = w8; }
                if (lane == 0) RSTDn[tok] = rs;
                float mine = 0.f;
#pragma unroll 1
                for (int j = 0; j < 10; ++j) { float s = 0.f;
#pragma unroll
                    for (int i = 0; i < 4; ++i) { const u32x4 g0 = *(const LAS u32x4*)(gfs + j * D + 1024 * i + 16 * lane), g1 = *(const LAS u32x4*)(gfs + j * D + 1024 * i + 16 * lane + 8);
#pragma unroll
                        for (int q = 0; q < 4; ++q) { s += acc[i][2 * q] * bf_lo(g0[q]) + acc[i][2 * q + 1] * bf_hi(g0[q]); s += acc[i][8 + 2 * q] * bf_lo(g1[q]) + acc[i][8 + 2 * q + 1] * bf_hi(g1[q]); } }
                    s = wave_sum_dpp(s); if (lane == j) mine = s; }
                if (lane < 10) { const int b_ = tok >> 11, s_ = tok & 2047; LOGFn[(size_t)(b_ * 10 + lane) * S + s_] = logsig(mine * rs + bf_n[lane]); }
            }
#pragma unroll
            for (int i = 0; i < 4; ++i)
#pragma unroll
                for (int q = 0; q < 4; ++q) { const int c = 1024 * i + 16 * lane + 4 * q; f32x4 o_;
                    if (FINAL) { const f32x4 g_ = *(const f32x4*)(fg + c); o_ = (f32x4){acc[i][4 * q] * rs * g_[0], acc[i][4 * q + 1] * rs * g_[1], acc[i][4 * q + 2] * rs * g_[2], acc[i][4 * q + 3] * rs * g_[3]}; }
                    else o_ = (f32x4){acc[i][4 * q], acc[i][4 * q + 1], acc[i][4 * q + 2], acc[i][4 * q + 3]};
                    *(f32x4*)(xo + c) = o_; }
        }
        LDS_WAIT(); asm volatile("" ::: "memory");
    }
}
}
namespace at {
using namespace mk;
constexpr int QB = 256, KVB = 64, HD = 128;
constexpr int SHM_V = KVB * HD * 2, SHM_K = KVB * HD * 2;
constexpr int OFF_V = 0, OFF_K = 2 * SHM_V, OFF_WS = OFF_K + 2 * SHM_K, OFF_CUM = OFF_WS + 8 * 256, OFF_RT = OFF_CUM + 2048 * 4, OFF_MISC = OFF_RT + 640 * 4;
constexpr float LOG2E = 1.4426950408889634f;
constexpr float THR2 = 10.0f;
constexpr float SB_DONE = -100.0f;

#define AT_KSWZ(row, colB) ((row) * 256 + ((colB) ^ (((row) & 7) << 4)))
__device__ __forceinline__ int v_st(int k, int c) { const int kk = (k & ~0xC) | ((k & 4) << 1) | ((k & 8) >> 1); return ((kk >> 3) * 4 + (c >> 5)) * 512 + ((kk & 7) * 32 + (c & 31)) * 2; }
__device__ __forceinline__ int v_rd_base(int lane) { return ((lane & 3) << 3) | (((lane >> 2) & 3) << 6) | (((lane >> 4) & 1) << 5) | (((lane >> 5) & 1) << 8); }
constexpr int v_rd_off(int d0, int ks, int half) { return d0 * 512 + ks * 4096 + half * 2048; }
__device__ __forceinline__ int crow(int r, int hi) { return (r & 3) + 8 * (r >> 2) + 4 * hi; }
__device__ __forceinline__ unsigned cvtpk(float lo, float hi) { unsigned r; asm volatile("v_cvt_pk_bf16_f32 %0, %1, %2" : "=v"(r) : "v"(lo), "v"(hi)); return r; }
__device__ __forceinline__ float partner(float v, int hi) { auto rr = __builtin_amdgcn_permlane32_swap(__builtin_bit_cast(unsigned, v), __builtin_bit_cast(unsigned, v), false, false); return __builtin_bit_cast(float, hi ? rr[0] : rr[1]); }

__device__ __forceinline__ float xchg_max(float v, int hi) { return fmaxf(v, partner(v, hi)); }
__device__ __forceinline__ float xchg_sum(float v, int hi) { return v + partner(v, hi); }

__device__ __forceinline__ void pack_p(const f32x16& p0, const f32x16& p1, bf16x8& pa0, bf16x8& pa1, bf16x8& pa2, bf16x8& pa3) {
#define AT_PK4(P, B_, OUT) do { unsigned a0 = cvtpk(P[B_ + 0], P[B_ + 1]), a1 = cvtpk(P[B_ + 2], P[B_ + 3]); unsigned b0 = cvtpk(P[B_ + 4], P[B_ + 5]), b1 = cvtpk(P[B_ + 6], P[B_ + 7]); \
        auto r0 = __builtin_amdgcn_permlane32_swap(a0, b0, false, false); auto r1 = __builtin_amdgcn_permlane32_swap(a1, b1, false, false); \
        u32x4 w = {r0[0], r1[0], r0[1], r1[1]}; OUT = __builtin_bit_cast(bf16x8, w); } while (0)
    AT_PK4(p0, 0, pa0); AT_PK4(p0, 8, pa1); AT_PK4(p1, 0, pa2); AT_PK4(p1, 8, pa3);
#undef AT_PK4
}
template <int KBUF>
__device__ __forceinline__ void qkt(f32x16& p0, f32x16& p1, LAS unsigned char* K_lds, int r32, int hi, const bf16x8 (&qr)[8]) {
    p0 = f32x16{}; p1 = f32x16{};
    LAS unsigned char* kb[4];
#pragma unroll
    for (int dd = 0; dd < 4; ++dd) kb[dd] = K_lds + KBUF * SHM_K + AT_KSWZ(r32, (dd * 16 + hi * 8) * 2);
#pragma unroll
    for (int d0 = 0; d0 < 8; ++d0) { LAS unsigned char* a = kb[d0 & 3] + (d0 >> 2) * 128;
        const bf16x8 b0 = *(const LAS bf16x8*)a; const bf16x8 b1 = *(const LAS bf16x8*)(a + 32 * 256);
        p0 = __builtin_amdgcn_mfma_f32_32x32x16_bf16(b0, qr[d0], p0, 0, 0, 0);
        p1 = __builtin_amdgcn_mfma_f32_32x32x16_bf16(b1, qr[d0], p1, 0, 0, 0); }
}
template <int VBUF>
__device__ __forceinline__ void pv_tile(f32x16 (&o)[4], int vb0, bf16x8 pa0, bf16x8 pa1, bf16x8 pa2, bf16x8 pa3) {
#define AT_TRRD(dst, off) asm volatile("ds_read_b64_tr_b16 %0, %1 offset:%2" : "=&v"(dst) : "v"(vb0), "i"(off) : "memory")
#define AT_PV_D0(d0) do { s16x4 l0, l1, l2, l3, h0, h1, h2, h3; constexpr int b_ = VBUF * SHM_V + v_rd_off(d0, 0, 0); \
        AT_TRRD(l0, b_); AT_TRRD(h0, b_ + 2048); AT_TRRD(l1, b_ + 4096); AT_TRRD(h1, b_ + 6144); AT_TRRD(l2, b_ + 8192); AT_TRRD(h2, b_ + 10240); AT_TRRD(l3, b_ + 12288); AT_TRRD(h3, b_ + 14336); \
        asm volatile("s_waitcnt lgkmcnt(0)" ::: "memory"); __builtin_amdgcn_sched_barrier(0); \
        o[d0] = __builtin_amdgcn_mfma_f32_32x32x16_bf16(pa0, (bf16x8){l0[0], l0[1], l0[2], l0[3], h0[0], h0[1], h0[2], h0[3]}, o[d0], 0, 0, 0); \
        o[d0] = __builtin_amdgcn_mfma_f32_32x32x16_bf16(pa1, (bf16x8){l1[0], l1[1], l1[2], l1[3], h1[0], h1[1], h1[2], h1[3]}, o[d0], 0, 0, 0); \
        o[d0] = __builtin_amdgcn_mfma_f32_32x32x16_bf16(pa2, (bf16x8){l2[0], l2[1], l2[2], l2[3], h2[0], h2[1], h2[2], h2[3]}, o[d0], 0, 0, 0); \
        o[d0] = __builtin_amdgcn_mfma_f32_32x32x16_bf16(pa3, (bf16x8){l3[0], l3[1], l3[2], l3[3], h3[0], h3[1], h3[2], h3[3]}, o[d0], 0, 0, 0); } while (0)
    AT_PV_D0(0); AT_PV_D0(1); AT_PV_D0(2); AT_PV_D0(3);
#undef AT_PV_D0
#undef AT_TRRD
}

template <int VAR>
__device__ __forceinline__ void attn_item(const bf16_t* Qh, const bf16_t* Kh, const bf16_t* Vh, bf16_t* OB, const float* relb, const float* LOGF, int b, int h, int qb, LAS unsigned char* lds, int tid) {
    const int wid = __builtin_amdgcn_readfirstlane(tid >> 6), lane = tid & 63, r32 = lane & 31, hi = lane >> 5;
    const int g = VAR == 0 ? h : (VAR == 1 ? 12 + h : 22 + h);
    const size_t hb = (size_t)(b * NH + g) * S * HD;
    const bf16_t* Kp = Kh + hb; const bf16_t* Vp = Vh + hb;
    LAS unsigned char* V_lds = lds + OFF_V; LAS unsigned char* K_lds = lds + OFF_K;
    LAS float* wsf = (LAS float*)(lds + OFF_WS) + wid * 64; LAS float* li_l = wsf; LAS float* al_l = wsf + 32;
    LAS float* cumL = (LAS float*)(lds + OFF_CUM); LAS float* Rt = (LAS float*)(lds + OFF_RT); volatile LAS unsigned* flags = (volatile LAS unsigned*)(lds + OFF_MISC);
    const int P0 = qb * QB, qlo = P0 + wid * 32, qpos = qlo + r32;
    int NT, jlo = 0;
    if (VAR == 0) { jlo = 4 * qb - 8; if (jlo < 0) jlo = 0; NT = 4 * qb + 4 - jlo; } else NT = 4 * qb + 4;
    const int cw = 4 * qb + (wid >> 1);
#define AT_KBASE(t) (VAR == 1 ? (4 * qb + 3 - (t)) * KVB : (jlo + (t)) * KVB)
#define AT_ACT(t) (VAR == 0 ? ((jlo + (t)) >= cw - 8 && (jlo + (t)) <= cw) : (VAR == 1 ? (AT_KBASE(t) <= qlo + 30) : (AT_KBASE(t) <= qlo + 31)))
    if (VAR == 0) {
        const float* tab = relb + h * 257;
        for (int j = tid; j < 639; j += 512) { int rel = 575 - j; rel = rel < -128 ? -128 : (rel > 128 ? 128 : rel); Rt[j] = tab[rel + 128] * LOG2E; }
    }
    if (VAR == 2) {
        const float* lf = LOGF + (size_t)(b * 10 + h) * S; const int kend = P0 + QB;
        f32x4 v = (f32x4){0.f, 0.f, 0.f, 0.f};
        if (4 * tid < kend) v = *(const f32x4*)(lf + 4 * tid);
        v[1] += v[0]; v[2] += v[1]; v[3] += v[2];
        float tot = v[3];
#pragma unroll
        for (int o = 1; o < 64; o <<= 1) { const float t_ = lane_read(tot, lane >= o ? lane - o : lane); if (lane >= o) tot += t_; }
        if (lane == 63) li_l[0] = tot;
        __syncthreads();
        float base = tot - v[3];
        for (int w = 0; w < wid; ++w) base += ((LAS float*)(lds + OFF_WS))[w * 64];
        if (4 * tid < kend) *(LAS f32x4*)(cumL + 4 * tid) = (f32x4){(base + v[0]) * LOG2E, (base + v[1]) * LOG2E, (base + v[2]) * LOG2E, (base + v[3]) * LOG2E};
    }
    bf16x8 qr[8];
    { const bf16_t* qp = Qh + hb + (size_t)(qlo + r32) * HD + hi * 8;
#pragma unroll
      for (int d0 = 0; d0 < 8; ++d0) qr[d0] = *(const bf16x8*)(qp + d0 * 16); }
    const int sr = tid >> 4, sc = (tid & 15) * 8, vst0 = v_st(sr, sc), vst1 = v_st(32 + sr, sc), kws = AT_KSWZ(sr, sc * 2);
    const int vb0 = (int)(unsigned)(size_t)V_lds + v_rd_base(lane);
    bf16x8 st_k0, st_k1, st_v0, st_v1;
#define AT_SLOAD(k0) do { const bf16_t* kp_ = Kp + (size_t)((k0) + sr) * HD + sc; const bf16_t* vp_ = Vp + (size_t)((k0) + sr) * HD + sc; \
        st_k0 = *(const bf16x8*)kp_; st_k1 = *(const bf16x8*)(kp_ + 32 * HD); st_v0 = *(const bf16x8*)vp_; st_v1 = *(const bf16x8*)(vp_ + 32 * HD); } while (0)
#define AT_SWRITE(bf) do { *(LAS bf16x8*)(K_lds + (bf) * SHM_K + kws) = st_k0; *(LAS bf16x8*)(K_lds + (bf) * SHM_K + kws + 32 * 256) = st_k1; \
        *(LAS bf16x8*)(V_lds + (bf) * SHM_V + vst0) = st_v0; *(LAS bf16x8*)(V_lds + (bf) * SHM_V + vst1) = st_v1; } while (0)
    AT_SLOAD(AT_KBASE(0)); asm volatile("s_waitcnt vmcnt(0)" ::: "memory"); AT_SWRITE(0);
    __syncthreads();
    float m_reg = -1e30f, l_reg = 0.f, carry = 0.f;
    f32x16 o[4] = {};
#define AT_STEP(BUF, t) do { \
        const bool more_ = (t) + 1 < NT; \
        if (more_) AT_SLOAD(AT_KBASE((t) + 1)); \
        if (AT_ACT(t)) { \
            const int kb_ = AT_KBASE(t); f32x16 p0, p1; bf16x8 pa0, pa1, pa2, pa3; \
            qkt<BUF>(p0, p1, K_lds, r32, hi, qr); \
            tile_math(p0, p1, kb_, pa0, pa1, pa2, pa3); \
            pv_tile<BUF>(o, vb0, pa0, pa1, pa2, pa3); \
        } \
        if (more_) { asm volatile("s_waitcnt vmcnt(0)" ::: "memory"); AT_SWRITE((BUF) ^ 1); } \
        if (VAR == 1) { const bool done_ = __all(carry < SB_DONE); if (lane == 0) flags[((t) & 1) * 8 + wid] = done_ ? 1u : 0u; } \
        __syncthreads(); \
    } while (0)
    auto tile_math = [&](f32x16& p0, f32x16& p1, int kb, bf16x8& pa0, bf16x8& pa1, bf16x8& pa2, bf16x8& pa3) __attribute__((always_inline)) {
        const int dq = qpos - kb - 4 * hi;
        if (VAR == 1) {
            const bool need_mask = kb + 63 >= qlo;
            f32x16 n0, n1;
#pragma unroll
            for (int r = 0; r < 16; ++r) { const float z = p0[r]; const float lp = __builtin_amdgcn_logf(1.0f + __builtin_amdgcn_exp2f(-fabsf(z))); n0[r] = fminf(-z, 0.f) - lp;
                                           const float y = p1[r]; const float lq = __builtin_amdgcn_logf(1.0f + __builtin_amdgcn_exp2f(-fabsf(y))); n1[r] = fminf(-y, 0.f) - lq; }
            if (need_mask) {
#pragma unroll
                for (int r = 0; r < 16; ++r) { const int c = (r & 3) + 8 * (r >> 2);
                    if (dq - c <= 0) { n0[r] = 0.f; p0[r] = -__builtin_inff(); }
                    if (dq - c - 32 <= 0) { n1[r] = 0.f; p1[r] = -__builtin_inff(); } }
            }
            float A[8], Bp[8];
#pragma unroll
            for (int q = 0; q < 4; ++q) { A[q] = (n0[4 * q] + n0[4 * q + 1]) + (n0[4 * q + 2] + n0[4 * q + 3]); A[4 + q] = (n1[4 * q] + n1[4 * q + 1]) + (n1[4 * q + 2] + n1[4 * q + 3]); }
#pragma unroll
            for (int q = 0; q < 8; ++q) Bp[q] = partner(A[q], hi);
            float st = 0.f;
#pragma unroll
            for (int q = 7; q >= 0; --q) {
                const float after = carry + st + (hi == 0 ? Bp[q] : 0.f);
                if (q >= 4) { const int r0 = 4 * (q - 4);
                    float tl = after; p1[r0 + 3] = __builtin_amdgcn_exp2f(p1[r0 + 3] + n1[r0 + 3] + tl); tl += n1[r0 + 3]; p1[r0 + 2] = __builtin_amdgcn_exp2f(p1[r0 + 2] + n1[r0 + 2] + tl); tl += n1[r0 + 2];
                    p1[r0 + 1] = __builtin_amdgcn_exp2f(p1[r0 + 1] + n1[r0 + 1] + tl); tl += n1[r0 + 1]; p1[r0] = __builtin_amdgcn_exp2f(p1[r0] + n1[r0] + tl); }
                else { const int r0 = 4 * q;
                    float tl = after; p0[r0 + 3] = __builtin_amdgcn_exp2f(p0[r0 + 3] + n0[r0 + 3] + tl); tl += n0[r0 + 3]; p0[r0 + 2] = __builtin_amdgcn_exp2f(p0[r0 + 2] + n0[r0 + 2] + tl); tl += n0[r0 + 2];
                    p0[r0 + 1] = __builtin_amdgcn_exp2f(p0[r0 + 1] + n0[r0 + 1] + tl); tl += n0[r0 + 1]; p0[r0] = __builtin_amdgcn_exp2f(p0[r0] + n0[r0] + tl); }
                st += A[q] + Bp[q];
            }
            carry += st;
            pack_p(p0, p1, pa0, pa1, pa2, pa3);
        } else {
            if (VAR == 0) {
                const LAS float* rp = Rt + (575 - (qpos - kb) + 4 * hi);
#pragma unroll
                for (int r = 0; r < 16; ++r) { const int c = (r & 3) + 8 * (r >> 2); p0[r] += rp[c]; p1[r] += rp[c + 32]; }
            } else {
                const LAS float* cp = cumL + kb + 4 * hi;
#pragma unroll
                for (int q = 0; q < 4; ++q) { const f32x4 c0 = *(const LAS f32x4*)(cp + 8 * q), c1 = *(const LAS f32x4*)(cp + 32 + 8 * q);
                    p0[4 * q] -= c0[0]; p0[4 * q + 1] -= c0[1]; p0[4 * q + 2] -= c0[2]; p0[4 * q + 3] -= c0[3];
                    p1[4 * q] -= c1[0]; p1[4 * q + 1] -= c1[1]; p1[4 * q + 2] -= c1[2]; p1[4 * q + 3] -= c1[3]; }
                if (kb + 63 > qlo) {
#pragma unroll
                    for (int r = 0; r < 16; ++r) { const int c = (r & 3) + 8 * (r >> 2);
                        if (dq - c < 0) p0[r] = -__builtin_inff();
                        if (dq - c - 32 < 0) p1[r] = -__builtin_inff(); }
                }
            }
            float pmax = p0[0];
#pragma unroll
            for (int r = 1; r < 16; ++r) pmax = fmaxf(pmax, p0[r]);
#pragma unroll
            for (int r = 0; r < 16; ++r) pmax = fmaxf(pmax, p1[r]);
            pmax = xchg_max(pmax, hi);
            float mn, alpha;
            if (__all(pmax - m_reg <= THR2)) { mn = m_reg; alpha = 1.f; }
            else { mn = fmaxf(m_reg, pmax); alpha = __builtin_amdgcn_exp2f(m_reg - mn); m_reg = mn; }
            float ps = 0.f;
#pragma unroll
            for (int r = 0; r < 16; ++r) { p0[r] = __builtin_amdgcn_exp2f(p0[r] - mn); p1[r] = __builtin_amdgcn_exp2f(p1[r] - mn); ps += p0[r] + p1[r]; }
            ps = xchg_sum(ps, hi);
            l_reg = l_reg * alpha + ps;
            if (__any(alpha < 1.f)) {
                if (hi == 0) al_l[r32] = alpha;
                asm volatile("s_waitcnt lgkmcnt(0)" ::: "memory");
                float av[16];
#pragma unroll
                for (int r = 0; r < 16; ++r) av[r] = al_l[crow(r, hi)];
#pragma unroll
                for (int d = 0; d < 4; ++d)
#pragma unroll
                    for (int r = 0; r < 16; ++r) o[d][r] *= av[r];
            }
            pack_p(p0, p1, pa0, pa1, pa2, pa3);
        }
    };
    for (int t = 0; t < NT; t += 2) {
        AT_STEP(0, t);
        if (VAR == 1) { unsigned all_ = 1u; for (int w = 0; w < 8; ++w) all_ &= flags[(t & 1) * 8 + w]; if (all_) break; }
        if (t + 1 >= NT) break;
        AT_STEP(1, t + 1);
        if (VAR == 1) { unsigned all_ = 1u; for (int w = 0; w < 8; ++w) all_ &= flags[((t + 1) & 1) * 8 + w]; if (all_) break; }
    }
    float rli[16];
    if (VAR != 1) {
        if (hi == 0) li_l[r32] = l_reg;
        asm volatile("s_waitcnt lgkmcnt(0)" ::: "memory");
#pragma unroll
        for (int r = 0; r < 16; ++r) rli[r] = __builtin_amdgcn_rcpf(li_l[crow(r, hi)]);
    }
    unsigned char* Ow8 = (unsigned char*)OB + (size_t)(b * S + qlo) * D + g * HD;
#pragma unroll
    for (int r = 0; r < 16; ++r) { const int orow = crow(r, hi);
#pragma unroll
        for (int d0 = 0; d0 < 4; ++d0) { const float v = VAR != 1 ? o[d0][r] * rli[r] : o[d0][r];
            const float vn = lane_read(v, lane ^ 1);
            if ((r32 & 1) == 0) *(unsigned short*)(Ow8 + (size_t)orow * D + d0 * 32 + r32) = (unsigned short)__builtin_amdgcn_cvt_pk_fp8_f32(clamp8(v * 16.0f), clamp8(vn * 16.0f), 0, false); } }
    __syncthreads();
#undef AT_STEP
#undef AT_SLOAD
#undef AT_SWRITE
#undef AT_KBASE
#undef AT_ACT
}

template <int VAR>
__device__ __forceinline__ void attn_queue(const bf16_t* Qh, const bf16_t* Kh, const bf16_t* Vh, bf16_t* OB, const float* relb, const float* LOGF, unsigned* qhead, LAS unsigned char* lds, int wave0) {
    FRESH_TID(); FRESH_LDS(lds);
    volatile LAS unsigned* qslot = (volatile LAS unsigned*)(lds + OFF_MISC) + 32;
    constexpr int NHV = VAR == 0 ? 12 : 10, NITEMS = 8 * NHV * 8;
    for (;;) {
        if (tid == 0) qslot[0] = __hip_atomic_fetch_add(qhead, 1u, __ATOMIC_RELAXED, __HIP_MEMORY_SCOPE_AGENT);
        __syncthreads();
        const int idx = (int)qslot[0];
        __syncthreads();
        if (idx >= NITEMS) break;
        const int qb = 7 - idx / (8 * NHV), bh = idx % (8 * NHV);
        attn_item<VAR>(Qh, Kh, Vh, OB, relb, LOGF, bh / NHV, bh % NHV, qb, lds, tid);
    }
}
__device__ __forceinline__ void attn_phase(const bf16_t* Qh, const bf16_t* Kh, const bf16_t* Vh, bf16_t* OB, const float* relb, const float* LOGF, unsigned* qheads, LAS unsigned char* lds, int wave0) {
    attn_queue<2>(Qh, Kh, Vh, OB, relb, LOGF, qheads + 0, lds, wave0);
    attn_queue<0>(Qh, Kh, Vh, OB, relb, LOGF, qheads + 64, lds, wave0);
    attn_queue<1>(Qh, Kh, Vh, OB, relb, LOGF, qheads + 128, lds, wave0);
}
}
namespace mk {
#define XB_TMO      128
#define XB_XCNT(j)  (256  + 64 * (j))
#define XB_XSUB(j)  (1280 + 64 * (j))
#define XB_XGEN(j)  (2304 + 64 * (j))
#define XB_TOP      3328
#define XB_TOPGEN   3392
#define XCD_BAR_WORDS 3456
#define XB_SPIN_CAP (1u << 22)

__device__ __forceinline__ unsigned xb_ld(unsigned* p)              { return __hip_atomic_load(p, __ATOMIC_RELAXED, __HIP_MEMORY_SCOPE_AGENT); }
__device__ __forceinline__ unsigned xb_add(unsigned* p, unsigned v) { return __hip_atomic_fetch_add(p, v, __ATOMIC_RELAXED, __HIP_MEMORY_SCOPE_AGENT); }
__device__ __forceinline__ unsigned xb_xcc_id() { return (unsigned)__builtin_amdgcn_s_getreg((3 << 11) | 20) & 0xFu; }
#define XB_SPIN(cond, bar) do { unsigned _sp = 0; while (cond) { __builtin_amdgcn_s_sleep(1); \
    if ((++_sp & 255u) == 0u) { if (xb_ld(&(bar)[XB_TMO])) break; if (_sp > XB_SPIN_CAP) { atomicAdd(&(bar)[XB_TMO], 1u); break; } } } } while (0)

struct XcdBarrier {
    unsigned* bar; unsigned x;
    volatile LAS unsigned* st;
};

__device__ __forceinline__ XcdBarrier xcd_barrier_post(unsigned* bar, volatile LAS unsigned* st, bool is_t0) {
    XcdBarrier b; b.bar = bar; b.x = xb_xcc_id(); b.st = st;
    if (is_t0) (void)xb_add(&bar[XB_XCNT(b.x)], 1u);
    return b;
}
__device__ __forceinline__ void xcd_barrier_complete(unsigned* bar, unsigned x, unsigned& nloc, unsigned& nx) {
    const unsigned G = gridDim.x * gridDim.y * gridDim.z;
    unsigned sum, cnt, mine, sp = 0u;
    for (;;) {
        sum = 0u; cnt = 0u; mine = 0u;
#pragma unroll
        for (unsigned j = 0; j < 16; ++j) { const unsigned c = xb_ld(&bar[XB_XCNT(j)]); sum += c; cnt += (c > 0u) ? 1u : 0u; mine = (j == x) ? c : mine; }
        if (sum == G) break;
        __builtin_amdgcn_s_sleep(1);
        if ((++sp & 255u) == 0u) { if (xb_ld(&bar[XB_TMO])) break; if (sp > XB_SPIN_CAP) { atomicAdd(&bar[XB_TMO], 1u); break; } }
    }
    nloc = mine > 0u ? mine : 1u; nx = cnt > 0u ? cnt : 1u;
}

__device__ __forceinline__ void xcd_barrier(const XcdBarrier& b, bool is_t0) {
    asm volatile("s_waitcnt vmcnt(0)" ::: "memory");
    __syncthreads();
    if (is_t0) {
        unsigned* bar = b.bar;
        __builtin_amdgcn_s_waitcnt(0);
        unsigned nloc = b.st[0], nx = b.st[1];
        if (nloc == 0u) { xcd_barrier_complete(bar, b.x, nloc, nx); b.st[0] = nloc; b.st[1] = nx; }
        const unsigned old = xb_add(&bar[XB_XSUB(b.x)], 1u);
        const unsigned gen = old / nloc;
        if (old + 1u == (gen + 1u) * nloc) {
            __builtin_amdgcn_fence(__ATOMIC_RELEASE, "agent");
            asm volatile("s_waitcnt vmcnt(0)" ::: "memory");
            const unsigned og = xb_add(&bar[XB_TOP], 1u);
            const unsigned tg = og / nx;
            if (og + 1u == (tg + 1u) * nx) xb_add(&bar[XB_TOPGEN], 1u);
            else XB_SPIN(xb_ld(&bar[XB_TOPGEN]) == tg, bar);
            __builtin_amdgcn_fence(__ATOMIC_ACQUIRE, "agent");
            xb_add(&bar[XB_XGEN(b.x)], 1u);
            asm volatile("s_waitcnt vmcnt(0)" ::: "memory");
        } else {
            XB_SPIN(xb_ld(&bar[XB_XGEN(b.x)]) == gen, bar);
            __builtin_amdgcn_fence(__ATOMIC_ACQUIRE, "agent");
            asm volatile("s_waitcnt vmcnt(0)" ::: "memory");
        }
    }
    __syncthreads();
}

constexpr int PH_PER_LAYER = 8;
typedef const __attribute__((address_space(4))) Args* KArgs;
#define KARGS() ({ KArgs p_ = (KArgs)__builtin_amdgcn_kernarg_segment_ptr(); asm volatile("" : "+s"(p_)); p_; })
#define GRID_BAR() do { KArgs k_ = KARGS(); XcdBarrier b_; b_.bar = (unsigned*)(k_->ws + WS_CTL) + CW_BAR; b_.x = xb_xcc_id(); b_.st = (volatile LAS unsigned*)(lds + MISC_OFF) + 8; unsigned z_ = 0u; asm volatile("" : "+v"(z_)); const bool t0_ = (wave0 == 0) && (__builtin_amdgcn_mbcnt_hi(~0u, __builtin_amdgcn_mbcnt_lo(~0u, z_)) == 0u);     xcd_barrier(b_, t0_); } while (0)
__global__ void __launch_bounds__(NWAVES * 64, 2) mk_fwd(Args a_unused) {
    extern __shared__ __attribute__((aligned(16))) unsigned char lds_raw[];
    LAS unsigned char* lds = (LAS unsigned char*)lds_raw;
    const int wave0 = __builtin_amdgcn_readfirstlane((int)threadIdx.x >> 6);
    for (int u = threadIdx.x; u < (LDS_BYTES - LDSCTL_OFF) / 4; u += NWAVES * 64) ((LAS unsigned*)(lds + LDSCTL_OFF))[u] = 0u;
    __syncthreads();
    int lo, hi;
    { KArgs k = KARGS(); lo = k->ph_lo; hi = k->ph_hi;
      if (hi - lo > 1) (void)xcd_barrier_post((unsigned*)(k->ws + WS_CTL) + CW_BAR, (volatile LAS unsigned*)(lds + MISC_OFF) + 8, threadIdx.x == 0); }
#define IN(k) (lo <= (k) && (k) < hi)
#define BOTH(k) (IN(k) && IN((k) + 1))
#pragma unroll
    for (int l = 0; l < 2; ++l) {
        const int pb = PH_PER_LAYER * l;
        if (IN(pb + 0)) { KArgs k = KARGS(); conv_phase(k, l, lds, wave0); }
        if (IN(pb + 1) && l == 0) {
            KArgs k = KARGS(); unsigned char* ws = k->ws;
            const float* xin = k->in[0];
            prep_phase<true>(xin, (bf16_t*)(ws + WS_XB), (float*)(ws + WS_RSTD), k->in[2] + (size_t)l * D * PW, k->in[1] + (size_t)l * D, k->in[3] + l * 10, (float*)(ws + WS_LOGF), lds, wave0);
            if (BOTH(pb + 1)) GRID_BAR();
        }
        if (l == 1 && IN(pb + 0) && IN(pb + 2)) GRID_BAR();
        if (IN(pb + 2)) {
            KArgs k = KARGS(); unsigned char* ws = k->ws;
            pg8::Gemm g{(const bf16_t*)(ws + WS_XB), (const bf16_t*)(ws + WS_WIN), M, 12288, D}; pg8::StaticOrder So; FRESH_BID(); So.init(M, 12288, G, bid);
            pg8::EpiQKV4 E{(bf16_t*)(ws + WS_Q), (const float*)(ws + WS_RSTD), 0.08838834764831845f * 1.4426950408889634f, US_INV};
            { LAS unsigned char* lds_ = lds; FRESH_LDS(lds_); FRESH_TID(); pg8::gemm_phase<pg8::EpiQKV4, pg8::StaticOrder, true, true, true>(lds_, g, So, E, tid); }
            if (BOTH(pb + 2)) GRID_BAR();
        }
        if (IN(pb + 3)) {
            KArgs k = KARGS(); unsigned char* ws = k->ws;
            at::attn_phase((const bf16_t*)(ws + WS_Q), (const bf16_t*)(ws + WS_K), (const bf16_t*)(ws + WS_V), (bf16_t*)(ws + WS_OB), k->in[4] + (size_t)l * 12 * 257, (const float*)(ws + WS_LOGF),
                           (unsigned*)(ws + WS_CTL) + CW_QUEUE + 256 * l, lds, wave0);
            if (BOTH(pb + 3)) GRID_BAR();
        }
        if (IN(pb + 4)) {
            KArgs k = KARGS(); unsigned char* ws = k->ws;
            const float* xin = l == 0 ? k->in[0] : (const float*)(ws + WS_X2);
            pg8::Gemm g{(const bf16_t*)(ws + WS_OB), (const bf16_t*)(ws + WS_WOUT), M, D, D}; pg8::StaticOrder So; FRESH_BID(); So.init(M, D, G, bid);
            pg8::EpiResidF32 E{xin, k->out, US_INV * (1.0f / 16.0f), (bf16_t*)(ws + WS_XB)};
            { LAS unsigned char* lds_ = lds; FRESH_LDS(lds_); FRESH_TID(); pg8::gemm_phase<pg8::EpiResidF32, pg8::StaticOrder, false, true, true>(lds_, g, So, E, tid); }
            if (BOTH(pb + 4)) GRID_BAR();
        }
        if (IN(pb + 5)) {
            KArgs k = KARGS(); unsigned char* ws = k->ws;
            pg8::Gemm g{(const bf16_t*)(ws + WS_XB), (const bf16_t*)(ws + WS_WQK), M, 2048, D}; pg8::StaticOrder So; FRESH_BID(); So.init(M, 2048, G, bid);
            pg8::EpiPlainF32<2048> E{(float*)(ws + WS_SC)};
            { LAS unsigned char* lds_ = lds; FRESH_LDS(lds_); FRESH_TID(); pg8::gemm_phase<pg8::EpiPlainF32<2048>, pg8::StaticOrder, true, true>(lds_, g, So, E, tid); }
            if (BOTH(pb + 5)) GRID_BAR();
        }
        if (IN(pb + 6)) {
            KArgs k = KARGS(); unsigned char* ws = k->ws;
            peer_u_phase((const float*)(ws + WS_SC), (const unsigned char*)(ws + WS_U16), k->out, (int*)(ws + WS_K), (float*)(ws + WS_K + 8 * MiB), lds, wave0);
            if (BOTH(pb + 6)) GRID_BAR();
        }
        if (IN(pb + 7)) {
            KArgs k = KARGS(); unsigned char* ws = k->ws;
            if (l == 0) peer_v_phase<false>((const int*)(ws + WS_K), (const float*)(ws + WS_K + 8 * MiB), (const unsigned char*)(ws + WS_U16) + (size_t)NE * D, k->out, (float*)(ws + WS_X2), nullptr,
                                            ws + WS_XB, (float*)(ws + WS_RSTD), (float*)(ws + WS_LOGF), k->in[2] + (size_t)D * PW, k->in[1] + D, k->in[3] + 10, lds, wave0);
            else peer_v_phase<true>((const int*)(ws + WS_K), (const float*)(ws + WS_K + 8 * MiB), (const unsigned char*)(ws + WS_U16) + (size_t)NE * D, k->out, k->out, k->in[12],
                                    nullptr, nullptr, nullptr, nullptr, nullptr, nullptr, lds, wave0);
            if (BOTH(pb + 7)) GRID_BAR();
        }
    }
#undef IN
#undef BOTH
}

static int g_grid = 0;
static void launch_phases(Args a, int lo, int hi, hipStream_t st) {
    a.ph_lo = lo; a.ph_hi = hi;
    hipLaunchKernelGGL(mk_fwd, dim3(g_grid), dim3(NWAVES * 64), LDS_BYTES, st, a);
}
}

extern "C" void kernel_launch(void* const* d_in, const int* in_sizes, int n_in, void* d_out, int out_size, void* d_ws, size_t ws_size, hipStream_t stream) {
    (void)in_sizes; (void)n_in; (void)out_size;
    using namespace mk;
    if (g_grid == 0) {
        if (ws_size < 2048 * MiB) { fprintf(stderr, "kernel_launch: workspace too small (%zu)\n", ws_size); g_grid = -1; return; }
        if (hipFuncSetAttribute((const void*)mk_fwd, hipFuncAttributeMaxDynamicSharedMemorySize, LDS_BYTES) != hipSuccess) { fprintf(stderr, "kernel_launch: hipFuncSetAttribute failed\n"); g_grid = -1; return; }
        int dev = 0, cus = 0; (void)hipGetDevice(&dev); (void)hipDeviceGetAttribute(&cus, hipDeviceAttributeMultiprocessorCount, dev);
        g_grid = cus > 0 ? cus : 256;
    }
    if (g_grid < 0) return;
    unsigned char* ws = (unsigned char*)d_ws; float* out = (float*)d_out;
    (void)hipMemsetAsync(ws + WS_CTL, 0, CTL_ZERO_BYTES, stream);
    Args a{};
    for (int i = 0; i < 13; ++i) a.in[i] = (const float*)d_in[i];
    a.out = out; a.ws = ws;
    launch_phases(a, 0, 2 * PH_PER_LAYER, stream);
}
```

```cpp
#include <hip/hip_runtime.h>
#include <cstdio>
#include <cstdint>
namespace pg8 {
#define PG8_LAS __attribute__((address_space(3)))
typedef unsigned short bf16_t;
typedef short bf16x8 __attribute__((ext_vector_type(8)));
typedef float f32x4 __attribute__((ext_vector_type(4)));
typedef unsigned u32x4 __attribute__((ext_vector_type(4)));
typedef unsigned u32x2 __attribute__((ext_vector_type(2)));
constexpr int BM = 256, BK = 64, HALF = 128, HTB = HALF * BK * 2  , STAGE_BYTES = 8 * HTB, NXCD = 8, WGM = 8;

__host__ __device__ __forceinline__ int lds_byte(int r, int c) { const int st = (r >> 4) * 2 + (c >> 5), rr = r & 15, cc = c & 31, ob = rr * 64 + cc * 2; return st * 1024 + (ob ^ (((ob >> 9) & 1) << 5)); }
__host__ __device__ __forceinline__ void stage_rc(int b, int& R, int& C) { const int st = b / 1024, sb = b % 1024, swz = sb ^ (((sb >> 9) & 1) << 5); R = (st >> 1) * 16 + swz / 64; C = (st & 1) * 32 + (swz % 64) / 2; }
__host__ __device__ __forceinline__ int perm32(int rho) { const int n = rho >> 4, i = rho & 15; return 8 * (i >> 2) + 4 * n + (i & 3); }

struct Unit { int pm, pn; };
struct Gemm { const bf16_t* A; const bf16_t* Bt; int M, N, K; };

struct StaticOrder {
    int nM, nN, nwg, G, c;
    __host__ __device__ void init(int M, int N, int G_, int c_) { nM = M / BM; nN = N / BM; nwg = nM * nN; G = G_; c = c_; }
    __host__ __device__ bool next(int i, Unit& u) const {
        const long L = (long)i * G + c; if (L >= nwg) return false;
        int wgid = (int)L; { const int q = nwg / NXCD, r = nwg % NXCD, xcd = wgid % NXCD, off = wgid / NXCD; wgid = (xcd < r ? xcd * (q + 1) : r * (q + 1) + (xcd - r) * q) + off; }
        const int nig = WGM * nN, gid = wgid / nig, fm = gid * WGM, gsz = (nM - fm) < WGM ? (nM - fm) : WGM;
        u.pm = fm + ((wgid % nig) % gsz); u.pn = (wgid % nig) / gsz; return true;
    }
    __device__ __forceinline__ void a_ready(const Unit&) const {}
    __device__ __forceinline__ void done(const Unit&) const {}
};
__device__ __forceinline__ unsigned cvt_pk_bf16(float lo, float hi) { unsigned r; asm volatile("v_cvt_pk_bf16_f32 %0, %1, %2" : "=v"(r) : "v"(lo), "v"(hi)); return r; }
typedef float f32x2 __attribute__((ext_vector_type(2)));
__device__ __forceinline__ f32x2 gelu_pk(f32x2 v) {
    const f32x2 av = __builtin_elementwise_abs(v), d = av * 0.2316418882f + 1.0f;
    f32x2 t; t.x = __builtin_amdgcn_rcpf(d.x); t.y = __builtin_amdgcn_rcpf(d.y);
    f32x2 q = t * 0.5307027145f + (-0.7265760135f); q = q * t + 0.7107068705f; q = q * t + (-0.142248368f); q = q * t + 0.127414796f; q = q * t;
    const f32x2 s = (v * v) * (-0.72134752044f);
    f32x2 e; e.x = __builtin_amdgcn_exp2f(s.x); e.y = __builtin_amdgcn_exp2f(s.y);
    const f32x2 m = v * (q * e), r = v - m;
    f32x2 o; o.x = v.x < 0.f ? m.x : r.x; o.y = v.y < 0.f ? m.y : r.y; return o;
}
#define EPI_FRESH_LANE() { unsigned z_ = 0u; asm volatile("" : "+v"(z_)); const int l_ = (int)__builtin_amdgcn_mbcnt_hi(~0u, __builtin_amdgcn_mbcnt_lo(~0u, z_)); fr = l_ & 15; fq = l_ >> 4; }
typedef __amdgpu_buffer_rsrc_t rsrc_t;
__device__ __forceinline__ rsrc_t mkrsrc(const void* p, unsigned bytes) { return __builtin_amdgcn_make_buffer_rsrc((void*)p, (short)0, (int)bytes, 0x00020000); }
template <int LDC> struct EpiPlainF32 {
    static constexpr bool PERM = false, AFTER_DRAIN = false;
    float* C;
    __device__ __forceinline__ void operator()(const f32x4 (&acc)[2][2][4][2], const Unit& u, int wr, int wc, int fr, int fq) const {
        EPI_FRESH_LANE();
        const rsrc_t rc = mkrsrc(C, 16384u * LDC * 4u);
        const int vo = ((wr * 64 + fr) * LDC + wc * 32 + 4 * fq) * 4, so = (u.pm * BM * LDC + u.pn * BM) * 4;
#pragma unroll
        for (int ai = 0; ai < 2; ++ai)
#pragma unroll
            for (int m = 0; m < 4; ++m)
#pragma unroll
                for (int bj = 0; bj < 2; ++bj)
#pragma unroll
                    for (int n = 0; n < 2; ++n) __builtin_amdgcn_raw_buffer_store_b128(__builtin_bit_cast(u32x4, acc[ai][bj][m][n]), rc, vo, so + ((ai * HALF + m * 16) * LDC + bj * HALF + n * 16) * 4, 0);
    }
};
template <int LDC> struct EpiRowScaleF32 {
    static constexpr bool PERM = false, AFTER_DRAIN = false;
    float* C; const float* rs;
    __device__ __forceinline__ void operator()(const f32x4 (&acc)[2][2][4][2], const Unit& u, int wr, int wc, int fr, int fq) const {
        const rsrc_t rc = mkrsrc(C, 16384u * LDC * 4u), rr = mkrsrc(rs, 16384u * 4u);
        const int vo = ((wr * 64 + fr) * LDC + wc * 32 + 4 * fq) * 4, vr = (wr * 64 + fr) * 4;
        const int so = (u.pm * BM * LDC + u.pn * BM) * 4, sr = u.pm * BM * 4;
#pragma unroll
        for (int ai = 0; ai < 2; ++ai)
#pragma unroll
            for (int m = 0; m < 4; ++m) { const float s = __builtin_bit_cast(float, __builtin_amdgcn_raw_buffer_load_b32(rr, vr, sr + (ai * HALF + m * 16) * 4, 0));
#pragma unroll
                for (int bj = 0; bj < 2; ++bj)
#pragma unroll
                    for (int n = 0; n < 2; ++n) { const f32x4 v = acc[ai][bj][m][n] * s; __builtin_amdgcn_raw_buffer_store_b128(__builtin_bit_cast(u32x4, v), rc, vo, so + ((ai * HALF + m * 16) * LDC + bj * HALF + n * 16) * 4, 0); } }
    }
};
template <bool BASE_F32> struct EpiResidB16 {
    static constexpr bool PERM = false, AFTER_DRAIN = false;
    const void* base; float ascale; bf16_t* xb;
    __device__ __forceinline__ void operator()(const f32x4 (&acc)[2][2][4][2], const Unit& u, int wr, int wc, int fr, int fq) const {
        EPI_FRESH_LANE();
        constexpr int LDC = 4096;
        const rsrc_t rb = mkrsrc(base, 16384u * LDC * (BASE_F32 ? 4u : 2u)), rx = mkrsrc(xb, 16384u * LDC * 2u);
        const int vo = ((wr * 64 + fr) * LDC + wc * 32 + 4 * fq) * 2;
        const int so = (u.pm * BM * LDC + u.pn * BM) * 2;
        f32x4 ra[2][2], rb2[2][2];
#define EPI_LD(dst, g_) do { _Pragma("unroll") for (int bj = 0; bj < 2; ++bj) _Pragma("unroll") for (int n = 0; n < 2; ++n) { \
            const int o = so + ((((g_) >> 2) * HALF + ((g_) & 3) * 16) * LDC + bj * HALF + n * 16) * 2; \
            if constexpr (BASE_F32) dst[bj][n] = __builtin_bit_cast(f32x4, __builtin_amdgcn_raw_buffer_load_b128(rb, vo * 2, o * 2, 0)); \
            else { const u32x2 t_ = __builtin_amdgcn_raw_buffer_load_b64(rb, vo, o, 0); dst[bj][n] = (f32x4){__builtin_bit_cast(float, t_.x << 16), __builtin_bit_cast(float, t_.x & 0xffff0000u), __builtin_bit_cast(float, t_.y << 16), __builtin_bit_cast(float, t_.y & 0xffff0000u)}; } } } while (0)
#define EPI_ST(src, g_) do { _Pragma("unroll") for (int bj = 0; bj < 2; ++bj) _Pragma("unroll") for (int n = 0; n < 2; ++n) { \
            const int o = so + ((((g_) >> 2) * HALF + ((g_) & 3) * 16) * LDC + bj * HALF + n * 16) * 2; \
            const f32x4 v = src[bj][n] + acc[(g_) >> 2][bj][(g_) & 3][n] * ascale; \
            u32x2 w; w.x = cvt_pk_bf16(v[0], v[1]); w.y = cvt_pk_bf16(v[2], v[3]); __builtin_amdgcn_raw_buffer_store_b64(w, rx, vo, o, 0); } } while (0)
        EPI_LD(ra, 0);
        EPI_LD(rb2, 1); EPI_ST(ra, 0);
        EPI_LD(ra, 2); EPI_ST(rb2, 1);
        EPI_LD(rb2, 3); EPI_ST(ra, 2);
        EPI_LD(ra, 4); EPI_ST(rb2, 3);
        EPI_LD(rb2, 5); EPI_ST(ra, 4);
        EPI_LD(ra, 6); EPI_ST(rb2, 5);
        EPI_LD(rb2, 7); EPI_ST(ra, 6);
        EPI_ST(rb2, 7);
#undef EPI_LD
#undef EPI_ST
    }
};
struct EpiQKV {
    static constexpr bool PERM = true, AFTER_DRAIN = false;
    bf16_t* Q; const float* rs; float qscale;
    __device__ __forceinline__ void operator()(const f32x4 (&acc)[2][2][4][2], const Unit& u, int wr, int wc, int fr, int fq) const {
        const rsrc_t rq = mkrsrc(Q, 3u * 16384u * 4096u * 2u), rr = mkrsrc(rs, 16384u * 4u);
        const int colt = u.pn * BM, which = colt >> 12, cw = colt & 4095, gt = cw >> 7;
        const int b = (u.pm * BM) >> 11, st = (u.pm * BM) & 2047;
        const float sc = which == 0 ? qscale : 1.f;
        const int so = (int)(((unsigned)which << 26) + (((unsigned)(b * 32 + gt) * 2048u + (unsigned)st) << 7)) * 2;
        const int vo = (((wr * 64 + fr) << 7) + wc * 32 + 8 * fq) * 2, vr = (wr * 64 + fr) * 4, sr = u.pm * BM * 4;
#pragma unroll
        for (int ai = 0; ai < 2; ++ai)
#pragma unroll
            for (int m = 0; m < 4; ++m) { const float f = sc * __builtin_bit_cast(float, __builtin_amdgcn_raw_buffer_load_b32(rr, vr, sr + (ai * HALF + m * 16) * 4, 0));
#pragma unroll
                for (int bj = 0; bj < 2; ++bj) {
                    const f32x4 v0 = acc[ai][bj][m][0] * f, v1 = acc[ai][bj][m][1] * f;
                    u32x4 w; w.x = cvt_pk_bf16(v0[0], v0[1]); w.y = cvt_pk_bf16(v0[2], v0[3]); w.z = cvt_pk_bf16(v1[0], v1[1]); w.w = cvt_pk_bf16(v1[2], v1[3]);
                    __builtin_amdgcn_raw_buffer_store_b128(w, rq, vo, so + ((bj * 2048 + ai * HALF + m * 16) << 7) * 2, 0); } }
    }
};

struct EpiQKV4 {
    static constexpr bool PERM = false, AFTER_DRAIN = false;
    bf16_t* Q; const float* rs; float qscale, wscale;
    __device__ __forceinline__ void operator()(const f32x4 (&acc)[2][2][4][2], const Unit& u, int wr, int wc, int fr, int fq) const {
        EPI_FRESH_LANE();
        const rsrc_t rq = mkrsrc(Q, 3u * 16384u * 4096u * 2u), rr = mkrsrc(rs, 16384u * 4u);
        const int colt = u.pn * BM, which = colt >> 12, cw = colt & 4095, gt = cw >> 7;
        const int b = (u.pm * BM) >> 11, st = (u.pm * BM) & 2047;
        const float sc = (which == 0 ? qscale : 1.f) * wscale;
        const int so = (int)(((unsigned)which << 26) + (((unsigned)(b * 32 + gt) * 2048u + (unsigned)st) << 7)) * 2;
        const int vo = (((wr * 64 + fr) << 7) + wc * 32 + 4 * fq) * 2, vr = (wr * 64 + fr) * 4, sr = u.pm * BM * 4;
        unsigned rsv[2][4];
#pragma unroll
        for (int ai = 0; ai < 2; ++ai)
#pragma unroll
            for (int m = 0; m < 4; ++m) rsv[ai][m] = __builtin_amdgcn_raw_buffer_load_b32(rr, vr, sr + (ai * HALF + m * 16) * 4, 0);
#pragma unroll
        for (int ai = 0; ai < 2; ++ai)
#pragma unroll
            for (int m = 0; m < 4; ++m) { const float f = sc * __builtin_bit_cast(float, rsv[ai][m]);
#pragma unroll
                for (int bj = 0; bj < 2; ++bj)
#pragma unroll
                    for (int n = 0; n < 2; ++n) { const f32x4 v0 = acc[ai][bj][m][n] * f; u32x2 w; w.x = cvt_pk_bf16(v0[0], v0[1]); w.y = cvt_pk_bf16(v0[2], v0[3]);
                        __builtin_amdgcn_raw_buffer_store_b64(w, rq, vo, so + (((bj * 2048 + ai * HALF + m * 16) << 7) + n * 16) * 2, 0); } }
    }
};

typedef int i32x8 __attribute__((ext_vector_type(8)));
template <bool F8> struct FragT { typedef bf16x8 type; };
template <> struct FragT<true> { typedef i32x8 type; };
__device__ __forceinline__ f32x4 mma_bf16(bf16x8 a, bf16x8 b, f32x4 c) { return __builtin_amdgcn_mfma_f32_16x16x32_bf16(a, b, c, 0, 0, 0); }
__device__ __forceinline__ f32x4 mma_bf16(i32x8, i32x8, f32x4 c) { return c; }
template <class Epi, class Sched, bool ALIGN_EPI = false, bool SP2 = false, bool F8 = false>
__device__ __forceinline__ void gemm_phase(PG8_LAS unsigned char* lds, const Gemm g, const Sched& S, const Epi& E, int tid_in) {
    int tid_ = tid_in;
    const int tid = tid_, wid = __builtin_amdgcn_readfirstlane(tid >> 6), lane = tid & 63, wr = wid >> 2, wc = wid & 3, fr = lane & 15, fq = lane >> 4;
    constexpr int EB = F8 ? 1 : 2;
    constexpr int K = 4096; constexpr int nt = (K * EB) / (BK * 2);
    unsigned voffA[2], voffB[2];
#pragma unroll
    for (int i = 0; i < 2; ++i) { int R, C; stage_rc(tid * 16 + i * 8192, R, C); const int Rb = Epi::PERM ? ((R & ~31) + perm32(R & 31)) : R;
        voffA[i] = (unsigned)(R * K * EB + C * 2); voffB[i] = (unsigned)(Rb * K * EB + C * 2); }
    const size_t kstep = (size_t)(BK * 2);
    const size_t hstep = (size_t)HALF * K * EB;
    const size_t tstep = 2 * hstep;
    const unsigned ldsw = (unsigned)wid * 1024u;
    const int aoff = F8 ? lds_byte(wr * 64 + fr, fq * 16) + (fq & 1) * 16 : lds_byte(wr * 64 + fr, fq * 8), boff = F8 ? lds_byte(wc * 32 + fr, fq * 16) + (fq & 1) * 16 : lds_byte(wc * 32 + fr, fq * 8);
    const int aoff1 = aoff + (F8 ? 16 - 32 * (fq & 1) : 0);
    const int f8o0_unused = 0; (void)f8o0_unused;
#define PG8_SA(b, h) (((b) * 2 + (h)) * HTB)
#define PG8_SB(b, h) ((4 + (b) * 2 + (h)) * HTB)
#define PG8_STAGE_X(bufoff, gbase, voff, rs_, base_) do { const int so_ = (int)((const char*)(gbase) - (const char*)(base_)); _Pragma("unroll") for (int _i = 0; _i < 2; ++_i) \
        __builtin_amdgcn_raw_ptr_buffer_load_lds(rs_, (PG8_LAS void*)(lds + (bufoff) + ldsw + _i * 8192), 16, (int)(voff)[_i], so_, 0, 0); } while (0)
#define PG8_LDA(dst, b, h) do { if constexpr (F8) { _Pragma("unroll") for (int m = 0; m < 4; ++m) { const u32x4 lo_ = *(const PG8_LAS u32x4*)(lds + PG8_SA(b, h) + aoff + m * 2048), hi_ = *(const PG8_LAS u32x4*)(lds + PG8_SA(b, h) + aoff1 + m * 2048); \
            dst[m][0] = (i32x8){(int)lo_[0], (int)lo_[1], (int)lo_[2], (int)lo_[3], (int)hi_[0], (int)hi_[1], (int)hi_[2], (int)hi_[3]}; } } \
        else { _Pragma("unroll") for (int m = 0; m < 4; ++m) _Pragma("unroll") for (int k = 0; k < 2; ++k) dst[m][k] = *(const PG8_LAS frag_t*)(lds + PG8_SA(b, h) + aoff + m * 2048 + k * 1024); } } while (0)
#define PG8_LDB(dst, b, h) do { if constexpr (F8) { _Pragma("unroll") for (int n = 0; n < 2; ++n) { const u32x4 lo_ = *(const PG8_LAS u32x4*)(lds + PG8_SB(b, h) + boff + n * 2048), hi_ = *(const PG8_LAS u32x4*)(lds + PG8_SB(b, h) + boff + (aoff1 - aoff) + n * 2048); \
            dst[n][0] = (i32x8){(int)lo_[0], (int)lo_[1], (int)lo_[2], (int)lo_[3], (int)hi_[0], (int)hi_[1], (int)hi_[2], (int)hi_[3]}; } } \
        else { _Pragma("unroll") for (int n = 0; n < 2; ++n) _Pragma("unroll") for (int k = 0; k < 2; ++k) dst[n][k] = *(const PG8_LAS frag_t*)(lds + PG8_SB(b, h) + boff + n * 2048 + k * 1024); } } while (0)
#define PG8_MMA(ai, bj, At, Bt) do { __builtin_amdgcn_s_setprio(1); _Pragma("unroll") for (int m = 0; m < 4; ++m) _Pragma("unroll") for (int n = 0; n < 2; ++n) { \
        if constexpr (F8) acc[ai][bj][m][n] = __builtin_amdgcn_mfma_scale_f32_16x16x128_f8f6f4(Bt[n][0], At[m][0], acc[ai][bj][m][n], 0, 0, 0, 0x7f7f7f7f, 0, 0x7f7f7f7f); \
        else { _Pragma("unroll") for (int k = 0; k < 2; ++k) acc[ai][bj][m][n] = mma_bf16(Bt[n][k], At[m][k], acc[ai][bj][m][n]); } } __builtin_amdgcn_s_setprio(0); } while (0)
#define PG8_WAIT_V(n) asm volatile("s_waitcnt vmcnt(" #n ")" ::: "memory")
#define PG8_WAIT_L(n) asm volatile("s_waitcnt lgkmcnt(" #n ")" ::: "memory")
#define PG8_BAR __builtin_amdgcn_s_barrier()
#define PG8_SCHED __builtin_amdgcn_sched_barrier(0)
    const __amdgpu_buffer_rsrc_t rsA = __builtin_amdgcn_make_buffer_rsrc((void*)g.A, (short)0, (int)((size_t)g.M * K * EB), 0x00020000), rsB = __builtin_amdgcn_make_buffer_rsrc((void*)g.Bt, (short)0, (int)((size_t)g.N * K * EB), 0x00020000);
    Unit cur, nxt; int ui = 0;
    if (!S.next(0, cur)) return;
    f32x4 acc[2][2][4][2];
#pragma unroll
    for (int a = 0; a < 2; ++a)
#pragma unroll
        for (int b = 0; b < 2; ++b)
#pragma unroll
            for (int m = 0; m < 4; ++m)
#pragma unroll
                for (int n = 0; n < 2; ++n) acc[a][b][m][n] = (f32x4){0.f, 0.f, 0.f, 0.f};
    typedef typename FragT<F8>::type frag_t;
    frag_t At[4][F8 ? 1 : 2], B0[2][F8 ? 1 : 2], B1[2][F8 ? 1 : 2];
    const char* cA = (const char*)g.A + (size_t)cur.pm * tstep; const char* cB = (const char*)g.Bt + (size_t)cur.pn * tstep;
    S.a_ready(cur);
    if constexpr (SP2) {
        PG8_STAGE_X(PG8_SB(0, 0), cB, voffB, rsB, g.Bt); PG8_STAGE_X(PG8_SB(0, 1), cB + hstep, voffB, rsB, g.Bt); PG8_STAGE_X(PG8_SA(0, 0), cA, voffA, rsA, g.A); PG8_STAGE_X(PG8_SA(0, 1), cA + hstep, voffA, rsA, g.A);
        if (wr == 1) PG8_BAR;
        PG8_WAIT_V(2); PG8_BAR;
        PG8_STAGE_X(PG8_SB(1, 0), cB + kstep, voffB, rsB, g.Bt); PG8_STAGE_X(PG8_SA(1, 0), cA + kstep, voffA, rsA, g.A); PG8_STAGE_X(PG8_SB(1, 1), cB + hstep + kstep, voffB, rsB, g.Bt);
        PG8_WAIT_V(6); PG8_BAR;
    } else {
        PG8_STAGE_X(PG8_SB(0, 0), cB, voffB, rsB, g.Bt); PG8_STAGE_X(PG8_SA(0, 0), cA, voffA, rsA, g.A); PG8_STAGE_X(PG8_SB(0, 1), cB + hstep, voffB, rsB, g.Bt); PG8_STAGE_X(PG8_SA(0, 1), cA + hstep, voffA, rsA, g.A);
        if (wr == 1) PG8_BAR;
        PG8_WAIT_V(4); PG8_BAR;
        PG8_STAGE_X(PG8_SB(1, 0), cB + kstep, voffB, rsB, g.Bt); PG8_STAGE_X(PG8_SA(1, 0), cA + kstep, voffA, rsA, g.A); PG8_STAGE_X(PG8_SB(1, 1), cB + hstep + kstep, voffB, rsB, g.Bt);
        PG8_WAIT_V(6); PG8_BAR;
    }
    for (;;) {
        const bool has_next = S.next(ui + 1, nxt);
        const char* nA = has_next ? (const char*)g.A + (size_t)nxt.pm * tstep : cA; const char* nB = has_next ? (const char*)g.Bt + (size_t)nxt.pn * tstep : cB;
        for (int t = 0; t < nt; t += 2) {
            const bool last = (t == nt - 2);
            const char* a1 = cA + (size_t)(t + 1) * kstep;
            const char* a2 = last ? nA : cA + (size_t)(t + 2) * kstep; const char* b2 = last ? nB : cB + (size_t)(t + 2) * kstep;
            const char* a3 = a2 + kstep; const char* b3 = b2 + kstep;
            if (last && has_next) S.a_ready(nxt);
            if constexpr (SP2) {
            PG8_LDB(B0, 0, 0); PG8_LDB(B1, 0, 1); PG8_SCHED; PG8_LDA(At, 0, 0); PG8_STAGE_X(PG8_SA(1, 1), a1 + hstep, voffA, rsA, g.A);
            PG8_WAIT_V(8); PG8_WAIT_L(0); PG8_BAR; PG8_MMA(0, 0, At, B0); PG8_MMA(0, 1, At, B1); PG8_BAR; PG8_SCHED;
            PG8_LDA(At, 0, 1); PG8_STAGE_X(PG8_SB(0, 0), b2, voffB, rsB, g.Bt); PG8_STAGE_X(PG8_SB(0, 1), b2 + hstep, voffB, rsB, g.Bt); PG8_STAGE_X(PG8_SA(0, 0), a2, voffA, rsA, g.A);
            PG8_WAIT_V(8); PG8_WAIT_L(0); PG8_BAR; PG8_MMA(1, 0, At, B0); PG8_MMA(1, 1, At, B1); PG8_BAR; PG8_SCHED;
            PG8_LDB(B0, 1, 0); PG8_LDB(B1, 1, 1); PG8_SCHED; PG8_LDA(At, 1, 0); PG8_STAGE_X(PG8_SA(0, 1), a2 + hstep, voffA, rsA, g.A);
            PG8_WAIT_V(8); PG8_WAIT_L(0); PG8_BAR; PG8_MMA(0, 0, At, B0); PG8_MMA(0, 1, At, B1); PG8_BAR; PG8_SCHED;
            PG8_LDA(At, 1, 1); PG8_STAGE_X(PG8_SB(1, 0), b3, voffB, rsB, g.Bt); PG8_STAGE_X(PG8_SB(1, 1), b3 + hstep, voffB, rsB, g.Bt); PG8_STAGE_X(PG8_SA(1, 0), a3, voffA, rsA, g.A);
            PG8_WAIT_V(8); PG8_WAIT_L(0); PG8_BAR; PG8_MMA(1, 0, At, B0); PG8_MMA(1, 1, At, B1); PG8_BAR; PG8_SCHED;
            } else {
            PG8_LDB(B0, 0, 0); PG8_SCHED; PG8_LDA(At, 0, 0); PG8_STAGE_X(PG8_SA(1, 1), a1 + hstep, voffA, rsA, g.A);
            PG8_WAIT_L(8); PG8_BAR; PG8_WAIT_L(0); PG8_MMA(0, 0, At, B0); PG8_BAR; PG8_SCHED;
            PG8_LDB(B1, 0, 1); PG8_STAGE_X(PG8_SB(0, 0), b2, voffB, rsB, g.Bt);
            PG8_BAR; PG8_WAIT_L(0); PG8_MMA(0, 1, At, B1); PG8_BAR;
            PG8_LDA(At, 0, 1); PG8_STAGE_X(PG8_SA(0, 0), a2, voffA, rsA, g.A);
            PG8_BAR; PG8_WAIT_L(0); PG8_MMA(1, 0, At, B0); PG8_BAR; PG8_SCHED;
            PG8_STAGE_X(PG8_SB(0, 1), b2 + hstep, voffB, rsB, g.Bt);
            PG8_WAIT_V(6); PG8_BAR; PG8_MMA(1, 1, At, B1); PG8_BAR;
            PG8_LDB(B0, 1, 0); PG8_SCHED; PG8_LDA(At, 1, 0); PG8_STAGE_X(PG8_SA(0, 1), a2 + hstep, voffA, rsA, g.A);
            PG8_WAIT_L(8); PG8_BAR; PG8_WAIT_L(0); PG8_MMA(0, 0, At, B0); PG8_BAR; PG8_SCHED;
            PG8_LDB(B1, 1, 1); PG8_STAGE_X(PG8_SB(1, 0), b3, voffB, rsB, g.Bt);
            PG8_BAR; PG8_WAIT_L(0); PG8_MMA(0, 1, At, B1); PG8_BAR;
            PG8_LDA(At, 1, 1); PG8_STAGE_X(PG8_SA(1, 0), a3, voffA, rsA, g.A);
            PG8_BAR; PG8_WAIT_L(0); PG8_MMA(1, 0, At, B0); PG8_BAR; PG8_SCHED;
            PG8_STAGE_X(PG8_SB(1, 1), b3 + hstep, voffB, rsB, g.Bt);
            PG8_WAIT_V(6); PG8_BAR; PG8_MMA(1, 1, At, B1); PG8_BAR;
            }
        }
        if constexpr (ALIGN_EPI) { if (wr == 0) PG8_BAR; }
        if constexpr (!Epi::AFTER_DRAIN) { E(acc, cur, wr, wc, fr, fq); S.done(cur); }
        if (!has_next) break;
#pragma unroll
        for (int a = 0; a < 2; ++a)
#pragma unroll
            for (int b = 0; b < 2; ++b)
#pragma unroll
                for (int m = 0; m < 4; ++m)
#pragma unroll
                    for (int n = 0; n < 2; ++n) acc[a][b][m][n] = (f32x4){0.f, 0.f, 0.f, 0.f};
        cur = nxt; cA = nA; cB = nB; ++ui;
        if constexpr (ALIGN_EPI) { if (wr == 1) PG8_BAR; }
    }
    PG8_WAIT_V(0);
    if constexpr (!ALIGN_EPI) { if (wr == 0) PG8_BAR; }
    PG8_BAR;
    if constexpr (Epi::AFTER_DRAIN) { E.fused(acc, cur, wr, wc, fr, fq, lds, wid, lane); S.done(cur); }
#undef PG8_SA
#undef PG8_SB
#undef PG8_STAGE_X
#undef PG8_LDA
#undef PG8_LDB
#undef PG8_MMA
#undef PG8_WAIT_V
#undef PG8_WAIT_L
#undef PG8_BAR
#undef PG8_SCHED
}
}
#define GAS __attribute__((address_space(1)))
#define LAS __attribute__((address_space(3)))
typedef unsigned short bf16_t;
typedef unsigned u32x4 __attribute__((ext_vector_type(4)));
typedef unsigned u32x2 __attribute__((ext_vector_type(2)));
typedef float f32x4 __attribute__((ext_vector_type(4)));
typedef float f32x2 __attribute__((ext_vector_type(2)));
typedef float f32x16 __attribute__((ext_vector_type(16)));
typedef short bf16x8 __attribute__((ext_vector_type(8)));
typedef short s16x4 __attribute__((ext_vector_type(4)));
typedef __bf16 bf16x2_t __attribute__((ext_vector_type(2)));

namespace mk {
constexpr int M = 16384, D = 4096, S = 2048, NB = 8, PW = 12298, NH = 32, NE = 16384;
constexpr int NWAVES = 8;
constexpr size_t MiB = 1u << 20;
constexpr size_t WS_CTL = 0, CTL_ZERO_BYTES = 1 * MiB;
constexpr size_t WS_RSTD = 2 * MiB, WS_LOGF = 3 * MiB, WS_WQK = 4 * MiB, WS_WOUT = 20 * MiB, WS_WIN = 52 * MiB, WS_U16 = 148 * MiB, WS_V16 = 276 * MiB,
                 WS_XB = 404 * MiB, WS_Q = 532 * MiB, WS_K = 660 * MiB, WS_V = 788 * MiB, WS_OB = 916 * MiB, WS_X2 = 1792 * MiB, WS_END = 2048 * MiB;
constexpr size_t WS_XB8N = WS_OB + 64 * MiB;
constexpr size_t WS_SC = WS_Q;
constexpr int CW_BAR = 4096;
constexpr int CW_QUEUE = 16384;
constexpr int RING_BYTES = 131072, LDSCTL_OFF = RING_BYTES, MISC_OFF = LDSCTL_OFF + 320, LDS_BYTES = 147456;

struct Args { const float* in[13]; float* out; unsigned char* ws; int ph_lo, ph_hi; };

__device__ __forceinline__ unsigned f2bf(float f) { unsigned u = __builtin_bit_cast(unsigned, f); return (u + 0x7fffu + ((u >> 16) & 1u)) >> 16; }
__device__ __forceinline__ unsigned pk2(float lo, float hi) { return f2bf(lo) | (f2bf(hi) << 16); }
__device__ __forceinline__ float bf_lo(unsigned w) { return __builtin_bit_cast(float, w << 16); }
__device__ __forceinline__ float bf_hi(unsigned w) { return __builtin_bit_cast(float, w & 0xffff0000u); }
__device__ __forceinline__ float lane_read(float v, int src_lane) { return __builtin_bit_cast(float, __builtin_amdgcn_ds_bpermute(src_lane << 2, __builtin_bit_cast(int, v))); }
__device__ __forceinline__ int lane_read(int v, int src_lane) { return __builtin_amdgcn_ds_bpermute(src_lane << 2, v); }
constexpr float US = 1024.0f, VS = 32.0f, US_INV = 1.0f / 1024.0f, VS_INV = 1.0f / 32.0f;
__device__ __forceinline__ float clamp8(float x) { return fminf(fmaxf(x, -224.0f), 224.0f); }
__device__ __forceinline__ float logsig(float z) { return fminf(z, 0.f) - 0.6931471805599453f * __builtin_amdgcn_logf(1.0f + __builtin_amdgcn_exp2f(-fabsf(z) * 1.4426950408889634f)); }
__device__ __forceinline__ float gelu_erf(float v) {
    const float av = fabsf(v), t = __builtin_amdgcn_rcpf(av * 0.2316418882f + 1.0f);
    float q = t * 0.5307027145f + (-0.7265760135f); q = q * t + 0.7107068705f; q = q * t + (-0.142248368f); q = q * t + 0.127414796f; q = q * t;
    const float e = __builtin_amdgcn_exp2f((v * v) * (-0.72134752044f));
    const float m = v * (q * e);
    return v < 0.f ? m : v - m;
}
#define LDS_WAIT() asm volatile("s_waitcnt lgkmcnt(0)" ::: "memory")
#define FRESH_LDS(l) do { unsigned v_ = (unsigned)(size_t)(l); asm volatile("" : "+s"(v_)); (l) = (LAS unsigned char*)(size_t)v_; } while (0)
#define FRESH_BID() int bid = blockIdx.x, G = gridDim.x; asm volatile("" : "+s"(bid), "+s"(G))
#define FRESH_TID() int tid; { int w_ = wave0, l_; { unsigned z_ = 0u; asm volatile("" : "+v"(z_)); l_ = (int)__builtin_amdgcn_mbcnt_hi(~0u, __builtin_amdgcn_mbcnt_lo(~0u, z_)); } asm volatile("" : "+s"(w_)); tid = w_ * 64 + l_; } const int lane = tid & 63, wave = __builtin_amdgcn_readfirstlane(tid >> 6); (void)lane; (void)wave

__device__ __forceinline__ unsigned wave_max_u32(unsigned v) {
    v = max(v, (unsigned)__builtin_amdgcn_update_dpp(0, (int)v, 0x111, 0xF, 0xF, true));
    v = max(v, (unsigned)__builtin_amdgcn_update_dpp(0, (int)v, 0x112, 0xF, 0xF, true));
    v = max(v, (unsigned)__builtin_amdgcn_update_dpp(0, (int)v, 0x114, 0xF, 0xF, true));
    v = max(v, (unsigned)__builtin_amdgcn_update_dpp(0, (int)v, 0x118, 0xF, 0xF, true));
    v = max(v, (unsigned)__builtin_amdgcn_update_dpp((int)v, (int)v, 0x142, 0xA, 0xF, false));
    v = max(v, (unsigned)__builtin_amdgcn_update_dpp((int)v, (int)v, 0x143, 0xC, 0xF, false));
    return (unsigned)__builtin_amdgcn_readlane((int)v, 63);
}
__device__ __forceinline__ float wave_sum_dpp(float x) {
    int v = __builtin_bit_cast(int, x);
#define DPP_ADD(ctrl, rm, bc, oldv) v = __builtin_bit_cast(int, __builtin_bit_cast(float, v) + __builtin_bit_cast(float, __builtin_amdgcn_update_dpp(oldv, v, ctrl, rm, 0xF, bc)))
    DPP_ADD(0x111, 0xF, true, 0); DPP_ADD(0x112, 0xF, true, 0); DPP_ADD(0x114, 0xF, true, 0); DPP_ADD(0x118, 0xF, true, 0);
#undef DPP_ADD
    const float r0 = __builtin_bit_cast(float, __builtin_amdgcn_readlane(v, 15)), r1 = __builtin_bit_cast(float, __builtin_amdgcn_readlane(v, 31)), r2 = __builtin_bit_cast(float, __builtin_amdgcn_readlane(v, 47)), r3 = __builtin_bit_cast(float, __builtin_amdgcn_readlane(v, 63));
    return (r0 + r1) + (r2 + r3);
}
__device__ __forceinline__ unsigned ordkey(float x) { const unsigned u = __builtin_bit_cast(unsigned, x); return (u & 0x80000000u) ? ~u : (u | 0x80000000u); }
__device__ __forceinline__ void transpose_item(const float* W, int K, int ldw, int ncols, const float* gain, bf16_t* WT, LAS float* scr, int item, int lane) {
    const int nblk = ncols / 32, kb = item / nblk, nb = item % nblk, k0 = 64 * kb, n0 = 32 * nb;
#pragma unroll 8
    for (int i = 0; i < 32; ++i) { const int kk = 2 * i + (lane >> 5); float v = W[(size_t)(k0 + kk) * ldw + n0 + (lane & 31)]; if (gain) v *= gain[k0 + kk]; scr[kk * 33 + (lane & 31)] = v; }
    LDS_WAIT(); asm volatile("" ::: "memory");
    const int c = lane & 7;
#pragma unroll
    for (int j = 0; j < 4; ++j) { const int n = (lane >> 3) + 8 * j; const LAS float* s = scr + (8 * c) * 33 + n;
        u32x4 o; o.x = pk2(s[0 * 33], s[1 * 33]); o.y = pk2(s[2 * 33], s[3 * 33]); o.z = pk2(s[4 * 33], s[5 * 33]); o.w = pk2(s[6 * 33], s[7 * 33]);
        *(u32x4*)(WT + (size_t)(n0 + n) * K + k0 + 8 * c) = o; }
    LDS_WAIT(); asm volatile("" ::: "memory");
}

typedef const __attribute__((address_space(4))) Args* KArgsT;
__device__ __forceinline__ unsigned pk4_fp8(float a, float b, float c, float d) { int p = __builtin_amdgcn_cvt_pk_fp8_f32(clamp8(a), clamp8(b), 0, false); p = __builtin_amdgcn_cvt_pk_fp8_f32(clamp8(c), clamp8(d), p, true); return (unsigned)p; }
__device__ __forceinline__ void transpose_item8(const float* W, int K, int ldw, int ncols, const float* gain, float scale, unsigned char* WT, LAS float* scr, int item, int lane) {
    const int nblk = ncols / 32, kb = item / nblk, nb = item % nblk, k0 = 64 * kb, n0 = 32 * nb;
    const int kr = lane >> 3, nq = (lane & 7) * 4;
    f32x4 v[8];
#pragma unroll
    for (int i = 0; i < 8; ++i) { const float* p = W + (size_t)(k0 + 8 * i + kr) * ldw + n0 + nq; v[i] = (f32x4){p[0], p[1], p[2], p[3]}; }
#pragma unroll
    for (int i = 0; i < 8; ++i) { const int kk = 8 * i + kr; const float g = (gain ? gain[k0 + kk] : 1.0f) * scale; LAS float* d = scr + kk * 33 + nq; d[0] = v[i][0] * g; d[1] = v[i][1] * g; d[2] = v[i][2] * g; d[3] = v[i][3] * g; }
    LDS_WAIT(); asm volatile("" ::: "memory");
    const int c = lane & 7;
#pragma unroll
    for (int j = 0; j < 4; ++j) { const int n = (lane >> 3) + 8 * j; const LAS float* s = scr + (8 * c) * 33 + n;
        u32x2 o; o.x = pk4_fp8(s[0 * 33], s[1 * 33], s[2 * 33], s[3 * 33]); o.y = pk4_fp8(s[4 * 33], s[5 * 33], s[6 * 33], s[7 * 33]);
        *(u32x2*)(WT + (size_t)(n0 + n) * K + k0 + 8 * c) = o; }
    LDS_WAIT(); asm volatile("" ::: "memory");
}
__device__ __forceinline__ void conv_phase(KArgsT ka, int l, LAS unsigned char* lds, int wave0) {
    FRESH_TID(); FRESH_LDS(lds); FRESH_BID();
    unsigned char* ws = ka->ws;
    const float* ln1 = ka->in[1] + (size_t)l * D; const float* w_in = ka->in[2] + (size_t)l * D * PW; const float* w_out = ka->in[5] + (size_t)l * D * D;
    const float* ln2 = ka->in[6] + (size_t)l * D; const float* wq = ka->in[7] + (size_t)l * D * 2048;
    const float* k1 = ka->in[8] + (size_t)l * 8 * 128 * 128; const float* k2 = ka->in[9] + (size_t)l * 8 * 128 * 128;
    const float* pu = ka->in[10] + (size_t)l * NE * D; const float* pv = ka->in[11] + (size_t)l * NE * D;
    bf16_t* WQK = (bf16_t*)(ws + WS_WQK); bf16_t* WOUT = (bf16_t*)(ws + WS_WOUT); bf16_t* WIN = (bf16_t*)(ws + WS_WIN); bf16_t* U16 = (bf16_t*)(ws + WS_U16); bf16_t* V16 = (bf16_t*)(ws + WS_V16);
    {
        LAS float* Ks = (LAS float*)lds;
        LAS float* Ws = (LAS float*)(lds + 128 * 132 * 4);
        for (int it = bid; it < 1024; it += G) {
            const int gi = it >> 6, c0 = (it & 63) * 64;
            const float* key = ((gi & 1) ? k2 : k1) + (size_t)(gi >> 1) * 128 * 128;
            for (int i = tid; i < 4096; i += 512) { const int r = i >> 5, c4 = (i & 31) * 4; *(LAS f32x4*)(Ks + r * 132 + c4) = *(const f32x4*)(key + r * 128 + c4); }
            for (int i = tid; i < 2048; i += 512) { const int r = i >> 5, c4 = (i & 31) * 4; *(LAS f32x4*)(Ws + r * 132 + c4) = *(const f32x4*)(wq + (size_t)(c0 + r) * 2048 + gi * 128 + c4); }
            __syncthreads();
            const int tc = tid & 15, tn = tid >> 4;
            float acc[4][4];
#pragma unroll
            for (int i = 0; i < 4; ++i)
#pragma unroll
                for (int j = 0; j < 4; ++j) acc[i][j] = 0.f;
#pragma unroll 2
            for (int d = 0; d < 128; d += 4) {
                f32x4 kv[4], wv[4];
#pragma unroll
                for (int i = 0; i < 4; ++i) kv[i] = *(const LAS f32x4*)(Ks + (4 * tn + i) * 132 + d);
#pragma unroll
                for (int j = 0; j < 4; ++j) wv[j] = *(const LAS f32x4*)(Ws + (tc + 16 * j) * 132 + d);
#pragma unroll
                for (int i = 0; i < 4; ++i)
#pragma unroll
                    for (int j = 0; j < 4; ++j) acc[i][j] += kv[i][0] * wv[j][0] + kv[i][1] * wv[j][1] + kv[i][2] * wv[j][2] + kv[i][3] * wv[j][3];
            }
#pragma unroll
            for (int j = 0; j < 4; ++j) { const int c = c0 + tc + 16 * j; const float gg = ln2[c];
#pragma unroll
                for (int i = 0; i < 4; ++i) WQK[(size_t)(gi * 128 + 4 * tn + i) * D + c] = (bf16_t)f2bf(acc[i][j] * gg); }
            __syncthreads();
        }
        __syncthreads();
    }
    const int gw = bid * NWAVES + wave, NGW = G * NWAVES;
    {
        unsigned char* U8 = (unsigned char*)U16; unsigned char* V8 = U8 + (size_t)NE * D;
        for (int r = gw; r < NE; r += NGW) {
            const float* us = pu + (size_t)r * D; const float* vs = pv + (size_t)r * D;
#pragma unroll
            for (int i = 0; i < 4; ++i) { const int c = 1024 * i + 16 * lane;
                u32x4 ou, ov;
#pragma unroll
                for (int q = 0; q < 4; ++q) { const f32x4 u0 = *(const f32x4*)(us + c + 4 * q), g0 = *(const f32x4*)(ln2 + c + 4 * q), v0 = *(const f32x4*)(vs + c + 4 * q);
                    int pu_ = __builtin_amdgcn_cvt_pk_fp8_f32(clamp8(u0[0] * g0[0] * US), clamp8(u0[1] * g0[1] * US), 0, false); pu_ = __builtin_amdgcn_cvt_pk_fp8_f32(clamp8(u0[2] * g0[2] * US), clamp8(u0[3] * g0[3] * US), pu_, true);
                    int pv_ = __builtin_amdgcn_cvt_pk_fp8_f32(clamp8(v0[0] * VS), clamp8(v0[1] * VS), 0, false); pv_ = __builtin_amdgcn_cvt_pk_fp8_f32(clamp8(v0[2] * VS), clamp8(v0[3] * VS), pv_, true);
                    ou[q] = (unsigned)pu_; ov[q] = (unsigned)pv_; }
                *(u32x4*)(U8 + (size_t)r * D + c) = ou; *(u32x4*)(V8 + (size_t)r * D + c) = ov; }
        }
    }
    {
        LAS float* scr = (LAS float*)(lds + wave * 16384);
        constexpr int I_O = (D / 64) * (D / 32), I_IN = (D / 64) * (12288 / 32);
        for (int it = gw; it < I_O + I_IN; it += NGW) {
            if (it < I_O) transpose_item8(w_out, D, D, D, nullptr, US, (unsigned char*)WOUT, scr, it, lane);
            else transpose_item8(w_in, D, PW, 12288, ln1, US, (unsigned char*)WIN, scr, it - I_O, lane);
        }
    }
}

template <bool WITH_F>
__device__ __forceinline__ void prep_phase(const float* X, bf16_t* XB, float* RSTD, const float* w_in, const float* ln1, const float* bf, float* LOGF, LAS unsigned char* lds, int wave0) {
    FRESH_TID(); FRESH_LDS(lds); FRESH_BID();
    LAS unsigned short* gfs = (LAS unsigned short*)lds;
    if (WITH_F) {
        __syncthreads();
        for (int c = tid; c < D; c += 512) { const float g = ln1[c]; const float* wr = w_in + (size_t)c * PW + 12288;
#pragma unroll
            for (int j = 0; j < 10; ++j) gfs[j * D + c] = (unsigned short)f2bf(wr[j] * g); }
        __syncthreads();
    }
    const int gw = bid * NWAVES + wave, NGW = G * NWAVES;
    for (int m = gw; m < M; m += NGW) {
        const f32x4* xr = (const f32x4*)(X + (size_t)m * D) + lane;
        f32x4 v[16]; float ss = 0.f;
#pragma unroll
        for (int i = 0; i < 16; ++i) { v[i] = xr[64 * i]; ss += (v[i][0] * v[i][0] + v[i][1] * v[i][1]) + (v[i][2] * v[i][2] + v[i][3] * v[i][3]); }
        ss = wave_sum_dpp(ss);
        const float rstd = rsqrtf(ss * (1.0f / D) + 1e-6f);
        if (WITH_F) {
            unsigned* o8 = (unsigned*)((unsigned char*)XB + (size_t)m * D) + lane;
#pragma unroll
            for (int i = 0; i < 16; ++i) o8[64 * i] = pk4_fp8(v[i][0], v[i][1], v[i][2], v[i][3]);
        } else {
        u32x2* o = (u32x2*)(XB + (size_t)m * D) + lane;
#pragma unroll
        for (int i = 0; i < 16; ++i) { u32x2 w; w.x = pk2(v[i][0], v[i][1]); w.y = pk2(v[i][2], v[i][3]); o[64 * i] = w; }
        }
        if (lane == 0) RSTD[m] = rstd;
        if (WITH_F) {
            float mine = 0.f;
#pragma unroll 1
            for (int j = 0; j < 10; ++j) { float s = 0.f;
#pragma unroll
                for (int i = 0; i < 16; ++i) { const u32x2 gp = *(const LAS u32x2*)(gfs + j * D + 256 * i + 4 * lane);
                    s += (v[i][0] * bf_lo(gp.x) + v[i][1] * bf_hi(gp.x)) + (v[i][2] * bf_lo(gp.y) + v[i][3] * bf_hi(gp.y)); }
                s = wave_sum_dpp(s); if (lane == j) mine = s; }
            if (lane < 10) { const int b = m >> 11, s = m & 2047; LOGF[(size_t)(b * 10 + lane) * S + s] = logsig(mine * rstd + bf[lane]); }
        }
    }
}


__device__ __forceinline__ void load16_bf16(const bf16_t* p, float (&d)[16]) {
    const u32x4 a = *(const u32x4*)p, b = *(const u32x4*)(p + 8);
#pragma unroll
    for (int q = 0; q < 4; ++q) { d[2 * q] = bf_lo(a[q]); d[2 * q + 1] = bf_hi(a[q]); d[8 + 2 * q] = bf_lo(b[q]); d[8 + 2 * q + 1] = bf_hi(b[q]); }
}
#define RFL(x) __builtin_amdgcn_readfirstlane(x)
__device__ __forceinline__ void peer_u_phase(const float* SC, const unsigned char* U8, const bf16_t* X1, int* EIDG, float* WG, LAS unsigned char* lds, int wave0) {
    FRESH_TID(); FRESH_LDS(lds); FRESH_BID();
    LAS int* s_eid = (LAS int*)(lds + wave * 1024); LAS float* s_w = (LAS float*)(lds + wave * 1024 + 512);
    const int gw = bid * NWAVES + wave, NGW = G * NWAVES;
    const float NEG = -3.0e38f;
    for (int tok = gw; tok < M; tok += NGW) {
        const bf16_t* x1 = X1 + (size_t)tok * D;
        float xv[4][16]; float rstd_tok;
        { float ss_ = 0.f;
#pragma unroll
          for (int i = 0; i < 4; ++i) { load16_bf16(x1 + 1024 * i + 16 * lane, xv[i]);
#pragma unroll
              for (int k = 0; k < 16; ++k) ss_ += xv[i][k] * xv[i][k]; }
          rstd_tok = rsqrtf(wave_sum_dpp(ss_) * (1.0f / D) + 1e-6f); }
        const float* sc = SC + (size_t)tok * 2048;
        for (int h = 0; h < 8; ++h) {
            const float a0 = sc[h * 256 + lane], a1 = sc[h * 256 + 64 + lane], c0 = sc[h * 256 + 128 + lane], c1 = sc[h * 256 + 192 + lane];
            unsigned ka0 = (ordkey(a0) & ~127u) | (unsigned)(127 - lane), ka1 = (ordkey(a1) & ~127u) | (unsigned)(63 - lane);
            unsigned kc0 = (ordkey(c0) & ~127u) | (unsigned)(127 - lane), kc1 = (ordkey(c1) & ~127u) | (unsigned)(63 - lane);
            float v1 = 0.f, v2 = 0.f; int i1 = 0, i2 = 0;
            for (int it = 0; it < 16; ++it) {
                const unsigned m1 = wave_max_u32(max(ka0, ka1)), m2 = wave_max_u32(max(kc0, kc1));
                const int n1 = 127 - (int)(m1 & 127u), n2 = 127 - (int)(m2 & 127u);
                const float x1lo = __builtin_bit_cast(float, __builtin_amdgcn_readlane(__builtin_bit_cast(int, a0), n1 & 63)), x1hi = __builtin_bit_cast(float, __builtin_amdgcn_readlane(__builtin_bit_cast(int, a1), n1 & 63));
                const float x2lo = __builtin_bit_cast(float, __builtin_amdgcn_readlane(__builtin_bit_cast(int, c0), n2 & 63)), x2hi = __builtin_bit_cast(float, __builtin_amdgcn_readlane(__builtin_bit_cast(int, c1), n2 & 63));
                ka0 = ka0 == m1 ? 0u : ka0; ka1 = ka1 == m1 ? 0u : ka1; kc0 = kc0 == m2 ? 0u : kc0; kc1 = kc1 == m2 ? 0u : kc1;
                if (lane == it) { v1 = (n1 & 64) ? x1hi : x1lo; i1 = n1; v2 = (n2 & 64) ? x2hi : x2lo; i2 = n2; }
            }
            unsigned kd0, kd1, kd2, kd3;
            { const float va = lane_read(v1, lane >> 2); const int pb_ = 255 - 4 * lane;
              kd0 = (ordkey(va + lane_read(v2, (lane & 3) * 4 + 0)) & ~255u) | (unsigned)(pb_); kd1 = (ordkey(va + lane_read(v2, (lane & 3) * 4 + 1)) & ~255u) | (unsigned)(pb_ - 1);
              kd2 = (ordkey(va + lane_read(v2, (lane & 3) * 4 + 2)) & ~255u) | (unsigned)(pb_ - 2); kd3 = (ordkey(va + lane_read(v2, (lane & 3) * 4 + 3)) & ~255u) | (unsigned)(pb_ - 3); }
            float best = 0.f; int be = 0;
            for (int it = 0; it < 16; ++it) {
                const unsigned m = wave_max_u32(max(max(kd0, kd1), max(kd2, kd3)));
                const int pos = 255 - (int)(m & 255u);
                const float bv = __builtin_bit_cast(float, __builtin_amdgcn_readlane(__builtin_bit_cast(int, v1), pos >> 4)) + __builtin_bit_cast(float, __builtin_amdgcn_readlane(__builtin_bit_cast(int, v2), pos & 15));
                const int e = (__builtin_amdgcn_readlane(i1, pos >> 4) << 7) | __builtin_amdgcn_readlane(i2, pos & 15);
                kd0 = kd0 == m ? 0u : kd0; kd1 = kd1 == m ? 0u : kd1; kd2 = kd2 == m ? 0u : kd2; kd3 = kd3 == m ? 0u : kd3;
                if (lane == it) { best = bv; be = e; }
            }
            const float mx = __builtin_bit_cast(float, __builtin_amdgcn_readlane(__builtin_bit_cast(int, best), 0));
            const float p = lane < 16 ? __builtin_amdgcn_exp2f((best - mx) * (1.4426950408889634f * rstd_tok)) : 0.f;
            const float sm = wave_sum_dpp(p);
            if (lane < 16) { s_eid[h * 16 + lane] = be; s_w[h * 16 + lane] = p / sm; }
        }
        LDS_WAIT(); asm volatile("" ::: "memory");
#define LOADROW8(dst, base, e) do { const u32x4* p_ = (const u32x4*)((base) + (size_t)(e) * D) + lane; _Pragma("unroll") for (int i_ = 0; i_ < 4; ++i_) dst[i_] = p_[64 * i_]; } while (0)
        {
            const float rstd = rstd_tok * US_INV;
#define UDOT8(row, j) do { float da_ = 0.f, db_ = 0.f; _Pragma("unroll") for (int i_ = 0; i_ < 4; ++i_) { _Pragma("unroll") for (int k_ = 0; k_ < 4; ++k_) { \
                unsigned w0_ = row[i_][k_]; asm volatile("" : "+v"(w0_));     \
                const f32x2 lo_ = __builtin_amdgcn_cvt_pk_f32_fp8((int)w0_, false), hi_ = __builtin_amdgcn_cvt_pk_f32_fp8((int)w0_, true); \
                da_ = fmaf(xv[i_][4 * k_], lo_[0], da_); db_ = fmaf(xv[i_][4 * k_ + 1], lo_[1], db_); da_ = fmaf(xv[i_][4 * k_ + 2], hi_[0], da_); db_ = fmaf(xv[i_][4 * k_ + 3], hi_[1], db_); } \
                asm volatile("" : "+v"(da_), "+v"(db_)); } \
            const float d_ = wave_sum_dpp(da_ + db_) * rstd; const float ge_ = gelu_erf(d_); if (lane == 0) s_w[j] *= ge_; } while (0)
            u32x4 r0[4], r1[4], r2[4];
            { const int e_ = RFL(s_eid[0]); LOADROW8(r0, U8, e_); } { const int e_ = RFL(s_eid[1]); LOADROW8(r1, U8, e_); } { const int e_ = RFL(s_eid[2]); LOADROW8(r2, U8, e_); }
            for (int j = 0; j < 126; j += 3) {
                UDOT8(r0, j);     if (j + 3 < 128) { const int e_ = RFL(s_eid[j + 3]); LOADROW8(r0, U8, e_); }
                UDOT8(r1, j + 1); if (j + 4 < 128) { const int e_ = RFL(s_eid[j + 4]); LOADROW8(r1, U8, e_); }
                UDOT8(r2, j + 2); if (j + 5 < 128) { const int e_ = RFL(s_eid[j + 5]); LOADROW8(r2, U8, e_); }
            }
            UDOT8(r0, 126); UDOT8(r1, 127);
#undef UDOT8
        }
        LDS_WAIT(); asm volatile("" ::: "memory");
        EIDG[(size_t)tok * 128 + lane] = s_eid[lane]; EIDG[(size_t)tok * 128 + 64 + lane] = s_eid[64 + lane];
        WG[(size_t)tok * 128 + lane] = s_w[lane]; WG[(size_t)tok * 128 + 64 + lane] = s_w[64 + lane];
        LDS_WAIT(); asm volatile("" ::: "memory");
    }
#undef LOADROW8
}

template <bool FINAL>
__device__ __forceinline__ void peer_v_phase(const int* EIDG, const float* WG, const unsigned char* V8, const bf16_t* X1, void* XOv, const float* fg,
                                             unsigned char* XB8n, float* RSTDn, float* LOGFn, const float* w_in_n, const float* ln1_n, const float* bf_n, LAS unsigned char* lds, int wave0) {
    FRESH_TID(); FRESH_LDS(lds); FRESH_BID();
    LAS int* s_eid = (LAS int*)(lds + 81920 + wave * 1024); LAS float* s_w = (LAS float*)(lds + 81920 + wave * 1024 + 512);
    LAS unsigned short* gfs = (LAS unsigned short*)lds;
    if (!FINAL) {
        __syncthreads();
        for (int c = tid; c < D; c += 512) { const float g = ln1_n[c]; const float* wr = w_in_n + (size_t)c * PW + 12288;
#pragma unroll
            for (int j = 0; j < 10; ++j) gfs[j * D + c] = (unsigned short)f2bf(wr[j] * g); }
        __syncthreads();
    }
    const int gw = bid * NWAVES + wave, NGW = G * NWAVES;
    for (int tok = gw; tok < M; tok += NGW) {
        s_eid[lane] = EIDG[(size_t)tok * 128 + lane]; s_eid[64 + lane] = EIDG[(size_t)tok * 128 + 64 + lane];
        s_w[lane] = WG[(size_t)tok * 128 + lane]; s_w[64 + lane] = WG[(size_t)tok * 128 + 64 + lane];
        LDS_WAIT(); asm volatile("" ::: "memory");
#define LOADROW8(dst, base, e) do { const u32x4* p_ = (const u32x4*)((base) + (size_t)(e) * D) + lane; _Pragma("unroll") for (int i_ = 0; i_ < 4; ++i_) dst[i_] = p_[64 * i_]; } while (0)
        const bf16_t* x1 = X1 + (size_t)tok * D;
        {
            float acc[4][16];
#pragma unroll
            for (int i = 0; i < 4; ++i)
#pragma unroll
                for (int k = 0; k < 16; ++k) acc[i][k] = 0.f;
#define VACC8(row, j) do { const float w_ = s_w[j]; _Pragma("unroll") for (int i_ = 0; i_ < 4; ++i_) { _Pragma("unroll") for (int k_ = 0; k_ < 4; ++k_) { \
                unsigned w0_ = row[i_][k_]; asm volatile("" : "+v"(w0_)); \
                const f32x2 lo_ = __builtin_amdgcn_cvt_pk_f32_fp8((int)w0_, false), hi_ = __builtin_amdgcn_cvt_pk_f32_fp8((int)w0_, true); \
                acc[i_][4 * k_] = fmaf(w_, lo_[0], acc[i_][4 * k_]); acc[i_][4 * k_ + 1] = fmaf(w_, lo_[1], acc[i_][4 * k_ + 1]); acc[i_][4 * k_ + 2] = fmaf(w_, hi_[0], acc[i_][4 * k_ + 2]); acc[i_][4 * k_ + 3] = fmaf(w_, hi_[1], acc[i_][4 * k_ + 3]); } \
                asm volatile("" : "+v"(acc[i_][0]), "+v"(acc[i_][1]), "+v"(acc[i_][2]), "+v"(acc[i_][3]), "+v"(acc[i_][4]), "+v"(acc[i_][5]), "+v"(acc[i_][6]), "+v"(acc[i_][7]), \
                                  "+v"(acc[i_][8]), "+v"(acc[i_][9]), "+v"(acc[i_][10]), "+v"(acc[i_][11]), "+v"(acc[i_][12]), "+v"(acc[i_][13]), "+v"(acc[i_][14]), "+v"(acc[i_][15])); } } while (0)
            u32x4 r0[4], r1[4], r2[4];
            { const int e_ = RFL(s_eid[0]); LOADROW8(r0, V8, e_); } { const int e_ = RFL(s_eid[1]); LOADROW8(r1, V8, e_); } { const int e_ = RFL(s_eid[2]); LOADROW8(r2, V8, e_); }
            for (int j = 0; j < 126; j += 3) {
                VACC8(r0, j);     if (j + 3 < 128) { const int e_ = RFL(s_eid[j + 3]); LOADROW8(r0, V8, e_); }
                VACC8(r1, j + 1); if (j + 4 < 128) { const int e_ = RFL(s_eid[j + 4]); LOADROW8(r1, V8, e_); }
                VACC8(r2, j + 2); if (j + 5 < 128) { const int e_ = RFL(s_eid[j + 5]); LOADROW8(r2, V8, e_); }
            }
            VACC8(r0, 126); VACC8(r1, 127);
#undef VACC8
#undef LOADROW8
            float ss = 0.f;
#pragma unroll
            for (int i = 0; i < 4; ++i) { float t[16]; load16_bf16(x1 + 1024 * i + 16 * lane, t);
#pragma unroll
                for (int k = 0; k < 16; ++k) { acc[i][k] = fmaf(acc[i][k], VS_INV, t[k]); ss += acc[i][k] * acc[i][k]; } }
            ss = wave_sum_dpp(ss);
            const float rs = rsqrtf(ss * (1.0f / D) + 1e-6f);
            if (!FINAL) {
#pragma unroll
                for (int i = 0; i < 4; ++i) { u32x4 w8;
#pragma unroll
                    for (int q = 0; q < 4; ++q) w8[q] = pk4_fp8(acc[i][4 * q], acc[i][4 * q + 1], acc[i][4 * q + 2], acc[i][4 * q + 3]);
                    *(u32x4*)(XB8n + (size_t)tok * D + 1024 * i + 16 * lane) = w8; }
                if (lane == 0) RSTDn[tok] = rs;
                float mine = 0.f;
#pragma unroll 1
                for (int j = 0; j < 10; ++j) { float s = 0.f;
#pragma unroll
                    for (int i = 0; i < 4; ++i) { const u32x4 g0 = *(const LAS u32x4*)(gfs + j * D + 1024 * i + 16 * lane), g1 = *(const LAS u32x4*)(gfs + j * D + 1024 * i + 16 * lane + 8);
#pragma unroll
                        for (int q = 0; q < 4; ++q) { s += acc[i][2 * q] * bf_lo(g0[q]) + acc[i][2 * q + 1] * bf_hi(g0[q]); s += acc[i][8 + 2 * q] * bf_lo(g1[q]) + acc[i][8 + 2 * q + 1] * bf_hi(g1[q]); } }
                    s = wave_sum_dpp(s); if (lane == j) mine = s; }
                if (lane < 10) { const int b_ = tok >> 11, s_ = tok & 2047; LOGFn[(size_t)(b_ * 10 + lane) * S + s_] = logsig(mine * rs + bf_n[lane]); }
            }
            if (FINAL) { float* xo = (float*)XOv + (size_t)tok * D;
#pragma unroll
                for (int i = 0; i < 4; ++i)
#pragma unroll
                    for (int q = 0; q < 4; ++q) { const int c = 1024 * i + 16 * lane + 4 * q; const f32x4 g_ = *(const f32x4*)(fg + c);
                        *(f32x4*)(xo + c) = (f32x4){acc[i][4 * q] * rs * g_[0], acc[i][4 * q + 1] * rs * g_[1], acc[i][4 * q + 2] * rs * g_[2], acc[i][4 * q + 3] * rs * g_[3]}; }
            } else { bf16_t* xo = (bf16_t*)XOv + (size_t)tok * D;
#pragma unroll
                for (int i = 0; i < 4; ++i) { u32x4 w0, w1;
#pragma unroll
                    for (int q = 0; q < 4; ++q) { w0[q] = pk2(acc[i][2 * q], acc[i][2 * q + 1]); w1[q] = pk2(acc[i][8 + 2 * q], acc[i][8 + 2 * q + 1]); }
                    *(u32x4*)(xo + 1024 * i + 16 * lane) = w0; *(u32x4*)(xo + 1024 * i + 16 * lane + 8) = w1; }
            }
        }
        LDS_WAIT(); asm volatile("" ::: "memory");
    }
}
}
namespace at {
using namespace mk;
constexpr int QB = 256, KVB = 64, HD = 128;
constexpr int SHM_V = KVB * HD * 2, SHM_K = KVB * HD * 2;
constexpr int OFF_V = 0, OFF_K = 2 * SHM_V, OFF_WS = OFF_K + 2 * SHM_K, OFF_CUM = OFF_WS + 8 * 256, OFF_RT = OFF_CUM + 2048 * 4, OFF_MISC = OFF_RT + 640 * 4;
constexpr float LOG2E = 1.4426950408889634f;
constexpr float THR2 = 10.0f;
constexpr float SB_DONE = -100.0f;

#define AT_KSWZ(row, colB) ((row) * 256 + ((colB) ^ (((row) & 7) << 4)))
__device__ __forceinline__ int v_st(int k, int c) { const int kk = (k & ~0xC) | ((k & 4) << 1) | ((k & 8) >> 1); return ((kk >> 3) * 4 + (c >> 5)) * 512 + ((kk & 7) * 32 + (c & 31)) * 2; }
__device__ __forceinline__ int v_rd_base(int lane) { return ((lane & 3) << 3) | (((lane >> 2) & 3) << 6) | (((lane >> 4) & 1) << 5) | (((lane >> 5) & 1) << 8); }
constexpr int v_rd_off(int d0, int ks, int half) { return d0 * 512 + ks * 4096 + half * 2048; }
__device__ __forceinline__ int crow(int r, int hi) { return (r & 3) + 8 * (r >> 2) + 4 * hi; }
__device__ __forceinline__ unsigned cvtpk(float lo, float hi) { unsigned r; asm volatile("v_cvt_pk_bf16_f32 %0, %1, %2" : "=v"(r) : "v"(lo), "v"(hi)); return r; }
__device__ __forceinline__ float partner(float v, int hi) { auto rr = __builtin_amdgcn_permlane32_swap(__builtin_bit_cast(unsigned, v), __builtin_bit_cast(unsigned, v), false, false); return __builtin_bit_cast(float, hi ? rr[0] : rr[1]); }

__device__ __forceinline__ float xchg_max(float v, int hi) { return fmaxf(v, partner(v, hi)); }
__device__ __forceinline__ float xchg_sum(float v, int hi) { return v + partner(v, hi); }

__device__ __forceinline__ void pack_p(const f32x16& p0, const f32x16& p1, bf16x8& pa0, bf16x8& pa1, bf16x8& pa2, bf16x8& pa3) {
#define AT_PK4(P, B_, OUT) do { unsigned a0 = cvtpk(P[B_ + 0], P[B_ + 1]), a1 = cvtpk(P[B_ + 2], P[B_ + 3]); unsigned b0 = cvtpk(P[B_ + 4], P[B_ + 5]), b1 = cvtpk(P[B_ + 6], P[B_ + 7]); \
        auto r0 = __builtin_amdgcn_permlane32_swap(a0, b0, false, false); auto r1 = __builtin_amdgcn_permlane32_swap(a1, b1, false, false); \
        u32x4 w = {r0[0], r1[0], r0[1], r1[1]}; OUT = __builtin_bit_cast(bf16x8, w); } while (0)
    AT_PK4(p0, 0, pa0); AT_PK4(p0, 8, pa1); AT_PK4(p1, 0, pa2); AT_PK4(p1, 8, pa3);
#undef AT_PK4
}
template <int KBUF>
__device__ __forceinline__ void qkt(f32x16& p0, f32x16& p1, LAS unsigned char* K_lds, int r32, int hi, const bf16x8 (&qr)[8]) {
    p0 = f32x16{}; p1 = f32x16{};
    LAS unsigned char* kb[4];
#pragma unroll
    for (int dd = 0; dd < 4; ++dd) kb[dd] = K_lds + KBUF * SHM_K + AT_KSWZ(r32, (dd * 16 + hi * 8) * 2);
#pragma unroll
    for (int d0 = 0; d0 < 8; ++d0) { LAS unsigned char* a = kb[d0 & 3] + (d0 >> 2) * 128;
        const bf16x8 b0 = *(const LAS bf16x8*)a; const bf16x8 b1 = *(const LAS bf16x8*)(a + 32 * 256);
        p0 = __builtin_amdgcn_mfma_f32_32x32x16_bf16(b0, qr[d0], p0, 0, 0, 0);
        p1 = __builtin_amdgcn_mfma_f32_32x32x16_bf16(b1, qr[d0], p1, 0, 0, 0); }
}
template <int VBUF>
__device__ __forceinline__ void pv_tile(f32x16 (&o)[4], int vb0, bf16x8 pa0, bf16x8 pa1, bf16x8 pa2, bf16x8 pa3) {
#define AT_TRRD(dst, off) asm volatile("ds_read_b64_tr_b16 %0, %1 offset:%2" : "=&v"(dst) : "v"(vb0), "i"(off) : "memory")
#define AT_PV_D0(d0) do { s16x4 l0, l1, l2, l3, h0, h1, h2, h3; constexpr int b_ = VBUF * SHM_V + v_rd_off(d0, 0, 0); \
        AT_TRRD(l0, b_); AT_TRRD(h0, b_ + 2048); AT_TRRD(l1, b_ + 4096); AT_TRRD(h1, b_ + 6144); AT_TRRD(l2, b_ + 8192); AT_TRRD(h2, b_ + 10240); AT_TRRD(l3, b_ + 12288); AT_TRRD(h3, b_ + 14336); \
        asm volatile("s_waitcnt lgkmcnt(0)" ::: "memory"); __builtin_amdgcn_sched_barrier(0); \
        o[d0] = __builtin_amdgcn_mfma_f32_32x32x16_bf16(pa0, (bf16x8){l0[0], l0[1], l0[2], l0[3], h0[0], h0[1], h0[2], h0[3]}, o[d0], 0, 0, 0); \
        o[d0] = __builtin_amdgcn_mfma_f32_32x32x16_bf16(pa1, (bf16x8){l1[0], l1[1], l1[2], l1[3], h1[0], h1[1], h1[2], h1[3]}, o[d0], 0, 0, 0); \
        o[d0] = __builtin_amdgcn_mfma_f32_32x32x16_bf16(pa2, (bf16x8){l2[0], l2[1], l2[2], l2[3], h2[0], h2[1], h2[2], h2[3]}, o[d0], 0, 0, 0); \
        o[d0] = __builtin_amdgcn_mfma_f32_32x32x16_bf16(pa3, (bf16x8){l3[0], l3[1], l3[2], l3[3], h3[0], h3[1], h3[2], h3[3]}, o[d0], 0, 0, 0); } while (0)
    AT_PV_D0(0); AT_PV_D0(1); AT_PV_D0(2); AT_PV_D0(3);
#undef AT_PV_D0
#undef AT_TRRD
}

template <int VAR>
__device__ __forceinline__ void attn_item(const bf16_t* Qh, const bf16_t* Kh, const bf16_t* Vh, bf16_t* OB, const float* relb, const float* LOGF, int b, int h, int qb, LAS unsigned char* lds, int tid) {
    const int wid = __builtin_amdgcn_readfirstlane(tid >> 6), lane = tid & 63, r32 = lane & 31, hi = lane >> 5;
    const int g = VAR == 0 ? h : (VAR == 1 ? 12 + h : 22 + h);
    const size_t hb = (size_t)(b * NH + g) * S * HD;
    const bf16_t* Kp = Kh + hb; const bf16_t* Vp = Vh + hb;
    LAS unsigned char* V_lds = lds + OFF_V; LAS unsigned char* K_lds = lds + OFF_K;
    LAS float* wsf = (LAS float*)(lds + OFF_WS) + wid * 64; LAS float* li_l = wsf; LAS float* al_l = wsf + 32;
    LAS float* cumL = (LAS float*)(lds + OFF_CUM); LAS float* Rt = (LAS float*)(lds + OFF_RT); volatile LAS unsigned* flags = (volatile LAS unsigned*)(lds + OFF_MISC);
    const int P0 = qb * QB, qlo = P0 + wid * 32, qpos = qlo + r32;
    int NT, jlo = 0;
    if (VAR == 0) { jlo = 4 * qb - 8; if (jlo < 0) jlo = 0; NT = 4 * qb + 4 - jlo; } else NT = 4 * qb + 4;
    const int cw = 4 * qb + (wid >> 1);
#define AT_KBASE(t) (VAR == 1 ? (4 * qb + 3 - (t)) * KVB : (jlo + (t)) * KVB)
#define AT_ACT(t) (VAR == 0 ? ((jlo + (t)) >= cw - 8 && (jlo + (t)) <= cw) : (VAR == 1 ? (AT_KBASE(t) <= qlo + 30) : (AT_KBASE(t) <= qlo + 31)))
    if (VAR == 0) {
        const float* tab = relb + h * 257;
        for (int j = tid; j < 639; j += 512) { int rel = 575 - j; rel = rel < -128 ? -128 : (rel > 128 ? 128 : rel); Rt[j] = tab[rel + 128] * LOG2E; }
    }
    if (VAR == 2) {
        const float* lf = LOGF + (size_t)(b * 10 + h) * S; const int kend = P0 + QB;
        f32x4 v = (f32x4){0.f, 0.f, 0.f, 0.f};
        if (4 * tid < kend) v = *(const f32x4*)(lf + 4 * tid);
        v[1] += v[0]; v[2] += v[1]; v[3] += v[2];
        float tot = v[3];
#pragma unroll
        for (int o = 1; o < 64; o <<= 1) { const float t_ = lane_read(tot, lane >= o ? lane - o : lane); if (lane >= o) tot += t_; }
        if (lane == 63) li_l[0] = tot;
        __syncthreads();
        float base = tot - v[3];
        for (int w = 0; w < wid; ++w) base += ((LAS float*)(lds + OFF_WS))[w * 64];
        if (4 * tid < kend) *(LAS f32x4*)(cumL + 4 * tid) = (f32x4){(base + v[0]) * LOG2E, (base + v[1]) * LOG2E, (base + v[2]) * LOG2E, (base + v[3]) * LOG2E};
    }
    bf16x8 qr[8];
    { const bf16_t* qp = Qh + hb + (size_t)(qlo + r32) * HD + hi * 8;
#pragma unroll
      for (int d0 = 0; d0 < 8; ++d0) qr[d0] = *(const bf16x8*)(qp + d0 * 16); }
    const int sr = tid >> 4, sc = (tid & 15) * 8, vst0 = v_st(sr, sc), vst1 = v_st(32 + sr, sc), kws = AT_KSWZ(sr, sc * 2);
    const int vb0 = (int)(unsigned)(size_t)V_lds + v_rd_base(lane);
    bf16x8 st_k0, st_k1, st_v0, st_v1;
#define AT_SLOAD(k0) do { const bf16_t* kp_ = Kp + (size_t)((k0) + sr) * HD + sc; const bf16_t* vp_ = Vp + (size_t)((k0) + sr) * HD + sc; \
        st_k0 = *(const bf16x8*)kp_; st_k1 = *(const bf16x8*)(kp_ + 32 * HD); st_v0 = *(const bf16x8*)vp_; st_v1 = *(const bf16x8*)(vp_ + 32 * HD); } while (0)
#define AT_SWRITE(bf) do { *(LAS bf16x8*)(K_lds + (bf) * SHM_K + kws) = st_k0; *(LAS bf16x8*)(K_lds + (bf) * SHM_K + kws + 32 * 256) = st_k1; \
        *(LAS bf16x8*)(V_lds + (bf) * SHM_V + vst0) = st_v0; *(LAS bf16x8*)(V_lds + (bf) * SHM_V + vst1) = st_v1; } while (0)
    AT_SLOAD(AT_KBASE(0)); asm volatile("s_waitcnt vmcnt(0)" ::: "memory"); AT_SWRITE(0);
    __syncthreads();
    float m_reg = -1e30f, l_reg = 0.f, carry = 0.f;
    f32x16 o[4] = {};
#define AT_STEP(BUF, t) do { \
        const bool more_ = (t) + 1 < NT; \
        if (more_) AT_SLOAD(AT_KBASE((t) + 1)); \
        if (AT_ACT(t)) { \
            const int kb_ = AT_KBASE(t); f32x16 p0, p1; bf16x8 pa0, pa1, pa2, pa3; \
            qkt<BUF>(p0, p1, K_lds, r32, hi, qr); \
            tile_math(p0, p1, kb_, pa0, pa1, pa2, pa3); \
            pv_tile<BUF>(o, vb0, pa0, pa1, pa2, pa3); \
        } \
        if (more_) { asm volatile("s_waitcnt vmcnt(0)" ::: "memory"); AT_SWRITE((BUF) ^ 1); } \
        if (VAR == 1) { const bool done_ = __all(carry < SB_DONE); if (lane == 0) flags[((t) & 1) * 8 + wid] = done_ ? 1u : 0u; } \
        __syncthreads(); \
    } while (0)
    auto tile_math = [&](f32x16& p0, f32x16& p1, int kb, bf16x8& pa0, bf16x8& pa1, bf16x8& pa2, bf16x8& pa3) __attribute__((always_inline)) {
        const int dq = qpos - kb - 4 * hi;
        if (VAR == 1) {
            const bool need_mask = kb + 63 >= qlo;
            f32x16 n0, n1;
#pragma unroll
            for (int r = 0; r < 16; ++r) { const float z = p0[r]; const float lp = __builtin_amdgcn_logf(1.0f + __builtin_amdgcn_exp2f(-fabsf(z))); n0[r] = fminf(-z, 0.f) - lp;
                                           const float y = p1[r]; const float lq = __builtin_amdgcn_logf(1.0f + __builtin_amdgcn_exp2f(-fabsf(y))); n1[r] = fminf(-y, 0.f) - lq; }
            if (need_mask) {
#pragma unroll
                for (int r = 0; r < 16; ++r) { const int c = (r & 3) + 8 * (r >> 2);
                    if (dq - c <= 0) { n0[r] = 0.f; p0[r] = -__builtin_inff(); }
                    if (dq - c - 32 <= 0) { n1[r] = 0.f; p1[r] = -__builtin_inff(); } }
            }
            float A[8], Bp[8];
#pragma unroll
            for (int q = 0; q < 4; ++q) { A[q] = (n0[4 * q] + n0[4 * q + 1]) + (n0[4 * q + 2] + n0[4 * q + 3]); A[4 + q] = (n1[4 * q] + n1[4 * q + 1]) + (n1[4 * q + 2] + n1[4 * q + 3]); }
#pragma unroll
            for (int q = 0; q < 8; ++q) Bp[q] = partner(A[q], hi);
            float st = 0.f;
#pragma unroll
            for (int q = 7; q >= 0; --q) {
                const float after = carry + st + (hi == 0 ? Bp[q] : 0.f);
                if (q >= 4) { const int r0 = 4 * (q - 4);
                    float tl = after; p1[r0 + 3] = __builtin_amdgcn_exp2f(p1[r0 + 3] + n1[r0 + 3] + tl); tl += n1[r0 + 3]; p1[r0 + 2] = __builtin_amdgcn_exp2f(p1[r0 + 2] + n1[r0 + 2] + tl); tl += n1[r0 + 2];
                    p1[r0 + 1] = __builtin_amdgcn_exp2f(p1[r0 + 1] + n1[r0 + 1] + tl); tl += n1[r0 + 1]; p1[r0] = __builtin_amdgcn_exp2f(p1[r0] + n1[r0] + tl); }
                else { const int r0 = 4 * q;
                    float tl = after; p0[r0 + 3] = __builtin_amdgcn_exp2f(p0[r0 + 3] + n0[r0 + 3] + tl); tl += n0[r0 + 3]; p0[r0 + 2] = __builtin_amdgcn_exp2f(p0[r0 + 2] + n0[r0 + 2] + tl); tl += n0[r0 + 2];
                    p0[r0 + 1] = __builtin_amdgcn_exp2f(p0[r0 + 1] + n0[r0 + 1] + tl); tl += n0[r0 + 1]; p0[r0] = __builtin_amdgcn_exp2f(p0[r0] + n0[r0] + tl); }
                st += A[q] + Bp[q];
            }
            carry += st;
            pack_p(p0, p1, pa0, pa1, pa2, pa3);
        } else {
            if (VAR == 0) {
                const LAS float* rp = Rt + (575 - (qpos - kb) + 4 * hi);
#pragma unroll
                for (int r = 0; r < 16; ++r) { const int c = (r & 3) + 8 * (r >> 2); p0[r] += rp[c]; p1[r] += rp[c + 32]; }
            } else {
                const LAS float* cp = cumL + kb + 4 * hi;
#pragma unroll
                for (int q = 0; q < 4; ++q) { const f32x4 c0 = *(const LAS f32x4*)(cp + 8 * q), c1 = *(const LAS f32x4*)(cp + 32 + 8 * q);
                    p0[4 * q] -= c0[0]; p0[4 * q + 1] -= c0[1]; p0[4 * q + 2] -= c0[2]; p0[4 * q + 3] -= c0[3];
                    p1[4 * q] -= c1[0]; p1[4 * q + 1] -= c1[1]; p1[4 * q + 2] -= c1[2]; p1[4 * q + 3] -= c1[3]; }
                if (kb + 63 > qlo) {
#pragma unroll
                    for (int r = 0; r < 16; ++r) { const int c = (r & 3) + 8 * (r >> 2);
                        if (dq - c < 0) p0[r] = -__builtin_inff();
                        if (dq - c - 32 < 0) p1[r] = -__builtin_inff(); }
                }
            }
            float pmax = p0[0];
#pragma unroll
            for (int r = 1; r < 16; ++r) pmax = fmaxf(pmax, p0[r]);
#pragma unroll
            for (int r = 0; r < 16; ++r) pmax = fmaxf(pmax, p1[r]);
            pmax = xchg_max(pmax, hi);
            float mn, alpha;
            if (__all(pmax - m_reg <= THR2)) { mn = m_reg; alpha = 1.f; }
            else { mn = fmaxf(m_reg, pmax); alpha = __builtin_amdgcn_exp2f(m_reg - mn); m_reg = mn; }
            float ps = 0.f;
#pragma unroll
            for (int r = 0; r < 16; ++r) { p0[r] = __builtin_amdgcn_exp2f(p0[r] - mn); p1[r] = __builtin_amdgcn_exp2f(p1[r] - mn); ps += p0[r] + p1[r]; }
            ps = xchg_sum(ps, hi);
            l_reg = l_reg * alpha + ps;
            if (__any(alpha < 1.f)) {
                if (hi == 0) al_l[r32] = alpha;
                asm volatile("s_waitcnt lgkmcnt(0)" ::: "memory");
                float av[16];
#pragma unroll
                for (int r = 0; r < 16; ++r) av[r] = al_l[crow(r, hi)];
#pragma unroll
                for (int d = 0; d < 4; ++d)
#pragma unroll
                    for (int r = 0; r < 16; ++r) o[d][r] *= av[r];
            }
            pack_p(p0, p1, pa0, pa1, pa2, pa3);
        }
    };
    for (int t = 0; t < NT; t += 2) {
        AT_STEP(0, t);
        if (VAR == 1) { unsigned all_ = 1u; for (int w = 0; w < 8; ++w) all_ &= flags[(t & 1) * 8 + w]; if (all_) break; }
        if (t + 1 >= NT) break;
        AT_STEP(1, t + 1);
        if (VAR == 1) { unsigned all_ = 1u; for (int w = 0; w < 8; ++w) all_ &= flags[((t + 1) & 1) * 8 + w]; if (all_) break; }
    }
    float rli[16];
    if (VAR != 1) {
        if (hi == 0) li_l[r32] = l_reg;
        asm volatile("s_waitcnt lgkmcnt(0)" ::: "memory");
#pragma unroll
        for (int r = 0; r < 16; ++r) rli[r] = __builtin_amdgcn_rcpf(li_l[crow(r, hi)]);
    }
    unsigned char* Ow8 = (unsigned char*)OB + (size_t)(b * S + qlo) * D + g * HD;
#pragma unroll
    for (int r = 0; r < 16; ++r) { const int orow = crow(r, hi);
#pragma unroll
        for (int d0 = 0; d0 < 4; ++d0) { const float v = VAR != 1 ? o[d0][r] * rli[r] : o[d0][r];
            const float vn = lane_read(v, lane ^ 1);
            if ((r32 & 1) == 0) *(unsigned short*)(Ow8 + (size_t)orow * D + d0 * 32 + r32) = (unsigned short)__builtin_amdgcn_cvt_pk_fp8_f32(clamp8(v * 16.0f), clamp8(vn * 16.0f), 0, false); } }
    __syncthreads();
#undef AT_STEP
#undef AT_SLOAD
#undef AT_SWRITE
#undef AT_KBASE
#undef AT_ACT
}

template <int VAR>
__device__ __forceinline__ void attn_queue(const bf16_t* Qh, const bf16_t* Kh, const bf16_t* Vh, bf16_t* OB, const float* relb, const float* LOGF, unsigned* qhead, LAS unsigned char* lds, int wave0) {
    FRESH_TID(); FRESH_LDS(lds);
    volatile LAS unsigned* qslot = (volatile LAS unsigned*)(lds + OFF_MISC) + 32;
    constexpr int NHV = VAR == 0 ? 12 : 10, NITEMS = 8 * NHV * 8;
    for (;;) {
        if (tid == 0) qslot[0] = __hip_atomic_fetch_add(qhead, 1u, __ATOMIC_RELAXED, __HIP_MEMORY_SCOPE_AGENT);
        __syncthreads();
        const int idx = (int)qslot[0];
        __syncthreads();
        if (idx >= NITEMS) break;
        const int qb = 7 - idx / (8 * NHV), bh = idx % (8 * NHV);
        attn_item<VAR>(Qh, Kh, Vh, OB, relb, LOGF, bh / NHV, bh % NHV, qb, lds, tid);
    }
}
__device__ __forceinline__ void attn_phase(const bf16_t* Qh, const bf16_t* Kh, const bf16_t* Vh, bf16_t* OB, const float* relb, const float* LOGF, unsigned* qheads, LAS unsigned char* lds, int wave0) {
    attn_queue<2>(Qh, Kh, Vh, OB, relb, LOGF, qheads + 0, lds, wave0);
    attn_queue<0>(Qh, Kh, Vh, OB, relb, LOGF, qheads + 64, lds, wave0);
    attn_queue<1>(Qh, Kh, Vh, OB, relb, LOGF, qheads + 128, lds, wave0);
}
}
namespace mk {
#define XB_TMO      128
#define XB_XCNT(j)  (256  + 64 * (j))
#define XB_XSUB(j)  (1280 + 64 * (j))
#define XB_XGEN(j)  (2304 + 64 * (j))
#define XB_TOP      3328
#define XB_TOPGEN   3392
#define XCD_BAR_WORDS 3456
#define XB_SPIN_CAP (1u << 22)

__device__ __forceinline__ unsigned xb_ld(unsigned* p)              { return __hip_atomic_load(p, __ATOMIC_RELAXED, __HIP_MEMORY_SCOPE_AGENT); }
__device__ __forceinline__ unsigned xb_add(unsigned* p, unsigned v) { return __hip_atomic_fetch_add(p, v, __ATOMIC_RELAXED, __HIP_MEMORY_SCOPE_AGENT); }
__device__ __forceinline__ unsigned xb_xcc_id() { return (unsigned)__builtin_amdgcn_s_getreg((3 << 11) | 20) & 0xFu; }
#define XB_SPIN(cond, bar) do { unsigned _sp = 0; while (cond) { __builtin_amdgcn_s_sleep(1); \
    if ((++_sp & 255u) == 0u) { if (xb_ld(&(bar)[XB_TMO])) break; if (_sp > XB_SPIN_CAP) { atomicAdd(&(bar)[XB_TMO], 1u); break; } } } } while (0)

struct XcdBarrier {
    unsigned* bar; unsigned x;
    volatile LAS unsigned* st;
};

__device__ __forceinline__ XcdBarrier xcd_barrier_post(unsigned* bar, volatile LAS unsigned* st, bool is_t0) {
    XcdBarrier b; b.bar = bar; b.x = xb_xcc_id(); b.st = st;
    if (is_t0) (void)xb_add(&bar[XB_XCNT(b.x)], 1u);
    return b;
}
__device__ __forceinline__ void xcd_barrier_complete(unsigned* bar, unsigned x, unsigned& nloc, unsigned& nx) {
    const unsigned G = gridDim.x * gridDim.y * gridDim.z;
    unsigned sum, cnt, mine, sp = 0u;
    for (;;) {
        sum = 0u; cnt = 0u; mine = 0u;
#pragma unroll
        for (unsigned j = 0; j < 16; ++j) { const unsigned c = xb_ld(&bar[XB_XCNT(j)]); sum += c; cnt += (c > 0u) ? 1u : 0u; mine = (j == x) ? c : mine; }
        if (sum == G) break;
        __builtin_amdgcn_s_sleep(1);
        if ((++sp & 255u) == 0u) { if (xb_ld(&bar[XB_TMO])) break; if (sp > XB_SPIN_CAP) { atomicAdd(&bar[XB_TMO], 1u); break; } }
    }
    nloc = mine > 0u ? mine : 1u; nx = cnt > 0u ? cnt : 1u;
}

__device__ __forceinline__ void xcd_barrier(const XcdBarrier& b, bool is_t0) {
    asm volatile("s_waitcnt vmcnt(0)" ::: "memory");
    __syncthreads();
    if (is_t0) {
        unsigned* bar = b.bar;
        __builtin_amdgcn_s_waitcnt(0);
        unsigned nloc = b.st[0], nx = b.st[1];
        if (nloc == 0u) { xcd_barrier_complete(bar, b.x, nloc, nx); b.st[0] = nloc; b.st[1] = nx; }
        const unsigned old = xb_add(&bar[XB_XSUB(b.x)], 1u);
        const unsigned gen = old / nloc;
        if (old + 1u == (gen + 1u) * nloc) {
            __builtin_amdgcn_fence(__ATOMIC_RELEASE, "agent");
            asm volatile("s_waitcnt vmcnt(0)" ::: "memory");
            const unsigned og = xb_add(&bar[XB_TOP], 1u);
            const unsigned tg = og / nx;
            if (og + 1u == (tg + 1u) * nx) xb_add(&bar[XB_TOPGEN], 1u);
            else XB_SPIN(xb_ld(&bar[XB_TOPGEN]) == tg, bar);
            __builtin_amdgcn_fence(__ATOMIC_ACQUIRE, "agent");
            xb_add(&bar[XB_XGEN(b.x)], 1u);
            asm volatile("s_waitcnt vmcnt(0)" ::: "memory");
        } else {
            XB_SPIN(xb_ld(&bar[XB_XGEN(b.x)]) == gen, bar);
            __builtin_amdgcn_fence(__ATOMIC_ACQUIRE, "agent");
            asm volatile("s_waitcnt vmcnt(0)" ::: "memory");
        }
    }
    __syncthreads();
}

constexpr int PH_PER_LAYER = 8;
typedef const __attribute__((address_space(4))) Args* KArgs;
#define KARGS() ({ KArgs p_ = (KArgs)__builtin_amdgcn_kernarg_segment_ptr(); asm volatile("" : "+s"(p_)); p_; })
#define GRID_BAR() do { KArgs k_ = KARGS(); XcdBarrier b_; b_.bar = (unsigned*)(k_->ws + WS_CTL) + CW_BAR; b_.x = xb_xcc_id(); b_.st = (volatile LAS unsigned*)(lds + MISC_OFF) + 8; unsigned z_ = 0u; asm volatile("" : "+v"(z_)); const bool t0_ = (wave0 == 0) && (__builtin_amdgcn_mbcnt_hi(~0u, __builtin_amdgcn_mbcnt_lo(~0u, z_)) == 0u);     xcd_barrier(b_, t0_); } while (0)
__global__ void __launch_bounds__(NWAVES * 64, 2) mk_fwd(Args a_unused) {
    extern __shared__ __attribute__((aligned(16))) unsigned char lds_raw[];
    LAS unsigned char* lds = (LAS unsigned char*)lds_raw;
    const int wave0 = __builtin_amdgcn_readfirstlane((int)threadIdx.x >> 6);
    for (int u = threadIdx.x; u < (LDS_BYTES - LDSCTL_OFF) / 4; u += NWAVES * 64) ((LAS unsigned*)(lds + LDSCTL_OFF))[u] = 0u;
    __syncthreads();
    int lo, hi;
    { KArgs k = KARGS(); lo = k->ph_lo; hi = k->ph_hi;
      if (hi - lo > 1) (void)xcd_barrier_post((unsigned*)(k->ws + WS_CTL) + CW_BAR, (volatile LAS unsigned*)(lds + MISC_OFF) + 8, threadIdx.x == 0); }
#define IN(k) (lo <= (k) && (k) < hi)
#define BOTH(k) (IN(k) && IN((k) + 1))
#pragma unroll
    for (int l = 0; l < 2; ++l) {
        const int pb = PH_PER_LAYER * l;
        if (IN(pb + 0)) { KArgs k = KARGS(); conv_phase(k, l, lds, wave0); }
        if (IN(pb + 1) && l == 0) {
            KArgs k = KARGS(); unsigned char* ws = k->ws;
            const float* xin = k->in[0];
            prep_phase<true>(xin, (bf16_t*)(ws + WS_XB8N), (float*)(ws + WS_RSTD), k->in[2] + (size_t)l * D * PW, k->in[1] + (size_t)l * D, k->in[3] + l * 10, (float*)(ws + WS_LOGF), lds, wave0);
            if (BOTH(pb + 1)) GRID_BAR();
        }
        if (l == 1 && IN(pb + 0) && IN(pb + 2)) GRID_BAR();
        if (IN(pb + 2)) {
            KArgs k = KARGS(); unsigned char* ws = k->ws;
            pg8::Gemm g{(const bf16_t*)(ws + WS_XB8N), (const bf16_t*)(ws + WS_WIN), M, 12288, D}; pg8::StaticOrder So; FRESH_BID(); So.init(M, 12288, G, bid);
            pg8::EpiQKV4 E{(bf16_t*)(ws + WS_Q), (const float*)(ws + WS_RSTD), 0.08838834764831845f * 1.4426950408889634f, US_INV};
            { LAS unsigned char* lds_ = lds; FRESH_LDS(lds_); FRESH_TID(); pg8::gemm_phase<pg8::EpiQKV4, pg8::StaticOrder, true, true, true>(lds_, g, So, E, tid); }
            if (BOTH(pb + 2)) GRID_BAR();
        }
        if (IN(pb + 3)) {
            KArgs k = KARGS(); unsigned char* ws = k->ws;
            at::attn_phase((const bf16_t*)(ws + WS_Q), (const bf16_t*)(ws + WS_K), (const bf16_t*)(ws + WS_V), (bf16_t*)(ws + WS_OB), k->in[4] + (size_t)l * 12 * 257, (const float*)(ws + WS_LOGF),
                           (unsigned*)(ws + WS_CTL) + CW_QUEUE + 256 * l, lds, wave0);
            if (BOTH(pb + 3)) GRID_BAR();
        }
        if (IN(pb + 4)) {
            KArgs k = KARGS(); unsigned char* ws = k->ws;
            pg8::Gemm g{(const bf16_t*)(ws + WS_OB), (const bf16_t*)(ws + WS_WOUT), M, D, D}; pg8::StaticOrder So; FRESH_BID(); So.init(M, D, G, bid);
            if (l == 0) { pg8::EpiResidB16<true> E{k->in[0], US_INV * (1.0f / 16.0f), (bf16_t*)(ws + WS_XB)};
                { LAS unsigned char* lds_ = lds; FRESH_LDS(lds_); FRESH_TID(); pg8::gemm_phase<pg8::EpiResidB16<true>, pg8::StaticOrder, false, true, true>(lds_, g, So, E, tid); } }
            else { pg8::EpiResidB16<false> E{ws + WS_X2, US_INV * (1.0f / 16.0f), (bf16_t*)(ws + WS_XB)};
                { LAS unsigned char* lds_ = lds; FRESH_LDS(lds_); FRESH_TID(); pg8::gemm_phase<pg8::EpiResidB16<false>, pg8::StaticOrder, false, true, true>(lds_, g, So, E, tid); } }
            if (BOTH(pb + 4)) GRID_BAR();
        }
        if (IN(pb + 5)) {
            KArgs k = KARGS(); unsigned char* ws = k->ws;
            pg8::Gemm g{(const bf16_t*)(ws + WS_XB), (const bf16_t*)(ws + WS_WQK), M, 2048, D}; pg8::StaticOrder So; FRESH_BID(); So.init(M, 2048, G, bid);
            pg8::EpiPlainF32<2048> E{(float*)(ws + WS_SC)};
            { LAS unsigned char* lds_ = lds; FRESH_LDS(lds_); FRESH_TID(); pg8::gemm_phase<pg8::EpiPlainF32<2048>, pg8::StaticOrder, true, true>(lds_, g, So, E, tid); }
            if (BOTH(pb + 5)) GRID_BAR();
        }
        if (IN(pb + 6)) {
            KArgs k = KARGS(); unsigned char* ws = k->ws;
            peer_u_phase((const float*)(ws + WS_SC), (const unsigned char*)(ws + WS_U16), (const bf16_t*)(ws + WS_XB), (int*)(ws + WS_K), (float*)(ws + WS_K + 8 * MiB), lds, wave0);
            if (BOTH(pb + 6)) GRID_BAR();
        }
        if (IN(pb + 7)) {
            KArgs k = KARGS(); unsigned char* ws = k->ws;
            if (l == 0) peer_v_phase<false>((const int*)(ws + WS_K), (const float*)(ws + WS_K + 8 * MiB), (const unsigned char*)(ws + WS_U16) + (size_t)NE * D, (const bf16_t*)(ws + WS_XB), ws + WS_X2, nullptr,
                                            ws + WS_XB8N, (float*)(ws + WS_RSTD), (float*)(ws + WS_LOGF), k->in[2] + (size_t)D * PW, k->in[1] + D, k->in[3] + 10, lds, wave0);
            else peer_v_phase<true>((const int*)(ws + WS_K), (const float*)(ws + WS_K + 8 * MiB), (const unsigned char*)(ws + WS_U16) + (size_t)NE * D, (const bf16_t*)(ws + WS_XB), k->out, k->in[12],
                                    nullptr, nullptr, nullptr, nullptr, nullptr, nullptr, lds, wave0);
            if (BOTH(pb + 7)) GRID_BAR();
        }
    }
#undef IN
#undef BOTH
}

static int g_grid = 0;
static void launch_phases(Args a, int lo, int hi, hipStream_t st) {
    a.ph_lo = lo; a.ph_hi = hi;
    hipLaunchKernelGGL(mk_fwd, dim3(g_grid), dim3(NWAVES * 64), LDS_BYTES, st, a);
}
}

extern "C" void kernel_launch(void* const* d_in, const int* in_sizes, int n_in, void* d_out, int out_size, void* d_ws, size_t ws_size, hipStream_t stream) {
    (void)in_sizes; (void)n_in; (void)out_size;
    using namespace mk;
    if (g_grid == 0) {
        if (ws_size < 2048 * MiB) { fprintf(stderr, "kernel_launch: workspace too small (%zu)\n", ws_size); g_grid = -1; return; }
        if (hipFuncSetAttribute((const void*)mk_fwd, hipFuncAttributeMaxDynamicSharedMemorySize, LDS_BYTES) != hipSuccess) { fprintf(stderr, "kernel_launch: hipFuncSetAttribute failed\n"); g_grid = -1; return; }
        int dev = 0, cus = 0; (void)hipGetDevice(&dev); (void)hipDeviceGetAttribute(&cus, hipDeviceAttributeMultiprocessorCount, dev);
        g_grid = cus > 0 ? cus : 256;
    }
    if (g_grid < 0) return;
    unsigned char* ws = (unsigned char*)d_ws; float* out = (float*)d_out;
    (void)hipMemsetAsync(ws + WS_CTL, 0, CTL_ZERO_BYTES, stream);
    Args a{};
    for (int i = 0; i < 13; ++i) a.in[i] = (const float*)d_in[i];
    a.out = out; a.ws = ws;
    launch_phases(a, 0, 2 * PH_PER_LAYER, stream);
}
```

```cpp
#include <hip/hip_runtime.h>
#include <cstdio>
#include <cstdint>
namespace pg8 {
#define PG8_LAS __attribute__((address_space(3)))
typedef unsigned short bf16_t;
typedef short bf16x8 __attribute__((ext_vector_type(8)));
typedef float f32x4 __attribute__((ext_vector_type(4)));
typedef unsigned u32x4 __attribute__((ext_vector_type(4)));
typedef unsigned u32x2 __attribute__((ext_vector_type(2)));
constexpr int BM = 256, BK = 64, HALF = 128, HTB = HALF * BK * 2  , STAGE_BYTES = 8 * HTB, NXCD = 8, WGM = 8;

__host__ __device__ __forceinline__ int lds_byte(int r, int c) { const int st = (r >> 4) * 2 + (c >> 5), rr = r & 15, cc = c & 31, ob = rr * 64 + cc * 2; return st * 1024 + (ob ^ (((ob >> 9) & 1) << 5)); }
__host__ __device__ __forceinline__ void stage_rc(int b, int& R, int& C) { const int st = b / 1024, sb = b % 1024, swz = sb ^ (((sb >> 9) & 1) << 5); R = (st >> 1) * 16 + swz / 64; C = (st & 1) * 32 + (swz % 64) / 2; }
__host__ __device__ __forceinline__ int perm32(int rho) { const int n = rho >> 4, i = rho & 15; return 8 * (i >> 2) + 4 * n + (i & 3); }

struct Unit { int pm, pn; };
struct Gemm { const bf16_t* A; const bf16_t* Bt; int M, N, K; };

struct StaticOrder {
    int nM, nN, nwg, G, c;
    __host__ __device__ void init(int M, int N, int G_, int c_) { nM = M / BM; nN = N / BM; nwg = nM * nN; G = G_; c = c_; }
    __host__ __device__ bool next(int i, Unit& u) const {
        const long L = (long)i * G + c; if (L >= nwg) return false;
        int wgid = (int)L; { const int q = nwg / NXCD, r = nwg % NXCD, xcd = wgid % NXCD, off = wgid / NXCD; wgid = (xcd < r ? xcd * (q + 1) : r * (q + 1) + (xcd - r) * q) + off; }
        const int nig = WGM * nN, gid = wgid / nig, fm = gid * WGM, gsz = (nM - fm) < WGM ? (nM - fm) : WGM;
        u.pm = fm + ((wgid % nig) % gsz); u.pn = (wgid % nig) / gsz; return true;
    }
    __device__ __forceinline__ void a_ready(const Unit&) const {}
    __device__ __forceinline__ void done(const Unit&) const {}
};
__device__ __forceinline__ unsigned cvt_pk_bf16(float lo, float hi) { unsigned r; asm volatile("v_cvt_pk_bf16_f32 %0, %1, %2" : "=v"(r) : "v"(lo), "v"(hi)); return r; }
typedef float f32x2 __attribute__((ext_vector_type(2)));
__device__ __forceinline__ f32x2 gelu_pk(f32x2 v) {
    const f32x2 av = __builtin_elementwise_abs(v), d = av * 0.2316418882f + 1.0f;
    f32x2 t; t.x = __builtin_amdgcn_rcpf(d.x); t.y = __builtin_amdgcn_rcpf(d.y);
    f32x2 q = t * 0.5307027145f + (-0.7265760135f); q = q * t + 0.7107068705f; q = q * t + (-0.142248368f); q = q * t + 0.127414796f; q = q * t;
    const f32x2 s = (v * v) * (-0.72134752044f);
    f32x2 e; e.x = __builtin_amdgcn_exp2f(s.x); e.y = __builtin_amdgcn_exp2f(s.y);
    const f32x2 m = v * (q * e), r = v - m;
    f32x2 o; o.x = v.x < 0.f ? m.x : r.x; o.y = v.y < 0.f ? m.y : r.y; return o;
}
#define EPI_FRESH_LANE() { unsigned z_ = 0u; asm volatile("" : "+v"(z_)); const int l_ = (int)__builtin_amdgcn_mbcnt_hi(~0u, __builtin_amdgcn_mbcnt_lo(~0u, z_)); fr = l_ & 15; fq = l_ >> 4; }
typedef __amdgpu_buffer_rsrc_t rsrc_t;
__device__ __forceinline__ rsrc_t mkrsrc(const void* p, unsigned bytes) { return __builtin_amdgcn_make_buffer_rsrc((void*)p, (short)0, (int)bytes, 0x00020000); }
template <int LDC> struct EpiPlainF32 {
    static constexpr bool PERM = false, AFTER_DRAIN = false;
    float* C;
    __device__ __forceinline__ void operator()(const f32x4 (&acc)[2][2][4][2], const Unit& u, int wr, int wc, int fr, int fq) const {
        EPI_FRESH_LANE();
        const rsrc_t rc = mkrsrc(C, 16384u * LDC * 4u);
        const int vo = ((wr * 64 + fr) * LDC + wc * 32 + 4 * fq) * 4, so = (u.pm * BM * LDC + u.pn * BM) * 4;
#pragma unroll
        for (int ai = 0; ai < 2; ++ai)
#pragma unroll
            for (int m = 0; m < 4; ++m)
#pragma unroll
                for (int bj = 0; bj < 2; ++bj)
#pragma unroll
                    for (int n = 0; n < 2; ++n) __builtin_amdgcn_raw_buffer_store_b128(__builtin_bit_cast(u32x4, acc[ai][bj][m][n]), rc, vo, so + ((ai * HALF + m * 16) * LDC + bj * HALF + n * 16) * 4, 0);
    }
};
template <int LDC> struct EpiRowScaleF32 {
    static constexpr bool PERM = false, AFTER_DRAIN = false;
    float* C; const float* rs;
    __device__ __forceinline__ void operator()(const f32x4 (&acc)[2][2][4][2], const Unit& u, int wr, int wc, int fr, int fq) const {
        const rsrc_t rc = mkrsrc(C, 16384u * LDC * 4u), rr = mkrsrc(rs, 16384u * 4u);
        const int vo = ((wr * 64 + fr) * LDC + wc * 32 + 4 * fq) * 4, vr = (wr * 64 + fr) * 4;
        const int so = (u.pm * BM * LDC + u.pn * BM) * 4, sr = u.pm * BM * 4;
#pragma unroll
        for (int ai = 0; ai < 2; ++ai)
#pragma unroll
            for (int m = 0; m < 4; ++m) { const float s = __builtin_bit_cast(float, __builtin_amdgcn_raw_buffer_load_b32(rr, vr, sr + (ai * HALF + m * 16) * 4, 0));
#pragma unroll
                for (int bj = 0; bj < 2; ++bj)
#pragma unroll
                    for (int n = 0; n < 2; ++n) { const f32x4 v = acc[ai][bj][m][n] * s; __builtin_amdgcn_raw_buffer_store_b128(__builtin_bit_cast(u32x4, v), rc, vo, so + ((ai * HALF + m * 16) * LDC + bj * HALF + n * 16) * 4, 0); } }
    }
};
template <bool BASE_F32> struct EpiResidB16 {
    static constexpr bool PERM = false, AFTER_DRAIN = false;
    const void* base; float ascale; bf16_t* xb;
    __device__ __forceinline__ void operator()(const f32x4 (&acc)[2][2][4][2], const Unit& u, int wr, int wc, int fr, int fq) const {
        EPI_FRESH_LANE();
        constexpr int LDC = 4096;
        const rsrc_t rb = mkrsrc(base, 16384u * LDC * (BASE_F32 ? 4u : 2u)), rx = mkrsrc(xb, 16384u * LDC * 2u);
        const int vo = ((wr * 64 + fr) * LDC + wc * 32 + 4 * fq) * 2;
        const int so = (u.pm * BM * LDC + u.pn * BM) * 2;
        f32x4 ra[2][2], rb2[2][2];
#define EPI_LD(dst, g_) do { _Pragma("unroll") for (int bj = 0; bj < 2; ++bj) _Pragma("unroll") for (int n = 0; n < 2; ++n) { \
            const int o = so + ((((g_) >> 2) * HALF + ((g_) & 3) * 16) * LDC + bj * HALF + n * 16) * 2; \
            if constexpr (BASE_F32) dst[bj][n] = __builtin_bit_cast(f32x4, __builtin_amdgcn_raw_buffer_load_b128(rb, vo * 2, o * 2, 0)); \
            else { const u32x2 t_ = __builtin_amdgcn_raw_buffer_load_b64(rb, vo, o, 0); dst[bj][n] = (f32x4){__builtin_bit_cast(float, t_.x << 16), __builtin_bit_cast(float, t_.x & 0xffff0000u), __builtin_bit_cast(float, t_.y << 16), __builtin_bit_cast(float, t_.y & 0xffff0000u)}; } } } while (0)
#define EPI_ST(src, g_) do { _Pragma("unroll") for (int bj = 0; bj < 2; ++bj) _Pragma("unroll") for (int n = 0; n < 2; ++n) { \
            const int o = so + ((((g_) >> 2) * HALF + ((g_) & 3) * 16) * LDC + bj * HALF + n * 16) * 2; \
            const f32x4 v = src[bj][n] + acc[(g_) >> 2][bj][(g_) & 3][n] * ascale; \
            u32x2 w; w.x = cvt_pk_bf16(v[0], v[1]); w.y = cvt_pk_bf16(v[2], v[3]); __builtin_amdgcn_raw_buffer_store_b64(w, rx, vo, o, 0); } } while (0)
        EPI_LD(ra, 0);
        EPI_LD(rb2, 1); EPI_ST(ra, 0);
        EPI_LD(ra, 2); EPI_ST(rb2, 1);
        EPI_LD(rb2, 3); EPI_ST(ra, 2);
        EPI_LD(ra, 4); EPI_ST(rb2, 3);
        EPI_LD(rb2, 5); EPI_ST(ra, 4);
        EPI_LD(ra, 6); EPI_ST(rb2, 5);
        EPI_LD(rb2, 7); EPI_ST(ra, 6);
        EPI_ST(rb2, 7);
#undef EPI_LD
#undef EPI_ST
    }
};
struct EpiQKV {
    static constexpr bool PERM = true, AFTER_DRAIN = false;
    bf16_t* Q; const float* rs; float qscale;
    __device__ __forceinline__ void operator()(const f32x4 (&acc)[2][2][4][2], const Unit& u, int wr, int wc, int fr, int fq) const {
        const rsrc_t rq = mkrsrc(Q, 3u * 16384u * 4096u * 2u), rr = mkrsrc(rs, 16384u * 4u);
        const int colt = u.pn * BM, which = colt >> 12, cw = colt & 4095, gt = cw >> 7;
        const int b = (u.pm * BM) >> 11, st = (u.pm * BM) & 2047;
        const float sc = which == 0 ? qscale : 1.f;
        const int so = (int)(((unsigned)which << 26) + (((unsigned)(b * 32 + gt) * 2048u + (unsigned)st) << 7)) * 2;
        const int vo = (((wr * 64 + fr) << 7) + wc * 32 + 8 * fq) * 2, vr = (wr * 64 + fr) * 4, sr = u.pm * BM * 4;
#pragma unroll
        for (int ai = 0; ai < 2; ++ai)
#pragma unroll
            for (int m = 0; m < 4; ++m) { const float f = sc * __builtin_bit_cast(float, __builtin_amdgcn_raw_buffer_load_b32(rr, vr, sr + (ai * HALF + m * 16) * 4, 0));
#pragma unroll
                for (int bj = 0; bj < 2; ++bj) {
                    const f32x4 v0 = acc[ai][bj][m][0] * f, v1 = acc[ai][bj][m][1] * f;
                    u32x4 w; w.x = cvt_pk_bf16(v0[0], v0[1]); w.y = cvt_pk_bf16(v0[2], v0[3]); w.z = cvt_pk_bf16(v1[0], v1[1]); w.w = cvt_pk_bf16(v1[2], v1[3]);
                    __builtin_amdgcn_raw_buffer_store_b128(w, rq, vo, so + ((bj * 2048 + ai * HALF + m * 16) << 7) * 2, 0); } }
    }
};

struct EpiQKV4 {
    static constexpr bool PERM = false, AFTER_DRAIN = false;
    bf16_t* Q; const float* rs; float qscale, wscale;
    __device__ __forceinline__ void operator()(const f32x4 (&acc)[2][2][4][2], const Unit& u, int wr, int wc, int fr, int fq) const {
        EPI_FRESH_LANE();
        const rsrc_t rq = mkrsrc(Q, 3u * 16384u * 4096u * 2u), rr = mkrsrc(rs, 16384u * 4u);
        const int colt = u.pn * BM, which = colt >> 12, cw = colt & 4095, gt = cw >> 7;
        const int b = (u.pm * BM) >> 11, st = (u.pm * BM) & 2047;
        const float sc = (which == 0 ? qscale : 1.f) * wscale;
        const int so = (int)(((unsigned)which << 26) + (((unsigned)(b * 32 + gt) * 2048u + (unsigned)st) << 7)) * 2;
        const int vo = (((wr * 64 + fr) << 7) + wc * 32 + 4 * fq) * 2, vr = (wr * 64 + fr) * 4, sr = u.pm * BM * 4;
        unsigned rsv[2][4];
#pragma unroll
        for (int ai = 0; ai < 2; ++ai)
#pragma unroll
            for (int m = 0; m < 4; ++m) rsv[ai][m] = __builtin_amdgcn_raw_buffer_load_b32(rr, vr, sr + (ai * HALF + m * 16) * 4, 0);
#pragma unroll
        for (int ai = 0; ai < 2; ++ai)
#pragma unroll
            for (int m = 0; m < 4; ++m) { const float f = sc * __builtin_bit_cast(float, rsv[ai][m]);
#pragma unroll
                for (int bj = 0; bj < 2; ++bj)
#pragma unroll
                    for (int n = 0; n < 2; ++n) { const f32x4 v0 = acc[ai][bj][m][n] * f; u32x2 w; w.x = cvt_pk_bf16(v0[0], v0[1]); w.y = cvt_pk_bf16(v0[2], v0[3]);
                        __builtin_amdgcn_raw_buffer_store_b64(w, rq, vo, so + (((bj * 2048 + ai * HALF + m * 16) << 7) + n * 16) * 2, 0); } }
    }
};

typedef int i32x8 __attribute__((ext_vector_type(8)));
template <bool F8> struct FragT { typedef bf16x8 type; };
template <> struct FragT<true> { typedef i32x8 type; };
__device__ __forceinline__ f32x4 mma_bf16(bf16x8 a, bf16x8 b, f32x4 c) { return __builtin_amdgcn_mfma_f32_16x16x32_bf16(a, b, c, 0, 0, 0); }
__device__ __forceinline__ f32x4 mma_bf16(i32x8, i32x8, f32x4 c) { return c; }
template <class Epi, class Sched, bool ALIGN_EPI = false, bool SP2 = false, bool F8 = false>
__device__ __forceinline__ void gemm_phase(PG8_LAS unsigned char* lds, const Gemm g, const Sched& S, const Epi& E, int tid_in) {
    int tid_ = tid_in;
    const int tid = tid_, wid = __builtin_amdgcn_readfirstlane(tid >> 6), lane = tid & 63, wr = wid >> 2, wc = wid & 3, fr = lane & 15, fq = lane >> 4;
    constexpr int EB = F8 ? 1 : 2;
    constexpr int K = 4096; constexpr int nt = (K * EB) / (BK * 2);
    unsigned voffA[2], voffB[2];
#pragma unroll
    for (int i = 0; i < 2; ++i) { int R, C; stage_rc(tid * 16 + i * 8192, R, C); const int Rb = Epi::PERM ? ((R & ~31) + perm32(R & 31)) : R;
        voffA[i] = (unsigned)(R * K * EB + C * 2); voffB[i] = (unsigned)(Rb * K * EB + C * 2); }
    const size_t kstep = (size_t)(BK * 2);
    const size_t hstep = (size_t)HALF * K * EB;
    const size_t tstep = 2 * hstep;
    const unsigned ldsw = (unsigned)wid * 1024u;
    const int aoff = F8 ? lds_byte(wr * 64 + fr, fq * 16) + (fq & 1) * 16 : lds_byte(wr * 64 + fr, fq * 8), boff = F8 ? lds_byte(wc * 32 + fr, fq * 16) + (fq & 1) * 16 : lds_byte(wc * 32 + fr, fq * 8);
    const int aoff1 = aoff + (F8 ? 16 - 32 * (fq & 1) : 0);
    const int f8o0_unused = 0; (void)f8o0_unused;
#define PG8_SA(b, h) (((b) * 2 + (h)) * HTB)
#define PG8_SB(b, h) ((4 + (b) * 2 + (h)) * HTB)
#define PG8_STAGE_X(bufoff, gbase, voff, rs_, base_) do { const int so_ = (int)((const char*)(gbase) - (const char*)(base_)); _Pragma("unroll") for (int _i = 0; _i < 2; ++_i) \
        __builtin_amdgcn_raw_ptr_buffer_load_lds(rs_, (PG8_LAS void*)(lds + (bufoff) + ldsw + _i * 8192), 16, (int)(voff)[_i], so_, 0, 0); } while (0)
#define PG8_LDA(dst, b, h) do { if constexpr (F8) { _Pragma("unroll") for (int m = 0; m < 4; ++m) { const u32x4 lo_ = *(const PG8_LAS u32x4*)(lds + PG8_SA(b, h) + aoff + m * 2048), hi_ = *(const PG8_LAS u32x4*)(lds + PG8_SA(b, h) + aoff1 + m * 2048); \
            dst[m][0] = (i32x8){(int)lo_[0], (int)lo_[1], (int)lo_[2], (int)lo_[3], (int)hi_[0], (int)hi_[1], (int)hi_[2], (int)hi_[3]}; } } \
        else { _Pragma("unroll") for (int m = 0; m < 4; ++m) _Pragma("unroll") for (int k = 0; k < 2; ++k) dst[m][k] = *(const PG8_LAS frag_t*)(lds + PG8_SA(b, h) + aoff + m * 2048 + k * 1024); } } while (0)
#define PG8_LDB(dst, b, h) do { if constexpr (F8) { _Pragma("unroll") for (int n = 0; n < 2; ++n) { const u32x4 lo_ = *(const PG8_LAS u32x4*)(lds + PG8_SB(b, h) + boff + n * 2048), hi_ = *(const PG8_LAS u32x4*)(lds + PG8_SB(b, h) + boff + (aoff1 - aoff) + n * 2048); \
            dst[n][0] = (i32x8){(int)lo_[0], (int)lo_[1], (int)lo_[2], (int)lo_[3], (int)hi_[0], (int)hi_[1], (int)hi_[2], (int)hi_[3]}; } } \
        else { _Pragma("unroll") for (int n = 0; n < 2; ++n) _Pragma("unroll") for (int k = 0; k < 2; ++k) dst[n][k] = *(const PG8_LAS frag_t*)(lds + PG8_SB(b, h) + boff + n * 2048 + k * 1024); } } while (0)
#define PG8_MMA(ai, bj, At, Bt) do { __builtin_amdgcn_s_setprio(1); _Pragma("unroll") for (int m = 0; m < 4; ++m) _Pragma("unroll") for (int n = 0; n < 2; ++n) { \
        if constexpr (F8) acc[ai][bj][m][n] = __builtin_amdgcn_mfma_scale_f32_16x16x128_f8f6f4(Bt[n][0], At[m][0], acc[ai][bj][m][n], 0, 0, 0, 0x7f7f7f7f, 0, 0x7f7f7f7f); \
        else { _Pragma("unroll") for (int k = 0; k < 2; ++k) acc[ai][bj][m][n] = mma_bf16(Bt[n][k], At[m][k], acc[ai][bj][m][n]); } } __builtin_amdgcn_s_setprio(0); } while (0)
#define PG8_WAIT_V(n) asm volatile("s_waitcnt vmcnt(" #n ")" ::: "memory")
#define PG8_WAIT_L(n) asm volatile("s_waitcnt lgkmcnt(" #n ")" ::: "memory")
#define PG8_BAR __builtin_amdgcn_s_barrier()
#define PG8_SCHED __builtin_amdgcn_sched_barrier(0)
    const __amdgpu_buffer_rsrc_t rsA = __builtin_amdgcn_make_buffer_rsrc((void*)g.A, (short)0, (int)((size_t)g.M * K * EB), 0x00020000), rsB = __builtin_amdgcn_make_buffer_rsrc((void*)g.Bt, (short)0, (int)((size_t)g.N * K * EB), 0x00020000);
    Unit cur, nxt; int ui = 0;
    if (!S.next(0, cur)) return;
    f32x4 acc[2][2][4][2];
#pragma unroll
    for (int a = 0; a < 2; ++a)
#pragma unroll
        for (int b = 0; b < 2; ++b)
#pragma unroll
            for (int m = 0; m < 4; ++m)
#pragma unroll
                for (int n = 0; n < 2; ++n) acc[a][b][m][n] = (f32x4){0.f, 0.f, 0.f, 0.f};
    typedef typename FragT<F8>::type frag_t;
    frag_t At[4][F8 ? 1 : 2], B0[2][F8 ? 1 : 2], B1[2][F8 ? 1 : 2];
    const char* cA = (const char*)g.A + (size_t)cur.pm * tstep; const char* cB = (const char*)g.Bt + (size_t)cur.pn * tstep;
    S.a_ready(cur);
    if constexpr (SP2) {
        PG8_STAGE_X(PG8_SB(0, 0), cB, voffB, rsB, g.Bt); PG8_STAGE_X(PG8_SB(0, 1), cB + hstep, voffB, rsB, g.Bt); PG8_STAGE_X(PG8_SA(0, 0), cA, voffA, rsA, g.A); PG8_STAGE_X(PG8_SA(0, 1), cA + hstep, voffA, rsA, g.A);
        if (wr == 1) PG8_BAR;
        PG8_WAIT_V(2); PG8_BAR;
        PG8_STAGE_X(PG8_SB(1, 0), cB + kstep, voffB, rsB, g.Bt); PG8_STAGE_X(PG8_SA(1, 0), cA + kstep, voffA, rsA, g.A); PG8_STAGE_X(PG8_SB(1, 1), cB + hstep + kstep, voffB, rsB, g.Bt);
        PG8_WAIT_V(6); PG8_BAR;
    } else {
        PG8_STAGE_X(PG8_SB(0, 0), cB, voffB, rsB, g.Bt); PG8_STAGE_X(PG8_SA(0, 0), cA, voffA, rsA, g.A); PG8_STAGE_X(PG8_SB(0, 1), cB + hstep, voffB, rsB, g.Bt); PG8_STAGE_X(PG8_SA(0, 1), cA + hstep, voffA, rsA, g.A);
        if (wr == 1) PG8_BAR;
        PG8_WAIT_V(4); PG8_BAR;
        PG8_STAGE_X(PG8_SB(1, 0), cB + kstep, voffB, rsB, g.Bt); PG8_STAGE_X(PG8_SA(1, 0), cA + kstep, voffA, rsA, g.A); PG8_STAGE_X(PG8_SB(1, 1), cB + hstep + kstep, voffB, rsB, g.Bt);
        PG8_WAIT_V(6); PG8_BAR;
    }
    for (;;) {
        const bool has_next = S.next(ui + 1, nxt);
        const char* nA = has_next ? (const char*)g.A + (size_t)nxt.pm * tstep : cA; const char* nB = has_next ? (const char*)g.Bt + (size_t)nxt.pn * tstep : cB;
        for (int t = 0; t < nt; t += 2) {
            const bool last = (t == nt - 2);
            const char* a1 = cA + (size_t)(t + 1) * kstep;
            const char* a2 = last ? nA : cA + (size_t)(t + 2) * kstep; const char* b2 = last ? nB : cB + (size_t)(t + 2) * kstep;
            const char* a3 = a2 + kstep; const char* b3 = b2 + kstep;
            if (last && has_next) S.a_ready(nxt);
            if constexpr (SP2) {
            PG8_LDB(B0, 0, 0); PG8_LDB(B1, 0, 1); PG8_SCHED; PG8_LDA(At, 0, 0); PG8_STAGE_X(PG8_SA(1, 1), a1 + hstep, voffA, rsA, g.A);
            PG8_WAIT_V(8); PG8_WAIT_L(0); PG8_BAR; PG8_MMA(0, 0, At, B0); PG8_MMA(0, 1, At, B1); PG8_BAR; PG8_SCHED;
            PG8_LDA(At, 0, 1); PG8_STAGE_X(PG8_SB(0, 0), b2, voffB, rsB, g.Bt); PG8_STAGE_X(PG8_SB(0, 1), b2 + hstep, voffB, rsB, g.Bt); PG8_STAGE_X(PG8_SA(0, 0), a2, voffA, rsA, g.A);
            PG8_WAIT_V(8); PG8_WAIT_L(0); PG8_BAR; PG8_MMA(1, 0, At, B0); PG8_MMA(1, 1, At, B1); PG8_BAR; PG8_SCHED;
            PG8_LDB(B0, 1, 0); PG8_LDB(B1, 1, 1); PG8_SCHED; PG8_LDA(At, 1, 0); PG8_STAGE_X(PG8_SA(0, 1), a2 + hstep, voffA, rsA, g.A);
            PG8_WAIT_V(8); PG8_WAIT_L(0); PG8_BAR; PG8_MMA(0, 0, At, B0); PG8_MMA(0, 1, At, B1); PG8_BAR; PG8_SCHED;
            PG8_LDA(At, 1, 1); PG8_STAGE_X(PG8_SB(1, 0), b3, voffB, rsB, g.Bt); PG8_STAGE_X(PG8_SB(1, 1), b3 + hstep, voffB, rsB, g.Bt); PG8_STAGE_X(PG8_SA(1, 0), a3, voffA, rsA, g.A);
            PG8_WAIT_V(8); PG8_WAIT_L(0); PG8_BAR; PG8_MMA(1, 0, At, B0); PG8_MMA(1, 1, At, B1); PG8_BAR; PG8_SCHED;
            } else {
            PG8_LDB(B0, 0, 0); PG8_SCHED; PG8_LDA(At, 0, 0); PG8_STAGE_X(PG8_SA(1, 1), a1 + hstep, voffA, rsA, g.A);
            PG8_WAIT_L(8); PG8_BAR; PG8_WAIT_L(0); PG8_MMA(0, 0, At, B0); PG8_BAR; PG8_SCHED;
            PG8_LDB(B1, 0, 1); PG8_STAGE_X(PG8_SB(0, 0), b2, voffB, rsB, g.Bt);
            PG8_BAR; PG8_WAIT_L(0); PG8_MMA(0, 1, At, B1); PG8_BAR;
            PG8_LDA(At, 0, 1); PG8_STAGE_X(PG8_SA(0, 0), a2, voffA, rsA, g.A);
            PG8_BAR; PG8_WAIT_L(0); PG8_MMA(1, 0, At, B0); PG8_BAR; PG8_SCHED;
            PG8_STAGE_X(PG8_SB(0, 1), b2 + hstep, voffB, rsB, g.Bt);
            PG8_WAIT_V(6); PG8_BAR; PG8_MMA(1, 1, At, B1); PG8_BAR;
            PG8_LDB(B0, 1, 0); PG8_SCHED; PG8_LDA(At, 1, 0); PG8_STAGE_X(PG8_SA(0, 1), a2 + hstep, voffA, rsA, g.A);
            PG8_WAIT_L(8); PG8_BAR; PG8_WAIT_L(0); PG8_MMA(0, 0, At, B0); PG8_BAR; PG8_SCHED;
            PG8_LDB(B1, 1, 1); PG8_STAGE_X(PG8_SB(1, 0), b3, voffB, rsB, g.Bt);
            PG8_BAR; PG8_WAIT_L(0); PG8_MMA(0, 1, At, B1); PG8_BAR;
            PG8_LDA(At, 1, 1); PG8_STAGE_X(PG8_SA(1, 0), a3, voffA, rsA, g.A);
            PG8_BAR; PG8_WAIT_L(0); PG8_MMA(1, 0, At, B0); PG8_BAR; PG8_SCHED;
            PG8_STAGE_X(PG8_SB(1, 1), b3 + hstep, voffB, rsB, g.Bt);
            PG8_WAIT_V(6); PG8_BAR; PG8_MMA(1, 1, At, B1); PG8_BAR;
            }
        }
        if constexpr (ALIGN_EPI) { if (wr == 0) PG8_BAR; }
        if constexpr (!Epi::AFTER_DRAIN) { E(acc, cur, wr, wc, fr, fq); S.done(cur); }
        if (!has_next) break;
#pragma unroll
        for (int a = 0; a < 2; ++a)
#pragma unroll
            for (int b = 0; b < 2; ++b)
#pragma unroll
                for (int m = 0; m < 4; ++m)
#pragma unroll
                    for (int n = 0; n < 2; ++n) acc[a][b][m][n] = (f32x4){0.f, 0.f, 0.f, 0.f};
        cur = nxt; cA = nA; cB = nB; ++ui;
        if constexpr (ALIGN_EPI) { if (wr == 1) PG8_BAR; }
    }
    PG8_WAIT_V(0);
    if constexpr (!ALIGN_EPI) { if (wr == 0) PG8_BAR; }
    PG8_BAR;
    if constexpr (Epi::AFTER_DRAIN) { E.fused(acc, cur, wr, wc, fr, fq, lds, wid, lane); S.done(cur); }
#undef PG8_SA
#undef PG8_SB
#undef PG8_STAGE_X
#undef PG8_LDA
#undef PG8_LDB
#undef PG8_MMA
#undef PG8_WAIT_V
#undef PG8_WAIT_L
#undef PG8_BAR
#undef PG8_SCHED
}
}
#define GAS __attribute__((address_space(1)))
#define LAS __attribute__((address_space(3)))
typedef unsigned short bf16_t;
typedef unsigned u32x4 __attribute__((ext_vector_type(4)));
typedef unsigned u32x2 __attribute__((ext_vector_type(2)));
typedef float f32x4 __attribute__((ext_vector_type(4)));
typedef float f32x2 __attribute__((ext_vector_type(2)));
typedef float f32x16 __attribute__((ext_vector_type(16)));
typedef short bf16x8 __attribute__((ext_vector_type(8)));
typedef short s16x4 __attribute__((ext_vector_type(4)));
typedef __bf16 bf16x2_t __attribute__((ext_vector_type(2)));

namespace mk {
constexpr int M = 16384, D = 4096, S = 2048, NB = 8, PW = 12298, NH = 32, NE = 16384;
constexpr int NWAVES = 8;
constexpr size_t MiB = 1u << 20;
constexpr size_t WS_CTL = 0, CTL_ZERO_BYTES = 1 * MiB;
constexpr size_t WS_RSTD = 2 * MiB, WS_LOGF = 3 * MiB, WS_WQK = 4 * MiB, WS_WOUT = 20 * MiB, WS_WIN = 52 * MiB, WS_U16 = 148 * MiB, WS_V16 = 276 * MiB,
                 WS_XB = 404 * MiB, WS_Q = 532 * MiB, WS_K = 660 * MiB, WS_V = 788 * MiB, WS_OB = 916 * MiB, WS_X2 = 1792 * MiB, WS_END = 2048 * MiB;
constexpr size_t WS_XB8N = WS_OB + 64 * MiB;
constexpr size_t WS_SC = WS_Q;
constexpr int CW_BAR = 4096;
constexpr int CW_QUEUE = 16384;
constexpr int RING_BYTES = 131072, LDSCTL_OFF = RING_BYTES, MISC_OFF = LDSCTL_OFF + 320, LDS_BYTES = 147456;

struct Args { const float* in[13]; float* out; unsigned char* ws; int ph_lo, ph_hi; };

__device__ __forceinline__ unsigned f2bf(float f) { unsigned u = __builtin_bit_cast(unsigned, f); return (u + 0x7fffu + ((u >> 16) & 1u)) >> 16; }
__device__ __forceinline__ unsigned pk2(float lo, float hi) { return f2bf(lo) | (f2bf(hi) << 16); }
__device__ __forceinline__ float bf_lo(unsigned w) { return __builtin_bit_cast(float, w << 16); }
__device__ __forceinline__ float bf_hi(unsigned w) { return __builtin_bit_cast(float, w & 0xffff0000u); }
__device__ __forceinline__ float lane_read(float v, int src_lane) { return __builtin_bit_cast(float, __builtin_amdgcn_ds_bpermute(src_lane << 2, __builtin_bit_cast(int, v))); }
__device__ __forceinline__ int lane_read(int v, int src_lane) { return __builtin_amdgcn_ds_bpermute(src_lane << 2, v); }
constexpr float US = 1024.0f, VS = 32.0f, US_INV = 1.0f / 1024.0f, VS_INV = 1.0f / 32.0f;
__device__ __forceinline__ float clamp8(float x) { return fminf(fmaxf(x, -224.0f), 224.0f); }
__device__ __forceinline__ float logsig(float z) { return fminf(z, 0.f) - 0.6931471805599453f * __builtin_amdgcn_logf(1.0f + __builtin_amdgcn_exp2f(-fabsf(z) * 1.4426950408889634f)); }
__device__ __forceinline__ float gelu_erf(float v) {
    const float av = fabsf(v), t = __builtin_amdgcn_rcpf(av * 0.2316418882f + 1.0f);
    float q = t * 0.5307027145f + (-0.7265760135f); q = q * t + 0.7107068705f; q = q * t + (-0.142248368f); q = q * t + 0.127414796f; q = q * t;
    const float e = __builtin_amdgcn_exp2f((v * v) * (-0.72134752044f));
    const float m = v * (q * e);
    return v < 0.f ? m : v - m;
}
#define LDS_WAIT() asm volatile("s_waitcnt lgkmcnt(0)" ::: "memory")
#define FRESH_LDS(l) do { unsigned v_ = (unsigned)(size_t)(l); asm volatile("" : "+s"(v_)); (l) = (LAS unsigned char*)(size_t)v_; } while (0)
#define FRESH_BID() int bid = blockIdx.x, G = gridDim.x; asm volatile("" : "+s"(bid), "+s"(G))
#define FRESH_TID() int tid; { int w_ = wave0, l_; { unsigned z_ = 0u; asm volatile("" : "+v"(z_)); l_ = (int)__builtin_amdgcn_mbcnt_hi(~0u, __builtin_amdgcn_mbcnt_lo(~0u, z_)); } asm volatile("" : "+s"(w_)); tid = w_ * 64 + l_; } const int lane = tid & 63, wave = __builtin_amdgcn_readfirstlane(tid >> 6); (void)lane; (void)wave

__device__ __forceinline__ unsigned wave_max_u32(unsigned v) {
    v = max(v, (unsigned)__builtin_amdgcn_update_dpp(0, (int)v, 0x111, 0xF, 0xF, true));
    v = max(v, (unsigned)__builtin_amdgcn_update_dpp(0, (int)v, 0x112, 0xF, 0xF, true));
    v = max(v, (unsigned)__builtin_amdgcn_update_dpp(0, (int)v, 0x114, 0xF, 0xF, true));
    v = max(v, (unsigned)__builtin_amdgcn_update_dpp(0, (int)v, 0x118, 0xF, 0xF, true));
    v = max(v, (unsigned)__builtin_amdgcn_update_dpp((int)v, (int)v, 0x142, 0xA, 0xF, false));
    v = max(v, (unsigned)__builtin_amdgcn_update_dpp((int)v, (int)v, 0x143, 0xC, 0xF, false));
    return (unsigned)__builtin_amdgcn_readlane((int)v, 63);
}
__device__ __forceinline__ float wave_sum_dpp(float x) {
    int v = __builtin_bit_cast(int, x);
#define DPP_ADD(ctrl, rm, bc, oldv) v = __builtin_bit_cast(int, __builtin_bit_cast(float, v) + __builtin_bit_cast(float, __builtin_amdgcn_update_dpp(oldv, v, ctrl, rm, 0xF, bc)))
    DPP_ADD(0x111, 0xF, true, 0); DPP_ADD(0x112, 0xF, true, 0); DPP_ADD(0x114, 0xF, true, 0); DPP_ADD(0x118, 0xF, true, 0);
#undef DPP_ADD
    const float r0 = __builtin_bit_cast(float, __builtin_amdgcn_readlane(v, 15)), r1 = __builtin_bit_cast(float, __builtin_amdgcn_readlane(v, 31)), r2 = __builtin_bit_cast(float, __builtin_amdgcn_readlane(v, 47)), r3 = __builtin_bit_cast(float, __builtin_amdgcn_readlane(v, 63));
    return (r0 + r1) + (r2 + r3);
}
__device__ __forceinline__ unsigned ordkey(float x) { const unsigned u = __builtin_bit_cast(unsigned, x); return (u & 0x80000000u) ? ~u : (u | 0x80000000u); }
__device__ __forceinline__ void transpose_item(const float* W, int K, int ldw, int ncols, const float* gain, bf16_t* WT, LAS float* scr, int item, int lane) {
    const int nblk = ncols / 32, kb = item / nblk, nb = item % nblk, k0 = 64 * kb, n0 = 32 * nb;
#pragma unroll 8
    for (int i = 0; i < 32; ++i) { const int kk = 2 * i + (lane >> 5); float v = W[(size_t)(k0 + kk) * ldw + n0 + (lane & 31)]; if (gain) v *= gain[k0 + kk]; scr[kk * 33 + (lane & 31)] = v; }
    LDS_WAIT(); asm volatile("" ::: "memory");
    const int c = lane & 7;
#pragma unroll
    for (int j = 0; j < 4; ++j) { const int n = (lane >> 3) + 8 * j; const LAS float* s = scr + (8 * c) * 33 + n;
        u32x4 o; o.x = pk2(s[0 * 33], s[1 * 33]); o.y = pk2(s[2 * 33], s[3 * 33]); o.z = pk2(s[4 * 33], s[5 * 33]); o.w = pk2(s[6 * 33], s[7 * 33]);
        *(u32x4*)(WT + (size_t)(n0 + n) * K + k0 + 8 * c) = o; }
    LDS_WAIT(); asm volatile("" ::: "memory");
}

typedef const __attribute__((address_space(4))) Args* KArgsT;
__device__ __forceinline__ unsigned pk4_fp8(float a, float b, float c, float d) { int p = __builtin_amdgcn_cvt_pk_fp8_f32(clamp8(a), clamp8(b), 0, false); p = __builtin_amdgcn_cvt_pk_fp8_f32(clamp8(c), clamp8(d), p, true); return (unsigned)p; }
__device__ __forceinline__ void transpose_item8(const float* W, int K, int ldw, int ncols, const float* gain, float scale, unsigned char* WT, LAS float* scr, int item, int lane) {
    const int nblk = ncols / 32, kb = item / nblk, nb = item % nblk, k0 = 64 * kb, n0 = 32 * nb;
    const int kr = lane >> 3, nq = (lane & 7) * 4;
    f32x4 v[8];
#pragma unroll
    for (int i = 0; i < 8; ++i) { const float* p = W + (size_t)(k0 + 8 * i + kr) * ldw + n0 + nq; v[i] = (f32x4){p[0], p[1], p[2], p[3]}; }
#pragma unroll
    for (int i = 0; i < 8; ++i) { const int kk = 8 * i + kr; const float g = (gain ? gain[k0 + kk] : 1.0f) * scale; LAS float* d = scr + kk * 33 + nq; d[0] = v[i][0] * g; d[1] = v[i][1] * g; d[2] = v[i][2] * g; d[3] = v[i][3] * g; }
    LDS_WAIT(); asm volatile("" ::: "memory");
    const int c = lane & 7;
#pragma unroll
    for (int j = 0; j < 4; ++j) { const int n = (lane >> 3) + 8 * j; const LAS float* s = scr + (8 * c) * 33 + n;
        u32x2 o; o.x = pk4_fp8(s[0 * 33], s[1 * 33], s[2 * 33], s[3 * 33]); o.y = pk4_fp8(s[4 * 33], s[5 * 33], s[6 * 33], s[7 * 33]);
        *(u32x2*)(WT + (size_t)(n0 + n) * K + k0 + 8 * c) = o; }
    LDS_WAIT(); asm volatile("" ::: "memory");
}
__device__ __forceinline__ void conv_phase(KArgsT ka, int l, LAS unsigned char* lds, int wave0) {
    FRESH_TID(); FRESH_LDS(lds); FRESH_BID();
    unsigned char* ws = ka->ws;
    const float* ln1 = ka->in[1] + (size_t)l * D; const float* w_in = ka->in[2] + (size_t)l * D * PW; const float* w_out = ka->in[5] + (size_t)l * D * D;
    const float* ln2 = ka->in[6] + (size_t)l * D; const float* wq = ka->in[7] + (size_t)l * D * 2048;
    const float* k1 = ka->in[8] + (size_t)l * 8 * 128 * 128; const float* k2 = ka->in[9] + (size_t)l * 8 * 128 * 128;
    const float* pu = ka->in[10] + (size_t)l * NE * D; const float* pv = ka->in[11] + (size_t)l * NE * D;
    bf16_t* WQK = (bf16_t*)(ws + WS_WQK); bf16_t* WOUT = (bf16_t*)(ws + WS_WOUT); bf16_t* WIN = (bf16_t*)(ws + WS_WIN); bf16_t* U16 = (bf16_t*)(ws + WS_U16); bf16_t* V16 = (bf16_t*)(ws + WS_V16);
    {
        LAS float* Ks = (LAS float*)lds;
        LAS float* Ws = (LAS float*)(lds + 128 * 132 * 4);
        for (int it = bid; it < 1024; it += G) {
            const int gi = it >> 6, c0 = (it & 63) * 64;
            const float* key = ((gi & 1) ? k2 : k1) + (size_t)(gi >> 1) * 128 * 128;
            for (int i = tid; i < 4096; i += 512) { const int r = i >> 5, c4 = (i & 31) * 4; *(LAS f32x4*)(Ks + r * 132 + c4) = *(const f32x4*)(key + r * 128 + c4); }
            for (int i = tid; i < 2048; i += 512) { const int r = i >> 5, c4 = (i & 31) * 4; *(LAS f32x4*)(Ws + r * 132 + c4) = *(const f32x4*)(wq + (size_t)(c0 + r) * 2048 + gi * 128 + c4); }
            __syncthreads();
            const int tc = tid & 15, tn = tid >> 4;
            float acc[4][4];
#pragma unroll
            for (int i = 0; i < 4; ++i)
#pragma unroll
                for (int j = 0; j < 4; ++j) acc[i][j] = 0.f;
#pragma unroll 2
            for (int d = 0; d < 128; d += 4) {
                f32x4 kv[4], wv[4];
#pragma unroll
                for (int i = 0; i < 4; ++i) kv[i] = *(const LAS f32x4*)(Ks + (4 * tn + i) * 132 + d);
#pragma unroll
                for (int j = 0; j < 4; ++j) wv[j] = *(const LAS f32x4*)(Ws + (tc + 16 * j) * 132 + d);
#pragma unroll
                for (int i = 0; i < 4; ++i)
#pragma unroll
                    for (int j = 0; j < 4; ++j) acc[i][j] += kv[i][0] * wv[j][0] + kv[i][1] * wv[j][1] + kv[i][2] * wv[j][2] + kv[i][3] * wv[j][3];
            }
#pragma unroll
            for (int j = 0; j < 4; ++j) { const int c = c0 + tc + 16 * j; const float gg = ln2[c];
#pragma unroll
                for (int i = 0; i < 4; ++i) WQK[(size_t)(gi * 128 + 4 * tn + i) * D + c] = (bf16_t)f2bf(acc[i][j] * gg); }
            __syncthreads();
        }
        __syncthreads();
    }
    const int gw = bid * NWAVES + wave, NGW = G * NWAVES;
    {
        unsigned char* U8 = (unsigned char*)U16; unsigned char* V8 = U8 + (size_t)NE * D;
        f32x4 gq[4][4];
#pragma unroll
        for (int i = 0; i < 4; ++i)
#pragma unroll
            for (int q = 0; q < 4; ++q) gq[i][q] = *(const f32x4*)(ln2 + 1024 * i + 16 * lane + 4 * q) * US;
        for (int r = gw; r < NE; r += NGW) {
            const float* us = pu + (size_t)r * D + 16 * lane; const float* vs = pv + (size_t)r * D + 16 * lane;
            f32x4 uu[4][4], vv[4][4];
#pragma unroll
            for (int i = 0; i < 4; ++i)
#pragma unroll
                for (int q = 0; q < 4; ++q) { uu[i][q] = *(const f32x4*)(us + 1024 * i + 4 * q); vv[i][q] = *(const f32x4*)(vs + 1024 * i + 4 * q); }
#pragma unroll
            for (int i = 0; i < 4; ++i) { u32x4 ou, ov;
#pragma unroll
                for (int q = 0; q < 4; ++q) { const f32x4 a_ = uu[i][q] * gq[i][q], b_ = vv[i][q] * VS; ou[q] = pk4_fp8(a_[0], a_[1], a_[2], a_[3]); ov[q] = pk4_fp8(b_[0], b_[1], b_[2], b_[3]); }
                *(u32x4*)(U8 + (size_t)r * D + 1024 * i + 16 * lane) = ou; *(u32x4*)(V8 + (size_t)r * D + 1024 * i + 16 * lane) = ov; }
        }
    }
    {
        LAS float* scr = (LAS float*)(lds + wave * 16384);
        constexpr int I_O = (D / 64) * (D / 32), I_IN = (D / 64) * (12288 / 32);
        for (int it = gw; it < I_O + I_IN; it += NGW) {
            if (it < I_O) transpose_item8(w_out, D, D, D, nullptr, US, (unsigned char*)WOUT, scr, it, lane);
            else transpose_item8(w_in, D, PW, 12288, ln1, US, (unsigned char*)WIN, scr, it - I_O, lane);
        }
    }
}

template <bool WITH_F>
__device__ __forceinline__ void prep_phase(const float* X, bf16_t* XB, float* RSTD, const float* w_in, const float* ln1, const float* bf, float* LOGF, LAS unsigned char* lds, int wave0) {
    FRESH_TID(); FRESH_LDS(lds); FRESH_BID();
    LAS unsigned short* gfs = (LAS unsigned short*)lds;
    if (WITH_F) {
        __syncthreads();
        for (int c = tid; c < D; c += 512) { const float g = ln1[c]; const float* wr = w_in + (size_t)c * PW + 12288;
#pragma unroll
            for (int j = 0; j < 10; ++j) gfs[j * D + c] = (unsigned short)f2bf(wr[j] * g); }
        __syncthreads();
    }
    const int gw = bid * NWAVES + wave, NGW = G * NWAVES;
    for (int m = gw; m < M; m += NGW) {
        const f32x4* xr = (const f32x4*)(X + (size_t)m * D) + lane;
        f32x4 v[16]; float ss = 0.f;
#pragma unroll
        for (int i = 0; i < 16; ++i) { v[i] = xr[64 * i]; ss += (v[i][0] * v[i][0] + v[i][1] * v[i][1]) + (v[i][2] * v[i][2] + v[i][3] * v[i][3]); }
        ss = wave_sum_dpp(ss);
        const float rstd = rsqrtf(ss * (1.0f / D) + 1e-6f);
        if (WITH_F) {
            unsigned* o8 = (unsigned*)((unsigned char*)XB + (size_t)m * D) + lane;
#pragma unroll
            for (int i = 0; i < 16; ++i) o8[64 * i] = pk4_fp8(v[i][0], v[i][1], v[i][2], v[i][3]);
        } else {
        u32x2* o = (u32x2*)(XB + (size_t)m * D) + lane;
#pragma unroll
        for (int i = 0; i < 16; ++i) { u32x2 w; w.x = pk2(v[i][0], v[i][1]); w.y = pk2(v[i][2], v[i][3]); o[64 * i] = w; }
        }
        if (lane == 0) RSTD[m] = rstd;
        if (WITH_F) {
            float mine = 0.f;
#pragma unroll 1
            for (int j = 0; j < 10; ++j) { float s = 0.f;
#pragma unroll
                for (int i = 0; i < 16; ++i) { const u32x2 gp = *(const LAS u32x2*)(gfs + j * D + 256 * i + 4 * lane);
                    s += (v[i][0] * bf_lo(gp.x) + v[i][1] * bf_hi(gp.x)) + (v[i][2] * bf_lo(gp.y) + v[i][3] * bf_hi(gp.y)); }
                s = wave_sum_dpp(s); if (lane == j) mine = s; }
            if (lane < 10) { const int b = m >> 11, s = m & 2047; LOGF[(size_t)(b * 10 + lane) * S + s] = logsig(mine * rstd + bf[lane]); }
        }
    }
}


__device__ __forceinline__ void load16_bf16(const bf16_t* p, float (&d)[16]) {
    const u32x4 a = *(const u32x4*)p, b = *(const u32x4*)(p + 8);
#pragma unroll
    for (int q = 0; q < 4; ++q) { d[2 * q] = bf_lo(a[q]); d[2 * q + 1] = bf_hi(a[q]); d[8 + 2 * q] = bf_lo(b[q]); d[8 + 2 * q + 1] = bf_hi(b[q]); }
}
#define RFL(x) __builtin_amdgcn_readfirstlane(x)
__device__ __forceinline__ void peer_u_phase(const float* SC, const unsigned char* U8, const bf16_t* X1, int* EIDG, float* WG, LAS unsigned char* lds, int wave0) {
    FRESH_TID(); FRESH_LDS(lds); FRESH_BID();
    LAS int* s_eid = (LAS int*)(lds + wave * 1024); LAS float* s_w = (LAS float*)(lds + wave * 1024 + 512);
    const int gw = bid * NWAVES + wave, NGW = G * NWAVES;
    const float NEG = -3.0e38f;
    for (int tok = gw; tok < M; tok += NGW) {
        const bf16_t* x1 = X1 + (size_t)tok * D;
        float xv[4][16]; float rstd_tok;
        { float ss_ = 0.f;
#pragma unroll
          for (int i = 0; i < 4; ++i) { load16_bf16(x1 + 1024 * i + 16 * lane, xv[i]);
#pragma unroll
              for (int k = 0; k < 16; ++k) ss_ += xv[i][k] * xv[i][k]; }
          rstd_tok = rsqrtf(wave_sum_dpp(ss_) * (1.0f / D) + 1e-6f); }
        const float* sc = SC + (size_t)tok * 2048;
        for (int h = 0; h < 4; ++h) {
            const float a0 = sc[h * 256 + lane], a1 = sc[h * 256 + 64 + lane], c0 = sc[h * 256 + 128 + lane], c1 = sc[h * 256 + 192 + lane];
            const float A0 = sc[(h + 4) * 256 + lane], A1 = sc[(h + 4) * 256 + 64 + lane], C0 = sc[(h + 4) * 256 + 128 + lane], C1 = sc[(h + 4) * 256 + 192 + lane];
            unsigned ka0 = (ordkey(a0) & ~127u) | (unsigned)(127 - lane), ka1 = (ordkey(a1) & ~127u) | (unsigned)(63 - lane);
            unsigned kc0 = (ordkey(c0) & ~127u) | (unsigned)(127 - lane), kc1 = (ordkey(c1) & ~127u) | (unsigned)(63 - lane);
            unsigned kA0 = (ordkey(A0) & ~127u) | (unsigned)(127 - lane), kA1 = (ordkey(A1) & ~127u) | (unsigned)(63 - lane);
            unsigned kC0 = (ordkey(C0) & ~127u) | (unsigned)(127 - lane), kC1 = (ordkey(C1) & ~127u) | (unsigned)(63 - lane);
            float v1 = 0.f, v2 = 0.f, V1 = 0.f, V2 = 0.f; int i1 = 0, i2 = 0, I1 = 0, I2 = 0;
#define RD(x, n) __builtin_bit_cast(float, __builtin_amdgcn_readlane(__builtin_bit_cast(int, x), (n) & 63))
            for (int it = 0; it < 16; ++it) {
                const unsigned m1 = wave_max_u32(max(ka0, ka1)), m2 = wave_max_u32(max(kc0, kc1)), M1 = wave_max_u32(max(kA0, kA1)), M2 = wave_max_u32(max(kC0, kC1));
                const int n1 = 127 - (int)(m1 & 127u), n2 = 127 - (int)(m2 & 127u), N1 = 127 - (int)(M1 & 127u), N2 = 127 - (int)(M2 & 127u);
                const float x1v = (n1 & 64) ? RD(a1, n1) : RD(a0, n1), x2v = (n2 & 64) ? RD(c1, n2) : RD(c0, n2), X1v = (N1 & 64) ? RD(A1, N1) : RD(A0, N1), X2v = (N2 & 64) ? RD(C1, N2) : RD(C0, N2);
                ka0 = ka0 == m1 ? 0u : ka0; ka1 = ka1 == m1 ? 0u : ka1; kc0 = kc0 == m2 ? 0u : kc0; kc1 = kc1 == m2 ? 0u : kc1;
                kA0 = kA0 == M1 ? 0u : kA0; kA1 = kA1 == M1 ? 0u : kA1; kC0 = kC0 == M2 ? 0u : kC0; kC1 = kC1 == M2 ? 0u : kC1;
                if (lane == it) { v1 = x1v; i1 = n1; v2 = x2v; i2 = n2; V1 = X1v; I1 = N1; V2 = X2v; I2 = N2; }
            }
            unsigned kd0, kd1, kd2, kd3, kD0, kD1, kD2, kD3;
            { const float va = lane_read(v1, lane >> 2), vA = lane_read(V1, lane >> 2); const int pb_ = 255 - 4 * lane;
              kd0 = (ordkey(va + lane_read(v2, (lane & 3) * 4 + 0)) & ~255u) | (unsigned)(pb_); kd1 = (ordkey(va + lane_read(v2, (lane & 3) * 4 + 1)) & ~255u) | (unsigned)(pb_ - 1);
              kd2 = (ordkey(va + lane_read(v2, (lane & 3) * 4 + 2)) & ~255u) | (unsigned)(pb_ - 2); kd3 = (ordkey(va + lane_read(v2, (lane & 3) * 4 + 3)) & ~255u) | (unsigned)(pb_ - 3);
              kD0 = (ordkey(vA + lane_read(V2, (lane & 3) * 4 + 0)) & ~255u) | (unsigned)(pb_); kD1 = (ordkey(vA + lane_read(V2, (lane & 3) * 4 + 1)) & ~255u) | (unsigned)(pb_ - 1);
              kD2 = (ordkey(vA + lane_read(V2, (lane & 3) * 4 + 2)) & ~255u) | (unsigned)(pb_ - 2); kD3 = (ordkey(vA + lane_read(V2, (lane & 3) * 4 + 3)) & ~255u) | (unsigned)(pb_ - 3); }
            float best = 0.f, Best = 0.f; int be = 0, Be = 0;
            for (int it = 0; it < 16; ++it) {
                const unsigned m = wave_max_u32(max(max(kd0, kd1), max(kd2, kd3))), Mx = wave_max_u32(max(max(kD0, kD1), max(kD2, kD3)));
                const int pos = 255 - (int)(m & 255u), Pos = 255 - (int)(Mx & 255u);
                const float bv = RD(v1, pos >> 4) + RD(v2, pos & 15), Bv = RD(V1, Pos >> 4) + RD(V2, Pos & 15);
                const int e = (__builtin_amdgcn_readlane(i1, pos >> 4) << 7) | __builtin_amdgcn_readlane(i2, pos & 15), E = (__builtin_amdgcn_readlane(I1, Pos >> 4) << 7) | __builtin_amdgcn_readlane(I2, Pos & 15);
                kd0 = kd0 == m ? 0u : kd0; kd1 = kd1 == m ? 0u : kd1; kd2 = kd2 == m ? 0u : kd2; kd3 = kd3 == m ? 0u : kd3;
                kD0 = kD0 == Mx ? 0u : kD0; kD1 = kD1 == Mx ? 0u : kD1; kD2 = kD2 == Mx ? 0u : kD2; kD3 = kD3 == Mx ? 0u : kD3;
                if (lane == it) { best = bv; be = e; Best = Bv; Be = E; }
            }
            const float mx = RD(best, 0), Mxx = RD(Best, 0);
#undef RD
            const float p = lane < 16 ? __builtin_amdgcn_exp2f((best - mx) * (1.4426950408889634f * rstd_tok)) : 0.f, P = lane < 16 ? __builtin_amdgcn_exp2f((Best - Mxx) * (1.4426950408889634f * rstd_tok)) : 0.f;
            const float sm = wave_sum_dpp(p), Sm = wave_sum_dpp(P);
            if (lane < 16) { s_eid[h * 16 + lane] = be; s_w[h * 16 + lane] = p / sm; s_eid[(h + 4) * 16 + lane] = Be; s_w[(h + 4) * 16 + lane] = P / Sm; }
        }
        LDS_WAIT(); asm volatile("" ::: "memory");
#define LOADROW8(dst, base, e) do { const u32x4* p_ = (const u32x4*)((base) + (size_t)(e) * D) + lane; _Pragma("unroll") for (int i_ = 0; i_ < 4; ++i_) dst[i_] = p_[64 * i_]; } while (0)
        {
            const float rstd = rstd_tok * US_INV;
#define UDOT8(row, j) do { float da_ = 0.f, db_ = 0.f; _Pragma("unroll") for (int i_ = 0; i_ < 4; ++i_) { _Pragma("unroll") for (int k_ = 0; k_ < 4; ++k_) { \
                unsigned w0_ = row[i_][k_]; asm volatile("" : "+v"(w0_));     \
                const f32x2 lo_ = __builtin_amdgcn_cvt_pk_f32_fp8((int)w0_, false), hi_ = __builtin_amdgcn_cvt_pk_f32_fp8((int)w0_, true); \
                da_ = fmaf(xv[i_][4 * k_], lo_[0], da_); db_ = fmaf(xv[i_][4 * k_ + 1], lo_[1], db_); da_ = fmaf(xv[i_][4 * k_ + 2], hi_[0], da_); db_ = fmaf(xv[i_][4 * k_ + 3], hi_[1], db_); } \
                asm volatile("" : "+v"(da_), "+v"(db_)); } \
            const float d_ = wave_sum_dpp(da_ + db_) * rstd; const float ge_ = gelu_erf(d_); if (lane == 0) s_w[j] *= ge_; } while (0)
            u32x4 r0[4], r1[4], r2[4];
            { const int e_ = RFL(s_eid[0]); LOADROW8(r0, U8, e_); } { const int e_ = RFL(s_eid[1]); LOADROW8(r1, U8, e_); } { const int e_ = RFL(s_eid[2]); LOADROW8(r2, U8, e_); }
            for (int j = 0; j < 126; j += 3) {
                UDOT8(r0, j);     if (j + 3 < 128) { const int e_ = RFL(s_eid[j + 3]); LOADROW8(r0, U8, e_); }
                UDOT8(r1, j + 1); if (j + 4 < 128) { const int e_ = RFL(s_eid[j + 4]); LOADROW8(r1, U8, e_); }
                UDOT8(r2, j + 2); if (j + 5 < 128) { const int e_ = RFL(s_eid[j + 5]); LOADROW8(r2, U8, e_); }
            }
            UDOT8(r0, 126); UDOT8(r1, 127);
#undef UDOT8
        }
        LDS_WAIT(); asm volatile("" ::: "memory");
        EIDG[(size_t)tok * 128 + lane] = s_eid[lane]; EIDG[(size_t)tok * 128 + 64 + lane] = s_eid[64 + lane];
        WG[(size_t)tok * 128 + lane] = s_w[lane]; WG[(size_t)tok * 128 + 64 + lane] = s_w[64 + lane];
        LDS_WAIT(); asm volatile("" ::: "memory");
    }
#undef LOADROW8
}

template <bool FINAL>
__device__ __forceinline__ void peer_v_phase(const int* EIDG, const float* WG, const unsigned char* V8, const bf16_t* X1, void* XOv, const float* fg,
                                             unsigned char* XB8n, float* RSTDn, float* LOGFn, const float* w_in_n, const float* ln1_n, const float* bf_n, LAS unsigned char* lds, int wave0) {
    FRESH_TID(); FRESH_LDS(lds); FRESH_BID();
    LAS int* s_eid = (LAS int*)(lds + 81920 + wave * 1024); LAS float* s_w = (LAS float*)(lds + 81920 + wave * 1024 + 512);
    LAS unsigned short* gfs = (LAS unsigned short*)lds;
    if (!FINAL) {
        __syncthreads();
        for (int c = tid; c < D; c += 512) { const float g = ln1_n[c]; const float* wr = w_in_n + (size_t)c * PW + 12288;
#pragma unroll
            for (int j = 0; j < 10; ++j) gfs[j * D + c] = (unsigned short)f2bf(wr[j] * g); }
        __syncthreads();
    }
    const int gw = bid * NWAVES + wave, NGW = G * NWAVES;
    for (int tok = gw; tok < M; tok += NGW) {
        s_eid[lane] = EIDG[(size_t)tok * 128 + lane]; s_eid[64 + lane] = EIDG[(size_t)tok * 128 + 64 + lane];
        s_w[lane] = WG[(size_t)tok * 128 + lane]; s_w[64 + lane] = WG[(size_t)tok * 128 + 64 + lane];
        LDS_WAIT(); asm volatile("" ::: "memory");
#define LOADROW8(dst, base, e) do { const u32x4* p_ = (const u32x4*)((base) + (size_t)(e) * D) + lane; _Pragma("unroll") for (int i_ = 0; i_ < 4; ++i_) dst[i_] = p_[64 * i_]; } while (0)
        const bf16_t* x1 = X1 + (size_t)tok * D;
        {
            float acc[4][16];
#pragma unroll
            for (int i = 0; i < 4; ++i)
#pragma unroll
                for (int k = 0; k < 16; ++k) acc[i][k] = 0.f;
#define VACC8(row, j) do { const float w_ = s_w[j]; _Pragma("unroll") for (int i_ = 0; i_ < 4; ++i_) { _Pragma("unroll") for (int k_ = 0; k_ < 4; ++k_) { \
                unsigned w0_ = row[i_][k_]; asm volatile("" : "+v"(w0_)); \
                const f32x2 lo_ = __builtin_amdgcn_cvt_pk_f32_fp8((int)w0_, false), hi_ = __builtin_amdgcn_cvt_pk_f32_fp8((int)w0_, true); \
                acc[i_][4 * k_] = fmaf(w_, lo_[0], acc[i_][4 * k_]); acc[i_][4 * k_ + 1] = fmaf(w_, lo_[1], acc[i_][4 * k_ + 1]); acc[i_][4 * k_ + 2] = fmaf(w_, hi_[0], acc[i_][4 * k_ + 2]); acc[i_][4 * k_ + 3] = fmaf(w_, hi_[1], acc[i_][4 * k_ + 3]); } \
                asm volatile("" : "+v"(acc[i_][0]), "+v"(acc[i_][1]), "+v"(acc[i_][2]), "+v"(acc[i_][3]), "+v"(acc[i_][4]), "+v"(acc[i_][5]), "+v"(acc[i_][6]), "+v"(acc[i_][7]), \
                                  "+v"(acc[i_][8]), "+v"(acc[i_][9]), "+v"(acc[i_][10]), "+v"(acc[i_][11]), "+v"(acc[i_][12]), "+v"(acc[i_][13]), "+v"(acc[i_][14]), "+v"(acc[i_][15])); } } while (0)
            u32x4 r0[4], r1[4], r2[4];
            { const int e_ = RFL(s_eid[0]); LOADROW8(r0, V8, e_); } { const int e_ = RFL(s_eid[1]); LOADROW8(r1, V8, e_); } { const int e_ = RFL(s_eid[2]); LOADROW8(r2, V8, e_); }
            for (int j = 0; j < 126; j += 3) {
                VACC8(r0, j);     if (j + 3 < 128) { const int e_ = RFL(s_eid[j + 3]); LOADROW8(r0, V8, e_); }
                VACC8(r1, j + 1); if (j + 4 < 128) { const int e_ = RFL(s_eid[j + 4]); LOADROW8(r1, V8, e_); }
                VACC8(r2, j + 2); if (j + 5 < 128) { const int e_ = RFL(s_eid[j + 5]); LOADROW8(r2, V8, e_); }
            }
            VACC8(r0, 126); VACC8(r1, 127);
#undef VACC8
#undef LOADROW8
            float ss = 0.f;
#pragma unroll
            for (int i = 0; i < 4; ++i) { float t[16]; load16_bf16(x1 + 1024 * i + 16 * lane, t);
#pragma unroll
                for (int k = 0; k < 16; ++k) { acc[i][k] = fmaf(acc[i][k], VS_INV, t[k]); ss += acc[i][k] * acc[i][k]; } }
            ss = wave_sum_dpp(ss);
            const float rs = rsqrtf(ss * (1.0f / D) + 1e-6f);
            if (!FINAL) {
#pragma unroll
                for (int i = 0; i < 4; ++i) { u32x4 w8;
#pragma unroll
                    for (int q = 0; q < 4; ++q) w8[q] = pk4_fp8(acc[i][4 * q], acc[i][4 * q + 1], acc[i][4 * q + 2], acc[i][4 * q + 3]);
                    *(u32x4*)(XB8n + (size_t)tok * D + 1024 * i + 16 * lane) = w8; }
                if (lane == 0) RSTDn[tok] = rs;
                float mine = 0.f;
#pragma unroll 1
                for (int j = 0; j < 10; ++j) { float s = 0.f;
#pragma unroll
                    for (int i = 0; i < 4; ++i) { const u32x4 g0 = *(const LAS u32x4*)(gfs + j * D + 1024 * i + 16 * lane), g1 = *(const LAS u32x4*)(gfs + j * D + 1024 * i + 16 * lane + 8);
#pragma unroll
                        for (int q = 0; q < 4; ++q) { s += acc[i][2 * q] * bf_lo(g0[q]) + acc[i][2 * q + 1] * bf_hi(g0[q]); s += acc[i][8 + 2 * q] * bf_lo(g1[q]) + acc[i][8 + 2 * q + 1] * bf_hi(g1[q]); } }
                    s = wave_sum_dpp(s); if (lane == j) mine = s; }
                if (lane < 10) { const int b_ = tok >> 11, s_ = tok & 2047; LOGFn[(size_t)(b_ * 10 + lane) * S + s_] = logsig(mine * rs + bf_n[lane]); }
            }
            if (FINAL) { float* xo = (float*)XOv + (size_t)tok * D;
#pragma unroll
                for (int i = 0; i < 4; ++i)
#pragma unroll
                    for (int q = 0; q < 4; ++q) { const int c = 1024 * i + 16 * lane + 4 * q; const f32x4 g_ = *(const f32x4*)(fg + c);
                        *(f32x4*)(xo + c) = (f32x4){acc[i][4 * q] * rs * g_[0], acc[i][4 * q + 1] * rs * g_[1], acc[i][4 * q + 2] * rs * g_[2], acc[i][4 * q + 3] * rs * g_[3]}; }
            } else { bf16_t* xo = (bf16_t*)XOv + (size_t)tok * D;
#pragma unroll
                for (int i = 0; i < 4; ++i) { u32x4 w0, w1;
#pragma unroll
                    for (int q = 0; q < 4; ++q) { w0[q] = pk2(acc[i][2 * q], acc[i][2 * q + 1]); w1[q] = pk2(acc[i][8 + 2 * q], acc[i][8 + 2 * q + 1]); }
                    *(u32x4*)(xo + 1024 * i + 16 * lane) = w0; *(u32x4*)(xo + 1024 * i + 16 * lane + 8) = w1; }
            }
        }
        LDS_WAIT(); asm volatile("" ::: "memory");
    }
}
}
namespace at {
using namespace mk;
constexpr int QB = 256, KVB = 64, HD = 128;
constexpr int SHM_V = KVB * HD * 2, SHM_K = KVB * HD * 2;
constexpr int OFF_V = 0, OFF_K = 2 * SHM_V, OFF_WS = OFF_K + 2 * SHM_K, OFF_CUM = OFF_WS + 8 * 256, OFF_RT = OFF_CUM + 2048 * 4, OFF_MISC = OFF_RT + 640 * 4;
constexpr float LOG2E = 1.4426950408889634f;
constexpr float THR2 = 10.0f;
constexpr float SB_DONE = -100.0f;

#define AT_KSWZ(row, colB) ((row) * 256 + ((colB) ^ (((row) & 7) << 4)))
__device__ __forceinline__ int v_st(int k, int c) { const int kk = (k & ~0xC) | ((k & 4) << 1) | ((k & 8) >> 1); return ((kk >> 3) * 4 + (c >> 5)) * 512 + ((kk & 7) * 32 + (c & 31)) * 2; }
__device__ __forceinline__ int v_rd_base(int lane) { return ((lane & 3) << 3) | (((lane >> 2) & 3) << 6) | (((lane >> 4) & 1) << 5) | (((lane >> 5) & 1) << 8); }
constexpr int v_rd_off(int d0, int ks, int half) { return d0 * 512 + ks * 4096 + half * 2048; }
__device__ __forceinline__ int crow(int r, int hi) { return (r & 3) + 8 * (r >> 2) + 4 * hi; }
__device__ __forceinline__ unsigned cvtpk(float lo, float hi) { unsigned r; asm volatile("v_cvt_pk_bf16_f32 %0, %1, %2" : "=v"(r) : "v"(lo), "v"(hi)); return r; }
__device__ __forceinline__ float partner(float v, int hi) { auto rr = __builtin_amdgcn_permlane32_swap(__builtin_bit_cast(unsigned, v), __builtin_bit_cast(unsigned, v), false, false); return __builtin_bit_cast(float, hi ? rr[0] : rr[1]); }

__device__ __forceinline__ float xchg_max(float v, int hi) { return fmaxf(v, partner(v, hi)); }
__device__ __forceinline__ float xchg_sum(float v, int hi) { return v + partner(v, hi); }

__device__ __forceinline__ void pack_p(const f32x16& p0, const f32x16& p1, bf16x8& pa0, bf16x8& pa1, bf16x8& pa2, bf16x8& pa3) {
#define AT_PK4(P, B_, OUT) do { unsigned a0 = cvtpk(P[B_ + 0], P[B_ + 1]), a1 = cvtpk(P[B_ + 2], P[B_ + 3]); unsigned b0 = cvtpk(P[B_ + 4], P[B_ + 5]), b1 = cvtpk(P[B_ + 6], P[B_ + 7]); \
        auto r0 = __builtin_amdgcn_permlane32_swap(a0, b0, false, false); auto r1 = __builtin_amdgcn_permlane32_swap(a1, b1, false, false); \
        u32x4 w = {r0[0], r1[0], r0[1], r1[1]}; OUT = __builtin_bit_cast(bf16x8, w); } while (0)
    AT_PK4(p0, 0, pa0); AT_PK4(p0, 8, pa1); AT_PK4(p1, 0, pa2); AT_PK4(p1, 8, pa3);
#undef AT_PK4
}
template <int KBUF>
__device__ __forceinline__ void qkt(f32x16& p0, f32x16& p1, LAS unsigned char* K_lds, int r32, int hi, const bf16x8 (&qr)[8]) {
    p0 = f32x16{}; p1 = f32x16{};
    LAS unsigned char* kb[4];
#pragma unroll
    for (int dd = 0; dd < 4; ++dd) kb[dd] = K_lds + KBUF * SHM_K + AT_KSWZ(r32, (dd * 16 + hi * 8) * 2);
#pragma unroll
    for (int d0 = 0; d0 < 8; ++d0) { LAS unsigned char* a = kb[d0 & 3] + (d0 >> 2) * 128;
        const bf16x8 b0 = *(const LAS bf16x8*)a; const bf16x8 b1 = *(const LAS bf16x8*)(a + 32 * 256);
        p0 = __builtin_amdgcn_mfma_f32_32x32x16_bf16(b0, qr[d0], p0, 0, 0, 0);
        p1 = __builtin_amdgcn_mfma_f32_32x32x16_bf16(b1, qr[d0], p1, 0, 0, 0); }
}
template <int VBUF>
__device__ __forceinline__ void pv_tile(f32x16 (&o)[4], int vb0, bf16x8 pa0, bf16x8 pa1, bf16x8 pa2, bf16x8 pa3) {
#define AT_TRRD(dst, off) asm volatile("ds_read_b64_tr_b16 %0, %1 offset:%2" : "=&v"(dst) : "v"(vb0), "i"(off) : "memory")
#define AT_PV_D0(d0) do { s16x4 l0, l1, l2, l3, h0, h1, h2, h3; constexpr int b_ = VBUF * SHM_V + v_rd_off(d0, 0, 0); \
        AT_TRRD(l0, b_); AT_TRRD(h0, b_ + 2048); AT_TRRD(l1, b_ + 4096); AT_TRRD(h1, b_ + 6144); AT_TRRD(l2, b_ + 8192); AT_TRRD(h2, b_ + 10240); AT_TRRD(l3, b_ + 12288); AT_TRRD(h3, b_ + 14336); \
        asm volatile("s_waitcnt lgkmcnt(0)" ::: "memory"); __builtin_amdgcn_sched_barrier(0); \
        o[d0] = __builtin_amdgcn_mfma_f32_32x32x16_bf16(pa0, (bf16x8){l0[0], l0[1], l0[2], l0[3], h0[0], h0[1], h0[2], h0[3]}, o[d0], 0, 0, 0); \
        o[d0] = __builtin_amdgcn_mfma_f32_32x32x16_bf16(pa1, (bf16x8){l1[0], l1[1], l1[2], l1[3], h1[0], h1[1], h1[2], h1[3]}, o[d0], 0, 0, 0); \
        o[d0] = __builtin_amdgcn_mfma_f32_32x32x16_bf16(pa2, (bf16x8){l2[0], l2[1], l2[2], l2[3], h2[0], h2[1], h2[2], h2[3]}, o[d0], 0, 0, 0); \
        o[d0] = __builtin_amdgcn_mfma_f32_32x32x16_bf16(pa3, (bf16x8){l3[0], l3[1], l3[2], l3[3], h3[0], h3[1], h3[2], h3[3]}, o[d0], 0, 0, 0); } while (0)
    AT_PV_D0(0); AT_PV_D0(1); AT_PV_D0(2); AT_PV_D0(3);
#undef AT_PV_D0
#undef AT_TRRD
}

template <int VAR>
__device__ __forceinline__ void attn_item(const bf16_t* Qh, const bf16_t* Kh, const bf16_t* Vh, bf16_t* OB, const float* relb, const float* LOGF, int b, int h, int qb, LAS unsigned char* lds, int tid) {
    const int wid = __builtin_amdgcn_readfirstlane(tid >> 6), lane = tid & 63, r32 = lane & 31, hi = lane >> 5;
    const int g = VAR == 0 ? h : (VAR == 1 ? 12 + h : 22 + h);
    const size_t hb = (size_t)(b * NH + g) * S * HD;
    const bf16_t* Kp = Kh + hb; const bf16_t* Vp = Vh + hb;
    LAS unsigned char* V_lds = lds + OFF_V; LAS unsigned char* K_lds = lds + OFF_K;
    LAS float* wsf = (LAS float*)(lds + OFF_WS) + wid * 64; LAS float* li_l = wsf; LAS float* al_l = wsf + 32;
    LAS float* cumL = (LAS float*)(lds + OFF_CUM); LAS float* Rt = (LAS float*)(lds + OFF_RT); volatile LAS unsigned* flags = (volatile LAS unsigned*)(lds + OFF_MISC);
    const int P0 = qb * QB, qlo = P0 + wid * 32, qpos = qlo + r32;
    int NT, jlo = 0;
    if (VAR == 0) { jlo = 4 * qb - 8; if (jlo < 0) jlo = 0; NT = 4 * qb + 4 - jlo; } else NT = 4 * qb + 4;
    const int cw = 4 * qb + (wid >> 1);
#define AT_KBASE(t) (VAR == 1 ? (4 * qb + 3 - (t)) * KVB : (jlo + (t)) * KVB)
#define AT_ACT(t) (VAR == 0 ? ((jlo + (t)) >= cw - 8 && (jlo + (t)) <= cw) : (VAR == 1 ? (AT_KBASE(t) <= qlo + 30) : (AT_KBASE(t) <= qlo + 31)))
    if (VAR == 0) {
        const float* tab = relb + h * 257;
        for (int j = tid; j < 639; j += 512) { int rel = 575 - j; rel = rel < -128 ? -128 : (rel > 128 ? 128 : rel); Rt[j] = tab[rel + 128] * LOG2E; }
    }
    if (VAR == 2) {
        const float* lf = LOGF + (size_t)(b * 10 + h) * S; const int kend = P0 + QB;
        f32x4 v = (f32x4){0.f, 0.f, 0.f, 0.f};
        if (4 * tid < kend) v = *(const f32x4*)(lf + 4 * tid);
        v[1] += v[0]; v[2] += v[1]; v[3] += v[2];
        float tot = v[3];
#pragma unroll
        for (int o = 1; o < 64; o <<= 1) { const float t_ = lane_read(tot, lane >= o ? lane - o : lane); if (lane >= o) tot += t_; }
        if (lane == 63) li_l[0] = tot;
        __syncthreads();
        float base = tot - v[3];
        for (int w = 0; w < wid; ++w) base += ((LAS float*)(lds + OFF_WS))[w * 64];
        if (4 * tid < kend) *(LAS f32x4*)(cumL + 4 * tid) = (f32x4){(base + v[0]) * LOG2E, (base + v[1]) * LOG2E, (base + v[2]) * LOG2E, (base + v[3]) * LOG2E};
    }
    bf16x8 qr[8];
    { const bf16_t* qp = Qh + hb + (size_t)(qlo + r32) * HD + hi * 8;
#pragma unroll
      for (int d0 = 0; d0 < 8; ++d0) qr[d0] = *(const bf16x8*)(qp + d0 * 16); }
    const int sr = tid >> 4, sc = (tid & 15) * 8, vst0 = v_st(sr, sc), vst1 = v_st(32 + sr, sc), kws = AT_KSWZ(sr, sc * 2);
    const int vb0 = (int)(unsigned)(size_t)V_lds + v_rd_base(lane);
    bf16x8 st_k0, st_k1, st_v0, st_v1;
#define AT_SLOAD(k0) do { const bf16_t* kp_ = Kp + (size_t)((k0) + sr) * HD + sc; const bf16_t* vp_ = Vp + (size_t)((k0) + sr) * HD + sc; \
        st_k0 = *(const bf16x8*)kp_; st_k1 = *(const bf16x8*)(kp_ + 32 * HD); st_v0 = *(const bf16x8*)vp_; st_v1 = *(const bf16x8*)(vp_ + 32 * HD); } while (0)
#define AT_SWRITE(bf) do { *(LAS bf16x8*)(K_lds + (bf) * SHM_K + kws) = st_k0; *(LAS bf16x8*)(K_lds + (bf) * SHM_K + kws + 32 * 256) = st_k1; \
        *(LAS bf16x8*)(V_lds + (bf) * SHM_V + vst0) = st_v0; *(LAS bf16x8*)(V_lds + (bf) * SHM_V + vst1) = st_v1; } while (0)
    AT_SLOAD(AT_KBASE(0)); asm volatile("s_waitcnt vmcnt(0)" ::: "memory"); AT_SWRITE(0);
    __syncthreads();
    float m_reg = -1e30f, l_reg = 0.f, carry = 0.f;
    f32x16 o[4] = {};
#define AT_STEP(BUF, t) do { \
        const bool more_ = (t) + 1 < NT; \
        if (more_) AT_SLOAD(AT_KBASE((t) + 1)); \
        if (AT_ACT(t)) { \
            const int kb_ = AT_KBASE(t); f32x16 p0, p1; bf16x8 pa0, pa1, pa2, pa3; \
            qkt<BUF>(p0, p1, K_lds, r32, hi, qr); \
            tile_math(p0, p1, kb_, pa0, pa1, pa2, pa3); \
            pv_tile<BUF>(o, vb0, pa0, pa1, pa2, pa3); \
        } \
        if (more_) { asm volatile("s_waitcnt vmcnt(0)" ::: "memory"); AT_SWRITE((BUF) ^ 1); } \
        if (VAR == 1) { const bool done_ = __all(carry < SB_DONE); if (lane == 0) flags[((t) & 1) * 8 + wid] = done_ ? 1u : 0u; } \
        __syncthreads(); \
    } while (0)
    auto tile_math = [&](f32x16& p0, f32x16& p1, int kb, bf16x8& pa0, bf16x8& pa1, bf16x8& pa2, bf16x8& pa3) __attribute__((always_inline)) {
        const int dq = qpos - kb - 4 * hi;
        if (VAR == 1) {
            const bool need_mask = kb + 63 >= qlo;
            f32x16 n0, n1;
#pragma unroll
            for (int r = 0; r < 16; ++r) { const float z = p0[r]; const float lp = __builtin_amdgcn_logf(1.0f + __builtin_amdgcn_exp2f(-fabsf(z))); n0[r] = fminf(-z, 0.f) - lp;
                                           const float y = p1[r]; const float lq = __builtin_amdgcn_logf(1.0f + __builtin_amdgcn_exp2f(-fabsf(y))); n1[r] = fminf(-y, 0.f) - lq; }
            if (need_mask) {
#pragma unroll
                for (int r = 0; r < 16; ++r) { const int c = (r & 3) + 8 * (r >> 2);
                    if (dq - c <= 0) { n0[r] = 0.f; p0[r] = -__builtin_inff(); }
                    if (dq - c - 32 <= 0) { n1[r] = 0.f; p1[r] = -__builtin_inff(); } }
            }
            float A[8], Bp[8];
#pragma unroll
            for (int q = 0; q < 4; ++q) { A[q] = (n0[4 * q] + n0[4 * q + 1]) + (n0[4 * q + 2] + n0[4 * q + 3]); A[4 + q] = (n1[4 * q] + n1[4 * q + 1]) + (n1[4 * q + 2] + n1[4 * q + 3]); }
#pragma unroll
            for (int q = 0; q < 8; ++q) Bp[q] = partner(A[q], hi);
            float st = 0.f;
#pragma unroll
            for (int q = 7; q >= 0; --q) {
                const float after = carry + st + (hi == 0 ? Bp[q] : 0.f);
                if (q >= 4) { const int r0 = 4 * (q - 4);
                    float tl = after; p1[r0 + 3] = __builtin_amdgcn_exp2f(p1[r0 + 3] + n1[r0 + 3] + tl); tl += n1[r0 + 3]; p1[r0 + 2] = __builtin_amdgcn_exp2f(p1[r0 + 2] + n1[r0 + 2] + tl); tl += n1[r0 + 2];
                    p1[r0 + 1] = __builtin_amdgcn_exp2f(p1[r0 + 1] + n1[r0 + 1] + tl); tl += n1[r0 + 1]; p1[r0] = __builtin_amdgcn_exp2f(p1[r0] + n1[r0] + tl); }
                else { const int r0 = 4 * q;
                    float tl = after; p0[r0 + 3] = __builtin_amdgcn_exp2f(p0[r0 + 3] + n0[r0 + 3] + tl); tl += n0[r0 + 3]; p0[r0 + 2] = __builtin_amdgcn_exp2f(p0[r0 + 2] + n0[r0 + 2] + tl); tl += n0[r0 + 2];
                    p0[r0 + 1] = __builtin_amdgcn_exp2f(p0[r0 + 1] + n0[r0 + 1] + tl); tl += n0[r0 + 1]; p0[r0] = __builtin_amdgcn_exp2f(p0[r0] + n0[r0] + tl); }
                st += A[q] + Bp[q];
            }
            carry += st;
            pack_p(p0, p1, pa0, pa1, pa2, pa3);
        } else {
            if (VAR == 0) {
                const LAS float* rp = Rt + (575 - (qpos - kb) + 4 * hi);
#pragma unroll
                for (int r = 0; r < 16; ++r) { const int c = (r & 3) + 8 * (r >> 2); p0[r] += rp[c]; p1[r] += rp[c + 32]; }
            } else {
                const LAS float* cp = cumL + kb + 4 * hi;
#pragma unroll
                for (int q = 0; q < 4; ++q) { const f32x4 c0 = *(const LAS f32x4*)(cp + 8 * q), c1 = *(const LAS f32x4*)(cp + 32 + 8 * q);
                    p0[4 * q] -= c0[0]; p0[4 * q + 1] -= c0[1]; p0[4 * q + 2] -= c0[2]; p0[4 * q + 3] -= c0[3];
                    p1[4 * q] -= c1[0]; p1[4 * q + 1] -= c1[1]; p1[4 * q + 2] -= c1[2]; p1[4 * q + 3] -= c1[3]; }
                if (kb + 63 > qlo) {
#pragma unroll
                    for (int r = 0; r < 16; ++r) { const int c = (r & 3) + 8 * (r >> 2);
                        if (dq - c < 0) p0[r] = -__builtin_inff();
                        if (dq - c - 32 < 0) p1[r] = -__builtin_inff(); }
                }
            }
            float pmax = p0[0];
#pragma unroll
            for (int r = 1; r < 16; ++r) pmax = fmaxf(pmax, p0[r]);
#pragma unroll
            for (int r = 0; r < 16; ++r) pmax = fmaxf(pmax, p1[r]);
            pmax = xchg_max(pmax, hi);
            float mn, alpha;
            if (__all(pmax - m_reg <= THR2)) { mn = m_reg; alpha = 1.f; }
            else { mn = fmaxf(m_reg, pmax); alpha = __builtin_amdgcn_exp2f(m_reg - mn); m_reg = mn; }
            float ps = 0.f;
#pragma unroll
            for (int r = 0; r < 16; ++r) { p0[r] = __builtin_amdgcn_exp2f(p0[r] - mn); p1[r] = __builtin_amdgcn_exp2f(p1[r] - mn); ps += p0[r] + p1[r]; }
            ps = xchg_sum(ps, hi);
            l_reg = l_reg * alpha + ps;
            if (__any(alpha < 1.f)) {
                if (hi == 0) al_l[r32] = alpha;
                asm volatile("s_waitcnt lgkmcnt(0)" ::: "memory");
                float av[16];
#pragma unroll
                for (int r = 0; r < 16; ++r) av[r] = al_l[crow(r, hi)];
#pragma unroll
                for (int d = 0; d < 4; ++d)
#pragma unroll
                    for (int r = 0; r < 16; ++r) o[d][r] *= av[r];
            }
            pack_p(p0, p1, pa0, pa1, pa2, pa3);
        }
    };
    for (int t = 0; t < NT; t += 2) {
        AT_STEP(0, t);
        if (VAR == 1) { unsigned all_ = 1u; for (int w = 0; w < 8; ++w) all_ &= flags[(t & 1) * 8 + w]; if (all_) break; }
        if (t + 1 >= NT) break;
        AT_STEP(1, t + 1);
        if (VAR == 1) { unsigned all_ = 1u; for (int w = 0; w < 8; ++w) all_ &= flags[((t + 1) & 1) * 8 + w]; if (all_) break; }
    }
    float rli[16];
    if (VAR != 1) {
        if (hi == 0) li_l[r32] = l_reg;
        asm volatile("s_waitcnt lgkmcnt(0)" ::: "memory");
#pragma unroll
        for (int r = 0; r < 16; ++r) rli[r] = __builtin_amdgcn_rcpf(li_l[crow(r, hi)]);
    }
    unsigned char* Ow8 = (unsigned char*)OB + (size_t)(b * S + qlo) * D + g * HD;
#pragma unroll
    for (int r = 0; r < 16; ++r) { const int orow = crow(r, hi);
#pragma unroll
        for (int d0 = 0; d0 < 4; ++d0) { const float v = VAR != 1 ? o[d0][r] * rli[r] : o[d0][r];
            const float vn = lane_read(v, lane ^ 1);
            if ((r32 & 1) == 0) *(unsigned short*)(Ow8 + (size_t)orow * D + d0 * 32 + r32) = (unsigned short)__builtin_amdgcn_cvt_pk_fp8_f32(clamp8(v * 16.0f), clamp8(vn * 16.0f), 0, false); } }
    __syncthreads();
#undef AT_STEP
#undef AT_SLOAD
#undef AT_SWRITE
#undef AT_KBASE
#undef AT_ACT
}

template <int VAR>
__device__ __forceinline__ void attn_queue(const bf16_t* Qh, const bf16_t* Kh, const bf16_t* Vh, bf16_t* OB, const float* relb, const float* LOGF, unsigned* qhead, LAS unsigned char* lds, int wave0) {
    FRESH_TID(); FRESH_LDS(lds);
    volatile LAS unsigned* qslot = (volatile LAS unsigned*)(lds + OFF_MISC) + 32;
    constexpr int NHV = VAR == 0 ? 12 : 10, NITEMS = 8 * NHV * 8;
    for (;;) {
        if (tid == 0) qslot[0] = __hip_atomic_fetch_add(qhead, 1u, __ATOMIC_RELAXED, __HIP_MEMORY_SCOPE_AGENT);
        __syncthreads();
        const int idx = (int)qslot[0];
        __syncthreads();
        if (idx >= NITEMS) break;
        const int qb = 7 - idx / (8 * NHV), bh = idx % (8 * NHV);
        attn_item<VAR>(Qh, Kh, Vh, OB, relb, LOGF, bh / NHV, bh % NHV, qb, lds, tid);
    }
}
__device__ __forceinline__ void attn_phase(const bf16_t* Qh, const bf16_t* Kh, const bf16_t* Vh, bf16_t* OB, const float* relb, const float* LOGF, unsigned* qheads, LAS unsigned char* lds, int wave0) {
    attn_queue<2>(Qh, Kh, Vh, OB, relb, LOGF, qheads + 0, lds, wave0);
    attn_queue<0>(Qh, Kh, Vh, OB, relb, LOGF, qheads + 64, lds, wave0);
    attn_queue<1>(Qh, Kh, Vh, OB, relb, LOGF, qheads + 128, lds, wave0);
}
}
namespace mk {
#define XB_TMO      128
#define XB_XCNT(j)  (256  + 64 * (j))
#define XB_XSUB(j)  (1280 + 64 * (j))
#define XB_XGEN(j)  (2304 + 64 * (j))
#define XB_TOP      3328
#define XB_TOPGEN   3392
#define XCD_BAR_WORDS 3456
#define XB_SPIN_CAP (1u << 22)

__device__ __forceinline__ unsigned xb_ld(unsigned* p)              { return __hip_atomic_load(p, __ATOMIC_RELAXED, __HIP_MEMORY_SCOPE_AGENT); }
__device__ __forceinline__ unsigned xb_add(unsigned* p, unsigned v) { return __hip_atomic_fetch_add(p, v, __ATOMIC_RELAXED, __HIP_MEMORY_SCOPE_AGENT); }
__device__ __forceinline__ unsigned xb_xcc_id() { return (unsigned)__builtin_amdgcn_s_getreg((3 << 11) | 20) & 0xFu; }
#define XB_SPIN(cond, bar) do { unsigned _sp = 0; while (cond) { __builtin_amdgcn_s_sleep(1); \
    if ((++_sp & 255u) == 0u) { if (xb_ld(&(bar)[XB_TMO])) break; if (_sp > XB_SPIN_CAP) { atomicAdd(&(bar)[XB_TMO], 1u); break; } } } } while (0)

struct XcdBarrier {
    unsigned* bar; unsigned x;
    volatile LAS unsigned* st;
};

__device__ __forceinline__ XcdBarrier xcd_barrier_post(unsigned* bar, volatile LAS unsigned* st, bool is_t0) {
    XcdBarrier b; b.bar = bar; b.x = xb_xcc_id(); b.st = st;
    if (is_t0) (void)xb_add(&bar[XB_XCNT(b.x)], 1u);
    return b;
}
__device__ __forceinline__ void xcd_barrier_complete(unsigned* bar, unsigned x, unsigned& nloc, unsigned& nx) {
    const unsigned G = gridDim.x * gridDim.y * gridDim.z;
    unsigned sum, cnt, mine, sp = 0u;
    for (;;) {
        sum = 0u; cnt = 0u; mine = 0u;
#pragma unroll
        for (unsigned j = 0; j < 16; ++j) { const unsigned c = xb_ld(&bar[XB_XCNT(j)]); sum += c; cnt += (c > 0u) ? 1u : 0u; mine = (j == x) ? c : mine; }
        if (sum == G) break;
        __builtin_amdgcn_s_sleep(1);
        if ((++sp & 255u) == 0u) { if (xb_ld(&bar[XB_TMO])) break; if (sp > XB_SPIN_CAP) { atomicAdd(&bar[XB_TMO], 1u); break; } }
    }
    nloc = mine > 0u ? mine : 1u; nx = cnt > 0u ? cnt : 1u;
}

__device__ __forceinline__ void xcd_barrier(const XcdBarrier& b, bool is_t0) {
    asm volatile("s_waitcnt vmcnt(0)" ::: "memory");
    __syncthreads();
    if (is_t0) {
        unsigned* bar = b.bar;
        __builtin_amdgcn_s_waitcnt(0);
        unsigned nloc = b.st[0], nx = b.st[1];
        if (nloc == 0u) { xcd_barrier_complete(bar, b.x, nloc, nx); b.st[0] = nloc; b.st[1] = nx; }
        const unsigned old = xb_add(&bar[XB_XSUB(b.x)], 1u);
        const unsigned gen = old / nloc;
        if (old + 1u == (gen + 1u) * nloc) {
            __builtin_amdgcn_fence(__ATOMIC_RELEASE, "agent");
            asm volatile("s_waitcnt vmcnt(0)" ::: "memory");
            const unsigned og = xb_add(&bar[XB_TOP], 1u);
            const unsigned tg = og / nx;
            if (og + 1u == (tg + 1u) * nx) xb_add(&bar[XB_TOPGEN], 1u);
            else XB_SPIN(xb_ld(&bar[XB_TOPGEN]) == tg, bar);
            __builtin_amdgcn_fence(__ATOMIC_ACQUIRE, "agent");
            xb_add(&bar[XB_XGEN(b.x)], 1u);
            asm volatile("s_waitcnt vmcnt(0)" ::: "memory");
        } else {
            XB_SPIN(xb_ld(&bar[XB_XGEN(b.x)]) == gen, bar);
            __builtin_amdgcn_fence(__ATOMIC_ACQUIRE, "agent");
            asm volatile("s_waitcnt vmcnt(0)" ::: "memory");
        }
    }
    __syncthreads();
}

constexpr int PH_PER_LAYER = 8;
typedef const __attribute__((address_space(4))) Args* KArgs;
#define KARGS() ({ KArgs p_ = (KArgs)__builtin_amdgcn_kernarg_segment_ptr(); asm volatile("" : "+s"(p_)); p_; })
#define GRID_BAR() do { KArgs k_ = KARGS(); XcdBarrier b_; b_.bar = (unsigned*)(k_->ws + WS_CTL) + CW_BAR; b_.x = xb_xcc_id(); b_.st = (volatile LAS unsigned*)(lds + MISC_OFF) + 8; unsigned z_ = 0u; asm volatile("" : "+v"(z_)); const bool t0_ = (wave0 == 0) && (__builtin_amdgcn_mbcnt_hi(~0u, __builtin_amdgcn_mbcnt_lo(~0u, z_)) == 0u);     xcd_barrier(b_, t0_); } while (0)
__global__ void __launch_bounds__(NWAVES * 64, 2) mk_fwd(Args a_unused) {
    extern __shared__ __attribute__((aligned(16))) unsigned char lds_raw[];
    LAS unsigned char* lds = (LAS unsigned char*)lds_raw;
    const int wave0 = __builtin_amdgcn_readfirstlane((int)threadIdx.x >> 6);
    for (int u = threadIdx.x; u < (LDS_BYTES - LDSCTL_OFF) / 4; u += NWAVES * 64) ((LAS unsigned*)(lds + LDSCTL_OFF))[u] = 0u;
    __syncthreads();
    int lo, hi;
    { KArgs k = KARGS(); lo = k->ph_lo; hi = k->ph_hi;
      if (hi - lo > 1) (void)xcd_barrier_post((unsigned*)(k->ws + WS_CTL) + CW_BAR, (volatile LAS unsigned*)(lds + MISC_OFF) + 8, threadIdx.x == 0); }
#define IN(k) (lo <= (k) && (k) < hi)
#define BOTH(k) (IN(k) && IN((k) + 1))
#pragma unroll
    for (int l = 0; l < 2; ++l) {
        const int pb = PH_PER_LAYER * l;
        if (IN(pb + 0)) { KArgs k = KARGS(); conv_phase(k, l, lds, wave0); }
        if (IN(pb + 1) && l == 0) {
            KArgs k = KARGS(); unsigned char* ws = k->ws;
            const float* xin = k->in[0];
            prep_phase<true>(xin, (bf16_t*)(ws + WS_XB8N), (float*)(ws + WS_RSTD), k->in[2] + (size_t)l * D * PW, k->in[1] + (size_t)l * D, k->in[3] + l * 10, (float*)(ws + WS_LOGF), lds, wave0);
            if (BOTH(pb + 1)) GRID_BAR();
        }
        if (l == 1 && IN(pb + 0) && IN(pb + 2)) GRID_BAR();
        if (IN(pb + 2)) {
            KArgs k = KARGS(); unsigned char* ws = k->ws;
            pg8::Gemm g{(const bf16_t*)(ws + WS_XB8N), (const bf16_t*)(ws + WS_WIN), M, 12288, D}; pg8::StaticOrder So; FRESH_BID(); So.init(M, 12288, G, bid);
            pg8::EpiQKV4 E{(bf16_t*)(ws + WS_Q), (const float*)(ws + WS_RSTD), 0.08838834764831845f * 1.4426950408889634f, US_INV};
            { LAS unsigned char* lds_ = lds; FRESH_LDS(lds_); FRESH_TID(); pg8::gemm_phase<pg8::EpiQKV4, pg8::StaticOrder, true, true, true>(lds_, g, So, E, tid); }
            if (BOTH(pb + 2)) GRID_BAR();
        }
        if (IN(pb + 3)) {
            KArgs k = KARGS(); unsigned char* ws = k->ws;
            at::attn_phase((const bf16_t*)(ws + WS_Q), (const bf16_t*)(ws + WS_K), (const bf16_t*)(ws + WS_V), (bf16_t*)(ws + WS_OB), k->in[4] + (size_t)l * 12 * 257, (const float*)(ws + WS_LOGF),
                           (unsigned*)(ws + WS_CTL) + CW_QUEUE + 256 * l, lds, wave0);
            if (BOTH(pb + 3)) GRID_BAR();
        }
        if (IN(pb + 4)) {
            KArgs k = KARGS(); unsigned char* ws = k->ws;
            pg8::Gemm g{(const bf16_t*)(ws + WS_OB), (const bf16_t*)(ws + WS_WOUT), M, D, D}; pg8::StaticOrder So; FRESH_BID(); So.init(M, D, G, bid);
            if (l == 0) { pg8::EpiResidB16<true> E{k->in[0], US_INV * (1.0f / 16.0f), (bf16_t*)(ws + WS_XB)};
                { LAS unsigned char* lds_ = lds; FRESH_LDS(lds_); FRESH_TID(); pg8::gemm_phase<pg8::EpiResidB16<true>, pg8::StaticOrder, false, true, true>(lds_, g, So, E, tid); } }
            else { pg8::EpiResidB16<false> E{ws + WS_X2, US_INV * (1.0f / 16.0f), (bf16_t*)(ws + WS_XB)};
                { LAS unsigned char* lds_ = lds; FRESH_LDS(lds_); FRESH_TID(); pg8::gemm_phase<pg8::EpiResidB16<false>, pg8::StaticOrder, false, true, true>(lds_, g, So, E, tid); } }
            if (BOTH(pb + 4)) GRID_BAR();
        }
        if (IN(pb + 5)) {
            KArgs k = KARGS(); unsigned char* ws = k->ws;
            pg8::Gemm g{(const bf16_t*)(ws + WS_XB), (const bf16_t*)(ws + WS_WQK), M, 2048, D}; pg8::StaticOrder So; FRESH_BID(); So.init(M, 2048, G, bid);
            pg8::EpiPlainF32<2048> E{(float*)(ws + WS_SC)};
            { LAS unsigned char* lds_ = lds; FRESH_LDS(lds_); FRESH_TID(); pg8::gemm_phase<pg8::EpiPlainF32<2048>, pg8::StaticOrder, true, true>(lds_, g, So, E, tid); }
            if (BOTH(pb + 5)) GRID_BAR();
        }
        if (IN(pb + 6)) {
            KArgs k = KARGS(); unsigned char* ws = k->ws;
            peer_u_phase((const float*)(ws + WS_SC), (const unsigned char*)(ws + WS_U16), (const bf16_t*)(ws + WS_XB), (int*)(ws + WS_K), (float*)(ws + WS_K + 8 * MiB), lds, wave0);
            if (BOTH(pb + 6)) GRID_BAR();
        }
        if (IN(pb + 7)) {
            KArgs k = KARGS(); unsigned char* ws = k->ws;
            if (l == 0) peer_v_phase<false>((const int*)(ws + WS_K), (const float*)(ws + WS_K + 8 * MiB), (const unsigned char*)(ws + WS_U16) + (size_t)NE * D, (const bf16_t*)(ws + WS_XB), ws + WS_X2, nullptr,
                                            ws + WS_XB8N, (float*)(ws + WS_RSTD), (float*)(ws + WS_LOGF), k->in[2] + (size_t)D * PW, k->in[1] + D, k->in[3] + 10, lds, wave0);
            else peer_v_phase<true>((const int*)(ws + WS_K), (const float*)(ws + WS_K + 8 * MiB), (const unsigned char*)(ws + WS_U16) + (size_t)NE * D, (const bf16_t*)(ws + WS_XB), k->out, k->in[12],
                                    nullptr, nullptr, nullptr, nullptr, nullptr, nullptr, lds, wave0);
            if (BOTH(pb + 7)) GRID_BAR();
        }
    }
#undef IN
#undef BOTH
}

static int g_grid = 0;
static void launch_phases(Args a, int lo, int hi, hipStream_t st) {
    a.ph_lo = lo; a.ph_hi = hi;
    hipLaunchKernelGGL(mk_fwd, dim3(g_grid), dim3(NWAVES * 64), LDS_BYTES, st, a);
}
}

extern "C" void kernel_launch(void* const* d_in, const int* in_sizes, int n_in, void* d_out, int out_size, void* d_ws, size_t ws_size, hipStream_t stream) {
    (void)in_sizes; (void)n_in; (void)out_size;
    using namespace mk;
    if (g_grid == 0) {
        if (ws_size < 2048 * MiB) { fprintf(stderr, "kernel_launch: workspace too small (%zu)\n", ws_size); g_grid = -1; return; }
        if (hipFuncSetAttribute((const void*)mk_fwd, hipFuncAttributeMaxDynamicSharedMemorySize, LDS_BYTES) != hipSuccess) { fprintf(stderr, "kernel_launch: hipFuncSetAttribute failed\n"); g_grid = -1; return; }
        int dev = 0, cus = 0; (void)hipGetDevice(&dev); (void)hipDeviceGetAttribute(&cus, hipDeviceAttributeMultiprocessorCount, dev);
        g_grid = cus > 0 ? cus : 256;
    }
    if (g_grid < 0) return;
    unsigned char* ws = (unsigned char*)d_ws; float* out = (float*)d_out;
    (void)hipMemsetAsync(ws + WS_CTL, 0, CTL_ZERO_BYTES, stream);
    Args a{};
    for (int i = 0; i < 13; ++i) a.in[i] = (const float*)d_in[i];
    a.out = out; a.ws = ws;
    launch_phases(a, 0, 2 * PH_PER_LAYER, stream);
}
```

```cpp
#include <hip/hip_runtime.h>
#include <cstdio>
#include <cstdint>
namespace pg8 {
#define PG8_LAS __attribute__((address_space(3)))
typedef unsigned short bf16_t;
typedef short bf16x8 __attribute__((ext_vector_type(8)));
typedef float f32x4 __attribute__((ext_vector_type(4)));
typedef unsigned u32x4 __attribute__((ext_vector_type(4)));
typedef unsigned u32x2 __attribute__((ext_vector_type(2)));
constexpr int BM = 256, BK = 64, HALF = 128, HTB = HALF * BK * 2  , STAGE_BYTES = 8 * HTB, NXCD = 8, WGM = 8;

__host__ __device__ __forceinline__ int lds_byte(int r, int c) { const int st = (r >> 4) * 2 + (c >> 5), rr = r & 15, cc = c & 31, ob = rr * 64 + cc * 2; return st * 1024 + (ob ^ (((ob >> 9) & 1) << 5)); }
__host__ __device__ __forceinline__ void stage_rc(int b, int& R, int& C) { const int st = b / 1024, sb = b % 1024, swz = sb ^ (((sb >> 9) & 1) << 5); R = (st >> 1) * 16 + swz / 64; C = (st & 1) * 32 + (swz % 64) / 2; }
__host__ __device__ __forceinline__ int perm32(int rho) { const int n = rho >> 4, i = rho & 15; return 8 * (i >> 2) + 4 * n + (i & 3); }

struct Unit { int pm, pn; };
struct Gemm { const bf16_t* A; const bf16_t* Bt; int M, N, K; };

struct StaticOrder {
    int nM, nN, nwg, G, c;
    __host__ __device__ void init(int M, int N, int G_, int c_) { nM = M / BM; nN = N / BM; nwg = nM * nN; G = G_; c = c_; }
    __host__ __device__ bool next(int i, Unit& u) const {
        const long L = (long)i * G + c; if (L >= nwg) return false;
        int wgid = (int)L; { const int q = nwg / NXCD, r = nwg % NXCD, xcd = wgid % NXCD, off = wgid / NXCD; wgid = (xcd < r ? xcd * (q + 1) : r * (q + 1) + (xcd - r) * q) + off; }
        const int nig = WGM * nN, gid = wgid / nig, fm = gid * WGM, gsz = (nM - fm) < WGM ? (nM - fm) : WGM;
        u.pm = fm + ((wgid % nig) % gsz); u.pn = (wgid % nig) / gsz; return true;
    }
    __device__ __forceinline__ void a_ready(const Unit&) const {}
    __device__ __forceinline__ void done(const Unit&) const {}
};
__device__ __forceinline__ unsigned cvt_pk_bf16(float lo, float hi) { unsigned r; asm volatile("v_cvt_pk_bf16_f32 %0, %1, %2" : "=v"(r) : "v"(lo), "v"(hi)); return r; }
typedef float f32x2 __attribute__((ext_vector_type(2)));
__device__ __forceinline__ f32x2 gelu_pk(f32x2 v) {
    const f32x2 av = __builtin_elementwise_abs(v), d = av * 0.2316418882f + 1.0f;
    f32x2 t; t.x = __builtin_amdgcn_rcpf(d.x); t.y = __builtin_amdgcn_rcpf(d.y);
    f32x2 q = t * 0.5307027145f + (-0.7265760135f); q = q * t + 0.7107068705f; q = q * t + (-0.142248368f); q = q * t + 0.127414796f; q = q * t;
    const f32x2 s = (v * v) * (-0.72134752044f);
    f32x2 e; e.x = __builtin_amdgcn_exp2f(s.x); e.y = __builtin_amdgcn_exp2f(s.y);
    const f32x2 m = v * (q * e), r = v - m;
    f32x2 o; o.x = v.x < 0.f ? m.x : r.x; o.y = v.y < 0.f ? m.y : r.y; return o;
}
#define EPI_FRESH_LANE() { unsigned z_ = 0u; asm volatile("" : "+v"(z_)); const int l_ = (int)__builtin_amdgcn_mbcnt_hi(~0u, __builtin_amdgcn_mbcnt_lo(~0u, z_)); fr = l_ & 15; fq = l_ >> 4; }
typedef __amdgpu_buffer_rsrc_t rsrc_t;
__device__ __forceinline__ rsrc_t mkrsrc(const void* p, unsigned bytes) { return __builtin_amdgcn_make_buffer_rsrc((void*)p, (short)0, (int)bytes, 0x00020000); }
template <int LDC> struct EpiPlainF32 {
    static constexpr bool PERM = false, AFTER_DRAIN = false;
    float* C;
    __device__ __forceinline__ void operator()(const f32x4 (&acc)[2][2][4][2], const Unit& u, int wr, int wc, int fr, int fq) const {
        EPI_FRESH_LANE();
        const rsrc_t rc = mkrsrc(C, 16384u * LDC * 4u);
        const int vo = ((wr * 64 + fr) * LDC + wc * 32 + 4 * fq) * 4, so = (u.pm * BM * LDC + u.pn * BM) * 4;
#pragma unroll
        for (int ai = 0; ai < 2; ++ai)
#pragma unroll
            for (int m = 0; m < 4; ++m)
#pragma unroll
                for (int bj = 0; bj < 2; ++bj)
#pragma unroll
                    for (int n = 0; n < 2; ++n) __builtin_amdgcn_raw_buffer_store_b128(__builtin_bit_cast(u32x4, acc[ai][bj][m][n]), rc, vo, so + ((ai * HALF + m * 16) * LDC + bj * HALF + n * 16) * 4, 0);
    }
};
template <int LDC> struct EpiRowScaleF32 {
    static constexpr bool PERM = false, AFTER_DRAIN = false;
    float* C; const float* rs;
    __device__ __forceinline__ void operator()(const f32x4 (&acc)[2][2][4][2], const Unit& u, int wr, int wc, int fr, int fq) const {
        const rsrc_t rc = mkrsrc(C, 16384u * LDC * 4u), rr = mkrsrc(rs, 16384u * 4u);
        const int vo = ((wr * 64 + fr) * LDC + wc * 32 + 4 * fq) * 4, vr = (wr * 64 + fr) * 4;
        const int so = (u.pm * BM * LDC + u.pn * BM) * 4, sr = u.pm * BM * 4;
#pragma unroll
        for (int ai = 0; ai < 2; ++ai)
#pragma unroll
            for (int m = 0; m < 4; ++m) { const float s = __builtin_bit_cast(float, __builtin_amdgcn_raw_buffer_load_b32(rr, vr, sr + (ai * HALF + m * 16) * 4, 0));
#pragma unroll
                for (int bj = 0; bj < 2; ++bj)
#pragma unroll
                    for (int n = 0; n < 2; ++n) { const f32x4 v = acc[ai][bj][m][n] * s; __builtin_amdgcn_raw_buffer_store_b128(__builtin_bit_cast(u32x4, v), rc, vo, so + ((ai * HALF + m * 16) * LDC + bj * HALF + n * 16) * 4, 0); } }
    }
};
template <bool BASE_F32> struct EpiResidB16 {
    static constexpr bool PERM = false, AFTER_DRAIN = false;
    const void* base; float ascale; bf16_t* xb;
    __device__ __forceinline__ void operator()(const f32x4 (&acc)[2][2][4][2], const Unit& u, int wr, int wc, int fr, int fq) const {
        EPI_FRESH_LANE();
        constexpr int LDC = 4096;
        const rsrc_t rb = mkrsrc(base, 16384u * LDC * (BASE_F32 ? 4u : 2u)), rx = mkrsrc(xb, 16384u * LDC * 2u);
        const int vo = ((wr * 64 + fr) * LDC + wc * 32 + 4 * fq) * 2;
        const int so = (u.pm * BM * LDC + u.pn * BM) * 2;
        f32x4 ra[2][2], rb2[2][2];
#define EPI_LD(dst, g_) do { _Pragma("unroll") for (int bj = 0; bj < 2; ++bj) _Pragma("unroll") for (int n = 0; n < 2; ++n) { \
            const int o = so + ((((g_) >> 2) * HALF + ((g_) & 3) * 16) * LDC + bj * HALF + n * 16) * 2; \
            if constexpr (BASE_F32) dst[bj][n] = __builtin_bit_cast(f32x4, __builtin_amdgcn_raw_buffer_load_b128(rb, vo * 2, o * 2, 0)); \
            else { const u32x2 t_ = __builtin_amdgcn_raw_buffer_load_b64(rb, vo, o, 0); dst[bj][n] = (f32x4){__builtin_bit_cast(float, t_.x << 16), __builtin_bit_cast(float, t_.x & 0xffff0000u), __builtin_bit_cast(float, t_.y << 16), __builtin_bit_cast(float, t_.y & 0xffff0000u)}; } } } while (0)
#define EPI_ST(src, g_) do { _Pragma("unroll") for (int bj = 0; bj < 2; ++bj) _Pragma("unroll") for (int n = 0; n < 2; ++n) { \
            const int o = so + ((((g_) >> 2) * HALF + ((g_) & 3) * 16) * LDC + bj * HALF + n * 16) * 2; \
            const f32x4 v = src[bj][n] + acc[(g_) >> 2][bj][(g_) & 3][n] * ascale; \
            u32x2 w; w.x = cvt_pk_bf16(v[0], v[1]); w.y = cvt_pk_bf16(v[2], v[3]); __builtin_amdgcn_raw_buffer_store_b64(w, rx, vo, o, 0); } } while (0)
        EPI_LD(ra, 0);
        EPI_LD(rb2, 1); EPI_ST(ra, 0);
        EPI_LD(ra, 2); EPI_ST(rb2, 1);
        EPI_LD(rb2, 3); EPI_ST(ra, 2);
        EPI_LD(ra, 4); EPI_ST(rb2, 3);
        EPI_LD(rb2, 5); EPI_ST(ra, 4);
        EPI_LD(ra, 6); EPI_ST(rb2, 5);
        EPI_LD(rb2, 7); EPI_ST(ra, 6);
        EPI_ST(rb2, 7);
#undef EPI_LD
#undef EPI_ST
    }
};
struct EpiQKV {
    static constexpr bool PERM = true, AFTER_DRAIN = false;
    bf16_t* Q; const float* rs; float qscale;
    __device__ __forceinline__ void operator()(const f32x4 (&acc)[2][2][4][2], const Unit& u, int wr, int wc, int fr, int fq) const {
        const rsrc_t rq = mkrsrc(Q, 3u * 16384u * 4096u * 2u), rr = mkrsrc(rs, 16384u * 4u);
        const int colt = u.pn * BM, which = colt >> 12, cw = colt & 4095, gt = cw >> 7;
        const int b = (u.pm * BM) >> 11, st = (u.pm * BM) & 2047;
        const float sc = which == 0 ? qscale : 1.f;
        const int so = (int)(((unsigned)which << 26) + (((unsigned)(b * 32 + gt) * 2048u + (unsigned)st) << 7)) * 2;
        const int vo = (((wr * 64 + fr) << 7) + wc * 32 + 8 * fq) * 2, vr = (wr * 64 + fr) * 4, sr = u.pm * BM * 4;
#pragma unroll
        for (int ai = 0; ai < 2; ++ai)
#pragma unroll
            for (int m = 0; m < 4; ++m) { const float f = sc * __builtin_bit_cast(float, __builtin_amdgcn_raw_buffer_load_b32(rr, vr, sr + (ai * HALF + m * 16) * 4, 0));
#pragma unroll
                for (int bj = 0; bj < 2; ++bj) {
                    const f32x4 v0 = acc[ai][bj][m][0] * f, v1 = acc[ai][bj][m][1] * f;
                    u32x4 w; w.x = cvt_pk_bf16(v0[0], v0[1]); w.y = cvt_pk_bf16(v0[2], v0[3]); w.z = cvt_pk_bf16(v1[0], v1[1]); w.w = cvt_pk_bf16(v1[2], v1[3]);
                    __builtin_amdgcn_raw_buffer_store_b128(w, rq, vo, so + ((bj * 2048 + ai * HALF + m * 16) << 7) * 2, 0); } }
    }
};

struct EpiQKV4 {
    static constexpr bool PERM = false, AFTER_DRAIN = false;
    bf16_t* Q; const float* rs; float qscale, wscale;
    __device__ __forceinline__ void operator()(const f32x4 (&acc)[2][2][4][2], const Unit& u, int wr, int wc, int fr, int fq) const {
        EPI_FRESH_LANE();
        const rsrc_t rq = mkrsrc(Q, 3u * 16384u * 4096u * 2u), rr = mkrsrc(rs, 16384u * 4u);
        const int colt = u.pn * BM, which = colt >> 12, cw = colt & 4095, gt = cw >> 7;
        const int b = (u.pm * BM) >> 11, st = (u.pm * BM) & 2047;
        const float sc = (which == 0 ? qscale : 1.f) * wscale;
        const int so = (int)(((unsigned)which << 26) + (((unsigned)(b * 32 + gt) * 2048u + (unsigned)st) << 7)) * 2;
        const int vo = (((wr * 64 + fr) << 7) + wc * 32 + 4 * fq) * 2, vr = (wr * 64 + fr) * 4, sr = u.pm * BM * 4;
        unsigned rsv[2][4];
#pragma unroll
        for (int ai = 0; ai < 2; ++ai)
#pragma unroll
            for (int m = 0; m < 4; ++m) rsv[ai][m] = __builtin_amdgcn_raw_buffer_load_b32(rr, vr, sr + (ai * HALF + m * 16) * 4, 0);
#pragma unroll
        for (int ai = 0; ai < 2; ++ai)
#pragma unroll
            for (int m = 0; m < 4; ++m) { const float f = sc * __builtin_bit_cast(float, rsv[ai][m]);
#pragma unroll
                for (int bj = 0; bj < 2; ++bj)
#pragma unroll
                    for (int n = 0; n < 2; ++n) { const f32x4 v0 = acc[ai][bj][m][n] * f; u32x2 w; w.x = cvt_pk_bf16(v0[0], v0[1]); w.y = cvt_pk_bf16(v0[2], v0[3]);
                        __builtin_amdgcn_raw_buffer_store_b64(w, rq, vo, so + (((bj * 2048 + ai * HALF + m * 16) << 7) + n * 16) * 2, 0); } }
    }
};

typedef int i32x8 __attribute__((ext_vector_type(8)));
template <bool F8> struct FragT { typedef bf16x8 type; };
template <> struct FragT<true> { typedef i32x8 type; };
__device__ __forceinline__ f32x4 mma_bf16(bf16x8 a, bf16x8 b, f32x4 c) { return __builtin_amdgcn_mfma_f32_16x16x32_bf16(a, b, c, 0, 0, 0); }
__device__ __forceinline__ f32x4 mma_bf16(i32x8, i32x8, f32x4 c) { return c; }
template <class Epi, class Sched, bool ALIGN_EPI = false, bool SP2 = false, bool F8 = false>
__device__ __forceinline__ void gemm_phase(PG8_LAS unsigned char* lds, const Gemm g, const Sched& S, const Epi& E, int tid_in) {
    int tid_ = tid_in;
    const int tid = tid_, wid = __builtin_amdgcn_readfirstlane(tid >> 6), lane = tid & 63, wr = wid >> 2, wc = wid & 3, fr = lane & 15, fq = lane >> 4;
    constexpr int EB = F8 ? 1 : 2;
    constexpr int K = 4096; constexpr int nt = (K * EB) / (BK * 2);
    unsigned voffA[2], voffB[2];
#pragma unroll
    for (int i = 0; i < 2; ++i) { int R, C; stage_rc(tid * 16 + i * 8192, R, C); const int Rb = Epi::PERM ? ((R & ~31) + perm32(R & 31)) : R;
        voffA[i] = (unsigned)(R * K * EB + C * 2); voffB[i] = (unsigned)(Rb * K * EB + C * 2); }
    const size_t kstep = (size_t)(BK * 2);
    const size_t hstep = (size_t)HALF * K * EB;
    const size_t tstep = 2 * hstep;
    const unsigned ldsw = (unsigned)wid * 1024u;
    const int aoff = F8 ? lds_byte(wr * 64 + fr, fq * 16) + (fq & 1) * 16 : lds_byte(wr * 64 + fr, fq * 8), boff = F8 ? lds_byte(wc * 32 + fr, fq * 16) + (fq & 1) * 16 : lds_byte(wc * 32 + fr, fq * 8);
    const int aoff1 = aoff + (F8 ? 16 - 32 * (fq & 1) : 0);
    const int f8o0_unused = 0; (void)f8o0_unused;
#define PG8_SA(b, h) (((b) * 2 + (h)) * HTB)
#define PG8_SB(b, h) ((4 + (b) * 2 + (h)) * HTB)
#define PG8_STAGE_X(bufoff, gbase, voff, rs_, base_) do { const int so_ = (int)((const char*)(gbase) - (const char*)(base_)); _Pragma("unroll") for (int _i = 0; _i < 2; ++_i) \
        __builtin_amdgcn_raw_ptr_buffer_load_lds(rs_, (PG8_LAS void*)(lds + (bufoff) + ldsw + _i * 8192), 16, (int)(voff)[_i], so_, 0, 0); } while (0)
#define PG8_LDA(dst, b, h) do { if constexpr (F8) { _Pragma("unroll") for (int m = 0; m < 4; ++m) { const u32x4 lo_ = *(const PG8_LAS u32x4*)(lds + PG8_SA(b, h) + aoff + m * 2048), hi_ = *(const PG8_LAS u32x4*)(lds + PG8_SA(b, h) + aoff1 + m * 2048); \
            dst[m][0] = (i32x8){(int)lo_[0], (int)lo_[1], (int)lo_[2], (int)lo_[3], (int)hi_[0], (int)hi_[1], (int)hi_[2], (int)hi_[3]}; } } \
        else { _Pragma("unroll") for (int m = 0; m < 4; ++m) _Pragma("unroll") for (int k = 0; k < 2; ++k) dst[m][k] = *(const PG8_LAS frag_t*)(lds + PG8_SA(b, h) + aoff + m * 2048 + k * 1024); } } while (0)
#define PG8_LDB(dst, b, h) do { if constexpr (F8) { _Pragma("unroll") for (int n = 0; n < 2; ++n) { const u32x4 lo_ = *(const PG8_LAS u32x4*)(lds + PG8_SB(b, h) + boff + n * 2048), hi_ = *(const PG8_LAS u32x4*)(lds + PG8_SB(b, h) + boff + (aoff1 - aoff) + n * 2048); \
            dst[n][0] = (i32x8){(int)lo_[0], (int)lo_[1], (int)lo_[2], (int)lo_[3], (int)hi_[0], (int)hi_[1], (int)hi_[2], (int)hi_[3]}; } } \
        else { _Pragma("unroll") for (int n = 0; n < 2; ++n) _Pragma("unroll") for (int k = 0; k < 2; ++k) dst[n][k] = *(const PG8_LAS frag_t*)(lds + PG8_SB(b, h) + boff + n * 2048 + k * 1024); } } while (0)
#define PG8_MMA(ai, bj, At, Bt) do { __builtin_amdgcn_s_setprio(1); _Pragma("unroll") for (int m = 0; m < 4; ++m) _Pragma("unroll") for (int n = 0; n < 2; ++n) { \
        if constexpr (F8) acc[ai][bj][m][n] = __builtin_amdgcn_mfma_scale_f32_16x16x128_f8f6f4(Bt[n][0], At[m][0], acc[ai][bj][m][n], 0, 0, 0, 0x7f7f7f7f, 0, 0x7f7f7f7f); \
        else { _Pragma("unroll") for (int k = 0; k < 2; ++k) acc[ai][bj][m][n] = mma_bf16(Bt[n][k], At[m][k], acc[ai][bj][m][n]); } } __builtin_amdgcn_s_setprio(0); } while (0)
#define PG8_WAIT_V(n) asm volatile("s_waitcnt vmcnt(" #n ")" ::: "memory")
#define PG8_WAIT_L(n) asm volatile("s_waitcnt lgkmcnt(" #n ")" ::: "memory")
#define PG8_BAR __builtin_amdgcn_s_barrier()
#define PG8_SCHED __builtin_amdgcn_sched_barrier(0)
    const __amdgpu_buffer_rsrc_t rsA = __builtin_amdgcn_make_buffer_rsrc((void*)g.A, (short)0, (int)((size_t)g.M * K * EB), 0x00020000), rsB = __builtin_amdgcn_make_buffer_rsrc((void*)g.Bt, (short)0, (int)((size_t)g.N * K * EB), 0x00020000);
    Unit cur, nxt; int ui = 0;
    if (!S.next(0, cur)) return;
    f32x4 acc[2][2][4][2];
#pragma unroll
    for (int a = 0; a < 2; ++a)
#pragma unroll
        for (int b = 0; b < 2; ++b)
#pragma unroll
            for (int m = 0; m < 4; ++m)
#pragma unroll
                for (int n = 0; n < 2; ++n) acc[a][b][m][n] = (f32x4){0.f, 0.f, 0.f, 0.f};
    typedef typename FragT<F8>::type frag_t;
    frag_t At[4][F8 ? 1 : 2], B0[2][F8 ? 1 : 2], B1[2][F8 ? 1 : 2];
    const char* cA = (const char*)g.A + (size_t)cur.pm * tstep; const char* cB = (const char*)g.Bt + (size_t)cur.pn * tstep;
    S.a_ready(cur);
    if constexpr (SP2) {
        PG8_STAGE_X(PG8_SB(0, 0), cB, voffB, rsB, g.Bt); PG8_STAGE_X(PG8_SB(0, 1), cB + hstep, voffB, rsB, g.Bt); PG8_STAGE_X(PG8_SA(0, 0), cA, voffA, rsA, g.A); PG8_STAGE_X(PG8_SA(0, 1), cA + hstep, voffA, rsA, g.A);
        if (wr == 1) PG8_BAR;
        PG8_WAIT_V(2); PG8_BAR;
        PG8_STAGE_X(PG8_SB(1, 0), cB + kstep, voffB, rsB, g.Bt); PG8_STAGE_X(PG8_SA(1, 0), cA + kstep, voffA, rsA, g.A); PG8_STAGE_X(PG8_SB(1, 1), cB + hstep + kstep, voffB, rsB, g.Bt);
        PG8_WAIT_V(6); PG8_BAR;
    } else {
        PG8_STAGE_X(PG8_SB(0, 0), cB, voffB, rsB, g.Bt); PG8_STAGE_X(PG8_SA(0, 0), cA, voffA, rsA, g.A); PG8_STAGE_X(PG8_SB(0, 1), cB + hstep, voffB, rsB, g.Bt); PG8_STAGE_X(PG8_SA(0, 1), cA + hstep, voffA, rsA, g.A);
        if (wr == 1) PG8_BAR;
        PG8_WAIT_V(4); PG8_BAR;
        PG8_STAGE_X(PG8_SB(1, 0), cB + kstep, voffB, rsB, g.Bt); PG8_STAGE_X(PG8_SA(1, 0), cA + kstep, voffA, rsA, g.A); PG8_STAGE_X(PG8_SB(1, 1), cB + hstep + kstep, voffB, rsB, g.Bt);
        PG8_WAIT_V(6); PG8_BAR;
    }
    for (;;) {
        const bool has_next = S.next(ui + 1, nxt);
        const char* nA = has_next ? (const char*)g.A + (size_t)nxt.pm * tstep : cA; const char* nB = has_next ? (const char*)g.Bt + (size_t)nxt.pn * tstep : cB;
        for (int t = 0; t < nt; t += 2) {
            const bool last = (t == nt - 2);
            const char* a1 = cA + (size_t)(t + 1) * kstep;
            const char* a2 = last ? nA : cA + (size_t)(t + 2) * kstep; const char* b2 = last ? nB : cB + (size_t)(t + 2) * kstep;
            const char* a3 = a2 + kstep; const char* b3 = b2 + kstep;
            if (last && has_next) S.a_ready(nxt);
            if constexpr (SP2) {
            PG8_LDB(B0, 0, 0); PG8_LDB(B1, 0, 1); PG8_SCHED; PG8_LDA(At, 0, 0); PG8_STAGE_X(PG8_SA(1, 1), a1 + hstep, voffA, rsA, g.A);
            PG8_WAIT_V(8); PG8_WAIT_L(0); PG8_BAR; PG8_MMA(0, 0, At, B0); PG8_MMA(0, 1, At, B1); PG8_BAR; PG8_SCHED;
            PG8_LDA(At, 0, 1); PG8_STAGE_X(PG8_SB(0, 0), b2, voffB, rsB, g.Bt); PG8_STAGE_X(PG8_SB(0, 1), b2 + hstep, voffB, rsB, g.Bt); PG8_STAGE_X(PG8_SA(0, 0), a2, voffA, rsA, g.A);
            PG8_WAIT_V(8); PG8_WAIT_L(0); PG8_BAR; PG8_MMA(1, 0, At, B0); PG8_MMA(1, 1, At, B1); PG8_BAR; PG8_SCHED;
            PG8_LDB(B0, 1, 0); PG8_LDB(B1, 1, 1); PG8_SCHED; PG8_LDA(At, 1, 0); PG8_STAGE_X(PG8_SA(0, 1), a2 + hstep, voffA, rsA, g.A);
            PG8_WAIT_V(8); PG8_WAIT_L(0); PG8_BAR; PG8_MMA(0, 0, At, B0); PG8_MMA(0, 1, At, B1); PG8_BAR; PG8_SCHED;
            PG8_LDA(At, 1, 1); PG8_STAGE_X(PG8_SB(1, 0), b3, voffB, rsB, g.Bt); PG8_STAGE_X(PG8_SB(1, 1), b3 + hstep, voffB, rsB, g.Bt); PG8_STAGE_X(PG8_SA(1, 0), a3, voffA, rsA, g.A);
            PG8_WAIT_V(8); PG8_WAIT_L(0); PG8_BAR; PG8_MMA(1, 0, At, B0); PG8_MMA(1, 1, At, B1); PG8_BAR; PG8_SCHED;
            } else {
            PG8_LDB(B0, 0, 0); PG8_SCHED; PG8_LDA(At, 0, 0); PG8_STAGE_X(PG8_SA(1, 1), a1 + hstep, voffA, rsA, g.A);
            PG8_WAIT_L(8); PG8_BAR; PG8_WAIT_L(0); PG8_MMA(0, 0, At, B0); PG8_BAR; PG8_SCHED;
            PG8_LDB(B1, 0, 1); PG8_STAGE_X(PG8_SB(0, 0), b2, voffB, rsB, g.Bt);
            PG8_BAR; PG8_WAIT_L(0); PG8_MMA(0, 1, At, B1); PG8_BAR;
            PG8_LDA(At, 0, 1); PG8_STAGE_X(PG8_SA(0, 0), a2, voffA, rsA, g.A);
            PG8_BAR; PG8_WAIT_L(0); PG8_MMA(1, 0, At, B0); PG8_BAR; PG8_SCHED;
            PG8_STAGE_X(PG8_SB(0, 1), b2 + hstep, voffB, rsB, g.Bt);
            PG8_WAIT_V(6); PG8_BAR; PG8_MMA(1, 1, At, B1); PG8_BAR;
            PG8_LDB(B0, 1, 0); PG8_SCHED; PG8_LDA(At, 1, 0); PG8_STAGE_X(PG8_SA(0, 1), a2 + hstep, voffA, rsA, g.A);
            PG8_WAIT_L(8); PG8_BAR; PG8_WAIT_L(0); PG8_MMA(0, 0, At, B0); PG8_BAR; PG8_SCHED;
            PG8_LDB(B1, 1, 1); PG8_STAGE_X(PG8_SB(1, 0), b3, voffB, rsB, g.Bt);
            PG8_BAR; PG8_WAIT_L(0); PG8_MMA(0, 1, At, B1); PG8_BAR;
            PG8_LDA(At, 1, 1); PG8_STAGE_X(PG8_SA(1, 0), a3, voffA, rsA, g.A);
            PG8_BAR; PG8_WAIT_L(0); PG8_MMA(1, 0, At, B0); PG8_BAR; PG8_SCHED;
            PG8_STAGE_X(PG8_SB(1, 1), b3 + hstep, voffB, rsB, g.Bt);
            PG8_WAIT_V(6); PG8_BAR; PG8_MMA(1, 1, At, B1); PG8_BAR;
            }
        }
        if constexpr (ALIGN_EPI) { if (wr == 0) PG8_BAR; }
        if constexpr (!Epi::AFTER_DRAIN) { E(acc, cur, wr, wc, fr, fq); S.done(cur); }
        if (!has_next) break;
#pragma unroll
        for (int a = 0; a < 2; ++a)
#pragma unroll
            for (int b = 0; b < 2; ++b)
#pragma unroll
                for (int m = 0; m < 4; ++m)
#pragma unroll
                    for (int n = 0; n < 2; ++n) acc[a][b][m][n] = (f32x4){0.f, 0.f, 0.f, 0.f};
        cur = nxt; cA = nA; cB = nB; ++ui;
        if constexpr (ALIGN_EPI) { if (wr == 1) PG8_BAR; }
    }
    PG8_WAIT_V(0);
    if constexpr (!ALIGN_EPI) { if (wr == 0) PG8_BAR; }
    PG8_BAR;
    if constexpr (Epi::AFTER_DRAIN) { E.fused(acc, cur, wr, wc, fr, fq, lds, wid, lane); S.done(cur); }
#undef PG8_SA
#undef PG8_SB
#undef PG8_STAGE_X
#undef PG8_LDA
#undef PG8_LDB
#undef PG8_MMA
#undef PG8_WAIT_V
#undef PG8_WAIT_L
#undef PG8_BAR
#undef PG8_SCHED
}
}
#define GAS __attribute__((address_space(1)))
#define LAS __attribute__((address_space(3)))
typedef unsigned short bf16_t;
typedef unsigned u32x4 __attribute__((ext_vector_type(4)));
typedef unsigned u32x2 __attribute__((ext_vector_type(2)));
typedef float f32x4 __attribute__((ext_vector_type(4)));
typedef float f32x2 __attribute__((ext_vector_type(2)));
typedef float f32x16 __attribute__((ext_vector_type(16)));
typedef short bf16x8 __attribute__((ext_vector_type(8)));
typedef short s16x4 __attribute__((ext_vector_type(4)));
typedef __bf16 bf16x2_t __attribute__((ext_vector_type(2)));
typedef unsigned u32x6 __attribute__((ext_vector_type(6)));
typedef unsigned u32x16 __attribute__((ext_vector_type(16)));
typedef float f32x32 __attribute__((ext_vector_type(32)));
typedef _Float16 f16x32 __attribute__((ext_vector_type(32)));
typedef _Float16 f16x2 __attribute__((ext_vector_type(2)));

namespace mk {
constexpr int M = 16384, D = 4096, S = 2048, NB = 8, PW = 12298, NH = 32, NE = 16384;
constexpr int NWAVES = 8;
constexpr size_t MiB = 1u << 20;
constexpr size_t WS_CTL = 0, CTL_ZERO_BYTES = 1 * MiB;
constexpr size_t WS_RSTD = 2 * MiB, WS_LOGF = 3 * MiB, WS_WQK = 4 * MiB, WS_WOUT = 20 * MiB, WS_WIN = 52 * MiB, WS_U16 = 148 * MiB, WS_V16 = 276 * MiB,
                 WS_XB = 404 * MiB, WS_Q = 532 * MiB, WS_K = 660 * MiB, WS_V = 788 * MiB, WS_OB = 916 * MiB, WS_X2 = 1792 * MiB, WS_END = 2048 * MiB;
constexpr size_t WS_XB8N = WS_OB + 64 * MiB;
constexpr size_t WS_SC = WS_Q;
constexpr int CW_BAR = 4096;
constexpr int CW_QUEUE = 16384;
constexpr int RING_BYTES = 131072, LDSCTL_OFF = RING_BYTES, MISC_OFF = LDSCTL_OFF + 320, LDS_BYTES = 147456;

struct Args { const float* in[13]; float* out; unsigned char* ws; int ph_lo, ph_hi; };

__device__ __forceinline__ unsigned f2bf(float f) { unsigned u = __builtin_bit_cast(unsigned, f); return (u + 0x7fffu + ((u >> 16) & 1u)) >> 16; }
__device__ __forceinline__ unsigned pk2(float lo, float hi) { return f2bf(lo) | (f2bf(hi) << 16); }
__device__ __forceinline__ float bf_lo(unsigned w) { return __builtin_bit_cast(float, w << 16); }
__device__ __forceinline__ float bf_hi(unsigned w) { return __builtin_bit_cast(float, w & 0xffff0000u); }
__device__ __forceinline__ float lane_read(float v, int src_lane) { return __builtin_bit_cast(float, __builtin_amdgcn_ds_bpermute(src_lane << 2, __builtin_bit_cast(int, v))); }
__device__ __forceinline__ int lane_read(int v, int src_lane) { return __builtin_amdgcn_ds_bpermute(src_lane << 2, v); }
constexpr float US = 1024.0f, VS = 32.0f, US_INV = 1.0f / 1024.0f, VS_INV = 1.0f / 32.0f;
constexpr int ROW6 = 3072;
__device__ __forceinline__ unsigned q_e2m3(float x, float inv) {
    const float a = fminf(fabsf(x) * inv, 7.5f);
    const float c = a < 2.0f ? __builtin_rintf(a * 8.0f) : (a < 4.0f ? __builtin_rintf(a * 4.0f) + 8.0f : __builtin_rintf(a * 2.0f) + 16.0f);
    return (unsigned)(int)c | ((__builtin_bit_cast(unsigned, x) >> 26) & 32u);
}
__device__ __forceinline__ u32x6 pack_fp6(const f32x4 (&a0)[4], const f32x4 (&a1)[4], float inv) {
    unsigned o[6];
#pragma unroll
    for (int w = 0; w < 6; ++w) o[w] = 0u;
#pragma unroll
    for (int j = 0; j < 32; ++j) { const float x = (j < 16) ? a0[(j & 15) >> 2][j & 3] : a1[(j & 15) >> 2][j & 3]; const unsigned c = q_e2m3(x, inv);
        const int b = 6 * j, w = b >> 5, sh = b & 31; o[w] |= c << sh; if (sh > 26) o[w + 1] |= c >> (32 - sh); }
    return (u32x6){o[0], o[1], o[2], o[3], o[4], o[5]};
}
__device__ __forceinline__ float clamp8(float x) { return fminf(fmaxf(x, -224.0f), 224.0f); }
__device__ __forceinline__ float logsig(float z) { return fminf(z, 0.f) - 0.6931471805599453f * __builtin_amdgcn_logf(1.0f + __builtin_amdgcn_exp2f(-fabsf(z) * 1.4426950408889634f)); }
__device__ __forceinline__ float gelu_erf(float v) {
    const float av = fabsf(v), t = __builtin_amdgcn_rcpf(av * 0.2316418882f + 1.0f);
    float q = t * 0.5307027145f + (-0.7265760135f); q = q * t + 0.7107068705f; q = q * t + (-0.142248368f); q = q * t + 0.127414796f; q = q * t;
    const float e = __builtin_amdgcn_exp2f((v * v) * (-0.72134752044f));
    const float m = v * (q * e);
    return v < 0.f ? m : v - m;
}
#define LDS_WAIT() asm volatile("s_waitcnt lgkmcnt(0)" ::: "memory")
#define FRESH_LDS(l) do { unsigned v_ = (unsigned)(size_t)(l); asm volatile("" : "+s"(v_)); (l) = (LAS unsigned char*)(size_t)v_; } while (0)
#define FRESH_BID() int bid = blockIdx.x, G = gridDim.x; asm volatile("" : "+s"(bid), "+s"(G))
#define FRESH_TID() int tid; { int w_ = wave0, l_; { unsigned z_ = 0u; asm volatile("" : "+v"(z_)); l_ = (int)__builtin_amdgcn_mbcnt_hi(~0u, __builtin_amdgcn_mbcnt_lo(~0u, z_)); } asm volatile("" : "+s"(w_)); tid = w_ * 64 + l_; } const int lane = tid & 63, wave = __builtin_amdgcn_readfirstlane(tid >> 6); (void)lane; (void)wave

__device__ __forceinline__ unsigned wave_max_u32(unsigned v) {
    v = max(v, (unsigned)__builtin_amdgcn_update_dpp(0, (int)v, 0x111, 0xF, 0xF, true));
    v = max(v, (unsigned)__builtin_amdgcn_update_dpp(0, (int)v, 0x112, 0xF, 0xF, true));
    v = max(v, (unsigned)__builtin_amdgcn_update_dpp(0, (int)v, 0x114, 0xF, 0xF, true));
    v = max(v, (unsigned)__builtin_amdgcn_update_dpp(0, (int)v, 0x118, 0xF, 0xF, true));
    v = max(v, (unsigned)__builtin_amdgcn_update_dpp((int)v, (int)v, 0x142, 0xA, 0xF, false));
    v = max(v, (unsigned)__builtin_amdgcn_update_dpp((int)v, (int)v, 0x143, 0xC, 0xF, false));
    return (unsigned)__builtin_amdgcn_readlane((int)v, 63);
}
__device__ __forceinline__ float wave_sum_dpp(float x) {
    int v = __builtin_bit_cast(int, x);
#define DPP_ADD(ctrl, rm, bc, oldv) v = __builtin_bit_cast(int, __builtin_bit_cast(float, v) + __builtin_bit_cast(float, __builtin_amdgcn_update_dpp(oldv, v, ctrl, rm, 0xF, bc)))
    DPP_ADD(0x111, 0xF, true, 0); DPP_ADD(0x112, 0xF, true, 0); DPP_ADD(0x114, 0xF, true, 0); DPP_ADD(0x118, 0xF, true, 0);
#undef DPP_ADD
    const float r0 = __builtin_bit_cast(float, __builtin_amdgcn_readlane(v, 15)), r1 = __builtin_bit_cast(float, __builtin_amdgcn_readlane(v, 31)), r2 = __builtin_bit_cast(float, __builtin_amdgcn_readlane(v, 47)), r3 = __builtin_bit_cast(float, __builtin_amdgcn_readlane(v, 63));
    return (r0 + r1) + (r2 + r3);
}
__device__ __forceinline__ unsigned ordkey(float x) { const unsigned u = __builtin_bit_cast(unsigned, x); return (u & 0x80000000u) ? ~u : (u | 0x80000000u); }
__device__ __forceinline__ void transpose_item(const float* W, int K, int ldw, int ncols, const float* gain, bf16_t* WT, LAS float* scr, int item, int lane) {
    const int nblk = ncols / 32, kb = item / nblk, nb = item % nblk, k0 = 64 * kb, n0 = 32 * nb;
#pragma unroll 8
    for (int i = 0; i < 32; ++i) { const int kk = 2 * i + (lane >> 5); float v = W[(size_t)(k0 + kk) * ldw + n0 + (lane & 31)]; if (gain) v *= gain[k0 + kk]; scr[kk * 33 + (lane & 31)] = v; }
    LDS_WAIT(); asm volatile("" ::: "memory");
    const int c = lane & 7;
#pragma unroll
    for (int j = 0; j < 4; ++j) { const int n = (lane >> 3) + 8 * j; const LAS float* s = scr + (8 * c) * 33 + n;
        u32x4 o; o.x = pk2(s[0 * 33], s[1 * 33]); o.y = pk2(s[2 * 33], s[3 * 33]); o.z = pk2(s[4 * 33], s[5 * 33]); o.w = pk2(s[6 * 33], s[7 * 33]);
        *(u32x4*)(WT + (size_t)(n0 + n) * K + k0 + 8 * c) = o; }
    LDS_WAIT(); asm volatile("" ::: "memory");
}

typedef const __attribute__((address_space(4))) Args* KArgsT;
__device__ __forceinline__ unsigned pk4_fp8(float a, float b, float c, float d) { int p = __builtin_amdgcn_cvt_pk_fp8_f32(clamp8(a), clamp8(b), 0, false); p = __builtin_amdgcn_cvt_pk_fp8_f32(clamp8(c), clamp8(d), p, true); return (unsigned)p; }
__device__ __forceinline__ void transpose_item8(const float* W, int K, int ldw, int ncols, const float* gain, float scale, unsigned char* WT, LAS float* scr, int item, int lane) {
    const int nblk = ncols / 32, kb = item / nblk, nb = item % nblk, k0 = 64 * kb, n0 = 32 * nb;
    const int kr = lane >> 3, nq = (lane & 7) * 4;
    f32x4 v[8];
#pragma unroll
    for (int i = 0; i < 8; ++i) { const float* p = W + (size_t)(k0 + 8 * i + kr) * ldw + n0 + nq; v[i] = (f32x4){p[0], p[1], p[2], p[3]}; }
#pragma unroll
    for (int i = 0; i < 8; ++i) { const int kk = 8 * i + kr; const float g = (gain ? gain[k0 + kk] : 1.0f) * scale; LAS float* d = scr + kk * 33 + nq; d[0] = v[i][0] * g; d[1] = v[i][1] * g; d[2] = v[i][2] * g; d[3] = v[i][3] * g; }
    LDS_WAIT(); asm volatile("" ::: "memory");
    const int c = lane & 7;
#pragma unroll
    for (int j = 0; j < 4; ++j) { const int n = (lane >> 3) + 8 * j; const LAS float* s = scr + (8 * c) * 33 + n;
        u32x2 o; o.x = pk4_fp8(s[0 * 33], s[1 * 33], s[2 * 33], s[3 * 33]); o.y = pk4_fp8(s[4 * 33], s[5 * 33], s[6 * 33], s[7 * 33]);
        *(u32x2*)(WT + (size_t)(n0 + n) * K + k0 + 8 * c) = o; }
    LDS_WAIT(); asm volatile("" ::: "memory");
}
__device__ __forceinline__ void conv_phase(KArgsT ka, int l, LAS unsigned char* lds, int wave0) {
    FRESH_TID(); FRESH_LDS(lds); FRESH_BID();
    unsigned char* ws = ka->ws;
    const float* ln1 = ka->in[1] + (size_t)l * D; const float* w_in = ka->in[2] + (size_t)l * D * PW; const float* w_out = ka->in[5] + (size_t)l * D * D;
    const float* ln2 = ka->in[6] + (size_t)l * D; const float* wq = ka->in[7] + (size_t)l * D * 2048;
    const float* k1 = ka->in[8] + (size_t)l * 8 * 128 * 128; const float* k2 = ka->in[9] + (size_t)l * 8 * 128 * 128;
    const float* pu = ka->in[10] + (size_t)l * NE * D; const float* pv = ka->in[11] + (size_t)l * NE * D;
    bf16_t* WQK = (bf16_t*)(ws + WS_WQK); bf16_t* WOUT = (bf16_t*)(ws + WS_WOUT); bf16_t* WIN = (bf16_t*)(ws + WS_WIN); bf16_t* U16 = (bf16_t*)(ws + WS_U16); bf16_t* V16 = (bf16_t*)(ws + WS_V16);
    {
        LAS float* Ks = (LAS float*)lds;
        LAS float* Ws = (LAS float*)(lds + 128 * 132 * 4);
        for (int it = bid; it < 1024; it += G) {
            const int gi = it >> 6, c0 = (it & 63) * 64;
            const float* key = ((gi & 1) ? k2 : k1) + (size_t)(gi >> 1) * 128 * 128;
            for (int i = tid; i < 4096; i += 512) { const int r = i >> 5, c4 = (i & 31) * 4; *(LAS f32x4*)(Ks + r * 132 + c4) = *(const f32x4*)(key + r * 128 + c4); }
            for (int i = tid; i < 2048; i += 512) { const int r = i >> 5, c4 = (i & 31) * 4; *(LAS f32x4*)(Ws + r * 132 + c4) = *(const f32x4*)(wq + (size_t)(c0 + r) * 2048 + gi * 128 + c4); }
            __syncthreads();
            const int tc = tid & 15, tn = tid >> 4;
            float acc[4][4];
#pragma unroll
            for (int i = 0; i < 4; ++i)
#pragma unroll
                for (int j = 0; j < 4; ++j) acc[i][j] = 0.f;
#pragma unroll 2
            for (int d = 0; d < 128; d += 4) {
                f32x4 kv[4], wv[4];
#pragma unroll
                for (int i = 0; i < 4; ++i) kv[i] = *(const LAS f32x4*)(Ks + (4 * tn + i) * 132 + d);
#pragma unroll
                for (int j = 0; j < 4; ++j) wv[j] = *(const LAS f32x4*)(Ws + (tc + 16 * j) * 132 + d);
#pragma unroll
                for (int i = 0; i < 4; ++i)
#pragma unroll
                    for (int j = 0; j < 4; ++j) acc[i][j] += kv[i][0] * wv[j][0] + kv[i][1] * wv[j][1] + kv[i][2] * wv[j][2] + kv[i][3] * wv[j][3];
            }
#pragma unroll
            for (int j = 0; j < 4; ++j) { const int c = c0 + tc + 16 * j; const float gg = ln2[c];
#pragma unroll
                for (int i = 0; i < 4; ++i) WQK[(size_t)(gi * 128 + 4 * tn + i) * D + c] = (bf16_t)f2bf(acc[i][j] * gg); }
            __syncthreads();
        }
        __syncthreads();
    }
    const int gw = bid * NWAVES + wave, NGW = G * NWAVES;
    {
        unsigned char* U6 = (unsigned char*)U16; unsigned char* V6 = U6 + (size_t)NE * ROW6; float* SCU = (float*)(U6 + 2 * (size_t)NE * ROW6); float* SCV = SCU + NE;
        for (int r = gw; r < NE; r += NGW) {
            const float* us = pu + (size_t)r * D + 16 * lane; const float* vs = pv + (size_t)r * D + 16 * lane;
            f32x4 uu[4][4], vv[4][4];
#pragma unroll
            for (int i = 0; i < 4; ++i)
#pragma unroll
                for (int q = 0; q < 4; ++q) { uu[i][q] = *(const f32x4*)(us + 1024 * i + 4 * q); vv[i][q] = *(const f32x4*)(vs + 1024 * i + 4 * q); }
            float au = 0.f, av = 0.f;
#pragma unroll
            for (int i = 0; i < 4; ++i)
#pragma unroll
                for (int q = 0; q < 4; ++q) { uu[i][q] *= *(const f32x4*)(ln2 + 1024 * i + 16 * lane + 4 * q);
                    au = fmaxf(fmaxf(au, fmaxf(fabsf(uu[i][q][0]), fabsf(uu[i][q][1]))), fmaxf(fabsf(uu[i][q][2]), fabsf(uu[i][q][3])));
                    av = fmaxf(fmaxf(av, fmaxf(fabsf(vv[i][q][0]), fabsf(vv[i][q][1]))), fmaxf(fabsf(vv[i][q][2]), fabsf(vv[i][q][3]))); }
            au = __builtin_bit_cast(float, wave_max_u32(__builtin_bit_cast(unsigned, au))); av = __builtin_bit_cast(float, wave_max_u32(__builtin_bit_cast(unsigned, av)));
            const float iu = au > 0.f ? 7.5f / au : 0.f, iv = av > 0.f ? 7.5f / av : 0.f;
            if (lane == 0) { SCU[r] = au * (1.0f / 7.5f); SCV[r] = av * (1.0f / 7.5f); }
            { const u32x6 g0 = pack_fp6(uu[0], uu[1], iu), g1 = pack_fp6(uu[2], uu[3], iu); u32x4* o = (u32x4*)(U6 + (size_t)r * ROW6) + lane;
              o[0] = (u32x4){g0[0], g0[1], g0[2], g0[3]}; o[64] = (u32x4){g0[4], g0[5], g1[0], g1[1]}; o[128] = (u32x4){g1[2], g1[3], g1[4], g1[5]}; }
            { const u32x6 g0 = pack_fp6(vv[0], vv[1], iv), g1 = pack_fp6(vv[2], vv[3], iv); u32x4* o = (u32x4*)(V6 + (size_t)r * ROW6) + lane;
              o[0] = (u32x4){g0[0], g0[1], g0[2], g0[3]}; o[64] = (u32x4){g0[4], g0[5], g1[0], g1[1]}; o[128] = (u32x4){g1[2], g1[3], g1[4], g1[5]}; }
        }
    }
    {
        LAS float* scr = (LAS float*)(lds + wave * 16384);
        constexpr int I_O = (D / 64) * (D / 32), I_IN = (D / 64) * (12288 / 32);
        for (int it = gw; it < I_O + I_IN; it += NGW) {
            if (it < I_O) transpose_item8(w_out, D, D, D, nullptr, US, (unsigned char*)WOUT, scr, it, lane);
            else transpose_item8(w_in, D, PW, 12288, ln1, US, (unsigned char*)WIN, scr, it - I_O, lane);
        }
    }
}

template <bool WITH_F>
__device__ __forceinline__ void prep_phase(const float* X, bf16_t* XB, float* RSTD, const float* w_in, const float* ln1, const float* bf, float* LOGF, LAS unsigned char* lds, int wave0) {
    FRESH_TID(); FRESH_LDS(lds); FRESH_BID();
    LAS unsigned short* gfs = (LAS unsigned short*)lds;
    if (WITH_F) {
        __syncthreads();
        for (int c = tid; c < D; c += 512) { const float g = ln1[c]; const float* wr = w_in + (size_t)c * PW + 12288;
#pragma unroll
            for (int j = 0; j < 10; ++j) gfs[j * D + c] = (unsigned short)f2bf(wr[j] * g); }
        __syncthreads();
    }
    const int gw = bid * NWAVES + wave, NGW = G * NWAVES;
    for (int m = gw; m < M; m += NGW) {
        const f32x4* xr = (const f32x4*)(X + (size_t)m * D) + lane;
        f32x4 v[16]; float ss = 0.f;
#pragma unroll
        for (int i = 0; i < 16; ++i) { v[i] = xr[64 * i]; ss += (v[i][0] * v[i][0] + v[i][1] * v[i][1]) + (v[i][2] * v[i][2] + v[i][3] * v[i][3]); }
        ss = wave_sum_dpp(ss);
        const float rstd = rsqrtf(ss * (1.0f / D) + 1e-6f);
        if (WITH_F) {
            unsigned* o8 = (unsigned*)((unsigned char*)XB + (size_t)m * D) + lane;
#pragma unroll
            for (int i = 0; i < 16; ++i) o8[64 * i] = pk4_fp8(v[i][0], v[i][1], v[i][2], v[i][3]);
        } else {
        u32x2* o = (u32x2*)(XB + (size_t)m * D) + lane;
#pragma unroll
        for (int i = 0; i < 16; ++i) { u32x2 w; w.x = pk2(v[i][0], v[i][1]); w.y = pk2(v[i][2], v[i][3]); o[64 * i] = w; }
        }
        if (lane == 0) RSTD[m] = rstd;
        if (WITH_F) {
            float mine = 0.f;
#pragma unroll 1
            for (int j = 0; j < 10; ++j) { float s = 0.f;
#pragma unroll
                for (int i = 0; i < 16; ++i) { const u32x2 gp = *(const LAS u32x2*)(gfs + j * D + 256 * i + 4 * lane);
                    s += (v[i][0] * bf_lo(gp.x) + v[i][1] * bf_hi(gp.x)) + (v[i][2] * bf_lo(gp.y) + v[i][3] * bf_hi(gp.y)); }
                s = wave_sum_dpp(s); if (lane == j) mine = s; }
            if (lane < 10) { const int b = m >> 11, s = m & 2047; LOGF[(size_t)(b * 10 + lane) * S + s] = logsig(mine * rstd + bf[lane]); }
        }
    }
}


__device__ __forceinline__ void load16_bf16(const bf16_t* p, float (&d)[16]) {
    const u32x4 a = *(const u32x4*)p, b = *(const u32x4*)(p + 8);
#pragma unroll
    for (int q = 0; q < 4; ++q) { d[2 * q] = bf_lo(a[q]); d[2 * q + 1] = bf_hi(a[q]); d[8 + 2 * q] = bf_lo(b[q]); d[8 + 2 * q + 1] = bf_hi(b[q]); }
}
#define RFL(x) __builtin_amdgcn_readfirstlane(x)
__device__ __forceinline__ void peer_u_phase(const float* SC, const unsigned char* U6, const bf16_t* X1, int* EIDG, float* WG, LAS unsigned char* lds, int wave0) {
    FRESH_TID(); FRESH_LDS(lds); FRESH_BID();
    LAS int* s_eid = (LAS int*)(lds + wave * 1024); LAS float* s_w = (LAS float*)(lds + wave * 1024 + 512); LAS float* s_su = (LAS float*)(lds + 8192 + wave * 512);
    const float* SCU = (const float*)(U6 + 2 * (size_t)NE * ROW6); const float* SCV = SCU + NE;
    const int gw = bid * NWAVES + wave, NGW = G * NWAVES;
    const float NEG = -3.0e38f;
    for (int tok = gw; tok < M; tok += NGW) {
        const bf16_t* x1 = X1 + (size_t)tok * D;
        f16x2 xh[2][16]; float rstd_tok;
        { float ss_ = 0.f;
#pragma unroll
          for (int i = 0; i < 4; ++i) { float t[16]; load16_bf16(x1 + 1024 * i + 16 * lane, t);
#pragma unroll
              for (int k = 0; k < 16; ++k) ss_ += t[k] * t[k];
#pragma unroll
              for (int k = 0; k < 8; ++k) xh[i >> 1][(i & 1) * 8 + k] = __builtin_bit_cast(f16x2, __builtin_amdgcn_cvt_pkrtz(t[2 * k], t[2 * k + 1])); }
          rstd_tok = rsqrtf(wave_sum_dpp(ss_) * (1.0f / D) + 1e-6f); }
        const float* sc = SC + (size_t)tok * 2048;
        for (int h = 0; h < 4; ++h) {
            const float a0 = sc[h * 256 + lane], a1 = sc[h * 256 + 64 + lane], c0 = sc[h * 256 + 128 + lane], c1 = sc[h * 256 + 192 + lane];
            const float A0 = sc[(h + 4) * 256 + lane], A1 = sc[(h + 4) * 256 + 64 + lane], C0 = sc[(h + 4) * 256 + 128 + lane], C1 = sc[(h + 4) * 256 + 192 + lane];
            unsigned ka0 = (ordkey(a0) & ~127u) | (unsigned)(127 - lane), ka1 = (ordkey(a1) & ~127u) | (unsigned)(63 - lane);
            unsigned kc0 = (ordkey(c0) & ~127u) | (unsigned)(127 - lane), kc1 = (ordkey(c1) & ~127u) | (unsigned)(63 - lane);
            unsigned kA0 = (ordkey(A0) & ~127u) | (unsigned)(127 - lane), kA1 = (ordkey(A1) & ~127u) | (unsigned)(63 - lane);
            unsigned kC0 = (ordkey(C0) & ~127u) | (unsigned)(127 - lane), kC1 = (ordkey(C1) & ~127u) | (unsigned)(63 - lane);
            float v1 = 0.f, v2 = 0.f, V1 = 0.f, V2 = 0.f; int i1 = 0, i2 = 0, I1 = 0, I2 = 0;
#define RD(x, n) __builtin_bit_cast(float, __builtin_amdgcn_readlane(__builtin_bit_cast(int, x), (n) & 63))
            for (int it = 0; it < 16; ++it) {
                const unsigned m1 = wave_max_u32(max(ka0, ka1)), m2 = wave_max_u32(max(kc0, kc1)), M1 = wave_max_u32(max(kA0, kA1)), M2 = wave_max_u32(max(kC0, kC1));
                const int n1 = 127 - (int)(m1 & 127u), n2 = 127 - (int)(m2 & 127u), N1 = 127 - (int)(M1 & 127u), N2 = 127 - (int)(M2 & 127u);
                const float x1v = (n1 & 64) ? RD(a1, n1) : RD(a0, n1), x2v = (n2 & 64) ? RD(c1, n2) : RD(c0, n2), X1v = (N1 & 64) ? RD(A1, N1) : RD(A0, N1), X2v = (N2 & 64) ? RD(C1, N2) : RD(C0, N2);
                ka0 = ka0 == m1 ? 0u : ka0; ka1 = ka1 == m1 ? 0u : ka1; kc0 = kc0 == m2 ? 0u : kc0; kc1 = kc1 == m2 ? 0u : kc1;
                kA0 = kA0 == M1 ? 0u : kA0; kA1 = kA1 == M1 ? 0u : kA1; kC0 = kC0 == M2 ? 0u : kC0; kC1 = kC1 == M2 ? 0u : kC1;
                if (lane == it) { v1 = x1v; i1 = n1; v2 = x2v; i2 = n2; V1 = X1v; I1 = N1; V2 = X2v; I2 = N2; }
            }
            unsigned kd0, kd1, kd2, kd3, kD0, kD1, kD2, kD3;
            { const float va = lane_read(v1, lane >> 2), vA = lane_read(V1, lane >> 2); const int pb_ = 255 - 4 * lane;
              kd0 = (ordkey(va + lane_read(v2, (lane & 3) * 4 + 0)) & ~255u) | (unsigned)(pb_); kd1 = (ordkey(va + lane_read(v2, (lane & 3) * 4 + 1)) & ~255u) | (unsigned)(pb_ - 1);
              kd2 = (ordkey(va + lane_read(v2, (lane & 3) * 4 + 2)) & ~255u) | (unsigned)(pb_ - 2); kd3 = (ordkey(va + lane_read(v2, (lane & 3) * 4 + 3)) & ~255u) | (unsigned)(pb_ - 3);
              kD0 = (ordkey(vA + lane_read(V2, (lane & 3) * 4 + 0)) & ~255u) | (unsigned)(pb_); kD1 = (ordkey(vA + lane_read(V2, (lane & 3) * 4 + 1)) & ~255u) | (unsigned)(pb_ - 1);
              kD2 = (ordkey(vA + lane_read(V2, (lane & 3) * 4 + 2)) & ~255u) | (unsigned)(pb_ - 2); kD3 = (ordkey(vA + lane_read(V2, (lane & 3) * 4 + 3)) & ~255u) | (unsigned)(pb_ - 3); }
            float best = 0.f, Best = 0.f; int be = 0, Be = 0;
            for (int it = 0; it < 16; ++it) {
                const unsigned m = wave_max_u32(max(max(kd0, kd1), max(kd2, kd3))), Mx = wave_max_u32(max(max(kD0, kD1), max(kD2, kD3)));
                const int pos = 255 - (int)(m & 255u), Pos = 255 - (int)(Mx & 255u);
                const float bv = RD(v1, pos >> 4) + RD(v2, pos & 15), Bv = RD(V1, Pos >> 4) + RD(V2, Pos & 15);
                const int e = (__builtin_amdgcn_readlane(i1, pos >> 4) << 7) | __builtin_amdgcn_readlane(i2, pos & 15), E = (__builtin_amdgcn_readlane(I1, Pos >> 4) << 7) | __builtin_amdgcn_readlane(I2, Pos & 15);
                kd0 = kd0 == m ? 0u : kd0; kd1 = kd1 == m ? 0u : kd1; kd2 = kd2 == m ? 0u : kd2; kd3 = kd3 == m ? 0u : kd3;
                kD0 = kD0 == Mx ? 0u : kD0; kD1 = kD1 == Mx ? 0u : kD1; kD2 = kD2 == Mx ? 0u : kD2; kD3 = kD3 == Mx ? 0u : kD3;
                if (lane == it) { best = bv; be = e; Best = Bv; Be = E; }
            }
            const float mx = RD(best, 0), Mxx = RD(Best, 0);
#undef RD
            const float p = lane < 16 ? __builtin_amdgcn_exp2f((best - mx) * (1.4426950408889634f * rstd_tok)) : 0.f, P = lane < 16 ? __builtin_amdgcn_exp2f((Best - Mxx) * (1.4426950408889634f * rstd_tok)) : 0.f;
            const float sm = wave_sum_dpp(p), Sm = wave_sum_dpp(P);
            if (lane < 16) { s_eid[h * 16 + lane] = be; s_w[h * 16 + lane] = p / sm * SCV[be]; s_su[h * 16 + lane] = SCU[be]; s_eid[(h + 4) * 16 + lane] = Be; s_w[(h + 4) * 16 + lane] = P / Sm * SCV[Be]; s_su[(h + 4) * 16 + lane] = SCU[Be]; }
        }
        LDS_WAIT(); asm volatile("" ::: "memory");
#define LOADROW6(dst, base, e) do { const u32x4* p_ = (const u32x4*)((base) + (size_t)(e) * ROW6) + lane; dst[0] = p_[0]; dst[1] = p_[64]; dst[2] = p_[128]; } while (0)
#define GRP6(row, g) ((g) == 0 ? (u32x6){row[0][0], row[0][1], row[0][2], row[0][3], row[1][0], row[1][1]} : (u32x6){row[1][2], row[1][3], row[2][0], row[2][1], row[2][2], row[2][3]})
        {
#define UDOT6(row, j) do { float da_ = 0.f, db_ = 0.f; _Pragma("unroll") for (int g_ = 0; g_ < 2; ++g_) { \
                u32x6 G_ = GRP6(row, g_); asm volatile("" : "+v"(G_));     \
                const f16x32 hv_ = __builtin_amdgcn_cvt_scalef32_pk32_f16_fp6(G_, 1.0f); \
                _Pragma("unroll") for (int k_ = 0; k_ < 16; k_ += 2) { da_ = __builtin_amdgcn_fdot2((f16x2){hv_[2 * k_], hv_[2 * k_ + 1]}, xh[g_][k_], da_, false); db_ = __builtin_amdgcn_fdot2((f16x2){hv_[2 * k_ + 2], hv_[2 * k_ + 3]}, xh[g_][k_ + 1], db_, false); } \
                asm volatile("" : "+v"(da_), "+v"(db_)); } \
            const float d_ = wave_sum_dpp(da_ + db_) * (rstd_tok * s_su[j]); const float ge_ = gelu_erf(d_); if (lane == 0) s_w[j] *= ge_; } while (0)
            u32x4 r0[3], r1[3], r2[3];
            { const int e_ = RFL(s_eid[0]); LOADROW6(r0, U6, e_); } { const int e_ = RFL(s_eid[1]); LOADROW6(r1, U6, e_); } { const int e_ = RFL(s_eid[2]); LOADROW6(r2, U6, e_); }
            for (int j = 0; j < 126; j += 3) {
                UDOT6(r0, j);     if (j + 3 < 128) { const int e_ = RFL(s_eid[j + 3]); LOADROW6(r0, U6, e_); }
                UDOT6(r1, j + 1); if (j + 4 < 128) { const int e_ = RFL(s_eid[j + 4]); LOADROW6(r1, U6, e_); }
                UDOT6(r2, j + 2); if (j + 5 < 128) { const int e_ = RFL(s_eid[j + 5]); LOADROW6(r2, U6, e_); }
            }
            UDOT6(r0, 126); UDOT6(r1, 127);
#undef UDOT6
        }
        LDS_WAIT(); asm volatile("" ::: "memory");
        EIDG[(size_t)tok * 128 + lane] = s_eid[lane]; EIDG[(size_t)tok * 128 + 64 + lane] = s_eid[64 + lane];
        WG[(size_t)tok * 128 + lane] = s_w[lane]; WG[(size_t)tok * 128 + 64 + lane] = s_w[64 + lane];
        LDS_WAIT(); asm volatile("" ::: "memory");
    }
}

template <bool FINAL>
__device__ __forceinline__ void peer_v_phase(const int* EIDG, const float* WG, const unsigned char* V6, const bf16_t* X1, void* XOv, const float* fg,
                                             unsigned char* XB8n, float* RSTDn, float* LOGFn, const float* w_in_n, const float* ln1_n, const float* bf_n, LAS unsigned char* lds, int wave0) {
    FRESH_TID(); FRESH_LDS(lds); FRESH_BID();
    LAS int* s_eid = (LAS int*)(lds + 81920 + wave * 1024); LAS float* s_w = (LAS float*)(lds + 81920 + wave * 1024 + 512);
    LAS unsigned short* gfs = (LAS unsigned short*)lds;
    if (!FINAL) {
        __syncthreads();
        for (int c = tid; c < D; c += 512) { const float g = ln1_n[c]; const float* wr = w_in_n + (size_t)c * PW + 12288;
#pragma unroll
            for (int j = 0; j < 10; ++j) gfs[j * D + c] = (unsigned short)f2bf(wr[j] * g); }
        __syncthreads();
    }
    const int gw = bid * NWAVES + wave, NGW = G * NWAVES;
    for (int tok = gw; tok < M; tok += NGW) {
        s_eid[lane] = EIDG[(size_t)tok * 128 + lane]; s_eid[64 + lane] = EIDG[(size_t)tok * 128 + 64 + lane];
        s_w[lane] = WG[(size_t)tok * 128 + lane]; s_w[64 + lane] = WG[(size_t)tok * 128 + 64 + lane];
        LDS_WAIT(); asm volatile("" ::: "memory");
        const bf16_t* x1 = X1 + (size_t)tok * D;
        {
            f32x2 acc2[2][16];
#define ACC(i, k) acc2[(i) >> 1][((i) & 1) * 8 + ((k) >> 1)][(k) & 1]
#pragma unroll
            for (int g = 0; g < 2; ++g)
#pragma unroll
                for (int k = 0; k < 16; ++k) acc2[g][k] = (f32x2){0.f, 0.f};
#define VACC6(row, j) do { const float w_ = s_w[j]; const f32x2 w2_ = {w_, w_}; _Pragma("unroll") for (int g_ = 0; g_ < 2; ++g_) { \
                u32x6 G_ = GRP6(row, g_); asm volatile("" : "+v"(G_)); \
                const f32x32 d_ = __builtin_amdgcn_cvt_scalef32_pk32_f32_fp6(G_, 1.0f); \
                _Pragma("unroll") for (int k_ = 0; k_ < 16; ++k_) acc2[g_][k_] = __builtin_elementwise_fma(w2_, (f32x2){d_[2 * k_], d_[2 * k_ + 1]}, acc2[g_][k_]); \
                asm volatile("" : "+v"(acc2[g_][0]), "+v"(acc2[g_][1]), "+v"(acc2[g_][2]), "+v"(acc2[g_][3]), "+v"(acc2[g_][4]), "+v"(acc2[g_][5]), "+v"(acc2[g_][6]), "+v"(acc2[g_][7]), \
                                  "+v"(acc2[g_][8]), "+v"(acc2[g_][9]), "+v"(acc2[g_][10]), "+v"(acc2[g_][11]), "+v"(acc2[g_][12]), "+v"(acc2[g_][13]), "+v"(acc2[g_][14]), "+v"(acc2[g_][15])); } } while (0)
            u32x4 r0[3], r1[3], r2[3];
            { const int e_ = RFL(s_eid[0]); LOADROW6(r0, V6, e_); } { const int e_ = RFL(s_eid[1]); LOADROW6(r1, V6, e_); } { const int e_ = RFL(s_eid[2]); LOADROW6(r2, V6, e_); }
            for (int j = 0; j < 126; j += 3) {
                VACC6(r0, j);     if (j + 3 < 128) { const int e_ = RFL(s_eid[j + 3]); LOADROW6(r0, V6, e_); }
                VACC6(r1, j + 1); if (j + 4 < 128) { const int e_ = RFL(s_eid[j + 4]); LOADROW6(r1, V6, e_); }
                VACC6(r2, j + 2); if (j + 5 < 128) { const int e_ = RFL(s_eid[j + 5]); LOADROW6(r2, V6, e_); }
            }
            VACC6(r0, 126); VACC6(r1, 127);
#undef VACC6
            float ss = 0.f;
#pragma unroll
            for (int i = 0; i < 4; ++i) { float t[16]; load16_bf16(x1 + 1024 * i + 16 * lane, t);
#pragma unroll
                for (int k = 0; k < 16; ++k) { ACC(i, k) += t[k]; ss += ACC(i, k) * ACC(i, k); } }
            ss = wave_sum_dpp(ss);
            const float rs = rsqrtf(ss * (1.0f / D) + 1e-6f);
            if (!FINAL) {
#pragma unroll
                for (int i = 0; i < 4; ++i) { u32x4 w8;
#pragma unroll
                    for (int q = 0; q < 4; ++q) w8[q] = pk4_fp8(ACC(i, 4 * q), ACC(i, 4 * q + 1), ACC(i, 4 * q + 2), ACC(i, 4 * q + 3));
                    *(u32x4*)(XB8n + (size_t)tok * D + 1024 * i + 16 * lane) = w8; }
                if (lane == 0) RSTDn[tok] = rs;
                float mine = 0.f;
#pragma unroll 1
                for (int j = 0; j < 10; ++j) { float s = 0.f;
#pragma unroll
                    for (int i = 0; i < 4; ++i) { const u32x4 g0 = *(const LAS u32x4*)(gfs + j * D + 1024 * i + 16 * lane), g1 = *(const LAS u32x4*)(gfs + j * D + 1024 * i + 16 * lane + 8);
#pragma unroll
                        for (int q = 0; q < 4; ++q) { s += ACC(i, 2 * q) * bf_lo(g0[q]) + ACC(i, 2 * q + 1) * bf_hi(g0[q]); s += ACC(i, 8 + 2 * q) * bf_lo(g1[q]) + ACC(i, 8 + 2 * q + 1) * bf_hi(g1[q]); } }
                    s = wave_sum_dpp(s); if (lane == j) mine = s; }
                if (lane < 10) { const int b_ = tok >> 11, s_ = tok & 2047; LOGFn[(size_t)(b_ * 10 + lane) * S + s_] = logsig(mine * rs + bf_n[lane]); }
            }
            if (FINAL) { float* xo = (float*)XOv + (size_t)tok * D;
#pragma unroll
                for (int i = 0; i < 4; ++i)
#pragma unroll
                    for (int q = 0; q < 4; ++q) { const int c = 1024 * i + 16 * lane + 4 * q; const f32x4 g_ = *(const f32x4*)(fg + c);
                        *(f32x4*)(xo + c) = (f32x4){ACC(i, 4 * q) * rs * g_[0], ACC(i, 4 * q + 1) * rs * g_[1], ACC(i, 4 * q + 2) * rs * g_[2], ACC(i, 4 * q + 3) * rs * g_[3]}; }
            } else { bf16_t* xo = (bf16_t*)XOv + (size_t)tok * D;
#pragma unroll
                for (int i = 0; i < 4; ++i) { u32x4 w0, w1;
#pragma unroll
                    for (int q = 0; q < 4; ++q) { w0[q] = pk2(ACC(i, 2 * q), ACC(i, 2 * q + 1)); w1[q] = pk2(ACC(i, 8 + 2 * q), ACC(i, 8 + 2 * q + 1)); }
                    *(u32x4*)(xo + 1024 * i + 16 * lane) = w0; *(u32x4*)(xo + 1024 * i + 16 * lane + 8) = w1; }
            }
        }
        LDS_WAIT(); asm volatile("" ::: "memory");
    }
#undef ACC
#undef LOADROW6
#undef GRP6
}
}
namespace at {
using namespace mk;
constexpr int QB = 256, KVB = 64, HD = 128;
constexpr int SHM_V = KVB * HD * 2, SHM_K = KVB * HD * 2;
constexpr int OFF_V = 0, OFF_K = 2 * SHM_V, OFF_WS = OFF_K + 2 * SHM_K, OFF_CUM = OFF_WS + 8 * 256, OFF_RT = OFF_CUM + 2048 * 4, OFF_MISC = OFF_RT + 640 * 4;
constexpr float LOG2E = 1.4426950408889634f;
constexpr float THR2 = 10.0f;
constexpr float SB_DONE = -100.0f;

#define AT_KSWZ(row, colB) ((row) * 256 + ((colB) ^ (((row) & 7) << 4)))
__device__ __forceinline__ int v_st(int k, int c) { const int kk = (k & ~0xC) | ((k & 4) << 1) | ((k & 8) >> 1); return ((kk >> 3) * 4 + (c >> 5)) * 512 + ((kk & 7) * 32 + (c & 31)) * 2; }
__device__ __forceinline__ int v_rd_base(int lane) { return ((lane & 3) << 3) | (((lane >> 2) & 3) << 6) | (((lane >> 4) & 1) << 5) | (((lane >> 5) & 1) << 8); }
constexpr int v_rd_off(int d0, int ks, int half) { return d0 * 512 + ks * 4096 + half * 2048; }
__device__ __forceinline__ int crow(int r, int hi) { return (r & 3) + 8 * (r >> 2) + 4 * hi; }
__device__ __forceinline__ unsigned cvtpk(float lo, float hi) { unsigned r; asm volatile("v_cvt_pk_bf16_f32 %0, %1, %2" : "=v"(r) : "v"(lo), "v"(hi)); return r; }
__device__ __forceinline__ float partner(float v, int hi) { auto rr = __builtin_amdgcn_permlane32_swap(__builtin_bit_cast(unsigned, v), __builtin_bit_cast(unsigned, v), false, false); return __builtin_bit_cast(float, hi ? rr[0] : rr[1]); }

__device__ __forceinline__ float xchg_max(float v, int hi) { return fmaxf(v, partner(v, hi)); }
__device__ __forceinline__ float xchg_sum(float v, int hi) { return v + partner(v, hi); }

__device__ __forceinline__ void pack_p(const f32x16& p0, const f32x16& p1, bf16x8& pa0, bf16x8& pa1, bf16x8& pa2, bf16x8& pa3) {
#define AT_PK4(P, B_, OUT) do { unsigned a0 = cvtpk(P[B_ + 0], P[B_ + 1]), a1 = cvtpk(P[B_ + 2], P[B_ + 3]); unsigned b0 = cvtpk(P[B_ + 4], P[B_ + 5]), b1 = cvtpk(P[B_ + 6], P[B_ + 7]); \
        auto r0 = __builtin_amdgcn_permlane32_swap(a0, b0, false, false); auto r1 = __builtin_amdgcn_permlane32_swap(a1, b1, false, false); \
        u32x4 w = {r0[0], r1[0], r0[1], r1[1]}; OUT = __builtin_bit_cast(bf16x8, w); } while (0)
    AT_PK4(p0, 0, pa0); AT_PK4(p0, 8, pa1); AT_PK4(p1, 0, pa2); AT_PK4(p1, 8, pa3);
#undef AT_PK4
}
template <int KBUF>
__device__ __forceinline__ void qkt(f32x16& p0, f32x16& p1, LAS unsigned char* K_lds, int r32, int hi, const bf16x8 (&qr)[8]) {
    p0 = f32x16{}; p1 = f32x16{};
    LAS unsigned char* kb[4];
#pragma unroll
    for (int dd = 0; dd < 4; ++dd) kb[dd] = K_lds + KBUF * SHM_K + AT_KSWZ(r32, (dd * 16 + hi * 8) * 2);
#pragma unroll
    for (int d0 = 0; d0 < 8; ++d0) { LAS unsigned char* a = kb[d0 & 3] + (d0 >> 2) * 128;
        const bf16x8 b0 = *(const LAS bf16x8*)a; const bf16x8 b1 = *(const LAS bf16x8*)(a + 32 * 256);
        p0 = __builtin_amdgcn_mfma_f32_32x32x16_bf16(b0, qr[d0], p0, 0, 0, 0);
        p1 = __builtin_amdgcn_mfma_f32_32x32x16_bf16(b1, qr[d0], p1, 0, 0, 0); }
}
template <int VBUF>
__device__ __forceinline__ void pv_tile(f32x16 (&o)[4], int vb0, bf16x8 pa0, bf16x8 pa1, bf16x8 pa2, bf16x8 pa3) {
#define AT_TRRD(dst, off) asm volatile("ds_read_b64_tr_b16 %0, %1 offset:%2" : "=&v"(dst) : "v"(vb0), "i"(off) : "memory")
#define AT_PV_D0(d0) do { s16x4 l0, l1, l2, l3, h0, h1, h2, h3; constexpr int b_ = VBUF * SHM_V + v_rd_off(d0, 0, 0); \
        AT_TRRD(l0, b_); AT_TRRD(h0, b_ + 2048); AT_TRRD(l1, b_ + 4096); AT_TRRD(h1, b_ + 6144); AT_TRRD(l2, b_ + 8192); AT_TRRD(h2, b_ + 10240); AT_TRRD(l3, b_ + 12288); AT_TRRD(h3, b_ + 14336); \
        asm volatile("s_waitcnt lgkmcnt(0)" ::: "memory"); __builtin_amdgcn_sched_barrier(0); \
        o[d0] = __builtin_amdgcn_mfma_f32_32x32x16_bf16(pa0, (bf16x8){l0[0], l0[1], l0[2], l0[3], h0[0], h0[1], h0[2], h0[3]}, o[d0], 0, 0, 0); \
        o[d0] = __builtin_amdgcn_mfma_f32_32x32x16_bf16(pa1, (bf16x8){l1[0], l1[1], l1[2], l1[3], h1[0], h1[1], h1[2], h1[3]}, o[d0], 0, 0, 0); \
        o[d0] = __builtin_amdgcn_mfma_f32_32x32x16_bf16(pa2, (bf16x8){l2[0], l2[1], l2[2], l2[3], h2[0], h2[1], h2[2], h2[3]}, o[d0], 0, 0, 0); \
        o[d0] = __builtin_amdgcn_mfma_f32_32x32x16_bf16(pa3, (bf16x8){l3[0], l3[1], l3[2], l3[3], h3[0], h3[1], h3[2], h3[3]}, o[d0], 0, 0, 0); } while (0)
    AT_PV_D0(0); AT_PV_D0(1); AT_PV_D0(2); AT_PV_D0(3);
#undef AT_PV_D0
#undef AT_TRRD
}

template <int VAR>
__device__ __forceinline__ void attn_item(const bf16_t* Qh, const bf16_t* Kh, const bf16_t* Vh, bf16_t* OB, const float* relb, const float* LOGF, int b, int h, int qb, LAS unsigned char* lds, int tid) {
    const int wid = __builtin_amdgcn_readfirstlane(tid >> 6), lane = tid & 63, r32 = lane & 31, hi = lane >> 5;
    const int g = VAR == 0 ? h : (VAR == 1 ? 12 + h : 22 + h);
    const size_t hb = (size_t)(b * NH + g) * S * HD;
    const bf16_t* Kp = Kh + hb; const bf16_t* Vp = Vh + hb;
    LAS unsigned char* V_lds = lds + OFF_V; LAS unsigned char* K_lds = lds + OFF_K;
    LAS float* wsf = (LAS float*)(lds + OFF_WS) + wid * 64; LAS float* li_l = wsf; LAS float* al_l = wsf + 32;
    LAS float* cumL = (LAS float*)(lds + OFF_CUM); LAS float* Rt = (LAS float*)(lds + OFF_RT); volatile LAS unsigned* flags = (volatile LAS unsigned*)(lds + OFF_MISC);
    const int P0 = qb * QB, qlo = P0 + wid * 32, qpos = qlo + r32;
    int NT, jlo = 0;
    if (VAR == 0) { jlo = 4 * qb - 8; if (jlo < 0) jlo = 0; NT = 4 * qb + 4 - jlo; } else NT = 4 * qb + 4;
    const int cw = 4 * qb + (wid >> 1);
#define AT_KBASE(t) (VAR == 1 ? (4 * qb + 3 - (t)) * KVB : (jlo + (t)) * KVB)
#define AT_ACT(t) (VAR == 0 ? ((jlo + (t)) >= cw - 8 && (jlo + (t)) <= cw) : (VAR == 1 ? (AT_KBASE(t) <= qlo + 30) : (AT_KBASE(t) <= qlo + 31)))
    if (VAR == 0) {
        const float* tab = relb + h * 257;
        for (int j = tid; j < 639; j += 512) { int rel = 575 - j; rel = rel < -128 ? -128 : (rel > 128 ? 128 : rel); Rt[j] = tab[rel + 128] * LOG2E; }
    }
    if (VAR == 2) {
        const float* lf = LOGF + (size_t)(b * 10 + h) * S; const int kend = P0 + QB;
        f32x4 v = (f32x4){0.f, 0.f, 0.f, 0.f};
        if (4 * tid < kend) v = *(const f32x4*)(lf + 4 * tid);
        v[1] += v[0]; v[2] += v[1]; v[3] += v[2];
        float tot = v[3];
#pragma unroll
        for (int o = 1; o < 64; o <<= 1) { const float t_ = lane_read(tot, lane >= o ? lane - o : lane); if (lane >= o) tot += t_; }
        if (lane == 63) li_l[0] = tot;
        __syncthreads();
        float base = tot - v[3];
        for (int w = 0; w < wid; ++w) base += ((LAS float*)(lds + OFF_WS))[w * 64];
        if (4 * tid < kend) *(LAS f32x4*)(cumL + 4 * tid) = (f32x4){(base + v[0]) * LOG2E, (base + v[1]) * LOG2E, (base + v[2]) * LOG2E, (base + v[3]) * LOG2E};
    }
    bf16x8 qr[8];
    { const bf16_t* qp = Qh + hb + (size_t)(qlo + r32) * HD + hi * 8;
#pragma unroll
      for (int d0 = 0; d0 < 8; ++d0) qr[d0] = *(const bf16x8*)(qp + d0 * 16); }
    const int sr = tid >> 4, sc = (tid & 15) * 8, vst0 = v_st(sr, sc), vst1 = v_st(32 + sr, sc), kws = AT_KSWZ(sr, sc * 2);
    const int vb0 = (int)(unsigned)(size_t)V_lds + v_rd_base(lane);
    bf16x8 st_k0, st_k1, st_v0, st_v1;
#define AT_SLOAD(k0) do { const bf16_t* kp_ = Kp + (size_t)((k0) + sr) * HD + sc; const bf16_t* vp_ = Vp + (size_t)((k0) + sr) * HD + sc; \
        st_k0 = *(const bf16x8*)kp_; st_k1 = *(const bf16x8*)(kp_ + 32 * HD); st_v0 = *(const bf16x8*)vp_; st_v1 = *(const bf16x8*)(vp_ + 32 * HD); } while (0)
#define AT_SWRITE(bf) do { *(LAS bf16x8*)(K_lds + (bf) * SHM_K + kws) = st_k0; *(LAS bf16x8*)(K_lds + (bf) * SHM_K + kws + 32 * 256) = st_k1; \
        *(LAS bf16x8*)(V_lds + (bf) * SHM_V + vst0) = st_v0; *(LAS bf16x8*)(V_lds + (bf) * SHM_V + vst1) = st_v1; } while (0)
    AT_SLOAD(AT_KBASE(0)); asm volatile("s_waitcnt vmcnt(0)" ::: "memory"); AT_SWRITE(0);
    __syncthreads();
    float m_reg = -1e30f, l_reg = 0.f, carry = 0.f;
    f32x16 o[4] = {};
#define AT_STEP(BUF, t) do { \
        const bool more_ = (t) + 1 < NT; \
        if (more_) AT_SLOAD(AT_KBASE((t) + 1)); \
        if (AT_ACT(t)) { \
            const int kb_ = AT_KBASE(t); f32x16 p0, p1; bf16x8 pa0, pa1, pa2, pa3; \
            qkt<BUF>(p0, p1, K_lds, r32, hi, qr); \
            tile_math(p0, p1, kb_, pa0, pa1, pa2, pa3); \
            pv_tile<BUF>(o, vb0, pa0, pa1, pa2, pa3); \
        } \
        if (more_) { asm volatile("s_waitcnt vmcnt(0)" ::: "memory"); AT_SWRITE((BUF) ^ 1); } \
        if (VAR == 1) { const bool done_ = __all(carry < SB_DONE); if (lane == 0) flags[((t) & 1) * 8 + wid] = done_ ? 1u : 0u; } \
        __syncthreads(); \
    } while (0)
    auto tile_math = [&](f32x16& p0, f32x16& p1, int kb, bf16x8& pa0, bf16x8& pa1, bf16x8& pa2, bf16x8& pa3) __attribute__((always_inline)) {
        const int dq = qpos - kb - 4 * hi;
        if (VAR == 1) {
            const bool need_mask = kb + 63 >= qlo;
            f32x16 n0, n1;
#pragma unroll
            for (int r = 0; r < 16; ++r) { const float z = p0[r]; const float lp = __builtin_amdgcn_logf(1.0f + __builtin_amdgcn_exp2f(-fabsf(z))); n0[r] = fminf(-z, 0.f) - lp;
                                           const float y = p1[r]; const float lq = __builtin_amdgcn_logf(1.0f + __builtin_amdgcn_exp2f(-fabsf(y))); n1[r] = fminf(-y, 0.f) - lq; }
            if (need_mask) {
#pragma unroll
                for (int r = 0; r < 16; ++r) { const int c = (r & 3) + 8 * (r >> 2);
                    if (dq - c <= 0) { n0[r] = 0.f; p0[r] = -__builtin_inff(); }
                    if (dq - c - 32 <= 0) { n1[r] = 0.f; p1[r] = -__builtin_inff(); } }
            }
            float A[8], Bp[8];
#pragma unroll
            for (int q = 0; q < 4; ++q) { A[q] = (n0[4 * q] + n0[4 * q + 1]) + (n0[4 * q + 2] + n0[4 * q + 3]); A[4 + q] = (n1[4 * q] + n1[4 * q + 1]) + (n1[4 * q + 2] + n1[4 * q + 3]); }
#pragma unroll
            for (int q = 0; q < 8; ++q) Bp[q] = partner(A[q], hi);
            float st = 0.f;
#pragma unroll
            for (int q = 7; q >= 0; --q) {
                const float after = carry + st + (hi == 0 ? Bp[q] : 0.f);
                if (q >= 4) { const int r0 = 4 * (q - 4);
                    float tl = after; p1[r0 + 3] = __builtin_amdgcn_exp2f(p1[r0 + 3] + n1[r0 + 3] + tl); tl += n1[r0 + 3]; p1[r0 + 2] = __builtin_amdgcn_exp2f(p1[r0 + 2] + n1[r0 + 2] + tl); tl += n1[r0 + 2];
                    p1[r0 + 1] = __builtin_amdgcn_exp2f(p1[r0 + 1] + n1[r0 + 1] + tl); tl += n1[r0 + 1]; p1[r0] = __builtin_amdgcn_exp2f(p1[r0] + n1[r0] + tl); }
                else { const int r0 = 4 * q;
                    float tl = after; p0[r0 + 3] = __builtin_amdgcn_exp2f(p0[r0 + 3] + n0[r0 + 3] + tl); tl += n0[r0 + 3]; p0[r0 + 2] = __builtin_amdgcn_exp2f(p0[r0 + 2] + n0[r0 + 2] + tl); tl += n0[r0 + 2];
                    p0[r0 + 1] = __builtin_amdgcn_exp2f(p0[r0 + 1] + n0[r0 + 1] + tl); tl += n0[r0 + 1]; p0[r0] = __builtin_amdgcn_exp2f(p0[r0] + n0[r0] + tl); }
                st += A[q] + Bp[q];
            }
            carry += st;
            pack_p(p0, p1, pa0, pa1, pa2, pa3);
        } else {
            if (VAR == 0) {
                const LAS float* rp = Rt + (575 - (qpos - kb) + 4 * hi);
#pragma unroll
                for (int r = 0; r < 16; ++r) { const int c = (r & 3) + 8 * (r >> 2); p0[r] += rp[c]; p1[r] += rp[c + 32]; }
            } else {
                const LAS float* cp = cumL + kb + 4 * hi;
#pragma unroll
                for (int q = 0; q < 4; ++q) { const f32x4 c0 = *(const LAS f32x4*)(cp + 8 * q), c1 = *(const LAS f32x4*)(cp + 32 + 8 * q);
                    p0[4 * q] -= c0[0]; p0[4 * q + 1] -= c0[1]; p0[4 * q + 2] -= c0[2]; p0[4 * q + 3] -= c0[3];
                    p1[4 * q] -= c1[0]; p1[4 * q + 1] -= c1[1]; p1[4 * q + 2] -= c1[2]; p1[4 * q + 3] -= c1[3]; }
                if (kb + 63 > qlo) {
#pragma unroll
                    for (int r = 0; r < 16; ++r) { const int c = (r & 3) + 8 * (r >> 2);
                        if (dq - c < 0) p0[r] = -__builtin_inff();
                        if (dq - c - 32 < 0) p1[r] = -__builtin_inff(); }
                }
            }
            float pmax = p0[0];
#pragma unroll
            for (int r = 1; r < 16; ++r) pmax = fmaxf(pmax, p0[r]);
#pragma unroll
            for (int r = 0; r < 16; ++r) pmax = fmaxf(pmax, p1[r]);
            pmax = xchg_max(pmax, hi);
            float mn, alpha;
            if (__all(pmax - m_reg <= THR2)) { mn = m_reg; alpha = 1.f; }
            else { mn = fmaxf(m_reg, pmax); alpha = __builtin_amdgcn_exp2f(m_reg - mn); m_reg = mn; }
            float ps = 0.f;
#pragma unroll
            for (int r = 0; r < 16; ++r) { p0[r] = __builtin_amdgcn_exp2f(p0[r] - mn); p1[r] = __builtin_amdgcn_exp2f(p1[r] - mn); ps += p0[r] + p1[r]; }
            ps = xchg_sum(ps, hi);
            l_reg = l_reg * alpha + ps;
            if (__any(alpha < 1.f)) {
                if (hi == 0) al_l[r32] = alpha;
                asm volatile("s_waitcnt lgkmcnt(0)" ::: "memory");
                float av[16];
#pragma unroll
                for (int r = 0; r < 16; ++r) av[r] = al_l[crow(r, hi)];
#pragma unroll
                for (int d = 0; d < 4; ++d)
#pragma unroll
                    for (int r = 0; r < 16; ++r) o[d][r] *= av[r];
            }
            pack_p(p0, p1, pa0, pa1, pa2, pa3);
        }
    };
    for (int t = 0; t < NT; t += 2) {
        AT_STEP(0, t);
        if (VAR == 1) { unsigned all_ = 1u; for (int w = 0; w < 8; ++w) all_ &= flags[(t & 1) * 8 + w]; if (all_) break; }
        if (t + 1 >= NT) break;
        AT_STEP(1, t + 1);
        if (VAR == 1) { unsigned all_ = 1u; for (int w = 0; w < 8; ++w) all_ &= flags[((t + 1) & 1) * 8 + w]; if (all_) break; }
    }
    float rli[16];
    if (VAR != 1) {
        if (hi == 0) li_l[r32] = l_reg;
        asm volatile("s_waitcnt lgkmcnt(0)" ::: "memory");
#pragma unroll
        for (int r = 0; r < 16; ++r) rli[r] = __builtin_amdgcn_rcpf(li_l[crow(r, hi)]);
    }
    unsigned char* Ow8 = (unsigned char*)OB + (size_t)(b * S + qlo) * D + g * HD;
#pragma unroll
    for (int r = 0; r < 16; ++r) { const int orow = crow(r, hi);
#pragma unroll
        for (int d0 = 0; d0 < 4; ++d0) { const float v = VAR != 1 ? o[d0][r] * rli[r] : o[d0][r];
            const float vn = lane_read(v, lane ^ 1);
            if ((r32 & 1) == 0) *(unsigned short*)(Ow8 + (size_t)orow * D + d0 * 32 + r32) = (unsigned short)__builtin_amdgcn_cvt_pk_fp8_f32(clamp8(v * 16.0f), clamp8(vn * 16.0f), 0, false); } }
    __syncthreads();
#undef AT_STEP
#undef AT_SLOAD
#undef AT_SWRITE
#undef AT_KBASE
#undef AT_ACT
}

template <int VAR>
__device__ __forceinline__ void attn_queue(const bf16_t* Qh, const bf16_t* Kh, const bf16_t* Vh, bf16_t* OB, const float* relb, const float* LOGF, unsigned* qhead, LAS unsigned char* lds, int wave0) {
    FRESH_TID(); FRESH_LDS(lds);
    volatile LAS unsigned* qslot = (volatile LAS unsigned*)(lds + OFF_MISC) + 32;
    constexpr int NHV = VAR == 0 ? 12 : 10, NITEMS = 8 * NHV * 8;
    for (;;) {
        if (tid == 0) qslot[0] = __hip_atomic_fetch_add(qhead, 1u, __ATOMIC_RELAXED, __HIP_MEMORY_SCOPE_AGENT);
        __syncthreads();
        const int idx = (int)qslot[0];
        __syncthreads();
        if (idx >= NITEMS) break;
        const int qb = 7 - idx / (8 * NHV), bh = idx % (8 * NHV);
        attn_item<VAR>(Qh, Kh, Vh, OB, relb, LOGF, bh / NHV, bh % NHV, qb, lds, tid);
    }
}
__device__ __forceinline__ void attn_phase(const bf16_t* Qh, const bf16_t* Kh, const bf16_t* Vh, bf16_t* OB, const float* relb, const float* LOGF, unsigned* qheads, LAS unsigned char* lds, int wave0) {
    attn_queue<2>(Qh, Kh, Vh, OB, relb, LOGF, qheads + 0, lds, wave0);
    attn_queue<0>(Qh, Kh, Vh, OB, relb, LOGF, qheads + 64, lds, wave0);
    attn_queue<1>(Qh, Kh, Vh, OB, relb, LOGF, qheads + 128, lds, wave0);
}
}
namespace mk {
#define XB_TMO      128
#define XB_XCNT(j)  (256  + 64 * (j))
#define XB_XSUB(j)  (1280 + 64 * (j))
#define XB_XGEN(j)  (2304 + 64 * (j))
#define XB_TOP      3328
#define XB_TOPGEN   3392
#define XCD_BAR_WORDS 3456
#define XB_SPIN_CAP (1u << 22)

__device__ __forceinline__ unsigned xb_ld(unsigned* p)              { return __hip_atomic_load(p, __ATOMIC_RELAXED, __HIP_MEMORY_SCOPE_AGENT); }
__device__ __forceinline__ unsigned xb_add(unsigned* p, unsigned v) { return __hip_atomic_fetch_add(p, v, __ATOMIC_RELAXED, __HIP_MEMORY_SCOPE_AGENT); }
__device__ __forceinline__ unsigned xb_xcc_id() { return (unsigned)__builtin_amdgcn_s_getreg((3 << 11) | 20) & 0xFu; }
#define XB_SPIN(cond, bar) do { unsigned _sp = 0; while (cond) { __builtin_amdgcn_s_sleep(1); \
    if ((++_sp & 255u) == 0u) { if (xb_ld(&(bar)[XB_TMO])) break; if (_sp > XB_SPIN_CAP) { atomicAdd(&(bar)[XB_TMO], 1u); break; } } } } while (0)

struct XcdBarrier {
    unsigned* bar; unsigned x;
    volatile LAS unsigned* st;
};

__device__ __forceinline__ XcdBarrier xcd_barrier_post(unsigned* bar, volatile LAS unsigned* st, bool is_t0) {
    XcdBarrier b; b.bar = bar; b.x = xb_xcc_id(); b.st = st;
    if (is_t0) (void)xb_add(&bar[XB_XCNT(b.x)], 1u);
    return b;
}
__device__ __forceinline__ void xcd_barrier_complete(unsigned* bar, unsigned x, unsigned& nloc, unsigned& nx) {
    const unsigned G = gridDim.x * gridDim.y * gridDim.z;
    unsigned sum, cnt, mine, sp = 0u;
    for (;;) {
        sum = 0u; cnt = 0u; mine = 0u;
#pragma unroll
        for (unsigned j = 0; j < 16; ++j) { const unsigned c = xb_ld(&bar[XB_XCNT(j)]); sum += c; cnt += (c > 0u) ? 1u : 0u; mine = (j == x) ? c : mine; }
        if (sum == G) break;
        __builtin_amdgcn_s_sleep(1);
        if ((++sp & 255u) == 0u) { if (xb_ld(&bar[XB_TMO])) break; if (sp > XB_SPIN_CAP) { atomicAdd(&bar[XB_TMO], 1u); break; } }
    }
    nloc = mine > 0u ? mine : 1u; nx = cnt > 0u ? cnt : 1u;
}

__device__ __forceinline__ void xcd_barrier(const XcdBarrier& b, bool is_t0) {
    asm volatile("s_waitcnt vmcnt(0)" ::: "memory");
    __syncthreads();
    if (is_t0) {
        unsigned* bar = b.bar;
        __builtin_amdgcn_s_waitcnt(0);
        unsigned nloc = b.st[0], nx = b.st[1];
        if (nloc == 0u) { xcd_barrier_complete(bar, b.x, nloc, nx); b.st[0] = nloc; b.st[1] = nx; }
        const unsigned old = xb_add(&bar[XB_XSUB(b.x)], 1u);
        const unsigned gen = old / nloc;
        if (old + 1u == (gen + 1u) * nloc) {
            __builtin_amdgcn_fence(__ATOMIC_RELEASE, "agent");
            asm volatile("s_waitcnt vmcnt(0)" ::: "memory");
            const unsigned og = xb_add(&bar[XB_TOP], 1u);
            const unsigned tg = og / nx;
            if (og + 1u == (tg + 1u) * nx) xb_add(&bar[XB_TOPGEN], 1u);
            else XB_SPIN(xb_ld(&bar[XB_TOPGEN]) == tg, bar);
            __builtin_amdgcn_fence(__ATOMIC_ACQUIRE, "agent");
            xb_add(&bar[XB_XGEN(b.x)], 1u);
            asm volatile("s_waitcnt vmcnt(0)" ::: "memory");
        } else {
            XB_SPIN(xb_ld(&bar[XB_XGEN(b.x)]) == gen, bar);
            __builtin_amdgcn_fence(__ATOMIC_ACQUIRE, "agent");
            asm volatile("s_waitcnt vmcnt(0)" ::: "memory");
        }
    }
    __syncthreads();
}

constexpr int PH_PER_LAYER = 8;
typedef const __attribute__((address_space(4))) Args* KArgs;
#define KARGS() ({ KArgs p_ = (KArgs)__builtin_amdgcn_kernarg_segment_ptr(); asm volatile("" : "+s"(p_)); p_; })
#define GRID_BAR() do { KArgs k_ = KARGS(); XcdBarrier b_; b_.bar = (unsigned*)(k_->ws + WS_CTL) + CW_BAR; b_.x = xb_xcc_id(); b_.st = (volatile LAS unsigned*)(lds + MISC_OFF) + 8; unsigned z_ = 0u; asm volatile("" : "+v"(z_)); const bool t0_ = (wave0 == 0) && (__builtin_amdgcn_mbcnt_hi(~0u, __builtin_amdgcn_mbcnt_lo(~0u, z_)) == 0u);     xcd_barrier(b_, t0_); } while (0)
__global__ void __launch_bounds__(NWAVES * 64, 2) mk_fwd(Args a_unused) {
    extern __shared__ __attribute__((aligned(16))) unsigned char lds_raw[];
    LAS unsigned char* lds = (LAS unsigned char*)lds_raw;
    const int wave0 = __builtin_amdgcn_readfirstlane((int)threadIdx.x >> 6);
    for (int u = threadIdx.x; u < (LDS_BYTES - LDSCTL_OFF) / 4; u += NWAVES * 64) ((LAS unsigned*)(lds + LDSCTL_OFF))[u] = 0u;
    __syncthreads();
    int lo, hi;
    { KArgs k = KARGS(); lo = k->ph_lo; hi = k->ph_hi;
      if (hi - lo > 1) (void)xcd_barrier_post((unsigned*)(k->ws + WS_CTL) + CW_BAR, (volatile LAS unsigned*)(lds + MISC_OFF) + 8, threadIdx.x == 0); }
#define IN(k) (lo <= (k) && (k) < hi)
#define BOTH(k) (IN(k) && IN((k) + 1))
#pragma unroll
    for (int l = 0; l < 2; ++l) {
        const int pb = PH_PER_LAYER * l;
        if (IN(pb + 0)) { KArgs k = KARGS(); conv_phase(k, l, lds, wave0); }
        if (IN(pb + 1) && l == 0) {
            KArgs k = KARGS(); unsigned char* ws = k->ws;
            const float* xin = k->in[0];
            prep_phase<true>(xin, (bf16_t*)(ws + WS_XB8N), (float*)(ws + WS_RSTD), k->in[2] + (size_t)l * D * PW, k->in[1] + (size_t)l * D, k->in[3] + l * 10, (float*)(ws + WS_LOGF), lds, wave0);
            if (BOTH(pb + 1)) GRID_BAR();
        }
        if (l == 1 && IN(pb + 0) && IN(pb + 2)) GRID_BAR();
        if (IN(pb + 2)) {
            KArgs k = KARGS(); unsigned char* ws = k->ws;
            pg8::Gemm g{(const bf16_t*)(ws + WS_XB8N), (const bf16_t*)(ws + WS_WIN), M, 12288, D}; pg8::StaticOrder So; FRESH_BID(); So.init(M, 12288, G, bid);
            pg8::EpiQKV4 E{(bf16_t*)(ws + WS_Q), (const float*)(ws + WS_RSTD), 0.08838834764831845f * 1.4426950408889634f, US_INV};
            { LAS unsigned char* lds_ = lds; FRESH_LDS(lds_); FRESH_TID(); pg8::gemm_phase<pg8::EpiQKV4, pg8::StaticOrder, true, true, true>(lds_, g, So, E, tid); }
            if (BOTH(pb + 2)) GRID_BAR();
        }
        if (IN(pb + 3)) {
            KArgs k = KARGS(); unsigned char* ws = k->ws;
            at::attn_phase((const bf16_t*)(ws + WS_Q), (const bf16_t*)(ws + WS_K), (const bf16_t*)(ws + WS_V), (bf16_t*)(ws + WS_OB), k->in[4] + (size_t)l * 12 * 257, (const float*)(ws + WS_LOGF),
                           (unsigned*)(ws + WS_CTL) + CW_QUEUE + 256 * l, lds, wave0);
            if (BOTH(pb + 3)) GRID_BAR();
        }
        if (IN(pb + 4)) {
            KArgs k = KARGS(); unsigned char* ws = k->ws;
            pg8::Gemm g{(const bf16_t*)(ws + WS_OB), (const bf16_t*)(ws + WS_WOUT), M, D, D}; pg8::StaticOrder So; FRESH_BID(); So.init(M, D, G, bid);
            if (l == 0) { pg8::EpiResidB16<true> E{k->in[0], US_INV * (1.0f / 16.0f), (bf16_t*)(ws + WS_XB)};
                { LAS unsigned char* lds_ = lds; FRESH_LDS(lds_); FRESH_TID(); pg8::gemm_phase<pg8::EpiResidB16<true>, pg8::StaticOrder, false, true, true>(lds_, g, So, E, tid); } }
            else { pg8::EpiResidB16<false> E{ws + WS_X2, US_INV * (1.0f / 16.0f), (bf16_t*)(ws + WS_XB)};
                { LAS unsigned char* lds_ = lds; FRESH_LDS(lds_); FRESH_TID(); pg8::gemm_phase<pg8::EpiResidB16<false>, pg8::StaticOrder, false, true, true>(lds_, g, So, E, tid); } }
            if (BOTH(pb + 4)) GRID_BAR();
        }
        if (IN(pb + 5)) {
            KArgs k = KARGS(); unsigned char* ws = k->ws;
            pg8::Gemm g{(const bf16_t*)(ws + WS_XB), (const bf16_t*)(ws + WS_WQK), M, 2048, D}; pg8::StaticOrder So; FRESH_BID(); So.init(M, 2048, G, bid);
            pg8::EpiPlainF32<2048> E{(float*)(ws + WS_SC)};
            { LAS unsigned char* lds_ = lds; FRESH_LDS(lds_); FRESH_TID(); pg8::gemm_phase<pg8::EpiPlainF32<2048>, pg8::StaticOrder, true, true>(lds_, g, So, E, tid); }
            if (BOTH(pb + 5)) GRID_BAR();
        }
        if (IN(pb + 6)) {
            KArgs k = KARGS(); unsigned char* ws = k->ws;
            peer_u_phase((const float*)(ws + WS_SC), (const unsigned char*)(ws + WS_U16), (const bf16_t*)(ws + WS_XB), (int*)(ws + WS_K), (float*)(ws + WS_K + 8 * MiB), lds, wave0);
            if (BOTH(pb + 6)) GRID_BAR();
        }
        if (IN(pb + 7)) {
            KArgs k = KARGS(); unsigned char* ws = k->ws;
            if (l == 0) peer_v_phase<false>((const int*)(ws + WS_K), (const float*)(ws + WS_K + 8 * MiB), (const unsigned char*)(ws + WS_U16) + (size_t)NE * ROW6, (const bf16_t*)(ws + WS_XB), ws + WS_X2, nullptr,
                                            ws + WS_XB8N, (float*)(ws + WS_RSTD), (float*)(ws + WS_LOGF), k->in[2] + (size_t)D * PW, k->in[1] + D, k->in[3] + 10, lds, wave0);
            else peer_v_phase<true>((const int*)(ws + WS_K), (const float*)(ws + WS_K + 8 * MiB), (const unsigned char*)(ws + WS_U16) + (size_t)NE * ROW6, (const bf16_t*)(ws + WS_XB), k->out, k->in[12],
                                    nullptr, nullptr, nullptr, nullptr, nullptr, nullptr, lds, wave0);
            if (BOTH(pb + 7)) GRID_BAR();
        }
    }
#undef IN
#undef BOTH
}

static int g_grid = 0;
static void launch_phases(Args a, int lo, int hi, hipStream_t st) {
    a.ph_lo = lo; a.ph_hi = hi;
    hipLaunchKernelGGL(mk_fwd, dim3(g_grid), dim3(NWAVES * 64), LDS_BYTES, st, a);
}
}

extern "C" void kernel_launch(void* const* d_in, const int* in_sizes, int n_in, void* d_out, int out_size, void* d_ws, size_t ws_size, hipStream_t stream) {
    (void)in_sizes; (void)n_in; (void)out_size;
    using namespace mk;
    if (g_grid == 0) {
        if (ws_size < 2048 * MiB) { fprintf(stderr, "kernel_launch: workspace too small (%zu)\n", ws_size); g_grid = -1; return; }
        if (hipFuncSetAttribute((const void*)mk_fwd, hipFuncAttributeMaxDynamicSharedMemorySize, LDS_BYTES) != hipSuccess) { fprintf(stderr, "kernel_launch: hipFuncSetAttribute failed\n"); g_grid = -1; return; }
        int dev = 0, cus = 0; (void)hipGetDevice(&dev); (void)hipDeviceGetAttribute(&cus, hipDeviceAttributeMultiprocessorCount, dev);
        g_grid = cus > 0 ? cus : 256;
    }
    if (g_grid < 0) return;
    unsigned char* ws = (unsigned char*)d_ws; float* out = (float*)d_out;
    (void)hipMemsetAsync(ws + WS_CTL, 0, CTL_ZERO_BYTES, stream);
    Args a{};
    for (int i = 0; i < 13; ++i) a.in[i] = (const float*)d_in[i];
    a.out = out; a.ws = ws;
    launch_phases(a, 0, 2 * PH_PER_LAYER, stream);
}
```

```cpp
#include <hip/hip_runtime.h>
#include <cstdio>
#include <cstdint>
namespace pg8 {
#define PG8_LAS __attribute__((address_space(3)))
typedef unsigned short bf16_t;
typedef short bf16x8 __attribute__((ext_vector_type(8)));
typedef float f32x4 __attribute__((ext_vector_type(4)));
typedef unsigned u32x4 __attribute__((ext_vector_type(4)));
typedef unsigned u32x2 __attribute__((ext_vector_type(2)));
constexpr int BM = 256, BK = 64, HALF = 128, HTB = HALF * BK * 2  , STAGE_BYTES = 8 * HTB, NXCD = 8, WGM = 8;

__host__ __device__ __forceinline__ int lds_byte(int r, int c) { const int st = (r >> 4) * 2 + (c >> 5), rr = r & 15, cc = c & 31, ob = rr * 64 + cc * 2; return st * 1024 + (ob ^ (((ob >> 9) & 1) << 5)); }
__host__ __device__ __forceinline__ void stage_rc(int b, int& R, int& C) { const int st = b / 1024, sb = b % 1024, swz = sb ^ (((sb >> 9) & 1) << 5); R = (st >> 1) * 16 + swz / 64; C = (st & 1) * 32 + (swz % 64) / 2; }
__host__ __device__ __forceinline__ int perm32(int rho) { const int n = rho >> 4, i = rho & 15; return 8 * (i >> 2) + 4 * n + (i & 3); }

struct Unit { int pm, pn; };
struct Gemm { const bf16_t* A; const bf16_t* Bt; int M, N, K; };

struct StaticOrder {
    int nM, nN, nwg, G, c;
    __host__ __device__ void init(int M, int N, int G_, int c_) { nM = M / BM; nN = N / BM; nwg = nM * nN; G = G_; c = c_; }
    __host__ __device__ bool next(int i, Unit& u) const {
        const long L = (long)i * G + c; if (L >= nwg) return false;
        int wgid = (int)L; { const int q = nwg / NXCD, r = nwg % NXCD, xcd = wgid % NXCD, off = wgid / NXCD; wgid = (xcd < r ? xcd * (q + 1) : r * (q + 1) + (xcd - r) * q) + off; }
        const int nig = WGM * nN, gid = wgid / nig, fm = gid * WGM, gsz = (nM - fm) < WGM ? (nM - fm) : WGM;
        u.pm = fm + ((wgid % nig) % gsz); u.pn = (wgid % nig) / gsz; return true;
    }
    __device__ __forceinline__ void a_ready(const Unit&) const {}
    __device__ __forceinline__ void done(const Unit&) const {}
};
__device__ __forceinline__ unsigned cvt_pk_bf16(float lo, float hi) { unsigned r; asm volatile("v_cvt_pk_bf16_f32 %0, %1, %2" : "=v"(r) : "v"(lo), "v"(hi)); return r; }
typedef float f32x2 __attribute__((ext_vector_type(2)));
__device__ __forceinline__ f32x2 gelu_pk(f32x2 v) {
    const f32x2 av = __builtin_elementwise_abs(v), d = av * 0.2316418882f + 1.0f;
    f32x2 t; t.x = __builtin_amdgcn_rcpf(d.x); t.y = __builtin_amdgcn_rcpf(d.y);
    f32x2 q = t * 0.5307027145f + (-0.7265760135f); q = q * t + 0.7107068705f; q = q * t + (-0.142248368f); q = q * t + 0.127414796f; q = q * t;
    const f32x2 s = (v * v) * (-0.72134752044f);
    f32x2 e; e.x = __builtin_amdgcn_exp2f(s.x); e.y = __builtin_amdgcn_exp2f(s.y);
    const f32x2 m = v * (q * e), r = v - m;
    f32x2 o; o.x = v.x < 0.f ? m.x : r.x; o.y = v.y < 0.f ? m.y : r.y; return o;
}
#define EPI_FRESH_LANE() { unsigned z_ = 0u; asm volatile("" : "+v"(z_)); const int l_ = (int)__builtin_amdgcn_mbcnt_hi(~0u, __builtin_amdgcn_mbcnt_lo(~0u, z_)); fr = l_ & 15; fq = l_ >> 4; }
typedef __amdgpu_buffer_rsrc_t rsrc_t;
__device__ __forceinline__ rsrc_t mkrsrc(const void* p, unsigned bytes) { return __builtin_amdgcn_make_buffer_rsrc((void*)p, (short)0, (int)bytes, 0x00020000); }
template <int LDC> struct EpiPlainF32 {
    static constexpr bool PERM = false, AFTER_DRAIN = false;
    float* C;
    __device__ __forceinline__ void operator()(const f32x4 (&acc)[2][2][4][2], const Unit& u, int wr, int wc, int fr, int fq) const {
        EPI_FRESH_LANE();
        const rsrc_t rc = mkrsrc(C, 16384u * LDC * 4u);
        const int vo = ((wr * 64 + fr) * LDC + wc * 32 + 4 * fq) * 4, so = (u.pm * BM * LDC + u.pn * BM) * 4;
#pragma unroll
        for (int ai = 0; ai < 2; ++ai)
#pragma unroll
            for (int m = 0; m < 4; ++m)
#pragma unroll
                for (int bj = 0; bj < 2; ++bj)
#pragma unroll
                    for (int n = 0; n < 2; ++n) __builtin_amdgcn_raw_buffer_store_b128(__builtin_bit_cast(u32x4, acc[ai][bj][m][n]), rc, vo, so + ((ai * HALF + m * 16) * LDC + bj * HALF + n * 16) * 4, 0);
    }
};
template <int LDC> struct EpiRowScaleF32 {
    static constexpr bool PERM = false, AFTER_DRAIN = false;
    float* C; const float* rs;
    __device__ __forceinline__ void operator()(const f32x4 (&acc)[2][2][4][2], const Unit& u, int wr, int wc, int fr, int fq) const {
        const rsrc_t rc = mkrsrc(C, 16384u * LDC * 4u), rr = mkrsrc(rs, 16384u * 4u);
        const int vo = ((wr * 64 + fr) * LDC + wc * 32 + 4 * fq) * 4, vr = (wr * 64 + fr) * 4;
        const int so = (u.pm * BM * LDC + u.pn * BM) * 4, sr = u.pm * BM * 4;
#pragma unroll
        for (int ai = 0; ai < 2; ++ai)
#pragma unroll
            for (int m = 0; m < 4; ++m) { const float s = __builtin_bit_cast(float, __builtin_amdgcn_raw_buffer_load_b32(rr, vr, sr + (ai * HALF + m * 16) * 4, 0));
#pragma unroll
                for (int bj = 0; bj < 2; ++bj)
#pragma unroll
                    for (int n = 0; n < 2; ++n) { const f32x4 v = acc[ai][bj][m][n] * s; __builtin_amdgcn_raw_buffer_store_b128(__builtin_bit_cast(u32x4, v), rc, vo, so + ((ai * HALF + m * 16) * LDC + bj * HALF + n * 16) * 4, 0); } }
    }
};
template <bool BASE_F32> struct EpiResidB16 {
    static constexpr bool PERM = false, AFTER_DRAIN = false;
    const void* base; float ascale; bf16_t* xb;
    __device__ __forceinline__ void operator()(const f32x4 (&acc)[2][2][4][2], const Unit& u, int wr, int wc, int fr, int fq) const {
        EPI_FRESH_LANE();
        constexpr int LDC = 4096;
        const rsrc_t rb = mkrsrc(base, 16384u * LDC * (BASE_F32 ? 4u : 2u)), rx = mkrsrc(xb, 16384u * LDC * 2u);
        const int vo = ((wr * 64 + fr) * LDC + wc * 32 + 4 * fq) * 2;
        const int so = (u.pm * BM * LDC + u.pn * BM) * 2;
        f32x4 ra[2][2], rb2[2][2];
#define EPI_LD(dst, g_) do { _Pragma("unroll") for (int bj = 0; bj < 2; ++bj) _Pragma("unroll") for (int n = 0; n < 2; ++n) { \
            const int o = so + ((((g_) >> 2) * HALF + ((g_) & 3) * 16) * LDC + bj * HALF + n * 16) * 2; \
            if constexpr (BASE_F32) dst[bj][n] = __builtin_bit_cast(f32x4, __builtin_amdgcn_raw_buffer_load_b128(rb, vo * 2, o * 2, 0)); \
            else { const u32x2 t_ = __builtin_amdgcn_raw_buffer_load_b64(rb, vo, o, 0); dst[bj][n] = (f32x4){__builtin_bit_cast(float, t_.x << 16), __builtin_bit_cast(float, t_.x & 0xffff0000u), __builtin_bit_cast(float, t_.y << 16), __builtin_bit_cast(float, t_.y & 0xffff0000u)}; } } } while (0)
#define EPI_ST(src, g_) do { _Pragma("unroll") for (int bj = 0; bj < 2; ++bj) _Pragma("unroll") for (int n = 0; n < 2; ++n) { \
            const int o = so + ((((g_) >> 2) * HALF + ((g_) & 3) * 16) * LDC + bj * HALF + n * 16) * 2; \
            const f32x4 v = src[bj][n] + acc[(g_) >> 2][bj][(g_) & 3][n] * ascale; \
            u32x2 w; w.x = cvt_pk_bf16(v[0], v[1]); w.y = cvt_pk_bf16(v[2], v[3]); __builtin_amdgcn_raw_buffer_store_b64(w, rx, vo, o, 0); } } while (0)
        EPI_LD(ra, 0);
        EPI_LD(rb2, 1); EPI_ST(ra, 0);
        EPI_LD(ra, 2); EPI_ST(rb2, 1);
        EPI_LD(rb2, 3); EPI_ST(ra, 2);
        EPI_LD(ra, 4); EPI_ST(rb2, 3);
        EPI_LD(rb2, 5); EPI_ST(ra, 4);
        EPI_LD(ra, 6); EPI_ST(rb2, 5);
        EPI_LD(rb2, 7); EPI_ST(ra, 6);
        EPI_ST(rb2, 7);
#undef EPI_LD
#undef EPI_ST
    }
};
struct EpiQKV {
    static constexpr bool PERM = true, AFTER_DRAIN = false;
    bf16_t* Q; const float* rs; float qscale;
    __device__ __forceinline__ void operator()(const f32x4 (&acc)[2][2][4][2], const Unit& u, int wr, int wc, int fr, int fq) const {
        const rsrc_t rq = mkrsrc(Q, 3u * 16384u * 4096u * 2u), rr = mkrsrc(rs, 16384u * 4u);
        const int colt = u.pn * BM, which = colt >> 12, cw = colt & 4095, gt = cw >> 7;
        const int b = (u.pm * BM) >> 11, st = (u.pm * BM) & 2047;
        const float sc = which == 0 ? qscale : 1.f;
        const int so = (int)(((unsigned)which << 26) + (((unsigned)(b * 32 + gt) * 2048u + (unsigned)st) << 7)) * 2;
        const int vo = (((wr * 64 + fr) << 7) + wc * 32 + 8 * fq) * 2, vr = (wr * 64 + fr) * 4, sr = u.pm * BM * 4;
#pragma unroll
        for (int ai = 0; ai < 2; ++ai)
#pragma unroll
            for (int m = 0; m < 4; ++m) { const float f = sc * __builtin_bit_cast(float, __builtin_amdgcn_raw_buffer_load_b32(rr, vr, sr + (ai * HALF + m * 16) * 4, 0));
#pragma unroll
                for (int bj = 0; bj < 2; ++bj) {
                    const f32x4 v0 = acc[ai][bj][m][0] * f, v1 = acc[ai][bj][m][1] * f;
                    u32x4 w; w.x = cvt_pk_bf16(v0[0], v0[1]); w.y = cvt_pk_bf16(v0[2], v0[3]); w.z = cvt_pk_bf16(v1[0], v1[1]); w.w = cvt_pk_bf16(v1[2], v1[3]);
                    __builtin_amdgcn_raw_buffer_store_b128(w, rq, vo, so + ((bj * 2048 + ai * HALF + m * 16) << 7) * 2, 0); } }
    }
};

struct EpiQKV4 {
    static constexpr bool PERM = false, AFTER_DRAIN = false;
    bf16_t* Q; const float* rs; float qscale, wscale;
    __device__ __forceinline__ void operator()(const f32x4 (&acc)[2][2][4][2], const Unit& u, int wr, int wc, int fr, int fq) const {
        EPI_FRESH_LANE();
        const rsrc_t rq = mkrsrc(Q, 3u * 16384u * 4096u * 2u), rr = mkrsrc(rs, 16384u * 4u);
        const int colt = u.pn * BM, which = colt >> 12, cw = colt & 4095, gt = cw >> 7;
        const int b = (u.pm * BM) >> 11, st = (u.pm * BM) & 2047;
        const float sc = (which == 0 ? qscale : 1.f) * wscale;
        const int so = (int)(((unsigned)which << 26) + (((unsigned)(b * 32 + gt) * 2048u + (unsigned)st) << 7)) * 2;
        const int vo = (((wr * 64 + fr) << 7) + wc * 32 + 4 * fq) * 2, vr = (wr * 64 + fr) * 4, sr = u.pm * BM * 4;
        unsigned rsv[2][4];
#pragma unroll
        for (int ai = 0; ai < 2; ++ai)
#pragma unroll
            for (int m = 0; m < 4; ++m) rsv[ai][m] = __builtin_amdgcn_raw_buffer_load_b32(rr, vr, sr + (ai * HALF + m * 16) * 4, 0);
#pragma unroll
        for (int ai = 0; ai < 2; ++ai)
#pragma unroll
            for (int m = 0; m < 4; ++m) { const float f = sc * __builtin_bit_cast(float, rsv[ai][m]);
#pragma unroll
                for (int bj = 0; bj < 2; ++bj)
#pragma unroll
                    for (int n = 0; n < 2; ++n) { const f32x4 v0 = acc[ai][bj][m][n] * f; u32x2 w; w.x = cvt_pk_bf16(v0[0], v0[1]); w.y = cvt_pk_bf16(v0[2], v0[3]);
                        __builtin_amdgcn_raw_buffer_store_b64(w, rq, vo, so + (((bj * 2048 + ai * HALF + m * 16) << 7) + n * 16) * 2, 0); } }
    }
};

typedef int i32x8 __attribute__((ext_vector_type(8)));
template <bool F8> struct FragT { typedef bf16x8 type; };
template <> struct FragT<true> { typedef i32x8 type; };
__device__ __forceinline__ f32x4 mma_bf16(bf16x8 a, bf16x8 b, f32x4 c) { return __builtin_amdgcn_mfma_f32_16x16x32_bf16(a, b, c, 0, 0, 0); }
__device__ __forceinline__ f32x4 mma_bf16(i32x8, i32x8, f32x4 c) { return c; }
template <class Epi, class Sched, bool ALIGN_EPI = false, bool SP2 = false, bool F8 = false>
__device__ __forceinline__ void gemm_phase(PG8_LAS unsigned char* lds, const Gemm g, const Sched& S, const Epi& E, int tid_in) {
    int tid_ = tid_in;
    const int tid = tid_, wid = __builtin_amdgcn_readfirstlane(tid >> 6), lane = tid & 63, wr = wid >> 2, wc = wid & 3, fr = lane & 15, fq = lane >> 4;
    constexpr int EB = F8 ? 1 : 2;
    constexpr int K = 4096; constexpr int nt = (K * EB) / (BK * 2);
    unsigned voffA[2], voffB[2];
#pragma unroll
    for (int i = 0; i < 2; ++i) { int R, C; stage_rc(tid * 16 + i * 8192, R, C); const int Rb = Epi::PERM ? ((R & ~31) + perm32(R & 31)) : R;
        voffA[i] = (unsigned)(R * K * EB + C * 2); voffB[i] = (unsigned)(Rb * K * EB + C * 2); }
    const size_t kstep = (size_t)(BK * 2);
    const size_t hstep = (size_t)HALF * K * EB;
    const size_t tstep = 2 * hstep;
    const unsigned ldsw = (unsigned)wid * 1024u;
    const int aoff = F8 ? lds_byte(wr * 64 + fr, fq * 16) + (fq & 1) * 16 : lds_byte(wr * 64 + fr, fq * 8), boff = F8 ? lds_byte(wc * 32 + fr, fq * 16) + (fq & 1) * 16 : lds_byte(wc * 32 + fr, fq * 8);
    const int aoff1 = aoff + (F8 ? 16 - 32 * (fq & 1) : 0);
    const int f8o0_unused = 0; (void)f8o0_unused;
#define PG8_SA(b, h) (((b) * 2 + (h)) * HTB)
#define PG8_SB(b, h) ((4 + (b) * 2 + (h)) * HTB)
#define PG8_STAGE_X(bufoff, gbase, voff, rs_, base_) do { const int so_ = (int)((const char*)(gbase) - (const char*)(base_)); _Pragma("unroll") for (int _i = 0; _i < 2; ++_i) \
        __builtin_amdgcn_raw_ptr_buffer_load_lds(rs_, (PG8_LAS void*)(lds + (bufoff) + ldsw + _i * 8192), 16, (int)(voff)[_i], so_, 0, 0); } while (0)
#define PG8_LDA(dst, b, h) do { if constexpr (F8) { _Pragma("unroll") for (int m = 0; m < 4; ++m) { const u32x4 lo_ = *(const PG8_LAS u32x4*)(lds + PG8_SA(b, h) + aoff + m * 2048), hi_ = *(const PG8_LAS u32x4*)(lds + PG8_SA(b, h) + aoff1 + m * 2048); \
            dst[m][0] = (i32x8){(int)lo_[0], (int)lo_[1], (int)lo_[2], (int)lo_[3], (int)hi_[0], (int)hi_[1], (int)hi_[2], (int)hi_[3]}; } } \
        else { _Pragma("unroll") for (int m = 0; m < 4; ++m) _Pragma("unroll") for (int k = 0; k < 2; ++k) dst[m][k] = *(const PG8_LAS frag_t*)(lds + PG8_SA(b, h) + aoff + m * 2048 + k * 1024); } } while (0)
#define PG8_LDB(dst, b, h) do { if constexpr (F8) { _Pragma("unroll") for (int n = 0; n < 2; ++n) { const u32x4 lo_ = *(const PG8_LAS u32x4*)(lds + PG8_SB(b, h) + boff + n * 2048), hi_ = *(const PG8_LAS u32x4*)(lds + PG8_SB(b, h) + boff + (aoff1 - aoff) + n * 2048); \
            dst[n][0] = (i32x8){(int)lo_[0], (int)lo_[1], (int)lo_[2], (int)lo_[3], (int)hi_[0], (int)hi_[1], (int)hi_[2], (int)hi_[3]}; } } \
        else { _Pragma("unroll") for (int n = 0; n < 2; ++n) _Pragma("unroll") for (int k = 0; k < 2; ++k) dst[n][k] = *(const PG8_LAS frag_t*)(lds + PG8_SB(b, h) + boff + n * 2048 + k * 1024); } } while (0)
#define PG8_MMA(ai, bj, At, Bt) do { __builtin_amdgcn_s_setprio(1); _Pragma("unroll") for (int m = 0; m < 4; ++m) _Pragma("unroll") for (int n = 0; n < 2; ++n) { \
        if constexpr (F8) acc[ai][bj][m][n] = __builtin_amdgcn_mfma_scale_f32_16x16x128_f8f6f4(Bt[n][0], At[m][0], acc[ai][bj][m][n], 0, 0, 0, 0x7f7f7f7f, 0, 0x7f7f7f7f); \
        else { _Pragma("unroll") for (int k = 0; k < 2; ++k) acc[ai][bj][m][n] = mma_bf16(Bt[n][k], At[m][k], acc[ai][bj][m][n]); } } __builtin_amdgcn_s_setprio(0); } while (0)
#define PG8_WAIT_V(n) asm volatile("s_waitcnt vmcnt(" #n ")" ::: "memory")
#define PG8_WAIT_L(n) asm volatile("s_waitcnt lgkmcnt(" #n ")" ::: "memory")
#define PG8_BAR __builtin_amdgcn_s_barrier()
#define PG8_SCHED __builtin_amdgcn_sched_barrier(0)
    const __amdgpu_buffer_rsrc_t rsA = __builtin_amdgcn_make_buffer_rsrc((void*)g.A, (short)0, (int)((size_t)g.M * K * EB), 0x00020000), rsB = __builtin_amdgcn_make_buffer_rsrc((void*)g.Bt, (short)0, (int)((size_t)g.N * K * EB), 0x00020000);
    Unit cur, nxt; int ui = 0;
    if (!S.next(0, cur)) return;
    f32x4 acc[2][2][4][2];
#pragma unroll
    for (int a = 0; a < 2; ++a)
#pragma unroll
        for (int b = 0; b < 2; ++b)
#pragma unroll
            for (int m = 0; m < 4; ++m)
#pragma unroll
                for (int n = 0; n < 2; ++n) acc[a][b][m][n] = (f32x4){0.f, 0.f, 0.f, 0.f};
    typedef typename FragT<F8>::type frag_t;
    frag_t At[4][F8 ? 1 : 2], B0[2][F8 ? 1 : 2], B1[2][F8 ? 1 : 2];
    const char* cA = (const char*)g.A + (size_t)cur.pm * tstep; const char* cB = (const char*)g.Bt + (size_t)cur.pn * tstep;
    S.a_ready(cur);
    if constexpr (SP2) {
        PG8_STAGE_X(PG8_SB(0, 0), cB, voffB, rsB, g.Bt); PG8_STAGE_X(PG8_SB(0, 1), cB + hstep, voffB, rsB, g.Bt); PG8_STAGE_X(PG8_SA(0, 0), cA, voffA, rsA, g.A); PG8_STAGE_X(PG8_SA(0, 1), cA + hstep, voffA, rsA, g.A);
        if (wr == 1) PG8_BAR;
        PG8_WAIT_V(2); PG8_BAR;
        PG8_STAGE_X(PG8_SB(1, 0), cB + kstep, voffB, rsB, g.Bt); PG8_STAGE_X(PG8_SA(1, 0), cA + kstep, voffA, rsA, g.A); PG8_STAGE_X(PG8_SB(1, 1), cB + hstep + kstep, voffB, rsB, g.Bt);
        PG8_WAIT_V(6); PG8_BAR;
    } else {
        PG8_STAGE_X(PG8_SB(0, 0), cB, voffB, rsB, g.Bt); PG8_STAGE_X(PG8_SA(0, 0), cA, voffA, rsA, g.A); PG8_STAGE_X(PG8_SB(0, 1), cB + hstep, voffB, rsB, g.Bt); PG8_STAGE_X(PG8_SA(0, 1), cA + hstep, voffA, rsA, g.A);
        if (wr == 1) PG8_BAR;
        PG8_WAIT_V(4); PG8_BAR;
        PG8_STAGE_X(PG8_SB(1, 0), cB + kstep, voffB, rsB, g.Bt); PG8_STAGE_X(PG8_SA(1, 0), cA + kstep, voffA, rsA, g.A); PG8_STAGE_X(PG8_SB(1, 1), cB + hstep + kstep, voffB, rsB, g.Bt);
        PG8_WAIT_V(6); PG8_BAR;
    }
    for (;;) {
        const bool has_next = S.next(ui + 1, nxt);
        const char* nA = has_next ? (const char*)g.A + (size_t)nxt.pm * tstep : cA; const char* nB = has_next ? (const char*)g.Bt + (size_t)nxt.pn * tstep : cB;
        for (int t = 0; t < nt; t += 2) {
            const bool last = (t == nt - 2);
            const char* a1 = cA + (size_t)(t + 1) * kstep;
            const char* a2 = last ? nA : cA + (size_t)(t + 2) * kstep; const char* b2 = last ? nB : cB + (size_t)(t + 2) * kstep;
            const char* a3 = a2 + kstep; const char* b3 = b2 + kstep;
            if (last && has_next) S.a_ready(nxt);
            if constexpr (SP2) {
            PG8_LDB(B0, 0, 0); PG8_LDB(B1, 0, 1); PG8_SCHED; PG8_LDA(At, 0, 0); PG8_STAGE_X(PG8_SA(1, 1), a1 + hstep, voffA, rsA, g.A);
            PG8_WAIT_V(8); PG8_WAIT_L(0); PG8_BAR; PG8_MMA(0, 0, At, B0); PG8_MMA(0, 1, At, B1); PG8_BAR; PG8_SCHED;
            PG8_LDA(At, 0, 1); PG8_STAGE_X(PG8_SB(0, 0), b2, voffB, rsB, g.Bt); PG8_STAGE_X(PG8_SB(0, 1), b2 + hstep, voffB, rsB, g.Bt); PG8_STAGE_X(PG8_SA(0, 0), a2, voffA, rsA, g.A);
            PG8_WAIT_V(8); PG8_WAIT_L(0); PG8_BAR; PG8_MMA(1, 0, At, B0); PG8_MMA(1, 1, At, B1); PG8_BAR; PG8_SCHED;
            PG8_LDB(B0, 1, 0); PG8_LDB(B1, 1, 1); PG8_SCHED; PG8_LDA(At, 1, 0); PG8_STAGE_X(PG8_SA(0, 1), a2 + hstep, voffA, rsA, g.A);
            PG8_WAIT_V(8); PG8_WAIT_L(0); PG8_BAR; PG8_MMA(0, 0, At, B0); PG8_MMA(0, 1, At, B1); PG8_BAR; PG8_SCHED;
            PG8_LDA(At, 1, 1); PG8_STAGE_X(PG8_SB(1, 0), b3, voffB, rsB, g.Bt); PG8_STAGE_X(PG8_SB(1, 1), b3 + hstep, voffB, rsB, g.Bt); PG8_STAGE_X(PG8_SA(1, 0), a3, voffA, rsA, g.A);
            PG8_WAIT_V(8); PG8_WAIT_L(0); PG8_BAR; PG8_MMA(1, 0, At, B0); PG8_MMA(1, 1, At, B1); PG8_BAR; PG8_SCHED;
            } else {
            PG8_LDB(B0, 0, 0); PG8_SCHED; PG8_LDA(At, 0, 0); PG8_STAGE_X(PG8_SA(1, 1), a1 + hstep, voffA, rsA, g.A);
            PG8_WAIT_L(8); PG8_BAR; PG8_WAIT_L(0); PG8_MMA(0, 0, At, B0); PG8_BAR; PG8_SCHED;
            PG8_LDB(B1, 0, 1); PG8_STAGE_X(PG8_SB(0, 0), b2, voffB, rsB, g.Bt);
            PG8_BAR; PG8_WAIT_L(0); PG8_MMA(0, 1, At, B1); PG8_BAR;
            PG8_LDA(At, 0, 1); PG8_STAGE_X(PG8_SA(0, 0), a2, voffA, rsA, g.A);
            PG8_BAR; PG8_WAIT_L(0); PG8_MMA(1, 0, At, B0); PG8_BAR; PG8_SCHED;
            PG8_STAGE_X(PG8_SB(0, 1), b2 + hstep, voffB, rsB, g.Bt);
            PG8_WAIT_V(6); PG8_BAR; PG8_MMA(1, 1, At, B1); PG8_BAR;
            PG8_LDB(B0, 1, 0); PG8_SCHED; PG8_LDA(At, 1, 0); PG8_STAGE_X(PG8_SA(0, 1), a2 + hstep, voffA, rsA, g.A);
            PG8_WAIT_L(8); PG8_BAR; PG8_WAIT_L(0); PG8_MMA(0, 0, At, B0); PG8_BAR; PG8_SCHED;
            PG8_LDB(B1, 1, 1); PG8_STAGE_X(PG8_SB(1, 0), b3, voffB, rsB, g.Bt);
            PG8_BAR; PG8_WAIT_L(0); PG8_MMA(0, 1, At, B1); PG8_BAR;
            PG8_LDA(At, 1, 1); PG8_STAGE_X(PG8_SA(1, 0), a3, voffA, rsA, g.A);
            PG8_BAR; PG8_WAIT_L(0); PG8_MMA(1, 0, At, B0); PG8_BAR; PG8_SCHED;
            PG8_STAGE_X(PG8_SB(1, 1), b3 + hstep, voffB, rsB, g.Bt);
            PG8_WAIT_V(6); PG8_BAR; PG8_MMA(1, 1, At, B1); PG8_BAR;
            }
        }
        if constexpr (ALIGN_EPI) { if (wr == 0) PG8_BAR; }
        if constexpr (!Epi::AFTER_DRAIN) { E(acc, cur, wr, wc, fr, fq); S.done(cur); }
        if (!has_next) break;
#pragma unroll
        for (int a = 0; a < 2; ++a)
#pragma unroll
            for (int b = 0; b < 2; ++b)
#pragma unroll
                for (int m = 0; m < 4; ++m)
#pragma unroll
                    for (int n = 0; n < 2; ++n) acc[a][b][m][n] = (f32x4){0.f, 0.f, 0.f, 0.f};
        cur = nxt; cA = nA; cB = nB; ++ui;
        if constexpr (ALIGN_EPI) { if (wr == 1) PG8_BAR; }
    }
    PG8_WAIT_V(0);
    if constexpr (!ALIGN_EPI) { if (wr == 0) PG8_BAR; }
    PG8_BAR;
    if constexpr (Epi::AFTER_DRAIN) { E.fused(acc, cur, wr, wc, fr, fq, lds, wid, lane); S.done(cur); }
#undef PG8_SA
#undef PG8_SB
#undef PG8_STAGE_X
#undef PG8_LDA
#undef PG8_LDB
#undef PG8_MMA
#undef PG8_WAIT_V
#undef PG8_WAIT_L
#undef PG8_BAR
#undef PG8_SCHED
}
}
#define GAS __attribute__((address_space(1)))
#define LAS __attribute__((address_space(3)))
typedef unsigned short bf16_t;
typedef unsigned u32x4 __attribute__((ext_vector_type(4)));
typedef unsigned u32x2 __attribute__((ext_vector_type(2)));
typedef float f32x4 __attribute__((ext_vector_type(4)));
typedef float f32x2 __attribute__((ext_vector_type(2)));
typedef float f32x16 __attribute__((ext_vector_type(16)));
typedef short bf16x8 __attribute__((ext_vector_type(8)));
typedef short s16x4 __attribute__((ext_vector_type(4)));
typedef __bf16 bf16x2_t __attribute__((ext_vector_type(2)));
typedef unsigned u32x6 __attribute__((ext_vector_type(6)));
typedef unsigned u32x16 __attribute__((ext_vector_type(16)));
typedef float f32x32 __attribute__((ext_vector_type(32)));
typedef _Float16 f16x32 __attribute__((ext_vector_type(32)));
typedef _Float16 f16x2 __attribute__((ext_vector_type(2)));

namespace mk {
constexpr int M = 16384, D = 4096, S = 2048, NB = 8, PW = 12298, NH = 32, NE = 16384;
constexpr int NWAVES = 8;
constexpr size_t MiB = 1u << 20;
constexpr size_t WS_CTL = 0, CTL_ZERO_BYTES = 1 * MiB;
constexpr size_t WS_RSTD = 2 * MiB, WS_LOGF = 3 * MiB, WS_WQK = 4 * MiB, WS_WOUT = 20 * MiB, WS_WIN = 52 * MiB, WS_U16 = 148 * MiB, WS_V16 = 276 * MiB,
                 WS_XB = 404 * MiB, WS_Q = 532 * MiB, WS_K = 660 * MiB, WS_V = 788 * MiB, WS_OB = 916 * MiB, WS_X2 = 1792 * MiB, WS_END = 2048 * MiB;
constexpr size_t WS_XB8N = WS_OB + 64 * MiB;
constexpr size_t WS_SC = WS_Q;
constexpr int CW_BAR = 4096;
constexpr int CW_QUEUE = 16384;
constexpr int RING_BYTES = 131072, LDSCTL_OFF = RING_BYTES, MISC_OFF = LDSCTL_OFF + 320, LDS_BYTES = 147456;

struct Args { const float* in[13]; float* out; unsigned char* ws; int ph_lo, ph_hi; };

__device__ __forceinline__ unsigned f2bf(float f) { unsigned u = __builtin_bit_cast(unsigned, f); return (u + 0x7fffu + ((u >> 16) & 1u)) >> 16; }
__device__ __forceinline__ unsigned pk2(float lo, float hi) { return f2bf(lo) | (f2bf(hi) << 16); }
__device__ __forceinline__ float bf_lo(unsigned w) { return __builtin_bit_cast(float, w << 16); }
__device__ __forceinline__ float bf_hi(unsigned w) { return __builtin_bit_cast(float, w & 0xffff0000u); }
__device__ __forceinline__ float lane_read(float v, int src_lane) { return __builtin_bit_cast(float, __builtin_amdgcn_ds_bpermute(src_lane << 2, __builtin_bit_cast(int, v))); }
__device__ __forceinline__ int lane_read(int v, int src_lane) { return __builtin_amdgcn_ds_bpermute(src_lane << 2, v); }
constexpr float US = 1024.0f, VS = 32.0f, US_INV = 1.0f / 1024.0f, VS_INV = 1.0f / 32.0f;
constexpr int ROW6 = 3072;
__device__ __forceinline__ unsigned q_e2m3(float x, float inv) {
    const float a = fminf(fabsf(x) * inv, 7.5f);
    const float c = a < 2.0f ? __builtin_rintf(a * 8.0f) : (a < 4.0f ? __builtin_rintf(a * 4.0f) + 8.0f : __builtin_rintf(a * 2.0f) + 16.0f);
    return (unsigned)(int)c | ((__builtin_bit_cast(unsigned, x) >> 26) & 32u);
}
__device__ __forceinline__ u32x6 pack_fp6(const f32x4 (&a0)[4], const f32x4 (&a1)[4], float inv) {
    unsigned o[6];
#pragma unroll
    for (int w = 0; w < 6; ++w) o[w] = 0u;
#pragma unroll
    for (int j = 0; j < 32; ++j) { const float x = (j < 16) ? a0[(j & 15) >> 2][j & 3] : a1[(j & 15) >> 2][j & 3]; const unsigned c = q_e2m3(x, inv);
        const int b = 6 * j, w = b >> 5, sh = b & 31; o[w] |= c << sh; if (sh > 26) o[w + 1] |= c >> (32 - sh); }
    return (u32x6){o[0], o[1], o[2], o[3], o[4], o[5]};
}
__device__ __forceinline__ float clamp8(float x) { return fminf(fmaxf(x, -224.0f), 224.0f); }
__device__ __forceinline__ float logsig(float z) { return fminf(z, 0.f) - 0.6931471805599453f * __builtin_amdgcn_logf(1.0f + __builtin_amdgcn_exp2f(-fabsf(z) * 1.4426950408889634f)); }
__device__ __forceinline__ float gelu_erf(float v) {
    const float av = fabsf(v), t = __builtin_amdgcn_rcpf(av * 0.2316418882f + 1.0f);
    float q = t * 0.5307027145f + (-0.7265760135f); q = q * t + 0.7107068705f; q = q * t + (-0.142248368f); q = q * t + 0.127414796f; q = q * t;
    const float e = __builtin_amdgcn_exp2f((v * v) * (-0.72134752044f));
    const float m = v * (q * e);
    return v < 0.f ? m : v - m;
}
#define LDS_WAIT() asm volatile("s_waitcnt lgkmcnt(0)" ::: "memory")
#define FRESH_LDS(l) do { unsigned v_ = (unsigned)(size_t)(l); asm volatile("" : "+s"(v_)); (l) = (LAS unsigned char*)(size_t)v_; } while (0)
#define FRESH_BID() int bid = blockIdx.x, G = gridDim.x; asm volatile("" : "+s"(bid), "+s"(G))
#define FRESH_TID() int tid; { int w_ = wave0, l_; { unsigned z_ = 0u; asm volatile("" : "+v"(z_)); l_ = (int)__builtin_amdgcn_mbcnt_hi(~0u, __builtin_amdgcn_mbcnt_lo(~0u, z_)); } asm volatile("" : "+s"(w_)); tid = w_ * 64 + l_; } const int lane = tid & 63, wave = __builtin_amdgcn_readfirstlane(tid >> 6); (void)lane; (void)wave

__device__ __forceinline__ unsigned wave_max_u32(unsigned v) {
    v = max(v, (unsigned)__builtin_amdgcn_update_dpp(0, (int)v, 0x111, 0xF, 0xF, true));
    v = max(v, (unsigned)__builtin_amdgcn_update_dpp(0, (int)v, 0x112, 0xF, 0xF, true));
    v = max(v, (unsigned)__builtin_amdgcn_update_dpp(0, (int)v, 0x114, 0xF, 0xF, true));
    v = max(v, (unsigned)__builtin_amdgcn_update_dpp(0, (int)v, 0x118, 0xF, 0xF, true));
    v = max(v, (unsigned)__builtin_amdgcn_update_dpp((int)v, (int)v, 0x142, 0xA, 0xF, false));
    v = max(v, (unsigned)__builtin_amdgcn_update_dpp((int)v, (int)v, 0x143, 0xC, 0xF, false));
    return (unsigned)__builtin_amdgcn_readlane((int)v, 63);
}
__device__ __forceinline__ float wave_sum_dpp(float x) {
    int v = __builtin_bit_cast(int, x);
#define DPP_ADD(ctrl, rm, bc, oldv) v = __builtin_bit_cast(int, __builtin_bit_cast(float, v) + __builtin_bit_cast(float, __builtin_amdgcn_update_dpp(oldv, v, ctrl, rm, 0xF, bc)))
    DPP_ADD(0x111, 0xF, true, 0); DPP_ADD(0x112, 0xF, true, 0); DPP_ADD(0x114, 0xF, true, 0); DPP_ADD(0x118, 0xF, true, 0);
#undef DPP_ADD
    const float r0 = __builtin_bit_cast(float, __builtin_amdgcn_readlane(v, 15)), r1 = __builtin_bit_cast(float, __builtin_amdgcn_readlane(v, 31)), r2 = __builtin_bit_cast(float, __builtin_amdgcn_readlane(v, 47)), r3 = __builtin_bit_cast(float, __builtin_amdgcn_readlane(v, 63));
    return (r0 + r1) + (r2 + r3);
}
__device__ __forceinline__ unsigned ordkey(float x) { const unsigned u = __builtin_bit_cast(unsigned, x); return (u & 0x80000000u) ? ~u : (u | 0x80000000u); }
__device__ __forceinline__ void transpose_item(const float* W, int K, int ldw, int ncols, const float* gain, bf16_t* WT, LAS float* scr, int item, int lane) {
    const int nblk = ncols / 32, kb = item / nblk, nb = item % nblk, k0 = 64 * kb, n0 = 32 * nb;
#pragma unroll 8
    for (int i = 0; i < 32; ++i) { const int kk = 2 * i + (lane >> 5); float v = W[(size_t)(k0 + kk) * ldw + n0 + (lane & 31)]; if (gain) v *= gain[k0 + kk]; scr[kk * 33 + (lane & 31)] = v; }
    LDS_WAIT(); asm volatile("" ::: "memory");
    const int c = lane & 7;
#pragma unroll
    for (int j = 0; j < 4; ++j) { const int n = (lane >> 3) + 8 * j; const LAS float* s = scr + (8 * c) * 33 + n;
        u32x4 o; o.x = pk2(s[0 * 33], s[1 * 33]); o.y = pk2(s[2 * 33], s[3 * 33]); o.z = pk2(s[4 * 33], s[5 * 33]); o.w = pk2(s[6 * 33], s[7 * 33]);
        *(u32x4*)(WT + (size_t)(n0 + n) * K + k0 + 8 * c) = o; }
    LDS_WAIT(); asm volatile("" ::: "memory");
}

typedef const __attribute__((address_space(4))) Args* KArgsT;
__device__ __forceinline__ unsigned pk4_fp8(float a, float b, float c, float d) { int p = __builtin_amdgcn_cvt_pk_fp8_f32(clamp8(a), clamp8(b), 0, false); p = __builtin_amdgcn_cvt_pk_fp8_f32(clamp8(c), clamp8(d), p, true); return (unsigned)p; }
__device__ __forceinline__ void transpose_item8(const float* W, int K, int ldw, int ncols, const float* gain, float scale, unsigned char* WT, LAS float* scr, int item, int lane) {
    const int nblk = ncols / 32, kb = item / nblk, nb = item % nblk, k0 = 64 * kb, n0 = 32 * nb;
    const int kr = lane >> 3, nq = (lane & 7) * 4;
    f32x4 v[8];
#pragma unroll
    for (int i = 0; i < 8; ++i) { const float* p = W + (size_t)(k0 + 8 * i + kr) * ldw + n0 + nq; v[i] = (f32x4){p[0], p[1], p[2], p[3]}; }
#pragma unroll
    for (int i = 0; i < 8; ++i) { const int kk = 8 * i + kr; const float g = (gain ? gain[k0 + kk] : 1.0f) * scale; LAS float* d = scr + kk * 33 + nq; d[0] = v[i][0] * g; d[1] = v[i][1] * g; d[2] = v[i][2] * g; d[3] = v[i][3] * g; }
    LDS_WAIT(); asm volatile("" ::: "memory");
    const int c = lane & 7;
#pragma unroll
    for (int j = 0; j < 4; ++j) { const int n = (lane >> 3) + 8 * j; const LAS float* s = scr + (8 * c) * 33 + n;
        u32x2 o; o.x = pk4_fp8(s[0 * 33], s[1 * 33], s[2 * 33], s[3 * 33]); o.y = pk4_fp8(s[4 * 33], s[5 * 33], s[6 * 33], s[7 * 33]);
        *(u32x2*)(WT + (size_t)(n0 + n) * K + k0 + 8 * c) = o; }
    LDS_WAIT(); asm volatile("" ::: "memory");
}
__device__ __forceinline__ void conv_phase(KArgsT ka, int l, LAS unsigned char* lds, int wave0) {
    FRESH_TID(); FRESH_LDS(lds); FRESH_BID();
    unsigned char* ws = ka->ws;
    const float* ln1 = ka->in[1] + (size_t)l * D; const float* w_in = ka->in[2] + (size_t)l * D * PW; const float* w_out = ka->in[5] + (size_t)l * D * D;
    const float* ln2 = ka->in[6] + (size_t)l * D; const float* wq = ka->in[7] + (size_t)l * D * 2048;
    const float* k1 = ka->in[8] + (size_t)l * 8 * 128 * 128; const float* k2 = ka->in[9] + (size_t)l * 8 * 128 * 128;
    const float* pu = ka->in[10] + (size_t)l * NE * D; const float* pv = ka->in[11] + (size_t)l * NE * D;
    bf16_t* WQK = (bf16_t*)(ws + WS_WQK); bf16_t* WOUT = (bf16_t*)(ws + WS_WOUT); bf16_t* WIN = (bf16_t*)(ws + WS_WIN); bf16_t* U16 = (bf16_t*)(ws + WS_U16); bf16_t* V16 = (bf16_t*)(ws + WS_V16);
    {
        LAS float* Ks = (LAS float*)lds;
        LAS float* Ws = (LAS float*)(lds + 128 * 132 * 4);
        for (int it = bid; it < 1024; it += G) {
            const int gi = it >> 6, c0 = (it & 63) * 64;
            const float* key = ((gi & 1) ? k2 : k1) + (size_t)(gi >> 1) * 128 * 128;
            for (int i = tid; i < 4096; i += 512) { const int r = i >> 5, c4 = (i & 31) * 4; *(LAS f32x4*)(Ks + r * 132 + c4) = *(const f32x4*)(key + r * 128 + c4); }
            for (int i = tid; i < 2048; i += 512) { const int r = i >> 5, c4 = (i & 31) * 4; *(LAS f32x4*)(Ws + r * 132 + c4) = *(const f32x4*)(wq + (size_t)(c0 + r) * 2048 + gi * 128 + c4); }
            __syncthreads();
            const int tc = tid & 15, tn = tid >> 4;
            float acc[4][4];
#pragma unroll
            for (int i = 0; i < 4; ++i)
#pragma unroll
                for (int j = 0; j < 4; ++j) acc[i][j] = 0.f;
#pragma unroll 2
            for (int d = 0; d < 128; d += 4) {
                f32x4 kv[4], wv[4];
#pragma unroll
                for (int i = 0; i < 4; ++i) kv[i] = *(const LAS f32x4*)(Ks + (4 * tn + i) * 132 + d);
#pragma unroll
                for (int j = 0; j < 4; ++j) wv[j] = *(const LAS f32x4*)(Ws + (tc + 16 * j) * 132 + d);
#pragma unroll
                for (int i = 0; i < 4; ++i)
#pragma unroll
                    for (int j = 0; j < 4; ++j) acc[i][j] += kv[i][0] * wv[j][0] + kv[i][1] * wv[j][1] + kv[i][2] * wv[j][2] + kv[i][3] * wv[j][3];
            }
#pragma unroll
            for (int j = 0; j < 4; ++j) { const int c = c0 + tc + 16 * j; const float gg = ln2[c];
#pragma unroll
                for (int i = 0; i < 4; ++i) WQK[(size_t)(gi * 128 + 4 * tn + i) * D + c] = (bf16_t)f2bf(acc[i][j] * gg); }
            __syncthreads();
        }
        __syncthreads();
    }
    const int gw = bid * NWAVES + wave, NGW = G * NWAVES;
    {
        unsigned char* U6 = (unsigned char*)U16; unsigned char* V6 = U6 + (size_t)NE * ROW6; float* SCU = (float*)(U6 + 2 * (size_t)NE * ROW6); float* SCV = SCU + NE;
        for (int r = gw; r < NE; r += NGW) {
            const float* us = pu + (size_t)r * D + 16 * lane; const float* vs = pv + (size_t)r * D + 16 * lane;
            f32x4 uu[4][4], vv[4][4];
#pragma unroll
            for (int i = 0; i < 4; ++i)
#pragma unroll
                for (int q = 0; q < 4; ++q) { uu[i][q] = *(const f32x4*)(us + 1024 * i + 4 * q); vv[i][q] = *(const f32x4*)(vs + 1024 * i + 4 * q); }
            float au = 0.f, av = 0.f;
#pragma unroll
            for (int i = 0; i < 4; ++i)
#pragma unroll
                for (int q = 0; q < 4; ++q) { uu[i][q] *= *(const f32x4*)(ln2 + 1024 * i + 16 * lane + 4 * q);
                    au = fmaxf(fmaxf(au, fmaxf(fabsf(uu[i][q][0]), fabsf(uu[i][q][1]))), fmaxf(fabsf(uu[i][q][2]), fabsf(uu[i][q][3])));
                    av = fmaxf(fmaxf(av, fmaxf(fabsf(vv[i][q][0]), fabsf(vv[i][q][1]))), fmaxf(fabsf(vv[i][q][2]), fabsf(vv[i][q][3]))); }
            au = __builtin_bit_cast(float, wave_max_u32(__builtin_bit_cast(unsigned, au))); av = __builtin_bit_cast(float, wave_max_u32(__builtin_bit_cast(unsigned, av)));
            const float iu = au > 0.f ? 7.5f / au : 0.f, iv = av > 0.f ? 7.5f / av : 0.f;
            if (lane == 0) { SCU[r] = au * (1.0f / 7.5f); SCV[r] = av * (1.0f / 7.5f); }
            { const u32x6 g0 = pack_fp6(uu[0], uu[1], iu), g1 = pack_fp6(uu[2], uu[3], iu); u32x4* o = (u32x4*)(U6 + (size_t)r * ROW6) + lane;
              o[0] = (u32x4){g0[0], g0[1], g0[2], g0[3]}; o[64] = (u32x4){g0[4], g0[5], g1[0], g1[1]}; o[128] = (u32x4){g1[2], g1[3], g1[4], g1[5]}; }
            { const u32x6 g0 = pack_fp6(vv[0], vv[1], iv), g1 = pack_fp6(vv[2], vv[3], iv); u32x4* o = (u32x4*)(V6 + (size_t)r * ROW6) + lane;
              o[0] = (u32x4){g0[0], g0[1], g0[2], g0[3]}; o[64] = (u32x4){g0[4], g0[5], g1[0], g1[1]}; o[128] = (u32x4){g1[2], g1[3], g1[4], g1[5]}; }
        }
    }
    {
        LAS float* scr = (LAS float*)(lds + wave * 16384);
        constexpr int I_O = (D / 64) * (D / 32), I_IN = (D / 64) * (12288 / 32);
        for (int it = gw; it < I_O + I_IN; it += NGW) {
            if (it < I_O) transpose_item8(w_out, D, D, D, nullptr, US, (unsigned char*)WOUT, scr, it, lane);
            else transpose_item8(w_in, D, PW, 12288, ln1, US, (unsigned char*)WIN, scr, it - I_O, lane);
        }
    }
}

template <bool WITH_F>
__device__ __forceinline__ void prep_phase(const float* X, bf16_t* XB, float* RSTD, const float* w_in, const float* ln1, const float* bf, float* LOGF, LAS unsigned char* lds, int wave0) {
    FRESH_TID(); FRESH_LDS(lds); FRESH_BID();
    LAS unsigned short* gfs = (LAS unsigned short*)lds;
    if (WITH_F) {
        __syncthreads();
        for (int c = tid; c < D; c += 512) { const float g = ln1[c]; const float* wr = w_in + (size_t)c * PW + 12288;
#pragma unroll
            for (int j = 0; j < 10; ++j) gfs[j * D + c] = (unsigned short)f2bf(wr[j] * g); }
        __syncthreads();
    }
    const int gw = bid * NWAVES + wave, NGW = G * NWAVES;
    for (int m = gw; m < M; m += NGW) {
        const f32x4* xr = (const f32x4*)(X + (size_t)m * D) + lane;
        f32x4 v[16]; float ss = 0.f;
#pragma unroll
        for (int i = 0; i < 16; ++i) { v[i] = xr[64 * i]; ss += (v[i][0] * v[i][0] + v[i][1] * v[i][1]) + (v[i][2] * v[i][2] + v[i][3] * v[i][3]); }
        ss = wave_sum_dpp(ss);
        const float rstd = rsqrtf(ss * (1.0f / D) + 1e-6f);
        if (WITH_F) {
            unsigned* o8 = (unsigned*)((unsigned char*)XB + (size_t)m * D) + lane;
#pragma unroll
            for (int i = 0; i < 16; ++i) o8[64 * i] = pk4_fp8(v[i][0], v[i][1], v[i][2], v[i][3]);
        } else {
        u32x2* o = (u32x2*)(XB + (size_t)m * D) + lane;
#pragma unroll
        for (int i = 0; i < 16; ++i) { u32x2 w; w.x = pk2(v[i][0], v[i][1]); w.y = pk2(v[i][2], v[i][3]); o[64 * i] = w; }
        }
        if (lane == 0) RSTD[m] = rstd;
        if (WITH_F) {
            float mine = 0.f;
#pragma unroll 1
            for (int j = 0; j < 10; ++j) { float s = 0.f;
#pragma unroll
                for (int i = 0; i < 16; ++i) { const u32x2 gp = *(const LAS u32x2*)(gfs + j * D + 256 * i + 4 * lane);
                    s += (v[i][0] * bf_lo(gp.x) + v[i][1] * bf_hi(gp.x)) + (v[i][2] * bf_lo(gp.y) + v[i][3] * bf_hi(gp.y)); }
                s = wave_sum_dpp(s); if (lane == j) mine = s; }
            if (lane < 10) { const int b = m >> 11, s = m & 2047; LOGF[(size_t)(b * 10 + lane) * S + s] = logsig(mine * rstd + bf[lane]); }
        }
    }
}


__device__ __forceinline__ void load16_bf16(const bf16_t* p, float (&d)[16]) {
    const u32x4 a = *(const u32x4*)p, b = *(const u32x4*)(p + 8);
#pragma unroll
    for (int q = 0; q < 4; ++q) { d[2 * q] = bf_lo(a[q]); d[2 * q + 1] = bf_hi(a[q]); d[8 + 2 * q] = bf_lo(b[q]); d[8 + 2 * q + 1] = bf_hi(b[q]); }
}
#define RFL(x) __builtin_amdgcn_readfirstlane(x)
__device__ __forceinline__ void peer_u_phase(const float* SC, const unsigned char* U6, const bf16_t* X1, int* EIDG, float* WG, LAS unsigned char* lds, int wave0) {
    FRESH_TID(); FRESH_LDS(lds); FRESH_BID();
    LAS int* s_eid = (LAS int*)(lds + wave * 1024); LAS float* s_w = (LAS float*)(lds + wave * 1024 + 512); LAS float* s_su = (LAS float*)(lds + 8192 + wave * 512);
    const float* SCU = (const float*)(U6 + 2 * (size_t)NE * ROW6); const float* SCV = SCU + NE;
    const int gw = bid * NWAVES + wave, NGW = G * NWAVES;
    const float NEG = -3.0e38f;
    for (int tok = gw; tok < M; tok += NGW) {
        const bf16_t* x1 = X1 + (size_t)tok * D;
        f16x2 xh[2][16]; float rstd_tok;
        { float ss_ = 0.f;
#pragma unroll
          for (int i = 0; i < 4; ++i) { float t[16]; load16_bf16(x1 + 1024 * i + 16 * lane, t);
#pragma unroll
              for (int k = 0; k < 16; ++k) ss_ += t[k] * t[k];
#pragma unroll
              for (int k = 0; k < 8; ++k) xh[i >> 1][(i & 1) * 8 + k] = __builtin_bit_cast(f16x2, __builtin_amdgcn_cvt_pkrtz(t[2 * k], t[2 * k + 1])); }
          rstd_tok = rsqrtf(wave_sum_dpp(ss_) * (1.0f / D) + 1e-6f); }
        const float* sc = SC + (size_t)tok * 2048;
        LAS float* selv = (LAS float*)(lds + 12288 + wave * 512); LAS int* seli = (LAS int*)(lds + 12288 + wave * 512 + 256);
#define BALLOT(c) __builtin_amdgcn_ballot_w64(c)
#define MBCNT(m) ((int)__builtin_amdgcn_mbcnt_hi((unsigned)((m) >> 32), __builtin_amdgcn_mbcnt_lo((unsigned)(m), 0u)))
        for (int h = 0; h < 4; ++h) {
            float x[2][2][2]; unsigned kk[2][2][2];
#pragma unroll
            for (int u = 0; u < 2; ++u)
#pragma unroll
                for (int f = 0; f < 2; ++f)
#pragma unroll
                    for (int r = 0; r < 2; ++r) { const float v = sc[(h + 4 * u) * 256 + f * 128 + r * 64 + lane]; x[u][f][r] = v; kk[u][f][r] = (ordkey(v) & ~127u) | (unsigned)(127 - 64 * r - lane); }
            unsigned T[2][2] = {{0u, 0u}, {0u, 0u}}; int dn = 0;
            for (unsigned bm = 0x80000000u; bm != 0u && dn != 15; bm >>= 1) {
#pragma unroll
                for (int u = 0; u < 2; ++u)
#pragma unroll
                    for (int f = 0; f < 2; ++f) { const unsigned cand = T[u][f] | bm;
                        const int c = __builtin_popcountll(BALLOT(kk[u][f][0] >= cand)) + __builtin_popcountll(BALLOT(kk[u][f][1] >= cand));
                        T[u][f] = c >= 16 ? cand : T[u][f]; dn |= (c == 16) ? (1 << (2 * u + f)) : 0; }
            }
#pragma unroll
            for (int u = 0; u < 2; ++u)
#pragma unroll
                for (int f = 0; f < 2; ++f) { const bool s0 = kk[u][f][0] >= T[u][f], s1 = kk[u][f][1] >= T[u][f]; const unsigned long long m0 = BALLOT(s0), m1 = BALLOT(s1);
                    const int p0 = MBCNT(m0), p1 = __builtin_popcountll(m0) + MBCNT(m1);
                    if (s0) { selv[(2 * u + f) * 16 + (p0 & 15)] = x[u][f][0]; seli[(2 * u + f) * 16 + (p0 & 15)] = lane; }
                    if (s1) { selv[(2 * u + f) * 16 + (p1 & 15)] = x[u][f][1]; seli[(2 * u + f) * 16 + (p1 & 15)] = 64 + lane; } }
            asm volatile("" ::: "memory");
            float s4[2][4]; unsigned k4[2][4];
#pragma unroll
            for (int u = 0; u < 2; ++u) { const float va = selv[(2 * u) * 16 + (lane >> 2)]; const f32x4 vb = *(const LAS f32x4*)(selv + (2 * u + 1) * 16 + (lane & 3) * 4);
#pragma unroll
                for (int q = 0; q < 4; ++q) { s4[u][q] = va + vb[q]; k4[u][q] = (ordkey(s4[u][q]) & ~255u) | (unsigned)(255 - 4 * lane - q); } }
            unsigned T2[2] = {0u, 0u}; int d2 = 0;
            for (unsigned bm = 0x80000000u; bm != 0u && d2 != 3; bm >>= 1) {
#pragma unroll
                for (int u = 0; u < 2; ++u) { const unsigned cand = T2[u] | bm;
                    const int c = (__builtin_popcountll(BALLOT(k4[u][0] >= cand)) + __builtin_popcountll(BALLOT(k4[u][1] >= cand))) + (__builtin_popcountll(BALLOT(k4[u][2] >= cand)) + __builtin_popcountll(BALLOT(k4[u][3] >= cand)));
                    T2[u] = c >= 16 ? cand : T2[u]; d2 |= (c == 16) ? (1 << u) : 0; }
            }
#pragma unroll
            for (int u = 0; u < 2; ++u) {
                const unsigned mk = wave_max_u32(max(max(k4[u][0], k4[u][1]), max(k4[u][2], k4[u][3]))) & ~255u;
                const float mx = __builtin_bit_cast(float, (mk & 0x80000000u) ? (mk & 0x7fffffffu) : ~mk);
                const float cs = 1.4426950408889634f * rstd_tok;
                float p[4], ps = 0.f;
#pragma unroll
                for (int q = 0; q < 4; ++q) { p[q] = (k4[u][q] >= T2[u]) ? __builtin_amdgcn_exp2f((s4[u][q] - mx) * cs) : 0.f; ps += p[q]; }
                const float tot = wave_sum_dpp(ps);
                const int i1 = seli[(2 * u) * 16 + (lane >> 2)]; const u32x4 i2 = *(const LAS u32x4*)(seli + (2 * u + 1) * 16 + (lane & 3) * 4);
                int base = (h + 4 * u) * 16;
#pragma unroll
                for (int q = 0; q < 4; ++q) { const bool sl = k4[u][q] >= T2[u]; const unsigned long long m = BALLOT(sl); const int slot = base + (MBCNT(m) & 15); base += __builtin_popcountll(m);
                    if (sl) { const int e = ((i1 & 127) << 7) | (int)(i2[q] & 127u); s_eid[slot] = e; s_w[slot] = p[q] / tot * SCV[e]; s_su[slot] = SCU[e]; } }
            }
            asm volatile("" ::: "memory");
        }
#undef BALLOT
#undef MBCNT
        LDS_WAIT(); asm volatile("" ::: "memory");
#define LOADROW6(dst, base, e) do { const u32x4* p_ = (const u32x4*)((base) + (size_t)(e) * ROW6) + lane; dst[0] = p_[0]; dst[1] = p_[64]; dst[2] = p_[128]; } while (0)
#define GRP6(row, g) ((g) == 0 ? (u32x6){row[0][0], row[0][1], row[0][2], row[0][3], row[1][0], row[1][1]} : (u32x6){row[1][2], row[1][3], row[2][0], row[2][1], row[2][2], row[2][3]})
        {
#define UDOT6(row, j) do { float da_ = 0.f, db_ = 0.f; _Pragma("unroll") for (int g_ = 0; g_ < 2; ++g_) { \
                u32x6 G_ = GRP6(row, g_); asm volatile("" : "+v"(G_));     \
                const f16x32 hv_ = __builtin_amdgcn_cvt_scalef32_pk32_f16_fp6(G_, 1.0f); \
                _Pragma("unroll") for (int k_ = 0; k_ < 16; k_ += 2) { da_ = __builtin_amdgcn_fdot2((f16x2){hv_[2 * k_], hv_[2 * k_ + 1]}, xh[g_][k_], da_, false); db_ = __builtin_amdgcn_fdot2((f16x2){hv_[2 * k_ + 2], hv_[2 * k_ + 3]}, xh[g_][k_ + 1], db_, false); } \
                asm volatile("" : "+v"(da_), "+v"(db_)); } \
            const float d_ = wave_sum_dpp(da_ + db_) * (rstd_tok * s_su[j]); const float ge_ = gelu_erf(d_); if (lane == 0) s_w[j] *= ge_; } while (0)
            u32x4 r0[3], r1[3], r2[3];
            { const int e_ = RFL(s_eid[0]); LOADROW6(r0, U6, e_); } { const int e_ = RFL(s_eid[1]); LOADROW6(r1, U6, e_); } { const int e_ = RFL(s_eid[2]); LOADROW6(r2, U6, e_); }
            for (int j = 0; j < 126; j += 3) {
                UDOT6(r0, j);     if (j + 3 < 128) { const int e_ = RFL(s_eid[j + 3]); LOADROW6(r0, U6, e_); }
                UDOT6(r1, j + 1); if (j + 4 < 128) { const int e_ = RFL(s_eid[j + 4]); LOADROW6(r1, U6, e_); }
                UDOT6(r2, j + 2); if (j + 5 < 128) { const int e_ = RFL(s_eid[j + 5]); LOADROW6(r2, U6, e_); }
            }
            UDOT6(r0, 126); UDOT6(r1, 127);
#undef UDOT6
        }
        LDS_WAIT(); asm volatile("" ::: "memory");
        EIDG[(size_t)tok * 128 + lane] = s_eid[lane]; EIDG[(size_t)tok * 128 + 64 + lane] = s_eid[64 + lane];
        WG[(size_t)tok * 128 + lane] = s_w[lane]; WG[(size_t)tok * 128 + 64 + lane] = s_w[64 + lane];
        LDS_WAIT(); asm volatile("" ::: "memory");
    }
}

template <bool FINAL>
__device__ __forceinline__ void peer_v_phase(const int* EIDG, const float* WG, const unsigned char* V6, const bf16_t* X1, void* XOv, const float* fg,
                                             unsigned char* XB8n, float* RSTDn, float* LOGFn, const float* w_in_n, const float* ln1_n, const float* bf_n, LAS unsigned char* lds, int wave0) {
    FRESH_TID(); FRESH_LDS(lds); FRESH_BID();
    LAS int* s_eid = (LAS int*)(lds + 81920 + wave * 1024); LAS float* s_w = (LAS float*)(lds + 81920 + wave * 1024 + 512);
    LAS unsigned short* gfs = (LAS unsigned short*)lds;
    if (!FINAL) {
        __syncthreads();
        for (int c = tid; c < D; c += 512) { const float g = ln1_n[c]; const float* wr = w_in_n + (size_t)c * PW + 12288;
#pragma unroll
            for (int j = 0; j < 10; ++j) gfs[j * D + c] = (unsigned short)f2bf(wr[j] * g); }
        __syncthreads();
    }
    const int gw = bid * NWAVES + wave, NGW = G * NWAVES;
    for (int tok = gw; tok < M; tok += NGW) {
        s_eid[lane] = EIDG[(size_t)tok * 128 + lane]; s_eid[64 + lane] = EIDG[(size_t)tok * 128 + 64 + lane];
        s_w[lane] = WG[(size_t)tok * 128 + lane]; s_w[64 + lane] = WG[(size_t)tok * 128 + 64 + lane];
        LDS_WAIT(); asm volatile("" ::: "memory");
        const bf16_t* x1 = X1 + (size_t)tok * D;
        {
            f32x2 acc2[2][16];
#define ACC(i, k) acc2[(i) >> 1][((i) & 1) * 8 + ((k) >> 1)][(k) & 1]
#pragma unroll
            for (int g = 0; g < 2; ++g)
#pragma unroll
                for (int k = 0; k < 16; ++k) acc2[g][k] = (f32x2){0.f, 0.f};
#define VACC6(row, j) do { const float w_ = s_w[j]; const f32x2 w2_ = {w_, w_}; _Pragma("unroll") for (int g_ = 0; g_ < 2; ++g_) { \
                u32x6 G_ = GRP6(row, g_); asm volatile("" : "+v"(G_)); \
                const f32x32 d_ = __builtin_amdgcn_cvt_scalef32_pk32_f32_fp6(G_, 1.0f); \
                _Pragma("unroll") for (int k_ = 0; k_ < 16; ++k_) acc2[g_][k_] = __builtin_elementwise_fma(w2_, (f32x2){d_[2 * k_], d_[2 * k_ + 1]}, acc2[g_][k_]); \
                asm volatile("" : "+v"(acc2[g_][0]), "+v"(acc2[g_][1]), "+v"(acc2[g_][2]), "+v"(acc2[g_][3]), "+v"(acc2[g_][4]), "+v"(acc2[g_][5]), "+v"(acc2[g_][6]), "+v"(acc2[g_][7]), \
                                  "+v"(acc2[g_][8]), "+v"(acc2[g_][9]), "+v"(acc2[g_][10]), "+v"(acc2[g_][11]), "+v"(acc2[g_][12]), "+v"(acc2[g_][13]), "+v"(acc2[g_][14]), "+v"(acc2[g_][15])); } } while (0)
            u32x4 r0[3], r1[3], r2[3];
            { const int e_ = RFL(s_eid[0]); LOADROW6(r0, V6, e_); } { const int e_ = RFL(s_eid[1]); LOADROW6(r1, V6, e_); } { const int e_ = RFL(s_eid[2]); LOADROW6(r2, V6, e_); }
            for (int j = 0; j < 126; j += 3) {
                VACC6(r0, j);     if (j + 3 < 128) { const int e_ = RFL(s_eid[j + 3]); LOADROW6(r0, V6, e_); }
                VACC6(r1, j + 1); if (j + 4 < 128) { const int e_ = RFL(s_eid[j + 4]); LOADROW6(r1, V6, e_); }
                VACC6(r2, j + 2); if (j + 5 < 128) { const int e_ = RFL(s_eid[j + 5]); LOADROW6(r2, V6, e_); }
            }
            VACC6(r0, 126); VACC6(r1, 127);
#undef VACC6
            float ss = 0.f;
#pragma unroll
            for (int i = 0; i < 4; ++i) { float t[16]; load16_bf16(x1 + 1024 * i + 16 * lane, t);
#pragma unroll
                for (int k = 0; k < 16; ++k) { ACC(i, k) += t[k]; ss += ACC(i, k) * ACC(i, k); } }
            ss = wave_sum_dpp(ss);
            const float rs = rsqrtf(ss * (1.0f / D) + 1e-6f);
            if (!FINAL) {
#pragma unroll
                for (int i = 0; i < 4; ++i) { u32x4 w8;
#pragma unroll
                    for (int q = 0; q < 4; ++q) w8[q] = pk4_fp8(ACC(i, 4 * q), ACC(i, 4 * q + 1), ACC(i, 4 * q + 2), ACC(i, 4 * q + 3));
                    *(u32x4*)(XB8n + (size_t)tok * D + 1024 * i + 16 * lane) = w8; }
                if (lane == 0) RSTDn[tok] = rs;
                float mine = 0.f;
#pragma unroll 1
                for (int j = 0; j < 10; ++j) { float s = 0.f;
#pragma unroll
                    for (int i = 0; i < 4; ++i) { const u32x4 g0 = *(const LAS u32x4*)(gfs + j * D + 1024 * i + 16 * lane), g1 = *(const LAS u32x4*)(gfs + j * D + 1024 * i + 16 * lane + 8);
#pragma unroll
                        for (int q = 0; q < 4; ++q) { s += ACC(i, 2 * q) * bf_lo(g0[q]) + ACC(i, 2 * q + 1) * bf_hi(g0[q]); s += ACC(i, 8 + 2 * q) * bf_lo(g1[q]) + ACC(i, 8 + 2 * q + 1) * bf_hi(g1[q]); } }
                    s = wave_sum_dpp(s); if (lane == j) mine = s; }
                if (lane < 10) { const int b_ = tok >> 11, s_ = tok & 2047; LOGFn[(size_t)(b_ * 10 + lane) * S + s_] = logsig(mine * rs + bf_n[lane]); }
            }
            if (FINAL) { float* xo = (float*)XOv + (size_t)tok * D;
#pragma unroll
                for (int i = 0; i < 4; ++i)
#pragma unroll
                    for (int q = 0; q < 4; ++q) { const int c = 1024 * i + 16 * lane + 4 * q; const f32x4 g_ = *(const f32x4*)(fg + c);
                        *(f32x4*)(xo + c) = (f32x4){ACC(i, 4 * q) * rs * g_[0], ACC(i, 4 * q + 1) * rs * g_[1], ACC(i, 4 * q + 2) * rs * g_[2], ACC(i, 4 * q + 3) * rs * g_[3]}; }
            } else { bf16_t* xo = (bf16_t*)XOv + (size_t)tok * D;
#pragma unroll
                for (int i = 0; i < 4; ++i) { u32x4 w0, w1;
#pragma unroll
                    for (int q = 0; q < 4; ++q) { w0[q] = pk2(ACC(i, 2 * q), ACC(i, 2 * q + 1)); w1[q] = pk2(ACC(i, 8 + 2 * q), ACC(i, 8 + 2 * q + 1)); }
                    *(u32x4*)(xo + 1024 * i + 16 * lane) = w0; *(u32x4*)(xo + 1024 * i + 16 * lane + 8) = w1; }
            }
        }
        LDS_WAIT(); asm volatile("" ::: "memory");
    }
#undef ACC
#undef LOADROW6
#undef GRP6
}
}
namespace at {
using namespace mk;
constexpr int QB = 256, KVB = 64, HD = 128;
constexpr int SHM_V = KVB * HD * 2, SHM_K = KVB * HD * 2;
constexpr int OFF_V = 0, OFF_K = 2 * SHM_V, OFF_WS = OFF_K + 2 * SHM_K, OFF_CUM = OFF_WS + 8 * 256, OFF_RT = OFF_CUM + 2048 * 4, OFF_MISC = OFF_RT + 640 * 4;
constexpr float LOG2E = 1.4426950408889634f;
constexpr float THR2 = 10.0f;
constexpr float SB_DONE = -100.0f;

#define AT_KSWZ(row, colB) ((row) * 256 + ((colB) ^ (((row) & 7) << 4)))
__device__ __forceinline__ int v_st(int k, int c) { const int kk = (k & ~0xC) | ((k & 4) << 1) | ((k & 8) >> 1); return ((kk >> 3) * 4 + (c >> 5)) * 512 + ((kk & 7) * 32 + (c & 31)) * 2; }
__device__ __forceinline__ int v_rd_base(int lane) { return ((lane & 3) << 3) | (((lane >> 2) & 3) << 6) | (((lane >> 4) & 1) << 5) | (((lane >> 5) & 1) << 8); }
constexpr int v_rd_off(int d0, int ks, int half) { return d0 * 512 + ks * 4096 + half * 2048; }
__device__ __forceinline__ int crow(int r, int hi) { return (r & 3) + 8 * (r >> 2) + 4 * hi; }
__device__ __forceinline__ unsigned cvtpk(float lo, float hi) { unsigned r; asm volatile("v_cvt_pk_bf16_f32 %0, %1, %2" : "=v"(r) : "v"(lo), "v"(hi)); return r; }
__device__ __forceinline__ float partner(float v, int hi) { auto rr = __builtin_amdgcn_permlane32_swap(__builtin_bit_cast(unsigned, v), __builtin_bit_cast(unsigned, v), false, false); return __builtin_bit_cast(float, hi ? rr[0] : rr[1]); }

__device__ __forceinline__ float xchg_max(float v, int hi) { return fmaxf(v, partner(v, hi)); }
__device__ __forceinline__ float xchg_sum(float v, int hi) { return v + partner(v, hi); }

__device__ __forceinline__ void pack_p(const f32x16& p0, const f32x16& p1, bf16x8& pa0, bf16x8& pa1, bf16x8& pa2, bf16x8& pa3) {
#define AT_PK4(P, B_, OUT) do { unsigned a0 = cvtpk(P[B_ + 0], P[B_ + 1]), a1 = cvtpk(P[B_ + 2], P[B_ + 3]); unsigned b0 = cvtpk(P[B_ + 4], P[B_ + 5]), b1 = cvtpk(P[B_ + 6], P[B_ + 7]); \
        auto r0 = __builtin_amdgcn_permlane32_swap(a0, b0, false, false); auto r1 = __builtin_amdgcn_permlane32_swap(a1, b1, false, false); \
        u32x4 w = {r0[0], r1[0], r0[1], r1[1]}; OUT = __builtin_bit_cast(bf16x8, w); } while (0)
    AT_PK4(p0, 0, pa0); AT_PK4(p0, 8, pa1); AT_PK4(p1, 0, pa2); AT_PK4(p1, 8, pa3);
#undef AT_PK4
}
template <int KBUF>
__device__ __forceinline__ void qkt(f32x16& p0, f32x16& p1, LAS unsigned char* K_lds, int r32, int hi, const bf16x8 (&qr)[8]) {
    p0 = f32x16{}; p1 = f32x16{};
    LAS unsigned char* kb[4];
#pragma unroll
    for (int dd = 0; dd < 4; ++dd) kb[dd] = K_lds + KBUF * SHM_K + AT_KSWZ(r32, (dd * 16 + hi * 8) * 2);
#pragma unroll
    for (int d0 = 0; d0 < 8; ++d0) { LAS unsigned char* a = kb[d0 & 3] + (d0 >> 2) * 128;
        const bf16x8 b0 = *(const LAS bf16x8*)a; const bf16x8 b1 = *(const LAS bf16x8*)(a + 32 * 256);
        p0 = __builtin_amdgcn_mfma_f32_32x32x16_bf16(b0, qr[d0], p0, 0, 0, 0);
        p1 = __builtin_amdgcn_mfma_f32_32x32x16_bf16(b1, qr[d0], p1, 0, 0, 0); }
}
template <int VBUF>
__device__ __forceinline__ void pv_tile(f32x16 (&o)[4], int vb0, bf16x8 pa0, bf16x8 pa1, bf16x8 pa2, bf16x8 pa3) {
#define AT_TRRD(dst, off) asm volatile("ds_read_b64_tr_b16 %0, %1 offset:%2" : "=&v"(dst) : "v"(vb0), "i"(off) : "memory")
#define AT_PV_D0(d0) do { s16x4 l0, l1, l2, l3, h0, h1, h2, h3; constexpr int b_ = VBUF * SHM_V + v_rd_off(d0, 0, 0); \
        AT_TRRD(l0, b_); AT_TRRD(h0, b_ + 2048); AT_TRRD(l1, b_ + 4096); AT_TRRD(h1, b_ + 6144); AT_TRRD(l2, b_ + 8192); AT_TRRD(h2, b_ + 10240); AT_TRRD(l3, b_ + 12288); AT_TRRD(h3, b_ + 14336); \
        asm volatile("s_waitcnt lgkmcnt(0)" ::: "memory"); __builtin_amdgcn_sched_barrier(0); \
        o[d0] = __builtin_amdgcn_mfma_f32_32x32x16_bf16(pa0, (bf16x8){l0[0], l0[1], l0[2], l0[3], h0[0], h0[1], h0[2], h0[3]}, o[d0], 0, 0, 0); \
        o[d0] = __builtin_amdgcn_mfma_f32_32x32x16_bf16(pa1, (bf16x8){l1[0], l1[1], l1[2], l1[3], h1[0], h1[1], h1[2], h1[3]}, o[d0], 0, 0, 0); \
        o[d0] = __builtin_amdgcn_mfma_f32_32x32x16_bf16(pa2, (bf16x8){l2[0], l2[1], l2[2], l2[3], h2[0], h2[1], h2[2], h2[3]}, o[d0], 0, 0, 0); \
        o[d0] = __builtin_amdgcn_mfma_f32_32x32x16_bf16(pa3, (bf16x8){l3[0], l3[1], l3[2], l3[3], h3[0], h3[1], h3[2], h3[3]}, o[d0], 0, 0, 0); } while (0)
    AT_PV_D0(0); AT_PV_D0(1); AT_PV_D0(2); AT_PV_D0(3);
#undef AT_PV_D0
#undef AT_TRRD
}

template <int VAR>
__device__ __forceinline__ void attn_item(const bf16_t* Qh, const bf16_t* Kh, const bf16_t* Vh, bf16_t* OB, const float* relb, const float* LOGF, int b, int h, int qb, LAS unsigned char* lds, int tid) {
    const int wid = __builtin_amdgcn_readfirstlane(tid >> 6), lane = tid & 63, r32 = lane & 31, hi = lane >> 5;
    const int g = VAR == 0 ? h : (VAR == 1 ? 12 + h : 22 + h);
    const size_t hb = (size_t)(b * NH + g) * S * HD;
    const bf16_t* Kp = Kh + hb; const bf16_t* Vp = Vh + hb;
    LAS unsigned char* V_lds = lds + OFF_V; LAS unsigned char* K_lds = lds + OFF_K;
    LAS float* wsf = (LAS float*)(lds + OFF_WS) + wid * 64; LAS float* li_l = wsf; LAS float* al_l = wsf + 32;
    LAS float* cumL = (LAS float*)(lds + OFF_CUM); LAS float* Rt = (LAS float*)(lds + OFF_RT); volatile LAS unsigned* flags = (volatile LAS unsigned*)(lds + OFF_MISC);
    const int P0 = qb * QB, qlo = P0 + wid * 32, qpos = qlo + r32;
    int NT, jlo = 0;
    if (VAR == 0) { jlo = 4 * qb - 8; if (jlo < 0) jlo = 0; NT = 4 * qb + 4 - jlo; } else NT = 4 * qb + 4;
    const int cw = 4 * qb + (wid >> 1);
#define AT_KBASE(t) (VAR == 1 ? (4 * qb + 3 - (t)) * KVB : (jlo + (t)) * KVB)
#define AT_ACT(t) (VAR == 0 ? ((jlo + (t)) >= cw - 8 && (jlo + (t)) <= cw) : (VAR == 1 ? (AT_KBASE(t) <= qlo + 30) : (AT_KBASE(t) <= qlo + 31)))
    if (VAR == 0) {
        const float* tab = relb + h * 257;
        for (int j = tid; j < 639; j += 512) { int rel = 575 - j; rel = rel < -128 ? -128 : (rel > 128 ? 128 : rel); Rt[j] = tab[rel + 128] * LOG2E; }
    }
    if (VAR == 2) {
        const float* lf = LOGF + (size_t)(b * 10 + h) * S; const int kend = P0 + QB;
        f32x4 v = (f32x4){0.f, 0.f, 0.f, 0.f};
        if (4 * tid < kend) v = *(const f32x4*)(lf + 4 * tid);
        v[1] += v[0]; v[2] += v[1]; v[3] += v[2];
        float tot = v[3];
#pragma unroll
        for (int o = 1; o < 64; o <<= 1) { const float t_ = lane_read(tot, lane >= o ? lane - o : lane); if (lane >= o) tot += t_; }
        if (lane == 63) li_l[0] = tot;
        __syncthreads();
        float base = tot - v[3];
        for (int w = 0; w < wid; ++w) base += ((LAS float*)(lds + OFF_WS))[w * 64];
        if (4 * tid < kend) *(LAS f32x4*)(cumL + 4 * tid) = (f32x4){(base + v[0]) * LOG2E, (base + v[1]) * LOG2E, (base + v[2]) * LOG2E, (base + v[3]) * LOG2E};
    }
    bf16x8 qr[8];
    { const bf16_t* qp = Qh + hb + (size_t)(qlo + r32) * HD + hi * 8;
#pragma unroll
      for (int d0 = 0; d0 < 8; ++d0) qr[d0] = *(const bf16x8*)(qp + d0 * 16); }
    const int sr = tid >> 4, sc = (tid & 15) * 8, vst0 = v_st(sr, sc), vst1 = v_st(32 + sr, sc), kws = AT_KSWZ(sr, sc * 2);
    const int vb0 = (int)(unsigned)(size_t)V_lds + v_rd_base(lane);
    bf16x8 st_k0, st_k1, st_v0, st_v1;
#define AT_SLOAD(k0) do { const bf16_t* kp_ = Kp + (size_t)((k0) + sr) * HD + sc; const bf16_t* vp_ = Vp + (size_t)((k0) + sr) * HD + sc; \
        st_k0 = *(const bf16x8*)kp_; st_k1 = *(const bf16x8*)(kp_ + 32 * HD); st_v0 = *(const bf16x8*)vp_; st_v1 = *(const bf16x8*)(vp_ + 32 * HD); } while (0)
#define AT_SWRITE(bf) do { *(LAS bf16x8*)(K_lds + (bf) * SHM_K + kws) = st_k0; *(LAS bf16x8*)(K_lds + (bf) * SHM_K + kws + 32 * 256) = st_k1; \
        *(LAS bf16x8*)(V_lds + (bf) * SHM_V + vst0) = st_v0; *(LAS bf16x8*)(V_lds + (bf) * SHM_V + vst1) = st_v1; } while (0)
    AT_SLOAD(AT_KBASE(0)); asm volatile("s_waitcnt vmcnt(0)" ::: "memory"); AT_SWRITE(0);
    __syncthreads();
    float m_reg = -1e30f, l_reg = 0.f, carry = 0.f;
    f32x16 o[4] = {};
#define AT_STEP(BUF, t) do { \
        const bool more_ = (t) + 1 < NT; \
        if (more_) AT_SLOAD(AT_KBASE((t) + 1)); \
        if (AT_ACT(t)) { \
            const int kb_ = AT_KBASE(t); f32x16 p0, p1; bf16x8 pa0, pa1, pa2, pa3; \
            qkt<BUF>(p0, p1, K_lds, r32, hi, qr); \
            tile_math(p0, p1, kb_, pa0, pa1, pa2, pa3); \
            pv_tile<BUF>(o, vb0, pa0, pa1, pa2, pa3); \
        } \
        if (more_) { asm volatile("s_waitcnt vmcnt(0)" ::: "memory"); AT_SWRITE((BUF) ^ 1); } \
        if (VAR == 1) { const bool done_ = __all(carry < SB_DONE); if (lane == 0) flags[((t) & 1) * 8 + wid] = done_ ? 1u : 0u; } \
        __syncthreads(); \
    } while (0)
    auto tile_math = [&](f32x16& p0, f32x16& p1, int kb, bf16x8& pa0, bf16x8& pa1, bf16x8& pa2, bf16x8& pa3) __attribute__((always_inline)) {
        const int dq = qpos - kb - 4 * hi;
        if (VAR == 1) {
            const bool need_mask = kb + 63 >= qlo;
            f32x16 n0, n1;
#pragma unroll
            for (int r = 0; r < 16; ++r) { const float z = p0[r]; const float lp = __builtin_amdgcn_logf(1.0f + __builtin_amdgcn_exp2f(-fabsf(z))); n0[r] = fminf(-z, 0.f) - lp;
                                           const float y = p1[r]; const float lq = __builtin_amdgcn_logf(1.0f + __builtin_amdgcn_exp2f(-fabsf(y))); n1[r] = fminf(-y, 0.f) - lq; }
            if (need_mask) {
#pragma unroll
                for (int r = 0; r < 16; ++r) { const int c = (r & 3) + 8 * (r >> 2);
                    if (dq - c <= 0) { n0[r] = 0.f; p0[r] = -__builtin_inff(); }
                    if (dq - c - 32 <= 0) { n1[r] = 0.f; p1[r] = -__builtin_inff(); } }
            }
            float A[8], Bp[8];
#pragma unroll
            for (int q = 0; q < 4; ++q) { A[q] = (n0[4 * q] + n0[4 * q + 1]) + (n0[4 * q + 2] + n0[4 * q + 3]); A[4 + q] = (n1[4 * q] + n1[4 * q + 1]) + (n1[4 * q + 2] + n1[4 * q + 3]); }
#pragma unroll
            for (int q = 0; q < 8; ++q) Bp[q] = partner(A[q], hi);
            float st = 0.f;
#pragma unroll
            for (int q = 7; q >= 0; --q) {
                const float after = carry + st + (hi == 0 ? Bp[q] : 0.f);
                if (q >= 4) { const int r0 = 4 * (q - 4);
                    float tl = after; p1[r0 + 3] = __builtin_amdgcn_exp2f(p1[r0 + 3] + n1[r0 + 3] + tl); tl += n1[r0 + 3]; p1[r0 + 2] = __builtin_amdgcn_exp2f(p1[r0 + 2] + n1[r0 + 2] + tl); tl += n1[r0 + 2];
                    p1[r0 + 1] = __builtin_amdgcn_exp2f(p1[r0 + 1] + n1[r0 + 1] + tl); tl += n1[r0 + 1]; p1[r0] = __builtin_amdgcn_exp2f(p1[r0] + n1[r0] + tl); }
                else { const int r0 = 4 * q;
                    float tl = after; p0[r0 + 3] = __builtin_amdgcn_exp2f(p0[r0 + 3] + n0[r0 + 3] + tl); tl += n0[r0 + 3]; p0[r0 + 2] = __builtin_amdgcn_exp2f(p0[r0 + 2] + n0[r0 + 2] + tl); tl += n0[r0 + 2];
                    p0[r0 + 1] = __builtin_amdgcn_exp2f(p0[r0 + 1] + n0[r0 + 1] + tl); tl += n0[r0 + 1]; p0[r0] = __builtin_amdgcn_exp2f(p0[r0] + n0[r0] + tl); }
                st += A[q] + Bp[q];
            }
            carry += st;
            pack_p(p0, p1, pa0, pa1, pa2, pa3);
        } else {
            if (VAR == 0) {
                const LAS float* rp = Rt + (575 - (qpos - kb) + 4 * hi);
#pragma unroll
                for (int r = 0; r < 16; ++r) { const int c = (r & 3) + 8 * (r >> 2); p0[r] += rp[c]; p1[r] += rp[c + 32]; }
            } else {
                const LAS float* cp = cumL + kb + 4 * hi;
#pragma unroll
                for (int q = 0; q < 4; ++q) { const f32x4 c0 = *(const LAS f32x4*)(cp + 8 * q), c1 = *(const LAS f32x4*)(cp + 32 + 8 * q);
                    p0[4 * q] -= c0[0]; p0[4 * q + 1] -= c0[1]; p0[4 * q + 2] -= c0[2]; p0[4 * q + 3] -= c0[3];
                    p1[4 * q] -= c1[0]; p1[4 * q + 1] -= c1[1]; p1[4 * q + 2] -= c1[2]; p1[4 * q + 3] -= c1[3]; }
                if (kb + 63 > qlo) {
#pragma unroll
                    for (int r = 0; r < 16; ++r) { const int c = (r & 3) + 8 * (r >> 2);
                        if (dq - c < 0) p0[r] = -__builtin_inff();
                        if (dq - c - 32 < 0) p1[r] = -__builtin_inff(); }
                }
            }
            float pmax = p0[0];
#pragma unroll
            for (int r = 1; r < 16; ++r) pmax = fmaxf(pmax, p0[r]);
#pragma unroll
            for (int r = 0; r < 16; ++r) pmax = fmaxf(pmax, p1[r]);
            pmax = xchg_max(pmax, hi);
            float mn, alpha;
            if (__all(pmax - m_reg <= THR2)) { mn = m_reg; alpha = 1.f; }
            else { mn = fmaxf(m_reg, pmax); alpha = __builtin_amdgcn_exp2f(m_reg - mn); m_reg = mn; }
            float ps = 0.f;
#pragma unroll
            for (int r = 0; r < 16; ++r) { p0[r] = __builtin_amdgcn_exp2f(p0[r] - mn); p1[r] = __builtin_amdgcn_exp2f(p1[r] - mn); ps += p0[r] + p1[r]; }
            ps = xchg_sum(ps, hi);
            l_reg = l_reg * alpha + ps;
            if (__any(alpha < 1.f)) {
                if (hi == 0) al_l[r32] = alpha;
                asm volatile("s_waitcnt lgkmcnt(0)" ::: "memory");
                float av[16];
#pragma unroll
                for (int r = 0; r < 16; ++r) av[r] = al_l[crow(r, hi)];
#pragma unroll
                for (int d = 0; d < 4; ++d)
#pragma unroll
                    for (int r = 0; r < 16; ++r) o[d][r] *= av[r];
            }
            pack_p(p0, p1, pa0, pa1, pa2, pa3);
        }
    };
    for (int t = 0; t < NT; t += 2) {
        AT_STEP(0, t);
        if (VAR == 1) { unsigned all_ = 1u; for (int w = 0; w < 8; ++w) all_ &= flags[(t & 1) * 8 + w]; if (all_) break; }
        if (t + 1 >= NT) break;
        AT_STEP(1, t + 1);
        if (VAR == 1) { unsigned all_ = 1u; for (int w = 0; w < 8; ++w) all_ &= flags[((t + 1) & 1) * 8 + w]; if (all_) break; }
    }
    float rli[16];
    if (VAR != 1) {
        if (hi == 0) li_l[r32] = l_reg;
        asm volatile("s_waitcnt lgkmcnt(0)" ::: "memory");
#pragma unroll
        for (int r = 0; r < 16; ++r) rli[r] = __builtin_amdgcn_rcpf(li_l[crow(r, hi)]);
    }
    unsigned char* Ow8 = (unsigned char*)OB + (size_t)(b * S + qlo) * D + g * HD;
#pragma unroll
    for (int r = 0; r < 16; ++r) { const int orow = crow(r, hi);
#pragma unroll
        for (int d0 = 0; d0 < 4; ++d0) { const float v = VAR != 1 ? o[d0][r] * rli[r] : o[d0][r];
            const float vn = lane_read(v, lane ^ 1);
            if ((r32 & 1) == 0) *(unsigned short*)(Ow8 + (size_t)orow * D + d0 * 32 + r32) = (unsigned short)__builtin_amdgcn_cvt_pk_fp8_f32(clamp8(v * 16.0f), clamp8(vn * 16.0f), 0, false); } }
    __syncthreads();
#undef AT_STEP
#undef AT_SLOAD
#undef AT_SWRITE
#undef AT_KBASE
#undef AT_ACT
}

template <int VAR>
__device__ __forceinline__ void attn_queue(const bf16_t* Qh, const bf16_t* Kh, const bf16_t* Vh, bf16_t* OB, const float* relb, const float* LOGF, unsigned* qhead, LAS unsigned char* lds, int wave0) {
    FRESH_TID(); FRESH_LDS(lds);
    volatile LAS unsigned* qslot = (volatile LAS unsigned*)(lds + OFF_MISC) + 32;
    constexpr int NHV = VAR == 0 ? 12 : 10, NITEMS = 8 * NHV * 8;
    for (;;) {
        if (tid == 0) qslot[0] = __hip_atomic_fetch_add(qhead, 1u, __ATOMIC_RELAXED, __HIP_MEMORY_SCOPE_AGENT);
        __syncthreads();
        const int idx = (int)qslot[0];
        __syncthreads();
        if (idx >= NITEMS) break;
        const int qb = 7 - idx / (8 * NHV), bh = idx % (8 * NHV);
        attn_item<VAR>(Qh, Kh, Vh, OB, relb, LOGF, bh / NHV, bh % NHV, qb, lds, tid);
    }
}
__device__ __forceinline__ void attn_phase(const bf16_t* Qh, const bf16_t* Kh, const bf16_t* Vh, bf16_t* OB, const float* relb, const float* LOGF, unsigned* qheads, LAS unsigned char* lds, int wave0) {
    attn_queue<2>(Qh, Kh, Vh, OB, relb, LOGF, qheads + 0, lds, wave0);
    attn_queue<0>(Qh, Kh, Vh, OB, relb, LOGF, qheads + 64, lds, wave0);
    attn_queue<1>(Qh, Kh, Vh, OB, relb, LOGF, qheads + 128, lds, wave0);
}
}
namespace mk {
#define XB_TMO      128
#define XB_XCNT(j)  (256  + 64 * (j))
#define XB_XSUB(j)  (1280 + 64 * (j))
#define XB_XGEN(j)  (2304 + 64 * (j))
#define XB_TOP      3328
#define XB_TOPGEN   3392
#define XCD_BAR_WORDS 3456
#define XB_SPIN_CAP (1u << 22)

__device__ __forceinline__ unsigned xb_ld(unsigned* p)              { return __hip_atomic_load(p, __ATOMIC_RELAXED, __HIP_MEMORY_SCOPE_AGENT); }
__device__ __forceinline__ unsigned xb_add(unsigned* p, unsigned v) { return __hip_atomic_fetch_add(p, v, __ATOMIC_RELAXED, __HIP_MEMORY_SCOPE_AGENT); }
__device__ __forceinline__ unsigned xb_xcc_id() { return (unsigned)__builtin_amdgcn_s_getreg((3 << 11) | 20) & 0xFu; }
#define XB_SPIN(cond, bar) do { unsigned _sp = 0; while (cond) { __builtin_amdgcn_s_sleep(1); \
    if ((++_sp & 255u) == 0u) { if (xb_ld(&(bar)[XB_TMO])) break; if (_sp > XB_SPIN_CAP) { atomicAdd(&(bar)[XB_TMO], 1u); break; } } } } while (0)

struct XcdBarrier {
    unsigned* bar; unsigned x;
    volatile LAS unsigned* st;
};

__device__ __forceinline__ XcdBarrier xcd_barrier_post(unsigned* bar, volatile LAS unsigned* st, bool is_t0) {
    XcdBarrier b; b.bar = bar; b.x = xb_xcc_id(); b.st = st;
    if (is_t0) (void)xb_add(&bar[XB_XCNT(b.x)], 1u);
    return b;
}
__device__ __forceinline__ void xcd_barrier_complete(unsigned* bar, unsigned x, unsigned& nloc, unsigned& nx) {
    const unsigned G = gridDim.x * gridDim.y * gridDim.z;
    unsigned sum, cnt, mine, sp = 0u;
    for (;;) {
        sum = 0u; cnt = 0u; mine = 0u;
#pragma unroll
        for (unsigned j = 0; j < 16; ++j) { const unsigned c = xb_ld(&bar[XB_XCNT(j)]); sum += c; cnt += (c > 0u) ? 1u : 0u; mine = (j == x) ? c : mine; }
        if (sum == G) break;
        __builtin_amdgcn_s_sleep(1);
        if ((++sp & 255u) == 0u) { if (xb_ld(&bar[XB_TMO])) break; if (sp > XB_SPIN_CAP) { atomicAdd(&bar[XB_TMO], 1u); break; } }
    }
    nloc = mine > 0u ? mine : 1u; nx = cnt > 0u ? cnt : 1u;
}

__device__ __forceinline__ void xcd_barrier(const XcdBarrier& b, bool is_t0) {
    asm volatile("s_waitcnt vmcnt(0)" ::: "memory");
    __syncthreads();
    if (is_t0) {
        unsigned* bar = b.bar;
        __builtin_amdgcn_s_waitcnt(0);
        unsigned nloc = b.st[0], nx = b.st[1];
        if (nloc == 0u) { xcd_barrier_complete(bar, b.x, nloc, nx); b.st[0] = nloc; b.st[1] = nx; }
        const unsigned old = xb_add(&bar[XB_XSUB(b.x)], 1u);
        const unsigned gen = old / nloc;
        if (old + 1u == (gen + 1u) * nloc) {
            __builtin_amdgcn_fence(__ATOMIC_RELEASE, "agent");
            asm volatile("s_waitcnt vmcnt(0)" ::: "memory");
            const unsigned og = xb_add(&bar[XB_TOP], 1u);
            const unsigned tg = og / nx;
            if (og + 1u == (tg + 1u) * nx) xb_add(&bar[XB_TOPGEN], 1u);
            else XB_SPIN(xb_ld(&bar[XB_TOPGEN]) == tg, bar);
            __builtin_amdgcn_fence(__ATOMIC_ACQUIRE, "agent");
            xb_add(&bar[XB_XGEN(b.x)], 1u);
            asm volatile("s_waitcnt vmcnt(0)" ::: "memory");
        } else {
            XB_SPIN(xb_ld(&bar[XB_XGEN(b.x)]) == gen, bar);
            __builtin_amdgcn_fence(__ATOMIC_ACQUIRE, "agent");
            asm volatile("s_waitcnt vmcnt(0)" ::: "memory");
        }
    }
    __syncthreads();
}

constexpr int PH_PER_LAYER = 8;
typedef const __attribute__((address_space(4))) Args* KArgs;
#define KARGS() ({ KArgs p_ = (KArgs)__builtin_amdgcn_kernarg_segment_ptr(); asm volatile("" : "+s"(p_)); p_; })
#define GRID_BAR() do { KArgs k_ = KARGS(); XcdBarrier b_; b_.bar = (unsigned*)(k_->ws + WS_CTL) + CW_BAR; b_.x = xb_xcc_id(); b_.st = (volatile LAS unsigned*)(lds + MISC_OFF) + 8; unsigned z_ = 0u; asm volatile("" : "+v"(z_)); const bool t0_ = (wave0 == 0) && (__builtin_amdgcn_mbcnt_hi(~0u, __builtin_amdgcn_mbcnt_lo(~0u, z_)) == 0u);     xcd_barrier(b_, t0_); } while (0)
__global__ void __launch_bounds__(NWAVES * 64, 2) mk_fwd(Args a_unused) {
    extern __shared__ __attribute__((aligned(16))) unsigned char lds_raw[];
    LAS unsigned char* lds = (LAS unsigned char*)lds_raw;
    const int wave0 = __builtin_amdgcn_readfirstlane((int)threadIdx.x >> 6);
    for (int u = threadIdx.x; u < (LDS_BYTES - LDSCTL_OFF) / 4; u += NWAVES * 64) ((LAS unsigned*)(lds + LDSCTL_OFF))[u] = 0u;
    __syncthreads();
    int lo, hi;
    { KArgs k = KARGS(); lo = k->ph_lo; hi = k->ph_hi;
      if (hi - lo > 1) (void)xcd_barrier_post((unsigned*)(k->ws + WS_CTL) + CW_BAR, (volatile LAS unsigned*)(lds + MISC_OFF) + 8, threadIdx.x == 0); }
#define IN(k) (lo <= (k) && (k) < hi)
#define BOTH(k) (IN(k) && IN((k) + 1))
#pragma unroll
    for (int l = 0; l < 2; ++l) {
        const int pb = PH_PER_LAYER * l;
        if (IN(pb + 0)) { KArgs k = KARGS(); conv_phase(k, l, lds, wave0); }
        if (IN(pb + 1) && l == 0) {
            KArgs k = KARGS(); unsigned char* ws = k->ws;
            const float* xin = k->in[0];
            prep_phase<true>(xin, (bf16_t*)(ws + WS_XB8N), (float*)(ws + WS_RSTD), k->in[2] + (size_t)l * D * PW, k->in[1] + (size_t)l * D, k->in[3] + l * 10, (float*)(ws + WS_LOGF), lds, wave0);
            if (BOTH(pb + 1)) GRID_BAR();
        }
        if (l == 1 && IN(pb + 0) && IN(pb + 2)) GRID_BAR();
        if (IN(pb + 2)) {
            KArgs k = KARGS(); unsigned char* ws = k->ws;
            pg8::Gemm g{(const bf16_t*)(ws + WS_XB8N), (const bf16_t*)(ws + WS_WIN), M, 12288, D}; pg8::StaticOrder So; FRESH_BID(); So.init(M, 12288, G, bid);
            pg8::EpiQKV4 E{(bf16_t*)(ws + WS_Q), (const float*)(ws + WS_RSTD), 0.08838834764831845f * 1.4426950408889634f, US_INV};
            { LAS unsigned char* lds_ = lds; FRESH_LDS(lds_); FRESH_TID(); pg8::gemm_phase<pg8::EpiQKV4, pg8::StaticOrder, true, true, true>(lds_, g, So, E, tid); }
            if (BOTH(pb + 2)) GRID_BAR();
        }
        if (IN(pb + 3)) {
            KArgs k = KARGS(); unsigned char* ws = k->ws;
            at::attn_phase((const bf16_t*)(ws + WS_Q), (const bf16_t*)(ws + WS_K), (const bf16_t*)(ws + WS_V), (bf16_t*)(ws + WS_OB), k->in[4] + (size_t)l * 12 * 257, (const float*)(ws + WS_LOGF),
                           (unsigned*)(ws + WS_CTL) + CW_QUEUE + 256 * l, lds, wave0);
            if (BOTH(pb + 3)) GRID_BAR();
        }
        if (IN(pb + 4)) {
            KArgs k = KARGS(); unsigned char* ws = k->ws;
            pg8::Gemm g{(const bf16_t*)(ws + WS_OB), (const bf16_t*)(ws + WS_WOUT), M, D, D}; pg8::StaticOrder So; FRESH_BID(); So.init(M, D, G, bid);
            if (l == 0) { pg8::EpiResidB16<true> E{k->in[0], US_INV * (1.0f / 16.0f), (bf16_t*)(ws + WS_XB)};
                { LAS unsigned char* lds_ = lds; FRESH_LDS(lds_); FRESH_TID(); pg8::gemm_phase<pg8::EpiResidB16<true>, pg8::StaticOrder, false, true, true>(lds_, g, So, E, tid); } }
            else { pg8::EpiResidB16<false> E{ws + WS_X2, US_INV * (1.0f / 16.0f), (bf16_t*)(ws + WS_XB)};
                { LAS unsigned char* lds_ = lds; FRESH_LDS(lds_); FRESH_TID(); pg8::gemm_phase<pg8::EpiResidB16<false>, pg8::StaticOrder, false, true, true>(lds_, g, So, E, tid); } }
            if (BOTH(pb + 4)) GRID_BAR();
        }
        if (IN(pb + 5)) {
            KArgs k = KARGS(); unsigned char* ws = k->ws;
            pg8::Gemm g{(const bf16_t*)(ws + WS_XB), (const bf16_t*)(ws + WS_WQK), M, 2048, D}; pg8::StaticOrder So; FRESH_BID(); So.init(M, 2048, G, bid);
            pg8::EpiPlainF32<2048> E{(float*)(ws + WS_SC)};
            { LAS unsigned char* lds_ = lds; FRESH_LDS(lds_); FRESH_TID(); pg8::gemm_phase<pg8::EpiPlainF32<2048>, pg8::StaticOrder, true, true>(lds_, g, So, E, tid); }
            if (BOTH(pb + 5)) GRID_BAR();
        }
        if (IN(pb + 6)) {
            KArgs k = KARGS(); unsigned char* ws = k->ws;
            peer_u_phase((const float*)(ws + WS_SC), (const unsigned char*)(ws + WS_U16), (const bf16_t*)(ws + WS_XB), (int*)(ws + WS_K), (float*)(ws + WS_K + 8 * MiB), lds, wave0);
            if (BOTH(pb + 6)) GRID_BAR();
        }
        if (IN(pb + 7)) {
            KArgs k = KARGS(); unsigned char* ws = k->ws;
            if (l == 0) peer_v_phase<false>((const int*)(ws + WS_K), (const float*)(ws + WS_K + 8 * MiB), (const unsigned char*)(ws + WS_U16) + (size_t)NE * ROW6, (const bf16_t*)(ws + WS_XB), ws + WS_X2, nullptr,
                                            ws + WS_XB8N, (float*)(ws + WS_RSTD), (float*)(ws + WS_LOGF), k->in[2] + (size_t)D * PW, k->in[1] + D, k->in[3] + 10, lds, wave0);
            else peer_v_phase<true>((const int*)(ws + WS_K), (const float*)(ws + WS_K + 8 * MiB), (const unsigned char*)(ws + WS_U16) + (size_t)NE * ROW6, (const bf16_t*)(ws + WS_XB), k->out, k->in[12],
                                    nullptr, nullptr, nullptr, nullptr, nullptr, nullptr, lds, wave0);
            if (BOTH(pb + 7)) GRID_BAR();
        }
    }
#undef IN
#undef BOTH
}

static int g_grid = 0;
static void launch_phases(Args a, int lo, int hi, hipStream_t st) {
    a.ph_lo = lo; a.ph_hi = hi;
    hipLaunchKernelGGL(mk_fwd, dim3(g_grid), dim3(NWAVES * 64), LDS_BYTES, st, a);
}
}

extern "C" void kernel_launch(void* const* d_in, const int* in_sizes, int n_in, void* d_out, int out_size, void* d_ws, size_t ws_size, hipStream_t stream) {
    (void)in_sizes; (void)n_in; (void)out_size;
    using namespace mk;
    if (g_grid == 0) {
        if (ws_size < 2048 * MiB) { fprintf(stderr, "kernel_launch: workspace too small (%zu)\n", ws_size); g_grid = -1; return; }
        if (hipFuncSetAttribute((const void*)mk_fwd, hipFuncAttributeMaxDynamicSharedMemorySize, LDS_BYTES) != hipSuccess) { fprintf(stderr, "kernel_launch: hipFuncSetAttribute failed\n"); g_grid = -1; return; }
        int dev = 0, cus = 0; (void)hipGetDevice(&dev); (void)hipDeviceGetAttribute(&cus, hipDeviceAttributeMultiprocessorCount, dev);
        g_grid = cus > 0 ? cus : 256;
    }
    if (g_grid < 0) return;
    unsigned char* ws = (unsigned char*)d_ws; float* out = (float*)d_out;
    (void)hipMemsetAsync(ws + WS_CTL, 0, CTL_ZERO_BYTES, stream);
    Args a{};
    for (int i = 0; i < 13; ++i) a.in[i] = (const float*)d_in[i];
    a.out = out; a.ws = ws;
    launch_phases(a, 0, 2 * PH_PER_LAYER, stream);
}
```

```cpp
#include <hip/hip_runtime.h>
#include <cstdio>
#include <cstdint>
namespace pg8 {
#define PG8_LAS __attribute__((address_space(3)))
typedef unsigned short bf16_t;
typedef short bf16x8 __attribute__((ext_vector_type(8)));
typedef float f32x4 __attribute__((ext_vector_type(4)));
typedef unsigned u32x4 __attribute__((ext_vector_type(4)));
typedef unsigned u32x2 __attribute__((ext_vector_type(2)));
constexpr int BM = 256, BK = 64, HALF = 128, HTB = HALF * BK * 2  , STAGE_BYTES = 8 * HTB, NXCD = 8, WGM = 8;

__host__ __device__ __forceinline__ int lds_byte(int r, int c) { const int st = (r >> 4) * 2 + (c >> 5), rr = r & 15, cc = c & 31, ob = rr * 64 + cc * 2; return st * 1024 + (ob ^ (((ob >> 9) & 1) << 5)); }
__host__ __device__ __forceinline__ void stage_rc(int b, int& R, int& C) { const int st = b / 1024, sb = b % 1024, swz = sb ^ (((sb >> 9) & 1) << 5); R = (st >> 1) * 16 + swz / 64; C = (st & 1) * 32 + (swz % 64) / 2; }
__host__ __device__ __forceinline__ int perm32(int rho) { const int n = rho >> 4, i = rho & 15; return 8 * (i >> 2) + 4 * n + (i & 3); }

struct Unit { int pm, pn; };
struct Gemm { const bf16_t* A; const bf16_t* Bt; int M, N, K; };

struct StaticOrder {
    int nM, nN, nwg, G, c;
    __host__ __device__ void init(int M, int N, int G_, int c_) { nM = M / BM; nN = N / BM; nwg = nM * nN; G = G_; c = c_; }
    __host__ __device__ bool next(int i, Unit& u) const {
        const long L = (long)i * G + c; if (L >= nwg) return false;
        int wgid = (int)L; { const int q = nwg / NXCD, r = nwg % NXCD, xcd = wgid % NXCD, off = wgid / NXCD; wgid = (xcd < r ? xcd * (q + 1) : r * (q + 1) + (xcd - r) * q) + off; }
        const int nig = WGM * nN, gid = wgid / nig, fm = gid * WGM, gsz = (nM - fm) < WGM ? (nM - fm) : WGM;
        u.pm = fm + ((wgid % nig) % gsz); u.pn = (wgid % nig) / gsz; return true;
    }
    __device__ __forceinline__ void a_ready(const Unit&) const {}
    __device__ __forceinline__ void done(const Unit&) const {}
};
__device__ __forceinline__ unsigned cvt_pk_bf16(float lo, float hi) { unsigned r; asm volatile("v_cvt_pk_bf16_f32 %0, %1, %2" : "=v"(r) : "v"(lo), "v"(hi)); return r; }
typedef float f32x2 __attribute__((ext_vector_type(2)));
__device__ __forceinline__ f32x2 gelu_pk(f32x2 v) {
    const f32x2 av = __builtin_elementwise_abs(v), d = av * 0.2316418882f + 1.0f;
    f32x2 t; t.x = __builtin_amdgcn_rcpf(d.x); t.y = __builtin_amdgcn_rcpf(d.y);
    f32x2 q = t * 0.5307027145f + (-0.7265760135f); q = q * t + 0.7107068705f; q = q * t + (-0.142248368f); q = q * t + 0.127414796f; q = q * t;
    const f32x2 s = (v * v) * (-0.72134752044f);
    f32x2 e; e.x = __builtin_amdgcn_exp2f(s.x); e.y = __builtin_amdgcn_exp2f(s.y);
    const f32x2 m = v * (q * e), r = v - m;
    f32x2 o; o.x = v.x < 0.f ? m.x : r.x; o.y = v.y < 0.f ? m.y : r.y; return o;
}
#define EPI_FRESH_LANE() { unsigned z_ = 0u; asm volatile("" : "+v"(z_)); const int l_ = (int)__builtin_amdgcn_mbcnt_hi(~0u, __builtin_amdgcn_mbcnt_lo(~0u, z_)); fr = l_ & 15; fq = l_ >> 4; }
typedef __amdgpu_buffer_rsrc_t rsrc_t;
__device__ __forceinline__ rsrc_t mkrsrc(const void* p, unsigned bytes) { return __builtin_amdgcn_make_buffer_rsrc((void*)p, (short)0, (int)bytes, 0x00020000); }
template <int LDC> struct EpiPlainF32 {
    static constexpr bool PERM = false, AFTER_DRAIN = false;
    float* C;
    __device__ __forceinline__ void operator()(const f32x4 (&acc)[2][2][4][2], const Unit& u, int wr, int wc, int fr, int fq) const {
        EPI_FRESH_LANE();
        const rsrc_t rc = mkrsrc(C, 16384u * LDC * 4u);
        const int vo = ((wr * 64 + fr) * LDC + wc * 32 + 4 * fq) * 4, so = (u.pm * BM * LDC + u.pn * BM) * 4;
#pragma unroll
        for (int ai = 0; ai < 2; ++ai)
#pragma unroll
            for (int m = 0; m < 4; ++m)
#pragma unroll
                for (int bj = 0; bj < 2; ++bj)
#pragma unroll
                    for (int n = 0; n < 2; ++n) __builtin_amdgcn_raw_buffer_store_b128(__builtin_bit_cast(u32x4, acc[ai][bj][m][n]), rc, vo, so + ((ai * HALF + m * 16) * LDC + bj * HALF + n * 16) * 4, 0);
    }
};
template <int LDC> struct EpiRowScaleF32 {
    static constexpr bool PERM = false, AFTER_DRAIN = false;
    float* C; const float* rs;
    __device__ __forceinline__ void operator()(const f32x4 (&acc)[2][2][4][2], const Unit& u, int wr, int wc, int fr, int fq) const {
        const rsrc_t rc = mkrsrc(C, 16384u * LDC * 4u), rr = mkrsrc(rs, 16384u * 4u);
        const int vo = ((wr * 64 + fr) * LDC + wc * 32 + 4 * fq) * 4, vr = (wr * 64 + fr) * 4;
        const int so = (u.pm * BM * LDC + u.pn * BM) * 4, sr = u.pm * BM * 4;
#pragma unroll
        for (int ai = 0; ai < 2; ++ai)
#pragma unroll
            for (int m = 0; m < 4; ++m) { const float s = __builtin_bit_cast(float, __builtin_amdgcn_raw_buffer_load_b32(rr, vr, sr + (ai * HALF + m * 16) * 4, 0));
#pragma unroll
                for (int bj = 0; bj < 2; ++bj)
#pragma unroll
                    for (int n = 0; n < 2; ++n) { const f32x4 v = acc[ai][bj][m][n] * s; __builtin_amdgcn_raw_buffer_store_b128(__builtin_bit_cast(u32x4, v), rc, vo, so + ((ai * HALF + m * 16) * LDC + bj * HALF + n * 16) * 4, 0); } }
    }
};
template <bool BASE_F32> struct EpiResidB16 {
    static constexpr bool PERM = false, AFTER_DRAIN = false;
    const void* base; float ascale; bf16_t* xb;
    __device__ __forceinline__ void operator()(const f32x4 (&acc)[2][2][4][2], const Unit& u, int wr, int wc, int fr, int fq) const {
        EPI_FRESH_LANE();
        constexpr int LDC = 4096;
        const rsrc_t rb = mkrsrc(base, 16384u * LDC * (BASE_F32 ? 4u : 2u)), rx = mkrsrc(xb, 16384u * LDC * 2u);
        const int vo = ((wr * 64 + fr) * LDC + wc * 32 + 4 * fq) * 2;
        const int so = (u.pm * BM * LDC + u.pn * BM) * 2;
        f32x4 ra[2][2], rb2[2][2];
#define EPI_LD(dst, g_) do { _Pragma("unroll") for (int bj = 0; bj < 2; ++bj) _Pragma("unroll") for (int n = 0; n < 2; ++n) { \
            const int o = so + ((((g_) >> 2) * HALF + ((g_) & 3) * 16) * LDC + bj * HALF + n * 16) * 2; \
            if constexpr (BASE_F32) dst[bj][n] = __builtin_bit_cast(f32x4, __builtin_amdgcn_raw_buffer_load_b128(rb, vo * 2, o * 2, 0)); \
            else { const u32x2 t_ = __builtin_amdgcn_raw_buffer_load_b64(rb, vo, o, 0); dst[bj][n] = (f32x4){__builtin_bit_cast(float, t_.x << 16), __builtin_bit_cast(float, t_.x & 0xffff0000u), __builtin_bit_cast(float, t_.y << 16), __builtin_bit_cast(float, t_.y & 0xffff0000u)}; } } } while (0)
#define EPI_ST(src, g_) do { _Pragma("unroll") for (int bj = 0; bj < 2; ++bj) _Pragma("unroll") for (int n = 0; n < 2; ++n) { \
            const int o = so + ((((g_) >> 2) * HALF + ((g_) & 3) * 16) * LDC + bj * HALF + n * 16) * 2; \
            const f32x4 v = src[bj][n] + acc[(g_) >> 2][bj][(g_) & 3][n] * ascale; \
            u32x2 w; w.x = cvt_pk_bf16(v[0], v[1]); w.y = cvt_pk_bf16(v[2], v[3]); __builtin_amdgcn_raw_buffer_store_b64(w, rx, vo, o, 0); } } while (0)
        EPI_LD(ra, 0);
        EPI_LD(rb2, 1); EPI_ST(ra, 0);
        EPI_LD(ra, 2); EPI_ST(rb2, 1);
        EPI_LD(rb2, 3); EPI_ST(ra, 2);
        EPI_LD(ra, 4); EPI_ST(rb2, 3);
        EPI_LD(rb2, 5); EPI_ST(ra, 4);
        EPI_LD(ra, 6); EPI_ST(rb2, 5);
        EPI_LD(rb2, 7); EPI_ST(ra, 6);
        EPI_ST(rb2, 7);
#undef EPI_LD
#undef EPI_ST
    }
};
struct EpiQKV {
    static constexpr bool PERM = true, AFTER_DRAIN = false;
    bf16_t* Q; const float* rs; float qscale;
    __device__ __forceinline__ void operator()(const f32x4 (&acc)[2][2][4][2], const Unit& u, int wr, int wc, int fr, int fq) const {
        const rsrc_t rq = mkrsrc(Q, 3u * 16384u * 4096u * 2u), rr = mkrsrc(rs, 16384u * 4u);
        const int colt = u.pn * BM, which = colt >> 12, cw = colt & 4095, gt = cw >> 7;
        const int b = (u.pm * BM) >> 11, st = (u.pm * BM) & 2047;
        const float sc = which == 0 ? qscale : 1.f;
        const int so = (int)(((unsigned)which << 26) + (((unsigned)(b * 32 + gt) * 2048u + (unsigned)st) << 7)) * 2;
        const int vo = (((wr * 64 + fr) << 7) + wc * 32 + 8 * fq) * 2, vr = (wr * 64 + fr) * 4, sr = u.pm * BM * 4;
#pragma unroll
        for (int ai = 0; ai < 2; ++ai)
#pragma unroll
            for (int m = 0; m < 4; ++m) { const float f = sc * __builtin_bit_cast(float, __builtin_amdgcn_raw_buffer_load_b32(rr, vr, sr + (ai * HALF + m * 16) * 4, 0));
#pragma unroll
                for (int bj = 0; bj < 2; ++bj) {
                    const f32x4 v0 = acc[ai][bj][m][0] * f, v1 = acc[ai][bj][m][1] * f;
                    u32x4 w; w.x = cvt_pk_bf16(v0[0], v0[1]); w.y = cvt_pk_bf16(v0[2], v0[3]); w.z = cvt_pk_bf16(v1[0], v1[1]); w.w = cvt_pk_bf16(v1[2], v1[3]);
                    __builtin_amdgcn_raw_buffer_store_b128(w, rq, vo, so + ((bj * 2048 + ai * HALF + m * 16) << 7) * 2, 0); } }
    }
};

struct EpiQKV4 {
    static constexpr bool PERM = false, AFTER_DRAIN = false;
    bf16_t* Q; const float* rs; float qscale, wscale;
    __device__ __forceinline__ void operator()(const f32x4 (&acc)[2][2][4][2], const Unit& u, int wr, int wc, int fr, int fq) const {
        EPI_FRESH_LANE();
        const rsrc_t rq = mkrsrc(Q, 3u * 16384u * 4096u * 2u), rr = mkrsrc(rs, 16384u * 4u);
        const int colt = u.pn * BM, which = colt >> 12, cw = colt & 4095, gt = cw >> 7;
        const int b = (u.pm * BM) >> 11, st = (u.pm * BM) & 2047;
        const float sc = (which == 0 ? qscale : 1.f) * wscale;
        const int so = (int)(((unsigned)which << 26) + (((unsigned)(b * 32 + gt) * 2048u + (unsigned)st) << 7)) * 2;
        const int vo = (((wr * 64 + fr) << 7) + wc * 32 + 4 * fq) * 2, vr = (wr * 64 + fr) * 4, sr = u.pm * BM * 4;
        unsigned rsv[2][4];
#pragma unroll
        for (int ai = 0; ai < 2; ++ai)
#pragma unroll
            for (int m = 0; m < 4; ++m) rsv[ai][m] = __builtin_amdgcn_raw_buffer_load_b32(rr, vr, sr + (ai * HALF + m * 16) * 4, 0);
#pragma unroll
        for (int ai = 0; ai < 2; ++ai)
#pragma unroll
            for (int m = 0; m < 4; ++m) { const float f = sc * __builtin_bit_cast(float, rsv[ai][m]);
#pragma unroll
                for (int bj = 0; bj < 2; ++bj)
#pragma unroll
                    for (int n = 0; n < 2; ++n) { const f32x4 v0 = acc[ai][bj][m][n] * f; u32x2 w; w.x = cvt_pk_bf16(v0[0], v0[1]); w.y = cvt_pk_bf16(v0[2], v0[3]);
                        __builtin_amdgcn_raw_buffer_store_b64(w, rq, vo, so + (((bj * 2048 + ai * HALF + m * 16) << 7) + n * 16) * 2, 0); } }
    }
};

typedef int i32x8 __attribute__((ext_vector_type(8)));
template <bool F8> struct FragT { typedef bf16x8 type; };
template <> struct FragT<true> { typedef i32x8 type; };
__device__ __forceinline__ f32x4 mma_bf16(bf16x8 a, bf16x8 b, f32x4 c) { return __builtin_amdgcn_mfma_f32_16x16x32_bf16(a, b, c, 0, 0, 0); }
__device__ __forceinline__ f32x4 mma_bf16(i32x8, i32x8, f32x4 c) { return c; }
template <class Epi, class Sched, bool ALIGN_EPI = false, bool SP2 = false, bool F8 = false>
__device__ __forceinline__ void gemm_phase(PG8_LAS unsigned char* lds, const Gemm g, const Sched& S, const Epi& E, int tid_in) {
    int tid_ = tid_in;
    const int tid = tid_, wid = __builtin_amdgcn_readfirstlane(tid >> 6), lane = tid & 63, wr = wid >> 2, wc = wid & 3, fr = lane & 15, fq = lane >> 4;
    constexpr int EB = F8 ? 1 : 2;
    constexpr int K = 4096; constexpr int nt = (K * EB) / (BK * 2);
    unsigned voffA[2], voffB[2];
#pragma unroll
    for (int i = 0; i < 2; ++i) { int R, C; stage_rc(tid * 16 + i * 8192, R, C); const int Rb = Epi::PERM ? ((R & ~31) + perm32(R & 31)) : R;
        voffA[i] = (unsigned)(R * K * EB + C * 2); voffB[i] = (unsigned)(Rb * K * EB + C * 2); }
    const size_t kstep = (size_t)(BK * 2);
    const size_t hstep = (size_t)HALF * K * EB;
    const size_t tstep = 2 * hstep;
    const unsigned ldsw = (unsigned)wid * 1024u;
    const int aoff = F8 ? lds_byte(wr * 64 + fr, fq * 16) + (fq & 1) * 16 : lds_byte(wr * 64 + fr, fq * 8), boff = F8 ? lds_byte(wc * 32 + fr, fq * 16) + (fq & 1) * 16 : lds_byte(wc * 32 + fr, fq * 8);
    const int aoff1 = aoff + (F8 ? 16 - 32 * (fq & 1) : 0);
    const int f8o0_unused = 0; (void)f8o0_unused;
#define PG8_SA(b, h) (((b) * 2 + (h)) * HTB)
#define PG8_SB(b, h) ((4 + (b) * 2 + (h)) * HTB)
#define PG8_STAGE_X(bufoff, gbase, voff, rs_, base_) do { const int so_ = (int)((const char*)(gbase) - (const char*)(base_)); _Pragma("unroll") for (int _i = 0; _i < 2; ++_i) \
        __builtin_amdgcn_raw_ptr_buffer_load_lds(rs_, (PG8_LAS void*)(lds + (bufoff) + ldsw + _i * 8192), 16, (int)(voff)[_i], so_, 0, 0); } while (0)
#define PG8_LDA(dst, b, h) do { if constexpr (F8) { _Pragma("unroll") for (int m = 0; m < 4; ++m) { const u32x4 lo_ = *(const PG8_LAS u32x4*)(lds + PG8_SA(b, h) + aoff + m * 2048), hi_ = *(const PG8_LAS u32x4*)(lds + PG8_SA(b, h) + aoff1 + m * 2048); \
            dst[m][0] = (i32x8){(int)lo_[0], (int)lo_[1], (int)lo_[2], (int)lo_[3], (int)hi_[0], (int)hi_[1], (int)hi_[2], (int)hi_[3]}; } } \
        else { _Pragma("unroll") for (int m = 0; m < 4; ++m) _Pragma("unroll") for (int k = 0; k < 2; ++k) dst[m][k] = *(const PG8_LAS frag_t*)(lds + PG8_SA(b, h) + aoff + m * 2048 + k * 1024); } } while (0)
#define PG8_LDB(dst, b, h) do { if constexpr (F8) { _Pragma("unroll") for (int n = 0; n < 2; ++n) { const u32x4 lo_ = *(const PG8_LAS u32x4*)(lds + PG8_SB(b, h) + boff + n * 2048), hi_ = *(const PG8_LAS u32x4*)(lds + PG8_SB(b, h) + boff + (aoff1 - aoff) + n * 2048); \
            dst[n][0] = (i32x8){(int)lo_[0], (int)lo_[1], (int)lo_[2], (int)lo_[3], (int)hi_[0], (int)hi_[1], (int)hi_[2], (int)hi_[3]}; } } \
        else { _Pragma("unroll") for (int n = 0; n < 2; ++n) _Pragma("unroll") for (int k = 0; k < 2; ++k) dst[n][k] = *(const PG8_LAS frag_t*)(lds + PG8_SB(b, h) + boff + n * 2048 + k * 1024); } } while (0)
#define PG8_MMA(ai, bj, At, Bt) do { __builtin_amdgcn_s_setprio(1); _Pragma("unroll") for (int m = 0; m < 4; ++m) _Pragma("unroll") for (int n = 0; n < 2; ++n) { \
        if constexpr (F8) acc[ai][bj][m][n] = __builtin_amdgcn_mfma_scale_f32_16x16x128_f8f6f4(Bt[n][0], At[m][0], acc[ai][bj][m][n], 0, 0, 0, 0x7f7f7f7f, 0, 0x7f7f7f7f); \
        else { _Pragma("unroll") for (int k = 0; k < 2; ++k) acc[ai][bj][m][n] = mma_bf16(Bt[n][k], At[m][k], acc[ai][bj][m][n]); } } __builtin_amdgcn_s_setprio(0); } while (0)
#define PG8_WAIT_V(n) asm volatile("s_waitcnt vmcnt(" #n ")" ::: "memory")
#define PG8_WAIT_L(n) asm volatile("s_waitcnt lgkmcnt(" #n ")" ::: "memory")
#define PG8_BAR __builtin_amdgcn_s_barrier()
#define PG8_SCHED __builtin_amdgcn_sched_barrier(0)
    const __amdgpu_buffer_rsrc_t rsA = __builtin_amdgcn_make_buffer_rsrc((void*)g.A, (short)0, (int)((size_t)g.M * K * EB), 0x00020000), rsB = __builtin_amdgcn_make_buffer_rsrc((void*)g.Bt, (short)0, (int)((size_t)g.N * K * EB), 0x00020000);
    Unit cur, nxt; int ui = 0;
    if (!S.next(0, cur)) return;
    f32x4 acc[2][2][4][2];
#pragma unroll
    for (int a = 0; a < 2; ++a)
#pragma unroll
        for (int b = 0; b < 2; ++b)
#pragma unroll
            for (int m = 0; m < 4; ++m)
#pragma unroll
                for (int n = 0; n < 2; ++n) acc[a][b][m][n] = (f32x4){0.f, 0.f, 0.f, 0.f};
    typedef typename FragT<F8>::type frag_t;
    frag_t At[4][F8 ? 1 : 2], B0[2][F8 ? 1 : 2], B1[2][F8 ? 1 : 2];
    const char* cA = (const char*)g.A + (size_t)cur.pm * tstep; const char* cB = (const char*)g.Bt + (size_t)cur.pn * tstep;
    S.a_ready(cur);
    if constexpr (SP2) {
        PG8_STAGE_X(PG8_SB(0, 0), cB, voffB, rsB, g.Bt); PG8_STAGE_X(PG8_SB(0, 1), cB + hstep, voffB, rsB, g.Bt); PG8_STAGE_X(PG8_SA(0, 0), cA, voffA, rsA, g.A); PG8_STAGE_X(PG8_SA(0, 1), cA + hstep, voffA, rsA, g.A);
        if (wr == 1) PG8_BAR;
        PG8_WAIT_V(2); PG8_BAR;
        PG8_STAGE_X(PG8_SB(1, 0), cB + kstep, voffB, rsB, g.Bt); PG8_STAGE_X(PG8_SA(1, 0), cA + kstep, voffA, rsA, g.A); PG8_STAGE_X(PG8_SB(1, 1), cB + hstep + kstep, voffB, rsB, g.Bt);
        PG8_WAIT_V(6); PG8_BAR;
    } else {
        PG8_STAGE_X(PG8_SB(0, 0), cB, voffB, rsB, g.Bt); PG8_STAGE_X(PG8_SA(0, 0), cA, voffA, rsA, g.A); PG8_STAGE_X(PG8_SB(0, 1), cB + hstep, voffB, rsB, g.Bt); PG8_STAGE_X(PG8_SA(0, 1), cA + hstep, voffA, rsA, g.A);
        if (wr == 1) PG8_BAR;
        PG8_WAIT_V(4); PG8_BAR;
        PG8_STAGE_X(PG8_SB(1, 0), cB + kstep, voffB, rsB, g.Bt); PG8_STAGE_X(PG8_SA(1, 0), cA + kstep, voffA, rsA, g.A); PG8_STAGE_X(PG8_SB(1, 1), cB + hstep + kstep, voffB, rsB, g.Bt);
        PG8_WAIT_V(6); PG8_BAR;
    }
    for (;;) {
        const bool has_next = S.next(ui + 1, nxt);
        const char* nA = has_next ? (const char*)g.A + (size_t)nxt.pm * tstep : cA; const char* nB = has_next ? (const char*)g.Bt + (size_t)nxt.pn * tstep : cB;
        for (int t = 0; t < nt; t += 2) {
            const bool last = (t == nt - 2);
            const char* a1 = cA + (size_t)(t + 1) * kstep;
            const char* a2 = last ? nA : cA + (size_t)(t + 2) * kstep; const char* b2 = last ? nB : cB + (size_t)(t + 2) * kstep;
            const char* a3 = a2 + kstep; const char* b3 = b2 + kstep;
            if (last && has_next) S.a_ready(nxt);
            if constexpr (SP2) {
            PG8_LDB(B0, 0, 0); PG8_LDB(B1, 0, 1); PG8_SCHED; PG8_LDA(At, 0, 0); PG8_STAGE_X(PG8_SA(1, 1), a1 + hstep, voffA, rsA, g.A);
            PG8_WAIT_V(8); PG8_WAIT_L(0); PG8_BAR; PG8_MMA(0, 0, At, B0); PG8_MMA(0, 1, At, B1); PG8_BAR; PG8_SCHED;
            PG8_LDA(At, 0, 1); PG8_STAGE_X(PG8_SB(0, 0), b2, voffB, rsB, g.Bt); PG8_STAGE_X(PG8_SB(0, 1), b2 + hstep, voffB, rsB, g.Bt); PG8_STAGE_X(PG8_SA(0, 0), a2, voffA, rsA, g.A);
            PG8_WAIT_V(8); PG8_WAIT_L(0); PG8_BAR; PG8_MMA(1, 0, At, B0); PG8_MMA(1, 1, At, B1); PG8_BAR; PG8_SCHED;
            PG8_LDB(B0, 1, 0); PG8_LDB(B1, 1, 1); PG8_SCHED; PG8_LDA(At, 1, 0); PG8_STAGE_X(PG8_SA(0, 1), a2 + hstep, voffA, rsA, g.A);
            PG8_WAIT_V(8); PG8_WAIT_L(0); PG8_BAR; PG8_MMA(0, 0, At, B0); PG8_MMA(0, 1, At, B1); PG8_BAR; PG8_SCHED;
            PG8_LDA(At, 1, 1); PG8_STAGE_X(PG8_SB(1, 0), b3, voffB, rsB, g.Bt); PG8_STAGE_X(PG8_SB(1, 1), b3 + hstep, voffB, rsB, g.Bt); PG8_STAGE_X(PG8_SA(1, 0), a3, voffA, rsA, g.A);
            PG8_WAIT_V(8); PG8_WAIT_L(0); PG8_BAR; PG8_MMA(1, 0, At, B0); PG8_MMA(1, 1, At, B1); PG8_BAR; PG8_SCHED;
            } else {
            PG8_LDB(B0, 0, 0); PG8_SCHED; PG8_LDA(At, 0, 0); PG8_STAGE_X(PG8_SA(1, 1), a1 + hstep, voffA, rsA, g.A);
            PG8_WAIT_L(8); PG8_BAR; PG8_WAIT_L(0); PG8_MMA(0, 0, At, B0); PG8_BAR; PG8_SCHED;
            PG8_LDB(B1, 0, 1); PG8_STAGE_X(PG8_SB(0, 0), b2, voffB, rsB, g.Bt);
            PG8_BAR; PG8_WAIT_L(0); PG8_MMA(0, 1, At, B1); PG8_BAR;
            PG8_LDA(At, 0, 1); PG8_STAGE_X(PG8_SA(0, 0), a2, voffA, rsA, g.A);
            PG8_BAR; PG8_WAIT_L(0); PG8_MMA(1, 0, At, B0); PG8_BAR; PG8_SCHED;
            PG8_STAGE_X(PG8_SB(0, 1), b2 + hstep, voffB, rsB, g.Bt);
            PG8_WAIT_V(6); PG8_BAR; PG8_MMA(1, 1, At, B1); PG8_BAR;
            PG8_LDB(B0, 1, 0); PG8_SCHED; PG8_LDA(At, 1, 0); PG8_STAGE_X(PG8_SA(0, 1), a2 + hstep, voffA, rsA, g.A);
            PG8_WAIT_L(8); PG8_BAR; PG8_WAIT_L(0); PG8_MMA(0, 0, At, B0); PG8_BAR; PG8_SCHED;
            PG8_LDB(B1, 1, 1); PG8_STAGE_X(PG8_SB(1, 0), b3, voffB, rsB, g.Bt);
            PG8_BAR; PG8_WAIT_L(0); PG8_MMA(0, 1, At, B1); PG8_BAR;
            PG8_LDA(At, 1, 1); PG8_STAGE_X(PG8_SA(1, 0), a3, voffA, rsA, g.A);
            PG8_BAR; PG8_WAIT_L(0); PG8_MMA(1, 0, At, B0); PG8_BAR; PG8_SCHED;
            PG8_STAGE_X(PG8_SB(1, 1), b3 + hstep, voffB, rsB, g.Bt);
            PG8_WAIT_V(6); PG8_BAR; PG8_MMA(1, 1, At, B1); PG8_BAR;
            }
        }
        if constexpr (ALIGN_EPI) { if (wr == 0) PG8_BAR; }
        if constexpr (!Epi::AFTER_DRAIN) { E(acc, cur, wr, wc, fr, fq); S.done(cur); }
        if (!has_next) break;
#pragma unroll
        for (int a = 0; a < 2; ++a)
#pragma unroll
            for (int b = 0; b < 2; ++b)
#pragma unroll
                for (int m = 0; m < 4; ++m)
#pragma unroll
                    for (int n = 0; n < 2; ++n) acc[a][b][m][n] = (f32x4){0.f, 0.f, 0.f, 0.f};
        cur = nxt; cA = nA; cB = nB; ++ui;
        if constexpr (ALIGN_EPI) { if (wr == 1) PG8_BAR; }
    }
    PG8_WAIT_V(0);
    if constexpr (!ALIGN_EPI) { if (wr == 0) PG8_BAR; }
    PG8_BAR;
    if constexpr (Epi::AFTER_DRAIN) { E.fused(acc, cur, wr, wc, fr, fq, lds, wid, lane); S.done(cur); }
#undef PG8_SA
#undef PG8_SB
#undef PG8_STAGE_X
#undef PG8_LDA
#undef PG8_LDB
#undef PG8_MMA
#undef PG8_WAIT_V
#undef PG8_WAIT_L
#undef PG8_BAR
#undef PG8_SCHED
}
}
#define GAS __attribute__((address_space(1)))
#define LAS __attribute__((address_space(3)))
typedef unsigned short bf16_t;
typedef unsigned u32x4 __attribute__((ext_vector_type(4)));
typedef unsigned u32x2 __attribute__((ext_vector_type(2)));
typedef float f32x4 __attribute__((ext_vector_type(4)));
typedef float f32x2 __attribute__((ext_vector_type(2)));
typedef float f32x16 __attribute__((ext_vector_type(16)));
typedef short bf16x8 __attribute__((ext_vector_type(8)));
typedef short s16x4 __attribute__((ext_vector_type(4)));
typedef __bf16 bf16x2_t __attribute__((ext_vector_type(2)));
typedef unsigned u32x6 __attribute__((ext_vector_type(6)));
typedef unsigned u32x16 __attribute__((ext_vector_type(16)));
typedef float f32x32 __attribute__((ext_vector_type(32)));
typedef _Float16 f16x32 __attribute__((ext_vector_type(32)));
typedef _Float16 f16x2 __attribute__((ext_vector_type(2)));

namespace mk {
constexpr int M = 16384, D = 4096, S = 2048, NB = 8, PW = 12298, NH = 32, NE = 16384;
constexpr int NWAVES = 8;
constexpr size_t MiB = 1u << 20;
constexpr size_t WS_CTL = 0, CTL_ZERO_BYTES = 1 * MiB;
constexpr size_t WS_RSTD = 2 * MiB, WS_LOGF = 3 * MiB, WS_WQK = 4 * MiB, WS_WOUT = 20 * MiB, WS_WIN = 52 * MiB, WS_U16 = 148 * MiB, WS_V16 = 276 * MiB,
                 WS_XB = 404 * MiB, WS_Q = 532 * MiB, WS_K = 660 * MiB, WS_V = 788 * MiB, WS_OB = 916 * MiB, WS_X2 = 1792 * MiB, WS_END = 2048 * MiB;
constexpr size_t WS_XB8N = WS_OB + 64 * MiB;
constexpr size_t WS_SC = WS_Q;
constexpr int CW_BAR = 4096;
constexpr int CW_QUEUE = 16384;
constexpr int RING_BYTES = 131072, LDSCTL_OFF = RING_BYTES, MISC_OFF = LDSCTL_OFF + 320, LDS_BYTES = 147456;

struct Args { const float* in[13]; float* out; unsigned char* ws; int ph_lo, ph_hi; };

__device__ __forceinline__ unsigned f2bf(float f) { unsigned u = __builtin_bit_cast(unsigned, f); return (u + 0x7fffu + ((u >> 16) & 1u)) >> 16; }
__device__ __forceinline__ unsigned pk2(float lo, float hi) { return f2bf(lo) | (f2bf(hi) << 16); }
__device__ __forceinline__ float bf_lo(unsigned w) { return __builtin_bit_cast(float, w << 16); }
__device__ __forceinline__ float bf_hi(unsigned w) { return __builtin_bit_cast(float, w & 0xffff0000u); }
__device__ __forceinline__ float lane_read(float v, int src_lane) { return __builtin_bit_cast(float, __builtin_amdgcn_ds_bpermute(src_lane << 2, __builtin_bit_cast(int, v))); }
__device__ __forceinline__ int lane_read(int v, int src_lane) { return __builtin_amdgcn_ds_bpermute(src_lane << 2, v); }
constexpr float US = 1024.0f, VS = 32.0f, US_INV = 1.0f / 1024.0f, VS_INV = 1.0f / 32.0f;
constexpr int ROW6 = 3072;
__device__ __forceinline__ unsigned q_e2m3(float x, float inv) {
    const float a = fminf(fabsf(x) * inv, 7.5f);
    const float c = a < 2.0f ? __builtin_rintf(a * 8.0f) : (a < 4.0f ? __builtin_rintf(a * 4.0f) + 8.0f : __builtin_rintf(a * 2.0f) + 16.0f);
    return (unsigned)(int)c | ((__builtin_bit_cast(unsigned, x) >> 26) & 32u);
}
__device__ __forceinline__ u32x6 pack_fp6(const f32x4 (&a0)[4], const f32x4 (&a1)[4], float inv) {
    unsigned o[6];
#pragma unroll
    for (int w = 0; w < 6; ++w) o[w] = 0u;
#pragma unroll
    for (int j = 0; j < 32; ++j) { const float x = (j < 16) ? a0[(j & 15) >> 2][j & 3] : a1[(j & 15) >> 2][j & 3]; const unsigned c = q_e2m3(x, inv);
        const int b = 6 * j, w = b >> 5, sh = b & 31; o[w] |= c << sh; if (sh > 26) o[w + 1] |= c >> (32 - sh); }
    return (u32x6){o[0], o[1], o[2], o[3], o[4], o[5]};
}
constexpr int ROW4 = 2048;
__device__ __forceinline__ unsigned q_e2m1(float x, float inv) {
    const float a = fminf(fabsf(x) * inv, 6.0f);
    const float c = a < 2.0f ? __builtin_rintf(a * 2.0f) : (a < 4.0f ? __builtin_rintf(a) + 2.0f : __builtin_rintf(a * 0.5f) + 4.0f);
    return (unsigned)(int)c | ((__builtin_bit_cast(unsigned, x) >> 28) & 8u);
}
__device__ __forceinline__ u32x4 pack_fp4(const f32x4 (&a0)[4], const f32x4 (&a1)[4], float inv) {
    unsigned o[4];
#pragma unroll
    for (int w = 0; w < 4; ++w) { o[w] = 0u;
#pragma unroll
        for (int t = 0; t < 8; ++t) { const int j = 8 * w + t; const float x = (j < 16) ? a0[(j & 15) >> 2][j & 3] : a1[(j & 15) >> 2][j & 3]; o[w] |= q_e2m1(x, inv) << (4 * t); } }
    return (u32x4){o[0], o[1], o[2], o[3]};
}
__device__ __forceinline__ float clamp8(float x) { return fminf(fmaxf(x, -224.0f), 224.0f); }
__device__ __forceinline__ float logsig(float z) { return fminf(z, 0.f) - 0.6931471805599453f * __builtin_amdgcn_logf(1.0f + __builtin_amdgcn_exp2f(-fabsf(z) * 1.4426950408889634f)); }
__device__ __forceinline__ float gelu_erf(float v) {
    const float av = fabsf(v), t = __builtin_amdgcn_rcpf(av * 0.2316418882f + 1.0f);
    float q = t * 0.5307027145f + (-0.7265760135f); q = q * t + 0.7107068705f; q = q * t + (-0.142248368f); q = q * t + 0.127414796f; q = q * t;
    const float e = __builtin_amdgcn_exp2f((v * v) * (-0.72134752044f));
    const float m = v * (q * e);
    return v < 0.f ? m : v - m;
}
#define LDS_WAIT() asm volatile("s_waitcnt lgkmcnt(0)" ::: "memory")
#define FRESH_LDS(l) do { unsigned v_ = (unsigned)(size_t)(l); asm volatile("" : "+s"(v_)); (l) = (LAS unsigned char*)(size_t)v_; } while (0)
#define FRESH_BID() int bid = blockIdx.x, G = gridDim.x; asm volatile("" : "+s"(bid), "+s"(G))
#define FRESH_TID() int tid; { int w_ = wave0, l_; { unsigned z_ = 0u; asm volatile("" : "+v"(z_)); l_ = (int)__builtin_amdgcn_mbcnt_hi(~0u, __builtin_amdgcn_mbcnt_lo(~0u, z_)); } asm volatile("" : "+s"(w_)); tid = w_ * 64 + l_; } const int lane = tid & 63, wave = __builtin_amdgcn_readfirstlane(tid >> 6); (void)lane; (void)wave

__device__ __forceinline__ unsigned wave_max_u32(unsigned v) {
    v = max(v, (unsigned)__builtin_amdgcn_update_dpp(0, (int)v, 0x111, 0xF, 0xF, true));
    v = max(v, (unsigned)__builtin_amdgcn_update_dpp(0, (int)v, 0x112, 0xF, 0xF, true));
    v = max(v, (unsigned)__builtin_amdgcn_update_dpp(0, (int)v, 0x114, 0xF, 0xF, true));
    v = max(v, (unsigned)__builtin_amdgcn_update_dpp(0, (int)v, 0x118, 0xF, 0xF, true));
    v = max(v, (unsigned)__builtin_amdgcn_update_dpp((int)v, (int)v, 0x142, 0xA, 0xF, false));
    v = max(v, (unsigned)__builtin_amdgcn_update_dpp((int)v, (int)v, 0x143, 0xC, 0xF, false));
    return (unsigned)__builtin_amdgcn_readlane((int)v, 63);
}
__device__ __forceinline__ float wave_sum_dpp(float x) {
    int v = __builtin_bit_cast(int, x);
#define DPP_ADD(ctrl, rm, bc, oldv) v = __builtin_bit_cast(int, __builtin_bit_cast(float, v) + __builtin_bit_cast(float, __builtin_amdgcn_update_dpp(oldv, v, ctrl, rm, 0xF, bc)))
    DPP_ADD(0x111, 0xF, true, 0); DPP_ADD(0x112, 0xF, true, 0); DPP_ADD(0x114, 0xF, true, 0); DPP_ADD(0x118, 0xF, true, 0);
#undef DPP_ADD
    const float r0 = __builtin_bit_cast(float, __builtin_amdgcn_readlane(v, 15)), r1 = __builtin_bit_cast(float, __builtin_amdgcn_readlane(v, 31)), r2 = __builtin_bit_cast(float, __builtin_amdgcn_readlane(v, 47)), r3 = __builtin_bit_cast(float, __builtin_amdgcn_readlane(v, 63));
    return (r0 + r1) + (r2 + r3);
}
__device__ __forceinline__ unsigned ordkey(float x) { const unsigned u = __builtin_bit_cast(unsigned, x); return (u & 0x80000000u) ? ~u : (u | 0x80000000u); }
__device__ __forceinline__ void transpose_item(const float* W, int K, int ldw, int ncols, const float* gain, bf16_t* WT, LAS float* scr, int item, int lane) {
    const int nblk = ncols / 32, kb = item / nblk, nb = item % nblk, k0 = 64 * kb, n0 = 32 * nb;
#pragma unroll 8
    for (int i = 0; i < 32; ++i) { const int kk = 2 * i + (lane >> 5); float v = W[(size_t)(k0 + kk) * ldw + n0 + (lane & 31)]; if (gain) v *= gain[k0 + kk]; scr[kk * 33 + (lane & 31)] = v; }
    LDS_WAIT(); asm volatile("" ::: "memory");
    const int c = lane & 7;
#pragma unroll
    for (int j = 0; j < 4; ++j) { const int n = (lane >> 3) + 8 * j; const LAS float* s = scr + (8 * c) * 33 + n;
        u32x4 o; o.x = pk2(s[0 * 33], s[1 * 33]); o.y = pk2(s[2 * 33], s[3 * 33]); o.z = pk2(s[4 * 33], s[5 * 33]); o.w = pk2(s[6 * 33], s[7 * 33]);
        *(u32x4*)(WT + (size_t)(n0 + n) * K + k0 + 8 * c) = o; }
    LDS_WAIT(); asm volatile("" ::: "memory");
}

typedef const __attribute__((address_space(4))) Args* KArgsT;
__device__ __forceinline__ unsigned pk4_fp8(float a, float b, float c, float d) { int p = __builtin_amdgcn_cvt_pk_fp8_f32(clamp8(a), clamp8(b), 0, false); p = __builtin_amdgcn_cvt_pk_fp8_f32(clamp8(c), clamp8(d), p, true); return (unsigned)p; }
__device__ __forceinline__ void transpose_item8(const float* W, int K, int ldw, int ncols, const float* gain, float scale, unsigned char* WT, LAS float* scr, int item, int lane) {
    const int nblk = ncols / 32, kb = item / nblk, nb = item % nblk, k0 = 64 * kb, n0 = 32 * nb;
    const int kr = lane >> 3, nq = (lane & 7) * 4;
    f32x4 v[8];
#pragma unroll
    for (int i = 0; i < 8; ++i) { const float* p = W + (size_t)(k0 + 8 * i + kr) * ldw + n0 + nq; v[i] = (f32x4){p[0], p[1], p[2], p[3]}; }
#pragma unroll
    for (int i = 0; i < 8; ++i) { const int kk = 8 * i + kr; const float g = (gain ? gain[k0 + kk] : 1.0f) * scale; LAS float* d = scr + kk * 33 + nq; d[0] = v[i][0] * g; d[1] = v[i][1] * g; d[2] = v[i][2] * g; d[3] = v[i][3] * g; }
    LDS_WAIT(); asm volatile("" ::: "memory");
    const int c = lane & 7;
#pragma unroll
    for (int j = 0; j < 4; ++j) { const int n = (lane >> 3) + 8 * j; const LAS float* s = scr + (8 * c) * 33 + n;
        u32x2 o; o.x = pk4_fp8(s[0 * 33], s[1 * 33], s[2 * 33], s[3 * 33]); o.y = pk4_fp8(s[4 * 33], s[5 * 33], s[6 * 33], s[7 * 33]);
        *(u32x2*)(WT + (size_t)(n0 + n) * K + k0 + 8 * c) = o; }
    LDS_WAIT(); asm volatile("" ::: "memory");
}
__device__ __forceinline__ void conv_phase(KArgsT ka, int l, LAS unsigned char* lds, int wave0) {
    FRESH_TID(); FRESH_LDS(lds); FRESH_BID();
    unsigned char* ws = ka->ws;
    const float* ln1 = ka->in[1] + (size_t)l * D; const float* w_in = ka->in[2] + (size_t)l * D * PW; const float* w_out = ka->in[5] + (size_t)l * D * D;
    const float* ln2 = ka->in[6] + (size_t)l * D; const float* wq = ka->in[7] + (size_t)l * D * 2048;
    const float* k1 = ka->in[8] + (size_t)l * 8 * 128 * 128; const float* k2 = ka->in[9] + (size_t)l * 8 * 128 * 128;
    const float* pu = ka->in[10] + (size_t)l * NE * D; const float* pv = ka->in[11] + (size_t)l * NE * D;
    bf16_t* WQK = (bf16_t*)(ws + WS_WQK); bf16_t* WOUT = (bf16_t*)(ws + WS_WOUT); bf16_t* WIN = (bf16_t*)(ws + WS_WIN); bf16_t* U16 = (bf16_t*)(ws + WS_U16); bf16_t* V16 = (bf16_t*)(ws + WS_V16);
    {
        LAS float* Ks = (LAS float*)lds;
        LAS float* Ws = (LAS float*)(lds + 128 * 132 * 4);
        for (int it = bid; it < 1024; it += G) {
            const int gi = it >> 6, c0 = (it & 63) * 64;
            const float* key = ((gi & 1) ? k2 : k1) + (size_t)(gi >> 1) * 128 * 128;
            for (int i = tid; i < 4096; i += 512) { const int r = i >> 5, c4 = (i & 31) * 4; *(LAS f32x4*)(Ks + r * 132 + c4) = *(const f32x4*)(key + r * 128 + c4); }
            for (int i = tid; i < 2048; i += 512) { const int r = i >> 5, c4 = (i & 31) * 4; *(LAS f32x4*)(Ws + r * 132 + c4) = *(const f32x4*)(wq + (size_t)(c0 + r) * 2048 + gi * 128 + c4); }
            __syncthreads();
            const int tc = tid & 15, tn = tid >> 4;
            float acc[4][4];
#pragma unroll
            for (int i = 0; i < 4; ++i)
#pragma unroll
                for (int j = 0; j < 4; ++j) acc[i][j] = 0.f;
#pragma unroll 2
            for (int d = 0; d < 128; d += 4) {
                f32x4 kv[4], wv[4];
#pragma unroll
                for (int i = 0; i < 4; ++i) kv[i] = *(const LAS f32x4*)(Ks + (4 * tn + i) * 132 + d);
#pragma unroll
                for (int j = 0; j < 4; ++j) wv[j] = *(const LAS f32x4*)(Ws + (tc + 16 * j) * 132 + d);
#pragma unroll
                for (int i = 0; i < 4; ++i)
#pragma unroll
                    for (int j = 0; j < 4; ++j) acc[i][j] += kv[i][0] * wv[j][0] + kv[i][1] * wv[j][1] + kv[i][2] * wv[j][2] + kv[i][3] * wv[j][3];
            }
#pragma unroll
            for (int j = 0; j < 4; ++j) { const int c = c0 + tc + 16 * j; const float gg = ln2[c];
#pragma unroll
                for (int i = 0; i < 4; ++i) WQK[(size_t)(gi * 128 + 4 * tn + i) * D + c] = (bf16_t)f2bf(acc[i][j] * gg); }
            __syncthreads();
        }
        __syncthreads();
    }
    const int gw = bid * NWAVES + wave, NGW = G * NWAVES;
    {
        unsigned char* U6 = (unsigned char*)U16; unsigned char* V4 = U6 + (size_t)NE * ROW6; float* SCU = (float*)(U6 + 2 * (size_t)NE * ROW6); float* SCV = SCU + NE;
        for (int r = gw; r < NE; r += NGW) {
            const float* us = pu + (size_t)r * D + 16 * lane; const float* vs = pv + (size_t)r * D + 16 * lane;
            f32x4 uu[4][4], vv[4][4];
#pragma unroll
            for (int i = 0; i < 4; ++i)
#pragma unroll
                for (int q = 0; q < 4; ++q) { uu[i][q] = *(const f32x4*)(us + 1024 * i + 4 * q); vv[i][q] = *(const f32x4*)(vs + 1024 * i + 4 * q); }
            float au = 0.f, av = 0.f;
#pragma unroll
            for (int i = 0; i < 4; ++i)
#pragma unroll
                for (int q = 0; q < 4; ++q) { uu[i][q] *= *(const f32x4*)(ln2 + 1024 * i + 16 * lane + 4 * q);
                    au = fmaxf(fmaxf(au, fmaxf(fabsf(uu[i][q][0]), fabsf(uu[i][q][1]))), fmaxf(fabsf(uu[i][q][2]), fabsf(uu[i][q][3])));
                    av += (vv[i][q][0] * vv[i][q][0] + vv[i][q][1] * vv[i][q][1]) + (vv[i][q][2] * vv[i][q][2] + vv[i][q][3] * vv[i][q][3]); }
            au = __builtin_bit_cast(float, wave_max_u32(__builtin_bit_cast(unsigned, au))); av = sqrtf(wave_sum_dpp(av) * (1.0f / D));
            const float iu = au > 0.f ? 7.5f / au : 0.f, iv = av > 0.f ? 2.0f / av : 0.f;
            if (lane == 0) { SCU[r] = au * (1.0f / 7.5f); SCV[r] = av * 0.5f; }
            { const u32x6 g0 = pack_fp6(uu[0], uu[1], iu), g1 = pack_fp6(uu[2], uu[3], iu); u32x4* o = (u32x4*)(U6 + (size_t)r * ROW6) + lane;
              o[0] = (u32x4){g0[0], g0[1], g0[2], g0[3]}; o[64] = (u32x4){g0[4], g0[5], g1[0], g1[1]}; o[128] = (u32x4){g1[2], g1[3], g1[4], g1[5]}; }
            { u32x4* o = (u32x4*)(V4 + (size_t)r * ROW4) + lane; o[0] = pack_fp4(vv[0], vv[1], iv); o[64] = pack_fp4(vv[2], vv[3], iv); }
        }
    }
    {
        LAS float* scr = (LAS float*)(lds + wave * 16384);
        constexpr int I_O = (D / 64) * (D / 32), I_IN = (D / 64) * (12288 / 32);
        for (int it = gw; it < I_O + I_IN; it += NGW) {
            if (it < I_O) transpose_item8(w_out, D, D, D, nullptr, US, (unsigned char*)WOUT, scr, it, lane);
            else transpose_item8(w_in, D, PW, 12288, ln1, US, (unsigned char*)WIN, scr, it - I_O, lane);
        }
    }
}

template <bool WITH_F>
__device__ __forceinline__ void prep_phase(const float* X, bf16_t* XB, float* RSTD, const float* w_in, const float* ln1, const float* bf, float* LOGF, LAS unsigned char* lds, int wave0) {
    FRESH_TID(); FRESH_LDS(lds); FRESH_BID();
    LAS unsigned short* gfs = (LAS unsigned short*)lds;
    if (WITH_F) {
        __syncthreads();
        for (int c = tid; c < D; c += 512) { const float g = ln1[c]; const float* wr = w_in + (size_t)c * PW + 12288;
#pragma unroll
            for (int j = 0; j < 10; ++j) gfs[j * D + c] = (unsigned short)f2bf(wr[j] * g); }
        __syncthreads();
    }
    const int gw = bid * NWAVES + wave, NGW = G * NWAVES;
    for (int m = gw; m < M; m += NGW) {
        const f32x4* xr = (const f32x4*)(X + (size_t)m * D) + lane;
        f32x4 v[16]; float ss = 0.f;
#pragma unroll
        for (int i = 0; i < 16; ++i) { v[i] = xr[64 * i]; ss += (v[i][0] * v[i][0] + v[i][1] * v[i][1]) + (v[i][2] * v[i][2] + v[i][3] * v[i][3]); }
        ss = wave_sum_dpp(ss);
        const float rstd = rsqrtf(ss * (1.0f / D) + 1e-6f);
        if (WITH_F) {
            unsigned* o8 = (unsigned*)((unsigned char*)XB + (size_t)m * D) + lane;
#pragma unroll
            for (int i = 0; i < 16; ++i) o8[64 * i] = pk4_fp8(v[i][0], v[i][1], v[i][2], v[i][3]);
        } else {
        u32x2* o = (u32x2*)(XB + (size_t)m * D) + lane;
#pragma unroll
        for (int i = 0; i < 16; ++i) { u32x2 w; w.x = pk2(v[i][0], v[i][1]); w.y = pk2(v[i][2], v[i][3]); o[64 * i] = w; }
        }
        if (lane == 0) RSTD[m] = rstd;
        if (WITH_F) {
            float mine = 0.f;
#pragma unroll 1
            for (int j = 0; j < 10; ++j) { float s = 0.f;
#pragma unroll
                for (int i = 0; i < 16; ++i) { const u32x2 gp = *(const LAS u32x2*)(gfs + j * D + 256 * i + 4 * lane);
                    s += (v[i][0] * bf_lo(gp.x) + v[i][1] * bf_hi(gp.x)) + (v[i][2] * bf_lo(gp.y) + v[i][3] * bf_hi(gp.y)); }
                s = wave_sum_dpp(s); if (lane == j) mine = s; }
            if (lane < 10) { const int b = m >> 11, s = m & 2047; LOGF[(size_t)(b * 10 + lane) * S + s] = logsig(mine * rstd + bf[lane]); }
        }
    }
}


__device__ __forceinline__ void load16_bf16(const bf16_t* p, float (&d)[16]) {
    const u32x4 a = *(const u32x4*)p, b = *(const u32x4*)(p + 8);
#pragma unroll
    for (int q = 0; q < 4; ++q) { d[2 * q] = bf_lo(a[q]); d[2 * q + 1] = bf_hi(a[q]); d[8 + 2 * q] = bf_lo(b[q]); d[8 + 2 * q + 1] = bf_hi(b[q]); }
}
#define RFL(x) __builtin_amdgcn_readfirstlane(x)
__device__ __forceinline__ void peer_u_phase(const float* SC, const unsigned char* U6, const bf16_t* X1, int* EIDG, float* WG, LAS unsigned char* lds, int wave0) {
    FRESH_TID(); FRESH_LDS(lds); FRESH_BID();
    LAS int* s_eid = (LAS int*)(lds + wave * 1024); LAS float* s_w = (LAS float*)(lds + wave * 1024 + 512); LAS float* s_su = (LAS float*)(lds + 8192 + wave * 512);
    const float* SCU = (const float*)(U6 + 2 * (size_t)NE * ROW6); const float* SCV = SCU + NE;
    const int gw = bid * NWAVES + wave, NGW = G * NWAVES;
    const float NEG = -3.0e38f;
    for (int tok = gw; tok < M; tok += NGW) {
        const bf16_t* x1 = X1 + (size_t)tok * D;
        f16x2 xh[2][16]; float rstd_tok;
        { float ss_ = 0.f;
#pragma unroll
          for (int i = 0; i < 4; ++i) { float t[16]; load16_bf16(x1 + 1024 * i + 16 * lane, t);
#pragma unroll
              for (int k = 0; k < 16; ++k) ss_ += t[k] * t[k];
#pragma unroll
              for (int k = 0; k < 8; ++k) xh[i >> 1][(i & 1) * 8 + k] = __builtin_bit_cast(f16x2, __builtin_amdgcn_cvt_pkrtz(t[2 * k], t[2 * k + 1])); }
          rstd_tok = rsqrtf(wave_sum_dpp(ss_) * (1.0f / D) + 1e-6f); }
        const float* sc = SC + (size_t)tok * 2048;
        LAS float* selv = (LAS float*)(lds + 12288 + wave * 512); LAS int* seli = (LAS int*)(lds + 12288 + wave * 512 + 256);
#define BALLOT(c) __builtin_amdgcn_ballot_w64(c)
#define MBCNT(m) ((int)__builtin_amdgcn_mbcnt_hi((unsigned)((m) >> 32), __builtin_amdgcn_mbcnt_lo((unsigned)(m), 0u)))
        for (int h = 0; h < 4; ++h) {
            float x[2][2][2]; unsigned kk[2][2][2];
#pragma unroll
            for (int u = 0; u < 2; ++u)
#pragma unroll
                for (int f = 0; f < 2; ++f)
#pragma unroll
                    for (int r = 0; r < 2; ++r) { const float v = sc[(h + 4 * u) * 256 + f * 128 + r * 64 + lane]; x[u][f][r] = v; kk[u][f][r] = (ordkey(v) & ~127u) | (unsigned)(127 - 64 * r - lane); }
            unsigned T[2][2] = {{0u, 0u}, {0u, 0u}}; int dn = 0;
            for (unsigned bm = 0x80000000u; bm != 0u && dn != 15; bm >>= 1) {
#pragma unroll
                for (int u = 0; u < 2; ++u)
#pragma unroll
                    for (int f = 0; f < 2; ++f) { const unsigned cand = T[u][f] | bm;
                        const int c = __builtin_popcountll(BALLOT(kk[u][f][0] >= cand)) + __builtin_popcountll(BALLOT(kk[u][f][1] >= cand));
                        T[u][f] = c >= 16 ? cand : T[u][f]; dn |= (c == 16) ? (1 << (2 * u + f)) : 0; }
            }
#pragma unroll
            for (int u = 0; u < 2; ++u)
#pragma unroll
                for (int f = 0; f < 2; ++f) { const bool s0 = kk[u][f][0] >= T[u][f], s1 = kk[u][f][1] >= T[u][f]; const unsigned long long m0 = BALLOT(s0), m1 = BALLOT(s1);
                    const int p0 = MBCNT(m0), p1 = __builtin_popcountll(m0) + MBCNT(m1);
                    if (s0) { selv[(2 * u + f) * 16 + (p0 & 15)] = x[u][f][0]; seli[(2 * u + f) * 16 + (p0 & 15)] = lane; }
                    if (s1) { selv[(2 * u + f) * 16 + (p1 & 15)] = x[u][f][1]; seli[(2 * u + f) * 16 + (p1 & 15)] = 64 + lane; } }
            asm volatile("" ::: "memory");
            float s4[2][4]; unsigned k4[2][4];
#pragma unroll
            for (int u = 0; u < 2; ++u) { const float va = selv[(2 * u) * 16 + (lane >> 2)]; const f32x4 vb = *(const LAS f32x4*)(selv + (2 * u + 1) * 16 + (lane & 3) * 4);
#pragma unroll
                for (int q = 0; q < 4; ++q) { s4[u][q] = va + vb[q]; k4[u][q] = (ordkey(s4[u][q]) & ~255u) | (unsigned)(255 - 4 * lane - q); } }
            unsigned T2[2] = {0u, 0u}; int d2 = 0;
            for (unsigned bm = 0x80000000u; bm != 0u && d2 != 3; bm >>= 1) {
#pragma unroll
                for (int u = 0; u < 2; ++u) { const unsigned cand = T2[u] | bm;
                    const int c = (__builtin_popcountll(BALLOT(k4[u][0] >= cand)) + __builtin_popcountll(BALLOT(k4[u][1] >= cand))) + (__builtin_popcountll(BALLOT(k4[u][2] >= cand)) + __builtin_popcountll(BALLOT(k4[u][3] >= cand)));
                    T2[u] = c >= 16 ? cand : T2[u]; d2 |= (c == 16) ? (1 << u) : 0; }
            }
#pragma unroll
            for (int u = 0; u < 2; ++u) {
                const unsigned mk = wave_max_u32(max(max(k4[u][0], k4[u][1]), max(k4[u][2], k4[u][3]))) & ~255u;
                const float mx = __builtin_bit_cast(float, (mk & 0x80000000u) ? (mk & 0x7fffffffu) : ~mk);
                const float cs = 1.4426950408889634f * rstd_tok;
                float p[4], ps = 0.f;
#pragma unroll
                for (int q = 0; q < 4; ++q) { p[q] = (k4[u][q] >= T2[u]) ? __builtin_amdgcn_exp2f((s4[u][q] - mx) * cs) : 0.f; ps += p[q]; }
                const float tot = wave_sum_dpp(ps);
                const int i1 = seli[(2 * u) * 16 + (lane >> 2)]; const u32x4 i2 = *(const LAS u32x4*)(seli + (2 * u + 1) * 16 + (lane & 3) * 4);
                int base = (h + 4 * u) * 16;
#pragma unroll
                for (int q = 0; q < 4; ++q) { const bool sl = k4[u][q] >= T2[u]; const unsigned long long m = BALLOT(sl); const int slot = base + (MBCNT(m) & 15); base += __builtin_popcountll(m);
                    if (sl) { const int e = ((i1 & 127) << 7) | (int)(i2[q] & 127u); s_eid[slot] = e; s_w[slot] = p[q] / tot * SCV[e]; s_su[slot] = SCU[e]; } }
            }
            asm volatile("" ::: "memory");
        }
#undef BALLOT
#undef MBCNT
        LDS_WAIT(); asm volatile("" ::: "memory");
#define LOADROW6(dst, base, e) do { const u32x4* p_ = (const u32x4*)((base) + (size_t)(e) * ROW6) + lane; dst[0] = p_[0]; dst[1] = p_[64]; dst[2] = p_[128]; } while (0)
#define GRP6(row, g) ((g) == 0 ? (u32x6){row[0][0], row[0][1], row[0][2], row[0][3], row[1][0], row[1][1]} : (u32x6){row[1][2], row[1][3], row[2][0], row[2][1], row[2][2], row[2][3]})
        {
#define UDOT6(row, j) do { float da_ = 0.f, db_ = 0.f; _Pragma("unroll") for (int g_ = 0; g_ < 2; ++g_) { \
                u32x6 G_ = GRP6(row, g_); asm volatile("" : "+v"(G_));     \
                const f16x32 hv_ = __builtin_amdgcn_cvt_scalef32_pk32_f16_fp6(G_, 1.0f); \
                _Pragma("unroll") for (int k_ = 0; k_ < 16; k_ += 2) { da_ = __builtin_amdgcn_fdot2((f16x2){hv_[2 * k_], hv_[2 * k_ + 1]}, xh[g_][k_], da_, false); db_ = __builtin_amdgcn_fdot2((f16x2){hv_[2 * k_ + 2], hv_[2 * k_ + 3]}, xh[g_][k_ + 1], db_, false); } \
                asm volatile("" : "+v"(da_), "+v"(db_)); } \
            const float d_ = wave_sum_dpp(da_ + db_) * (rstd_tok * s_su[j]); const float ge_ = gelu_erf(d_); if (lane == 0) s_w[j] *= ge_; } while (0)
            u32x4 r0[3], r1[3], r2[3];
            { const int e_ = RFL(s_eid[0]); LOADROW6(r0, U6, e_); } { const int e_ = RFL(s_eid[1]); LOADROW6(r1, U6, e_); } { const int e_ = RFL(s_eid[2]); LOADROW6(r2, U6, e_); }
            for (int j = 0; j < 126; j += 3) {
                UDOT6(r0, j);     if (j + 3 < 128) { const int e_ = RFL(s_eid[j + 3]); LOADROW6(r0, U6, e_); }
                UDOT6(r1, j + 1); if (j + 4 < 128) { const int e_ = RFL(s_eid[j + 4]); LOADROW6(r1, U6, e_); }
                UDOT6(r2, j + 2); if (j + 5 < 128) { const int e_ = RFL(s_eid[j + 5]); LOADROW6(r2, U6, e_); }
            }
            UDOT6(r0, 126); UDOT6(r1, 127);
#undef UDOT6
        }
        LDS_WAIT(); asm volatile("" ::: "memory");
        EIDG[(size_t)tok * 128 + lane] = s_eid[lane]; EIDG[(size_t)tok * 128 + 64 + lane] = s_eid[64 + lane];
        WG[(size_t)tok * 128 + lane] = s_w[lane]; WG[(size_t)tok * 128 + 64 + lane] = s_w[64 + lane];
        LDS_WAIT(); asm volatile("" ::: "memory");
    }
}

template <bool FINAL>
__device__ __forceinline__ void peer_v_phase(const int* EIDG, const float* WG, const unsigned char* V4, const bf16_t* X1, void* XOv, const float* fg,
                                             unsigned char* XB8n, float* RSTDn, float* LOGFn, const float* w_in_n, const float* ln1_n, const float* bf_n, LAS unsigned char* lds, int wave0) {
    FRESH_TID(); FRESH_LDS(lds); FRESH_BID();
    LAS int* s_eid = (LAS int*)(lds + 81920 + wave * 1024); LAS float* s_w = (LAS float*)(lds + 81920 + wave * 1024 + 512);
    LAS unsigned short* gfs = (LAS unsigned short*)lds;
    if (!FINAL) {
        __syncthreads();
        for (int c = tid; c < D; c += 512) { const float g = ln1_n[c]; const float* wr = w_in_n + (size_t)c * PW + 12288;
#pragma unroll
            for (int j = 0; j < 10; ++j) gfs[j * D + c] = (unsigned short)f2bf(wr[j] * g); }
        __syncthreads();
    }
    const int gw = bid * NWAVES + wave, NGW = G * NWAVES;
    for (int tok = gw; tok < M; tok += NGW) {
        s_eid[lane] = EIDG[(size_t)tok * 128 + lane]; s_eid[64 + lane] = EIDG[(size_t)tok * 128 + 64 + lane];
        s_w[lane] = WG[(size_t)tok * 128 + lane]; s_w[64 + lane] = WG[(size_t)tok * 128 + 64 + lane];
        LDS_WAIT(); asm volatile("" ::: "memory");
        const bf16_t* x1 = X1 + (size_t)tok * D;
        {
            f32x2 acc2[2][16];
#define ACC(i, k) acc2[(i) >> 1][((i) & 1) * 8 + ((k) >> 1)][(k) & 1]
#pragma unroll
            for (int g = 0; g < 2; ++g)
#pragma unroll
                for (int k = 0; k < 16; ++k) acc2[g][k] = (f32x2){0.f, 0.f};
#define LOADROW4(dst, base, e) do { const u32x4* p_ = (const u32x4*)((base) + (size_t)(e) * ROW4) + lane; dst[0] = p_[0]; dst[1] = p_[64]; } while (0)
#define VACC4(row, j) do { const float w_ = s_w[j]; const f32x2 w2_ = {w_, w_}; _Pragma("unroll") for (int g_ = 0; g_ < 2; ++g_) { \
                u32x4 G_ = row[g_]; asm volatile("" : "+v"(G_)); \
                _Pragma("unroll") for (int k_ = 0; k_ < 4; ++k_) { const unsigned d_ = G_[k_]; \
                    acc2[g_][4 * k_] = __builtin_elementwise_fma(w2_, __builtin_amdgcn_cvt_scalef32_pk_f32_fp4(d_, 1.0f, 0), acc2[g_][4 * k_]); acc2[g_][4 * k_ + 1] = __builtin_elementwise_fma(w2_, __builtin_amdgcn_cvt_scalef32_pk_f32_fp4(d_, 1.0f, 1), acc2[g_][4 * k_ + 1]); \
                    acc2[g_][4 * k_ + 2] = __builtin_elementwise_fma(w2_, __builtin_amdgcn_cvt_scalef32_pk_f32_fp4(d_, 1.0f, 2), acc2[g_][4 * k_ + 2]); acc2[g_][4 * k_ + 3] = __builtin_elementwise_fma(w2_, __builtin_amdgcn_cvt_scalef32_pk_f32_fp4(d_, 1.0f, 3), acc2[g_][4 * k_ + 3]); } \
                asm volatile("" : "+v"(acc2[g_][0]), "+v"(acc2[g_][1]), "+v"(acc2[g_][2]), "+v"(acc2[g_][3]), "+v"(acc2[g_][4]), "+v"(acc2[g_][5]), "+v"(acc2[g_][6]), "+v"(acc2[g_][7]), \
                                  "+v"(acc2[g_][8]), "+v"(acc2[g_][9]), "+v"(acc2[g_][10]), "+v"(acc2[g_][11]), "+v"(acc2[g_][12]), "+v"(acc2[g_][13]), "+v"(acc2[g_][14]), "+v"(acc2[g_][15])); } } while (0)
            u32x4 r0[2], r1[2], r2[2], r3[2];
            { const int e_ = RFL(s_eid[0]); LOADROW4(r0, V4, e_); } { const int e_ = RFL(s_eid[1]); LOADROW4(r1, V4, e_); } { const int e_ = RFL(s_eid[2]); LOADROW4(r2, V4, e_); } { const int e_ = RFL(s_eid[3]); LOADROW4(r3, V4, e_); }
            for (int j = 0; j < 124; j += 4) {
                VACC4(r0, j);     { const int e_ = RFL(s_eid[j + 4]); LOADROW4(r0, V4, e_); }
                VACC4(r1, j + 1); { const int e_ = RFL(s_eid[j + 5]); LOADROW4(r1, V4, e_); }
                VACC4(r2, j + 2); { const int e_ = RFL(s_eid[j + 6]); LOADROW4(r2, V4, e_); }
                VACC4(r3, j + 3); { const int e_ = RFL(s_eid[j + 7]); LOADROW4(r3, V4, e_); }
            }
            VACC4(r0, 124); VACC4(r1, 125); VACC4(r2, 126); VACC4(r3, 127);
#undef VACC4
#undef LOADROW4
            float ss = 0.f;
#pragma unroll
            for (int i = 0; i < 4; ++i) { float t[16]; load16_bf16(x1 + 1024 * i + 16 * lane, t);
#pragma unroll
                for (int k = 0; k < 16; ++k) { ACC(i, k) += t[k]; ss += ACC(i, k) * ACC(i, k); } }
            ss = wave_sum_dpp(ss);
            const float rs = rsqrtf(ss * (1.0f / D) + 1e-6f);
            if (!FINAL) {
#pragma unroll
                for (int i = 0; i < 4; ++i) { u32x4 w8;
#pragma unroll
                    for (int q = 0; q < 4; ++q) w8[q] = pk4_fp8(ACC(i, 4 * q), ACC(i, 4 * q + 1), ACC(i, 4 * q + 2), ACC(i, 4 * q + 3));
                    *(u32x4*)(XB8n + (size_t)tok * D + 1024 * i + 16 * lane) = w8; }
                if (lane == 0) RSTDn[tok] = rs;
                float mine = 0.f;
#pragma unroll 1
                for (int j = 0; j < 10; ++j) { float s = 0.f;
#pragma unroll
                    for (int i = 0; i < 4; ++i) { const u32x4 g0 = *(const LAS u32x4*)(gfs + j * D + 1024 * i + 16 * lane), g1 = *(const LAS u32x4*)(gfs + j * D + 1024 * i + 16 * lane + 8);
#pragma unroll
                        for (int q = 0; q < 4; ++q) { s += ACC(i, 2 * q) * bf_lo(g0[q]) + ACC(i, 2 * q + 1) * bf_hi(g0[q]); s += ACC(i, 8 + 2 * q) * bf_lo(g1[q]) + ACC(i, 8 + 2 * q + 1) * bf_hi(g1[q]); } }
                    s = wave_sum_dpp(s); if (lane == j) mine = s; }
                if (lane < 10) { const int b_ = tok >> 11, s_ = tok & 2047; LOGFn[(size_t)(b_ * 10 + lane) * S + s_] = logsig(mine * rs + bf_n[lane]); }
            }
            if (FINAL) { float* xo = (float*)XOv + (size_t)tok * D;
#pragma unroll
                for (int i = 0; i < 4; ++i)
#pragma unroll
                    for (int q = 0; q < 4; ++q) { const int c = 1024 * i + 16 * lane + 4 * q; const f32x4 g_ = *(const f32x4*)(fg + c);
                        *(f32x4*)(xo + c) = (f32x4){ACC(i, 4 * q) * rs * g_[0], ACC(i, 4 * q + 1) * rs * g_[1], ACC(i, 4 * q + 2) * rs * g_[2], ACC(i, 4 * q + 3) * rs * g_[3]}; }
            } else { bf16_t* xo = (bf16_t*)XOv + (size_t)tok * D;
#pragma unroll
                for (int i = 0; i < 4; ++i) { u32x4 w0, w1;
#pragma unroll
                    for (int q = 0; q < 4; ++q) { w0[q] = pk2(ACC(i, 2 * q), ACC(i, 2 * q + 1)); w1[q] = pk2(ACC(i, 8 + 2 * q), ACC(i, 8 + 2 * q + 1)); }
                    *(u32x4*)(xo + 1024 * i + 16 * lane) = w0; *(u32x4*)(xo + 1024 * i + 16 * lane + 8) = w1; }
            }
        }
        LDS_WAIT(); asm volatile("" ::: "memory");
    }
#undef ACC
#undef LOADROW6
#undef GRP6
}
}
namespace at {
using namespace mk;
constexpr int QB = 256, KVB = 64, HD = 128;
constexpr int SHM_V = KVB * HD * 2, SHM_K = KVB * HD * 2;
constexpr int OFF_V = 0, OFF_K = 2 * SHM_V, OFF_WS = OFF_K + 2 * SHM_K, OFF_CUM = OFF_WS + 8 * 256, OFF_RT = OFF_CUM + 2048 * 4, OFF_MISC = OFF_RT + 640 * 4;
constexpr float LOG2E = 1.4426950408889634f;
constexpr float THR2 = 10.0f;
constexpr float SB_DONE = -100.0f;

#define AT_KSWZ(row, colB) ((row) * 256 + ((colB) ^ (((row) & 7) << 4)))
__device__ __forceinline__ int v_st(int k, int c) { const int kk = (k & ~0xC) | ((k & 4) << 1) | ((k & 8) >> 1); return ((kk >> 3) * 4 + (c >> 5)) * 512 + ((kk & 7) * 32 + (c & 31)) * 2; }
__device__ __forceinline__ int v_rd_base(int lane) { return ((lane & 3) << 3) | (((lane >> 2) & 3) << 6) | (((lane >> 4) & 1) << 5) | (((lane >> 5) & 1) << 8); }
constexpr int v_rd_off(int d0, int ks, int half) { return d0 * 512 + ks * 4096 + half * 2048; }
__device__ __forceinline__ int crow(int r, int hi) { return (r & 3) + 8 * (r >> 2) + 4 * hi; }
__device__ __forceinline__ unsigned cvtpk(float lo, float hi) { unsigned r; asm volatile("v_cvt_pk_bf16_f32 %0, %1, %2" : "=v"(r) : "v"(lo), "v"(hi)); return r; }
__device__ __forceinline__ float partner(float v, int hi) { auto rr = __builtin_amdgcn_permlane32_swap(__builtin_bit_cast(unsigned, v), __builtin_bit_cast(unsigned, v), false, false); return __builtin_bit_cast(float, hi ? rr[0] : rr[1]); }

__device__ __forceinline__ float xchg_max(float v, int hi) { return fmaxf(v, partner(v, hi)); }
__device__ __forceinline__ float xchg_sum(float v, int hi) { return v + partner(v, hi); }

__device__ __forceinline__ void pack_p(const f32x16& p0, const f32x16& p1, bf16x8& pa0, bf16x8& pa1, bf16x8& pa2, bf16x8& pa3) {
#define AT_PK4(P, B_, OUT) do { unsigned a0 = cvtpk(P[B_ + 0], P[B_ + 1]), a1 = cvtpk(P[B_ + 2], P[B_ + 3]); unsigned b0 = cvtpk(P[B_ + 4], P[B_ + 5]), b1 = cvtpk(P[B_ + 6], P[B_ + 7]); \
        auto r0 = __builtin_amdgcn_permlane32_swap(a0, b0, false, false); auto r1 = __builtin_amdgcn_permlane32_swap(a1, b1, false, false); \
        u32x4 w = {r0[0], r1[0], r0[1], r1[1]}; OUT = __builtin_bit_cast(bf16x8, w); } while (0)
    AT_PK4(p0, 0, pa0); AT_PK4(p0, 8, pa1); AT_PK4(p1, 0, pa2); AT_PK4(p1, 8, pa3);
#undef AT_PK4
}
template <int KBUF>
__device__ __forceinline__ void qkt(f32x16& p0, f32x16& p1, LAS unsigned char* K_lds, int r32, int hi, const bf16x8 (&qr)[8]) {
    p0 = f32x16{}; p1 = f32x16{};
    LAS unsigned char* kb[4];
#pragma unroll
    for (int dd = 0; dd < 4; ++dd) kb[dd] = K_lds + KBUF * SHM_K + AT_KSWZ(r32, (dd * 16 + hi * 8) * 2);
#pragma unroll
    for (int d0 = 0; d0 < 8; ++d0) { LAS unsigned char* a = kb[d0 & 3] + (d0 >> 2) * 128;
        const bf16x8 b0 = *(const LAS bf16x8*)a; const bf16x8 b1 = *(const LAS bf16x8*)(a + 32 * 256);
        p0 = __builtin_amdgcn_mfma_f32_32x32x16_bf16(b0, qr[d0], p0, 0, 0, 0);
        p1 = __builtin_amdgcn_mfma_f32_32x32x16_bf16(b1, qr[d0], p1, 0, 0, 0); }
}
template <int VBUF>
__device__ __forceinline__ void pv_tile(f32x16 (&o)[4], int vb0, bf16x8 pa0, bf16x8 pa1, bf16x8 pa2, bf16x8 pa3) {
#define AT_TRRD(dst, off) asm volatile("ds_read_b64_tr_b16 %0, %1 offset:%2" : "=&v"(dst) : "v"(vb0), "i"(off) : "memory")
#define AT_PV_D0(d0) do { s16x4 l0, l1, l2, l3, h0, h1, h2, h3; constexpr int b_ = VBUF * SHM_V + v_rd_off(d0, 0, 0); \
        AT_TRRD(l0, b_); AT_TRRD(h0, b_ + 2048); AT_TRRD(l1, b_ + 4096); AT_TRRD(h1, b_ + 6144); AT_TRRD(l2, b_ + 8192); AT_TRRD(h2, b_ + 10240); AT_TRRD(l3, b_ + 12288); AT_TRRD(h3, b_ + 14336); \
        asm volatile("s_waitcnt lgkmcnt(0)" ::: "memory"); __builtin_amdgcn_sched_barrier(0); \
        o[d0] = __builtin_amdgcn_mfma_f32_32x32x16_bf16(pa0, (bf16x8){l0[0], l0[1], l0[2], l0[3], h0[0], h0[1], h0[2], h0[3]}, o[d0], 0, 0, 0); \
        o[d0] = __builtin_amdgcn_mfma_f32_32x32x16_bf16(pa1, (bf16x8){l1[0], l1[1], l1[2], l1[3], h1[0], h1[1], h1[2], h1[3]}, o[d0], 0, 0, 0); \
        o[d0] = __builtin_amdgcn_mfma_f32_32x32x16_bf16(pa2, (bf16x8){l2[0], l2[1], l2[2], l2[3], h2[0], h2[1], h2[2], h2[3]}, o[d0], 0, 0, 0); \
        o[d0] = __builtin_amdgcn_mfma_f32_32x32x16_bf16(pa3, (bf16x8){l3[0], l3[1], l3[2], l3[3], h3[0], h3[1], h3[2], h3[3]}, o[d0], 0, 0, 0); } while (0)
    AT_PV_D0(0); AT_PV_D0(1); AT_PV_D0(2); AT_PV_D0(3);
#undef AT_PV_D0
#undef AT_TRRD
}

template <int VAR>
__device__ __forceinline__ void attn_item(const bf16_t* Qh, const bf16_t* Kh, const bf16_t* Vh, bf16_t* OB, const float* relb, const float* LOGF, int b, int h, int qb, LAS unsigned char* lds, int tid) {
    const int wid = __builtin_amdgcn_readfirstlane(tid >> 6), lane = tid & 63, r32 = lane & 31, hi = lane >> 5;
    const int g = VAR == 0 ? h : (VAR == 1 ? 12 + h : 22 + h);
    const size_t hb = (size_t)(b * NH + g) * S * HD;
    const bf16_t* Kp = Kh + hb; const bf16_t* Vp = Vh + hb;
    LAS unsigned char* V_lds = lds + OFF_V; LAS unsigned char* K_lds = lds + OFF_K;
    LAS float* wsf = (LAS float*)(lds + OFF_WS) + wid * 64; LAS float* li_l = wsf; LAS float* al_l = wsf + 32;
    LAS float* cumL = (LAS float*)(lds + OFF_CUM); LAS float* Rt = (LAS float*)(lds + OFF_RT); volatile LAS unsigned* flags = (volatile LAS unsigned*)(lds + OFF_MISC);
    const int P0 = qb * QB, qlo = P0 + wid * 32, qpos = qlo + r32;
    int NT, jlo = 0;
    if (VAR == 0) { jlo = 4 * qb - 8; if (jlo < 0) jlo = 0; NT = 4 * qb + 4 - jlo; } else NT = 4 * qb + 4;
    const int cw = 4 * qb + (wid >> 1);
#define AT_KBASE(t) (VAR == 1 ? (4 * qb + 3 - (t)) * KVB : (jlo + (t)) * KVB)
#define AT_ACT(t) (VAR == 0 ? ((jlo + (t)) >= cw - 8 && (jlo + (t)) <= cw) : (VAR == 1 ? (AT_KBASE(t) <= qlo + 30) : (AT_KBASE(t) <= qlo + 31)))
    if (VAR == 0) {
        const float* tab = relb + h * 257;
        for (int j = tid; j < 639; j += 512) { int rel = 575 - j; rel = rel < -128 ? -128 : (rel > 128 ? 128 : rel); Rt[j] = tab[rel + 128] * LOG2E; }
    }
    if (VAR == 2) {
        const float* lf = LOGF + (size_t)(b * 10 + h) * S; const int kend = P0 + QB;
        f32x4 v = (f32x4){0.f, 0.f, 0.f, 0.f};
        if (4 * tid < kend) v = *(const f32x4*)(lf + 4 * tid);
        v[1] += v[0]; v[2] += v[1]; v[3] += v[2];
        float tot = v[3];
#pragma unroll
        for (int o = 1; o < 64; o <<= 1) { const float t_ = lane_read(tot, lane >= o ? lane - o : lane); if (lane >= o) tot += t_; }
        if (lane == 63) li_l[0] = tot;
        __syncthreads();
        float base = tot - v[3];
        for (int w = 0; w < wid; ++w) base += ((LAS float*)(lds + OFF_WS))[w * 64];
        if (4 * tid < kend) *(LAS f32x4*)(cumL + 4 * tid) = (f32x4){(base + v[0]) * LOG2E, (base + v[1]) * LOG2E, (base + v[2]) * LOG2E, (base + v[3]) * LOG2E};
    }
    bf16x8 qr[8];
    { const bf16_t* qp = Qh + hb + (size_t)(qlo + r32) * HD + hi * 8;
#pragma unroll
      for (int d0 = 0; d0 < 8; ++d0) qr[d0] = *(const bf16x8*)(qp + d0 * 16); }
    const int sr = tid >> 4, sc = (tid & 15) * 8, vst0 = v_st(sr, sc), vst1 = v_st(32 + sr, sc), kws = AT_KSWZ(sr, sc * 2);
    const int vb0 = (int)(unsigned)(size_t)V_lds + v_rd_base(lane);
    bf16x8 st_k0, st_k1, st_v0, st_v1;
#define AT_SLOAD(k0) do { const bf16_t* kp_ = Kp + (size_t)((k0) + sr) * HD + sc; const bf16_t* vp_ = Vp + (size_t)((k0) + sr) * HD + sc; \
        st_k0 = *(const bf16x8*)kp_; st_k1 = *(const bf16x8*)(kp_ + 32 * HD); st_v0 = *(const bf16x8*)vp_; st_v1 = *(const bf16x8*)(vp_ + 32 * HD); } while (0)
#define AT_SWRITE(bf) do { *(LAS bf16x8*)(K_lds + (bf) * SHM_K + kws) = st_k0; *(LAS bf16x8*)(K_lds + (bf) * SHM_K + kws + 32 * 256) = st_k1; \
        *(LAS bf16x8*)(V_lds + (bf) * SHM_V + vst0) = st_v0; *(LAS bf16x8*)(V_lds + (bf) * SHM_V + vst1) = st_v1; } while (0)
    AT_SLOAD(AT_KBASE(0)); asm volatile("s_waitcnt vmcnt(0)" ::: "memory"); AT_SWRITE(0);
    __syncthreads();
    float m_reg = -1e30f, l_reg = 0.f, carry = 0.f;
    f32x16 o[4] = {};
#define AT_STEP(BUF, t) do { \
        const bool more_ = (t) + 1 < NT; \
        if (more_) AT_SLOAD(AT_KBASE((t) + 1)); \
        if (AT_ACT(t)) { \
            const int kb_ = AT_KBASE(t); f32x16 p0, p1; bf16x8 pa0, pa1, pa2, pa3; \
            qkt<BUF>(p0, p1, K_lds, r32, hi, qr); \
            tile_math(p0, p1, kb_, pa0, pa1, pa2, pa3); \
            pv_tile<BUF>(o, vb0, pa0, pa1, pa2, pa3); \
        } \
        if (more_) { asm volatile("s_waitcnt vmcnt(0)" ::: "memory"); AT_SWRITE((BUF) ^ 1); } \
        if (VAR == 1) { const bool done_ = __all(carry < SB_DONE); if (lane == 0) flags[((t) & 1) * 8 + wid] = done_ ? 1u : 0u; } \
        __syncthreads(); \
    } while (0)
    auto tile_math = [&](f32x16& p0, f32x16& p1, int kb, bf16x8& pa0, bf16x8& pa1, bf16x8& pa2, bf16x8& pa3) __attribute__((always_inline)) {
        const int dq = qpos - kb - 4 * hi;
        if (VAR == 1) {
            const bool need_mask = kb + 63 >= qlo;
            f32x16 n0, n1;
#pragma unroll
            for (int r = 0; r < 16; ++r) { const float z = p0[r]; const float lp = __builtin_amdgcn_logf(1.0f + __builtin_amdgcn_exp2f(-fabsf(z))); n0[r] = fminf(-z, 0.f) - lp;
                                           const float y = p1[r]; const float lq = __builtin_amdgcn_logf(1.0f + __builtin_amdgcn_exp2f(-fabsf(y))); n1[r] = fminf(-y, 0.f) - lq; }
            if (need_mask) {
#pragma unroll
                for (int r = 0; r < 16; ++r) { const int c = (r & 3) + 8 * (r >> 2);
                    if (dq - c <= 0) { n0[r] = 0.f; p0[r] = -__builtin_inff(); }
                    if (dq - c - 32 <= 0) { n1[r] = 0.f; p1[r] = -__builtin_inff(); } }
            }
            float A[8], Bp[8];
#pragma unroll
            for (int q = 0; q < 4; ++q) { A[q] = (n0[4 * q] + n0[4 * q + 1]) + (n0[4 * q + 2] + n0[4 * q + 3]); A[4 + q] = (n1[4 * q] + n1[4 * q + 1]) + (n1[4 * q + 2] + n1[4 * q + 3]); }
#pragma unroll
            for (int q = 0; q < 8; ++q) Bp[q] = partner(A[q], hi);
            float st = 0.f;
#pragma unroll
            for (int q = 7; q >= 0; --q) {
                const float after = carry + st + (hi == 0 ? Bp[q] : 0.f);
                if (q >= 4) { const int r0 = 4 * (q - 4);
                    float tl = after; p1[r0 + 3] = __builtin_amdgcn_exp2f(p1[r0 + 3] + n1[r0 + 3] + tl); tl += n1[r0 + 3]; p1[r0 + 2] = __builtin_amdgcn_exp2f(p1[r0 + 2] + n1[r0 + 2] + tl); tl += n1[r0 + 2];
                    p1[r0 + 1] = __builtin_amdgcn_exp2f(p1[r0 + 1] + n1[r0 + 1] + tl); tl += n1[r0 + 1]; p1[r0] = __builtin_amdgcn_exp2f(p1[r0] + n1[r0] + tl); }
                else { const int r0 = 4 * q;
                    float tl = after; p0[r0 + 3] = __builtin_amdgcn_exp2f(p0[r0 + 3] + n0[r0 + 3] + tl); tl += n0[r0 + 3]; p0[r0 + 2] = __builtin_amdgcn_exp2f(p0[r0 + 2] + n0[r0 + 2] + tl); tl += n0[r0 + 2];
                    p0[r0 + 1] = __builtin_amdgcn_exp2f(p0[r0 + 1] + n0[r0 + 1] + tl); tl += n0[r0 + 1]; p0[r0] = __builtin_amdgcn_exp2f(p0[r0] + n0[r0] + tl); }
                st += A[q] + Bp[q];
            }
            carry += st;
            pack_p(p0, p1, pa0, pa1, pa2, pa3);
        } else {
            if (VAR == 0) {
                const LAS float* rp = Rt + (575 - (qpos - kb) + 4 * hi);
#pragma unroll
                for (int r = 0; r < 16; ++r) { const int c = (r & 3) + 8 * (r >> 2); p0[r] += rp[c]; p1[r] += rp[c + 32]; }
            } else {
                const LAS float* cp = cumL + kb + 4 * hi;
#pragma unroll
                for (int q = 0; q < 4; ++q) { const f32x4 c0 = *(const LAS f32x4*)(cp + 8 * q), c1 = *(const LAS f32x4*)(cp + 32 + 8 * q);
                    p0[4 * q] -= c0[0]; p0[4 * q + 1] -= c0[1]; p0[4 * q + 2] -= c0[2]; p0[4 * q + 3] -= c0[3];
                    p1[4 * q] -= c1[0]; p1[4 * q + 1] -= c1[1]; p1[4 * q + 2] -= c1[2]; p1[4 * q + 3] -= c1[3]; }
                if (kb + 63 > qlo) {
#pragma unroll
                    for (int r = 0; r < 16; ++r) { const int c = (r & 3) + 8 * (r >> 2);
                        if (dq - c < 0) p0[r] = -__builtin_inff();
                        if (dq - c - 32 < 0) p1[r] = -__builtin_inff(); }
                }
            }
            float pmax = p0[0];
#pragma unroll
            for (int r = 1; r < 16; ++r) pmax = fmaxf(pmax, p0[r]);
#pragma unroll
            for (int r = 0; r < 16; ++r) pmax = fmaxf(pmax, p1[r]);
            pmax = xchg_max(pmax, hi);
            float mn, alpha;
            if (__all(pmax - m_reg <= THR2)) { mn = m_reg; alpha = 1.f; }
            else { mn = fmaxf(m_reg, pmax); alpha = __builtin_amdgcn_exp2f(m_reg - mn); m_reg = mn; }
            float ps = 0.f;
#pragma unroll
            for (int r = 0; r < 16; ++r) { p0[r] = __builtin_amdgcn_exp2f(p0[r] - mn); p1[r] = __builtin_amdgcn_exp2f(p1[r] - mn); ps += p0[r] + p1[r]; }
            ps = xchg_sum(ps, hi);
            l_reg = l_reg * alpha + ps;
            if (__any(alpha < 1.f)) {
                if (hi == 0) al_l[r32] = alpha;
                asm volatile("s_waitcnt lgkmcnt(0)" ::: "memory");
                float av[16];
#pragma unroll
                for (int r = 0; r < 16; ++r) av[r] = al_l[crow(r, hi)];
#pragma unroll
                for (int d = 0; d < 4; ++d)
#pragma unroll
                    for (int r = 0; r < 16; ++r) o[d][r] *= av[r];
            }
            pack_p(p0, p1, pa0, pa1, pa2, pa3);
        }
    };
    for (int t = 0; t < NT; t += 2) {
        AT_STEP(0, t);
        if (VAR == 1) { unsigned all_ = 1u; for (int w = 0; w < 8; ++w) all_ &= flags[(t & 1) * 8 + w]; if (all_) break; }
        if (t + 1 >= NT) break;
        AT_STEP(1, t + 1);
        if (VAR == 1) { unsigned all_ = 1u; for (int w = 0; w < 8; ++w) all_ &= flags[((t + 1) & 1) * 8 + w]; if (all_) break; }
    }
    float rli[16];
    if (VAR != 1) {
        if (hi == 0) li_l[r32] = l_reg;
        asm volatile("s_waitcnt lgkmcnt(0)" ::: "memory");
#pragma unroll
        for (int r = 0; r < 16; ++r) rli[r] = __builtin_amdgcn_rcpf(li_l[crow(r, hi)]);
    }
    unsigned char* Ow8 = (unsigned char*)OB + (size_t)(b * S + qlo) * D + g * HD;
#pragma unroll
    for (int r = 0; r < 16; ++r) { const int orow = crow(r, hi);
#pragma unroll
        for (int d0 = 0; d0 < 4; ++d0) { const float v = VAR != 1 ? o[d0][r] * rli[r] : o[d0][r];
            const float vn = lane_read(v, lane ^ 1);
            if ((r32 & 1) == 0) *(unsigned short*)(Ow8 + (size_t)orow * D + d0 * 32 + r32) = (unsigned short)__builtin_amdgcn_cvt_pk_fp8_f32(clamp8(v * 16.0f), clamp8(vn * 16.0f), 0, false); } }
    __syncthreads();
#undef AT_STEP
#undef AT_SLOAD
#undef AT_SWRITE
#undef AT_KBASE
#undef AT_ACT
}

template <int VAR>
__device__ __forceinline__ void attn_queue(const bf16_t* Qh, const bf16_t* Kh, const bf16_t* Vh, bf16_t* OB, const float* relb, const float* LOGF, unsigned* qhead, LAS unsigned char* lds, int wave0) {
    FRESH_TID(); FRESH_LDS(lds);
    volatile LAS unsigned* qslot = (volatile LAS unsigned*)(lds + OFF_MISC) + 32;
    constexpr int NHV = VAR == 0 ? 12 : 10, NITEMS = 8 * NHV * 8;
    for (;;) {
        if (tid == 0) qslot[0] = __hip_atomic_fetch_add(qhead, 1u, __ATOMIC_RELAXED, __HIP_MEMORY_SCOPE_AGENT);
        __syncthreads();
        const int idx = (int)qslot[0];
        __syncthreads();
        if (idx >= NITEMS) break;
        const int qb = 7 - idx / (8 * NHV), bh = idx % (8 * NHV);
        attn_item<VAR>(Qh, Kh, Vh, OB, relb, LOGF, bh / NHV, bh % NHV, qb, lds, tid);
    }
}
__device__ __forceinline__ void attn_phase(const bf16_t* Qh, const bf16_t* Kh, const bf16_t* Vh, bf16_t* OB, const float* relb, const float* LOGF, unsigned* qheads, LAS unsigned char* lds, int wave0) {
    attn_queue<2>(Qh, Kh, Vh, OB, relb, LOGF, qheads + 0, lds, wave0);
    attn_queue<0>(Qh, Kh, Vh, OB, relb, LOGF, qheads + 64, lds, wave0);
    attn_queue<1>(Qh, Kh, Vh, OB, relb, LOGF, qheads + 128, lds, wave0);
}
}
namespace mk {
#define XB_TMO      128
#define XB_XCNT(j)  (256  + 64 * (j))
#define XB_XSUB(j)  (1280 + 64 * (j))
#define XB_XGEN(j)  (2304 + 64 * (j))
#define XB_TOP      3328
#define XB_TOPGEN   3392
#define XCD_BAR_WORDS 3456
#define XB_SPIN_CAP (1u << 22)

__device__ __forceinline__ unsigned xb_ld(unsigned* p)              { return __hip_atomic_load(p, __ATOMIC_RELAXED, __HIP_MEMORY_SCOPE_AGENT); }
__device__ __forceinline__ unsigned xb_add(unsigned* p, unsigned v) { return __hip_atomic_fetch_add(p, v, __ATOMIC_RELAXED, __HIP_MEMORY_SCOPE_AGENT); }
__device__ __forceinline__ unsigned xb_xcc_id() { return (unsigned)__builtin_amdgcn_s_getreg((3 << 11) | 20) & 0xFu; }
#define XB_SPIN(cond, bar) do { unsigned _sp = 0; while (cond) { __builtin_amdgcn_s_sleep(1); \
    if ((++_sp & 255u) == 0u) { if (xb_ld(&(bar)[XB_TMO])) break; if (_sp > XB_SPIN_CAP) { atomicAdd(&(bar)[XB_TMO], 1u); break; } } } } while (0)

struct XcdBarrier {
    unsigned* bar; unsigned x;
    volatile LAS unsigned* st;
};

__device__ __forceinline__ XcdBarrier xcd_barrier_post(unsigned* bar, volatile LAS unsigned* st, bool is_t0) {
    XcdBarrier b; b.bar = bar; b.x = xb_xcc_id(); b.st = st;
    if (is_t0) (void)xb_add(&bar[XB_XCNT(b.x)], 1u);
    return b;
}
__device__ __forceinline__ void xcd_barrier_complete(unsigned* bar, unsigned x, unsigned& nloc, unsigned& nx) {
    const unsigned G = gridDim.x * gridDim.y * gridDim.z;
    unsigned sum, cnt, mine, sp = 0u;
    for (;;) {
        sum = 0u; cnt = 0u; mine = 0u;
#pragma unroll
        for (unsigned j = 0; j < 16; ++j) { const unsigned c = xb_ld(&bar[XB_XCNT(j)]); sum += c; cnt += (c > 0u) ? 1u : 0u; mine = (j == x) ? c : mine; }
        if (sum == G) break;
        __builtin_amdgcn_s_sleep(1);
        if ((++sp & 255u) == 0u) { if (xb_ld(&bar[XB_TMO])) break; if (sp > XB_SPIN_CAP) { atomicAdd(&bar[XB_TMO], 1u); break; } }
    }
    nloc = mine > 0u ? mine : 1u; nx = cnt > 0u ? cnt : 1u;
}

__device__ __forceinline__ void xcd_barrier(const XcdBarrier& b, bool is_t0) {
    asm volatile("s_waitcnt vmcnt(0)" ::: "memory");
    __syncthreads();
    if (is_t0) {
        unsigned* bar = b.bar;
        __builtin_amdgcn_s_waitcnt(0);
        unsigned nloc = b.st[0], nx = b.st[1];
        if (nloc == 0u) { xcd_barrier_complete(bar, b.x, nloc, nx); b.st[0] = nloc; b.st[1] = nx; }
        const unsigned old = xb_add(&bar[XB_XSUB(b.x)], 1u);
        const unsigned gen = old / nloc;
        if (old + 1u == (gen + 1u) * nloc) {
            __builtin_amdgcn_fence(__ATOMIC_RELEASE, "agent");
            asm volatile("s_waitcnt vmcnt(0)" ::: "memory");
            const unsigned og = xb_add(&bar[XB_TOP], 1u);
            const unsigned tg = og / nx;
            if (og + 1u == (tg + 1u) * nx) xb_add(&bar[XB_TOPGEN], 1u);
            else XB_SPIN(xb_ld(&bar[XB_TOPGEN]) == tg, bar);
            __builtin_amdgcn_fence(__ATOMIC_ACQUIRE, "agent");
            xb_add(&bar[XB_XGEN(b.x)], 1u);
            asm volatile("s_waitcnt vmcnt(0)" ::: "memory");
        } else {
            XB_SPIN(xb_ld(&bar[XB_XGEN(b.x)]) == gen, bar);
            __builtin_amdgcn_fence(__ATOMIC_ACQUIRE, "agent");
            asm volatile("s_waitcnt vmcnt(0)" ::: "memory");
        }
    }
    __syncthreads();
}

constexpr int PH_PER_LAYER = 8;
typedef const __attribute__((address_space(4))) Args* KArgs;
#define KARGS() ({ KArgs p_ = (KArgs)__builtin_amdgcn_kernarg_segment_ptr(); asm volatile("" : "+s"(p_)); p_; })
#define GRID_BAR() do { KArgs k_ = KARGS(); XcdBarrier b_; b_.bar = (unsigned*)(k_->ws + WS_CTL) + CW_BAR; b_.x = xb_xcc_id(); b_.st = (volatile LAS unsigned*)(lds + MISC_OFF) + 8; unsigned z_ = 0u; asm volatile("" : "+v"(z_)); const bool t0_ = (wave0 == 0) && (__builtin_amdgcn_mbcnt_hi(~0u, __builtin_amdgcn_mbcnt_lo(~0u, z_)) == 0u);     xcd_barrier(b_, t0_); } while (0)
__global__ void __launch_bounds__(NWAVES * 64, 2) mk_fwd(Args a_unused) {
    extern __shared__ __attribute__((aligned(16))) unsigned char lds_raw[];
    LAS unsigned char* lds = (LAS unsigned char*)lds_raw;
    const int wave0 = __builtin_amdgcn_readfirstlane((int)threadIdx.x >> 6);
    for (int u = threadIdx.x; u < (LDS_BYTES - LDSCTL_OFF) / 4; u += NWAVES * 64) ((LAS unsigned*)(lds + LDSCTL_OFF))[u] = 0u;
    __syncthreads();
    int lo, hi;
    { KArgs k = KARGS(); lo = k->ph_lo; hi = k->ph_hi;
      if (hi - lo > 1) (void)xcd_barrier_post((unsigned*)(k->ws + WS_CTL) + CW_BAR, (volatile LAS unsigned*)(lds + MISC_OFF) + 8, threadIdx.x == 0); }
#define IN(k) (lo <= (k) && (k) < hi)
#define BOTH(k) (IN(k) && IN((k) + 1))
#pragma unroll
    for (int l = 0; l < 2; ++l) {
        const int pb = PH_PER_LAYER * l;
        if (IN(pb + 0)) { KArgs k = KARGS(); conv_phase(k, l, lds, wave0); }
        if (IN(pb + 1) && l == 0) {
            KArgs k = KARGS(); unsigned char* ws = k->ws;
            const float* xin = k->in[0];
            prep_phase<true>(xin, (bf16_t*)(ws + WS_XB8N), (float*)(ws + WS_RSTD), k->in[2] + (size_t)l * D * PW, k->in[1] + (size_t)l * D, k->in[3] + l * 10, (float*)(ws + WS_LOGF), lds, wave0);
            if (BOTH(pb + 1)) GRID_BAR();
        }
        if (l == 1 && IN(pb + 0) && IN(pb + 2)) GRID_BAR();
        if (IN(pb + 2)) {
            KArgs k = KARGS(); unsigned char* ws = k->ws;
            pg8::Gemm g{(const bf16_t*)(ws + WS_XB8N), (const bf16_t*)(ws + WS_WIN), M, 12288, D}; pg8::StaticOrder So; FRESH_BID(); So.init(M, 12288, G, bid);
            pg8::EpiQKV4 E{(bf16_t*)(ws + WS_Q), (const float*)(ws + WS_RSTD), 0.08838834764831845f * 1.4426950408889634f, US_INV};
            { LAS unsigned char* lds_ = lds; FRESH_LDS(lds_); FRESH_TID(); pg8::gemm_phase<pg8::EpiQKV4, pg8::StaticOrder, true, true, true>(lds_, g, So, E, tid); }
            if (BOTH(pb + 2)) GRID_BAR();
        }
        if (IN(pb + 3)) {
            KArgs k = KARGS(); unsigned char* ws = k->ws;
            at::attn_phase((const bf16_t*)(ws + WS_Q), (const bf16_t*)(ws + WS_K), (const bf16_t*)(ws + WS_V), (bf16_t*)(ws + WS_OB), k->in[4] + (size_t)l * 12 * 257, (const float*)(ws + WS_LOGF),
                           (unsigned*)(ws + WS_CTL) + CW_QUEUE + 256 * l, lds, wave0);
            if (BOTH(pb + 3)) GRID_BAR();
        }
        if (IN(pb + 4)) {
            KArgs k = KARGS(); unsigned char* ws = k->ws;
            pg8::Gemm g{(const bf16_t*)(ws + WS_OB), (const bf16_t*)(ws + WS_WOUT), M, D, D}; pg8::StaticOrder So; FRESH_BID(); So.init(M, D, G, bid);
            if (l == 0) { pg8::EpiResidB16<true> E{k->in[0], US_INV * (1.0f / 16.0f), (bf16_t*)(ws + WS_XB)};
                { LAS unsigned char* lds_ = lds; FRESH_LDS(lds_); FRESH_TID(); pg8::gemm_phase<pg8::EpiResidB16<true>, pg8::StaticOrder, false, true, true>(lds_, g, So, E, tid); } }
            else { pg8::EpiResidB16<false> E{ws + WS_X2, US_INV * (1.0f / 16.0f), (bf16_t*)(ws + WS_XB)};
                { LAS unsigned char* lds_ = lds; FRESH_LDS(lds_); FRESH_TID(); pg8::gemm_phase<pg8::EpiResidB16<false>, pg8::StaticOrder, false, true, true>(lds_, g, So, E, tid); } }
            if (BOTH(pb + 4)) GRID_BAR();
        }
        if (IN(pb + 5)) {
            KArgs k = KARGS(); unsigned char* ws = k->ws;
            pg8::Gemm g{(const bf16_t*)(ws + WS_XB), (const bf16_t*)(ws + WS_WQK), M, 2048, D}; pg8::StaticOrder So; FRESH_BID(); So.init(M, 2048, G, bid);
            pg8::EpiPlainF32<2048> E{(float*)(ws + WS_SC)};
            { LAS unsigned char* lds_ = lds; FRESH_LDS(lds_); FRESH_TID(); pg8::gemm_phase<pg8::EpiPlainF32<2048>, pg8::StaticOrder, true, true>(lds_, g, So, E, tid); }
            if (BOTH(pb + 5)) GRID_BAR();
        }
        if (IN(pb + 6)) {
            KArgs k = KARGS(); unsigned char* ws = k->ws;
            peer_u_phase((const float*)(ws + WS_SC), (const unsigned char*)(ws + WS_U16), (const bf16_t*)(ws + WS_XB), (int*)(ws + WS_K), (float*)(ws + WS_K + 8 * MiB), lds, wave0);
            if (BOTH(pb + 6)) GRID_BAR();
        }
        if (IN(pb + 7)) {
            KArgs k = KARGS(); unsigned char* ws = k->ws;
            if (l == 0) peer_v_phase<false>((const int*)(ws + WS_K), (const float*)(ws + WS_K + 8 * MiB), (const unsigned char*)(ws + WS_U16) + (size_t)NE * ROW6  , (const bf16_t*)(ws + WS_XB), ws + WS_X2, nullptr,
                                            ws + WS_XB8N, (float*)(ws + WS_RSTD), (float*)(ws + WS_LOGF), k->in[2] + (size_t)D * PW, k->in[1] + D, k->in[3] + 10, lds, wave0);
            else peer_v_phase<true>((const int*)(ws + WS_K), (const float*)(ws + WS_K + 8 * MiB), (const unsigned char*)(ws + WS_U16) + (size_t)NE * ROW6  , (const bf16_t*)(ws + WS_XB), k->out, k->in[12],
                                    nullptr, nullptr, nullptr, nullptr, nullptr, nullptr, lds, wave0);
            if (BOTH(pb + 7)) GRID_BAR();
        }
    }
#undef IN
#undef BOTH
}

static int g_grid = 0;
static void launch_phases(Args a, int lo, int hi, hipStream_t st) {
    a.ph_lo = lo; a.ph_hi = hi;
    hipLaunchKernelGGL(mk_fwd, dim3(g_grid), dim3(NWAVES * 64), LDS_BYTES, st, a);
}
}

extern "C" void kernel_launch(void* const* d_in, const int* in_sizes, int n_in, void* d_out, int out_size, void* d_ws, size_t ws_size, hipStream_t stream) {
    (void)in_sizes; (void)n_in; (void)out_size;
    using namespace mk;
    if (g_grid == 0) {
        if (ws_size < 2048 * MiB) { fprintf(stderr, "kernel_launch: workspace too small (%zu)\n", ws_size); g_grid = -1; return; }
        if (hipFuncSetAttribute((const void*)mk_fwd, hipFuncAttributeMaxDynamicSharedMemorySize, LDS_BYTES) != hipSuccess) { fprintf(stderr, "kernel_launch: hipFuncSetAttribute failed\n"); g_grid = -1; return; }
        int dev = 0, cus = 0; (void)hipGetDevice(&dev); (void)hipDeviceGetAttribute(&cus, hipDeviceAttributeMultiprocessorCount, dev);
        g_grid = cus > 0 ? cus : 256;
    }
    if (g_grid < 0) return;
    unsigned char* ws = (unsigned char*)d_ws; float* out = (float*)d_out;
    (void)hipMemsetAsync(ws + WS_CTL, 0, CTL_ZERO_BYTES, stream);
    Args a{};
    for (int i = 0; i < 13; ++i) a.in[i] = (const float*)d_in[i];
    a.out = out; a.ws = ws;
    launch_phases(a, 0, 2 * PH_PER_LAYER, stream);
}
```

```cpp
#include <hip/hip_runtime.h>
#include <cstdio>
#include <cstdint>
namespace pg8 {
#define PG8_LAS __attribute__((address_space(3)))
typedef unsigned short bf16_t;
typedef short bf16x8 __attribute__((ext_vector_type(8)));
typedef float f32x4 __attribute__((ext_vector_type(4)));
typedef unsigned u32x4 __attribute__((ext_vector_type(4)));
typedef unsigned u32x2 __attribute__((ext_vector_type(2)));
constexpr int BM = 256, BK = 64, HALF = 128, HTB = HALF * BK * 2  , STAGE_BYTES = 8 * HTB, NXCD = 8, WGM = 8;

__host__ __device__ __forceinline__ int lds_byte(int r, int c) { const int st = (r >> 4) * 2 + (c >> 5), rr = r & 15, cc = c & 31, ob = rr * 64 + cc * 2; return st * 1024 + (ob ^ (((ob >> 9) & 1) << 5)); }
__host__ __device__ __forceinline__ void stage_rc(int b, int& R, int& C) { const int st = b / 1024, sb = b % 1024, swz = sb ^ (((sb >> 9) & 1) << 5); R = (st >> 1) * 16 + swz / 64; C = (st & 1) * 32 + (swz % 64) / 2; }
__host__ __device__ __forceinline__ int perm32(int rho) { const int n = rho >> 4, i = rho & 15; return 8 * (i >> 2) + 4 * n + (i & 3); }

struct Unit { int pm, pn; };
struct Gemm { const bf16_t* A; const bf16_t* Bt; int M, N, K; };

struct StaticOrder {
    int nM, nN, nwg, G, c;
    __host__ __device__ void init(int M, int N, int G_, int c_) { nM = M / BM; nN = N / BM; nwg = nM * nN; G = G_; c = c_; }
    __host__ __device__ bool next(int i, Unit& u) const {
        const long L = (long)i * G + c; if (L >= nwg) return false;
        int wgid = (int)L; { const int q = nwg / NXCD, r = nwg % NXCD, xcd = wgid % NXCD, off = wgid / NXCD; wgid = (xcd < r ? xcd * (q + 1) : r * (q + 1) + (xcd - r) * q) + off; }
        const int nig = WGM * nN, gid = wgid / nig, fm = gid * WGM, gsz = (nM - fm) < WGM ? (nM - fm) : WGM;
        u.pm = fm + ((wgid % nig) % gsz); u.pn = (wgid % nig) / gsz; return true;
    }
    __device__ __forceinline__ void a_ready(const Unit&) const {}
    __device__ __forceinline__ void done(const Unit&) const {}
};
__device__ __forceinline__ unsigned cvt_pk_bf16(float lo, float hi) { unsigned r; asm volatile("v_cvt_pk_bf16_f32 %0, %1, %2" : "=v"(r) : "v"(lo), "v"(hi)); return r; }
typedef float f32x2 __attribute__((ext_vector_type(2)));
__device__ __forceinline__ f32x2 gelu_pk(f32x2 v) {
    const f32x2 av = __builtin_elementwise_abs(v), d = av * 0.2316418882f + 1.0f;
    f32x2 t; t.x = __builtin_amdgcn_rcpf(d.x); t.y = __builtin_amdgcn_rcpf(d.y);
    f32x2 q = t * 0.5307027145f + (-0.7265760135f); q = q * t + 0.7107068705f; q = q * t + (-0.142248368f); q = q * t + 0.127414796f; q = q * t;
    const f32x2 s = (v * v) * (-0.72134752044f);
    f32x2 e; e.x = __builtin_amdgcn_exp2f(s.x); e.y = __builtin_amdgcn_exp2f(s.y);
    const f32x2 m = v * (q * e), r = v - m;
    f32x2 o; o.x = v.x < 0.f ? m.x : r.x; o.y = v.y < 0.f ? m.y : r.y; return o;
}
#define EPI_FRESH_LANE() { unsigned z_ = 0u; asm volatile("" : "+v"(z_)); const int l_ = (int)__builtin_amdgcn_mbcnt_hi(~0u, __builtin_amdgcn_mbcnt_lo(~0u, z_)); fr = l_ & 15; fq = l_ >> 4; }
typedef __amdgpu_buffer_rsrc_t rsrc_t;
__device__ __forceinline__ rsrc_t mkrsrc(const void* p, unsigned bytes) { return __builtin_amdgcn_make_buffer_rsrc((void*)p, (short)0, (int)bytes, 0x00020000); }
template <int LDC> struct EpiPlainF32 {
    static constexpr bool PERM = false, AFTER_DRAIN = false;
    float* C;
    __device__ __forceinline__ void operator()(const f32x4 (&acc)[2][2][4][2], const Unit& u, int wr, int wc, int fr, int fq) const {
        EPI_FRESH_LANE();
        const rsrc_t rc = mkrsrc(C, 16384u * LDC * 4u);
        const int vo = ((wr * 64 + fr) * LDC + wc * 32 + 4 * fq) * 4, so = (u.pm * BM * LDC + u.pn * BM) * 4;
#pragma unroll
        for (int ai = 0; ai < 2; ++ai)
#pragma unroll
            for (int m = 0; m < 4; ++m)
#pragma unroll
                for (int bj = 0; bj < 2; ++bj)
#pragma unroll
                    for (int n = 0; n < 2; ++n) __builtin_amdgcn_raw_buffer_store_b128(__builtin_bit_cast(u32x4, acc[ai][bj][m][n]), rc, vo, so + ((ai * HALF + m * 16) * LDC + bj * HALF + n * 16) * 4, 0);
    }
};
template <int LDC> struct EpiRowScaleF32 {
    static constexpr bool PERM = false, AFTER_DRAIN = false;
    float* C; const float* rs;
    __device__ __forceinline__ void operator()(const f32x4 (&acc)[2][2][4][2], const Unit& u, int wr, int wc, int fr, int fq) const {
        const rsrc_t rc = mkrsrc(C, 16384u * LDC * 4u), rr = mkrsrc(rs, 16384u * 4u);
        const int vo = ((wr * 64 + fr) * LDC + wc * 32 + 4 * fq) * 4, vr = (wr * 64 + fr) * 4;
        const int so = (u.pm * BM * LDC + u.pn * BM) * 4, sr = u.pm * BM * 4;
#pragma unroll
        for (int ai = 0; ai < 2; ++ai)
#pragma unroll
            for (int m = 0; m < 4; ++m) { const float s = __builtin_bit_cast(float, __builtin_amdgcn_raw_buffer_load_b32(rr, vr, sr + (ai * HALF + m * 16) * 4, 0));
#pragma unroll
                for (int bj = 0; bj < 2; ++bj)
#pragma unroll
                    for (int n = 0; n < 2; ++n) { const f32x4 v = acc[ai][bj][m][n] * s; __builtin_amdgcn_raw_buffer_store_b128(__builtin_bit_cast(u32x4, v), rc, vo, so + ((ai * HALF + m * 16) * LDC + bj * HALF + n * 16) * 4, 0); } }
    }
};
template <bool BASE_F32> struct EpiResidB16 {
    static constexpr bool PERM = false, AFTER_DRAIN = false;
    const void* base; float ascale; bf16_t* xb;
    __device__ __forceinline__ void operator()(const f32x4 (&acc)[2][2][4][2], const Unit& u, int wr, int wc, int fr, int fq) const {
        EPI_FRESH_LANE();
        constexpr int LDC = 4096;
        const rsrc_t rb = mkrsrc(base, 16384u * LDC * (BASE_F32 ? 4u : 2u)), rx = mkrsrc(xb, 16384u * LDC * 2u);
        const int vo = ((wr * 64 + fr) * LDC + wc * 32 + 4 * fq) * 2;
        const int so = (u.pm * BM * LDC + u.pn * BM) * 2;
        f32x4 ra[2][2], rb2[2][2];
#define EPI_LD(dst, g_) do { _Pragma("unroll") for (int bj = 0; bj < 2; ++bj) _Pragma("unroll") for (int n = 0; n < 2; ++n) { \
            const int o = so + ((((g_) >> 2) * HALF + ((g_) & 3) * 16) * LDC + bj * HALF + n * 16) * 2; \
            if constexpr (BASE_F32) dst[bj][n] = __builtin_bit_cast(f32x4, __builtin_amdgcn_raw_buffer_load_b128(rb, vo * 2, o * 2, 0)); \
            else { const u32x2 t_ = __builtin_amdgcn_raw_buffer_load_b64(rb, vo, o, 0); dst[bj][n] = (f32x4){__builtin_bit_cast(float, t_.x << 16), __builtin_bit_cast(float, t_.x & 0xffff0000u), __builtin_bit_cast(float, t_.y << 16), __builtin_bit_cast(float, t_.y & 0xffff0000u)}; } } } while (0)
#define EPI_ST(src, g_) do { _Pragma("unroll") for (int bj = 0; bj < 2; ++bj) _Pragma("unroll") for (int n = 0; n < 2; ++n) { \
            const int o = so + ((((g_) >> 2) * HALF + ((g_) & 3) * 16) * LDC + bj * HALF + n * 16) * 2; \
            const f32x4 v = src[bj][n] + acc[(g_) >> 2][bj][(g_) & 3][n] * ascale; \
            u32x2 w; w.x = cvt_pk_bf16(v[0], v[1]); w.y = cvt_pk_bf16(v[2], v[3]); __builtin_amdgcn_raw_buffer_store_b64(w, rx, vo, o, 0); } } while (0)
        EPI_LD(ra, 0);
        EPI_LD(rb2, 1); EPI_ST(ra, 0);
        EPI_LD(ra, 2); EPI_ST(rb2, 1);
        EPI_LD(rb2, 3); EPI_ST(ra, 2);
        EPI_LD(ra, 4); EPI_ST(rb2, 3);
        EPI_LD(rb2, 5); EPI_ST(ra, 4);
        EPI_LD(ra, 6); EPI_ST(rb2, 5);
        EPI_LD(rb2, 7); EPI_ST(ra, 6);
        EPI_ST(rb2, 7);
#undef EPI_LD
#undef EPI_ST
    }
};
struct EpiQKV {
    static constexpr bool PERM = true, AFTER_DRAIN = false;
    bf16_t* Q; const float* rs; float qscale;
    __device__ __forceinline__ void operator()(const f32x4 (&acc)[2][2][4][2], const Unit& u, int wr, int wc, int fr, int fq) const {
        const rsrc_t rq = mkrsrc(Q, 3u * 16384u * 4096u * 2u), rr = mkrsrc(rs, 16384u * 4u);
        const int colt = u.pn * BM, which = colt >> 12, cw = colt & 4095, gt = cw >> 7;
        const int b = (u.pm * BM) >> 11, st = (u.pm * BM) & 2047;
        const float sc = which == 0 ? qscale : 1.f;
        const int so = (int)(((unsigned)which << 26) + (((unsigned)(b * 32 + gt) * 2048u + (unsigned)st) << 7)) * 2;
        const int vo = (((wr * 64 + fr) << 7) + wc * 32 + 8 * fq) * 2, vr = (wr * 64 + fr) * 4, sr = u.pm * BM * 4;
#pragma unroll
        for (int ai = 0; ai < 2; ++ai)
#pragma unroll
            for (int m = 0; m < 4; ++m) { const float f = sc * __builtin_bit_cast(float, __builtin_amdgcn_raw_buffer_load_b32(rr, vr, sr + (ai * HALF + m * 16) * 4, 0));
#pragma unroll
                for (int bj = 0; bj < 2; ++bj) {
                    const f32x4 v0 = acc[ai][bj][m][0] * f, v1 = acc[ai][bj][m][1] * f;
                    u32x4 w; w.x = cvt_pk_bf16(v0[0], v0[1]); w.y = cvt_pk_bf16(v0[2], v0[3]); w.z = cvt_pk_bf16(v1[0], v1[1]); w.w = cvt_pk_bf16(v1[2], v1[3]);
                    __builtin_amdgcn_raw_buffer_store_b128(w, rq, vo, so + ((bj * 2048 + ai * HALF + m * 16) << 7) * 2, 0); } }
    }
};

struct EpiQKV4 {
    static constexpr bool PERM = false, AFTER_DRAIN = false;
    bf16_t* Q; const float* rs; float qscale, wscale;
    __device__ __forceinline__ void operator()(const f32x4 (&acc)[2][2][4][2], const Unit& u, int wr, int wc, int fr, int fq) const {
        EPI_FRESH_LANE();
        const rsrc_t rq = mkrsrc(Q, 3u * 16384u * 4096u * 2u), rr = mkrsrc(rs, 16384u * 4u);
        const int colt = u.pn * BM, which = colt >> 12, cw = colt & 4095, gt = cw >> 7;
        const int b = (u.pm * BM) >> 11, st = (u.pm * BM) & 2047;
        const float sc = (which == 0 ? qscale : 1.f) * wscale;
        const int so = (int)(((unsigned)which << 26) + (((unsigned)(b * 32 + gt) * 2048u + (unsigned)st) << 7)) * 2;
        const int vo = (((wr * 64 + fr) << 7) + wc * 32 + 4 * fq) * 2, vr = (wr * 64 + fr) * 4, sr = u.pm * BM * 4;
        unsigned rsv[2][4];
#pragma unroll
        for (int ai = 0; ai < 2; ++ai)
#pragma unroll
            for (int m = 0; m < 4; ++m) rsv[ai][m] = __builtin_amdgcn_raw_buffer_load_b32(rr, vr, sr + (ai * HALF + m * 16) * 4, 0);
#pragma unroll
        for (int ai = 0; ai < 2; ++ai)
#pragma unroll
            for (int m = 0; m < 4; ++m) { const float f = sc * __builtin_bit_cast(float, rsv[ai][m]);
#pragma unroll
                for (int bj = 0; bj < 2; ++bj)
#pragma unroll
                    for (int n = 0; n < 2; ++n) { const f32x4 v0 = acc[ai][bj][m][n] * f; u32x2 w; w.x = cvt_pk_bf16(v0[0], v0[1]); w.y = cvt_pk_bf16(v0[2], v0[3]);
                        __builtin_amdgcn_raw_buffer_store_b64(w, rq, vo, so + (((bj * 2048 + ai * HALF + m * 16) << 7) + n * 16) * 2, 0); } }
    }
};

typedef int i32x8 __attribute__((ext_vector_type(8)));
template <bool F8> struct FragT { typedef bf16x8 type; };
template <> struct FragT<true> { typedef i32x8 type; };
__device__ __forceinline__ f32x4 mma_bf16(bf16x8 a, bf16x8 b, f32x4 c) { return __builtin_amdgcn_mfma_f32_16x16x32_bf16(a, b, c, 0, 0, 0); }
__device__ __forceinline__ f32x4 mma_bf16(i32x8, i32x8, f32x4 c) { return c; }
template <class Epi, class Sched, bool ALIGN_EPI = false, bool SP2 = false, bool F8 = false>
__device__ __forceinline__ void gemm_phase(PG8_LAS unsigned char* lds, const Gemm g, const Sched& S, const Epi& E, int tid_in) {
    int tid_ = tid_in;
    const int tid = tid_, wid = __builtin_amdgcn_readfirstlane(tid >> 6), lane = tid & 63, wr = wid >> 2, wc = wid & 3, fr = lane & 15, fq = lane >> 4;
    constexpr int EB = F8 ? 1 : 2;
    constexpr int K = 4096; constexpr int nt = (K * EB) / (BK * 2);
    unsigned voffA[2], voffB[2];
#pragma unroll
    for (int i = 0; i < 2; ++i) { int R, C; stage_rc(tid * 16 + i * 8192, R, C); const int Rb = Epi::PERM ? ((R & ~31) + perm32(R & 31)) : R;
        voffA[i] = (unsigned)(R * K * EB + C * 2); voffB[i] = (unsigned)(Rb * K * EB + C * 2); }
    const size_t kstep = (size_t)(BK * 2);
    const size_t hstep = (size_t)HALF * K * EB;
    const size_t tstep = 2 * hstep;
    const unsigned ldsw = (unsigned)wid * 1024u;
    const int aoff = F8 ? lds_byte(wr * 64 + fr, fq * 16) + (fq & 1) * 16 : lds_byte(wr * 64 + fr, fq * 8), boff = F8 ? lds_byte(wc * 32 + fr, fq * 16) + (fq & 1) * 16 : lds_byte(wc * 32 + fr, fq * 8);
    const int aoff1 = aoff + (F8 ? 16 - 32 * (fq & 1) : 0);
    const int f8o0_unused = 0; (void)f8o0_unused;
#define PG8_SA(b, h) (((b) * 2 + (h)) * HTB)
#define PG8_SB(b, h) ((4 + (b) * 2 + (h)) * HTB)
#define PG8_STAGE_X(bufoff, gbase, voff, rs_, base_) do { const int so_ = (int)((const char*)(gbase) - (const char*)(base_)); _Pragma("unroll") for (int _i = 0; _i < 2; ++_i) \
        __builtin_amdgcn_raw_ptr_buffer_load_lds(rs_, (PG8_LAS void*)(lds + (bufoff) + ldsw + _i * 8192), 16, (int)(voff)[_i], so_, 0, 0); } while (0)
#define PG8_LDA(dst, b, h) do { if constexpr (F8) { _Pragma("unroll") for (int m = 0; m < 4; ++m) { const u32x4 lo_ = *(const PG8_LAS u32x4*)(lds + PG8_SA(b, h) + aoff + m * 2048), hi_ = *(const PG8_LAS u32x4*)(lds + PG8_SA(b, h) + aoff1 + m * 2048); \
            dst[m][0] = (i32x8){(int)lo_[0], (int)lo_[1], (int)lo_[2], (int)lo_[3], (int)hi_[0], (int)hi_[1], (int)hi_[2], (int)hi_[3]}; } } \
        else { _Pragma("unroll") for (int m = 0; m < 4; ++m) _Pragma("unroll") for (int k = 0; k < 2; ++k) dst[m][k] = *(const PG8_LAS frag_t*)(lds + PG8_SA(b, h) + aoff + m * 2048 + k * 1024); } } while (0)
#define PG8_LDB(dst, b, h) do { if constexpr (F8) { _Pragma("unroll") for (int n = 0; n < 2; ++n) { const u32x4 lo_ = *(const PG8_LAS u32x4*)(lds + PG8_SB(b, h) + boff + n * 2048), hi_ = *(const PG8_LAS u32x4*)(lds + PG8_SB(b, h) + boff + (aoff1 - aoff) + n * 2048); \
            dst[n][0] = (i32x8){(int)lo_[0], (int)lo_[1], (int)lo_[2], (int)lo_[3], (int)hi_[0], (int)hi_[1], (int)hi_[2], (int)hi_[3]}; } } \
        else { _Pragma("unroll") for (int n = 0; n < 2; ++n) _Pragma("unroll") for (int k = 0; k < 2; ++k) dst[n][k] = *(const PG8_LAS frag_t*)(lds + PG8_SB(b, h) + boff + n * 2048 + k * 1024); } } while (0)
#define PG8_MMA(ai, bj, At, Bt) do { __builtin_amdgcn_s_setprio(1); _Pragma("unroll") for (int m = 0; m < 4; ++m) _Pragma("unroll") for (int n = 0; n < 2; ++n) { \
        if constexpr (F8) acc[ai][bj][m][n] = __builtin_amdgcn_mfma_scale_f32_16x16x128_f8f6f4(Bt[n][0], At[m][0], acc[ai][bj][m][n], 0, 0, 0, 0x7f7f7f7f, 0, 0x7f7f7f7f); \
        else { _Pragma("unroll") for (int k = 0; k < 2; ++k) acc[ai][bj][m][n] = mma_bf16(Bt[n][k], At[m][k], acc[ai][bj][m][n]); } } __builtin_amdgcn_s_setprio(0); } while (0)
#define PG8_WAIT_V(n) asm volatile("s_waitcnt vmcnt(" #n ")" ::: "memory")
#define PG8_WAIT_L(n) asm volatile("s_waitcnt lgkmcnt(" #n ")" ::: "memory")
#define PG8_BAR __builtin_amdgcn_s_barrier()
#define PG8_SCHED __builtin_amdgcn_sched_barrier(0)
    const __amdgpu_buffer_rsrc_t rsA = __builtin_amdgcn_make_buffer_rsrc((void*)g.A, (short)0, (int)((size_t)g.M * K * EB), 0x00020000), rsB = __builtin_amdgcn_make_buffer_rsrc((void*)g.Bt, (short)0, (int)((size_t)g.N * K * EB), 0x00020000);
    Unit cur, nxt; int ui = 0;
    if (!S.next(0, cur)) return;
    f32x4 acc[2][2][4][2];
#pragma unroll
    for (int a = 0; a < 2; ++a)
#pragma unroll
        for (int b = 0; b < 2; ++b)
#pragma unroll
            for (int m = 0; m < 4; ++m)
#pragma unroll
                for (int n = 0; n < 2; ++n) acc[a][b][m][n] = (f32x4){0.f, 0.f, 0.f, 0.f};
    typedef typename FragT<F8>::type frag_t;
    frag_t At[4][F8 ? 1 : 2], B0[2][F8 ? 1 : 2], B1[2][F8 ? 1 : 2];
    const char* cA = (const char*)g.A + (size_t)cur.pm * tstep; const char* cB = (const char*)g.Bt + (size_t)cur.pn * tstep;
    S.a_ready(cur);
    if constexpr (SP2) {
        PG8_STAGE_X(PG8_SB(0, 0), cB, voffB, rsB, g.Bt); PG8_STAGE_X(PG8_SB(0, 1), cB + hstep, voffB, rsB, g.Bt); PG8_STAGE_X(PG8_SA(0, 0), cA, voffA, rsA, g.A); PG8_STAGE_X(PG8_SA(0, 1), cA + hstep, voffA, rsA, g.A);
        if (wr == 1) PG8_BAR;
        PG8_WAIT_V(2); PG8_BAR;
        PG8_STAGE_X(PG8_SB(1, 0), cB + kstep, voffB, rsB, g.Bt); PG8_STAGE_X(PG8_SA(1, 0), cA + kstep, voffA, rsA, g.A); PG8_STAGE_X(PG8_SB(1, 1), cB + hstep + kstep, voffB, rsB, g.Bt);
        PG8_WAIT_V(6); PG8_BAR;
    } else {
        PG8_STAGE_X(PG8_SB(0, 0), cB, voffB, rsB, g.Bt); PG8_STAGE_X(PG8_SA(0, 0), cA, voffA, rsA, g.A); PG8_STAGE_X(PG8_SB(0, 1), cB + hstep, voffB, rsB, g.Bt); PG8_STAGE_X(PG8_SA(0, 1), cA + hstep, voffA, rsA, g.A);
        if (wr == 1) PG8_BAR;
        PG8_WAIT_V(4); PG8_BAR;
        PG8_STAGE_X(PG8_SB(1, 0), cB + kstep, voffB, rsB, g.Bt); PG8_STAGE_X(PG8_SA(1, 0), cA + kstep, voffA, rsA, g.A); PG8_STAGE_X(PG8_SB(1, 1), cB + hstep + kstep, voffB, rsB, g.Bt);
        PG8_WAIT_V(6); PG8_BAR;
    }
    for (;;) {
        const bool has_next = S.next(ui + 1, nxt);
        const char* nA = has_next ? (const char*)g.A + (size_t)nxt.pm * tstep : cA; const char* nB = has_next ? (const char*)g.Bt + (size_t)nxt.pn * tstep : cB;
        for (int t = 0; t < nt; t += 2) {
            const bool last = (t == nt - 2);
            const char* a1 = cA + (size_t)(t + 1) * kstep;
            const char* a2 = last ? nA : cA + (size_t)(t + 2) * kstep; const char* b2 = last ? nB : cB + (size_t)(t + 2) * kstep;
            const char* a3 = a2 + kstep; const char* b3 = b2 + kstep;
            if (last && has_next) S.a_ready(nxt);
            if constexpr (SP2) {
            PG8_LDB(B0, 0, 0); PG8_LDB(B1, 0, 1); PG8_SCHED; PG8_LDA(At, 0, 0); PG8_STAGE_X(PG8_SA(1, 1), a1 + hstep, voffA, rsA, g.A);
            PG8_WAIT_V(8); PG8_WAIT_L(0); PG8_BAR; PG8_MMA(0, 0, At, B0); PG8_MMA(0, 1, At, B1); PG8_BAR; PG8_SCHED;
            PG8_LDA(At, 0, 1); PG8_STAGE_X(PG8_SB(0, 0), b2, voffB, rsB, g.Bt); PG8_STAGE_X(PG8_SB(0, 1), b2 + hstep, voffB, rsB, g.Bt); PG8_STAGE_X(PG8_SA(0, 0), a2, voffA, rsA, g.A);
            PG8_WAIT_V(8); PG8_WAIT_L(0); PG8_BAR; PG8_MMA(1, 0, At, B0); PG8_MMA(1, 1, At, B1); PG8_BAR; PG8_SCHED;
            PG8_LDB(B0, 1, 0); PG8_LDB(B1, 1, 1); PG8_SCHED; PG8_LDA(At, 1, 0); PG8_STAGE_X(PG8_SA(0, 1), a2 + hstep, voffA, rsA, g.A);
            PG8_WAIT_V(8); PG8_WAIT_L(0); PG8_BAR; PG8_MMA(0, 0, At, B0); PG8_MMA(0, 1, At, B1); PG8_BAR; PG8_SCHED;
            PG8_LDA(At, 1, 1); PG8_STAGE_X(PG8_SB(1, 0), b3, voffB, rsB, g.Bt); PG8_STAGE_X(PG8_SB(1, 1), b3 + hstep, voffB, rsB, g.Bt); PG8_STAGE_X(PG8_SA(1, 0), a3, voffA, rsA, g.A);
            PG8_WAIT_V(8); PG8_WAIT_L(0); PG8_BAR; PG8_MMA(1, 0, At, B0); PG8_MMA(1, 1, At, B1); PG8_BAR; PG8_SCHED;
            } else {
            PG8_LDB(B0, 0, 0); PG8_SCHED; PG8_LDA(At, 0, 0); PG8_STAGE_X(PG8_SA(1, 1), a1 + hstep, voffA, rsA, g.A);
            PG8_WAIT_L(8); PG8_BAR; PG8_WAIT_L(0); PG8_MMA(0, 0, At, B0); PG8_BAR; PG8_SCHED;
            PG8_LDB(B1, 0, 1); PG8_STAGE_X(PG8_SB(0, 0), b2, voffB, rsB, g.Bt);
            PG8_BAR; PG8_WAIT_L(0); PG8_MMA(0, 1, At, B1); PG8_BAR;
            PG8_LDA(At, 0, 1); PG8_STAGE_X(PG8_SA(0, 0), a2, voffA, rsA, g.A);
            PG8_BAR; PG8_WAIT_L(0); PG8_MMA(1, 0, At, B0); PG8_BAR; PG8_SCHED;
            PG8_STAGE_X(PG8_SB(0, 1), b2 + hstep, voffB, rsB, g.Bt);
            PG8_WAIT_V(6); PG8_BAR; PG8_MMA(1, 1, At, B1); PG8_BAR;
            PG8_LDB(B0, 1, 0); PG8_SCHED; PG8_LDA(At, 1, 0); PG8_STAGE_X(PG8_SA(0, 1), a2 + hstep, voffA, rsA, g.A);
            PG8_WAIT_L(8); PG8_BAR; PG8_WAIT_L(0); PG8_MMA(0, 0, At, B0); PG8_BAR; PG8_SCHED;
            PG8_LDB(B1, 1, 1); PG8_STAGE_X(PG8_SB(1, 0), b3, voffB, rsB, g.Bt);
            PG8_BAR; PG8_WAIT_L(0); PG8_MMA(0, 1, At, B1); PG8_BAR;
            PG8_LDA(At, 1, 1); PG8_STAGE_X(PG8_SA(1, 0), a3, voffA, rsA, g.A);
            PG8_BAR; PG8_WAIT_L(0); PG8_MMA(1, 0, At, B0); PG8_BAR; PG8_SCHED;
            PG8_STAGE_X(PG8_SB(1, 1), b3 + hstep, voffB, rsB, g.Bt);
            PG8_WAIT_V(6); PG8_BAR; PG8_MMA(1, 1, At, B1); PG8_BAR;
            }
        }
        if constexpr (ALIGN_EPI) { if (wr == 0) PG8_BAR; }
        if constexpr (!Epi::AFTER_DRAIN) { E(acc, cur, wr, wc, fr, fq); S.done(cur); }
        if (!has_next) break;
#pragma unroll
        for (int a = 0; a < 2; ++a)
#pragma unroll
            for (int b = 0; b < 2; ++b)
#pragma unroll
                for (int m = 0; m < 4; ++m)
#pragma unroll
                    for (int n = 0; n < 2; ++n) acc[a][b][m][n] = (f32x4){0.f, 0.f, 0.f, 0.f};
        cur = nxt; cA = nA; cB = nB; ++ui;
        if constexpr (ALIGN_EPI) { if (wr == 1) PG8_BAR; }
    }
    PG8_WAIT_V(0);
    if constexpr (!ALIGN_EPI) { if (wr == 0) PG8_BAR; }
    PG8_BAR;
    if constexpr (Epi::AFTER_DRAIN) { E.fused(acc, cur, wr, wc, fr, fq, lds, wid, lane); S.done(cur); }
#undef PG8_SA
#undef PG8_SB
#undef PG8_STAGE_X
#undef PG8_LDA
#undef PG8_LDB
#undef PG8_MMA
#undef PG8_WAIT_V
#undef PG8_WAIT_L
#undef PG8_BAR
#undef PG8_SCHED
}
}
#define GAS __attribute__((address_space(1)))
#define LAS __attribute__((address_space(3)))
typedef unsigned short bf16_t;
typedef unsigned u32x4 __attribute__((ext_vector_type(4)));
typedef unsigned u32x2 __attribute__((ext_vector_type(2)));
typedef float f32x4 __attribute__((ext_vector_type(4)));
typedef float f32x2 __attribute__((ext_vector_type(2)));
typedef float f32x16 __attribute__((ext_vector_type(16)));
typedef short bf16x8 __attribute__((ext_vector_type(8)));
typedef short s16x4 __attribute__((ext_vector_type(4)));
typedef __bf16 bf16x2_t __attribute__((ext_vector_type(2)));
typedef unsigned u32x6 __attribute__((ext_vector_type(6)));
typedef int i32x8 __attribute__((ext_vector_type(8)));
typedef unsigned u32x16 __attribute__((ext_vector_type(16)));
typedef float f32x32 __attribute__((ext_vector_type(32)));
typedef _Float16 f16x32 __attribute__((ext_vector_type(32)));
typedef _Float16 f16x2 __attribute__((ext_vector_type(2)));

namespace mk {
constexpr int M = 16384, D = 4096, S = 2048, NB = 8, PW = 12298, NH = 32, NE = 16384;
constexpr int NWAVES = 8;
constexpr size_t MiB = 1u << 20;
constexpr size_t WS_CTL = 0, CTL_ZERO_BYTES = 1 * MiB;
constexpr size_t WS_RSTD = 2 * MiB, WS_LOGF = 3 * MiB, WS_WQK = 4 * MiB, WS_WOUT = 20 * MiB, WS_WIN = 52 * MiB, WS_U16 = 148 * MiB, WS_V16 = 276 * MiB,
                 WS_XB = 404 * MiB, WS_Q = 532 * MiB, WS_K = 660 * MiB, WS_V = 788 * MiB, WS_OB = 916 * MiB, WS_X2 = 1792 * MiB, WS_END = 2048 * MiB;
constexpr size_t WS_XB8N = WS_OB + 64 * MiB;
constexpr size_t WS_SC = WS_Q;
constexpr int CW_BAR = 4096;
constexpr int CW_QUEUE = 16384;
constexpr int RING_BYTES = 131072, LDSCTL_OFF = RING_BYTES, MISC_OFF = LDSCTL_OFF + 320, LDS_BYTES = 147456;

struct Args { const float* in[13]; float* out; unsigned char* ws; int ph_lo, ph_hi; };

__device__ __forceinline__ unsigned f2bf(float f) { unsigned u = __builtin_bit_cast(unsigned, f); return (u + 0x7fffu + ((u >> 16) & 1u)) >> 16; }
__device__ __forceinline__ unsigned pk2(float lo, float hi) { return f2bf(lo) | (f2bf(hi) << 16); }
__device__ __forceinline__ float bf_lo(unsigned w) { return __builtin_bit_cast(float, w << 16); }
__device__ __forceinline__ float bf_hi(unsigned w) { return __builtin_bit_cast(float, w & 0xffff0000u); }
__device__ __forceinline__ float lane_read(float v, int src_lane) { return __builtin_bit_cast(float, __builtin_amdgcn_ds_bpermute(src_lane << 2, __builtin_bit_cast(int, v))); }
__device__ __forceinline__ int lane_read(int v, int src_lane) { return __builtin_amdgcn_ds_bpermute(src_lane << 2, v); }
constexpr float US = 1024.0f, VS = 32.0f, US_INV = 1.0f / 1024.0f, VS_INV = 1.0f / 32.0f;
constexpr int ROW6 = 3072;
__device__ __forceinline__ unsigned q_e2m3(float x, float inv) {
    const float a = fminf(fabsf(x) * inv, 7.5f);
    const float c = a < 2.0f ? __builtin_rintf(a * 8.0f) : (a < 4.0f ? __builtin_rintf(a * 4.0f) + 8.0f : __builtin_rintf(a * 2.0f) + 16.0f);
    return (unsigned)(int)c | ((__builtin_bit_cast(unsigned, x) >> 26) & 32u);
}
__device__ __forceinline__ u32x6 pack_fp6(const f32x4 (&a0)[4], const f32x4 (&a1)[4], float inv) {
    unsigned o[6];
#pragma unroll
    for (int w = 0; w < 6; ++w) o[w] = 0u;
#pragma unroll
    for (int j = 0; j < 32; ++j) { const float x = (j < 16) ? a0[(j & 15) >> 2][j & 3] : a1[(j & 15) >> 2][j & 3]; const unsigned c = q_e2m3(x, inv);
        const int b = 6 * j, w = b >> 5, sh = b & 31; o[w] |= c << sh; if (sh > 26) o[w + 1] |= c >> (32 - sh); }
    return (u32x6){o[0], o[1], o[2], o[3], o[4], o[5]};
}
constexpr int ROW4 = 2048;
__device__ __forceinline__ unsigned q_e2m1(float x, float inv) {
    const float a = fminf(fabsf(x) * inv, 6.0f);
    const float c = a < 2.0f ? __builtin_rintf(a * 2.0f) : (a < 4.0f ? __builtin_rintf(a) + 2.0f : __builtin_rintf(a * 0.5f) + 4.0f);
    return (unsigned)(int)c | ((__builtin_bit_cast(unsigned, x) >> 28) & 8u);
}
__device__ __forceinline__ u32x4 pack_fp4(const f32x4 (&a0)[4], const f32x4 (&a1)[4], float inv) {
    unsigned o[4];
#pragma unroll
    for (int w = 0; w < 4; ++w) { o[w] = 0u;
#pragma unroll
        for (int t = 0; t < 8; ++t) { const int j = 8 * w + t; const float x = (j < 16) ? a0[(j & 15) >> 2][j & 3] : a1[(j & 15) >> 2][j & 3]; o[w] |= q_e2m1(x, inv) << (4 * t); } }
    return (u32x4){o[0], o[1], o[2], o[3]};
}
__device__ __forceinline__ float clamp8(float x) { return fminf(fmaxf(x, -224.0f), 224.0f); }
__device__ __forceinline__ float logsig(float z) { return fminf(z, 0.f) - 0.6931471805599453f * __builtin_amdgcn_logf(1.0f + __builtin_amdgcn_exp2f(-fabsf(z) * 1.4426950408889634f)); }
__device__ __forceinline__ float gelu_erf(float v) {
    const float av = fabsf(v), t = __builtin_amdgcn_rcpf(av * 0.2316418882f + 1.0f);
    float q = t * 0.5307027145f + (-0.7265760135f); q = q * t + 0.7107068705f; q = q * t + (-0.142248368f); q = q * t + 0.127414796f; q = q * t;
    const float e = __builtin_amdgcn_exp2f((v * v) * (-0.72134752044f));
    const float m = v * (q * e);
    return v < 0.f ? m : v - m;
}
#define LDS_WAIT() asm volatile("s_waitcnt lgkmcnt(0)" ::: "memory")
#define FRESH_LDS(l) do { unsigned v_ = (unsigned)(size_t)(l); asm volatile("" : "+s"(v_)); (l) = (LAS unsigned char*)(size_t)v_; } while (0)
#define FRESH_BID() int bid = blockIdx.x, G = gridDim.x; asm volatile("" : "+s"(bid), "+s"(G))
#define FRESH_TID() int tid; { int w_ = wave0, l_; { unsigned z_ = 0u; asm volatile("" : "+v"(z_)); l_ = (int)__builtin_amdgcn_mbcnt_hi(~0u, __builtin_amdgcn_mbcnt_lo(~0u, z_)); } asm volatile("" : "+s"(w_)); tid = w_ * 64 + l_; } const int lane = tid & 63, wave = __builtin_amdgcn_readfirstlane(tid >> 6); (void)lane; (void)wave

__device__ __forceinline__ unsigned wave_max_u32(unsigned v) {
    v = max(v, (unsigned)__builtin_amdgcn_update_dpp(0, (int)v, 0x111, 0xF, 0xF, true));
    v = max(v, (unsigned)__builtin_amdgcn_update_dpp(0, (int)v, 0x112, 0xF, 0xF, true));
    v = max(v, (unsigned)__builtin_amdgcn_update_dpp(0, (int)v, 0x114, 0xF, 0xF, true));
    v = max(v, (unsigned)__builtin_amdgcn_update_dpp(0, (int)v, 0x118, 0xF, 0xF, true));
    v = max(v, (unsigned)__builtin_amdgcn_update_dpp((int)v, (int)v, 0x142, 0xA, 0xF, false));
    v = max(v, (unsigned)__builtin_amdgcn_update_dpp((int)v, (int)v, 0x143, 0xC, 0xF, false));
    return (unsigned)__builtin_amdgcn_readlane((int)v, 63);
}
__device__ __forceinline__ float wave_sum_dpp(float x) {
    int v = __builtin_bit_cast(int, x);
#define DPP_ADD(ctrl, rm, bc, oldv) v = __builtin_bit_cast(int, __builtin_bit_cast(float, v) + __builtin_bit_cast(float, __builtin_amdgcn_update_dpp(oldv, v, ctrl, rm, 0xF, bc)))
    DPP_ADD(0x111, 0xF, true, 0); DPP_ADD(0x112, 0xF, true, 0); DPP_ADD(0x114, 0xF, true, 0); DPP_ADD(0x118, 0xF, true, 0);
#undef DPP_ADD
    const float r0 = __builtin_bit_cast(float, __builtin_amdgcn_readlane(v, 15)), r1 = __builtin_bit_cast(float, __builtin_amdgcn_readlane(v, 31)), r2 = __builtin_bit_cast(float, __builtin_amdgcn_readlane(v, 47)), r3 = __builtin_bit_cast(float, __builtin_amdgcn_readlane(v, 63));
    return (r0 + r1) + (r2 + r3);
}
__device__ __forceinline__ unsigned ordkey(float x) { const unsigned u = __builtin_bit_cast(unsigned, x); return (u & 0x80000000u) ? ~u : (u | 0x80000000u); }
__device__ __forceinline__ void transpose_item(const float* W, int K, int ldw, int ncols, const float* gain, bf16_t* WT, LAS float* scr, int item, int lane) {
    const int nblk = ncols / 32, kb = item / nblk, nb = item % nblk, k0 = 64 * kb, n0 = 32 * nb;
#pragma unroll 8
    for (int i = 0; i < 32; ++i) { const int kk = 2 * i + (lane >> 5); float v = W[(size_t)(k0 + kk) * ldw + n0 + (lane & 31)]; if (gain) v *= gain[k0 + kk]; scr[kk * 33 + (lane & 31)] = v; }
    LDS_WAIT(); asm volatile("" ::: "memory");
    const int c = lane & 7;
#pragma unroll
    for (int j = 0; j < 4; ++j) { const int n = (lane >> 3) + 8 * j; const LAS float* s = scr + (8 * c) * 33 + n;
        u32x4 o; o.x = pk2(s[0 * 33], s[1 * 33]); o.y = pk2(s[2 * 33], s[3 * 33]); o.z = pk2(s[4 * 33], s[5 * 33]); o.w = pk2(s[6 * 33], s[7 * 33]);
        *(u32x4*)(WT + (size_t)(n0 + n) * K + k0 + 8 * c) = o; }
    LDS_WAIT(); asm volatile("" ::: "memory");
}

typedef const __attribute__((address_space(4))) Args* KArgsT;
__device__ __forceinline__ unsigned pk4_fp8(float a, float b, float c, float d) { int p = __builtin_amdgcn_cvt_pk_fp8_f32(clamp8(a), clamp8(b), 0, false); p = __builtin_amdgcn_cvt_pk_fp8_f32(clamp8(c), clamp8(d), p, true); return (unsigned)p; }
__device__ __forceinline__ void transpose_item8(const float* W, int K, int ldw, int ncols, const float* gain, float scale, unsigned char* WT, LAS float* scr, int item, int lane) {
    const int nblk = ncols / 32, kb = item / nblk, nb = item % nblk, k0 = 64 * kb, n0 = 32 * nb;
    const int kr = lane >> 3, nq = (lane & 7) * 4;
    f32x4 v[8];
#pragma unroll
    for (int i = 0; i < 8; ++i) { const float* p = W + (size_t)(k0 + 8 * i + kr) * ldw + n0 + nq; v[i] = (f32x4){p[0], p[1], p[2], p[3]}; }
#pragma unroll
    for (int i = 0; i < 8; ++i) { const int kk = 8 * i + kr; const float g = (gain ? gain[k0 + kk] : 1.0f) * scale; LAS float* d = scr + kk * 33 + nq; d[0] = v[i][0] * g; d[1] = v[i][1] * g; d[2] = v[i][2] * g; d[3] = v[i][3] * g; }
    LDS_WAIT(); asm volatile("" ::: "memory");
    const int c = lane & 7;
#pragma unroll
    for (int j = 0; j < 4; ++j) { const int n = (lane >> 3) + 8 * j; const LAS float* s = scr + (8 * c) * 33 + n;
        u32x2 o; o.x = pk4_fp8(s[0 * 33], s[1 * 33], s[2 * 33], s[3 * 33]); o.y = pk4_fp8(s[4 * 33], s[5 * 33], s[6 * 33], s[7 * 33]);
        *(u32x2*)(WT + (size_t)(n0 + n) * K + k0 + 8 * c) = o; }
    LDS_WAIT(); asm volatile("" ::: "memory");
}
__device__ __forceinline__ void conv_phase(KArgsT ka, int l, LAS unsigned char* lds, int wave0) {
    FRESH_TID(); FRESH_LDS(lds); FRESH_BID();
    unsigned char* ws = ka->ws;
    const float* ln1 = ka->in[1] + (size_t)l * D; const float* w_in = ka->in[2] + (size_t)l * D * PW; const float* w_out = ka->in[5] + (size_t)l * D * D;
    const float* ln2 = ka->in[6] + (size_t)l * D; const float* wq = ka->in[7] + (size_t)l * D * 2048;
    const float* k1 = ka->in[8] + (size_t)l * 8 * 128 * 128; const float* k2 = ka->in[9] + (size_t)l * 8 * 128 * 128;
    const float* pu = ka->in[10] + (size_t)l * NE * D; const float* pv = ka->in[11] + (size_t)l * NE * D;
    bf16_t* WQK = (bf16_t*)(ws + WS_WQK); bf16_t* WOUT = (bf16_t*)(ws + WS_WOUT); bf16_t* WIN = (bf16_t*)(ws + WS_WIN); bf16_t* U16 = (bf16_t*)(ws + WS_U16); bf16_t* V16 = (bf16_t*)(ws + WS_V16);
    {
        LAS float* Ks = (LAS float*)lds;
        LAS float* Ws = (LAS float*)(lds + 128 * 132 * 4);
        for (int it = bid; it < 1024; it += G) {
            const int gi = it >> 6, c0 = (it & 63) * 64;
            const float* key = ((gi & 1) ? k2 : k1) + (size_t)(gi >> 1) * 128 * 128;
            for (int i = tid; i < 4096; i += 512) { const int r = i >> 5, c4 = (i & 31) * 4; *(LAS f32x4*)(Ks + r * 132 + c4) = *(const f32x4*)(key + r * 128 + c4); }
            for (int i = tid; i < 2048; i += 512) { const int r = i >> 5, c4 = (i & 31) * 4; *(LAS f32x4*)(Ws + r * 132 + c4) = *(const f32x4*)(wq + (size_t)(c0 + r) * 2048 + gi * 128 + c4); }
            __syncthreads();
            const int tc = tid & 15, tn = tid >> 4;
            float acc[4][4];
#pragma unroll
            for (int i = 0; i < 4; ++i)
#pragma unroll
                for (int j = 0; j < 4; ++j) acc[i][j] = 0.f;
#pragma unroll 2
            for (int d = 0; d < 128; d += 4) {
                f32x4 kv[4], wv[4];
#pragma unroll
                for (int i = 0; i < 4; ++i) kv[i] = *(const LAS f32x4*)(Ks + (4 * tn + i) * 132 + d);
#pragma unroll
                for (int j = 0; j < 4; ++j) wv[j] = *(const LAS f32x4*)(Ws + (tc + 16 * j) * 132 + d);
#pragma unroll
                for (int i = 0; i < 4; ++i)
#pragma unroll
                    for (int j = 0; j < 4; ++j) acc[i][j] += kv[i][0] * wv[j][0] + kv[i][1] * wv[j][1] + kv[i][2] * wv[j][2] + kv[i][3] * wv[j][3];
            }
#pragma unroll
            for (int j = 0; j < 4; ++j) { const int c = c0 + tc + 16 * j; const float gg = ln2[c];
#pragma unroll
                for (int i = 0; i < 4; ++i) WQK[(size_t)(gi * 128 + 4 * tn + i) * D + c] = (bf16_t)f2bf(acc[i][j] * gg); }
            __syncthreads();
        }
        __syncthreads();
    }
    const int gw = bid * NWAVES + wave, NGW = G * NWAVES;
    {
        unsigned char* U6 = (unsigned char*)U16; unsigned char* V4 = U6 + (size_t)NE * ROW6; float* SCU = (float*)(U6 + 2 * (size_t)NE * ROW6); float* SCV = SCU + NE;
        for (int r = gw; r < NE; r += NGW) {
            const float* us = pu + (size_t)r * D + 16 * lane; const float* vs = pv + (size_t)r * D + 16 * lane;
            f32x4 uu[4][4], vv[4][4];
#pragma unroll
            for (int i = 0; i < 4; ++i)
#pragma unroll
                for (int q = 0; q < 4; ++q) { uu[i][q] = *(const f32x4*)(us + 1024 * i + 4 * q); vv[i][q] = *(const f32x4*)(vs + 1024 * i + 4 * q); }
            float au = 0.f, av = 0.f;
#pragma unroll
            for (int i = 0; i < 4; ++i)
#pragma unroll
                for (int q = 0; q < 4; ++q) { uu[i][q] *= *(const f32x4*)(ln2 + 1024 * i + 16 * lane + 4 * q);
                    au += (uu[i][q][0] * uu[i][q][0] + uu[i][q][1] * uu[i][q][1]) + (uu[i][q][2] * uu[i][q][2] + uu[i][q][3] * uu[i][q][3]);
                    av += (vv[i][q][0] * vv[i][q][0] + vv[i][q][1] * vv[i][q][1]) + (vv[i][q][2] * vv[i][q][2] + vv[i][q][3] * vv[i][q][3]); }
            au = sqrtf(wave_sum_dpp(au) * (1.0f / D)); av = sqrtf(wave_sum_dpp(av) * (1.0f / D));
            const float iu = au > 0.f ? 2.0f / au : 0.f, iv = av > 0.f ? 2.0f / av : 0.f;
            if (lane == 0) { SCU[r] = au * 0.5f; SCV[r] = av * 0.5f; }
            { u32x4* o = (u32x4*)(U6 + (size_t)r * ROW4) + lane; o[0] = pack_fp4(uu[0], uu[1], iu); o[64] = pack_fp4(uu[2], uu[3], iu); }
            { u32x4* o = (u32x4*)(V4 + (size_t)r * ROW4) + lane; o[0] = pack_fp4(vv[0], vv[1], iv); o[64] = pack_fp4(vv[2], vv[3], iv); }
        }
    }
    {
        LAS float* scr = (LAS float*)(lds + wave * 16384);
        constexpr int I_O = (D / 64) * (D / 32), I_IN = (D / 64) * (12288 / 32);
        for (int it = gw; it < I_O + I_IN; it += NGW) {
            if (it < I_O) transpose_item8(w_out, D, D, D, nullptr, US, (unsigned char*)WOUT, scr, it, lane);
            else transpose_item8(w_in, D, PW, 12288, ln1, US, (unsigned char*)WIN, scr, it - I_O, lane);
        }
    }
}

template <bool WITH_F>
__device__ __forceinline__ void prep_phase(const float* X, bf16_t* XB, float* RSTD, const float* w_in, const float* ln1, const float* bf, float* LOGF, LAS unsigned char* lds, int wave0) {
    FRESH_TID(); FRESH_LDS(lds); FRESH_BID();
    LAS unsigned short* gfs = (LAS unsigned short*)lds;
    if (WITH_F) {
        __syncthreads();
        for (int c = tid; c < D; c += 512) { const float g = ln1[c]; const float* wr = w_in + (size_t)c * PW + 12288;
#pragma unroll
            for (int j = 0; j < 10; ++j) gfs[j * D + c] = (unsigned short)f2bf(wr[j] * g); }
        __syncthreads();
    }
    const int gw = bid * NWAVES + wave, NGW = G * NWAVES;
    for (int m = gw; m < M; m += NGW) {
        const f32x4* xr = (const f32x4*)(X + (size_t)m * D) + lane;
        f32x4 v[16]; float ss = 0.f;
#pragma unroll
        for (int i = 0; i < 16; ++i) { v[i] = xr[64 * i]; ss += (v[i][0] * v[i][0] + v[i][1] * v[i][1]) + (v[i][2] * v[i][2] + v[i][3] * v[i][3]); }
        ss = wave_sum_dpp(ss);
        const float rstd = rsqrtf(ss * (1.0f / D) + 1e-6f);
        if (WITH_F) {
            unsigned* o8 = (unsigned*)((unsigned char*)XB + (size_t)m * D) + lane;
#pragma unroll
            for (int i = 0; i < 16; ++i) o8[64 * i] = pk4_fp8(v[i][0], v[i][1], v[i][2], v[i][3]);
        } else {
        u32x2* o = (u32x2*)(XB + (size_t)m * D) + lane;
#pragma unroll
        for (int i = 0; i < 16; ++i) { u32x2 w; w.x = pk2(v[i][0], v[i][1]); w.y = pk2(v[i][2], v[i][3]); o[64 * i] = w; }
        }
        if (lane == 0) RSTD[m] = rstd;
        if (WITH_F) {
            float mine = 0.f;
#pragma unroll 1
            for (int j = 0; j < 10; ++j) { float s = 0.f;
#pragma unroll
                for (int i = 0; i < 16; ++i) { const u32x2 gp = *(const LAS u32x2*)(gfs + j * D + 256 * i + 4 * lane);
                    s += (v[i][0] * bf_lo(gp.x) + v[i][1] * bf_hi(gp.x)) + (v[i][2] * bf_lo(gp.y) + v[i][3] * bf_hi(gp.y)); }
                s = wave_sum_dpp(s); if (lane == j) mine = s; }
            if (lane < 10) { const int b = m >> 11, s = m & 2047; LOGF[(size_t)(b * 10 + lane) * S + s] = logsig(mine * rstd + bf[lane]); }
        }
    }
}


__device__ __forceinline__ void load16_bf16(const bf16_t* p, float (&d)[16]) {
    const u32x4 a = *(const u32x4*)p, b = *(const u32x4*)(p + 8);
#pragma unroll
    for (int q = 0; q < 4; ++q) { d[2 * q] = bf_lo(a[q]); d[2 * q + 1] = bf_hi(a[q]); d[8 + 2 * q] = bf_lo(b[q]); d[8 + 2 * q + 1] = bf_hi(b[q]); }
}
#define RFL(x) __builtin_amdgcn_readfirstlane(x)
__device__ __forceinline__ void peer_u_phase(const float* SC, const unsigned char* U6, const bf16_t* X1, int* EIDG, float* WG, LAS unsigned char* lds, int wave0) {
    FRESH_TID(); FRESH_LDS(lds); FRESH_BID();
    LAS int* s_eid = (LAS int*)(lds + wave * 1024); LAS float* s_w = (LAS float*)(lds + wave * 1024 + 512); LAS float* s_su = (LAS float*)(lds + 8192 + wave * 512);
    const float* SCU = (const float*)(U6 + 2 * (size_t)NE * ROW6); const float* SCV = SCU + NE;
    const int gw = bid * NWAVES + wave, NGW = G * NWAVES;
    const float NEG = -3.0e38f;
    for (int tok = gw; tok < M; tok += NGW) {
        const bf16_t* x1 = X1 + (size_t)tok * D;
        i32x8 xq[2]; float rstd_tok;
        { const int sg_ = lane & 15, gp_ = lane >> 4; float t[2][2][16]; float ss_ = 0.f;
#pragma unroll
          for (int s2 = 0; s2 < 2; ++s2)
#pragma unroll
              for (int hf = 0; hf < 2; ++hf) { load16_bf16(x1 + 1024 * (2 * s2 + (gp_ & 1)) + 16 * (sg_ + 32 * hf + 16 * (gp_ >> 1)), t[s2][hf]);
#pragma unroll
                  for (int k = 0; k < 16; ++k) ss_ += t[s2][hf][k] * t[s2][hf][k]; }
          rstd_tok = rsqrtf(wave_sum_dpp(ss_) * (1.0f / D) + 1e-6f);
#pragma unroll
          for (int s2 = 0; s2 < 2; ++s2)
#pragma unroll
              for (int hf = 0; hf < 2; ++hf)
#pragma unroll
                  for (int q = 0; q < 4; ++q) xq[s2][4 * hf + q] = (int)pk4_fp8(t[s2][hf][4 * q] * rstd_tok, t[s2][hf][4 * q + 1] * rstd_tok, t[s2][hf][4 * q + 2] * rstd_tok, t[s2][hf][4 * q + 3] * rstd_tok); }
        const float* sc = SC + (size_t)tok * 2048;
        LAS float* selv = (LAS float*)(lds + 12288 + wave * 512); LAS int* seli = (LAS int*)(lds + 12288 + wave * 512 + 256);
#define BALLOT(c) __builtin_amdgcn_ballot_w64(c)
#define MBCNT(m) ((int)__builtin_amdgcn_mbcnt_hi((unsigned)((m) >> 32), __builtin_amdgcn_mbcnt_lo((unsigned)(m), 0u)))
        for (int h = 0; h < 4; ++h) {
            float x[2][2][2]; unsigned kk[2][2][2];
#pragma unroll
            for (int u = 0; u < 2; ++u)
#pragma unroll
                for (int f = 0; f < 2; ++f)
#pragma unroll
                    for (int r = 0; r < 2; ++r) { const float v = sc[(h + 4 * u) * 256 + f * 128 + r * 64 + lane]; x[u][f][r] = v; kk[u][f][r] = (ordkey(v) & ~127u) | (unsigned)(127 - 64 * r - lane); }
            unsigned T[2][2] = {{0u, 0u}, {0u, 0u}}; int dn = 0;
            for (unsigned bm = 0x80000000u; bm != 0u && dn != 15; bm >>= 1) {
#pragma unroll
                for (int u = 0; u < 2; ++u)
#pragma unroll
                    for (int f = 0; f < 2; ++f) { const unsigned cand = T[u][f] | bm;
                        const int c = __builtin_popcountll(BALLOT(kk[u][f][0] >= cand)) + __builtin_popcountll(BALLOT(kk[u][f][1] >= cand));
                        T[u][f] = c >= 16 ? cand : T[u][f]; dn |= (c == 16) ? (1 << (2 * u + f)) : 0; }
            }
#pragma unroll
            for (int u = 0; u < 2; ++u)
#pragma unroll
                for (int f = 0; f < 2; ++f) { const bool s0 = kk[u][f][0] >= T[u][f], s1 = kk[u][f][1] >= T[u][f]; const unsigned long long m0 = BALLOT(s0), m1 = BALLOT(s1);
                    const int p0 = MBCNT(m0), p1 = __builtin_popcountll(m0) + MBCNT(m1);
                    if (s0) { selv[(2 * u + f) * 16 + (p0 & 15)] = x[u][f][0]; seli[(2 * u + f) * 16 + (p0 & 15)] = lane; }
                    if (s1) { selv[(2 * u + f) * 16 + (p1 & 15)] = x[u][f][1]; seli[(2 * u + f) * 16 + (p1 & 15)] = 64 + lane; } }
            asm volatile("" ::: "memory");
            float s4[2][4]; unsigned k4[2][4];
#pragma unroll
            for (int u = 0; u < 2; ++u) { const float va = selv[(2 * u) * 16 + (lane >> 2)]; const f32x4 vb = *(const LAS f32x4*)(selv + (2 * u + 1) * 16 + (lane & 3) * 4);
#pragma unroll
                for (int q = 0; q < 4; ++q) { s4[u][q] = va + vb[q]; k4[u][q] = (ordkey(s4[u][q]) & ~255u) | (unsigned)(255 - 4 * lane - q); } }
            unsigned T2[2] = {0u, 0u}; int d2 = 0;
            for (unsigned bm = 0x80000000u; bm != 0u && d2 != 3; bm >>= 1) {
#pragma unroll
                for (int u = 0; u < 2; ++u) { const unsigned cand = T2[u] | bm;
                    const int c = (__builtin_popcountll(BALLOT(k4[u][0] >= cand)) + __builtin_popcountll(BALLOT(k4[u][1] >= cand))) + (__builtin_popcountll(BALLOT(k4[u][2] >= cand)) + __builtin_popcountll(BALLOT(k4[u][3] >= cand)));
                    T2[u] = c >= 16 ? cand : T2[u]; d2 |= (c == 16) ? (1 << u) : 0; }
            }
#pragma unroll
            for (int u = 0; u < 2; ++u) {
                const unsigned mk = wave_max_u32(max(max(k4[u][0], k4[u][1]), max(k4[u][2], k4[u][3]))) & ~255u;
                const float mx = __builtin_bit_cast(float, (mk & 0x80000000u) ? (mk & 0x7fffffffu) : ~mk);
                const float cs = 1.4426950408889634f * rstd_tok;
                float p[4], ps = 0.f;
#pragma unroll
                for (int q = 0; q < 4; ++q) { p[q] = (k4[u][q] >= T2[u]) ? __builtin_amdgcn_exp2f((s4[u][q] - mx) * cs) : 0.f; ps += p[q]; }
                const float tot = wave_sum_dpp(ps);
                const int i1 = seli[(2 * u) * 16 + (lane >> 2)]; const u32x4 i2 = *(const LAS u32x4*)(seli + (2 * u + 1) * 16 + (lane & 3) * 4);
                int base = (h + 4 * u) * 16;
#pragma unroll
                for (int q = 0; q < 4; ++q) { const bool sl = k4[u][q] >= T2[u]; const unsigned long long m = BALLOT(sl); const int slot = base + (MBCNT(m) & 15); base += __builtin_popcountll(m);
                    if (sl) { const int e = ((i1 & 127) << 7) | (int)(i2[q] & 127u); s_eid[slot] = e; s_w[slot] = p[q] / tot * SCV[e]; s_su[slot] = SCU[e]; } }
            }
            asm volatile("" ::: "memory");
        }
#undef BALLOT
#undef MBCNT
        LDS_WAIT(); asm volatile("" ::: "memory");
#define LOADROW6(dst, base, e) do { const u32x4* p_ = (const u32x4*)((base) + (size_t)(e) * ROW6) + lane; dst[0] = p_[0]; dst[1] = p_[64]; dst[2] = p_[128]; } while (0)
#define GRP6(row, g) ((g) == 0 ? (u32x6){row[0][0], row[0][1], row[0][2], row[0][3], row[1][0], row[1][1]} : (u32x6){row[1][2], row[1][3], row[2][0], row[2][1], row[2][2], row[2][3]})
        {
#define LOADROW4(dst, base, e) do { const u32x4* p_ = (const u32x4*)((base) + (size_t)(e) * ROW4) + lane; dst[0] = p_[0]; dst[1] = p_[64]; } while (0)
            const bool dg_ = ((lane & 15) >> 2) == (lane >> 4);
#define UDOT4(row, j) do { f32x4 ac_ = {0.f, 0.f, 0.f, 0.f}; \
            ac_ = __builtin_amdgcn_mfma_scale_f32_16x16x128_f8f6f4((i32x8){(int)row[0][0], (int)row[0][1], (int)row[0][2], (int)row[0][3], 0, 0, 0, 0}, xq[0], ac_, 4, 0, 0, 0x7f7f7f7f, 0, 0x7f7f7f7f); \
            ac_ = __builtin_amdgcn_mfma_scale_f32_16x16x128_f8f6f4((i32x8){(int)row[1][0], (int)row[1][1], (int)row[1][2], (int)row[1][3], 0, 0, 0, 0}, xq[1], ac_, 4, 0, 0, 0x7f7f7f7f, 0, 0x7f7f7f7f); \
            asm volatile("" : "+v"(ac_));     \
            const float pv_ = dg_ ? ((lane & 2) ? ((lane & 1) ? ac_[3] : ac_[2]) : ((lane & 1) ? ac_[1] : ac_[0])) : 0.f; \
            const float d_ = wave_sum_dpp(pv_) * s_su[j]; const float ge_ = gelu_erf(d_); if (lane == 0) s_w[j] *= ge_; } while (0)
            u32x4 r0[2], r1[2], r2[2], r3[2];
            { const int e_ = RFL(s_eid[0]); LOADROW4(r0, U6, e_); } { const int e_ = RFL(s_eid[1]); LOADROW4(r1, U6, e_); } { const int e_ = RFL(s_eid[2]); LOADROW4(r2, U6, e_); } { const int e_ = RFL(s_eid[3]); LOADROW4(r3, U6, e_); }
            for (int j = 0; j < 124; j += 4) {
                UDOT4(r0, j);     { const int e_ = RFL(s_eid[j + 4]); LOADROW4(r0, U6, e_); }
                UDOT4(r1, j + 1); { const int e_ = RFL(s_eid[j + 5]); LOADROW4(r1, U6, e_); }
                UDOT4(r2, j + 2); { const int e_ = RFL(s_eid[j + 6]); LOADROW4(r2, U6, e_); }
                UDOT4(r3, j + 3); { const int e_ = RFL(s_eid[j + 7]); LOADROW4(r3, U6, e_); }
            }
            UDOT4(r0, 124); UDOT4(r1, 125); UDOT4(r2, 126); UDOT4(r3, 127);
#undef UDOT4
#undef LOADROW4
        }
        LDS_WAIT(); asm volatile("" ::: "memory");
        EIDG[(size_t)tok * 128 + lane] = s_eid[lane]; EIDG[(size_t)tok * 128 + 64 + lane] = s_eid[64 + lane];
        WG[(size_t)tok * 128 + lane] = s_w[lane]; WG[(size_t)tok * 128 + 64 + lane] = s_w[64 + lane];
        LDS_WAIT(); asm volatile("" ::: "memory");
    }
}

template <bool FINAL>
__device__ __forceinline__ void peer_v_phase(const int* EIDG, const float* WG, const unsigned char* V4, const bf16_t* X1, void* XOv, const float* fg,
                                             unsigned char* XB8n, float* RSTDn, float* LOGFn, const float* w_in_n, const float* ln1_n, const float* bf_n, LAS unsigned char* lds, int wave0) {
    FRESH_TID(); FRESH_LDS(lds); FRESH_BID();
    LAS int* s_eid = (LAS int*)(lds + 81920 + wave * 1024); LAS float* s_w = (LAS float*)(lds + 81920 + wave * 1024 + 512);
    LAS unsigned short* gfs = (LAS unsigned short*)lds;
    if (!FINAL) {
        __syncthreads();
        for (int c = tid; c < D; c += 512) { const float g = ln1_n[c]; const float* wr = w_in_n + (size_t)c * PW + 12288;
#pragma unroll
            for (int j = 0; j < 10; ++j) gfs[j * D + c] = (unsigned short)f2bf(wr[j] * g); }
        __syncthreads();
    }
    const int gw = bid * NWAVES + wave, NGW = G * NWAVES;
    for (int tok = gw; tok < M; tok += NGW) {
        s_eid[lane] = EIDG[(size_t)tok * 128 + lane]; s_eid[64 + lane] = EIDG[(size_t)tok * 128 + 64 + lane];
        s_w[lane] = WG[(size_t)tok * 128 + lane]; s_w[64 + lane] = WG[(size_t)tok * 128 + 64 + lane];
        LDS_WAIT(); asm volatile("" ::: "memory");
        const bf16_t* x1 = X1 + (size_t)tok * D;
        {
            f32x2 acc2[2][16];
#define ACC(i, k) acc2[(i) >> 1][((i) & 1) * 8 + ((k) >> 1)][(k) & 1]
#pragma unroll
            for (int g = 0; g < 2; ++g)
#pragma unroll
                for (int k = 0; k < 16; ++k) acc2[g][k] = (f32x2){0.f, 0.f};
#define LOADROW4(dst, base, e) do { const u32x4* p_ = (const u32x4*)((base) + (size_t)(e) * ROW4) + lane; dst[0] = p_[0]; dst[1] = p_[64]; } while (0)
#define VACC4(row, j) do { const float w_ = s_w[j]; const f32x2 w2_ = {w_, w_}; _Pragma("unroll") for (int g_ = 0; g_ < 2; ++g_) { \
                u32x4 G_ = row[g_]; asm volatile("" : "+v"(G_)); \
                _Pragma("unroll") for (int k_ = 0; k_ < 4; ++k_) { const unsigned d_ = G_[k_]; \
                    acc2[g_][4 * k_] = __builtin_elementwise_fma(w2_, __builtin_amdgcn_cvt_scalef32_pk_f32_fp4(d_, 1.0f, 0), acc2[g_][4 * k_]); acc2[g_][4 * k_ + 1] = __builtin_elementwise_fma(w2_, __builtin_amdgcn_cvt_scalef32_pk_f32_fp4(d_, 1.0f, 1), acc2[g_][4 * k_ + 1]); \
                    acc2[g_][4 * k_ + 2] = __builtin_elementwise_fma(w2_, __builtin_amdgcn_cvt_scalef32_pk_f32_fp4(d_, 1.0f, 2), acc2[g_][4 * k_ + 2]); acc2[g_][4 * k_ + 3] = __builtin_elementwise_fma(w2_, __builtin_amdgcn_cvt_scalef32_pk_f32_fp4(d_, 1.0f, 3), acc2[g_][4 * k_ + 3]); } \
                asm volatile("" : "+v"(acc2[g_][0]), "+v"(acc2[g_][1]), "+v"(acc2[g_][2]), "+v"(acc2[g_][3]), "+v"(acc2[g_][4]), "+v"(acc2[g_][5]), "+v"(acc2[g_][6]), "+v"(acc2[g_][7]), \
                                  "+v"(acc2[g_][8]), "+v"(acc2[g_][9]), "+v"(acc2[g_][10]), "+v"(acc2[g_][11]), "+v"(acc2[g_][12]), "+v"(acc2[g_][13]), "+v"(acc2[g_][14]), "+v"(acc2[g_][15])); } } while (0)
            u32x4 r0[2], r1[2], r2[2], r3[2];
            { const int e_ = RFL(s_eid[0]); LOADROW4(r0, V4, e_); } { const int e_ = RFL(s_eid[1]); LOADROW4(r1, V4, e_); } { const int e_ = RFL(s_eid[2]); LOADROW4(r2, V4, e_); } { const int e_ = RFL(s_eid[3]); LOADROW4(r3, V4, e_); }
            for (int j = 0; j < 124; j += 4) {
                VACC4(r0, j);     { const int e_ = RFL(s_eid[j + 4]); LOADROW4(r0, V4, e_); }
                VACC4(r1, j + 1); { const int e_ = RFL(s_eid[j + 5]); LOADROW4(r1, V4, e_); }
                VACC4(r2, j + 2); { const int e_ = RFL(s_eid[j + 6]); LOADROW4(r2, V4, e_); }
                VACC4(r3, j + 3); { const int e_ = RFL(s_eid[j + 7]); LOADROW4(r3, V4, e_); }
            }
            VACC4(r0, 124); VACC4(r1, 125); VACC4(r2, 126); VACC4(r3, 127);
#undef VACC4
#undef LOADROW4
            float ss = 0.f;
#pragma unroll
            for (int i = 0; i < 4; ++i) { float t[16]; load16_bf16(x1 + 1024 * i + 16 * lane, t);
#pragma unroll
                for (int k = 0; k < 16; ++k) { ACC(i, k) += t[k]; ss += ACC(i, k) * ACC(i, k); } }
            ss = wave_sum_dpp(ss);
            const float rs = rsqrtf(ss * (1.0f / D) + 1e-6f);
            if (!FINAL) {
#pragma unroll
                for (int i = 0; i < 4; ++i) { u32x4 w8;
#pragma unroll
                    for (int q = 0; q < 4; ++q) w8[q] = pk4_fp8(ACC(i, 4 * q), ACC(i, 4 * q + 1), ACC(i, 4 * q + 2), ACC(i, 4 * q + 3));
                    *(u32x4*)(XB8n + (size_t)tok * D + 1024 * i + 16 * lane) = w8; }
                if (lane == 0) RSTDn[tok] = rs;
                float mine = 0.f;
#pragma unroll 1
                for (int j = 0; j < 10; ++j) { float s = 0.f;
#pragma unroll
                    for (int i = 0; i < 4; ++i) { const u32x4 g0 = *(const LAS u32x4*)(gfs + j * D + 1024 * i + 16 * lane), g1 = *(const LAS u32x4*)(gfs + j * D + 1024 * i + 16 * lane + 8);
#pragma unroll
                        for (int q = 0; q < 4; ++q) { s += ACC(i, 2 * q) * bf_lo(g0[q]) + ACC(i, 2 * q + 1) * bf_hi(g0[q]); s += ACC(i, 8 + 2 * q) * bf_lo(g1[q]) + ACC(i, 8 + 2 * q + 1) * bf_hi(g1[q]); } }
                    s = wave_sum_dpp(s); if (lane == j) mine = s; }
                if (lane < 10) { const int b_ = tok >> 11, s_ = tok & 2047; LOGFn[(size_t)(b_ * 10 + lane) * S + s_] = logsig(mine * rs + bf_n[lane]); }
            }
            if (FINAL) { float* xo = (float*)XOv + (size_t)tok * D;
#pragma unroll
                for (int i = 0; i < 4; ++i)
#pragma unroll
                    for (int q = 0; q < 4; ++q) { const int c = 1024 * i + 16 * lane + 4 * q; const f32x4 g_ = *(const f32x4*)(fg + c);
                        *(f32x4*)(xo + c) = (f32x4){ACC(i, 4 * q) * rs * g_[0], ACC(i, 4 * q + 1) * rs * g_[1], ACC(i, 4 * q + 2) * rs * g_[2], ACC(i, 4 * q + 3) * rs * g_[3]}; }
            } else { bf16_t* xo = (bf16_t*)XOv + (size_t)tok * D;
#pragma unroll
                for (int i = 0; i < 4; ++i) { u32x4 w0, w1;
#pragma unroll
                    for (int q = 0; q < 4; ++q) { w0[q] = pk2(ACC(i, 2 * q), ACC(i, 2 * q + 1)); w1[q] = pk2(ACC(i, 8 + 2 * q), ACC(i, 8 + 2 * q + 1)); }
                    *(u32x4*)(xo + 1024 * i + 16 * lane) = w0; *(u32x4*)(xo + 1024 * i + 16 * lane + 8) = w1; }
            }
        }
        LDS_WAIT(); asm volatile("" ::: "memory");
    }
#undef ACC
#undef LOADROW6
#undef GRP6
}
}
namespace at {
using namespace mk;
constexpr int QB = 256, KVB = 64, HD = 128;
constexpr int SHM_V = KVB * HD * 2, SHM_K = KVB * HD * 2;
constexpr int OFF_V = 0, OFF_K = 2 * SHM_V, OFF_WS = OFF_K + 2 * SHM_K, OFF_CUM = OFF_WS + 8 * 256, OFF_RT = OFF_CUM + 2048 * 4, OFF_MISC = OFF_RT + 640 * 4;
constexpr float LOG2E = 1.4426950408889634f;
constexpr float THR2 = 10.0f;
constexpr float SB_DONE = -100.0f;

#define AT_KSWZ(row, colB) ((row) * 256 + ((colB) ^ (((row) & 7) << 4)))
__device__ __forceinline__ int v_st(int k, int c) { const int kk = (k & ~0xC) | ((k & 4) << 1) | ((k & 8) >> 1); return ((kk >> 3) * 4 + (c >> 5)) * 512 + ((kk & 7) * 32 + (c & 31)) * 2; }
__device__ __forceinline__ int v_rd_base(int lane) { return ((lane & 3) << 3) | (((lane >> 2) & 3) << 6) | (((lane >> 4) & 1) << 5) | (((lane >> 5) & 1) << 8); }
constexpr int v_rd_off(int d0, int ks, int half) { return d0 * 512 + ks * 4096 + half * 2048; }
__device__ __forceinline__ int crow(int r, int hi) { return (r & 3) + 8 * (r >> 2) + 4 * hi; }
__device__ __forceinline__ unsigned cvtpk(float lo, float hi) { unsigned r; asm volatile("v_cvt_pk_bf16_f32 %0, %1, %2" : "=v"(r) : "v"(lo), "v"(hi)); return r; }
__device__ __forceinline__ float partner(float v, int hi) { auto rr = __builtin_amdgcn_permlane32_swap(__builtin_bit_cast(unsigned, v), __builtin_bit_cast(unsigned, v), false, false); return __builtin_bit_cast(float, hi ? rr[0] : rr[1]); }

__device__ __forceinline__ float xchg_max(float v, int hi) { return fmaxf(v, partner(v, hi)); }
__device__ __forceinline__ float xchg_sum(float v, int hi) { return v + partner(v, hi); }

__device__ __forceinline__ void pack_p(const f32x16& p0, const f32x16& p1, bf16x8& pa0, bf16x8& pa1, bf16x8& pa2, bf16x8& pa3) {
#define AT_PK4(P, B_, OUT) do { unsigned a0 = cvtpk(P[B_ + 0], P[B_ + 1]), a1 = cvtpk(P[B_ + 2], P[B_ + 3]); unsigned b0 = cvtpk(P[B_ + 4], P[B_ + 5]), b1 = cvtpk(P[B_ + 6], P[B_ + 7]); \
        auto r0 = __builtin_amdgcn_permlane32_swap(a0, b0, false, false); auto r1 = __builtin_amdgcn_permlane32_swap(a1, b1, false, false); \
        u32x4 w = {r0[0], r1[0], r0[1], r1[1]}; OUT = __builtin_bit_cast(bf16x8, w); } while (0)
    AT_PK4(p0, 0, pa0); AT_PK4(p0, 8, pa1); AT_PK4(p1, 0, pa2); AT_PK4(p1, 8, pa3);
#undef AT_PK4
}
template <int KBUF>
__device__ __forceinline__ void qkt(f32x16& p0, f32x16& p1, LAS unsigned char* K_lds, int r32, int hi, const bf16x8 (&qr)[8]) {
    p0 = f32x16{}; p1 = f32x16{};
    LAS unsigned char* kb[4];
#pragma unroll
    for (int dd = 0; dd < 4; ++dd) kb[dd] = K_lds + KBUF * SHM_K + AT_KSWZ(r32, (dd * 16 + hi * 8) * 2);
#pragma unroll
    for (int d0 = 0; d0 < 8; ++d0) { LAS unsigned char* a = kb[d0 & 3] + (d0 >> 2) * 128;
        const bf16x8 b0 = *(const LAS bf16x8*)a; const bf16x8 b1 = *(const LAS bf16x8*)(a + 32 * 256);
        p0 = __builtin_amdgcn_mfma_f32_32x32x16_bf16(b0, qr[d0], p0, 0, 0, 0);
        p1 = __builtin_amdgcn_mfma_f32_32x32x16_bf16(b1, qr[d0], p1, 0, 0, 0); }
}
template <int VBUF>
__device__ __forceinline__ void pv_tile(f32x16 (&o)[4], int vb0, bf16x8 pa0, bf16x8 pa1, bf16x8 pa2, bf16x8 pa3) {
#define AT_TRRD(dst, off) asm volatile("ds_read_b64_tr_b16 %0, %1 offset:%2" : "=&v"(dst) : "v"(vb0), "i"(off) : "memory")
#define AT_PV_D0(d0) do { s16x4 l0, l1, l2, l3, h0, h1, h2, h3; constexpr int b_ = VBUF * SHM_V + v_rd_off(d0, 0, 0); \
        AT_TRRD(l0, b_); AT_TRRD(h0, b_ + 2048); AT_TRRD(l1, b_ + 4096); AT_TRRD(h1, b_ + 6144); AT_TRRD(l2, b_ + 8192); AT_TRRD(h2, b_ + 10240); AT_TRRD(l3, b_ + 12288); AT_TRRD(h3, b_ + 14336); \
        asm volatile("s_waitcnt lgkmcnt(0)" ::: "memory"); __builtin_amdgcn_sched_barrier(0); \
        o[d0] = __builtin_amdgcn_mfma_f32_32x32x16_bf16(pa0, (bf16x8){l0[0], l0[1], l0[2], l0[3], h0[0], h0[1], h0[2], h0[3]}, o[d0], 0, 0, 0); \
        o[d0] = __builtin_amdgcn_mfma_f32_32x32x16_bf16(pa1, (bf16x8){l1[0], l1[1], l1[2], l1[3], h1[0], h1[1], h1[2], h1[3]}, o[d0], 0, 0, 0); \
        o[d0] = __builtin_amdgcn_mfma_f32_32x32x16_bf16(pa2, (bf16x8){l2[0], l2[1], l2[2], l2[3], h2[0], h2[1], h2[2], h2[3]}, o[d0], 0, 0, 0); \
        o[d0] = __builtin_amdgcn_mfma_f32_32x32x16_bf16(pa3, (bf16x8){l3[0], l3[1], l3[2], l3[3], h3[0], h3[1], h3[2], h3[3]}, o[d0], 0, 0, 0); } while (0)
    AT_PV_D0(0); AT_PV_D0(1); AT_PV_D0(2); AT_PV_D0(3);
#undef AT_PV_D0
#undef AT_TRRD
}

template <int VAR>
__device__ __forceinline__ void attn_item(const bf16_t* Qh, const bf16_t* Kh, const bf16_t* Vh, bf16_t* OB, const float* relb, const float* LOGF, int b, int h, int qb, LAS unsigned char* lds, int tid) {
    const int wid = __builtin_amdgcn_readfirstlane(tid >> 6), lane = tid & 63, r32 = lane & 31, hi = lane >> 5;
    const int g = VAR == 0 ? h : (VAR == 1 ? 12 + h : 22 + h);
    const size_t hb = (size_t)(b * NH + g) * S * HD;
    const bf16_t* Kp = Kh + hb; const bf16_t* Vp = Vh + hb;
    LAS unsigned char* V_lds = lds + OFF_V; LAS unsigned char* K_lds = lds + OFF_K;
    LAS float* wsf = (LAS float*)(lds + OFF_WS) + wid * 64; LAS float* li_l = wsf; LAS float* al_l = wsf + 32;
    LAS float* cumL = (LAS float*)(lds + OFF_CUM); LAS float* Rt = (LAS float*)(lds + OFF_RT); volatile LAS unsigned* flags = (volatile LAS unsigned*)(lds + OFF_MISC);
    const int P0 = qb * QB, qlo = P0 + wid * 32, qpos = qlo + r32;
    int NT, jlo = 0;
    if (VAR == 0) { jlo = 4 * qb - 8; if (jlo < 0) jlo = 0; NT = 4 * qb + 4 - jlo; } else NT = 4 * qb + 4;
    const int cw = 4 * qb + (wid >> 1);
#define AT_KBASE(t) (VAR == 1 ? (4 * qb + 3 - (t)) * KVB : (jlo + (t)) * KVB)
#define AT_ACT(t) (VAR == 0 ? ((jlo + (t)) >= cw - 8 && (jlo + (t)) <= cw) : (VAR == 1 ? (AT_KBASE(t) <= qlo + 30) : (AT_KBASE(t) <= qlo + 31)))
    if (VAR == 0) {
        const float* tab = relb + h * 257;
        for (int j = tid; j < 639; j += 512) { int rel = 575 - j; rel = rel < -128 ? -128 : (rel > 128 ? 128 : rel); Rt[j] = tab[rel + 128] * LOG2E; }
    }
    if (VAR == 2) {
        const float* lf = LOGF + (size_t)(b * 10 + h) * S; const int kend = P0 + QB;
        f32x4 v = (f32x4){0.f, 0.f, 0.f, 0.f};
        if (4 * tid < kend) v = *(const f32x4*)(lf + 4 * tid);
        v[1] += v[0]; v[2] += v[1]; v[3] += v[2];
        float tot = v[3];
#pragma unroll
        for (int o = 1; o < 64; o <<= 1) { const float t_ = lane_read(tot, lane >= o ? lane - o : lane); if (lane >= o) tot += t_; }
        if (lane == 63) li_l[0] = tot;
        __syncthreads();
        float base = tot - v[3];
        for (int w = 0; w < wid; ++w) base += ((LAS float*)(lds + OFF_WS))[w * 64];
        if (4 * tid < kend) *(LAS f32x4*)(cumL + 4 * tid) = (f32x4){(base + v[0]) * LOG2E, (base + v[1]) * LOG2E, (base + v[2]) * LOG2E, (base + v[3]) * LOG2E};
    }
    bf16x8 qr[8];
    { const bf16_t* qp = Qh + hb + (size_t)(qlo + r32) * HD + hi * 8;
#pragma unroll
      for (int d0 = 0; d0 < 8; ++d0) qr[d0] = *(const bf16x8*)(qp + d0 * 16); }
    const int sr = tid >> 4, sc = (tid & 15) * 8, vst0 = v_st(sr, sc), vst1 = v_st(32 + sr, sc), kws = AT_KSWZ(sr, sc * 2);
    const int vb0 = (int)(unsigned)(size_t)V_lds + v_rd_base(lane);
    bf16x8 st_k0, st_k1, st_v0, st_v1;
#define AT_SLOAD(k0) do { const bf16_t* kp_ = Kp + (size_t)((k0) + sr) * HD + sc; const bf16_t* vp_ = Vp + (size_t)((k0) + sr) * HD + sc; \
        st_k0 = *(const bf16x8*)kp_; st_k1 = *(const bf16x8*)(kp_ + 32 * HD); st_v0 = *(const bf16x8*)vp_; st_v1 = *(const bf16x8*)(vp_ + 32 * HD); } while (0)
#define AT_SWRITE(bf) do { *(LAS bf16x8*)(K_lds + (bf) * SHM_K + kws) = st_k0; *(LAS bf16x8*)(K_lds + (bf) * SHM_K + kws + 32 * 256) = st_k1; \
        *(LAS bf16x8*)(V_lds + (bf) * SHM_V + vst0) = st_v0; *(LAS bf16x8*)(V_lds + (bf) * SHM_V + vst1) = st_v1; } while (0)
    AT_SLOAD(AT_KBASE(0)); asm volatile("s_waitcnt vmcnt(0)" ::: "memory"); AT_SWRITE(0);
    __syncthreads();
    float m_reg = -1e30f, l_reg = 0.f, carry = 0.f;
    f32x16 o[4] = {};
#define AT_STEP(BUF, t) do { \
        const bool more_ = (t) + 1 < NT; \
        if (more_) AT_SLOAD(AT_KBASE((t) + 1)); \
        if (AT_ACT(t)) { \
            const int kb_ = AT_KBASE(t); f32x16 p0, p1; bf16x8 pa0, pa1, pa2, pa3; \
            qkt<BUF>(p0, p1, K_lds, r32, hi, qr); \
            tile_math(p0, p1, kb_, pa0, pa1, pa2, pa3); \
            pv_tile<BUF>(o, vb0, pa0, pa1, pa2, pa3); \
        } \
        if (more_) { asm volatile("s_waitcnt vmcnt(0)" ::: "memory"); AT_SWRITE((BUF) ^ 1); } \
        if (VAR == 1) { const bool done_ = __all(carry < SB_DONE); if (lane == 0) flags[((t) & 1) * 8 + wid] = done_ ? 1u : 0u; } \
        __syncthreads(); \
    } while (0)
    auto tile_math = [&](f32x16& p0, f32x16& p1, int kb, bf16x8& pa0, bf16x8& pa1, bf16x8& pa2, bf16x8& pa3) __attribute__((always_inline)) {
        const int dq = qpos - kb - 4 * hi;
        if (VAR == 1) {
            const bool need_mask = kb + 63 >= qlo;
            f32x16 n0, n1;
#pragma unroll
            for (int r = 0; r < 16; ++r) { const float z = p0[r]; const float lp = __builtin_amdgcn_logf(1.0f + __builtin_amdgcn_exp2f(-fabsf(z))); n0[r] = fminf(-z, 0.f) - lp;
                                           const float y = p1[r]; const float lq = __builtin_amdgcn_logf(1.0f + __builtin_amdgcn_exp2f(-fabsf(y))); n1[r] = fminf(-y, 0.f) - lq; }
            if (need_mask) {
#pragma unroll
                for (int r = 0; r < 16; ++r) { const int c = (r & 3) + 8 * (r >> 2);
                    if (dq - c <= 0) { n0[r] = 0.f; p0[r] = -__builtin_inff(); }
                    if (dq - c - 32 <= 0) { n1[r] = 0.f; p1[r] = -__builtin_inff(); } }
            }
            float A[8], Bp[8];
#pragma unroll
            for (int q = 0; q < 4; ++q) { A[q] = (n0[4 * q] + n0[4 * q + 1]) + (n0[4 * q + 2] + n0[4 * q + 3]); A[4 + q] = (n1[4 * q] + n1[4 * q + 1]) + (n1[4 * q + 2] + n1[4 * q + 3]); }
#pragma unroll
            for (int q = 0; q < 8; ++q) Bp[q] = partner(A[q], hi);
            float st = 0.f;
#pragma unroll
            for (int q = 7; q >= 0; --q) {
                const float after = carry + st + (hi == 0 ? Bp[q] : 0.f);
                if (q >= 4) { const int r0 = 4 * (q - 4);
                    float tl = after; p1[r0 + 3] = __builtin_amdgcn_exp2f(p1[r0 + 3] + n1[r0 + 3] + tl); tl += n1[r0 + 3]; p1[r0 + 2] = __builtin_amdgcn_exp2f(p1[r0 + 2] + n1[r0 + 2] + tl); tl += n1[r0 + 2];
                    p1[r0 + 1] = __builtin_amdgcn_exp2f(p1[r0 + 1] + n1[r0 + 1] + tl); tl += n1[r0 + 1]; p1[r0] = __builtin_amdgcn_exp2f(p1[r0] + n1[r0] + tl); }
                else { const int r0 = 4 * q;
                    float tl = after; p0[r0 + 3] = __builtin_amdgcn_exp2f(p0[r0 + 3] + n0[r0 + 3] + tl); tl += n0[r0 + 3]; p0[r0 + 2] = __builtin_amdgcn_exp2f(p0[r0 + 2] + n0[r0 + 2] + tl); tl += n0[r0 + 2];
                    p0[r0 + 1] = __builtin_amdgcn_exp2f(p0[r0 + 1] + n0[r0 + 1] + tl); tl += n0[r0 + 1]; p0[r0] = __builtin_amdgcn_exp2f(p0[r0] + n0[r0] + tl); }
                st += A[q] + Bp[q];
            }
            carry += st;
            pack_p(p0, p1, pa0, pa1, pa2, pa3);
        } else {
            if (VAR == 0) {
                const LAS float* rp = Rt + (575 - (qpos - kb) + 4 * hi);
#pragma unroll
                for (int r = 0; r < 16; ++r) { const int c = (r & 3) + 8 * (r >> 2); p0[r] += rp[c]; p1[r] += rp[c + 32]; }
            } else {
                const LAS float* cp = cumL + kb + 4 * hi;
#pragma unroll
                for (int q = 0; q < 4; ++q) { const f32x4 c0 = *(const LAS f32x4*)(cp + 8 * q), c1 = *(const LAS f32x4*)(cp + 32 + 8 * q);
                    p0[4 * q] -= c0[0]; p0[4 * q + 1] -= c0[1]; p0[4 * q + 2] -= c0[2]; p0[4 * q + 3] -= c0[3];
                    p1[4 * q] -= c1[0]; p1[4 * q + 1] -= c1[1]; p1[4 * q + 2] -= c1[2]; p1[4 * q + 3] -= c1[3]; }
                if (kb + 63 > qlo) {
#pragma unroll
                    for (int r = 0; r < 16; ++r) { const int c = (r & 3) + 8 * (r >> 2);
                        if (dq - c < 0) p0[r] = -__builtin_inff();
                        if (dq - c - 32 < 0) p1[r] = -__builtin_inff(); }
                }
            }
            float pmax = p0[0];
#pragma unroll
            for (int r = 1; r < 16; ++r) pmax = fmaxf(pmax, p0[r]);
#pragma unroll
            for (int r = 0; r < 16; ++r) pmax = fmaxf(pmax, p1[r]);
            pmax = xchg_max(pmax, hi);
            float mn, alpha;
            if (__all(pmax - m_reg <= THR2)) { mn = m_reg; alpha = 1.f; }
            else { mn = fmaxf(m_reg, pmax); alpha = __builtin_amdgcn_exp2f(m_reg - mn); m_reg = mn; }
            float ps = 0.f;
#pragma unroll
            for (int r = 0; r < 16; ++r) { p0[r] = __builtin_amdgcn_exp2f(p0[r] - mn); p1[r] = __builtin_amdgcn_exp2f(p1[r] - mn); ps += p0[r] + p1[r]; }
            ps = xchg_sum(ps, hi);
            l_reg = l_reg * alpha + ps;
            if (__any(alpha < 1.f)) {
                if (hi == 0) al_l[r32] = alpha;
                asm volatile("s_waitcnt lgkmcnt(0)" ::: "memory");
                float av[16];
#pragma unroll
                for (int r = 0; r < 16; ++r) av[r] = al_l[crow(r, hi)];
#pragma unroll
                for (int d = 0; d < 4; ++d)
#pragma unroll
                    for (int r = 0; r < 16; ++r) o[d][r] *= av[r];
            }
            pack_p(p0, p1, pa0, pa1, pa2, pa3);
        }
    };
    for (int t = 0; t < NT; t += 2) {
        AT_STEP(0, t);
        if (VAR == 1) { unsigned all_ = 1u; for (int w = 0; w < 8; ++w) all_ &= flags[(t & 1) * 8 + w]; if (all_) break; }
        if (t + 1 >= NT) break;
        AT_STEP(1, t + 1);
        if (VAR == 1) { unsigned all_ = 1u; for (int w = 0; w < 8; ++w) all_ &= flags[((t + 1) & 1) * 8 + w]; if (all_) break; }
    }
    float rli[16];
    if (VAR != 1) {
        if (hi == 0) li_l[r32] = l_reg;
        asm volatile("s_waitcnt lgkmcnt(0)" ::: "memory");
#pragma unroll
        for (int r = 0; r < 16; ++r) rli[r] = __builtin_amdgcn_rcpf(li_l[crow(r, hi)]);
    }
    unsigned char* Ow8 = (unsigned char*)OB + (size_t)(b * S + qlo) * D + g * HD;
#pragma unroll
    for (int r = 0; r < 16; ++r) { const int orow = crow(r, hi);
#pragma unroll
        for (int d0 = 0; d0 < 4; ++d0) { const float v = VAR != 1 ? o[d0][r] * rli[r] : o[d0][r];
            const float vn = lane_read(v, lane ^ 1);
            if ((r32 & 1) == 0) *(unsigned short*)(Ow8 + (size_t)orow * D + d0 * 32 + r32) = (unsigned short)__builtin_amdgcn_cvt_pk_fp8_f32(clamp8(v * 16.0f), clamp8(vn * 16.0f), 0, false); } }
    __syncthreads();
#undef AT_STEP
#undef AT_SLOAD
#undef AT_SWRITE
#undef AT_KBASE
#undef AT_ACT
}

template <int VAR>
__device__ __forceinline__ void attn_queue(const bf16_t* Qh, const bf16_t* Kh, const bf16_t* Vh, bf16_t* OB, const float* relb, const float* LOGF, unsigned* qhead, LAS unsigned char* lds, int wave0) {
    FRESH_TID(); FRESH_LDS(lds);
    volatile LAS unsigned* qslot = (volatile LAS unsigned*)(lds + OFF_MISC) + 32;
    constexpr int NHV = VAR == 0 ? 12 : 10, NITEMS = 8 * NHV * 8;
    for (;;) {
        if (tid == 0) qslot[0] = __hip_atomic_fetch_add(qhead, 1u, __ATOMIC_RELAXED, __HIP_MEMORY_SCOPE_AGENT);
        __syncthreads();
        const int idx = (int)qslot[0];
        __syncthreads();
        if (idx >= NITEMS) break;
        const int qb = 7 - idx / (8 * NHV), bh = idx % (8 * NHV);
        attn_item<VAR>(Qh, Kh, Vh, OB, relb, LOGF, bh / NHV, bh % NHV, qb, lds, tid);
    }
}
__device__ __forceinline__ void attn_phase(const bf16_t* Qh, const bf16_t* Kh, const bf16_t* Vh, bf16_t* OB, const float* relb, const float* LOGF, unsigned* qheads, LAS unsigned char* lds, int wave0) {
    attn_queue<2>(Qh, Kh, Vh, OB, relb, LOGF, qheads + 0, lds, wave0);
    attn_queue<0>(Qh, Kh, Vh, OB, relb, LOGF, qheads + 64, lds, wave0);
    attn_queue<1>(Qh, Kh, Vh, OB, relb, LOGF, qheads + 128, lds, wave0);
}
}
namespace mk {
#define XB_TMO      128
#define XB_XCNT(j)  (256  + 64 * (j))
#define XB_XSUB(j)  (1280 + 64 * (j))
#define XB_XGEN(j)  (2304 + 64 * (j))
#define XB_TOP      3328
#define XB_TOPGEN   3392
#define XCD_BAR_WORDS 3456
#define XB_SPIN_CAP (1u << 22)

__device__ __forceinline__ unsigned xb_ld(unsigned* p)              { return __hip_atomic_load(p, __ATOMIC_RELAXED, __HIP_MEMORY_SCOPE_AGENT); }
__device__ __forceinline__ unsigned xb_add(unsigned* p, unsigned v) { return __hip_atomic_fetch_add(p, v, __ATOMIC_RELAXED, __HIP_MEMORY_SCOPE_AGENT); }
__device__ __forceinline__ unsigned xb_xcc_id() { return (unsigned)__builtin_amdgcn_s_getreg((3 << 11) | 20) & 0xFu; }
#define XB_SPIN(cond, bar) do { unsigned _sp = 0; while (cond) { __builtin_amdgcn_s_sleep(1); \
    if ((++_sp & 255u) == 0u) { if (xb_ld(&(bar)[XB_TMO])) break; if (_sp > XB_SPIN_CAP) { atomicAdd(&(bar)[XB_TMO], 1u); break; } } } } while (0)

struct XcdBarrier {
    unsigned* bar; unsigned x;
    volatile LAS unsigned* st;
};

__device__ __forceinline__ XcdBarrier xcd_barrier_post(unsigned* bar, volatile LAS unsigned* st, bool is_t0) {
    XcdBarrier b; b.bar = bar; b.x = xb_xcc_id(); b.st = st;
    if (is_t0) (void)xb_add(&bar[XB_XCNT(b.x)], 1u);
    return b;
}
__device__ __forceinline__ void xcd_barrier_complete(unsigned* bar, unsigned x, unsigned& nloc, unsigned& nx) {
    const unsigned G = gridDim.x * gridDim.y * gridDim.z;
    unsigned sum, cnt, mine, sp = 0u;
    for (;;) {
        sum = 0u; cnt = 0u; mine = 0u;
#pragma unroll
        for (unsigned j = 0; j < 16; ++j) { const unsigned c = xb_ld(&bar[XB_XCNT(j)]); sum += c; cnt += (c > 0u) ? 1u : 0u; mine = (j == x) ? c : mine; }
        if (sum == G) break;
        __builtin_amdgcn_s_sleep(1);
        if ((++sp & 255u) == 0u) { if (xb_ld(&bar[XB_TMO])) break; if (sp > XB_SPIN_CAP) { atomicAdd(&bar[XB_TMO], 1u); break; } }
    }
    nloc = mine > 0u ? mine : 1u; nx = cnt > 0u ? cnt : 1u;
}

__device__ __forceinline__ void xcd_barrier(const XcdBarrier& b, bool is_t0) {
    asm volatile("s_waitcnt vmcnt(0)" ::: "memory");
    __syncthreads();
    if (is_t0) {
        unsigned* bar = b.bar;
        __builtin_amdgcn_s_waitcnt(0);
        unsigned nloc = b.st[0], nx = b.st[1];
        if (nloc == 0u) { xcd_barrier_complete(bar, b.x, nloc, nx); b.st[0] = nloc; b.st[1] = nx; }
        const unsigned old = xb_add(&bar[XB_XSUB(b.x)], 1u);
        const unsigned gen = old / nloc;
        if (old + 1u == (gen + 1u) * nloc) {
            __builtin_amdgcn_fence(__ATOMIC_RELEASE, "agent");
            asm volatile("s_waitcnt vmcnt(0)" ::: "memory");
            const unsigned og = xb_add(&bar[XB_TOP], 1u);
            const unsigned tg = og / nx;
            if (og + 1u == (tg + 1u) * nx) xb_add(&bar[XB_TOPGEN], 1u);
            else XB_SPIN(xb_ld(&bar[XB_TOPGEN]) == tg, bar);
            __builtin_amdgcn_fence(__ATOMIC_ACQUIRE, "agent");
            xb_add(&bar[XB_XGEN(b.x)], 1u);
            asm volatile("s_waitcnt vmcnt(0)" ::: "memory");
        } else {
            XB_SPIN(xb_ld(&bar[XB_XGEN(b.x)]) == gen, bar);
            __builtin_amdgcn_fence(__ATOMIC_ACQUIRE, "agent");
            asm volatile("s_waitcnt vmcnt(0)" ::: "memory");
        }
    }
    __syncthreads();
}

constexpr int PH_PER_LAYER = 8;
typedef const __attribute__((address_space(4))) Args* KArgs;
#define KARGS() ({ KArgs p_ = (KArgs)__builtin_amdgcn_kernarg_segment_ptr(); asm volatile("" : "+s"(p_)); p_; })
#define GRID_BAR() do { KArgs k_ = KARGS(); XcdBarrier b_; b_.bar = (unsigned*)(k_->ws + WS_CTL) + CW_BAR; b_.x = xb_xcc_id(); b_.st = (volatile LAS unsigned*)(lds + MISC_OFF) + 8; unsigned z_ = 0u; asm volatile("" : "+v"(z_)); const bool t0_ = (wave0 == 0) && (__builtin_amdgcn_mbcnt_hi(~0u, __builtin_amdgcn_mbcnt_lo(~0u, z_)) == 0u);     xcd_barrier(b_, t0_); } while (0)
__global__ void __launch_bounds__(NWAVES * 64, 2) mk_fwd(Args a_unused) {
    extern __shared__ __attribute__((aligned(16))) unsigned char lds_raw[];
    LAS unsigned char* lds = (LAS unsigned char*)lds_raw;
    const int wave0 = __builtin_amdgcn_readfirstlane((int)threadIdx.x >> 6);
    for (int u = threadIdx.x; u < (LDS_BYTES - LDSCTL_OFF) / 4; u += NWAVES * 64) ((LAS unsigned*)(lds + LDSCTL_OFF))[u] = 0u;
    __syncthreads();
    int lo, hi;
    { KArgs k = KARGS(); lo = k->ph_lo; hi = k->ph_hi;
      if (hi - lo > 1) (void)xcd_barrier_post((unsigned*)(k->ws + WS_CTL) + CW_BAR, (volatile LAS unsigned*)(lds + MISC_OFF) + 8, threadIdx.x == 0); }
#define IN(k) (lo <= (k) && (k) < hi)
#define BOTH(k) (IN(k) && IN((k) + 1))
#pragma unroll
    for (int l = 0; l < 2; ++l) {
        const int pb = PH_PER_LAYER * l;
        if (IN(pb + 0)) { KArgs k = KARGS(); conv_phase(k, l, lds, wave0); }
        if (IN(pb + 1) && l == 0) {
            KArgs k = KARGS(); unsigned char* ws = k->ws;
            const float* xin = k->in[0];
            prep_phase<true>(xin, (bf16_t*)(ws + WS_XB8N), (float*)(ws + WS_RSTD), k->in[2] + (size_t)l * D * PW, k->in[1] + (size_t)l * D, k->in[3] + l * 10, (float*)(ws + WS_LOGF), lds, wave0);
            if (BOTH(pb + 1)) GRID_BAR();
        }
        if (l == 1 && IN(pb + 0) && IN(pb + 2)) GRID_BAR();
        if (IN(pb + 2)) {
            KArgs k = KARGS(); unsigned char* ws = k->ws;
            pg8::Gemm g{(const bf16_t*)(ws + WS_XB8N), (const bf16_t*)(ws + WS_WIN), M, 12288, D}; pg8::StaticOrder So; FRESH_BID(); So.init(M, 12288, G, bid);
            pg8::EpiQKV4 E{(bf16_t*)(ws + WS_Q), (const float*)(ws + WS_RSTD), 0.08838834764831845f * 1.4426950408889634f, US_INV};
            { LAS unsigned char* lds_ = lds; FRESH_LDS(lds_); FRESH_TID(); pg8::gemm_phase<pg8::EpiQKV4, pg8::StaticOrder, true, true, true>(lds_, g, So, E, tid); }
            if (BOTH(pb + 2)) GRID_BAR();
        }
        if (IN(pb + 3)) {
            KArgs k = KARGS(); unsigned char* ws = k->ws;
            at::attn_phase((const bf16_t*)(ws + WS_Q), (const bf16_t*)(ws + WS_K), (const bf16_t*)(ws + WS_V), (bf16_t*)(ws + WS_OB), k->in[4] + (size_t)l * 12 * 257, (const float*)(ws + WS_LOGF),
                           (unsigned*)(ws + WS_CTL) + CW_QUEUE + 256 * l, lds, wave0);
            if (BOTH(pb + 3)) GRID_BAR();
        }
        if (IN(pb + 4)) {
            KArgs k = KARGS(); unsigned char* ws = k->ws;
            pg8::Gemm g{(const bf16_t*)(ws + WS_OB), (const bf16_t*)(ws + WS_WOUT), M, D, D}; pg8::StaticOrder So; FRESH_BID(); So.init(M, D, G, bid);
            if (l == 0) { pg8::EpiResidB16<true> E{k->in[0], US_INV * (1.0f / 16.0f), (bf16_t*)(ws + WS_XB)};
                { LAS unsigned char* lds_ = lds; FRESH_LDS(lds_); FRESH_TID(); pg8::gemm_phase<pg8::EpiResidB16<true>, pg8::StaticOrder, false, true, true>(lds_, g, So, E, tid); } }
            else { pg8::EpiResidB16<false> E{ws + WS_X2, US_INV * (1.0f / 16.0f), (bf16_t*)(ws + WS_XB)};
                { LAS unsigned char* lds_ = lds; FRESH_LDS(lds_); FRESH_TID(); pg8::gemm_phase<pg8::EpiResidB16<false>, pg8::StaticOrder, false, true, true>(lds_, g, So, E, tid); } }
            if (BOTH(pb + 4)) GRID_BAR();
        }
        if (IN(pb + 5)) {
            KArgs k = KARGS(); unsigned char* ws = k->ws;
            pg8::Gemm g{(const bf16_t*)(ws + WS_XB), (const bf16_t*)(ws + WS_WQK), M, 2048, D}; pg8::StaticOrder So; FRESH_BID(); So.init(M, 2048, G, bid);
            pg8::EpiPlainF32<2048> E{(float*)(ws + WS_SC)};
            { LAS unsigned char* lds_ = lds; FRESH_LDS(lds_); FRESH_TID(); pg8::gemm_phase<pg8::EpiPlainF32<2048>, pg8::StaticOrder, true, true>(lds_, g, So, E, tid); }
            if (BOTH(pb + 5)) GRID_BAR();
        }
        if (IN(pb + 6)) {
            KArgs k = KARGS(); unsigned char* ws = k->ws;
            peer_u_phase((const float*)(ws + WS_SC), (const unsigned char*)(ws + WS_U16), (const bf16_t*)(ws + WS_XB), (int*)(ws + WS_K), (float*)(ws + WS_K + 8 * MiB), lds, wave0);
            if (BOTH(pb + 6)) GRID_BAR();
        }
        if (IN(pb + 7)) {
            KArgs k = KARGS(); unsigned char* ws = k->ws;
            if (l == 0) peer_v_phase<false>((const int*)(ws + WS_K), (const float*)(ws + WS_K + 8 * MiB), (const unsigned char*)(ws + WS_U16) + (size_t)NE * ROW6  , (const bf16_t*)(ws + WS_XB), ws + WS_X2, nullptr,
                                            ws + WS_XB8N, (float*)(ws + WS_RSTD), (float*)(ws + WS_LOGF), k->in[2] + (size_t)D * PW, k->in[1] + D, k->in[3] + 10, lds, wave0);
            else peer_v_phase<true>((const int*)(ws + WS_K), (const float*)(ws + WS_K + 8 * MiB), (const unsigned char*)(ws + WS_U16) + (size_t)NE * ROW6  , (const bf16_t*)(ws + WS_XB), k->out, k->in[12],
                                    nullptr, nullptr, nullptr, nullptr, nullptr, nullptr, lds, wave0);
            if (BOTH(pb + 7)) GRID_BAR();
        }
    }
#undef IN
#undef BOTH
}

static int g_grid = 0;
static void launch_phases(Args a, int lo, int hi, hipStream_t st) {
    a.ph_lo = lo; a.ph_hi = hi;
    hipLaunchKernelGGL(mk_fwd, dim3(g_grid), dim3(NWAVES * 64), LDS_BYTES, st, a);
}
}

extern "C" void kernel_launch(void* const* d_in, const int* in_sizes, int n_in, void* d_out, int out_size, void* d_ws, size_t ws_size, hipStream_t stream) {
    (void)in_sizes; (void)n_in; (void)out_size;
    using namespace mk;
    if (g_grid == 0) {
        if (ws_size < 2048 * MiB) { fprintf(stderr, "kernel_launch: workspace too small (%zu)\n", ws_size); g_grid = -1; return; }
        if (hipFuncSetAttribute((const void*)mk_fwd, hipFuncAttributeMaxDynamicSharedMemorySize, LDS_BYTES) != hipSuccess) { fprintf(stderr, "kernel_launch: hipFuncSetAttribute failed\n"); g_grid = -1; return; }
        int dev = 0, cus = 0; (void)hipGetDevice(&dev); (void)hipDeviceGetAttribute(&cus, hipDeviceAttributeMultiprocessorCount, dev);
        g_grid = cus > 0 ? cus : 256;
    }
    if (g_grid < 0) return;
    unsigned char* ws = (unsigned char*)d_ws; float* out = (float*)d_out;
    (void)hipMemsetAsync(ws + WS_CTL, 0, CTL_ZERO_BYTES, stream);
    Args a{};
    for (int i = 0; i < 13; ++i) a.in[i] = (const float*)d_in[i];
    a.out = out; a.ws = ws;
    launch_phases(a, 0, 2 * PH_PER_LAYER, stream);
}
```

```cpp
#include <hip/hip_runtime.h>
#include <cstdio>
#include <cstdint>
namespace pg8 {
#define PG8_LAS __attribute__((address_space(3)))
typedef unsigned short bf16_t;
typedef short bf16x8 __attribute__((ext_vector_type(8)));
typedef float f32x4 __attribute__((ext_vector_type(4)));
typedef unsigned u32x4 __attribute__((ext_vector_type(4)));
typedef unsigned u32x2 __attribute__((ext_vector_type(2)));
constexpr int BM = 256, BK = 64, HALF = 128, HTB = HALF * BK * 2  , STAGE_BYTES = 8 * HTB, NXCD = 8, WGM = 8;

__host__ __device__ __forceinline__ int lds_byte(int r, int c) { const int st = (r >> 4) * 2 + (c >> 5), rr = r & 15, cc = c & 31, ob = rr * 64 + cc * 2; return st * 1024 + (ob ^ (((ob >> 9) & 1) << 5)); }
__host__ __device__ __forceinline__ void stage_rc(int b, int& R, int& C) { const int st = b / 1024, sb = b % 1024, swz = sb ^ (((sb >> 9) & 1) << 5); R = (st >> 1) * 16 + swz / 64; C = (st & 1) * 32 + (swz % 64) / 2; }
__host__ __device__ __forceinline__ int perm32(int rho) { const int n = rho >> 4, i = rho & 15; return 8 * (i >> 2) + 4 * n + (i & 3); }

struct Unit { int pm, pn; };
struct Gemm { const bf16_t* A; const bf16_t* Bt; int M, N, K; };

struct StaticOrder {
    int nM, nN, nwg, G, c;
    __host__ __device__ void init(int M, int N, int G_, int c_) { nM = M / BM; nN = N / BM; nwg = nM * nN; G = G_; c = c_; }
    __host__ __device__ bool next(int i, Unit& u) const {
        const long L = (long)i * G + c; if (L >= nwg) return false;
        int wgid = (int)L; { const int q = nwg / NXCD, r = nwg % NXCD, xcd = wgid % NXCD, off = wgid / NXCD; wgid = (xcd < r ? xcd * (q + 1) : r * (q + 1) + (xcd - r) * q) + off; }
        const int nig = WGM * nN, gid = wgid / nig, fm = gid * WGM, gsz = (nM - fm) < WGM ? (nM - fm) : WGM;
        u.pm = fm + ((wgid % nig) % gsz); u.pn = (wgid % nig) / gsz; return true;
    }
    __device__ __forceinline__ void a_ready(const Unit&) const {}
    __device__ __forceinline__ void done(const Unit&) const {}
};
__device__ __forceinline__ unsigned cvt_pk_bf16(float lo, float hi) { unsigned r; asm volatile("v_cvt_pk_bf16_f32 %0, %1, %2" : "=v"(r) : "v"(lo), "v"(hi)); return r; }
typedef float f32x2 __attribute__((ext_vector_type(2)));
__device__ __forceinline__ f32x2 gelu_pk(f32x2 v) {
    const f32x2 av = __builtin_elementwise_abs(v), d = av * 0.2316418882f + 1.0f;
    f32x2 t; t.x = __builtin_amdgcn_rcpf(d.x); t.y = __builtin_amdgcn_rcpf(d.y);
    f32x2 q = t * 0.5307027145f + (-0.7265760135f); q = q * t + 0.7107068705f; q = q * t + (-0.142248368f); q = q * t + 0.127414796f; q = q * t;
    const f32x2 s = (v * v) * (-0.72134752044f);
    f32x2 e; e.x = __builtin_amdgcn_exp2f(s.x); e.y = __builtin_amdgcn_exp2f(s.y);
    const f32x2 m = v * (q * e), r = v - m;
    f32x2 o; o.x = v.x < 0.f ? m.x : r.x; o.y = v.y < 0.f ? m.y : r.y; return o;
}
#define EPI_FRESH_LANE() { unsigned z_ = 0u; asm volatile("" : "+v"(z_)); const int l_ = (int)__builtin_amdgcn_mbcnt_hi(~0u, __builtin_amdgcn_mbcnt_lo(~0u, z_)); fr = l_ & 15; fq = l_ >> 4; }
typedef __amdgpu_buffer_rsrc_t rsrc_t;
__device__ __forceinline__ rsrc_t mkrsrc(const void* p, unsigned bytes) { return __builtin_amdgcn_make_buffer_rsrc((void*)p, (short)0, (int)bytes, 0x00020000); }
template <int LDC> struct EpiPlainF32 {
    static constexpr bool PERM = false, AFTER_DRAIN = false;
    float* C;
    __device__ __forceinline__ void operator()(const f32x4 (&acc)[2][2][4][2], const Unit& u, int wr, int wc, int fr, int fq) const {
        EPI_FRESH_LANE();
        const rsrc_t rc = mkrsrc(C, 16384u * LDC * 4u);
        const int vo = ((wr * 64 + fr) * LDC + wc * 32 + 4 * fq) * 4, so = (u.pm * BM * LDC + u.pn * BM) * 4;
#pragma unroll
        for (int ai = 0; ai < 2; ++ai)
#pragma unroll
            for (int m = 0; m < 4; ++m)
#pragma unroll
                for (int bj = 0; bj < 2; ++bj)
#pragma unroll
                    for (int n = 0; n < 2; ++n) __builtin_amdgcn_raw_buffer_store_b128(__builtin_bit_cast(u32x4, acc[ai][bj][m][n]), rc, vo, so + ((ai * HALF + m * 16) * LDC + bj * HALF + n * 16) * 4, 0);
    }
};
template <int LDC> struct EpiRowScaleF32 {
    static constexpr bool PERM = false, AFTER_DRAIN = false;
    float* C; const float* rs;
    __device__ __forceinline__ void operator()(const f32x4 (&acc)[2][2][4][2], const Unit& u, int wr, int wc, int fr, int fq) const {
        const rsrc_t rc = mkrsrc(C, 16384u * LDC * 4u), rr = mkrsrc(rs, 16384u * 4u);
        const int vo = ((wr * 64 + fr) * LDC + wc * 32 + 4 * fq) * 4, vr = (wr * 64 + fr) * 4;
        const int so = (u.pm * BM * LDC + u.pn * BM) * 4, sr = u.pm * BM * 4;
#pragma unroll
        for (int ai = 0; ai < 2; ++ai)
#pragma unroll
            for (int m = 0; m < 4; ++m) { const float s = __builtin_bit_cast(float, __builtin_amdgcn_raw_buffer_load_b32(rr, vr, sr + (ai * HALF + m * 16) * 4, 0));
#pragma unroll
                for (int bj = 0; bj < 2; ++bj)
#pragma unroll
                    for (int n = 0; n < 2; ++n) { const f32x4 v = acc[ai][bj][m][n] * s; __builtin_amdgcn_raw_buffer_store_b128(__builtin_bit_cast(u32x4, v), rc, vo, so + ((ai * HALF + m * 16) * LDC + bj * HALF + n * 16) * 4, 0); } }
    }
};
template <bool BASE_F32> struct EpiResidB16 {
    static constexpr bool PERM = false, AFTER_DRAIN = false;
    const void* base; float ascale; bf16_t* xb;
    __device__ __forceinline__ void operator()(const f32x4 (&acc)[2][2][4][2], const Unit& u, int wr, int wc, int fr, int fq) const {
        EPI_FRESH_LANE();
        constexpr int LDC = 4096;
        const rsrc_t rb = mkrsrc(base, 16384u * LDC * (BASE_F32 ? 4u : 2u)), rx = mkrsrc(xb, 16384u * LDC * 2u);
        const int vo = ((wr * 64 + fr) * LDC + wc * 32 + 4 * fq) * 2;
        const int so = (u.pm * BM * LDC + u.pn * BM) * 2;
        f32x4 ra[2][2], rb2[2][2];
#define EPI_LD(dst, g_) do { _Pragma("unroll") for (int bj = 0; bj < 2; ++bj) _Pragma("unroll") for (int n = 0; n < 2; ++n) { \
            const int o = so + ((((g_) >> 2) * HALF + ((g_) & 3) * 16) * LDC + bj * HALF + n * 16) * 2; \
            if constexpr (BASE_F32) dst[bj][n] = __builtin_bit_cast(f32x4, __builtin_amdgcn_raw_buffer_load_b128(rb, vo * 2, o * 2, 0)); \
            else { const u32x2 t_ = __builtin_amdgcn_raw_buffer_load_b64(rb, vo, o, 0); dst[bj][n] = (f32x4){__builtin_bit_cast(float, t_.x << 16), __builtin_bit_cast(float, t_.x & 0xffff0000u), __builtin_bit_cast(float, t_.y << 16), __builtin_bit_cast(float, t_.y & 0xffff0000u)}; } } } while (0)
#define EPI_ST(src, g_) do { _Pragma("unroll") for (int bj = 0; bj < 2; ++bj) _Pragma("unroll") for (int n = 0; n < 2; ++n) { \
            const int o = so + ((((g_) >> 2) * HALF + ((g_) & 3) * 16) * LDC + bj * HALF + n * 16) * 2; \
            const f32x4 v = src[bj][n] + acc[(g_) >> 2][bj][(g_) & 3][n] * ascale; \
            u32x2 w; w.x = cvt_pk_bf16(v[0], v[1]); w.y = cvt_pk_bf16(v[2], v[3]); __builtin_amdgcn_raw_buffer_store_b64(w, rx, vo, o, 0); } } while (0)
        EPI_LD(ra, 0);
        EPI_LD(rb2, 1); EPI_ST(ra, 0);
        EPI_LD(ra, 2); EPI_ST(rb2, 1);
        EPI_LD(rb2, 3); EPI_ST(ra, 2);
        EPI_LD(ra, 4); EPI_ST(rb2, 3);
        EPI_LD(rb2, 5); EPI_ST(ra, 4);
        EPI_LD(ra, 6); EPI_ST(rb2, 5);
        EPI_LD(rb2, 7); EPI_ST(ra, 6);
        EPI_ST(rb2, 7);
#undef EPI_LD
#undef EPI_ST
    }
};
struct EpiQKV {
    static constexpr bool PERM = true, AFTER_DRAIN = false;
    bf16_t* Q; const float* rs; float qscale;
    __device__ __forceinline__ void operator()(const f32x4 (&acc)[2][2][4][2], const Unit& u, int wr, int wc, int fr, int fq) const {
        const rsrc_t rq = mkrsrc(Q, 3u * 16384u * 4096u * 2u), rr = mkrsrc(rs, 16384u * 4u);
        const int colt = u.pn * BM, which = colt >> 12, cw = colt & 4095, gt = cw >> 7;
        const int b = (u.pm * BM) >> 11, st = (u.pm * BM) & 2047;
        const float sc = which == 0 ? qscale : 1.f;
        const int so = (int)(((unsigned)which << 26) + (((unsigned)(b * 32 + gt) * 2048u + (unsigned)st) << 7)) * 2;
        const int vo = (((wr * 64 + fr) << 7) + wc * 32 + 8 * fq) * 2, vr = (wr * 64 + fr) * 4, sr = u.pm * BM * 4;
#pragma unroll
        for (int ai = 0; ai < 2; ++ai)
#pragma unroll
            for (int m = 0; m < 4; ++m) { const float f = sc * __builtin_bit_cast(float, __builtin_amdgcn_raw_buffer_load_b32(rr, vr, sr + (ai * HALF + m * 16) * 4, 0));
#pragma unroll
                for (int bj = 0; bj < 2; ++bj) {
                    const f32x4 v0 = acc[ai][bj][m][0] * f, v1 = acc[ai][bj][m][1] * f;
                    u32x4 w; w.x = cvt_pk_bf16(v0[0], v0[1]); w.y = cvt_pk_bf16(v0[2], v0[3]); w.z = cvt_pk_bf16(v1[0], v1[1]); w.w = cvt_pk_bf16(v1[2], v1[3]);
                    __builtin_amdgcn_raw_buffer_store_b128(w, rq, vo, so + ((bj * 2048 + ai * HALF + m * 16) << 7) * 2, 0); } }
    }
};

struct EpiQKV4 {
    static constexpr bool PERM = false, AFTER_DRAIN = false;
    bf16_t* Q; const float* rs; float qscale, wscale;
    __device__ __forceinline__ void operator()(const f32x4 (&acc)[2][2][4][2], const Unit& u, int wr, int wc, int fr, int fq) const {
        EPI_FRESH_LANE();
        const rsrc_t rq = mkrsrc(Q, 3u * 16384u * 4096u * 2u), rr = mkrsrc(rs, 16384u * 4u);
        const int colt = u.pn * BM, which = colt >> 12, cw = colt & 4095, gt = cw >> 7;
        const int b = (u.pm * BM) >> 11, st = (u.pm * BM) & 2047;
        const float sc = (which == 0 ? qscale : 1.f) * wscale;
        const int so = (int)(((unsigned)which << 26) + (((unsigned)(b * 32 + gt) * 2048u + (unsigned)st) << 7)) * 2;
        const int vo = (((wr * 64 + fr) << 7) + wc * 32 + 4 * fq) * 2, vr = (wr * 64 + fr) * 4, sr = u.pm * BM * 4;
        unsigned rsv[2][4];
#pragma unroll
        for (int ai = 0; ai < 2; ++ai)
#pragma unroll
            for (int m = 0; m < 4; ++m) rsv[ai][m] = __builtin_amdgcn_raw_buffer_load_b32(rr, vr, sr + (ai * HALF + m * 16) * 4, 0);
#pragma unroll
        for (int ai = 0; ai < 2; ++ai)
#pragma unroll
            for (int m = 0; m < 4; ++m) { const float f = sc * __builtin_bit_cast(float, rsv[ai][m]);
#pragma unroll
                for (int bj = 0; bj < 2; ++bj)
#pragma unroll
                    for (int n = 0; n < 2; ++n) { const f32x4 v0 = acc[ai][bj][m][n] * f; u32x2 w; w.x = cvt_pk_bf16(v0[0], v0[1]); w.y = cvt_pk_bf16(v0[2], v0[3]);
                        __builtin_amdgcn_raw_buffer_store_b64(w, rq, vo, so + (((bj * 2048 + ai * HALF + m * 16) << 7) + n * 16) * 2, 0); } }
    }
};

typedef int i32x8 __attribute__((ext_vector_type(8)));
template <bool F8> struct FragT { typedef bf16x8 type; };
template <> struct FragT<true> { typedef i32x8 type; };
__device__ __forceinline__ f32x4 mma_bf16(bf16x8 a, bf16x8 b, f32x4 c) { return __builtin_amdgcn_mfma_f32_16x16x32_bf16(a, b, c, 0, 0, 0); }
__device__ __forceinline__ f32x4 mma_bf16(i32x8, i32x8, f32x4 c) { return c; }
template <class Epi, class Sched, bool ALIGN_EPI = false, bool SP2 = false, bool F8 = false>
__device__ __forceinline__ void gemm_phase(PG8_LAS unsigned char* lds, const Gemm g, const Sched& S, const Epi& E, int tid_in) {
    int tid_ = tid_in;
    const int tid = tid_, wid = __builtin_amdgcn_readfirstlane(tid >> 6), lane = tid & 63, wr = wid >> 2, wc = wid & 3, fr = lane & 15, fq = lane >> 4;
    constexpr int EB = F8 ? 1 : 2;
    constexpr int K = 4096; constexpr int nt = (K * EB) / (BK * 2);
    unsigned voffA[2], voffB[2];
#pragma unroll
    for (int i = 0; i < 2; ++i) { int R, C; stage_rc(tid * 16 + i * 8192, R, C); const int Rb = Epi::PERM ? ((R & ~31) + perm32(R & 31)) : R;
        voffA[i] = (unsigned)(R * K * EB + C * 2); voffB[i] = (unsigned)(Rb * K * EB + C * 2); }
    const size_t kstep = (size_t)(BK * 2);
    const size_t hstep = (size_t)HALF * K * EB;
    const size_t tstep = 2 * hstep;
    const unsigned ldsw = (unsigned)wid * 1024u;
    const int aoff = F8 ? lds_byte(wr * 64 + fr, fq * 16) + (fq & 1) * 16 : lds_byte(wr * 64 + fr, fq * 8), boff = F8 ? lds_byte(wc * 32 + fr, fq * 16) + (fq & 1) * 16 : lds_byte(wc * 32 + fr, fq * 8);
    const int aoff1 = aoff + (F8 ? 16 - 32 * (fq & 1) : 0);
    const int f8o0_unused = 0; (void)f8o0_unused;
#define PG8_SA(b, h) (((b) * 2 + (h)) * HTB)
#define PG8_SB(b, h) ((4 + (b) * 2 + (h)) * HTB)
#define PG8_STAGE_X(bufoff, gbase, voff, rs_, base_) do { const int so_ = (int)((const char*)(gbase) - (const char*)(base_)); _Pragma("unroll") for (int _i = 0; _i < 2; ++_i) \
        __builtin_amdgcn_raw_ptr_buffer_load_lds(rs_, (PG8_LAS void*)(lds + (bufoff) + ldsw + _i * 8192), 16, (int)(voff)[_i], so_, 0, 0); } while (0)
#define PG8_LDA(dst, b, h) do { if constexpr (F8) { _Pragma("unroll") for (int m = 0; m < 4; ++m) { const u32x4 lo_ = *(const PG8_LAS u32x4*)(lds + PG8_SA(b, h) + aoff + m * 2048), hi_ = *(const PG8_LAS u32x4*)(lds + PG8_SA(b, h) + aoff1 + m * 2048); \
            dst[m][0] = (i32x8){(int)lo_[0], (int)lo_[1], (int)lo_[2], (int)lo_[3], (int)hi_[0], (int)hi_[1], (int)hi_[2], (int)hi_[3]}; } } \
        else { _Pragma("unroll") for (int m = 0; m < 4; ++m) _Pragma("unroll") for (int k = 0; k < 2; ++k) dst[m][k] = *(const PG8_LAS frag_t*)(lds + PG8_SA(b, h) + aoff + m * 2048 + k * 1024); } } while (0)
#define PG8_LDB(dst, b, h) do { if constexpr (F8) { _Pragma("unroll") for (int n = 0; n < 2; ++n) { const u32x4 lo_ = *(const PG8_LAS u32x4*)(lds + PG8_SB(b, h) + boff + n * 2048), hi_ = *(const PG8_LAS u32x4*)(lds + PG8_SB(b, h) + boff + (aoff1 - aoff) + n * 2048); \
            dst[n][0] = (i32x8){(int)lo_[0], (int)lo_[1], (int)lo_[2], (int)lo_[3], (int)hi_[0], (int)hi_[1], (int)hi_[2], (int)hi_[3]}; } } \
        else { _Pragma("unroll") for (int n = 0; n < 2; ++n) _Pragma("unroll") for (int k = 0; k < 2; ++k) dst[n][k] = *(const PG8_LAS frag_t*)(lds + PG8_SB(b, h) + boff + n * 2048 + k * 1024); } } while (0)
#define PG8_MMA(ai, bj, At, Bt) do { __builtin_amdgcn_s_setprio(1); _Pragma("unroll") for (int m = 0; m < 4; ++m) _Pragma("unroll") for (int n = 0; n < 2; ++n) { \
        if constexpr (F8) acc[ai][bj][m][n] = __builtin_amdgcn_mfma_scale_f32_16x16x128_f8f6f4(Bt[n][0], At[m][0], acc[ai][bj][m][n], 0, 0, 0, 0x7f7f7f7f, 0, 0x7f7f7f7f); \
        else { _Pragma("unroll") for (int k = 0; k < 2; ++k) acc[ai][bj][m][n] = mma_bf16(Bt[n][k], At[m][k], acc[ai][bj][m][n]); } } __builtin_amdgcn_s_setprio(0); } while (0)
#define PG8_WAIT_V(n) asm volatile("s_waitcnt vmcnt(" #n ")" ::: "memory")
#define PG8_WAIT_L(n) asm volatile("s_waitcnt lgkmcnt(" #n ")" ::: "memory")
#define PG8_BAR __builtin_amdgcn_s_barrier()
#define PG8_SCHED __builtin_amdgcn_sched_barrier(0)
    const __amdgpu_buffer_rsrc_t rsA = __builtin_amdgcn_make_buffer_rsrc((void*)g.A, (short)0, (int)((size_t)g.M * K * EB), 0x00020000), rsB = __builtin_amdgcn_make_buffer_rsrc((void*)g.Bt, (short)0, (int)((size_t)g.N * K * EB), 0x00020000);
    Unit cur, nxt; int ui = 0;
    if (!S.next(0, cur)) return;
    f32x4 acc[2][2][4][2];
#pragma unroll
    for (int a = 0; a < 2; ++a)
#pragma unroll
        for (int b = 0; b < 2; ++b)
#pragma unroll
            for (int m = 0; m < 4; ++m)
#pragma unroll
                for (int n = 0; n < 2; ++n) acc[a][b][m][n] = (f32x4){0.f, 0.f, 0.f, 0.f};
    typedef typename FragT<F8>::type frag_t;
    frag_t At[4][F8 ? 1 : 2], B0[2][F8 ? 1 : 2], B1[2][F8 ? 1 : 2];
    const char* cA = (const char*)g.A + (size_t)cur.pm * tstep; const char* cB = (const char*)g.Bt + (size_t)cur.pn * tstep;
    S.a_ready(cur);
    if constexpr (SP2) {
        PG8_STAGE_X(PG8_SB(0, 0), cB, voffB, rsB, g.Bt); PG8_STAGE_X(PG8_SB(0, 1), cB + hstep, voffB, rsB, g.Bt); PG8_STAGE_X(PG8_SA(0, 0), cA, voffA, rsA, g.A); PG8_STAGE_X(PG8_SA(0, 1), cA + hstep, voffA, rsA, g.A);
        if (wr == 1) PG8_BAR;
        PG8_WAIT_V(2); PG8_BAR;
        PG8_STAGE_X(PG8_SB(1, 0), cB + kstep, voffB, rsB, g.Bt); PG8_STAGE_X(PG8_SA(1, 0), cA + kstep, voffA, rsA, g.A); PG8_STAGE_X(PG8_SB(1, 1), cB + hstep + kstep, voffB, rsB, g.Bt);
        PG8_WAIT_V(6); PG8_BAR;
    } else {
        PG8_STAGE_X(PG8_SB(0, 0), cB, voffB, rsB, g.Bt); PG8_STAGE_X(PG8_SA(0, 0), cA, voffA, rsA, g.A); PG8_STAGE_X(PG8_SB(0, 1), cB + hstep, voffB, rsB, g.Bt); PG8_STAGE_X(PG8_SA(0, 1), cA + hstep, voffA, rsA, g.A);
        if (wr == 1) PG8_BAR;
        PG8_WAIT_V(4); PG8_BAR;
        PG8_STAGE_X(PG8_SB(1, 0), cB + kstep, voffB, rsB, g.Bt); PG8_STAGE_X(PG8_SA(1, 0), cA + kstep, voffA, rsA, g.A); PG8_STAGE_X(PG8_SB(1, 1), cB + hstep + kstep, voffB, rsB, g.Bt);
        PG8_WAIT_V(6); PG8_BAR;
    }
    for (;;) {
        const bool has_next = S.next(ui + 1, nxt);
        const char* nA = has_next ? (const char*)g.A + (size_t)nxt.pm * tstep : cA; const char* nB = has_next ? (const char*)g.Bt + (size_t)nxt.pn * tstep : cB;
        for (int t = 0; t < nt; t += 2) {
            const bool last = (t == nt - 2);
            const char* a1 = cA + (size_t)(t + 1) * kstep;
            const char* a2 = last ? nA : cA + (size_t)(t + 2) * kstep; const char* b2 = last ? nB : cB + (size_t)(t + 2) * kstep;
            const char* a3 = a2 + kstep; const char* b3 = b2 + kstep;
            if (last && has_next) S.a_ready(nxt);
            if constexpr (SP2) {
            PG8_LDB(B0, 0, 0); PG8_LDB(B1, 0, 1); PG8_SCHED; PG8_LDA(At, 0, 0); PG8_STAGE_X(PG8_SA(1, 1), a1 + hstep, voffA, rsA, g.A);
            PG8_WAIT_V(8); PG8_WAIT_L(0); PG8_BAR; PG8_MMA(0, 0, At, B0); PG8_MMA(0, 1, At, B1); PG8_BAR; PG8_SCHED;
            PG8_LDA(At, 0, 1); PG8_STAGE_X(PG8_SB(0, 0), b2, voffB, rsB, g.Bt); PG8_STAGE_X(PG8_SB(0, 1), b2 + hstep, voffB, rsB, g.Bt); PG8_STAGE_X(PG8_SA(0, 0), a2, voffA, rsA, g.A);
            PG8_WAIT_V(8); PG8_WAIT_L(0); PG8_BAR; PG8_MMA(1, 0, At, B0); PG8_MMA(1, 1, At, B1); PG8_BAR; PG8_SCHED;
            PG8_LDB(B0, 1, 0); PG8_LDB(B1, 1, 1); PG8_SCHED; PG8_LDA(At, 1, 0); PG8_STAGE_X(PG8_SA(0, 1), a2 + hstep, voffA, rsA, g.A);
            PG8_WAIT_V(8); PG8_WAIT_L(0); PG8_BAR; PG8_MMA(0, 0, At, B0); PG8_MMA(0, 1, At, B1); PG8_BAR; PG8_SCHED;
            PG8_LDA(At, 1, 1); PG8_STAGE_X(PG8_SB(1, 0), b3, voffB, rsB, g.Bt); PG8_STAGE_X(PG8_SB(1, 1), b3 + hstep, voffB, rsB, g.Bt); PG8_STAGE_X(PG8_SA(1, 0), a3, voffA, rsA, g.A);
            PG8_WAIT_V(8); PG8_WAIT_L(0); PG8_BAR; PG8_MMA(1, 0, At, B0); PG8_MMA(1, 1, At, B1); PG8_BAR; PG8_SCHED;
            } else {
            PG8_LDB(B0, 0, 0); PG8_SCHED; PG8_LDA(At, 0, 0); PG8_STAGE_X(PG8_SA(1, 1), a1 + hstep, voffA, rsA, g.A);
            PG8_WAIT_L(8); PG8_BAR; PG8_WAIT_L(0); PG8_MMA(0, 0, At, B0); PG8_BAR; PG8_SCHED;
            PG8_LDB(B1, 0, 1); PG8_STAGE_X(PG8_SB(0, 0), b2, voffB, rsB, g.Bt);
            PG8_BAR; PG8_WAIT_L(0); PG8_MMA(0, 1, At, B1); PG8_BAR;
            PG8_LDA(At, 0, 1); PG8_STAGE_X(PG8_SA(0, 0), a2, voffA, rsA, g.A);
            PG8_BAR; PG8_WAIT_L(0); PG8_MMA(1, 0, At, B0); PG8_BAR; PG8_SCHED;
            PG8_STAGE_X(PG8_SB(0, 1), b2 + hstep, voffB, rsB, g.Bt);
            PG8_WAIT_V(6); PG8_BAR; PG8_MMA(1, 1, At, B1); PG8_BAR;
            PG8_LDB(B0, 1, 0); PG8_SCHED; PG8_LDA(At, 1, 0); PG8_STAGE_X(PG8_SA(0, 1), a2 + hstep, voffA, rsA, g.A);
            PG8_WAIT_L(8); PG8_BAR; PG8_WAIT_L(0); PG8_MMA(0, 0, At, B0); PG8_BAR; PG8_SCHED;
            PG8_LDB(B1, 1, 1); PG8_STAGE_X(PG8_SB(1, 0), b3, voffB, rsB, g.Bt);
            PG8_BAR; PG8_WAIT_L(0); PG8_MMA(0, 1, At, B1); PG8_BAR;
            PG8_LDA(At, 1, 1); PG8_STAGE_X(PG8_SA(1, 0), a3, voffA, rsA, g.A);
            PG8_BAR; PG8_WAIT_L(0); PG8_MMA(1, 0, At, B0); PG8_BAR; PG8_SCHED;
            PG8_STAGE_X(PG8_SB(1, 1), b3 + hstep, voffB, rsB, g.Bt);
            PG8_WAIT_V(6); PG8_BAR; PG8_MMA(1, 1, At, B1); PG8_BAR;
            }
        }
        if constexpr (ALIGN_EPI) { if (wr == 0) PG8_BAR; }
        if constexpr (!Epi::AFTER_DRAIN) { E(acc, cur, wr, wc, fr, fq); S.done(cur); }
        if (!has_next) break;
#pragma unroll
        for (int a = 0; a < 2; ++a)
#pragma unroll
            for (int b = 0; b < 2; ++b)
#pragma unroll
                for (int m = 0; m < 4; ++m)
#pragma unroll
                    for (int n = 0; n < 2; ++n) acc[a][b][m][n] = (f32x4){0.f, 0.f, 0.f, 0.f};
        cur = nxt; cA = nA; cB = nB; ++ui;
        if constexpr (ALIGN_EPI) { if (wr == 1) PG8_BAR; }
    }
    PG8_WAIT_V(0);
    if constexpr (!ALIGN_EPI) { if (wr == 0) PG8_BAR; }
    PG8_BAR;
    if constexpr (Epi::AFTER_DRAIN) { E.fused(acc, cur, wr, wc, fr, fq, lds, wid, lane); S.done(cur); }
#undef PG8_SA
#undef PG8_SB
#undef PG8_STAGE_X
#undef PG8_LDA
#undef PG8_LDB
#undef PG8_MMA
#undef PG8_WAIT_V
#undef PG8_WAIT_L
#undef PG8_BAR
#undef PG8_SCHED
}
}
#define GAS __attribute__((address_space(1)))
#define LAS __attribute__((address_space(3)))
typedef unsigned short bf16_t;
typedef unsigned u32x4 __attribute__((ext_vector_type(4)));
typedef unsigned u32x2 __attribute__((ext_vector_type(2)));
typedef float f32x4 __attribute__((ext_vector_type(4)));
typedef float f32x2 __attribute__((ext_vector_type(2)));
typedef float f32x16 __attribute__((ext_vector_type(16)));
typedef short bf16x8 __attribute__((ext_vector_type(8)));
typedef short s16x4 __attribute__((ext_vector_type(4)));
typedef __bf16 bf16x2_t __attribute__((ext_vector_type(2)));
typedef unsigned u32x6 __attribute__((ext_vector_type(6)));
typedef int i32x8 __attribute__((ext_vector_type(8)));
typedef unsigned u32x16 __attribute__((ext_vector_type(16)));
typedef float f32x32 __attribute__((ext_vector_type(32)));
typedef _Float16 f16x32 __attribute__((ext_vector_type(32)));
typedef _Float16 f16x2 __attribute__((ext_vector_type(2)));

namespace mk {
constexpr int M = 16384, D = 4096, S = 2048, NB = 8, PW = 12298, NH = 32, NE = 16384;
constexpr int NWAVES = 8;
constexpr size_t MiB = 1u << 20;
constexpr size_t WS_CTL = 0, CTL_ZERO_BYTES = 1 * MiB;
constexpr size_t WS_RSTD = 2 * MiB, WS_LOGF = 3 * MiB, WS_WQK = 4 * MiB, WS_WOUT = 20 * MiB, WS_WIN = 52 * MiB, WS_U16 = 148 * MiB, WS_V16 = 276 * MiB,
                 WS_XB = 404 * MiB, WS_Q = 532 * MiB, WS_K = 660 * MiB, WS_V = 788 * MiB, WS_OB = 916 * MiB, WS_X2 = 1792 * MiB, WS_END = 2048 * MiB;
constexpr size_t WS_XB8N = WS_OB + 64 * MiB;
constexpr size_t WS_SC = WS_Q;
constexpr int CW_BAR = 4096;
constexpr int CW_QUEUE = 16384;
constexpr int RING_BYTES = 131072, LDSCTL_OFF = RING_BYTES, MISC_OFF = LDSCTL_OFF + 320, LDS_BYTES = 147456;

struct Args { const float* in[13]; float* out; unsigned char* ws; int ph_lo, ph_hi; };

__device__ __forceinline__ unsigned f2bf(float f) { unsigned u = __builtin_bit_cast(unsigned, f); return (u + 0x7fffu + ((u >> 16) & 1u)) >> 16; }
__device__ __forceinline__ unsigned pk2(float lo, float hi) { return f2bf(lo) | (f2bf(hi) << 16); }
__device__ __forceinline__ float bf_lo(unsigned w) { return __builtin_bit_cast(float, w << 16); }
__device__ __forceinline__ float bf_hi(unsigned w) { return __builtin_bit_cast(float, w & 0xffff0000u); }
__device__ __forceinline__ float lane_read(float v, int src_lane) { return __builtin_bit_cast(float, __builtin_amdgcn_ds_bpermute(src_lane << 2, __builtin_bit_cast(int, v))); }
__device__ __forceinline__ int lane_read(int v, int src_lane) { return __builtin_amdgcn_ds_bpermute(src_lane << 2, v); }
constexpr float US = 1024.0f, VS = 32.0f, US_INV = 1.0f / 1024.0f, VS_INV = 1.0f / 32.0f;
constexpr int ROW6 = 3072;
__device__ __forceinline__ unsigned q_e2m3(float x, float inv) {
    const float a = fminf(fabsf(x) * inv, 7.5f);
    const float c = a < 2.0f ? __builtin_rintf(a * 8.0f) : (a < 4.0f ? __builtin_rintf(a * 4.0f) + 8.0f : __builtin_rintf(a * 2.0f) + 16.0f);
    return (unsigned)(int)c | ((__builtin_bit_cast(unsigned, x) >> 26) & 32u);
}
__device__ __forceinline__ u32x6 pack_fp6(const f32x4 (&a0)[4], const f32x4 (&a1)[4], float inv) {
    unsigned o[6];
#pragma unroll
    for (int w = 0; w < 6; ++w) o[w] = 0u;
#pragma unroll
    for (int j = 0; j < 32; ++j) { const float x = (j < 16) ? a0[(j & 15) >> 2][j & 3] : a1[(j & 15) >> 2][j & 3]; const unsigned c = q_e2m3(x, inv);
        const int b = 6 * j, w = b >> 5, sh = b & 31; o[w] |= c << sh; if (sh > 26) o[w + 1] |= c >> (32 - sh); }
    return (u32x6){o[0], o[1], o[2], o[3], o[4], o[5]};
}
constexpr int ROW4 = 2048;
__device__ __forceinline__ unsigned q_e2m1(float x, float inv) {
    const float a = fminf(fabsf(x) * inv, 6.0f);
    const float c = a < 2.0f ? __builtin_rintf(a * 2.0f) : (a < 4.0f ? __builtin_rintf(a) + 2.0f : __builtin_rintf(a * 0.5f) + 4.0f);
    return (unsigned)(int)c | ((__builtin_bit_cast(unsigned, x) >> 28) & 8u);
}
__device__ __forceinline__ u32x4 pack_fp4(const f32x4 (&a0)[4], const f32x4 (&a1)[4], float inv) {
    unsigned o[4];
#pragma unroll
    for (int w = 0; w < 4; ++w) { o[w] = 0u;
#pragma unroll
        for (int t = 0; t < 8; ++t) { const int j = 8 * w + t; const float x = (j < 16) ? a0[(j & 15) >> 2][j & 3] : a1[(j & 15) >> 2][j & 3]; o[w] |= q_e2m1(x, inv) << (4 * t); } }
    return (u32x4){o[0], o[1], o[2], o[3]};
}
__device__ __forceinline__ float clamp8(float x) { return fminf(fmaxf(x, -224.0f), 224.0f); }
__device__ __forceinline__ float logsig(float z) { return fminf(z, 0.f) - 0.6931471805599453f * __builtin_amdgcn_logf(1.0f + __builtin_amdgcn_exp2f(-fabsf(z) * 1.4426950408889634f)); }
__device__ __forceinline__ float gelu_erf(float v) {
    const float av = fabsf(v), t = __builtin_amdgcn_rcpf(av * 0.2316418882f + 1.0f);
    float q = t * 0.5307027145f + (-0.7265760135f); q = q * t + 0.7107068705f; q = q * t + (-0.142248368f); q = q * t + 0.127414796f; q = q * t;
    const float e = __builtin_amdgcn_exp2f((v * v) * (-0.72134752044f));
    const float m = v * (q * e);
    return v < 0.f ? m : v - m;
}
#define LDS_WAIT() asm volatile("s_waitcnt lgkmcnt(0)" ::: "memory")
#define FRESH_LDS(l) do { unsigned v_ = (unsigned)(size_t)(l); asm volatile("" : "+s"(v_)); (l) = (LAS unsigned char*)(size_t)v_; } while (0)
#define FRESH_BID() int bid = blockIdx.x, G = gridDim.x; asm volatile("" : "+s"(bid), "+s"(G))
#define FRESH_TID() int tid; { int w_ = wave0, l_; { unsigned z_ = 0u; asm volatile("" : "+v"(z_)); l_ = (int)__builtin_amdgcn_mbcnt_hi(~0u, __builtin_amdgcn_mbcnt_lo(~0u, z_)); } asm volatile("" : "+s"(w_)); tid = w_ * 64 + l_; } const int lane = tid & 63, wave = __builtin_amdgcn_readfirstlane(tid >> 6); (void)lane; (void)wave

__device__ __forceinline__ unsigned wave_max_u32(unsigned v) {
    v = max(v, (unsigned)__builtin_amdgcn_update_dpp(0, (int)v, 0x111, 0xF, 0xF, true));
    v = max(v, (unsigned)__builtin_amdgcn_update_dpp(0, (int)v, 0x112, 0xF, 0xF, true));
    v = max(v, (unsigned)__builtin_amdgcn_update_dpp(0, (int)v, 0x114, 0xF, 0xF, true));
    v = max(v, (unsigned)__builtin_amdgcn_update_dpp(0, (int)v, 0x118, 0xF, 0xF, true));
    v = max(v, (unsigned)__builtin_amdgcn_update_dpp((int)v, (int)v, 0x142, 0xA, 0xF, false));
    v = max(v, (unsigned)__builtin_amdgcn_update_dpp((int)v, (int)v, 0x143, 0xC, 0xF, false));
    return (unsigned)__builtin_amdgcn_readlane((int)v, 63);
}
__device__ __forceinline__ float wave_sum_dpp(float x) {
    int v = __builtin_bit_cast(int, x);
#define DPP_ADD(ctrl, rm, bc, oldv) v = __builtin_bit_cast(int, __builtin_bit_cast(float, v) + __builtin_bit_cast(float, __builtin_amdgcn_update_dpp(oldv, v, ctrl, rm, 0xF, bc)))
    DPP_ADD(0x111, 0xF, true, 0); DPP_ADD(0x112, 0xF, true, 0); DPP_ADD(0x114, 0xF, true, 0); DPP_ADD(0x118, 0xF, true, 0);
#undef DPP_ADD
    const float r0 = __builtin_bit_cast(float, __builtin_amdgcn_readlane(v, 15)), r1 = __builtin_bit_cast(float, __builtin_amdgcn_readlane(v, 31)), r2 = __builtin_bit_cast(float, __builtin_amdgcn_readlane(v, 47)), r3 = __builtin_bit_cast(float, __builtin_amdgcn_readlane(v, 63));
    return (r0 + r1) + (r2 + r3);
}
__device__ __forceinline__ unsigned ordkey(float x) { const unsigned u = __builtin_bit_cast(unsigned, x); return (u & 0x80000000u) ? ~u : (u | 0x80000000u); }
__device__ __forceinline__ void transpose_item(const float* W, int K, int ldw, int ncols, const float* gain, bf16_t* WT, LAS float* scr, int item, int lane) {
    const int nblk = ncols / 32, kb = item / nblk, nb = item % nblk, k0 = 64 * kb, n0 = 32 * nb;
#pragma unroll 8
    for (int i = 0; i < 32; ++i) { const int kk = 2 * i + (lane >> 5); float v = W[(size_t)(k0 + kk) * ldw + n0 + (lane & 31)]; if (gain) v *= gain[k0 + kk]; scr[kk * 33 + (lane & 31)] = v; }
    LDS_WAIT(); asm volatile("" ::: "memory");
    const int c = lane & 7;
#pragma unroll
    for (int j = 0; j < 4; ++j) { const int n = (lane >> 3) + 8 * j; const LAS float* s = scr + (8 * c) * 33 + n;
        u32x4 o; o.x = pk2(s[0 * 33], s[1 * 33]); o.y = pk2(s[2 * 33], s[3 * 33]); o.z = pk2(s[4 * 33], s[5 * 33]); o.w = pk2(s[6 * 33], s[7 * 33]);
        *(u32x4*)(WT + (size_t)(n0 + n) * K + k0 + 8 * c) = o; }
    LDS_WAIT(); asm volatile("" ::: "memory");
}

typedef const __attribute__((address_space(4))) Args* KArgsT;
__device__ __forceinline__ unsigned pk4_fp8(float a, float b, float c, float d) { int p = __builtin_amdgcn_cvt_pk_fp8_f32(clamp8(a), clamp8(b), 0, false); p = __builtin_amdgcn_cvt_pk_fp8_f32(clamp8(c), clamp8(d), p, true); return (unsigned)p; }
__device__ __forceinline__ void transpose_item8(const float* W, int K, int ldw, int ncols, const float* gain, float scale, unsigned char* WT, LAS float* scr, int item, int lane) {
    const int nblk = ncols / 32, kb = item / nblk, nb = item % nblk, k0 = 64 * kb, n0 = 32 * nb;
    const int kr = lane >> 3, nq = (lane & 7) * 4;
    f32x4 v[8];
#pragma unroll
    for (int i = 0; i < 8; ++i) { const float* p = W + (size_t)(k0 + 8 * i + kr) * ldw + n0 + nq; v[i] = (f32x4){p[0], p[1], p[2], p[3]}; }
#pragma unroll
    for (int i = 0; i < 8; ++i) { const int kk = 8 * i + kr; const float g = (gain ? gain[k0 + kk] : 1.0f) * scale; LAS float* d = scr + kk * 33 + nq; d[0] = v[i][0] * g; d[1] = v[i][1] * g; d[2] = v[i][2] * g; d[3] = v[i][3] * g; }
    LDS_WAIT(); asm volatile("" ::: "memory");
    const int c = lane & 7;
#pragma unroll
    for (int j = 0; j < 4; ++j) { const int n = (lane >> 3) + 8 * j; const LAS float* s = scr + (8 * c) * 33 + n;
        u32x2 o; o.x = pk4_fp8(s[0 * 33], s[1 * 33], s[2 * 33], s[3 * 33]); o.y = pk4_fp8(s[4 * 33], s[5 * 33], s[6 * 33], s[7 * 33]);
        *(u32x2*)(WT + (size_t)(n0 + n) * K + k0 + 8 * c) = o; }
    LDS_WAIT(); asm volatile("" ::: "memory");
}
__device__ __forceinline__ void conv_phase(KArgsT ka, int l, LAS unsigned char* lds, int wave0) {
    FRESH_TID(); FRESH_LDS(lds); FRESH_BID();
    unsigned char* ws = ka->ws;
    const float* ln1 = ka->in[1] + (size_t)l * D; const float* w_in = ka->in[2] + (size_t)l * D * PW; const float* w_out = ka->in[5] + (size_t)l * D * D;
    const float* ln2 = ka->in[6] + (size_t)l * D; const float* wq = ka->in[7] + (size_t)l * D * 2048;
    const float* k1 = ka->in[8] + (size_t)l * 8 * 128 * 128; const float* k2 = ka->in[9] + (size_t)l * 8 * 128 * 128;
    const float* pu = ka->in[10] + (size_t)l * NE * D; const float* pv = ka->in[11] + (size_t)l * NE * D;
    bf16_t* WQK = (bf16_t*)(ws + WS_WQK); bf16_t* WOUT = (bf16_t*)(ws + WS_WOUT); bf16_t* WIN = (bf16_t*)(ws + WS_WIN); bf16_t* U16 = (bf16_t*)(ws + WS_U16); bf16_t* V16 = (bf16_t*)(ws + WS_V16);
    {
        LAS float* Ks = (LAS float*)lds;
        LAS float* Ws = (LAS float*)(lds + 128 * 132 * 4);
        for (int it = bid; it < 1024; it += G) {
            const int gi = it >> 6, c0 = (it & 63) * 64;
            const float* key = ((gi & 1) ? k2 : k1) + (size_t)(gi >> 1) * 128 * 128;
            for (int i = tid; i < 4096; i += 512) { const int r = i >> 5, c4 = (i & 31) * 4; *(LAS f32x4*)(Ks + r * 132 + c4) = *(const f32x4*)(key + r * 128 + c4); }
            for (int i = tid; i < 2048; i += 512) { const int r = i >> 5, c4 = (i & 31) * 4; *(LAS f32x4*)(Ws + r * 132 + c4) = *(const f32x4*)(wq + (size_t)(c0 + r) * 2048 + gi * 128 + c4); }
            __syncthreads();
            const int tc = tid & 15, tn = tid >> 4;
            float acc[4][4];
#pragma unroll
            for (int i = 0; i < 4; ++i)
#pragma unroll
                for (int j = 0; j < 4; ++j) acc[i][j] = 0.f;
#pragma unroll 2
            for (int d = 0; d < 128; d += 4) {
                f32x4 kv[4], wv[4];
#pragma unroll
                for (int i = 0; i < 4; ++i) kv[i] = *(const LAS f32x4*)(Ks + (4 * tn + i) * 132 + d);
#pragma unroll
                for (int j = 0; j < 4; ++j) wv[j] = *(const LAS f32x4*)(Ws + (tc + 16 * j) * 132 + d);
#pragma unroll
                for (int i = 0; i < 4; ++i)
#pragma unroll
                    for (int j = 0; j < 4; ++j) acc[i][j] += kv[i][0] * wv[j][0] + kv[i][1] * wv[j][1] + kv[i][2] * wv[j][2] + kv[i][3] * wv[j][3];
            }
#pragma unroll
            for (int j = 0; j < 4; ++j) { const int c = c0 + tc + 16 * j; const float gg = ln2[c];
#pragma unroll
                for (int i = 0; i < 4; ++i) WQK[(size_t)(gi * 128 + 4 * tn + i) * D + c] = (bf16_t)f2bf(acc[i][j] * gg); }
            __syncthreads();
        }
        __syncthreads();
    }
    const int gw = bid * NWAVES + wave, NGW = G * NWAVES;
    {
        unsigned char* U6 = (unsigned char*)U16; unsigned char* V4 = U6 + (size_t)NE * ROW6; float* SCU = (float*)(U6 + 2 * (size_t)NE * ROW6); float* SCV = SCU + NE;
        for (int r = gw; r < NE; r += NGW) {
            const float* us = pu + (size_t)r * D + 16 * lane; const float* vs = pv + (size_t)r * D + 16 * lane;
            f32x4 uu[4][4], vv[4][4];
#pragma unroll
            for (int i = 0; i < 4; ++i)
#pragma unroll
                for (int q = 0; q < 4; ++q) { uu[i][q] = *(const f32x4*)(us + 1024 * i + 4 * q); vv[i][q] = *(const f32x4*)(vs + 1024 * i + 4 * q); }
            float au = 0.f, av = 0.f;
#pragma unroll
            for (int i = 0; i < 4; ++i)
#pragma unroll
                for (int q = 0; q < 4; ++q) { uu[i][q] *= *(const f32x4*)(ln2 + 1024 * i + 16 * lane + 4 * q);
                    au += (uu[i][q][0] * uu[i][q][0] + uu[i][q][1] * uu[i][q][1]) + (uu[i][q][2] * uu[i][q][2] + uu[i][q][3] * uu[i][q][3]);
                    av += (vv[i][q][0] * vv[i][q][0] + vv[i][q][1] * vv[i][q][1]) + (vv[i][q][2] * vv[i][q][2] + vv[i][q][3] * vv[i][q][3]); }
            au = sqrtf(wave_sum_dpp(au) * (1.0f / D)); av = sqrtf(wave_sum_dpp(av) * (1.0f / D));
            const float iu = au > 0.f ? 2.0f / au : 0.f, iv = av > 0.f ? 2.0f / av : 0.f;
            if (lane == 0) { SCU[r] = au * 0.5f; SCV[r] = av * 0.5f; }
            { u32x4* o = (u32x4*)(U6 + (size_t)r * ROW4) + lane; o[0] = pack_fp4(uu[0], uu[1], iu); o[64] = pack_fp4(uu[2], uu[3], iu); }
            { u32x4* o = (u32x4*)(V4 + (size_t)r * ROW4) + lane; o[0] = pack_fp4(vv[0], vv[1], iv); o[64] = pack_fp4(vv[2], vv[3], iv); }
        }
    }
    {
        LAS float* scr = (LAS float*)(lds + wave * 16384);
        constexpr int I_O = (D / 64) * (D / 32), I_IN = (D / 64) * (12288 / 32);
        for (int it = gw; it < I_O + I_IN; it += NGW) {
            if (it < I_O) transpose_item8(w_out, D, D, D, nullptr, US, (unsigned char*)WOUT, scr, it, lane);
            else transpose_item8(w_in, D, PW, 12288, ln1, US, (unsigned char*)WIN, scr, it - I_O, lane);
        }
    }
}

template <bool WITH_F>
__device__ __forceinline__ void prep_phase(const float* X, bf16_t* XB, float* RSTD, const float* w_in, const float* ln1, const float* bf, float* LOGF, LAS unsigned char* lds, int wave0) {
    FRESH_TID(); FRESH_LDS(lds); FRESH_BID();
    LAS unsigned short* gfs = (LAS unsigned short*)lds;
    if (WITH_F) {
        __syncthreads();
        for (int c = tid; c < D; c += 512) { const float g = ln1[c]; const float* wr = w_in + (size_t)c * PW + 12288;
#pragma unroll
            for (int j = 0; j < 10; ++j) gfs[j * D + c] = (unsigned short)f2bf(wr[j] * g); }
        __syncthreads();
    }
    const int gw = bid * NWAVES + wave, NGW = G * NWAVES;
    for (int m = gw; m < M; m += NGW) {
        const f32x4* xr = (const f32x4*)(X + (size_t)m * D) + lane;
        f32x4 v[16]; float ss = 0.f;
#pragma unroll
        for (int i = 0; i < 16; ++i) { v[i] = xr[64 * i]; ss += (v[i][0] * v[i][0] + v[i][1] * v[i][1]) + (v[i][2] * v[i][2] + v[i][3] * v[i][3]); }
        ss = wave_sum_dpp(ss);
        const float rstd = rsqrtf(ss * (1.0f / D) + 1e-6f);
        if (WITH_F) {
            unsigned* o8 = (unsigned*)((unsigned char*)XB + (size_t)m * D) + lane;
#pragma unroll
            for (int i = 0; i < 16; ++i) o8[64 * i] = pk4_fp8(v[i][0], v[i][1], v[i][2], v[i][3]);
        } else {
        u32x2* o = (u32x2*)(XB + (size_t)m * D) + lane;
#pragma unroll
        for (int i = 0; i < 16; ++i) { u32x2 w; w.x = pk2(v[i][0], v[i][1]); w.y = pk2(v[i][2], v[i][3]); o[64 * i] = w; }
        }
        if (lane == 0) RSTD[m] = rstd;
        if (WITH_F) {
            float mine = 0.f;
#pragma unroll 1
            for (int j = 0; j < 10; ++j) { float s = 0.f;
#pragma unroll
                for (int i = 0; i < 16; ++i) { const u32x2 gp = *(const LAS u32x2*)(gfs + j * D + 256 * i + 4 * lane);
                    s += (v[i][0] * bf_lo(gp.x) + v[i][1] * bf_hi(gp.x)) + (v[i][2] * bf_lo(gp.y) + v[i][3] * bf_hi(gp.y)); }
                s = wave_sum_dpp(s); if (lane == j) mine = s; }
            if (lane < 10) { const int b = m >> 11, s = m & 2047; LOGF[(size_t)(b * 10 + lane) * S + s] = logsig(mine * rstd + bf[lane]); }
        }
    }
}


__device__ __forceinline__ void load16_bf16(const bf16_t* p, float (&d)[16]) {
    const u32x4 a = *(const u32x4*)p, b = *(const u32x4*)(p + 8);
#pragma unroll
    for (int q = 0; q < 4; ++q) { d[2 * q] = bf_lo(a[q]); d[2 * q + 1] = bf_hi(a[q]); d[8 + 2 * q] = bf_lo(b[q]); d[8 + 2 * q + 1] = bf_hi(b[q]); }
}
#define RFL(x) __builtin_amdgcn_readfirstlane(x)
template <bool FINAL>
__device__ __forceinline__ void peer_uv_phase(const float* SC, const unsigned char* U6, const unsigned char* V4, const bf16_t* X1, void* XOv, const float* fg,
                                              unsigned char* XB8n, float* RSTDn, float* LOGFn, const float* w_in_n, const float* ln1_n, const float* bf_n, LAS unsigned char* lds, int wave0) {
    FRESH_TID(); FRESH_LDS(lds); FRESH_BID();
    LAS int* s_eid = (LAS int*)(lds + 81920 + wave * 1024); LAS float* s_w = (LAS float*)(lds + 81920 + wave * 1024 + 512); LAS float* s_su = (LAS float*)(lds + 90112 + wave * 512);
    const float* SCU = (const float*)(U6 + 2 * (size_t)NE * ROW6); const float* SCV = SCU + NE;
    LAS unsigned short* gfs = (LAS unsigned short*)lds;
    if (!FINAL) {
        __syncthreads();
        for (int c = tid; c < D; c += 512) { const float g = ln1_n[c]; const float* wr = w_in_n + (size_t)c * PW + 12288;
#pragma unroll
            for (int j = 0; j < 10; ++j) gfs[j * D + c] = (unsigned short)f2bf(wr[j] * g); }
        __syncthreads();
    }
    const int gw = bid * NWAVES + wave, NGW = G * NWAVES;
    for (int tok = gw; tok < M; tok += NGW) {
        const bf16_t* x1 = X1 + (size_t)tok * D;
        i32x8 xq[2]; float rstd_tok;
        { const int sg_ = lane & 15, gp_ = lane >> 4; float t[2][2][16]; float ss_ = 0.f;
#pragma unroll
          for (int s2 = 0; s2 < 2; ++s2)
#pragma unroll
              for (int hf = 0; hf < 2; ++hf) { load16_bf16(x1 + 1024 * (2 * s2 + (gp_ & 1)) + 16 * (sg_ + 32 * hf + 16 * (gp_ >> 1)), t[s2][hf]);
#pragma unroll
                  for (int k = 0; k < 16; ++k) ss_ += t[s2][hf][k] * t[s2][hf][k]; }
          rstd_tok = rsqrtf(wave_sum_dpp(ss_) * (1.0f / D) + 1e-6f);
#pragma unroll
          for (int s2 = 0; s2 < 2; ++s2)
#pragma unroll
              for (int hf = 0; hf < 2; ++hf)
#pragma unroll
                  for (int q = 0; q < 4; ++q) xq[s2][4 * hf + q] = (int)pk4_fp8(t[s2][hf][4 * q] * rstd_tok, t[s2][hf][4 * q + 1] * rstd_tok, t[s2][hf][4 * q + 2] * rstd_tok, t[s2][hf][4 * q + 3] * rstd_tok); }
        const float* sc = SC + (size_t)tok * 2048;
        LAS float* selv = (LAS float*)(lds + 94208 + wave * 512); LAS int* seli = (LAS int*)(lds + 94208 + wave * 512 + 256);
#define BALLOT(c) __builtin_amdgcn_ballot_w64(c)
#define MBCNT(m) ((int)__builtin_amdgcn_mbcnt_hi((unsigned)((m) >> 32), __builtin_amdgcn_mbcnt_lo((unsigned)(m), 0u)))
        for (int h = 0; h < 4; ++h) {
            float x[2][2][2]; unsigned kk[2][2][2];
#pragma unroll
            for (int u = 0; u < 2; ++u)
#pragma unroll
                for (int f = 0; f < 2; ++f)
#pragma unroll
                    for (int r = 0; r < 2; ++r) { const float v = sc[(h + 4 * u) * 256 + f * 128 + r * 64 + lane]; x[u][f][r] = v; kk[u][f][r] = (ordkey(v) & ~127u) | (unsigned)(127 - 64 * r - lane); }
            unsigned T[2][2] = {{0u, 0u}, {0u, 0u}}; int dn = 0;
            for (unsigned bm = 0x80000000u; bm != 0u && dn != 15; bm >>= 1) {
#pragma unroll
                for (int u = 0; u < 2; ++u)
#pragma unroll
                    for (int f = 0; f < 2; ++f) { const unsigned cand = T[u][f] | bm;
                        const int c = __builtin_popcountll(BALLOT(kk[u][f][0] >= cand)) + __builtin_popcountll(BALLOT(kk[u][f][1] >= cand));
                        T[u][f] = c >= 16 ? cand : T[u][f]; dn |= (c == 16) ? (1 << (2 * u + f)) : 0; }
            }
#pragma unroll
            for (int u = 0; u < 2; ++u)
#pragma unroll
                for (int f = 0; f < 2; ++f) { const bool s0 = kk[u][f][0] >= T[u][f], s1 = kk[u][f][1] >= T[u][f]; const unsigned long long m0 = BALLOT(s0), m1 = BALLOT(s1);
                    const int p0 = MBCNT(m0), p1 = __builtin_popcountll(m0) + MBCNT(m1);
                    if (s0) { selv[(2 * u + f) * 16 + (p0 & 15)] = x[u][f][0]; seli[(2 * u + f) * 16 + (p0 & 15)] = lane; }
                    if (s1) { selv[(2 * u + f) * 16 + (p1 & 15)] = x[u][f][1]; seli[(2 * u + f) * 16 + (p1 & 15)] = 64 + lane; } }
            asm volatile("" ::: "memory");
            float s4[2][4]; unsigned k4[2][4];
#pragma unroll
            for (int u = 0; u < 2; ++u) { const float va = selv[(2 * u) * 16 + (lane >> 2)]; const f32x4 vb = *(const LAS f32x4*)(selv + (2 * u + 1) * 16 + (lane & 3) * 4);
#pragma unroll
                for (int q = 0; q < 4; ++q) { s4[u][q] = va + vb[q]; k4[u][q] = (ordkey(s4[u][q]) & ~255u) | (unsigned)(255 - 4 * lane - q); } }
            unsigned T2[2] = {0u, 0u}; int d2 = 0;
            for (unsigned bm = 0x80000000u; bm != 0u && d2 != 3; bm >>= 1) {
#pragma unroll
                for (int u = 0; u < 2; ++u) { const unsigned cand = T2[u] | bm;
                    const int c = (__builtin_popcountll(BALLOT(k4[u][0] >= cand)) + __builtin_popcountll(BALLOT(k4[u][1] >= cand))) + (__builtin_popcountll(BALLOT(k4[u][2] >= cand)) + __builtin_popcountll(BALLOT(k4[u][3] >= cand)));
                    T2[u] = c >= 16 ? cand : T2[u]; d2 |= (c == 16) ? (1 << u) : 0; }
            }
#pragma unroll
            for (int u = 0; u < 2; ++u) {
                const unsigned mk = wave_max_u32(max(max(k4[u][0], k4[u][1]), max(k4[u][2], k4[u][3]))) & ~255u;
                const float mx = __builtin_bit_cast(float, (mk & 0x80000000u) ? (mk & 0x7fffffffu) : ~mk);
                const float cs = 1.4426950408889634f * rstd_tok;
                float p[4], ps = 0.f;
#pragma unroll
                for (int q = 0; q < 4; ++q) { p[q] = (k4[u][q] >= T2[u]) ? __builtin_amdgcn_exp2f((s4[u][q] - mx) * cs) : 0.f; ps += p[q]; }
                const float tot = wave_sum_dpp(ps);
                const int i1 = seli[(2 * u) * 16 + (lane >> 2)]; const u32x4 i2 = *(const LAS u32x4*)(seli + (2 * u + 1) * 16 + (lane & 3) * 4);
                int base = (h + 4 * u) * 16;
#pragma unroll
                for (int q = 0; q < 4; ++q) { const bool sl = k4[u][q] >= T2[u]; const unsigned long long m = BALLOT(sl); const int slot = base + (MBCNT(m) & 15); base += __builtin_popcountll(m);
                    if (sl) { const int e = ((i1 & 127) << 7) | (int)(i2[q] & 127u); s_eid[slot] = e; s_w[slot] = p[q] / tot * SCV[e]; s_su[slot] = SCU[e]; } }
            }
            asm volatile("" ::: "memory");
        }
#undef BALLOT
#undef MBCNT
        LDS_WAIT(); asm volatile("" ::: "memory");
#define LOADROW6(dst, base, e) do { const u32x4* p_ = (const u32x4*)((base) + (size_t)(e) * ROW6) + lane; dst[0] = p_[0]; dst[1] = p_[64]; dst[2] = p_[128]; } while (0)
#define GRP6(row, g) ((g) == 0 ? (u32x6){row[0][0], row[0][1], row[0][2], row[0][3], row[1][0], row[1][1]} : (u32x6){row[1][2], row[1][3], row[2][0], row[2][1], row[2][2], row[2][3]})
        {
#define LOADROW4(dst, base, e) do { const u32x4* p_ = (const u32x4*)((base) + (size_t)(e) * ROW4) + lane; dst[0] = p_[0]; dst[1] = p_[64]; } while (0)
            const bool dg_ = ((lane & 15) >> 2) == (lane >> 4);
#define UDOT4(row, j) do { f32x4 ac_ = {0.f, 0.f, 0.f, 0.f}; \
            ac_ = __builtin_amdgcn_mfma_scale_f32_16x16x128_f8f6f4((i32x8){(int)row[0][0], (int)row[0][1], (int)row[0][2], (int)row[0][3], 0, 0, 0, 0}, xq[0], ac_, 4, 0, 0, 0x7f7f7f7f, 0, 0x7f7f7f7f); \
            ac_ = __builtin_amdgcn_mfma_scale_f32_16x16x128_f8f6f4((i32x8){(int)row[1][0], (int)row[1][1], (int)row[1][2], (int)row[1][3], 0, 0, 0, 0}, xq[1], ac_, 4, 0, 0, 0x7f7f7f7f, 0, 0x7f7f7f7f); \
            asm volatile("" : "+v"(ac_));     \
            const float pv_ = dg_ ? ((lane & 2) ? ((lane & 1) ? ac_[3] : ac_[2]) : ((lane & 1) ? ac_[1] : ac_[0])) : 0.f; \
            const float d_ = wave_sum_dpp(pv_) * s_su[j]; const float ge_ = gelu_erf(d_); if (lane == 0) s_w[j] *= ge_; } while (0)
            u32x4 r0[2], r1[2], r2[2], r3[2], r4[2], r5[2], r6[2], r7[2];
            { const int e_ = RFL(s_eid[0]); LOADROW4(r0, U6, e_); } { const int e_ = RFL(s_eid[1]); LOADROW4(r1, U6, e_); } { const int e_ = RFL(s_eid[2]); LOADROW4(r2, U6, e_); } { const int e_ = RFL(s_eid[3]); LOADROW4(r3, U6, e_); } { const int e_ = RFL(s_eid[4]); LOADROW4(r4, U6, e_); } { const int e_ = RFL(s_eid[5]); LOADROW4(r5, U6, e_); } { const int e_ = RFL(s_eid[6]); LOADROW4(r6, U6, e_); } { const int e_ = RFL(s_eid[7]); LOADROW4(r7, U6, e_); }
            for (int j = 0; j < 120; j += 8) {
                UDOT4(r0, j + 0); { const int e_ = RFL(s_eid[j + 8]); LOADROW4(r0, U6, e_); }
                UDOT4(r1, j + 1); { const int e_ = RFL(s_eid[j + 9]); LOADROW4(r1, U6, e_); }
                UDOT4(r2, j + 2); { const int e_ = RFL(s_eid[j + 10]); LOADROW4(r2, U6, e_); }
                UDOT4(r3, j + 3); { const int e_ = RFL(s_eid[j + 11]); LOADROW4(r3, U6, e_); }
                UDOT4(r4, j + 4); { const int e_ = RFL(s_eid[j + 12]); LOADROW4(r4, U6, e_); }
                UDOT4(r5, j + 5); { const int e_ = RFL(s_eid[j + 13]); LOADROW4(r5, U6, e_); }
                UDOT4(r6, j + 6); { const int e_ = RFL(s_eid[j + 14]); LOADROW4(r6, U6, e_); }
                UDOT4(r7, j + 7); { const int e_ = RFL(s_eid[j + 15]); LOADROW4(r7, U6, e_); }
            }
            UDOT4(r0, 120); UDOT4(r1, 121); UDOT4(r2, 122); UDOT4(r3, 123); UDOT4(r4, 124); UDOT4(r5, 125); UDOT4(r6, 126); UDOT4(r7, 127);
#undef UDOT4
#undef LOADROW4
        }
        LDS_WAIT(); asm volatile("" ::: "memory");
        {
            f32x2 acc2[2][16];
#define ACC(i, k) acc2[(i) >> 1][((i) & 1) * 8 + ((k) >> 1)][(k) & 1]
#pragma unroll
            for (int g = 0; g < 2; ++g)
#pragma unroll
                for (int k = 0; k < 16; ++k) acc2[g][k] = (f32x2){0.f, 0.f};
#define LOADROW4(dst, base, e) do { const u32x4* p_ = (const u32x4*)((base) + (size_t)(e) * ROW4) + lane; dst[0] = p_[0]; dst[1] = p_[64]; } while (0)
#define VACC4(row, j) do { const float w_ = s_w[j]; const f32x2 w2_ = {w_, w_}; _Pragma("unroll") for (int g_ = 0; g_ < 2; ++g_) { \
                u32x4 G_ = row[g_]; asm volatile("" : "+v"(G_)); \
                _Pragma("unroll") for (int k_ = 0; k_ < 4; ++k_) { const unsigned d_ = G_[k_]; \
                    acc2[g_][4 * k_] = __builtin_elementwise_fma(w2_, __builtin_amdgcn_cvt_scalef32_pk_f32_fp4(d_, 1.0f, 0), acc2[g_][4 * k_]); acc2[g_][4 * k_ + 1] = __builtin_elementwise_fma(w2_, __builtin_amdgcn_cvt_scalef32_pk_f32_fp4(d_, 1.0f, 1), acc2[g_][4 * k_ + 1]); \
                    acc2[g_][4 * k_ + 2] = __builtin_elementwise_fma(w2_, __builtin_amdgcn_cvt_scalef32_pk_f32_fp4(d_, 1.0f, 2), acc2[g_][4 * k_ + 2]); acc2[g_][4 * k_ + 3] = __builtin_elementwise_fma(w2_, __builtin_amdgcn_cvt_scalef32_pk_f32_fp4(d_, 1.0f, 3), acc2[g_][4 * k_ + 3]); } \
                asm volatile("" : "+v"(acc2[g_][0]), "+v"(acc2[g_][1]), "+v"(acc2[g_][2]), "+v"(acc2[g_][3]), "+v"(acc2[g_][4]), "+v"(acc2[g_][5]), "+v"(acc2[g_][6]), "+v"(acc2[g_][7]), \
                                  "+v"(acc2[g_][8]), "+v"(acc2[g_][9]), "+v"(acc2[g_][10]), "+v"(acc2[g_][11]), "+v"(acc2[g_][12]), "+v"(acc2[g_][13]), "+v"(acc2[g_][14]), "+v"(acc2[g_][15])); } } while (0)
            u32x4 r0[2], r1[2], r2[2], r3[2], r4[2], r5[2], r6[2], r7[2];
            { const int e_ = RFL(s_eid[0]); LOADROW4(r0, V4, e_); } { const int e_ = RFL(s_eid[1]); LOADROW4(r1, V4, e_); } { const int e_ = RFL(s_eid[2]); LOADROW4(r2, V4, e_); } { const int e_ = RFL(s_eid[3]); LOADROW4(r3, V4, e_); } { const int e_ = RFL(s_eid[4]); LOADROW4(r4, V4, e_); } { const int e_ = RFL(s_eid[5]); LOADROW4(r5, V4, e_); } { const int e_ = RFL(s_eid[6]); LOADROW4(r6, V4, e_); } { const int e_ = RFL(s_eid[7]); LOADROW4(r7, V4, e_); }
            for (int j = 0; j < 120; j += 8) {
                VACC4(r0, j + 0); { const int e_ = RFL(s_eid[j + 8]); LOADROW4(r0, V4, e_); }
                VACC4(r1, j + 1); { const int e_ = RFL(s_eid[j + 9]); LOADROW4(r1, V4, e_); }
                VACC4(r2, j + 2); { const int e_ = RFL(s_eid[j + 10]); LOADROW4(r2, V4, e_); }
                VACC4(r3, j + 3); { const int e_ = RFL(s_eid[j + 11]); LOADROW4(r3, V4, e_); }
                VACC4(r4, j + 4); { const int e_ = RFL(s_eid[j + 12]); LOADROW4(r4, V4, e_); }
                VACC4(r5, j + 5); { const int e_ = RFL(s_eid[j + 13]); LOADROW4(r5, V4, e_); }
                VACC4(r6, j + 6); { const int e_ = RFL(s_eid[j + 14]); LOADROW4(r6, V4, e_); }
                VACC4(r7, j + 7); { const int e_ = RFL(s_eid[j + 15]); LOADROW4(r7, V4, e_); }
            }
            VACC4(r0, 120); VACC4(r1, 121); VACC4(r2, 122); VACC4(r3, 123); VACC4(r4, 124); VACC4(r5, 125); VACC4(r6, 126); VACC4(r7, 127);
#undef VACC4
#undef LOADROW4
            float ss = 0.f;
#pragma unroll
            for (int i = 0; i < 4; ++i) { float t[16]; load16_bf16(x1 + 1024 * i + 16 * lane, t);
#pragma unroll
                for (int k = 0; k < 16; ++k) { ACC(i, k) += t[k]; ss += ACC(i, k) * ACC(i, k); } }
            ss = wave_sum_dpp(ss);
            const float rs = rsqrtf(ss * (1.0f / D) + 1e-6f);
            if (!FINAL) {
#pragma unroll
                for (int i = 0; i < 4; ++i) { u32x4 w8;
#pragma unroll
                    for (int q = 0; q < 4; ++q) w8[q] = pk4_fp8(ACC(i, 4 * q), ACC(i, 4 * q + 1), ACC(i, 4 * q + 2), ACC(i, 4 * q + 3));
                    *(u32x4*)(XB8n + (size_t)tok * D + 1024 * i + 16 * lane) = w8; }
                if (lane == 0) RSTDn[tok] = rs;
                float mine = 0.f;
#pragma unroll 1
                for (int j = 0; j < 10; ++j) { float s = 0.f;
#pragma unroll
                    for (int i = 0; i < 4; ++i) { const u32x4 g0 = *(const LAS u32x4*)(gfs + j * D + 1024 * i + 16 * lane), g1 = *(const LAS u32x4*)(gfs + j * D + 1024 * i + 16 * lane + 8);
#pragma unroll
                        for (int q = 0; q < 4; ++q) { s += ACC(i, 2 * q) * bf_lo(g0[q]) + ACC(i, 2 * q + 1) * bf_hi(g0[q]); s += ACC(i, 8 + 2 * q) * bf_lo(g1[q]) + ACC(i, 8 + 2 * q + 1) * bf_hi(g1[q]); } }
                    s = wave_sum_dpp(s); if (lane == j) mine = s; }
                if (lane < 10) { const int b_ = tok >> 11, s_ = tok & 2047; LOGFn[(size_t)(b_ * 10 + lane) * S + s_] = logsig(mine * rs + bf_n[lane]); }
            }
            if (FINAL) { float* xo = (float*)XOv + (size_t)tok * D;
#pragma unroll
                for (int i = 0; i < 4; ++i)
#pragma unroll
                    for (int q = 0; q < 4; ++q) { const int c = 1024 * i + 16 * lane + 4 * q; const f32x4 g_ = *(const f32x4*)(fg + c);
                        *(f32x4*)(xo + c) = (f32x4){ACC(i, 4 * q) * rs * g_[0], ACC(i, 4 * q + 1) * rs * g_[1], ACC(i, 4 * q + 2) * rs * g_[2], ACC(i, 4 * q + 3) * rs * g_[3]}; }
            } else { bf16_t* xo = (bf16_t*)XOv + (size_t)tok * D;
#pragma unroll
                for (int i = 0; i < 4; ++i) { u32x4 w0, w1;
#pragma unroll
                    for (int q = 0; q < 4; ++q) { w0[q] = pk2(ACC(i, 2 * q), ACC(i, 2 * q + 1)); w1[q] = pk2(ACC(i, 8 + 2 * q), ACC(i, 8 + 2 * q + 1)); }
                    *(u32x4*)(xo + 1024 * i + 16 * lane) = w0; *(u32x4*)(xo + 1024 * i + 16 * lane + 8) = w1; }
            }
        }
        LDS_WAIT(); asm volatile("" ::: "memory");
    }
#undef ACC
#undef LOADROW6
#undef GRP6
}
}
namespace at {
using namespace mk;
constexpr int QB = 256, KVB = 64, HD = 128;
constexpr int SHM_V = KVB * HD * 2, SHM_K = KVB * HD * 2;
constexpr int OFF_V = 0, OFF_K = 2 * SHM_V, OFF_WS = OFF_K + 2 * SHM_K, OFF_CUM = OFF_WS + 8 * 256, OFF_RT = OFF_CUM + 2048 * 4, OFF_MISC = OFF_RT + 640 * 4;
constexpr float LOG2E = 1.4426950408889634f;
constexpr float THR2 = 10.0f;
constexpr float SB_DONE = -100.0f;

#define AT_KSWZ(row, colB) ((row) * 256 + ((colB) ^ (((row) & 7) << 4)))
__device__ __forceinline__ int v_st(int k, int c) { const int kk = (k & ~0xC) | ((k & 4) << 1) | ((k & 8) >> 1); return ((kk >> 3) * 4 + (c >> 5)) * 512 + ((kk & 7) * 32 + (c & 31)) * 2; }
__device__ __forceinline__ int v_rd_base(int lane) { return ((lane & 3) << 3) | (((lane >> 2) & 3) << 6) | (((lane >> 4) & 1) << 5) | (((lane >> 5) & 1) << 8); }
constexpr int v_rd_off(int d0, int ks, int half) { return d0 * 512 + ks * 4096 + half * 2048; }
__device__ __forceinline__ int crow(int r, int hi) { return (r & 3) + 8 * (r >> 2) + 4 * hi; }
__device__ __forceinline__ unsigned cvtpk(float lo, float hi) { unsigned r; asm volatile("v_cvt_pk_bf16_f32 %0, %1, %2" : "=v"(r) : "v"(lo), "v"(hi)); return r; }
__device__ __forceinline__ float partner(float v, int hi) { auto rr = __builtin_amdgcn_permlane32_swap(__builtin_bit_cast(unsigned, v), __builtin_bit_cast(unsigned, v), false, false); return __builtin_bit_cast(float, hi ? rr[0] : rr[1]); }

__device__ __forceinline__ float xchg_max(float v, int hi) { return fmaxf(v, partner(v, hi)); }
__device__ __forceinline__ float xchg_sum(float v, int hi) { return v + partner(v, hi); }

__device__ __forceinline__ void pack_p(const f32x16& p0, const f32x16& p1, bf16x8& pa0, bf16x8& pa1, bf16x8& pa2, bf16x8& pa3) {
#define AT_PK4(P, B_, OUT) do { unsigned a0 = cvtpk(P[B_ + 0], P[B_ + 1]), a1 = cvtpk(P[B_ + 2], P[B_ + 3]); unsigned b0 = cvtpk(P[B_ + 4], P[B_ + 5]), b1 = cvtpk(P[B_ + 6], P[B_ + 7]); \
        auto r0 = __builtin_amdgcn_permlane32_swap(a0, b0, false, false); auto r1 = __builtin_amdgcn_permlane32_swap(a1, b1, false, false); \
        u32x4 w = {r0[0], r1[0], r0[1], r1[1]}; OUT = __builtin_bit_cast(bf16x8, w); } while (0)
    AT_PK4(p0, 0, pa0); AT_PK4(p0, 8, pa1); AT_PK4(p1, 0, pa2); AT_PK4(p1, 8, pa3);
#undef AT_PK4
}
template <int KBUF>
__device__ __forceinline__ void qkt(f32x16& p0, f32x16& p1, LAS unsigned char* K_lds, int r32, int hi, const bf16x8 (&qr)[8]) {
    p0 = f32x16{}; p1 = f32x16{};
    LAS unsigned char* kb[4];
#pragma unroll
    for (int dd = 0; dd < 4; ++dd) kb[dd] = K_lds + KBUF * SHM_K + AT_KSWZ(r32, (dd * 16 + hi * 8) * 2);
#pragma unroll
    for (int d0 = 0; d0 < 8; ++d0) { LAS unsigned char* a = kb[d0 & 3] + (d0 >> 2) * 128;
        const bf16x8 b0 = *(const LAS bf16x8*)a; const bf16x8 b1 = *(const LAS bf16x8*)(a + 32 * 256);
        p0 = __builtin_amdgcn_mfma_f32_32x32x16_bf16(b0, qr[d0], p0, 0, 0, 0);
        p1 = __builtin_amdgcn_mfma_f32_32x32x16_bf16(b1, qr[d0], p1, 0, 0, 0); }
}
template <int VBUF>
__device__ __forceinline__ void pv_tile(f32x16 (&o)[4], int vb0, bf16x8 pa0, bf16x8 pa1, bf16x8 pa2, bf16x8 pa3) {
#define AT_TRRD(dst, off) asm volatile("ds_read_b64_tr_b16 %0, %1 offset:%2" : "=&v"(dst) : "v"(vb0), "i"(off) : "memory")
#define AT_PV_D0(d0) do { s16x4 l0, l1, l2, l3, h0, h1, h2, h3; constexpr int b_ = VBUF * SHM_V + v_rd_off(d0, 0, 0); \
        AT_TRRD(l0, b_); AT_TRRD(h0, b_ + 2048); AT_TRRD(l1, b_ + 4096); AT_TRRD(h1, b_ + 6144); AT_TRRD(l2, b_ + 8192); AT_TRRD(h2, b_ + 10240); AT_TRRD(l3, b_ + 12288); AT_TRRD(h3, b_ + 14336); \
        asm volatile("s_waitcnt lgkmcnt(0)" ::: "memory"); __builtin_amdgcn_sched_barrier(0); \
        o[d0] = __builtin_amdgcn_mfma_f32_32x32x16_bf16(pa0, (bf16x8){l0[0], l0[1], l0[2], l0[3], h0[0], h0[1], h0[2], h0[3]}, o[d0], 0, 0, 0); \
        o[d0] = __builtin_amdgcn_mfma_f32_32x32x16_bf16(pa1, (bf16x8){l1[0], l1[1], l1[2], l1[3], h1[0], h1[1], h1[2], h1[3]}, o[d0], 0, 0, 0); \
        o[d0] = __builtin_amdgcn_mfma_f32_32x32x16_bf16(pa2, (bf16x8){l2[0], l2[1], l2[2], l2[3], h2[0], h2[1], h2[2], h2[3]}, o[d0], 0, 0, 0); \
        o[d0] = __builtin_amdgcn_mfma_f32_32x32x16_bf16(pa3, (bf16x8){l3[0], l3[1], l3[2], l3[3], h3[0], h3[1], h3[2], h3[3]}, o[d0], 0, 0, 0); } while (0)
    AT_PV_D0(0); AT_PV_D0(1); AT_PV_D0(2); AT_PV_D0(3);
#undef AT_PV_D0
#undef AT_TRRD
}

template <int VAR>
__device__ __forceinline__ void attn_item(const bf16_t* Qh, const bf16_t* Kh, const bf16_t* Vh, bf16_t* OB, const float* relb, const float* LOGF, int b, int h, int qb, LAS unsigned char* lds, int tid) {
    const int wid = __builtin_amdgcn_readfirstlane(tid >> 6), lane = tid & 63, r32 = lane & 31, hi = lane >> 5;
    const int g = VAR == 0 ? h : (VAR == 1 ? 12 + h : 22 + h);
    const size_t hb = (size_t)(b * NH + g) * S * HD;
    const bf16_t* Kp = Kh + hb; const bf16_t* Vp = Vh + hb;
    LAS unsigned char* V_lds = lds + OFF_V; LAS unsigned char* K_lds = lds + OFF_K;
    LAS float* wsf = (LAS float*)(lds + OFF_WS) + wid * 64; LAS float* li_l = wsf; LAS float* al_l = wsf + 32;
    LAS float* cumL = (LAS float*)(lds + OFF_CUM); LAS float* Rt = (LAS float*)(lds + OFF_RT); volatile LAS unsigned* flags = (volatile LAS unsigned*)(lds + OFF_MISC);
    const int P0 = qb * QB, qlo = P0 + wid * 32, qpos = qlo + r32;
    int NT, jlo = 0;
    if (VAR == 0) { jlo = 4 * qb - 8; if (jlo < 0) jlo = 0; NT = 4 * qb + 4 - jlo; } else NT = 4 * qb + 4;
    const int cw = 4 * qb + (wid >> 1);
#define AT_KBASE(t) (VAR == 1 ? (4 * qb + 3 - (t)) * KVB : (jlo + (t)) * KVB)
#define AT_ACT(t) (VAR == 0 ? ((jlo + (t)) >= cw - 8 && (jlo + (t)) <= cw) : (VAR == 1 ? (AT_KBASE(t) <= qlo + 30) : (AT_KBASE(t) <= qlo + 31)))
    if (VAR == 0) {
        const float* tab = relb + h * 257;
        for (int j = tid; j < 639; j += 512) { int rel = 575 - j; rel = rel < -128 ? -128 : (rel > 128 ? 128 : rel); Rt[j] = tab[rel + 128] * LOG2E; }
    }
    if (VAR == 2) {
        const float* lf = LOGF + (size_t)(b * 10 + h) * S; const int kend = P0 + QB;
        f32x4 v = (f32x4){0.f, 0.f, 0.f, 0.f};
        if (4 * tid < kend) v = *(const f32x4*)(lf + 4 * tid);
        v[1] += v[0]; v[2] += v[1]; v[3] += v[2];
        float tot = v[3];
#pragma unroll
        for (int o = 1; o < 64; o <<= 1) { const float t_ = lane_read(tot, lane >= o ? lane - o : lane); if (lane >= o) tot += t_; }
        if (lane == 63) li_l[0] = tot;
        __syncthreads();
        float base = tot - v[3];
        for (int w = 0; w < wid; ++w) base += ((LAS float*)(lds + OFF_WS))[w * 64];
        if (4 * tid < kend) *(LAS f32x4*)(cumL + 4 * tid) = (f32x4){(base + v[0]) * LOG2E, (base + v[1]) * LOG2E, (base + v[2]) * LOG2E, (base + v[3]) * LOG2E};
    }
    bf16x8 qr[8];
    { const bf16_t* qp = Qh + hb + (size_t)(qlo + r32) * HD + hi * 8;
#pragma unroll
      for (int d0 = 0; d0 < 8; ++d0) qr[d0] = *(const bf16x8*)(qp + d0 * 16); }
    const int sr = tid >> 4, sc = (tid & 15) * 8, vst0 = v_st(sr, sc), vst1 = v_st(32 + sr, sc), kws = AT_KSWZ(sr, sc * 2);
    const int vb0 = (int)(unsigned)(size_t)V_lds + v_rd_base(lane);
    bf16x8 st_k0, st_k1, st_v0, st_v1;
#define AT_SLOAD(k0) do { const bf16_t* kp_ = Kp + (size_t)((k0) + sr) * HD + sc; const bf16_t* vp_ = Vp + (size_t)((k0) + sr) * HD + sc; \
        st_k0 = *(const bf16x8*)kp_; st_k1 = *(const bf16x8*)(kp_ + 32 * HD); st_v0 = *(const bf16x8*)vp_; st_v1 = *(const bf16x8*)(vp_ + 32 * HD); } while (0)
#define AT_SWRITE(bf) do { *(LAS bf16x8*)(K_lds + (bf) * SHM_K + kws) = st_k0; *(LAS bf16x8*)(K_lds + (bf) * SHM_K + kws + 32 * 256) = st_k1; \
        *(LAS bf16x8*)(V_lds + (bf) * SHM_V + vst0) = st_v0; *(LAS bf16x8*)(V_lds + (bf) * SHM_V + vst1) = st_v1; } while (0)
    AT_SLOAD(AT_KBASE(0)); asm volatile("s_waitcnt vmcnt(0)" ::: "memory"); AT_SWRITE(0);
    __syncthreads();
    float m_reg = -1e30f, l_reg = 0.f, carry = 0.f;
    f32x16 o[4] = {};
#define AT_STEP(BUF, t) do { \
        const bool more_ = (t) + 1 < NT; \
        if (more_) AT_SLOAD(AT_KBASE((t) + 1)); \
        if (AT_ACT(t)) { \
            const int kb_ = AT_KBASE(t); f32x16 p0, p1; bf16x8 pa0, pa1, pa2, pa3; \
            qkt<BUF>(p0, p1, K_lds, r32, hi, qr); \
            tile_math(p0, p1, kb_, pa0, pa1, pa2, pa3); \
            pv_tile<BUF>(o, vb0, pa0, pa1, pa2, pa3); \
        } \
        if (more_) { asm volatile("s_waitcnt vmcnt(0)" ::: "memory"); AT_SWRITE((BUF) ^ 1); } \
        if (VAR == 1) { const bool done_ = __all(carry < SB_DONE); if (lane == 0) flags[((t) & 1) * 8 + wid] = done_ ? 1u : 0u; } \
        __syncthreads(); \
    } while (0)
    auto tile_math = [&](f32x16& p0, f32x16& p1, int kb, bf16x8& pa0, bf16x8& pa1, bf16x8& pa2, bf16x8& pa3) __attribute__((always_inline)) {
        const int dq = qpos - kb - 4 * hi;
        if (VAR == 1) {
            const bool need_mask = kb + 63 >= qlo;
            f32x16 n0, n1;
#pragma unroll
            for (int r = 0; r < 16; ++r) { const float z = p0[r]; const float lp = __builtin_amdgcn_logf(1.0f + __builtin_amdgcn_exp2f(-fabsf(z))); n0[r] = fminf(-z, 0.f) - lp;
                                           const float y = p1[r]; const float lq = __builtin_amdgcn_logf(1.0f + __builtin_amdgcn_exp2f(-fabsf(y))); n1[r] = fminf(-y, 0.f) - lq; }
            if (need_mask) {
#pragma unroll
                for (int r = 0; r < 16; ++r) { const int c = (r & 3) + 8 * (r >> 2);
                    if (dq - c <= 0) { n0[r] = 0.f; p0[r] = -__builtin_inff(); }
                    if (dq - c - 32 <= 0) { n1[r] = 0.f; p1[r] = -__builtin_inff(); } }
            }
            float A[8], Bp[8];
#pragma unroll
            for (int q = 0; q < 4; ++q) { A[q] = (n0[4 * q] + n0[4 * q + 1]) + (n0[4 * q + 2] + n0[4 * q + 3]); A[4 + q] = (n1[4 * q] + n1[4 * q + 1]) + (n1[4 * q + 2] + n1[4 * q + 3]); }
#pragma unroll
            for (int q = 0; q < 8; ++q) Bp[q] = partner(A[q], hi);
            float st = 0.f;
#pragma unroll
            for (int q = 7; q >= 0; --q) {
                const float after = carry + st + (hi == 0 ? Bp[q] : 0.f);
                if (q >= 4) { const int r0 = 4 * (q - 4);
                    float tl = after; p1[r0 + 3] = __builtin_amdgcn_exp2f(p1[r0 + 3] + n1[r0 + 3] + tl); tl += n1[r0 + 3]; p1[r0 + 2] = __builtin_amdgcn_exp2f(p1[r0 + 2] + n1[r0 + 2] + tl); tl += n1[r0 + 2];
                    p1[r0 + 1] = __builtin_amdgcn_exp2f(p1[r0 + 1] + n1[r0 + 1] + tl); tl += n1[r0 + 1]; p1[r0] = __builtin_amdgcn_exp2f(p1[r0] + n1[r0] + tl); }
                else { const int r0 = 4 * q;
                    float tl = after; p0[r0 + 3] = __builtin_amdgcn_exp2f(p0[r0 + 3] + n0[r0 + 3] + tl); tl += n0[r0 + 3]; p0[r0 + 2] = __builtin_amdgcn_exp2f(p0[r0 + 2] + n0[r0 + 2] + tl); tl += n0[r0 + 2];
                    p0[r0 + 1] = __builtin_amdgcn_exp2f(p0[r0 + 1] + n0[r0 + 1] + tl); tl += n0[r0 + 1]; p0[r0] = __builtin_amdgcn_exp2f(p0[r0] + n0[r0] + tl); }
                st += A[q] + Bp[q];
            }
            carry += st;
            pack_p(p0, p1, pa0, pa1, pa2, pa3);
        } else {
            if (VAR == 0) {
                const LAS float* rp = Rt + (575 - (qpos - kb) + 4 * hi);
#pragma unroll
                for (int r = 0; r < 16; ++r) { const int c = (r & 3) + 8 * (r >> 2); p0[r] += rp[c]; p1[r] += rp[c + 32]; }
            } else {
                const LAS float* cp = cumL + kb + 4 * hi;
#pragma unroll
                for (int q = 0; q < 4; ++q) { const f32x4 c0 = *(const LAS f32x4*)(cp + 8 * q), c1 = *(const LAS f32x4*)(cp + 32 + 8 * q);
                    p0[4 * q] -= c0[0]; p0[4 * q + 1] -= c0[1]; p0[4 * q + 2] -= c0[2]; p0[4 * q + 3] -= c0[3];
                    p1[4 * q] -= c1[0]; p1[4 * q + 1] -= c1[1]; p1[4 * q + 2] -= c1[2]; p1[4 * q + 3] -= c1[3]; }
                if (kb + 63 > qlo) {
#pragma unroll
                    for (int r = 0; r < 16; ++r) { const int c = (r & 3) + 8 * (r >> 2);
                        if (dq - c < 0) p0[r] = -__builtin_inff();
                        if (dq - c - 32 < 0) p1[r] = -__builtin_inff(); }
                }
            }
            float pmax = p0[0];
#pragma unroll
            for (int r = 1; r < 16; ++r) pmax = fmaxf(pmax, p0[r]);
#pragma unroll
            for (int r = 0; r < 16; ++r) pmax = fmaxf(pmax, p1[r]);
            pmax = xchg_max(pmax, hi);
            float mn, alpha;
            if (__all(pmax - m_reg <= THR2)) { mn = m_reg; alpha = 1.f; }
            else { mn = fmaxf(m_reg, pmax); alpha = __builtin_amdgcn_exp2f(m_reg - mn); m_reg = mn; }
            float ps = 0.f;
#pragma unroll
            for (int r = 0; r < 16; ++r) { p0[r] = __builtin_amdgcn_exp2f(p0[r] - mn); p1[r] = __builtin_amdgcn_exp2f(p1[r] - mn); ps += p0[r] + p1[r]; }
            ps = xchg_sum(ps, hi);
            l_reg = l_reg * alpha + ps;
            if (__any(alpha < 1.f)) {
                if (hi == 0) al_l[r32] = alpha;
                asm volatile("s_waitcnt lgkmcnt(0)" ::: "memory");
                float av[16];
#pragma unroll
                for (int r = 0; r < 16; ++r) av[r] = al_l[crow(r, hi)];
#pragma unroll
                for (int d = 0; d < 4; ++d)
#pragma unroll
                    for (int r = 0; r < 16; ++r) o[d][r] *= av[r];
            }
            pack_p(p0, p1, pa0, pa1, pa2, pa3);
        }
    };
    for (int t = 0; t < NT; t += 2) {
        AT_STEP(0, t);
        if (VAR == 1) { unsigned all_ = 1u; for (int w = 0; w < 8; ++w) all_ &= flags[(t & 1) * 8 + w]; if (all_) break; }
        if (t + 1 >= NT) break;
        AT_STEP(1, t + 1);
        if (VAR == 1) { unsigned all_ = 1u; for (int w = 0; w < 8; ++w) all_ &= flags[((t + 1) & 1) * 8 + w]; if (all_) break; }
    }
    float rli[16];
    if (VAR != 1) {
        if (hi == 0) li_l[r32] = l_reg;
        asm volatile("s_waitcnt lgkmcnt(0)" ::: "memory");
#pragma unroll
        for (int r = 0; r < 16; ++r) rli[r] = __builtin_amdgcn_rcpf(li_l[crow(r, hi)]);
    }
    unsigned char* Ow8 = (unsigned char*)OB + (size_t)(b * S + qlo) * D + g * HD;
#pragma unroll
    for (int r = 0; r < 16; ++r) { const int orow = crow(r, hi);
#pragma unroll
        for (int d0 = 0; d0 < 4; ++d0) { const float v = VAR != 1 ? o[d0][r] * rli[r] : o[d0][r];
            const float vn = lane_read(v, lane ^ 1);
            if ((r32 & 1) == 0) *(unsigned short*)(Ow8 + (size_t)orow * D + d0 * 32 + r32) = (unsigned short)__builtin_amdgcn_cvt_pk_fp8_f32(clamp8(v * 16.0f), clamp8(vn * 16.0f), 0, false); } }
    __syncthreads();
#undef AT_STEP
#undef AT_SLOAD
#undef AT_SWRITE
#undef AT_KBASE
#undef AT_ACT
}

template <int VAR>
__device__ __forceinline__ void attn_queue(const bf16_t* Qh, const bf16_t* Kh, const bf16_t* Vh, bf16_t* OB, const float* relb, const float* LOGF, unsigned* qhead, LAS unsigned char* lds, int wave0) {
    FRESH_TID(); FRESH_LDS(lds);
    volatile LAS unsigned* qslot = (volatile LAS unsigned*)(lds + OFF_MISC) + 32;
    constexpr int NHV = VAR == 0 ? 12 : 10, NITEMS = 8 * NHV * 8;
    for (;;) {
        if (tid == 0) qslot[0] = __hip_atomic_fetch_add(qhead, 1u, __ATOMIC_RELAXED, __HIP_MEMORY_SCOPE_AGENT);
        __syncthreads();
        const int idx = (int)qslot[0];
        __syncthreads();
        if (idx >= NITEMS) break;
        const int qb = 7 - idx / (8 * NHV), bh = idx % (8 * NHV);
        attn_item<VAR>(Qh, Kh, Vh, OB, relb, LOGF, bh / NHV, bh % NHV, qb, lds, tid);
    }
}
__device__ __forceinline__ void attn_phase(const bf16_t* Qh, const bf16_t* Kh, const bf16_t* Vh, bf16_t* OB, const float* relb, const float* LOGF, unsigned* qheads, LAS unsigned char* lds, int wave0) {
    attn_queue<2>(Qh, Kh, Vh, OB, relb, LOGF, qheads + 0, lds, wave0);
    attn_queue<0>(Qh, Kh, Vh, OB, relb, LOGF, qheads + 64, lds, wave0);
    attn_queue<1>(Qh, Kh, Vh, OB, relb, LOGF, qheads + 128, lds, wave0);
}
}
namespace mk {
#define XB_TMO      128
#define XB_XCNT(j)  (256  + 64 * (j))
#define XB_XSUB(j)  (1280 + 64 * (j))
#define XB_XGEN(j)  (2304 + 64 * (j))
#define XB_TOP      3328
#define XB_TOPGEN   3392
#define XCD_BAR_WORDS 3456
#define XB_SPIN_CAP (1u << 22)

__device__ __forceinline__ unsigned xb_ld(unsigned* p)              { return __hip_atomic_load(p, __ATOMIC_RELAXED, __HIP_MEMORY_SCOPE_AGENT); }
__device__ __forceinline__ unsigned xb_add(unsigned* p, unsigned v) { return __hip_atomic_fetch_add(p, v, __ATOMIC_RELAXED, __HIP_MEMORY_SCOPE_AGENT); }
__device__ __forceinline__ unsigned xb_xcc_id() { return (unsigned)__builtin_amdgcn_s_getreg((3 << 11) | 20) & 0xFu; }
#define XB_SPIN(cond, bar) do { unsigned _sp = 0; while (cond) { __builtin_amdgcn_s_sleep(1); \
    if ((++_sp & 255u) == 0u) { if (xb_ld(&(bar)[XB_TMO])) break; if (_sp > XB_SPIN_CAP) { atomicAdd(&(bar)[XB_TMO], 1u); break; } } } } while (0)

struct XcdBarrier {
    unsigned* bar; unsigned x;
    volatile LAS unsigned* st;
};

__device__ __forceinline__ XcdBarrier xcd_barrier_post(unsigned* bar, volatile LAS unsigned* st, bool is_t0) {
    XcdBarrier b; b.bar = bar; b.x = xb_xcc_id(); b.st = st;
    if (is_t0) (void)xb_add(&bar[XB_XCNT(b.x)], 1u);
    return b;
}
__device__ __forceinline__ void xcd_barrier_complete(unsigned* bar, unsigned x, unsigned& nloc, unsigned& nx) {
    const unsigned G = gridDim.x * gridDim.y * gridDim.z;
    unsigned sum, cnt, mine, sp = 0u;
    for (;;) {
        sum = 0u; cnt = 0u; mine = 0u;
#pragma unroll
        for (unsigned j = 0; j < 16; ++j) { const unsigned c = xb_ld(&bar[XB_XCNT(j)]); sum += c; cnt += (c > 0u) ? 1u : 0u; mine = (j == x) ? c : mine; }
        if (sum == G) break;
        __builtin_amdgcn_s_sleep(1);
        if ((++sp & 255u) == 0u) { if (xb_ld(&bar[XB_TMO])) break; if (sp > XB_SPIN_CAP) { atomicAdd(&bar[XB_TMO], 1u); break; } }
    }
    nloc = mine > 0u ? mine : 1u; nx = cnt > 0u ? cnt : 1u;
}

__device__ __forceinline__ void xcd_barrier(const XcdBarrier& b, bool is_t0) {
    asm volatile("s_waitcnt vmcnt(0)" ::: "memory");
    __syncthreads();
    if (is_t0) {
        unsigned* bar = b.bar;
        __builtin_amdgcn_s_waitcnt(0);
        unsigned nloc = b.st[0], nx = b.st[1];
        if (nloc == 0u) { xcd_barrier_complete(bar, b.x, nloc, nx); b.st[0] = nloc; b.st[1] = nx; }
        const unsigned old = xb_add(&bar[XB_XSUB(b.x)], 1u);
        const unsigned gen = old / nloc;
        if (old + 1u == (gen + 1u) * nloc) {
            __builtin_amdgcn_fence(__ATOMIC_RELEASE, "agent");
            asm volatile("s_waitcnt vmcnt(0)" ::: "memory");
            const unsigned og = xb_add(&bar[XB_TOP], 1u);
            const unsigned tg = og / nx;
            if (og + 1u == (tg + 1u) * nx) xb_add(&bar[XB_TOPGEN], 1u);
            else XB_SPIN(xb_ld(&bar[XB_TOPGEN]) == tg, bar);
            __builtin_amdgcn_fence(__ATOMIC_ACQUIRE, "agent");
            xb_add(&bar[XB_XGEN(b.x)], 1u);
            asm volatile("s_waitcnt vmcnt(0)" ::: "memory");
        } else {
            XB_SPIN(xb_ld(&bar[XB_XGEN(b.x)]) == gen, bar);
            __builtin_amdgcn_fence(__ATOMIC_ACQUIRE, "agent");
            asm volatile("s_waitcnt vmcnt(0)" ::: "memory");
        }
    }
    __syncthreads();
}

constexpr int PH_PER_LAYER = 8;
typedef const __attribute__((address_space(4))) Args* KArgs;
#define KARGS() ({ KArgs p_ = (KArgs)__builtin_amdgcn_kernarg_segment_ptr(); asm volatile("" : "+s"(p_)); p_; })
#define GRID_BAR() do { KArgs k_ = KARGS(); XcdBarrier b_; b_.bar = (unsigned*)(k_->ws + WS_CTL) + CW_BAR; b_.x = xb_xcc_id(); b_.st = (volatile LAS unsigned*)(lds + MISC_OFF) + 8; unsigned z_ = 0u; asm volatile("" : "+v"(z_)); const bool t0_ = (wave0 == 0) && (__builtin_amdgcn_mbcnt_hi(~0u, __builtin_amdgcn_mbcnt_lo(~0u, z_)) == 0u);     xcd_barrier(b_, t0_); } while (0)
__global__ void __launch_bounds__(NWAVES * 64, 2) mk_fwd(Args a_unused) {
    extern __shared__ __attribute__((aligned(16))) unsigned char lds_raw[];
    LAS unsigned char* lds = (LAS unsigned char*)lds_raw;
    const int wave0 = __builtin_amdgcn_readfirstlane((int)threadIdx.x >> 6);
    for (int u = threadIdx.x; u < (LDS_BYTES - LDSCTL_OFF) / 4; u += NWAVES * 64) ((LAS unsigned*)(lds + LDSCTL_OFF))[u] = 0u;
    __syncthreads();
    int lo, hi;
    { KArgs k = KARGS(); lo = k->ph_lo; hi = k->ph_hi;
      if (hi - lo > 1) (void)xcd_barrier_post((unsigned*)(k->ws + WS_CTL) + CW_BAR, (volatile LAS unsigned*)(lds + MISC_OFF) + 8, threadIdx.x == 0); }
#define IN(k) (lo <= (k) && (k) < hi)
#define BOTH(k) (IN(k) && IN((k) + 1))
#pragma unroll
    for (int l = 0; l < 2; ++l) {
        const int pb = PH_PER_LAYER * l;
        if (IN(pb + 0)) { KArgs k = KARGS(); conv_phase(k, l, lds, wave0); }
        if (IN(pb + 1) && l == 0) {
            KArgs k = KARGS(); unsigned char* ws = k->ws;
            const float* xin = k->in[0];
            prep_phase<true>(xin, (bf16_t*)(ws + WS_XB8N), (float*)(ws + WS_RSTD), k->in[2] + (size_t)l * D * PW, k->in[1] + (size_t)l * D, k->in[3] + l * 10, (float*)(ws + WS_LOGF), lds, wave0);
            if (BOTH(pb + 1)) GRID_BAR();
        }
        if (l == 1 && IN(pb + 0) && IN(pb + 2)) GRID_BAR();
        if (IN(pb + 2)) {
            KArgs k = KARGS(); unsigned char* ws = k->ws;
            pg8::Gemm g{(const bf16_t*)(ws + WS_XB8N), (const bf16_t*)(ws + WS_WIN), M, 12288, D}; pg8::StaticOrder So; FRESH_BID(); So.init(M, 12288, G, bid);
            pg8::EpiQKV4 E{(bf16_t*)(ws + WS_Q), (const float*)(ws + WS_RSTD), 0.08838834764831845f * 1.4426950408889634f, US_INV};
            { LAS unsigned char* lds_ = lds; FRESH_LDS(lds_); FRESH_TID(); pg8::gemm_phase<pg8::EpiQKV4, pg8::StaticOrder, true, true, true>(lds_, g, So, E, tid); }
            if (BOTH(pb + 2)) GRID_BAR();
        }
        if (IN(pb + 3)) {
            KArgs k = KARGS(); unsigned char* ws = k->ws;
            at::attn_phase((const bf16_t*)(ws + WS_Q), (const bf16_t*)(ws + WS_K), (const bf16_t*)(ws + WS_V), (bf16_t*)(ws + WS_OB), k->in[4] + (size_t)l * 12 * 257, (const float*)(ws + WS_LOGF),
                           (unsigned*)(ws + WS_CTL) + CW_QUEUE + 256 * l, lds, wave0);
            if (BOTH(pb + 3)) GRID_BAR();
        }
        if (IN(pb + 4)) {
            KArgs k = KARGS(); unsigned char* ws = k->ws;
            pg8::Gemm g{(const bf16_t*)(ws + WS_OB), (const bf16_t*)(ws + WS_WOUT), M, D, D}; pg8::StaticOrder So; FRESH_BID(); So.init(M, D, G, bid);
            if (l == 0) { pg8::EpiResidB16<true> E{k->in[0], US_INV * (1.0f / 16.0f), (bf16_t*)(ws + WS_XB)};
                { LAS unsigned char* lds_ = lds; FRESH_LDS(lds_); FRESH_TID(); pg8::gemm_phase<pg8::EpiResidB16<true>, pg8::StaticOrder, false, true, true>(lds_, g, So, E, tid); } }
            else { pg8::EpiResidB16<false> E{ws + WS_X2, US_INV * (1.0f / 16.0f), (bf16_t*)(ws + WS_XB)};
                { LAS unsigned char* lds_ = lds; FRESH_LDS(lds_); FRESH_TID(); pg8::gemm_phase<pg8::EpiResidB16<false>, pg8::StaticOrder, false, true, true>(lds_, g, So, E, tid); } }
            if (BOTH(pb + 4)) GRID_BAR();
        }
        if (IN(pb + 5)) {
            KArgs k = KARGS(); unsigned char* ws = k->ws;
            pg8::Gemm g{(const bf16_t*)(ws + WS_XB), (const bf16_t*)(ws + WS_WQK), M, 2048, D}; pg8::StaticOrder So; FRESH_BID(); So.init(M, 2048, G, bid);
            pg8::EpiPlainF32<2048> E{(float*)(ws + WS_SC)};
            { LAS unsigned char* lds_ = lds; FRESH_LDS(lds_); FRESH_TID(); pg8::gemm_phase<pg8::EpiPlainF32<2048>, pg8::StaticOrder, true, true>(lds_, g, So, E, tid); }
            if (BOTH(pb + 5)) GRID_BAR();
        }
        if (IN(pb + 6)) {
            KArgs k = KARGS(); unsigned char* ws = k->ws;
            if (l == 0) peer_uv_phase<false>((const float*)(ws + WS_SC), (const unsigned char*)(ws + WS_U16), (const unsigned char*)(ws + WS_U16) + (size_t)NE * ROW6  , (const bf16_t*)(ws + WS_XB), ws + WS_X2, nullptr,
                                             ws + WS_XB8N, (float*)(ws + WS_RSTD), (float*)(ws + WS_LOGF), k->in[2] + (size_t)D * PW, k->in[1] + D, k->in[3] + 10, lds, wave0);
            else peer_uv_phase<true>((const float*)(ws + WS_SC), (const unsigned char*)(ws + WS_U16), (const unsigned char*)(ws + WS_U16) + (size_t)NE * ROW6  , (const bf16_t*)(ws + WS_XB), k->out, k->in[12],
                                     nullptr, nullptr, nullptr, nullptr, nullptr, nullptr, lds, wave0);
            if (BOTH(pb + 7)) GRID_BAR();
        }
    }
#undef IN
#undef BOTH
}

static int g_grid = 0;
static void launch_phases(Args a, int lo, int hi, hipStream_t st) {
    a.ph_lo = lo; a.ph_hi = hi;
    hipLaunchKernelGGL(mk_fwd, dim3(g_grid), dim3(NWAVES * 64), LDS_BYTES, st, a);
}
}

extern "C" void kernel_launch(void* const* d_in, const int* in_sizes, int n_in, void* d_out, int out_size, void* d_ws, size_t ws_size, hipStream_t stream) {
    (void)in_sizes; (void)n_in; (void)out_size;
    using namespace mk;
    if (g_grid == 0) {
        if (ws_size < 2048 * MiB) { fprintf(stderr, "kernel_launch: workspace too small (%zu)\n", ws_size); g_grid = -1; return; }
        if (hipFuncSetAttribute((const void*)mk_fwd, hipFuncAttributeMaxDynamicSharedMemorySize, LDS_BYTES) != hipSuccess) { fprintf(stderr, "kernel_launch: hipFuncSetAttribute failed\n"); g_grid = -1; return; }
        int dev = 0, cus = 0; (void)hipGetDevice(&dev); (void)hipDeviceGetAttribute(&cus, hipDeviceAttributeMultiprocessorCount, dev);
        g_grid = cus > 0 ? cus : 256;
    }
    if (g_grid < 0) return;
    unsigned char* ws = (unsigned char*)d_ws; float* out = (float*)d_out;
    (void)hipMemsetAsync(ws + WS_CTL, 0, CTL_ZERO_BYTES, stream);
    Args a{};
    for (int i = 0; i < 13; ++i) a.in[i] = (const float*)d_in[i];
    a.out = out; a.ws = ws;
    launch_phases(a, 0, 2 * PH_PER_LAYER, stream);
}
```

```cpp
#include <hip/hip_runtime.h>
#include <cstdio>
#include <cstdint>
namespace pg8 {
#define PG8_LAS __attribute__((address_space(3)))
typedef unsigned short bf16_t;
typedef short bf16x8 __attribute__((ext_vector_type(8)));
typedef float f32x4 __attribute__((ext_vector_type(4)));
typedef unsigned u32x4 __attribute__((ext_vector_type(4)));
typedef unsigned u32x2 __attribute__((ext_vector_type(2)));
constexpr int BM = 256, BK = 64, HALF = 128, HTB = HALF * BK * 2  , STAGE_BYTES = 8 * HTB, NXCD = 8, WGM = 8;

__host__ __device__ __forceinline__ int lds_byte(int r, int c) { const int st = (r >> 4) * 2 + (c >> 5), rr = r & 15, cc = c & 31, ob = rr * 64 + cc * 2; return st * 1024 + (ob ^ (((ob >> 9) & 1) << 5)); }
__host__ __device__ __forceinline__ void stage_rc(int b, int& R, int& C) { const int st = b / 1024, sb = b % 1024, swz = sb ^ (((sb >> 9) & 1) << 5); R = (st >> 1) * 16 + swz / 64; C = (st & 1) * 32 + (swz % 64) / 2; }
__host__ __device__ __forceinline__ int perm32(int rho) { const int n = rho >> 4, i = rho & 15; return 8 * (i >> 2) + 4 * n + (i & 3); }

struct Unit { int pm, pn; };
struct Gemm { const bf16_t* A; const bf16_t* Bt; int M, N, K; };

struct StaticOrder {
    int nM, nN, nwg, G, c;
    __host__ __device__ void init(int M, int N, int G_, int c_) { nM = M / BM; nN = N / BM; nwg = nM * nN; G = G_; c = c_; }
    __host__ __device__ bool next(int i, Unit& u) const {
        const long L = (long)i * G + c; if (L >= nwg) return false;
        int wgid = (int)L; { const int q = nwg / NXCD, r = nwg % NXCD, xcd = wgid % NXCD, off = wgid / NXCD; wgid = (xcd < r ? xcd * (q + 1) : r * (q + 1) + (xcd - r) * q) + off; }
        const int nig = WGM * nN, gid = wgid / nig, fm = gid * WGM, gsz = (nM - fm) < WGM ? (nM - fm) : WGM;
        u.pm = fm + ((wgid % nig) % gsz); u.pn = (wgid % nig) / gsz; return true;
    }
    __device__ __forceinline__ void a_ready(const Unit&) const {}
    __device__ __forceinline__ void done(const Unit&) const {}
};
__device__ __forceinline__ unsigned cvt_pk_bf16(float lo, float hi) { unsigned r; asm volatile("v_cvt_pk_bf16_f32 %0, %1, %2" : "=v"(r) : "v"(lo), "v"(hi)); return r; }
typedef float f32x2 __attribute__((ext_vector_type(2)));
__device__ __forceinline__ f32x2 gelu_pk(f32x2 v) {
    const f32x2 av = __builtin_elementwise_abs(v), d = av * 0.2316418882f + 1.0f;
    f32x2 t; t.x = __builtin_amdgcn_rcpf(d.x); t.y = __builtin_amdgcn_rcpf(d.y);
    f32x2 q = t * 0.5307027145f + (-0.7265760135f); q = q * t + 0.7107068705f; q = q * t + (-0.142248368f); q = q * t + 0.127414796f; q = q * t;
    const f32x2 s = (v * v) * (-0.72134752044f);
    f32x2 e; e.x = __builtin_amdgcn_exp2f(s.x); e.y = __builtin_amdgcn_exp2f(s.y);
    const f32x2 m = v * (q * e), r = v - m;
    f32x2 o; o.x = v.x < 0.f ? m.x : r.x; o.y = v.y < 0.f ? m.y : r.y; return o;
}
#define EPI_FRESH_LANE() { unsigned z_ = 0u; asm volatile("" : "+v"(z_)); const int l_ = (int)__builtin_amdgcn_mbcnt_hi(~0u, __builtin_amdgcn_mbcnt_lo(~0u, z_)); fr = l_ & 15; fq = l_ >> 4; }
typedef __amdgpu_buffer_rsrc_t rsrc_t;
__device__ __forceinline__ rsrc_t mkrsrc(const void* p, unsigned bytes) { return __builtin_amdgcn_make_buffer_rsrc((void*)p, (short)0, (int)bytes, 0x00020000); }
template <int LDC> struct EpiPlainF32 {
    static constexpr bool PERM = false, AFTER_DRAIN = false;
    float* C;
    __device__ __forceinline__ void operator()(const f32x4 (&acc)[2][2][4][2], const Unit& u, int wr, int wc, int fr, int fq) const {
        EPI_FRESH_LANE();
        const rsrc_t rc = mkrsrc(C, 16384u * LDC * 4u);
        const int vo = ((wr * 64 + fr) * LDC + wc * 32 + 4 * fq) * 4, so = (u.pm * BM * LDC + u.pn * BM) * 4;
#pragma unroll
        for (int ai = 0; ai < 2; ++ai)
#pragma unroll
            for (int m = 0; m < 4; ++m)
#pragma unroll
                for (int bj = 0; bj < 2; ++bj)
#pragma unroll
                    for (int n = 0; n < 2; ++n) __builtin_amdgcn_raw_buffer_store_b128(__builtin_bit_cast(u32x4, acc[ai][bj][m][n]), rc, vo, so + ((ai * HALF + m * 16) * LDC + bj * HALF + n * 16) * 4, 0);
    }
};
template <int LDC> struct EpiRowScaleF32 {
    static constexpr bool PERM = false, AFTER_DRAIN = false;
    float* C; const float* rs;
    __device__ __forceinline__ void operator()(const f32x4 (&acc)[2][2][4][2], const Unit& u, int wr, int wc, int fr, int fq) const {
        const rsrc_t rc = mkrsrc(C, 16384u * LDC * 4u), rr = mkrsrc(rs, 16384u * 4u);
        const int vo = ((wr * 64 + fr) * LDC + wc * 32 + 4 * fq) * 4, vr = (wr * 64 + fr) * 4;
        const int so = (u.pm * BM * LDC + u.pn * BM) * 4, sr = u.pm * BM * 4;
#pragma unroll
        for (int ai = 0; ai < 2; ++ai)
#pragma unroll
            for (int m = 0; m < 4; ++m) { const float s = __builtin_bit_cast(float, __builtin_amdgcn_raw_buffer_load_b32(rr, vr, sr + (ai * HALF + m * 16) * 4, 0));
#pragma unroll
                for (int bj = 0; bj < 2; ++bj)
#pragma unroll
                    for (int n = 0; n < 2; ++n) { const f32x4 v = acc[ai][bj][m][n] * s; __builtin_amdgcn_raw_buffer_store_b128(__builtin_bit_cast(u32x4, v), rc, vo, so + ((ai * HALF + m * 16) * LDC + bj * HALF + n * 16) * 4, 0); } }
    }
};
template <bool BASE_F32> struct EpiResidB16 {
    static constexpr bool PERM = false, AFTER_DRAIN = false;
    const void* base; float ascale; bf16_t* xb;
    __device__ __forceinline__ void operator()(const f32x4 (&acc)[2][2][4][2], const Unit& u, int wr, int wc, int fr, int fq) const {
        EPI_FRESH_LANE();
        constexpr int LDC = 4096;
        const rsrc_t rb = mkrsrc(base, 16384u * LDC * (BASE_F32 ? 4u : 2u)), rx = mkrsrc(xb, 16384u * LDC * 2u);
        const int vo = ((wr * 64 + fr) * LDC + wc * 32 + 4 * fq) * 2;
        const int so = (u.pm * BM * LDC + u.pn * BM) * 2;
        f32x4 ra[2][2], rb2[2][2];
#define EPI_LD(dst, g_) do { _Pragma("unroll") for (int bj = 0; bj < 2; ++bj) _Pragma("unroll") for (int n = 0; n < 2; ++n) { \
            const int o = so + ((((g_) >> 2) * HALF + ((g_) & 3) * 16) * LDC + bj * HALF + n * 16) * 2; \
            if constexpr (BASE_F32) dst[bj][n] = __builtin_bit_cast(f32x4, __builtin_amdgcn_raw_buffer_load_b128(rb, vo * 2, o * 2, 0)); \
            else { const u32x2 t_ = __builtin_amdgcn_raw_buffer_load_b64(rb, vo, o, 0); dst[bj][n] = (f32x4){__builtin_bit_cast(float, t_.x << 16), __builtin_bit_cast(float, t_.x & 0xffff0000u), __builtin_bit_cast(float, t_.y << 16), __builtin_bit_cast(float, t_.y & 0xffff0000u)}; } } } while (0)
#define EPI_ST(src, g_) do { _Pragma("unroll") for (int bj = 0; bj < 2; ++bj) _Pragma("unroll") for (int n = 0; n < 2; ++n) { \
            const int o = so + ((((g_) >> 2) * HALF + ((g_) & 3) * 16) * LDC + bj * HALF + n * 16) * 2; \
            const f32x4 v = src[bj][n] + acc[(g_) >> 2][bj][(g_) & 3][n] * ascale; \
            u32x2 w; w.x = cvt_pk_bf16(v[0], v[1]); w.y = cvt_pk_bf16(v[2], v[3]); __builtin_amdgcn_raw_buffer_store_b64(w, rx, vo, o, 0); } } while (0)
        EPI_LD(ra, 0);
        EPI_LD(rb2, 1); EPI_ST(ra, 0);
        EPI_LD(ra, 2); EPI_ST(rb2, 1);
        EPI_LD(rb2, 3); EPI_ST(ra, 2);
        EPI_LD(ra, 4); EPI_ST(rb2, 3);
        EPI_LD(rb2, 5); EPI_ST(ra, 4);
        EPI_LD(ra, 6); EPI_ST(rb2, 5);
        EPI_LD(rb2, 7); EPI_ST(ra, 6);
        EPI_ST(rb2, 7);
#undef EPI_LD
#undef EPI_ST
    }
};
struct EpiQKV {
    static constexpr bool PERM = true, AFTER_DRAIN = false;
    bf16_t* Q; const float* rs; float qscale;
    __device__ __forceinline__ void operator()(const f32x4 (&acc)[2][2][4][2], const Unit& u, int wr, int wc, int fr, int fq) const {
        const rsrc_t rq = mkrsrc(Q, 3u * 16384u * 4096u * 2u), rr = mkrsrc(rs, 16384u * 4u);
        const int colt = u.pn * BM, which = colt >> 12, cw = colt & 4095, gt = cw >> 7;
        const int b = (u.pm * BM) >> 11, st = (u.pm * BM) & 2047;
        const float sc = which == 0 ? qscale : 1.f;
        const int so = (int)(((unsigned)which << 26) + (((unsigned)(b * 32 + gt) * 2048u + (unsigned)st) << 7)) * 2;
        const int vo = (((wr * 64 + fr) << 7) + wc * 32 + 8 * fq) * 2, vr = (wr * 64 + fr) * 4, sr = u.pm * BM * 4;
#pragma unroll
        for (int ai = 0; ai < 2; ++ai)
#pragma unroll
            for (int m = 0; m < 4; ++m) { const float f = sc * __builtin_bit_cast(float, __builtin_amdgcn_raw_buffer_load_b32(rr, vr, sr + (ai * HALF + m * 16) * 4, 0));
#pragma unroll
                for (int bj = 0; bj < 2; ++bj) {
                    const f32x4 v0 = acc[ai][bj][m][0] * f, v1 = acc[ai][bj][m][1] * f;
                    u32x4 w; w.x = cvt_pk_bf16(v0[0], v0[1]); w.y = cvt_pk_bf16(v0[2], v0[3]); w.z = cvt_pk_bf16(v1[0], v1[1]); w.w = cvt_pk_bf16(v1[2], v1[3]);
                    __builtin_amdgcn_raw_buffer_store_b128(w, rq, vo, so + ((bj * 2048 + ai * HALF + m * 16) << 7) * 2, 0); } }
    }
};

struct EpiQKV4 {
    static constexpr bool PERM = false, AFTER_DRAIN = false;
    bf16_t* Q; const float* rs; float qscale, wscale;
    __device__ __forceinline__ void operator()(const f32x4 (&acc)[2][2][4][2], const Unit& u, int wr, int wc, int fr, int fq) const {
        EPI_FRESH_LANE();
        const rsrc_t rq = mkrsrc(Q, 3u * 16384u * 4096u * 2u), rr = mkrsrc(rs, 16384u * 4u);
        const int colt = u.pn * BM, which = colt >> 12, cw = colt & 4095, gt = cw >> 7;
        const int b = (u.pm * BM) >> 11, st = (u.pm * BM) & 2047;
        const float sc = (which == 0 ? qscale : 1.f) * wscale;
        const int so = (int)(((unsigned)which << 26) + (((unsigned)(b * 32 + gt) * 2048u + (unsigned)st) << 7)) * 2;
        const int vo = (((wr * 64 + fr) << 7) + wc * 32 + 4 * fq) * 2, vr = (wr * 64 + fr) * 4, sr = u.pm * BM * 4;
        unsigned rsv[2][4];
#pragma unroll
        for (int ai = 0; ai < 2; ++ai)
#pragma unroll
            for (int m = 0; m < 4; ++m) rsv[ai][m] = __builtin_amdgcn_raw_buffer_load_b32(rr, vr, sr + (ai * HALF + m * 16) * 4, 0);
#pragma unroll
        for (int ai = 0; ai < 2; ++ai)
#pragma unroll
            for (int m = 0; m < 4; ++m) { const float f = sc * __builtin_bit_cast(float, rsv[ai][m]);
#pragma unroll
                for (int bj = 0; bj < 2; ++bj)
#pragma unroll
                    for (int n = 0; n < 2; ++n) { const f32x4 v0 = acc[ai][bj][m][n] * f; u32x2 w; w.x = cvt_pk_bf16(v0[0], v0[1]); w.y = cvt_pk_bf16(v0[2], v0[3]);
                        __builtin_amdgcn_raw_buffer_store_b64(w, rq, vo, so + (((bj * 2048 + ai * HALF + m * 16) << 7) + n * 16) * 2, 0); } }
    }
};

typedef int i32x8 __attribute__((ext_vector_type(8)));
template <bool F8> struct FragT { typedef bf16x8 type; };
template <> struct FragT<true> { typedef i32x8 type; };
__device__ __forceinline__ f32x4 mma_bf16(bf16x8 a, bf16x8 b, f32x4 c) { return __builtin_amdgcn_mfma_f32_16x16x32_bf16(a, b, c, 0, 0, 0); }
__device__ __forceinline__ f32x4 mma_bf16(i32x8, i32x8, f32x4 c) { return c; }
template <class Epi, class Sched, bool ALIGN_EPI = false, bool SP2 = false, bool F8 = false>
__device__ __forceinline__ void gemm_phase(PG8_LAS unsigned char* lds, const Gemm g, const Sched& S, const Epi& E, int tid_in) {
    int tid_ = tid_in;
    const int tid = tid_, wid = __builtin_amdgcn_readfirstlane(tid >> 6), lane = tid & 63, wr = wid >> 2, wc = wid & 3, fr = lane & 15, fq = lane >> 4;
    constexpr int EB = F8 ? 1 : 2;
    constexpr int K = 4096; constexpr int nt = (K * EB) / (BK * 2);
    unsigned voffA[2], voffB[2];
#pragma unroll
    for (int i = 0; i < 2; ++i) { int R, C; stage_rc(tid * 16 + i * 8192, R, C); const int Rb = Epi::PERM ? ((R & ~31) + perm32(R & 31)) : R;
        voffA[i] = (unsigned)(R * K * EB + C * 2); voffB[i] = (unsigned)(Rb * K * EB + C * 2); }
    const size_t kstep = (size_t)(BK * 2);
    const size_t hstep = (size_t)HALF * K * EB;
    const size_t tstep = 2 * hstep;
    const unsigned ldsw = (unsigned)wid * 1024u;
    const int aoff = F8 ? lds_byte(wr * 64 + fr, fq * 16) + (fq & 1) * 16 : lds_byte(wr * 64 + fr, fq * 8), boff = F8 ? lds_byte(wc * 32 + fr, fq * 16) + (fq & 1) * 16 : lds_byte(wc * 32 + fr, fq * 8);
    const int aoff1 = aoff + (F8 ? 16 - 32 * (fq & 1) : 0);
    const int f8o0_unused = 0; (void)f8o0_unused;
#define PG8_SA(b, h) (((b) * 2 + (h)) * HTB)
#define PG8_SB(b, h) ((4 + (b) * 2 + (h)) * HTB)
#define PG8_STAGE_X(bufoff, gbase, voff, rs_, base_) do { const int so_ = (int)((const char*)(gbase) - (const char*)(base_)); _Pragma("unroll") for (int _i = 0; _i < 2; ++_i) \
        __builtin_amdgcn_raw_ptr_buffer_load_lds(rs_, (PG8_LAS void*)(lds + (bufoff) + ldsw + _i * 8192), 16, (int)(voff)[_i], so_, 0, 0); } while (0)
#define PG8_LDA(dst, b, h) do { if constexpr (F8) { _Pragma("unroll") for (int m = 0; m < 4; ++m) { const u32x4 lo_ = *(const PG8_LAS u32x4*)(lds + PG8_SA(b, h) + aoff + m * 2048), hi_ = *(const PG8_LAS u32x4*)(lds + PG8_SA(b, h) + aoff1 + m * 2048); \
            dst[m][0] = (i32x8){(int)lo_[0], (int)lo_[1], (int)lo_[2], (int)lo_[3], (int)hi_[0], (int)hi_[1], (int)hi_[2], (int)hi_[3]}; } } \
        else { _Pragma("unroll") for (int m = 0; m < 4; ++m) _Pragma("unroll") for (int k = 0; k < 2; ++k) dst[m][k] = *(const PG8_LAS frag_t*)(lds + PG8_SA(b, h) + aoff + m * 2048 + k * 1024); } } while (0)
#define PG8_LDB(dst, b, h) do { if constexpr (F8) { _Pragma("unroll") for (int n = 0; n < 2; ++n) { const u32x4 lo_ = *(const PG8_LAS u32x4*)(lds + PG8_SB(b, h) + boff + n * 2048), hi_ = *(const PG8_LAS u32x4*)(lds + PG8_SB(b, h) + boff + (aoff1 - aoff) + n * 2048); \
            dst[n][0] = (i32x8){(int)lo_[0], (int)lo_[1], (int)lo_[2], (int)lo_[3], (int)hi_[0], (int)hi_[1], (int)hi_[2], (int)hi_[3]}; } } \
        else { _Pragma("unroll") for (int n = 0; n < 2; ++n) _Pragma("unroll") for (int k = 0; k < 2; ++k) dst[n][k] = *(const PG8_LAS frag_t*)(lds + PG8_SB(b, h) + boff + n * 2048 + k * 1024); } } while (0)
#define PG8_MMA(ai, bj, At, Bt) do { __builtin_amdgcn_s_setprio(1); _Pragma("unroll") for (int m = 0; m < 4; ++m) _Pragma("unroll") for (int n = 0; n < 2; ++n) { \
        if constexpr (F8) acc[ai][bj][m][n] = __builtin_amdgcn_mfma_scale_f32_16x16x128_f8f6f4(Bt[n][0], At[m][0], acc[ai][bj][m][n], 0, 0, 0, 0x7f7f7f7f, 0, 0x7f7f7f7f); \
        else { _Pragma("unroll") for (int k = 0; k < 2; ++k) acc[ai][bj][m][n] = mma_bf16(Bt[n][k], At[m][k], acc[ai][bj][m][n]); } } __builtin_amdgcn_s_setprio(0); } while (0)
#define PG8_WAIT_V(n) asm volatile("s_waitcnt vmcnt(" #n ")" ::: "memory")
#define PG8_WAIT_L(n) asm volatile("s_waitcnt lgkmcnt(" #n ")" ::: "memory")
#define PG8_BAR __builtin_amdgcn_s_barrier()
#define PG8_SCHED __builtin_amdgcn_sched_barrier(0)
    const __amdgpu_buffer_rsrc_t rsA = __builtin_amdgcn_make_buffer_rsrc((void*)g.A, (short)0, (int)((size_t)g.M * K * EB), 0x00020000), rsB = __builtin_amdgcn_make_buffer_rsrc((void*)g.Bt, (short)0, (int)((size_t)g.N * K * EB), 0x00020000);
    Unit cur, nxt; int ui = 0;
    if (!S.next(0, cur)) return;
    f32x4 acc[2][2][4][2];
#pragma unroll
    for (int a = 0; a < 2; ++a)
#pragma unroll
        for (int b = 0; b < 2; ++b)
#pragma unroll
            for (int m = 0; m < 4; ++m)
#pragma unroll
                for (int n = 0; n < 2; ++n) acc[a][b][m][n] = (f32x4){0.f, 0.f, 0.f, 0.f};
    typedef typename FragT<F8>::type frag_t;
    frag_t At[4][F8 ? 1 : 2], B0[2][F8 ? 1 : 2], B1[2][F8 ? 1 : 2];
    const char* cA = (const char*)g.A + (size_t)cur.pm * tstep; const char* cB = (const char*)g.Bt + (size_t)cur.pn * tstep;
    S.a_ready(cur);
    if constexpr (SP2) {
        PG8_STAGE_X(PG8_SB(0, 0), cB, voffB, rsB, g.Bt); PG8_STAGE_X(PG8_SB(0, 1), cB + hstep, voffB, rsB, g.Bt); PG8_STAGE_X(PG8_SA(0, 0), cA, voffA, rsA, g.A); PG8_STAGE_X(PG8_SA(0, 1), cA + hstep, voffA, rsA, g.A);
        if (wr == 1) PG8_BAR;
        PG8_WAIT_V(2); PG8_BAR;
        PG8_STAGE_X(PG8_SB(1, 0), cB + kstep, voffB, rsB, g.Bt); PG8_STAGE_X(PG8_SA(1, 0), cA + kstep, voffA, rsA, g.A); PG8_STAGE_X(PG8_SB(1, 1), cB + hstep + kstep, voffB, rsB, g.Bt);
        PG8_WAIT_V(6); PG8_BAR;
    } else {
        PG8_STAGE_X(PG8_SB(0, 0), cB, voffB, rsB, g.Bt); PG8_STAGE_X(PG8_SA(0, 0), cA, voffA, rsA, g.A); PG8_STAGE_X(PG8_SB(0, 1), cB + hstep, voffB, rsB, g.Bt); PG8_STAGE_X(PG8_SA(0, 1), cA + hstep, voffA, rsA, g.A);
        if (wr == 1) PG8_BAR;
        PG8_WAIT_V(4); PG8_BAR;
        PG8_STAGE_X(PG8_SB(1, 0), cB + kstep, voffB, rsB, g.Bt); PG8_STAGE_X(PG8_SA(1, 0), cA + kstep, voffA, rsA, g.A); PG8_STAGE_X(PG8_SB(1, 1), cB + hstep + kstep, voffB, rsB, g.Bt);
        PG8_WAIT_V(6); PG8_BAR;
    }
    for (;;) {
        const bool has_next = S.next(ui + 1, nxt);
        const char* nA = has_next ? (const char*)g.A + (size_t)nxt.pm * tstep : cA; const char* nB = has_next ? (const char*)g.Bt + (size_t)nxt.pn * tstep : cB;
        for (int t = 0; t < nt; t += 2) {
            const bool last = (t == nt - 2);
            const char* a1 = cA + (size_t)(t + 1) * kstep;
            const char* a2 = last ? nA : cA + (size_t)(t + 2) * kstep; const char* b2 = last ? nB : cB + (size_t)(t + 2) * kstep;
            const char* a3 = a2 + kstep; const char* b3 = b2 + kstep;
            if (last && has_next) S.a_ready(nxt);
            if constexpr (SP2) {
            PG8_LDB(B0, 0, 0); PG8_LDB(B1, 0, 1); PG8_SCHED; PG8_LDA(At, 0, 0); PG8_STAGE_X(PG8_SA(1, 1), a1 + hstep, voffA, rsA, g.A);
            PG8_WAIT_V(8); PG8_WAIT_L(0); PG8_BAR; PG8_MMA(0, 0, At, B0); PG8_MMA(0, 1, At, B1); PG8_BAR; PG8_SCHED;
            PG8_LDA(At, 0, 1); PG8_STAGE_X(PG8_SB(0, 0), b2, voffB, rsB, g.Bt); PG8_STAGE_X(PG8_SB(0, 1), b2 + hstep, voffB, rsB, g.Bt); PG8_STAGE_X(PG8_SA(0, 0), a2, voffA, rsA, g.A);
            PG8_WAIT_V(8); PG8_WAIT_L(0); PG8_BAR; PG8_MMA(1, 0, At, B0); PG8_MMA(1, 1, At, B1); PG8_BAR; PG8_SCHED;
            PG8_LDB(B0, 1, 0); PG8_LDB(B1, 1, 1); PG8_SCHED; PG8_LDA(At, 1, 0); PG8_STAGE_X(PG8_SA(0, 1), a2 + hstep, voffA, rsA, g.A);
            PG8_WAIT_V(8); PG8_WAIT_L(0); PG8_BAR; PG8_MMA(0, 0, At, B0); PG8_MMA(0, 1, At, B1); PG8_BAR; PG8_SCHED;
            PG8_LDA(At, 1, 1); PG8_STAGE_X(PG8_SB(1, 0), b3, voffB, rsB, g.Bt); PG8_STAGE_X(PG8_SB(1, 1), b3 + hstep, voffB, rsB, g.Bt); PG8_STAGE_X(PG8_SA(1, 0), a3, voffA, rsA, g.A);
            PG8_WAIT_V(8); PG8_WAIT_L(0); PG8_BAR; PG8_MMA(1, 0, At, B0); PG8_MMA(1, 1, At, B1); PG8_BAR; PG8_SCHED;
            } else {
            PG8_LDB(B0, 0, 0); PG8_SCHED; PG8_LDA(At, 0, 0); PG8_STAGE_X(PG8_SA(1, 1), a1 + hstep, voffA, rsA, g.A);
            PG8_WAIT_L(8); PG8_BAR; PG8_WAIT_L(0); PG8_MMA(0, 0, At, B0); PG8_BAR; PG8_SCHED;
            PG8_LDB(B1, 0, 1); PG8_STAGE_X(PG8_SB(0, 0), b2, voffB, rsB, g.Bt);
            PG8_BAR; PG8_WAIT_L(0); PG8_MMA(0, 1, At, B1); PG8_BAR;
            PG8_LDA(At, 0, 1); PG8_STAGE_X(PG8_SA(0, 0), a2, voffA, rsA, g.A);
            PG8_BAR; PG8_WAIT_L(0); PG8_MMA(1, 0, At, B0); PG8_BAR; PG8_SCHED;
            PG8_STAGE_X(PG8_SB(0, 1), b2 + hstep, voffB, rsB, g.Bt);
            PG8_WAIT_V(6); PG8_BAR; PG8_MMA(1, 1, At, B1); PG8_BAR;
            PG8_LDB(B0, 1, 0); PG8_SCHED; PG8_LDA(At, 1, 0); PG8_STAGE_X(PG8_SA(0, 1), a2 + hstep, voffA, rsA, g.A);
            PG8_WAIT_L(8); PG8_BAR; PG8_WAIT_L(0); PG8_MMA(0, 0, At, B0); PG8_BAR; PG8_SCHED;
            PG8_LDB(B1, 1, 1); PG8_STAGE_X(PG8_SB(1, 0), b3, voffB, rsB, g.Bt);
            PG8_BAR; PG8_WAIT_L(0); PG8_MMA(0, 1, At, B1); PG8_BAR;
            PG8_LDA(At, 1, 1); PG8_STAGE_X(PG8_SA(1, 0), a3, voffA, rsA, g.A);
            PG8_BAR; PG8_WAIT_L(0); PG8_MMA(1, 0, At, B0); PG8_BAR; PG8_SCHED;
            PG8_STAGE_X(PG8_SB(1, 1), b3 + hstep, voffB, rsB, g.Bt);
            PG8_WAIT_V(6); PG8_BAR; PG8_MMA(1, 1, At, B1); PG8_BAR;
            }
        }
        if constexpr (ALIGN_EPI) { if (wr == 0) PG8_BAR; }
        if constexpr (!Epi::AFTER_DRAIN) { E(acc, cur, wr, wc, fr, fq); S.done(cur); }
        if (!has_next) break;
#pragma unroll
        for (int a = 0; a < 2; ++a)
#pragma unroll
            for (int b = 0; b < 2; ++b)
#pragma unroll
                for (int m = 0; m < 4; ++m)
#pragma unroll
                    for (int n = 0; n < 2; ++n) acc[a][b][m][n] = (f32x4){0.f, 0.f, 0.f, 0.f};
        cur = nxt; cA = nA; cB = nB; ++ui;
        if constexpr (ALIGN_EPI) { if (wr == 1) PG8_BAR; }
    }
    PG8_WAIT_V(0);
    if constexpr (!ALIGN_EPI) { if (wr == 0) PG8_BAR; }
    PG8_BAR;
    if constexpr (Epi::AFTER_DRAIN) { E.fused(acc, cur, wr, wc, fr, fq, lds, wid, lane); S.done(cur); }
#undef PG8_SA
#undef PG8_SB
#undef PG8_STAGE_X
#undef PG8_LDA
#undef PG8_LDB
#undef PG8_MMA
#undef PG8_WAIT_V
#undef PG8_WAIT_L
#undef PG8_BAR
#undef PG8_SCHED
}
}
#define GAS __attribute__((address_space(1)))
#define LAS __attribute__((address_space(3)))
typedef unsigned short bf16_t;
typedef unsigned u32x4 __attribute__((ext_vector_type(4)));
typedef unsigned u32x2 __attribute__((ext_vector_type(2)));
typedef float f32x4 __attribute__((ext_vector_type(4)));
typedef float f32x2 __attribute__((ext_vector_type(2)));
typedef float f32x16 __attribute__((ext_vector_type(16)));
typedef short bf16x8 __attribute__((ext_vector_type(8)));
typedef short s16x4 __attribute__((ext_vector_type(4)));
typedef __bf16 bf16x2_t __attribute__((ext_vector_type(2)));
typedef unsigned u32x6 __attribute__((ext_vector_type(6)));
typedef int i32x8 __attribute__((ext_vector_type(8)));
typedef unsigned u32x16 __attribute__((ext_vector_type(16)));
typedef float f32x32 __attribute__((ext_vector_type(32)));
typedef _Float16 f16x32 __attribute__((ext_vector_type(32)));
typedef _Float16 f16x2 __attribute__((ext_vector_type(2)));

namespace mk {
constexpr int M = 16384, D = 4096, S = 2048, NB = 8, PW = 12298, NH = 32, NE = 16384;
constexpr int NWAVES = 8;
constexpr size_t MiB = 1u << 20;
constexpr size_t WS_CTL = 0, CTL_ZERO_BYTES = 1 * MiB;
constexpr size_t WS_RSTD = 2 * MiB, WS_LOGF = 3 * MiB, WS_WQK = 4 * MiB, WS_WOUT = 20 * MiB, WS_WIN = 52 * MiB, WS_U16 = 148 * MiB, WS_V16 = 276 * MiB,
                 WS_XB = 404 * MiB, WS_Q = 532 * MiB, WS_K = 660 * MiB, WS_V = 788 * MiB, WS_OB = 916 * MiB, WS_X2 = 1792 * MiB, WS_END = 2048 * MiB;
constexpr size_t WS_XB8N = WS_OB + 64 * MiB;
constexpr size_t WS_SC = WS_Q;
constexpr int CW_BAR = 4096;
constexpr int CW_QUEUE = 16384;
constexpr int RING_BYTES = 131072, LDSCTL_OFF = RING_BYTES, MISC_OFF = LDSCTL_OFF + 320, LDS_BYTES = 147456;

struct Args { const float* in[13]; float* out; unsigned char* ws; int ph_lo, ph_hi; };

__device__ __forceinline__ unsigned f2bf(float f) { unsigned u = __builtin_bit_cast(unsigned, f); return (u + 0x7fffu + ((u >> 16) & 1u)) >> 16; }
__device__ __forceinline__ unsigned pk2(float lo, float hi) { return f2bf(lo) | (f2bf(hi) << 16); }
__device__ __forceinline__ float bf_lo(unsigned w) { return __builtin_bit_cast(float, w << 16); }
__device__ __forceinline__ float bf_hi(unsigned w) { return __builtin_bit_cast(float, w & 0xffff0000u); }
__device__ __forceinline__ float lane_read(float v, int src_lane) { return __builtin_bit_cast(float, __builtin_amdgcn_ds_bpermute(src_lane << 2, __builtin_bit_cast(int, v))); }
__device__ __forceinline__ int lane_read(int v, int src_lane) { return __builtin_amdgcn_ds_bpermute(src_lane << 2, v); }
constexpr float US = 1024.0f, VS = 32.0f, US_INV = 1.0f / 1024.0f, VS_INV = 1.0f / 32.0f;
constexpr int ROW6 = 3072;
__device__ __forceinline__ unsigned q_e2m3(float x, float inv) {
    const float a = fminf(fabsf(x) * inv, 7.5f);
    const float c = a < 2.0f ? __builtin_rintf(a * 8.0f) : (a < 4.0f ? __builtin_rintf(a * 4.0f) + 8.0f : __builtin_rintf(a * 2.0f) + 16.0f);
    return (unsigned)(int)c | ((__builtin_bit_cast(unsigned, x) >> 26) & 32u);
}
__device__ __forceinline__ u32x6 pack_fp6(const f32x4 (&a0)[4], const f32x4 (&a1)[4], float inv) {
    unsigned o[6];
#pragma unroll
    for (int w = 0; w < 6; ++w) o[w] = 0u;
#pragma unroll
    for (int j = 0; j < 32; ++j) { const float x = (j < 16) ? a0[(j & 15) >> 2][j & 3] : a1[(j & 15) >> 2][j & 3]; const unsigned c = q_e2m3(x, inv);
        const int b = 6 * j, w = b >> 5, sh = b & 31; o[w] |= c << sh; if (sh > 26) o[w + 1] |= c >> (32 - sh); }
    return (u32x6){o[0], o[1], o[2], o[3], o[4], o[5]};
}
constexpr int ROW4 = 2048;
__device__ __forceinline__ unsigned q_e2m1(float x, float inv) {
    const float a = fminf(fabsf(x) * inv, 6.0f);
    const float c = a < 2.0f ? __builtin_rintf(a * 2.0f) : (a < 4.0f ? __builtin_rintf(a) + 2.0f : __builtin_rintf(a * 0.5f) + 4.0f);
    return (unsigned)(int)c | ((__builtin_bit_cast(unsigned, x) >> 28) & 8u);
}
#define FP4X_(j) ((j) < 16 ? a0[((j) & 15) >> 2][(j) & 3] : a1[((j) & 15) >> 2][(j) & 3])
__device__ __forceinline__ u32x4 pack_fp4(const f32x4 (&a0)[4], const f32x4 (&a1)[4], float inv) {
    unsigned o[4];
#pragma unroll
    for (int w = 0; w < 4; ++w) { unsigned v = 0u;
        v = __builtin_amdgcn_cvt_scalef32_pk_fp4_f32(v, FP4X_(8 * w + 0) * inv, FP4X_(8 * w + 1) * inv, 1.0f, 0); v = __builtin_amdgcn_cvt_scalef32_pk_fp4_f32(v, FP4X_(8 * w + 2) * inv, FP4X_(8 * w + 3) * inv, 1.0f, 1);
        v = __builtin_amdgcn_cvt_scalef32_pk_fp4_f32(v, FP4X_(8 * w + 4) * inv, FP4X_(8 * w + 5) * inv, 1.0f, 2); v = __builtin_amdgcn_cvt_scalef32_pk_fp4_f32(v, FP4X_(8 * w + 6) * inv, FP4X_(8 * w + 7) * inv, 1.0f, 3);
        o[w] = v; }
    return (u32x4){o[0], o[1], o[2], o[3]};
}
#undef FP4X_
__device__ __forceinline__ float clamp8(float x) { return fminf(fmaxf(x, -224.0f), 224.0f); }
__device__ __forceinline__ float logsig(float z) { return fminf(z, 0.f) - 0.6931471805599453f * __builtin_amdgcn_logf(1.0f + __builtin_amdgcn_exp2f(-fabsf(z) * 1.4426950408889634f)); }
__device__ __forceinline__ float gelu_erf(float v) {
    const float av = fabsf(v), t = __builtin_amdgcn_rcpf(av * 0.2316418882f + 1.0f);
    float q = t * 0.5307027145f + (-0.7265760135f); q = q * t + 0.7107068705f; q = q * t + (-0.142248368f); q = q * t + 0.127414796f; q = q * t;
    const float e = __builtin_amdgcn_exp2f((v * v) * (-0.72134752044f));
    const float m = v * (q * e);
    return v < 0.f ? m : v - m;
}
#define LDS_WAIT() asm volatile("s_waitcnt lgkmcnt(0)" ::: "memory")
#define FRESH_LDS(l) do { unsigned v_ = (unsigned)(size_t)(l); asm volatile("" : "+s"(v_)); (l) = (LAS unsigned char*)(size_t)v_; } while (0)
#define FRESH_BID() int bid = blockIdx.x, G = gridDim.x; asm volatile("" : "+s"(bid), "+s"(G))
#define FRESH_TID() int tid; { int w_ = wave0, l_; { unsigned z_ = 0u; asm volatile("" : "+v"(z_)); l_ = (int)__builtin_amdgcn_mbcnt_hi(~0u, __builtin_amdgcn_mbcnt_lo(~0u, z_)); } asm volatile("" : "+s"(w_)); tid = w_ * 64 + l_; } const int lane = tid & 63, wave = __builtin_amdgcn_readfirstlane(tid >> 6); (void)lane; (void)wave

__device__ __forceinline__ unsigned wave_max_u32(unsigned v) {
    v = max(v, (unsigned)__builtin_amdgcn_update_dpp(0, (int)v, 0x111, 0xF, 0xF, true));
    v = max(v, (unsigned)__builtin_amdgcn_update_dpp(0, (int)v, 0x112, 0xF, 0xF, true));
    v = max(v, (unsigned)__builtin_amdgcn_update_dpp(0, (int)v, 0x114, 0xF, 0xF, true));
    v = max(v, (unsigned)__builtin_amdgcn_update_dpp(0, (int)v, 0x118, 0xF, 0xF, true));
    v = max(v, (unsigned)__builtin_amdgcn_update_dpp((int)v, (int)v, 0x142, 0xA, 0xF, false));
    v = max(v, (unsigned)__builtin_amdgcn_update_dpp((int)v, (int)v, 0x143, 0xC, 0xF, false));
    return (unsigned)__builtin_amdgcn_readlane((int)v, 63);
}
__device__ __forceinline__ float wave_sum_dpp(float x) {
    int v = __builtin_bit_cast(int, x);
#define DPP_ADD(ctrl, rm, bc, oldv) v = __builtin_bit_cast(int, __builtin_bit_cast(float, v) + __builtin_bit_cast(float, __builtin_amdgcn_update_dpp(oldv, v, ctrl, rm, 0xF, bc)))
    DPP_ADD(0x111, 0xF, true, 0); DPP_ADD(0x112, 0xF, true, 0); DPP_ADD(0x114, 0xF, true, 0); DPP_ADD(0x118, 0xF, true, 0);
#undef DPP_ADD
    const float r0 = __builtin_bit_cast(float, __builtin_amdgcn_readlane(v, 15)), r1 = __builtin_bit_cast(float, __builtin_amdgcn_readlane(v, 31)), r2 = __builtin_bit_cast(float, __builtin_amdgcn_readlane(v, 47)), r3 = __builtin_bit_cast(float, __builtin_amdgcn_readlane(v, 63));
    return (r0 + r1) + (r2 + r3);
}
__device__ __forceinline__ unsigned ordkey(float x) { const unsigned u = __builtin_bit_cast(unsigned, x); return (u & 0x80000000u) ? ~u : (u | 0x80000000u); }
__device__ __forceinline__ void transpose_item(const float* W, int K, int ldw, int ncols, const float* gain, bf16_t* WT, LAS float* scr, int item, int lane) {
    const int nblk = ncols / 32, kb = item / nblk, nb = item % nblk, k0 = 64 * kb, n0 = 32 * nb;
#pragma unroll 8
    for (int i = 0; i < 32; ++i) { const int kk = 2 * i + (lane >> 5); float v = W[(size_t)(k0 + kk) * ldw + n0 + (lane & 31)]; if (gain) v *= gain[k0 + kk]; scr[kk * 33 + (lane & 31)] = v; }
    LDS_WAIT(); asm volatile("" ::: "memory");
    const int c = lane & 7;
#pragma unroll
    for (int j = 0; j < 4; ++j) { const int n = (lane >> 3) + 8 * j; const LAS float* s = scr + (8 * c) * 33 + n;
        u32x4 o; o.x = pk2(s[0 * 33], s[1 * 33]); o.y = pk2(s[2 * 33], s[3 * 33]); o.z = pk2(s[4 * 33], s[5 * 33]); o.w = pk2(s[6 * 33], s[7 * 33]);
        *(u32x4*)(WT + (size_t)(n0 + n) * K + k0 + 8 * c) = o; }
    LDS_WAIT(); asm volatile("" ::: "memory");
}

typedef const __attribute__((address_space(4))) Args* KArgsT;
__device__ __forceinline__ unsigned pk4_fp8(float a, float b, float c, float d) { int p = __builtin_amdgcn_cvt_pk_fp8_f32(clamp8(a), clamp8(b), 0, false); p = __builtin_amdgcn_cvt_pk_fp8_f32(clamp8(c), clamp8(d), p, true); return (unsigned)p; }
__device__ __forceinline__ void transpose_item8(const float* W, int K, int ldw, int ncols, const float* gain, float scale, unsigned char* WT, LAS float* scr, int item, int lane) {
    const int nblk = ncols / 32, kb = item / nblk, nb = item % nblk, k0 = 64 * kb, n0 = 32 * nb;
    const int kr = lane >> 3, nq = (lane & 7) * 4;
    f32x4 v[8];
#pragma unroll
    for (int i = 0; i < 8; ++i) { const float* p = W + (size_t)(k0 + 8 * i + kr) * ldw + n0 + nq; v[i] = (f32x4){p[0], p[1], p[2], p[3]}; }
#pragma unroll
    for (int i = 0; i < 8; ++i) { const int kk = 8 * i + kr; const float g = (gain ? gain[k0 + kk] : 1.0f) * scale; LAS float* d = scr + kk * 33 + nq; d[0] = v[i][0] * g; d[1] = v[i][1] * g; d[2] = v[i][2] * g; d[3] = v[i][3] * g; }
    LDS_WAIT(); asm volatile("" ::: "memory");
    const int c = lane & 7;
#pragma unroll
    for (int j = 0; j < 4; ++j) { const int n = (lane >> 3) + 8 * j; const LAS float* s = scr + (8 * c) * 33 + n;
        u32x2 o; o.x = pk4_fp8(s[0 * 33], s[1 * 33], s[2 * 33], s[3 * 33]); o.y = pk4_fp8(s[4 * 33], s[5 * 33], s[6 * 33], s[7 * 33]);
        *(u32x2*)(WT + (size_t)(n0 + n) * K + k0 + 8 * c) = o; }
    LDS_WAIT(); asm volatile("" ::: "memory");
}
__device__ __forceinline__ void conv_phase(KArgsT ka, int l, LAS unsigned char* lds, int wave0) {
    FRESH_TID(); FRESH_LDS(lds); FRESH_BID();
    unsigned char* ws = ka->ws;
    const float* ln1 = ka->in[1] + (size_t)l * D; const float* w_in = ka->in[2] + (size_t)l * D * PW; const float* w_out = ka->in[5] + (size_t)l * D * D;
    const float* ln2 = ka->in[6] + (size_t)l * D; const float* wq = ka->in[7] + (size_t)l * D * 2048;
    const float* k1 = ka->in[8] + (size_t)l * 8 * 128 * 128; const float* k2 = ka->in[9] + (size_t)l * 8 * 128 * 128;
    const float* pu = ka->in[10] + (size_t)l * NE * D; const float* pv = ka->in[11] + (size_t)l * NE * D;
    bf16_t* WQK = (bf16_t*)(ws + WS_WQK); bf16_t* WOUT = (bf16_t*)(ws + WS_WOUT); bf16_t* WIN = (bf16_t*)(ws + WS_WIN); bf16_t* U16 = (bf16_t*)(ws + WS_U16); bf16_t* V16 = (bf16_t*)(ws + WS_V16);
    {
        LAS float* Ks = (LAS float*)lds;
        LAS float* Ws = (LAS float*)(lds + 128 * 132 * 4);
        for (int it = bid; it < 1024; it += G) {
            const int gi = it >> 6, c0 = (it & 63) * 64;
            const float* key = ((gi & 1) ? k2 : k1) + (size_t)(gi >> 1) * 128 * 128;
            for (int i = tid; i < 4096; i += 512) { const int r = i >> 5, c4 = (i & 31) * 4; *(LAS f32x4*)(Ks + r * 132 + c4) = *(const f32x4*)(key + r * 128 + c4); }
            for (int i = tid; i < 2048; i += 512) { const int r = i >> 5, c4 = (i & 31) * 4; *(LAS f32x4*)(Ws + r * 132 + c4) = *(const f32x4*)(wq + (size_t)(c0 + r) * 2048 + gi * 128 + c4); }
            __syncthreads();
            const int tc = tid & 15, tn = tid >> 4;
            float acc[4][4];
#pragma unroll
            for (int i = 0; i < 4; ++i)
#pragma unroll
                for (int j = 0; j < 4; ++j) acc[i][j] = 0.f;
#pragma unroll 2
            for (int d = 0; d < 128; d += 4) {
                f32x4 kv[4], wv[4];
#pragma unroll
                for (int i = 0; i < 4; ++i) kv[i] = *(const LAS f32x4*)(Ks + (4 * tn + i) * 132 + d);
#pragma unroll
                for (int j = 0; j < 4; ++j) wv[j] = *(const LAS f32x4*)(Ws + (tc + 16 * j) * 132 + d);
#pragma unroll
                for (int i = 0; i < 4; ++i)
#pragma unroll
                    for (int j = 0; j < 4; ++j) acc[i][j] += kv[i][0] * wv[j][0] + kv[i][1] * wv[j][1] + kv[i][2] * wv[j][2] + kv[i][3] * wv[j][3];
            }
#pragma unroll
            for (int j = 0; j < 4; ++j) { const int c = c0 + tc + 16 * j; const float gg = ln2[c];
#pragma unroll
                for (int i = 0; i < 4; ++i) WQK[(size_t)(gi * 128 + 4 * tn + i) * D + c] = (bf16_t)f2bf(acc[i][j] * gg); }
            __syncthreads();
        }
        __syncthreads();
    }
    const int gw = bid * NWAVES + wave, NGW = G * NWAVES;
    {
        unsigned char* U6 = (unsigned char*)U16; unsigned char* V4 = U6 + (size_t)NE * ROW6; float* SCU = (float*)(U6 + 2 * (size_t)NE * ROW6); float* SCV = SCU + NE;
        for (int r = gw; r < NE; r += NGW) {
            const float* us = pu + (size_t)r * D + 16 * lane; const float* vs = pv + (size_t)r * D + 16 * lane;
            f32x4 uu[4][4], vv[4][4];
#pragma unroll
            for (int i = 0; i < 4; ++i)
#pragma unroll
                for (int q = 0; q < 4; ++q) { uu[i][q] = *(const f32x4*)(us + 1024 * i + 4 * q); vv[i][q] = *(const f32x4*)(vs + 1024 * i + 4 * q); }
            float au = 0.f, av = 0.f;
#pragma unroll
            for (int i = 0; i < 4; ++i)
#pragma unroll
                for (int q = 0; q < 4; ++q) { uu[i][q] *= *(const f32x4*)(ln2 + 1024 * i + 16 * lane + 4 * q);
                    au += (uu[i][q][0] * uu[i][q][0] + uu[i][q][1] * uu[i][q][1]) + (uu[i][q][2] * uu[i][q][2] + uu[i][q][3] * uu[i][q][3]);
                    av += (vv[i][q][0] * vv[i][q][0] + vv[i][q][1] * vv[i][q][1]) + (vv[i][q][2] * vv[i][q][2] + vv[i][q][3] * vv[i][q][3]); }
            au = sqrtf(wave_sum_dpp(au) * (1.0f / D)); av = sqrtf(wave_sum_dpp(av) * (1.0f / D));
            const float iu = au > 0.f ? 2.0f / au : 0.f, iv = av > 0.f ? 2.0f / av : 0.f;
            if (lane == 0) { SCU[r] = au * 0.5f; SCV[r] = av * 0.5f; }
            { u32x4* o = (u32x4*)(U6 + (size_t)r * ROW4) + lane; o[0] = pack_fp4(uu[0], uu[1], iu); o[64] = pack_fp4(uu[2], uu[3], iu); }
            { u32x4* o = (u32x4*)(V4 + (size_t)r * ROW4) + lane; o[0] = pack_fp4(vv[0], vv[1], iv); o[64] = pack_fp4(vv[2], vv[3], iv); }
        }
    }
    {
        LAS float* scr = (LAS float*)(lds + wave * 16384);
        constexpr int I_O = (D / 64) * (D / 32), I_IN = (D / 64) * (12288 / 32);
        for (int it = gw; it < I_O + I_IN; it += NGW) {
            if (it < I_O) transpose_item8(w_out, D, D, D, nullptr, US, (unsigned char*)WOUT, scr, it, lane);
            else transpose_item8(w_in, D, PW, 12288, ln1, US, (unsigned char*)WIN, scr, it - I_O, lane);
        }
    }
}

template <bool WITH_F>
__device__ __forceinline__ void prep_phase(const float* X, bf16_t* XB, float* RSTD, const float* w_in, const float* ln1, const float* bf, float* LOGF, LAS unsigned char* lds, int wave0) {
    FRESH_TID(); FRESH_LDS(lds); FRESH_BID();
    LAS unsigned short* gfs = (LAS unsigned short*)lds;
    if (WITH_F) {
        __syncthreads();
        for (int c = tid; c < D; c += 512) { const float g = ln1[c]; const float* wr = w_in + (size_t)c * PW + 12288;
#pragma unroll
            for (int j = 0; j < 10; ++j) gfs[j * D + c] = (unsigned short)f2bf(wr[j] * g); }
        __syncthreads();
    }
    const int gw = bid * NWAVES + wave, NGW = G * NWAVES;
    for (int m = gw; m < M; m += NGW) {
        const f32x4* xr = (const f32x4*)(X + (size_t)m * D) + lane;
        f32x4 v[16]; float ss = 0.f;
#pragma unroll
        for (int i = 0; i < 16; ++i) { v[i] = xr[64 * i]; ss += (v[i][0] * v[i][0] + v[i][1] * v[i][1]) + (v[i][2] * v[i][2] + v[i][3] * v[i][3]); }
        ss = wave_sum_dpp(ss);
        const float rstd = rsqrtf(ss * (1.0f / D) + 1e-6f);
        if (WITH_F) {
            unsigned* o8 = (unsigned*)((unsigned char*)XB + (size_t)m * D) + lane;
#pragma unroll
            for (int i = 0; i < 16; ++i) o8[64 * i] = pk4_fp8(v[i][0], v[i][1], v[i][2], v[i][3]);
        } else {
        u32x2* o = (u32x2*)(XB + (size_t)m * D) + lane;
#pragma unroll
        for (int i = 0; i < 16; ++i) { u32x2 w; w.x = pk2(v[i][0], v[i][1]); w.y = pk2(v[i][2], v[i][3]); o[64 * i] = w; }
        }
        if (lane == 0) RSTD[m] = rstd;
        if (WITH_F) {
            float mine = 0.f;
#pragma unroll 1
            for (int j = 0; j < 10; ++j) { float s = 0.f;
#pragma unroll
                for (int i = 0; i < 16; ++i) { const u32x2 gp = *(const LAS u32x2*)(gfs + j * D + 256 * i + 4 * lane);
                    s += (v[i][0] * bf_lo(gp.x) + v[i][1] * bf_hi(gp.x)) + (v[i][2] * bf_lo(gp.y) + v[i][3] * bf_hi(gp.y)); }
                s = wave_sum_dpp(s); if (lane == j) mine = s; }
            if (lane < 10) { const int b = m >> 11, s = m & 2047; LOGF[(size_t)(b * 10 + lane) * S + s] = logsig(mine * rstd + bf[lane]); }
        }
    }
}


__device__ __forceinline__ void load16_bf16(const bf16_t* p, float (&d)[16]) {
    const u32x4 a = *(const u32x4*)p, b = *(const u32x4*)(p + 8);
#pragma unroll
    for (int q = 0; q < 4; ++q) { d[2 * q] = bf_lo(a[q]); d[2 * q + 1] = bf_hi(a[q]); d[8 + 2 * q] = bf_lo(b[q]); d[8 + 2 * q + 1] = bf_hi(b[q]); }
}
#define RFL(x) __builtin_amdgcn_readfirstlane(x)
template <bool FINAL>
__device__ __forceinline__ void peer_uv_phase(const float* SC, const unsigned char* U6, const unsigned char* V4, const bf16_t* X1, void* XOv, const float* fg,
                                              unsigned char* XB8n, float* RSTDn, float* LOGFn, const float* w_in_n, const float* ln1_n, const float* bf_n, LAS unsigned char* lds, int wave0) {
    FRESH_TID(); FRESH_LDS(lds); FRESH_BID();
    LAS int* s_eid = (LAS int*)(lds + 81920 + wave * 1024); LAS float* s_w = (LAS float*)(lds + 81920 + wave * 1024 + 512); LAS float* s_su = (LAS float*)(lds + 90112 + wave * 512);
    const float* SCU = (const float*)(U6 + 2 * (size_t)NE * ROW6); const float* SCV = SCU + NE;
    LAS unsigned short* gfs = (LAS unsigned short*)lds;
    if (!FINAL) {
        __syncthreads();
        for (int c = tid; c < D; c += 512) { const float g = ln1_n[c]; const float* wr = w_in_n + (size_t)c * PW + 12288;
#pragma unroll
            for (int j = 0; j < 10; ++j) gfs[j * D + c] = (unsigned short)f2bf(wr[j] * g); }
        __syncthreads();
    }
    const int gw = bid * NWAVES + wave, NGW = G * NWAVES;
    for (int tok = gw; tok < M; tok += NGW) {
        const bf16_t* x1 = X1 + (size_t)tok * D;
        i32x8 xq[2]; float rstd_tok;
        { const int sg_ = lane & 15, gp_ = lane >> 4; float t[2][2][16]; float ss_ = 0.f;
#pragma unroll
          for (int s2 = 0; s2 < 2; ++s2)
#pragma unroll
              for (int hf = 0; hf < 2; ++hf) { load16_bf16(x1 + 1024 * (2 * s2 + (gp_ & 1)) + 16 * (sg_ + 32 * hf + 16 * (gp_ >> 1)), t[s2][hf]);
#pragma unroll
                  for (int k = 0; k < 16; ++k) ss_ += t[s2][hf][k] * t[s2][hf][k]; }
          rstd_tok = rsqrtf(wave_sum_dpp(ss_) * (1.0f / D) + 1e-6f);
#pragma unroll
          for (int s2 = 0; s2 < 2; ++s2)
#pragma unroll
              for (int hf = 0; hf < 2; ++hf)
#pragma unroll
                  for (int q = 0; q < 4; ++q) xq[s2][4 * hf + q] = (int)pk4_fp8(t[s2][hf][4 * q] * rstd_tok, t[s2][hf][4 * q + 1] * rstd_tok, t[s2][hf][4 * q + 2] * rstd_tok, t[s2][hf][4 * q + 3] * rstd_tok); }
        const float* sc = SC + (size_t)tok * 2048;
        LAS float* selv = (LAS float*)(lds + 94208 + wave * 512); LAS int* seli = (LAS int*)(lds + 94208 + wave * 512 + 256);
#define BALLOT(c) __builtin_amdgcn_ballot_w64(c)
#define MBCNT(m) ((int)__builtin_amdgcn_mbcnt_hi((unsigned)((m) >> 32), __builtin_amdgcn_mbcnt_lo((unsigned)(m), 0u)))
        for (int h = 0; h < 4; ++h) {
            float x[2][2][2]; unsigned kk[2][2][2];
#pragma unroll
            for (int u = 0; u < 2; ++u)
#pragma unroll
                for (int f = 0; f < 2; ++f)
#pragma unroll
                    for (int r = 0; r < 2; ++r) { const float v = sc[(h + 4 * u) * 256 + f * 128 + r * 64 + lane]; x[u][f][r] = v; kk[u][f][r] = (ordkey(v) & ~127u) | (unsigned)(127 - 64 * r - lane); }
            unsigned T[2][2] = {{0u, 0u}, {0u, 0u}}; int dn = 0;
            for (unsigned bm = 0x80000000u; bm != 0u && dn != 15; bm >>= 1) {
#pragma unroll
                for (int u = 0; u < 2; ++u)
#pragma unroll
                    for (int f = 0; f < 2; ++f) { const unsigned cand = T[u][f] | bm;
                        const int c = __builtin_popcountll(BALLOT(kk[u][f][0] >= cand)) + __builtin_popcountll(BALLOT(kk[u][f][1] >= cand));
                        T[u][f] = c >= 16 ? cand : T[u][f]; dn |= (c == 16) ? (1 << (2 * u + f)) : 0; }
            }
#pragma unroll
            for (int u = 0; u < 2; ++u)
#pragma unroll
                for (int f = 0; f < 2; ++f) { const bool s0 = kk[u][f][0] >= T[u][f], s1 = kk[u][f][1] >= T[u][f]; const unsigned long long m0 = BALLOT(s0), m1 = BALLOT(s1);
                    const int p0 = MBCNT(m0), p1 = __builtin_popcountll(m0) + MBCNT(m1);
                    if (s0) { selv[(2 * u + f) * 16 + (p0 & 15)] = x[u][f][0]; seli[(2 * u + f) * 16 + (p0 & 15)] = lane; }
                    if (s1) { selv[(2 * u + f) * 16 + (p1 & 15)] = x[u][f][1]; seli[(2 * u + f) * 16 + (p1 & 15)] = 64 + lane; } }
            asm volatile("" ::: "memory");
            float s4[2][4]; unsigned k4[2][4];
#pragma unroll
            for (int u = 0; u < 2; ++u) { const float va = selv[(2 * u) * 16 + (lane >> 2)]; const f32x4 vb = *(const LAS f32x4*)(selv + (2 * u + 1) * 16 + (lane & 3) * 4);
#pragma unroll
                for (int q = 0; q < 4; ++q) { s4[u][q] = va + vb[q]; k4[u][q] = (ordkey(s4[u][q]) & ~255u) | (unsigned)(255 - 4 * lane - q); } }
            unsigned T2[2] = {0u, 0u}; int d2 = 0;
            for (unsigned bm = 0x80000000u; bm != 0u && d2 != 3; bm >>= 1) {
#pragma unroll
                for (int u = 0; u < 2; ++u) { const unsigned cand = T2[u] | bm;
                    const int c = (__builtin_popcountll(BALLOT(k4[u][0] >= cand)) + __builtin_popcountll(BALLOT(k4[u][1] >= cand))) + (__builtin_popcountll(BALLOT(k4[u][2] >= cand)) + __builtin_popcountll(BALLOT(k4[u][3] >= cand)));
                    T2[u] = c >= 16 ? cand : T2[u]; d2 |= (c == 16) ? (1 << u) : 0; }
            }
#pragma unroll
            for (int u = 0; u < 2; ++u) {
                const unsigned mk = wave_max_u32(max(max(k4[u][0], k4[u][1]), max(k4[u][2], k4[u][3]))) & ~255u;
                const float mx = __builtin_bit_cast(float, (mk & 0x80000000u) ? (mk & 0x7fffffffu) : ~mk);
                const float cs = 1.4426950408889634f * rstd_tok;
                float p[4], ps = 0.f;
#pragma unroll
                for (int q = 0; q < 4; ++q) { p[q] = (k4[u][q] >= T2[u]) ? __builtin_amdgcn_exp2f((s4[u][q] - mx) * cs) : 0.f; ps += p[q]; }
                const float tot = wave_sum_dpp(ps);
                const int i1 = seli[(2 * u) * 16 + (lane >> 2)]; const u32x4 i2 = *(const LAS u32x4*)(seli + (2 * u + 1) * 16 + (lane & 3) * 4);
                int base = (h + 4 * u) * 16;
#pragma unroll
                for (int q = 0; q < 4; ++q) { const bool sl = k4[u][q] >= T2[u]; const unsigned long long m = BALLOT(sl); const int slot = base + (MBCNT(m) & 15); base += __builtin_popcountll(m);
                    if (sl) { const int e = ((i1 & 127) << 7) | (int)(i2[q] & 127u); s_eid[slot] = e; s_w[slot] = p[q] / tot * SCV[e]; s_su[slot] = SCU[e]; } }
            }
            asm volatile("" ::: "memory");
        }
#undef BALLOT
#undef MBCNT
        LDS_WAIT(); asm volatile("" ::: "memory");
#define LOADROW6(dst, base, e) do { const u32x4* p_ = (const u32x4*)((base) + (size_t)(e) * ROW6) + lane; dst[0] = p_[0]; dst[1] = p_[64]; dst[2] = p_[128]; } while (0)
#define GRP6(row, g) ((g) == 0 ? (u32x6){row[0][0], row[0][1], row[0][2], row[0][3], row[1][0], row[1][1]} : (u32x6){row[1][2], row[1][3], row[2][0], row[2][1], row[2][2], row[2][3]})
        {
#define LOADROW4(dst, base, e) do { const u32x4* p_ = (const u32x4*)((base) + (size_t)(e) * ROW4) + lane; dst[0] = p_[0]; dst[1] = p_[64]; } while (0)
            const bool dg_ = ((lane & 15) >> 2) == (lane >> 4);
#define UDOT4(row, j) do { f32x4 ac_ = {0.f, 0.f, 0.f, 0.f}; \
            ac_ = __builtin_amdgcn_mfma_scale_f32_16x16x128_f8f6f4((i32x8){(int)row[0][0], (int)row[0][1], (int)row[0][2], (int)row[0][3], 0, 0, 0, 0}, xq[0], ac_, 4, 0, 0, 0x7f7f7f7f, 0, 0x7f7f7f7f); \
            ac_ = __builtin_amdgcn_mfma_scale_f32_16x16x128_f8f6f4((i32x8){(int)row[1][0], (int)row[1][1], (int)row[1][2], (int)row[1][3], 0, 0, 0, 0}, xq[1], ac_, 4, 0, 0, 0x7f7f7f7f, 0, 0x7f7f7f7f); \
            asm volatile("" : "+v"(ac_));     \
            const float pv_ = dg_ ? ((lane & 2) ? ((lane & 1) ? ac_[3] : ac_[2]) : ((lane & 1) ? ac_[1] : ac_[0])) : 0.f; \
            const float d_ = wave_sum_dpp(pv_) * s_su[j]; const float ge_ = gelu_erf(d_); if (lane == 0) s_w[j] *= ge_; } while (0)
            u32x4 r0[2], r1[2], r2[2], r3[2], r4[2], r5[2], r6[2], r7[2];
            { const int e_ = RFL(s_eid[0]); LOADROW4(r0, U6, e_); } { const int e_ = RFL(s_eid[1]); LOADROW4(r1, U6, e_); } { const int e_ = RFL(s_eid[2]); LOADROW4(r2, U6, e_); } { const int e_ = RFL(s_eid[3]); LOADROW4(r3, U6, e_); } { const int e_ = RFL(s_eid[4]); LOADROW4(r4, U6, e_); } { const int e_ = RFL(s_eid[5]); LOADROW4(r5, U6, e_); } { const int e_ = RFL(s_eid[6]); LOADROW4(r6, U6, e_); } { const int e_ = RFL(s_eid[7]); LOADROW4(r7, U6, e_); }
            for (int j = 0; j < 120; j += 8) {
                UDOT4(r0, j + 0); { const int e_ = RFL(s_eid[j + 8]); LOADROW4(r0, U6, e_); }
                UDOT4(r1, j + 1); { const int e_ = RFL(s_eid[j + 9]); LOADROW4(r1, U6, e_); }
                UDOT4(r2, j + 2); { const int e_ = RFL(s_eid[j + 10]); LOADROW4(r2, U6, e_); }
                UDOT4(r3, j + 3); { const int e_ = RFL(s_eid[j + 11]); LOADROW4(r3, U6, e_); }
                UDOT4(r4, j + 4); { const int e_ = RFL(s_eid[j + 12]); LOADROW4(r4, U6, e_); }
                UDOT4(r5, j + 5); { const int e_ = RFL(s_eid[j + 13]); LOADROW4(r5, U6, e_); }
                UDOT4(r6, j + 6); { const int e_ = RFL(s_eid[j + 14]); LOADROW4(r6, U6, e_); }
                UDOT4(r7, j + 7); { const int e_ = RFL(s_eid[j + 15]); LOADROW4(r7, U6, e_); }
            }
            UDOT4(r0, 120); UDOT4(r1, 121); UDOT4(r2, 122); UDOT4(r3, 123); UDOT4(r4, 124); UDOT4(r5, 125); UDOT4(r6, 126); UDOT4(r7, 127);
#undef UDOT4
#undef LOADROW4
        }
        LDS_WAIT(); asm volatile("" ::: "memory");
        {
            f32x2 acc2[2][16];
#define ACC(i, k) acc2[(i) >> 1][((i) & 1) * 8 + ((k) >> 1)][(k) & 1]
#pragma unroll
            for (int g = 0; g < 2; ++g)
#pragma unroll
                for (int k = 0; k < 16; ++k) acc2[g][k] = (f32x2){0.f, 0.f};
#define LOADROW4(dst, base, e) do { const u32x4* p_ = (const u32x4*)((base) + (size_t)(e) * ROW4) + lane; dst[0] = p_[0]; dst[1] = p_[64]; } while (0)
#define VACC4(row, j) do { const float w_ = s_w[j]; const f32x2 w2_ = {w_, w_}; _Pragma("unroll") for (int g_ = 0; g_ < 2; ++g_) { \
                u32x4 G_ = row[g_]; asm volatile("" : "+v"(G_)); \
                _Pragma("unroll") for (int k_ = 0; k_ < 4; ++k_) { const unsigned d_ = G_[k_]; \
                    acc2[g_][4 * k_] = __builtin_elementwise_fma(w2_, __builtin_amdgcn_cvt_scalef32_pk_f32_fp4(d_, 1.0f, 0), acc2[g_][4 * k_]); acc2[g_][4 * k_ + 1] = __builtin_elementwise_fma(w2_, __builtin_amdgcn_cvt_scalef32_pk_f32_fp4(d_, 1.0f, 1), acc2[g_][4 * k_ + 1]); \
                    acc2[g_][4 * k_ + 2] = __builtin_elementwise_fma(w2_, __builtin_amdgcn_cvt_scalef32_pk_f32_fp4(d_, 1.0f, 2), acc2[g_][4 * k_ + 2]); acc2[g_][4 * k_ + 3] = __builtin_elementwise_fma(w2_, __builtin_amdgcn_cvt_scalef32_pk_f32_fp4(d_, 1.0f, 3), acc2[g_][4 * k_ + 3]); } \
                asm volatile("" : "+v"(acc2[g_][0]), "+v"(acc2[g_][1]), "+v"(acc2[g_][2]), "+v"(acc2[g_][3]), "+v"(acc2[g_][4]), "+v"(acc2[g_][5]), "+v"(acc2[g_][6]), "+v"(acc2[g_][7]), \
                                  "+v"(acc2[g_][8]), "+v"(acc2[g_][9]), "+v"(acc2[g_][10]), "+v"(acc2[g_][11]), "+v"(acc2[g_][12]), "+v"(acc2[g_][13]), "+v"(acc2[g_][14]), "+v"(acc2[g_][15])); } } while (0)
            u32x4 r0[2], r1[2], r2[2], r3[2], r4[2], r5[2], r6[2], r7[2];
            { const int e_ = RFL(s_eid[0]); LOADROW4(r0, V4, e_); } { const int e_ = RFL(s_eid[1]); LOADROW4(r1, V4, e_); } { const int e_ = RFL(s_eid[2]); LOADROW4(r2, V4, e_); } { const int e_ = RFL(s_eid[3]); LOADROW4(r3, V4, e_); } { const int e_ = RFL(s_eid[4]); LOADROW4(r4, V4, e_); } { const int e_ = RFL(s_eid[5]); LOADROW4(r5, V4, e_); } { const int e_ = RFL(s_eid[6]); LOADROW4(r6, V4, e_); } { const int e_ = RFL(s_eid[7]); LOADROW4(r7, V4, e_); }
            for (int j = 0; j < 120; j += 8) {
                VACC4(r0, j + 0); { const int e_ = RFL(s_eid[j + 8]); LOADROW4(r0, V4, e_); }
                VACC4(r1, j + 1); { const int e_ = RFL(s_eid[j + 9]); LOADROW4(r1, V4, e_); }
                VACC4(r2, j + 2); { const int e_ = RFL(s_eid[j + 10]); LOADROW4(r2, V4, e_); }
                VACC4(r3, j + 3); { const int e_ = RFL(s_eid[j + 11]); LOADROW4(r3, V4, e_); }
                VACC4(r4, j + 4); { const int e_ = RFL(s_eid[j + 12]); LOADROW4(r4, V4, e_); }
                VACC4(r5, j + 5); { const int e_ = RFL(s_eid[j + 13]); LOADROW4(r5, V4, e_); }
                VACC4(r6, j + 6); { const int e_ = RFL(s_eid[j + 14]); LOADROW4(r6, V4, e_); }
                VACC4(r7, j + 7); { const int e_ = RFL(s_eid[j + 15]); LOADROW4(r7, V4, e_); }
            }
            VACC4(r0, 120); VACC4(r1, 121); VACC4(r2, 122); VACC4(r3, 123); VACC4(r4, 124); VACC4(r5, 125); VACC4(r6, 126); VACC4(r7, 127);
#undef VACC4
#undef LOADROW4
            float ss = 0.f;
#pragma unroll
            for (int i = 0; i < 4; ++i) { float t[16]; load16_bf16(x1 + 1024 * i + 16 * lane, t);
#pragma unroll
                for (int k = 0; k < 16; ++k) { ACC(i, k) += t[k]; ss += ACC(i, k) * ACC(i, k); } }
            ss = wave_sum_dpp(ss);
            const float rs = rsqrtf(ss * (1.0f / D) + 1e-6f);
            if (!FINAL) {
#pragma unroll
                for (int i = 0; i < 4; ++i) { u32x4 w8;
#pragma unroll
                    for (int q = 0; q < 4; ++q) w8[q] = pk4_fp8(ACC(i, 4 * q), ACC(i, 4 * q + 1), ACC(i, 4 * q + 2), ACC(i, 4 * q + 3));
                    *(u32x4*)(XB8n + (size_t)tok * D + 1024 * i + 16 * lane) = w8; }
                if (lane == 0) RSTDn[tok] = rs;
                float mine = 0.f;
#pragma unroll 1
                for (int j = 0; j < 10; ++j) { float s = 0.f;
#pragma unroll
                    for (int i = 0; i < 4; ++i) { const u32x4 g0 = *(const LAS u32x4*)(gfs + j * D + 1024 * i + 16 * lane), g1 = *(const LAS u32x4*)(gfs + j * D + 1024 * i + 16 * lane + 8);
#pragma unroll
                        for (int q = 0; q < 4; ++q) { s += ACC(i, 2 * q) * bf_lo(g0[q]) + ACC(i, 2 * q + 1) * bf_hi(g0[q]); s += ACC(i, 8 + 2 * q) * bf_lo(g1[q]) + ACC(i, 8 + 2 * q + 1) * bf_hi(g1[q]); } }
                    s = wave_sum_dpp(s); if (lane == j) mine = s; }
                if (lane < 10) { const int b_ = tok >> 11, s_ = tok & 2047; LOGFn[(size_t)(b_ * 10 + lane) * S + s_] = logsig(mine * rs + bf_n[lane]); }
            }
            if (FINAL) { float* xo = (float*)XOv + (size_t)tok * D;
#pragma unroll
                for (int i = 0; i < 4; ++i)
#pragma unroll
                    for (int q = 0; q < 4; ++q) { const int c = 1024 * i + 16 * lane + 4 * q; const f32x4 g_ = *(const f32x4*)(fg + c);
                        *(f32x4*)(xo + c) = (f32x4){ACC(i, 4 * q) * rs * g_[0], ACC(i, 4 * q + 1) * rs * g_[1], ACC(i, 4 * q + 2) * rs * g_[2], ACC(i, 4 * q + 3) * rs * g_[3]}; }
            } else { bf16_t* xo = (bf16_t*)XOv + (size_t)tok * D;
#pragma unroll
                for (int i = 0; i < 4; ++i) { u32x4 w0, w1;
#pragma unroll
                    for (int q = 0; q < 4; ++q) { w0[q] = pk2(ACC(i, 2 * q), ACC(i, 2 * q + 1)); w1[q] = pk2(ACC(i, 8 + 2 * q), ACC(i, 8 + 2 * q + 1)); }
                    *(u32x4*)(xo + 1024 * i + 16 * lane) = w0; *(u32x4*)(xo + 1024 * i + 16 * lane + 8) = w1; }
            }
        }
        LDS_WAIT(); asm volatile("" ::: "memory");
    }
#undef ACC
#undef LOADROW6
#undef GRP6
}
}
namespace at {
using namespace mk;
constexpr int QB = 256, KVB = 64, HD = 128;
constexpr int SHM_V = KVB * HD * 2, SHM_K = KVB * HD * 2;
constexpr int OFF_V = 0, OFF_K = 2 * SHM_V, OFF_WS = OFF_K + 2 * SHM_K, OFF_CUM = OFF_WS + 8 * 256, OFF_RT = OFF_CUM + 2048 * 4, OFF_MISC = OFF_RT + 640 * 4;
constexpr float LOG2E = 1.4426950408889634f;
constexpr float THR2 = 10.0f;
constexpr float SB_DONE = -100.0f;

#define AT_KSWZ(row, colB) ((row) * 256 + ((colB) ^ (((row) & 7) << 4)))
__device__ __forceinline__ int v_st(int k, int c) { const int kk = (k & ~0xC) | ((k & 4) << 1) | ((k & 8) >> 1); return ((kk >> 3) * 4 + (c >> 5)) * 512 + ((kk & 7) * 32 + (c & 31)) * 2; }
__device__ __forceinline__ int v_rd_base(int lane) { return ((lane & 3) << 3) | (((lane >> 2) & 3) << 6) | (((lane >> 4) & 1) << 5) | (((lane >> 5) & 1) << 8); }
constexpr int v_rd_off(int d0, int ks, int half) { return d0 * 512 + ks * 4096 + half * 2048; }
__device__ __forceinline__ int crow(int r, int hi) { return (r & 3) + 8 * (r >> 2) + 4 * hi; }
__device__ __forceinline__ unsigned cvtpk(float lo, float hi) { unsigned r; asm volatile("v_cvt_pk_bf16_f32 %0, %1, %2" : "=v"(r) : "v"(lo), "v"(hi)); return r; }
__device__ __forceinline__ float partner(float v, int hi) { auto rr = __builtin_amdgcn_permlane32_swap(__builtin_bit_cast(unsigned, v), __builtin_bit_cast(unsigned, v), false, false); return __builtin_bit_cast(float, hi ? rr[0] : rr[1]); }

__device__ __forceinline__ float xchg_max(float v, int hi) { return fmaxf(v, partner(v, hi)); }
__device__ __forceinline__ float xchg_sum(float v, int hi) { return v + partner(v, hi); }

__device__ __forceinline__ void pack_p(const f32x16& p0, const f32x16& p1, bf16x8& pa0, bf16x8& pa1, bf16x8& pa2, bf16x8& pa3) {
#define AT_PK4(P, B_, OUT) do { unsigned a0 = cvtpk(P[B_ + 0], P[B_ + 1]), a1 = cvtpk(P[B_ + 2], P[B_ + 3]); unsigned b0 = cvtpk(P[B_ + 4], P[B_ + 5]), b1 = cvtpk(P[B_ + 6], P[B_ + 7]); \
        auto r0 = __builtin_amdgcn_permlane32_swap(a0, b0, false, false); auto r1 = __builtin_amdgcn_permlane32_swap(a1, b1, false, false); \
        u32x4 w = {r0[0], r1[0], r0[1], r1[1]}; OUT = __builtin_bit_cast(bf16x8, w); } while (0)
    AT_PK4(p0, 0, pa0); AT_PK4(p0, 8, pa1); AT_PK4(p1, 0, pa2); AT_PK4(p1, 8, pa3);
#undef AT_PK4
}
template <int KBUF>
__device__ __forceinline__ void qkt(f32x16& p0, f32x16& p1, LAS unsigned char* K_lds, int r32, int hi, const bf16x8 (&qr)[8]) {
    p0 = f32x16{}; p1 = f32x16{};
    LAS unsigned char* kb[4];
#pragma unroll
    for (int dd = 0; dd < 4; ++dd) kb[dd] = K_lds + KBUF * SHM_K + AT_KSWZ(r32, (dd * 16 + hi * 8) * 2);
#pragma unroll
    for (int d0 = 0; d0 < 8; ++d0) { LAS unsigned char* a = kb[d0 & 3] + (d0 >> 2) * 128;
        const bf16x8 b0 = *(const LAS bf16x8*)a; const bf16x8 b1 = *(const LAS bf16x8*)(a + 32 * 256);
        p0 = __builtin_amdgcn_mfma_f32_32x32x16_bf16(b0, qr[d0], p0, 0, 0, 0);
        p1 = __builtin_amdgcn_mfma_f32_32x32x16_bf16(b1, qr[d0], p1, 0, 0, 0); }
}
template <int VBUF>
__device__ __forceinline__ void pv_tile(f32x16 (&o)[4], int vb0, bf16x8 pa0, bf16x8 pa1, bf16x8 pa2, bf16x8 pa3) {
#define AT_TRRD(dst, off) asm volatile("ds_read_b64_tr_b16 %0, %1 offset:%2" : "=&v"(dst) : "v"(vb0), "i"(off) : "memory")
#define AT_PV_D0(d0) do { s16x4 l0, l1, l2, l3, h0, h1, h2, h3; constexpr int b_ = VBUF * SHM_V + v_rd_off(d0, 0, 0); \
        AT_TRRD(l0, b_); AT_TRRD(h0, b_ + 2048); AT_TRRD(l1, b_ + 4096); AT_TRRD(h1, b_ + 6144); AT_TRRD(l2, b_ + 8192); AT_TRRD(h2, b_ + 10240); AT_TRRD(l3, b_ + 12288); AT_TRRD(h3, b_ + 14336); \
        asm volatile("s_waitcnt lgkmcnt(0)" ::: "memory"); __builtin_amdgcn_sched_barrier(0); \
        o[d0] = __builtin_amdgcn_mfma_f32_32x32x16_bf16(pa0, (bf16x8){l0[0], l0[1], l0[2], l0[3], h0[0], h0[1], h0[2], h0[3]}, o[d0], 0, 0, 0); \
        o[d0] = __builtin_amdgcn_mfma_f32_32x32x16_bf16(pa1, (bf16x8){l1[0], l1[1], l1[2], l1[3], h1[0], h1[1], h1[2], h1[3]}, o[d0], 0, 0, 0); \
        o[d0] = __builtin_amdgcn_mfma_f32_32x32x16_bf16(pa2, (bf16x8){l2[0], l2[1], l2[2], l2[3], h2[0], h2[1], h2[2], h2[3]}, o[d0], 0, 0, 0); \
        o[d0] = __builtin_amdgcn_mfma_f32_32x32x16_bf16(pa3, (bf16x8){l3[0], l3[1], l3[2], l3[3], h3[0], h3[1], h3[2], h3[3]}, o[d0], 0, 0, 0); } while (0)
    AT_PV_D0(0); AT_PV_D0(1); AT_PV_D0(2); AT_PV_D0(3);
#undef AT_PV_D0
#undef AT_TRRD
}

template <int VAR>
__device__ __forceinline__ void attn_item(const bf16_t* Qh, const bf16_t* Kh, const bf16_t* Vh, bf16_t* OB, const float* relb, const float* LOGF, int b, int h, int qb, LAS unsigned char* lds, int tid) {
    const int wid = __builtin_amdgcn_readfirstlane(tid >> 6), lane = tid & 63, r32 = lane & 31, hi = lane >> 5;
    const int g = VAR == 0 ? h : (VAR == 1 ? 12 + h : 22 + h);
    const size_t hb = (size_t)(b * NH + g) * S * HD;
    const bf16_t* Kp = Kh + hb; const bf16_t* Vp = Vh + hb;
    LAS unsigned char* V_lds = lds + OFF_V; LAS unsigned char* K_lds = lds + OFF_K;
    LAS float* wsf = (LAS float*)(lds + OFF_WS) + wid * 64; LAS float* li_l = wsf; LAS float* al_l = wsf + 32;
    LAS float* cumL = (LAS float*)(lds + OFF_CUM); LAS float* Rt = (LAS float*)(lds + OFF_RT); volatile LAS unsigned* flags = (volatile LAS unsigned*)(lds + OFF_MISC);
    const int P0 = qb * QB, qlo = P0 + wid * 32, qpos = qlo + r32;
    int NT, jlo = 0;
    if (VAR == 0) { jlo = 4 * qb - 8; if (jlo < 0) jlo = 0; NT = 4 * qb + 4 - jlo; } else NT = 4 * qb + 4;
    const int cw = 4 * qb + (wid >> 1);
#define AT_KBASE(t) (VAR == 1 ? (4 * qb + 3 - (t)) * KVB : (jlo + (t)) * KVB)
#define AT_ACT(t) (VAR == 0 ? ((jlo + (t)) >= cw - 8 && (jlo + (t)) <= cw) : (VAR == 1 ? (AT_KBASE(t) <= qlo + 30) : (AT_KBASE(t) <= qlo + 31)))
    if (VAR == 0) {
        const float* tab = relb + h * 257;
        for (int j = tid; j < 639; j += 512) { int rel = 575 - j; rel = rel < -128 ? -128 : (rel > 128 ? 128 : rel); Rt[j] = tab[rel + 128] * LOG2E; }
    }
    if (VAR == 2) {
        const float* lf = LOGF + (size_t)(b * 10 + h) * S; const int kend = P0 + QB;
        f32x4 v = (f32x4){0.f, 0.f, 0.f, 0.f};
        if (4 * tid < kend) v = *(const f32x4*)(lf + 4 * tid);
        v[1] += v[0]; v[2] += v[1]; v[3] += v[2];
        float tot = v[3];
#pragma unroll
        for (int o = 1; o < 64; o <<= 1) { const float t_ = lane_read(tot, lane >= o ? lane - o : lane); if (lane >= o) tot += t_; }
        if (lane == 63) li_l[0] = tot;
        __syncthreads();
        float base = tot - v[3];
        for (int w = 0; w < wid; ++w) base += ((LAS float*)(lds + OFF_WS))[w * 64];
        if (4 * tid < kend) *(LAS f32x4*)(cumL + 4 * tid) = (f32x4){(base + v[0]) * LOG2E, (base + v[1]) * LOG2E, (base + v[2]) * LOG2E, (base + v[3]) * LOG2E};
    }
    bf16x8 qr[8];
    { const bf16_t* qp = Qh + hb + (size_t)(qlo + r32) * HD + hi * 8;
#pragma unroll
      for (int d0 = 0; d0 < 8; ++d0) qr[d0] = *(const bf16x8*)(qp + d0 * 16); }
    const int sr = tid >> 4, sc = (tid & 15) * 8, vst0 = v_st(sr, sc), vst1 = v_st(32 + sr, sc), kws = AT_KSWZ(sr, sc * 2);
    const int vb0 = (int)(unsigned)(size_t)V_lds + v_rd_base(lane);
    bf16x8 st_k0, st_k1, st_v0, st_v1;
#define AT_SLOAD(k0) do { const bf16_t* kp_ = Kp + (size_t)((k0) + sr) * HD + sc; const bf16_t* vp_ = Vp + (size_t)((k0) + sr) * HD + sc; \
        st_k0 = *(const bf16x8*)kp_; st_k1 = *(const bf16x8*)(kp_ + 32 * HD); st_v0 = *(const bf16x8*)vp_; st_v1 = *(const bf16x8*)(vp_ + 32 * HD); } while (0)
#define AT_SWRITE(bf) do { *(LAS bf16x8*)(K_lds + (bf) * SHM_K + kws) = st_k0; *(LAS bf16x8*)(K_lds + (bf) * SHM_K + kws + 32 * 256) = st_k1; \
        *(LAS bf16x8*)(V_lds + (bf) * SHM_V + vst0) = st_v0; *(LAS bf16x8*)(V_lds + (bf) * SHM_V + vst1) = st_v1; } while (0)
    AT_SLOAD(AT_KBASE(0)); asm volatile("s_waitcnt vmcnt(0)" ::: "memory"); AT_SWRITE(0);
    __syncthreads();
    float m_reg = -1e30f, l_reg = 0.f, carry = 0.f;
    f32x16 o[4] = {};
#define AT_STEP(BUF, t) do { \
        const bool more_ = (t) + 1 < NT; \
        if (more_) AT_SLOAD(AT_KBASE((t) + 1)); \
        if (AT_ACT(t)) { \
            const int kb_ = AT_KBASE(t); f32x16 p0, p1; bf16x8 pa0, pa1, pa2, pa3; \
            qkt<BUF>(p0, p1, K_lds, r32, hi, qr); \
            tile_math(p0, p1, kb_, pa0, pa1, pa2, pa3); \
            pv_tile<BUF>(o, vb0, pa0, pa1, pa2, pa3); \
        } \
        if (more_) { asm volatile("s_waitcnt vmcnt(0)" ::: "memory"); AT_SWRITE((BUF) ^ 1); } \
        if (VAR == 1) { const bool done_ = __all(carry < SB_DONE); if (lane == 0) flags[((t) & 1) * 8 + wid] = done_ ? 1u : 0u; } \
        __syncthreads(); \
    } while (0)
    auto tile_math = [&](f32x16& p0, f32x16& p1, int kb, bf16x8& pa0, bf16x8& pa1, bf16x8& pa2, bf16x8& pa3) __attribute__((always_inline)) {
        const int dq = qpos - kb - 4 * hi;
        if (VAR == 1) {
            const bool need_mask = kb + 63 >= qlo;
            f32x16 n0, n1;
#pragma unroll
            for (int r = 0; r < 16; ++r) { const float z = p0[r]; const float lp = __builtin_amdgcn_logf(1.0f + __builtin_amdgcn_exp2f(-fabsf(z))); n0[r] = fminf(-z, 0.f) - lp;
                                           const float y = p1[r]; const float lq = __builtin_amdgcn_logf(1.0f + __builtin_amdgcn_exp2f(-fabsf(y))); n1[r] = fminf(-y, 0.f) - lq; }
            if (need_mask) {
#pragma unroll
                for (int r = 0; r < 16; ++r) { const int c = (r & 3) + 8 * (r >> 2);
                    if (dq - c <= 0) { n0[r] = 0.f; p0[r] = -__builtin_inff(); }
                    if (dq - c - 32 <= 0) { n1[r] = 0.f; p1[r] = -__builtin_inff(); } }
            }
            float A[8], Bp[8];
#pragma unroll
            for (int q = 0; q < 4; ++q) { A[q] = (n0[4 * q] + n0[4 * q + 1]) + (n0[4 * q + 2] + n0[4 * q + 3]); A[4 + q] = (n1[4 * q] + n1[4 * q + 1]) + (n1[4 * q + 2] + n1[4 * q + 3]); }
#pragma unroll
            for (int q = 0; q < 8; ++q) Bp[q] = partner(A[q], hi);
            float st = 0.f;
#pragma unroll
            for (int q = 7; q >= 0; --q) {
                const float after = carry + st + (hi == 0 ? Bp[q] : 0.f);
                if (q >= 4) { const int r0 = 4 * (q - 4);
                    float tl = after; p1[r0 + 3] = __builtin_amdgcn_exp2f(p1[r0 + 3] + n1[r0 + 3] + tl); tl += n1[r0 + 3]; p1[r0 + 2] = __builtin_amdgcn_exp2f(p1[r0 + 2] + n1[r0 + 2] + tl); tl += n1[r0 + 2];
                    p1[r0 + 1] = __builtin_amdgcn_exp2f(p1[r0 + 1] + n1[r0 + 1] + tl); tl += n1[r0 + 1]; p1[r0] = __builtin_amdgcn_exp2f(p1[r0] + n1[r0] + tl); }
                else { const int r0 = 4 * q;
                    float tl = after; p0[r0 + 3] = __builtin_amdgcn_exp2f(p0[r0 + 3] + n0[r0 + 3] + tl); tl += n0[r0 + 3]; p0[r0 + 2] = __builtin_amdgcn_exp2f(p0[r0 + 2] + n0[r0 + 2] + tl); tl += n0[r0 + 2];
                    p0[r0 + 1] = __builtin_amdgcn_exp2f(p0[r0 + 1] + n0[r0 + 1] + tl); tl += n0[r0 + 1]; p0[r0] = __builtin_amdgcn_exp2f(p0[r0] + n0[r0] + tl); }
                st += A[q] + Bp[q];
            }
            carry += st;
            pack_p(p0, p1, pa0, pa1, pa2, pa3);
        } else {
            if (VAR == 0) {
                const LAS float* rp = Rt + (575 - (qpos - kb) + 4 * hi);
#pragma unroll
                for (int r = 0; r < 16; ++r) { const int c = (r & 3) + 8 * (r >> 2); p0[r] += rp[c]; p1[r] += rp[c + 32]; }
            } else {
                const LAS float* cp = cumL + kb + 4 * hi;
#pragma unroll
                for (int q = 0; q < 4; ++q) { const f32x4 c0 = *(const LAS f32x4*)(cp + 8 * q), c1 = *(const LAS f32x4*)(cp + 32 + 8 * q);
                    p0[4 * q] -= c0[0]; p0[4 * q + 1] -= c0[1]; p0[4 * q + 2] -= c0[2]; p0[4 * q + 3] -= c0[3];
                    p1[4 * q] -= c1[0]; p1[4 * q + 1] -= c1[1]; p1[4 * q + 2] -= c1[2]; p1[4 * q + 3] -= c1[3]; }
                if (kb + 63 > qlo) {
#pragma unroll
                    for (int r = 0; r < 16; ++r) { const int c = (r & 3) + 8 * (r >> 2);
                        if (dq - c < 0) p0[r] = -__builtin_inff();
                        if (dq - c - 32 < 0) p1[r] = -__builtin_inff(); }
                }
            }
            float pmax = p0[0];
#pragma unroll
            for (int r = 1; r < 16; ++r) pmax = fmaxf(pmax, p0[r]);
#pragma unroll
            for (int r = 0; r < 16; ++r) pmax = fmaxf(pmax, p1[r]);
            pmax = xchg_max(pmax, hi);
            float mn, alpha;
            if (__all(pmax - m_reg <= THR2)) { mn = m_reg; alpha = 1.f; }
            else { mn = fmaxf(m_reg, pmax); alpha = __builtin_amdgcn_exp2f(m_reg - mn); m_reg = mn; }
            float ps = 0.f;
#pragma unroll
            for (int r = 0; r < 16; ++r) { p0[r] = __builtin_amdgcn_exp2f(p0[r] - mn); p1[r] = __builtin_amdgcn_exp2f(p1[r] - mn); ps += p0[r] + p1[r]; }
            ps = xchg_sum(ps, hi);
            l_reg = l_reg * alpha + ps;
            if (__any(alpha < 1.f)) {
                if (hi == 0) al_l[r32] = alpha;
                asm volatile("s_waitcnt lgkmcnt(0)" ::: "memory");
                float av[16];
#pragma unroll
                for (int r = 0; r < 16; ++r) av[r] = al_l[crow(r, hi)];
#pragma unroll
                for (int d = 0; d < 4; ++d)
#pragma unroll
                    for (int r = 0; r < 16; ++r) o[d][r] *= av[r];
            }
            pack_p(p0, p1, pa0, pa1, pa2, pa3);
        }
    };
    for (int t = 0; t < NT; t += 2) {
        AT_STEP(0, t);
        if (VAR == 1) { unsigned all_ = 1u; for (int w = 0; w < 8; ++w) all_ &= flags[(t & 1) * 8 + w]; if (all_) break; }
        if (t + 1 >= NT) break;
        AT_STEP(1, t + 1);
        if (VAR == 1) { unsigned all_ = 1u; for (int w = 0; w < 8; ++w) all_ &= flags[((t + 1) & 1) * 8 + w]; if (all_) break; }
    }
    float rli[16];
    if (VAR != 1) {
        if (hi == 0) li_l[r32] = l_reg;
        asm volatile("s_waitcnt lgkmcnt(0)" ::: "memory");
#pragma unroll
        for (int r = 0; r < 16; ++r) rli[r] = __builtin_amdgcn_rcpf(li_l[crow(r, hi)]);
    }
    unsigned char* Ow8 = (unsigned char*)OB + (size_t)(b * S + qlo) * D + g * HD;
#pragma unroll
    for (int r = 0; r < 16; ++r) { const int orow = crow(r, hi);
#pragma unroll
        for (int d0 = 0; d0 < 4; ++d0) { const float v = VAR != 1 ? o[d0][r] * rli[r] : o[d0][r];
            const float vn = lane_read(v, lane ^ 1);
            if ((r32 & 1) == 0) *(unsigned short*)(Ow8 + (size_t)orow * D + d0 * 32 + r32) = (unsigned short)__builtin_amdgcn_cvt_pk_fp8_f32(clamp8(v * 16.0f), clamp8(vn * 16.0f), 0, false); } }
    __syncthreads();
#undef AT_STEP
#undef AT_SLOAD
#undef AT_SWRITE
#undef AT_KBASE
#undef AT_ACT
}

template <int VAR>
__device__ __forceinline__ void attn_queue(const bf16_t* Qh, const bf16_t* Kh, const bf16_t* Vh, bf16_t* OB, const float* relb, const float* LOGF, unsigned* qhead, LAS unsigned char* lds, int wave0) {
    FRESH_TID(); FRESH_LDS(lds);
    volatile LAS unsigned* qslot = (volatile LAS unsigned*)(lds + OFF_MISC) + 32;
    constexpr int NHV = VAR == 0 ? 12 : 10, NITEMS = 8 * NHV * 8;
    for (;;) {
        if (tid == 0) qslot[0] = __hip_atomic_fetch_add(qhead, 1u, __ATOMIC_RELAXED, __HIP_MEMORY_SCOPE_AGENT);
        __syncthreads();
        const int idx = (int)qslot[0];
        __syncthreads();
        if (idx >= NITEMS) break;
        const int qb = 7 - idx / (8 * NHV), bh = idx % (8 * NHV);
        attn_item<VAR>(Qh, Kh, Vh, OB, relb, LOGF, bh / NHV, bh % NHV, qb, lds, tid);
    }
}
__device__ __forceinline__ void attn_phase(const bf16_t* Qh, const bf16_t* Kh, const bf16_t* Vh, bf16_t* OB, const float* relb, const float* LOGF, unsigned* qheads, LAS unsigned char* lds, int wave0) {
    attn_queue<2>(Qh, Kh, Vh, OB, relb, LOGF, qheads + 0, lds, wave0);
    attn_queue<0>(Qh, Kh, Vh, OB, relb, LOGF, qheads + 64, lds, wave0);
    attn_queue<1>(Qh, Kh, Vh, OB, relb, LOGF, qheads + 128, lds, wave0);
}
}
namespace mk {
#define XB_TMO      128
#define XB_XCNT(j)  (256  + 64 * (j))
#define XB_XSUB(j)  (1280 + 64 * (j))
#define XB_XGEN(j)  (2304 + 64 * (j))
#define XB_TOP      3328
#define XB_TOPGEN   3392
#define XCD_BAR_WORDS 3456
#define XB_SPIN_CAP (1u << 22)

__device__ __forceinline__ unsigned xb_ld(unsigned* p)              { return __hip_atomic_load(p, __ATOMIC_RELAXED, __HIP_MEMORY_SCOPE_AGENT); }
__device__ __forceinline__ unsigned xb_add(unsigned* p, unsigned v) { return __hip_atomic_fetch_add(p, v, __ATOMIC_RELAXED, __HIP_MEMORY_SCOPE_AGENT); }
__device__ __forceinline__ unsigned xb_xcc_id() { return (unsigned)__builtin_amdgcn_s_getreg((3 << 11) | 20) & 0xFu; }
#define XB_SPIN(cond, bar) do { unsigned _sp = 0; while (cond) { __builtin_amdgcn_s_sleep(1); \
    if ((++_sp & 255u) == 0u) { if (xb_ld(&(bar)[XB_TMO])) break; if (_sp > XB_SPIN_CAP) { atomicAdd(&(bar)[XB_TMO], 1u); break; } } } } while (0)

struct XcdBarrier {
    unsigned* bar; unsigned x;
    volatile LAS unsigned* st;
};

__device__ __forceinline__ XcdBarrier xcd_barrier_post(unsigned* bar, volatile LAS unsigned* st, bool is_t0) {
    XcdBarrier b; b.bar = bar; b.x = xb_xcc_id(); b.st = st;
    if (is_t0) (void)xb_add(&bar[XB_XCNT(b.x)], 1u);
    return b;
}
__device__ __forceinline__ void xcd_barrier_complete(unsigned* bar, unsigned x, unsigned& nloc, unsigned& nx) {
    const unsigned G = gridDim.x * gridDim.y * gridDim.z;
    unsigned sum, cnt, mine, sp = 0u;
    for (;;) {
        sum = 0u; cnt = 0u; mine = 0u;
#pragma unroll
        for (unsigned j = 0; j < 16; ++j) { const unsigned c = xb_ld(&bar[XB_XCNT(j)]); sum += c; cnt += (c > 0u) ? 1u : 0u; mine = (j == x) ? c : mine; }
        if (sum == G) break;
        __builtin_amdgcn_s_sleep(1);
        if ((++sp & 255u) == 0u) { if (xb_ld(&bar[XB_TMO])) break; if (sp > XB_SPIN_CAP) { atomicAdd(&bar[XB_TMO], 1u); break; } }
    }
    nloc = mine > 0u ? mine : 1u; nx = cnt > 0u ? cnt : 1u;
}

__device__ __forceinline__ void xcd_barrier(const XcdBarrier& b, bool is_t0) {
    asm volatile("s_waitcnt vmcnt(0)" ::: "memory");
    __syncthreads();
    if (is_t0) {
        unsigned* bar = b.bar;
        __builtin_amdgcn_s_waitcnt(0);
        unsigned nloc = b.st[0], nx = b.st[1];
        if (nloc == 0u) { xcd_barrier_complete(bar, b.x, nloc, nx); b.st[0] = nloc; b.st[1] = nx; }
        const unsigned old = xb_add(&bar[XB_XSUB(b.x)], 1u);
        const unsigned gen = old / nloc;
        if (old + 1u == (gen + 1u) * nloc) {
            __builtin_amdgcn_fence(__ATOMIC_RELEASE, "agent");
            asm volatile("s_waitcnt vmcnt(0)" ::: "memory");
            const unsigned og = xb_add(&bar[XB_TOP], 1u);
            const unsigned tg = og / nx;
            if (og + 1u == (tg + 1u) * nx) xb_add(&bar[XB_TOPGEN], 1u);
            else XB_SPIN(xb_ld(&bar[XB_TOPGEN]) == tg, bar);
            __builtin_amdgcn_fence(__ATOMIC_ACQUIRE, "agent");
            xb_add(&bar[XB_XGEN(b.x)], 1u);
            asm volatile("s_waitcnt vmcnt(0)" ::: "memory");
        } else {
            XB_SPIN(xb_ld(&bar[XB_XGEN(b.x)]) == gen, bar);
            __builtin_amdgcn_fence(__ATOMIC_ACQUIRE, "agent");
            asm volatile("s_waitcnt vmcnt(0)" ::: "memory");
        }
    }
    __syncthreads();
}

constexpr int PH_PER_LAYER = 8;
typedef const __attribute__((address_space(4))) Args* KArgs;
#define KARGS() ({ KArgs p_ = (KArgs)__builtin_amdgcn_kernarg_segment_ptr(); asm volatile("" : "+s"(p_)); p_; })
#define GRID_BAR() do { KArgs k_ = KARGS(); XcdBarrier b_; b_.bar = (unsigned*)(k_->ws + WS_CTL) + CW_BAR; b_.x = xb_xcc_id(); b_.st = (volatile LAS unsigned*)(lds + MISC_OFF) + 8; unsigned z_ = 0u; asm volatile("" : "+v"(z_)); const bool t0_ = (wave0 == 0) && (__builtin_amdgcn_mbcnt_hi(~0u, __builtin_amdgcn_mbcnt_lo(~0u, z_)) == 0u);     xcd_barrier(b_, t0_); } while (0)
__global__ void __launch_bounds__(NWAVES * 64, 2) mk_fwd(Args a_unused) {
    extern __shared__ __attribute__((aligned(16))) unsigned char lds_raw[];
    LAS unsigned char* lds = (LAS unsigned char*)lds_raw;
    const int wave0 = __builtin_amdgcn_readfirstlane((int)threadIdx.x >> 6);
    for (int u = threadIdx.x; u < (LDS_BYTES - LDSCTL_OFF) / 4; u += NWAVES * 64) ((LAS unsigned*)(lds + LDSCTL_OFF))[u] = 0u;
    __syncthreads();
    int lo, hi;
    { KArgs k = KARGS(); lo = k->ph_lo; hi = k->ph_hi;
      if (hi - lo > 1) (void)xcd_barrier_post((unsigned*)(k->ws + WS_CTL) + CW_BAR, (volatile LAS unsigned*)(lds + MISC_OFF) + 8, threadIdx.x == 0); }
#define IN(k) (lo <= (k) && (k) < hi)
#define BOTH(k) (IN(k) && IN((k) + 1))
#pragma unroll
    for (int l = 0; l < 2; ++l) {
        const int pb = PH_PER_LAYER * l;
        if (IN(pb + 0)) { KArgs k = KARGS(); conv_phase(k, l, lds, wave0); }
        if (IN(pb + 1) && l == 0) {
            KArgs k = KARGS(); unsigned char* ws = k->ws;
            const float* xin = k->in[0];
            prep_phase<true>(xin, (bf16_t*)(ws + WS_XB8N), (float*)(ws + WS_RSTD), k->in[2] + (size_t)l * D * PW, k->in[1] + (size_t)l * D, k->in[3] + l * 10, (float*)(ws + WS_LOGF), lds, wave0);
            if (BOTH(pb + 1)) GRID_BAR();
        }
        if (l == 1 && IN(pb + 0) && IN(pb + 2)) GRID_BAR();
        if (IN(pb + 2)) {
            KArgs k = KARGS(); unsigned char* ws = k->ws;
            pg8::Gemm g{(const bf16_t*)(ws + WS_XB8N), (const bf16_t*)(ws + WS_WIN), M, 12288, D}; pg8::StaticOrder So; FRESH_BID(); So.init(M, 12288, G, bid);
            pg8::EpiQKV4 E{(bf16_t*)(ws + WS_Q), (const float*)(ws + WS_RSTD), 0.08838834764831845f * 1.4426950408889634f, US_INV};
            { LAS unsigned char* lds_ = lds; FRESH_LDS(lds_); FRESH_TID(); pg8::gemm_phase<pg8::EpiQKV4, pg8::StaticOrder, true, true, true>(lds_, g, So, E, tid); }
            if (BOTH(pb + 2)) GRID_BAR();
        }
        if (IN(pb + 3)) {
            KArgs k = KARGS(); unsigned char* ws = k->ws;
            at::attn_phase((const bf16_t*)(ws + WS_Q), (const bf16_t*)(ws + WS_K), (const bf16_t*)(ws + WS_V), (bf16_t*)(ws + WS_OB), k->in[4] + (size_t)l * 12 * 257, (const float*)(ws + WS_LOGF),
                           (unsigned*)(ws + WS_CTL) + CW_QUEUE + 256 * l, lds, wave0);
            if (BOTH(pb + 3)) GRID_BAR();
        }
        if (IN(pb + 4)) {
            KArgs k = KARGS(); unsigned char* ws = k->ws;
            pg8::Gemm g{(const bf16_t*)(ws + WS_OB), (const bf16_t*)(ws + WS_WOUT), M, D, D}; pg8::StaticOrder So; FRESH_BID(); So.init(M, D, G, bid);
            if (l == 0) { pg8::EpiResidB16<true> E{k->in[0], US_INV * (1.0f / 16.0f), (bf16_t*)(ws + WS_XB)};
                { LAS unsigned char* lds_ = lds; FRESH_LDS(lds_); FRESH_TID(); pg8::gemm_phase<pg8::EpiResidB16<true>, pg8::StaticOrder, false, true, true>(lds_, g, So, E, tid); } }
            else { pg8::EpiResidB16<false> E{ws + WS_X2, US_INV * (1.0f / 16.0f), (bf16_t*)(ws + WS_XB)};
                { LAS unsigned char* lds_ = lds; FRESH_LDS(lds_); FRESH_TID(); pg8::gemm_phase<pg8::EpiResidB16<false>, pg8::StaticOrder, false, true, true>(lds_, g, So, E, tid); } }
            if (BOTH(pb + 4)) GRID_BAR();
        }
        if (IN(pb + 5)) {
            KArgs k = KARGS(); unsigned char* ws = k->ws;
            pg8::Gemm g{(const bf16_t*)(ws + WS_XB), (const bf16_t*)(ws + WS_WQK), M, 2048, D}; pg8::StaticOrder So; FRESH_BID(); So.init(M, 2048, G, bid);
            pg8::EpiPlainF32<2048> E{(float*)(ws + WS_SC)};
            { LAS unsigned char* lds_ = lds; FRESH_LDS(lds_); FRESH_TID(); pg8::gemm_phase<pg8::EpiPlainF32<2048>, pg8::StaticOrder, true, true>(lds_, g, So, E, tid); }
            if (BOTH(pb + 5)) GRID_BAR();
        }
        if (IN(pb + 6)) {
            KArgs k = KARGS(); unsigned char* ws = k->ws;
            if (l == 0) peer_uv_phase<false>((const float*)(ws + WS_SC), (const unsigned char*)(ws + WS_U16), (const unsigned char*)(ws + WS_U16) + (size_t)NE * ROW6  , (const bf16_t*)(ws + WS_XB), ws + WS_X2, nullptr,
                                             ws + WS_XB8N, (float*)(ws + WS_RSTD), (float*)(ws + WS_LOGF), k->in[2] + (size_t)D * PW, k->in[1] + D, k->in[3] + 10, lds, wave0);
            else peer_uv_phase<true>((const float*)(ws + WS_SC), (const unsigned char*)(ws + WS_U16), (const unsigned char*)(ws + WS_U16) + (size_t)NE * ROW6  , (const bf16_t*)(ws + WS_XB), k->out, k->in[12],
                                     nullptr, nullptr, nullptr, nullptr, nullptr, nullptr, lds, wave0);
            if (BOTH(pb + 7)) GRID_BAR();
        }
    }
#undef IN
#undef BOTH
}

static int g_grid = 0;
static void launch_phases(Args a, int lo, int hi, hipStream_t st) {
    a.ph_lo = lo; a.ph_hi = hi;
    hipLaunchKernelGGL(mk_fwd, dim3(g_grid), dim3(NWAVES * 64), LDS_BYTES, st, a);
}
}

extern "C" void kernel_launch(void* const* d_in, const int* in_sizes, int n_in, void* d_out, int out_size, void* d_ws, size_t ws_size, hipStream_t stream) {
    (void)in_sizes; (void)n_in; (void)out_size;
    using namespace mk;
    if (g_grid == 0) {
        if (ws_size < 2048 * MiB) { fprintf(stderr, "kernel_launch: workspace too small (%zu)\n", ws_size); g_grid = -1; return; }
        if (hipFuncSetAttribute((const void*)mk_fwd, hipFuncAttributeMaxDynamicSharedMemorySize, LDS_BYTES) != hipSuccess) { fprintf(stderr, "kernel_launch: hipFuncSetAttribute failed\n"); g_grid = -1; return; }
        int dev = 0, cus = 0; (void)hipGetDevice(&dev); (void)hipDeviceGetAttribute(&cus, hipDeviceAttributeMultiprocessorCount, dev);
        g_grid = cus > 0 ? cus : 256;
    }
    if (g_grid < 0) return;
    unsigned char* ws = (unsigned char*)d_ws; float* out = (float*)d_out;
    (void)hipMemsetAsync(ws + WS_CTL, 0, CTL_ZERO_BYTES, stream);
    Args a{};
    for (int i = 0; i < 13; ++i) a.in[i] = (const float*)d_in[i];
    a.out = out; a.ws = ws;
    launch_phases(a, 0, 2 * PH_PER_LAYER, stream);
}
```

```cpp
#include <hip/hip_runtime.h>
#include <cstdio>
#include <cstdint>
namespace pg8 {
#define PG8_LAS __attribute__((address_space(3)))
typedef unsigned short bf16_t;
typedef short bf16x8 __attribute__((ext_vector_type(8)));
typedef float f32x4 __attribute__((ext_vector_type(4)));
typedef unsigned u32x4 __attribute__((ext_vector_type(4)));
typedef unsigned u32x2 __attribute__((ext_vector_type(2)));
constexpr int BM = 256, BK = 64, HALF = 128, HTB = HALF * BK * 2  , STAGE_BYTES = 8 * HTB, NXCD = 8, WGM = 8;

__host__ __device__ __forceinline__ int lds_byte(int r, int c) { const int st = (r >> 4) * 2 + (c >> 5), rr = r & 15, cc = c & 31, ob = rr * 64 + cc * 2; return st * 1024 + (ob ^ (((ob >> 9) & 1) << 5)); }
__host__ __device__ __forceinline__ void stage_rc(int b, int& R, int& C) { const int st = b / 1024, sb = b % 1024, swz = sb ^ (((sb >> 9) & 1) << 5); R = (st >> 1) * 16 + swz / 64; C = (st & 1) * 32 + (swz % 64) / 2; }
__host__ __device__ __forceinline__ int perm32(int rho) { const int n = rho >> 4, i = rho & 15; return 8 * (i >> 2) + 4 * n + (i & 3); }

struct Unit { int pm, pn; };
struct Gemm { const bf16_t* A; const bf16_t* Bt; int M, N, K; };

struct StaticOrder {
    int nM, nN, nwg, G, c;
    __host__ __device__ void init(int M, int N, int G_, int c_) { nM = M / BM; nN = N / BM; nwg = nM * nN; G = G_; c = c_; }
    __host__ __device__ bool next(int i, Unit& u) const {
        const long L = (long)i * G + c; if (L >= nwg) return false;
        int wgid = (int)L; { const int q = nwg / NXCD, r = nwg % NXCD, xcd = wgid % NXCD, off = wgid / NXCD; wgid = (xcd < r ? xcd * (q + 1) : r * (q + 1) + (xcd - r) * q) + off; }
        const int nig = WGM * nN, gid = wgid / nig, fm = gid * WGM, gsz = (nM - fm) < WGM ? (nM - fm) : WGM;
        u.pm = fm + ((wgid % nig) % gsz); u.pn = (wgid % nig) / gsz; return true;
    }
    __device__ __forceinline__ void a_ready(const Unit&) const {}
    __device__ __forceinline__ void done(const Unit&) const {}
};
__device__ __forceinline__ unsigned cvt_pk_bf16(float lo, float hi) { unsigned r; asm volatile("v_cvt_pk_bf16_f32 %0, %1, %2" : "=v"(r) : "v"(lo), "v"(hi)); return r; }
typedef float f32x2 __attribute__((ext_vector_type(2)));
__device__ __forceinline__ f32x2 gelu_pk(f32x2 v) {
    const f32x2 av = __builtin_elementwise_abs(v), d = av * 0.2316418882f + 1.0f;
    f32x2 t; t.x = __builtin_amdgcn_rcpf(d.x); t.y = __builtin_amdgcn_rcpf(d.y);
    f32x2 q = t * 0.5307027145f + (-0.7265760135f); q = q * t + 0.7107068705f; q = q * t + (-0.142248368f); q = q * t + 0.127414796f; q = q * t;
    const f32x2 s = (v * v) * (-0.72134752044f);
    f32x2 e; e.x = __builtin_amdgcn_exp2f(s.x); e.y = __builtin_amdgcn_exp2f(s.y);
    const f32x2 m = v * (q * e), r = v - m;
    f32x2 o; o.x = v.x < 0.f ? m.x : r.x; o.y = v.y < 0.f ? m.y : r.y; return o;
}
#define EPI_FRESH_LANE() { unsigned z_ = 0u; asm volatile("" : "+v"(z_)); const int l_ = (int)__builtin_amdgcn_mbcnt_hi(~0u, __builtin_amdgcn_mbcnt_lo(~0u, z_)); fr = l_ & 15; fq = l_ >> 4; }
typedef __amdgpu_buffer_rsrc_t rsrc_t;
__device__ __forceinline__ rsrc_t mkrsrc(const void* p, unsigned bytes) { return __builtin_amdgcn_make_buffer_rsrc((void*)p, (short)0, (int)bytes, 0x00020000); }
template <int LDC> struct EpiPlainF32 {
    static constexpr bool PERM = false, AFTER_DRAIN = false;
    float* C;
    __device__ __forceinline__ void operator()(const f32x4 (&acc)[2][2][4][2], const Unit& u, int wr, int wc, int fr, int fq) const {
        EPI_FRESH_LANE();
        const rsrc_t rc = mkrsrc(C, 16384u * LDC * 4u);
        const int vo = ((wr * 64 + fr) * LDC + wc * 32 + 4 * fq) * 4, so = (u.pm * BM * LDC + u.pn * BM) * 4;
#pragma unroll
        for (int ai = 0; ai < 2; ++ai)
#pragma unroll
            for (int m = 0; m < 4; ++m)
#pragma unroll
                for (int bj = 0; bj < 2; ++bj)
#pragma unroll
                    for (int n = 0; n < 2; ++n) __builtin_amdgcn_raw_buffer_store_b128(__builtin_bit_cast(u32x4, acc[ai][bj][m][n]), rc, vo, so + ((ai * HALF + m * 16) * LDC + bj * HALF + n * 16) * 4, 0);
    }
};
template <int LDC> struct EpiRowScaleF32 {
    static constexpr bool PERM = false, AFTER_DRAIN = false;
    float* C; const float* rs;
    __device__ __forceinline__ void operator()(const f32x4 (&acc)[2][2][4][2], const Unit& u, int wr, int wc, int fr, int fq) const {
        const rsrc_t rc = mkrsrc(C, 16384u * LDC * 4u), rr = mkrsrc(rs, 16384u * 4u);
        const int vo = ((wr * 64 + fr) * LDC + wc * 32 + 4 * fq) * 4, vr = (wr * 64 + fr) * 4;
        const int so = (u.pm * BM * LDC + u.pn * BM) * 4, sr = u.pm * BM * 4;
#pragma unroll
        for (int ai = 0; ai < 2; ++ai)
#pragma unroll
            for (int m = 0; m < 4; ++m) { const float s = __builtin_bit_cast(float, __builtin_amdgcn_raw_buffer_load_b32(rr, vr, sr + (ai * HALF + m * 16) * 4, 0));
#pragma unroll
                for (int bj = 0; bj < 2; ++bj)
#pragma unroll
                    for (int n = 0; n < 2; ++n) { const f32x4 v = acc[ai][bj][m][n] * s; __builtin_amdgcn_raw_buffer_store_b128(__builtin_bit_cast(u32x4, v), rc, vo, so + ((ai * HALF + m * 16) * LDC + bj * HALF + n * 16) * 4, 0); } }
    }
};
template <bool BASE_F32> struct EpiResidB16 {
    static constexpr bool PERM = false, AFTER_DRAIN = false;
    const void* base; float ascale; bf16_t* xb;
    __device__ __forceinline__ void operator()(const f32x4 (&acc)[2][2][4][2], const Unit& u, int wr, int wc, int fr, int fq) const {
        EPI_FRESH_LANE();
        constexpr int LDC = 4096;
        const rsrc_t rb = mkrsrc(base, 16384u * LDC * (BASE_F32 ? 4u : 2u)), rx = mkrsrc(xb, 16384u * LDC * 2u);
        const int vo = ((wr * 64 + fr) * LDC + wc * 32 + 4 * fq) * 2;
        const int so = (u.pm * BM * LDC + u.pn * BM) * 2;
        f32x4 ra[2][2], rb2[2][2];
#define EPI_LD(dst, g_) do { _Pragma("unroll") for (int bj = 0; bj < 2; ++bj) _Pragma("unroll") for (int n = 0; n < 2; ++n) { \
            const int o = so + ((((g_) >> 2) * HALF + ((g_) & 3) * 16) * LDC + bj * HALF + n * 16) * 2; \
            if constexpr (BASE_F32) dst[bj][n] = __builtin_bit_cast(f32x4, __builtin_amdgcn_raw_buffer_load_b128(rb, vo * 2, o * 2, 0)); \
            else { const u32x2 t_ = __builtin_amdgcn_raw_buffer_load_b64(rb, vo, o, 0); dst[bj][n] = (f32x4){__builtin_bit_cast(float, t_.x << 16), __builtin_bit_cast(float, t_.x & 0xffff0000u), __builtin_bit_cast(float, t_.y << 16), __builtin_bit_cast(float, t_.y & 0xffff0000u)}; } } } while (0)
#define EPI_ST(src, g_) do { _Pragma("unroll") for (int bj = 0; bj < 2; ++bj) _Pragma("unroll") for (int n = 0; n < 2; ++n) { \
            const int o = so + ((((g_) >> 2) * HALF + ((g_) & 3) * 16) * LDC + bj * HALF + n * 16) * 2; \
            const f32x4 v = src[bj][n] + acc[(g_) >> 2][bj][(g_) & 3][n] * ascale; \
            u32x2 w; w.x = cvt_pk_bf16(v[0], v[1]); w.y = cvt_pk_bf16(v[2], v[3]); __builtin_amdgcn_raw_buffer_store_b64(w, rx, vo, o, 0); } } while (0)
        EPI_LD(ra, 0);
        EPI_LD(rb2, 1); EPI_ST(ra, 0);
        EPI_LD(ra, 2); EPI_ST(rb2, 1);
        EPI_LD(rb2, 3); EPI_ST(ra, 2);
        EPI_LD(ra, 4); EPI_ST(rb2, 3);
        EPI_LD(rb2, 5); EPI_ST(ra, 4);
        EPI_LD(ra, 6); EPI_ST(rb2, 5);
        EPI_LD(rb2, 7); EPI_ST(ra, 6);
        EPI_ST(rb2, 7);
#undef EPI_LD
#undef EPI_ST
    }
};
struct EpiQKV {
    static constexpr bool PERM = true, AFTER_DRAIN = false;
    bf16_t* Q; const float* rs; float qscale;
    __device__ __forceinline__ void operator()(const f32x4 (&acc)[2][2][4][2], const Unit& u, int wr, int wc, int fr, int fq) const {
        const rsrc_t rq = mkrsrc(Q, 3u * 16384u * 4096u * 2u), rr = mkrsrc(rs, 16384u * 4u);
        const int colt = u.pn * BM, which = colt >> 12, cw = colt & 4095, gt = cw >> 7;
        const int b = (u.pm * BM) >> 11, st = (u.pm * BM) & 2047;
        const float sc = which == 0 ? qscale : 1.f;
        const int so = (int)(((unsigned)which << 26) + (((unsigned)(b * 32 + gt) * 2048u + (unsigned)st) << 7)) * 2;
        const int vo = (((wr * 64 + fr) << 7) + wc * 32 + 8 * fq) * 2, vr = (wr * 64 + fr) * 4, sr = u.pm * BM * 4;
#pragma unroll
        for (int ai = 0; ai < 2; ++ai)
#pragma unroll
            for (int m = 0; m < 4; ++m) { const float f = sc * __builtin_bit_cast(float, __builtin_amdgcn_raw_buffer_load_b32(rr, vr, sr + (ai * HALF + m * 16) * 4, 0));
#pragma unroll
                for (int bj = 0; bj < 2; ++bj) {
                    const f32x4 v0 = acc[ai][bj][m][0] * f, v1 = acc[ai][bj][m][1] * f;
                    u32x4 w; w.x = cvt_pk_bf16(v0[0], v0[1]); w.y = cvt_pk_bf16(v0[2], v0[3]); w.z = cvt_pk_bf16(v1[0], v1[1]); w.w = cvt_pk_bf16(v1[2], v1[3]);
                    __builtin_amdgcn_raw_buffer_store_b128(w, rq, vo, so + ((bj * 2048 + ai * HALF + m * 16) << 7) * 2, 0); } }
    }
};

struct EpiQKV4 {
    static constexpr bool PERM = false, AFTER_DRAIN = false;
    bf16_t* Q; const float* rs; float qscale, wscale;
    __device__ __forceinline__ void operator()(const f32x4 (&acc)[2][2][4][2], const Unit& u, int wr, int wc, int fr, int fq) const {
        EPI_FRESH_LANE();
        const rsrc_t rq = mkrsrc(Q, 3u * 16384u * 4096u * 2u), rr = mkrsrc(rs, 16384u * 4u);
        const int colt = u.pn * BM, which = colt >> 12, cw = colt & 4095, gt = cw >> 7;
        const int b = (u.pm * BM) >> 11, st = (u.pm * BM) & 2047;
        const float sc = (which == 0 ? qscale : 1.f) * wscale;
        const int so = (int)(((unsigned)which << 26) + (((unsigned)(b * 32 + gt) * 2048u + (unsigned)st) << 7)) * 2;
        const int vo = (((wr * 64 + fr) << 7) + wc * 32 + 4 * fq) * 2, vr = (wr * 64 + fr) * 4, sr = u.pm * BM * 4;
        unsigned rsv[2][4];
#pragma unroll
        for (int ai = 0; ai < 2; ++ai)
#pragma unroll
            for (int m = 0; m < 4; ++m) rsv[ai][m] = __builtin_amdgcn_raw_buffer_load_b32(rr, vr, sr + (ai * HALF + m * 16) * 4, 0);
#pragma unroll
        for (int ai = 0; ai < 2; ++ai)
#pragma unroll
            for (int m = 0; m < 4; ++m) { const float f = sc * __builtin_bit_cast(float, rsv[ai][m]);
#pragma unroll
                for (int bj = 0; bj < 2; ++bj)
#pragma unroll
                    for (int n = 0; n < 2; ++n) { const f32x4 v0 = acc[ai][bj][m][n] * f; u32x2 w; w.x = cvt_pk_bf16(v0[0], v0[1]); w.y = cvt_pk_bf16(v0[2], v0[3]);
                        __builtin_amdgcn_raw_buffer_store_b64(w, rq, vo, so + (((bj * 2048 + ai * HALF + m * 16) << 7) + n * 16) * 2, 0); } }
    }
};

typedef int i32x8 __attribute__((ext_vector_type(8)));
template <bool F8> struct FragT { typedef bf16x8 type; };
template <> struct FragT<true> { typedef i32x8 type; };
__device__ __forceinline__ f32x4 mma_bf16(bf16x8 a, bf16x8 b, f32x4 c) { return __builtin_amdgcn_mfma_f32_16x16x32_bf16(a, b, c, 0, 0, 0); }
__device__ __forceinline__ f32x4 mma_bf16(i32x8, i32x8, f32x4 c) { return c; }
template <class Epi, class Sched, bool ALIGN_EPI = false, bool SP2 = false, bool F8 = false>
__device__ __forceinline__ void gemm_phase(PG8_LAS unsigned char* lds, const Gemm g, const Sched& S, const Epi& E, int tid_in) {
    int tid_ = tid_in;
    const int tid = tid_, wid = __builtin_amdgcn_readfirstlane(tid >> 6), lane = tid & 63, wr = wid >> 2, wc = wid & 3, fr = lane & 15, fq = lane >> 4;
    constexpr int EB = F8 ? 1 : 2;
    constexpr int K = 4096; constexpr int nt = (K * EB) / (BK * 2);
    unsigned voffA[2], voffB[2];
#pragma unroll
    for (int i = 0; i < 2; ++i) { int R, C; stage_rc(tid * 16 + i * 8192, R, C); const int Rb = Epi::PERM ? ((R & ~31) + perm32(R & 31)) : R;
        voffA[i] = (unsigned)(R * K * EB + C * 2); voffB[i] = (unsigned)(Rb * K * EB + C * 2); }
    const size_t kstep = (size_t)(BK * 2);
    const size_t hstep = (size_t)HALF * K * EB;
    const size_t tstep = 2 * hstep;
    const unsigned ldsw = (unsigned)wid * 1024u;
    const int aoff = F8 ? lds_byte(wr * 64 + fr, fq * 16) + (fq & 1) * 16 : lds_byte(wr * 64 + fr, fq * 8), boff = F8 ? lds_byte(wc * 32 + fr, fq * 16) + (fq & 1) * 16 : lds_byte(wc * 32 + fr, fq * 8);
    const int aoff1 = aoff + (F8 ? 16 - 32 * (fq & 1) : 0);
    const int f8o0_unused = 0; (void)f8o0_unused;
#define PG8_SA(b, h) (((b) * 2 + (h)) * HTB)
#define PG8_SB(b, h) ((4 + (b) * 2 + (h)) * HTB)
#define PG8_STAGE_X(bufoff, gbase, voff, rs_, base_) do { const int so_ = (int)((const char*)(gbase) - (const char*)(base_)); _Pragma("unroll") for (int _i = 0; _i < 2; ++_i) \
        __builtin_amdgcn_raw_ptr_buffer_load_lds(rs_, (PG8_LAS void*)(lds + (bufoff) + ldsw + _i * 8192), 16, (int)(voff)[_i], so_, 0, 0); } while (0)
#define PG8_LDA(dst, b, h) do { if constexpr (F8) { _Pragma("unroll") for (int m = 0; m < 4; ++m) { const u32x4 lo_ = *(const PG8_LAS u32x4*)(lds + PG8_SA(b, h) + aoff + m * 2048), hi_ = *(const PG8_LAS u32x4*)(lds + PG8_SA(b, h) + aoff1 + m * 2048); \
            dst[m][0] = (i32x8){(int)lo_[0], (int)lo_[1], (int)lo_[2], (int)lo_[3], (int)hi_[0], (int)hi_[1], (int)hi_[2], (int)hi_[3]}; } } \
        else { _Pragma("unroll") for (int m = 0; m < 4; ++m) _Pragma("unroll") for (int k = 0; k < 2; ++k) dst[m][k] = *(const PG8_LAS frag_t*)(lds + PG8_SA(b, h) + aoff + m * 2048 + k * 1024); } } while (0)
#define PG8_LDB(dst, b, h) do { if constexpr (F8) { _Pragma("unroll") for (int n = 0; n < 2; ++n) { const u32x4 lo_ = *(const PG8_LAS u32x4*)(lds + PG8_SB(b, h) + boff + n * 2048), hi_ = *(const PG8_LAS u32x4*)(lds + PG8_SB(b, h) + boff + (aoff1 - aoff) + n * 2048); \
            dst[n][0] = (i32x8){(int)lo_[0], (int)lo_[1], (int)lo_[2], (int)lo_[3], (int)hi_[0], (int)hi_[1], (int)hi_[2], (int)hi_[3]}; } } \
        else { _Pragma("unroll") for (int n = 0; n < 2; ++n) _Pragma("unroll") for (int k = 0; k < 2; ++k) dst[n][k] = *(const PG8_LAS frag_t*)(lds + PG8_SB(b, h) + boff + n * 2048 + k * 1024); } } while (0)
#define PG8_MMA(ai, bj, At, Bt) do { __builtin_amdgcn_s_setprio(1); _Pragma("unroll") for (int m = 0; m < 4; ++m) _Pragma("unroll") for (int n = 0; n < 2; ++n) { \
        if constexpr (F8) acc[ai][bj][m][n] = __builtin_amdgcn_mfma_scale_f32_16x16x128_f8f6f4(Bt[n][0], At[m][0], acc[ai][bj][m][n], 0, 0, 0, 0x7f7f7f7f, 0, 0x7f7f7f7f); \
        else { _Pragma("unroll") for (int k = 0; k < 2; ++k) acc[ai][bj][m][n] = mma_bf16(Bt[n][k], At[m][k], acc[ai][bj][m][n]); } } __builtin_amdgcn_s_setprio(0); } while (0)
#define PG8_WAIT_V(n) asm volatile("s_waitcnt vmcnt(" #n ")" ::: "memory")
#define PG8_WAIT_L(n) asm volatile("s_waitcnt lgkmcnt(" #n ")" ::: "memory")
#define PG8_BAR __builtin_amdgcn_s_barrier()
#define PG8_SCHED __builtin_amdgcn_sched_barrier(0)
    const __amdgpu_buffer_rsrc_t rsA = __builtin_amdgcn_make_buffer_rsrc((void*)g.A, (short)0, (int)((size_t)g.M * K * EB), 0x00020000), rsB = __builtin_amdgcn_make_buffer_rsrc((void*)g.Bt, (short)0, (int)((size_t)g.N * K * EB), 0x00020000);
    Unit cur, nxt; int ui = 0;
    if (!S.next(0, cur)) return;
    f32x4 acc[2][2][4][2];
#pragma unroll
    for (int a = 0; a < 2; ++a)
#pragma unroll
        for (int b = 0; b < 2; ++b)
#pragma unroll
            for (int m = 0; m < 4; ++m)
#pragma unroll
                for (int n = 0; n < 2; ++n) acc[a][b][m][n] = (f32x4){0.f, 0.f, 0.f, 0.f};
    typedef typename FragT<F8>::type frag_t;
    frag_t At[4][F8 ? 1 : 2], B0[2][F8 ? 1 : 2], B1[2][F8 ? 1 : 2];
    const char* cA = (const char*)g.A + (size_t)cur.pm * tstep; const char* cB = (const char*)g.Bt + (size_t)cur.pn * tstep;
    S.a_ready(cur);
    if constexpr (SP2) {
        PG8_STAGE_X(PG8_SB(0, 0), cB, voffB, rsB, g.Bt); PG8_STAGE_X(PG8_SB(0, 1), cB + hstep, voffB, rsB, g.Bt); PG8_STAGE_X(PG8_SA(0, 0), cA, voffA, rsA, g.A); PG8_STAGE_X(PG8_SA(0, 1), cA + hstep, voffA, rsA, g.A);
        if (wr == 1) PG8_BAR;
        PG8_WAIT_V(2); PG8_BAR;
        PG8_STAGE_X(PG8_SB(1, 0), cB + kstep, voffB, rsB, g.Bt); PG8_STAGE_X(PG8_SA(1, 0), cA + kstep, voffA, rsA, g.A); PG8_STAGE_X(PG8_SB(1, 1), cB + hstep + kstep, voffB, rsB, g.Bt);
        PG8_WAIT_V(6); PG8_BAR;
    } else {
        PG8_STAGE_X(PG8_SB(0, 0), cB, voffB, rsB, g.Bt); PG8_STAGE_X(PG8_SA(0, 0), cA, voffA, rsA, g.A); PG8_STAGE_X(PG8_SB(0, 1), cB + hstep, voffB, rsB, g.Bt); PG8_STAGE_X(PG8_SA(0, 1), cA + hstep, voffA, rsA, g.A);
        if (wr == 1) PG8_BAR;
        PG8_WAIT_V(4); PG8_BAR;
        PG8_STAGE_X(PG8_SB(1, 0), cB + kstep, voffB, rsB, g.Bt); PG8_STAGE_X(PG8_SA(1, 0), cA + kstep, voffA, rsA, g.A); PG8_STAGE_X(PG8_SB(1, 1), cB + hstep + kstep, voffB, rsB, g.Bt);
        PG8_WAIT_V(6); PG8_BAR;
    }
    for (;;) {
        const bool has_next = S.next(ui + 1, nxt);
        const char* nA = has_next ? (const char*)g.A + (size_t)nxt.pm * tstep : cA; const char* nB = has_next ? (const char*)g.Bt + (size_t)nxt.pn * tstep : cB;
        for (int t = 0; t < nt; t += 2) {
            const bool last = (t == nt - 2);
            const char* a1 = cA + (size_t)(t + 1) * kstep;
            const char* a2 = last ? nA : cA + (size_t)(t + 2) * kstep; const char* b2 = last ? nB : cB + (size_t)(t + 2) * kstep;
            const char* a3 = a2 + kstep; const char* b3 = b2 + kstep;
            if (last && has_next) S.a_ready(nxt);
            if constexpr (SP2) {
            PG8_LDB(B0, 0, 0); PG8_LDB(B1, 0, 1); PG8_SCHED; PG8_LDA(At, 0, 0); PG8_STAGE_X(PG8_SA(1, 1), a1 + hstep, voffA, rsA, g.A);
            PG8_WAIT_V(8); PG8_WAIT_L(0); PG8_BAR; PG8_MMA(0, 0, At, B0); PG8_MMA(0, 1, At, B1); PG8_BAR; PG8_SCHED;
            PG8_LDA(At, 0, 1); PG8_STAGE_X(PG8_SB(0, 0), b2, voffB, rsB, g.Bt); PG8_STAGE_X(PG8_SB(0, 1), b2 + hstep, voffB, rsB, g.Bt); PG8_STAGE_X(PG8_SA(0, 0), a2, voffA, rsA, g.A);
            PG8_WAIT_V(8); PG8_WAIT_L(0); PG8_BAR; PG8_MMA(1, 0, At, B0); PG8_MMA(1, 1, At, B1); PG8_BAR; PG8_SCHED;
            PG8_LDB(B0, 1, 0); PG8_LDB(B1, 1, 1); PG8_SCHED; PG8_LDA(At, 1, 0); PG8_STAGE_X(PG8_SA(0, 1), a2 + hstep, voffA, rsA, g.A);
            PG8_WAIT_V(8); PG8_WAIT_L(0); PG8_BAR; PG8_MMA(0, 0, At, B0); PG8_MMA(0, 1, At, B1); PG8_BAR; PG8_SCHED;
            PG8_LDA(At, 1, 1); PG8_STAGE_X(PG8_SB(1, 0), b3, voffB, rsB, g.Bt); PG8_STAGE_X(PG8_SB(1, 1), b3 + hstep, voffB, rsB, g.Bt); PG8_STAGE_X(PG8_SA(1, 0), a3, voffA, rsA, g.A);
            PG8_WAIT_V(8); PG8_WAIT_L(0); PG8_BAR; PG8_MMA(1, 0, At, B0); PG8_MMA(1, 1, At, B1); PG8_BAR; PG8_SCHED;
            } else {
            PG8_LDB(B0, 0, 0); PG8_SCHED; PG8_LDA(At, 0, 0); PG8_STAGE_X(PG8_SA(1, 1), a1 + hstep, voffA, rsA, g.A);
            PG8_WAIT_L(8); PG8_BAR; PG8_WAIT_L(0); PG8_MMA(0, 0, At, B0); PG8_BAR; PG8_SCHED;
            PG8_LDB(B1, 0, 1); PG8_STAGE_X(PG8_SB(0, 0), b2, voffB, rsB, g.Bt);
            PG8_BAR; PG8_WAIT_L(0); PG8_MMA(0, 1, At, B1); PG8_BAR;
            PG8_LDA(At, 0, 1); PG8_STAGE_X(PG8_SA(0, 0), a2, voffA, rsA, g.A);
            PG8_BAR; PG8_WAIT_L(0); PG8_MMA(1, 0, At, B0); PG8_BAR; PG8_SCHED;
            PG8_STAGE_X(PG8_SB(0, 1), b2 + hstep, voffB, rsB, g.Bt);
            PG8_WAIT_V(6); PG8_BAR; PG8_MMA(1, 1, At, B1); PG8_BAR;
            PG8_LDB(B0, 1, 0); PG8_SCHED; PG8_LDA(At, 1, 0); PG8_STAGE_X(PG8_SA(0, 1), a2 + hstep, voffA, rsA, g.A);
            PG8_WAIT_L(8); PG8_BAR; PG8_WAIT_L(0); PG8_MMA(0, 0, At, B0); PG8_BAR; PG8_SCHED;
            PG8_LDB(B1, 1, 1); PG8_STAGE_X(PG8_SB(1, 0), b3, voffB, rsB, g.Bt);
            PG8_BAR; PG8_WAIT_L(0); PG8_MMA(0, 1, At, B1); PG8_BAR;
            PG8_LDA(At, 1, 1); PG8_STAGE_X(PG8_SA(1, 0), a3, voffA, rsA, g.A);
            PG8_BAR; PG8_WAIT_L(0); PG8_MMA(1, 0, At, B0); PG8_BAR; PG8_SCHED;
            PG8_STAGE_X(PG8_SB(1, 1), b3 + hstep, voffB, rsB, g.Bt);
            PG8_WAIT_V(6); PG8_BAR; PG8_MMA(1, 1, At, B1); PG8_BAR;
            }
        }
        if constexpr (ALIGN_EPI) { if (wr == 0) PG8_BAR; }
        if constexpr (!Epi::AFTER_DRAIN) { E(acc, cur, wr, wc, fr, fq); S.done(cur); }
        if (!has_next) break;
#pragma unroll
        for (int a = 0; a < 2; ++a)
#pragma unroll
            for (int b = 0; b < 2; ++b)
#pragma unroll
                for (int m = 0; m < 4; ++m)
#pragma unroll
                    for (int n = 0; n < 2; ++n) acc[a][b][m][n] = (f32x4){0.f, 0.f, 0.f, 0.f};
        cur = nxt; cA = nA; cB = nB; ++ui;
        if constexpr (ALIGN_EPI) { if (wr == 1) PG8_BAR; }
    }
    PG8_WAIT_V(0);
    if constexpr (!ALIGN_EPI) { if (wr == 0) PG8_BAR; }
    PG8_BAR;
    if constexpr (Epi::AFTER_DRAIN) { E.fused(acc, cur, wr, wc, fr, fq, lds, wid, lane); S.done(cur); }
#undef PG8_SA
#undef PG8_SB
#undef PG8_STAGE_X
#undef PG8_LDA
#undef PG8_LDB
#undef PG8_MMA
#undef PG8_WAIT_V
#undef PG8_WAIT_L
#undef PG8_BAR
#undef PG8_SCHED
}
}
#define GAS __attribute__((address_space(1)))
#define LAS __attribute__((address_space(3)))
typedef unsigned short bf16_t;
typedef unsigned u32x4 __attribute__((ext_vector_type(4)));
typedef unsigned u32x2 __attribute__((ext_vector_type(2)));
typedef float f32x4 __attribute__((ext_vector_type(4)));
typedef float f32x2 __attribute__((ext_vector_type(2)));
typedef float f32x16 __attribute__((ext_vector_type(16)));
typedef short bf16x8 __attribute__((ext_vector_type(8)));
typedef short s16x4 __attribute__((ext_vector_type(4)));
typedef __bf16 bf16x2_t __attribute__((ext_vector_type(2)));
typedef unsigned u32x6 __attribute__((ext_vector_type(6)));
typedef int i32x8 __attribute__((ext_vector_type(8)));
typedef unsigned u32x16 __attribute__((ext_vector_type(16)));
typedef float f32x32 __attribute__((ext_vector_type(32)));
typedef _Float16 f16x32 __attribute__((ext_vector_type(32)));
typedef _Float16 f16x2 __attribute__((ext_vector_type(2)));

namespace mk {
constexpr int M = 16384, D = 4096, S = 2048, NB = 8, PW = 12298, NH = 32, NE = 16384;
constexpr int NWAVES = 8;
constexpr size_t MiB = 1u << 20;
constexpr size_t WS_CTL = 0, CTL_ZERO_BYTES = 1 * MiB;
constexpr size_t WS_RSTD = 2 * MiB, WS_LOGF = 3 * MiB, WS_WQK = 4 * MiB, WS_WOUT = 20 * MiB, WS_WIN = 52 * MiB, WS_U16 = 148 * MiB, WS_V16 = 276 * MiB,
                 WS_XB = 404 * MiB, WS_Q = 532 * MiB, WS_K = 660 * MiB, WS_V = 788 * MiB, WS_OB = 916 * MiB, WS_X2 = 1792 * MiB, WS_END = 2048 * MiB;
constexpr size_t WS_XB8N = WS_OB + 64 * MiB;
constexpr size_t WS_SC = WS_Q;
constexpr int CW_BAR = 4096;
constexpr int CW_QUEUE = 16384;
constexpr int RING_BYTES = 131072, LDSCTL_OFF = RING_BYTES, MISC_OFF = LDSCTL_OFF + 320, LDS_BYTES = 147456;

struct Args { const float* in[13]; float* out; unsigned char* ws; int ph_lo, ph_hi; };

__device__ __forceinline__ unsigned f2bf(float f) { unsigned u = __builtin_bit_cast(unsigned, f); return (u + 0x7fffu + ((u >> 16) & 1u)) >> 16; }
__device__ __forceinline__ unsigned pk2(float lo, float hi) { return f2bf(lo) | (f2bf(hi) << 16); }
__device__ __forceinline__ float bf_lo(unsigned w) { return __builtin_bit_cast(float, w << 16); }
__device__ __forceinline__ float bf_hi(unsigned w) { return __builtin_bit_cast(float, w & 0xffff0000u); }
__device__ __forceinline__ float lane_read(float v, int src_lane) { return __builtin_bit_cast(float, __builtin_amdgcn_ds_bpermute(src_lane << 2, __builtin_bit_cast(int, v))); }
__device__ __forceinline__ int lane_read(int v, int src_lane) { return __builtin_amdgcn_ds_bpermute(src_lane << 2, v); }
constexpr float US = 1024.0f, VS = 32.0f, US_INV = 1.0f / 1024.0f, VS_INV = 1.0f / 32.0f;
constexpr int ROW6 = 3072;
__device__ __forceinline__ unsigned q_e2m3(float x, float inv) {
    const float a = fminf(fabsf(x) * inv, 7.5f);
    const float c = a < 2.0f ? __builtin_rintf(a * 8.0f) : (a < 4.0f ? __builtin_rintf(a * 4.0f) + 8.0f : __builtin_rintf(a * 2.0f) + 16.0f);
    return (unsigned)(int)c | ((__builtin_bit_cast(unsigned, x) >> 26) & 32u);
}
__device__ __forceinline__ u32x6 pack_fp6(const f32x4 (&a0)[4], const f32x4 (&a1)[4], float inv) {
    unsigned o[6];
#pragma unroll
    for (int w = 0; w < 6; ++w) o[w] = 0u;
#pragma unroll
    for (int j = 0; j < 32; ++j) { const float x = (j < 16) ? a0[(j & 15) >> 2][j & 3] : a1[(j & 15) >> 2][j & 3]; const unsigned c = q_e2m3(x, inv);
        const int b = 6 * j, w = b >> 5, sh = b & 31; o[w] |= c << sh; if (sh > 26) o[w + 1] |= c >> (32 - sh); }
    return (u32x6){o[0], o[1], o[2], o[3], o[4], o[5]};
}
constexpr int ROW4 = 2048;
__device__ __forceinline__ unsigned q_e2m1(float x, float inv) {
    const float a = fminf(fabsf(x) * inv, 6.0f);
    const float c = a < 2.0f ? __builtin_rintf(a * 2.0f) : (a < 4.0f ? __builtin_rintf(a) + 2.0f : __builtin_rintf(a * 0.5f) + 4.0f);
    return (unsigned)(int)c | ((__builtin_bit_cast(unsigned, x) >> 28) & 8u);
}
#define FP4X_(j) ((j) < 16 ? a0[((j) & 15) >> 2][(j) & 3] : a1[((j) & 15) >> 2][(j) & 3])
__device__ __forceinline__ u32x4 pack_fp4(const f32x4 (&a0)[4], const f32x4 (&a1)[4], float inv) {
    unsigned o[4];
#pragma unroll
    for (int w = 0; w < 4; ++w) { unsigned v = 0u;
        v = __builtin_amdgcn_cvt_scalef32_pk_fp4_f32(v, FP4X_(8 * w + 0) * inv, FP4X_(8 * w + 1) * inv, 1.0f, 0); v = __builtin_amdgcn_cvt_scalef32_pk_fp4_f32(v, FP4X_(8 * w + 2) * inv, FP4X_(8 * w + 3) * inv, 1.0f, 1);
        v = __builtin_amdgcn_cvt_scalef32_pk_fp4_f32(v, FP4X_(8 * w + 4) * inv, FP4X_(8 * w + 5) * inv, 1.0f, 2); v = __builtin_amdgcn_cvt_scalef32_pk_fp4_f32(v, FP4X_(8 * w + 6) * inv, FP4X_(8 * w + 7) * inv, 1.0f, 3);
        o[w] = v; }
    return (u32x4){o[0], o[1], o[2], o[3]};
}
#undef FP4X_
__device__ __forceinline__ float clamp8(float x) { return fminf(fmaxf(x, -224.0f), 224.0f); }
__device__ __forceinline__ float logsig(float z) { return fminf(z, 0.f) - 0.6931471805599453f * __builtin_amdgcn_logf(1.0f + __builtin_amdgcn_exp2f(-fabsf(z) * 1.4426950408889634f)); }
__device__ __forceinline__ float gelu_erf(float v) {
    const float av = fabsf(v), t = __builtin_amdgcn_rcpf(av * 0.2316418882f + 1.0f);
    float q = t * 0.5307027145f + (-0.7265760135f); q = q * t + 0.7107068705f; q = q * t + (-0.142248368f); q = q * t + 0.127414796f; q = q * t;
    const float e = __builtin_amdgcn_exp2f((v * v) * (-0.72134752044f));
    const float m = v * (q * e);
    return v < 0.f ? m : v - m;
}
#define LDS_WAIT() asm volatile("s_waitcnt lgkmcnt(0)" ::: "memory")
#define FRESH_LDS(l) do { unsigned v_ = (unsigned)(size_t)(l); asm volatile("" : "+s"(v_)); (l) = (LAS unsigned char*)(size_t)v_; } while (0)
#define FRESH_BID() int bid = blockIdx.x, G = gridDim.x; asm volatile("" : "+s"(bid), "+s"(G))
#define FRESH_TID() int tid; { int w_ = wave0, l_; { unsigned z_ = 0u; asm volatile("" : "+v"(z_)); l_ = (int)__builtin_amdgcn_mbcnt_hi(~0u, __builtin_amdgcn_mbcnt_lo(~0u, z_)); } asm volatile("" : "+s"(w_)); tid = w_ * 64 + l_; } const int lane = tid & 63, wave = __builtin_amdgcn_readfirstlane(tid >> 6); (void)lane; (void)wave

__device__ __forceinline__ unsigned wave_max_u32(unsigned v) {
    v = max(v, (unsigned)__builtin_amdgcn_update_dpp(0, (int)v, 0x111, 0xF, 0xF, true));
    v = max(v, (unsigned)__builtin_amdgcn_update_dpp(0, (int)v, 0x112, 0xF, 0xF, true));
    v = max(v, (unsigned)__builtin_amdgcn_update_dpp(0, (int)v, 0x114, 0xF, 0xF, true));
    v = max(v, (unsigned)__builtin_amdgcn_update_dpp(0, (int)v, 0x118, 0xF, 0xF, true));
    v = max(v, (unsigned)__builtin_amdgcn_update_dpp((int)v, (int)v, 0x142, 0xA, 0xF, false));
    v = max(v, (unsigned)__builtin_amdgcn_update_dpp((int)v, (int)v, 0x143, 0xC, 0xF, false));
    return (unsigned)__builtin_amdgcn_readlane((int)v, 63);
}
__device__ __forceinline__ float wave_sum_dpp(float x) {
    int v = __builtin_bit_cast(int, x);
#define DPP_ADD(ctrl, rm, bc, oldv) v = __builtin_bit_cast(int, __builtin_bit_cast(float, v) + __builtin_bit_cast(float, __builtin_amdgcn_update_dpp(oldv, v, ctrl, rm, 0xF, bc)))
    DPP_ADD(0x111, 0xF, true, 0); DPP_ADD(0x112, 0xF, true, 0); DPP_ADD(0x114, 0xF, true, 0); DPP_ADD(0x118, 0xF, true, 0);
#undef DPP_ADD
    const float r0 = __builtin_bit_cast(float, __builtin_amdgcn_readlane(v, 15)), r1 = __builtin_bit_cast(float, __builtin_amdgcn_readlane(v, 31)), r2 = __builtin_bit_cast(float, __builtin_amdgcn_readlane(v, 47)), r3 = __builtin_bit_cast(float, __builtin_amdgcn_readlane(v, 63));
    return (r0 + r1) + (r2 + r3);
}
__device__ __forceinline__ unsigned ordkey(float x) { const unsigned u = __builtin_bit_cast(unsigned, x); return (u & 0x80000000u) ? ~u : (u | 0x80000000u); }
__device__ __forceinline__ void transpose_item(const float* W, int K, int ldw, int ncols, const float* gain, bf16_t* WT, LAS float* scr, int item, int lane) {
    const int nblk = ncols / 32, kb = item / nblk, nb = item % nblk, k0 = 64 * kb, n0 = 32 * nb;
#pragma unroll 8
    for (int i = 0; i < 32; ++i) { const int kk = 2 * i + (lane >> 5); float v = W[(size_t)(k0 + kk) * ldw + n0 + (lane & 31)]; if (gain) v *= gain[k0 + kk]; scr[kk * 33 + (lane & 31)] = v; }
    LDS_WAIT(); asm volatile("" ::: "memory");
    const int c = lane & 7;
#pragma unroll
    for (int j = 0; j < 4; ++j) { const int n = (lane >> 3) + 8 * j; const LAS float* s = scr + (8 * c) * 33 + n;
        u32x4 o; o.x = pk2(s[0 * 33], s[1 * 33]); o.y = pk2(s[2 * 33], s[3 * 33]); o.z = pk2(s[4 * 33], s[5 * 33]); o.w = pk2(s[6 * 33], s[7 * 33]);
        *(u32x4*)(WT + (size_t)(n0 + n) * K + k0 + 8 * c) = o; }
    LDS_WAIT(); asm volatile("" ::: "memory");
}

typedef const __attribute__((address_space(4))) Args* KArgsT;
__device__ __forceinline__ unsigned pk4_fp8(float a, float b, float c, float d) { int p = __builtin_amdgcn_cvt_pk_fp8_f32(clamp8(a), clamp8(b), 0, false); p = __builtin_amdgcn_cvt_pk_fp8_f32(clamp8(c), clamp8(d), p, true); return (unsigned)p; }
__device__ __forceinline__ void transpose_item8(const float* W, int K, int ldw, int ncols, const float* gain, float scale, unsigned char* WT, LAS float* scr, int item, int lane) {
    const int nblk = ncols / 32, kb = item / nblk, nb = item % nblk, k0 = 64 * kb, n0 = 32 * nb;
    const int kr = lane >> 3, nq = (lane & 7) * 4;
    f32x4 v[8];
#pragma unroll
    for (int i = 0; i < 8; ++i) { const float* p = W + (size_t)(k0 + 8 * i + kr) * ldw + n0 + nq; v[i] = (f32x4){p[0], p[1], p[2], p[3]}; }
#pragma unroll
    for (int i = 0; i < 8; ++i) { const int kk = 8 * i + kr; const float g = (gain ? gain[k0 + kk] : 1.0f) * scale; LAS float* d = scr + kk * 33 + nq; d[0] = v[i][0] * g; d[1] = v[i][1] * g; d[2] = v[i][2] * g; d[3] = v[i][3] * g; }
    LDS_WAIT(); asm volatile("" ::: "memory");
    const int c = lane & 7;
#pragma unroll
    for (int j = 0; j < 4; ++j) { const int n = (lane >> 3) + 8 * j; const LAS float* s = scr + (8 * c) * 33 + n;
        u32x2 o; o.x = pk4_fp8(s[0 * 33], s[1 * 33], s[2 * 33], s[3 * 33]); o.y = pk4_fp8(s[4 * 33], s[5 * 33], s[6 * 33], s[7 * 33]);
        *(u32x2*)(WT + (size_t)(n0 + n) * K + k0 + 8 * c) = o; }
    LDS_WAIT(); asm volatile("" ::: "memory");
}
__device__ __forceinline__ void conv_phase(KArgsT ka, int l, LAS unsigned char* lds, int wave0) {
    FRESH_TID(); FRESH_LDS(lds); FRESH_BID();
    unsigned char* ws = ka->ws;
    const float* ln1 = ka->in[1] + (size_t)l * D; const float* w_in = ka->in[2] + (size_t)l * D * PW; const float* w_out = ka->in[5] + (size_t)l * D * D;
    const float* ln2 = ka->in[6] + (size_t)l * D; const float* wq = ka->in[7] + (size_t)l * D * 2048;
    const float* k1 = ka->in[8] + (size_t)l * 8 * 128 * 128; const float* k2 = ka->in[9] + (size_t)l * 8 * 128 * 128;
    const float* pu = ka->in[10] + (size_t)l * NE * D; const float* pv = ka->in[11] + (size_t)l * NE * D;
    bf16_t* WQK = (bf16_t*)(ws + WS_WQK); bf16_t* WOUT = (bf16_t*)(ws + WS_WOUT); bf16_t* WIN = (bf16_t*)(ws + WS_WIN); bf16_t* U16 = (bf16_t*)(ws + WS_U16); bf16_t* V16 = (bf16_t*)(ws + WS_V16);
    {
        LAS float* Ks = (LAS float*)lds;
        LAS float* Ws = (LAS float*)(lds + 128 * 132 * 4);
        const int IPB = (1024 + G - 1) / G, it0 = bid * IPB, it1 = min(1024, it0 + IPB);
        int gi_cur = -1; f32x4 pre[4];
        if (it0 < it1) {
#pragma unroll
            for (int m = 0; m < 4; ++m) { const int i = tid + 512 * m, r = i >> 5, c4 = (i & 31) * 4; pre[m] = *(const f32x4*)(wq + (size_t)((it0 & 63) * 64 + r) * 2048 + (it0 >> 6) * 128 + c4); } }
        for (int it = it0; it < it1; ++it) {
            const int gi = it >> 6, c0 = (it & 63) * 64;
            __syncthreads();
            if (gi != gi_cur) { gi_cur = gi;
                const float* key = ((gi & 1) ? k2 : k1) + (size_t)(gi >> 1) * 128 * 128;
                for (int i = tid; i < 4096; i += 512) { const int r = i >> 5, c4 = (i & 31) * 4; *(LAS f32x4*)(Ks + r * 132 + c4) = *(const f32x4*)(key + r * 128 + c4); } }
#pragma unroll
            for (int m = 0; m < 4; ++m) { const int i = tid + 512 * m, r = i >> 5, c4 = (i & 31) * 4; *(LAS f32x4*)(Ws + r * 132 + c4) = pre[m]; }
            __syncthreads();
            if (it + 1 < it1) {
#pragma unroll
                for (int m = 0; m < 4; ++m) { const int i = tid + 512 * m, r = i >> 5, c4 = (i & 31) * 4; pre[m] = *(const f32x4*)(wq + (size_t)(((it + 1) & 63) * 64 + r) * 2048 + ((it + 1) >> 6) * 128 + c4); } }
            const int ti = wave & 3, tj = wave >> 2, li = lane & 31, kh = lane >> 5;
            const LAS float* ap = Ks + (32 * ti + li) * 132 + 64 * kh; const LAS float* bp = Ws + (32 * tj + li) * 132 + 64 * kh;
            f32x16 acc;
#pragma unroll
            for (int r = 0; r < 16; ++r) acc[r] = 0.f;
#pragma unroll 4
            for (int s4 = 0; s4 < 16; ++s4) { const f32x4 a4 = *(const LAS f32x4*)(ap + 4 * s4), b4 = *(const LAS f32x4*)(bp + 4 * s4);
                acc = __builtin_amdgcn_mfma_f32_32x32x2f32(a4[0], b4[0], acc, 0, 0, 0); acc = __builtin_amdgcn_mfma_f32_32x32x2f32(a4[1], b4[1], acc, 0, 0, 0);
                acc = __builtin_amdgcn_mfma_f32_32x32x2f32(a4[2], b4[2], acc, 0, 0, 0); acc = __builtin_amdgcn_mfma_f32_32x32x2f32(a4[3], b4[3], acc, 0, 0, 0); }
            { const int c = c0 + 32 * tj + li; const float gg = ln2[c];
#pragma unroll
              for (int r = 0; r < 16; ++r) { const int n = 32 * ti + (r & 3) + 8 * (r >> 2) + 4 * kh; WQK[(size_t)(gi * 128 + n) * D + c] = (bf16_t)f2bf(acc[r] * gg); } }
        }
        __syncthreads();
    }
    const int gw = bid * NWAVES + wave, NGW = G * NWAVES;
    {
        unsigned char* U6 = (unsigned char*)U16; unsigned char* V4 = U6 + (size_t)NE * ROW6; float* SCU = (float*)(U6 + 2 * (size_t)NE * ROW6); float* SCV = SCU + NE;
        for (int r = gw; r < NE; r += NGW) {
            const float* us = pu + (size_t)r * D + 16 * lane; const float* vs = pv + (size_t)r * D + 16 * lane;
            f32x4 uu[4][4], vv[4][4];
#pragma unroll
            for (int i = 0; i < 4; ++i)
#pragma unroll
                for (int q = 0; q < 4; ++q) { uu[i][q] = *(const f32x4*)(us + 1024 * i + 4 * q); vv[i][q] = *(const f32x4*)(vs + 1024 * i + 4 * q); }
            float au = 0.f, av = 0.f;
#pragma unroll
            for (int i = 0; i < 4; ++i)
#pragma unroll
                for (int q = 0; q < 4; ++q) { uu[i][q] *= *(const f32x4*)(ln2 + 1024 * i + 16 * lane + 4 * q);
                    au += (uu[i][q][0] * uu[i][q][0] + uu[i][q][1] * uu[i][q][1]) + (uu[i][q][2] * uu[i][q][2] + uu[i][q][3] * uu[i][q][3]);
                    av += (vv[i][q][0] * vv[i][q][0] + vv[i][q][1] * vv[i][q][1]) + (vv[i][q][2] * vv[i][q][2] + vv[i][q][3] * vv[i][q][3]); }
            au = sqrtf(wave_sum_dpp(au) * (1.0f / D)); av = sqrtf(wave_sum_dpp(av) * (1.0f / D));
            const float iu = au > 0.f ? 2.0f / au : 0.f, iv = av > 0.f ? 2.0f / av : 0.f;
            if (lane == 0) { SCU[r] = au * 0.5f; SCV[r] = av * 0.5f; }
            { u32x4* o = (u32x4*)(U6 + (size_t)r * ROW4) + lane; o[0] = pack_fp4(uu[0], uu[1], iu); o[64] = pack_fp4(uu[2], uu[3], iu); }
            { u32x4* o = (u32x4*)(V4 + (size_t)r * ROW4) + lane; o[0] = pack_fp4(vv[0], vv[1], iv); o[64] = pack_fp4(vv[2], vv[3], iv); }
        }
    }
    {
        LAS float* scr = (LAS float*)(lds + wave * 16384);
        constexpr int I_O = (D / 64) * (D / 32), I_IN = (D / 64) * (12288 / 32);
        for (int it = gw; it < I_O + I_IN; it += NGW) {
            if (it < I_O) transpose_item8(w_out, D, D, D, nullptr, US, (unsigned char*)WOUT, scr, it, lane);
            else transpose_item8(w_in, D, PW, 12288, ln1, US, (unsigned char*)WIN, scr, it - I_O, lane);
        }
    }
}

template <bool WITH_F>
__device__ __forceinline__ void prep_phase(const float* X, bf16_t* XB, float* RSTD, const float* w_in, const float* ln1, const float* bf, float* LOGF, LAS unsigned char* lds, int wave0) {
    FRESH_TID(); FRESH_LDS(lds); FRESH_BID();
    LAS unsigned short* gfs = (LAS unsigned short*)lds;
    if (WITH_F) {
        __syncthreads();
        for (int c = tid; c < D; c += 512) { const float g = ln1[c]; const float* wr = w_in + (size_t)c * PW + 12288;
#pragma unroll
            for (int j = 0; j < 10; ++j) gfs[j * D + c] = (unsigned short)f2bf(wr[j] * g); }
        __syncthreads();
    }
    const int gw = bid * NWAVES + wave, NGW = G * NWAVES;
    for (int m = gw; m < M; m += NGW) {
        const f32x4* xr = (const f32x4*)(X + (size_t)m * D) + lane;
        f32x4 v[16]; float ss = 0.f;
#pragma unroll
        for (int i = 0; i < 16; ++i) { v[i] = xr[64 * i]; ss += (v[i][0] * v[i][0] + v[i][1] * v[i][1]) + (v[i][2] * v[i][2] + v[i][3] * v[i][3]); }
        ss = wave_sum_dpp(ss);
        const float rstd = rsqrtf(ss * (1.0f / D) + 1e-6f);
        if (WITH_F) {
            unsigned* o8 = (unsigned*)((unsigned char*)XB + (size_t)m * D) + lane;
#pragma unroll
            for (int i = 0; i < 16; ++i) o8[64 * i] = pk4_fp8(v[i][0], v[i][1], v[i][2], v[i][3]);
        } else {
        u32x2* o = (u32x2*)(XB + (size_t)m * D) + lane;
#pragma unroll
        for (int i = 0; i < 16; ++i) { u32x2 w; w.x = pk2(v[i][0], v[i][1]); w.y = pk2(v[i][2], v[i][3]); o[64 * i] = w; }
        }
        if (lane == 0) RSTD[m] = rstd;
        if (WITH_F) {
            float mine = 0.f;
#pragma unroll 1
            for (int j = 0; j < 10; ++j) { float s = 0.f;
#pragma unroll
                for (int i = 0; i < 16; ++i) { const u32x2 gp = *(const LAS u32x2*)(gfs + j * D + 256 * i + 4 * lane);
                    s += (v[i][0] * bf_lo(gp.x) + v[i][1] * bf_hi(gp.x)) + (v[i][2] * bf_lo(gp.y) + v[i][3] * bf_hi(gp.y)); }
                s = wave_sum_dpp(s); if (lane == j) mine = s; }
            if (lane < 10) { const int b = m >> 11, s = m & 2047; LOGF[(size_t)(b * 10 + lane) * S + s] = logsig(mine * rstd + bf[lane]); }
        }
    }
}


__device__ __forceinline__ void load16_bf16(const bf16_t* p, float (&d)[16]) {
    const u32x4 a = *(const u32x4*)p, b = *(const u32x4*)(p + 8);
#pragma unroll
    for (int q = 0; q < 4; ++q) { d[2 * q] = bf_lo(a[q]); d[2 * q + 1] = bf_hi(a[q]); d[8 + 2 * q] = bf_lo(b[q]); d[8 + 2 * q + 1] = bf_hi(b[q]); }
}
#define RFL(x) __builtin_amdgcn_readfirstlane(x)
template <bool FINAL>
__device__ __forceinline__ void peer_uv_phase(const float* SC, const unsigned char* U6, const unsigned char* V4, const bf16_t* X1, void* XOv, const float* fg,
                                              unsigned char* XB8n, float* RSTDn, float* LOGFn, const float* w_in_n, const float* ln1_n, const float* bf_n, LAS unsigned char* lds, int wave0) {
    FRESH_TID(); FRESH_LDS(lds); FRESH_BID();
    LAS int* s_eid = (LAS int*)(lds + 81920 + wave * 1024); LAS float* s_w = (LAS float*)(lds + 81920 + wave * 1024 + 512); LAS float* s_su = (LAS float*)(lds + 90112 + wave * 512);
    const float* SCU = (const float*)(U6 + 2 * (size_t)NE * ROW6); const float* SCV = SCU + NE;
    LAS unsigned short* gfs = (LAS unsigned short*)lds;
    if (!FINAL) {
        __syncthreads();
        for (int c = tid; c < D; c += 512) { const float g = ln1_n[c]; const float* wr = w_in_n + (size_t)c * PW + 12288;
#pragma unroll
            for (int j = 0; j < 10; ++j) gfs[j * D + c] = (unsigned short)f2bf(wr[j] * g); }
        __syncthreads();
    }
    const int gw = bid * NWAVES + wave, NGW = G * NWAVES;
    for (int tok = gw; tok < M; tok += NGW) {
        const bf16_t* x1 = X1 + (size_t)tok * D;
        i32x8 xq[2]; float rstd_tok;
        { const int sg_ = lane & 15, gp_ = lane >> 4; float t[2][2][16]; float ss_ = 0.f;
#pragma unroll
          for (int s2 = 0; s2 < 2; ++s2)
#pragma unroll
              for (int hf = 0; hf < 2; ++hf) { load16_bf16(x1 + 1024 * (2 * s2 + (gp_ & 1)) + 16 * (sg_ + 32 * hf + 16 * (gp_ >> 1)), t[s2][hf]);
#pragma unroll
                  for (int k = 0; k < 16; ++k) ss_ += t[s2][hf][k] * t[s2][hf][k]; }
          rstd_tok = rsqrtf(wave_sum_dpp(ss_) * (1.0f / D) + 1e-6f);
#pragma unroll
          for (int s2 = 0; s2 < 2; ++s2)
#pragma unroll
              for (int hf = 0; hf < 2; ++hf)
#pragma unroll
                  for (int q = 0; q < 4; ++q) xq[s2][4 * hf + q] = (int)pk4_fp8(t[s2][hf][4 * q] * rstd_tok, t[s2][hf][4 * q + 1] * rstd_tok, t[s2][hf][4 * q + 2] * rstd_tok, t[s2][hf][4 * q + 3] * rstd_tok); }
        const float* sc = SC + (size_t)tok * 2048;
        LAS float* selv = (LAS float*)(lds + 94208 + wave * 512); LAS int* seli = (LAS int*)(lds + 94208 + wave * 512 + 256);
#define BALLOT(c) __builtin_amdgcn_ballot_w64(c)
#define MBCNT(m) ((int)__builtin_amdgcn_mbcnt_hi((unsigned)((m) >> 32), __builtin_amdgcn_mbcnt_lo((unsigned)(m), 0u)))
        for (int h = 0; h < 4; ++h) {
            float x[2][2][2]; unsigned kk[2][2][2];
#pragma unroll
            for (int u = 0; u < 2; ++u)
#pragma unroll
                for (int f = 0; f < 2; ++f)
#pragma unroll
                    for (int r = 0; r < 2; ++r) { const float v = sc[(h + 4 * u) * 256 + f * 128 + r * 64 + lane]; x[u][f][r] = v; kk[u][f][r] = (ordkey(v) & ~127u) | (unsigned)(127 - 64 * r - lane); }
            unsigned T[2][2] = {{0u, 0u}, {0u, 0u}}; int dn = 0;
            for (unsigned bm = 0x80000000u; bm != 0u && dn != 15; bm >>= 1) {
#pragma unroll
                for (int u = 0; u < 2; ++u)
#pragma unroll
                    for (int f = 0; f < 2; ++f) { const unsigned cand = T[u][f] | bm;
                        const int c = __builtin_popcountll(BALLOT(kk[u][f][0] >= cand)) + __builtin_popcountll(BALLOT(kk[u][f][1] >= cand));
                        T[u][f] = c >= 16 ? cand : T[u][f]; dn |= (c == 16) ? (1 << (2 * u + f)) : 0; }
            }
#pragma unroll
            for (int u = 0; u < 2; ++u)
#pragma unroll
                for (int f = 0; f < 2; ++f) { const bool s0 = kk[u][f][0] >= T[u][f], s1 = kk[u][f][1] >= T[u][f]; const unsigned long long m0 = BALLOT(s0), m1 = BALLOT(s1);
                    const int p0 = MBCNT(m0), p1 = __builtin_popcountll(m0) + MBCNT(m1);
                    if (s0) { selv[(2 * u + f) * 16 + (p0 & 15)] = x[u][f][0]; seli[(2 * u + f) * 16 + (p0 & 15)] = lane; }
                    if (s1) { selv[(2 * u + f) * 16 + (p1 & 15)] = x[u][f][1]; seli[(2 * u + f) * 16 + (p1 & 15)] = 64 + lane; } }
            asm volatile("" ::: "memory");
            float s4[2][4]; unsigned k4[2][4];
#pragma unroll
            for (int u = 0; u < 2; ++u) { const float va = selv[(2 * u) * 16 + (lane >> 2)]; const f32x4 vb = *(const LAS f32x4*)(selv + (2 * u + 1) * 16 + (lane & 3) * 4);
#pragma unroll
                for (int q = 0; q < 4; ++q) { s4[u][q] = va + vb[q]; k4[u][q] = (ordkey(s4[u][q]) & ~255u) | (unsigned)(255 - 4 * lane - q); } }
            unsigned T2[2] = {0u, 0u}; int d2 = 0;
            for (unsigned bm = 0x80000000u; bm != 0u && d2 != 3; bm >>= 1) {
#pragma unroll
                for (int u = 0; u < 2; ++u) { const unsigned cand = T2[u] | bm;
                    const int c = (__builtin_popcountll(BALLOT(k4[u][0] >= cand)) + __builtin_popcountll(BALLOT(k4[u][1] >= cand))) + (__builtin_popcountll(BALLOT(k4[u][2] >= cand)) + __builtin_popcountll(BALLOT(k4[u][3] >= cand)));
                    T2[u] = c >= 16 ? cand : T2[u]; d2 |= (c == 16) ? (1 << u) : 0; }
            }
#pragma unroll
            for (int u = 0; u < 2; ++u) {
                const unsigned mk = wave_max_u32(max(max(k4[u][0], k4[u][1]), max(k4[u][2], k4[u][3]))) & ~255u;
                const float mx = __builtin_bit_cast(float, (mk & 0x80000000u) ? (mk & 0x7fffffffu) : ~mk);
                const float cs = 1.4426950408889634f * rstd_tok;
                float p[4], ps = 0.f;
#pragma unroll
                for (int q = 0; q < 4; ++q) { p[q] = (k4[u][q] >= T2[u]) ? __builtin_amdgcn_exp2f((s4[u][q] - mx) * cs) : 0.f; ps += p[q]; }
                const float tot = wave_sum_dpp(ps);
                const int i1 = seli[(2 * u) * 16 + (lane >> 2)]; const u32x4 i2 = *(const LAS u32x4*)(seli + (2 * u + 1) * 16 + (lane & 3) * 4);
                int base = (h + 4 * u) * 16;
#pragma unroll
                for (int q = 0; q < 4; ++q) { const bool sl = k4[u][q] >= T2[u]; const unsigned long long m = BALLOT(sl); const int slot = base + (MBCNT(m) & 15); base += __builtin_popcountll(m);
                    if (sl) { const int e = ((i1 & 127) << 7) | (int)(i2[q] & 127u); s_eid[slot] = e; s_w[slot] = p[q] / tot * SCV[e]; s_su[slot] = SCU[e]; } }
            }
            asm volatile("" ::: "memory");
        }
#undef BALLOT
#undef MBCNT
        LDS_WAIT(); asm volatile("" ::: "memory");
#define LOADROW6(dst, base, e) do { const u32x4* p_ = (const u32x4*)((base) + (size_t)(e) * ROW6) + lane; dst[0] = p_[0]; dst[1] = p_[64]; dst[2] = p_[128]; } while (0)
#define GRP6(row, g) ((g) == 0 ? (u32x6){row[0][0], row[0][1], row[0][2], row[0][3], row[1][0], row[1][1]} : (u32x6){row[1][2], row[1][3], row[2][0], row[2][1], row[2][2], row[2][3]})
        {
#define LOADROW4(dst, base, e) do { const u32x4* p_ = (const u32x4*)((base) + (size_t)(e) * ROW4) + lane; dst[0] = p_[0]; dst[1] = p_[64]; } while (0)
            const bool dg_ = ((lane & 15) >> 2) == (lane >> 4);
#define UDOT4(row, j) do { f32x4 ac_ = {0.f, 0.f, 0.f, 0.f}; \
            ac_ = __builtin_amdgcn_mfma_scale_f32_16x16x128_f8f6f4((i32x8){(int)row[0][0], (int)row[0][1], (int)row[0][2], (int)row[0][3], 0, 0, 0, 0}, xq[0], ac_, 4, 0, 0, 0x7f7f7f7f, 0, 0x7f7f7f7f); \
            ac_ = __builtin_amdgcn_mfma_scale_f32_16x16x128_f8f6f4((i32x8){(int)row[1][0], (int)row[1][1], (int)row[1][2], (int)row[1][3], 0, 0, 0, 0}, xq[1], ac_, 4, 0, 0, 0x7f7f7f7f, 0, 0x7f7f7f7f); \
            asm volatile("" : "+v"(ac_));     \
            const float pv_ = dg_ ? ((lane & 2) ? ((lane & 1) ? ac_[3] : ac_[2]) : ((lane & 1) ? ac_[1] : ac_[0])) : 0.f; \
            const float d_ = wave_sum_dpp(pv_) * s_su[j]; const float ge_ = gelu_erf(d_); if (lane == 0) s_w[j] *= ge_; } while (0)
            u32x4 r0[2], r1[2], r2[2], r3[2], r4[2], r5[2], r6[2], r7[2];
            { const int e_ = RFL(s_eid[0]); LOADROW4(r0, U6, e_); } { const int e_ = RFL(s_eid[1]); LOADROW4(r1, U6, e_); } { const int e_ = RFL(s_eid[2]); LOADROW4(r2, U6, e_); } { const int e_ = RFL(s_eid[3]); LOADROW4(r3, U6, e_); } { const int e_ = RFL(s_eid[4]); LOADROW4(r4, U6, e_); } { const int e_ = RFL(s_eid[5]); LOADROW4(r5, U6, e_); } { const int e_ = RFL(s_eid[6]); LOADROW4(r6, U6, e_); } { const int e_ = RFL(s_eid[7]); LOADROW4(r7, U6, e_); }
            for (int j = 0; j < 120; j += 8) {
                UDOT4(r0, j + 0); { const int e_ = RFL(s_eid[j + 8]); LOADROW4(r0, U6, e_); }
                UDOT4(r1, j + 1); { const int e_ = RFL(s_eid[j + 9]); LOADROW4(r1, U6, e_); }
                UDOT4(r2, j + 2); { const int e_ = RFL(s_eid[j + 10]); LOADROW4(r2, U6, e_); }
                UDOT4(r3, j + 3); { const int e_ = RFL(s_eid[j + 11]); LOADROW4(r3, U6, e_); }
                UDOT4(r4, j + 4); { const int e_ = RFL(s_eid[j + 12]); LOADROW4(r4, U6, e_); }
                UDOT4(r5, j + 5); { const int e_ = RFL(s_eid[j + 13]); LOADROW4(r5, U6, e_); }
                UDOT4(r6, j + 6); { const int e_ = RFL(s_eid[j + 14]); LOADROW4(r6, U6, e_); }
                UDOT4(r7, j + 7); { const int e_ = RFL(s_eid[j + 15]); LOADROW4(r7, U6, e_); }
            }
            UDOT4(r0, 120); UDOT4(r1, 121); UDOT4(r2, 122); UDOT4(r3, 123); UDOT4(r4, 124); UDOT4(r5, 125); UDOT4(r6, 126); UDOT4(r7, 127);
#undef UDOT4
#undef LOADROW4
        }
        LDS_WAIT(); asm volatile("" ::: "memory");
        {
            f32x2 acc2[2][16];
#define ACC(i, k) acc2[(i) >> 1][((i) & 1) * 8 + ((k) >> 1)][(k) & 1]
#pragma unroll
            for (int g = 0; g < 2; ++g)
#pragma unroll
                for (int k = 0; k < 16; ++k) acc2[g][k] = (f32x2){0.f, 0.f};
#define LOADROW4(dst, base, e) do { const u32x4* p_ = (const u32x4*)((base) + (size_t)(e) * ROW4) + lane; dst[0] = p_[0]; dst[1] = p_[64]; } while (0)
#define VACC4(row, j) do { const float w_ = s_w[j]; const f32x2 w2_ = {w_, w_}; _Pragma("unroll") for (int g_ = 0; g_ < 2; ++g_) { \
                u32x4 G_ = row[g_]; asm volatile("" : "+v"(G_)); \
                _Pragma("unroll") for (int k_ = 0; k_ < 4; ++k_) { const unsigned d_ = G_[k_]; \
                    acc2[g_][4 * k_] = __builtin_elementwise_fma(w2_, __builtin_amdgcn_cvt_scalef32_pk_f32_fp4(d_, 1.0f, 0), acc2[g_][4 * k_]); acc2[g_][4 * k_ + 1] = __builtin_elementwise_fma(w2_, __builtin_amdgcn_cvt_scalef32_pk_f32_fp4(d_, 1.0f, 1), acc2[g_][4 * k_ + 1]); \
                    acc2[g_][4 * k_ + 2] = __builtin_elementwise_fma(w2_, __builtin_amdgcn_cvt_scalef32_pk_f32_fp4(d_, 1.0f, 2), acc2[g_][4 * k_ + 2]); acc2[g_][4 * k_ + 3] = __builtin_elementwise_fma(w2_, __builtin_amdgcn_cvt_scalef32_pk_f32_fp4(d_, 1.0f, 3), acc2[g_][4 * k_ + 3]); } \
                asm volatile("" : "+v"(acc2[g_][0]), "+v"(acc2[g_][1]), "+v"(acc2[g_][2]), "+v"(acc2[g_][3]), "+v"(acc2[g_][4]), "+v"(acc2[g_][5]), "+v"(acc2[g_][6]), "+v"(acc2[g_][7]), \
                                  "+v"(acc2[g_][8]), "+v"(acc2[g_][9]), "+v"(acc2[g_][10]), "+v"(acc2[g_][11]), "+v"(acc2[g_][12]), "+v"(acc2[g_][13]), "+v"(acc2[g_][14]), "+v"(acc2[g_][15])); } } while (0)
            u32x4 r0[2], r1[2], r2[2], r3[2], r4[2], r5[2], r6[2], r7[2];
            { const int e_ = RFL(s_eid[0]); LOADROW4(r0, V4, e_); } { const int e_ = RFL(s_eid[1]); LOADROW4(r1, V4, e_); } { const int e_ = RFL(s_eid[2]); LOADROW4(r2, V4, e_); } { const int e_ = RFL(s_eid[3]); LOADROW4(r3, V4, e_); } { const int e_ = RFL(s_eid[4]); LOADROW4(r4, V4, e_); } { const int e_ = RFL(s_eid[5]); LOADROW4(r5, V4, e_); } { const int e_ = RFL(s_eid[6]); LOADROW4(r6, V4, e_); } { const int e_ = RFL(s_eid[7]); LOADROW4(r7, V4, e_); }
            for (int j = 0; j < 120; j += 8) {
                VACC4(r0, j + 0); { const int e_ = RFL(s_eid[j + 8]); LOADROW4(r0, V4, e_); }
                VACC4(r1, j + 1); { const int e_ = RFL(s_eid[j + 9]); LOADROW4(r1, V4, e_); }
                VACC4(r2, j + 2); { const int e_ = RFL(s_eid[j + 10]); LOADROW4(r2, V4, e_); }
                VACC4(r3, j + 3); { const int e_ = RFL(s_eid[j + 11]); LOADROW4(r3, V4, e_); }
                VACC4(r4, j + 4); { const int e_ = RFL(s_eid[j + 12]); LOADROW4(r4, V4, e_); }
                VACC4(r5, j + 5); { const int e_ = RFL(s_eid[j + 13]); LOADROW4(r5, V4, e_); }
                VACC4(r6, j + 6); { const int e_ = RFL(s_eid[j + 14]); LOADROW4(r6, V4, e_); }
                VACC4(r7, j + 7); { const int e_ = RFL(s_eid[j + 15]); LOADROW4(r7, V4, e_); }
            }
            VACC4(r0, 120); VACC4(r1, 121); VACC4(r2, 122); VACC4(r3, 123); VACC4(r4, 124); VACC4(r5, 125); VACC4(r6, 126); VACC4(r7, 127);
#undef VACC4
#undef LOADROW4
            float ss = 0.f;
#pragma unroll
            for (int i = 0; i < 4; ++i) { float t[16]; load16_bf16(x1 + 1024 * i + 16 * lane, t);
#pragma unroll
                for (int k = 0; k < 16; ++k) { ACC(i, k) += t[k]; ss += ACC(i, k) * ACC(i, k); } }
            ss = wave_sum_dpp(ss);
            const float rs = rsqrtf(ss * (1.0f / D) + 1e-6f);
            if (!FINAL) {
#pragma unroll
                for (int i = 0; i < 4; ++i) { u32x4 w8;
#pragma unroll
                    for (int q = 0; q < 4; ++q) w8[q] = pk4_fp8(ACC(i, 4 * q), ACC(i, 4 * q + 1), ACC(i, 4 * q + 2), ACC(i, 4 * q + 3));
                    *(u32x4*)(XB8n + (size_t)tok * D + 1024 * i + 16 * lane) = w8; }
                if (lane == 0) RSTDn[tok] = rs;
                float mine = 0.f;
#pragma unroll 1
                for (int j = 0; j < 10; ++j) { float s = 0.f;
#pragma unroll
                    for (int i = 0; i < 4; ++i) { const u32x4 g0 = *(const LAS u32x4*)(gfs + j * D + 1024 * i + 16 * lane), g1 = *(const LAS u32x4*)(gfs + j * D + 1024 * i + 16 * lane + 8);
#pragma unroll
                        for (int q = 0; q < 4; ++q) { s += ACC(i, 2 * q) * bf_lo(g0[q]) + ACC(i, 2 * q + 1) * bf_hi(g0[q]); s += ACC(i, 8 + 2 * q) * bf_lo(g1[q]) + ACC(i, 8 + 2 * q + 1) * bf_hi(g1[q]); } }
                    s = wave_sum_dpp(s); if (lane == j) mine = s; }
                if (lane < 10) { const int b_ = tok >> 11, s_ = tok & 2047; LOGFn[(size_t)(b_ * 10 + lane) * S + s_] = logsig(mine * rs + bf_n[lane]); }
            }
            if (FINAL) { float* xo = (float*)XOv + (size_t)tok * D;
#pragma unroll
                for (int i = 0; i < 4; ++i)
#pragma unroll
                    for (int q = 0; q < 4; ++q) { const int c = 1024 * i + 16 * lane + 4 * q; const f32x4 g_ = *(const f32x4*)(fg + c);
                        *(f32x4*)(xo + c) = (f32x4){ACC(i, 4 * q) * rs * g_[0], ACC(i, 4 * q + 1) * rs * g_[1], ACC(i, 4 * q + 2) * rs * g_[2], ACC(i, 4 * q + 3) * rs * g_[3]}; }
            } else { bf16_t* xo = (bf16_t*)XOv + (size_t)tok * D;
#pragma unroll
                for (int i = 0; i < 4; ++i) { u32x4 w0, w1;
#pragma unroll
                    for (int q = 0; q < 4; ++q) { w0[q] = pk2(ACC(i, 2 * q), ACC(i, 2 * q + 1)); w1[q] = pk2(ACC(i, 8 + 2 * q), ACC(i, 8 + 2 * q + 1)); }
                    *(u32x4*)(xo + 1024 * i + 16 * lane) = w0; *(u32x4*)(xo + 1024 * i + 16 * lane + 8) = w1; }
            }
        }
        LDS_WAIT(); asm volatile("" ::: "memory");
    }
#undef ACC
#undef LOADROW6
#undef GRP6
}
}
namespace at {
using namespace mk;
constexpr int QB = 256, KVB = 64, HD = 128;
constexpr int SHM_V = KVB * HD * 2, SHM_K = KVB * HD * 2;
constexpr int OFF_V = 0, OFF_K = 2 * SHM_V, OFF_WS = OFF_K + 2 * SHM_K, OFF_CUM = OFF_WS + 8 * 256, OFF_RT = OFF_CUM + 2048 * 4, OFF_MISC = OFF_RT + 640 * 4;
constexpr float LOG2E = 1.4426950408889634f;
constexpr float THR2 = 10.0f;
constexpr float SB_DONE = -100.0f;

#define AT_KSWZ(row, colB) ((row) * 256 + ((colB) ^ (((row) & 7) << 4)))
__device__ __forceinline__ int v_st(int k, int c) { const int kk = (k & ~0xC) | ((k & 4) << 1) | ((k & 8) >> 1); return ((kk >> 3) * 4 + (c >> 5)) * 512 + ((kk & 7) * 32 + (c & 31)) * 2; }
__device__ __forceinline__ int v_rd_base(int lane) { return ((lane & 3) << 3) | (((lane >> 2) & 3) << 6) | (((lane >> 4) & 1) << 5) | (((lane >> 5) & 1) << 8); }
constexpr int v_rd_off(int d0, int ks, int half) { return d0 * 512 + ks * 4096 + half * 2048; }
__device__ __forceinline__ int crow(int r, int hi) { return (r & 3) + 8 * (r >> 2) + 4 * hi; }
__device__ __forceinline__ unsigned cvtpk(float lo, float hi) { unsigned r; asm volatile("v_cvt_pk_bf16_f32 %0, %1, %2" : "=v"(r) : "v"(lo), "v"(hi)); return r; }
__device__ __forceinline__ float partner(float v, int hi) { auto rr = __builtin_amdgcn_permlane32_swap(__builtin_bit_cast(unsigned, v), __builtin_bit_cast(unsigned, v), false, false); return __builtin_bit_cast(float, hi ? rr[0] : rr[1]); }

__device__ __forceinline__ float xchg_max(float v, int hi) { return fmaxf(v, partner(v, hi)); }
__device__ __forceinline__ float xchg_sum(float v, int hi) { return v + partner(v, hi); }

__device__ __forceinline__ void pack_p(const f32x16& p0, const f32x16& p1, bf16x8& pa0, bf16x8& pa1, bf16x8& pa2, bf16x8& pa3) {
#define AT_PK4(P, B_, OUT) do { unsigned a0 = cvtpk(P[B_ + 0], P[B_ + 1]), a1 = cvtpk(P[B_ + 2], P[B_ + 3]); unsigned b0 = cvtpk(P[B_ + 4], P[B_ + 5]), b1 = cvtpk(P[B_ + 6], P[B_ + 7]); \
        auto r0 = __builtin_amdgcn_permlane32_swap(a0, b0, false, false); auto r1 = __builtin_amdgcn_permlane32_swap(a1, b1, false, false); \
        u32x4 w = {r0[0], r1[0], r0[1], r1[1]}; OUT = __builtin_bit_cast(bf16x8, w); } while (0)
    AT_PK4(p0, 0, pa0); AT_PK4(p0, 8, pa1); AT_PK4(p1, 0, pa2); AT_PK4(p1, 8, pa3);
#undef AT_PK4
}
template <int KBUF>
__device__ __forceinline__ void qkt(f32x16& p0, f32x16& p1, LAS unsigned char* K_lds, int r32, int hi, const bf16x8 (&qr)[8]) {
    p0 = f32x16{}; p1 = f32x16{};
    LAS unsigned char* kb[4];
#pragma unroll
    for (int dd = 0; dd < 4; ++dd) kb[dd] = K_lds + KBUF * SHM_K + AT_KSWZ(r32, (dd * 16 + hi * 8) * 2);
#pragma unroll
    for (int d0 = 0; d0 < 8; ++d0) { LAS unsigned char* a = kb[d0 & 3] + (d0 >> 2) * 128;
        const bf16x8 b0 = *(const LAS bf16x8*)a; const bf16x8 b1 = *(const LAS bf16x8*)(a + 32 * 256);
        p0 = __builtin_amdgcn_mfma_f32_32x32x16_bf16(b0, qr[d0], p0, 0, 0, 0);
        p1 = __builtin_amdgcn_mfma_f32_32x32x16_bf16(b1, qr[d0], p1, 0, 0, 0); }
}
template <int VBUF>
__device__ __forceinline__ void pv_tile(f32x16 (&o)[4], int vb0, bf16x8 pa0, bf16x8 pa1, bf16x8 pa2, bf16x8 pa3) {
#define AT_TRRD(dst, off) asm volatile("ds_read_b64_tr_b16 %0, %1 offset:%2" : "=&v"(dst) : "v"(vb0), "i"(off) : "memory")
#define AT_PV_D0(d0) do { s16x4 l0, l1, l2, l3, h0, h1, h2, h3; constexpr int b_ = VBUF * SHM_V + v_rd_off(d0, 0, 0); \
        AT_TRRD(l0, b_); AT_TRRD(h0, b_ + 2048); AT_TRRD(l1, b_ + 4096); AT_TRRD(h1, b_ + 6144); AT_TRRD(l2, b_ + 8192); AT_TRRD(h2, b_ + 10240); AT_TRRD(l3, b_ + 12288); AT_TRRD(h3, b_ + 14336); \
        asm volatile("s_waitcnt lgkmcnt(0)" ::: "memory"); __builtin_amdgcn_sched_barrier(0); \
        o[d0] = __builtin_amdgcn_mfma_f32_32x32x16_bf16(pa0, (bf16x8){l0[0], l0[1], l0[2], l0[3], h0[0], h0[1], h0[2], h0[3]}, o[d0], 0, 0, 0); \
        o[d0] = __builtin_amdgcn_mfma_f32_32x32x16_bf16(pa1, (bf16x8){l1[0], l1[1], l1[2], l1[3], h1[0], h1[1], h1[2], h1[3]}, o[d0], 0, 0, 0); \
        o[d0] = __builtin_amdgcn_mfma_f32_32x32x16_bf16(pa2, (bf16x8){l2[0], l2[1], l2[2], l2[3], h2[0], h2[1], h2[2], h2[3]}, o[d0], 0, 0, 0); \
        o[d0] = __builtin_amdgcn_mfma_f32_32x32x16_bf16(pa3, (bf16x8){l3[0], l3[1], l3[2], l3[3], h3[0], h3[1], h3[2], h3[3]}, o[d0], 0, 0, 0); } while (0)
    AT_PV_D0(0); AT_PV_D0(1); AT_PV_D0(2); AT_PV_D0(3);
#undef AT_PV_D0
#undef AT_TRRD
}

template <int VAR>
__device__ __forceinline__ void attn_item(const bf16_t* Qh, const bf16_t* Kh, const bf16_t* Vh, bf16_t* OB, const float* relb, const float* LOGF, int b, int h, int qb, LAS unsigned char* lds, int tid) {
    const int wid = __builtin_amdgcn_readfirstlane(tid >> 6), lane = tid & 63, r32 = lane & 31, hi = lane >> 5;
    const int g = VAR == 0 ? h : (VAR == 1 ? 12 + h : 22 + h);
    const size_t hb = (size_t)(b * NH + g) * S * HD;
    const bf16_t* Kp = Kh + hb; const bf16_t* Vp = Vh + hb;
    LAS unsigned char* V_lds = lds + OFF_V; LAS unsigned char* K_lds = lds + OFF_K;
    LAS float* wsf = (LAS float*)(lds + OFF_WS) + wid * 64; LAS float* li_l = wsf; LAS float* al_l = wsf + 32;
    LAS float* cumL = (LAS float*)(lds + OFF_CUM); LAS float* Rt = (LAS float*)(lds + OFF_RT); volatile LAS unsigned* flags = (volatile LAS unsigned*)(lds + OFF_MISC);
    const int P0 = qb * QB, qlo = P0 + wid * 32, qpos = qlo + r32;
    int NT, jlo = 0;
    if (VAR == 0) { jlo = 4 * qb - 8; if (jlo < 0) jlo = 0; NT = 4 * qb + 4 - jlo; } else NT = 4 * qb + 4;
    const int cw = 4 * qb + (wid >> 1);
#define AT_KBASE(t) (VAR == 1 ? (4 * qb + 3 - (t)) * KVB : (jlo + (t)) * KVB)
#define AT_ACT(t) (VAR == 0 ? ((jlo + (t)) >= cw - 8 && (jlo + (t)) <= cw) : (VAR == 1 ? (AT_KBASE(t) <= qlo + 30) : (AT_KBASE(t) <= qlo + 31)))
    if (VAR == 0) {
        const float* tab = relb + h * 257;
        for (int j = tid; j < 639; j += 512) { int rel = 575 - j; rel = rel < -128 ? -128 : (rel > 128 ? 128 : rel); Rt[j] = tab[rel + 128] * LOG2E; }
    }
    if (VAR == 2) {
        const float* lf = LOGF + (size_t)(b * 10 + h) * S; const int kend = P0 + QB;
        f32x4 v = (f32x4){0.f, 0.f, 0.f, 0.f};
        if (4 * tid < kend) v = *(const f32x4*)(lf + 4 * tid);
        v[1] += v[0]; v[2] += v[1]; v[3] += v[2];
        float tot = v[3];
#pragma unroll
        for (int o = 1; o < 64; o <<= 1) { const float t_ = lane_read(tot, lane >= o ? lane - o : lane); if (lane >= o) tot += t_; }
        if (lane == 63) li_l[0] = tot;
        __syncthreads();
        float base = tot - v[3];
        for (int w = 0; w < wid; ++w) base += ((LAS float*)(lds + OFF_WS))[w * 64];
        if (4 * tid < kend) *(LAS f32x4*)(cumL + 4 * tid) = (f32x4){(base + v[0]) * LOG2E, (base + v[1]) * LOG2E, (base + v[2]) * LOG2E, (base + v[3]) * LOG2E};
    }
    bf16x8 qr[8];
    { const bf16_t* qp = Qh + hb + (size_t)(qlo + r32) * HD + hi * 8;
#pragma unroll
      for (int d0 = 0; d0 < 8; ++d0) qr[d0] = *(const bf16x8*)(qp + d0 * 16); }
    const int sr = tid >> 4, sc = (tid & 15) * 8, vst0 = v_st(sr, sc), vst1 = v_st(32 + sr, sc), kws = AT_KSWZ(sr, sc * 2);
    const int vb0 = (int)(unsigned)(size_t)V_lds + v_rd_base(lane);
    bf16x8 st_k0, st_k1, st_v0, st_v1;
#define AT_SLOAD(k0) do { const bf16_t* kp_ = Kp + (size_t)((k0) + sr) * HD + sc; const bf16_t* vp_ = Vp + (size_t)((k0) + sr) * HD + sc; \
        st_k0 = *(const bf16x8*)kp_; st_k1 = *(const bf16x8*)(kp_ + 32 * HD); st_v0 = *(const bf16x8*)vp_; st_v1 = *(const bf16x8*)(vp_ + 32 * HD); } while (0)
#define AT_SWRITE(bf) do { *(LAS bf16x8*)(K_lds + (bf) * SHM_K + kws) = st_k0; *(LAS bf16x8*)(K_lds + (bf) * SHM_K + kws + 32 * 256) = st_k1; \
        *(LAS bf16x8*)(V_lds + (bf) * SHM_V + vst0) = st_v0; *(LAS bf16x8*)(V_lds + (bf) * SHM_V + vst1) = st_v1; } while (0)
    AT_SLOAD(AT_KBASE(0)); asm volatile("s_waitcnt vmcnt(0)" ::: "memory"); AT_SWRITE(0);
    __syncthreads();
    float m_reg = -1e30f, l_reg = 0.f, carry = 0.f;
    f32x16 o[4] = {};
#define AT_STEP(BUF, t) do { \
        const bool more_ = (t) + 1 < NT; \
        if (more_) AT_SLOAD(AT_KBASE((t) + 1)); \
        if (AT_ACT(t)) { \
            const int kb_ = AT_KBASE(t); f32x16 p0, p1; bf16x8 pa0, pa1, pa2, pa3; \
            qkt<BUF>(p0, p1, K_lds, r32, hi, qr); \
            tile_math(p0, p1, kb_, pa0, pa1, pa2, pa3); \
            pv_tile<BUF>(o, vb0, pa0, pa1, pa2, pa3); \
        } \
        if (more_) { asm volatile("s_waitcnt vmcnt(0)" ::: "memory"); AT_SWRITE((BUF) ^ 1); } \
        if (VAR == 1) { const bool done_ = __all(carry < SB_DONE); if (lane == 0) flags[((t) & 1) * 8 + wid] = done_ ? 1u : 0u; } \
        __syncthreads(); \
    } while (0)
    auto tile_math = [&](f32x16& p0, f32x16& p1, int kb, bf16x8& pa0, bf16x8& pa1, bf16x8& pa2, bf16x8& pa3) __attribute__((always_inline)) {
        const int dq = qpos - kb - 4 * hi;
        if (VAR == 1) {
            const bool need_mask = kb + 63 >= qlo;
            f32x16 n0, n1;
#pragma unroll
            for (int r = 0; r < 16; ++r) { const float z = p0[r]; const float lp = __builtin_amdgcn_logf(1.0f + __builtin_amdgcn_exp2f(-fabsf(z))); n0[r] = fminf(-z, 0.f) - lp;
                                           const float y = p1[r]; const float lq = __builtin_amdgcn_logf(1.0f + __builtin_amdgcn_exp2f(-fabsf(y))); n1[r] = fminf(-y, 0.f) - lq; }
            if (need_mask) {
#pragma unroll
                for (int r = 0; r < 16; ++r) { const int c = (r & 3) + 8 * (r >> 2);
                    if (dq - c <= 0) { n0[r] = 0.f; p0[r] = -__builtin_inff(); }
                    if (dq - c - 32 <= 0) { n1[r] = 0.f; p1[r] = -__builtin_inff(); } }
            }
            float A[8], Bp[8];
#pragma unroll
            for (int q = 0; q < 4; ++q) { A[q] = (n0[4 * q] + n0[4 * q + 1]) + (n0[4 * q + 2] + n0[4 * q + 3]); A[4 + q] = (n1[4 * q] + n1[4 * q + 1]) + (n1[4 * q + 2] + n1[4 * q + 3]); }
#pragma unroll
            for (int q = 0; q < 8; ++q) Bp[q] = partner(A[q], hi);
            float st = 0.f;
#pragma unroll
            for (int q = 7; q >= 0; --q) {
                const float after = carry + st + (hi == 0 ? Bp[q] : 0.f);
                if (q >= 4) { const int r0 = 4 * (q - 4);
                    float tl = after; p1[r0 + 3] = __builtin_amdgcn_exp2f(p1[r0 + 3] + n1[r0 + 3] + tl); tl += n1[r0 + 3]; p1[r0 + 2] = __builtin_amdgcn_exp2f(p1[r0 + 2] + n1[r0 + 2] + tl); tl += n1[r0 + 2];
                    p1[r0 + 1] = __builtin_amdgcn_exp2f(p1[r0 + 1] + n1[r0 + 1] + tl); tl += n1[r0 + 1]; p1[r0] = __builtin_amdgcn_exp2f(p1[r0] + n1[r0] + tl); }
                else { const int r0 = 4 * q;
                    float tl = after; p0[r0 + 3] = __builtin_amdgcn_exp2f(p0[r0 + 3] + n0[r0 + 3] + tl); tl += n0[r0 + 3]; p0[r0 + 2] = __builtin_amdgcn_exp2f(p0[r0 + 2] + n0[r0 + 2] + tl); tl += n0[r0 + 2];
                    p0[r0 + 1] = __builtin_amdgcn_exp2f(p0[r0 + 1] + n0[r0 + 1] + tl); tl += n0[r0 + 1]; p0[r0] = __builtin_amdgcn_exp2f(p0[r0] + n0[r0] + tl); }
                st += A[q] + Bp[q];
            }
            carry += st;
            pack_p(p0, p1, pa0, pa1, pa2, pa3);
        } else {
            if (VAR == 0) {
                const LAS float* rp = Rt + (575 - (qpos - kb) + 4 * hi);
#pragma unroll
                for (int r = 0; r < 16; ++r) { const int c = (r & 3) + 8 * (r >> 2); p0[r] += rp[c]; p1[r] += rp[c + 32]; }
            } else {
                const LAS float* cp = cumL + kb + 4 * hi;
#pragma unroll
                for (int q = 0; q < 4; ++q) { const f32x4 c0 = *(const LAS f32x4*)(cp + 8 * q), c1 = *(const LAS f32x4*)(cp + 32 + 8 * q);
                    p0[4 * q] -= c0[0]; p0[4 * q + 1] -= c0[1]; p0[4 * q + 2] -= c0[2]; p0[4 * q + 3] -= c0[3];
                    p1[4 * q] -= c1[0]; p1[4 * q + 1] -= c1[1]; p1[4 * q + 2] -= c1[2]; p1[4 * q + 3] -= c1[3]; }
                if (kb + 63 > qlo) {
#pragma unroll
                    for (int r = 0; r < 16; ++r) { const int c = (r & 3) + 8 * (r >> 2);
                        if (dq - c < 0) p0[r] = -__builtin_inff();
                        if (dq - c - 32 < 0) p1[r] = -__builtin_inff(); }
                }
            }
            float pmax = p0[0];
#pragma unroll
            for (int r = 1; r < 16; ++r) pmax = fmaxf(pmax, p0[r]);
#pragma unroll
            for (int r = 0; r < 16; ++r) pmax = fmaxf(pmax, p1[r]);
            pmax = xchg_max(pmax, hi);
            float mn, alpha;
            if (__all(pmax - m_reg <= THR2)) { mn = m_reg; alpha = 1.f; }
            else { mn = fmaxf(m_reg, pmax); alpha = __builtin_amdgcn_exp2f(m_reg - mn); m_reg = mn; }
            float ps = 0.f;
#pragma unroll
            for (int r = 0; r < 16; ++r) { p0[r] = __builtin_amdgcn_exp2f(p0[r] - mn); p1[r] = __builtin_amdgcn_exp2f(p1[r] - mn); ps += p0[r] + p1[r]; }
            ps = xchg_sum(ps, hi);
            l_reg = l_reg * alpha + ps;
            if (__any(alpha < 1.f)) {
                if (hi == 0) al_l[r32] = alpha;
                asm volatile("s_waitcnt lgkmcnt(0)" ::: "memory");
                float av[16];
#pragma unroll
                for (int r = 0; r < 16; ++r) av[r] = al_l[crow(r, hi)];
#pragma unroll
                for (int d = 0; d < 4; ++d)
#pragma unroll
                    for (int r = 0; r < 16; ++r) o[d][r] *= av[r];
            }
            pack_p(p0, p1, pa0, pa1, pa2, pa3);
        }
    };
    for (int t = 0; t < NT; t += 2) {
        AT_STEP(0, t);
        if (VAR == 1) { unsigned all_ = 1u; for (int w = 0; w < 8; ++w) all_ &= flags[(t & 1) * 8 + w]; if (all_) break; }
        if (t + 1 >= NT) break;
        AT_STEP(1, t + 1);
        if (VAR == 1) { unsigned all_ = 1u; for (int w = 0; w < 8; ++w) all_ &= flags[((t + 1) & 1) * 8 + w]; if (all_) break; }
    }
    float rli[16];
    if (VAR != 1) {
        if (hi == 0) li_l[r32] = l_reg;
        asm volatile("s_waitcnt lgkmcnt(0)" ::: "memory");
#pragma unroll
        for (int r = 0; r < 16; ++r) rli[r] = __builtin_amdgcn_rcpf(li_l[crow(r, hi)]);
    }
    unsigned char* Ow8 = (unsigned char*)OB + (size_t)(b * S + qlo) * D + g * HD;
#pragma unroll
    for (int r = 0; r < 16; ++r) { const int orow = crow(r, hi);
#pragma unroll
        for (int d0 = 0; d0 < 4; ++d0) { const float v = VAR != 1 ? o[d0][r] * rli[r] : o[d0][r];
            const float vn = lane_read(v, lane ^ 1);
            if ((r32 & 1) == 0) *(unsigned short*)(Ow8 + (size_t)orow * D + d0 * 32 + r32) = (unsigned short)__builtin_amdgcn_cvt_pk_fp8_f32(clamp8(v * 16.0f), clamp8(vn * 16.0f), 0, false); } }
    __syncthreads();
#undef AT_STEP
#undef AT_SLOAD
#undef AT_SWRITE
#undef AT_KBASE
#undef AT_ACT
}

template <int VAR>
__device__ __forceinline__ void attn_queue(const bf16_t* Qh, const bf16_t* Kh, const bf16_t* Vh, bf16_t* OB, const float* relb, const float* LOGF, unsigned* qhead, LAS unsigned char* lds, int wave0) {
    FRESH_TID(); FRESH_LDS(lds);
    volatile LAS unsigned* qslot = (volatile LAS unsigned*)(lds + OFF_MISC) + 32;
    constexpr int NHV = VAR == 0 ? 12 : 10, NITEMS = 8 * NHV * 8;
    for (;;) {
        if (tid == 0) qslot[0] = __hip_atomic_fetch_add(qhead, 1u, __ATOMIC_RELAXED, __HIP_MEMORY_SCOPE_AGENT);
        __syncthreads();
        const int idx = (int)qslot[0];
        __syncthreads();
        if (idx >= NITEMS) break;
        const int qb = 7 - idx / (8 * NHV), bh = idx % (8 * NHV);
        attn_item<VAR>(Qh, Kh, Vh, OB, relb, LOGF, bh / NHV, bh % NHV, qb, lds, tid);
    }
}
__device__ __forceinline__ void attn_phase(const bf16_t* Qh, const bf16_t* Kh, const bf16_t* Vh, bf16_t* OB, const float* relb, const float* LOGF, unsigned* qheads, LAS unsigned char* lds, int wave0) {
    attn_queue<2>(Qh, Kh, Vh, OB, relb, LOGF, qheads + 0, lds, wave0);
    attn_queue<0>(Qh, Kh, Vh, OB, relb, LOGF, qheads + 64, lds, wave0);
    attn_queue<1>(Qh, Kh, Vh, OB, relb, LOGF, qheads + 128, lds, wave0);
}
}
namespace mk {
#define XB_TMO      128
#define XB_XCNT(j)  (256  + 64 * (j))
#define XB_XSUB(j)  (1280 + 64 * (j))
#define XB_XGEN(j)  (2304 + 64 * (j))
#define XB_TOP      3328
#define XB_TOPGEN   3392
#define XCD_BAR_WORDS 3456
#define XB_SPIN_CAP (1u << 22)

__device__ __forceinline__ unsigned xb_ld(unsigned* p)              { return __hip_atomic_load(p, __ATOMIC_RELAXED, __HIP_MEMORY_SCOPE_AGENT); }
__device__ __forceinline__ unsigned xb_add(unsigned* p, unsigned v) { return __hip_atomic_fetch_add(p, v, __ATOMIC_RELAXED, __HIP_MEMORY_SCOPE_AGENT); }
__device__ __forceinline__ unsigned xb_xcc_id() { return (unsigned)__builtin_amdgcn_s_getreg((3 << 11) | 20) & 0xFu; }
#define XB_SPIN(cond, bar) do { unsigned _sp = 0; while (cond) { __builtin_amdgcn_s_sleep(1); \
    if ((++_sp & 255u) == 0u) { if (xb_ld(&(bar)[XB_TMO])) break; if (_sp > XB_SPIN_CAP) { atomicAdd(&(bar)[XB_TMO], 1u); break; } } } } while (0)

struct XcdBarrier {
    unsigned* bar; unsigned x;
    volatile LAS unsigned* st;
};

__device__ __forceinline__ XcdBarrier xcd_barrier_post(unsigned* bar, volatile LAS unsigned* st, bool is_t0) {
    XcdBarrier b; b.bar = bar; b.x = xb_xcc_id(); b.st = st;
    if (is_t0) (void)xb_add(&bar[XB_XCNT(b.x)], 1u);
    return b;
}
__device__ __forceinline__ void xcd_barrier_complete(unsigned* bar, unsigned x, unsigned& nloc, unsigned& nx) {
    const unsigned G = gridDim.x * gridDim.y * gridDim.z;
    unsigned sum, cnt, mine, sp = 0u;
    for (;;) {
        sum = 0u; cnt = 0u; mine = 0u;
#pragma unroll
        for (unsigned j = 0; j < 16; ++j) { const unsigned c = xb_ld(&bar[XB_XCNT(j)]); sum += c; cnt += (c > 0u) ? 1u : 0u; mine = (j == x) ? c : mine; }
        if (sum == G) break;
        __builtin_amdgcn_s_sleep(1);
        if ((++sp & 255u) == 0u) { if (xb_ld(&bar[XB_TMO])) break; if (sp > XB_SPIN_CAP) { atomicAdd(&bar[XB_TMO], 1u); break; } }
    }
    nloc = mine > 0u ? mine : 1u; nx = cnt > 0u ? cnt : 1u;
}

__device__ __forceinline__ void xcd_barrier(const XcdBarrier& b, bool is_t0) {
    asm volatile("s_waitcnt vmcnt(0)" ::: "memory");
    __syncthreads();
    if (is_t0) {
        unsigned* bar = b.bar;
        __builtin_amdgcn_s_waitcnt(0);
        unsigned nloc = b.st[0], nx = b.st[1];
        if (nloc == 0u) { xcd_barrier_complete(bar, b.x, nloc, nx); b.st[0] = nloc; b.st[1] = nx; }
        const unsigned old = xb_add(&bar[XB_XSUB(b.x)], 1u);
        const unsigned gen = old / nloc;
        if (old + 1u == (gen + 1u) * nloc) {
            __builtin_amdgcn_fence(__ATOMIC_RELEASE, "agent");
            asm volatile("s_waitcnt vmcnt(0)" ::: "memory");
            const unsigned og = xb_add(&bar[XB_TOP], 1u);
            const unsigned tg = og / nx;
            if (og + 1u == (tg + 1u) * nx) xb_add(&bar[XB_TOPGEN], 1u);
            else XB_SPIN(xb_ld(&bar[XB_TOPGEN]) == tg, bar);
            __builtin_amdgcn_fence(__ATOMIC_ACQUIRE, "agent");
            xb_add(&bar[XB_XGEN(b.x)], 1u);
            asm volatile("s_waitcnt vmcnt(0)" ::: "memory");
        } else {
            XB_SPIN(xb_ld(&bar[XB_XGEN(b.x)]) == gen, bar);
            __builtin_amdgcn_fence(__ATOMIC_ACQUIRE, "agent");
            asm volatile("s_waitcnt vmcnt(0)" ::: "memory");
        }
    }
    __syncthreads();
}

constexpr int PH_PER_LAYER = 8;
typedef const __attribute__((address_space(4))) Args* KArgs;
#define KARGS() ({ KArgs p_ = (KArgs)__builtin_amdgcn_kernarg_segment_ptr(); asm volatile("" : "+s"(p_)); p_; })
#define GRID_BAR() do { KArgs k_ = KARGS(); XcdBarrier b_; b_.bar = (unsigned*)(k_->ws + WS_CTL) + CW_BAR; b_.x = xb_xcc_id(); b_.st = (volatile LAS unsigned*)(lds + MISC_OFF) + 8; unsigned z_ = 0u; asm volatile("" : "+v"(z_)); const bool t0_ = (wave0 == 0) && (__builtin_amdgcn_mbcnt_hi(~0u, __builtin_amdgcn_mbcnt_lo(~0u, z_)) == 0u);     xcd_barrier(b_, t0_); } while (0)
__global__ void __launch_bounds__(NWAVES * 64, 2) mk_fwd(Args a_unused) {
    extern __shared__ __attribute__((aligned(16))) unsigned char lds_raw[];
    LAS unsigned char* lds = (LAS unsigned char*)lds_raw;
    const int wave0 = __builtin_amdgcn_readfirstlane((int)threadIdx.x >> 6);
    for (int u = threadIdx.x; u < (LDS_BYTES - LDSCTL_OFF) / 4; u += NWAVES * 64) ((LAS unsigned*)(lds + LDSCTL_OFF))[u] = 0u;
    __syncthreads();
    int lo, hi;
    { KArgs k = KARGS(); lo = k->ph_lo; hi = k->ph_hi;
      if (hi - lo > 1) (void)xcd_barrier_post((unsigned*)(k->ws + WS_CTL) + CW_BAR, (volatile LAS unsigned*)(lds + MISC_OFF) + 8, threadIdx.x == 0); }
#define IN(k) (lo <= (k) && (k) < hi)
#define BOTH(k) (IN(k) && IN((k) + 1))
#pragma unroll
    for (int l = 0; l < 2; ++l) {
        const int pb = PH_PER_LAYER * l;
        if (IN(pb + 0)) { KArgs k = KARGS(); conv_phase(k, l, lds, wave0); }
        if (IN(pb + 1) && l == 0) {
            KArgs k = KARGS(); unsigned char* ws = k->ws;
            const float* xin = k->in[0];
            prep_phase<true>(xin, (bf16_t*)(ws + WS_XB8N), (float*)(ws + WS_RSTD), k->in[2] + (size_t)l * D * PW, k->in[1] + (size_t)l * D, k->in[3] + l * 10, (float*)(ws + WS_LOGF), lds, wave0);
            if (BOTH(pb + 1)) GRID_BAR();
        }
        if (l == 1 && IN(pb + 0) && IN(pb + 2)) GRID_BAR();
        if (IN(pb + 2)) {
            KArgs k = KARGS(); unsigned char* ws = k->ws;
            pg8::Gemm g{(const bf16_t*)(ws + WS_XB8N), (const bf16_t*)(ws + WS_WIN), M, 12288, D}; pg8::StaticOrder So; FRESH_BID(); So.init(M, 12288, G, bid);
            pg8::EpiQKV4 E{(bf16_t*)(ws + WS_Q), (const float*)(ws + WS_RSTD), 0.08838834764831845f * 1.4426950408889634f, US_INV};
            { LAS unsigned char* lds_ = lds; FRESH_LDS(lds_); FRESH_TID(); pg8::gemm_phase<pg8::EpiQKV4, pg8::StaticOrder, true, true, true>(lds_, g, So, E, tid); }
            if (BOTH(pb + 2)) GRID_BAR();
        }
        if (IN(pb + 3)) {
            KArgs k = KARGS(); unsigned char* ws = k->ws;
            at::attn_phase((const bf16_t*)(ws + WS_Q), (const bf16_t*)(ws + WS_K), (const bf16_t*)(ws + WS_V), (bf16_t*)(ws + WS_OB), k->in[4] + (size_t)l * 12 * 257, (const float*)(ws + WS_LOGF),
                           (unsigned*)(ws + WS_CTL) + CW_QUEUE + 256 * l, lds, wave0);
            if (BOTH(pb + 3)) GRID_BAR();
        }
        if (IN(pb + 4)) {
            KArgs k = KARGS(); unsigned char* ws = k->ws;
            pg8::Gemm g{(const bf16_t*)(ws + WS_OB), (const bf16_t*)(ws + WS_WOUT), M, D, D}; pg8::StaticOrder So; FRESH_BID(); So.init(M, D, G, bid);
            if (l == 0) { pg8::EpiResidB16<true> E{k->in[0], US_INV * (1.0f / 16.0f), (bf16_t*)(ws + WS_XB)};
                { LAS unsigned char* lds_ = lds; FRESH_LDS(lds_); FRESH_TID(); pg8::gemm_phase<pg8::EpiResidB16<true>, pg8::StaticOrder, false, true, true>(lds_, g, So, E, tid); } }
            else { pg8::EpiResidB16<false> E{ws + WS_X2, US_INV * (1.0f / 16.0f), (bf16_t*)(ws + WS_XB)};
                { LAS unsigned char* lds_ = lds; FRESH_LDS(lds_); FRESH_TID(); pg8::gemm_phase<pg8::EpiResidB16<false>, pg8::StaticOrder, false, true, true>(lds_, g, So, E, tid); } }
            if (BOTH(pb + 4)) GRID_BAR();
        }
        if (IN(pb + 5)) {
            KArgs k = KARGS(); unsigned char* ws = k->ws;
            pg8::Gemm g{(const bf16_t*)(ws + WS_XB), (const bf16_t*)(ws + WS_WQK), M, 2048, D}; pg8::StaticOrder So; FRESH_BID(); So.init(M, 2048, G, bid);
            pg8::EpiPlainF32<2048> E{(float*)(ws + WS_SC)};
            { LAS unsigned char* lds_ = lds; FRESH_LDS(lds_); FRESH_TID(); pg8::gemm_phase<pg8::EpiPlainF32<2048>, pg8::StaticOrder, true, true>(lds_, g, So, E, tid); }
            if (BOTH(pb + 5)) GRID_BAR();
        }
        if (IN(pb + 6)) {
            KArgs k = KARGS(); unsigned char* ws = k->ws;
            if (l == 0) peer_uv_phase<false>((const float*)(ws + WS_SC), (const unsigned char*)(ws + WS_U16), (const unsigned char*)(ws + WS_U16) + (size_t)NE * ROW6  , (const bf16_t*)(ws + WS_XB), ws + WS_X2, nullptr,
                                             ws + WS_XB8N, (float*)(ws + WS_RSTD), (float*)(ws + WS_LOGF), k->in[2] + (size_t)D * PW, k->in[1] + D, k->in[3] + 10, lds, wave0);
            else peer_uv_phase<true>((const float*)(ws + WS_SC), (const unsigned char*)(ws + WS_U16), (const unsigned char*)(ws + WS_U16) + (size_t)NE * ROW6  , (const bf16_t*)(ws + WS_XB), k->out, k->in[12],
                                     nullptr, nullptr, nullptr, nullptr, nullptr, nullptr, lds, wave0);
            if (BOTH(pb + 7)) GRID_BAR();
        }
    }
#undef IN
#undef BOTH
}

static int g_grid = 0;
static void launch_phases(Args a, int lo, int hi, hipStream_t st) {
    a.ph_lo = lo; a.ph_hi = hi;
    hipLaunchKernelGGL(mk_fwd, dim3(g_grid), dim3(NWAVES * 64), LDS_BYTES, st, a);
}
}

extern "C" void kernel_launch(void* const* d_in, const int* in_sizes, int n_in, void* d_out, int out_size, void* d_ws, size_t ws_size, hipStream_t stream) {
    (void)in_sizes; (void)n_in; (void)out_size;
    using namespace mk;
    if (g_grid == 0) {
        if (ws_size < 2048 * MiB) { fprintf(stderr, "kernel_launch: workspace too small (%zu)\n", ws_size); g_grid = -1; return; }
        if (hipFuncSetAttribute((const void*)mk_fwd, hipFuncAttributeMaxDynamicSharedMemorySize, LDS_BYTES) != hipSuccess) { fprintf(stderr, "kernel_launch: hipFuncSetAttribute failed\n"); g_grid = -1; return; }
        int dev = 0, cus = 0; (void)hipGetDevice(&dev); (void)hipDeviceGetAttribute(&cus, hipDeviceAttributeMultiprocessorCount, dev);
        g_grid = cus > 0 ? cus : 256;
    }
    if (g_grid < 0) return;
    unsigned char* ws = (unsigned char*)d_ws; float* out = (float*)d_out;
    (void)hipMemsetAsync(ws + WS_CTL, 0, CTL_ZERO_BYTES, stream);
    Args a{};
    for (int i = 0; i < 13; ++i) a.in[i] = (const float*)d_in[i];
    a.out = out; a.ws = ws;
    launch_phases(a, 0, 2 * PH_PER_LAYER, stream);
}
```

```cpp
#include <hip/hip_runtime.h>
#include <cstdio>
#include <cstdint>
namespace pg8 {
#define PG8_LAS __attribute__((address_space(3)))
typedef unsigned short bf16_t;
typedef short bf16x8 __attribute__((ext_vector_type(8)));
typedef float f32x4 __attribute__((ext_vector_type(4)));
typedef unsigned u32x4 __attribute__((ext_vector_type(4)));
typedef unsigned u32x2 __attribute__((ext_vector_type(2)));
constexpr int BM = 256, BK = 64, HALF = 128, HTB = HALF * BK * 2  , STAGE_BYTES = 8 * HTB, NXCD = 8, WGM = 8;

__host__ __device__ __forceinline__ int lds_byte(int r, int c) { const int st = (r >> 4) * 2 + (c >> 5), rr = r & 15, cc = c & 31, ob = rr * 64 + cc * 2; return st * 1024 + (ob ^ (((ob >> 9) & 1) << 5)); }
__host__ __device__ __forceinline__ void stage_rc(int b, int& R, int& C) { const int st = b / 1024, sb = b % 1024, swz = sb ^ (((sb >> 9) & 1) << 5); R = (st >> 1) * 16 + swz / 64; C = (st & 1) * 32 + (swz % 64) / 2; }
__host__ __device__ __forceinline__ int perm32(int rho) { const int n = rho >> 4, i = rho & 15; return 8 * (i >> 2) + 4 * n + (i & 3); }

struct Unit { int pm, pn; };
struct Gemm { const bf16_t* A; const bf16_t* Bt; int M, N, K; };

struct StaticOrder {
    int nM, nN, nwg, G, c;
    __host__ __device__ void init(int M, int N, int G_, int c_) { nM = M / BM; nN = N / BM; nwg = nM * nN; G = G_; c = c_; }
    __host__ __device__ bool next(int i, Unit& u) const {
        const long L = (long)i * G + c; if (L >= nwg) return false;
        int wgid = (int)L; { const int q = nwg / NXCD, r = nwg % NXCD, xcd = wgid % NXCD, off = wgid / NXCD; wgid = (xcd < r ? xcd * (q + 1) : r * (q + 1) + (xcd - r) * q) + off; }
        const int nig = WGM * nN, gid = wgid / nig, fm = gid * WGM, gsz = (nM - fm) < WGM ? (nM - fm) : WGM;
        u.pm = fm + ((wgid % nig) % gsz); u.pn = (wgid % nig) / gsz; return true;
    }
    __device__ __forceinline__ void a_ready(const Unit&) const {}
    __device__ __forceinline__ void done(const Unit&) const {}
};
__device__ __forceinline__ unsigned cvt_pk_bf16(float lo, float hi) { unsigned r; asm volatile("v_cvt_pk_bf16_f32 %0, %1, %2" : "=v"(r) : "v"(lo), "v"(hi)); return r; }
typedef float f32x2 __attribute__((ext_vector_type(2)));
__device__ __forceinline__ f32x2 gelu_pk(f32x2 v) {
    const f32x2 av = __builtin_elementwise_abs(v), d = av * 0.2316418882f + 1.0f;
    f32x2 t; t.x = __builtin_amdgcn_rcpf(d.x); t.y = __builtin_amdgcn_rcpf(d.y);
    f32x2 q = t * 0.5307027145f + (-0.7265760135f); q = q * t + 0.7107068705f; q = q * t + (-0.142248368f); q = q * t + 0.127414796f; q = q * t;
    const f32x2 s = (v * v) * (-0.72134752044f);
    f32x2 e; e.x = __builtin_amdgcn_exp2f(s.x); e.y = __builtin_amdgcn_exp2f(s.y);
    const f32x2 m = v * (q * e), r = v - m;
    f32x2 o; o.x = v.x < 0.f ? m.x : r.x; o.y = v.y < 0.f ? m.y : r.y; return o;
}
#define EPI_FRESH_LANE() { unsigned z_ = 0u; asm volatile("" : "+v"(z_)); const int l_ = (int)__builtin_amdgcn_mbcnt_hi(~0u, __builtin_amdgcn_mbcnt_lo(~0u, z_)); fr = l_ & 15; fq = l_ >> 4; }
typedef __amdgpu_buffer_rsrc_t rsrc_t;
__device__ __forceinline__ rsrc_t mkrsrc(const void* p, unsigned bytes) { return __builtin_amdgcn_make_buffer_rsrc((void*)p, (short)0, (int)bytes, 0x00020000); }
template <int LDC> struct EpiPlainF32 {
    static constexpr bool PERM = false, AFTER_DRAIN = false;
    float* C;
    __device__ __forceinline__ void operator()(const f32x4 (&acc)[2][2][4][2], const Unit& u, int wr, int wc, int fr, int fq) const {
        EPI_FRESH_LANE();
        const rsrc_t rc = mkrsrc(C, 16384u * LDC * 4u);
        const int vo = ((wr * 64 + fr) * LDC + wc * 32 + 4 * fq) * 4, so = (u.pm * BM * LDC + u.pn * BM) * 4;
#pragma unroll
        for (int ai = 0; ai < 2; ++ai)
#pragma unroll
            for (int m = 0; m < 4; ++m)
#pragma unroll
                for (int bj = 0; bj < 2; ++bj)
#pragma unroll
                    for (int n = 0; n < 2; ++n) __builtin_amdgcn_raw_buffer_store_b128(__builtin_bit_cast(u32x4, acc[ai][bj][m][n]), rc, vo, so + ((ai * HALF + m * 16) * LDC + bj * HALF + n * 16) * 4, 0);
    }
};
template <int LDC> struct EpiRowScaleF32 {
    static constexpr bool PERM = false, AFTER_DRAIN = false;
    float* C; const float* rs;
    __device__ __forceinline__ void operator()(const f32x4 (&acc)[2][2][4][2], const Unit& u, int wr, int wc, int fr, int fq) const {
        const rsrc_t rc = mkrsrc(C, 16384u * LDC * 4u), rr = mkrsrc(rs, 16384u * 4u);
        const int vo = ((wr * 64 + fr) * LDC + wc * 32 + 4 * fq) * 4, vr = (wr * 64 + fr) * 4;
        const int so = (u.pm * BM * LDC + u.pn * BM) * 4, sr = u.pm * BM * 4;
#pragma unroll
        for (int ai = 0; ai < 2; ++ai)
#pragma unroll
            for (int m = 0; m < 4; ++m) { const float s = __builtin_bit_cast(float, __builtin_amdgcn_raw_buffer_load_b32(rr, vr, sr + (ai * HALF + m * 16) * 4, 0));
#pragma unroll
                for (int bj = 0; bj < 2; ++bj)
#pragma unroll
                    for (int n = 0; n < 2; ++n) { const f32x4 v = acc[ai][bj][m][n] * s; __builtin_amdgcn_raw_buffer_store_b128(__builtin_bit_cast(u32x4, v), rc, vo, so + ((ai * HALF + m * 16) * LDC + bj * HALF + n * 16) * 4, 0); } }
    }
};
template <bool BASE_F32> struct EpiResidB16 {
    static constexpr bool PERM = false, AFTER_DRAIN = false;
    const void* base; float ascale; bf16_t* xb;
    __device__ __forceinline__ void operator()(const f32x4 (&acc)[2][2][4][2], const Unit& u, int wr, int wc, int fr, int fq) const {
        EPI_FRESH_LANE();
        constexpr int LDC = 4096;
        const rsrc_t rb = mkrsrc(base, 16384u * LDC * (BASE_F32 ? 4u : 2u)), rx = mkrsrc(xb, 16384u * LDC * 2u);
        const int vo = ((wr * 64 + fr) * LDC + wc * 32 + 4 * fq) * 2;
        const int so = (u.pm * BM * LDC + u.pn * BM) * 2;
        f32x4 ra[2][2], rb2[2][2];
#define EPI_LD(dst, g_) do { _Pragma("unroll") for (int bj = 0; bj < 2; ++bj) _Pragma("unroll") for (int n = 0; n < 2; ++n) { \
            const int o = so + ((((g_) >> 2) * HALF + ((g_) & 3) * 16) * LDC + bj * HALF + n * 16) * 2; \
            if constexpr (BASE_F32) dst[bj][n] = __builtin_bit_cast(f32x4, __builtin_amdgcn_raw_buffer_load_b128(rb, vo * 2, o * 2, 0)); \
            else { const u32x2 t_ = __builtin_amdgcn_raw_buffer_load_b64(rb, vo, o, 0); dst[bj][n] = (f32x4){__builtin_bit_cast(float, t_.x << 16), __builtin_bit_cast(float, t_.x & 0xffff0000u), __builtin_bit_cast(float, t_.y << 16), __builtin_bit_cast(float, t_.y & 0xffff0000u)}; } } } while (0)
#define EPI_ST(src, g_) do { _Pragma("unroll") for (int bj = 0; bj < 2; ++bj) _Pragma("unroll") for (int n = 0; n < 2; ++n) { \
            const int o = so + ((((g_) >> 2) * HALF + ((g_) & 3) * 16) * LDC + bj * HALF + n * 16) * 2; \
            const f32x4 v = src[bj][n] + acc[(g_) >> 2][bj][(g_) & 3][n] * ascale; \
            u32x2 w; w.x = cvt_pk_bf16(v[0], v[1]); w.y = cvt_pk_bf16(v[2], v[3]); __builtin_amdgcn_raw_buffer_store_b64(w, rx, vo, o, 0); } } while (0)
        EPI_LD(ra, 0);
        EPI_LD(rb2, 1); EPI_ST(ra, 0);
        EPI_LD(ra, 2); EPI_ST(rb2, 1);
        EPI_LD(rb2, 3); EPI_ST(ra, 2);
        EPI_LD(ra, 4); EPI_ST(rb2, 3);
        EPI_LD(rb2, 5); EPI_ST(ra, 4);
        EPI_LD(ra, 6); EPI_ST(rb2, 5);
        EPI_LD(rb2, 7); EPI_ST(ra, 6);
        EPI_ST(rb2, 7);
#undef EPI_LD
#undef EPI_ST
    }
};
struct EpiQKV {
    static constexpr bool PERM = true, AFTER_DRAIN = false;
    bf16_t* Q; const float* rs; float qscale;
    __device__ __forceinline__ void operator()(const f32x4 (&acc)[2][2][4][2], const Unit& u, int wr, int wc, int fr, int fq) const {
        const rsrc_t rq = mkrsrc(Q, 3u * 16384u * 4096u * 2u), rr = mkrsrc(rs, 16384u * 4u);
        const int colt = u.pn * BM, which = colt >> 12, cw = colt & 4095, gt = cw >> 7;
        const int b = (u.pm * BM) >> 11, st = (u.pm * BM) & 2047;
        const float sc = which == 0 ? qscale : 1.f;
        const int so = (int)(((unsigned)which << 26) + (((unsigned)(b * 32 + gt) * 2048u + (unsigned)st) << 7)) * 2;
        const int vo = (((wr * 64 + fr) << 7) + wc * 32 + 8 * fq) * 2, vr = (wr * 64 + fr) * 4, sr = u.pm * BM * 4;
#pragma unroll
        for (int ai = 0; ai < 2; ++ai)
#pragma unroll
            for (int m = 0; m < 4; ++m) { const float f = sc * __builtin_bit_cast(float, __builtin_amdgcn_raw_buffer_load_b32(rr, vr, sr + (ai * HALF + m * 16) * 4, 0));
#pragma unroll
                for (int bj = 0; bj < 2; ++bj) {
                    const f32x4 v0 = acc[ai][bj][m][0] * f, v1 = acc[ai][bj][m][1] * f;
                    u32x4 w; w.x = cvt_pk_bf16(v0[0], v0[1]); w.y = cvt_pk_bf16(v0[2], v0[3]); w.z = cvt_pk_bf16(v1[0], v1[1]); w.w = cvt_pk_bf16(v1[2], v1[3]);
                    __builtin_amdgcn_raw_buffer_store_b128(w, rq, vo, so + ((bj * 2048 + ai * HALF + m * 16) << 7) * 2, 0); } }
    }
};

struct EpiQKV4 {
    static constexpr bool PERM = false, AFTER_DRAIN = false;
    bf16_t* Q; const float* rs; float qscale, wscale;
    __device__ __forceinline__ void operator()(const f32x4 (&acc)[2][2][4][2], const Unit& u, int wr, int wc, int fr, int fq) const {
        EPI_FRESH_LANE();
        const rsrc_t rq = mkrsrc(Q, 3u * 16384u * 4096u * 2u), rr = mkrsrc(rs, 16384u * 4u);
        const int colt = u.pn * BM, which = colt >> 12, cw = colt & 4095, gt = cw >> 7;
        const int b = (u.pm * BM) >> 11, st = (u.pm * BM) & 2047;
        const float sc = (which == 0 ? qscale : 1.f) * wscale;
        const int so = (int)(((unsigned)which << 26) + (((unsigned)(b * 32 + gt) * 2048u + (unsigned)st) << 7)) * 2;
        const int vo = (((wr * 64 + fr) << 7) + wc * 32 + 4 * fq) * 2, vr = (wr * 64 + fr) * 4, sr = u.pm * BM * 4;
        unsigned rsv[2][4];
#pragma unroll
        for (int ai = 0; ai < 2; ++ai)
#pragma unroll
            for (int m = 0; m < 4; ++m) rsv[ai][m] = __builtin_amdgcn_raw_buffer_load_b32(rr, vr, sr + (ai * HALF + m * 16) * 4, 0);
#pragma unroll
        for (int ai = 0; ai < 2; ++ai)
#pragma unroll
            for (int m = 0; m < 4; ++m) { const float f = sc * __builtin_bit_cast(float, rsv[ai][m]);
#pragma unroll
                for (int bj = 0; bj < 2; ++bj)
#pragma unroll
                    for (int n = 0; n < 2; ++n) { const f32x4 v0 = acc[ai][bj][m][n] * f; u32x2 w; w.x = cvt_pk_bf16(v0[0], v0[1]); w.y = cvt_pk_bf16(v0[2], v0[3]);
                        __builtin_amdgcn_raw_buffer_store_b64(w, rq, vo, so + (((bj * 2048 + ai * HALF + m * 16) << 7) + n * 16) * 2, 0); } }
    }
};

typedef int i32x8 __attribute__((ext_vector_type(8)));
template <bool F8> struct FragT { typedef bf16x8 type; };
template <> struct FragT<true> { typedef i32x8 type; };
__device__ __forceinline__ f32x4 mma_bf16(bf16x8 a, bf16x8 b, f32x4 c) { return __builtin_amdgcn_mfma_f32_16x16x32_bf16(a, b, c, 0, 0, 0); }
__device__ __forceinline__ f32x4 mma_bf16(i32x8, i32x8, f32x4 c) { return c; }
template <class Epi, class Sched, bool ALIGN_EPI = false, bool SP2 = false, bool F8 = false>
__device__ __forceinline__ void gemm_phase(PG8_LAS unsigned char* lds, const Gemm g, const Sched& S, const Epi& E, int tid_in) {
    int tid_ = tid_in;
    const int tid = tid_, wid = __builtin_amdgcn_readfirstlane(tid >> 6), lane = tid & 63, wr = wid >> 2, wc = wid & 3, fr = lane & 15, fq = lane >> 4;
    constexpr int EB = F8 ? 1 : 2;
    constexpr int K = 4096; constexpr int nt = (K * EB) / (BK * 2);
    unsigned voffA[2], voffB[2];
#pragma unroll
    for (int i = 0; i < 2; ++i) { int R, C; stage_rc(tid * 16 + i * 8192, R, C); const int Rb = Epi::PERM ? ((R & ~31) + perm32(R & 31)) : R;
        voffA[i] = (unsigned)(R * K * EB + C * 2); voffB[i] = (unsigned)(Rb * K * EB + C * 2); }
    const size_t kstep = (size_t)(BK * 2);
    const size_t hstep = (size_t)HALF * K * EB;
    const size_t tstep = 2 * hstep;
    const unsigned ldsw = (unsigned)wid * 1024u;
    const int aoff = F8 ? lds_byte(wr * 64 + fr, fq * 16) + (fq & 1) * 16 : lds_byte(wr * 64 + fr, fq * 8), boff = F8 ? lds_byte(wc * 32 + fr, fq * 16) + (fq & 1) * 16 : lds_byte(wc * 32 + fr, fq * 8);
    const int aoff1 = aoff + (F8 ? 16 - 32 * (fq & 1) : 0);
    const int f8o0_unused = 0; (void)f8o0_unused;
#define PG8_SA(b, h) (((b) * 2 + (h)) * HTB)
#define PG8_SB(b, h) ((4 + (b) * 2 + (h)) * HTB)
#define PG8_STAGE_X(bufoff, gbase, voff, rs_, base_) do { const int so_ = (int)((const char*)(gbase) - (const char*)(base_)); _Pragma("unroll") for (int _i = 0; _i < 2; ++_i) \
        __builtin_amdgcn_raw_ptr_buffer_load_lds(rs_, (PG8_LAS void*)(lds + (bufoff) + ldsw + _i * 8192), 16, (int)(voff)[_i], so_, 0, 0); } while (0)
#define PG8_LDA(dst, b, h) do { if constexpr (F8) { _Pragma("unroll") for (int m = 0; m < 4; ++m) { const u32x4 lo_ = *(const PG8_LAS u32x4*)(lds + PG8_SA(b, h) + aoff + m * 2048), hi_ = *(const PG8_LAS u32x4*)(lds + PG8_SA(b, h) + aoff1 + m * 2048); \
            dst[m][0] = (i32x8){(int)lo_[0], (int)lo_[1], (int)lo_[2], (int)lo_[3], (int)hi_[0], (int)hi_[1], (int)hi_[2], (int)hi_[3]}; } } \
        else { _Pragma("unroll") for (int m = 0; m < 4; ++m) _Pragma("unroll") for (int k = 0; k < 2; ++k) dst[m][k] = *(const PG8_LAS frag_t*)(lds + PG8_SA(b, h) + aoff + m * 2048 + k * 1024); } } while (0)
#define PG8_LDB(dst, b, h) do { if constexpr (F8) { _Pragma("unroll") for (int n = 0; n < 2; ++n) { const u32x4 lo_ = *(const PG8_LAS u32x4*)(lds + PG8_SB(b, h) + boff + n * 2048), hi_ = *(const PG8_LAS u32x4*)(lds + PG8_SB(b, h) + boff + (aoff1 - aoff) + n * 2048); \
            dst[n][0] = (i32x8){(int)lo_[0], (int)lo_[1], (int)lo_[2], (int)lo_[3], (int)hi_[0], (int)hi_[1], (int)hi_[2], (int)hi_[3]}; } } \
        else { _Pragma("unroll") for (int n = 0; n < 2; ++n) _Pragma("unroll") for (int k = 0; k < 2; ++k) dst[n][k] = *(const PG8_LAS frag_t*)(lds + PG8_SB(b, h) + boff + n * 2048 + k * 1024); } } while (0)
#define PG8_MMA(ai, bj, At, Bt) do { __builtin_amdgcn_s_setprio(1); _Pragma("unroll") for (int m = 0; m < 4; ++m) _Pragma("unroll") for (int n = 0; n < 2; ++n) { \
        if constexpr (F8) acc[ai][bj][m][n] = __builtin_amdgcn_mfma_scale_f32_16x16x128_f8f6f4(Bt[n][0], At[m][0], acc[ai][bj][m][n], 0, 0, 0, 0x7f7f7f7f, 0, 0x7f7f7f7f); \
        else { _Pragma("unroll") for (int k = 0; k < 2; ++k) acc[ai][bj][m][n] = mma_bf16(Bt[n][k], At[m][k], acc[ai][bj][m][n]); } } __builtin_amdgcn_s_setprio(0); } while (0)
#define PG8_WAIT_V(n) asm volatile("s_waitcnt vmcnt(" #n ")" ::: "memory")
#define PG8_WAIT_L(n) asm volatile("s_waitcnt lgkmcnt(" #n ")" ::: "memory")
#define PG8_BAR __builtin_amdgcn_s_barrier()
#define PG8_SCHED __builtin_amdgcn_sched_barrier(0)
    const __amdgpu_buffer_rsrc_t rsA = __builtin_amdgcn_make_buffer_rsrc((void*)g.A, (short)0, (int)((size_t)g.M * K * EB), 0x00020000), rsB = __builtin_amdgcn_make_buffer_rsrc((void*)g.Bt, (short)0, (int)((size_t)g.N * K * EB), 0x00020000);
    Unit cur, nxt; int ui = 0;
    if (!S.next(0, cur)) return;
    f32x4 acc[2][2][4][2];
#pragma unroll
    for (int a = 0; a < 2; ++a)
#pragma unroll
        for (int b = 0; b < 2; ++b)
#pragma unroll
            for (int m = 0; m < 4; ++m)
#pragma unroll
                for (int n = 0; n < 2; ++n) acc[a][b][m][n] = (f32x4){0.f, 0.f, 0.f, 0.f};
    typedef typename FragT<F8>::type frag_t;
    frag_t At[4][F8 ? 1 : 2], B0[2][F8 ? 1 : 2], B1[2][F8 ? 1 : 2];
    const char* cA = (const char*)g.A + (size_t)cur.pm * tstep; const char* cB = (const char*)g.Bt + (size_t)cur.pn * tstep;
    S.a_ready(cur);
    if constexpr (SP2) {
        PG8_STAGE_X(PG8_SB(0, 0), cB, voffB, rsB, g.Bt); PG8_STAGE_X(PG8_SB(0, 1), cB + hstep, voffB, rsB, g.Bt); PG8_STAGE_X(PG8_SA(0, 0), cA, voffA, rsA, g.A); PG8_STAGE_X(PG8_SA(0, 1), cA + hstep, voffA, rsA, g.A);
        if (wr == 1) PG8_BAR;
        PG8_WAIT_V(2); PG8_BAR;
        PG8_STAGE_X(PG8_SB(1, 0), cB + kstep, voffB, rsB, g.Bt); PG8_STAGE_X(PG8_SA(1, 0), cA + kstep, voffA, rsA, g.A); PG8_STAGE_X(PG8_SB(1, 1), cB + hstep + kstep, voffB, rsB, g.Bt);
        PG8_WAIT_V(6); PG8_BAR;
    } else {
        PG8_STAGE_X(PG8_SB(0, 0), cB, voffB, rsB, g.Bt); PG8_STAGE_X(PG8_SA(0, 0), cA, voffA, rsA, g.A); PG8_STAGE_X(PG8_SB(0, 1), cB + hstep, voffB, rsB, g.Bt); PG8_STAGE_X(PG8_SA(0, 1), cA + hstep, voffA, rsA, g.A);
        if (wr == 1) PG8_BAR;
        PG8_WAIT_V(4); PG8_BAR;
        PG8_STAGE_X(PG8_SB(1, 0), cB + kstep, voffB, rsB, g.Bt); PG8_STAGE_X(PG8_SA(1, 0), cA + kstep, voffA, rsA, g.A); PG8_STAGE_X(PG8_SB(1, 1), cB + hstep + kstep, voffB, rsB, g.Bt);
        PG8_WAIT_V(6); PG8_BAR;
    }
    for (;;) {
        const bool has_next = S.next(ui + 1, nxt);
        const char* nA = has_next ? (const char*)g.A + (size_t)nxt.pm * tstep : cA; const char* nB = has_next ? (const char*)g.Bt + (size_t)nxt.pn * tstep : cB;
        for (int t = 0; t < nt; t += 2) {
            const bool last = (t == nt - 2);
            const char* a1 = cA + (size_t)(t + 1) * kstep;
            const char* a2 = last ? nA : cA + (size_t)(t + 2) * kstep; const char* b2 = last ? nB : cB + (size_t)(t + 2) * kstep;
            const char* a3 = a2 + kstep; const char* b3 = b2 + kstep;
            if (last && has_next) S.a_ready(nxt);
            if constexpr (SP2) {
            PG8_LDB(B0, 0, 0); PG8_LDB(B1, 0, 1); PG8_SCHED; PG8_LDA(At, 0, 0); PG8_STAGE_X(PG8_SA(1, 1), a1 + hstep, voffA, rsA, g.A);
            PG8_WAIT_V(8); PG8_WAIT_L(0); PG8_BAR; PG8_MMA(0, 0, At, B0); PG8_MMA(0, 1, At, B1); PG8_BAR; PG8_SCHED;
            PG8_LDA(At, 0, 1); PG8_STAGE_X(PG8_SB(0, 0), b2, voffB, rsB, g.Bt); PG8_STAGE_X(PG8_SB(0, 1), b2 + hstep, voffB, rsB, g.Bt); PG8_STAGE_X(PG8_SA(0, 0), a2, voffA, rsA, g.A);
            PG8_WAIT_V(8); PG8_WAIT_L(0); PG8_BAR; PG8_MMA(1, 0, At, B0); PG8_MMA(1, 1, At, B1); PG8_BAR; PG8_SCHED;
            PG8_LDB(B0, 1, 0); PG8_LDB(B1, 1, 1); PG8_SCHED; PG8_LDA(At, 1, 0); PG8_STAGE_X(PG8_SA(0, 1), a2 + hstep, voffA, rsA, g.A);
            PG8_WAIT_V(8); PG8_WAIT_L(0); PG8_BAR; PG8_MMA(0, 0, At, B0); PG8_MMA(0, 1, At, B1); PG8_BAR; PG8_SCHED;
            PG8_LDA(At, 1, 1); PG8_STAGE_X(PG8_SB(1, 0), b3, voffB, rsB, g.Bt); PG8_STAGE_X(PG8_SB(1, 1), b3 + hstep, voffB, rsB, g.Bt); PG8_STAGE_X(PG8_SA(1, 0), a3, voffA, rsA, g.A);
            PG8_WAIT_V(8); PG8_WAIT_L(0); PG8_BAR; PG8_MMA(1, 0, At, B0); PG8_MMA(1, 1, At, B1); PG8_BAR; PG8_SCHED;
            } else {
            PG8_LDB(B0, 0, 0); PG8_SCHED; PG8_LDA(At, 0, 0); PG8_STAGE_X(PG8_SA(1, 1), a1 + hstep, voffA, rsA, g.A);
            PG8_WAIT_L(8); PG8_BAR; PG8_WAIT_L(0); PG8_MMA(0, 0, At, B0); PG8_BAR; PG8_SCHED;
            PG8_LDB(B1, 0, 1); PG8_STAGE_X(PG8_SB(0, 0), b2, voffB, rsB, g.Bt);
            PG8_BAR; PG8_WAIT_L(0); PG8_MMA(0, 1, At, B1); PG8_BAR;
            PG8_LDA(At, 0, 1); PG8_STAGE_X(PG8_SA(0, 0), a2, voffA, rsA, g.A);
            PG8_BAR; PG8_WAIT_L(0); PG8_MMA(1, 0, At, B0); PG8_BAR; PG8_SCHED;
            PG8_STAGE_X(PG8_SB(0, 1), b2 + hstep, voffB, rsB, g.Bt);
            PG8_WAIT_V(6); PG8_BAR; PG8_MMA(1, 1, At, B1); PG8_BAR;
            PG8_LDB(B0, 1, 0); PG8_SCHED; PG8_LDA(At, 1, 0); PG8_STAGE_X(PG8_SA(0, 1), a2 + hstep, voffA, rsA, g.A);
            PG8_WAIT_L(8); PG8_BAR; PG8_WAIT_L(0); PG8_MMA(0, 0, At, B0); PG8_BAR; PG8_SCHED;
            PG8_LDB(B1, 1, 1); PG8_STAGE_X(PG8_SB(1, 0), b3, voffB, rsB, g.Bt);
            PG8_BAR; PG8_WAIT_L(0); PG8_MMA(0, 1, At, B1); PG8_BAR;
            PG8_LDA(At, 1, 1); PG8_STAGE_X(PG8_SA(1, 0), a3, voffA, rsA, g.A);
            PG8_BAR; PG8_WAIT_L(0); PG8_MMA(1, 0, At, B0); PG8_BAR; PG8_SCHED;
            PG8_STAGE_X(PG8_SB(1, 1), b3 + hstep, voffB, rsB, g.Bt);
            PG8_WAIT_V(6); PG8_BAR; PG8_MMA(1, 1, At, B1); PG8_BAR;
            }
        }
        if constexpr (ALIGN_EPI) { if (wr == 0) PG8_BAR; }
        if constexpr (!Epi::AFTER_DRAIN) { E(acc, cur, wr, wc, fr, fq); S.done(cur); }
        if (!has_next) break;
#pragma unroll
        for (int a = 0; a < 2; ++a)
#pragma unroll
            for (int b = 0; b < 2; ++b)
#pragma unroll
                for (int m = 0; m < 4; ++m)
#pragma unroll
                    for (int n = 0; n < 2; ++n) acc[a][b][m][n] = (f32x4){0.f, 0.f, 0.f, 0.f};
        cur = nxt; cA = nA; cB = nB; ++ui;
        if constexpr (ALIGN_EPI) { if (wr == 1) PG8_BAR; }
    }
    PG8_WAIT_V(0);
    if constexpr (!ALIGN_EPI) { if (wr == 0) PG8_BAR; }
    PG8_BAR;
    if constexpr (Epi::AFTER_DRAIN) { E.fused(acc, cur, wr, wc, fr, fq, lds, wid, lane); S.done(cur); }
#undef PG8_SA
#undef PG8_SB
#undef PG8_STAGE_X
#undef PG8_LDA
#undef PG8_LDB
#undef PG8_MMA
#undef PG8_WAIT_V
#undef PG8_WAIT_L
#undef PG8_BAR
#undef PG8_SCHED
}
}
#define GAS __attribute__((address_space(1)))
#define LAS __attribute__((address_space(3)))
typedef unsigned short bf16_t;
typedef unsigned u32x4 __attribute__((ext_vector_type(4)));
typedef unsigned u32x2 __attribute__((ext_vector_type(2)));
typedef float f32x4 __attribute__((ext_vector_type(4)));
typedef float f32x2 __attribute__((ext_vector_type(2)));
typedef float f32x16 __attribute__((ext_vector_type(16)));
typedef short bf16x8 __attribute__((ext_vector_type(8)));
typedef short s16x4 __attribute__((ext_vector_type(4)));
typedef __bf16 bf16x2_t __attribute__((ext_vector_type(2)));
typedef unsigned u32x6 __attribute__((ext_vector_type(6)));
typedef int i32x8 __attribute__((ext_vector_type(8)));
typedef unsigned u32x16 __attribute__((ext_vector_type(16)));
typedef float f32x32 __attribute__((ext_vector_type(32)));
typedef _Float16 f16x32 __attribute__((ext_vector_type(32)));
typedef _Float16 f16x2 __attribute__((ext_vector_type(2)));

namespace mk {
constexpr int M = 16384, D = 4096, S = 2048, NB = 8, PW = 12298, NH = 32, NE = 16384;
constexpr int NWAVES = 8;
constexpr size_t MiB = 1u << 20;
constexpr size_t WS_CTL = 0, CTL_ZERO_BYTES = 1 * MiB;
constexpr size_t WS_RSTD = 2 * MiB, WS_LOGF = 3 * MiB, WS_WQK = 4 * MiB, WS_WOUT = 20 * MiB, WS_WIN = 52 * MiB, WS_U16 = 148 * MiB, WS_V16 = 276 * MiB,
                 WS_XB = 404 * MiB, WS_Q = 532 * MiB, WS_K = 660 * MiB, WS_V = 788 * MiB, WS_OB = 916 * MiB, WS_X2 = 1792 * MiB, WS_END = 2048 * MiB;
constexpr size_t WS_XB8N = WS_OB + 64 * MiB;
constexpr size_t WS_SC = WS_Q;
constexpr int CW_BAR = 4096;
constexpr int CW_QUEUE = 16384;
constexpr int RING_BYTES = 131072, LDSCTL_OFF = RING_BYTES, MISC_OFF = LDSCTL_OFF + 320, LDS_BYTES = 147456;

struct Args { const float* in[13]; float* out; unsigned char* ws; int ph_lo, ph_hi; };

__device__ __forceinline__ unsigned f2bf(float f) { unsigned u = __builtin_bit_cast(unsigned, f); return (u + 0x7fffu + ((u >> 16) & 1u)) >> 16; }
__device__ __forceinline__ unsigned pk2(float lo, float hi) { return f2bf(lo) | (f2bf(hi) << 16); }
__device__ __forceinline__ float bf_lo(unsigned w) { return __builtin_bit_cast(float, w << 16); }
__device__ __forceinline__ float bf_hi(unsigned w) { return __builtin_bit_cast(float, w & 0xffff0000u); }
__device__ __forceinline__ float lane_read(float v, int src_lane) { return __builtin_bit_cast(float, __builtin_amdgcn_ds_bpermute(src_lane << 2, __builtin_bit_cast(int, v))); }
__device__ __forceinline__ int lane_read(int v, int src_lane) { return __builtin_amdgcn_ds_bpermute(src_lane << 2, v); }
constexpr float US = 1024.0f, VS = 32.0f, US_INV = 1.0f / 1024.0f, VS_INV = 1.0f / 32.0f;
constexpr int ROW6 = 3072;
__device__ __forceinline__ unsigned q_e2m3(float x, float inv) {
    const float a = fminf(fabsf(x) * inv, 7.5f);
    const float c = a < 2.0f ? __builtin_rintf(a * 8.0f) : (a < 4.0f ? __builtin_rintf(a * 4.0f) + 8.0f : __builtin_rintf(a * 2.0f) + 16.0f);
    return (unsigned)(int)c | ((__builtin_bit_cast(unsigned, x) >> 26) & 32u);
}
__device__ __forceinline__ u32x6 pack_fp6(const f32x4 (&a0)[4], const f32x4 (&a1)[4], float inv) {
    unsigned o[6];
#pragma unroll
    for (int w = 0; w < 6; ++w) o[w] = 0u;
#pragma unroll
    for (int j = 0; j < 32; ++j) { const float x = (j < 16) ? a0[(j & 15) >> 2][j & 3] : a1[(j & 15) >> 2][j & 3]; const unsigned c = q_e2m3(x, inv);
        const int b = 6 * j, w = b >> 5, sh = b & 31; o[w] |= c << sh; if (sh > 26) o[w + 1] |= c >> (32 - sh); }
    return (u32x6){o[0], o[1], o[2], o[3], o[4], o[5]};
}
constexpr int ROW4 = 2048;
__device__ __forceinline__ unsigned q_e2m1(float x, float inv) {
    const float a = fminf(fabsf(x) * inv, 6.0f);
    const float c = a < 2.0f ? __builtin_rintf(a * 2.0f) : (a < 4.0f ? __builtin_rintf(a) + 2.0f : __builtin_rintf(a * 0.5f) + 4.0f);
    return (unsigned)(int)c | ((__builtin_bit_cast(unsigned, x) >> 28) & 8u);
}
#define FP4X_(j) ((j) < 16 ? a0[((j) & 15) >> 2][(j) & 3] : a1[((j) & 15) >> 2][(j) & 3])
__device__ __forceinline__ u32x4 pack_fp4(const f32x4 (&a0)[4], const f32x4 (&a1)[4], float inv) {
    unsigned o[4];
#pragma unroll
    for (int w = 0; w < 4; ++w) { unsigned v = 0u;
        v = __builtin_amdgcn_cvt_scalef32_pk_fp4_f32(v, FP4X_(8 * w + 0) * inv, FP4X_(8 * w + 1) * inv, 1.0f, 0); v = __builtin_amdgcn_cvt_scalef32_pk_fp4_f32(v, FP4X_(8 * w + 2) * inv, FP4X_(8 * w + 3) * inv, 1.0f, 1);
        v = __builtin_amdgcn_cvt_scalef32_pk_fp4_f32(v, FP4X_(8 * w + 4) * inv, FP4X_(8 * w + 5) * inv, 1.0f, 2); v = __builtin_amdgcn_cvt_scalef32_pk_fp4_f32(v, FP4X_(8 * w + 6) * inv, FP4X_(8 * w + 7) * inv, 1.0f, 3);
        o[w] = v; }
    return (u32x4){o[0], o[1], o[2], o[3]};
}
#undef FP4X_
__device__ __forceinline__ float clamp8(float x) { return fminf(fmaxf(x, -224.0f), 224.0f); }
__device__ __forceinline__ float logsig(float z) { return fminf(z, 0.f) - 0.6931471805599453f * __builtin_amdgcn_logf(1.0f + __builtin_amdgcn_exp2f(-fabsf(z) * 1.4426950408889634f)); }
__device__ __forceinline__ float gelu_erf(float v) {
    const float av = fabsf(v), t = __builtin_amdgcn_rcpf(av * 0.2316418882f + 1.0f);
    float q = t * 0.5307027145f + (-0.7265760135f); q = q * t + 0.7107068705f; q = q * t + (-0.142248368f); q = q * t + 0.127414796f; q = q * t;
    const float e = __builtin_amdgcn_exp2f((v * v) * (-0.72134752044f));
    const float m = v * (q * e);
    return v < 0.f ? m : v - m;
}
#define LDS_WAIT() asm volatile("s_waitcnt lgkmcnt(0)" ::: "memory")
#define FRESH_LDS(l) do { unsigned v_ = (unsigned)(size_t)(l); asm volatile("" : "+s"(v_)); (l) = (LAS unsigned char*)(size_t)v_; } while (0)
#define FRESH_BID() int bid = blockIdx.x, G = gridDim.x; asm volatile("" : "+s"(bid), "+s"(G))
#define FRESH_TID() int tid; { int w_ = wave0, l_; { unsigned z_ = 0u; asm volatile("" : "+v"(z_)); l_ = (int)__builtin_amdgcn_mbcnt_hi(~0u, __builtin_amdgcn_mbcnt_lo(~0u, z_)); } asm volatile("" : "+s"(w_)); tid = w_ * 64 + l_; } const int lane = tid & 63, wave = __builtin_amdgcn_readfirstlane(tid >> 6); (void)lane; (void)wave

__device__ __forceinline__ unsigned wave_max_u32(unsigned v) {
    v = max(v, (unsigned)__builtin_amdgcn_update_dpp(0, (int)v, 0x111, 0xF, 0xF, true));
    v = max(v, (unsigned)__builtin_amdgcn_update_dpp(0, (int)v, 0x112, 0xF, 0xF, true));
    v = max(v, (unsigned)__builtin_amdgcn_update_dpp(0, (int)v, 0x114, 0xF, 0xF, true));
    v = max(v, (unsigned)__builtin_amdgcn_update_dpp(0, (int)v, 0x118, 0xF, 0xF, true));
    v = max(v, (unsigned)__builtin_amdgcn_update_dpp((int)v, (int)v, 0x142, 0xA, 0xF, false));
    v = max(v, (unsigned)__builtin_amdgcn_update_dpp((int)v, (int)v, 0x143, 0xC, 0xF, false));
    return (unsigned)__builtin_amdgcn_readlane((int)v, 63);
}
__device__ __forceinline__ float wave_sum_dpp(float x) {
    int v = __builtin_bit_cast(int, x);
#define DPP_ADD(ctrl, rm, bc, oldv) v = __builtin_bit_cast(int, __builtin_bit_cast(float, v) + __builtin_bit_cast(float, __builtin_amdgcn_update_dpp(oldv, v, ctrl, rm, 0xF, bc)))
    DPP_ADD(0x111, 0xF, true, 0); DPP_ADD(0x112, 0xF, true, 0); DPP_ADD(0x114, 0xF, true, 0); DPP_ADD(0x118, 0xF, true, 0);
#undef DPP_ADD
    const float r0 = __builtin_bit_cast(float, __builtin_amdgcn_readlane(v, 15)), r1 = __builtin_bit_cast(float, __builtin_amdgcn_readlane(v, 31)), r2 = __builtin_bit_cast(float, __builtin_amdgcn_readlane(v, 47)), r3 = __builtin_bit_cast(float, __builtin_amdgcn_readlane(v, 63));
    return (r0 + r1) + (r2 + r3);
}
__device__ __forceinline__ unsigned ordkey(float x) { const unsigned u = __builtin_bit_cast(unsigned, x); return (u & 0x80000000u) ? ~u : (u | 0x80000000u); }
__device__ __forceinline__ void transpose_item(const float* W, int K, int ldw, int ncols, const float* gain, bf16_t* WT, LAS float* scr, int item, int lane) {
    const int nblk = ncols / 32, kb = item / nblk, nb = item % nblk, k0 = 64 * kb, n0 = 32 * nb;
#pragma unroll 8
    for (int i = 0; i < 32; ++i) { const int kk = 2 * i + (lane >> 5); float v = W[(size_t)(k0 + kk) * ldw + n0 + (lane & 31)]; if (gain) v *= gain[k0 + kk]; scr[kk * 33 + (lane & 31)] = v; }
    LDS_WAIT(); asm volatile("" ::: "memory");
    const int c = lane & 7;
#pragma unroll
    for (int j = 0; j < 4; ++j) { const int n = (lane >> 3) + 8 * j; const LAS float* s = scr + (8 * c) * 33 + n;
        u32x4 o; o.x = pk2(s[0 * 33], s[1 * 33]); o.y = pk2(s[2 * 33], s[3 * 33]); o.z = pk2(s[4 * 33], s[5 * 33]); o.w = pk2(s[6 * 33], s[7 * 33]);
        *(u32x4*)(WT + (size_t)(n0 + n) * K + k0 + 8 * c) = o; }
    LDS_WAIT(); asm volatile("" ::: "memory");
}

typedef const __attribute__((address_space(4))) Args* KArgsT;
__device__ __forceinline__ unsigned pk4_fp8(float a, float b, float c, float d) { int p = __builtin_amdgcn_cvt_pk_fp8_f32(clamp8(a), clamp8(b), 0, false); p = __builtin_amdgcn_cvt_pk_fp8_f32(clamp8(c), clamp8(d), p, true); return (unsigned)p; }
__device__ __forceinline__ void transpose_item8(const float* W, int K, int ldw, int ncols, const float* gain, float scale, unsigned char* WT, LAS float* scr, int item, int lane) {
    const int nblk = ncols / 32, kb = item / nblk, nb = item % nblk, k0 = 64 * kb, n0 = 32 * nb;
    const int kr = lane >> 3, nq = (lane & 7) * 4;
    f32x4 v[8];
#pragma unroll
    for (int i = 0; i < 8; ++i) { const float* p = W + (size_t)(k0 + 8 * i + kr) * ldw + n0 + nq; v[i] = (f32x4){p[0], p[1], p[2], p[3]}; }
#pragma unroll
    for (int i = 0; i < 8; ++i) { const int kk = 8 * i + kr; const float g = (gain ? gain[k0 + kk] : 1.0f) * scale; LAS float* d = scr + kk * 33 + nq; d[0] = v[i][0] * g; d[1] = v[i][1] * g; d[2] = v[i][2] * g; d[3] = v[i][3] * g; }
    LDS_WAIT(); asm volatile("" ::: "memory");
    const int c = lane & 7;
#pragma unroll
    for (int j = 0; j < 4; ++j) { const int n = (lane >> 3) + 8 * j; const LAS float* s = scr + (8 * c) * 33 + n;
        u32x2 o; o.x = pk4_fp8(s[0 * 33], s[1 * 33], s[2 * 33], s[3 * 33]); o.y = pk4_fp8(s[4 * 33], s[5 * 33], s[6 * 33], s[7 * 33]);
        *(u32x2*)(WT + (size_t)(n0 + n) * K + k0 + 8 * c) = o; }
    LDS_WAIT(); asm volatile("" ::: "memory");
}
__device__ __forceinline__ void conv_phase(KArgsT ka, int l, LAS unsigned char* lds, int wave0) {
    FRESH_TID(); FRESH_LDS(lds); FRESH_BID();
    unsigned char* ws = ka->ws;
    const float* ln1 = ka->in[1] + (size_t)l * D; const float* w_in = ka->in[2] + (size_t)l * D * PW; const float* w_out = ka->in[5] + (size_t)l * D * D;
    const float* ln2 = ka->in[6] + (size_t)l * D; const float* wq = ka->in[7] + (size_t)l * D * 2048;
    const float* k1 = ka->in[8] + (size_t)l * 8 * 128 * 128; const float* k2 = ka->in[9] + (size_t)l * 8 * 128 * 128;
    const float* pu = ka->in[10] + (size_t)l * NE * D; const float* pv = ka->in[11] + (size_t)l * NE * D;
    bf16_t* WQK = (bf16_t*)(ws + WS_WQK); bf16_t* WOUT = (bf16_t*)(ws + WS_WOUT); bf16_t* WIN = (bf16_t*)(ws + WS_WIN); bf16_t* U16 = (bf16_t*)(ws + WS_U16); bf16_t* V16 = (bf16_t*)(ws + WS_V16);
    {
        LAS float* Ks = (LAS float*)lds;
        LAS float* Ws = (LAS float*)(lds + 128 * 132 * 4);
        const int IPB = (1024 + G - 1) / G, it0 = bid * IPB, it1 = min(1024, it0 + IPB);
        int gi_cur = -1; f32x4 pre[4];
        if (it0 < it1) {
#pragma unroll
            for (int m = 0; m < 4; ++m) { const int i = tid + 512 * m, r = i >> 5, c4 = (i & 31) * 4; pre[m] = *(const f32x4*)(wq + (size_t)((it0 & 63) * 64 + r) * 2048 + (it0 >> 6) * 128 + c4); } }
        for (int it = it0; it < it1; ++it) {
            const int gi = it >> 6, c0 = (it & 63) * 64;
            __syncthreads();
            if (gi != gi_cur) { gi_cur = gi;
                const float* key = ((gi & 1) ? k2 : k1) + (size_t)(gi >> 1) * 128 * 128;
                for (int i = tid; i < 4096; i += 512) { const int r = i >> 5, c4 = (i & 31) * 4; *(LAS f32x4*)(Ks + r * 132 + c4) = *(const f32x4*)(key + r * 128 + c4); } }
#pragma unroll
            for (int m = 0; m < 4; ++m) { const int i = tid + 512 * m, r = i >> 5, c4 = (i & 31) * 4; *(LAS f32x4*)(Ws + r * 132 + c4) = pre[m]; }
            __syncthreads();
            if (it + 1 < it1) {
#pragma unroll
                for (int m = 0; m < 4; ++m) { const int i = tid + 512 * m, r = i >> 5, c4 = (i & 31) * 4; pre[m] = *(const f32x4*)(wq + (size_t)(((it + 1) & 63) * 64 + r) * 2048 + ((it + 1) >> 6) * 128 + c4); } }
            const int ti = wave & 3, tj = wave >> 2, li = lane & 31, kh = lane >> 5;
            const LAS float* ap = Ks + (32 * ti + li) * 132 + 64 * kh; const LAS float* bp = Ws + (32 * tj + li) * 132 + 64 * kh;
            f32x16 acc;
#pragma unroll
            for (int r = 0; r < 16; ++r) acc[r] = 0.f;
#pragma unroll 4
            for (int s4 = 0; s4 < 16; ++s4) { const f32x4 a4 = *(const LAS f32x4*)(ap + 4 * s4), b4 = *(const LAS f32x4*)(bp + 4 * s4);
                acc = __builtin_amdgcn_mfma_f32_32x32x2f32(a4[0], b4[0], acc, 0, 0, 0); acc = __builtin_amdgcn_mfma_f32_32x32x2f32(a4[1], b4[1], acc, 0, 0, 0);
                acc = __builtin_amdgcn_mfma_f32_32x32x2f32(a4[2], b4[2], acc, 0, 0, 0); acc = __builtin_amdgcn_mfma_f32_32x32x2f32(a4[3], b4[3], acc, 0, 0, 0); }
            { const int c = c0 + 32 * tj + li; const float gg = ln2[c];
#pragma unroll
              for (int r = 0; r < 16; ++r) { const int n = 32 * ti + (r & 3) + 8 * (r >> 2) + 4 * kh; WQK[(size_t)(gi * 128 + n) * D + c] = (bf16_t)f2bf(acc[r] * gg); } }
        }
        __syncthreads();
    }
    const int gw = bid * NWAVES + wave, NGW = G * NWAVES;
    {
        unsigned char* U6 = (unsigned char*)U16; unsigned char* V4 = U6 + (size_t)NE * ROW6; float* SCU = (float*)(U6 + 2 * (size_t)NE * ROW6); float* SCV = SCU + NE;
        f32x4 gq[4][4];
#pragma unroll
        for (int i = 0; i < 4; ++i)
#pragma unroll
            for (int m = 0; m < 4; ++m) gq[i][m] = *(const f32x4*)(ln2 + 1024 * i + 256 * m + 4 * lane);
        f32x4 uu[4][4], vv[4][4];
        const unsigned hm_ = (lane & 1) ? 65536u : 1u;
#define LDROW_(dst, src, rr) do { const float* p_ = (src) + (size_t)(rr) * D + 4 * lane; _Pragma("unroll") for (int i = 0; i < 4; ++i) _Pragma("unroll") for (int m = 0; m < 4; ++m) dst[i][m] = *(const f32x4*)(p_ + 1024 * i + 256 * m); } while (0)
#define H16_(v, inv) ((__builtin_amdgcn_cvt_scalef32_pk_fp4_f32(__builtin_amdgcn_cvt_scalef32_pk_fp4_f32(0u, (v)[0] * (inv), (v)[1] * (inv), 1.0f, 0), (v)[2] * (inv), (v)[3] * (inv), 1.0f, 1) & 0xffffu) * hm_)
#define QSWAP1_(x) ((unsigned)__builtin_amdgcn_update_dpp(0, (int)(x), 0xB1, 0xF, 0xF, false))
#define QSWAP2_(x) ((unsigned)__builtin_amdgcn_update_dpp(0, (int)(x), 0x4E, 0xF, 0xF, false))
#define PUTROW_(src, tab, rr, inv) do { _Pragma("unroll") for (int j = 0; j < 2; ++j) _Pragma("unroll") for (int m = 0; m < 4; ++m) { \
            unsigned da_ = H16_(src[2 * j][m], inv), db_ = H16_(src[2 * j + 1][m], inv); da_ |= QSWAP1_(da_); db_ |= QSWAP1_(db_); \
            const unsigned oa_ = QSWAP2_(da_), ob_ = QSWAP2_(db_); \
            if ((lane & 3) == 0) *(u32x4*)((tab) + (size_t)(rr) * ROW4 + j * 1024 + 16 * (16 * m + (lane >> 2))) = (u32x4){da_, oa_, db_, ob_}; } } while (0)
        if (gw < NE) { LDROW_(uu, pu, gw); LDROW_(vv, pv, gw); }
        for (int r = gw; r < NE; r += NGW) {
            const int rn = r + NGW;
            { float au = 0.f;
#pragma unroll
              for (int i = 0; i < 4; ++i)
#pragma unroll
                  for (int m = 0; m < 4; ++m) { uu[i][m] *= gq[i][m]; au += (uu[i][m][0] * uu[i][m][0] + uu[i][m][1] * uu[i][m][1]) + (uu[i][m][2] * uu[i][m][2] + uu[i][m][3] * uu[i][m][3]); }
              au = sqrtf(wave_sum_dpp(au) * (1.0f / D)); const float iu = au > 0.f ? 2.0f / au : 0.f;
              if (lane == 0) SCU[r] = au * 0.5f;
              PUTROW_(uu, U6, r, iu); }
            if (rn < NE) LDROW_(uu, pu, rn);
            { float av = 0.f;
#pragma unroll
              for (int i = 0; i < 4; ++i)
#pragma unroll
                  for (int m = 0; m < 4; ++m) av += (vv[i][m][0] * vv[i][m][0] + vv[i][m][1] * vv[i][m][1]) + (vv[i][m][2] * vv[i][m][2] + vv[i][m][3] * vv[i][m][3]);
              av = sqrtf(wave_sum_dpp(av) * (1.0f / D)); const float iv = av > 0.f ? 2.0f / av : 0.f;
              if (lane == 0) SCV[r] = av * 0.5f;
              PUTROW_(vv, V4, r, iv); }
            if (rn < NE) LDROW_(vv, pv, rn);
        }
#undef LDROW_
#undef H16_
#undef QSWAP1_
#undef QSWAP2_
#undef PUTROW_
    }
    {
        LAS float* scr = (LAS float*)(lds + wave * 16384);
        constexpr int I_O = (D / 64) * (D / 32), I_IN = (D / 64) * (12288 / 32);
        for (int it = gw; it < I_O + I_IN; it += NGW) {
            if (it < I_O) transpose_item8(w_out, D, D, D, nullptr, US, (unsigned char*)WOUT, scr, it, lane);
            else transpose_item8(w_in, D, PW, 12288, ln1, US, (unsigned char*)WIN, scr, it - I_O, lane);
        }
    }
}

template <bool WITH_F>
__device__ __forceinline__ void prep_phase(const float* X, bf16_t* XB, float* RSTD, const float* w_in, const float* ln1, const float* bf, float* LOGF, LAS unsigned char* lds, int wave0) {
    FRESH_TID(); FRESH_LDS(lds); FRESH_BID();
    LAS unsigned short* gfs = (LAS unsigned short*)lds;
    if (WITH_F) {
        __syncthreads();
        for (int c = tid; c < D; c += 512) { const float g = ln1[c]; const float* wr = w_in + (size_t)c * PW + 12288;
#pragma unroll
            for (int j = 0; j < 10; ++j) gfs[j * D + c] = (unsigned short)f2bf(wr[j] * g); }
        __syncthreads();
    }
    const int gw = bid * NWAVES + wave, NGW = G * NWAVES;
    for (int m = gw; m < M; m += NGW) {
        const f32x4* xr = (const f32x4*)(X + (size_t)m * D) + lane;
        f32x4 v[16]; float ss = 0.f;
#pragma unroll
        for (int i = 0; i < 16; ++i) { v[i] = xr[64 * i]; ss += (v[i][0] * v[i][0] + v[i][1] * v[i][1]) + (v[i][2] * v[i][2] + v[i][3] * v[i][3]); }
        ss = wave_sum_dpp(ss);
        const float rstd = rsqrtf(ss * (1.0f / D) + 1e-6f);
        if (WITH_F) {
            unsigned* o8 = (unsigned*)((unsigned char*)XB + (size_t)m * D) + lane;
#pragma unroll
            for (int i = 0; i < 16; ++i) o8[64 * i] = pk4_fp8(v[i][0], v[i][1], v[i][2], v[i][3]);
        } else {
        u32x2* o = (u32x2*)(XB + (size_t)m * D) + lane;
#pragma unroll
        for (int i = 0; i < 16; ++i) { u32x2 w; w.x = pk2(v[i][0], v[i][1]); w.y = pk2(v[i][2], v[i][3]); o[64 * i] = w; }
        }
        if (lane == 0) RSTD[m] = rstd;
        if (WITH_F) {
            float mine = 0.f;
#pragma unroll 1
            for (int j = 0; j < 10; ++j) { float s = 0.f;
#pragma unroll
                for (int i = 0; i < 16; ++i) { const u32x2 gp = *(const LAS u32x2*)(gfs + j * D + 256 * i + 4 * lane);
                    s += (v[i][0] * bf_lo(gp.x) + v[i][1] * bf_hi(gp.x)) + (v[i][2] * bf_lo(gp.y) + v[i][3] * bf_hi(gp.y)); }
                s = wave_sum_dpp(s); if (lane == j) mine = s; }
            if (lane < 10) { const int b = m >> 11, s = m & 2047; LOGF[(size_t)(b * 10 + lane) * S + s] = logsig(mine * rstd + bf[lane]); }
        }
    }
}


__device__ __forceinline__ void load16_bf16(const bf16_t* p, float (&d)[16]) {
    const u32x4 a = *(const u32x4*)p, b = *(const u32x4*)(p + 8);
#pragma unroll
    for (int q = 0; q < 4; ++q) { d[2 * q] = bf_lo(a[q]); d[2 * q + 1] = bf_hi(a[q]); d[8 + 2 * q] = bf_lo(b[q]); d[8 + 2 * q + 1] = bf_hi(b[q]); }
}
#define RFL(x) __builtin_amdgcn_readfirstlane(x)
template <bool FINAL>
__device__ __forceinline__ void peer_uv_phase(const float* SC, const unsigned char* U6, const unsigned char* V4, const bf16_t* X1, void* XOv, const float* fg,
                                              unsigned char* XB8n, float* RSTDn, float* LOGFn, const float* w_in_n, const float* ln1_n, const float* bf_n, LAS unsigned char* lds, int wave0) {
    FRESH_TID(); FRESH_LDS(lds); FRESH_BID();
    LAS int* s_eid = (LAS int*)(lds + 81920 + wave * 1024); LAS float* s_w = (LAS float*)(lds + 81920 + wave * 1024 + 512); LAS float* s_su = (LAS float*)(lds + 90112 + wave * 512);
    const float* SCU = (const float*)(U6 + 2 * (size_t)NE * ROW6); const float* SCV = SCU + NE;
    LAS unsigned short* gfs = (LAS unsigned short*)lds;
    if (!FINAL) {
        __syncthreads();
        for (int c = tid; c < D; c += 512) { const float g = ln1_n[c]; const float* wr = w_in_n + (size_t)c * PW + 12288;
#pragma unroll
            for (int j = 0; j < 10; ++j) gfs[j * D + c] = (unsigned short)f2bf(wr[j] * g); }
        __syncthreads();
    }
    const int gw = bid * NWAVES + wave, NGW = G * NWAVES;
    for (int tok = gw; tok < M; tok += NGW) {
        const bf16_t* x1 = X1 + (size_t)tok * D;
        i32x8 xq[2]; float rstd_tok;
        { const int sg_ = lane & 15, gp_ = lane >> 4; float t[2][2][16]; float ss_ = 0.f;
#pragma unroll
          for (int s2 = 0; s2 < 2; ++s2)
#pragma unroll
              for (int hf = 0; hf < 2; ++hf) { load16_bf16(x1 + 1024 * (2 * s2 + (gp_ & 1)) + 16 * (sg_ + 32 * hf + 16 * (gp_ >> 1)), t[s2][hf]);
#pragma unroll
                  for (int k = 0; k < 16; ++k) ss_ += t[s2][hf][k] * t[s2][hf][k]; }
          rstd_tok = rsqrtf(wave_sum_dpp(ss_) * (1.0f / D) + 1e-6f);
#pragma unroll
          for (int s2 = 0; s2 < 2; ++s2)
#pragma unroll
              for (int hf = 0; hf < 2; ++hf)
#pragma unroll
                  for (int q = 0; q < 4; ++q) xq[s2][4 * hf + q] = (int)pk4_fp8(t[s2][hf][4 * q] * rstd_tok, t[s2][hf][4 * q + 1] * rstd_tok, t[s2][hf][4 * q + 2] * rstd_tok, t[s2][hf][4 * q + 3] * rstd_tok); }
        const float* sc = SC + (size_t)tok * 2048;
        LAS float* selv = (LAS float*)(lds + 94208 + wave * 512); LAS int* seli = (LAS int*)(lds + 94208 + wave * 512 + 256);
#define BALLOT(c) __builtin_amdgcn_ballot_w64(c)
#define MBCNT(m) ((int)__builtin_amdgcn_mbcnt_hi((unsigned)((m) >> 32), __builtin_amdgcn_mbcnt_lo((unsigned)(m), 0u)))
        for (int h = 0; h < 4; ++h) {
            float x[2][2][2]; unsigned kk[2][2][2];
#pragma unroll
            for (int u = 0; u < 2; ++u)
#pragma unroll
                for (int f = 0; f < 2; ++f)
#pragma unroll
                    for (int r = 0; r < 2; ++r) { const float v = sc[(h + 4 * u) * 256 + f * 128 + r * 64 + lane]; x[u][f][r] = v; kk[u][f][r] = (ordkey(v) & ~127u) | (unsigned)(127 - 64 * r - lane); }
            unsigned T[2][2] = {{0u, 0u}, {0u, 0u}}; int dn = 0;
            for (unsigned bm = 0x80000000u; bm != 0u && dn != 15; bm >>= 1) {
#pragma unroll
                for (int u = 0; u < 2; ++u)
#pragma unroll
                    for (int f = 0; f < 2; ++f) { const unsigned cand = T[u][f] | bm;
                        const int c = __builtin_popcountll(BALLOT(kk[u][f][0] >= cand)) + __builtin_popcountll(BALLOT(kk[u][f][1] >= cand));
                        T[u][f] = c >= 16 ? cand : T[u][f]; dn |= (c == 16) ? (1 << (2 * u + f)) : 0; }
            }
#pragma unroll
            for (int u = 0; u < 2; ++u)
#pragma unroll
                for (int f = 0; f < 2; ++f) { const bool s0 = kk[u][f][0] >= T[u][f], s1 = kk[u][f][1] >= T[u][f]; const unsigned long long m0 = BALLOT(s0), m1 = BALLOT(s1);
                    const int p0 = MBCNT(m0), p1 = __builtin_popcountll(m0) + MBCNT(m1);
                    if (s0) { selv[(2 * u + f) * 16 + (p0 & 15)] = x[u][f][0]; seli[(2 * u + f) * 16 + (p0 & 15)] = lane; }
                    if (s1) { selv[(2 * u + f) * 16 + (p1 & 15)] = x[u][f][1]; seli[(2 * u + f) * 16 + (p1 & 15)] = 64 + lane; } }
            asm volatile("" ::: "memory");
            float s4[2][4]; unsigned k4[2][4];
#pragma unroll
            for (int u = 0; u < 2; ++u) { const float va = selv[(2 * u) * 16 + (lane >> 2)]; const f32x4 vb = *(const LAS f32x4*)(selv + (2 * u + 1) * 16 + (lane & 3) * 4);
#pragma unroll
                for (int q = 0; q < 4; ++q) { s4[u][q] = va + vb[q]; k4[u][q] = (ordkey(s4[u][q]) & ~255u) | (unsigned)(255 - 4 * lane - q); } }
            unsigned T2[2] = {0u, 0u}; int d2 = 0;
            for (unsigned bm = 0x80000000u; bm != 0u && d2 != 3; bm >>= 1) {
#pragma unroll
                for (int u = 0; u < 2; ++u) { const unsigned cand = T2[u] | bm;
                    const int c = (__builtin_popcountll(BALLOT(k4[u][0] >= cand)) + __builtin_popcountll(BALLOT(k4[u][1] >= cand))) + (__builtin_popcountll(BALLOT(k4[u][2] >= cand)) + __builtin_popcountll(BALLOT(k4[u][3] >= cand)));
                    T2[u] = c >= 16 ? cand : T2[u]; d2 |= (c == 16) ? (1 << u) : 0; }
            }
#pragma unroll
            for (int u = 0; u < 2; ++u) {
                const unsigned mk = wave_max_u32(max(max(k4[u][0], k4[u][1]), max(k4[u][2], k4[u][3]))) & ~255u;
                const float mx = __builtin_bit_cast(float, (mk & 0x80000000u) ? (mk & 0x7fffffffu) : ~mk);
                const float cs = 1.4426950408889634f * rstd_tok;
                float p[4], ps = 0.f;
#pragma unroll
                for (int q = 0; q < 4; ++q) { p[q] = (k4[u][q] >= T2[u]) ? __builtin_amdgcn_exp2f((s4[u][q] - mx) * cs) : 0.f; ps += p[q]; }
                const float tot = wave_sum_dpp(ps);
                const int i1 = seli[(2 * u) * 16 + (lane >> 2)]; const u32x4 i2 = *(const LAS u32x4*)(seli + (2 * u + 1) * 16 + (lane & 3) * 4);
                int base = (h + 4 * u) * 16;
#pragma unroll
                for (int q = 0; q < 4; ++q) { const bool sl = k4[u][q] >= T2[u]; const unsigned long long m = BALLOT(sl); const int slot = base + (MBCNT(m) & 15); base += __builtin_popcountll(m);
                    if (sl) { const int e = ((i1 & 127) << 7) | (int)(i2[q] & 127u); s_eid[slot] = e; s_w[slot] = p[q] / tot * SCV[e]; s_su[slot] = SCU[e]; } }
            }
            asm volatile("" ::: "memory");
        }
#undef BALLOT
#undef MBCNT
        LDS_WAIT(); asm volatile("" ::: "memory");
#define LOADROW6(dst, base, e) do { const u32x4* p_ = (const u32x4*)((base) + (size_t)(e) * ROW6) + lane; dst[0] = p_[0]; dst[1] = p_[64]; dst[2] = p_[128]; } while (0)
#define GRP6(row, g) ((g) == 0 ? (u32x6){row[0][0], row[0][1], row[0][2], row[0][3], row[1][0], row[1][1]} : (u32x6){row[1][2], row[1][3], row[2][0], row[2][1], row[2][2], row[2][3]})
        {
#define LOADROW4(dst, base, e) do { const u32x4* p_ = (const u32x4*)((base) + (size_t)(e) * ROW4) + lane; dst[0] = p_[0]; dst[1] = p_[64]; } while (0)
            const bool dg_ = ((lane & 15) >> 2) == (lane >> 4);
#define UDOT4(row, j) do { f32x4 ac_ = {0.f, 0.f, 0.f, 0.f}; \
            ac_ = __builtin_amdgcn_mfma_scale_f32_16x16x128_f8f6f4((i32x8){(int)row[0][0], (int)row[0][1], (int)row[0][2], (int)row[0][3], 0, 0, 0, 0}, xq[0], ac_, 4, 0, 0, 0x7f7f7f7f, 0, 0x7f7f7f7f); \
            ac_ = __builtin_amdgcn_mfma_scale_f32_16x16x128_f8f6f4((i32x8){(int)row[1][0], (int)row[1][1], (int)row[1][2], (int)row[1][3], 0, 0, 0, 0}, xq[1], ac_, 4, 0, 0, 0x7f7f7f7f, 0, 0x7f7f7f7f); \
            asm volatile("" : "+v"(ac_));     \
            const float pv_ = dg_ ? ((lane & 2) ? ((lane & 1) ? ac_[3] : ac_[2]) : ((lane & 1) ? ac_[1] : ac_[0])) : 0.f; \
            const float d_ = wave_sum_dpp(pv_) * s_su[j]; const float ge_ = gelu_erf(d_); if (lane == 0) s_w[j] *= ge_; } while (0)
            u32x4 r0[2], r1[2], r2[2], r3[2], r4[2], r5[2], r6[2], r7[2];
            { const int e_ = RFL(s_eid[0]); LOADROW4(r0, U6, e_); } { const int e_ = RFL(s_eid[1]); LOADROW4(r1, U6, e_); } { const int e_ = RFL(s_eid[2]); LOADROW4(r2, U6, e_); } { const int e_ = RFL(s_eid[3]); LOADROW4(r3, U6, e_); } { const int e_ = RFL(s_eid[4]); LOADROW4(r4, U6, e_); } { const int e_ = RFL(s_eid[5]); LOADROW4(r5, U6, e_); } { const int e_ = RFL(s_eid[6]); LOADROW4(r6, U6, e_); } { const int e_ = RFL(s_eid[7]); LOADROW4(r7, U6, e_); }
            for (int j = 0; j < 120; j += 8) {
                UDOT4(r0, j + 0); { const int e_ = RFL(s_eid[j + 8]); LOADROW4(r0, U6, e_); }
                UDOT4(r1, j + 1); { const int e_ = RFL(s_eid[j + 9]); LOADROW4(r1, U6, e_); }
                UDOT4(r2, j + 2); { const int e_ = RFL(s_eid[j + 10]); LOADROW4(r2, U6, e_); }
                UDOT4(r3, j + 3); { const int e_ = RFL(s_eid[j + 11]); LOADROW4(r3, U6, e_); }
                UDOT4(r4, j + 4); { const int e_ = RFL(s_eid[j + 12]); LOADROW4(r4, U6, e_); }
                UDOT4(r5, j + 5); { const int e_ = RFL(s_eid[j + 13]); LOADROW4(r5, U6, e_); }
                UDOT4(r6, j + 6); { const int e_ = RFL(s_eid[j + 14]); LOADROW4(r6, U6, e_); }
                UDOT4(r7, j + 7); { const int e_ = RFL(s_eid[j + 15]); LOADROW4(r7, U6, e_); }
            }
            UDOT4(r0, 120); UDOT4(r1, 121); UDOT4(r2, 122); UDOT4(r3, 123); UDOT4(r4, 124); UDOT4(r5, 125); UDOT4(r6, 126); UDOT4(r7, 127);
#undef UDOT4
#undef LOADROW4
        }
        LDS_WAIT(); asm volatile("" ::: "memory");
        {
            f32x2 acc2[2][16];
#define ACC(i, k) acc2[(i) >> 1][((i) & 1) * 8 + ((k) >> 1)][(k) & 1]
#pragma unroll
            for (int g = 0; g < 2; ++g)
#pragma unroll
                for (int k = 0; k < 16; ++k) acc2[g][k] = (f32x2){0.f, 0.f};
#define LOADROW4(dst, base, e) do { const u32x4* p_ = (const u32x4*)((base) + (size_t)(e) * ROW4) + lane; dst[0] = p_[0]; dst[1] = p_[64]; } while (0)
#define VACC4(row, j) do { const float w_ = s_w[j]; const f32x2 w2_ = {w_, w_}; _Pragma("unroll") for (int g_ = 0; g_ < 2; ++g_) { \
                u32x4 G_ = row[g_]; asm volatile("" : "+v"(G_)); \
                _Pragma("unroll") for (int k_ = 0; k_ < 4; ++k_) { const unsigned d_ = G_[k_]; \
                    acc2[g_][4 * k_] = __builtin_elementwise_fma(w2_, __builtin_amdgcn_cvt_scalef32_pk_f32_fp4(d_, 1.0f, 0), acc2[g_][4 * k_]); acc2[g_][4 * k_ + 1] = __builtin_elementwise_fma(w2_, __builtin_amdgcn_cvt_scalef32_pk_f32_fp4(d_, 1.0f, 1), acc2[g_][4 * k_ + 1]); \
                    acc2[g_][4 * k_ + 2] = __builtin_elementwise_fma(w2_, __builtin_amdgcn_cvt_scalef32_pk_f32_fp4(d_, 1.0f, 2), acc2[g_][4 * k_ + 2]); acc2[g_][4 * k_ + 3] = __builtin_elementwise_fma(w2_, __builtin_amdgcn_cvt_scalef32_pk_f32_fp4(d_, 1.0f, 3), acc2[g_][4 * k_ + 3]); } \
                asm volatile("" : "+v"(acc2[g_][0]), "+v"(acc2[g_][1]), "+v"(acc2[g_][2]), "+v"(acc2[g_][3]), "+v"(acc2[g_][4]), "+v"(acc2[g_][5]), "+v"(acc2[g_][6]), "+v"(acc2[g_][7]), \
                                  "+v"(acc2[g_][8]), "+v"(acc2[g_][9]), "+v"(acc2[g_][10]), "+v"(acc2[g_][11]), "+v"(acc2[g_][12]), "+v"(acc2[g_][13]), "+v"(acc2[g_][14]), "+v"(acc2[g_][15])); } } while (0)
            u32x4 r0[2], r1[2], r2[2], r3[2], r4[2], r5[2], r6[2], r7[2];
            { const int e_ = RFL(s_eid[0]); LOADROW4(r0, V4, e_); } { const int e_ = RFL(s_eid[1]); LOADROW4(r1, V4, e_); } { const int e_ = RFL(s_eid[2]); LOADROW4(r2, V4, e_); } { const int e_ = RFL(s_eid[3]); LOADROW4(r3, V4, e_); } { const int e_ = RFL(s_eid[4]); LOADROW4(r4, V4, e_); } { const int e_ = RFL(s_eid[5]); LOADROW4(r5, V4, e_); } { const int e_ = RFL(s_eid[6]); LOADROW4(r6, V4, e_); } { const int e_ = RFL(s_eid[7]); LOADROW4(r7, V4, e_); }
            for (int j = 0; j < 120; j += 8) {
                VACC4(r0, j + 0); { const int e_ = RFL(s_eid[j + 8]); LOADROW4(r0, V4, e_); }
                VACC4(r1, j + 1); { const int e_ = RFL(s_eid[j + 9]); LOADROW4(r1, V4, e_); }
                VACC4(r2, j + 2); { const int e_ = RFL(s_eid[j + 10]); LOADROW4(r2, V4, e_); }
                VACC4(r3, j + 3); { const int e_ = RFL(s_eid[j + 11]); LOADROW4(r3, V4, e_); }
                VACC4(r4, j + 4); { const int e_ = RFL(s_eid[j + 12]); LOADROW4(r4, V4, e_); }
                VACC4(r5, j + 5); { const int e_ = RFL(s_eid[j + 13]); LOADROW4(r5, V4, e_); }
                VACC4(r6, j + 6); { const int e_ = RFL(s_eid[j + 14]); LOADROW4(r6, V4, e_); }
                VACC4(r7, j + 7); { const int e_ = RFL(s_eid[j + 15]); LOADROW4(r7, V4, e_); }
            }
            VACC4(r0, 120); VACC4(r1, 121); VACC4(r2, 122); VACC4(r3, 123); VACC4(r4, 124); VACC4(r5, 125); VACC4(r6, 126); VACC4(r7, 127);
#undef VACC4
#undef LOADROW4
            float ss = 0.f;
#pragma unroll
            for (int i = 0; i < 4; ++i) { float t[16]; load16_bf16(x1 + 1024 * i + 16 * lane, t);
#pragma unroll
                for (int k = 0; k < 16; ++k) { ACC(i, k) += t[k]; ss += ACC(i, k) * ACC(i, k); } }
            ss = wave_sum_dpp(ss);
            const float rs = rsqrtf(ss * (1.0f / D) + 1e-6f);
            if (!FINAL) {
#pragma unroll
                for (int i = 0; i < 4; ++i) { u32x4 w8;
#pragma unroll
                    for (int q = 0; q < 4; ++q) w8[q] = pk4_fp8(ACC(i, 4 * q), ACC(i, 4 * q + 1), ACC(i, 4 * q + 2), ACC(i, 4 * q + 3));
                    *(u32x4*)(XB8n + (size_t)tok * D + 1024 * i + 16 * lane) = w8; }
                if (lane == 0) RSTDn[tok] = rs;
                float mine = 0.f;
#pragma unroll 1
                for (int j = 0; j < 10; ++j) { float s = 0.f;
#pragma unroll
                    for (int i = 0; i < 4; ++i) { const u32x4 g0 = *(const LAS u32x4*)(gfs + j * D + 1024 * i + 16 * lane), g1 = *(const LAS u32x4*)(gfs + j * D + 1024 * i + 16 * lane + 8);
#pragma unroll
                        for (int q = 0; q < 4; ++q) { s += ACC(i, 2 * q) * bf_lo(g0[q]) + ACC(i, 2 * q + 1) * bf_hi(g0[q]); s += ACC(i, 8 + 2 * q) * bf_lo(g1[q]) + ACC(i, 8 + 2 * q + 1) * bf_hi(g1[q]); } }
                    s = wave_sum_dpp(s); if (lane == j) mine = s; }
                if (lane < 10) { const int b_ = tok >> 11, s_ = tok & 2047; LOGFn[(size_t)(b_ * 10 + lane) * S + s_] = logsig(mine * rs + bf_n[lane]); }
            }
            if (FINAL) { float* xo = (float*)XOv + (size_t)tok * D;
#pragma unroll
                for (int i = 0; i < 4; ++i)
#pragma unroll
                    for (int q = 0; q < 4; ++q) { const int c = 1024 * i + 16 * lane + 4 * q; const f32x4 g_ = *(const f32x4*)(fg + c);
                        *(f32x4*)(xo + c) = (f32x4){ACC(i, 4 * q) * rs * g_[0], ACC(i, 4 * q + 1) * rs * g_[1], ACC(i, 4 * q + 2) * rs * g_[2], ACC(i, 4 * q + 3) * rs * g_[3]}; }
            } else { bf16_t* xo = (bf16_t*)XOv + (size_t)tok * D;
#pragma unroll
                for (int i = 0; i < 4; ++i) { u32x4 w0, w1;
#pragma unroll
                    for (int q = 0; q < 4; ++q) { w0[q] = pk2(ACC(i, 2 * q), ACC(i, 2 * q + 1)); w1[q] = pk2(ACC(i, 8 + 2 * q), ACC(i, 8 + 2 * q + 1)); }
                    *(u32x4*)(xo + 1024 * i + 16 * lane) = w0; *(u32x4*)(xo + 1024 * i + 16 * lane + 8) = w1; }
            }
        }
        LDS_WAIT(); asm volatile("" ::: "memory");
    }
#undef ACC
#undef LOADROW6
#undef GRP6
}
}
namespace at {
using namespace mk;
constexpr int QB = 256, KVB = 64, HD = 128;
constexpr int SHM_V = KVB * HD * 2, SHM_K = KVB * HD * 2;
constexpr int OFF_V = 0, OFF_K = 2 * SHM_V, OFF_WS = OFF_K + 2 * SHM_K, OFF_CUM = OFF_WS + 8 * 256, OFF_RT = OFF_CUM + 2048 * 4, OFF_MISC = OFF_RT + 640 * 4;
constexpr float LOG2E = 1.4426950408889634f;
constexpr float THR2 = 10.0f;
constexpr float SB_DONE = -100.0f;

#define AT_KSWZ(row, colB) ((row) * 256 + ((colB) ^ (((row) & 7) << 4)))
__device__ __forceinline__ int v_st(int k, int c) { const int kk = (k & ~0xC) | ((k & 4) << 1) | ((k & 8) >> 1); return ((kk >> 3) * 4 + (c >> 5)) * 512 + ((kk & 7) * 32 + (c & 31)) * 2; }
__device__ __forceinline__ int v_rd_base(int lane) { return ((lane & 3) << 3) | (((lane >> 2) & 3) << 6) | (((lane >> 4) & 1) << 5) | (((lane >> 5) & 1) << 8); }
constexpr int v_rd_off(int d0, int ks, int half) { return d0 * 512 + ks * 4096 + half * 2048; }
__device__ __forceinline__ int crow(int r, int hi) { return (r & 3) + 8 * (r >> 2) + 4 * hi; }
__device__ __forceinline__ unsigned cvtpk(float lo, float hi) { unsigned r; asm volatile("v_cvt_pk_bf16_f32 %0, %1, %2" : "=v"(r) : "v"(lo), "v"(hi)); return r; }
__device__ __forceinline__ float partner(float v, int hi) { auto rr = __builtin_amdgcn_permlane32_swap(__builtin_bit_cast(unsigned, v), __builtin_bit_cast(unsigned, v), false, false); return __builtin_bit_cast(float, hi ? rr[0] : rr[1]); }

__device__ __forceinline__ float xchg_max(float v, int hi) { return fmaxf(v, partner(v, hi)); }
__device__ __forceinline__ float xchg_sum(float v, int hi) { return v + partner(v, hi); }

__device__ __forceinline__ void pack_p(const f32x16& p0, const f32x16& p1, bf16x8& pa0, bf16x8& pa1, bf16x8& pa2, bf16x8& pa3) {
#define AT_PK4(P, B_, OUT) do { unsigned a0 = cvtpk(P[B_ + 0], P[B_ + 1]), a1 = cvtpk(P[B_ + 2], P[B_ + 3]); unsigned b0 = cvtpk(P[B_ + 4], P[B_ + 5]), b1 = cvtpk(P[B_ + 6], P[B_ + 7]); \
        auto r0 = __builtin_amdgcn_permlane32_swap(a0, b0, false, false); auto r1 = __builtin_amdgcn_permlane32_swap(a1, b1, false, false); \
        u32x4 w = {r0[0], r1[0], r0[1], r1[1]}; OUT = __builtin_bit_cast(bf16x8, w); } while (0)
    AT_PK4(p0, 0, pa0); AT_PK4(p0, 8, pa1); AT_PK4(p1, 0, pa2); AT_PK4(p1, 8, pa3);
#undef AT_PK4
}
template <int KBUF>
__device__ __forceinline__ void qkt(f32x16& p0, f32x16& p1, LAS unsigned char* K_lds, int r32, int hi, const bf16x8 (&qr)[8]) {
    p0 = f32x16{}; p1 = f32x16{};
    LAS unsigned char* kb[4];
#pragma unroll
    for (int dd = 0; dd < 4; ++dd) kb[dd] = K_lds + KBUF * SHM_K + AT_KSWZ(r32, (dd * 16 + hi * 8) * 2);
#pragma unroll
    for (int d0 = 0; d0 < 8; ++d0) { LAS unsigned char* a = kb[d0 & 3] + (d0 >> 2) * 128;
        const bf16x8 b0 = *(const LAS bf16x8*)a; const bf16x8 b1 = *(const LAS bf16x8*)(a + 32 * 256);
        p0 = __builtin_amdgcn_mfma_f32_32x32x16_bf16(b0, qr[d0], p0, 0, 0, 0);
        p1 = __builtin_amdgcn_mfma_f32_32x32x16_bf16(b1, qr[d0], p1, 0, 0, 0); }
}
template <int VBUF>
__device__ __forceinline__ void pv_tile(f32x16 (&o)[4], int vb0, bf16x8 pa0, bf16x8 pa1, bf16x8 pa2, bf16x8 pa3) {
#define AT_TRRD(dst, off) asm volatile("ds_read_b64_tr_b16 %0, %1 offset:%2" : "=&v"(dst) : "v"(vb0), "i"(off) : "memory")
#define AT_PV_D0(d0) do { s16x4 l0, l1, l2, l3, h0, h1, h2, h3; constexpr int b_ = VBUF * SHM_V + v_rd_off(d0, 0, 0); \
        AT_TRRD(l0, b_); AT_TRRD(h0, b_ + 2048); AT_TRRD(l1, b_ + 4096); AT_TRRD(h1, b_ + 6144); AT_TRRD(l2, b_ + 8192); AT_TRRD(h2, b_ + 10240); AT_TRRD(l3, b_ + 12288); AT_TRRD(h3, b_ + 14336); \
        asm volatile("s_waitcnt lgkmcnt(0)" ::: "memory"); __builtin_amdgcn_sched_barrier(0); \
        o[d0] = __builtin_amdgcn_mfma_f32_32x32x16_bf16(pa0, (bf16x8){l0[0], l0[1], l0[2], l0[3], h0[0], h0[1], h0[2], h0[3]}, o[d0], 0, 0, 0); \
        o[d0] = __builtin_amdgcn_mfma_f32_32x32x16_bf16(pa1, (bf16x8){l1[0], l1[1], l1[2], l1[3], h1[0], h1[1], h1[2], h1[3]}, o[d0], 0, 0, 0); \
        o[d0] = __builtin_amdgcn_mfma_f32_32x32x16_bf16(pa2, (bf16x8){l2[0], l2[1], l2[2], l2[3], h2[0], h2[1], h2[2], h2[3]}, o[d0], 0, 0, 0); \
        o[d0] = __builtin_amdgcn_mfma_f32_32x32x16_bf16(pa3, (bf16x8){l3[0], l3[1], l3[2], l3[3], h3[0], h3[1], h3[2], h3[3]}, o[d0], 0, 0, 0); } while (0)
    AT_PV_D0(0); AT_PV_D0(1); AT_PV_D0(2); AT_PV_D0(3);
#undef AT_PV_D0
#undef AT_TRRD
}

template <int VAR>
__device__ __forceinline__ void attn_item(const bf16_t* Qh, const bf16_t* Kh, const bf16_t* Vh, bf16_t* OB, const float* relb, const float* LOGF, int b, int h, int qb, LAS unsigned char* lds, int tid) {
    const int wid = __builtin_amdgcn_readfirstlane(tid >> 6), lane = tid & 63, r32 = lane & 31, hi = lane >> 5;
    const int g = VAR == 0 ? h : (VAR == 1 ? 12 + h : 22 + h);
    const size_t hb = (size_t)(b * NH + g) * S * HD;
    const bf16_t* Kp = Kh + hb; const bf16_t* Vp = Vh + hb;
    LAS unsigned char* V_lds = lds + OFF_V; LAS unsigned char* K_lds = lds + OFF_K;
    LAS float* wsf = (LAS float*)(lds + OFF_WS) + wid * 64; LAS float* li_l = wsf; LAS float* al_l = wsf + 32;
    LAS float* cumL = (LAS float*)(lds + OFF_CUM); LAS float* Rt = (LAS float*)(lds + OFF_RT); volatile LAS unsigned* flags = (volatile LAS unsigned*)(lds + OFF_MISC);
    const int P0 = qb * QB, qlo = P0 + wid * 32, qpos = qlo + r32;
    int NT, jlo = 0;
    if (VAR == 0) { jlo = 4 * qb - 8; if (jlo < 0) jlo = 0; NT = 4 * qb + 4 - jlo; } else NT = 4 * qb + 4;
    const int cw = 4 * qb + (wid >> 1);
#define AT_KBASE(t) (VAR == 1 ? (4 * qb + 3 - (t)) * KVB : (jlo + (t)) * KVB)
#define AT_ACT(t) (VAR == 0 ? ((jlo + (t)) >= cw - 8 && (jlo + (t)) <= cw) : (VAR == 1 ? (AT_KBASE(t) <= qlo + 30) : (AT_KBASE(t) <= qlo + 31)))
    if (VAR == 0) {
        const float* tab = relb + h * 257;
        for (int j = tid; j < 639; j += 512) { int rel = 575 - j; rel = rel < -128 ? -128 : (rel > 128 ? 128 : rel); Rt[j] = tab[rel + 128] * LOG2E; }
    }
    if (VAR == 2) {
        const float* lf = LOGF + (size_t)(b * 10 + h) * S; const int kend = P0 + QB;
        f32x4 v = (f32x4){0.f, 0.f, 0.f, 0.f};
        if (4 * tid < kend) v = *(const f32x4*)(lf + 4 * tid);
        v[1] += v[0]; v[2] += v[1]; v[3] += v[2];
        float tot = v[3];
#pragma unroll
        for (int o = 1; o < 64; o <<= 1) { const float t_ = lane_read(tot, lane >= o ? lane - o : lane); if (lane >= o) tot += t_; }
        if (lane == 63) li_l[0] = tot;
        __syncthreads();
        float base = tot - v[3];
        for (int w = 0; w < wid; ++w) base += ((LAS float*)(lds + OFF_WS))[w * 64];
        if (4 * tid < kend) *(LAS f32x4*)(cumL + 4 * tid) = (f32x4){(base + v[0]) * LOG2E, (base + v[1]) * LOG2E, (base + v[2]) * LOG2E, (base + v[3]) * LOG2E};
    }
    bf16x8 qr[8];
    { const bf16_t* qp = Qh + hb + (size_t)(qlo + r32) * HD + hi * 8;
#pragma unroll
      for (int d0 = 0; d0 < 8; ++d0) qr[d0] = *(const bf16x8*)(qp + d0 * 16); }
    const int sr = tid >> 4, sc = (tid & 15) * 8, vst0 = v_st(sr, sc), vst1 = v_st(32 + sr, sc), kws = AT_KSWZ(sr, sc * 2);
    const int vb0 = (int)(unsigned)(size_t)V_lds + v_rd_base(lane);
    bf16x8 st_k0, st_k1, st_v0, st_v1;
#define AT_SLOAD(k0) do { const bf16_t* kp_ = Kp + (size_t)((k0) + sr) * HD + sc; const bf16_t* vp_ = Vp + (size_t)((k0) + sr) * HD + sc; \
        st_k0 = *(const bf16x8*)kp_; st_k1 = *(const bf16x8*)(kp_ + 32 * HD); st_v0 = *(const bf16x8*)vp_; st_v1 = *(const bf16x8*)(vp_ + 32 * HD); } while (0)
#define AT_SWRITE(bf) do { *(LAS bf16x8*)(K_lds + (bf) * SHM_K + kws) = st_k0; *(LAS bf16x8*)(K_lds + (bf) * SHM_K + kws + 32 * 256) = st_k1; \
        *(LAS bf16x8*)(V_lds + (bf) * SHM_V + vst0) = st_v0; *(LAS bf16x8*)(V_lds + (bf) * SHM_V + vst1) = st_v1; } while (0)
    AT_SLOAD(AT_KBASE(0)); asm volatile("s_waitcnt vmcnt(0)" ::: "memory"); AT_SWRITE(0);
    __syncthreads();
    float m_reg = -1e30f, l_reg = 0.f, carry = 0.f;
    f32x16 o[4] = {};
#define AT_STEP(BUF, t) do { \
        const bool more_ = (t) + 1 < NT; \
        if (more_) AT_SLOAD(AT_KBASE((t) + 1)); \
        if (AT_ACT(t)) { \
            const int kb_ = AT_KBASE(t); f32x16 p0, p1; bf16x8 pa0, pa1, pa2, pa3; \
            qkt<BUF>(p0, p1, K_lds, r32, hi, qr); \
            tile_math(p0, p1, kb_, pa0, pa1, pa2, pa3); \
            pv_tile<BUF>(o, vb0, pa0, pa1, pa2, pa3); \
        } \
        if (more_) { asm volatile("s_waitcnt vmcnt(0)" ::: "memory"); AT_SWRITE((BUF) ^ 1); } \
        if (VAR == 1) { const bool done_ = __all(carry < SB_DONE); if (lane == 0) flags[((t) & 1) * 8 + wid] = done_ ? 1u : 0u; } \
        __syncthreads(); \
    } while (0)
    auto tile_math = [&](f32x16& p0, f32x16& p1, int kb, bf16x8& pa0, bf16x8& pa1, bf16x8& pa2, bf16x8& pa3) __attribute__((always_inline)) {
        const int dq = qpos - kb - 4 * hi;
        if (VAR == 1) {
            const bool need_mask = kb + 63 >= qlo;
            f32x16 n0, n1;
#pragma unroll
            for (int r = 0; r < 16; ++r) { const float z = p0[r]; const float lp = __builtin_amdgcn_logf(1.0f + __builtin_amdgcn_exp2f(-fabsf(z))); n0[r] = fminf(-z, 0.f) - lp;
                                           const float y = p1[r]; const float lq = __builtin_amdgcn_logf(1.0f + __builtin_amdgcn_exp2f(-fabsf(y))); n1[r] = fminf(-y, 0.f) - lq; }
            if (need_mask) {
#pragma unroll
                for (int r = 0; r < 16; ++r) { const int c = (r & 3) + 8 * (r >> 2);
                    if (dq - c <= 0) { n0[r] = 0.f; p0[r] = -__builtin_inff(); }
                    if (dq - c - 32 <= 0) { n1[r] = 0.f; p1[r] = -__builtin_inff(); } }
            }
            float A[8], Bp[8];
#pragma unroll
            for (int q = 0; q < 4; ++q) { A[q] = (n0[4 * q] + n0[4 * q + 1]) + (n0[4 * q + 2] + n0[4 * q + 3]); A[4 + q] = (n1[4 * q] + n1[4 * q + 1]) + (n1[4 * q + 2] + n1[4 * q + 3]); }
#pragma unroll
            for (int q = 0; q < 8; ++q) Bp[q] = partner(A[q], hi);
            float st = 0.f;
#pragma unroll
            for (int q = 7; q >= 0; --q) {
                const float after = carry + st + (hi == 0 ? Bp[q] : 0.f);
                if (q >= 4) { const int r0 = 4 * (q - 4);
                    float tl = after; p1[r0 + 3] = __builtin_amdgcn_exp2f(p1[r0 + 3] + n1[r0 + 3] + tl); tl += n1[r0 + 3]; p1[r0 + 2] = __builtin_amdgcn_exp2f(p1[r0 + 2] + n1[r0 + 2] + tl); tl += n1[r0 + 2];
                    p1[r0 + 1] = __builtin_amdgcn_exp2f(p1[r0 + 1] + n1[r0 + 1] + tl); tl += n1[r0 + 1]; p1[r0] = __builtin_amdgcn_exp2f(p1[r0] + n1[r0] + tl); }
                else { const int r0 = 4 * q;
                    float tl = after; p0[r0 + 3] = __builtin_amdgcn_exp2f(p0[r0 + 3] + n0[r0 + 3] + tl); tl += n0[r0 + 3]; p0[r0 + 2] = __builtin_amdgcn_exp2f(p0[r0 + 2] + n0[r0 + 2] + tl); tl += n0[r0 + 2];
                    p0[r0 + 1] = __builtin_amdgcn_exp2f(p0[r0 + 1] + n0[r0 + 1] + tl); tl += n0[r0 + 1]; p0[r0] = __builtin_amdgcn_exp2f(p0[r0] + n0[r0] + tl); }
                st += A[q] + Bp[q];
            }
            carry += st;
            pack_p(p0, p1, pa0, pa1, pa2, pa3);
        } else {
            if (VAR == 0) {
                const LAS float* rp = Rt + (575 - (qpos - kb) + 4 * hi);
#pragma unroll
                for (int r = 0; r < 16; ++r) { const int c = (r & 3) + 8 * (r >> 2); p0[r] += rp[c]; p1[r] += rp[c + 32]; }
            } else {
                const LAS float* cp = cumL + kb + 4 * hi;
#pragma unroll
                for (int q = 0; q < 4; ++q) { const f32x4 c0 = *(const LAS f32x4*)(cp + 8 * q), c1 = *(const LAS f32x4*)(cp + 32 + 8 * q);
                    p0[4 * q] -= c0[0]; p0[4 * q + 1] -= c0[1]; p0[4 * q + 2] -= c0[2]; p0[4 * q + 3] -= c0[3];
                    p1[4 * q] -= c1[0]; p1[4 * q + 1] -= c1[1]; p1[4 * q + 2] -= c1[2]; p1[4 * q + 3] -= c1[3]; }
                if (kb + 63 > qlo) {
#pragma unroll
                    for (int r = 0; r < 16; ++r) { const int c = (r & 3) + 8 * (r >> 2);
                        if (dq - c < 0) p0[r] = -__builtin_inff();
                        if (dq - c - 32 < 0) p1[r] = -__builtin_inff(); }
                }
            }
            float pmax = p0[0];
#pragma unroll
            for (int r = 1; r < 16; ++r) pmax = fmaxf(pmax, p0[r]);
#pragma unroll
            for (int r = 0; r < 16; ++r) pmax = fmaxf(pmax, p1[r]);
            pmax = xchg_max(pmax, hi);
            float mn, alpha;
            if (__all(pmax - m_reg <= THR2)) { mn = m_reg; alpha = 1.f; }
            else { mn = fmaxf(m_reg, pmax); alpha = __builtin_amdgcn_exp2f(m_reg - mn); m_reg = mn; }
            float ps = 0.f;
#pragma unroll
            for (int r = 0; r < 16; ++r) { p0[r] = __builtin_amdgcn_exp2f(p0[r] - mn); p1[r] = __builtin_amdgcn_exp2f(p1[r] - mn); ps += p0[r] + p1[r]; }
            ps = xchg_sum(ps, hi);
            l_reg = l_reg * alpha + ps;
            if (__any(alpha < 1.f)) {
                if (hi == 0) al_l[r32] = alpha;
                asm volatile("s_waitcnt lgkmcnt(0)" ::: "memory");
                float av[16];
#pragma unroll
                for (int r = 0; r < 16; ++r) av[r] = al_l[crow(r, hi)];
#pragma unroll
                for (int d = 0; d < 4; ++d)
#pragma unroll
                    for (int r = 0; r < 16; ++r) o[d][r] *= av[r];
            }
            pack_p(p0, p1, pa0, pa1, pa2, pa3);
        }
    };
    for (int t = 0; t < NT; t += 2) {
        AT_STEP(0, t);
        if (VAR == 1) { unsigned all_ = 1u; for (int w = 0; w < 8; ++w) all_ &= flags[(t & 1) * 8 + w]; if (all_) break; }
        if (t + 1 >= NT) break;
        AT_STEP(1, t + 1);
        if (VAR == 1) { unsigned all_ = 1u; for (int w = 0; w < 8; ++w) all_ &= flags[((t + 1) & 1) * 8 + w]; if (all_) break; }
    }
    float rli[16];
    if (VAR != 1) {
        if (hi == 0) li_l[r32] = l_reg;
        asm volatile("s_waitcnt lgkmcnt(0)" ::: "memory");
#pragma unroll
        for (int r = 0; r < 16; ++r) rli[r] = __builtin_amdgcn_rcpf(li_l[crow(r, hi)]);
    }
    unsigned char* Ow8 = (unsigned char*)OB + (size_t)(b * S + qlo) * D + g * HD;
#pragma unroll
    for (int r = 0; r < 16; ++r) { const int orow = crow(r, hi);
#pragma unroll
        for (int d0 = 0; d0 < 4; ++d0) { const float v = VAR != 1 ? o[d0][r] * rli[r] : o[d0][r];
            const float vn = lane_read(v, lane ^ 1);
            if ((r32 & 1) == 0) *(unsigned short*)(Ow8 + (size_t)orow * D + d0 * 32 + r32) = (unsigned short)__builtin_amdgcn_cvt_pk_fp8_f32(clamp8(v * 16.0f), clamp8(vn * 16.0f), 0, false); } }
    __syncthreads();
#undef AT_STEP
#undef AT_SLOAD
#undef AT_SWRITE
#undef AT_KBASE
#undef AT_ACT
}

template <int VAR>
__device__ __forceinline__ void attn_queue(const bf16_t* Qh, const bf16_t* Kh, const bf16_t* Vh, bf16_t* OB, const float* relb, const float* LOGF, unsigned* qhead, LAS unsigned char* lds, int wave0) {
    FRESH_TID(); FRESH_LDS(lds);
    volatile LAS unsigned* qslot = (volatile LAS unsigned*)(lds + OFF_MISC) + 32;
    constexpr int NHV = VAR == 0 ? 12 : 10, NITEMS = 8 * NHV * 8;
    for (;;) {
        if (tid == 0) qslot[0] = __hip_atomic_fetch_add(qhead, 1u, __ATOMIC_RELAXED, __HIP_MEMORY_SCOPE_AGENT);
        __syncthreads();
        const int idx = (int)qslot[0];
        __syncthreads();
        if (idx >= NITEMS) break;
        const int qb = 7 - idx / (8 * NHV), bh = idx % (8 * NHV);
        attn_item<VAR>(Qh, Kh, Vh, OB, relb, LOGF, bh / NHV, bh % NHV, qb, lds, tid);
    }
}
__device__ __forceinline__ void attn_phase(const bf16_t* Qh, const bf16_t* Kh, const bf16_t* Vh, bf16_t* OB, const float* relb, const float* LOGF, unsigned* qheads, LAS unsigned char* lds, int wave0) {
    attn_queue<2>(Qh, Kh, Vh, OB, relb, LOGF, qheads + 0, lds, wave0);
    attn_queue<0>(Qh, Kh, Vh, OB, relb, LOGF, qheads + 64, lds, wave0);
    attn_queue<1>(Qh, Kh, Vh, OB, relb, LOGF, qheads + 128, lds, wave0);
}
}
namespace mk {
#define XB_TMO      128
#define XB_XCNT(j)  (256  + 64 * (j))
#define XB_XSUB(j)  (1280 + 64 * (j))
#define XB_XGEN(j)  (2304 + 64 * (j))
#define XB_TOP      3328
#define XB_TOPGEN   3392
#define XCD_BAR_WORDS 3456
#define XB_SPIN_CAP (1u << 22)

__device__ __forceinline__ unsigned xb_ld(unsigned* p)              { return __hip_atomic_load(p, __ATOMIC_RELAXED, __HIP_MEMORY_SCOPE_AGENT); }
__device__ __forceinline__ unsigned xb_add(unsigned* p, unsigned v) { return __hip_atomic_fetch_add(p, v, __ATOMIC_RELAXED, __HIP_MEMORY_SCOPE_AGENT); }
__device__ __forceinline__ unsigned xb_xcc_id() { return (unsigned)__builtin_amdgcn_s_getreg((3 << 11) | 20) & 0xFu; }
#define XB_SPIN(cond, bar) do { unsigned _sp = 0; while (cond) { __builtin_amdgcn_s_sleep(1); \
    if ((++_sp & 255u) == 0u) { if (xb_ld(&(bar)[XB_TMO])) break; if (_sp > XB_SPIN_CAP) { atomicAdd(&(bar)[XB_TMO], 1u); break; } } } } while (0)

struct XcdBarrier {
    unsigned* bar; unsigned x;
    volatile LAS unsigned* st;
};

__device__ __forceinline__ XcdBarrier xcd_barrier_post(unsigned* bar, volatile LAS unsigned* st, bool is_t0) {
    XcdBarrier b; b.bar = bar; b.x = xb_xcc_id(); b.st = st;
    if (is_t0) (void)xb_add(&bar[XB_XCNT(b.x)], 1u);
    return b;
}
__device__ __forceinline__ void xcd_barrier_complete(unsigned* bar, unsigned x, unsigned& nloc, unsigned& nx) {
    const unsigned G = gridDim.x * gridDim.y * gridDim.z;
    unsigned sum, cnt, mine, sp = 0u;
    for (;;) {
        sum = 0u; cnt = 0u; mine = 0u;
#pragma unroll
        for (unsigned j = 0; j < 16; ++j) { const unsigned c = xb_ld(&bar[XB_XCNT(j)]); sum += c; cnt += (c > 0u) ? 1u : 0u; mine = (j == x) ? c : mine; }
        if (sum == G) break;
        __builtin_amdgcn_s_sleep(1);
        if ((++sp & 255u) == 0u) { if (xb_ld(&bar[XB_TMO])) break; if (sp > XB_SPIN_CAP) { atomicAdd(&bar[XB_TMO], 1u); break; } }
    }
    nloc = mine > 0u ? mine : 1u; nx = cnt > 0u ? cnt : 1u;
}

__device__ __forceinline__ void xcd_barrier(const XcdBarrier& b, bool is_t0) {
    asm volatile("s_waitcnt vmcnt(0)" ::: "memory");
    __syncthreads();
    if (is_t0) {
        unsigned* bar = b.bar;
        __builtin_amdgcn_s_waitcnt(0);
        unsigned nloc = b.st[0], nx = b.st[1];
        if (nloc == 0u) { xcd_barrier_complete(bar, b.x, nloc, nx); b.st[0] = nloc; b.st[1] = nx; }
        const unsigned old = xb_add(&bar[XB_XSUB(b.x)], 1u);
        const unsigned gen = old / nloc;
        if (old + 1u == (gen + 1u) * nloc) {
            __builtin_amdgcn_fence(__ATOMIC_RELEASE, "agent");
            asm volatile("s_waitcnt vmcnt(0)" ::: "memory");
            const unsigned og = xb_add(&bar[XB_TOP], 1u);
            const unsigned tg = og / nx;
            if (og + 1u == (tg + 1u) * nx) xb_add(&bar[XB_TOPGEN], 1u);
            else XB_SPIN(xb_ld(&bar[XB_TOPGEN]) == tg, bar);
            __builtin_amdgcn_fence(__ATOMIC_ACQUIRE, "agent");
            xb_add(&bar[XB_XGEN(b.x)], 1u);
            asm volatile("s_waitcnt vmcnt(0)" ::: "memory");
        } else {
            XB_SPIN(xb_ld(&bar[XB_XGEN(b.x)]) == gen, bar);
            __builtin_amdgcn_fence(__ATOMIC_ACQUIRE, "agent");
            asm volatile("s_waitcnt vmcnt(0)" ::: "memory");
        }
    }
    __syncthreads();
}

constexpr int PH_PER_LAYER = 8;
typedef const __attribute__((address_space(4))) Args* KArgs;
#define KARGS() ({ KArgs p_ = (KArgs)__builtin_amdgcn_kernarg_segment_ptr(); asm volatile("" : "+s"(p_)); p_; })
#define GRID_BAR() do { KArgs k_ = KARGS(); XcdBarrier b_; b_.bar = (unsigned*)(k_->ws + WS_CTL) + CW_BAR; b_.x = xb_xcc_id(); b_.st = (volatile LAS unsigned*)(lds + MISC_OFF) + 8; unsigned z_ = 0u; asm volatile("" : "+v"(z_)); const bool t0_ = (wave0 == 0) && (__builtin_amdgcn_mbcnt_hi(~0u, __builtin_amdgcn_mbcnt_lo(~0u, z_)) == 0u);     xcd_barrier(b_, t0_); } while (0)
__global__ void __launch_bounds__(NWAVES * 64, 2) mk_fwd(Args a_unused) {
    extern __shared__ __attribute__((aligned(16))) unsigned char lds_raw[];
    LAS unsigned char* lds = (LAS unsigned char*)lds_raw;
    const int wave0 = __builtin_amdgcn_readfirstlane((int)threadIdx.x >> 6);
    for (int u = threadIdx.x; u < (LDS_BYTES - LDSCTL_OFF) / 4; u += NWAVES * 64) ((LAS unsigned*)(lds + LDSCTL_OFF))[u] = 0u;
    __syncthreads();
    int lo, hi;
    { KArgs k = KARGS(); lo = k->ph_lo; hi = k->ph_hi;
      if (hi - lo > 1) (void)xcd_barrier_post((unsigned*)(k->ws + WS_CTL) + CW_BAR, (volatile LAS unsigned*)(lds + MISC_OFF) + 8, threadIdx.x == 0); }
#define IN(k) (lo <= (k) && (k) < hi)
#define BOTH(k) (IN(k) && IN((k) + 1))
#pragma unroll
    for (int l = 0; l < 2; ++l) {
        const int pb = PH_PER_LAYER * l;
        if (IN(pb + 0)) { KArgs k = KARGS(); conv_phase(k, l, lds, wave0); }
        if (IN(pb + 1) && l == 0) {
            KArgs k = KARGS(); unsigned char* ws = k->ws;
            const float* xin = k->in[0];
            prep_phase<true>(xin, (bf16_t*)(ws + WS_XB8N), (float*)(ws + WS_RSTD), k->in[2] + (size_t)l * D * PW, k->in[1] + (size_t)l * D, k->in[3] + l * 10, (float*)(ws + WS_LOGF), lds, wave0);
            if (BOTH(pb + 1)) GRID_BAR();
        }
        if (l == 1 && IN(pb + 0) && IN(pb + 2)) GRID_BAR();
        if (IN(pb + 2)) {
            KArgs k = KARGS(); unsigned char* ws = k->ws;
            pg8::Gemm g{(const bf16_t*)(ws + WS_XB8N), (const bf16_t*)(ws + WS_WIN), M, 12288, D}; pg8::StaticOrder So; FRESH_BID(); So.init(M, 12288, G, bid);
            pg8::EpiQKV4 E{(bf16_t*)(ws + WS_Q), (const float*)(ws + WS_RSTD), 0.08838834764831845f * 1.4426950408889634f, US_INV};
            { LAS unsigned char* lds_ = lds; FRESH_LDS(lds_); FRESH_TID(); pg8::gemm_phase<pg8::EpiQKV4, pg8::StaticOrder, true, true, true>(lds_, g, So, E, tid); }
            if (BOTH(pb + 2)) GRID_BAR();
        }
        if (IN(pb + 3)) {
            KArgs k = KARGS(); unsigned char* ws = k->ws;
            at::attn_phase((const bf16_t*)(ws + WS_Q), (const bf16_t*)(ws + WS_K), (const bf16_t*)(ws + WS_V), (bf16_t*)(ws + WS_OB), k->in[4] + (size_t)l * 12 * 257, (const float*)(ws + WS_LOGF),
                           (unsigned*)(ws + WS_CTL) + CW_QUEUE + 256 * l, lds, wave0);
            if (BOTH(pb + 3)) GRID_BAR();
        }
        if (IN(pb + 4)) {
            KArgs k = KARGS(); unsigned char* ws = k->ws;
            pg8::Gemm g{(const bf16_t*)(ws + WS_OB), (const bf16_t*)(ws + WS_WOUT), M, D, D}; pg8::StaticOrder So; FRESH_BID(); So.init(M, D, G, bid);
            if (l == 0) { pg8::EpiResidB16<true> E{k->in[0], US_INV * (1.0f / 16.0f), (bf16_t*)(ws + WS_XB)};
                { LAS unsigned char* lds_ = lds; FRESH_LDS(lds_); FRESH_TID(); pg8::gemm_phase<pg8::EpiResidB16<true>, pg8::StaticOrder, false, true, true>(lds_, g, So, E, tid); } }
            else { pg8::EpiResidB16<false> E{ws + WS_X2, US_INV * (1.0f / 16.0f), (bf16_t*)(ws + WS_XB)};
                { LAS unsigned char* lds_ = lds; FRESH_LDS(lds_); FRESH_TID(); pg8::gemm_phase<pg8::EpiResidB16<false>, pg8::StaticOrder, false, true, true>(lds_, g, So, E, tid); } }
            if (BOTH(pb + 4)) GRID_BAR();
        }
        if (IN(pb + 5)) {
            KArgs k = KARGS(); unsigned char* ws = k->ws;
            pg8::Gemm g{(const bf16_t*)(ws + WS_XB), (const bf16_t*)(ws + WS_WQK), M, 2048, D}; pg8::StaticOrder So; FRESH_BID(); So.init(M, 2048, G, bid);
            pg8::EpiPlainF32<2048> E{(float*)(ws + WS_SC)};
            { LAS unsigned char* lds_ = lds; FRESH_LDS(lds_); FRESH_TID(); pg8::gemm_phase<pg8::EpiPlainF32<2048>, pg8::StaticOrder, true, true>(lds_, g, So, E, tid); }
            if (BOTH(pb + 5)) GRID_BAR();
        }
        if (IN(pb + 6)) {
            KArgs k = KARGS(); unsigned char* ws = k->ws;
            if (l == 0) peer_uv_phase<false>((const float*)(ws + WS_SC), (const unsigned char*)(ws + WS_U16), (const unsigned char*)(ws + WS_U16) + (size_t)NE * ROW6  , (const bf16_t*)(ws + WS_XB), ws + WS_X2, nullptr,
                                             ws + WS_XB8N, (float*)(ws + WS_RSTD), (float*)(ws + WS_LOGF), k->in[2] + (size_t)D * PW, k->in[1] + D, k->in[3] + 10, lds, wave0);
            else peer_uv_phase<true>((const float*)(ws + WS_SC), (const unsigned char*)(ws + WS_U16), (const unsigned char*)(ws + WS_U16) + (size_t)NE * ROW6  , (const bf16_t*)(ws + WS_XB), k->out, k->in[12],
                                     nullptr, nullptr, nullptr, nullptr, nullptr, nullptr, lds, wave0);
            if (BOTH(pb + 7)) GRID_BAR();
        }
    }
#undef IN
#undef BOTH
}

static int g_grid = 0;
static void launch_phases(Args a, int lo, int hi, hipStream_t st) {
    a.ph_lo = lo; a.ph_hi = hi;
    hipLaunchKernelGGL(mk_fwd, dim3(g_grid), dim3(NWAVES * 64), LDS_BYTES, st, a);
}
}

extern "C" void kernel_launch(void* const* d_in, const int* in_sizes, int n_in, void* d_out, int out_size, void* d_ws, size_t ws_size, hipStream_t stream) {
    (void)in_sizes; (void)n_in; (void)out_size;
    using namespace mk;
    if (g_grid == 0) {
        if (ws_size < 2048 * MiB) { fprintf(stderr, "kernel_launch: workspace too small (%zu)\n", ws_size); g_grid = -1; return; }
        if (hipFuncSetAttribute((const void*)mk_fwd, hipFuncAttributeMaxDynamicSharedMemorySize, LDS_BYTES) != hipSuccess) { fprintf(stderr, "kernel_launch: hipFuncSetAttribute failed\n"); g_grid = -1; return; }
        int dev = 0, cus = 0; (void)hipGetDevice(&dev); (void)hipDeviceGetAttribute(&cus, hipDeviceAttributeMultiprocessorCount, dev);
        g_grid = cus > 0 ? cus : 256;
    }
    if (g_grid < 0) return;
    unsigned char* ws = (unsigned char*)d_ws; float* out = (float*)d_out;
    (void)hipMemsetAsync(ws + WS_CTL, 0, CTL_ZERO_BYTES, stream);
    Args a{};
    for (int i = 0; i < 13; ++i) a.in[i] = (const float*)d_in[i];
    a.out = out; a.ws = ws;
    launch_phases(a, 0, 2 * PH_PER_LAYER, stream);
}
```

```cpp
#include <hip/hip_runtime.h>
#include <cstdio>
#include <cstdint>
namespace pg8 {
#define PG8_LAS __attribute__((address_space(3)))
typedef unsigned short bf16_t;
typedef short bf16x8 __attribute__((ext_vector_type(8)));
typedef float f32x4 __attribute__((ext_vector_type(4)));
typedef unsigned u32x4 __attribute__((ext_vector_type(4)));
typedef unsigned u32x2 __attribute__((ext_vector_type(2)));
constexpr int BM = 256, BK = 64, HALF = 128, HTB = HALF * BK * 2  , STAGE_BYTES = 8 * HTB, NXCD = 8, WGM = 8;

__host__ __device__ __forceinline__ int lds_byte(int r, int c) { const int st = (r >> 4) * 2 + (c >> 5), rr = r & 15, cc = c & 31, ob = rr * 64 + cc * 2; return st * 1024 + (ob ^ (((ob >> 9) & 1) << 5)); }
__host__ __device__ __forceinline__ void stage_rc(int b, int& R, int& C) { const int st = b / 1024, sb = b % 1024, swz = sb ^ (((sb >> 9) & 1) << 5); R = (st >> 1) * 16 + swz / 64; C = (st & 1) * 32 + (swz % 64) / 2; }
__host__ __device__ __forceinline__ int perm32(int rho) { const int n = rho >> 4, i = rho & 15; return 8 * (i >> 2) + 4 * n + (i & 3); }

struct Unit { int pm, pn; };
struct Gemm { const bf16_t* A; const bf16_t* Bt; int M, N, K; };

struct StaticOrder {
    int nM, nN, nwg, G, c;
    __host__ __device__ void init(int M, int N, int G_, int c_) { nM = M / BM; nN = N / BM; nwg = nM * nN; G = G_; c = c_; }
    __host__ __device__ bool next(int i, Unit& u) const {
        const long L = (long)i * G + c; if (L >= nwg) return false;
        int wgid = (int)L; { const int q = nwg / NXCD, r = nwg % NXCD, xcd = wgid % NXCD, off = wgid / NXCD; wgid = (xcd < r ? xcd * (q + 1) : r * (q + 1) + (xcd - r) * q) + off; }
        const int nig = WGM * nN, gid = wgid / nig, fm = gid * WGM, gsz = (nM - fm) < WGM ? (nM - fm) : WGM;
        u.pm = fm + ((wgid % nig) % gsz); u.pn = (wgid % nig) / gsz; return true;
    }
    __device__ __forceinline__ void a_ready(const Unit&) const {}
    __device__ __forceinline__ void done(const Unit&) const {}
};
__device__ __forceinline__ unsigned cvt_pk_bf16(float lo, float hi) { unsigned r; asm volatile("v_cvt_pk_bf16_f32 %0, %1, %2" : "=v"(r) : "v"(lo), "v"(hi)); return r; }
typedef float f32x2 __attribute__((ext_vector_type(2)));
__device__ __forceinline__ f32x2 gelu_pk(f32x2 v) {
    const f32x2 av = __builtin_elementwise_abs(v), d = av * 0.2316418882f + 1.0f;
    f32x2 t; t.x = __builtin_amdgcn_rcpf(d.x); t.y = __builtin_amdgcn_rcpf(d.y);
    f32x2 q = t * 0.5307027145f + (-0.7265760135f); q = q * t + 0.7107068705f; q = q * t + (-0.142248368f); q = q * t + 0.127414796f; q = q * t;
    const f32x2 s = (v * v) * (-0.72134752044f);
    f32x2 e; e.x = __builtin_amdgcn_exp2f(s.x); e.y = __builtin_amdgcn_exp2f(s.y);
    const f32x2 m = v * (q * e), r = v - m;
    f32x2 o; o.x = v.x < 0.f ? m.x : r.x; o.y = v.y < 0.f ? m.y : r.y; return o;
}
#define EPI_FRESH_LANE() { unsigned z_ = 0u; asm volatile("" : "+v"(z_)); const int l_ = (int)__builtin_amdgcn_mbcnt_hi(~0u, __builtin_amdgcn_mbcnt_lo(~0u, z_)); fr = l_ & 15; fq = l_ >> 4; }
typedef __amdgpu_buffer_rsrc_t rsrc_t;
__device__ __forceinline__ rsrc_t mkrsrc(const void* p, unsigned bytes) { return __builtin_amdgcn_make_buffer_rsrc((void*)p, (short)0, (int)bytes, 0x00020000); }
template <int LDC> struct EpiPlainF32 {
    static constexpr bool PERM = false, AFTER_DRAIN = false;
    float* C;
    __device__ __forceinline__ void operator()(const f32x4 (&acc)[2][2][4][2], const Unit& u, int wr, int wc, int fr, int fq) const {
        EPI_FRESH_LANE();
        const rsrc_t rc = mkrsrc(C, 16384u * LDC * 4u);
        const int vo = ((wr * 64 + fr) * LDC + wc * 32 + 4 * fq) * 4, so = (u.pm * BM * LDC + u.pn * BM) * 4;
#pragma unroll
        for (int ai = 0; ai < 2; ++ai)
#pragma unroll
            for (int m = 0; m < 4; ++m)
#pragma unroll
                for (int bj = 0; bj < 2; ++bj)
#pragma unroll
                    for (int n = 0; n < 2; ++n) __builtin_amdgcn_raw_buffer_store_b128(__builtin_bit_cast(u32x4, acc[ai][bj][m][n]), rc, vo, so + ((ai * HALF + m * 16) * LDC + bj * HALF + n * 16) * 4, 0);
    }
};
template <int LDC> struct EpiRowScaleF32 {
    static constexpr bool PERM = false, AFTER_DRAIN = false;
    float* C; const float* rs;
    __device__ __forceinline__ void operator()(const f32x4 (&acc)[2][2][4][2], const Unit& u, int wr, int wc, int fr, int fq) const {
        const rsrc_t rc = mkrsrc(C, 16384u * LDC * 4u), rr = mkrsrc(rs, 16384u * 4u);
        const int vo = ((wr * 64 + fr) * LDC + wc * 32 + 4 * fq) * 4, vr = (wr * 64 + fr) * 4;
        const int so = (u.pm * BM * LDC + u.pn * BM) * 4, sr = u.pm * BM * 4;
#pragma unroll
        for (int ai = 0; ai < 2; ++ai)
#pragma unroll
            for (int m = 0; m < 4; ++m) { const float s = __builtin_bit_cast(float, __builtin_amdgcn_raw_buffer_load_b32(rr, vr, sr + (ai * HALF + m * 16) * 4, 0));
#pragma unroll
                for (int bj = 0; bj < 2; ++bj)
#pragma unroll
                    for (int n = 0; n < 2; ++n) { const f32x4 v = acc[ai][bj][m][n] * s; __builtin_amdgcn_raw_buffer_store_b128(__builtin_bit_cast(u32x4, v), rc, vo, so + ((ai * HALF + m * 16) * LDC + bj * HALF + n * 16) * 4, 0); } }
    }
};
template <bool BASE_F32> struct EpiResidB16 {
    static constexpr bool PERM = false, AFTER_DRAIN = false;
    const void* base; float ascale; bf16_t* xb;
    __device__ __forceinline__ void operator()(const f32x4 (&acc)[2][2][4][2], const Unit& u, int wr, int wc, int fr, int fq) const {
        EPI_FRESH_LANE();
        constexpr int LDC = 4096;
        const rsrc_t rb = mkrsrc(base, 16384u * LDC * (BASE_F32 ? 4u : 2u)), rx = mkrsrc(xb, 16384u * LDC * 2u);
        const int vo = ((wr * 64 + fr) * LDC + wc * 32 + 4 * fq) * 2;
        const int so = (u.pm * BM * LDC + u.pn * BM) * 2;
        f32x4 ra[2][2], rb2[2][2];
#define EPI_LD(dst, g_) do { _Pragma("unroll") for (int bj = 0; bj < 2; ++bj) _Pragma("unroll") for (int n = 0; n < 2; ++n) { \
            const int o = so + ((((g_) >> 2) * HALF + ((g_) & 3) * 16) * LDC + bj * HALF + n * 16) * 2; \
            if constexpr (BASE_F32) dst[bj][n] = __builtin_bit_cast(f32x4, __builtin_amdgcn_raw_buffer_load_b128(rb, vo * 2, o * 2, 0)); \
            else { const u32x2 t_ = __builtin_amdgcn_raw_buffer_load_b64(rb, vo, o, 0); dst[bj][n] = (f32x4){__builtin_bit_cast(float, t_.x << 16), __builtin_bit_cast(float, t_.x & 0xffff0000u), __builtin_bit_cast(float, t_.y << 16), __builtin_bit_cast(float, t_.y & 0xffff0000u)}; } } } while (0)
#define EPI_ST(src, g_) do { _Pragma("unroll") for (int bj = 0; bj < 2; ++bj) _Pragma("unroll") for (int n = 0; n < 2; ++n) { \
            const int o = so + ((((g_) >> 2) * HALF + ((g_) & 3) * 16) * LDC + bj * HALF + n * 16) * 2; \
            const f32x4 v = src[bj][n] + acc[(g_) >> 2][bj][(g_) & 3][n] * ascale; \
            u32x2 w; w.x = cvt_pk_bf16(v[0], v[1]); w.y = cvt_pk_bf16(v[2], v[3]); __builtin_amdgcn_raw_buffer_store_b64(w, rx, vo, o, 0); } } while (0)
        EPI_LD(ra, 0);
        EPI_LD(rb2, 1); EPI_ST(ra, 0);
        EPI_LD(ra, 2); EPI_ST(rb2, 1);
        EPI_LD(rb2, 3); EPI_ST(ra, 2);
        EPI_LD(ra, 4); EPI_ST(rb2, 3);
        EPI_LD(rb2, 5); EPI_ST(ra, 4);
        EPI_LD(ra, 6); EPI_ST(rb2, 5);
        EPI_LD(rb2, 7); EPI_ST(ra, 6);
        EPI_ST(rb2, 7);
#undef EPI_LD
#undef EPI_ST
    }
};
struct EpiQKV {
    static constexpr bool PERM = true, AFTER_DRAIN = false;
    bf16_t* Q; const float* rs; float qscale;
    __device__ __forceinline__ void operator()(const f32x4 (&acc)[2][2][4][2], const Unit& u, int wr, int wc, int fr, int fq) const {
        const rsrc_t rq = mkrsrc(Q, 3u * 16384u * 4096u * 2u), rr = mkrsrc(rs, 16384u * 4u);
        const int colt = u.pn * BM, which = colt >> 12, cw = colt & 4095, gt = cw >> 7;
        const int b = (u.pm * BM) >> 11, st = (u.pm * BM) & 2047;
        const float sc = which == 0 ? qscale : 1.f;
        const int so = (int)(((unsigned)which << 26) + (((unsigned)(b * 32 + gt) * 2048u + (unsigned)st) << 7)) * 2;
        const int vo = (((wr * 64 + fr) << 7) + wc * 32 + 8 * fq) * 2, vr = (wr * 64 + fr) * 4, sr = u.pm * BM * 4;
#pragma unroll
        for (int ai = 0; ai < 2; ++ai)
#pragma unroll
            for (int m = 0; m < 4; ++m) { const float f = sc * __builtin_bit_cast(float, __builtin_amdgcn_raw_buffer_load_b32(rr, vr, sr + (ai * HALF + m * 16) * 4, 0));
#pragma unroll
                for (int bj = 0; bj < 2; ++bj) {
                    const f32x4 v0 = acc[ai][bj][m][0] * f, v1 = acc[ai][bj][m][1] * f;
                    u32x4 w; w.x = cvt_pk_bf16(v0[0], v0[1]); w.y = cvt_pk_bf16(v0[2], v0[3]); w.z = cvt_pk_bf16(v1[0], v1[1]); w.w = cvt_pk_bf16(v1[2], v1[3]);
                    __builtin_amdgcn_raw_buffer_store_b128(w, rq, vo, so + ((bj * 2048 + ai * HALF + m * 16) << 7) * 2, 0); } }
    }
};

struct EpiQKV4 {
    static constexpr bool PERM = false, AFTER_DRAIN = false;
    bf16_t* Q; const float* rs; float qscale, wscale;
    __device__ __forceinline__ void operator()(const f32x4 (&acc)[2][2][4][2], const Unit& u, int wr, int wc, int fr, int fq) const {
        EPI_FRESH_LANE();
        const rsrc_t rq = mkrsrc(Q, 3u * 16384u * 4096u * 2u), rr = mkrsrc(rs, 16384u * 4u);
        const int colt = u.pn * BM, which = colt >> 12, cw = colt & 4095, gt = cw >> 7;
        const int b = (u.pm * BM) >> 11, st = (u.pm * BM) & 2047;
        const float sc = (which == 0 ? qscale : 1.f) * wscale;
        const int so = (int)(((unsigned)which << 26) + (((unsigned)(b * 32 + gt) * 2048u + (unsigned)st) << 7)) * 2;
        const int vo = (((wr * 64 + fr) << 7) + wc * 32 + 4 * fq) * 2, vr = (wr * 64 + fr) * 4, sr = u.pm * BM * 4;
        unsigned rsv[2][4];
#pragma unroll
        for (int ai = 0; ai < 2; ++ai)
#pragma unroll
            for (int m = 0; m < 4; ++m) rsv[ai][m] = __builtin_amdgcn_raw_buffer_load_b32(rr, vr, sr + (ai * HALF + m * 16) * 4, 0);
#pragma unroll
        for (int ai = 0; ai < 2; ++ai)
#pragma unroll
            for (int m = 0; m < 4; ++m) { const float f = sc * __builtin_bit_cast(float, rsv[ai][m]);
#pragma unroll
                for (int bj = 0; bj < 2; ++bj)
#pragma unroll
                    for (int n = 0; n < 2; ++n) { const f32x4 v0 = acc[ai][bj][m][n] * f; u32x2 w; w.x = cvt_pk_bf16(v0[0], v0[1]); w.y = cvt_pk_bf16(v0[2], v0[3]);
                        __builtin_amdgcn_raw_buffer_store_b64(w, rq, vo, so + (((bj * 2048 + ai * HALF + m * 16) << 7) + n * 16) * 2, 0); } }
    }
};

typedef int i32x8 __attribute__((ext_vector_type(8)));
template <bool F8> struct FragT { typedef bf16x8 type; };
template <> struct FragT<true> { typedef i32x8 type; };
__device__ __forceinline__ f32x4 mma_bf16(bf16x8 a, bf16x8 b, f32x4 c) { return __builtin_amdgcn_mfma_f32_16x16x32_bf16(a, b, c, 0, 0, 0); }
__device__ __forceinline__ f32x4 mma_bf16(i32x8, i32x8, f32x4 c) { return c; }
template <class Epi, class Sched, bool ALIGN_EPI = false, bool SP2 = false, bool F8 = false>
__device__ __forceinline__ void gemm_phase(PG8_LAS unsigned char* lds, const Gemm g, const Sched& S, const Epi& E, int tid_in) {
    int tid_ = tid_in;
    const int tid = tid_, wid = __builtin_amdgcn_readfirstlane(tid >> 6), lane = tid & 63, wr = wid >> 2, wc = wid & 3, fr = lane & 15, fq = lane >> 4;
    constexpr int EB = F8 ? 1 : 2;
    constexpr int K = 4096; constexpr int nt = (K * EB) / (BK * 2);
    unsigned voffA[2], voffB[2];
#pragma unroll
    for (int i = 0; i < 2; ++i) { int R, C; stage_rc(tid * 16 + i * 8192, R, C); const int Rb = Epi::PERM ? ((R & ~31) + perm32(R & 31)) : R;
        voffA[i] = (unsigned)(R * K * EB + C * 2); voffB[i] = (unsigned)(Rb * K * EB + C * 2); }
    const size_t kstep = (size_t)(BK * 2);
    const size_t hstep = (size_t)HALF * K * EB;
    const size_t tstep = 2 * hstep;
    const unsigned ldsw = (unsigned)wid * 1024u;
    const int aoff = F8 ? lds_byte(wr * 64 + fr, fq * 16) + (fq & 1) * 16 : lds_byte(wr * 64 + fr, fq * 8), boff = F8 ? lds_byte(wc * 32 + fr, fq * 16) + (fq & 1) * 16 : lds_byte(wc * 32 + fr, fq * 8);
    const int aoff1 = aoff + (F8 ? 16 - 32 * (fq & 1) : 0);
    const int f8o0_unused = 0; (void)f8o0_unused;
#define PG8_SA(b, h) (((b) * 2 + (h)) * HTB)
#define PG8_SB(b, h) ((4 + (b) * 2 + (h)) * HTB)
#define PG8_STAGE_X(bufoff, gbase, voff, rs_, base_) do { const int so_ = (int)((const char*)(gbase) - (const char*)(base_)); _Pragma("unroll") for (int _i = 0; _i < 2; ++_i) \
        __builtin_amdgcn_raw_ptr_buffer_load_lds(rs_, (PG8_LAS void*)(lds + (bufoff) + ldsw + _i * 8192), 16, (int)(voff)[_i], so_, 0, 0); } while (0)
#define PG8_LDA(dst, b, h) do { if constexpr (F8) { _Pragma("unroll") for (int m = 0; m < 4; ++m) { const u32x4 lo_ = *(const PG8_LAS u32x4*)(lds + PG8_SA(b, h) + aoff + m * 2048), hi_ = *(const PG8_LAS u32x4*)(lds + PG8_SA(b, h) + aoff1 + m * 2048); \
            dst[m][0] = (i32x8){(int)lo_[0], (int)lo_[1], (int)lo_[2], (int)lo_[3], (int)hi_[0], (int)hi_[1], (int)hi_[2], (int)hi_[3]}; } } \
        else { _Pragma("unroll") for (int m = 0; m < 4; ++m) _Pragma("unroll") for (int k = 0; k < 2; ++k) dst[m][k] = *(const PG8_LAS frag_t*)(lds + PG8_SA(b, h) + aoff + m * 2048 + k * 1024); } } while (0)
#define PG8_LDB(dst, b, h) do { if constexpr (F8) { _Pragma("unroll") for (int n = 0; n < 2; ++n) { const u32x4 lo_ = *(const PG8_LAS u32x4*)(lds + PG8_SB(b, h) + boff + n * 2048), hi_ = *(const PG8_LAS u32x4*)(lds + PG8_SB(b, h) + boff + (aoff1 - aoff) + n * 2048); \
            dst[n][0] = (i32x8){(int)lo_[0], (int)lo_[1], (int)lo_[2], (int)lo_[3], (int)hi_[0], (int)hi_[1], (int)hi_[2], (int)hi_[3]}; } } \
        else { _Pragma("unroll") for (int n = 0; n < 2; ++n) _Pragma("unroll") for (int k = 0; k < 2; ++k) dst[n][k] = *(const PG8_LAS frag_t*)(lds + PG8_SB(b, h) + boff + n * 2048 + k * 1024); } } while (0)
#define PG8_MMA(ai, bj, At, Bt) do { __builtin_amdgcn_s_setprio(1); _Pragma("unroll") for (int m = 0; m < 4; ++m) _Pragma("unroll") for (int n = 0; n < 2; ++n) { \
        if constexpr (F8) acc[ai][bj][m][n] = __builtin_amdgcn_mfma_scale_f32_16x16x128_f8f6f4(Bt[n][0], At[m][0], acc[ai][bj][m][n], 0, 0, 0, 0x7f7f7f7f, 0, 0x7f7f7f7f); \
        else { _Pragma("unroll") for (int k = 0; k < 2; ++k) acc[ai][bj][m][n] = mma_bf16(Bt[n][k], At[m][k], acc[ai][bj][m][n]); } } __builtin_amdgcn_s_setprio(0); } while (0)
#define PG8_WAIT_V(n) asm volatile("s_waitcnt vmcnt(" #n ")" ::: "memory")
#define PG8_WAIT_L(n) asm volatile("s_waitcnt lgkmcnt(" #n ")" ::: "memory")
#define PG8_BAR __builtin_amdgcn_s_barrier()
#define PG8_SCHED __builtin_amdgcn_sched_barrier(0)
    const __amdgpu_buffer_rsrc_t rsA = __builtin_amdgcn_make_buffer_rsrc((void*)g.A, (short)0, (int)((size_t)g.M * K * EB), 0x00020000), rsB = __builtin_amdgcn_make_buffer_rsrc((void*)g.Bt, (short)0, (int)((size_t)g.N * K * EB), 0x00020000);
    Unit cur, nxt; int ui = 0;
    if (!S.next(0, cur)) return;
    f32x4 acc[2][2][4][2];
#pragma unroll
    for (int a = 0; a < 2; ++a)
#pragma unroll
        for (int b = 0; b < 2; ++b)
#pragma unroll
            for (int m = 0; m < 4; ++m)
#pragma unroll
                for (int n = 0; n < 2; ++n) acc[a][b][m][n] = (f32x4){0.f, 0.f, 0.f, 0.f};
    typedef typename FragT<F8>::type frag_t;
    frag_t At[4][F8 ? 1 : 2], B0[2][F8 ? 1 : 2], B1[2][F8 ? 1 : 2];
    const char* cA = (const char*)g.A + (size_t)cur.pm * tstep; const char* cB = (const char*)g.Bt + (size_t)cur.pn * tstep;
    S.a_ready(cur);
    if constexpr (SP2) {
        PG8_STAGE_X(PG8_SB(0, 0), cB, voffB, rsB, g.Bt); PG8_STAGE_X(PG8_SB(0, 1), cB + hstep, voffB, rsB, g.Bt); PG8_STAGE_X(PG8_SA(0, 0), cA, voffA, rsA, g.A); PG8_STAGE_X(PG8_SA(0, 1), cA + hstep, voffA, rsA, g.A);
        if (wr == 1) PG8_BAR;
        PG8_WAIT_V(2); PG8_BAR;
        PG8_STAGE_X(PG8_SB(1, 0), cB + kstep, voffB, rsB, g.Bt); PG8_STAGE_X(PG8_SA(1, 0), cA + kstep, voffA, rsA, g.A); PG8_STAGE_X(PG8_SB(1, 1), cB + hstep + kstep, voffB, rsB, g.Bt);
        PG8_WAIT_V(6); PG8_BAR;
    } else {
        PG8_STAGE_X(PG8_SB(0, 0), cB, voffB, rsB, g.Bt); PG8_STAGE_X(PG8_SA(0, 0), cA, voffA, rsA, g.A); PG8_STAGE_X(PG8_SB(0, 1), cB + hstep, voffB, rsB, g.Bt); PG8_STAGE_X(PG8_SA(0, 1), cA + hstep, voffA, rsA, g.A);
        if (wr == 1) PG8_BAR;
        PG8_WAIT_V(4); PG8_BAR;
        PG8_STAGE_X(PG8_SB(1, 0), cB + kstep, voffB, rsB, g.Bt); PG8_STAGE_X(PG8_SA(1, 0), cA + kstep, voffA, rsA, g.A); PG8_STAGE_X(PG8_SB(1, 1), cB + hstep + kstep, voffB, rsB, g.Bt);
        PG8_WAIT_V(6); PG8_BAR;
    }
    for (;;) {
        const bool has_next = S.next(ui + 1, nxt);
        const char* nA = has_next ? (const char*)g.A + (size_t)nxt.pm * tstep : cA; const char* nB = has_next ? (const char*)g.Bt + (size_t)nxt.pn * tstep : cB;
        for (int t = 0; t < nt; t += 2) {
            const bool last = (t == nt - 2);
            const char* a1 = cA + (size_t)(t + 1) * kstep;
            const char* a2 = last ? nA : cA + (size_t)(t + 2) * kstep; const char* b2 = last ? nB : cB + (size_t)(t + 2) * kstep;
            const char* a3 = a2 + kstep; const char* b3 = b2 + kstep;
            if (last && has_next) S.a_ready(nxt);
            if constexpr (SP2) {
            PG8_LDB(B0, 0, 0); PG8_LDB(B1, 0, 1); PG8_SCHED; PG8_LDA(At, 0, 0); PG8_STAGE_X(PG8_SA(1, 1), a1 + hstep, voffA, rsA, g.A);
            PG8_WAIT_V(8); PG8_WAIT_L(0); PG8_BAR; PG8_MMA(0, 0, At, B0); PG8_MMA(0, 1, At, B1); PG8_BAR; PG8_SCHED;
            PG8_LDA(At, 0, 1); PG8_STAGE_X(PG8_SB(0, 0), b2, voffB, rsB, g.Bt); PG8_STAGE_X(PG8_SB(0, 1), b2 + hstep, voffB, rsB, g.Bt); PG8_STAGE_X(PG8_SA(0, 0), a2, voffA, rsA, g.A);
            PG8_WAIT_V(8); PG8_WAIT_L(0); PG8_BAR; PG8_MMA(1, 0, At, B0); PG8_MMA(1, 1, At, B1); PG8_BAR; PG8_SCHED;
            PG8_LDB(B0, 1, 0); PG8_LDB(B1, 1, 1); PG8_SCHED; PG8_LDA(At, 1, 0); PG8_STAGE_X(PG8_SA(0, 1), a2 + hstep, voffA, rsA, g.A);
            PG8_WAIT_V(8); PG8_WAIT_L(0); PG8_BAR; PG8_MMA(0, 0, At, B0); PG8_MMA(0, 1, At, B1); PG8_BAR; PG8_SCHED;
            PG8_LDA(At, 1, 1); PG8_STAGE_X(PG8_SB(1, 0), b3, voffB, rsB, g.Bt); PG8_STAGE_X(PG8_SB(1, 1), b3 + hstep, voffB, rsB, g.Bt); PG8_STAGE_X(PG8_SA(1, 0), a3, voffA, rsA, g.A);
            PG8_WAIT_V(8); PG8_WAIT_L(0); PG8_BAR; PG8_MMA(1, 0, At, B0); PG8_MMA(1, 1, At, B1); PG8_BAR; PG8_SCHED;
            } else {
            PG8_LDB(B0, 0, 0); PG8_SCHED; PG8_LDA(At, 0, 0); PG8_STAGE_X(PG8_SA(1, 1), a1 + hstep, voffA, rsA, g.A);
            PG8_WAIT_L(8); PG8_BAR; PG8_WAIT_L(0); PG8_MMA(0, 0, At, B0); PG8_BAR; PG8_SCHED;
            PG8_LDB(B1, 0, 1); PG8_STAGE_X(PG8_SB(0, 0), b2, voffB, rsB, g.Bt);
            PG8_BAR; PG8_WAIT_L(0); PG8_MMA(0, 1, At, B1); PG8_BAR;
            PG8_LDA(At, 0, 1); PG8_STAGE_X(PG8_SA(0, 0), a2, voffA, rsA, g.A);
            PG8_BAR; PG8_WAIT_L(0); PG8_MMA(1, 0, At, B0); PG8_BAR; PG8_SCHED;
            PG8_STAGE_X(PG8_SB(0, 1), b2 + hstep, voffB, rsB, g.Bt);
            PG8_WAIT_V(6); PG8_BAR; PG8_MMA(1, 1, At, B1); PG8_BAR;
            PG8_LDB(B0, 1, 0); PG8_SCHED; PG8_LDA(At, 1, 0); PG8_STAGE_X(PG8_SA(0, 1), a2 + hstep, voffA, rsA, g.A);
            PG8_WAIT_L(8); PG8_BAR; PG8_WAIT_L(0); PG8_MMA(0, 0, At, B0); PG8_BAR; PG8_SCHED;
            PG8_LDB(B1, 1, 1); PG8_STAGE_X(PG8_SB(1, 0), b3, voffB, rsB, g.Bt);
            PG8_BAR; PG8_WAIT_L(0); PG8_MMA(0, 1, At, B1); PG8_BAR;
            PG8_LDA(At, 1, 1); PG8_STAGE_X(PG8_SA(1, 0), a3, voffA, rsA, g.A);
            PG8_BAR; PG8_WAIT_L(0); PG8_MMA(1, 0, At, B0); PG8_BAR; PG8_SCHED;
            PG8_STAGE_X(PG8_SB(1, 1), b3 + hstep, voffB, rsB, g.Bt);
            PG8_WAIT_V(6); PG8_BAR; PG8_MMA(1, 1, At, B1); PG8_BAR;
            }
        }
        if constexpr (ALIGN_EPI) { if (wr == 0) PG8_BAR; }
        if constexpr (!Epi::AFTER_DRAIN) { E(acc, cur, wr, wc, fr, fq); S.done(cur); }
        if (!has_next) break;
#pragma unroll
        for (int a = 0; a < 2; ++a)
#pragma unroll
            for (int b = 0; b < 2; ++b)
#pragma unroll
                for (int m = 0; m < 4; ++m)
#pragma unroll
                    for (int n = 0; n < 2; ++n) acc[a][b][m][n] = (f32x4){0.f, 0.f, 0.f, 0.f};
        cur = nxt; cA = nA; cB = nB; ++ui;
        if constexpr (ALIGN_EPI) { if (wr == 1) PG8_BAR; }
    }
    PG8_WAIT_V(0);
    if constexpr (!ALIGN_EPI) { if (wr == 0) PG8_BAR; }
    PG8_BAR;
    if constexpr (Epi::AFTER_DRAIN) { E.fused(acc, cur, wr, wc, fr, fq, lds, wid, lane); S.done(cur); }
#undef PG8_SA
#undef PG8_SB
#undef PG8_STAGE_X
#undef PG8_LDA
#undef PG8_LDB
#undef PG8_MMA
#undef PG8_WAIT_V
#undef PG8_WAIT_L
#undef PG8_BAR
#undef PG8_SCHED
}
}
#define GAS __attribute__((address_space(1)))
#define LAS __attribute__((address_space(3)))
typedef unsigned short bf16_t;
typedef unsigned u32x4 __attribute__((ext_vector_type(4)));
typedef unsigned u32x2 __attribute__((ext_vector_type(2)));
typedef float f32x4 __attribute__((ext_vector_type(4)));
typedef float f32x2 __attribute__((ext_vector_type(2)));
typedef float f32x16 __attribute__((ext_vector_type(16)));
typedef short bf16x8 __attribute__((ext_vector_type(8)));
typedef short s16x4 __attribute__((ext_vector_type(4)));
typedef __bf16 bf16x2_t __attribute__((ext_vector_type(2)));
typedef unsigned u32x6 __attribute__((ext_vector_type(6)));
typedef int i32x8 __attribute__((ext_vector_type(8)));
typedef unsigned u32x16 __attribute__((ext_vector_type(16)));
typedef float f32x32 __attribute__((ext_vector_type(32)));
typedef _Float16 f16x32 __attribute__((ext_vector_type(32)));
typedef _Float16 f16x2 __attribute__((ext_vector_type(2)));

namespace mk {
constexpr int M = 16384, D = 4096, S = 2048, NB = 8, PW = 12298, NH = 32, NE = 16384;
constexpr int NWAVES = 8;
constexpr size_t MiB = 1u << 20;
constexpr size_t WS_CTL = 0, CTL_ZERO_BYTES = 1 * MiB;
constexpr size_t WS_RSTD = 2 * MiB, WS_LOGF = 3 * MiB, WS_WQK = 4 * MiB, WS_WOUT = 20 * MiB, WS_WIN = 52 * MiB, WS_U16 = 148 * MiB, WS_V16 = 276 * MiB,
                 WS_XB = 404 * MiB, WS_Q = 532 * MiB, WS_K = 660 * MiB, WS_V = 788 * MiB, WS_OB = 916 * MiB, WS_X2 = 1792 * MiB, WS_END = 2048 * MiB;
constexpr size_t WS_L1 = 1920 * MiB;
__host__ __device__ constexpr size_t ws_wqk(int l) { return l ? WS_L1 : WS_WQK; }
__host__ __device__ constexpr size_t ws_wout(int l) { return l ? WS_L1 + 16 * MiB : WS_WOUT; }
__host__ __device__ constexpr size_t ws_win(int l) { return l ? WS_L1 + 32 * MiB : WS_WIN; }
__host__ __device__ constexpr size_t ws_tab(int l) { return l ? WS_V16 : WS_U16; }
constexpr size_t WS_XB8N = WS_OB + 64 * MiB;
constexpr size_t WS_SC = WS_Q;
constexpr int CW_BAR = 4096;
constexpr int CW_QUEUE = 16384;
constexpr int RING_BYTES = 131072, LDSCTL_OFF = RING_BYTES, MISC_OFF = LDSCTL_OFF + 320, LDS_BYTES = 147456;

struct Args { const float* in[13]; float* out; unsigned char* ws; int ph_lo, ph_hi; };

__device__ __forceinline__ unsigned f2bf(float f) { unsigned u = __builtin_bit_cast(unsigned, f); return (u + 0x7fffu + ((u >> 16) & 1u)) >> 16; }
__device__ __forceinline__ unsigned pk2(float lo, float hi) { return f2bf(lo) | (f2bf(hi) << 16); }
__device__ __forceinline__ float bf_lo(unsigned w) { return __builtin_bit_cast(float, w << 16); }
__device__ __forceinline__ float bf_hi(unsigned w) { return __builtin_bit_cast(float, w & 0xffff0000u); }
__device__ __forceinline__ float lane_read(float v, int src_lane) { return __builtin_bit_cast(float, __builtin_amdgcn_ds_bpermute(src_lane << 2, __builtin_bit_cast(int, v))); }
__device__ __forceinline__ int lane_read(int v, int src_lane) { return __builtin_amdgcn_ds_bpermute(src_lane << 2, v); }
constexpr float US = 1024.0f, VS = 32.0f, US_INV = 1.0f / 1024.0f, VS_INV = 1.0f / 32.0f;
constexpr int ROW6 = 3072;
__device__ __forceinline__ unsigned q_e2m3(float x, float inv) {
    const float a = fminf(fabsf(x) * inv, 7.5f);
    const float c = a < 2.0f ? __builtin_rintf(a * 8.0f) : (a < 4.0f ? __builtin_rintf(a * 4.0f) + 8.0f : __builtin_rintf(a * 2.0f) + 16.0f);
    return (unsigned)(int)c | ((__builtin_bit_cast(unsigned, x) >> 26) & 32u);
}
__device__ __forceinline__ u32x6 pack_fp6(const f32x4 (&a0)[4], const f32x4 (&a1)[4], float inv) {
    unsigned o[6];
#pragma unroll
    for (int w = 0; w < 6; ++w) o[w] = 0u;
#pragma unroll
    for (int j = 0; j < 32; ++j) { const float x = (j < 16) ? a0[(j & 15) >> 2][j & 3] : a1[(j & 15) >> 2][j & 3]; const unsigned c = q_e2m3(x, inv);
        const int b = 6 * j, w = b >> 5, sh = b & 31; o[w] |= c << sh; if (sh > 26) o[w + 1] |= c >> (32 - sh); }
    return (u32x6){o[0], o[1], o[2], o[3], o[4], o[5]};
}
constexpr int ROW4 = 2048;
__device__ __forceinline__ unsigned q_e2m1(float x, float inv) {
    const float a = fminf(fabsf(x) * inv, 6.0f);
    const float c = a < 2.0f ? __builtin_rintf(a * 2.0f) : (a < 4.0f ? __builtin_rintf(a) + 2.0f : __builtin_rintf(a * 0.5f) + 4.0f);
    return (unsigned)(int)c | ((__builtin_bit_cast(unsigned, x) >> 28) & 8u);
}
#define FP4X_(j) ((j) < 16 ? a0[((j) & 15) >> 2][(j) & 3] : a1[((j) & 15) >> 2][(j) & 3])
__device__ __forceinline__ u32x4 pack_fp4(const f32x4 (&a0)[4], const f32x4 (&a1)[4], float inv) {
    unsigned o[4];
#pragma unroll
    for (int w = 0; w < 4; ++w) { unsigned v = 0u;
        v = __builtin_amdgcn_cvt_scalef32_pk_fp4_f32(v, FP4X_(8 * w + 0) * inv, FP4X_(8 * w + 1) * inv, 1.0f, 0); v = __builtin_amdgcn_cvt_scalef32_pk_fp4_f32(v, FP4X_(8 * w + 2) * inv, FP4X_(8 * w + 3) * inv, 1.0f, 1);
        v = __builtin_amdgcn_cvt_scalef32_pk_fp4_f32(v, FP4X_(8 * w + 4) * inv, FP4X_(8 * w + 5) * inv, 1.0f, 2); v = __builtin_amdgcn_cvt_scalef32_pk_fp4_f32(v, FP4X_(8 * w + 6) * inv, FP4X_(8 * w + 7) * inv, 1.0f, 3);
        o[w] = v; }
    return (u32x4){o[0], o[1], o[2], o[3]};
}
#undef FP4X_
__device__ __forceinline__ float clamp8(float x) { return fminf(fmaxf(x, -224.0f), 224.0f); }
__device__ __forceinline__ float logsig(float z) { return fminf(z, 0.f) - 0.6931471805599453f * __builtin_amdgcn_logf(1.0f + __builtin_amdgcn_exp2f(-fabsf(z) * 1.4426950408889634f)); }
__device__ __forceinline__ float gelu_erf(float v) {
    const float av = fabsf(v), t = __builtin_amdgcn_rcpf(av * 0.2316418882f + 1.0f);
    float q = t * 0.5307027145f + (-0.7265760135f); q = q * t + 0.7107068705f; q = q * t + (-0.142248368f); q = q * t + 0.127414796f; q = q * t;
    const float e = __builtin_amdgcn_exp2f((v * v) * (-0.72134752044f));
    const float m = v * (q * e);
    return v < 0.f ? m : v - m;
}
#define LDS_WAIT() asm volatile("s_waitcnt lgkmcnt(0)" ::: "memory")
#define FRESH_LDS(l) do { unsigned v_ = (unsigned)(size_t)(l); asm volatile("" : "+s"(v_)); (l) = (LAS unsigned char*)(size_t)v_; } while (0)
#define FRESH_BID() int bid = blockIdx.x, G = gridDim.x; asm volatile("" : "+s"(bid), "+s"(G))
#define FRESH_TID() int tid; { int w_ = wave0, l_; { unsigned z_ = 0u; asm volatile("" : "+v"(z_)); l_ = (int)__builtin_amdgcn_mbcnt_hi(~0u, __builtin_amdgcn_mbcnt_lo(~0u, z_)); } asm volatile("" : "+s"(w_)); tid = w_ * 64 + l_; } const int lane = tid & 63, wave = __builtin_amdgcn_readfirstlane(tid >> 6); (void)lane; (void)wave

__device__ __forceinline__ unsigned wave_max_u32(unsigned v) {
    v = max(v, (unsigned)__builtin_amdgcn_update_dpp(0, (int)v, 0x111, 0xF, 0xF, true));
    v = max(v, (unsigned)__builtin_amdgcn_update_dpp(0, (int)v, 0x112, 0xF, 0xF, true));
    v = max(v, (unsigned)__builtin_amdgcn_update_dpp(0, (int)v, 0x114, 0xF, 0xF, true));
    v = max(v, (unsigned)__builtin_amdgcn_update_dpp(0, (int)v, 0x118, 0xF, 0xF, true));
    v = max(v, (unsigned)__builtin_amdgcn_update_dpp((int)v, (int)v, 0x142, 0xA, 0xF, false));
    v = max(v, (unsigned)__builtin_amdgcn_update_dpp((int)v, (int)v, 0x143, 0xC, 0xF, false));
    return (unsigned)__builtin_amdgcn_readlane((int)v, 63);
}
__device__ __forceinline__ float wave_sum_dpp(float x) {
    int v = __builtin_bit_cast(int, x);
#define DPP_ADD(ctrl, rm, bc, oldv) v = __builtin_bit_cast(int, __builtin_bit_cast(float, v) + __builtin_bit_cast(float, __builtin_amdgcn_update_dpp(oldv, v, ctrl, rm, 0xF, bc)))
    DPP_ADD(0x111, 0xF, true, 0); DPP_ADD(0x112, 0xF, true, 0); DPP_ADD(0x114, 0xF, true, 0); DPP_ADD(0x118, 0xF, true, 0);
#undef DPP_ADD
    const float r0 = __builtin_bit_cast(float, __builtin_amdgcn_readlane(v, 15)), r1 = __builtin_bit_cast(float, __builtin_amdgcn_readlane(v, 31)), r2 = __builtin_bit_cast(float, __builtin_amdgcn_readlane(v, 47)), r3 = __builtin_bit_cast(float, __builtin_amdgcn_readlane(v, 63));
    return (r0 + r1) + (r2 + r3);
}
__device__ __forceinline__ unsigned ordkey(float x) { const unsigned u = __builtin_bit_cast(unsigned, x); return (u & 0x80000000u) ? ~u : (u | 0x80000000u); }
__device__ __forceinline__ void transpose_item(const float* W, int K, int ldw, int ncols, const float* gain, bf16_t* WT, LAS float* scr, int item, int lane) {
    const int nblk = ncols / 32, kb = item / nblk, nb = item % nblk, k0 = 64 * kb, n0 = 32 * nb;
#pragma unroll 8
    for (int i = 0; i < 32; ++i) { const int kk = 2 * i + (lane >> 5); float v = W[(size_t)(k0 + kk) * ldw + n0 + (lane & 31)]; if (gain) v *= gain[k0 + kk]; scr[kk * 33 + (lane & 31)] = v; }
    LDS_WAIT(); asm volatile("" ::: "memory");
    const int c = lane & 7;
#pragma unroll
    for (int j = 0; j < 4; ++j) { const int n = (lane >> 3) + 8 * j; const LAS float* s = scr + (8 * c) * 33 + n;
        u32x4 o; o.x = pk2(s[0 * 33], s[1 * 33]); o.y = pk2(s[2 * 33], s[3 * 33]); o.z = pk2(s[4 * 33], s[5 * 33]); o.w = pk2(s[6 * 33], s[7 * 33]);
        *(u32x4*)(WT + (size_t)(n0 + n) * K + k0 + 8 * c) = o; }
    LDS_WAIT(); asm volatile("" ::: "memory");
}

typedef const __attribute__((address_space(4))) Args* KArgsT;
__device__ __forceinline__ unsigned pk4_fp8(float a, float b, float c, float d) { int p = __builtin_amdgcn_cvt_pk_fp8_f32(clamp8(a), clamp8(b), 0, false); p = __builtin_amdgcn_cvt_pk_fp8_f32(clamp8(c), clamp8(d), p, true); return (unsigned)p; }
__device__ __forceinline__ void transpose_item8(const float* W, int K, int ldw, int ncols, const float* gain, float scale, unsigned char* WT, LAS float* scr, int item, int lane) {
    const int nblk = ncols / 32, kb = item / nblk, nb = item % nblk, k0 = 64 * kb, n0 = 32 * nb;
    const int kr = lane >> 3, nq = (lane & 7) * 4;
    f32x4 v[8];
#pragma unroll
    for (int i = 0; i < 8; ++i) { const float* p = W + (size_t)(k0 + 8 * i + kr) * ldw + n0 + nq; v[i] = (f32x4){p[0], p[1], p[2], p[3]}; }
#pragma unroll
    for (int i = 0; i < 8; ++i) { const int kk = 8 * i + kr; const float g = (gain ? gain[k0 + kk] : 1.0f) * scale; LAS float* d = scr + kk * 33 + nq; d[0] = v[i][0] * g; d[1] = v[i][1] * g; d[2] = v[i][2] * g; d[3] = v[i][3] * g; }
    LDS_WAIT(); asm volatile("" ::: "memory");
    const int c = lane & 7;
#pragma unroll
    for (int j = 0; j < 4; ++j) { const int n = (lane >> 3) + 8 * j; const LAS float* s = scr + (8 * c) * 33 + n;
        u32x2 o; o.x = pk4_fp8(s[0 * 33], s[1 * 33], s[2 * 33], s[3 * 33]); o.y = pk4_fp8(s[4 * 33], s[5 * 33], s[6 * 33], s[7 * 33]);
        *(u32x2*)(WT + (size_t)(n0 + n) * K + k0 + 8 * c) = o; }
    LDS_WAIT(); asm volatile("" ::: "memory");
}
__device__ __forceinline__ void conv_phase(KArgsT ka, int l, LAS unsigned char* lds, int wave0) {
    FRESH_TID(); FRESH_LDS(lds); FRESH_BID();
    unsigned char* ws = ka->ws;
    const float* ln1 = ka->in[1] + (size_t)l * D; const float* w_in = ka->in[2] + (size_t)l * D * PW; const float* w_out = ka->in[5] + (size_t)l * D * D;
    const float* ln2 = ka->in[6] + (size_t)l * D; const float* wq = ka->in[7] + (size_t)l * D * 2048;
    const float* k1 = ka->in[8] + (size_t)l * 8 * 128 * 128; const float* k2 = ka->in[9] + (size_t)l * 8 * 128 * 128;
    const float* pu = ka->in[10] + (size_t)l * NE * D; const float* pv = ka->in[11] + (size_t)l * NE * D;
    bf16_t* WQK = (bf16_t*)(ws + ws_wqk(l)); bf16_t* WOUT = (bf16_t*)(ws + ws_wout(l)); bf16_t* WIN = (bf16_t*)(ws + ws_win(l)); bf16_t* U16 = (bf16_t*)(ws + ws_tab(l));
    {
        LAS float* Ks = (LAS float*)lds;
        LAS float* Ws = (LAS float*)(lds + 128 * 132 * 4);
        const int IPB = (1024 + G - 1) / G, it0 = bid * IPB, it1 = min(1024, it0 + IPB);
        int gi_cur = -1; f32x4 pre[4];
        if (it0 < it1) {
#pragma unroll
            for (int m = 0; m < 4; ++m) { const int i = tid + 512 * m, r = i >> 5, c4 = (i & 31) * 4; pre[m] = *(const f32x4*)(wq + (size_t)((it0 & 63) * 64 + r) * 2048 + (it0 >> 6) * 128 + c4); } }
        for (int it = it0; it < it1; ++it) {
            const int gi = it >> 6, c0 = (it & 63) * 64;
            __syncthreads();
            if (gi != gi_cur) { gi_cur = gi;
                const float* key = ((gi & 1) ? k2 : k1) + (size_t)(gi >> 1) * 128 * 128;
                for (int i = tid; i < 4096; i += 512) { const int r = i >> 5, c4 = (i & 31) * 4; *(LAS f32x4*)(Ks + r * 132 + c4) = *(const f32x4*)(key + r * 128 + c4); } }
#pragma unroll
            for (int m = 0; m < 4; ++m) { const int i = tid + 512 * m, r = i >> 5, c4 = (i & 31) * 4; *(LAS f32x4*)(Ws + r * 132 + c4) = pre[m]; }
            __syncthreads();
            if (it + 1 < it1) {
#pragma unroll
                for (int m = 0; m < 4; ++m) { const int i = tid + 512 * m, r = i >> 5, c4 = (i & 31) * 4; pre[m] = *(const f32x4*)(wq + (size_t)(((it + 1) & 63) * 64 + r) * 2048 + ((it + 1) >> 6) * 128 + c4); } }
            const int ti = wave & 3, tj = wave >> 2, li = lane & 31, kh = lane >> 5;
            const LAS float* ap = Ks + (32 * ti + li) * 132 + 64 * kh; const LAS float* bp = Ws + (32 * tj + li) * 132 + 64 * kh;
            f32x16 acc;
#pragma unroll
            for (int r = 0; r < 16; ++r) acc[r] = 0.f;
#pragma unroll 4
            for (int s4 = 0; s4 < 16; ++s4) { const f32x4 a4 = *(const LAS f32x4*)(ap + 4 * s4), b4 = *(const LAS f32x4*)(bp + 4 * s4);
                acc = __builtin_amdgcn_mfma_f32_32x32x2f32(a4[0], b4[0], acc, 0, 0, 0); acc = __builtin_amdgcn_mfma_f32_32x32x2f32(a4[1], b4[1], acc, 0, 0, 0);
                acc = __builtin_amdgcn_mfma_f32_32x32x2f32(a4[2], b4[2], acc, 0, 0, 0); acc = __builtin_amdgcn_mfma_f32_32x32x2f32(a4[3], b4[3], acc, 0, 0, 0); }
            { const int c = c0 + 32 * tj + li; const float gg = ln2[c];
#pragma unroll
              for (int r = 0; r < 16; ++r) { const int n = 32 * ti + (r & 3) + 8 * (r >> 2) + 4 * kh; WQK[(size_t)(gi * 128 + n) * D + c] = (bf16_t)f2bf(acc[r] * gg); } }
        }
        __syncthreads();
    }
    const int gw = bid * NWAVES + wave, NGW = G * NWAVES;
    {
        unsigned char* U6 = (unsigned char*)U16; unsigned char* V4 = U6 + (size_t)NE * ROW6; float* SCU = (float*)(U6 + 2 * (size_t)NE * ROW6); float* SCV = SCU + NE;
        f32x4 gq[4][4];
#pragma unroll
        for (int i = 0; i < 4; ++i)
#pragma unroll
            for (int m = 0; m < 4; ++m) gq[i][m] = *(const f32x4*)(ln2 + 1024 * i + 256 * m + 4 * lane);
        f32x4 uu[4][4], vv[4][4];
        const unsigned hm_ = (lane & 1) ? 65536u : 1u;
#define LDROW_(dst, src, rr) do { const float* p_ = (src) + (size_t)(rr) * D + 4 * lane; _Pragma("unroll") for (int i = 0; i < 4; ++i) _Pragma("unroll") for (int m = 0; m < 4; ++m) dst[i][m] = *(const f32x4*)(p_ + 1024 * i + 256 * m); } while (0)
#define H16_(v, inv) ((__builtin_amdgcn_cvt_scalef32_pk_fp4_f32(__builtin_amdgcn_cvt_scalef32_pk_fp4_f32(0u, (v)[0] * (inv), (v)[1] * (inv), 1.0f, 0), (v)[2] * (inv), (v)[3] * (inv), 1.0f, 1) & 0xffffu) * hm_)
#define QSWAP1_(x) ((unsigned)__builtin_amdgcn_update_dpp(0, (int)(x), 0xB1, 0xF, 0xF, false))
#define QSWAP2_(x) ((unsigned)__builtin_amdgcn_update_dpp(0, (int)(x), 0x4E, 0xF, 0xF, false))
#define PUTROW_(src, tab, rr, inv) do { _Pragma("unroll") for (int j = 0; j < 2; ++j) _Pragma("unroll") for (int m = 0; m < 4; ++m) { \
            unsigned da_ = H16_(src[2 * j][m], inv), db_ = H16_(src[2 * j + 1][m], inv); da_ |= QSWAP1_(da_); db_ |= QSWAP1_(db_); \
            const unsigned oa_ = QSWAP2_(da_), ob_ = QSWAP2_(db_); \
            if ((lane & 3) == 0) *(u32x4*)((tab) + (size_t)(rr) * ROW4 + j * 1024 + 16 * (16 * m + (lane >> 2))) = (u32x4){da_, oa_, db_, ob_}; } } while (0)
        if (gw < NE) { LDROW_(uu, pu, gw); LDROW_(vv, pv, gw); }
        for (int r = gw; r < NE; r += NGW) {
            const int rn = r + NGW;
            { float au = 0.f;
#pragma unroll
              for (int i = 0; i < 4; ++i)
#pragma unroll
                  for (int m = 0; m < 4; ++m) { uu[i][m] *= gq[i][m]; au += (uu[i][m][0] * uu[i][m][0] + uu[i][m][1] * uu[i][m][1]) + (uu[i][m][2] * uu[i][m][2] + uu[i][m][3] * uu[i][m][3]); }
              au = sqrtf(wave_sum_dpp(au) * (1.0f / D)); const float iu = au > 0.f ? 2.0f / au : 0.f;
              if (lane == 0) SCU[r] = au * 0.5f;
              PUTROW_(uu, U6, r, iu); }
            if (rn < NE) LDROW_(uu, pu, rn);
            { float av = 0.f;
#pragma unroll
              for (int i = 0; i < 4; ++i)
#pragma unroll
                  for (int m = 0; m < 4; ++m) av += (vv[i][m][0] * vv[i][m][0] + vv[i][m][1] * vv[i][m][1]) + (vv[i][m][2] * vv[i][m][2] + vv[i][m][3] * vv[i][m][3]);
              av = sqrtf(wave_sum_dpp(av) * (1.0f / D)); const float iv = av > 0.f ? 2.0f / av : 0.f;
              if (lane == 0) SCV[r] = av * 0.5f;
              PUTROW_(vv, V4, r, iv); }
            if (rn < NE) LDROW_(vv, pv, rn);
        }
#undef LDROW_
#undef H16_
#undef QSWAP1_
#undef QSWAP2_
#undef PUTROW_
    }
    {
        LAS float* scr = (LAS float*)(lds + wave * 16384);
        constexpr int I_O = (D / 64) * (D / 32), I_IN = (D / 64) * (12288 / 32);
        for (int it = gw; it < I_O + I_IN; it += NGW) {
            if (it < I_O) transpose_item8(w_out, D, D, D, nullptr, US, (unsigned char*)WOUT, scr, it, lane);
            else transpose_item8(w_in, D, PW, 12288, ln1, US, (unsigned char*)WIN, scr, it - I_O, lane);
        }
    }
}

template <bool WITH_F>
__device__ __forceinline__ void prep_phase(const float* X, bf16_t* XB, float* RSTD, const float* w_in, const float* ln1, const float* bf, float* LOGF, LAS unsigned char* lds, int wave0) {
    FRESH_TID(); FRESH_LDS(lds); FRESH_BID();
    LAS unsigned short* gfs = (LAS unsigned short*)lds;
    if (WITH_F) {
        __syncthreads();
        for (int c = tid; c < D; c += 512) { const float g = ln1[c]; const float* wr = w_in + (size_t)c * PW + 12288;
#pragma unroll
            for (int j = 0; j < 10; ++j) gfs[j * D + c] = (unsigned short)f2bf(wr[j] * g); }
        __syncthreads();
    }
    const int gw = bid * NWAVES + wave, NGW = G * NWAVES;
    for (int m = gw; m < M; m += NGW) {
        const f32x4* xr = (const f32x4*)(X + (size_t)m * D) + lane;
        f32x4 v[16]; float ss = 0.f;
#pragma unroll
        for (int i = 0; i < 16; ++i) { v[i] = xr[64 * i]; ss += (v[i][0] * v[i][0] + v[i][1] * v[i][1]) + (v[i][2] * v[i][2] + v[i][3] * v[i][3]); }
        ss = wave_sum_dpp(ss);
        const float rstd = rsqrtf(ss * (1.0f / D) + 1e-6f);
        if (WITH_F) {
            unsigned* o8 = (unsigned*)((unsigned char*)XB + (size_t)m * D) + lane;
#pragma unroll
            for (int i = 0; i < 16; ++i) o8[64 * i] = pk4_fp8(v[i][0], v[i][1], v[i][2], v[i][3]);
        } else {
        u32x2* o = (u32x2*)(XB + (size_t)m * D) + lane;
#pragma unroll
        for (int i = 0; i < 16; ++i) { u32x2 w; w.x = pk2(v[i][0], v[i][1]); w.y = pk2(v[i][2], v[i][3]); o[64 * i] = w; }
        }
        if (lane == 0) RSTD[m] = rstd;
        if (WITH_F) {
            float mine = 0.f;
#pragma unroll 1
            for (int j = 0; j < 10; ++j) { float s = 0.f;
#pragma unroll
                for (int i = 0; i < 16; ++i) { const u32x2 gp = *(const LAS u32x2*)(gfs + j * D + 256 * i + 4 * lane);
                    s += (v[i][0] * bf_lo(gp.x) + v[i][1] * bf_hi(gp.x)) + (v[i][2] * bf_lo(gp.y) + v[i][3] * bf_hi(gp.y)); }
                s = wave_sum_dpp(s); if (lane == j) mine = s; }
            if (lane < 10) { const int b = m >> 11, s = m & 2047; LOGF[(size_t)(b * 10 + lane) * S + s] = logsig(mine * rstd + bf[lane]); }
        }
    }
}


__device__ __forceinline__ void load16_bf16(const bf16_t* p, float (&d)[16]) {
    const u32x4 a = *(const u32x4*)p, b = *(const u32x4*)(p + 8);
#pragma unroll
    for (int q = 0; q < 4; ++q) { d[2 * q] = bf_lo(a[q]); d[2 * q + 1] = bf_hi(a[q]); d[8 + 2 * q] = bf_lo(b[q]); d[8 + 2 * q + 1] = bf_hi(b[q]); }
}
#define RFL(x) __builtin_amdgcn_readfirstlane(x)
template <bool FINAL>
__device__ __forceinline__ void peer_uv_phase(const float* SC, const unsigned char* U6, const unsigned char* V4, const bf16_t* X1, void* XOv, const float* fg,
                                              unsigned char* XB8n, float* RSTDn, float* LOGFn, const float* w_in_n, const float* ln1_n, const float* bf_n, LAS unsigned char* lds, int wave0) {
    FRESH_TID(); FRESH_LDS(lds); FRESH_BID();
    LAS int* s_eid = (LAS int*)(lds + 81920 + wave * 1024); LAS float* s_w = (LAS float*)(lds + 81920 + wave * 1024 + 512); LAS float* s_su = (LAS float*)(lds + 90112 + wave * 512);
    const float* SCU = (const float*)(U6 + 2 * (size_t)NE * ROW6); const float* SCV = SCU + NE;
    LAS unsigned short* gfs = (LAS unsigned short*)lds;
    if (!FINAL) {
        __syncthreads();
        for (int c = tid; c < D; c += 512) { const float g = ln1_n[c]; const float* wr = w_in_n + (size_t)c * PW + 12288;
#pragma unroll
            for (int j = 0; j < 10; ++j) gfs[j * D + c] = (unsigned short)f2bf(wr[j] * g); }
        __syncthreads();
    }
    const int gw = bid * NWAVES + wave, NGW = G * NWAVES;
    for (int tok = gw; tok < M; tok += NGW) {
        const bf16_t* x1 = X1 + (size_t)tok * D;
        i32x8 xq[2]; float rstd_tok;
        { const int sg_ = lane & 15, gp_ = lane >> 4; float t[2][2][16]; float ss_ = 0.f;
#pragma unroll
          for (int s2 = 0; s2 < 2; ++s2)
#pragma unroll
              for (int hf = 0; hf < 2; ++hf) { load16_bf16(x1 + 1024 * (2 * s2 + (gp_ & 1)) + 16 * (sg_ + 32 * hf + 16 * (gp_ >> 1)), t[s2][hf]);
#pragma unroll
                  for (int k = 0; k < 16; ++k) ss_ += t[s2][hf][k] * t[s2][hf][k]; }
          rstd_tok = rsqrtf(wave_sum_dpp(ss_) * (1.0f / D) + 1e-6f);
#pragma unroll
          for (int s2 = 0; s2 < 2; ++s2)
#pragma unroll
              for (int hf = 0; hf < 2; ++hf)
#pragma unroll
                  for (int q = 0; q < 4; ++q) xq[s2][4 * hf + q] = (int)pk4_fp8(t[s2][hf][4 * q] * rstd_tok, t[s2][hf][4 * q + 1] * rstd_tok, t[s2][hf][4 * q + 2] * rstd_tok, t[s2][hf][4 * q + 3] * rstd_tok); }
        const float* sc = SC + (size_t)tok * 2048;
        LAS float* selv = (LAS float*)(lds + 94208 + wave * 512); LAS int* seli = (LAS int*)(lds + 94208 + wave * 512 + 256);
#define BALLOT(c) __builtin_amdgcn_ballot_w64(c)
#define MBCNT(m) ((int)__builtin_amdgcn_mbcnt_hi((unsigned)((m) >> 32), __builtin_amdgcn_mbcnt_lo((unsigned)(m), 0u)))
        for (int h = 0; h < 4; ++h) {
            float x[2][2][2]; unsigned kk[2][2][2];
#pragma unroll
            for (int u = 0; u < 2; ++u)
#pragma unroll
                for (int f = 0; f < 2; ++f)
#pragma unroll
                    for (int r = 0; r < 2; ++r) { const float v = sc[(h + 4 * u) * 256 + f * 128 + r * 64 + lane]; x[u][f][r] = v; kk[u][f][r] = (ordkey(v) & ~127u) | (unsigned)(127 - 64 * r - lane); }
            unsigned T[2][2] = {{0u, 0u}, {0u, 0u}}; int dn = 0;
            for (unsigned bm = 0x80000000u; bm != 0u && dn != 15; bm >>= 1) {
#pragma unroll
                for (int u = 0; u < 2; ++u)
#pragma unroll
                    for (int f = 0; f < 2; ++f) { const unsigned cand = T[u][f] | bm;
                        const int c = __builtin_popcountll(BALLOT(kk[u][f][0] >= cand)) + __builtin_popcountll(BALLOT(kk[u][f][1] >= cand));
                        T[u][f] = c >= 16 ? cand : T[u][f]; dn |= (c == 16) ? (1 << (2 * u + f)) : 0; }
            }
#pragma unroll
            for (int u = 0; u < 2; ++u)
#pragma unroll
                for (int f = 0; f < 2; ++f) { const bool s0 = kk[u][f][0] >= T[u][f], s1 = kk[u][f][1] >= T[u][f]; const unsigned long long m0 = BALLOT(s0), m1 = BALLOT(s1);
                    const int p0 = MBCNT(m0), p1 = __builtin_popcountll(m0) + MBCNT(m1);
                    if (s0) { selv[(2 * u + f) * 16 + (p0 & 15)] = x[u][f][0]; seli[(2 * u + f) * 16 + (p0 & 15)] = lane; }
                    if (s1) { selv[(2 * u + f) * 16 + (p1 & 15)] = x[u][f][1]; seli[(2 * u + f) * 16 + (p1 & 15)] = 64 + lane; } }
            asm volatile("" ::: "memory");
            float s4[2][4]; unsigned k4[2][4];
#pragma unroll
            for (int u = 0; u < 2; ++u) { const float va = selv[(2 * u) * 16 + (lane >> 2)]; const f32x4 vb = *(const LAS f32x4*)(selv + (2 * u + 1) * 16 + (lane & 3) * 4);
#pragma unroll
                for (int q = 0; q < 4; ++q) { s4[u][q] = va + vb[q]; k4[u][q] = (ordkey(s4[u][q]) & ~255u) | (unsigned)(255 - 4 * lane - q); } }
            unsigned T2[2] = {0u, 0u}; int d2 = 0;
            for (unsigned bm = 0x80000000u; bm != 0u && d2 != 3; bm >>= 1) {
#pragma unroll
                for (int u = 0; u < 2; ++u) { const unsigned cand = T2[u] | bm;
                    const int c = (__builtin_popcountll(BALLOT(k4[u][0] >= cand)) + __builtin_popcountll(BALLOT(k4[u][1] >= cand))) + (__builtin_popcountll(BALLOT(k4[u][2] >= cand)) + __builtin_popcountll(BALLOT(k4[u][3] >= cand)));
                    T2[u] = c >= 16 ? cand : T2[u]; d2 |= (c == 16) ? (1 << u) : 0; }
            }
#pragma unroll
            for (int u = 0; u < 2; ++u) {
                const unsigned mk = wave_max_u32(max(max(k4[u][0], k4[u][1]), max(k4[u][2], k4[u][3]))) & ~255u;
                const float mx = __builtin_bit_cast(float, (mk & 0x80000000u) ? (mk & 0x7fffffffu) : ~mk);
                const float cs = 1.4426950408889634f * rstd_tok;
                float p[4], ps = 0.f;
#pragma unroll
                for (int q = 0; q < 4; ++q) { p[q] = (k4[u][q] >= T2[u]) ? __builtin_amdgcn_exp2f((s4[u][q] - mx) * cs) : 0.f; ps += p[q]; }
                const float tot = wave_sum_dpp(ps);
                const int i1 = seli[(2 * u) * 16 + (lane >> 2)]; const u32x4 i2 = *(const LAS u32x4*)(seli + (2 * u + 1) * 16 + (lane & 3) * 4);
                int base = (h + 4 * u) * 16;
#pragma unroll
                for (int q = 0; q < 4; ++q) { const bool sl = k4[u][q] >= T2[u]; const unsigned long long m = BALLOT(sl); const int slot = base + (MBCNT(m) & 15); base += __builtin_popcountll(m);
                    if (sl) { const int e = ((i1 & 127) << 7) | (int)(i2[q] & 127u); s_eid[slot] = e; s_w[slot] = p[q] / tot * SCV[e]; s_su[slot] = SCU[e]; } }
            }
            asm volatile("" ::: "memory");
        }
#undef BALLOT
#undef MBCNT
        LDS_WAIT(); asm volatile("" ::: "memory");
#define LOADROW6(dst, base, e) do { const u32x4* p_ = (const u32x4*)((base) + (size_t)(e) * ROW6) + lane; dst[0] = p_[0]; dst[1] = p_[64]; dst[2] = p_[128]; } while (0)
#define GRP6(row, g) ((g) == 0 ? (u32x6){row[0][0], row[0][1], row[0][2], row[0][3], row[1][0], row[1][1]} : (u32x6){row[1][2], row[1][3], row[2][0], row[2][1], row[2][2], row[2][3]})
        {
#define LOADROW4(dst, base, e) do { const u32x4* p_ = (const u32x4*)((base) + (size_t)(e) * ROW4) + lane; dst[0] = p_[0]; dst[1] = p_[64]; } while (0)
            const bool dg_ = ((lane & 15) >> 2) == (lane >> 4);
#define UDOT4(row, j) do { f32x4 ac_ = {0.f, 0.f, 0.f, 0.f}; \
            ac_ = __builtin_amdgcn_mfma_scale_f32_16x16x128_f8f6f4((i32x8){(int)row[0][0], (int)row[0][1], (int)row[0][2], (int)row[0][3], 0, 0, 0, 0}, xq[0], ac_, 4, 0, 0, 0x7f7f7f7f, 0, 0x7f7f7f7f); \
            ac_ = __builtin_amdgcn_mfma_scale_f32_16x16x128_f8f6f4((i32x8){(int)row[1][0], (int)row[1][1], (int)row[1][2], (int)row[1][3], 0, 0, 0, 0}, xq[1], ac_, 4, 0, 0, 0x7f7f7f7f, 0, 0x7f7f7f7f); \
            asm volatile("" : "+v"(ac_));     \
            const float pv_ = dg_ ? ((lane & 2) ? ((lane & 1) ? ac_[3] : ac_[2]) : ((lane & 1) ? ac_[1] : ac_[0])) : 0.f; \
            const float d_ = wave_sum_dpp(pv_) * s_su[j]; const float ge_ = gelu_erf(d_); if (lane == 0) s_w[j] *= ge_; } while (0)
            u32x4 r0[2], r1[2], r2[2], r3[2], r4[2], r5[2], r6[2], r7[2];
            { const int e_ = RFL(s_eid[0]); LOADROW4(r0, U6, e_); } { const int e_ = RFL(s_eid[1]); LOADROW4(r1, U6, e_); } { const int e_ = RFL(s_eid[2]); LOADROW4(r2, U6, e_); } { const int e_ = RFL(s_eid[3]); LOADROW4(r3, U6, e_); } { const int e_ = RFL(s_eid[4]); LOADROW4(r4, U6, e_); } { const int e_ = RFL(s_eid[5]); LOADROW4(r5, U6, e_); } { const int e_ = RFL(s_eid[6]); LOADROW4(r6, U6, e_); } { const int e_ = RFL(s_eid[7]); LOADROW4(r7, U6, e_); }
            for (int j = 0; j < 120; j += 8) {
                UDOT4(r0, j + 0); { const int e_ = RFL(s_eid[j + 8]); LOADROW4(r0, U6, e_); }
                UDOT4(r1, j + 1); { const int e_ = RFL(s_eid[j + 9]); LOADROW4(r1, U6, e_); }
                UDOT4(r2, j + 2); { const int e_ = RFL(s_eid[j + 10]); LOADROW4(r2, U6, e_); }
                UDOT4(r3, j + 3); { const int e_ = RFL(s_eid[j + 11]); LOADROW4(r3, U6, e_); }
                UDOT4(r4, j + 4); { const int e_ = RFL(s_eid[j + 12]); LOADROW4(r4, U6, e_); }
                UDOT4(r5, j + 5); { const int e_ = RFL(s_eid[j + 13]); LOADROW4(r5, U6, e_); }
                UDOT4(r6, j + 6); { const int e_ = RFL(s_eid[j + 14]); LOADROW4(r6, U6, e_); }
                UDOT4(r7, j + 7); { const int e_ = RFL(s_eid[j + 15]); LOADROW4(r7, U6, e_); }
            }
            UDOT4(r0, 120); UDOT4(r1, 121); UDOT4(r2, 122); UDOT4(r3, 123); UDOT4(r4, 124); UDOT4(r5, 125); UDOT4(r6, 126); UDOT4(r7, 127);
#undef UDOT4
#undef LOADROW4
        }
        LDS_WAIT(); asm volatile("" ::: "memory");
        {
            f32x2 acc2[2][16];
#define ACC(i, k) acc2[(i) >> 1][((i) & 1) * 8 + ((k) >> 1)][(k) & 1]
#pragma unroll
            for (int g = 0; g < 2; ++g)
#pragma unroll
                for (int k = 0; k < 16; ++k) acc2[g][k] = (f32x2){0.f, 0.f};
#define LOADROW4(dst, base, e) do { const u32x4* p_ = (const u32x4*)((base) + (size_t)(e) * ROW4) + lane; dst[0] = p_[0]; dst[1] = p_[64]; } while (0)
#define VACC4(row, j) do { const float w_ = s_w[j]; const f32x2 w2_ = {w_, w_}; _Pragma("unroll") for (int g_ = 0; g_ < 2; ++g_) { \
                u32x4 G_ = row[g_]; asm volatile("" : "+v"(G_)); \
                _Pragma("unroll") for (int k_ = 0; k_ < 4; ++k_) { const unsigned d_ = G_[k_]; \
                    acc2[g_][4 * k_] = __builtin_elementwise_fma(w2_, __builtin_amdgcn_cvt_scalef32_pk_f32_fp4(d_, 1.0f, 0), acc2[g_][4 * k_]); acc2[g_][4 * k_ + 1] = __builtin_elementwise_fma(w2_, __builtin_amdgcn_cvt_scalef32_pk_f32_fp4(d_, 1.0f, 1), acc2[g_][4 * k_ + 1]); \
                    acc2[g_][4 * k_ + 2] = __builtin_elementwise_fma(w2_, __builtin_amdgcn_cvt_scalef32_pk_f32_fp4(d_, 1.0f, 2), acc2[g_][4 * k_ + 2]); acc2[g_][4 * k_ + 3] = __builtin_elementwise_fma(w2_, __builtin_amdgcn_cvt_scalef32_pk_f32_fp4(d_, 1.0f, 3), acc2[g_][4 * k_ + 3]); } \
                asm volatile("" : "+v"(acc2[g_][0]), "+v"(acc2[g_][1]), "+v"(acc2[g_][2]), "+v"(acc2[g_][3]), "+v"(acc2[g_][4]), "+v"(acc2[g_][5]), "+v"(acc2[g_][6]), "+v"(acc2[g_][7]), \
                                  "+v"(acc2[g_][8]), "+v"(acc2[g_][9]), "+v"(acc2[g_][10]), "+v"(acc2[g_][11]), "+v"(acc2[g_][12]), "+v"(acc2[g_][13]), "+v"(acc2[g_][14]), "+v"(acc2[g_][15])); } } while (0)
            u32x4 r0[2], r1[2], r2[2], r3[2], r4[2], r5[2], r6[2], r7[2];
            { const int e_ = RFL(s_eid[0]); LOADROW4(r0, V4, e_); } { const int e_ = RFL(s_eid[1]); LOADROW4(r1, V4, e_); } { const int e_ = RFL(s_eid[2]); LOADROW4(r2, V4, e_); } { const int e_ = RFL(s_eid[3]); LOADROW4(r3, V4, e_); } { const int e_ = RFL(s_eid[4]); LOADROW4(r4, V4, e_); } { const int e_ = RFL(s_eid[5]); LOADROW4(r5, V4, e_); } { const int e_ = RFL(s_eid[6]); LOADROW4(r6, V4, e_); } { const int e_ = RFL(s_eid[7]); LOADROW4(r7, V4, e_); }
            for (int j = 0; j < 120; j += 8) {
                VACC4(r0, j + 0); { const int e_ = RFL(s_eid[j + 8]); LOADROW4(r0, V4, e_); }
                VACC4(r1, j + 1); { const int e_ = RFL(s_eid[j + 9]); LOADROW4(r1, V4, e_); }
                VACC4(r2, j + 2); { const int e_ = RFL(s_eid[j + 10]); LOADROW4(r2, V4, e_); }
                VACC4(r3, j + 3); { const int e_ = RFL(s_eid[j + 11]); LOADROW4(r3, V4, e_); }
                VACC4(r4, j + 4); { const int e_ = RFL(s_eid[j + 12]); LOADROW4(r4, V4, e_); }
                VACC4(r5, j + 5); { const int e_ = RFL(s_eid[j + 13]); LOADROW4(r5, V4, e_); }
                VACC4(r6, j + 6); { const int e_ = RFL(s_eid[j + 14]); LOADROW4(r6, V4, e_); }
                VACC4(r7, j + 7); { const int e_ = RFL(s_eid[j + 15]); LOADROW4(r7, V4, e_); }
            }
            VACC4(r0, 120); VACC4(r1, 121); VACC4(r2, 122); VACC4(r3, 123); VACC4(r4, 124); VACC4(r5, 125); VACC4(r6, 126); VACC4(r7, 127);
#undef VACC4
#undef LOADROW4
            float ss = 0.f;
#pragma unroll
            for (int i = 0; i < 4; ++i) { float t[16]; load16_bf16(x1 + 1024 * i + 16 * lane, t);
#pragma unroll
                for (int k = 0; k < 16; ++k) { ACC(i, k) += t[k]; ss += ACC(i, k) * ACC(i, k); } }
            ss = wave_sum_dpp(ss);
            const float rs = rsqrtf(ss * (1.0f / D) + 1e-6f);
            if (!FINAL) {
#pragma unroll
                for (int i = 0; i < 4; ++i) { u32x4 w8;
#pragma unroll
                    for (int q = 0; q < 4; ++q) w8[q] = pk4_fp8(ACC(i, 4 * q), ACC(i, 4 * q + 1), ACC(i, 4 * q + 2), ACC(i, 4 * q + 3));
                    *(u32x4*)(XB8n + (size_t)tok * D + 1024 * i + 16 * lane) = w8; }
                if (lane == 0) RSTDn[tok] = rs;
                float mine = 0.f;
#pragma unroll 1
                for (int j = 0; j < 10; ++j) { float s = 0.f;
#pragma unroll
                    for (int i = 0; i < 4; ++i) { const u32x4 g0 = *(const LAS u32x4*)(gfs + j * D + 1024 * i + 16 * lane), g1 = *(const LAS u32x4*)(gfs + j * D + 1024 * i + 16 * lane + 8);
#pragma unroll
                        for (int q = 0; q < 4; ++q) { s += ACC(i, 2 * q) * bf_lo(g0[q]) + ACC(i, 2 * q + 1) * bf_hi(g0[q]); s += ACC(i, 8 + 2 * q) * bf_lo(g1[q]) + ACC(i, 8 + 2 * q + 1) * bf_hi(g1[q]); } }
                    s = wave_sum_dpp(s); if (lane == j) mine = s; }
                if (lane < 10) { const int b_ = tok >> 11, s_ = tok & 2047; LOGFn[(size_t)(b_ * 10 + lane) * S + s_] = logsig(mine * rs + bf_n[lane]); }
            }
            if (FINAL) { float* xo = (float*)XOv + (size_t)tok * D;
#pragma unroll
                for (int i = 0; i < 4; ++i)
#pragma unroll
                    for (int q = 0; q < 4; ++q) { const int c = 1024 * i + 16 * lane + 4 * q; const f32x4 g_ = *(const f32x4*)(fg + c);
                        *(f32x4*)(xo + c) = (f32x4){ACC(i, 4 * q) * rs * g_[0], ACC(i, 4 * q + 1) * rs * g_[1], ACC(i, 4 * q + 2) * rs * g_[2], ACC(i, 4 * q + 3) * rs * g_[3]}; }
            } else { bf16_t* xo = (bf16_t*)XOv + (size_t)tok * D;
#pragma unroll
                for (int i = 0; i < 4; ++i) { u32x4 w0, w1;
#pragma unroll
                    for (int q = 0; q < 4; ++q) { w0[q] = pk2(ACC(i, 2 * q), ACC(i, 2 * q + 1)); w1[q] = pk2(ACC(i, 8 + 2 * q), ACC(i, 8 + 2 * q + 1)); }
                    *(u32x4*)(xo + 1024 * i + 16 * lane) = w0; *(u32x4*)(xo + 1024 * i + 16 * lane + 8) = w1; }
            }
        }
        LDS_WAIT(); asm volatile("" ::: "memory");
    }
#undef ACC
#undef LOADROW6
#undef GRP6
}
}
namespace at {
using namespace mk;
constexpr int QB = 256, KVB = 64, HD = 128;
constexpr int SHM_V = KVB * HD * 2, SHM_K = KVB * HD * 2;
constexpr int OFF_V = 0, OFF_K = 2 * SHM_V, OFF_WS = OFF_K + 2 * SHM_K, OFF_CUM = OFF_WS + 8 * 256, OFF_RT = OFF_CUM + 2048 * 4, OFF_MISC = OFF_RT + 640 * 4;
constexpr float LOG2E = 1.4426950408889634f;
constexpr float THR2 = 10.0f;
constexpr float SB_DONE = -100.0f;

#define AT_KSWZ(row, colB) ((row) * 256 + ((colB) ^ (((row) & 7) << 4)))
__device__ __forceinline__ int v_st(int k, int c) { const int kk = (k & ~0xC) | ((k & 4) << 1) | ((k & 8) >> 1); return ((kk >> 3) * 4 + (c >> 5)) * 512 + ((kk & 7) * 32 + (c & 31)) * 2; }
__device__ __forceinline__ int v_rd_base(int lane) { return ((lane & 3) << 3) | (((lane >> 2) & 3) << 6) | (((lane >> 4) & 1) << 5) | (((lane >> 5) & 1) << 8); }
constexpr int v_rd_off(int d0, int ks, int half) { return d0 * 512 + ks * 4096 + half * 2048; }
__device__ __forceinline__ int crow(int r, int hi) { return (r & 3) + 8 * (r >> 2) + 4 * hi; }
__device__ __forceinline__ unsigned cvtpk(float lo, float hi) { unsigned r; asm volatile("v_cvt_pk_bf16_f32 %0, %1, %2" : "=v"(r) : "v"(lo), "v"(hi)); return r; }
__device__ __forceinline__ float partner(float v, int hi) { auto rr = __builtin_amdgcn_permlane32_swap(__builtin_bit_cast(unsigned, v), __builtin_bit_cast(unsigned, v), false, false); return __builtin_bit_cast(float, hi ? rr[0] : rr[1]); }

__device__ __forceinline__ float xchg_max(float v, int hi) { return fmaxf(v, partner(v, hi)); }
__device__ __forceinline__ float xchg_sum(float v, int hi) { return v + partner(v, hi); }

__device__ __forceinline__ void pack_p(const f32x16& p0, const f32x16& p1, bf16x8& pa0, bf16x8& pa1, bf16x8& pa2, bf16x8& pa3) {
#define AT_PK4(P, B_, OUT) do { unsigned a0 = cvtpk(P[B_ + 0], P[B_ + 1]), a1 = cvtpk(P[B_ + 2], P[B_ + 3]); unsigned b0 = cvtpk(P[B_ + 4], P[B_ + 5]), b1 = cvtpk(P[B_ + 6], P[B_ + 7]); \
        auto r0 = __builtin_amdgcn_permlane32_swap(a0, b0, false, false); auto r1 = __builtin_amdgcn_permlane32_swap(a1, b1, false, false); \
        u32x4 w = {r0[0], r1[0], r0[1], r1[1]}; OUT = __builtin_bit_cast(bf16x8, w); } while (0)
    AT_PK4(p0, 0, pa0); AT_PK4(p0, 8, pa1); AT_PK4(p1, 0, pa2); AT_PK4(p1, 8, pa3);
#undef AT_PK4
}
template <int KBUF>
__device__ __forceinline__ void qkt(f32x16& p0, f32x16& p1, LAS unsigned char* K_lds, int r32, int hi, const bf16x8 (&qr)[8]) {
    p0 = f32x16{}; p1 = f32x16{};
    LAS unsigned char* kb[4];
#pragma unroll
    for (int dd = 0; dd < 4; ++dd) kb[dd] = K_lds + KBUF * SHM_K + AT_KSWZ(r32, (dd * 16 + hi * 8) * 2);
#pragma unroll
    for (int d0 = 0; d0 < 8; ++d0) { LAS unsigned char* a = kb[d0 & 3] + (d0 >> 2) * 128;
        const bf16x8 b0 = *(const LAS bf16x8*)a; const bf16x8 b1 = *(const LAS bf16x8*)(a + 32 * 256);
        p0 = __builtin_amdgcn_mfma_f32_32x32x16_bf16(b0, qr[d0], p0, 0, 0, 0);
        p1 = __builtin_amdgcn_mfma_f32_32x32x16_bf16(b1, qr[d0], p1, 0, 0, 0); }
}
template <int VBUF>
__device__ __forceinline__ void pv_tile(f32x16 (&o)[4], int vb0, bf16x8 pa0, bf16x8 pa1, bf16x8 pa2, bf16x8 pa3) {
#define AT_TRRD(dst, off) asm volatile("ds_read_b64_tr_b16 %0, %1 offset:%2" : "=&v"(dst) : "v"(vb0), "i"(off) : "memory")
#define AT_PV_D0(d0) do { s16x4 l0, l1, l2, l3, h0, h1, h2, h3; constexpr int b_ = VBUF * SHM_V + v_rd_off(d0, 0, 0); \
        AT_TRRD(l0, b_); AT_TRRD(h0, b_ + 2048); AT_TRRD(l1, b_ + 4096); AT_TRRD(h1, b_ + 6144); AT_TRRD(l2, b_ + 8192); AT_TRRD(h2, b_ + 10240); AT_TRRD(l3, b_ + 12288); AT_TRRD(h3, b_ + 14336); \
        asm volatile("s_waitcnt lgkmcnt(0)" ::: "memory"); __builtin_amdgcn_sched_barrier(0); \
        o[d0] = __builtin_amdgcn_mfma_f32_32x32x16_bf16(pa0, (bf16x8){l0[0], l0[1], l0[2], l0[3], h0[0], h0[1], h0[2], h0[3]}, o[d0], 0, 0, 0); \
        o[d0] = __builtin_amdgcn_mfma_f32_32x32x16_bf16(pa1, (bf16x8){l1[0], l1[1], l1[2], l1[3], h1[0], h1[1], h1[2], h1[3]}, o[d0], 0, 0, 0); \
        o[d0] = __builtin_amdgcn_mfma_f32_32x32x16_bf16(pa2, (bf16x8){l2[0], l2[1], l2[2], l2[3], h2[0], h2[1], h2[2], h2[3]}, o[d0], 0, 0, 0); \
        o[d0] = __builtin_amdgcn_mfma_f32_32x32x16_bf16(pa3, (bf16x8){l3[0], l3[1], l3[2], l3[3], h3[0], h3[1], h3[2], h3[3]}, o[d0], 0, 0, 0); } while (0)
    AT_PV_D0(0); AT_PV_D0(1); AT_PV_D0(2); AT_PV_D0(3);
#undef AT_PV_D0
#undef AT_TRRD
}

template <int VAR>
__device__ __forceinline__ void attn_item(const bf16_t* Qh, const bf16_t* Kh, const bf16_t* Vh, bf16_t* OB, const float* relb, const float* LOGF, int b, int h, int qb, LAS unsigned char* lds, int tid) {
    const int wid = __builtin_amdgcn_readfirstlane(tid >> 6), lane = tid & 63, r32 = lane & 31, hi = lane >> 5;
    const int g = VAR == 0 ? h : (VAR == 1 ? 12 + h : 22 + h);
    const size_t hb = (size_t)(b * NH + g) * S * HD;
    const bf16_t* Kp = Kh + hb; const bf16_t* Vp = Vh + hb;
    LAS unsigned char* V_lds = lds + OFF_V; LAS unsigned char* K_lds = lds + OFF_K;
    LAS float* wsf = (LAS float*)(lds + OFF_WS) + wid * 64; LAS float* li_l = wsf; LAS float* al_l = wsf + 32;
    LAS float* cumL = (LAS float*)(lds + OFF_CUM); LAS float* Rt = (LAS float*)(lds + OFF_RT); volatile LAS unsigned* flags = (volatile LAS unsigned*)(lds + OFF_MISC);
    const int P0 = qb * QB, qlo = P0 + wid * 32, qpos = qlo + r32;
    int NT, jlo = 0;
    if (VAR == 0) { jlo = 4 * qb - 8; if (jlo < 0) jlo = 0; NT = 4 * qb + 4 - jlo; } else NT = 4 * qb + 4;
    const int cw = 4 * qb + (wid >> 1);
#define AT_KBASE(t) (VAR == 1 ? (4 * qb + 3 - (t)) * KVB : (jlo + (t)) * KVB)
#define AT_ACT(t) (VAR == 0 ? ((jlo + (t)) >= cw - 8 && (jlo + (t)) <= cw) : (VAR == 1 ? (AT_KBASE(t) <= qlo + 30) : (AT_KBASE(t) <= qlo + 31)))
    if (VAR == 0) {
        const float* tab = relb + h * 257;
        for (int j = tid; j < 639; j += 512) { int rel = 575 - j; rel = rel < -128 ? -128 : (rel > 128 ? 128 : rel); Rt[j] = tab[rel + 128] * LOG2E; }
    }
    if (VAR == 2) {
        const float* lf = LOGF + (size_t)(b * 10 + h) * S; const int kend = P0 + QB;
        f32x4 v = (f32x4){0.f, 0.f, 0.f, 0.f};
        if (4 * tid < kend) v = *(const f32x4*)(lf + 4 * tid);
        v[1] += v[0]; v[2] += v[1]; v[3] += v[2];
        float tot = v[3];
#pragma unroll
        for (int o = 1; o < 64; o <<= 1) { const float t_ = lane_read(tot, lane >= o ? lane - o : lane); if (lane >= o) tot += t_; }
        if (lane == 63) li_l[0] = tot;
        __syncthreads();
        float base = tot - v[3];
        for (int w = 0; w < wid; ++w) base += ((LAS float*)(lds + OFF_WS))[w * 64];
        if (4 * tid < kend) *(LAS f32x4*)(cumL + 4 * tid) = (f32x4){(base + v[0]) * LOG2E, (base + v[1]) * LOG2E, (base + v[2]) * LOG2E, (base + v[3]) * LOG2E};
    }
    bf16x8 qr[8];
    { const bf16_t* qp = Qh + hb + (size_t)(qlo + r32) * HD + hi * 8;
#pragma unroll
      for (int d0 = 0; d0 < 8; ++d0) qr[d0] = *(const bf16x8*)(qp + d0 * 16); }
    const int sr = tid >> 4, sc = (tid & 15) * 8, vst0 = v_st(sr, sc), vst1 = v_st(32 + sr, sc), kws = AT_KSWZ(sr, sc * 2);
    const int vb0 = (int)(unsigned)(size_t)V_lds + v_rd_base(lane);
    bf16x8 st_k0, st_k1, st_v0, st_v1;
#define AT_SLOAD(k0) do { const bf16_t* kp_ = Kp + (size_t)((k0) + sr) * HD + sc; const bf16_t* vp_ = Vp + (size_t)((k0) + sr) * HD + sc; \
        st_k0 = *(const bf16x8*)kp_; st_k1 = *(const bf16x8*)(kp_ + 32 * HD); st_v0 = *(const bf16x8*)vp_; st_v1 = *(const bf16x8*)(vp_ + 32 * HD); } while (0)
#define AT_SWRITE(bf) do { *(LAS bf16x8*)(K_lds + (bf) * SHM_K + kws) = st_k0; *(LAS bf16x8*)(K_lds + (bf) * SHM_K + kws + 32 * 256) = st_k1; \
        *(LAS bf16x8*)(V_lds + (bf) * SHM_V + vst0) = st_v0; *(LAS bf16x8*)(V_lds + (bf) * SHM_V + vst1) = st_v1; } while (0)
    AT_SLOAD(AT_KBASE(0)); asm volatile("s_waitcnt vmcnt(0)" ::: "memory"); AT_SWRITE(0);
    __syncthreads();
    float m_reg = -1e30f, l_reg = 0.f, carry = 0.f;
    f32x16 o[4] = {};
#define AT_STEP(BUF, t) do { \
        const bool more_ = (t) + 1 < NT; \
        if (more_) AT_SLOAD(AT_KBASE((t) + 1)); \
        if (AT_ACT(t)) { \
            const int kb_ = AT_KBASE(t); f32x16 p0, p1; bf16x8 pa0, pa1, pa2, pa3; \
            qkt<BUF>(p0, p1, K_lds, r32, hi, qr); \
            tile_math(p0, p1, kb_, pa0, pa1, pa2, pa3); \
            pv_tile<BUF>(o, vb0, pa0, pa1, pa2, pa3); \
        } \
        if (more_) { asm volatile("s_waitcnt vmcnt(0)" ::: "memory"); AT_SWRITE((BUF) ^ 1); } \
        if (VAR == 1) { const bool done_ = __all(carry < SB_DONE); if (lane == 0) flags[((t) & 1) * 8 + wid] = done_ ? 1u : 0u; } \
        __syncthreads(); \
    } while (0)
    auto tile_math = [&](f32x16& p0, f32x16& p1, int kb, bf16x8& pa0, bf16x8& pa1, bf16x8& pa2, bf16x8& pa3) __attribute__((always_inline)) {
        const int dq = qpos - kb - 4 * hi;
        if (VAR == 1) {
            const bool need_mask = kb + 63 >= qlo;
            f32x16 n0, n1;
#pragma unroll
            for (int r = 0; r < 16; ++r) { const float z = p0[r]; const float lp = __builtin_amdgcn_logf(1.0f + __builtin_amdgcn_exp2f(-fabsf(z))); n0[r] = fminf(-z, 0.f) - lp;
                                           const float y = p1[r]; const float lq = __builtin_amdgcn_logf(1.0f + __builtin_amdgcn_exp2f(-fabsf(y))); n1[r] = fminf(-y, 0.f) - lq; }
            if (need_mask) {
#pragma unroll
                for (int r = 0; r < 16; ++r) { const int c = (r & 3) + 8 * (r >> 2);
                    if (dq - c <= 0) { n0[r] = 0.f; p0[r] = -__builtin_inff(); }
                    if (dq - c - 32 <= 0) { n1[r] = 0.f; p1[r] = -__builtin_inff(); } }
            }
            float A[8], Bp[8];
#pragma unroll
            for (int q = 0; q < 4; ++q) { A[q] = (n0[4 * q] + n0[4 * q + 1]) + (n0[4 * q + 2] + n0[4 * q + 3]); A[4 + q] = (n1[4 * q] + n1[4 * q + 1]) + (n1[4 * q + 2] + n1[4 * q + 3]); }
#pragma unroll
            for (int q = 0; q < 8; ++q) Bp[q] = partner(A[q], hi);
            float st = 0.f;
#pragma unroll
            for (int q = 7; q >= 0; --q) {
                const float after = carry + st + (hi == 0 ? Bp[q] : 0.f);
                if (q >= 4) { const int r0 = 4 * (q - 4);
                    float tl = after; p1[r0 + 3] = __builtin_amdgcn_exp2f(p1[r0 + 3] + n1[r0 + 3] + tl); tl += n1[r0 + 3]; p1[r0 + 2] = __builtin_amdgcn_exp2f(p1[r0 + 2] + n1[r0 + 2] + tl); tl += n1[r0 + 2];
                    p1[r0 + 1] = __builtin_amdgcn_exp2f(p1[r0 + 1] + n1[r0 + 1] + tl); tl += n1[r0 + 1]; p1[r0] = __builtin_amdgcn_exp2f(p1[r0] + n1[r0] + tl); }
                else { const int r0 = 4 * q;
                    float tl = after; p0[r0 + 3] = __builtin_amdgcn_exp2f(p0[r0 + 3] + n0[r0 + 3] + tl); tl += n0[r0 + 3]; p0[r0 + 2] = __builtin_amdgcn_exp2f(p0[r0 + 2] + n0[r0 + 2] + tl); tl += n0[r0 + 2];
                    p0[r0 + 1] = __builtin_amdgcn_exp2f(p0[r0 + 1] + n0[r0 + 1] + tl); tl += n0[r0 + 1]; p0[r0] = __builtin_amdgcn_exp2f(p0[r0] + n0[r0] + tl); }
                st += A[q] + Bp[q];
            }
            carry += st;
            pack_p(p0, p1, pa0, pa1, pa2, pa3);
        } else {
            if (VAR == 0) {
                const LAS float* rp = Rt + (575 - (qpos - kb) + 4 * hi);
#pragma unroll
                for (int r = 0; r < 16; ++r) { const int c = (r & 3) + 8 * (r >> 2); p0[r] += rp[c]; p1[r] += rp[c + 32]; }
            } else {
                const LAS float* cp = cumL + kb + 4 * hi;
#pragma unroll
                for (int q = 0; q < 4; ++q) { const f32x4 c0 = *(const LAS f32x4*)(cp + 8 * q), c1 = *(const LAS f32x4*)(cp + 32 + 8 * q);
                    p0[4 * q] -= c0[0]; p0[4 * q + 1] -= c0[1]; p0[4 * q + 2] -= c0[2]; p0[4 * q + 3] -= c0[3];
                    p1[4 * q] -= c1[0]; p1[4 * q + 1] -= c1[1]; p1[4 * q + 2] -= c1[2]; p1[4 * q + 3] -= c1[3]; }
                if (kb + 63 > qlo) {
#pragma unroll
                    for (int r = 0; r < 16; ++r) { const int c = (r & 3) + 8 * (r >> 2);
                        if (dq - c < 0) p0[r] = -__builtin_inff();
                        if (dq - c - 32 < 0) p1[r] = -__builtin_inff(); }
                }
            }
            float pmax = p0[0];
#pragma unroll
            for (int r = 1; r < 16; ++r) pmax = fmaxf(pmax, p0[r]);
#pragma unroll
            for (int r = 0; r < 16; ++r) pmax = fmaxf(pmax, p1[r]);
            pmax = xchg_max(pmax, hi);
            float mn, alpha;
            if (__all(pmax - m_reg <= THR2)) { mn = m_reg; alpha = 1.f; }
            else { mn = fmaxf(m_reg, pmax); alpha = __builtin_amdgcn_exp2f(m_reg - mn); m_reg = mn; }
            float ps = 0.f;
#pragma unroll
            for (int r = 0; r < 16; ++r) { p0[r] = __builtin_amdgcn_exp2f(p0[r] - mn); p1[r] = __builtin_amdgcn_exp2f(p1[r] - mn); ps += p0[r] + p1[r]; }
            ps = xchg_sum(ps, hi);
            l_reg = l_reg * alpha + ps;
            if (__any(alpha < 1.f)) {
                if (hi == 0) al_l[r32] = alpha;
                asm volatile("s_waitcnt lgkmcnt(0)" ::: "memory");
                float av[16];
#pragma unroll
                for (int r = 0; r < 16; ++r) av[r] = al_l[crow(r, hi)];
#pragma unroll
                for (int d = 0; d < 4; ++d)
#pragma unroll
                    for (int r = 0; r < 16; ++r) o[d][r] *= av[r];
            }
            pack_p(p0, p1, pa0, pa1, pa2, pa3);
        }
    };
    for (int t = 0; t < NT; t += 2) {
        AT_STEP(0, t);
        if (VAR == 1) { unsigned all_ = 1u; for (int w = 0; w < 8; ++w) all_ &= flags[(t & 1) * 8 + w]; if (all_) break; }
        if (t + 1 >= NT) break;
        AT_STEP(1, t + 1);
        if (VAR == 1) { unsigned all_ = 1u; for (int w = 0; w < 8; ++w) all_ &= flags[((t + 1) & 1) * 8 + w]; if (all_) break; }
    }
    float rli[16];
    if (VAR != 1) {
        if (hi == 0) li_l[r32] = l_reg;
        asm volatile("s_waitcnt lgkmcnt(0)" ::: "memory");
#pragma unroll
        for (int r = 0; r < 16; ++r) rli[r] = __builtin_amdgcn_rcpf(li_l[crow(r, hi)]);
    }
    unsigned char* Ow8 = (unsigned char*)OB + (size_t)(b * S + qlo) * D + g * HD;
#pragma unroll
    for (int r = 0; r < 16; ++r) { const int orow = crow(r, hi);
#pragma unroll
        for (int d0 = 0; d0 < 4; ++d0) { const float v = VAR != 1 ? o[d0][r] * rli[r] : o[d0][r];
            const float vn = lane_read(v, lane ^ 1);
            if ((r32 & 1) == 0) *(unsigned short*)(Ow8 + (size_t)orow * D + d0 * 32 + r32) = (unsigned short)__builtin_amdgcn_cvt_pk_fp8_f32(clamp8(v * 16.0f), clamp8(vn * 16.0f), 0, false); } }
    __syncthreads();
#undef AT_STEP
#undef AT_SLOAD
#undef AT_SWRITE
#undef AT_KBASE
#undef AT_ACT
}

template <int VAR>
__device__ __forceinline__ void attn_queue(const bf16_t* Qh, const bf16_t* Kh, const bf16_t* Vh, bf16_t* OB, const float* relb, const float* LOGF, unsigned* qhead, LAS unsigned char* lds, int wave0) {
    FRESH_TID(); FRESH_LDS(lds);
    volatile LAS unsigned* qslot = (volatile LAS unsigned*)(lds + OFF_MISC) + 32;
    constexpr int NHV = VAR == 0 ? 12 : 10, NITEMS = 8 * NHV * 8;
    for (;;) {
        if (tid == 0) qslot[0] = __hip_atomic_fetch_add(qhead, 1u, __ATOMIC_RELAXED, __HIP_MEMORY_SCOPE_AGENT);
        __syncthreads();
        const int idx = (int)qslot[0];
        __syncthreads();
        if (idx >= NITEMS) break;
        const int qb = 7 - idx / (8 * NHV), bh = idx % (8 * NHV);
        attn_item<VAR>(Qh, Kh, Vh, OB, relb, LOGF, bh / NHV, bh % NHV, qb, lds, tid);
    }
}
__device__ __forceinline__ void attn_phase(const bf16_t* Qh, const bf16_t* Kh, const bf16_t* Vh, bf16_t* OB, const float* relb, const float* LOGF, unsigned* qheads, LAS unsigned char* lds, int wave0, mk::KArgsT ka, int conv_l) {
    int grp = (int)((blockIdx.x >> 3) & 3u); asm volatile("" : "+s"(grp));
    int cnt = 0; bool conv_done = conv_l < 0;
#pragma unroll 1
    for (int seg = 0; seg < 4; ++seg) {
        for (;;) {
            if (!conv_done && (cnt == grp || seg == 3)) { mk::conv_phase(ka, conv_l, lds, wave0); __syncthreads(); conv_done = true; }
            if (seg == 3) break;
            int idx;
            { FRESH_TID(); LAS unsigned char* l_ = lds; FRESH_LDS(l_); volatile LAS unsigned* qslot = (volatile LAS unsigned*)(l_ + OFF_MISC) + 32;
              if (tid == 0) qslot[0] = __hip_atomic_fetch_add(qheads + 64 * seg, 1u, __ATOMIC_RELAXED, __HIP_MEMORY_SCOPE_AGENT);
              __syncthreads();
              idx = (int)qslot[0];
              __syncthreads(); }
            const int NHV = seg == 1 ? 12 : 10;
            if (idx >= 64 * NHV) break;
            ++cnt;
            const int qb = 7 - idx / (8 * NHV), bh = idx % (8 * NHV);
            { FRESH_TID(); LAS unsigned char* l_ = lds; FRESH_LDS(l_);
              if (seg == 0) attn_item<2>(Qh, Kh, Vh, OB, relb, LOGF, bh / NHV, bh % NHV, qb, l_, tid);
              else if (seg == 1) attn_item<0>(Qh, Kh, Vh, OB, relb, LOGF, bh / NHV, bh % NHV, qb, l_, tid);
              else attn_item<1>(Qh, Kh, Vh, OB, relb, LOGF, bh / NHV, bh % NHV, qb, l_, tid); }
        }
    }
}
}
namespace mk {
#define XB_TMO      128
#define XB_XCNT(j)  (256  + 64 * (j))
#define XB_XSUB(j)  (1280 + 64 * (j))
#define XB_XGEN(j)  (2304 + 64 * (j))
#define XB_TOP      3328
#define XB_TOPGEN   3392
#define XCD_BAR_WORDS 3456
#define XB_SPIN_CAP (1u << 22)

__device__ __forceinline__ unsigned xb_ld(unsigned* p)              { return __hip_atomic_load(p, __ATOMIC_RELAXED, __HIP_MEMORY_SCOPE_AGENT); }
__device__ __forceinline__ unsigned xb_add(unsigned* p, unsigned v) { return __hip_atomic_fetch_add(p, v, __ATOMIC_RELAXED, __HIP_MEMORY_SCOPE_AGENT); }
__device__ __forceinline__ unsigned xb_xcc_id() { return (unsigned)__builtin_amdgcn_s_getreg((3 << 11) | 20) & 0xFu; }
#define XB_SPIN(cond, bar) do { unsigned _sp = 0; while (cond) { __builtin_amdgcn_s_sleep(1); \
    if ((++_sp & 255u) == 0u) { if (xb_ld(&(bar)[XB_TMO])) break; if (_sp > XB_SPIN_CAP) { atomicAdd(&(bar)[XB_TMO], 1u); break; } } } } while (0)

struct XcdBarrier {
    unsigned* bar; unsigned x;
    volatile LAS unsigned* st;
};

__device__ __forceinline__ XcdBarrier xcd_barrier_post(unsigned* bar, volatile LAS unsigned* st, bool is_t0) {
    XcdBarrier b; b.bar = bar; b.x = xb_xcc_id(); b.st = st;
    if (is_t0) (void)xb_add(&bar[XB_XCNT(b.x)], 1u);
    return b;
}
__device__ __forceinline__ void xcd_barrier_complete(unsigned* bar, unsigned x, unsigned& nloc, unsigned& nx) {
    const unsigned G = gridDim.x * gridDim.y * gridDim.z;
    unsigned sum, cnt, mine, sp = 0u;
    for (;;) {
        sum = 0u; cnt = 0u; mine = 0u;
#pragma unroll
        for (unsigned j = 0; j < 16; ++j) { const unsigned c = xb_ld(&bar[XB_XCNT(j)]); sum += c; cnt += (c > 0u) ? 1u : 0u; mine = (j == x) ? c : mine; }
        if (sum == G) break;
        __builtin_amdgcn_s_sleep(1);
        if ((++sp & 255u) == 0u) { if (xb_ld(&bar[XB_TMO])) break; if (sp > XB_SPIN_CAP) { atomicAdd(&bar[XB_TMO], 1u); break; } }
    }
    nloc = mine > 0u ? mine : 1u; nx = cnt > 0u ? cnt : 1u;
}

__device__ __forceinline__ void xcd_barrier(const XcdBarrier& b, bool is_t0) {
    asm volatile("s_waitcnt vmcnt(0)" ::: "memory");
    __syncthreads();
    if (is_t0) {
        unsigned* bar = b.bar;
        __builtin_amdgcn_s_waitcnt(0);
        unsigned nloc = b.st[0], nx = b.st[1];
        if (nloc == 0u) { xcd_barrier_complete(bar, b.x, nloc, nx); b.st[0] = nloc; b.st[1] = nx; }
        const unsigned old = xb_add(&bar[XB_XSUB(b.x)], 1u);
        const unsigned gen = old / nloc;
        if (old + 1u == (gen + 1u) * nloc) {
            __builtin_amdgcn_fence(__ATOMIC_RELEASE, "agent");
            asm volatile("s_waitcnt vmcnt(0)" ::: "memory");
            const unsigned og = xb_add(&bar[XB_TOP], 1u);
            const unsigned tg = og / nx;
            if (og + 1u == (tg + 1u) * nx) xb_add(&bar[XB_TOPGEN], 1u);
            else XB_SPIN(xb_ld(&bar[XB_TOPGEN]) == tg, bar);
            __builtin_amdgcn_fence(__ATOMIC_ACQUIRE, "agent");
            xb_add(&bar[XB_XGEN(b.x)], 1u);
            asm volatile("s_waitcnt vmcnt(0)" ::: "memory");
        } else {
            XB_SPIN(xb_ld(&bar[XB_XGEN(b.x)]) == gen, bar);
            __builtin_amdgcn_fence(__ATOMIC_ACQUIRE, "agent");
            asm volatile("s_waitcnt vmcnt(0)" ::: "memory");
        }
    }
    __syncthreads();
}

constexpr int PH_PER_LAYER = 8;
typedef const __attribute__((address_space(4))) Args* KArgs;
#define KARGS() ({ KArgs p_ = (KArgs)__builtin_amdgcn_kernarg_segment_ptr(); asm volatile("" : "+s"(p_)); p_; })
#define GRID_BAR() do { KArgs k_ = KARGS(); XcdBarrier b_; b_.bar = (unsigned*)(k_->ws + WS_CTL) + CW_BAR; b_.x = xb_xcc_id(); b_.st = (volatile LAS unsigned*)(lds + MISC_OFF) + 8; unsigned z_ = 0u; asm volatile("" : "+v"(z_)); const bool t0_ = (wave0 == 0) && (__builtin_amdgcn_mbcnt_hi(~0u, __builtin_amdgcn_mbcnt_lo(~0u, z_)) == 0u);     xcd_barrier(b_, t0_); } while (0)
__global__ void __launch_bounds__(NWAVES * 64, 2) mk_fwd(Args a_unused) {
    extern __shared__ __attribute__((aligned(16))) unsigned char lds_raw[];
    LAS unsigned char* lds = (LAS unsigned char*)lds_raw;
    const int wave0 = __builtin_amdgcn_readfirstlane((int)threadIdx.x >> 6);
    for (int u = threadIdx.x; u < (LDS_BYTES - LDSCTL_OFF) / 4; u += NWAVES * 64) ((LAS unsigned*)(lds + LDSCTL_OFF))[u] = 0u;
    __syncthreads();
    int lo, hi;
    { KArgs k = KARGS(); lo = k->ph_lo; hi = k->ph_hi;
      if (hi - lo > 1) (void)xcd_barrier_post((unsigned*)(k->ws + WS_CTL) + CW_BAR, (volatile LAS unsigned*)(lds + MISC_OFF) + 8, threadIdx.x == 0); }
#define IN(k) (lo <= (k) && (k) < hi)
#define BOTH(k) (IN(k) && IN((k) + 1))
#pragma unroll
    for (int l = 0; l < 2; ++l) {
        const int pb = PH_PER_LAYER * l;
        if (IN(pb + 0) && l == 0) { KArgs k = KARGS(); conv_phase(k, l, lds, wave0); }
        if (IN(pb + 1) && l == 0) {
            KArgs k = KARGS(); unsigned char* ws = k->ws;
            const float* xin = k->in[0];
            prep_phase<true>(xin, (bf16_t*)(ws + WS_XB8N), (float*)(ws + WS_RSTD), k->in[2] + (size_t)l * D * PW, k->in[1] + (size_t)l * D, k->in[3] + l * 10, (float*)(ws + WS_LOGF), lds, wave0);
            if (BOTH(pb + 1)) GRID_BAR();
        }
        if (IN(pb + 2)) {
            KArgs k = KARGS(); unsigned char* ws = k->ws;
            pg8::Gemm g{(const bf16_t*)(ws + WS_XB8N), (const bf16_t*)(ws + ws_win(l)), M, 12288, D}; pg8::StaticOrder So; FRESH_BID(); So.init(M, 12288, G, bid);
            pg8::EpiQKV4 E{(bf16_t*)(ws + WS_Q), (const float*)(ws + WS_RSTD), 0.08838834764831845f * 1.4426950408889634f, US_INV};
            { LAS unsigned char* lds_ = lds; FRESH_LDS(lds_); FRESH_TID(); pg8::gemm_phase<pg8::EpiQKV4, pg8::StaticOrder, true, true, true>(lds_, g, So, E, tid); }
            if (BOTH(pb + 2)) GRID_BAR();
        }
        if (IN(pb + 3)) {
            KArgs k = KARGS(); unsigned char* ws = k->ws;
            at::attn_phase((const bf16_t*)(ws + WS_Q), (const bf16_t*)(ws + WS_K), (const bf16_t*)(ws + WS_V), (bf16_t*)(ws + WS_OB), k->in[4] + (size_t)l * 12 * 257, (const float*)(ws + WS_LOGF),
                           (unsigned*)(ws + WS_CTL) + CW_QUEUE + 256 * l, lds, wave0, k, l == 0 ? 1 : -1);
            if (BOTH(pb + 3)) GRID_BAR();
        }
        if (IN(pb + 4)) {
            KArgs k = KARGS(); unsigned char* ws = k->ws;
            pg8::Gemm g{(const bf16_t*)(ws + WS_OB), (const bf16_t*)(ws + ws_wout(l)), M, D, D}; pg8::StaticOrder So; FRESH_BID(); So.init(M, D, G, bid);
            if (l == 0) { pg8::EpiResidB16<true> E{k->in[0], US_INV * (1.0f / 16.0f), (bf16_t*)(ws + WS_XB)};
                { LAS unsigned char* lds_ = lds; FRESH_LDS(lds_); FRESH_TID(); pg8::gemm_phase<pg8::EpiResidB16<true>, pg8::StaticOrder, false, true, true>(lds_, g, So, E, tid); } }
            else { pg8::EpiResidB16<false> E{ws + WS_X2, US_INV * (1.0f / 16.0f), (bf16_t*)(ws + WS_XB)};
                { LAS unsigned char* lds_ = lds; FRESH_LDS(lds_); FRESH_TID(); pg8::gemm_phase<pg8::EpiResidB16<false>, pg8::StaticOrder, false, true, true>(lds_, g, So, E, tid); } }
            if (BOTH(pb + 4)) GRID_BAR();
        }
        if (IN(pb + 5)) {
            KArgs k = KARGS(); unsigned char* ws = k->ws;
            pg8::Gemm g{(const bf16_t*)(ws + WS_XB), (const bf16_t*)(ws + ws_wqk(l)), M, 2048, D}; pg8::StaticOrder So; FRESH_BID(); So.init(M, 2048, G, bid);
            pg8::EpiPlainF32<2048> E{(float*)(ws + WS_SC)};
            { LAS unsigned char* lds_ = lds; FRESH_LDS(lds_); FRESH_TID(); pg8::gemm_phase<pg8::EpiPlainF32<2048>, pg8::StaticOrder, true, true>(lds_, g, So, E, tid); }
            if (BOTH(pb + 5)) GRID_BAR();
        }
        if (IN(pb + 6)) {
            KArgs k = KARGS(); unsigned char* ws = k->ws;
            if (l == 0) peer_uv_phase<false>((const float*)(ws + WS_SC), (const unsigned char*)(ws + ws_tab(l)), (const unsigned char*)(ws + ws_tab(l)) + (size_t)NE * ROW6  , (const bf16_t*)(ws + WS_XB), ws + WS_X2, nullptr,
                                             ws + WS_XB8N, (float*)(ws + WS_RSTD), (float*)(ws + WS_LOGF), k->in[2] + (size_t)D * PW, k->in[1] + D, k->in[3] + 10, lds, wave0);
            else peer_uv_phase<true>((const float*)(ws + WS_SC), (const unsigned char*)(ws + ws_tab(l)), (const unsigned char*)(ws + ws_tab(l)) + (size_t)NE * ROW6  , (const bf16_t*)(ws + WS_XB), k->out, k->in[12],
                                     nullptr, nullptr, nullptr, nullptr, nullptr, nullptr, lds, wave0);
            if (BOTH(pb + 7)) GRID_BAR();
        }
    }
#undef IN
#undef BOTH
}

static int g_grid = 0;
static void launch_phases(Args a, int lo, int hi, hipStream_t st) {
    a.ph_lo = lo; a.ph_hi = hi;
    hipLaunchKernelGGL(mk_fwd, dim3(g_grid), dim3(NWAVES * 64), LDS_BYTES, st, a);
}
}

extern "C" void kernel_launch(void* const* d_in, const int* in_sizes, int n_in, void* d_out, int out_size, void* d_ws, size_t ws_size, hipStream_t stream) {
    (void)in_sizes; (void)n_in; (void)out_size;
    using namespace mk;
    if (g_grid == 0) {
        if (ws_size < 2048 * MiB) { fprintf(stderr, "kernel_launch: workspace too small (%zu)\n", ws_size); g_grid = -1; return; }
        if (hipFuncSetAttribute((const void*)mk_fwd, hipFuncAttributeMaxDynamicSharedMemorySize, LDS_BYTES) != hipSuccess) { fprintf(stderr, "kernel_launch: hipFuncSetAttribute failed\n"); g_grid = -1; return; }
        int dev = 0, cus = 0; (void)hipGetDevice(&dev); (void)hipDeviceGetAttribute(&cus, hipDeviceAttributeMultiprocessorCount, dev);
        g_grid = cus > 0 ? cus : 256;
    }
    if (g_grid < 0) return;
    unsigned char* ws = (unsigned char*)d_ws; float* out = (float*)d_out;
    (void)hipMemsetAsync(ws + WS_CTL, 0, CTL_ZERO_BYTES, stream);
    Args a{};
    for (int i = 0; i < 13; ++i) a.in[i] = (const float*)d_in[i];
    a.out = out; a.ws = ws;
    launch_phases(a, 0, 2 * PH_PER_LAYER, stream);
}
```

```cpp
#include <hip/hip_runtime.h>
#include <cstdio>
#include <cstdint>
namespace pg8 {
#define PG8_LAS __attribute__((address_space(3)))
typedef unsigned short bf16_t;
typedef short bf16x8 __attribute__((ext_vector_type(8)));
typedef float f32x4 __attribute__((ext_vector_type(4)));
typedef unsigned u32x4 __attribute__((ext_vector_type(4)));
typedef unsigned u32x2 __attribute__((ext_vector_type(2)));
constexpr int BM = 256, BK = 64, HALF = 128, HTB = HALF * BK * 2  , STAGE_BYTES = 8 * HTB, NXCD = 8, WGM = 8;

__host__ __device__ __forceinline__ int lds_byte(int r, int c) { const int st = (r >> 4) * 2 + (c >> 5), rr = r & 15, cc = c & 31, ob = rr * 64 + cc * 2; return st * 1024 + (ob ^ (((ob >> 9) & 1) << 5)); }
__host__ __device__ __forceinline__ void stage_rc(int b, int& R, int& C) { const int st = b / 1024, sb = b % 1024, swz = sb ^ (((sb >> 9) & 1) << 5); R = (st >> 1) * 16 + swz / 64; C = (st & 1) * 32 + (swz % 64) / 2; }
__host__ __device__ __forceinline__ int perm32(int rho) { const int n = rho >> 4, i = rho & 15; return 8 * (i >> 2) + 4 * n + (i & 3); }

struct Unit { int pm, pn; };
struct Gemm { const bf16_t* A; const bf16_t* Bt; int M, N, K; };

struct StaticOrder {
    int nM, nN, nwg, G, c;
    __host__ __device__ void init(int M, int N, int G_, int c_) { nM = M / BM; nN = N / BM; nwg = nM * nN; G = G_; c = c_; }
    __host__ __device__ bool next(int i, Unit& u) const {
        const long L = (long)i * G + c; if (L >= nwg) return false;
        int wgid = (int)L; { const int q = nwg / NXCD, r = nwg % NXCD, xcd = wgid % NXCD, off = wgid / NXCD; wgid = (xcd < r ? xcd * (q + 1) : r * (q + 1) + (xcd - r) * q) + off; }
        const int nig = WGM * nN, gid = wgid / nig, fm = gid * WGM, gsz = (nM - fm) < WGM ? (nM - fm) : WGM;
        u.pm = fm + ((wgid % nig) % gsz); u.pn = (wgid % nig) / gsz; return true;
    }
    __device__ __forceinline__ void a_ready(const Unit&) const {}
    __device__ __forceinline__ void done(const Unit&) const {}
};
__device__ __forceinline__ unsigned cvt_pk_bf16(float lo, float hi) { unsigned r; asm volatile("v_cvt_pk_bf16_f32 %0, %1, %2" : "=v"(r) : "v"(lo), "v"(hi)); return r; }
typedef float f32x2 __attribute__((ext_vector_type(2)));
__device__ __forceinline__ f32x2 gelu_pk(f32x2 v) {
    const f32x2 av = __builtin_elementwise_abs(v), d = av * 0.2316418882f + 1.0f;
    f32x2 t; t.x = __builtin_amdgcn_rcpf(d.x); t.y = __builtin_amdgcn_rcpf(d.y);
    f32x2 q = t * 0.5307027145f + (-0.7265760135f); q = q * t + 0.7107068705f; q = q * t + (-0.142248368f); q = q * t + 0.127414796f; q = q * t;
    const f32x2 s = (v * v) * (-0.72134752044f);
    f32x2 e; e.x = __builtin_amdgcn_exp2f(s.x); e.y = __builtin_amdgcn_exp2f(s.y);
    const f32x2 m = v * (q * e), r = v - m;
    f32x2 o; o.x = v.x < 0.f ? m.x : r.x; o.y = v.y < 0.f ? m.y : r.y; return o;
}
#define EPI_FRESH_LANE() { unsigned z_ = 0u; asm volatile("" : "+v"(z_)); const int l_ = (int)__builtin_amdgcn_mbcnt_hi(~0u, __builtin_amdgcn_mbcnt_lo(~0u, z_)); fr = l_ & 15; fq = l_ >> 4; }
typedef __amdgpu_buffer_rsrc_t rsrc_t;
__device__ __forceinline__ rsrc_t mkrsrc(const void* p, unsigned bytes) { return __builtin_amdgcn_make_buffer_rsrc((void*)p, (short)0, (int)bytes, 0x00020000); }
template <int LDC> struct EpiPlainF32 {
    static constexpr bool PERM = false, AFTER_DRAIN = false;
    float* C;
    __device__ __forceinline__ void operator()(const f32x4 (&acc)[2][2][4][2], const Unit& u, int wr, int wc, int fr, int fq) const {
        EPI_FRESH_LANE();
        const rsrc_t rc = mkrsrc(C, 16384u * LDC * 4u);
        const int vo = ((wr * 64 + fr) * LDC + wc * 32 + 4 * fq) * 4, so = (u.pm * BM * LDC + u.pn * BM) * 4;
#pragma unroll
        for (int ai = 0; ai < 2; ++ai)
#pragma unroll
            for (int m = 0; m < 4; ++m)
#pragma unroll
                for (int bj = 0; bj < 2; ++bj)
#pragma unroll
                    for (int n = 0; n < 2; ++n) __builtin_amdgcn_raw_buffer_store_b128(__builtin_bit_cast(u32x4, acc[ai][bj][m][n]), rc, vo, so + ((ai * HALF + m * 16) * LDC + bj * HALF + n * 16) * 4, 0);
    }
};
template <int LDC> struct EpiRowScaleF32 {
    static constexpr bool PERM = false, AFTER_DRAIN = false;
    float* C; const float* rs;
    __device__ __forceinline__ void operator()(const f32x4 (&acc)[2][2][4][2], const Unit& u, int wr, int wc, int fr, int fq) const {
        const rsrc_t rc = mkrsrc(C, 16384u * LDC * 4u), rr = mkrsrc(rs, 16384u * 4u);
        const int vo = ((wr * 64 + fr) * LDC + wc * 32 + 4 * fq) * 4, vr = (wr * 64 + fr) * 4;
        const int so = (u.pm * BM * LDC + u.pn * BM) * 4, sr = u.pm * BM * 4;
#pragma unroll
        for (int ai = 0; ai < 2; ++ai)
#pragma unroll
            for (int m = 0; m < 4; ++m) { const float s = __builtin_bit_cast(float, __builtin_amdgcn_raw_buffer_load_b32(rr, vr, sr + (ai * HALF + m * 16) * 4, 0));
#pragma unroll
                for (int bj = 0; bj < 2; ++bj)
#pragma unroll
                    for (int n = 0; n < 2; ++n) { const f32x4 v = acc[ai][bj][m][n] * s; __builtin_amdgcn_raw_buffer_store_b128(__builtin_bit_cast(u32x4, v), rc, vo, so + ((ai * HALF + m * 16) * LDC + bj * HALF + n * 16) * 4, 0); } }
    }
};
__device__ __forceinline__ u32x4 widen_pair(unsigned x0, unsigned x1, unsigned y0, unsigned y1, int lane_, int fq_) {
    const bool odd = fq_ & 1; const int pa = (lane_ ^ 16) << 2;
    const unsigned r0 = (unsigned)__builtin_amdgcn_ds_bpermute(pa, (int)(odd ? x0 : y0)), r1 = (unsigned)__builtin_amdgcn_ds_bpermute(pa, (int)(odd ? x1 : y1));
    return odd ? (u32x4){r0, r1, y0, y1} : (u32x4){x0, x1, r0, r1};
}
template <bool BASE_F32> struct EpiResidB16 {
    static constexpr bool PERM = false, AFTER_DRAIN = false;
    const void* base; float ascale; bf16_t* xb;
    __device__ __forceinline__ void operator()(const f32x4 (&acc)[2][2][4][2], const Unit& u, int wr, int wc, int fr, int fq) const {
        EPI_FRESH_LANE();
        constexpr int LDC = 4096;
        const rsrc_t rb = mkrsrc(base, 16384u * LDC * (BASE_F32 ? 4u : 2u)), rx = mkrsrc(xb, 16384u * LDC * 2u);
        const int vo = ((wr * 64 + fr) * LDC + wc * 32 + 4 * fq) * 2;
        const int so = (u.pm * BM * LDC + u.pn * BM) * 2;
        const int vo8 = ((wr * 64 + fr) * LDC + wc * 32 + (fq & 1) * 16 + (fq >> 1) * 8) * 2;
        f32x4 ra[2][2], rb2[2][2];
#define EPI_LD(dst, g_) do { _Pragma("unroll") for (int bj = 0; bj < 2; ++bj) _Pragma("unroll") for (int n = 0; n < 2; ++n) { \
            const int o = so + ((((g_) >> 2) * HALF + ((g_) & 3) * 16) * LDC + bj * HALF + n * 16) * 2; \
            if constexpr (BASE_F32) dst[bj][n] = __builtin_bit_cast(f32x4, __builtin_amdgcn_raw_buffer_load_b128(rb, vo * 2, o * 2, 0)); \
            else { const u32x2 t_ = __builtin_amdgcn_raw_buffer_load_b64(rb, vo, o, 0); dst[bj][n] = (f32x4){__builtin_bit_cast(float, t_.x << 16), __builtin_bit_cast(float, t_.x & 0xffff0000u), __builtin_bit_cast(float, t_.y << 16), __builtin_bit_cast(float, t_.y & 0xffff0000u)}; } } } while (0)
#define EPI_ST(src, g_) do { _Pragma("unroll") for (int bj = 0; bj < 2; ++bj) { \
            const int o = so + ((((g_) >> 2) * HALF + ((g_) & 3) * 16) * LDC + bj * HALF) * 2; \
            const f32x4 v0 = src[bj][0] + acc[(g_) >> 2][bj][(g_) & 3][0] * ascale, v1 = src[bj][1] + acc[(g_) >> 2][bj][(g_) & 3][1] * ascale; \
            const u32x4 w16 = widen_pair(cvt_pk_bf16(v0[0], v0[1]), cvt_pk_bf16(v0[2], v0[3]), cvt_pk_bf16(v1[0], v1[1]), cvt_pk_bf16(v1[2], v1[3]), 16 * fq + fr, fq); \
            __builtin_amdgcn_raw_buffer_store_b128(w16, rx, vo8, o, 0); } } while (0)
        EPI_LD(ra, 0);
        EPI_LD(rb2, 1); EPI_ST(ra, 0);
        EPI_LD(ra, 2); EPI_ST(rb2, 1);
        EPI_LD(rb2, 3); EPI_ST(ra, 2);
        EPI_LD(ra, 4); EPI_ST(rb2, 3);
        EPI_LD(rb2, 5); EPI_ST(ra, 4);
        EPI_LD(ra, 6); EPI_ST(rb2, 5);
        EPI_LD(rb2, 7); EPI_ST(ra, 6);
        EPI_ST(rb2, 7);
#undef EPI_LD
#undef EPI_ST
    }
};
struct EpiQKV {
    static constexpr bool PERM = true, AFTER_DRAIN = false;
    bf16_t* Q; const float* rs; float qscale;
    __device__ __forceinline__ void operator()(const f32x4 (&acc)[2][2][4][2], const Unit& u, int wr, int wc, int fr, int fq) const {
        const rsrc_t rq = mkrsrc(Q, 3u * 16384u * 4096u * 2u), rr = mkrsrc(rs, 16384u * 4u);
        const int colt = u.pn * BM, which = colt >> 12, cw = colt & 4095, gt = cw >> 7;
        const int b = (u.pm * BM) >> 11, st = (u.pm * BM) & 2047;
        const float sc = which == 0 ? qscale : 1.f;
        const int so = (int)(((unsigned)which << 26) + (((unsigned)(b * 32 + gt) * 2048u + (unsigned)st) << 7)) * 2;
        const int vo = (((wr * 64 + fr) << 7) + wc * 32 + 8 * fq) * 2, vr = (wr * 64 + fr) * 4, sr = u.pm * BM * 4;
#pragma unroll
        for (int ai = 0; ai < 2; ++ai)
#pragma unroll
            for (int m = 0; m < 4; ++m) { const float f = sc * __builtin_bit_cast(float, __builtin_amdgcn_raw_buffer_load_b32(rr, vr, sr + (ai * HALF + m * 16) * 4, 0));
#pragma unroll
                for (int bj = 0; bj < 2; ++bj) {
                    const f32x4 v0 = acc[ai][bj][m][0] * f, v1 = acc[ai][bj][m][1] * f;
                    u32x4 w; w.x = cvt_pk_bf16(v0[0], v0[1]); w.y = cvt_pk_bf16(v0[2], v0[3]); w.z = cvt_pk_bf16(v1[0], v1[1]); w.w = cvt_pk_bf16(v1[2], v1[3]);
                    __builtin_amdgcn_raw_buffer_store_b128(w, rq, vo, so + ((bj * 2048 + ai * HALF + m * 16) << 7) * 2, 0); } }
    }
};

struct EpiQKV4 {
    static constexpr bool PERM = false, AFTER_DRAIN = false;
    bf16_t* Q; const float* rs; float qscale, wscale;
    __device__ __forceinline__ void operator()(const f32x4 (&acc)[2][2][4][2], const Unit& u, int wr, int wc, int fr, int fq) const {
        EPI_FRESH_LANE();
        const rsrc_t rq = mkrsrc(Q, 3u * 16384u * 4096u * 2u), rr = mkrsrc(rs, 16384u * 4u);
        const int colt = u.pn * BM, which = colt >> 12, cw = colt & 4095, gt = cw >> 7;
        const int b = (u.pm * BM) >> 11, st = (u.pm * BM) & 2047;
        const float sc = (which == 0 ? qscale : 1.f) * wscale;
        const int so = (int)(((unsigned)which << 26) + (((unsigned)(b * 32 + gt) * 2048u + (unsigned)st) << 7)) * 2;
        const int vo8 = (((wr * 64 + fr) << 7) + wc * 32 + (fq & 1) * 16 + (fq >> 1) * 8) * 2, vr = (wr * 64 + fr) * 4, sr = u.pm * BM * 4;
        unsigned rsv[2][4];
#pragma unroll
        for (int ai = 0; ai < 2; ++ai)
#pragma unroll
            for (int m = 0; m < 4; ++m) rsv[ai][m] = __builtin_amdgcn_raw_buffer_load_b32(rr, vr, sr + (ai * HALF + m * 16) * 4, 0);
#pragma unroll
        for (int ai = 0; ai < 2; ++ai)
#pragma unroll
            for (int m = 0; m < 4; ++m) { const float f = sc * __builtin_bit_cast(float, rsv[ai][m]);
#pragma unroll
                for (int bj = 0; bj < 2; ++bj) {
                    const f32x4 v0 = acc[ai][bj][m][0] * f, v1 = acc[ai][bj][m][1] * f;
                    const u32x4 w16 = widen_pair(cvt_pk_bf16(v0[0], v0[1]), cvt_pk_bf16(v0[2], v0[3]), cvt_pk_bf16(v1[0], v1[1]), cvt_pk_bf16(v1[2], v1[3]), 16 * fq + fr, fq);
                    __builtin_amdgcn_raw_buffer_store_b128(w16, rq, vo8, so + (((bj * 2048 + ai * HALF + m * 16) << 7)) * 2, 0); } }
    }
};

typedef int i32x8 __attribute__((ext_vector_type(8)));
template <bool F8> struct FragT { typedef bf16x8 type; };
template <> struct FragT<true> { typedef i32x8 type; };
__device__ __forceinline__ f32x4 mma_bf16(bf16x8 a, bf16x8 b, f32x4 c) { return __builtin_amdgcn_mfma_f32_16x16x32_bf16(a, b, c, 0, 0, 0); }
__device__ __forceinline__ f32x4 mma_bf16(i32x8, i32x8, f32x4 c) { return c; }
template <class Epi, class Sched, bool ALIGN_EPI = false, bool SP2 = false, bool F8 = false>
__device__ __forceinline__ void gemm_phase(PG8_LAS unsigned char* lds, const Gemm g, const Sched& S, const Epi& E, int tid_in) {
    int tid_ = tid_in;
    const int tid = tid_, wid = __builtin_amdgcn_readfirstlane(tid >> 6), lane = tid & 63, wr = wid >> 2, wc = wid & 3, fr = lane & 15, fq = lane >> 4;
    constexpr int EB = F8 ? 1 : 2;
    constexpr int K = 4096; constexpr int nt = (K * EB) / (BK * 2);
    unsigned voffA[2], voffB[2];
#pragma unroll
    for (int i = 0; i < 2; ++i) { int R, C; stage_rc(tid * 16 + i * 8192, R, C); const int Rb = Epi::PERM ? ((R & ~31) + perm32(R & 31)) : R;
        voffA[i] = (unsigned)(R * K * EB + C * 2); voffB[i] = (unsigned)(Rb * K * EB + C * 2); }
    const size_t kstep = (size_t)(BK * 2);
    const size_t hstep = (size_t)HALF * K * EB;
    const size_t tstep = 2 * hstep;
    const unsigned ldsw = (unsigned)wid * 1024u;
    const int aoff = F8 ? lds_byte(wr * 64 + fr, fq * 16) + (fq & 1) * 16 : lds_byte(wr * 64 + fr, fq * 8), boff = F8 ? lds_byte(wc * 32 + fr, fq * 16) + (fq & 1) * 16 : lds_byte(wc * 32 + fr, fq * 8);
    const int aoff1 = aoff + (F8 ? 16 - 32 * (fq & 1) : 0);
    const int f8o0_unused = 0; (void)f8o0_unused;
#define PG8_SA(b, h) (((b) * 2 + (h)) * HTB)
#define PG8_SB(b, h) ((4 + (b) * 2 + (h)) * HTB)
#define PG8_STAGE_X(bufoff, gbase, voff, rs_, base_) do { const int so_ = (int)((const char*)(gbase) - (const char*)(base_)); _Pragma("unroll") for (int _i = 0; _i < 2; ++_i) \
        __builtin_amdgcn_raw_ptr_buffer_load_lds(rs_, (PG8_LAS void*)(lds + (bufoff) + ldsw + _i * 8192), 16, (int)(voff)[_i], so_, 0, 0); } while (0)
#define PG8_LDA(dst, b, h) do { if constexpr (F8) { _Pragma("unroll") for (int m = 0; m < 4; ++m) { const u32x4 lo_ = *(const PG8_LAS u32x4*)(lds + PG8_SA(b, h) + aoff + m * 2048), hi_ = *(const PG8_LAS u32x4*)(lds + PG8_SA(b, h) + aoff1 + m * 2048); \
            dst[m][0] = (i32x8){(int)lo_[0], (int)lo_[1], (int)lo_[2], (int)lo_[3], (int)hi_[0], (int)hi_[1], (int)hi_[2], (int)hi_[3]}; } } \
        else { _Pragma("unroll") for (int m = 0; m < 4; ++m) _Pragma("unroll") for (int k = 0; k < 2; ++k) dst[m][k] = *(const PG8_LAS frag_t*)(lds + PG8_SA(b, h) + aoff + m * 2048 + k * 1024); } } while (0)
#define PG8_LDB(dst, b, h) do { if constexpr (F8) { _Pragma("unroll") for (int n = 0; n < 2; ++n) { const u32x4 lo_ = *(const PG8_LAS u32x4*)(lds + PG8_SB(b, h) + boff + n * 2048), hi_ = *(const PG8_LAS u32x4*)(lds + PG8_SB(b, h) + boff + (aoff1 - aoff) + n * 2048); \
            dst[n][0] = (i32x8){(int)lo_[0], (int)lo_[1], (int)lo_[2], (int)lo_[3], (int)hi_[0], (int)hi_[1], (int)hi_[2], (int)hi_[3]}; } } \
        else { _Pragma("unroll") for (int n = 0; n < 2; ++n) _Pragma("unroll") for (int k = 0; k < 2; ++k) dst[n][k] = *(const PG8_LAS frag_t*)(lds + PG8_SB(b, h) + boff + n * 2048 + k * 1024); } } while (0)
#define PG8_MMA(ai, bj, At, Bt) do { __builtin_amdgcn_s_setprio(1); _Pragma("unroll") for (int m = 0; m < 4; ++m) _Pragma("unroll") for (int n = 0; n < 2; ++n) { \
        if constexpr (F8) acc[ai][bj][m][n] = __builtin_amdgcn_mfma_scale_f32_16x16x128_f8f6f4(Bt[n][0], At[m][0], acc[ai][bj][m][n], 0, 0, 0, 0x7f7f7f7f, 0, 0x7f7f7f7f); \
        else { _Pragma("unroll") for (int k = 0; k < 2; ++k) acc[ai][bj][m][n] = mma_bf16(Bt[n][k], At[m][k], acc[ai][bj][m][n]); } } __builtin_amdgcn_s_setprio(0); } while (0)
#define PG8_WAIT_V(n) asm volatile("s_waitcnt vmcnt(" #n ")" ::: "memory")
#define PG8_WAIT_L(n) asm volatile("s_waitcnt lgkmcnt(" #n ")" ::: "memory")
#define PG8_BAR __builtin_amdgcn_s_barrier()
#define PG8_SCHED __builtin_amdgcn_sched_barrier(0)
    const __amdgpu_buffer_rsrc_t rsA = __builtin_amdgcn_make_buffer_rsrc((void*)g.A, (short)0, (int)((size_t)g.M * K * EB), 0x00020000), rsB = __builtin_amdgcn_make_buffer_rsrc((void*)g.Bt, (short)0, (int)((size_t)g.N * K * EB), 0x00020000);
    Unit cur, nxt; int ui = 0;
    if (!S.next(0, cur)) return;
    f32x4 acc[2][2][4][2];
#pragma unroll
    for (int a = 0; a < 2; ++a)
#pragma unroll
        for (int b = 0; b < 2; ++b)
#pragma unroll
            for (int m = 0; m < 4; ++m)
#pragma unroll
                for (int n = 0; n < 2; ++n) acc[a][b][m][n] = (f32x4){0.f, 0.f, 0.f, 0.f};
    typedef typename FragT<F8>::type frag_t;
    frag_t At[4][F8 ? 1 : 2], B0[2][F8 ? 1 : 2], B1[2][F8 ? 1 : 2];
    const char* cA = (const char*)g.A + (size_t)cur.pm * tstep; const char* cB = (const char*)g.Bt + (size_t)cur.pn * tstep;
    S.a_ready(cur);
    if constexpr (SP2) {
        PG8_STAGE_X(PG8_SB(0, 0), cB, voffB, rsB, g.Bt); PG8_STAGE_X(PG8_SB(0, 1), cB + hstep, voffB, rsB, g.Bt); PG8_STAGE_X(PG8_SA(0, 0), cA, voffA, rsA, g.A); PG8_STAGE_X(PG8_SA(0, 1), cA + hstep, voffA, rsA, g.A);
        if (wr == 1) PG8_BAR;
        PG8_WAIT_V(2); PG8_BAR;
        PG8_STAGE_X(PG8_SB(1, 0), cB + kstep, voffB, rsB, g.Bt); PG8_STAGE_X(PG8_SA(1, 0), cA + kstep, voffA, rsA, g.A); PG8_STAGE_X(PG8_SB(1, 1), cB + hstep + kstep, voffB, rsB, g.Bt);
        PG8_WAIT_V(6); PG8_BAR;
    } else {
        PG8_STAGE_X(PG8_SB(0, 0), cB, voffB, rsB, g.Bt); PG8_STAGE_X(PG8_SA(0, 0), cA, voffA, rsA, g.A); PG8_STAGE_X(PG8_SB(0, 1), cB + hstep, voffB, rsB, g.Bt); PG8_STAGE_X(PG8_SA(0, 1), cA + hstep, voffA, rsA, g.A);
        if (wr == 1) PG8_BAR;
        PG8_WAIT_V(4); PG8_BAR;
        PG8_STAGE_X(PG8_SB(1, 0), cB + kstep, voffB, rsB, g.Bt); PG8_STAGE_X(PG8_SA(1, 0), cA + kstep, voffA, rsA, g.A); PG8_STAGE_X(PG8_SB(1, 1), cB + hstep + kstep, voffB, rsB, g.Bt);
        PG8_WAIT_V(6); PG8_BAR;
    }
    for (;;) {
        const bool has_next = S.next(ui + 1, nxt);
        const char* nA = has_next ? (const char*)g.A + (size_t)nxt.pm * tstep : cA; const char* nB = has_next ? (const char*)g.Bt + (size_t)nxt.pn * tstep : cB;
        for (int t = 0; t < nt; t += 2) {
            const bool last = (t == nt - 2);
            const char* a1 = cA + (size_t)(t + 1) * kstep;
            const char* a2 = last ? nA : cA + (size_t)(t + 2) * kstep; const char* b2 = last ? nB : cB + (size_t)(t + 2) * kstep;
            const char* a3 = a2 + kstep; const char* b3 = b2 + kstep;
            if (last && has_next) S.a_ready(nxt);
            if constexpr (SP2) {
            PG8_LDB(B0, 0, 0); PG8_LDB(B1, 0, 1); PG8_SCHED; PG8_LDA(At, 0, 0); PG8_STAGE_X(PG8_SA(1, 1), a1 + hstep, voffA, rsA, g.A);
            PG8_WAIT_V(8); PG8_WAIT_L(0); PG8_BAR; PG8_MMA(0, 0, At, B0); PG8_MMA(0, 1, At, B1); PG8_BAR; PG8_SCHED;
            PG8_LDA(At, 0, 1); PG8_STAGE_X(PG8_SB(0, 0), b2, voffB, rsB, g.Bt); PG8_STAGE_X(PG8_SB(0, 1), b2 + hstep, voffB, rsB, g.Bt); PG8_STAGE_X(PG8_SA(0, 0), a2, voffA, rsA, g.A);
            PG8_WAIT_V(8); PG8_WAIT_L(0); PG8_BAR; PG8_MMA(1, 0, At, B0); PG8_MMA(1, 1, At, B1); PG8_BAR; PG8_SCHED;
            PG8_LDB(B0, 1, 0); PG8_LDB(B1, 1, 1); PG8_SCHED; PG8_LDA(At, 1, 0); PG8_STAGE_X(PG8_SA(0, 1), a2 + hstep, voffA, rsA, g.A);
            PG8_WAIT_V(8); PG8_WAIT_L(0); PG8_BAR; PG8_MMA(0, 0, At, B0); PG8_MMA(0, 1, At, B1); PG8_BAR; PG8_SCHED;
            PG8_LDA(At, 1, 1); PG8_STAGE_X(PG8_SB(1, 0), b3, voffB, rsB, g.Bt); PG8_STAGE_X(PG8_SB(1, 1), b3 + hstep, voffB, rsB, g.Bt); PG8_STAGE_X(PG8_SA(1, 0), a3, voffA, rsA, g.A);
            PG8_WAIT_V(8); PG8_WAIT_L(0); PG8_BAR; PG8_MMA(1, 0, At, B0); PG8_MMA(1, 1, At, B1); PG8_BAR; PG8_SCHED;
            } else {
            PG8_LDB(B0, 0, 0); PG8_SCHED; PG8_LDA(At, 0, 0); PG8_STAGE_X(PG8_SA(1, 1), a1 + hstep, voffA, rsA, g.A);
            PG8_WAIT_L(8); PG8_BAR; PG8_WAIT_L(0); PG8_MMA(0, 0, At, B0); PG8_BAR; PG8_SCHED;
            PG8_LDB(B1, 0, 1); PG8_STAGE_X(PG8_SB(0, 0), b2, voffB, rsB, g.Bt);
            PG8_BAR; PG8_WAIT_L(0); PG8_MMA(0, 1, At, B1); PG8_BAR;
            PG8_LDA(At, 0, 1); PG8_STAGE_X(PG8_SA(0, 0), a2, voffA, rsA, g.A);
            PG8_BAR; PG8_WAIT_L(0); PG8_MMA(1, 0, At, B0); PG8_BAR; PG8_SCHED;
            PG8_STAGE_X(PG8_SB(0, 1), b2 + hstep, voffB, rsB, g.Bt);
            PG8_WAIT_V(6); PG8_BAR; PG8_MMA(1, 1, At, B1); PG8_BAR;
            PG8_LDB(B0, 1, 0); PG8_SCHED; PG8_LDA(At, 1, 0); PG8_STAGE_X(PG8_SA(0, 1), a2 + hstep, voffA, rsA, g.A);
            PG8_WAIT_L(8); PG8_BAR; PG8_WAIT_L(0); PG8_MMA(0, 0, At, B0); PG8_BAR; PG8_SCHED;
            PG8_LDB(B1, 1, 1); PG8_STAGE_X(PG8_SB(1, 0), b3, voffB, rsB, g.Bt);
            PG8_BAR; PG8_WAIT_L(0); PG8_MMA(0, 1, At, B1); PG8_BAR;
            PG8_LDA(At, 1, 1); PG8_STAGE_X(PG8_SA(1, 0), a3, voffA, rsA, g.A);
            PG8_BAR; PG8_WAIT_L(0); PG8_MMA(1, 0, At, B0); PG8_BAR; PG8_SCHED;
            PG8_STAGE_X(PG8_SB(1, 1), b3 + hstep, voffB, rsB, g.Bt);
            PG8_WAIT_V(6); PG8_BAR; PG8_MMA(1, 1, At, B1); PG8_BAR;
            }
        }
        if constexpr (ALIGN_EPI) { if (wr == 0) PG8_BAR; }
        if constexpr (!Epi::AFTER_DRAIN) { E(acc, cur, wr, wc, fr, fq); S.done(cur); }
        if (!has_next) break;
#pragma unroll
        for (int a = 0; a < 2; ++a)
#pragma unroll
            for (int b = 0; b < 2; ++b)
#pragma unroll
                for (int m = 0; m < 4; ++m)
#pragma unroll
                    for (int n = 0; n < 2; ++n) acc[a][b][m][n] = (f32x4){0.f, 0.f, 0.f, 0.f};
        cur = nxt; cA = nA; cB = nB; ++ui;
        if constexpr (ALIGN_EPI) { if (wr == 1) PG8_BAR; }
    }
    PG8_WAIT_V(0);
    if constexpr (!ALIGN_EPI) { if (wr == 0) PG8_BAR; }
    PG8_BAR;
    if constexpr (Epi::AFTER_DRAIN) { E.fused(acc, cur, wr, wc, fr, fq, lds, wid, lane); S.done(cur); }
#undef PG8_SA
#undef PG8_SB
#undef PG8_STAGE_X
#undef PG8_LDA
#undef PG8_LDB
#undef PG8_MMA
#undef PG8_WAIT_V
#undef PG8_WAIT_L
#undef PG8_BAR
#undef PG8_SCHED
}
}
#define GAS __attribute__((address_space(1)))
#define LAS __attribute__((address_space(3)))
typedef unsigned short bf16_t;
typedef unsigned u32x4 __attribute__((ext_vector_type(4)));
typedef unsigned u32x2 __attribute__((ext_vector_type(2)));
typedef float f32x4 __attribute__((ext_vector_type(4)));
typedef float f32x2 __attribute__((ext_vector_type(2)));
typedef float f32x16 __attribute__((ext_vector_type(16)));
typedef short bf16x8 __attribute__((ext_vector_type(8)));
typedef short s16x4 __attribute__((ext_vector_type(4)));
typedef __bf16 bf16x2_t __attribute__((ext_vector_type(2)));
typedef unsigned u32x6 __attribute__((ext_vector_type(6)));
typedef int i32x8 __attribute__((ext_vector_type(8)));
typedef unsigned u32x16 __attribute__((ext_vector_type(16)));
typedef float f32x32 __attribute__((ext_vector_type(32)));
typedef _Float16 f16x32 __attribute__((ext_vector_type(32)));
typedef _Float16 f16x2 __attribute__((ext_vector_type(2)));

namespace mk {
constexpr int M = 16384, D = 4096, S = 2048, NB = 8, PW = 12298, NH = 32, NE = 16384;
constexpr int NWAVES = 8;
constexpr size_t MiB = 1u << 20;
constexpr size_t WS_CTL = 0, CTL_ZERO_BYTES = 1 * MiB;
constexpr size_t WS_RSTD = 2 * MiB, WS_LOGF = 3 * MiB, WS_WQK = 4 * MiB, WS_WOUT = 20 * MiB, WS_WIN = 52 * MiB, WS_U16 = 148 * MiB, WS_V16 = 276 * MiB,
                 WS_XB = 404 * MiB, WS_Q = 532 * MiB, WS_K = 660 * MiB, WS_V = 788 * MiB, WS_OB = 916 * MiB, WS_X2 = 1792 * MiB, WS_END = 2048 * MiB;
constexpr size_t WS_L1 = 1920 * MiB;
__host__ __device__ constexpr size_t ws_wqk(int l) { return l ? WS_L1 : WS_WQK; }
__host__ __device__ constexpr size_t ws_wout(int l) { return l ? WS_L1 + 16 * MiB : WS_WOUT; }
__host__ __device__ constexpr size_t ws_win(int l) { return l ? WS_L1 + 32 * MiB : WS_WIN; }
__host__ __device__ constexpr size_t ws_tab(int l) { return l ? WS_V16 : WS_U16; }
constexpr size_t WS_XB8N = WS_OB + 64 * MiB;
constexpr size_t WS_SC = WS_Q;
constexpr int CW_BAR = 4096;
constexpr int CW_QUEUE = 16384;
constexpr int RING_BYTES = 131072, LDSCTL_OFF = RING_BYTES, MISC_OFF = LDSCTL_OFF + 320, LDS_BYTES = 147456;

struct Args { const float* in[13]; float* out; unsigned char* ws; int ph_lo, ph_hi; };

__device__ __forceinline__ unsigned f2bf(float f) { unsigned u = __builtin_bit_cast(unsigned, f); return (u + 0x7fffu + ((u >> 16) & 1u)) >> 16; }
__device__ __forceinline__ unsigned pk2(float lo, float hi) { return f2bf(lo) | (f2bf(hi) << 16); }
__device__ __forceinline__ float bf_lo(unsigned w) { return __builtin_bit_cast(float, w << 16); }
__device__ __forceinline__ float bf_hi(unsigned w) { return __builtin_bit_cast(float, w & 0xffff0000u); }
__device__ __forceinline__ float lane_read(float v, int src_lane) { return __builtin_bit_cast(float, __builtin_amdgcn_ds_bpermute(src_lane << 2, __builtin_bit_cast(int, v))); }
__device__ __forceinline__ int lane_read(int v, int src_lane) { return __builtin_amdgcn_ds_bpermute(src_lane << 2, v); }
constexpr float US = 1024.0f, VS = 32.0f, US_INV = 1.0f / 1024.0f, VS_INV = 1.0f / 32.0f;
constexpr int REC4 = 4096;
constexpr int ROW4 = 2048;
#define FP4X_(j) ((j) < 16 ? a0[((j) & 15) >> 2][(j) & 3] : a1[((j) & 15) >> 2][(j) & 3])
__device__ __forceinline__ u32x4 pack_fp4(const f32x4 (&a0)[4], const f32x4 (&a1)[4], float inv) {
    unsigned o[4];
#pragma unroll
    for (int w = 0; w < 4; ++w) { unsigned v = 0u;
        v = __builtin_amdgcn_cvt_scalef32_pk_fp4_f32(v, FP4X_(8 * w + 0) * inv, FP4X_(8 * w + 1) * inv, 1.0f, 0); v = __builtin_amdgcn_cvt_scalef32_pk_fp4_f32(v, FP4X_(8 * w + 2) * inv, FP4X_(8 * w + 3) * inv, 1.0f, 1);
        v = __builtin_amdgcn_cvt_scalef32_pk_fp4_f32(v, FP4X_(8 * w + 4) * inv, FP4X_(8 * w + 5) * inv, 1.0f, 2); v = __builtin_amdgcn_cvt_scalef32_pk_fp4_f32(v, FP4X_(8 * w + 6) * inv, FP4X_(8 * w + 7) * inv, 1.0f, 3);
        o[w] = v; }
    return (u32x4){o[0], o[1], o[2], o[3]};
}
#undef FP4X_
__device__ __forceinline__ float clamp8(float x) { return fminf(fmaxf(x, -224.0f), 224.0f); }
__device__ __forceinline__ float logsig(float z) { return fminf(z, 0.f) - 0.6931471805599453f * __builtin_amdgcn_logf(1.0f + __builtin_amdgcn_exp2f(-fabsf(z) * 1.4426950408889634f)); }
__device__ __forceinline__ float gelu_erf(float v) {
    const float av = fabsf(v), t = __builtin_amdgcn_rcpf(av * 0.2316418882f + 1.0f);
    float q = t * 0.5307027145f + (-0.7265760135f); q = q * t + 0.7107068705f; q = q * t + (-0.142248368f); q = q * t + 0.127414796f; q = q * t;
    const float e = __builtin_amdgcn_exp2f((v * v) * (-0.72134752044f));
    const float m = v * (q * e);
    return v < 0.f ? m : v - m;
}
#define LDS_WAIT() asm volatile("s_waitcnt lgkmcnt(0)" ::: "memory")
#define FRESH_LDS(l) do { unsigned v_ = (unsigned)(size_t)(l); asm volatile("" : "+s"(v_)); (l) = (LAS unsigned char*)(size_t)v_; } while (0)
#define FRESH_BID() int bid = blockIdx.x, G = gridDim.x; asm volatile("" : "+s"(bid), "+s"(G))
#define FRESH_TID() int tid; { int w_ = wave0, l_; { unsigned z_ = 0u; asm volatile("" : "+v"(z_)); l_ = (int)__builtin_amdgcn_mbcnt_hi(~0u, __builtin_amdgcn_mbcnt_lo(~0u, z_)); } asm volatile("" : "+s"(w_)); tid = w_ * 64 + l_; } const int lane = tid & 63, wave = __builtin_amdgcn_readfirstlane(tid >> 6); (void)lane; (void)wave

__device__ __forceinline__ unsigned wave_max_u32(unsigned v) {
    v = max(v, (unsigned)__builtin_amdgcn_update_dpp(0, (int)v, 0x111, 0xF, 0xF, true));
    v = max(v, (unsigned)__builtin_amdgcn_update_dpp(0, (int)v, 0x112, 0xF, 0xF, true));
    v = max(v, (unsigned)__builtin_amdgcn_update_dpp(0, (int)v, 0x114, 0xF, 0xF, true));
    v = max(v, (unsigned)__builtin_amdgcn_update_dpp(0, (int)v, 0x118, 0xF, 0xF, true));
    v = max(v, (unsigned)__builtin_amdgcn_update_dpp((int)v, (int)v, 0x142, 0xA, 0xF, false));
    v = max(v, (unsigned)__builtin_amdgcn_update_dpp((int)v, (int)v, 0x143, 0xC, 0xF, false));
    return (unsigned)__builtin_amdgcn_readlane((int)v, 63);
}
__device__ __forceinline__ float wave_sum_dpp(float x) {
    int v = __builtin_bit_cast(int, x);
#define DPP_ADD(ctrl, rm, bc, oldv) v = __builtin_bit_cast(int, __builtin_bit_cast(float, v) + __builtin_bit_cast(float, __builtin_amdgcn_update_dpp(oldv, v, ctrl, rm, 0xF, bc)))
    DPP_ADD(0x111, 0xF, true, 0); DPP_ADD(0x112, 0xF, true, 0); DPP_ADD(0x114, 0xF, true, 0); DPP_ADD(0x118, 0xF, true, 0);
#undef DPP_ADD
    const float r0 = __builtin_bit_cast(float, __builtin_amdgcn_readlane(v, 15)), r1 = __builtin_bit_cast(float, __builtin_amdgcn_readlane(v, 31)), r2 = __builtin_bit_cast(float, __builtin_amdgcn_readlane(v, 47)), r3 = __builtin_bit_cast(float, __builtin_amdgcn_readlane(v, 63));
    return (r0 + r1) + (r2 + r3);
}
__device__ __forceinline__ unsigned ordkey(float x) { const unsigned u = __builtin_bit_cast(unsigned, x); return (u & 0x80000000u) ? ~u : (u | 0x80000000u); }
__device__ __forceinline__ void transpose_item(const float* W, int K, int ldw, int ncols, const float* gain, bf16_t* WT, LAS float* scr, int item, int lane) {
    const int nblk = ncols / 32, kb = item / nblk, nb = item % nblk, k0 = 64 * kb, n0 = 32 * nb;
#pragma unroll 8
    for (int i = 0; i < 32; ++i) { const int kk = 2 * i + (lane >> 5); float v = W[(size_t)(k0 + kk) * ldw + n0 + (lane & 31)]; if (gain) v *= gain[k0 + kk]; scr[kk * 33 + (lane & 31)] = v; }
    LDS_WAIT(); asm volatile("" ::: "memory");
    const int c = lane & 7;
#pragma unroll
    for (int j = 0; j < 4; ++j) { const int n = (lane >> 3) + 8 * j; const LAS float* s = scr + (8 * c) * 33 + n;
        u32x4 o; o.x = pk2(s[0 * 33], s[1 * 33]); o.y = pk2(s[2 * 33], s[3 * 33]); o.z = pk2(s[4 * 33], s[5 * 33]); o.w = pk2(s[6 * 33], s[7 * 33]);
        *(u32x4*)(WT + (size_t)(n0 + n) * K + k0 + 8 * c) = o; }
    LDS_WAIT(); asm volatile("" ::: "memory");
}

typedef const __attribute__((address_space(4))) Args* KArgsT;
__device__ __forceinline__ unsigned pk4_fp8(float a, float b, float c, float d) { int p = __builtin_amdgcn_cvt_pk_fp8_f32(clamp8(a), clamp8(b), 0, false); p = __builtin_amdgcn_cvt_pk_fp8_f32(clamp8(c), clamp8(d), p, true); return (unsigned)p; }
__device__ __forceinline__ void transpose_item8(const float* W, int K, int ldw, int ncols, const float* gain, float scale, unsigned char* WT, LAS float* scr, int item, int lane) {
    const int nblk = ncols / 32, kb = item / nblk, nb = item % nblk, k0 = 64 * kb, n0 = 32 * nb;
    const int kr = lane >> 3, nq = (lane & 7) * 4;
    f32x4 v[8];
#pragma unroll
    for (int i = 0; i < 8; ++i) { const float* p = W + (size_t)(k0 + 8 * i + kr) * ldw + n0 + nq; v[i] = (f32x4){p[0], p[1], p[2], p[3]}; }
#pragma unroll
    for (int i = 0; i < 8; ++i) { const int kk = 8 * i + kr; const float g = (gain ? gain[k0 + kk] : 1.0f) * scale; LAS float* d = scr + kk * 33 + nq; d[0] = v[i][0] * g; d[1] = v[i][1] * g; d[2] = v[i][2] * g; d[3] = v[i][3] * g; }
    LDS_WAIT(); asm volatile("" ::: "memory");
    const int c = lane & 7;
#pragma unroll
    for (int j = 0; j < 4; ++j) { const int n = (lane >> 3) + 8 * j; const LAS float* s = scr + (8 * c) * 33 + n;
        u32x2 o; o.x = pk4_fp8(s[0 * 33], s[1 * 33], s[2 * 33], s[3 * 33]); o.y = pk4_fp8(s[4 * 33], s[5 * 33], s[6 * 33], s[7 * 33]);
        *(u32x2*)(WT + (size_t)(n0 + n) * K + k0 + 8 * c) = o; }
    LDS_WAIT(); asm volatile("" ::: "memory");
}
__device__ __forceinline__ void conv_phase(KArgsT ka, int l, LAS unsigned char* lds, int wave0) {
    FRESH_TID(); FRESH_LDS(lds); FRESH_BID();
    unsigned char* ws = ka->ws;
    const float* ln1 = ka->in[1] + (size_t)l * D; const float* w_in = ka->in[2] + (size_t)l * D * PW; const float* w_out = ka->in[5] + (size_t)l * D * D;
    const float* ln2 = ka->in[6] + (size_t)l * D; const float* wq = ka->in[7] + (size_t)l * D * 2048;
    const float* k1 = ka->in[8] + (size_t)l * 8 * 128 * 128; const float* k2 = ka->in[9] + (size_t)l * 8 * 128 * 128;
    const float* pu = ka->in[10] + (size_t)l * NE * D; const float* pv = ka->in[11] + (size_t)l * NE * D;
    bf16_t* WQK = (bf16_t*)(ws + ws_wqk(l)); bf16_t* WOUT = (bf16_t*)(ws + ws_wout(l)); bf16_t* WIN = (bf16_t*)(ws + ws_win(l)); bf16_t* U16 = (bf16_t*)(ws + ws_tab(l));
    {
        LAS float* Ks = (LAS float*)lds;
        LAS float* Ws = (LAS float*)(lds + 128 * 132 * 4);
        const int IPB = (1024 + G - 1) / G, it0 = bid * IPB, it1 = min(1024, it0 + IPB);
        int gi_cur = -1; f32x4 pre[4];
        if (it0 < it1) {
#pragma unroll
            for (int m = 0; m < 4; ++m) { const int i = tid + 512 * m, r = i >> 5, c4 = (i & 31) * 4; pre[m] = *(const f32x4*)(wq + (size_t)((it0 & 63) * 64 + r) * 2048 + (it0 >> 6) * 128 + c4); } }
        for (int it = it0; it < it1; ++it) {
            const int gi = it >> 6, c0 = (it & 63) * 64;
            __syncthreads();
            if (gi != gi_cur) { gi_cur = gi;
                const float* key = ((gi & 1) ? k2 : k1) + (size_t)(gi >> 1) * 128 * 128;
                for (int i = tid; i < 4096; i += 512) { const int r = i >> 5, c4 = (i & 31) * 4; *(LAS f32x4*)(Ks + r * 132 + c4) = *(const f32x4*)(key + r * 128 + c4); } }
#pragma unroll
            for (int m = 0; m < 4; ++m) { const int i = tid + 512 * m, r = i >> 5, c4 = (i & 31) * 4; *(LAS f32x4*)(Ws + r * 132 + c4) = pre[m]; }
            __syncthreads();
            if (it + 1 < it1) {
#pragma unroll
                for (int m = 0; m < 4; ++m) { const int i = tid + 512 * m, r = i >> 5, c4 = (i & 31) * 4; pre[m] = *(const f32x4*)(wq + (size_t)(((it + 1) & 63) * 64 + r) * 2048 + ((it + 1) >> 6) * 128 + c4); } }
            const int ti = wave & 3, tj = wave >> 2, li = lane & 31, kh = lane >> 5;
            const LAS float* ap = Ks + (32 * ti + li) * 132 + 64 * kh; const LAS float* bp = Ws + (32 * tj + li) * 132 + 64 * kh;
            f32x16 acc;
#pragma unroll
            for (int r = 0; r < 16; ++r) acc[r] = 0.f;
#pragma unroll 4
            for (int s4 = 0; s4 < 16; ++s4) { const f32x4 a4 = *(const LAS f32x4*)(ap + 4 * s4), b4 = *(const LAS f32x4*)(bp + 4 * s4);
                acc = __builtin_amdgcn_mfma_f32_32x32x2f32(a4[0], b4[0], acc, 0, 0, 0); acc = __builtin_amdgcn_mfma_f32_32x32x2f32(a4[1], b4[1], acc, 0, 0, 0);
                acc = __builtin_amdgcn_mfma_f32_32x32x2f32(a4[2], b4[2], acc, 0, 0, 0); acc = __builtin_amdgcn_mfma_f32_32x32x2f32(a4[3], b4[3], acc, 0, 0, 0); }
            { const int c = c0 + 32 * tj + li; const float gg = ln2[c];
#pragma unroll
              for (int r = 0; r < 16; ++r) { const int n = 32 * ti + (r & 3) + 8 * (r >> 2) + 4 * kh; WQK[(size_t)(gi * 128 + n) * D + c] = (bf16_t)f2bf(acc[r] * gg); } }
        }
        __syncthreads();
    }
    const int gw = bid * NWAVES + wave, NGW = G * NWAVES;
    {
        unsigned char* U6 = (unsigned char*)U16; unsigned char* V4 = U6 + ROW4; float* SCU = (float*)(U6 + (size_t)NE * REC4); float* SCV = SCU + NE;
        f32x4 gq[4][4];
#pragma unroll
        for (int i = 0; i < 4; ++i)
#pragma unroll
            for (int m = 0; m < 4; ++m) gq[i][m] = *(const f32x4*)(ln2 + 1024 * i + 256 * m + 4 * lane);
        f32x4 uu[4][4], vv[4][4];
        const unsigned hm_ = (lane & 1) ? 65536u : 1u;
#define LDROW_(dst, src, rr) do { const float* p_ = (src) + (size_t)(rr) * D + 4 * lane; _Pragma("unroll") for (int i = 0; i < 4; ++i) _Pragma("unroll") for (int m = 0; m < 4; ++m) dst[i][m] = *(const f32x4*)(p_ + 1024 * i + 256 * m); } while (0)
#define H16_(v, inv) ((__builtin_amdgcn_cvt_scalef32_pk_fp4_f32(__builtin_amdgcn_cvt_scalef32_pk_fp4_f32(0u, (v)[0] * (inv), (v)[1] * (inv), 1.0f, 0), (v)[2] * (inv), (v)[3] * (inv), 1.0f, 1) & 0xffffu) * hm_)
#define QSWAP1_(x) ((unsigned)__builtin_amdgcn_update_dpp(0, (int)(x), 0xB1, 0xF, 0xF, false))
#define QSWAP2_(x) ((unsigned)__builtin_amdgcn_update_dpp(0, (int)(x), 0x4E, 0xF, 0xF, false))
#define PUTROW_(src, tab, rr, inv) do { _Pragma("unroll") for (int j = 0; j < 2; ++j) _Pragma("unroll") for (int m = 0; m < 4; ++m) { \
            unsigned da_ = H16_(src[2 * j][m], inv), db_ = H16_(src[2 * j + 1][m], inv); da_ |= QSWAP1_(da_); db_ |= QSWAP1_(db_); \
            const unsigned oa_ = QSWAP2_(da_), ob_ = QSWAP2_(db_); \
            if ((lane & 3) == 0) *(u32x4*)((tab) + (size_t)(rr) * REC4 + j * 1024 + 16 * (16 * m + (lane >> 2))) = (u32x4){da_, oa_, db_, ob_}; } } while (0)
        if (gw < NE) { LDROW_(uu, pu, gw); LDROW_(vv, pv, gw); }
        for (int r = gw; r < NE; r += NGW) {
            const int rn = r + NGW;
            { float au = 0.f;
#pragma unroll
              for (int i = 0; i < 4; ++i)
#pragma unroll
                  for (int m = 0; m < 4; ++m) { uu[i][m] *= gq[i][m]; au += (uu[i][m][0] * uu[i][m][0] + uu[i][m][1] * uu[i][m][1]) + (uu[i][m][2] * uu[i][m][2] + uu[i][m][3] * uu[i][m][3]); }
              au = sqrtf(wave_sum_dpp(au) * (1.0f / D)); const float iu = au > 0.f ? 2.0f / au : 0.f;
              if (lane == 0) SCU[r] = au * 0.5f;
              PUTROW_(uu, U6, r, iu); }
            if (rn < NE) LDROW_(uu, pu, rn);
            { float av = 0.f;
#pragma unroll
              for (int i = 0; i < 4; ++i)
#pragma unroll
                  for (int m = 0; m < 4; ++m) av += (vv[i][m][0] * vv[i][m][0] + vv[i][m][1] * vv[i][m][1]) + (vv[i][m][2] * vv[i][m][2] + vv[i][m][3] * vv[i][m][3]);
              av = sqrtf(wave_sum_dpp(av) * (1.0f / D)); const float iv = av > 0.f ? 2.0f / av : 0.f;
              if (lane == 0) SCV[r] = av * 0.5f;
              PUTROW_(vv, V4, r, iv); }
            if (rn < NE) LDROW_(vv, pv, rn);
        }
#undef LDROW_
#undef H16_
#undef QSWAP1_
#undef QSWAP2_
#undef PUTROW_
    }
    {
        LAS float* scr = (LAS float*)(lds + wave * 16384);
        constexpr int I_O = (D / 64) * (D / 32), I_IN = (D / 64) * (12288 / 32);
        for (int it = gw; it < I_O + I_IN; it += NGW) {
            if (it < I_O) transpose_item8(w_out, D, D, D, nullptr, US, (unsigned char*)WOUT, scr, it, lane);
            else transpose_item8(w_in, D, PW, 12288, ln1, US, (unsigned char*)WIN, scr, it - I_O, lane);
        }
    }
}

template <bool WITH_F>
__device__ __forceinline__ void prep_phase(const float* X, bf16_t* XB, float* RSTD, const float* w_in, const float* ln1, const float* bf, float* LOGF, LAS unsigned char* lds, int wave0) {
    FRESH_TID(); FRESH_LDS(lds); FRESH_BID();
    LAS unsigned short* gfs = (LAS unsigned short*)lds;
    if (WITH_F) {
        __syncthreads();
        for (int c = tid; c < D; c += 512) { const float g = ln1[c]; const float* wr = w_in + (size_t)c * PW + 12288;
#pragma unroll
            for (int j = 0; j < 10; ++j) gfs[j * D + c] = (unsigned short)f2bf(wr[j] * g); }
        __syncthreads();
    }
    const int gw = bid * NWAVES + wave, NGW = G * NWAVES;
    for (int m = gw; m < M; m += NGW) {
        const f32x4* xr = (const f32x4*)(X + (size_t)m * D) + lane;
        f32x4 v[16]; float ss = 0.f;
#pragma unroll
        for (int i = 0; i < 16; ++i) { v[i] = xr[64 * i]; ss += (v[i][0] * v[i][0] + v[i][1] * v[i][1]) + (v[i][2] * v[i][2] + v[i][3] * v[i][3]); }
        ss = wave_sum_dpp(ss);
        const float rstd = rsqrtf(ss * (1.0f / D) + 1e-6f);
        if (WITH_F) {
            unsigned* o8 = (unsigned*)((unsigned char*)XB + (size_t)m * D) + lane;
#pragma unroll
            for (int i = 0; i < 16; ++i) o8[64 * i] = pk4_fp8(v[i][0], v[i][1], v[i][2], v[i][3]);
        } else {
        u32x2* o = (u32x2*)(XB + (size_t)m * D) + lane;
#pragma unroll
        for (int i = 0; i < 16; ++i) { u32x2 w; w.x = pk2(v[i][0], v[i][1]); w.y = pk2(v[i][2], v[i][3]); o[64 * i] = w; }
        }
        if (lane == 0) RSTD[m] = rstd;
        if (WITH_F) {
            float mine = 0.f;
#pragma unroll 1
            for (int j = 0; j < 10; ++j) { float s = 0.f;
#pragma unroll
                for (int i = 0; i < 16; ++i) { const u32x2 gp = *(const LAS u32x2*)(gfs + j * D + 256 * i + 4 * lane);
                    s += (v[i][0] * bf_lo(gp.x) + v[i][1] * bf_hi(gp.x)) + (v[i][2] * bf_lo(gp.y) + v[i][3] * bf_hi(gp.y)); }
                s = wave_sum_dpp(s); if (lane == j) mine = s; }
            if (lane < 10) { const int b = m >> 11, s = m & 2047; LOGF[(size_t)(b * 10 + lane) * S + s] = logsig(mine * rstd + bf[lane]); }
        }
    }
}


__device__ __forceinline__ void load16_bf16(const bf16_t* p, float (&d)[16]) {
    const u32x4 a = *(const u32x4*)p, b = *(const u32x4*)(p + 8);
#pragma unroll
    for (int q = 0; q < 4; ++q) { d[2 * q] = bf_lo(a[q]); d[2 * q + 1] = bf_hi(a[q]); d[8 + 2 * q] = bf_lo(b[q]); d[8 + 2 * q + 1] = bf_hi(b[q]); }
}
#define RFL(x) __builtin_amdgcn_readfirstlane(x)
template <bool FINAL>
__device__ __forceinline__ void peer_uv_phase(const float* SC, const unsigned char* T4, const bf16_t* X1, void* XOv, const float* fg,
                                              unsigned char* XB8n, float* RSTDn, float* LOGFn, const float* w_in_n, const float* ln1_n, const float* bf_n, LAS unsigned char* lds, int wave0) {
    FRESH_TID(); FRESH_LDS(lds); FRESH_BID();
    LAS int* s_eid = (LAS int*)(lds + 81920 + wave * 1024); LAS float* s_w = (LAS float*)(lds + 81920 + wave * 1024 + 512); LAS float* s_su = (LAS float*)(lds + 90112 + wave * 512);
    const float* SCU = (const float*)(T4 + (size_t)NE * REC4); const float* SCV = SCU + NE;
    LAS unsigned short* gfs = (LAS unsigned short*)lds;
    if (!FINAL) {
        __syncthreads();
        for (int c = tid; c < D; c += 512) { const float g = ln1_n[c]; const float* wr = w_in_n + (size_t)c * PW + 12288;
#pragma unroll
            for (int j = 0; j < 10; ++j) gfs[j * D + c] = (unsigned short)f2bf(wr[j] * g); }
        __syncthreads();
    }
    const int gw = bid * NWAVES + wave, NGW = G * NWAVES;
    for (int tok = gw; tok < M; tok += NGW) {
        const bf16_t* x1 = X1 + (size_t)tok * D;
        i32x8 xq[2]; float rstd_tok;
        { const int sg_ = lane & 15, gp_ = lane >> 4; float t[2][2][16]; float ss_ = 0.f;
#pragma unroll
          for (int s2 = 0; s2 < 2; ++s2)
#pragma unroll
              for (int hf = 0; hf < 2; ++hf) { load16_bf16(x1 + 1024 * (2 * s2 + (gp_ & 1)) + 16 * (sg_ + 32 * hf + 16 * (gp_ >> 1)), t[s2][hf]);
#pragma unroll
                  for (int k = 0; k < 16; ++k) ss_ += t[s2][hf][k] * t[s2][hf][k]; }
          rstd_tok = rsqrtf(wave_sum_dpp(ss_) * (1.0f / D) + 1e-6f);
#pragma unroll
          for (int s2 = 0; s2 < 2; ++s2)
#pragma unroll
              for (int hf = 0; hf < 2; ++hf)
#pragma unroll
                  for (int q = 0; q < 4; ++q) xq[s2][4 * hf + q] = (int)pk4_fp8(t[s2][hf][4 * q] * rstd_tok, t[s2][hf][4 * q + 1] * rstd_tok, t[s2][hf][4 * q + 2] * rstd_tok, t[s2][hf][4 * q + 3] * rstd_tok); }
        const float* sc = SC + (size_t)tok * 2048;
        LAS float* selv = (LAS float*)(lds + 94208 + wave * 512); LAS int* seli = (LAS int*)(lds + 94208 + wave * 512 + 256);
#define BALLOT(c) __builtin_amdgcn_ballot_w64(c)
#define MBCNT(m) ((int)__builtin_amdgcn_mbcnt_hi((unsigned)((m) >> 32), __builtin_amdgcn_mbcnt_lo((unsigned)(m), 0u)))
        for (int h = 0; h < 4; ++h) {
            float x[2][2][2]; unsigned kk[2][2][2];
#pragma unroll
            for (int u = 0; u < 2; ++u)
#pragma unroll
                for (int f = 0; f < 2; ++f)
#pragma unroll
                    for (int r = 0; r < 2; ++r) { const float v = sc[(h + 4 * u) * 256 + f * 128 + r * 64 + lane]; x[u][f][r] = v; kk[u][f][r] = (ordkey(v) & ~127u) | (unsigned)(127 - 64 * r - lane); }
            unsigned T[2][2] = {{0u, 0u}, {0u, 0u}}; int dn = 0;
            for (unsigned bm = 0x80000000u; bm != 0u && dn != 15; bm >>= 1) {
#pragma unroll
                for (int u = 0; u < 2; ++u)
#pragma unroll
                    for (int f = 0; f < 2; ++f) { const unsigned cand = T[u][f] | bm;
                        const int c = __builtin_popcountll(BALLOT(kk[u][f][0] >= cand)) + __builtin_popcountll(BALLOT(kk[u][f][1] >= cand));
                        T[u][f] = c >= 16 ? cand : T[u][f]; dn |= (c == 16) ? (1 << (2 * u + f)) : 0; }
            }
#pragma unroll
            for (int u = 0; u < 2; ++u)
#pragma unroll
                for (int f = 0; f < 2; ++f) { const bool s0 = kk[u][f][0] >= T[u][f], s1 = kk[u][f][1] >= T[u][f]; const unsigned long long m0 = BALLOT(s0), m1 = BALLOT(s1);
                    const int p0 = MBCNT(m0), p1 = __builtin_popcountll(m0) + MBCNT(m1);
                    if (s0) { selv[(2 * u + f) * 16 + (p0 & 15)] = x[u][f][0]; seli[(2 * u + f) * 16 + (p0 & 15)] = lane; }
                    if (s1) { selv[(2 * u + f) * 16 + (p1 & 15)] = x[u][f][1]; seli[(2 * u + f) * 16 + (p1 & 15)] = 64 + lane; } }
            asm volatile("" ::: "memory");
            float s4[2][4]; unsigned k4[2][4];
#pragma unroll
            for (int u = 0; u < 2; ++u) { const float va = selv[(2 * u) * 16 + (lane >> 2)]; const f32x4 vb = *(const LAS f32x4*)(selv + (2 * u + 1) * 16 + (lane & 3) * 4);
#pragma unroll
                for (int q = 0; q < 4; ++q) { s4[u][q] = va + vb[q]; k4[u][q] = (ordkey(s4[u][q]) & ~255u) | (unsigned)(255 - 4 * lane - q); } }
            unsigned T2[2] = {0u, 0u}; int d2 = 0;
            for (unsigned bm = 0x80000000u; bm != 0u && d2 != 3; bm >>= 1) {
#pragma unroll
                for (int u = 0; u < 2; ++u) { const unsigned cand = T2[u] | bm;
                    const int c = (__builtin_popcountll(BALLOT(k4[u][0] >= cand)) + __builtin_popcountll(BALLOT(k4[u][1] >= cand))) + (__builtin_popcountll(BALLOT(k4[u][2] >= cand)) + __builtin_popcountll(BALLOT(k4[u][3] >= cand)));
                    T2[u] = c >= 16 ? cand : T2[u]; d2 |= (c == 16) ? (1 << u) : 0; }
            }
#pragma unroll
            for (int u = 0; u < 2; ++u) {
                const unsigned mk = wave_max_u32(max(max(k4[u][0], k4[u][1]), max(k4[u][2], k4[u][3]))) & ~255u;
                const float mx = __builtin_bit_cast(float, (mk & 0x80000000u) ? (mk & 0x7fffffffu) : ~mk);
                const float cs = 1.4426950408889634f * rstd_tok;
                float p[4], ps = 0.f;
#pragma unroll
                for (int q = 0; q < 4; ++q) { p[q] = (k4[u][q] >= T2[u]) ? __builtin_amdgcn_exp2f((s4[u][q] - mx) * cs) : 0.f; ps += p[q]; }
                const float tot = wave_sum_dpp(ps);
                const int i1 = seli[(2 * u) * 16 + (lane >> 2)]; const u32x4 i2 = *(const LAS u32x4*)(seli + (2 * u + 1) * 16 + (lane & 3) * 4);
                int base = (h + 4 * u) * 16;
#pragma unroll
                for (int q = 0; q < 4; ++q) { const bool sl = k4[u][q] >= T2[u]; const unsigned long long m = BALLOT(sl); const int slot = base + (MBCNT(m) & 15); base += __builtin_popcountll(m);
                    if (sl) { const int e = ((i1 & 127) << 7) | (int)(i2[q] & 127u); s_eid[slot] = e; s_w[slot] = p[q] / tot * SCV[e]; s_su[slot] = SCU[e]; } }
            }
            asm volatile("" ::: "memory");
        }
#undef BALLOT
#undef MBCNT
        LDS_WAIT(); asm volatile("" ::: "memory");
        {
            f32x2 acc2[2][16];
#define ACC(i, k) acc2[(i) >> 1][((i) & 1) * 8 + ((k) >> 1)][(k) & 1]
#pragma unroll
            for (int g = 0; g < 2; ++g)
#pragma unroll
                for (int k = 0; k < 16; ++k) acc2[g][k] = (f32x2){0.f, 0.f};
            const bool dg_ = ((lane & 15) >> 2) == (lane >> 4);
            const float mk0_ = (dg_ && (lane & 3) == 0) ? 1.f : 0.f, mk1_ = (dg_ && (lane & 3) == 1) ? 1.f : 0.f, mk2_ = (dg_ && (lane & 3) == 2) ? 1.f : 0.f, mk3_ = (dg_ && (lane & 3) == 3) ? 1.f : 0.f;
#define LOADREC4(dst, e) do { const u32x4* p_ = (const u32x4*)(T4 + (size_t)(e) * REC4) + lane; dst[0] = p_[0]; dst[1] = p_[64]; dst[2] = p_[128]; dst[3] = p_[192]; } while (0)
#define PROW4(row, j) do { f32x4 ac_ = {0.f, 0.f, 0.f, 0.f}; \
            ac_ = __builtin_amdgcn_mfma_scale_f32_16x16x128_f8f6f4((i32x8){(int)row[0][0], (int)row[0][1], (int)row[0][2], (int)row[0][3], 0, 0, 0, 0}, xq[0], ac_, 4, 0, 0, 0x7f7f7f7f, 0, 0x7f7f7f7f); \
            ac_ = __builtin_amdgcn_mfma_scale_f32_16x16x128_f8f6f4((i32x8){(int)row[1][0], (int)row[1][1], (int)row[1][2], (int)row[1][3], 0, 0, 0, 0}, xq[1], ac_, 4, 0, 0, 0x7f7f7f7f, 0, 0x7f7f7f7f); \
            const float pv_ = (ac_[0] * mk0_ + ac_[1] * mk1_) + (ac_[2] * mk2_ + ac_[3] * mk3_); \
            const float d_ = wave_sum_dpp(pv_) * s_su[j]; const float w_ = s_w[j] * gelu_erf(d_); const f32x2 w2_ = {w_, w_}; \
            _Pragma("unroll") for (int g_ = 0; g_ < 2; ++g_) { \
                u32x4 G_ = row[2 + g_]; asm volatile("" : "+v"(G_)); \
                _Pragma("unroll") for (int k_ = 0; k_ < 4; ++k_) { const unsigned d4_ = G_[k_]; \
                    acc2[g_][4 * k_] = __builtin_elementwise_fma(w2_, __builtin_amdgcn_cvt_scalef32_pk_f32_fp4(d4_, 1.0f, 0), acc2[g_][4 * k_]); acc2[g_][4 * k_ + 1] = __builtin_elementwise_fma(w2_, __builtin_amdgcn_cvt_scalef32_pk_f32_fp4(d4_, 1.0f, 1), acc2[g_][4 * k_ + 1]); \
                    acc2[g_][4 * k_ + 2] = __builtin_elementwise_fma(w2_, __builtin_amdgcn_cvt_scalef32_pk_f32_fp4(d4_, 1.0f, 2), acc2[g_][4 * k_ + 2]); acc2[g_][4 * k_ + 3] = __builtin_elementwise_fma(w2_, __builtin_amdgcn_cvt_scalef32_pk_f32_fp4(d4_, 1.0f, 3), acc2[g_][4 * k_ + 3]); } \
                asm volatile("" : "+v"(acc2[g_][0]), "+v"(acc2[g_][1]), "+v"(acc2[g_][2]), "+v"(acc2[g_][3]), "+v"(acc2[g_][4]), "+v"(acc2[g_][5]), "+v"(acc2[g_][6]), "+v"(acc2[g_][7]), \
                                  "+v"(acc2[g_][8]), "+v"(acc2[g_][9]), "+v"(acc2[g_][10]), "+v"(acc2[g_][11]), "+v"(acc2[g_][12]), "+v"(acc2[g_][13]), "+v"(acc2[g_][14]), "+v"(acc2[g_][15])); } } while (0)
            u32x4 r0[4], r1[4], r2[4], r3[4];
            { const int e_ = RFL(s_eid[0]); LOADREC4(r0, e_); } { const int e_ = RFL(s_eid[1]); LOADREC4(r1, e_); } { const int e_ = RFL(s_eid[2]); LOADREC4(r2, e_); } { const int e_ = RFL(s_eid[3]); LOADREC4(r3, e_); }
            for (int j = 0; j < 124; j += 4) {
                PROW4(r0, j + 0); { const int e_ = RFL(s_eid[j + 4]); LOADREC4(r0, e_); }
                PROW4(r1, j + 1); { const int e_ = RFL(s_eid[j + 5]); LOADREC4(r1, e_); }
                PROW4(r2, j + 2); { const int e_ = RFL(s_eid[j + 6]); LOADREC4(r2, e_); }
                PROW4(r3, j + 3); { const int e_ = RFL(s_eid[j + 7]); LOADREC4(r3, e_); }
            }
            PROW4(r0, 124); PROW4(r1, 125); PROW4(r2, 126); PROW4(r3, 127);
#undef PROW4
#undef LOADREC4
            float ss = 0.f;
#pragma unroll
            for (int i = 0; i < 4; ++i) { float t[16]; load16_bf16(x1 + 1024 * i + 16 * lane, t);
#pragma unroll
                for (int k = 0; k < 16; ++k) { ACC(i, k) += t[k]; ss += ACC(i, k) * ACC(i, k); } }
            ss = wave_sum_dpp(ss);
            const float rs = rsqrtf(ss * (1.0f / D) + 1e-6f);
            if (!FINAL) {
#pragma unroll
                for (int i = 0; i < 4; ++i) { u32x4 w8;
#pragma unroll
                    for (int q = 0; q < 4; ++q) w8[q] = pk4_fp8(ACC(i, 4 * q), ACC(i, 4 * q + 1), ACC(i, 4 * q + 2), ACC(i, 4 * q + 3));
                    *(u32x4*)(XB8n + (size_t)tok * D + 1024 * i + 16 * lane) = w8; }
                if (lane == 0) RSTDn[tok] = rs;
                float mine = 0.f;
#pragma unroll 1
                for (int j = 0; j < 10; ++j) { float s = 0.f;
#pragma unroll
                    for (int i = 0; i < 4; ++i) { const u32x4 g0 = *(const LAS u32x4*)(gfs + j * D + 1024 * i + 16 * lane), g1 = *(const LAS u32x4*)(gfs + j * D + 1024 * i + 16 * lane + 8);
#pragma unroll
                        for (int q = 0; q < 4; ++q) { s += ACC(i, 2 * q) * bf_lo(g0[q]) + ACC(i, 2 * q + 1) * bf_hi(g0[q]); s += ACC(i, 8 + 2 * q) * bf_lo(g1[q]) + ACC(i, 8 + 2 * q + 1) * bf_hi(g1[q]); } }
                    s = wave_sum_dpp(s); if (lane == j) mine = s; }
                if (lane < 10) { const int b_ = tok >> 11, s_ = tok & 2047; LOGFn[(size_t)(b_ * 10 + lane) * S + s_] = logsig(mine * rs + bf_n[lane]); }
            }
            if (FINAL) { float* xo = (float*)XOv + (size_t)tok * D;
#pragma unroll
                for (int i = 0; i < 4; ++i)
#pragma unroll
                    for (int q = 0; q < 4; ++q) { const int c = 1024 * i + 16 * lane + 4 * q; const f32x4 g_ = *(const f32x4*)(fg + c);
                        *(f32x4*)(xo + c) = (f32x4){ACC(i, 4 * q) * rs * g_[0], ACC(i, 4 * q + 1) * rs * g_[1], ACC(i, 4 * q + 2) * rs * g_[2], ACC(i, 4 * q + 3) * rs * g_[3]}; }
            } else { bf16_t* xo = (bf16_t*)XOv + (size_t)tok * D;
#pragma unroll
                for (int i = 0; i < 4; ++i) { u32x4 w0, w1;
#pragma unroll
                    for (int q = 0; q < 4; ++q) { w0[q] = pk2(ACC(i, 2 * q), ACC(i, 2 * q + 1)); w1[q] = pk2(ACC(i, 8 + 2 * q), ACC(i, 8 + 2 * q + 1)); }
                    *(u32x4*)(xo + 1024 * i + 16 * lane) = w0; *(u32x4*)(xo + 1024 * i + 16 * lane + 8) = w1; }
            }
        }
        LDS_WAIT(); asm volatile("" ::: "memory");
    }
#undef ACC
}
}
namespace at {
using namespace mk;
constexpr int QB = 256, KVB = 64, HD = 128;
constexpr int SHM_V = KVB * HD * 2, SHM_K = KVB * HD * 2;
constexpr int OFF_V = 0, OFF_K = 2 * SHM_V, OFF_WS = OFF_K + 2 * SHM_K, OFF_CUM = OFF_WS + 8 * 256, OFF_RT = OFF_CUM + 2048 * 4, OFF_MISC = OFF_RT + 640 * 4;
constexpr float LOG2E = 1.4426950408889634f;
constexpr float THR2 = 10.0f;
constexpr float SB_DONE = -100.0f;

#define AT_KSWZ(row, colB) ((row) * 256 + ((colB) ^ (((row) & 7) << 4)))
__device__ __forceinline__ int v_st(int k, int c) { const int kk = (k & ~0xC) | ((k & 4) << 1) | ((k & 8) >> 1); return ((kk >> 3) * 4 + (c >> 5)) * 512 + ((kk & 7) * 32 + (c & 31)) * 2; }
__device__ __forceinline__ int v_rd_base(int lane) { return ((lane & 3) << 3) | (((lane >> 2) & 3) << 6) | (((lane >> 4) & 1) << 5) | (((lane >> 5) & 1) << 8); }
constexpr int v_rd_off(int d0, int ks, int half) { return d0 * 512 + ks * 4096 + half * 2048; }
__device__ __forceinline__ int crow(int r, int hi) { return (r & 3) + 8 * (r >> 2) + 4 * hi; }
__device__ __forceinline__ unsigned cvtpk(float lo, float hi) { typedef __bf16 b2_t __attribute__((ext_vector_type(2))); const b2_t v = {(__bf16)lo, (__bf16)hi}; return __builtin_bit_cast(unsigned, v); }
__device__ __forceinline__ float partner(float v, int hi) { auto rr = __builtin_amdgcn_permlane32_swap(__builtin_bit_cast(unsigned, v), __builtin_bit_cast(unsigned, v), false, false); return __builtin_bit_cast(float, hi ? rr[0] : rr[1]); }

__device__ __forceinline__ float xchg_max(float v, int hi) { return fmaxf(v, partner(v, hi)); }
__device__ __forceinline__ float xchg_sum(float v, int hi) { return v + partner(v, hi); }

__device__ __forceinline__ void pack_p(const f32x16& p0, const f32x16& p1, bf16x8& pa0, bf16x8& pa1, bf16x8& pa2, bf16x8& pa3) {
#define AT_PK4(P, B_, OUT) do { unsigned a0 = cvtpk(P[B_ + 0], P[B_ + 1]), a1 = cvtpk(P[B_ + 2], P[B_ + 3]); unsigned b0 = cvtpk(P[B_ + 4], P[B_ + 5]), b1 = cvtpk(P[B_ + 6], P[B_ + 7]); \
        auto r0 = __builtin_amdgcn_permlane32_swap(a0, b0, false, false); auto r1 = __builtin_amdgcn_permlane32_swap(a1, b1, false, false); \
        u32x4 w = {r0[0], r1[0], r0[1], r1[1]}; OUT = __builtin_bit_cast(bf16x8, w); } while (0)
    AT_PK4(p0, 0, pa0); AT_PK4(p0, 8, pa1); AT_PK4(p1, 0, pa2); AT_PK4(p1, 8, pa3);
#undef AT_PK4
}
template <int KBUF>
__device__ __forceinline__ void qkt(f32x16& p0, f32x16& p1, LAS unsigned char* K_lds, int r32, int hi, const bf16x8 (&qr)[8]) {
    p0 = f32x16{}; p1 = f32x16{};
    LAS unsigned char* kb[4];
#pragma unroll
    for (int dd = 0; dd < 4; ++dd) kb[dd] = K_lds + KBUF * SHM_K + AT_KSWZ(r32, (dd * 16 + hi * 8) * 2);
#pragma unroll
    for (int d0 = 0; d0 < 8; ++d0) { LAS unsigned char* a = kb[d0 & 3] + (d0 >> 2) * 128;
        const bf16x8 b0 = *(const LAS bf16x8*)a; const bf16x8 b1 = *(const LAS bf16x8*)(a + 32 * 256);
        p0 = __builtin_amdgcn_mfma_f32_32x32x16_bf16(b0, qr[d0], p0, 0, 0, 0);
        p1 = __builtin_amdgcn_mfma_f32_32x32x16_bf16(b1, qr[d0], p1, 0, 0, 0); }
}
template <int VBUF>
__device__ __forceinline__ void pv_tile(f32x16 (&o)[4], int vb0, bf16x8 pa0, bf16x8 pa1, bf16x8 pa2, bf16x8 pa3) {
#define AT_TRRD(dst, off) asm volatile("ds_read_b64_tr_b16 %0, %1 offset:%2" : "=&v"(dst) : "v"(vb0), "i"(off) : "memory")
#define AT_PV_D0(d0) do { s16x4 l0, l1, l2, l3, h0, h1, h2, h3; constexpr int b_ = VBUF * SHM_V + v_rd_off(d0, 0, 0); \
        AT_TRRD(l0, b_); AT_TRRD(h0, b_ + 2048); AT_TRRD(l1, b_ + 4096); AT_TRRD(h1, b_ + 6144); AT_TRRD(l2, b_ + 8192); AT_TRRD(h2, b_ + 10240); AT_TRRD(l3, b_ + 12288); AT_TRRD(h3, b_ + 14336); \
        asm volatile("s_waitcnt lgkmcnt(0)" ::: "memory"); __builtin_amdgcn_sched_barrier(0); \
        o[d0] = __builtin_amdgcn_mfma_f32_32x32x16_bf16(pa0, (bf16x8){l0[0], l0[1], l0[2], l0[3], h0[0], h0[1], h0[2], h0[3]}, o[d0], 0, 0, 0); \
        o[d0] = __builtin_amdgcn_mfma_f32_32x32x16_bf16(pa1, (bf16x8){l1[0], l1[1], l1[2], l1[3], h1[0], h1[1], h1[2], h1[3]}, o[d0], 0, 0, 0); \
        o[d0] = __builtin_amdgcn_mfma_f32_32x32x16_bf16(pa2, (bf16x8){l2[0], l2[1], l2[2], l2[3], h2[0], h2[1], h2[2], h2[3]}, o[d0], 0, 0, 0); \
        o[d0] = __builtin_amdgcn_mfma_f32_32x32x16_bf16(pa3, (bf16x8){l3[0], l3[1], l3[2], l3[3], h3[0], h3[1], h3[2], h3[3]}, o[d0], 0, 0, 0); } while (0)
    AT_PV_D0(0); AT_PV_D0(1); AT_PV_D0(2); AT_PV_D0(3);
#undef AT_PV_D0
#undef AT_TRRD
}

template <int VAR>
__device__ __forceinline__ void attn_item(const bf16_t* Qh, const bf16_t* Kh, const bf16_t* Vh, bf16_t* OB, const float* relb, const float* LOGF, int b, int h, int qb, LAS unsigned char* lds, int tid) {
    const int wid = __builtin_amdgcn_readfirstlane(tid >> 6), lane = tid & 63, r32 = lane & 31, hi = lane >> 5;
    const int g = VAR == 0 ? h : (VAR == 1 ? 12 + h : 22 + h);
    const size_t hb = (size_t)(b * NH + g) * S * HD;
    const bf16_t* Kp = Kh + hb; const bf16_t* Vp = Vh + hb;
    LAS unsigned char* V_lds = lds + OFF_V; LAS unsigned char* K_lds = lds + OFF_K;
    LAS float* wsf = (LAS float*)(lds + OFF_WS) + wid * 64; LAS float* li_l = wsf; LAS float* al_l = wsf + 32;
    LAS float* cumL = (LAS float*)(lds + OFF_CUM); LAS float* Rt = (LAS float*)(lds + OFF_RT); volatile LAS unsigned* flags = (volatile LAS unsigned*)(lds + OFF_MISC);
    const int P0 = qb * QB, qlo = P0 + wid * 32, qpos = qlo + r32;
    int NT, jlo = 0;
    if (VAR == 0) { jlo = 4 * qb - 8; if (jlo < 0) jlo = 0; NT = 4 * qb + 4 - jlo; } else NT = 4 * qb + 4;
    const int cw = 4 * qb + (wid >> 1);
#define AT_KBASE(t) (VAR == 1 ? (4 * qb + 3 - (t)) * KVB : (jlo + (t)) * KVB)
#define AT_ACT(t) (VAR == 0 ? ((jlo + (t)) >= cw - 8 && (jlo + (t)) <= cw) : (VAR == 1 ? (AT_KBASE(t) <= qlo + 30) : (AT_KBASE(t) <= qlo + 31)))
    if (VAR == 0) {
        const float* tab = relb + h * 257;
        for (int j = tid; j < 639; j += 512) { int rel = 575 - j; rel = rel < -128 ? -128 : (rel > 128 ? 128 : rel); Rt[j] = tab[rel + 128] * LOG2E; }
    }
    if (VAR == 2) {
        const float* lf = LOGF + (size_t)(b * 10 + h) * S; const int kend = P0 + QB;
        f32x4 v = (f32x4){0.f, 0.f, 0.f, 0.f};
        if (4 * tid < kend) v = *(const f32x4*)(lf + 4 * tid);
        v[1] += v[0]; v[2] += v[1]; v[3] += v[2];
        float tot = v[3];
#pragma unroll
        for (int o = 1; o < 64; o <<= 1) { const float t_ = lane_read(tot, lane >= o ? lane - o : lane); if (lane >= o) tot += t_; }
        if (lane == 63) li_l[0] = tot;
        __syncthreads();
        float base = tot - v[3];
        for (int w = 0; w < wid; ++w) base += ((LAS float*)(lds + OFF_WS))[w * 64];
        if (4 * tid < kend) *(LAS f32x4*)(cumL + 4 * tid) = (f32x4){(base + v[0]) * LOG2E, (base + v[1]) * LOG2E, (base + v[2]) * LOG2E, (base + v[3]) * LOG2E};
    }
    bf16x8 qr[8];
    { const bf16_t* qp = Qh + hb + (size_t)(qlo + r32) * HD + hi * 8;
#pragma unroll
      for (int d0 = 0; d0 < 8; ++d0) qr[d0] = *(const bf16x8*)(qp + d0 * 16); }
    const int sr = tid >> 4, sc = (tid & 15) * 8, vst0 = v_st(sr, sc), vst1 = v_st(32 + sr, sc), kws = AT_KSWZ(sr, sc * 2);
    const int vb0 = (int)(unsigned)(size_t)V_lds + v_rd_base(lane);
    bf16x8 st_k0, st_k1, st_v0, st_v1;
#define AT_SLOAD(k0) do { const bf16_t* kp_ = Kp + (size_t)((k0) + sr) * HD + sc; const bf16_t* vp_ = Vp + (size_t)((k0) + sr) * HD + sc; \
        st_k0 = *(const bf16x8*)kp_; st_k1 = *(const bf16x8*)(kp_ + 32 * HD); st_v0 = *(const bf16x8*)vp_; st_v1 = *(const bf16x8*)(vp_ + 32 * HD); } while (0)
#define AT_SWRITE(bf) do { *(LAS bf16x8*)(K_lds + (bf) * SHM_K + kws) = st_k0; *(LAS bf16x8*)(K_lds + (bf) * SHM_K + kws + 32 * 256) = st_k1; \
        *(LAS bf16x8*)(V_lds + (bf) * SHM_V + vst0) = st_v0; *(LAS bf16x8*)(V_lds + (bf) * SHM_V + vst1) = st_v1; } while (0)
    AT_SLOAD(AT_KBASE(0)); asm volatile("s_waitcnt vmcnt(0)" ::: "memory"); AT_SWRITE(0);
    __syncthreads();
    float m_reg = -1e30f, l_reg = 0.f, carry = 0.f;
    f32x16 o[4] = {};
#define AT_STEP(BUF, t) do { \
        const bool more_ = (t) + 1 < NT; \
        if (more_) AT_SLOAD(AT_KBASE((t) + 1)); \
        if (AT_ACT(t)) { \
            const int kb_ = AT_KBASE(t); f32x16 p0, p1; bf16x8 pa0, pa1, pa2, pa3; \
            qkt<BUF>(p0, p1, K_lds, r32, hi, qr); \
            tile_math(p0, p1, kb_, pa0, pa1, pa2, pa3); \
            pv_tile<BUF>(o, vb0, pa0, pa1, pa2, pa3); \
        } \
        if (more_) { asm volatile("s_waitcnt vmcnt(0)" ::: "memory"); AT_SWRITE((BUF) ^ 1); } \
        if (VAR == 1) { const bool done_ = __all(carry < SB_DONE); if (lane == 0) flags[((t) & 1) * 8 + wid] = done_ ? 1u : 0u; } \
        __syncthreads(); \
    } while (0)
    auto tile_math = [&](f32x16& p0, f32x16& p1, int kb, bf16x8& pa0, bf16x8& pa1, bf16x8& pa2, bf16x8& pa3) __attribute__((always_inline)) {
        const int dq = qpos - kb - 4 * hi;
        if (VAR == 1) {
            const bool need_mask = kb + 63 >= qlo;
            f32x16 n0, n1;
#pragma unroll
            for (int r = 0; r < 16; ++r) { const float z = p0[r]; const float lp = __builtin_amdgcn_logf(1.0f + __builtin_amdgcn_exp2f(-fabsf(z))); n0[r] = fminf(-z, 0.f) - lp;
                                           const float y = p1[r]; const float lq = __builtin_amdgcn_logf(1.0f + __builtin_amdgcn_exp2f(-fabsf(y))); n1[r] = fminf(-y, 0.f) - lq; }
            if (need_mask) {
#pragma unroll
                for (int r = 0; r < 16; ++r) { const int c = (r & 3) + 8 * (r >> 2);
                    if (dq - c <= 0) { n0[r] = 0.f; p0[r] = -__builtin_inff(); }
                    if (dq - c - 32 <= 0) { n1[r] = 0.f; p1[r] = -__builtin_inff(); } }
            }
            float A[8], Bp[8];
#pragma unroll
            for (int q = 0; q < 4; ++q) { A[q] = (n0[4 * q] + n0[4 * q + 1]) + (n0[4 * q + 2] + n0[4 * q + 3]); A[4 + q] = (n1[4 * q] + n1[4 * q + 1]) + (n1[4 * q + 2] + n1[4 * q + 3]); }
#pragma unroll
            for (int q = 0; q < 8; ++q) Bp[q] = partner(A[q], hi);
            float st = 0.f;
#pragma unroll
            for (int q = 7; q >= 0; --q) {
                const float after = carry + st + (hi == 0 ? Bp[q] : 0.f);
                if (q >= 4) { const int r0 = 4 * (q - 4);
                    float tl = after; p1[r0 + 3] = __builtin_amdgcn_exp2f(p1[r0 + 3] + n1[r0 + 3] + tl); tl += n1[r0 + 3]; p1[r0 + 2] = __builtin_amdgcn_exp2f(p1[r0 + 2] + n1[r0 + 2] + tl); tl += n1[r0 + 2];
                    p1[r0 + 1] = __builtin_amdgcn_exp2f(p1[r0 + 1] + n1[r0 + 1] + tl); tl += n1[r0 + 1]; p1[r0] = __builtin_amdgcn_exp2f(p1[r0] + n1[r0] + tl); }
                else { const int r0 = 4 * q;
                    float tl = after; p0[r0 + 3] = __builtin_amdgcn_exp2f(p0[r0 + 3] + n0[r0 + 3] + tl); tl += n0[r0 + 3]; p0[r0 + 2] = __builtin_amdgcn_exp2f(p0[r0 + 2] + n0[r0 + 2] + tl); tl += n0[r0 + 2];
                    p0[r0 + 1] = __builtin_amdgcn_exp2f(p0[r0 + 1] + n0[r0 + 1] + tl); tl += n0[r0 + 1]; p0[r0] = __builtin_amdgcn_exp2f(p0[r0] + n0[r0] + tl); }
                st += A[q] + Bp[q];
            }
            carry += st;
            pack_p(p0, p1, pa0, pa1, pa2, pa3);
        } else {
            if (VAR == 0) {
                const LAS float* rp = Rt + (575 - (qpos - kb) + 4 * hi);
#pragma unroll
                for (int r = 0; r < 16; ++r) { const int c = (r & 3) + 8 * (r >> 2); p0[r] += rp[c]; p1[r] += rp[c + 32]; }
            } else {
                const LAS float* cp = cumL + kb + 4 * hi;
#pragma unroll
                for (int q = 0; q < 4; ++q) { const f32x4 c0 = *(const LAS f32x4*)(cp + 8 * q), c1 = *(const LAS f32x4*)(cp + 32 + 8 * q);
                    p0[4 * q] -= c0[0]; p0[4 * q + 1] -= c0[1]; p0[4 * q + 2] -= c0[2]; p0[4 * q + 3] -= c0[3];
                    p1[4 * q] -= c1[0]; p1[4 * q + 1] -= c1[1]; p1[4 * q + 2] -= c1[2]; p1[4 * q + 3] -= c1[3]; }
                if (kb + 63 > qlo) {
#pragma unroll
                    for (int r = 0; r < 16; ++r) { const int c = (r & 3) + 8 * (r >> 2);
                        if (dq - c < 0) p0[r] = -__builtin_inff();
                        if (dq - c - 32 < 0) p1[r] = -__builtin_inff(); }
                }
            }
            float pmax = p0[0];
#pragma unroll
            for (int r = 1; r < 16; ++r) pmax = fmaxf(pmax, p0[r]);
#pragma unroll
            for (int r = 0; r < 16; ++r) pmax = fmaxf(pmax, p1[r]);
            pmax = xchg_max(pmax, hi);
            float mn, alpha;
            if (__all(pmax - m_reg <= THR2)) { mn = m_reg; alpha = 1.f; }
            else { mn = fmaxf(m_reg, pmax); alpha = __builtin_amdgcn_exp2f(m_reg - mn); m_reg = mn; }
            float ps = 0.f;
#pragma unroll
            for (int r = 0; r < 16; ++r) { p0[r] = __builtin_amdgcn_exp2f(p0[r] - mn); p1[r] = __builtin_amdgcn_exp2f(p1[r] - mn); ps += p0[r] + p1[r]; }
            ps = xchg_sum(ps, hi);
            l_reg = l_reg * alpha + ps;
            if (__any(alpha < 1.f)) {
                if (hi == 0) al_l[r32] = alpha;
                asm volatile("s_waitcnt lgkmcnt(0)" ::: "memory");
                float av[16];
#pragma unroll
                for (int r = 0; r < 16; ++r) av[r] = al_l[crow(r, hi)];
#pragma unroll
                for (int d = 0; d < 4; ++d)
#pragma unroll
                    for (int r = 0; r < 16; ++r) o[d][r] *= av[r];
            }
            pack_p(p0, p1, pa0, pa1, pa2, pa3);
        }
    };
    for (int t = 0; t < NT; t += 2) {
        AT_STEP(0, t);
        if (VAR == 1) { unsigned all_ = 1u; for (int w = 0; w < 8; ++w) all_ &= flags[(t & 1) * 8 + w]; if (all_) break; }
        if (t + 1 >= NT) break;
        AT_STEP(1, t + 1);
        if (VAR == 1) { unsigned all_ = 1u; for (int w = 0; w < 8; ++w) all_ &= flags[((t + 1) & 1) * 8 + w]; if (all_) break; }
    }
    float rli[16];
    if (VAR != 1) {
        if (hi == 0) li_l[r32] = l_reg;
        asm volatile("s_waitcnt lgkmcnt(0)" ::: "memory");
#pragma unroll
        for (int r = 0; r < 16; ++r) rli[r] = __builtin_amdgcn_rcpf(li_l[crow(r, hi)]);
    }
    unsigned char* Ow8 = (unsigned char*)OB + (size_t)(b * S + qlo) * D + g * HD;
    const unsigned bsel_ = (unsigned)(lane & 3) | ((4u + (unsigned)(lane & 3)) << 8);
#pragma unroll
    for (int r = 0; r < 16; ++r) { const int orow = crow(r, hi); const float sc_ = VAR != 1 ? rli[r] * 16.0f : 16.0f;
        const unsigned w = mk::pk4_fp8(o[0][r] * sc_, o[1][r] * sc_, o[2][r] * sc_, o[3][r] * sc_);
        const unsigned t0 = (unsigned)__builtin_amdgcn_update_dpp(0, (int)w, 0x00, 0xF, 0xF, false), t1 = (unsigned)__builtin_amdgcn_update_dpp(0, (int)w, 0x55, 0xF, 0xF, false),
                       t2 = (unsigned)__builtin_amdgcn_update_dpp(0, (int)w, 0xAA, 0xF, 0xF, false), t3 = (unsigned)__builtin_amdgcn_update_dpp(0, (int)w, 0xFF, 0xF, 0xF, false);
        const unsigned r01 = __builtin_amdgcn_perm(t1, t0, bsel_), r23 = __builtin_amdgcn_perm(t3, t2, bsel_);
        *(unsigned*)(Ow8 + (size_t)orow * D + (lane & 3) * 32 + (r32 & ~3)) = __builtin_amdgcn_perm(r23, r01, 0x05040100u); }
    __syncthreads();
#undef AT_STEP
#undef AT_SLOAD
#undef AT_SWRITE
#undef AT_KBASE
#undef AT_ACT
}

template <int VAR>
__device__ __forceinline__ void attn_queue(const bf16_t* Qh, const bf16_t* Kh, const bf16_t* Vh, bf16_t* OB, const float* relb, const float* LOGF, unsigned* qhead, LAS unsigned char* lds, int wave0) {
    FRESH_TID(); FRESH_LDS(lds);
    volatile LAS unsigned* qslot = (volatile LAS unsigned*)(lds + OFF_MISC) + 32;
    constexpr int NHV = VAR == 0 ? 12 : 10, NITEMS = 8 * NHV * 8;
    for (;;) {
        if (tid == 0) qslot[0] = __hip_atomic_fetch_add(qhead, 1u, __ATOMIC_RELAXED, __HIP_MEMORY_SCOPE_AGENT);
        __syncthreads();
        const int idx = (int)qslot[0];
        __syncthreads();
        if (idx >= NITEMS) break;
        const int qb = 7 - idx / (8 * NHV), bh = idx % (8 * NHV);
        attn_item<VAR>(Qh, Kh, Vh, OB, relb, LOGF, bh / NHV, bh % NHV, qb, lds, tid);
    }
}
__device__ __forceinline__ void attn_phase(const bf16_t* Qh, const bf16_t* Kh, const bf16_t* Vh, bf16_t* OB, const float* relb, const float* LOGF, unsigned* qheads, LAS unsigned char* lds, int wave0, mk::KArgsT ka, int conv_l) {
    int grp = (int)((blockIdx.x >> 3) & 3u); asm volatile("" : "+s"(grp));
    int cnt = 0; bool conv_done = conv_l < 0;
#pragma unroll 1
    for (int seg = 0; seg < 4; ++seg) {
        for (;;) {
            if (!conv_done && (cnt == grp || seg == 3)) { mk::conv_phase(ka, conv_l, lds, wave0); __syncthreads(); conv_done = true; }
            if (seg == 3) break;
            int idx;
            { FRESH_TID(); LAS unsigned char* l_ = lds; FRESH_LDS(l_); volatile LAS unsigned* qslot = (volatile LAS unsigned*)(l_ + OFF_MISC) + 32;
              if (tid == 0) qslot[0] = __hip_atomic_fetch_add(qheads + 64 * seg, 1u, __ATOMIC_RELAXED, __HIP_MEMORY_SCOPE_AGENT);
              __syncthreads();
              idx = (int)qslot[0];
              __syncthreads(); }
            const int NHV = seg == 1 ? 12 : 10;
            if (idx >= 64 * NHV) break;
            ++cnt;
            const int qb = 7 - idx / (8 * NHV), bh = idx % (8 * NHV);
            { FRESH_TID(); LAS unsigned char* l_ = lds; FRESH_LDS(l_);
              if (seg == 0) attn_item<2>(Qh, Kh, Vh, OB, relb, LOGF, bh / NHV, bh % NHV, qb, l_, tid);
              else if (seg == 1) attn_item<0>(Qh, Kh, Vh, OB, relb, LOGF, bh / NHV, bh % NHV, qb, l_, tid);
              else attn_item<1>(Qh, Kh, Vh, OB, relb, LOGF, bh / NHV, bh % NHV, qb, l_, tid); }
        }
    }
}
}
namespace mk {
#define XB_TMO      128
#define XB_XCNT(j)  (256  + 64 * (j))
#define XB_XSUB(j)  (1280 + 64 * (j))
#define XB_XGEN(j)  (2304 + 64 * (j))
#define XB_TOP      3328
#define XB_TOPGEN   3392
#define XCD_BAR_WORDS 3456
#define XB_SPIN_CAP (1u << 22)

__device__ __forceinline__ unsigned xb_ld(unsigned* p)              { return __hip_atomic_load(p, __ATOMIC_RELAXED, __HIP_MEMORY_SCOPE_AGENT); }
__device__ __forceinline__ unsigned xb_add(unsigned* p, unsigned v) { return __hip_atomic_fetch_add(p, v, __ATOMIC_RELAXED, __HIP_MEMORY_SCOPE_AGENT); }
__device__ __forceinline__ unsigned xb_xcc_id() { return (unsigned)__builtin_amdgcn_s_getreg((3 << 11) | 20) & 0xFu; }
#define XB_SPIN(cond, bar) do { unsigned _sp = 0; while (cond) { __builtin_amdgcn_s_sleep(1); \
    if ((++_sp & 255u) == 0u) { if (xb_ld(&(bar)[XB_TMO])) break; if (_sp > XB_SPIN_CAP) { atomicAdd(&(bar)[XB_TMO], 1u); break; } } } } while (0)

struct XcdBarrier {
    unsigned* bar; unsigned x;
    volatile LAS unsigned* st;
};

__device__ __forceinline__ XcdBarrier xcd_barrier_post(unsigned* bar, volatile LAS unsigned* st, bool is_t0) {
    XcdBarrier b; b.bar = bar; b.x = xb_xcc_id(); b.st = st;
    if (is_t0) (void)xb_add(&bar[XB_XCNT(b.x)], 1u);
    return b;
}
__device__ __forceinline__ void xcd_barrier_complete(unsigned* bar, unsigned x, unsigned& nloc, unsigned& nx) {
    const unsigned G = gridDim.x * gridDim.y * gridDim.z;
    unsigned sum, cnt, mine, sp = 0u;
    for (;;) {
        sum = 0u; cnt = 0u; mine = 0u;
#pragma unroll
        for (unsigned j = 0; j < 16; ++j) { const unsigned c = xb_ld(&bar[XB_XCNT(j)]); sum += c; cnt += (c > 0u) ? 1u : 0u; mine = (j == x) ? c : mine; }
        if (sum == G) break;
        __builtin_amdgcn_s_sleep(1);
        if ((++sp & 255u) == 0u) { if (xb_ld(&bar[XB_TMO])) break; if (sp > XB_SPIN_CAP) { atomicAdd(&bar[XB_TMO], 1u); break; } }
    }
    nloc = mine > 0u ? mine : 1u; nx = cnt > 0u ? cnt : 1u;
}

__device__ __forceinline__ void xcd_barrier(const XcdBarrier& b, bool is_t0) {
    asm volatile("s_waitcnt vmcnt(0)" ::: "memory");
    __syncthreads();
    if (is_t0) {
        unsigned* bar = b.bar;
        __builtin_amdgcn_s_waitcnt(0);
        unsigned nloc = b.st[0], nx = b.st[1];
        if (nloc == 0u) { xcd_barrier_complete(bar, b.x, nloc, nx); b.st[0] = nloc; b.st[1] = nx; }
        const unsigned old = xb_add(&bar[XB_XSUB(b.x)], 1u);
        const unsigned gen = old / nloc;
        if (old + 1u == (gen + 1u) * nloc) {
            __builtin_amdgcn_fence(__ATOMIC_RELEASE, "agent");
            asm volatile("s_waitcnt vmcnt(0)" ::: "memory");
            const unsigned og = xb_add(&bar[XB_TOP], 1u);
            const unsigned tg = og / nx;
            if (og + 1u == (tg + 1u) * nx) xb_add(&bar[XB_TOPGEN], 1u);
            else XB_SPIN(xb_ld(&bar[XB_TOPGEN]) == tg, bar);
            __builtin_amdgcn_fence(__ATOMIC_ACQUIRE, "agent");
            xb_add(&bar[XB_XGEN(b.x)], 1u);
            asm volatile("s_waitcnt vmcnt(0)" ::: "memory");
        } else {
            XB_SPIN(xb_ld(&bar[XB_XGEN(b.x)]) == gen, bar);
            __builtin_amdgcn_fence(__ATOMIC_ACQUIRE, "agent");
            asm volatile("s_waitcnt vmcnt(0)" ::: "memory");
        }
    }
    __syncthreads();
}

constexpr int PH_PER_LAYER = 8;
typedef const __attribute__((address_space(4))) Args* KArgs;
#define KARGS() ({ KArgs p_ = (KArgs)__builtin_amdgcn_kernarg_segment_ptr(); asm volatile("" : "+s"(p_)); p_; })
#define GRID_BAR() do { KArgs k_ = KARGS(); XcdBarrier b_; b_.bar = (unsigned*)(k_->ws + WS_CTL) + CW_BAR; b_.x = xb_xcc_id(); b_.st = (volatile LAS unsigned*)(lds + MISC_OFF) + 8; unsigned z_ = 0u; asm volatile("" : "+v"(z_)); const bool t0_ = (wave0 == 0) && (__builtin_amdgcn_mbcnt_hi(~0u, __builtin_amdgcn_mbcnt_lo(~0u, z_)) == 0u);     xcd_barrier(b_, t0_); } while (0)
__global__ void __launch_bounds__(NWAVES * 64, 2) mk_fwd(Args a_unused) {
    extern __shared__ __attribute__((aligned(16))) unsigned char lds_raw[];
    LAS unsigned char* lds = (LAS unsigned char*)lds_raw;
    const int wave0 = __builtin_amdgcn_readfirstlane((int)threadIdx.x >> 6);
    for (int u = threadIdx.x; u < (LDS_BYTES - LDSCTL_OFF) / 4; u += NWAVES * 64) ((LAS unsigned*)(lds + LDSCTL_OFF))[u] = 0u;
    __syncthreads();
    int lo, hi;
    { KArgs k = KARGS(); lo = k->ph_lo; hi = k->ph_hi;
      if (hi - lo > 1) (void)xcd_barrier_post((unsigned*)(k->ws + WS_CTL) + CW_BAR, (volatile LAS unsigned*)(lds + MISC_OFF) + 8, threadIdx.x == 0); }
#define IN(k) (lo <= (k) && (k) < hi)
#define BOTH(k) (IN(k) && IN((k) + 1))
#pragma unroll
    for (int l = 0; l < 2; ++l) {
        const int pb = PH_PER_LAYER * l;
        if (IN(pb + 0) && l == 0) { KArgs k = KARGS(); conv_phase(k, l, lds, wave0); }
        if (IN(pb + 1) && l == 0) {
            KArgs k = KARGS(); unsigned char* ws = k->ws;
            const float* xin = k->in[0];
            prep_phase<true>(xin, (bf16_t*)(ws + WS_XB8N), (float*)(ws + WS_RSTD), k->in[2] + (size_t)l * D * PW, k->in[1] + (size_t)l * D, k->in[3] + l * 10, (float*)(ws + WS_LOGF), lds, wave0);
            if (BOTH(pb + 1)) GRID_BAR();
        }
        if (IN(pb + 2)) {
            KArgs k = KARGS(); unsigned char* ws = k->ws;
            pg8::Gemm g{(const bf16_t*)(ws + WS_XB8N), (const bf16_t*)(ws + ws_win(l)), M, 12288, D}; pg8::StaticOrder So; FRESH_BID(); So.init(M, 12288, G, bid);
            pg8::EpiQKV4 E{(bf16_t*)(ws + WS_Q), (const float*)(ws + WS_RSTD), 0.08838834764831845f * 1.4426950408889634f, US_INV};
            { LAS unsigned char* lds_ = lds; FRESH_LDS(lds_); FRESH_TID(); pg8::gemm_phase<pg8::EpiQKV4, pg8::StaticOrder, true, true, true>(lds_, g, So, E, tid); }
            if (BOTH(pb + 2)) GRID_BAR();
        }
        if (IN(pb + 3)) {
            KArgs k = KARGS(); unsigned char* ws = k->ws;
            at::attn_phase((const bf16_t*)(ws + WS_Q), (const bf16_t*)(ws + WS_K), (const bf16_t*)(ws + WS_V), (bf16_t*)(ws + WS_OB), k->in[4] + (size_t)l * 12 * 257, (const float*)(ws + WS_LOGF),
                           (unsigned*)(ws + WS_CTL) + CW_QUEUE + 256 * l, lds, wave0, k, l == 0 ? 1 : -1);
            if (BOTH(pb + 3)) GRID_BAR();
        }
        if (IN(pb + 4)) {
            KArgs k = KARGS(); unsigned char* ws = k->ws;
            pg8::Gemm g{(const bf16_t*)(ws + WS_OB), (const bf16_t*)(ws + ws_wout(l)), M, D, D}; pg8::StaticOrder So; FRESH_BID(); So.init(M, D, G, bid);
            if (l == 0) { pg8::EpiResidB16<true> E{k->in[0], US_INV * (1.0f / 16.0f), (bf16_t*)(ws + WS_XB)};
                { LAS unsigned char* lds_ = lds; FRESH_LDS(lds_); FRESH_TID(); pg8::gemm_phase<pg8::EpiResidB16<true>, pg8::StaticOrder, false, true, true>(lds_, g, So, E, tid); } }
            else { pg8::EpiResidB16<false> E{ws + WS_X2, US_INV * (1.0f / 16.0f), (bf16_t*)(ws + WS_XB)};
                { LAS unsigned char* lds_ = lds; FRESH_LDS(lds_); FRESH_TID(); pg8::gemm_phase<pg8::EpiResidB16<false>, pg8::StaticOrder, false, true, true>(lds_, g, So, E, tid); } }
            if (BOTH(pb + 4)) GRID_BAR();
        }
        if (IN(pb + 5)) {
            KArgs k = KARGS(); unsigned char* ws = k->ws;
            pg8::Gemm g{(const bf16_t*)(ws + WS_XB), (const bf16_t*)(ws + ws_wqk(l)), M, 2048, D}; pg8::StaticOrder So; FRESH_BID(); So.init(M, 2048, G, bid);
            pg8::EpiPlainF32<2048> E{(float*)(ws + WS_SC)};
            { LAS unsigned char* lds_ = lds; FRESH_LDS(lds_); FRESH_TID(); pg8::gemm_phase<pg8::EpiPlainF32<2048>, pg8::StaticOrder, true, true>(lds_, g, So, E, tid); }
            if (BOTH(pb + 5)) GRID_BAR();
        }
        if (IN(pb + 6)) {
            KArgs k = KARGS(); unsigned char* ws = k->ws;
            if (l == 0) peer_uv_phase<false>((const float*)(ws + WS_SC), (const unsigned char*)(ws + ws_tab(l)), (const bf16_t*)(ws + WS_XB), ws + WS_X2, nullptr,
                                             ws + WS_XB8N, (float*)(ws + WS_RSTD), (float*)(ws + WS_LOGF), k->in[2] + (size_t)D * PW, k->in[1] + D, k->in[3] + 10, lds, wave0);
            else peer_uv_phase<true>((const float*)(ws + WS_SC), (const unsigned char*)(ws + ws_tab(l)), (const bf16_t*)(ws + WS_XB), k->out, k->in[12],
                                     nullptr, nullptr, nullptr, nullptr, nullptr, nullptr, lds, wave0);
            if (BOTH(pb + 7)) GRID_BAR();
        }
    }
#undef IN
#undef BOTH
}

static int g_grid = 0;
static void launch_phases(Args a, int lo, int hi, hipStream_t st) {
    a.ph_lo = lo; a.ph_hi = hi;
    hipLaunchKernelGGL(mk_fwd, dim3(g_grid), dim3(NWAVES * 64), LDS_BYTES, st, a);
}
}

extern "C" void kernel_launch(void* const* d_in, const int* in_sizes, int n_in, void* d_out, int out_size, void* d_ws, size_t ws_size, hipStream_t stream) {
    (void)in_sizes; (void)n_in; (void)out_size;
    using namespace mk;
    if (g_grid == 0) {
        if (ws_size < 2048 * MiB) { fprintf(stderr, "kernel_launch: workspace too small (%zu)\n", ws_size); g_grid = -1; return; }
        if (hipFuncSetAttribute((const void*)mk_fwd, hipFuncAttributeMaxDynamicSharedMemorySize, LDS_BYTES) != hipSuccess) { fprintf(stderr, "kernel_launch: hipFuncSetAttribute failed\n"); g_grid = -1; return; }
        int dev = 0, cus = 0; (void)hipGetDevice(&dev); (void)hipDeviceGetAttribute(&cus, hipDeviceAttributeMultiprocessorCount, dev);
        g_grid = cus > 0 ? cus : 256;
    }
    if (g_grid < 0) return;
    unsigned char* ws = (unsigned char*)d_ws; float* out = (float*)d_out;
    (void)hipMemsetAsync(ws + WS_CTL, 0, CTL_ZERO_BYTES, stream);
    Args a{};
    for (int i = 0; i < 13; ++i) a.in[i] = (const float*)d_in[i];
    a.out = out; a.ws = ws;
    launch_phases(a, 0, 2 * PH_PER_LAYER, stream);
}
```

```cpp
#include <hip/hip_runtime.h>
#include <cstdio>
#include <cstdint>
namespace pg8 {
#define PG8_LAS __attribute__((address_space(3)))
typedef unsigned short bf16_t;
typedef short bf16x8 __attribute__((ext_vector_type(8)));
typedef float f32x4 __attribute__((ext_vector_type(4)));
typedef unsigned u32x4 __attribute__((ext_vector_type(4)));
typedef unsigned u32x2 __attribute__((ext_vector_type(2)));
constexpr int BM = 256, BK = 64, HALF = 128, HTB = HALF * BK * 2  , STAGE_BYTES = 8 * HTB, NXCD = 8, WGM = 8;

__host__ __device__ __forceinline__ int lds_byte(int r, int c) { const int st = (r >> 4) * 2 + (c >> 5), rr = r & 15, cc = c & 31, ob = rr * 64 + cc * 2; return st * 1024 + (ob ^ (((ob >> 9) & 1) << 5)); }
__host__ __device__ __forceinline__ void stage_rc(int b, int& R, int& C) { const int st = b / 1024, sb = b % 1024, swz = sb ^ (((sb >> 9) & 1) << 5); R = (st >> 1) * 16 + swz / 64; C = (st & 1) * 32 + (swz % 64) / 2; }
__host__ __device__ __forceinline__ int perm32(int rho) { const int n = rho >> 4, i = rho & 15; return 8 * (i >> 2) + 4 * n + (i & 3); }

struct Unit { int pm, pn; };
struct Gemm { const bf16_t* A; const bf16_t* Bt; int M, N, K; };

struct StaticOrder {
    int nM, nN, nwg, G, c;
    __host__ __device__ void init(int M, int N, int G_, int c_) { nM = M / BM; nN = N / BM; nwg = nM * nN; G = G_; c = c_; }
    __host__ __device__ bool next(int i, Unit& u) const {
        const long L = (long)i * G + c; if (L >= nwg) return false;
        int wgid = (int)L; { const int q = nwg / NXCD, r = nwg % NXCD, xcd = wgid % NXCD, off = wgid / NXCD; wgid = (xcd < r ? xcd * (q + 1) : r * (q + 1) + (xcd - r) * q) + off; }
        const int nig = WGM * nN, gid = wgid / nig, fm = gid * WGM, gsz = (nM - fm) < WGM ? (nM - fm) : WGM;
        u.pm = fm + ((wgid % nig) % gsz); u.pn = (wgid % nig) / gsz; return true;
    }
    __device__ __forceinline__ void a_ready(const Unit&) const {}
    __device__ __forceinline__ void done(const Unit&) const {}
};
__device__ __forceinline__ unsigned cvt_pk_bf16(float lo, float hi) { unsigned r; asm volatile("v_cvt_pk_bf16_f32 %0, %1, %2" : "=v"(r) : "v"(lo), "v"(hi)); return r; }
typedef float f32x2 __attribute__((ext_vector_type(2)));
__device__ __forceinline__ f32x2 gelu_pk(f32x2 v) {
    const f32x2 av = __builtin_elementwise_abs(v), d = av * 0.2316418882f + 1.0f;
    f32x2 t; t.x = __builtin_amdgcn_rcpf(d.x); t.y = __builtin_amdgcn_rcpf(d.y);
    f32x2 q = t * 0.5307027145f + (-0.7265760135f); q = q * t + 0.7107068705f; q = q * t + (-0.142248368f); q = q * t + 0.127414796f; q = q * t;
    const f32x2 s = (v * v) * (-0.72134752044f);
    f32x2 e; e.x = __builtin_amdgcn_exp2f(s.x); e.y = __builtin_amdgcn_exp2f(s.y);
    const f32x2 m = v * (q * e), r = v - m;
    f32x2 o; o.x = v.x < 0.f ? m.x : r.x; o.y = v.y < 0.f ? m.y : r.y; return o;
}
#define EPI_FRESH_LANE() { unsigned z_ = 0u; asm volatile("" : "+v"(z_)); const int l_ = (int)__builtin_amdgcn_mbcnt_hi(~0u, __builtin_amdgcn_mbcnt_lo(~0u, z_)); fr = l_ & 15; fq = l_ >> 4; }
typedef __amdgpu_buffer_rsrc_t rsrc_t;
__device__ __forceinline__ rsrc_t mkrsrc(const void* p, unsigned bytes) { return __builtin_amdgcn_make_buffer_rsrc((void*)p, (short)0, (int)bytes, 0x00020000); }
template <int LDC> struct EpiPlainF32 {
    static constexpr bool PERM = false, AFTER_DRAIN = false;
    float* C;
    __device__ __forceinline__ void operator()(const f32x4 (&acc)[2][2][4][2], const Unit& u, int wr, int wc, int fr, int fq) const {
        EPI_FRESH_LANE();
        const rsrc_t rc = mkrsrc(C, 16384u * LDC * 4u);
        const int vo = ((wr * 64 + fr) * LDC + wc * 32 + 4 * fq) * 4, so = (u.pm * BM * LDC + u.pn * BM) * 4;
#pragma unroll
        for (int ai = 0; ai < 2; ++ai)
#pragma unroll
            for (int m = 0; m < 4; ++m)
#pragma unroll
                for (int bj = 0; bj < 2; ++bj)
#pragma unroll
                    for (int n = 0; n < 2; ++n) __builtin_amdgcn_raw_buffer_store_b128(__builtin_bit_cast(u32x4, acc[ai][bj][m][n]), rc, vo, so + ((ai * HALF + m * 16) * LDC + bj * HALF + n * 16) * 4, 0);
    }
};
template <int LDC> struct EpiRowScaleF32 {
    static constexpr bool PERM = false, AFTER_DRAIN = false;
    float* C; const float* rs;
    __device__ __forceinline__ void operator()(const f32x4 (&acc)[2][2][4][2], const Unit& u, int wr, int wc, int fr, int fq) const {
        const rsrc_t rc = mkrsrc(C, 16384u * LDC * 4u), rr = mkrsrc(rs, 16384u * 4u);
        const int vo = ((wr * 64 + fr) * LDC + wc * 32 + 4 * fq) * 4, vr = (wr * 64 + fr) * 4;
        const int so = (u.pm * BM * LDC + u.pn * BM) * 4, sr = u.pm * BM * 4;
#pragma unroll
        for (int ai = 0; ai < 2; ++ai)
#pragma unroll
            for (int m = 0; m < 4; ++m) { const float s = __builtin_bit_cast(float, __builtin_amdgcn_raw_buffer_load_b32(rr, vr, sr + (ai * HALF + m * 16) * 4, 0));
#pragma unroll
                for (int bj = 0; bj < 2; ++bj)
#pragma unroll
                    for (int n = 0; n < 2; ++n) { const f32x4 v = acc[ai][bj][m][n] * s; __builtin_amdgcn_raw_buffer_store_b128(__builtin_bit_cast(u32x4, v), rc, vo, so + ((ai * HALF + m * 16) * LDC + bj * HALF + n * 16) * 4, 0); } }
    }
};
__device__ __forceinline__ u32x4 widen_pair(unsigned x0, unsigned x1, unsigned y0, unsigned y1, int lane_, int fq_) {
    const bool odd = fq_ & 1; const int pa = (lane_ ^ 16) << 2;
    const unsigned r0 = (unsigned)__builtin_amdgcn_ds_bpermute(pa, (int)(odd ? x0 : y0)), r1 = (unsigned)__builtin_amdgcn_ds_bpermute(pa, (int)(odd ? x1 : y1));
    return odd ? (u32x4){r0, r1, y0, y1} : (u32x4){x0, x1, r0, r1};
}
template <bool BASE_F32> struct EpiResidB16 {
    static constexpr bool PERM = false, AFTER_DRAIN = false;
    const void* base; float ascale; bf16_t* xb;
    __device__ __forceinline__ void operator()(const f32x4 (&acc)[2][2][4][2], const Unit& u, int wr, int wc, int fr, int fq) const {
        EPI_FRESH_LANE();
        constexpr int LDC = 4096;
        const rsrc_t rb = mkrsrc(base, 16384u * LDC * (BASE_F32 ? 4u : 2u)), rx = mkrsrc(xb, 16384u * LDC * 2u);
        const int vo = ((wr * 64 + fr) * LDC + wc * 32 + 4 * fq) * 2;
        const int so = (u.pm * BM * LDC + u.pn * BM) * 2;
        const int vo8 = ((wr * 64 + fr) * LDC + wc * 32 + (fq & 1) * 16 + (fq >> 1) * 8) * 2;
        f32x4 ra[2][2], rb2[2][2];
#define EPI_LD(dst, g_) do { _Pragma("unroll") for (int bj = 0; bj < 2; ++bj) _Pragma("unroll") for (int n = 0; n < 2; ++n) { \
            const int o = so + ((((g_) >> 2) * HALF + ((g_) & 3) * 16) * LDC + bj * HALF + n * 16) * 2; \
            if constexpr (BASE_F32) dst[bj][n] = __builtin_bit_cast(f32x4, __builtin_amdgcn_raw_buffer_load_b128(rb, vo * 2, o * 2, 0)); \
            else { const u32x2 t_ = __builtin_amdgcn_raw_buffer_load_b64(rb, vo, o, 0); dst[bj][n] = (f32x4){__builtin_bit_cast(float, t_.x << 16), __builtin_bit_cast(float, t_.x & 0xffff0000u), __builtin_bit_cast(float, t_.y << 16), __builtin_bit_cast(float, t_.y & 0xffff0000u)}; } } } while (0)
#define EPI_ST(src, g_) do { _Pragma("unroll") for (int bj = 0; bj < 2; ++bj) { \
            const int o = so + ((((g_) >> 2) * HALF + ((g_) & 3) * 16) * LDC + bj * HALF) * 2; \
            const f32x4 v0 = src[bj][0] + acc[(g_) >> 2][bj][(g_) & 3][0] * ascale, v1 = src[bj][1] + acc[(g_) >> 2][bj][(g_) & 3][1] * ascale; \
            const u32x4 w16 = widen_pair(cvt_pk_bf16(v0[0], v0[1]), cvt_pk_bf16(v0[2], v0[3]), cvt_pk_bf16(v1[0], v1[1]), cvt_pk_bf16(v1[2], v1[3]), 16 * fq + fr, fq); \
            __builtin_amdgcn_raw_buffer_store_b128(w16, rx, vo8, o, 0); } } while (0)
        EPI_LD(ra, 0);
        EPI_LD(rb2, 1); EPI_ST(ra, 0);
        EPI_LD(ra, 2); EPI_ST(rb2, 1);
        EPI_LD(rb2, 3); EPI_ST(ra, 2);
        EPI_LD(ra, 4); EPI_ST(rb2, 3);
        EPI_LD(rb2, 5); EPI_ST(ra, 4);
        EPI_LD(ra, 6); EPI_ST(rb2, 5);
        EPI_LD(rb2, 7); EPI_ST(ra, 6);
        EPI_ST(rb2, 7);
#undef EPI_LD
#undef EPI_ST
    }
};
struct EpiQKV {
    static constexpr bool PERM = true, AFTER_DRAIN = false;
    bf16_t* Q; const float* rs; float qscale;
    __device__ __forceinline__ void operator()(const f32x4 (&acc)[2][2][4][2], const Unit& u, int wr, int wc, int fr, int fq) const {
        const rsrc_t rq = mkrsrc(Q, 3u * 16384u * 4096u * 2u), rr = mkrsrc(rs, 16384u * 4u);
        const int colt = u.pn * BM, which = colt >> 12, cw = colt & 4095, gt = cw >> 7;
        const int b = (u.pm * BM) >> 11, st = (u.pm * BM) & 2047;
        const float sc = which == 0 ? qscale : 1.f;
        const int so = (int)(((unsigned)which << 26) + (((unsigned)(b * 32 + gt) * 2048u + (unsigned)st) << 7)) * 2;
        const int vo = (((wr * 64 + fr) << 7) + wc * 32 + 8 * fq) * 2, vr = (wr * 64 + fr) * 4, sr = u.pm * BM * 4;
#pragma unroll
        for (int ai = 0; ai < 2; ++ai)
#pragma unroll
            for (int m = 0; m < 4; ++m) { const float f = sc * __builtin_bit_cast(float, __builtin_amdgcn_raw_buffer_load_b32(rr, vr, sr + (ai * HALF + m * 16) * 4, 0));
#pragma unroll
                for (int bj = 0; bj < 2; ++bj) {
                    const f32x4 v0 = acc[ai][bj][m][0] * f, v1 = acc[ai][bj][m][1] * f;
                    u32x4 w; w.x = cvt_pk_bf16(v0[0], v0[1]); w.y = cvt_pk_bf16(v0[2], v0[3]); w.z = cvt_pk_bf16(v1[0], v1[1]); w.w = cvt_pk_bf16(v1[2], v1[3]);
                    __builtin_amdgcn_raw_buffer_store_b128(w, rq, vo, so + ((bj * 2048 + ai * HALF + m * 16) << 7) * 2, 0); } }
    }
};

struct EpiQKV4 {
    static constexpr bool PERM = false, AFTER_DRAIN = false;
    bf16_t* Q; const float* rs; float qscale, wscale;
    __device__ __forceinline__ void operator()(const f32x4 (&acc)[2][2][4][2], const Unit& u, int wr, int wc, int fr, int fq) const {
        EPI_FRESH_LANE();
        const rsrc_t rq = mkrsrc(Q, 3u * 16384u * 4096u * 2u), rr = mkrsrc(rs, 16384u * 4u);
        const int colt = u.pn * BM, which = colt >> 12, cw = colt & 4095, gt = cw >> 7;
        const int b = (u.pm * BM) >> 11, st = (u.pm * BM) & 2047;
        const float sc = (which == 0 ? qscale : 1.f) * wscale;
        const int so = (int)(((unsigned)which << 26) + (((unsigned)(b * 32 + gt) * 2048u + (unsigned)st) << 7)) * 2;
        const int vo8 = (((wr * 64 + fr) << 7) + wc * 32 + (fq & 1) * 16 + (fq >> 1) * 8) * 2, vr = (wr * 64 + fr) * 4, sr = u.pm * BM * 4;
        unsigned rsv[2][4];
#pragma unroll
        for (int ai = 0; ai < 2; ++ai)
#pragma unroll
            for (int m = 0; m < 4; ++m) rsv[ai][m] = __builtin_amdgcn_raw_buffer_load_b32(rr, vr, sr + (ai * HALF + m * 16) * 4, 0);
#pragma unroll
        for (int ai = 0; ai < 2; ++ai)
#pragma unroll
            for (int m = 0; m < 4; ++m) { const float f = sc * __builtin_bit_cast(float, rsv[ai][m]);
#pragma unroll
                for (int bj = 0; bj < 2; ++bj) {
                    const f32x4 v0 = acc[ai][bj][m][0] * f, v1 = acc[ai][bj][m][1] * f;
                    const u32x4 w16 = widen_pair(cvt_pk_bf16(v0[0], v0[1]), cvt_pk_bf16(v0[2], v0[3]), cvt_pk_bf16(v1[0], v1[1]), cvt_pk_bf16(v1[2], v1[3]), 16 * fq + fr, fq);
                    __builtin_amdgcn_raw_buffer_store_b128(w16, rq, vo8, so + (((bj * 2048 + ai * HALF + m * 16) << 7)) * 2, 0); } }
    }
};

typedef int i32x8 __attribute__((ext_vector_type(8)));
template <bool F8> struct FragT { typedef bf16x8 type; };
template <> struct FragT<true> { typedef i32x8 type; };
__device__ __forceinline__ f32x4 mma_bf16(bf16x8 a, bf16x8 b, f32x4 c) { return __builtin_amdgcn_mfma_f32_16x16x32_bf16(a, b, c, 0, 0, 0); }
__device__ __forceinline__ f32x4 mma_bf16(i32x8, i32x8, f32x4 c) { return c; }
template <class Epi, class Sched, bool ALIGN_EPI = false, bool SP2 = false, bool F8 = false>
__device__ __forceinline__ void gemm_phase(PG8_LAS unsigned char* lds, const Gemm g, const Sched& S, const Epi& E, int tid_in) {
    int tid_ = tid_in;
    const int tid = tid_, wid = __builtin_amdgcn_readfirstlane(tid >> 6), lane = tid & 63, wr = wid >> 2, wc = wid & 3, fr = lane & 15, fq = lane >> 4;
    constexpr int EB = F8 ? 1 : 2;
    constexpr int K = 4096; constexpr int nt = (K * EB) / (BK * 2);
    unsigned voffA[2], voffB[2];
#pragma unroll
    for (int i = 0; i < 2; ++i) { int R, C; stage_rc(tid * 16 + i * 8192, R, C); const int Rb = Epi::PERM ? ((R & ~31) + perm32(R & 31)) : R;
        voffA[i] = (unsigned)(R * K * EB + C * 2); voffB[i] = (unsigned)(Rb * K * EB + C * 2); }
    const size_t kstep = (size_t)(BK * 2);
    const size_t hstep = (size_t)HALF * K * EB;
    const size_t tstep = 2 * hstep;
    const unsigned ldsw = (unsigned)wid * 1024u;
    const int aoff = F8 ? lds_byte(wr * 64 + fr, fq * 16) + (fq & 1) * 16 : lds_byte(wr * 64 + fr, fq * 8), boff = F8 ? lds_byte(wc * 32 + fr, fq * 16) + (fq & 1) * 16 : lds_byte(wc * 32 + fr, fq * 8);
    const int aoff1 = aoff + (F8 ? 16 - 32 * (fq & 1) : 0);
    const int f8o0_unused = 0; (void)f8o0_unused;
#define PG8_SA(b, h) (((b) * 2 + (h)) * HTB)
#define PG8_SB(b, h) ((4 + (b) * 2 + (h)) * HTB)
#define PG8_STAGE_X(bufoff, gbase, voff, rs_, base_) do { const int so_ = (int)((const char*)(gbase) - (const char*)(base_)); _Pragma("unroll") for (int _i = 0; _i < 2; ++_i) \
        __builtin_amdgcn_raw_ptr_buffer_load_lds(rs_, (PG8_LAS void*)(lds + (bufoff) + ldsw + _i * 8192), 16, (int)(voff)[_i], so_, 0, 0); } while (0)
#define PG8_LDA(dst, b, h) do { if constexpr (F8) { _Pragma("unroll") for (int m = 0; m < 4; ++m) { const u32x4 lo_ = *(const PG8_LAS u32x4*)(lds + PG8_SA(b, h) + aoff + m * 2048), hi_ = *(const PG8_LAS u32x4*)(lds + PG8_SA(b, h) + aoff1 + m * 2048); \
            dst[m][0] = (i32x8){(int)lo_[0], (int)lo_[1], (int)lo_[2], (int)lo_[3], (int)hi_[0], (int)hi_[1], (int)hi_[2], (int)hi_[3]}; } } \
        else { _Pragma("unroll") for (int m = 0; m < 4; ++m) _Pragma("unroll") for (int k = 0; k < 2; ++k) dst[m][k] = *(const PG8_LAS frag_t*)(lds + PG8_SA(b, h) + aoff + m * 2048 + k * 1024); } } while (0)
#define PG8_LDB(dst, b, h) do { if constexpr (F8) { _Pragma("unroll") for (int n = 0; n < 2; ++n) { const u32x4 lo_ = *(const PG8_LAS u32x4*)(lds + PG8_SB(b, h) + boff + n * 2048), hi_ = *(const PG8_LAS u32x4*)(lds + PG8_SB(b, h) + boff + (aoff1 - aoff) + n * 2048); \
            dst[n][0] = (i32x8){(int)lo_[0], (int)lo_[1], (int)lo_[2], (int)lo_[3], (int)hi_[0], (int)hi_[1], (int)hi_[2], (int)hi_[3]}; } } \
        else { _Pragma("unroll") for (int n = 0; n < 2; ++n) _Pragma("unroll") for (int k = 0; k < 2; ++k) dst[n][k] = *(const PG8_LAS frag_t*)(lds + PG8_SB(b, h) + boff + n * 2048 + k * 1024); } } while (0)
#define PG8_MMA(ai, bj, At, Bt) do { __builtin_amdgcn_s_setprio(1); _Pragma("unroll") for (int m = 0; m < 4; ++m) _Pragma("unroll") for (int n = 0; n < 2; ++n) { \
        if constexpr (F8) acc[ai][bj][m][n] = __builtin_amdgcn_mfma_scale_f32_16x16x128_f8f6f4(Bt[n][0], At[m][0], acc[ai][bj][m][n], 0, 0, 0, 0x7f7f7f7f, 0, 0x7f7f7f7f); \
        else { _Pragma("unroll") for (int k = 0; k < 2; ++k) acc[ai][bj][m][n] = mma_bf16(Bt[n][k], At[m][k], acc[ai][bj][m][n]); } } __builtin_amdgcn_s_setprio(0); } while (0)
#define PG8_WAIT_V(n) asm volatile("s_waitcnt vmcnt(" #n ")" ::: "memory")
#define PG8_WAIT_L(n) asm volatile("s_waitcnt lgkmcnt(" #n ")" ::: "memory")
#define PG8_BAR __builtin_amdgcn_s_barrier()
#define PG8_SCHED __builtin_amdgcn_sched_barrier(0)
    const __amdgpu_buffer_rsrc_t rsA = __builtin_amdgcn_make_buffer_rsrc((void*)g.A, (short)0, (int)((size_t)g.M * K * EB), 0x00020000), rsB = __builtin_amdgcn_make_buffer_rsrc((void*)g.Bt, (short)0, (int)((size_t)g.N * K * EB), 0x00020000);
    Unit cur, nxt; int ui = 0;
    if (!S.next(0, cur)) return;
    f32x4 acc[2][2][4][2];
#pragma unroll
    for (int a = 0; a < 2; ++a)
#pragma unroll
        for (int b = 0; b < 2; ++b)
#pragma unroll
            for (int m = 0; m < 4; ++m)
#pragma unroll
                for (int n = 0; n < 2; ++n) acc[a][b][m][n] = (f32x4){0.f, 0.f, 0.f, 0.f};
    typedef typename FragT<F8>::type frag_t;
    frag_t At[4][F8 ? 1 : 2], B0[2][F8 ? 1 : 2], B1[2][F8 ? 1 : 2];
    const char* cA = (const char*)g.A + (size_t)cur.pm * tstep; const char* cB = (const char*)g.Bt + (size_t)cur.pn * tstep;
    S.a_ready(cur);
    if constexpr (SP2) {
        PG8_STAGE_X(PG8_SB(0, 0), cB, voffB, rsB, g.Bt); PG8_STAGE_X(PG8_SB(0, 1), cB + hstep, voffB, rsB, g.Bt); PG8_STAGE_X(PG8_SA(0, 0), cA, voffA, rsA, g.A); PG8_STAGE_X(PG8_SA(0, 1), cA + hstep, voffA, rsA, g.A);
        if (wr == 1) PG8_BAR;
        PG8_WAIT_V(2); PG8_BAR;
        PG8_STAGE_X(PG8_SB(1, 0), cB + kstep, voffB, rsB, g.Bt); PG8_STAGE_X(PG8_SA(1, 0), cA + kstep, voffA, rsA, g.A); PG8_STAGE_X(PG8_SB(1, 1), cB + hstep + kstep, voffB, rsB, g.Bt);
        PG8_WAIT_V(6); PG8_BAR;
    } else {
        PG8_STAGE_X(PG8_SB(0, 0), cB, voffB, rsB, g.Bt); PG8_STAGE_X(PG8_SA(0, 0), cA, voffA, rsA, g.A); PG8_STAGE_X(PG8_SB(0, 1), cB + hstep, voffB, rsB, g.Bt); PG8_STAGE_X(PG8_SA(0, 1), cA + hstep, voffA, rsA, g.A);
        if (wr == 1) PG8_BAR;
        PG8_WAIT_V(4); PG8_BAR;
        PG8_STAGE_X(PG8_SB(1, 0), cB + kstep, voffB, rsB, g.Bt); PG8_STAGE_X(PG8_SA(1, 0), cA + kstep, voffA, rsA, g.A); PG8_STAGE_X(PG8_SB(1, 1), cB + hstep + kstep, voffB, rsB, g.Bt);
        PG8_WAIT_V(6); PG8_BAR;
    }
    for (;;) {
        const bool has_next = S.next(ui + 1, nxt);
        const char* nA = has_next ? (const char*)g.A + (size_t)nxt.pm * tstep : cA; const char* nB = has_next ? (const char*)g.Bt + (size_t)nxt.pn * tstep : cB;
        for (int t = 0; t < nt; t += 2) {
            const bool last = (t == nt - 2);
            const char* a1 = cA + (size_t)(t + 1) * kstep;
            const char* a2 = last ? nA : cA + (size_t)(t + 2) * kstep; const char* b2 = last ? nB : cB + (size_t)(t + 2) * kstep;
            const char* a3 = a2 + kstep; const char* b3 = b2 + kstep;
            if (last && has_next) S.a_ready(nxt);
            if constexpr (SP2) {
            PG8_LDB(B0, 0, 0); PG8_LDB(B1, 0, 1); PG8_SCHED; PG8_LDA(At, 0, 0); PG8_STAGE_X(PG8_SA(1, 1), a1 + hstep, voffA, rsA, g.A);
            PG8_WAIT_V(8); PG8_WAIT_L(0); PG8_BAR; PG8_MMA(0, 0, At, B0); PG8_MMA(0, 1, At, B1); PG8_BAR; PG8_SCHED;
            PG8_LDA(At, 0, 1); PG8_STAGE_X(PG8_SB(0, 0), b2, voffB, rsB, g.Bt); PG8_STAGE_X(PG8_SB(0, 1), b2 + hstep, voffB, rsB, g.Bt); PG8_STAGE_X(PG8_SA(0, 0), a2, voffA, rsA, g.A);
            PG8_WAIT_V(8); PG8_WAIT_L(0); PG8_BAR; PG8_MMA(1, 0, At, B0); PG8_MMA(1, 1, At, B1); PG8_BAR; PG8_SCHED;
            PG8_LDB(B0, 1, 0); PG8_LDB(B1, 1, 1); PG8_SCHED; PG8_LDA(At, 1, 0); PG8_STAGE_X(PG8_SA(0, 1), a2 + hstep, voffA, rsA, g.A);
            PG8_WAIT_V(8); PG8_WAIT_L(0); PG8_BAR; PG8_MMA(0, 0, At, B0); PG8_MMA(0, 1, At, B1); PG8_BAR; PG8_SCHED;
            PG8_LDA(At, 1, 1); PG8_STAGE_X(PG8_SB(1, 0), b3, voffB, rsB, g.Bt); PG8_STAGE_X(PG8_SB(1, 1), b3 + hstep, voffB, rsB, g.Bt); PG8_STAGE_X(PG8_SA(1, 0), a3, voffA, rsA, g.A);
            PG8_WAIT_V(8); PG8_WAIT_L(0); PG8_BAR; PG8_MMA(1, 0, At, B0); PG8_MMA(1, 1, At, B1); PG8_BAR; PG8_SCHED;
            } else {
            PG8_LDB(B0, 0, 0); PG8_SCHED; PG8_LDA(At, 0, 0); PG8_STAGE_X(PG8_SA(1, 1), a1 + hstep, voffA, rsA, g.A);
            PG8_WAIT_L(8); PG8_BAR; PG8_WAIT_L(0); PG8_MMA(0, 0, At, B0); PG8_BAR; PG8_SCHED;
            PG8_LDB(B1, 0, 1); PG8_STAGE_X(PG8_SB(0, 0), b2, voffB, rsB, g.Bt);
            PG8_BAR; PG8_WAIT_L(0); PG8_MMA(0, 1, At, B1); PG8_BAR;
            PG8_LDA(At, 0, 1); PG8_STAGE_X(PG8_SA(0, 0), a2, voffA, rsA, g.A);
            PG8_BAR; PG8_WAIT_L(0); PG8_MMA(1, 0, At, B0); PG8_BAR; PG8_SCHED;
            PG8_STAGE_X(PG8_SB(0, 1), b2 + hstep, voffB, rsB, g.Bt);
            PG8_WAIT_V(6); PG8_BAR; PG8_MMA(1, 1, At, B1); PG8_BAR;
            PG8_LDB(B0, 1, 0); PG8_SCHED; PG8_LDA(At, 1, 0); PG8_STAGE_X(PG8_SA(0, 1), a2 + hstep, voffA, rsA, g.A);
            PG8_WAIT_L(8); PG8_BAR; PG8_WAIT_L(0); PG8_MMA(0, 0, At, B0); PG8_BAR; PG8_SCHED;
            PG8_LDB(B1, 1, 1); PG8_STAGE_X(PG8_SB(1, 0), b3, voffB, rsB, g.Bt);
            PG8_BAR; PG8_WAIT_L(0); PG8_MMA(0, 1, At, B1); PG8_BAR;
            PG8_LDA(At, 1, 1); PG8_STAGE_X(PG8_SA(1, 0), a3, voffA, rsA, g.A);
            PG8_BAR; PG8_WAIT_L(0); PG8_MMA(1, 0, At, B0); PG8_BAR; PG8_SCHED;
            PG8_STAGE_X(PG8_SB(1, 1), b3 + hstep, voffB, rsB, g.Bt);
            PG8_WAIT_V(6); PG8_BAR; PG8_MMA(1, 1, At, B1); PG8_BAR;
            }
        }
        if constexpr (ALIGN_EPI) { if (wr == 0) PG8_BAR; }
        if constexpr (!Epi::AFTER_DRAIN) { E(acc, cur, wr, wc, fr, fq); S.done(cur); }
        if (!has_next) break;
#pragma unroll
        for (int a = 0; a < 2; ++a)
#pragma unroll
            for (int b = 0; b < 2; ++b)
#pragma unroll
                for (int m = 0; m < 4; ++m)
#pragma unroll
                    for (int n = 0; n < 2; ++n) acc[a][b][m][n] = (f32x4){0.f, 0.f, 0.f, 0.f};
        cur = nxt; cA = nA; cB = nB; ++ui;
        if constexpr (ALIGN_EPI) { if (wr == 1) PG8_BAR; }
    }
    PG8_WAIT_V(0);
    if constexpr (!ALIGN_EPI) { if (wr == 0) PG8_BAR; }
    PG8_BAR;
    if constexpr (Epi::AFTER_DRAIN) { E.fused(acc, cur, wr, wc, fr, fq, lds, wid, lane); S.done(cur); }
#undef PG8_SA
#undef PG8_SB
#undef PG8_STAGE_X
#undef PG8_LDA
#undef PG8_LDB
#undef PG8_MMA
#undef PG8_WAIT_V
#undef PG8_WAIT_L
#undef PG8_BAR
#undef PG8_SCHED
}
}
#define GAS __attribute__((address_space(1)))
#define LAS __attribute__((address_space(3)))
typedef unsigned short bf16_t;
typedef unsigned u32x4 __attribute__((ext_vector_type(4)));
typedef unsigned u32x2 __attribute__((ext_vector_type(2)));
typedef float f32x4 __attribute__((ext_vector_type(4)));
typedef float f32x2 __attribute__((ext_vector_type(2)));
typedef float f32x16 __attribute__((ext_vector_type(16)));
typedef short bf16x8 __attribute__((ext_vector_type(8)));
typedef short s16x4 __attribute__((ext_vector_type(4)));
typedef __bf16 bf16x2_t __attribute__((ext_vector_type(2)));
typedef unsigned u32x6 __attribute__((ext_vector_type(6)));
typedef int i32x8 __attribute__((ext_vector_type(8)));
typedef unsigned u32x16 __attribute__((ext_vector_type(16)));
typedef float f32x32 __attribute__((ext_vector_type(32)));
typedef _Float16 f16x32 __attribute__((ext_vector_type(32)));
typedef _Float16 f16x2 __attribute__((ext_vector_type(2)));

namespace mk {
constexpr int M = 16384, D = 4096, S = 2048, NB = 8, PW = 12298, NH = 32, NE = 16384;
constexpr int NWAVES = 8;
constexpr size_t MiB = 1u << 20;
constexpr size_t WS_CTL = 0, CTL_ZERO_BYTES = 1 * MiB;
constexpr size_t WS_RSTD = 2 * MiB, WS_LOGF = 3 * MiB, WS_WQK = 4 * MiB, WS_WOUT = 20 * MiB, WS_WIN = 52 * MiB, WS_U16 = 148 * MiB, WS_V16 = 276 * MiB,
                 WS_XB = 404 * MiB, WS_Q = 532 * MiB, WS_K = 660 * MiB, WS_V = 788 * MiB, WS_OB = 916 * MiB, WS_X2 = 1792 * MiB, WS_END = 2048 * MiB;
constexpr size_t WS_L1 = 1920 * MiB;
__host__ __device__ constexpr size_t ws_wqk(int l) { return l ? WS_L1 : WS_WQK; }
__host__ __device__ constexpr size_t ws_wout(int l) { return l ? WS_L1 + 16 * MiB : WS_WOUT; }
__host__ __device__ constexpr size_t ws_win(int l) { return l ? WS_L1 + 32 * MiB : WS_WIN; }
__host__ __device__ constexpr size_t ws_tab(int l) { return l ? WS_V16 : WS_U16; }
constexpr size_t WS_XB8N = WS_OB + 64 * MiB;
constexpr size_t WS_SC = WS_Q;
constexpr int CW_BAR = 4096;
constexpr int CW_QUEUE = 16384;
constexpr int RING_BYTES = 131072, LDSCTL_OFF = RING_BYTES, MISC_OFF = LDSCTL_OFF + 320, LDS_BYTES = 147456;

struct Args { const float* in[13]; float* out; unsigned char* ws; int ph_lo, ph_hi; };

__device__ __forceinline__ unsigned f2bf(float f) { unsigned u = __builtin_bit_cast(unsigned, f); return (u + 0x7fffu + ((u >> 16) & 1u)) >> 16; }
__device__ __forceinline__ unsigned pk2(float lo, float hi) { return f2bf(lo) | (f2bf(hi) << 16); }
__device__ __forceinline__ float bf_lo(unsigned w) { return __builtin_bit_cast(float, w << 16); }
__device__ __forceinline__ float bf_hi(unsigned w) { return __builtin_bit_cast(float, w & 0xffff0000u); }
__device__ __forceinline__ float lane_read(float v, int src_lane) { return __builtin_bit_cast(float, __builtin_amdgcn_ds_bpermute(src_lane << 2, __builtin_bit_cast(int, v))); }
__device__ __forceinline__ int lane_read(int v, int src_lane) { return __builtin_amdgcn_ds_bpermute(src_lane << 2, v); }
constexpr float US = 1024.0f, VS = 32.0f, US_INV = 1.0f / 1024.0f, VS_INV = 1.0f / 32.0f;
constexpr int REC4 = 4096;
constexpr int ROW4 = 2048;
#define FP4X_(j) ((j) < 16 ? a0[((j) & 15) >> 2][(j) & 3] : a1[((j) & 15) >> 2][(j) & 3])
__device__ __forceinline__ u32x4 pack_fp4(const f32x4 (&a0)[4], const f32x4 (&a1)[4], float inv) {
    unsigned o[4];
#pragma unroll
    for (int w = 0; w < 4; ++w) { unsigned v = 0u;
        v = __builtin_amdgcn_cvt_scalef32_pk_fp4_f32(v, FP4X_(8 * w + 0) * inv, FP4X_(8 * w + 1) * inv, 1.0f, 0); v = __builtin_amdgcn_cvt_scalef32_pk_fp4_f32(v, FP4X_(8 * w + 2) * inv, FP4X_(8 * w + 3) * inv, 1.0f, 1);
        v = __builtin_amdgcn_cvt_scalef32_pk_fp4_f32(v, FP4X_(8 * w + 4) * inv, FP4X_(8 * w + 5) * inv, 1.0f, 2); v = __builtin_amdgcn_cvt_scalef32_pk_fp4_f32(v, FP4X_(8 * w + 6) * inv, FP4X_(8 * w + 7) * inv, 1.0f, 3);
        o[w] = v; }
    return (u32x4){o[0], o[1], o[2], o[3]};
}
#undef FP4X_
__device__ __forceinline__ float clamp8(float x) { return fminf(fmaxf(x, -224.0f), 224.0f); }
__device__ __forceinline__ float logsig(float z) { return fminf(z, 0.f) - 0.6931471805599453f * __builtin_amdgcn_logf(1.0f + __builtin_amdgcn_exp2f(-fabsf(z) * 1.4426950408889634f)); }
__device__ __forceinline__ float gelu_erf(float v) {
    const float av = fabsf(v), t = __builtin_amdgcn_rcpf(av * 0.2316418882f + 1.0f);
    float q = t * 0.5307027145f + (-0.7265760135f); q = q * t + 0.7107068705f; q = q * t + (-0.142248368f); q = q * t + 0.127414796f; q = q * t;
    const float e = __builtin_amdgcn_exp2f((v * v) * (-0.72134752044f));
    const float m = v * (q * e);
    return v < 0.f ? m : v - m;
}
#define LDS_WAIT() asm volatile("s_waitcnt lgkmcnt(0)" ::: "memory")
#define FRESH_LDS(l) do { unsigned v_ = (unsigned)(size_t)(l); asm volatile("" : "+s"(v_)); (l) = (LAS unsigned char*)(size_t)v_; } while (0)
#define FRESH_BID() int bid = blockIdx.x, G = gridDim.x; asm volatile("" : "+s"(bid), "+s"(G))
#define FRESH_TID() int tid; { int w_ = wave0, l_; { unsigned z_ = 0u; asm volatile("" : "+v"(z_)); l_ = (int)__builtin_amdgcn_mbcnt_hi(~0u, __builtin_amdgcn_mbcnt_lo(~0u, z_)); } asm volatile("" : "+s"(w_)); tid = w_ * 64 + l_; } const int lane = tid & 63, wave = __builtin_amdgcn_readfirstlane(tid >> 6); (void)lane; (void)wave

__device__ __forceinline__ unsigned wave_max_u32(unsigned v) {
    v = max(v, (unsigned)__builtin_amdgcn_update_dpp(0, (int)v, 0x111, 0xF, 0xF, true));
    v = max(v, (unsigned)__builtin_amdgcn_update_dpp(0, (int)v, 0x112, 0xF, 0xF, true));
    v = max(v, (unsigned)__builtin_amdgcn_update_dpp(0, (int)v, 0x114, 0xF, 0xF, true));
    v = max(v, (unsigned)__builtin_amdgcn_update_dpp(0, (int)v, 0x118, 0xF, 0xF, true));
    v = max(v, (unsigned)__builtin_amdgcn_update_dpp((int)v, (int)v, 0x142, 0xA, 0xF, false));
    v = max(v, (unsigned)__builtin_amdgcn_update_dpp((int)v, (int)v, 0x143, 0xC, 0xF, false));
    return (unsigned)__builtin_amdgcn_readlane((int)v, 63);
}
__device__ __forceinline__ float wave_sum_dpp(float x) {
    int v = __builtin_bit_cast(int, x);
#define DPP_ADD(ctrl, rm, bc, oldv) v = __builtin_bit_cast(int, __builtin_bit_cast(float, v) + __builtin_bit_cast(float, __builtin_amdgcn_update_dpp(oldv, v, ctrl, rm, 0xF, bc)))
    DPP_ADD(0x111, 0xF, true, 0); DPP_ADD(0x112, 0xF, true, 0); DPP_ADD(0x114, 0xF, true, 0); DPP_ADD(0x118, 0xF, true, 0);
#undef DPP_ADD
    const float r0 = __builtin_bit_cast(float, __builtin_amdgcn_readlane(v, 15)), r1 = __builtin_bit_cast(float, __builtin_amdgcn_readlane(v, 31)), r2 = __builtin_bit_cast(float, __builtin_amdgcn_readlane(v, 47)), r3 = __builtin_bit_cast(float, __builtin_amdgcn_readlane(v, 63));
    return (r0 + r1) + (r2 + r3);
}
__device__ __forceinline__ unsigned ordkey(float x) { const unsigned u = __builtin_bit_cast(unsigned, x); return (u & 0x80000000u) ? ~u : (u | 0x80000000u); }
__device__ __forceinline__ void transpose_item(const float* W, int K, int ldw, int ncols, const float* gain, bf16_t* WT, LAS float* scr, int item, int lane) {
    const int nblk = ncols / 32, kb = item / nblk, nb = item % nblk, k0 = 64 * kb, n0 = 32 * nb;
#pragma unroll 8
    for (int i = 0; i < 32; ++i) { const int kk = 2 * i + (lane >> 5); float v = W[(size_t)(k0 + kk) * ldw + n0 + (lane & 31)]; if (gain) v *= gain[k0 + kk]; scr[kk * 33 + (lane & 31)] = v; }
    LDS_WAIT(); asm volatile("" ::: "memory");
    const int c = lane & 7;
#pragma unroll
    for (int j = 0; j < 4; ++j) { const int n = (lane >> 3) + 8 * j; const LAS float* s = scr + (8 * c) * 33 + n;
        u32x4 o; o.x = pk2(s[0 * 33], s[1 * 33]); o.y = pk2(s[2 * 33], s[3 * 33]); o.z = pk2(s[4 * 33], s[5 * 33]); o.w = pk2(s[6 * 33], s[7 * 33]);
        *(u32x4*)(WT + (size_t)(n0 + n) * K + k0 + 8 * c) = o; }
    LDS_WAIT(); asm volatile("" ::: "memory");
}

typedef const __attribute__((address_space(4))) Args* KArgsT;
__device__ __forceinline__ unsigned pk4_fp8(float a, float b, float c, float d) { int p = __builtin_amdgcn_cvt_pk_fp8_f32(clamp8(a), clamp8(b), 0, false); p = __builtin_amdgcn_cvt_pk_fp8_f32(clamp8(c), clamp8(d), p, true); return (unsigned)p; }
__device__ __forceinline__ void transpose_item8(const float* W, int K, int ldw, int ncols, const float* gain, float scale, unsigned char* WT, LAS float* scr, int item, int lane) {
    const int nblk = ncols / 32, kb = item / nblk, nb = item % nblk, k0 = 64 * kb, n0 = 32 * nb;
    const int kr = lane >> 3, nq = (lane & 7) * 4;
    f32x4 v[8];
#pragma unroll
    for (int i = 0; i < 8; ++i) { const float* p = W + (size_t)(k0 + 8 * i + kr) * ldw + n0 + nq; v[i] = (f32x4){p[0], p[1], p[2], p[3]}; }
#pragma unroll
    for (int i = 0; i < 8; ++i) { const int kk = 8 * i + kr; const float g = (gain ? gain[k0 + kk] : 1.0f) * scale; LAS float* d = scr + kk * 33 + nq; d[0] = v[i][0] * g; d[1] = v[i][1] * g; d[2] = v[i][2] * g; d[3] = v[i][3] * g; }
    LDS_WAIT(); asm volatile("" ::: "memory");
    const int c = lane & 7;
#pragma unroll
    for (int j = 0; j < 4; ++j) { const int n = (lane >> 3) + 8 * j; const LAS float* s = scr + (8 * c) * 33 + n;
        u32x2 o; o.x = pk4_fp8(s[0 * 33], s[1 * 33], s[2 * 33], s[3 * 33]); o.y = pk4_fp8(s[4 * 33], s[5 * 33], s[6 * 33], s[7 * 33]);
        *(u32x2*)(WT + (size_t)(n0 + n) * K + k0 + 8 * c) = o; }
    LDS_WAIT(); asm volatile("" ::: "memory");
}
__device__ __forceinline__ void conv_phase(KArgsT ka, int l, LAS unsigned char* lds, int wave0) {
    FRESH_TID(); FRESH_LDS(lds); FRESH_BID();
    unsigned char* ws = ka->ws;
    const float* ln1 = ka->in[1] + (size_t)l * D; const float* w_in = ka->in[2] + (size_t)l * D * PW; const float* w_out = ka->in[5] + (size_t)l * D * D;
    const float* ln2 = ka->in[6] + (size_t)l * D; const float* wq = ka->in[7] + (size_t)l * D * 2048;
    const float* k1 = ka->in[8] + (size_t)l * 8 * 128 * 128; const float* k2 = ka->in[9] + (size_t)l * 8 * 128 * 128;
    const float* pu = ka->in[10] + (size_t)l * NE * D; const float* pv = ka->in[11] + (size_t)l * NE * D;
    bf16_t* WQK = (bf16_t*)(ws + ws_wqk(l)); bf16_t* WOUT = (bf16_t*)(ws + ws_wout(l)); bf16_t* WIN = (bf16_t*)(ws + ws_win(l)); bf16_t* U16 = (bf16_t*)(ws + ws_tab(l));
    {
        LAS float* Ks = (LAS float*)lds;
        LAS float* Ws = (LAS float*)(lds + 128 * 132 * 4);
        const int IPB = (1024 + G - 1) / G, it0 = bid * IPB, it1 = min(1024, it0 + IPB);
        int gi_cur = -1; f32x4 pre[4];
        if (it0 < it1) {
#pragma unroll
            for (int m = 0; m < 4; ++m) { const int i = tid + 512 * m, r = i >> 5, c4 = (i & 31) * 4; pre[m] = *(const f32x4*)(wq + (size_t)((it0 & 63) * 64 + r) * 2048 + (it0 >> 6) * 128 + c4); } }
        for (int it = it0; it < it1; ++it) {
            const int gi = it >> 6, c0 = (it & 63) * 64;
            __syncthreads();
            if (gi != gi_cur) { gi_cur = gi;
                const float* key = ((gi & 1) ? k2 : k1) + (size_t)(gi >> 1) * 128 * 128;
                for (int i = tid; i < 4096; i += 512) { const int r = i >> 5, c4 = (i & 31) * 4; *(LAS f32x4*)(Ks + r * 132 + c4) = *(const f32x4*)(key + r * 128 + c4); } }
#pragma unroll
            for (int m = 0; m < 4; ++m) { const int i = tid + 512 * m, r = i >> 5, c4 = (i & 31) * 4; *(LAS f32x4*)(Ws + r * 132 + c4) = pre[m]; }
            __syncthreads();
            if (it + 1 < it1) {
#pragma unroll
                for (int m = 0; m < 4; ++m) { const int i = tid + 512 * m, r = i >> 5, c4 = (i & 31) * 4; pre[m] = *(const f32x4*)(wq + (size_t)(((it + 1) & 63) * 64 + r) * 2048 + ((it + 1) >> 6) * 128 + c4); } }
            const int ti = wave & 3, tj = wave >> 2, li = lane & 31, kh = lane >> 5;
            const LAS float* ap = Ks + (32 * ti + li) * 132 + 64 * kh; const LAS float* bp = Ws + (32 * tj + li) * 132 + 64 * kh;
            f32x16 acc;
#pragma unroll
            for (int r = 0; r < 16; ++r) acc[r] = 0.f;
#pragma unroll 4
            for (int s4 = 0; s4 < 16; ++s4) { const f32x4 a4 = *(const LAS f32x4*)(ap + 4 * s4), b4 = *(const LAS f32x4*)(bp + 4 * s4);
                acc = __builtin_amdgcn_mfma_f32_32x32x2f32(a4[0], b4[0], acc, 0, 0, 0); acc = __builtin_amdgcn_mfma_f32_32x32x2f32(a4[1], b4[1], acc, 0, 0, 0);
                acc = __builtin_amdgcn_mfma_f32_32x32x2f32(a4[2], b4[2], acc, 0, 0, 0); acc = __builtin_amdgcn_mfma_f32_32x32x2f32(a4[3], b4[3], acc, 0, 0, 0); }
            { const int c = c0 + 32 * tj + li; const float gg = ln2[c];
#pragma unroll
              for (int r = 0; r < 16; ++r) { const int n = 32 * ti + (r & 3) + 8 * (r >> 2) + 4 * kh; WQK[(size_t)(gi * 128 + n) * D + c] = (bf16_t)f2bf(acc[r] * gg); } }
        }
        __syncthreads();
    }
    const int gw = bid * NWAVES + wave, NGW = G * NWAVES;
    {
        unsigned char* U6 = (unsigned char*)U16; unsigned char* V4 = U6 + ROW4; float* SCU = (float*)(U6 + (size_t)NE * REC4); float* SCV = SCU + NE;
        f32x4 gq[4][4];
#pragma unroll
        for (int i = 0; i < 4; ++i)
#pragma unroll
            for (int m = 0; m < 4; ++m) gq[i][m] = *(const f32x4*)(ln2 + 1024 * i + 256 * m + 4 * lane);
        f32x4 uu[4][4], vv[4][4];
        const unsigned hm_ = (lane & 1) ? 65536u : 1u;
#define LDROW_(dst, src, rr) do { const float* p_ = (src) + (size_t)(rr) * D + 4 * lane; _Pragma("unroll") for (int i = 0; i < 4; ++i) _Pragma("unroll") for (int m = 0; m < 4; ++m) dst[i][m] = *(const f32x4*)(p_ + 1024 * i + 256 * m); } while (0)
#define H16_(v, inv) ((__builtin_amdgcn_cvt_scalef32_pk_fp4_f32(__builtin_amdgcn_cvt_scalef32_pk_fp4_f32(0u, (v)[0] * (inv), (v)[1] * (inv), 1.0f, 0), (v)[2] * (inv), (v)[3] * (inv), 1.0f, 1) & 0xffffu) * hm_)
#define QSWAP1_(x) ((unsigned)__builtin_amdgcn_update_dpp(0, (int)(x), 0xB1, 0xF, 0xF, false))
#define QSWAP2_(x) ((unsigned)__builtin_amdgcn_update_dpp(0, (int)(x), 0x4E, 0xF, 0xF, false))
#define PUTROW_(src, tab, rr, inv) do { _Pragma("unroll") for (int j = 0; j < 2; ++j) _Pragma("unroll") for (int m = 0; m < 4; ++m) { \
            unsigned da_ = H16_(src[2 * j][m], inv), db_ = H16_(src[2 * j + 1][m], inv); da_ |= QSWAP1_(da_); db_ |= QSWAP1_(db_); \
            const unsigned oa_ = QSWAP2_(da_), ob_ = QSWAP2_(db_); \
            if ((lane & 3) == 0) *(u32x4*)((tab) + (size_t)(rr) * REC4 + j * 1024 + 16 * (16 * m + (lane >> 2))) = (u32x4){da_, oa_, db_, ob_}; } } while (0)
        if (gw < NE) { LDROW_(uu, pu, gw); LDROW_(vv, pv, gw); }
        for (int r = gw; r < NE; r += NGW) {
            const int rn = r + NGW;
            { float au = 0.f;
#pragma unroll
              for (int i = 0; i < 4; ++i)
#pragma unroll
                  for (int m = 0; m < 4; ++m) { uu[i][m] *= gq[i][m]; au += (uu[i][m][0] * uu[i][m][0] + uu[i][m][1] * uu[i][m][1]) + (uu[i][m][2] * uu[i][m][2] + uu[i][m][3] * uu[i][m][3]); }
              au = sqrtf(wave_sum_dpp(au) * (1.0f / D)); const float iu = au > 0.f ? 2.0f / au : 0.f;
              if (lane == 0) SCU[r] = au * 0.5f;
              PUTROW_(uu, U6, r, iu); }
            if (rn < NE) LDROW_(uu, pu, rn);
            { float av = 0.f;
#pragma unroll
              for (int i = 0; i < 4; ++i)
#pragma unroll
                  for (int m = 0; m < 4; ++m) av += (vv[i][m][0] * vv[i][m][0] + vv[i][m][1] * vv[i][m][1]) + (vv[i][m][2] * vv[i][m][2] + vv[i][m][3] * vv[i][m][3]);
              av = sqrtf(wave_sum_dpp(av) * (1.0f / D)); const float iv = av > 0.f ? 2.0f / av : 0.f;
              if (lane == 0) SCV[r] = av * 0.5f;
              PUTROW_(vv, V4, r, iv); }
            if (rn < NE) LDROW_(vv, pv, rn);
        }
#undef LDROW_
#undef H16_
#undef QSWAP1_
#undef QSWAP2_
#undef PUTROW_
    }
    {
        LAS float* scr = (LAS float*)(lds + wave * 16384);
        constexpr int I_O = (D / 64) * (D / 32), I_IN = (D / 64) * (12288 / 32);
        for (int it = gw; it < I_O + I_IN; it += NGW) {
            if (it < I_O) transpose_item8(w_out, D, D, D, nullptr, US, (unsigned char*)WOUT, scr, it, lane);
            else transpose_item8(w_in, D, PW, 12288, ln1, US, (unsigned char*)WIN, scr, it - I_O, lane);
        }
    }
}

template <bool WITH_F>
__device__ __forceinline__ void prep_phase(const float* X, bf16_t* XB, float* RSTD, const float* w_in, const float* ln1, const float* bf, float* LOGF, LAS unsigned char* lds, int wave0) {
    FRESH_TID(); FRESH_LDS(lds); FRESH_BID();
    LAS unsigned short* gfs = (LAS unsigned short*)lds;
    if (WITH_F) {
        __syncthreads();
        for (int c = tid; c < D; c += 512) { const float g = ln1[c]; const float* wr = w_in + (size_t)c * PW + 12288;
#pragma unroll
            for (int j = 0; j < 10; ++j) gfs[j * D + c] = (unsigned short)f2bf(wr[j] * g); }
        __syncthreads();
    }
    const int gw = bid * NWAVES + wave, NGW = G * NWAVES;
    for (int m = gw; m < M; m += NGW) {
        const f32x4* xr = (const f32x4*)(X + (size_t)m * D) + lane;
        f32x4 v[16]; float ss = 0.f;
#pragma unroll
        for (int i = 0; i < 16; ++i) { v[i] = xr[64 * i]; ss += (v[i][0] * v[i][0] + v[i][1] * v[i][1]) + (v[i][2] * v[i][2] + v[i][3] * v[i][3]); }
        ss = wave_sum_dpp(ss);
        const float rstd = rsqrtf(ss * (1.0f / D) + 1e-6f);
        if (WITH_F) {
            unsigned* o8 = (unsigned*)((unsigned char*)XB + (size_t)m * D) + lane;
#pragma unroll
            for (int i = 0; i < 16; ++i) o8[64 * i] = pk4_fp8(v[i][0], v[i][1], v[i][2], v[i][3]);
        } else {
        u32x2* o = (u32x2*)(XB + (size_t)m * D) + lane;
#pragma unroll
        for (int i = 0; i < 16; ++i) { u32x2 w; w.x = pk2(v[i][0], v[i][1]); w.y = pk2(v[i][2], v[i][3]); o[64 * i] = w; }
        }
        if (lane == 0) RSTD[m] = rstd;
        if (WITH_F) {
            float mine = 0.f;
#pragma unroll 1
            for (int j = 0; j < 10; ++j) { float s = 0.f;
#pragma unroll
                for (int i = 0; i < 16; ++i) { const u32x2 gp = *(const LAS u32x2*)(gfs + j * D + 256 * i + 4 * lane);
                    s += (v[i][0] * bf_lo(gp.x) + v[i][1] * bf_hi(gp.x)) + (v[i][2] * bf_lo(gp.y) + v[i][3] * bf_hi(gp.y)); }
                s = wave_sum_dpp(s); if (lane == j) mine = s; }
            if (lane < 10) { const int b = m >> 11, s = m & 2047; LOGF[(size_t)(b * 10 + lane) * S + s] = logsig(mine * rstd + bf[lane]); }
        }
    }
}


__device__ __forceinline__ void load16_bf16(const bf16_t* p, float (&d)[16]) {
    const u32x4 a = *(const u32x4*)p, b = *(const u32x4*)(p + 8);
#pragma unroll
    for (int q = 0; q < 4; ++q) { d[2 * q] = bf_lo(a[q]); d[2 * q + 1] = bf_hi(a[q]); d[8 + 2 * q] = bf_lo(b[q]); d[8 + 2 * q + 1] = bf_hi(b[q]); }
}
#define RFL(x) __builtin_amdgcn_readfirstlane(x)
template <bool FINAL>
__device__ __forceinline__ void peer_uv_phase(const float* SC, const unsigned char* T4, const bf16_t* X1, void* XOv, const float* fg,
                                              unsigned char* XB8n, float* RSTDn, float* LOGFn, const float* w_in_n, const float* ln1_n, const float* bf_n, LAS unsigned char* lds, int wave0) {
    FRESH_TID(); FRESH_LDS(lds); FRESH_BID();
    LAS int* s_eid = (LAS int*)(lds + 81920 + wave * 1024); LAS float* s_w = (LAS float*)(lds + 81920 + wave * 1024 + 512); LAS float* s_su = (LAS float*)(lds + 90112 + wave * 512);
    const float* SCU = (const float*)(T4 + (size_t)NE * REC4); const float* SCV = SCU + NE;
    LAS unsigned short* gfs = (LAS unsigned short*)lds;
    if (!FINAL) {
        __syncthreads();
        for (int c = tid; c < D; c += 512) { const float g = ln1_n[c]; const float* wr = w_in_n + (size_t)c * PW + 12288;
#pragma unroll
            for (int j = 0; j < 10; ++j) gfs[j * D + c] = (unsigned short)f2bf(wr[j] * g); }
        __syncthreads();
    }
    const int gw = bid * NWAVES + wave, NGW = G * NWAVES;
    for (int tok = gw; tok < M; tok += NGW) {
        const bf16_t* x1 = X1 + (size_t)tok * D;
        i32x8 xq[2]; float rstd_tok;
        const float* sc = SC + (size_t)tok * 2048;
        float xn_[2][2][2];
#define LDSC_(hh) do { _Pragma("unroll") for (int u = 0; u < 2; ++u) _Pragma("unroll") for (int f = 0; f < 2; ++f) _Pragma("unroll") for (int r = 0; r < 2; ++r) xn_[u][f][r] = sc[((hh) + 4 * u) * 256 + f * 128 + r * 64 + lane]; } while (0)
        LDSC_(0);
        { const int sg_ = lane & 15, gp_ = lane >> 4; float t[2][2][16]; float ss_ = 0.f;
#pragma unroll
          for (int s2 = 0; s2 < 2; ++s2)
#pragma unroll
              for (int hf = 0; hf < 2; ++hf) { load16_bf16(x1 + 1024 * (2 * s2 + (gp_ & 1)) + 16 * (sg_ + 32 * hf + 16 * (gp_ >> 1)), t[s2][hf]);
#pragma unroll
                  for (int k = 0; k < 16; ++k) ss_ += t[s2][hf][k] * t[s2][hf][k]; }
          rstd_tok = rsqrtf(wave_sum_dpp(ss_) * (1.0f / D) + 1e-6f);
#pragma unroll
          for (int s2 = 0; s2 < 2; ++s2)
#pragma unroll
              for (int hf = 0; hf < 2; ++hf)
#pragma unroll
                  for (int q = 0; q < 4; ++q) xq[s2][4 * hf + q] = (int)pk4_fp8(t[s2][hf][4 * q] * rstd_tok, t[s2][hf][4 * q + 1] * rstd_tok, t[s2][hf][4 * q + 2] * rstd_tok, t[s2][hf][4 * q + 3] * rstd_tok); }
        LAS float* selv = (LAS float*)(lds + 94208 + wave * 512); LAS int* seli = (LAS int*)(lds + 94208 + wave * 512 + 256);
#define BALLOT(c) __builtin_amdgcn_ballot_w64(c)
#define MBCNT(m) ((int)__builtin_amdgcn_mbcnt_hi((unsigned)((m) >> 32), __builtin_amdgcn_mbcnt_lo((unsigned)(m), 0u)))
        for (int h = 0; h < 4; ++h) {
            float x[2][2][2]; unsigned kk[2][2][2];
#pragma unroll
            for (int u = 0; u < 2; ++u)
#pragma unroll
                for (int f = 0; f < 2; ++f)
#pragma unroll
                    for (int r = 0; r < 2; ++r) { const float v = xn_[u][f][r]; x[u][f][r] = v; kk[u][f][r] = (ordkey(v) & ~127u) | (unsigned)(127 - 64 * r - lane); }
            LDSC_(min(h + 1, 3));
            unsigned T[2][2] = {{0u, 0u}, {0u, 0u}}; int dn = 0;
            for (unsigned bm = 0x80000000u; bm != 0u && dn != 15; bm >>= 1) {
#pragma unroll
                for (int u = 0; u < 2; ++u)
#pragma unroll
                    for (int f = 0; f < 2; ++f) { const unsigned cand = T[u][f] | bm;
                        const int c = __builtin_popcountll(BALLOT(kk[u][f][0] >= cand)) + __builtin_popcountll(BALLOT(kk[u][f][1] >= cand));
                        T[u][f] = c >= 16 ? cand : T[u][f]; dn |= (c == 16) ? (1 << (2 * u + f)) : 0; }
            }
#pragma unroll
            for (int u = 0; u < 2; ++u)
#pragma unroll
                for (int f = 0; f < 2; ++f) { const bool s0 = kk[u][f][0] >= T[u][f], s1 = kk[u][f][1] >= T[u][f]; const unsigned long long m0 = BALLOT(s0), m1 = BALLOT(s1);
                    const int p0 = MBCNT(m0), p1 = __builtin_popcountll(m0) + MBCNT(m1);
                    if (s0) { selv[(2 * u + f) * 16 + (p0 & 15)] = x[u][f][0]; seli[(2 * u + f) * 16 + (p0 & 15)] = lane; }
                    if (s1) { selv[(2 * u + f) * 16 + (p1 & 15)] = x[u][f][1]; seli[(2 * u + f) * 16 + (p1 & 15)] = 64 + lane; } }
            asm volatile("" ::: "memory");
            float s4[2][4]; unsigned k4[2][4];
#pragma unroll
            for (int u = 0; u < 2; ++u) { const float va = selv[(2 * u) * 16 + (lane >> 2)]; const f32x4 vb = *(const LAS f32x4*)(selv + (2 * u + 1) * 16 + (lane & 3) * 4);
#pragma unroll
                for (int q = 0; q < 4; ++q) { s4[u][q] = va + vb[q]; k4[u][q] = (ordkey(s4[u][q]) & ~255u) | (unsigned)(255 - 4 * lane - q); } }
            unsigned T2[2] = {0u, 0u}; int d2 = 0;
            for (unsigned bm = 0x80000000u; bm != 0u && d2 != 3; bm >>= 1) {
#pragma unroll
                for (int u = 0; u < 2; ++u) { const unsigned cand = T2[u] | bm;
                    const int c = (__builtin_popcountll(BALLOT(k4[u][0] >= cand)) + __builtin_popcountll(BALLOT(k4[u][1] >= cand))) + (__builtin_popcountll(BALLOT(k4[u][2] >= cand)) + __builtin_popcountll(BALLOT(k4[u][3] >= cand)));
                    T2[u] = c >= 16 ? cand : T2[u]; d2 |= (c == 16) ? (1 << u) : 0; }
            }
#pragma unroll
            for (int u = 0; u < 2; ++u) {
                const unsigned mk = wave_max_u32(max(max(k4[u][0], k4[u][1]), max(k4[u][2], k4[u][3]))) & ~255u;
                const float mx = __builtin_bit_cast(float, (mk & 0x80000000u) ? (mk & 0x7fffffffu) : ~mk);
                const float cs = 1.4426950408889634f * rstd_tok;
                float p[4], ps = 0.f;
#pragma unroll
                for (int q = 0; q < 4; ++q) { p[q] = (k4[u][q] >= T2[u]) ? __builtin_amdgcn_exp2f((s4[u][q] - mx) * cs) : 0.f; ps += p[q]; }
                const float tot = wave_sum_dpp(ps);
                const int i1 = seli[(2 * u) * 16 + (lane >> 2)]; const u32x4 i2 = *(const LAS u32x4*)(seli + (2 * u + 1) * 16 + (lane & 3) * 4);
                int base = (h + 4 * u) * 16;
#pragma unroll
                for (int q = 0; q < 4; ++q) { const bool sl = k4[u][q] >= T2[u]; const unsigned long long m = BALLOT(sl); const int slot = base + (MBCNT(m) & 15); base += __builtin_popcountll(m);
                    if (sl) { const int e = ((i1 & 127) << 7) | (int)(i2[q] & 127u); s_eid[slot] = e; s_w[slot] = p[q] / tot * SCV[e]; s_su[slot] = SCU[e]; } }
            }
            asm volatile("" ::: "memory");
        }
#undef BALLOT
#undef MBCNT
#undef LDSC_
        LDS_WAIT(); asm volatile("" ::: "memory");
        {
            f32x2 acc2[2][16];
#define ACC(i, k) acc2[(i) >> 1][((i) & 1) * 8 + ((k) >> 1)][(k) & 1]
#pragma unroll
            for (int g = 0; g < 2; ++g)
#pragma unroll
                for (int k = 0; k < 16; ++k) acc2[g][k] = (f32x2){0.f, 0.f};
            const bool dg_ = ((lane & 15) >> 2) == (lane >> 4);
            const float mk0_ = (dg_ && (lane & 3) == 0) ? 1.f : 0.f, mk1_ = (dg_ && (lane & 3) == 1) ? 1.f : 0.f, mk2_ = (dg_ && (lane & 3) == 2) ? 1.f : 0.f, mk3_ = (dg_ && (lane & 3) == 3) ? 1.f : 0.f;
#define LOADREC4(dst, e) do { const u32x4* p_ = (const u32x4*)(T4 + (size_t)(e) * REC4) + lane; dst[0] = p_[0]; dst[1] = p_[64]; dst[2] = p_[128]; dst[3] = p_[192]; } while (0)
#define PROW4(row, j) do { f32x4 ac_ = {0.f, 0.f, 0.f, 0.f}; \
            ac_ = __builtin_amdgcn_mfma_scale_f32_16x16x128_f8f6f4((i32x8){(int)row[0][0], (int)row[0][1], (int)row[0][2], (int)row[0][3], 0, 0, 0, 0}, xq[0], ac_, 4, 0, 0, 0x7f7f7f7f, 0, 0x7f7f7f7f); \
            ac_ = __builtin_amdgcn_mfma_scale_f32_16x16x128_f8f6f4((i32x8){(int)row[1][0], (int)row[1][1], (int)row[1][2], (int)row[1][3], 0, 0, 0, 0}, xq[1], ac_, 4, 0, 0, 0x7f7f7f7f, 0, 0x7f7f7f7f); \
            const float pv_ = (ac_[0] * mk0_ + ac_[1] * mk1_) + (ac_[2] * mk2_ + ac_[3] * mk3_); \
            const float d_ = wave_sum_dpp(pv_) * s_su[j]; const float w_ = s_w[j] * gelu_erf(d_); const f32x2 w2_ = {w_, w_}; \
            _Pragma("unroll") for (int g_ = 0; g_ < 2; ++g_) { \
                u32x4 G_ = row[2 + g_]; asm volatile("" : "+v"(G_)); \
                _Pragma("unroll") for (int k_ = 0; k_ < 4; ++k_) { const unsigned d4_ = G_[k_]; \
                    acc2[g_][4 * k_] = __builtin_elementwise_fma(w2_, __builtin_amdgcn_cvt_scalef32_pk_f32_fp4(d4_, 1.0f, 0), acc2[g_][4 * k_]); acc2[g_][4 * k_ + 1] = __builtin_elementwise_fma(w2_, __builtin_amdgcn_cvt_scalef32_pk_f32_fp4(d4_, 1.0f, 1), acc2[g_][4 * k_ + 1]); \
                    acc2[g_][4 * k_ + 2] = __builtin_elementwise_fma(w2_, __builtin_amdgcn_cvt_scalef32_pk_f32_fp4(d4_, 1.0f, 2), acc2[g_][4 * k_ + 2]); acc2[g_][4 * k_ + 3] = __builtin_elementwise_fma(w2_, __builtin_amdgcn_cvt_scalef32_pk_f32_fp4(d4_, 1.0f, 3), acc2[g_][4 * k_ + 3]); } \
                asm volatile("" : "+v"(acc2[g_][0]), "+v"(acc2[g_][1]), "+v"(acc2[g_][2]), "+v"(acc2[g_][3]), "+v"(acc2[g_][4]), "+v"(acc2[g_][5]), "+v"(acc2[g_][6]), "+v"(acc2[g_][7]), \
                                  "+v"(acc2[g_][8]), "+v"(acc2[g_][9]), "+v"(acc2[g_][10]), "+v"(acc2[g_][11]), "+v"(acc2[g_][12]), "+v"(acc2[g_][13]), "+v"(acc2[g_][14]), "+v"(acc2[g_][15])); } } while (0)
            u32x4 r0[4], r1[4], r2[4], r3[4];
            { const int e_ = RFL(s_eid[0]); LOADREC4(r0, e_); } { const int e_ = RFL(s_eid[1]); LOADREC4(r1, e_); } { const int e_ = RFL(s_eid[2]); LOADREC4(r2, e_); } { const int e_ = RFL(s_eid[3]); LOADREC4(r3, e_); }
            for (int j = 0; j < 124; j += 4) {
                PROW4(r0, j + 0); { const int e_ = RFL(s_eid[j + 4]); LOADREC4(r0, e_); }
                PROW4(r1, j + 1); { const int e_ = RFL(s_eid[j + 5]); LOADREC4(r1, e_); }
                PROW4(r2, j + 2); { const int e_ = RFL(s_eid[j + 6]); LOADREC4(r2, e_); }
                PROW4(r3, j + 3); { const int e_ = RFL(s_eid[j + 7]); LOADREC4(r3, e_); }
            }
            PROW4(r0, 124); PROW4(r1, 125); PROW4(r2, 126); PROW4(r3, 127);
#undef PROW4
#undef LOADREC4
            float ss = 0.f;
#pragma unroll
            for (int i = 0; i < 4; ++i) { float t[16]; load16_bf16(x1 + 1024 * i + 16 * lane, t);
#pragma unroll
                for (int k = 0; k < 16; ++k) { ACC(i, k) += t[k]; ss += ACC(i, k) * ACC(i, k); } }
            ss = wave_sum_dpp(ss);
            const float rs = rsqrtf(ss * (1.0f / D) + 1e-6f);
            if (!FINAL) {
#pragma unroll
                for (int i = 0; i < 4; ++i) { u32x4 w8;
#pragma unroll
                    for (int q = 0; q < 4; ++q) w8[q] = pk4_fp8(ACC(i, 4 * q), ACC(i, 4 * q + 1), ACC(i, 4 * q + 2), ACC(i, 4 * q + 3));
                    *(u32x4*)(XB8n + (size_t)tok * D + 1024 * i + 16 * lane) = w8; }
                if (lane == 0) RSTDn[tok] = rs;
                float mine = 0.f;
#pragma unroll 1
                for (int j = 0; j < 10; ++j) { float s = 0.f;
#pragma unroll
                    for (int i = 0; i < 4; ++i) { const u32x4 g0 = *(const LAS u32x4*)(gfs + j * D + 1024 * i + 16 * lane), g1 = *(const LAS u32x4*)(gfs + j * D + 1024 * i + 16 * lane + 8);
#pragma unroll
                        for (int q = 0; q < 4; ++q) { s += ACC(i, 2 * q) * bf_lo(g0[q]) + ACC(i, 2 * q + 1) * bf_hi(g0[q]); s += ACC(i, 8 + 2 * q) * bf_lo(g1[q]) + ACC(i, 8 + 2 * q + 1) * bf_hi(g1[q]); } }
                    s = wave_sum_dpp(s); if (lane == j) mine = s; }
                if (lane < 10) { const int b_ = tok >> 11, s_ = tok & 2047; LOGFn[(size_t)(b_ * 10 + lane) * S + s_] = logsig(mine * rs + bf_n[lane]); }
            }
            if (FINAL) { float* xo = (float*)XOv + (size_t)tok * D;
#pragma unroll
                for (int i = 0; i < 4; ++i)
#pragma unroll
                    for (int q = 0; q < 4; ++q) { const int c = 1024 * i + 16 * lane + 4 * q; const f32x4 g_ = *(const f32x4*)(fg + c);
                        *(f32x4*)(xo + c) = (f32x4){ACC(i, 4 * q) * rs * g_[0], ACC(i, 4 * q + 1) * rs * g_[1], ACC(i, 4 * q + 2) * rs * g_[2], ACC(i, 4 * q + 3) * rs * g_[3]}; }
            } else { bf16_t* xo = (bf16_t*)XOv + (size_t)tok * D;
#pragma unroll
                for (int i = 0; i < 4; ++i) { u32x4 w0, w1;
#pragma unroll
                    for (int q = 0; q < 4; ++q) { w0[q] = pk2(ACC(i, 2 * q), ACC(i, 2 * q + 1)); w1[q] = pk2(ACC(i, 8 + 2 * q), ACC(i, 8 + 2 * q + 1)); }
                    *(u32x4*)(xo + 1024 * i + 16 * lane) = w0; *(u32x4*)(xo + 1024 * i + 16 * lane + 8) = w1; }
            }
        }
        LDS_WAIT(); asm volatile("" ::: "memory");
    }
#undef ACC
}
}
namespace at {
using namespace mk;
constexpr int QB = 256, KVB = 64, HD = 128;
constexpr int SHM_V = KVB * HD * 2, SHM_K = KVB * HD * 2;
constexpr int OFF_V = 0, OFF_K = 2 * SHM_V, OFF_WS = OFF_K + 2 * SHM_K, OFF_CUM = OFF_WS + 8 * 256, OFF_RT = OFF_CUM + 2048 * 4, OFF_MISC = OFF_RT + 640 * 4;
constexpr float LOG2E = 1.4426950408889634f;
constexpr float THR2 = 10.0f;
constexpr float SB_DONE = -100.0f;

#define AT_KSWZ(row, colB) ((row) * 256 + ((colB) ^ (((row) & 7) << 4)))
__device__ __forceinline__ int v_st(int k, int c) { const int kk = (k & ~0xC) | ((k & 4) << 1) | ((k & 8) >> 1); return ((kk >> 3) * 4 + (c >> 5)) * 512 + ((kk & 7) * 32 + (c & 31)) * 2; }
__device__ __forceinline__ int v_rd_base(int lane) { return ((lane & 3) << 3) | (((lane >> 2) & 3) << 6) | (((lane >> 4) & 1) << 5) | (((lane >> 5) & 1) << 8); }
constexpr int v_rd_off(int d0, int ks, int half) { return d0 * 512 + ks * 4096 + half * 2048; }
__device__ __forceinline__ int crow(int r, int hi) { return (r & 3) + 8 * (r >> 2) + 4 * hi; }
__device__ __forceinline__ unsigned cvtpk(float lo, float hi) { unsigned r; asm volatile("v_cvt_pk_bf16_f32 %0, %1, %2" : "=v"(r) : "v"(lo), "v"(hi)); return r; }
__device__ __forceinline__ float partner(float v, int hi) { auto rr = __builtin_amdgcn_permlane32_swap(__builtin_bit_cast(unsigned, v), __builtin_bit_cast(unsigned, v), false, false); return __builtin_bit_cast(float, hi ? rr[0] : rr[1]); }

__device__ __forceinline__ float xchg_max(float v, int hi) { return fmaxf(v, partner(v, hi)); }
__device__ __forceinline__ float xchg_sum(float v, int hi) { return v + partner(v, hi); }

__device__ __forceinline__ void pack_p(const f32x16& p0, const f32x16& p1, bf16x8& pa0, bf16x8& pa1, bf16x8& pa2, bf16x8& pa3) {
#define AT_PK4(P, B_, OUT) do { unsigned a0 = cvtpk(P[B_ + 0], P[B_ + 1]), a1 = cvtpk(P[B_ + 2], P[B_ + 3]); unsigned b0 = cvtpk(P[B_ + 4], P[B_ + 5]), b1 = cvtpk(P[B_ + 6], P[B_ + 7]); \
        auto r0 = __builtin_amdgcn_permlane32_swap(a0, b0, false, false); auto r1 = __builtin_amdgcn_permlane32_swap(a1, b1, false, false); \
        u32x4 w = {r0[0], r1[0], r0[1], r1[1]}; OUT = __builtin_bit_cast(bf16x8, w); } while (0)
    AT_PK4(p0, 0, pa0); AT_PK4(p0, 8, pa1); AT_PK4(p1, 0, pa2); AT_PK4(p1, 8, pa3);
#undef AT_PK4
}
template <int KBUF>
__device__ __forceinline__ void qkt(f32x16& p0, f32x16& p1, LAS unsigned char* K_lds, int r32, int hi, const bf16x8 (&qr)[8]) {
    p0 = f32x16{}; p1 = f32x16{};
    LAS unsigned char* kb[4];
#pragma unroll
    for (int dd = 0; dd < 4; ++dd) kb[dd] = K_lds + KBUF * SHM_K + AT_KSWZ(r32, (dd * 16 + hi * 8) * 2);
#pragma unroll
    for (int d0 = 0; d0 < 8; ++d0) { LAS unsigned char* a = kb[d0 & 3] + (d0 >> 2) * 128;
        const bf16x8 b0 = *(const LAS bf16x8*)a; const bf16x8 b1 = *(const LAS bf16x8*)(a + 32 * 256);
        p0 = __builtin_amdgcn_mfma_f32_32x32x16_bf16(b0, qr[d0], p0, 0, 0, 0);
        p1 = __builtin_amdgcn_mfma_f32_32x32x16_bf16(b1, qr[d0], p1, 0, 0, 0); }
}
template <int VBUF>
__device__ __forceinline__ void pv_tile(f32x16 (&o)[4], int vb0, bf16x8 pa0, bf16x8 pa1, bf16x8 pa2, bf16x8 pa3) {
#define AT_TRRD(dst, off) asm volatile("ds_read_b64_tr_b16 %0, %1 offset:%2" : "=&v"(dst) : "v"(vb0), "i"(off) : "memory")
#define AT_PV_D0(d0) do { s16x4 l0, l1, l2, l3, h0, h1, h2, h3; constexpr int b_ = VBUF * SHM_V + v_rd_off(d0, 0, 0); \
        AT_TRRD(l0, b_); AT_TRRD(h0, b_ + 2048); AT_TRRD(l1, b_ + 4096); AT_TRRD(h1, b_ + 6144); AT_TRRD(l2, b_ + 8192); AT_TRRD(h2, b_ + 10240); AT_TRRD(l3, b_ + 12288); AT_TRRD(h3, b_ + 14336); \
        asm volatile("s_waitcnt lgkmcnt(0)" ::: "memory"); __builtin_amdgcn_sched_barrier(0); \
        o[d0] = __builtin_amdgcn_mfma_f32_32x32x16_bf16(pa0, (bf16x8){l0[0], l0[1], l0[2], l0[3], h0[0], h0[1], h0[2], h0[3]}, o[d0], 0, 0, 0); \
        o[d0] = __builtin_amdgcn_mfma_f32_32x32x16_bf16(pa1, (bf16x8){l1[0], l1[1], l1[2], l1[3], h1[0], h1[1], h1[2], h1[3]}, o[d0], 0, 0, 0); \
        o[d0] = __builtin_amdgcn_mfma_f32_32x32x16_bf16(pa2, (bf16x8){l2[0], l2[1], l2[2], l2[3], h2[0], h2[1], h2[2], h2[3]}, o[d0], 0, 0, 0); \
        o[d0] = __builtin_amdgcn_mfma_f32_32x32x16_bf16(pa3, (bf16x8){l3[0], l3[1], l3[2], l3[3], h3[0], h3[1], h3[2], h3[3]}, o[d0], 0, 0, 0); } while (0)
    AT_PV_D0(0); AT_PV_D0(1); AT_PV_D0(2); AT_PV_D0(3);
#undef AT_PV_D0
#undef AT_TRRD
}

template <int VAR>
__device__ __forceinline__ void attn_item(const bf16_t* Qh, const bf16_t* Kh, const bf16_t* Vh, bf16_t* OB, const float* relb, const float* LOGF, int b, int h, int qb, LAS unsigned char* lds, int tid) {
    const int wid = __builtin_amdgcn_readfirstlane(tid >> 6), lane = tid & 63, r32 = lane & 31, hi = lane >> 5;
    const int g = VAR == 0 ? h : (VAR == 1 ? 12 + h : 22 + h);
    const size_t hb = (size_t)(b * NH + g) * S * HD;
    const bf16_t* Kp = Kh + hb; const bf16_t* Vp = Vh + hb;
    LAS unsigned char* V_lds = lds + OFF_V; LAS unsigned char* K_lds = lds + OFF_K;
    LAS float* wsf = (LAS float*)(lds + OFF_WS) + wid * 64; LAS float* li_l = wsf; LAS float* al_l = wsf + 32;
    LAS float* cumL = (LAS float*)(lds + OFF_CUM); LAS float* Rt = (LAS float*)(lds + OFF_RT); volatile LAS unsigned* flags = (volatile LAS unsigned*)(lds + OFF_MISC);
    const int P0 = qb * QB, qlo = P0 + wid * 32, qpos = qlo + r32;
    int NT, jlo = 0;
    if (VAR == 0) { jlo = 4 * qb - 8; if (jlo < 0) jlo = 0; NT = 4 * qb + 4 - jlo; } else NT = 4 * qb + 4;
    const int cw = 4 * qb + (wid >> 1);
#define AT_KBASE(t) (VAR == 1 ? (4 * qb + 3 - (t)) * KVB : (jlo + (t)) * KVB)
#define AT_ACT(t) (VAR == 0 ? ((jlo + (t)) >= cw - 8 && (jlo + (t)) <= cw) : (VAR == 1 ? (AT_KBASE(t) <= qlo + 30) : (AT_KBASE(t) <= qlo + 31)))
    if (VAR == 0) {
        const float* tab = relb + h * 257;
        for (int j = tid; j < 639; j += 512) { int rel = 575 - j; rel = rel < -128 ? -128 : (rel > 128 ? 128 : rel); Rt[j] = tab[rel + 128] * LOG2E; }
    }
    if (VAR == 2) {
        const float* lf = LOGF + (size_t)(b * 10 + h) * S; const int kend = P0 + QB;
        f32x4 v = (f32x4){0.f, 0.f, 0.f, 0.f};
        if (4 * tid < kend) v = *(const f32x4*)(lf + 4 * tid);
        v[1] += v[0]; v[2] += v[1]; v[3] += v[2];
        float tot = v[3];
#pragma unroll
        for (int o = 1; o < 64; o <<= 1) { const float t_ = lane_read(tot, lane >= o ? lane - o : lane); if (lane >= o) tot += t_; }
        if (lane == 63) li_l[0] = tot;
        __syncthreads();
        float base = tot - v[3];
        for (int w = 0; w < wid; ++w) base += ((LAS float*)(lds + OFF_WS))[w * 64];
        if (4 * tid < kend) *(LAS f32x4*)(cumL + 4 * tid) = (f32x4){(base + v[0]) * LOG2E, (base + v[1]) * LOG2E, (base + v[2]) * LOG2E, (base + v[3]) * LOG2E};
    }
    bf16x8 qr[8];
    { const bf16_t* qp = Qh + hb + (size_t)(qlo + r32) * HD + hi * 8;
#pragma unroll
      for (int d0 = 0; d0 < 8; ++d0) qr[d0] = *(const bf16x8*)(qp + d0 * 16); }
    const int sr = tid >> 4, sc = (tid & 15) * 8, vst0 = v_st(sr, sc), vst1 = v_st(32 + sr, sc), kws = AT_KSWZ(sr, sc * 2);
    const int vb0 = (int)(unsigned)(size_t)V_lds + v_rd_base(lane);
    bf16x8 st_k0, st_k1, st_v0, st_v1;
#define AT_SLOAD(k0) do { const bf16_t* kp_ = Kp + (size_t)((k0) + sr) * HD + sc; const bf16_t* vp_ = Vp + (size_t)((k0) + sr) * HD + sc; \
        st_k0 = *(const bf16x8*)kp_; st_k1 = *(const bf16x8*)(kp_ + 32 * HD); st_v0 = *(const bf16x8*)vp_; st_v1 = *(const bf16x8*)(vp_ + 32 * HD); } while (0)
#define AT_SWRITE(bf) do { *(LAS bf16x8*)(K_lds + (bf) * SHM_K + kws) = st_k0; *(LAS bf16x8*)(K_lds + (bf) * SHM_K + kws + 32 * 256) = st_k1; \
        *(LAS bf16x8*)(V_lds + (bf) * SHM_V + vst0) = st_v0; *(LAS bf16x8*)(V_lds + (bf) * SHM_V + vst1) = st_v1; } while (0)
    AT_SLOAD(AT_KBASE(0)); asm volatile("s_waitcnt vmcnt(0)" ::: "memory"); AT_SWRITE(0);
    __syncthreads();
    float m_reg = -1e30f, l_reg = 0.f, carry = 0.f;
    f32x16 o[4] = {};
#define AT_STEP(BUF, t) do { \
        const bool more_ = (t) + 1 < NT; \
        if (more_) AT_SLOAD(AT_KBASE((t) + 1)); \
        if (AT_ACT(t)) { \
            const int kb_ = AT_KBASE(t); f32x16 p0, p1; bf16x8 pa0, pa1, pa2, pa3; \
            qkt<BUF>(p0, p1, K_lds, r32, hi, qr); \
            tile_math(p0, p1, kb_, pa0, pa1, pa2, pa3); \
            pv_tile<BUF>(o, vb0, pa0, pa1, pa2, pa3); \
        } \
        if (more_) { asm volatile("s_waitcnt vmcnt(0)" ::: "memory"); AT_SWRITE((BUF) ^ 1); } \
        if (VAR == 1) { const bool done_ = __all(carry < SB_DONE); if (lane == 0) flags[((t) & 1) * 8 + wid] = done_ ? 1u : 0u; } \
        __syncthreads(); \
    } while (0)
    auto tile_math = [&](f32x16& p0, f32x16& p1, int kb, bf16x8& pa0, bf16x8& pa1, bf16x8& pa2, bf16x8& pa3) __attribute__((always_inline)) {
        const int dq = qpos - kb - 4 * hi;
        if (VAR == 1) {
            const bool need_mask = kb + 63 >= qlo;
            f32x16 n0, n1;
#pragma unroll
            for (int r = 0; r < 16; ++r) { const float z = p0[r]; const float lp = __builtin_amdgcn_logf(1.0f + __builtin_amdgcn_exp2f(-fabsf(z))); n0[r] = fminf(-z, 0.f) - lp;
                                           const float y = p1[r]; const float lq = __builtin_amdgcn_logf(1.0f + __builtin_amdgcn_exp2f(-fabsf(y))); n1[r] = fminf(-y, 0.f) - lq; }
            if (need_mask) {
#pragma unroll
                for (int r = 0; r < 16; ++r) { const int c = (r & 3) + 8 * (r >> 2);
                    if (dq - c <= 0) { n0[r] = 0.f; p0[r] = -__builtin_inff(); }
                    if (dq - c - 32 <= 0) { n1[r] = 0.f; p1[r] = -__builtin_inff(); } }
            }
            float A[8], Bp[8];
#pragma unroll
            for (int q = 0; q < 4; ++q) { A[q] = (n0[4 * q] + n0[4 * q + 1]) + (n0[4 * q + 2] + n0[4 * q + 3]); A[4 + q] = (n1[4 * q] + n1[4 * q + 1]) + (n1[4 * q + 2] + n1[4 * q + 3]); }
#pragma unroll
            for (int q = 0; q < 8; ++q) Bp[q] = partner(A[q], hi);
            float st = 0.f;
#pragma unroll
            for (int q = 7; q >= 0; --q) {
                const float after = carry + st + (hi == 0 ? Bp[q] : 0.f);
                if (q >= 4) { const int r0 = 4 * (q - 4);
                    float tl = after; p1[r0 + 3] = __builtin_amdgcn_exp2f(p1[r0 + 3] + n1[r0 + 3] + tl); tl += n1[r0 + 3]; p1[r0 + 2] = __builtin_amdgcn_exp2f(p1[r0 + 2] + n1[r0 + 2] + tl); tl += n1[r0 + 2];
                    p1[r0 + 1] = __builtin_amdgcn_exp2f(p1[r0 + 1] + n1[r0 + 1] + tl); tl += n1[r0 + 1]; p1[r0] = __builtin_amdgcn_exp2f(p1[r0] + n1[r0] + tl); }
                else { const int r0 = 4 * q;
                    float tl = after; p0[r0 + 3] = __builtin_amdgcn_exp2f(p0[r0 + 3] + n0[r0 + 3] + tl); tl += n0[r0 + 3]; p0[r0 + 2] = __builtin_amdgcn_exp2f(p0[r0 + 2] + n0[r0 + 2] + tl); tl += n0[r0 + 2];
                    p0[r0 + 1] = __builtin_amdgcn_exp2f(p0[r0 + 1] + n0[r0 + 1] + tl); tl += n0[r0 + 1]; p0[r0] = __builtin_amdgcn_exp2f(p0[r0] + n0[r0] + tl); }
                st += A[q] + Bp[q];
            }
            carry += st;
            pack_p(p0, p1, pa0, pa1, pa2, pa3);
        } else {
            if (VAR == 0) {
                const LAS float* rp = Rt + (575 - (qpos - kb) + 4 * hi);
#pragma unroll
                for (int r = 0; r < 16; ++r) { const int c = (r & 3) + 8 * (r >> 2); p0[r] += rp[c]; p1[r] += rp[c + 32]; }
            } else {
                const LAS float* cp = cumL + kb + 4 * hi;
#pragma unroll
                for (int q = 0; q < 4; ++q) { const f32x4 c0 = *(const LAS f32x4*)(cp + 8 * q), c1 = *(const LAS f32x4*)(cp + 32 + 8 * q);
                    p0[4 * q] -= c0[0]; p0[4 * q + 1] -= c0[1]; p0[4 * q + 2] -= c0[2]; p0[4 * q + 3] -= c0[3];
                    p1[4 * q] -= c1[0]; p1[4 * q + 1] -= c1[1]; p1[4 * q + 2] -= c1[2]; p1[4 * q + 3] -= c1[3]; }
                if (kb + 63 > qlo) {
#pragma unroll
                    for (int r = 0; r < 16; ++r) { const int c = (r & 3) + 8 * (r >> 2);
                        if (dq - c < 0) p0[r] = -__builtin_inff();
                        if (dq - c - 32 < 0) p1[r] = -__builtin_inff(); }
                }
            }
            float pmax = p0[0];
#pragma unroll
            for (int r = 1; r < 16; ++r) pmax = fmaxf(pmax, p0[r]);
#pragma unroll
            for (int r = 0; r < 16; ++r) pmax = fmaxf(pmax, p1[r]);
            pmax = xchg_max(pmax, hi);
            float mn, alpha;
            if (__all(pmax - m_reg <= THR2)) { mn = m_reg; alpha = 1.f; }
            else { mn = fmaxf(m_reg, pmax); alpha = __builtin_amdgcn_exp2f(m_reg - mn); m_reg = mn; }
            float ps = 0.f;
#pragma unroll
            for (int r = 0; r < 16; ++r) { p0[r] = __builtin_amdgcn_exp2f(p0[r] - mn); p1[r] = __builtin_amdgcn_exp2f(p1[r] - mn); ps += p0[r] + p1[r]; }
            ps = xchg_sum(ps, hi);
            l_reg = l_reg * alpha + ps;
            if (__any(alpha < 1.f)) {
                if (hi == 0) al_l[r32] = alpha;
                asm volatile("s_waitcnt lgkmcnt(0)" ::: "memory");
                float av[16];
#pragma unroll
                for (int r = 0; r < 16; ++r) av[r] = al_l[crow(r, hi)];
#pragma unroll
                for (int d = 0; d < 4; ++d)
#pragma unroll
                    for (int r = 0; r < 16; ++r) o[d][r] *= av[r];
            }
            pack_p(p0, p1, pa0, pa1, pa2, pa3);
        }
    };
    for (int t = 0; t < NT; t += 2) {
        AT_STEP(0, t);
        if (VAR == 1) { unsigned all_ = 1u; for (int w = 0; w < 8; ++w) all_ &= flags[(t & 1) * 8 + w]; if (all_) break; }
        if (t + 1 >= NT) break;
        AT_STEP(1, t + 1);
        if (VAR == 1) { unsigned all_ = 1u; for (int w = 0; w < 8; ++w) all_ &= flags[((t + 1) & 1) * 8 + w]; if (all_) break; }
    }
    float rli[16];
    if (VAR != 1) {
        if (hi == 0) li_l[r32] = l_reg;
        asm volatile("s_waitcnt lgkmcnt(0)" ::: "memory");
#pragma unroll
        for (int r = 0; r < 16; ++r) rli[r] = __builtin_amdgcn_rcpf(li_l[crow(r, hi)]);
    }
    unsigned char* Ow8 = (unsigned char*)OB + (size_t)(b * S + qlo) * D + g * HD;
    const unsigned bsel_ = (unsigned)(lane & 3) | ((4u + (unsigned)(lane & 3)) << 8);
#pragma unroll
    for (int r = 0; r < 16; ++r) { const int orow = crow(r, hi); const float sc_ = VAR != 1 ? rli[r] * 16.0f : 16.0f;
        const unsigned w = mk::pk4_fp8(o[0][r] * sc_, o[1][r] * sc_, o[2][r] * sc_, o[3][r] * sc_);
        const unsigned t0 = (unsigned)__builtin_amdgcn_update_dpp(0, (int)w, 0x00, 0xF, 0xF, false), t1 = (unsigned)__builtin_amdgcn_update_dpp(0, (int)w, 0x55, 0xF, 0xF, false),
                       t2 = (unsigned)__builtin_amdgcn_update_dpp(0, (int)w, 0xAA, 0xF, 0xF, false), t3 = (unsigned)__builtin_amdgcn_update_dpp(0, (int)w, 0xFF, 0xF, 0xF, false);
        const unsigned r01 = __builtin_amdgcn_perm(t1, t0, bsel_), r23 = __builtin_amdgcn_perm(t3, t2, bsel_);
        *(unsigned*)(Ow8 + (size_t)orow * D + (lane & 3) * 32 + (r32 & ~3)) = __builtin_amdgcn_perm(r23, r01, 0x05040100u); }
    __syncthreads();
#undef AT_STEP
#undef AT_SLOAD
#undef AT_SWRITE
#undef AT_KBASE
#undef AT_ACT
}

template <int VAR>
__device__ __forceinline__ void attn_queue(const bf16_t* Qh, const bf16_t* Kh, const bf16_t* Vh, bf16_t* OB, const float* relb, const float* LOGF, unsigned* qhead, LAS unsigned char* lds, int wave0) {
    FRESH_TID(); FRESH_LDS(lds);
    volatile LAS unsigned* qslot = (volatile LAS unsigned*)(lds + OFF_MISC) + 32;
    constexpr int NHV = VAR == 0 ? 12 : 10, NITEMS = 8 * NHV * 8;
    for (;;) {
        if (tid == 0) qslot[0] = __hip_atomic_fetch_add(qhead, 1u, __ATOMIC_RELAXED, __HIP_MEMORY_SCOPE_AGENT);
        __syncthreads();
        const int idx = (int)qslot[0];
        __syncthreads();
        if (idx >= NITEMS) break;
        const int qb = 7 - idx / (8 * NHV), bh = idx % (8 * NHV);
        attn_item<VAR>(Qh, Kh, Vh, OB, relb, LOGF, bh / NHV, bh % NHV, qb, lds, tid);
    }
}
__device__ __forceinline__ void attn_phase(const bf16_t* Qh, const bf16_t* Kh, const bf16_t* Vh, bf16_t* OB, const float* relb, const float* LOGF, unsigned* qheads, LAS unsigned char* lds, int wave0, mk::KArgsT ka, int conv_l) {
    int grp = (int)((blockIdx.x >> 3) & 3u); asm volatile("" : "+s"(grp));
    int cnt = 0; bool conv_done = conv_l < 0;
#pragma unroll 1
    for (int seg = 0; seg < 4; ++seg) {
        for (;;) {
            if (!conv_done && (cnt == grp || seg == 3)) { mk::conv_phase(ka, conv_l, lds, wave0); __syncthreads(); conv_done = true; }
            if (seg == 3) break;
            int idx;
            { FRESH_TID(); LAS unsigned char* l_ = lds; FRESH_LDS(l_); volatile LAS unsigned* qslot = (volatile LAS unsigned*)(l_ + OFF_MISC) + 32;
              if (tid == 0) qslot[0] = __hip_atomic_fetch_add(qheads + 64 * seg, 1u, __ATOMIC_RELAXED, __HIP_MEMORY_SCOPE_AGENT);
              __syncthreads();
              idx = (int)qslot[0];
              __syncthreads(); }
            const int NHV = seg == 1 ? 12 : 10;
            if (idx >= 64 * NHV) break;
            ++cnt;
            const int qb = 7 - idx / (8 * NHV), bh = idx % (8 * NHV);
            { FRESH_TID(); LAS unsigned char* l_ = lds; FRESH_LDS(l_);
              if (seg == 0) attn_item<2>(Qh, Kh, Vh, OB, relb, LOGF, bh / NHV, bh % NHV, qb, l_, tid);
              else if (seg == 1) attn_item<0>(Qh, Kh, Vh, OB, relb, LOGF, bh / NHV, bh % NHV, qb, l_, tid);
              else attn_item<1>(Qh, Kh, Vh, OB, relb, LOGF, bh / NHV, bh % NHV, qb, l_, tid); }
        }
    }
}
}
namespace mk {
#define XB_TMO      128
#define XB_XCNT(j)  (256  + 64 * (j))
#define XB_XSUB(j)  (1280 + 64 * (j))
#define XB_XGEN(j)  (2304 + 64 * (j))
#define XB_TOP      3328
#define XB_TOPGEN   3392
#define XCD_BAR_WORDS 3456
#define XB_SPIN_CAP (1u << 22)

__device__ __forceinline__ unsigned xb_ld(unsigned* p)              { return __hip_atomic_load(p, __ATOMIC_RELAXED, __HIP_MEMORY_SCOPE_AGENT); }
__device__ __forceinline__ unsigned xb_add(unsigned* p, unsigned v) { return __hip_atomic_fetch_add(p, v, __ATOMIC_RELAXED, __HIP_MEMORY_SCOPE_AGENT); }
__device__ __forceinline__ unsigned xb_xcc_id() { return (unsigned)__builtin_amdgcn_s_getreg((3 << 11) | 20) & 0xFu; }
#define XB_SPIN(cond, bar) do { unsigned _sp = 0; while (cond) { __builtin_amdgcn_s_sleep(1); \
    if ((++_sp & 255u) == 0u) { if (xb_ld(&(bar)[XB_TMO])) break; if (_sp > XB_SPIN_CAP) { atomicAdd(&(bar)[XB_TMO], 1u); break; } } } } while (0)

struct XcdBarrier {
    unsigned* bar; unsigned x;
    volatile LAS unsigned* st;
};

__device__ __forceinline__ XcdBarrier xcd_barrier_post(unsigned* bar, volatile LAS unsigned* st, bool is_t0) {
    XcdBarrier b; b.bar = bar; b.x = xb_xcc_id(); b.st = st;
    if (is_t0) (void)xb_add(&bar[XB_XCNT(b.x)], 1u);
    return b;
}
__device__ __forceinline__ void xcd_barrier_complete(unsigned* bar, unsigned x, unsigned& nloc, unsigned& nx) {
    const unsigned G = gridDim.x * gridDim.y * gridDim.z;
    unsigned sum, cnt, mine, sp = 0u;
    for (;;) {
        sum = 0u; cnt = 0u; mine = 0u;
#pragma unroll
        for (unsigned j = 0; j < 16; ++j) { const unsigned c = xb_ld(&bar[XB_XCNT(j)]); sum += c; cnt += (c > 0u) ? 1u : 0u; mine = (j == x) ? c : mine; }
        if (sum == G) break;
        __builtin_amdgcn_s_sleep(1);
        if ((++sp & 255u) == 0u) { if (xb_ld(&bar[XB_TMO])) break; if (sp > XB_SPIN_CAP) { atomicAdd(&bar[XB_TMO], 1u); break; } }
    }
    nloc = mine > 0u ? mine : 1u; nx = cnt > 0u ? cnt : 1u;
}

__device__ __forceinline__ void xcd_barrier(const XcdBarrier& b, bool is_t0) {
    asm volatile("s_waitcnt vmcnt(0)" ::: "memory");
    __syncthreads();
    if (is_t0) {
        unsigned* bar = b.bar;
        __builtin_amdgcn_s_waitcnt(0);
        unsigned nloc = b.st[0], nx = b.st[1];
        if (nloc == 0u) { xcd_barrier_complete(bar, b.x, nloc, nx); b.st[0] = nloc; b.st[1] = nx; }
        const unsigned old = xb_add(&bar[XB_XSUB(b.x)], 1u);
        const unsigned gen = old / nloc;
        if (old + 1u == (gen + 1u) * nloc) {
            __builtin_amdgcn_fence(__ATOMIC_RELEASE, "agent");
            asm volatile("s_waitcnt vmcnt(0)" ::: "memory");
            const unsigned og = xb_add(&bar[XB_TOP], 1u);
            const unsigned tg = og / nx;
            if (og + 1u == (tg + 1u) * nx) xb_add(&bar[XB_TOPGEN], 1u);
            else XB_SPIN(xb_ld(&bar[XB_TOPGEN]) == tg, bar);
            __builtin_amdgcn_fence(__ATOMIC_ACQUIRE, "agent");
            xb_add(&bar[XB_XGEN(b.x)], 1u);
            asm volatile("s_waitcnt vmcnt(0)" ::: "memory");
        } else {
            XB_SPIN(xb_ld(&bar[XB_XGEN(b.x)]) == gen, bar);
            __builtin_amdgcn_fence(__ATOMIC_ACQUIRE, "agent");
            asm volatile("s_waitcnt vmcnt(0)" ::: "memory");
        }
    }
    __syncthreads();
}

constexpr int PH_PER_LAYER = 8;
typedef const __attribute__((address_space(4))) Args* KArgs;
#define KARGS() ({ KArgs p_ = (KArgs)__builtin_amdgcn_kernarg_segment_ptr(); asm volatile("" : "+s"(p_)); p_; })
#define GRID_BAR() do { KArgs k_ = KARGS(); XcdBarrier b_; b_.bar = (unsigned*)(k_->ws + WS_CTL) + CW_BAR; b_.x = xb_xcc_id(); b_.st = (volatile LAS unsigned*)(lds + MISC_OFF) + 8; unsigned z_ = 0u; asm volatile("" : "+v"(z_)); const bool t0_ = (wave0 == 0) && (__builtin_amdgcn_mbcnt_hi(~0u, __builtin_amdgcn_mbcnt_lo(~0u, z_)) == 0u);     xcd_barrier(b_, t0_); } while (0)
__global__ void __launch_bounds__(NWAVES * 64, 2) mk_fwd(Args a_unused) {
    extern __shared__ __attribute__((aligned(16))) unsigned char lds_raw[];
    LAS unsigned char* lds = (LAS unsigned char*)lds_raw;
    const int wave0 = __builtin_amdgcn_readfirstlane((int)threadIdx.x >> 6);
    for (int u = threadIdx.x; u < (LDS_BYTES - LDSCTL_OFF) / 4; u += NWAVES * 64) ((LAS unsigned*)(lds + LDSCTL_OFF))[u] = 0u;
    __syncthreads();
    int lo, hi;
    { KArgs k = KARGS(); lo = k->ph_lo; hi = k->ph_hi;
      if (hi - lo > 1) (void)xcd_barrier_post((unsigned*)(k->ws + WS_CTL) + CW_BAR, (volatile LAS unsigned*)(lds + MISC_OFF) + 8, threadIdx.x == 0); }
#define IN(k) (lo <= (k) && (k) < hi)
#define BOTH(k) (IN(k) && IN((k) + 1))
#pragma unroll
    for (int l = 0; l < 2; ++l) {
        const int pb = PH_PER_LAYER * l;
        if (IN(pb + 0) && l == 0) { KArgs k = KARGS(); conv_phase(k, l, lds, wave0); }
        if (IN(pb + 1) && l == 0) {
            KArgs k = KARGS(); unsigned char* ws = k->ws;
            const float* xin = k->in[0];
            prep_phase<true>(xin, (bf16_t*)(ws + WS_XB8N), (float*)(ws + WS_RSTD), k->in[2] + (size_t)l * D * PW, k->in[1] + (size_t)l * D, k->in[3] + l * 10, (float*)(ws + WS_LOGF), lds, wave0);
            if (BOTH(pb + 1)) GRID_BAR();
        }
        if (IN(pb + 2)) {
            KArgs k = KARGS(); unsigned char* ws = k->ws;
            pg8::Gemm g{(const bf16_t*)(ws + WS_XB8N), (const bf16_t*)(ws + ws_win(l)), M, 12288, D}; pg8::StaticOrder So; FRESH_BID(); So.init(M, 12288, G, bid);
            pg8::EpiQKV4 E{(bf16_t*)(ws + WS_Q), (const float*)(ws + WS_RSTD), 0.08838834764831845f * 1.4426950408889634f, US_INV};
            { LAS unsigned char* lds_ = lds; FRESH_LDS(lds_); FRESH_TID(); pg8::gemm_phase<pg8::EpiQKV4, pg8::StaticOrder, true, true, true>(lds_, g, So, E, tid); }
            if (BOTH(pb + 2)) GRID_BAR();
        }
        if (IN(pb + 3)) {
            KArgs k = KARGS(); unsigned char* ws = k->ws;
            at::attn_phase((const bf16_t*)(ws + WS_Q), (const bf16_t*)(ws + WS_K), (const bf16_t*)(ws + WS_V), (bf16_t*)(ws + WS_OB), k->in[4] + (size_t)l * 12 * 257, (const float*)(ws + WS_LOGF),
                           (unsigned*)(ws + WS_CTL) + CW_QUEUE + 256 * l, lds, wave0, k, l == 0 ? 1 : -1);
            if (BOTH(pb + 3)) GRID_BAR();
        }
        if (IN(pb + 4)) {
            KArgs k = KARGS(); unsigned char* ws = k->ws;
            pg8::Gemm g{(const bf16_t*)(ws + WS_OB), (const bf16_t*)(ws + ws_wout(l)), M, D, D}; pg8::StaticOrder So; FRESH_BID(); So.init(M, D, G, bid);
            if (l == 0) { pg8::EpiResidB16<true> E{k->in[0], US_INV * (1.0f / 16.0f), (bf16_t*)(ws + WS_XB)};
                { LAS unsigned char* lds_ = lds; FRESH_LDS(lds_); FRESH_TID(); pg8::gemm_phase<pg8::EpiResidB16<true>, pg8::StaticOrder, false, true, true>(lds_, g, So, E, tid); } }
            else { pg8::EpiResidB16<false> E{ws + WS_X2, US_INV * (1.0f / 16.0f), (bf16_t*)(ws + WS_XB)};
                { LAS unsigned char* lds_ = lds; FRESH_LDS(lds_); FRESH_TID(); pg8::gemm_phase<pg8::EpiResidB16<false>, pg8::StaticOrder, false, true, true>(lds_, g, So, E, tid); } }
            if (BOTH(pb + 4)) GRID_BAR();
        }
        if (IN(pb + 5)) {
            KArgs k = KARGS(); unsigned char* ws = k->ws;
            pg8::Gemm g{(const bf16_t*)(ws + WS_XB), (const bf16_t*)(ws + ws_wqk(l)), M, 2048, D}; pg8::StaticOrder So; FRESH_BID(); So.init(M, 2048, G, bid);
            pg8::EpiPlainF32<2048> E{(float*)(ws + WS_SC)};
            { LAS unsigned char* lds_ = lds; FRESH_LDS(lds_); FRESH_TID(); pg8::gemm_phase<pg8::EpiPlainF32<2048>, pg8::StaticOrder, true, true>(lds_, g, So, E, tid); }
            if (BOTH(pb + 5)) GRID_BAR();
        }
        if (IN(pb + 6)) {
            KArgs k = KARGS(); unsigned char* ws = k->ws;
            if (l == 0) peer_uv_phase<false>((const float*)(ws + WS_SC), (const unsigned char*)(ws + ws_tab(l)), (const bf16_t*)(ws + WS_XB), ws + WS_X2, nullptr,
                                             ws + WS_XB8N, (float*)(ws + WS_RSTD), (float*)(ws + WS_LOGF), k->in[2] + (size_t)D * PW, k->in[1] + D, k->in[3] + 10, lds, wave0);
            else peer_uv_phase<true>((const float*)(ws + WS_SC), (const unsigned char*)(ws + ws_tab(l)), (const bf16_t*)(ws + WS_XB), k->out, k->in[12],
                                     nullptr, nullptr, nullptr, nullptr, nullptr, nullptr, lds, wave0);
            if (BOTH(pb + 7)) GRID_BAR();
        }
    }
#undef IN
#undef BOTH
}

static int g_grid = 0;
static void launch_phases(Args a, int lo, int hi, hipStream_t st) {
    a.ph_lo = lo; a.ph_hi = hi;
    hipLaunchKernelGGL(mk_fwd, dim3(g_grid), dim3(NWAVES * 64), LDS_BYTES, st, a);
}
}

extern "C" void kernel_launch(void* const* d_in, const int* in_sizes, int n_in, void* d_out, int out_size, void* d_ws, size_t ws_size, hipStream_t stream) {
    (void)in_sizes; (void)n_in; (void)out_size;
    using namespace mk;
    if (g_grid == 0) {
        if (ws_size < 2048 * MiB) { fprintf(stderr, "kernel_launch: workspace too small (%zu)\n", ws_size); g_grid = -1; return; }
        if (hipFuncSetAttribute((const void*)mk_fwd, hipFuncAttributeMaxDynamicSharedMemorySize, LDS_BYTES) != hipSuccess) { fprintf(stderr, "kernel_launch: hipFuncSetAttribute failed\n"); g_grid = -1; return; }
        int dev = 0, cus = 0; (void)hipGetDevice(&dev); (void)hipDeviceGetAttribute(&cus, hipDeviceAttributeMultiprocessorCount, dev);
        g_grid = cus > 0 ? cus : 256;
    }
    if (g_grid < 0) return;
    unsigned char* ws = (unsigned char*)d_ws; float* out = (float*)d_out;
    (void)hipMemsetAsync(ws + WS_CTL, 0, CTL_ZERO_BYTES, stream);
    Args a{};
    for (int i = 0; i < 13; ++i) a.in[i] = (const float*)d_in[i];
    a.out = out; a.ws = ws;
    launch_phases(a, 0, 2 * PH_PER_LAYER, stream);
}
```

```cpp
#include <hip/hip_runtime.h>
#include <cstdio>
#include <cstdint>
namespace pg8 {
#define PG8_LAS __attribute__((address_space(3)))
typedef unsigned short bf16_t;
typedef short bf16x8 __attribute__((ext_vector_type(8)));
typedef float f32x4 __attribute__((ext_vector_type(4)));
typedef unsigned u32x4 __attribute__((ext_vector_type(4)));
typedef unsigned u32x2 __attribute__((ext_vector_type(2)));
constexpr int BM = 256, BK = 64, HALF = 128, HTB = HALF * BK * 2  , STAGE_BYTES = 8 * HTB, NXCD = 8, WGM = 8;

__host__ __device__ __forceinline__ int lds_byte(int r, int c) { const int st = (r >> 4) * 2 + (c >> 5), rr = r & 15, cc = c & 31, ob = rr * 64 + cc * 2; return st * 1024 + (ob ^ (((ob >> 9) & 1) << 5)); }
__host__ __device__ __forceinline__ void stage_rc(int b, int& R, int& C) { const int st = b / 1024, sb = b % 1024, swz = sb ^ (((sb >> 9) & 1) << 5); R = (st >> 1) * 16 + swz / 64; C = (st & 1) * 32 + (swz % 64) / 2; }
__host__ __device__ __forceinline__ int perm32(int rho) { const int n = rho >> 4, i = rho & 15; return 8 * (i >> 2) + 4 * n + (i & 3); }

struct Unit { int pm, pn; };
struct Gemm { const bf16_t* A; const bf16_t* Bt; int M, N, K; };

struct StaticOrder {
    int nM, nN, nwg, G, c;
    __host__ __device__ void init(int M, int N, int G_, int c_) { nM = M / BM; nN = N / BM; nwg = nM * nN; G = G_; c = c_; }
    __host__ __device__ bool next(int i, Unit& u) const {
        const long L = (long)i * G + c; if (L >= nwg) return false;
        int wgid = (int)L; { const int q = nwg / NXCD, r = nwg % NXCD, xcd = wgid % NXCD, off = wgid / NXCD; wgid = (xcd < r ? xcd * (q + 1) : r * (q + 1) + (xcd - r) * q) + off; }
        const int nig = WGM * nN, gid = wgid / nig, fm = gid * WGM, gsz = (nM - fm) < WGM ? (nM - fm) : WGM;
        u.pm = fm + ((wgid % nig) % gsz); u.pn = (wgid % nig) / gsz; return true;
    }
    __device__ __forceinline__ void a_ready(const Unit&) const {}
    __device__ __forceinline__ void done(const Unit&) const {}
};
__device__ __forceinline__ unsigned cvt_pk_bf16(float lo, float hi) { unsigned r; asm volatile("v_cvt_pk_bf16_f32 %0, %1, %2" : "=v"(r) : "v"(lo), "v"(hi)); return r; }
typedef float f32x2 __attribute__((ext_vector_type(2)));
__device__ __forceinline__ f32x2 gelu_pk(f32x2 v) {
    const f32x2 av = __builtin_elementwise_abs(v), d = av * 0.2316418882f + 1.0f;
    f32x2 t; t.x = __builtin_amdgcn_rcpf(d.x); t.y = __builtin_amdgcn_rcpf(d.y);
    f32x2 q = t * 0.5307027145f + (-0.7265760135f); q = q * t + 0.7107068705f; q = q * t + (-0.142248368f); q = q * t + 0.127414796f; q = q * t;
    const f32x2 s = (v * v) * (-0.72134752044f);
    f32x2 e; e.x = __builtin_amdgcn_exp2f(s.x); e.y = __builtin_amdgcn_exp2f(s.y);
    const f32x2 m = v * (q * e), r = v - m;
    f32x2 o; o.x = v.x < 0.f ? m.x : r.x; o.y = v.y < 0.f ? m.y : r.y; return o;
}
#define EPI_FRESH_LANE() { unsigned z_ = 0u; asm volatile("" : "+v"(z_)); const int l_ = (int)__builtin_amdgcn_mbcnt_hi(~0u, __builtin_amdgcn_mbcnt_lo(~0u, z_)); fr = l_ & 15; fq = l_ >> 4; }
typedef __amdgpu_buffer_rsrc_t rsrc_t;
__device__ __forceinline__ rsrc_t mkrsrc(const void* p, unsigned bytes) { return __builtin_amdgcn_make_buffer_rsrc((void*)p, (short)0, (int)bytes, 0x00020000); }
template <int LDC> struct EpiPlainF32 {
    static constexpr bool PERM = false, AFTER_DRAIN = false;
    float* C;
    __device__ __forceinline__ void operator()(const f32x4 (&acc)[2][2][4][2], const Unit& u, int wr, int wc, int fr, int fq) const {
        EPI_FRESH_LANE();
        const rsrc_t rc = mkrsrc(C, 16384u * LDC * 4u);
        const int vo = ((wr * 64 + fr) * LDC + wc * 32 + 4 * fq) * 4, so = (u.pm * BM * LDC + u.pn * BM) * 4;
#pragma unroll
        for (int ai = 0; ai < 2; ++ai)
#pragma unroll
            for (int m = 0; m < 4; ++m)
#pragma unroll
                for (int bj = 0; bj < 2; ++bj)
#pragma unroll
                    for (int n = 0; n < 2; ++n) __builtin_amdgcn_raw_buffer_store_b128(__builtin_bit_cast(u32x4, acc[ai][bj][m][n]), rc, vo, so + ((ai * HALF + m * 16) * LDC + bj * HALF + n * 16) * 4, 0);
    }
};
template <int LDC> struct EpiRowScaleF32 {
    static constexpr bool PERM = false, AFTER_DRAIN = false;
    float* C; const float* rs;
    __device__ __forceinline__ void operator()(const f32x4 (&acc)[2][2][4][2], const Unit& u, int wr, int wc, int fr, int fq) const {
        const rsrc_t rc = mkrsrc(C, 16384u * LDC * 4u), rr = mkrsrc(rs, 16384u * 4u);
        const int vo = ((wr * 64 + fr) * LDC + wc * 32 + 4 * fq) * 4, vr = (wr * 64 + fr) * 4;
        const int so = (u.pm * BM * LDC + u.pn * BM) * 4, sr = u.pm * BM * 4;
#pragma unroll
        for (int ai = 0; ai < 2; ++ai)
#pragma unroll
            for (int m = 0; m < 4; ++m) { const float s = __builtin_bit_cast(float, __builtin_amdgcn_raw_buffer_load_b32(rr, vr, sr + (ai * HALF + m * 16) * 4, 0));
#pragma unroll
                for (int bj = 0; bj < 2; ++bj)
#pragma unroll
                    for (int n = 0; n < 2; ++n) { const f32x4 v = acc[ai][bj][m][n] * s; __builtin_amdgcn_raw_buffer_store_b128(__builtin_bit_cast(u32x4, v), rc, vo, so + ((ai * HALF + m * 16) * LDC + bj * HALF + n * 16) * 4, 0); } }
    }
};
__device__ __forceinline__ u32x4 widen_pair(unsigned x0, unsigned x1, unsigned y0, unsigned y1, int lane_, int fq_) {
    const bool odd = fq_ & 1; const int pa = (lane_ ^ 16) << 2;
    const unsigned r0 = (unsigned)__builtin_amdgcn_ds_bpermute(pa, (int)(odd ? x0 : y0)), r1 = (unsigned)__builtin_amdgcn_ds_bpermute(pa, (int)(odd ? x1 : y1));
    return odd ? (u32x4){r0, r1, y0, y1} : (u32x4){x0, x1, r0, r1};
}
template <bool BASE_F32> struct EpiResidB16 {
    static constexpr bool PERM = false, AFTER_DRAIN = false;
    const void* base; float ascale; bf16_t* xb;
    __device__ __forceinline__ void operator()(const f32x4 (&acc)[2][2][4][2], const Unit& u, int wr, int wc, int fr, int fq) const {
        EPI_FRESH_LANE();
        constexpr int LDC = 4096;
        const rsrc_t rb = mkrsrc(base, 16384u * LDC * (BASE_F32 ? 4u : 2u)), rx = mkrsrc(xb, 16384u * LDC * 2u);
        const int vo = ((wr * 64 + fr) * LDC + wc * 32 + 4 * fq) * 2;
        const int so = (u.pm * BM * LDC + u.pn * BM) * 2;
        const int vo8 = ((wr * 64 + fr) * LDC + wc * 32 + (fq & 1) * 16 + (fq >> 1) * 8) * 2;
        f32x4 ra[2][2], rb2[2][2];
#define EPI_LD(dst, g_) do { _Pragma("unroll") for (int bj = 0; bj < 2; ++bj) _Pragma("unroll") for (int n = 0; n < 2; ++n) { \
            const int o = so + ((((g_) >> 2) * HALF + ((g_) & 3) * 16) * LDC + bj * HALF + n * 16) * 2; \
            if constexpr (BASE_F32) dst[bj][n] = __builtin_bit_cast(f32x4, __builtin_amdgcn_raw_buffer_load_b128(rb, vo * 2, o * 2, 0)); \
            else { const u32x2 t_ = __builtin_amdgcn_raw_buffer_load_b64(rb, vo, o, 0); dst[bj][n] = (f32x4){__builtin_bit_cast(float, t_.x << 16), __builtin_bit_cast(float, t_.x & 0xffff0000u), __builtin_bit_cast(float, t_.y << 16), __builtin_bit_cast(float, t_.y & 0xffff0000u)}; } } } while (0)
#define EPI_ST(src, g_) do { _Pragma("unroll") for (int bj = 0; bj < 2; ++bj) { \
            const int o = so + ((((g_) >> 2) * HALF + ((g_) & 3) * 16) * LDC + bj * HALF) * 2; \
            const f32x4 v0 = src[bj][0] + acc[(g_) >> 2][bj][(g_) & 3][0] * ascale, v1 = src[bj][1] + acc[(g_) >> 2][bj][(g_) & 3][1] * ascale; \
            const u32x4 w16 = widen_pair(cvt_pk_bf16(v0[0], v0[1]), cvt_pk_bf16(v0[2], v0[3]), cvt_pk_bf16(v1[0], v1[1]), cvt_pk_bf16(v1[2], v1[3]), 16 * fq + fr, fq); \
            __builtin_amdgcn_raw_buffer_store_b128(w16, rx, vo8, o, 0); } } while (0)
        EPI_LD(ra, 0);
        EPI_LD(rb2, 1); EPI_ST(ra, 0);
        EPI_LD(ra, 2); EPI_ST(rb2, 1);
        EPI_LD(rb2, 3); EPI_ST(ra, 2);
        EPI_LD(ra, 4); EPI_ST(rb2, 3);
        EPI_LD(rb2, 5); EPI_ST(ra, 4);
        EPI_LD(ra, 6); EPI_ST(rb2, 5);
        EPI_LD(rb2, 7); EPI_ST(ra, 6);
        EPI_ST(rb2, 7);
#undef EPI_LD
#undef EPI_ST
    }
};
struct EpiQKV {
    static constexpr bool PERM = true, AFTER_DRAIN = false;
    bf16_t* Q; const float* rs; float qscale;
    __device__ __forceinline__ void operator()(const f32x4 (&acc)[2][2][4][2], const Unit& u, int wr, int wc, int fr, int fq) const {
        const rsrc_t rq = mkrsrc(Q, 3u * 16384u * 4096u * 2u), rr = mkrsrc(rs, 16384u * 4u);
        const int colt = u.pn * BM, which = colt >> 12, cw = colt & 4095, gt = cw >> 7;
        const int b = (u.pm * BM) >> 11, st = (u.pm * BM) & 2047;
        const float sc = which == 0 ? qscale : 1.f;
        const int so = (int)(((unsigned)which << 26) + (((unsigned)(b * 32 + gt) * 2048u + (unsigned)st) << 7)) * 2;
        const int vo = (((wr * 64 + fr) << 7) + wc * 32 + 8 * fq) * 2, vr = (wr * 64 + fr) * 4, sr = u.pm * BM * 4;
#pragma unroll
        for (int ai = 0; ai < 2; ++ai)
#pragma unroll
            for (int m = 0; m < 4; ++m) { const float f = sc * __builtin_bit_cast(float, __builtin_amdgcn_raw_buffer_load_b32(rr, vr, sr + (ai * HALF + m * 16) * 4, 0));
#pragma unroll
                for (int bj = 0; bj < 2; ++bj) {
                    const f32x4 v0 = acc[ai][bj][m][0] * f, v1 = acc[ai][bj][m][1] * f;
                    u32x4 w; w.x = cvt_pk_bf16(v0[0], v0[1]); w.y = cvt_pk_bf16(v0[2], v0[3]); w.z = cvt_pk_bf16(v1[0], v1[1]); w.w = cvt_pk_bf16(v1[2], v1[3]);
                    __builtin_amdgcn_raw_buffer_store_b128(w, rq, vo, so + ((bj * 2048 + ai * HALF + m * 16) << 7) * 2, 0); } }
    }
};

struct EpiQKV4 {
    static constexpr bool PERM = false, AFTER_DRAIN = false;
    bf16_t* Q; const float* rs; float qscale, wscale;
    __device__ __forceinline__ void operator()(const f32x4 (&acc)[2][2][4][2], const Unit& u, int wr, int wc, int fr, int fq) const {
        EPI_FRESH_LANE();
        const rsrc_t rq = mkrsrc(Q, 3u * 16384u * 4096u * 2u), rr = mkrsrc(rs, 16384u * 4u);
        const int colt = u.pn * BM, which = colt >> 12, cw = colt & 4095, gt = cw >> 7;
        const int b = (u.pm * BM) >> 11, st = (u.pm * BM) & 2047;
        const float sc = (which == 0 ? qscale : 1.f) * wscale;
        const int so = (int)(((unsigned)which << 26) + (((unsigned)(b * 32 + gt) * 2048u + (unsigned)st) << 7)) * 2;
        const int vo8 = (((wr * 64 + fr) << 7) + wc * 32 + (fq & 1) * 16 + (fq >> 1) * 8) * 2, vr = (wr * 64 + fr) * 4, sr = u.pm * BM * 4;
        unsigned rsv[2][4];
#pragma unroll
        for (int ai = 0; ai < 2; ++ai)
#pragma unroll
            for (int m = 0; m < 4; ++m) rsv[ai][m] = __builtin_amdgcn_raw_buffer_load_b32(rr, vr, sr + (ai * HALF + m * 16) * 4, 0);
#pragma unroll
        for (int ai = 0; ai < 2; ++ai)
#pragma unroll
            for (int m = 0; m < 4; ++m) { const float f = sc * __builtin_bit_cast(float, rsv[ai][m]);
#pragma unroll
                for (int bj = 0; bj < 2; ++bj) {
                    const f32x4 v0 = acc[ai][bj][m][0] * f, v1 = acc[ai][bj][m][1] * f;
                    const u32x4 w16 = widen_pair(cvt_pk_bf16(v0[0], v0[1]), cvt_pk_bf16(v0[2], v0[3]), cvt_pk_bf16(v1[0], v1[1]), cvt_pk_bf16(v1[2], v1[3]), 16 * fq + fr, fq);
                    __builtin_amdgcn_raw_buffer_store_b128(w16, rq, vo8, so + (((bj * 2048 + ai * HALF + m * 16) << 7)) * 2, 0); } }
    }
};

typedef int i32x8 __attribute__((ext_vector_type(8)));
template <bool F8> struct FragT { typedef bf16x8 type; };
template <> struct FragT<true> { typedef i32x8 type; };
__device__ __forceinline__ f32x4 mma_bf16(bf16x8 a, bf16x8 b, f32x4 c) { return __builtin_amdgcn_mfma_f32_16x16x32_bf16(a, b, c, 0, 0, 0); }
__device__ __forceinline__ f32x4 mma_bf16(i32x8, i32x8, f32x4 c) { return c; }
template <class Epi, class Sched, bool ALIGN_EPI = false, bool SP2 = false, bool F8 = false>
__device__ __forceinline__ void gemm_phase(PG8_LAS unsigned char* lds, const Gemm g, const Sched& S, const Epi& E, int tid_in) {
    int tid_ = tid_in;
    const int tid = tid_, wid = __builtin_amdgcn_readfirstlane(tid >> 6), lane = tid & 63, wr = wid >> 2, wc = wid & 3, fr = lane & 15, fq = lane >> 4;
    constexpr int EB = F8 ? 1 : 2;
    constexpr int K = 4096; constexpr int nt = (K * EB) / (BK * 2);
    unsigned voffA[2], voffB[2];
#pragma unroll
    for (int i = 0; i < 2; ++i) { int R, C; stage_rc(tid * 16 + i * 8192, R, C); const int Rb = Epi::PERM ? ((R & ~31) + perm32(R & 31)) : R;
        voffA[i] = (unsigned)(R * K * EB + C * 2); voffB[i] = (unsigned)(Rb * K * EB + C * 2); }
    const size_t kstep = (size_t)(BK * 2);
    const size_t hstep = (size_t)HALF * K * EB;
    const size_t tstep = 2 * hstep;
    const unsigned ldsw = (unsigned)wid * 1024u;
    const int aoff = F8 ? lds_byte(wr * 64 + fr, fq * 16) + (fq & 1) * 16 : lds_byte(wr * 64 + fr, fq * 8), boff = F8 ? lds_byte(wc * 32 + fr, fq * 16) + (fq & 1) * 16 : lds_byte(wc * 32 + fr, fq * 8);
    const int aoff1 = aoff + (F8 ? 16 - 32 * (fq & 1) : 0);
    const int f8o0_unused = 0; (void)f8o0_unused;
#define PG8_SA(b, h) (((b) * 2 + (h)) * HTB)
#define PG8_SB(b, h) ((4 + (b) * 2 + (h)) * HTB)
#define PG8_STAGE_X(bufoff, gbase, voff, rs_, base_) do { const int so_ = (int)((const char*)(gbase) - (const char*)(base_)); _Pragma("unroll") for (int _i = 0; _i < 2; ++_i) \
        __builtin_amdgcn_raw_ptr_buffer_load_lds(rs_, (PG8_LAS void*)(lds + (bufoff) + ldsw + _i * 8192), 16, (int)(voff)[_i], so_, 0, 0); } while (0)
#define PG8_LDA(dst, b, h) do { if constexpr (F8) { _Pragma("unroll") for (int m = 0; m < 4; ++m) { const u32x4 lo_ = *(const PG8_LAS u32x4*)(lds + PG8_SA(b, h) + aoff + m * 2048), hi_ = *(const PG8_LAS u32x4*)(lds + PG8_SA(b, h) + aoff1 + m * 2048); \
            dst[m][0] = (i32x8){(int)lo_[0], (int)lo_[1], (int)lo_[2], (int)lo_[3], (int)hi_[0], (int)hi_[1], (int)hi_[2], (int)hi_[3]}; } } \
        else { _Pragma("unroll") for (int m = 0; m < 4; ++m) _Pragma("unroll") for (int k = 0; k < 2; ++k) dst[m][k] = *(const PG8_LAS frag_t*)(lds + PG8_SA(b, h) + aoff + m * 2048 + k * 1024); } } while (0)
#define PG8_LDB(dst, b, h) do { if constexpr (F8) { _Pragma("unroll") for (int n = 0; n < 2; ++n) { const u32x4 lo_ = *(const PG8_LAS u32x4*)(lds + PG8_SB(b, h) + boff + n * 2048), hi_ = *(const PG8_LAS u32x4*)(lds + PG8_SB(b, h) + boff + (aoff1 - aoff) + n * 2048); \
            dst[n][0] = (i32x8){(int)lo_[0], (int)lo_[1], (int)lo_[2], (int)lo_[3], (int)hi_[0], (int)hi_[1], (int)hi_[2], (int)hi_[3]}; } } \
        else { _Pragma("unroll") for (int n = 0; n < 2; ++n) _Pragma("unroll") for (int k = 0; k < 2; ++k) dst[n][k] = *(const PG8_LAS frag_t*)(lds + PG8_SB(b, h) + boff + n * 2048 + k * 1024); } } while (0)
#define PG8_MMA(ai, bj, At, Bt) do { __builtin_amdgcn_s_setprio(1); _Pragma("unroll") for (int m = 0; m < 4; ++m) _Pragma("unroll") for (int n = 0; n < 2; ++n) { \
        if constexpr (F8) acc[ai][bj][m][n] = __builtin_amdgcn_mfma_scale_f32_16x16x128_f8f6f4(Bt[n][0], At[m][0], acc[ai][bj][m][n], 0, 0, 0, 0x7f7f7f7f, 0, 0x7f7f7f7f); \
        else { _Pragma("unroll") for (int k = 0; k < 2; ++k) acc[ai][bj][m][n] = mma_bf16(Bt[n][k], At[m][k], acc[ai][bj][m][n]); } } __builtin_amdgcn_s_setprio(0); } while (0)
#define PG8_WAIT_V(n) asm volatile("s_waitcnt vmcnt(" #n ")" ::: "memory")
#define PG8_WAIT_L(n) asm volatile("s_waitcnt lgkmcnt(" #n ")" ::: "memory")
#define PG8_BAR __builtin_amdgcn_s_barrier()
#define PG8_SCHED __builtin_amdgcn_sched_barrier(0)
    const __amdgpu_buffer_rsrc_t rsA = __builtin_amdgcn_make_buffer_rsrc((void*)g.A, (short)0, (int)((size_t)g.M * K * EB), 0x00020000), rsB = __builtin_amdgcn_make_buffer_rsrc((void*)g.Bt, (short)0, (int)((size_t)g.N * K * EB), 0x00020000);
    Unit cur, nxt; int ui = 0;
    if (!S.next(0, cur)) return;
    f32x4 acc[2][2][4][2];
#pragma unroll
    for (int a = 0; a < 2; ++a)
#pragma unroll
        for (int b = 0; b < 2; ++b)
#pragma unroll
            for (int m = 0; m < 4; ++m)
#pragma unroll
                for (int n = 0; n < 2; ++n) acc[a][b][m][n] = (f32x4){0.f, 0.f, 0.f, 0.f};
    typedef typename FragT<F8>::type frag_t;
    frag_t At[4][F8 ? 1 : 2], B0[2][F8 ? 1 : 2], B1[2][F8 ? 1 : 2];
    const char* cA = (const char*)g.A + (size_t)cur.pm * tstep; const char* cB = (const char*)g.Bt + (size_t)cur.pn * tstep;
    S.a_ready(cur);
    if constexpr (SP2) {
        PG8_STAGE_X(PG8_SB(0, 0), cB, voffB, rsB, g.Bt); PG8_STAGE_X(PG8_SB(0, 1), cB + hstep, voffB, rsB, g.Bt); PG8_STAGE_X(PG8_SA(0, 0), cA, voffA, rsA, g.A); PG8_STAGE_X(PG8_SA(0, 1), cA + hstep, voffA, rsA, g.A);
        if (wr == 1) PG8_BAR;
        PG8_WAIT_V(2); PG8_BAR;
        PG8_STAGE_X(PG8_SB(1, 0), cB + kstep, voffB, rsB, g.Bt); PG8_STAGE_X(PG8_SA(1, 0), cA + kstep, voffA, rsA, g.A); PG8_STAGE_X(PG8_SB(1, 1), cB + hstep + kstep, voffB, rsB, g.Bt);
        PG8_WAIT_V(6); PG8_BAR;
    } else {
        PG8_STAGE_X(PG8_SB(0, 0), cB, voffB, rsB, g.Bt); PG8_STAGE_X(PG8_SA(0, 0), cA, voffA, rsA, g.A); PG8_STAGE_X(PG8_SB(0, 1), cB + hstep, voffB, rsB, g.Bt); PG8_STAGE_X(PG8_SA(0, 1), cA + hstep, voffA, rsA, g.A);
        if (wr == 1) PG8_BAR;
        PG8_WAIT_V(4); PG8_BAR;
        PG8_STAGE_X(PG8_SB(1, 0), cB + kstep, voffB, rsB, g.Bt); PG8_STAGE_X(PG8_SA(1, 0), cA + kstep, voffA, rsA, g.A); PG8_STAGE_X(PG8_SB(1, 1), cB + hstep + kstep, voffB, rsB, g.Bt);
        PG8_WAIT_V(6); PG8_BAR;
    }
    for (;;) {
        const bool has_next = S.next(ui + 1, nxt);
        const char* nA = has_next ? (const char*)g.A + (size_t)nxt.pm * tstep : cA; const char* nB = has_next ? (const char*)g.Bt + (size_t)nxt.pn * tstep : cB;
        for (int t = 0; t < nt; t += 2) {
            const bool last = (t == nt - 2);
            const char* a1 = cA + (size_t)(t + 1) * kstep;
            const char* a2 = last ? nA : cA + (size_t)(t + 2) * kstep; const char* b2 = last ? nB : cB + (size_t)(t + 2) * kstep;
            const char* a3 = a2 + kstep; const char* b3 = b2 + kstep;
            if (last && has_next) S.a_ready(nxt);
            if constexpr (SP2) {
            PG8_LDB(B0, 0, 0); PG8_LDB(B1, 0, 1); PG8_SCHED; PG8_LDA(At, 0, 0); PG8_STAGE_X(PG8_SA(1, 1), a1 + hstep, voffA, rsA, g.A);
            PG8_WAIT_V(8); PG8_WAIT_L(0); PG8_BAR; PG8_MMA(0, 0, At, B0); PG8_MMA(0, 1, At, B1); PG8_BAR; PG8_SCHED;
            PG8_LDA(At, 0, 1); PG8_STAGE_X(PG8_SB(0, 0), b2, voffB, rsB, g.Bt); PG8_STAGE_X(PG8_SB(0, 1), b2 + hstep, voffB, rsB, g.Bt); PG8_STAGE_X(PG8_SA(0, 0), a2, voffA, rsA, g.A);
            PG8_WAIT_V(8); PG8_WAIT_L(0); PG8_BAR; PG8_MMA(1, 0, At, B0); PG8_MMA(1, 1, At, B1); PG8_BAR; PG8_SCHED;
            PG8_LDB(B0, 1, 0); PG8_LDB(B1, 1, 1); PG8_SCHED; PG8_LDA(At, 1, 0); PG8_STAGE_X(PG8_SA(0, 1), a2 + hstep, voffA, rsA, g.A);
            PG8_WAIT_V(8); PG8_WAIT_L(0); PG8_BAR; PG8_MMA(0, 0, At, B0); PG8_MMA(0, 1, At, B1); PG8_BAR; PG8_SCHED;
            PG8_LDA(At, 1, 1); PG8_STAGE_X(PG8_SB(1, 0), b3, voffB, rsB, g.Bt); PG8_STAGE_X(PG8_SB(1, 1), b3 + hstep, voffB, rsB, g.Bt); PG8_STAGE_X(PG8_SA(1, 0), a3, voffA, rsA, g.A);
            PG8_WAIT_V(8); PG8_WAIT_L(0); PG8_BAR; PG8_MMA(1, 0, At, B0); PG8_MMA(1, 1, At, B1); PG8_BAR; PG8_SCHED;
            } else {
            PG8_LDB(B0, 0, 0); PG8_SCHED; PG8_LDA(At, 0, 0); PG8_STAGE_X(PG8_SA(1, 1), a1 + hstep, voffA, rsA, g.A);
            PG8_WAIT_L(8); PG8_BAR; PG8_WAIT_L(0); PG8_MMA(0, 0, At, B0); PG8_BAR; PG8_SCHED;
            PG8_LDB(B1, 0, 1); PG8_STAGE_X(PG8_SB(0, 0), b2, voffB, rsB, g.Bt);
            PG8_BAR; PG8_WAIT_L(0); PG8_MMA(0, 1, At, B1); PG8_BAR;
            PG8_LDA(At, 0, 1); PG8_STAGE_X(PG8_SA(0, 0), a2, voffA, rsA, g.A);
            PG8_BAR; PG8_WAIT_L(0); PG8_MMA(1, 0, At, B0); PG8_BAR; PG8_SCHED;
            PG8_STAGE_X(PG8_SB(0, 1), b2 + hstep, voffB, rsB, g.Bt);
            PG8_WAIT_V(6); PG8_BAR; PG8_MMA(1, 1, At, B1); PG8_BAR;
            PG8_LDB(B0, 1, 0); PG8_SCHED; PG8_LDA(At, 1, 0); PG8_STAGE_X(PG8_SA(0, 1), a2 + hstep, voffA, rsA, g.A);
            PG8_WAIT_L(8); PG8_BAR; PG8_WAIT_L(0); PG8_MMA(0, 0, At, B0); PG8_BAR; PG8_SCHED;
            PG8_LDB(B1, 1, 1); PG8_STAGE_X(PG8_SB(1, 0), b3, voffB, rsB, g.Bt);
            PG8_BAR; PG8_WAIT_L(0); PG8_MMA(0, 1, At, B1); PG8_BAR;
            PG8_LDA(At, 1, 1); PG8_STAGE_X(PG8_SA(1, 0), a3, voffA, rsA, g.A);
            PG8_BAR; PG8_WAIT_L(0); PG8_MMA(1, 0, At, B0); PG8_BAR; PG8_SCHED;
            PG8_STAGE_X(PG8_SB(1, 1), b3 + hstep, voffB, rsB, g.Bt);
            PG8_WAIT_V(6); PG8_BAR; PG8_MMA(1, 1, At, B1); PG8_BAR;
            }
        }
        if constexpr (ALIGN_EPI) { if (wr == 0) PG8_BAR; }
        if constexpr (!Epi::AFTER_DRAIN) { E(acc, cur, wr, wc, fr, fq); S.done(cur); }
        if (!has_next) break;
#pragma unroll
        for (int a = 0; a < 2; ++a)
#pragma unroll
            for (int b = 0; b < 2; ++b)
#pragma unroll
                for (int m = 0; m < 4; ++m)
#pragma unroll
                    for (int n = 0; n < 2; ++n) acc[a][b][m][n] = (f32x4){0.f, 0.f, 0.f, 0.f};
        cur = nxt; cA = nA; cB = nB; ++ui;
        if constexpr (ALIGN_EPI) { if (wr == 1) PG8_BAR; }
    }
    PG8_WAIT_V(0);
    if constexpr (!ALIGN_EPI) { if (wr == 0) PG8_BAR; }
    PG8_BAR;
    if constexpr (Epi::AFTER_DRAIN) { E.fused(acc, cur, wr, wc, fr, fq, lds, wid, lane); S.done(cur); }
#undef PG8_SA
#undef PG8_SB
#undef PG8_STAGE_X
#undef PG8_LDA
#undef PG8_LDB
#undef PG8_MMA
#undef PG8_WAIT_V
#undef PG8_WAIT_L
#undef PG8_BAR
#undef PG8_SCHED
}
}
#define GAS __attribute__((address_space(1)))
#define LAS __attribute__((address_space(3)))
typedef unsigned short bf16_t;
typedef unsigned u32x4 __attribute__((ext_vector_type(4)));
typedef unsigned u32x2 __attribute__((ext_vector_type(2)));
typedef float f32x4 __attribute__((ext_vector_type(4)));
typedef float f32x2 __attribute__((ext_vector_type(2)));
typedef float f32x16 __attribute__((ext_vector_type(16)));
typedef short bf16x8 __attribute__((ext_vector_type(8)));
typedef short s16x4 __attribute__((ext_vector_type(4)));
typedef __bf16 bf16x2_t __attribute__((ext_vector_type(2)));
typedef unsigned u32x6 __attribute__((ext_vector_type(6)));
typedef int i32x8 __attribute__((ext_vector_type(8)));
typedef unsigned u32x16 __attribute__((ext_vector_type(16)));
typedef float f32x32 __attribute__((ext_vector_type(32)));
typedef _Float16 f16x32 __attribute__((ext_vector_type(32)));
typedef _Float16 f16x2 __attribute__((ext_vector_type(2)));

namespace mk {
constexpr int M = 16384, D = 4096, S = 2048, NB = 8, PW = 12298, NH = 32, NE = 16384;
constexpr int NWAVES = 8;
constexpr size_t MiB = 1u << 20;
constexpr size_t WS_CTL = 0, CTL_ZERO_BYTES = 1 * MiB;
constexpr size_t WS_RSTD = 2 * MiB, WS_LOGF = 3 * MiB, WS_WQK = 4 * MiB, WS_WOUT = 20 * MiB, WS_WIN = 52 * MiB, WS_U16 = 148 * MiB, WS_V16 = 276 * MiB,
                 WS_XB = 404 * MiB, WS_Q = 532 * MiB, WS_K = 660 * MiB, WS_V = 788 * MiB, WS_OB = 916 * MiB, WS_X2 = 1792 * MiB, WS_END = 2048 * MiB;
constexpr size_t WS_L1 = 1920 * MiB;
__host__ __device__ constexpr size_t ws_wqk(int l) { return l ? WS_L1 : WS_WQK; }
__host__ __device__ constexpr size_t ws_wout(int l) { return l ? WS_L1 + 16 * MiB : WS_WOUT; }
__host__ __device__ constexpr size_t ws_win(int l) { return l ? WS_L1 + 32 * MiB : WS_WIN; }
__host__ __device__ constexpr size_t ws_tab(int l) { return l ? WS_V16 : WS_U16; }
constexpr size_t WS_XB8N = WS_OB + 64 * MiB;
constexpr size_t WS_SC = WS_Q;
constexpr int CW_BAR = 4096;
constexpr int CW_QUEUE = 16384;
constexpr int RING_BYTES = 131072, LDSCTL_OFF = RING_BYTES, MISC_OFF = LDSCTL_OFF + 320, LDS_BYTES = 147456;

struct Args { const float* in[13]; float* out; unsigned char* ws; int ph_lo, ph_hi; };

__device__ __forceinline__ unsigned f2bf(float f) { unsigned u = __builtin_bit_cast(unsigned, f); return (u + 0x7fffu + ((u >> 16) & 1u)) >> 16; }
__device__ __forceinline__ unsigned pk2(float lo, float hi) { return f2bf(lo) | (f2bf(hi) << 16); }
__device__ __forceinline__ float bf_lo(unsigned w) { return __builtin_bit_cast(float, w << 16); }
__device__ __forceinline__ float bf_hi(unsigned w) { return __builtin_bit_cast(float, w & 0xffff0000u); }
__device__ __forceinline__ float lane_read(float v, int src_lane) { return __builtin_bit_cast(float, __builtin_amdgcn_ds_bpermute(src_lane << 2, __builtin_bit_cast(int, v))); }
__device__ __forceinline__ int lane_read(int v, int src_lane) { return __builtin_amdgcn_ds_bpermute(src_lane << 2, v); }
constexpr float US = 1024.0f, VS = 32.0f, US_INV = 1.0f / 1024.0f, VS_INV = 1.0f / 32.0f;
constexpr int REC4 = 4096;
constexpr int ROW4 = 2048;
#define FP4X_(j) ((j) < 16 ? a0[((j) & 15) >> 2][(j) & 3] : a1[((j) & 15) >> 2][(j) & 3])
__device__ __forceinline__ u32x4 pack_fp4(const f32x4 (&a0)[4], const f32x4 (&a1)[4], float inv) {
    unsigned o[4];
#pragma unroll
    for (int w = 0; w < 4; ++w) { unsigned v = 0u;
        v = __builtin_amdgcn_cvt_scalef32_pk_fp4_f32(v, FP4X_(8 * w + 0) * inv, FP4X_(8 * w + 1) * inv, 1.0f, 0); v = __builtin_amdgcn_cvt_scalef32_pk_fp4_f32(v, FP4X_(8 * w + 2) * inv, FP4X_(8 * w + 3) * inv, 1.0f, 1);
        v = __builtin_amdgcn_cvt_scalef32_pk_fp4_f32(v, FP4X_(8 * w + 4) * inv, FP4X_(8 * w + 5) * inv, 1.0f, 2); v = __builtin_amdgcn_cvt_scalef32_pk_fp4_f32(v, FP4X_(8 * w + 6) * inv, FP4X_(8 * w + 7) * inv, 1.0f, 3);
        o[w] = v; }
    return (u32x4){o[0], o[1], o[2], o[3]};
}
#undef FP4X_
__device__ __forceinline__ float clamp8(float x) { return fminf(fmaxf(x, -224.0f), 224.0f); }
__device__ __forceinline__ float logsig(float z) { return fminf(z, 0.f) - 0.6931471805599453f * __builtin_amdgcn_logf(1.0f + __builtin_amdgcn_exp2f(-fabsf(z) * 1.4426950408889634f)); }
__device__ __forceinline__ float gelu_erf(float v) {
    const float av = fabsf(v), t = __builtin_amdgcn_rcpf(av * 0.2316418882f + 1.0f);
    float q = t * 0.5307027145f + (-0.7265760135f); q = q * t + 0.7107068705f; q = q * t + (-0.142248368f); q = q * t + 0.127414796f; q = q * t;
    const float e = __builtin_amdgcn_exp2f((v * v) * (-0.72134752044f));
    const float m = v * (q * e);
    return v < 0.f ? m : v - m;
}
#define LDS_WAIT() asm volatile("s_waitcnt lgkmcnt(0)" ::: "memory")
#define FRESH_LDS(l) do { unsigned v_ = (unsigned)(size_t)(l); asm volatile("" : "+s"(v_)); (l) = (LAS unsigned char*)(size_t)v_; } while (0)
#define FRESH_BID() int bid = blockIdx.x, G = gridDim.x; asm volatile("" : "+s"(bid), "+s"(G))
#define FRESH_TID() int tid; { int w_ = wave0, l_; { unsigned z_ = 0u; asm volatile("" : "+v"(z_)); l_ = (int)__builtin_amdgcn_mbcnt_hi(~0u, __builtin_amdgcn_mbcnt_lo(~0u, z_)); } asm volatile("" : "+s"(w_)); tid = w_ * 64 + l_; } const int lane = tid & 63, wave = __builtin_amdgcn_readfirstlane(tid >> 6); (void)lane; (void)wave

__device__ __forceinline__ unsigned wave_max_u32(unsigned v) {
    v = max(v, (unsigned)__builtin_amdgcn_update_dpp(0, (int)v, 0x111, 0xF, 0xF, true));
    v = max(v, (unsigned)__builtin_amdgcn_update_dpp(0, (int)v, 0x112, 0xF, 0xF, true));
    v = max(v, (unsigned)__builtin_amdgcn_update_dpp(0, (int)v, 0x114, 0xF, 0xF, true));
    v = max(v, (unsigned)__builtin_amdgcn_update_dpp(0, (int)v, 0x118, 0xF, 0xF, true));
    v = max(v, (unsigned)__builtin_amdgcn_update_dpp((int)v, (int)v, 0x142, 0xA, 0xF, false));
    v = max(v, (unsigned)__builtin_amdgcn_update_dpp((int)v, (int)v, 0x143, 0xC, 0xF, false));
    return (unsigned)__builtin_amdgcn_readlane((int)v, 63);
}
__device__ __forceinline__ float wave_sum_dpp(float x) {
    int v = __builtin_bit_cast(int, x);
#define DPP_ADD(ctrl, rm, bc, oldv) v = __builtin_bit_cast(int, __builtin_bit_cast(float, v) + __builtin_bit_cast(float, __builtin_amdgcn_update_dpp(oldv, v, ctrl, rm, 0xF, bc)))
    DPP_ADD(0x111, 0xF, true, 0); DPP_ADD(0x112, 0xF, true, 0); DPP_ADD(0x114, 0xF, true, 0); DPP_ADD(0x118, 0xF, true, 0);
#undef DPP_ADD
    const float r0 = __builtin_bit_cast(float, __builtin_amdgcn_readlane(v, 15)), r1 = __builtin_bit_cast(float, __builtin_amdgcn_readlane(v, 31)), r2 = __builtin_bit_cast(float, __builtin_amdgcn_readlane(v, 47)), r3 = __builtin_bit_cast(float, __builtin_amdgcn_readlane(v, 63));
    return (r0 + r1) + (r2 + r3);
}
__device__ __forceinline__ float diag_sum_dpp(float x) {
    int v = __builtin_bit_cast(int, x);
#define DPP_ADD(ctrl) v = __builtin_bit_cast(int, __builtin_bit_cast(float, v) + __builtin_bit_cast(float, __builtin_amdgcn_update_dpp(0, v, ctrl, 0xF, 0xF, true)))
    DPP_ADD(0x111); DPP_ADD(0x112);
#undef DPP_ADD
    const float r0 = __builtin_bit_cast(float, __builtin_amdgcn_readlane(v, 3)), r1 = __builtin_bit_cast(float, __builtin_amdgcn_readlane(v, 23)), r2 = __builtin_bit_cast(float, __builtin_amdgcn_readlane(v, 43)), r3 = __builtin_bit_cast(float, __builtin_amdgcn_readlane(v, 63));
    return (r0 + r1) + (r2 + r3);
}
__device__ __forceinline__ unsigned ordkey(float x) { const unsigned u = __builtin_bit_cast(unsigned, x); return (u & 0x80000000u) ? ~u : (u | 0x80000000u); }
__device__ __forceinline__ void transpose_item(const float* W, int K, int ldw, int ncols, const float* gain, bf16_t* WT, LAS float* scr, int item, int lane) {
    const int nblk = ncols / 32, kb = item / nblk, nb = item % nblk, k0 = 64 * kb, n0 = 32 * nb;
#pragma unroll 8
    for (int i = 0; i < 32; ++i) { const int kk = 2 * i + (lane >> 5); float v = W[(size_t)(k0 + kk) * ldw + n0 + (lane & 31)]; if (gain) v *= gain[k0 + kk]; scr[kk * 33 + (lane & 31)] = v; }
    LDS_WAIT(); asm volatile("" ::: "memory");
    const int c = lane & 7;
#pragma unroll
    for (int j = 0; j < 4; ++j) { const int n = (lane >> 3) + 8 * j; const LAS float* s = scr + (8 * c) * 33 + n;
        u32x4 o; o.x = pk2(s[0 * 33], s[1 * 33]); o.y = pk2(s[2 * 33], s[3 * 33]); o.z = pk2(s[4 * 33], s[5 * 33]); o.w = pk2(s[6 * 33], s[7 * 33]);
        *(u32x4*)(WT + (size_t)(n0 + n) * K + k0 + 8 * c) = o; }
    LDS_WAIT(); asm volatile("" ::: "memory");
}

typedef const __attribute__((address_space(4))) Args* KArgsT;
__device__ __forceinline__ unsigned pk4_fp8(float a, float b, float c, float d) { int p = __builtin_amdgcn_cvt_pk_fp8_f32(clamp8(a), clamp8(b), 0, false); p = __builtin_amdgcn_cvt_pk_fp8_f32(clamp8(c), clamp8(d), p, true); return (unsigned)p; }
__device__ __forceinline__ void transpose_item8(const float* W, int K, int ldw, int ncols, const float* gain, float scale, unsigned char* WT, LAS float* scr, int item, int lane) {
    const int nblk = ncols / 32, kb = item / nblk, nb = item % nblk, k0 = 64 * kb, n0 = 32 * nb;
    const int kr = lane >> 3, nq = (lane & 7) * 4;
    f32x4 v[8];
#pragma unroll
    for (int i = 0; i < 8; ++i) { const float* p = W + (size_t)(k0 + 8 * i + kr) * ldw + n0 + nq; v[i] = (f32x4){p[0], p[1], p[2], p[3]}; }
#pragma unroll
    for (int i = 0; i < 8; ++i) { const int kk = 8 * i + kr; const float g = (gain ? gain[k0 + kk] : 1.0f) * scale; LAS float* d = scr + kk * 33 + nq; d[0] = v[i][0] * g; d[1] = v[i][1] * g; d[2] = v[i][2] * g; d[3] = v[i][3] * g; }
    LDS_WAIT(); asm volatile("" ::: "memory");
    const int c = lane & 7;
#pragma unroll
    for (int j = 0; j < 4; ++j) { const int n = (lane >> 3) + 8 * j; const LAS float* s = scr + (8 * c) * 33 + n;
        u32x2 o; o.x = pk4_fp8(s[0 * 33], s[1 * 33], s[2 * 33], s[3 * 33]); o.y = pk4_fp8(s[4 * 33], s[5 * 33], s[6 * 33], s[7 * 33]);
        *(u32x2*)(WT + (size_t)(n0 + n) * K + k0 + 8 * c) = o; }
    LDS_WAIT(); asm volatile("" ::: "memory");
}
__device__ __forceinline__ void conv_phase(KArgsT ka, int l, LAS unsigned char* lds, int wave0) {
    FRESH_TID(); FRESH_LDS(lds); FRESH_BID();
    unsigned char* ws = ka->ws;
    const float* ln1 = ka->in[1] + (size_t)l * D; const float* w_in = ka->in[2] + (size_t)l * D * PW; const float* w_out = ka->in[5] + (size_t)l * D * D;
    const float* ln2 = ka->in[6] + (size_t)l * D; const float* wq = ka->in[7] + (size_t)l * D * 2048;
    const float* k1 = ka->in[8] + (size_t)l * 8 * 128 * 128; const float* k2 = ka->in[9] + (size_t)l * 8 * 128 * 128;
    const float* pu = ka->in[10] + (size_t)l * NE * D; const float* pv = ka->in[11] + (size_t)l * NE * D;
    bf16_t* WQK = (bf16_t*)(ws + ws_wqk(l)); bf16_t* WOUT = (bf16_t*)(ws + ws_wout(l)); bf16_t* WIN = (bf16_t*)(ws + ws_win(l)); bf16_t* U16 = (bf16_t*)(ws + ws_tab(l));
    {
        LAS float* Ks = (LAS float*)lds;
        LAS float* Ws = (LAS float*)(lds + 128 * 132 * 4);
        const int IPB = (1024 + G - 1) / G, it0 = bid * IPB, it1 = min(1024, it0 + IPB);
        int gi_cur = -1; f32x4 pre[4];
        if (it0 < it1) {
#pragma unroll
            for (int m = 0; m < 4; ++m) { const int i = tid + 512 * m, r = i >> 5, c4 = (i & 31) * 4; pre[m] = *(const f32x4*)(wq + (size_t)((it0 & 63) * 64 + r) * 2048 + (it0 >> 6) * 128 + c4); } }
        for (int it = it0; it < it1; ++it) {
            const int gi = it >> 6, c0 = (it & 63) * 64;
            __syncthreads();
            if (gi != gi_cur) { gi_cur = gi;
                const float* key = ((gi & 1) ? k2 : k1) + (size_t)(gi >> 1) * 128 * 128;
                for (int i = tid; i < 4096; i += 512) { const int r = i >> 5, c4 = (i & 31) * 4; *(LAS f32x4*)(Ks + r * 132 + c4) = *(const f32x4*)(key + r * 128 + c4); } }
#pragma unroll
            for (int m = 0; m < 4; ++m) { const int i = tid + 512 * m, r = i >> 5, c4 = (i & 31) * 4; *(LAS f32x4*)(Ws + r * 132 + c4) = pre[m]; }
            __syncthreads();
            if (it + 1 < it1) {
#pragma unroll
                for (int m = 0; m < 4; ++m) { const int i = tid + 512 * m, r = i >> 5, c4 = (i & 31) * 4; pre[m] = *(const f32x4*)(wq + (size_t)(((it + 1) & 63) * 64 + r) * 2048 + ((it + 1) >> 6) * 128 + c4); } }
            const int ti = wave & 3, tj = wave >> 2, li = lane & 31, kh = lane >> 5;
            const LAS float* ap = Ks + (32 * ti + li) * 132 + 64 * kh; const LAS float* bp = Ws + (32 * tj + li) * 132 + 64 * kh;
            f32x16 acc;
#pragma unroll
            for (int r = 0; r < 16; ++r) acc[r] = 0.f;
#pragma unroll 4
            for (int s4 = 0; s4 < 16; ++s4) { const f32x4 a4 = *(const LAS f32x4*)(ap + 4 * s4), b4 = *(const LAS f32x4*)(bp + 4 * s4);
                acc = __builtin_amdgcn_mfma_f32_32x32x2f32(a4[0], b4[0], acc, 0, 0, 0); acc = __builtin_amdgcn_mfma_f32_32x32x2f32(a4[1], b4[1], acc, 0, 0, 0);
                acc = __builtin_amdgcn_mfma_f32_32x32x2f32(a4[2], b4[2], acc, 0, 0, 0); acc = __builtin_amdgcn_mfma_f32_32x32x2f32(a4[3], b4[3], acc, 0, 0, 0); }
            { const int c = c0 + 32 * tj + li; const float gg = ln2[c];
#pragma unroll
              for (int r = 0; r < 16; ++r) { const int n = 32 * ti + (r & 3) + 8 * (r >> 2) + 4 * kh; WQK[(size_t)(gi * 128 + n) * D + c] = (bf16_t)f2bf(acc[r] * gg); } }
        }
        __syncthreads();
    }
    const int gw = bid * NWAVES + wave, NGW = G * NWAVES;
    {
        unsigned char* U6 = (unsigned char*)U16; unsigned char* V4 = U6 + ROW4; float* SCU = (float*)(U6 + (size_t)NE * REC4); float* SCV = SCU + NE;
        f32x4 gq[4][4];
#pragma unroll
        for (int i = 0; i < 4; ++i)
#pragma unroll
            for (int m = 0; m < 4; ++m) gq[i][m] = *(const f32x4*)(ln2 + 1024 * i + 256 * m + 4 * lane);
        f32x4 uu[4][4], vv[4][4];
        const unsigned hm_ = (lane & 1) ? 65536u : 1u;
#define LDROW_(dst, src, rr) do { const float* p_ = (src) + (size_t)(rr) * D + 4 * lane; _Pragma("unroll") for (int i = 0; i < 4; ++i) _Pragma("unroll") for (int m = 0; m < 4; ++m) dst[i][m] = *(const f32x4*)(p_ + 1024 * i + 256 * m); } while (0)
#define H16_(v, inv) ((__builtin_amdgcn_cvt_scalef32_pk_fp4_f32(__builtin_amdgcn_cvt_scalef32_pk_fp4_f32(0u, (v)[0] * (inv), (v)[1] * (inv), 1.0f, 0), (v)[2] * (inv), (v)[3] * (inv), 1.0f, 1) & 0xffffu) * hm_)
#define QSWAP1_(x) ((unsigned)__builtin_amdgcn_update_dpp(0, (int)(x), 0xB1, 0xF, 0xF, false))
#define QSWAP2_(x) ((unsigned)__builtin_amdgcn_update_dpp(0, (int)(x), 0x4E, 0xF, 0xF, false))
#define PUTROW_(src, tab, rr, inv) do { _Pragma("unroll") for (int j = 0; j < 2; ++j) _Pragma("unroll") for (int m = 0; m < 4; ++m) { \
            unsigned da_ = H16_(src[2 * j][m], inv), db_ = H16_(src[2 * j + 1][m], inv); da_ |= QSWAP1_(da_); db_ |= QSWAP1_(db_); \
            const unsigned oa_ = QSWAP2_(da_), ob_ = QSWAP2_(db_); \
            if ((lane & 3) == 0) *(u32x4*)((tab) + (size_t)(rr) * REC4 + j * 1024 + 16 * (16 * m + (lane >> 2))) = (u32x4){da_, oa_, db_, ob_}; } } while (0)
        if (gw < NE) { LDROW_(uu, pu, gw); LDROW_(vv, pv, gw); }
        for (int r = gw; r < NE; r += NGW) {
            const int rn = r + NGW;
            { float au = 0.f;
#pragma unroll
              for (int i = 0; i < 4; ++i)
#pragma unroll
                  for (int m = 0; m < 4; ++m) { uu[i][m] *= gq[i][m]; au += (uu[i][m][0] * uu[i][m][0] + uu[i][m][1] * uu[i][m][1]) + (uu[i][m][2] * uu[i][m][2] + uu[i][m][3] * uu[i][m][3]); }
              au = sqrtf(wave_sum_dpp(au) * (1.0f / D)); const float iu = au > 0.f ? 2.0f / au : 0.f;
              if (lane == 0) SCU[r] = au * 0.5f;
              PUTROW_(uu, U6, r, iu); }
            if (rn < NE) LDROW_(uu, pu, rn);
            { float av = 0.f;
#pragma unroll
              for (int i = 0; i < 4; ++i)
#pragma unroll
                  for (int m = 0; m < 4; ++m) av += (vv[i][m][0] * vv[i][m][0] + vv[i][m][1] * vv[i][m][1]) + (vv[i][m][2] * vv[i][m][2] + vv[i][m][3] * vv[i][m][3]);
              av = sqrtf(wave_sum_dpp(av) * (1.0f / D)); const float iv = av > 0.f ? 2.0f / av : 0.f;
              if (lane == 0) SCV[r] = av * 0.5f;
              PUTROW_(vv, V4, r, iv); }
            if (rn < NE) LDROW_(vv, pv, rn);
        }
#undef LDROW_
#undef H16_
#undef QSWAP1_
#undef QSWAP2_
#undef PUTROW_
    }
    {
        LAS float* scr = (LAS float*)(lds + wave * 16384);
        constexpr int I_O = (D / 64) * (D / 32), I_IN = (D / 64) * (12288 / 32);
        for (int it = gw; it < I_O + I_IN; it += NGW) {
            if (it < I_O) transpose_item8(w_out, D, D, D, nullptr, US, (unsigned char*)WOUT, scr, it, lane);
            else transpose_item8(w_in, D, PW, 12288, ln1, US, (unsigned char*)WIN, scr, it - I_O, lane);
        }
    }
}

template <bool WITH_F>
__device__ __forceinline__ void prep_phase(const float* X, bf16_t* XB, float* RSTD, const float* w_in, const float* ln1, const float* bf, float* LOGF, LAS unsigned char* lds, int wave0) {
    FRESH_TID(); FRESH_LDS(lds); FRESH_BID();
    LAS unsigned short* gfs = (LAS unsigned short*)lds;
    if (WITH_F) {
        __syncthreads();
        for (int c = tid; c < D; c += 512) { const float g = ln1[c]; const float* wr = w_in + (size_t)c * PW + 12288;
#pragma unroll
            for (int j = 0; j < 10; ++j) gfs[j * D + c] = (unsigned short)f2bf(wr[j] * g); }
        __syncthreads();
    }
    const int gw = bid * NWAVES + wave, NGW = G * NWAVES;
    for (int m = gw; m < M; m += NGW) {
        const f32x4* xr = (const f32x4*)(X + (size_t)m * D) + lane;
        f32x4 v[16]; float ss = 0.f;
#pragma unroll
        for (int i = 0; i < 16; ++i) { v[i] = xr[64 * i]; ss += (v[i][0] * v[i][0] + v[i][1] * v[i][1]) + (v[i][2] * v[i][2] + v[i][3] * v[i][3]); }
        ss = wave_sum_dpp(ss);
        const float rstd = rsqrtf(ss * (1.0f / D) + 1e-6f);
        if (WITH_F) {
            unsigned* o8 = (unsigned*)((unsigned char*)XB + (size_t)m * D) + lane;
#pragma unroll
            for (int i = 0; i < 16; ++i) o8[64 * i] = pk4_fp8(v[i][0], v[i][1], v[i][2], v[i][3]);
        } else {
        u32x2* o = (u32x2*)(XB + (size_t)m * D) + lane;
#pragma unroll
        for (int i = 0; i < 16; ++i) { u32x2 w; w.x = pk2(v[i][0], v[i][1]); w.y = pk2(v[i][2], v[i][3]); o[64 * i] = w; }
        }
        if (lane == 0) RSTD[m] = rstd;
        if (WITH_F) {
            float mine = 0.f;
#pragma unroll 1
            for (int j = 0; j < 10; ++j) { float s = 0.f;
#pragma unroll
                for (int i = 0; i < 16; ++i) { const u32x2 gp = *(const LAS u32x2*)(gfs + j * D + 256 * i + 4 * lane);
                    s += (v[i][0] * bf_lo(gp.x) + v[i][1] * bf_hi(gp.x)) + (v[i][2] * bf_lo(gp.y) + v[i][3] * bf_hi(gp.y)); }
                s = wave_sum_dpp(s); if (lane == j) mine = s; }
            if (lane < 10) { const int b = m >> 11, s = m & 2047; LOGF[(size_t)(b * 10 + lane) * S + s] = logsig(mine * rstd + bf[lane]); }
        }
    }
}


__device__ __forceinline__ void load16_bf16(const bf16_t* p, float (&d)[16]) {
    const u32x4 a = *(const u32x4*)p, b = *(const u32x4*)(p + 8);
#pragma unroll
    for (int q = 0; q < 4; ++q) { d[2 * q] = bf_lo(a[q]); d[2 * q + 1] = bf_hi(a[q]); d[8 + 2 * q] = bf_lo(b[q]); d[8 + 2 * q + 1] = bf_hi(b[q]); }
}
#define RFL(x) __builtin_amdgcn_readfirstlane(x)
template <bool FINAL>
__device__ __forceinline__ void peer_uv_phase(const float* SC, const unsigned char* T4, const bf16_t* X1, void* XOv, const float* fg,
                                              unsigned char* XB8n, float* RSTDn, float* LOGFn, const float* w_in_n, const float* ln1_n, const float* bf_n, LAS unsigned char* lds, int wave0) {
    FRESH_TID(); FRESH_LDS(lds); FRESH_BID();
    LAS int* s_eid = (LAS int*)(lds + 81920 + wave * 1024); LAS float* s_w = (LAS float*)(lds + 81920 + wave * 1024 + 512); LAS float* s_su = (LAS float*)(lds + 90112 + wave * 512);
    const float* SCU = (const float*)(T4 + (size_t)NE * REC4); const float* SCV = SCU + NE;
    LAS unsigned short* gfs = (LAS unsigned short*)lds;
    if (!FINAL) {
        __syncthreads();
        for (int c = tid; c < D; c += 512) { const float g = ln1_n[c]; const float* wr = w_in_n + (size_t)c * PW + 12288;
#pragma unroll
            for (int j = 0; j < 10; ++j) gfs[j * D + c] = (unsigned short)f2bf(wr[j] * g); }
        __syncthreads();
    }
    const int gw = bid * NWAVES + wave, NGW = G * NWAVES;
    for (int tok = gw; tok < M; tok += NGW) {
        const bf16_t* x1 = X1 + (size_t)tok * D;
        i32x8 xq[2]; float rstd_tok;
        const float* sc = SC + (size_t)tok * 2048;
        float xn_[2][2][2];
#define LDSC_(hh) do { _Pragma("unroll") for (int u = 0; u < 2; ++u) _Pragma("unroll") for (int f = 0; f < 2; ++f) _Pragma("unroll") for (int r = 0; r < 2; ++r) xn_[u][f][r] = sc[((hh) + 4 * u) * 256 + f * 128 + r * 64 + lane]; } while (0)
        LDSC_(0);
        { const int sg_ = lane & 15, gp_ = lane >> 4; float t[2][2][16]; float ss_ = 0.f;
#pragma unroll
          for (int s2 = 0; s2 < 2; ++s2)
#pragma unroll
              for (int hf = 0; hf < 2; ++hf) { load16_bf16(x1 + 1024 * (2 * s2 + (gp_ & 1)) + 16 * (sg_ + 32 * hf + 16 * (gp_ >> 1)), t[s2][hf]);
#pragma unroll
                  for (int k = 0; k < 16; ++k) ss_ += t[s2][hf][k] * t[s2][hf][k]; }
          rstd_tok = rsqrtf(wave_sum_dpp(ss_) * (1.0f / D) + 1e-6f);
#pragma unroll
          for (int s2 = 0; s2 < 2; ++s2)
#pragma unroll
              for (int hf = 0; hf < 2; ++hf)
#pragma unroll
                  for (int q = 0; q < 4; ++q) xq[s2][4 * hf + q] = (int)pk4_fp8(t[s2][hf][4 * q] * rstd_tok, t[s2][hf][4 * q + 1] * rstd_tok, t[s2][hf][4 * q + 2] * rstd_tok, t[s2][hf][4 * q + 3] * rstd_tok); }
        LAS float* selv = (LAS float*)(lds + 94208 + wave * 512); LAS int* seli = (LAS int*)(lds + 94208 + wave * 512 + 256);
#define BALLOT(c) __builtin_amdgcn_ballot_w64(c)
#define MBCNT(m) ((int)__builtin_amdgcn_mbcnt_hi((unsigned)((m) >> 32), __builtin_amdgcn_mbcnt_lo((unsigned)(m), 0u)))
        for (int h = 0; h < 4; ++h) {
            float x[2][2][2]; unsigned kk[2][2][2];
#pragma unroll
            for (int u = 0; u < 2; ++u)
#pragma unroll
                for (int f = 0; f < 2; ++f)
#pragma unroll
                    for (int r = 0; r < 2; ++r) { const float v = xn_[u][f][r]; x[u][f][r] = v; kk[u][f][r] = (ordkey(v) & ~127u) | (unsigned)(127 - 64 * r - lane); }
            LDSC_(min(h + 1, 3));
            unsigned T[2][2] = {{0u, 0u}, {0u, 0u}}; int dn = 0;
            for (unsigned bm = 0x80000000u; bm != 0u && dn != 15; bm >>= 1) {
#pragma unroll
                for (int u = 0; u < 2; ++u)
#pragma unroll
                    for (int f = 0; f < 2; ++f) { const unsigned cand = T[u][f] | bm;
                        const int c = __builtin_popcountll(BALLOT(kk[u][f][0] >= cand)) + __builtin_popcountll(BALLOT(kk[u][f][1] >= cand));
                        T[u][f] = c >= 16 ? cand : T[u][f]; dn |= (c == 16) ? (1 << (2 * u + f)) : 0; }
            }
#pragma unroll
            for (int u = 0; u < 2; ++u)
#pragma unroll
                for (int f = 0; f < 2; ++f) { const bool s0 = kk[u][f][0] >= T[u][f], s1 = kk[u][f][1] >= T[u][f]; const unsigned long long m0 = BALLOT(s0), m1 = BALLOT(s1);
                    const int p0 = MBCNT(m0), p1 = __builtin_popcountll(m0) + MBCNT(m1);
                    if (s0) { selv[(2 * u + f) * 16 + (p0 & 15)] = x[u][f][0]; seli[(2 * u + f) * 16 + (p0 & 15)] = lane; }
                    if (s1) { selv[(2 * u + f) * 16 + (p1 & 15)] = x[u][f][1]; seli[(2 * u + f) * 16 + (p1 & 15)] = 64 + lane; } }
            asm volatile("" ::: "memory");
            float s4[2][4]; unsigned k4[2][4];
#pragma unroll
            for (int u = 0; u < 2; ++u) { const float va = selv[(2 * u) * 16 + (lane >> 2)]; const f32x4 vb = *(const LAS f32x4*)(selv + (2 * u + 1) * 16 + (lane & 3) * 4);
#pragma unroll
                for (int q = 0; q < 4; ++q) { s4[u][q] = va + vb[q]; k4[u][q] = (ordkey(s4[u][q]) & ~255u) | (unsigned)(255 - 4 * lane - q); } }
            unsigned T2[2] = {0u, 0u}; int d2 = 0;
            for (unsigned bm = 0x80000000u; bm != 0u && d2 != 3; bm >>= 1) {
#pragma unroll
                for (int u = 0; u < 2; ++u) { const unsigned cand = T2[u] | bm;
                    const int c = (__builtin_popcountll(BALLOT(k4[u][0] >= cand)) + __builtin_popcountll(BALLOT(k4[u][1] >= cand))) + (__builtin_popcountll(BALLOT(k4[u][2] >= cand)) + __builtin_popcountll(BALLOT(k4[u][3] >= cand)));
                    T2[u] = c >= 16 ? cand : T2[u]; d2 |= (c == 16) ? (1 << u) : 0; }
            }
#pragma unroll
            for (int u = 0; u < 2; ++u) {
                const unsigned mk = wave_max_u32(max(max(k4[u][0], k4[u][1]), max(k4[u][2], k4[u][3]))) & ~255u;
                const float mx = __builtin_bit_cast(float, (mk & 0x80000000u) ? (mk & 0x7fffffffu) : ~mk);
                const float cs = 1.4426950408889634f * rstd_tok;
                float p[4], ps = 0.f;
#pragma unroll
                for (int q = 0; q < 4; ++q) { p[q] = (k4[u][q] >= T2[u]) ? __builtin_amdgcn_exp2f((s4[u][q] - mx) * cs) : 0.f; ps += p[q]; }
                const float tot = wave_sum_dpp(ps);
                const int i1 = seli[(2 * u) * 16 + (lane >> 2)]; const u32x4 i2 = *(const LAS u32x4*)(seli + (2 * u + 1) * 16 + (lane & 3) * 4);
                int base = (h + 4 * u) * 16;
#pragma unroll
                for (int q = 0; q < 4; ++q) { const bool sl = k4[u][q] >= T2[u]; const unsigned long long m = BALLOT(sl); const int slot = base + (MBCNT(m) & 15); base += __builtin_popcountll(m);
                    if (sl) { const int e = ((i1 & 127) << 7) | (int)(i2[q] & 127u); s_eid[slot] = e; s_w[slot] = p[q] / tot * SCV[e]; s_su[slot] = SCU[e]; } }
            }
            asm volatile("" ::: "memory");
        }
#undef BALLOT
#undef MBCNT
#undef LDSC_
        LDS_WAIT(); asm volatile("" ::: "memory");
        {
            f32x2 acc2[2][16];
#define ACC(i, k) acc2[(i) >> 1][((i) & 1) * 8 + ((k) >> 1)][(k) & 1]
#pragma unroll
            for (int g = 0; g < 2; ++g)
#pragma unroll
                for (int k = 0; k < 16; ++k) acc2[g][k] = (f32x2){0.f, 0.f};
            const bool dg_ = ((lane & 15) >> 2) == (lane >> 4);
            const float mk0_ = (dg_ && (lane & 3) == 0) ? 1.f : 0.f, mk1_ = (dg_ && (lane & 3) == 1) ? 1.f : 0.f, mk2_ = (dg_ && (lane & 3) == 2) ? 1.f : 0.f, mk3_ = (dg_ && (lane & 3) == 3) ? 1.f : 0.f;
#define LOADREC4(dst, e) do { const u32x4* p_ = (const u32x4*)(T4 + (size_t)(e) * REC4) + lane; dst[0] = p_[0]; dst[1] = p_[64]; dst[2] = p_[128]; dst[3] = p_[192]; } while (0)
#define PROW4(row, j) do { f32x4 ac_ = {0.f, 0.f, 0.f, 0.f}; \
            ac_ = __builtin_amdgcn_mfma_scale_f32_16x16x128_f8f6f4((i32x8){(int)row[0][0], (int)row[0][1], (int)row[0][2], (int)row[0][3], 0, 0, 0, 0}, xq[0], ac_, 4, 0, 0, 0x7f7f7f7f, 0, 0x7f7f7f7f); \
            ac_ = __builtin_amdgcn_mfma_scale_f32_16x16x128_f8f6f4((i32x8){(int)row[1][0], (int)row[1][1], (int)row[1][2], (int)row[1][3], 0, 0, 0, 0}, xq[1], ac_, 4, 0, 0, 0x7f7f7f7f, 0, 0x7f7f7f7f); \
            const float pv_ = (ac_[0] * mk0_ + ac_[1] * mk1_) + (ac_[2] * mk2_ + ac_[3] * mk3_); \
            const float d_ = diag_sum_dpp(pv_) * s_su[j]; const float w_ = s_w[j] * gelu_erf(d_); const f32x2 w2_ = {w_, w_}; \
            _Pragma("unroll") for (int g_ = 0; g_ < 2; ++g_) { \
                u32x4 G_ = row[2 + g_]; asm volatile("" : "+v"(G_)); \
                _Pragma("unroll") for (int k_ = 0; k_ < 4; ++k_) { const unsigned d4_ = G_[k_]; \
                    acc2[g_][4 * k_] = __builtin_elementwise_fma(w2_, __builtin_amdgcn_cvt_scalef32_pk_f32_fp4(d4_, 1.0f, 0), acc2[g_][4 * k_]); acc2[g_][4 * k_ + 1] = __builtin_elementwise_fma(w2_, __builtin_amdgcn_cvt_scalef32_pk_f32_fp4(d4_, 1.0f, 1), acc2[g_][4 * k_ + 1]); \
                    acc2[g_][4 * k_ + 2] = __builtin_elementwise_fma(w2_, __builtin_amdgcn_cvt_scalef32_pk_f32_fp4(d4_, 1.0f, 2), acc2[g_][4 * k_ + 2]); acc2[g_][4 * k_ + 3] = __builtin_elementwise_fma(w2_, __builtin_amdgcn_cvt_scalef32_pk_f32_fp4(d4_, 1.0f, 3), acc2[g_][4 * k_ + 3]); } \
                asm volatile("" : "+v"(acc2[g_][0]), "+v"(acc2[g_][1]), "+v"(acc2[g_][2]), "+v"(acc2[g_][3]), "+v"(acc2[g_][4]), "+v"(acc2[g_][5]), "+v"(acc2[g_][6]), "+v"(acc2[g_][7]), \
                                  "+v"(acc2[g_][8]), "+v"(acc2[g_][9]), "+v"(acc2[g_][10]), "+v"(acc2[g_][11]), "+v"(acc2[g_][12]), "+v"(acc2[g_][13]), "+v"(acc2[g_][14]), "+v"(acc2[g_][15])); } } while (0)
            u32x4 r0[4], r1[4], r2[4], r3[4];
            { const int e_ = RFL(s_eid[0]); LOADREC4(r0, e_); } { const int e_ = RFL(s_eid[1]); LOADREC4(r1, e_); } { const int e_ = RFL(s_eid[2]); LOADREC4(r2, e_); } { const int e_ = RFL(s_eid[3]); LOADREC4(r3, e_); }
            for (int j = 0; j < 124; j += 4) {
                PROW4(r0, j + 0); { const int e_ = RFL(s_eid[j + 4]); LOADREC4(r0, e_); }
                PROW4(r1, j + 1); { const int e_ = RFL(s_eid[j + 5]); LOADREC4(r1, e_); }
                PROW4(r2, j + 2); { const int e_ = RFL(s_eid[j + 6]); LOADREC4(r2, e_); }
                PROW4(r3, j + 3); { const int e_ = RFL(s_eid[j + 7]); LOADREC4(r3, e_); }
            }
            PROW4(r0, 124); PROW4(r1, 125); PROW4(r2, 126); PROW4(r3, 127);
#undef PROW4
#undef LOADREC4
            float ss = 0.f;
#pragma unroll
            for (int i = 0; i < 4; ++i) { float t[16]; load16_bf16(x1 + 1024 * i + 16 * lane, t);
#pragma unroll
                for (int k = 0; k < 16; ++k) { ACC(i, k) += t[k]; ss += ACC(i, k) * ACC(i, k); } }
            ss = wave_sum_dpp(ss);
            const float rs = rsqrtf(ss * (1.0f / D) + 1e-6f);
            if (!FINAL) {
#pragma unroll
                for (int i = 0; i < 4; ++i) { u32x4 w8;
#pragma unroll
                    for (int q = 0; q < 4; ++q) w8[q] = pk4_fp8(ACC(i, 4 * q), ACC(i, 4 * q + 1), ACC(i, 4 * q + 2), ACC(i, 4 * q + 3));
                    *(u32x4*)(XB8n + (size_t)tok * D + 1024 * i + 16 * lane) = w8; }
                if (lane == 0) RSTDn[tok] = rs;
                float mine = 0.f;
#pragma unroll 1
                for (int j = 0; j < 10; ++j) { float s = 0.f;
#pragma unroll
                    for (int i = 0; i < 4; ++i) { const u32x4 g0 = *(const LAS u32x4*)(gfs + j * D + 1024 * i + 16 * lane), g1 = *(const LAS u32x4*)(gfs + j * D + 1024 * i + 16 * lane + 8);
#pragma unroll
                        for (int q = 0; q < 4; ++q) { s += ACC(i, 2 * q) * bf_lo(g0[q]) + ACC(i, 2 * q + 1) * bf_hi(g0[q]); s += ACC(i, 8 + 2 * q) * bf_lo(g1[q]) + ACC(i, 8 + 2 * q + 1) * bf_hi(g1[q]); } }
                    s = wave_sum_dpp(s); if (lane == j) mine = s; }
                if (lane < 10) { const int b_ = tok >> 11, s_ = tok & 2047; LOGFn[(size_t)(b_ * 10 + lane) * S + s_] = logsig(mine * rs + bf_n[lane]); }
            }
            if (FINAL) { float* xo = (float*)XOv + (size_t)tok * D;
#pragma unroll
                for (int i = 0; i < 4; ++i)
#pragma unroll
                    for (int q = 0; q < 4; ++q) { const int c = 1024 * i + 16 * lane + 4 * q; const f32x4 g_ = *(const f32x4*)(fg + c);
                        *(f32x4*)(xo + c) = (f32x4){ACC(i, 4 * q) * rs * g_[0], ACC(i, 4 * q + 1) * rs * g_[1], ACC(i, 4 * q + 2) * rs * g_[2], ACC(i, 4 * q + 3) * rs * g_[3]}; }
            } else { bf16_t* xo = (bf16_t*)XOv + (size_t)tok * D;
#pragma unroll
                for (int i = 0; i < 4; ++i) { u32x4 w0, w1;
#pragma unroll
                    for (int q = 0; q < 4; ++q) { w0[q] = pk2(ACC(i, 2 * q), ACC(i, 2 * q + 1)); w1[q] = pk2(ACC(i, 8 + 2 * q), ACC(i, 8 + 2 * q + 1)); }
                    *(u32x4*)(xo + 1024 * i + 16 * lane) = w0; *(u32x4*)(xo + 1024 * i + 16 * lane + 8) = w1; }
            }
        }
        LDS_WAIT(); asm volatile("" ::: "memory");
    }
#undef ACC
}
}
namespace at {
using namespace mk;
constexpr int QB = 256, KVB = 64, HD = 128;
constexpr int SHM_V = KVB * HD * 2, SHM_K = KVB * HD * 2;
constexpr int OFF_V = 0, OFF_K = 2 * SHM_V, OFF_WS = OFF_K + 2 * SHM_K, OFF_CUM = OFF_WS + 8 * 256, OFF_RT = OFF_CUM + 2048 * 4, OFF_MISC = OFF_RT + 640 * 4;
constexpr float LOG2E = 1.4426950408889634f;
constexpr float THR2 = 10.0f;
constexpr float SB_DONE = -100.0f;

#define AT_KSWZ(row, colB) ((row) * 256 + ((colB) ^ (((row) & 7) << 4)))
__device__ __forceinline__ int v_st(int k, int c) { const int kk = (k & ~0xC) | ((k & 4) << 1) | ((k & 8) >> 1); return ((kk >> 3) * 4 + (c >> 5)) * 512 + ((kk & 7) * 32 + (c & 31)) * 2; }
__device__ __forceinline__ int v_rd_base(int lane) { return ((lane & 3) << 3) | (((lane >> 2) & 3) << 6) | (((lane >> 4) & 1) << 5) | (((lane >> 5) & 1) << 8); }
constexpr int v_rd_off(int d0, int ks, int half) { return d0 * 512 + ks * 4096 + half * 2048; }
__device__ __forceinline__ int crow(int r, int hi) { return (r & 3) + 8 * (r >> 2) + 4 * hi; }
__device__ __forceinline__ unsigned cvtpk(float lo, float hi) { unsigned r; asm volatile("v_cvt_pk_bf16_f32 %0, %1, %2" : "=v"(r) : "v"(lo), "v"(hi)); return r; }
__device__ __forceinline__ float partner(float v, int hi) { auto rr = __builtin_amdgcn_permlane32_swap(__builtin_bit_cast(unsigned, v), __builtin_bit_cast(unsigned, v), false, false); return __builtin_bit_cast(float, hi ? rr[0] : rr[1]); }

__device__ __forceinline__ float xchg_max(float v, int hi) { return fmaxf(v, partner(v, hi)); }
__device__ __forceinline__ float xchg_sum(float v, int hi) { return v + partner(v, hi); }

__device__ __forceinline__ void pack_p(const f32x16& p0, const f32x16& p1, bf16x8& pa0, bf16x8& pa1, bf16x8& pa2, bf16x8& pa3) {
#define AT_PK4(P, B_, OUT) do { unsigned a0 = cvtpk(P[B_ + 0], P[B_ + 1]), a1 = cvtpk(P[B_ + 2], P[B_ + 3]); unsigned b0 = cvtpk(P[B_ + 4], P[B_ + 5]), b1 = cvtpk(P[B_ + 6], P[B_ + 7]); \
        auto r0 = __builtin_amdgcn_permlane32_swap(a0, b0, false, false); auto r1 = __builtin_amdgcn_permlane32_swap(a1, b1, false, false); \
        u32x4 w = {r0[0], r1[0], r0[1], r1[1]}; OUT = __builtin_bit_cast(bf16x8, w); } while (0)
    AT_PK4(p0, 0, pa0); AT_PK4(p0, 8, pa1); AT_PK4(p1, 0, pa2); AT_PK4(p1, 8, pa3);
#undef AT_PK4
}
template <int KBUF>
__device__ __forceinline__ void qkt(f32x16& p0, f32x16& p1, LAS unsigned char* K_lds, int r32, int hi, const bf16x8 (&qr)[8]) {
    p0 = f32x16{}; p1 = f32x16{};
    LAS unsigned char* kb[4];
#pragma unroll
    for (int dd = 0; dd < 4; ++dd) kb[dd] = K_lds + KBUF * SHM_K + AT_KSWZ(r32, (dd * 16 + hi * 8) * 2);
#pragma unroll
    for (int d0 = 0; d0 < 8; ++d0) { LAS unsigned char* a = kb[d0 & 3] + (d0 >> 2) * 128;
        const bf16x8 b0 = *(const LAS bf16x8*)a; const bf16x8 b1 = *(const LAS bf16x8*)(a + 32 * 256);
        p0 = __builtin_amdgcn_mfma_f32_32x32x16_bf16(b0, qr[d0], p0, 0, 0, 0);
        p1 = __builtin_amdgcn_mfma_f32_32x32x16_bf16(b1, qr[d0], p1, 0, 0, 0); }
}
template <int VBUF>
__device__ __forceinline__ void pv_tile(f32x16 (&o)[4], int vb0, bf16x8 pa0, bf16x8 pa1, bf16x8 pa2, bf16x8 pa3) {
#define AT_TRRD(dst, off) asm volatile("ds_read_b64_tr_b16 %0, %1 offset:%2" : "=&v"(dst) : "v"(vb0), "i"(off) : "memory")
#define AT_PV_D0(d0) do { s16x4 l0, l1, l2, l3, h0, h1, h2, h3; constexpr int b_ = VBUF * SHM_V + v_rd_off(d0, 0, 0); \
        AT_TRRD(l0, b_); AT_TRRD(h0, b_ + 2048); AT_TRRD(l1, b_ + 4096); AT_TRRD(h1, b_ + 6144); AT_TRRD(l2, b_ + 8192); AT_TRRD(h2, b_ + 10240); AT_TRRD(l3, b_ + 12288); AT_TRRD(h3, b_ + 14336); \
        asm volatile("s_waitcnt lgkmcnt(0)" ::: "memory"); __builtin_amdgcn_sched_barrier(0); \
        o[d0] = __builtin_amdgcn_mfma_f32_32x32x16_bf16(pa0, (bf16x8){l0[0], l0[1], l0[2], l0[3], h0[0], h0[1], h0[2], h0[3]}, o[d0], 0, 0, 0); \
        o[d0] = __builtin_amdgcn_mfma_f32_32x32x16_bf16(pa1, (bf16x8){l1[0], l1[1], l1[2], l1[3], h1[0], h1[1], h1[2], h1[3]}, o[d0], 0, 0, 0); \
        o[d0] = __builtin_amdgcn_mfma_f32_32x32x16_bf16(pa2, (bf16x8){l2[0], l2[1], l2[2], l2[3], h2[0], h2[1], h2[2], h2[3]}, o[d0], 0, 0, 0); \
        o[d0] = __builtin_amdgcn_mfma_f32_32x32x16_bf16(pa3, (bf16x8){l3[0], l3[1], l3[2], l3[3], h3[0], h3[1], h3[2], h3[3]}, o[d0], 0, 0, 0); } while (0)
    AT_PV_D0(0); AT_PV_D0(1); AT_PV_D0(2); AT_PV_D0(3);
#undef AT_PV_D0
#undef AT_TRRD
}

template <int VAR>
__device__ __forceinline__ void attn_item(const bf16_t* Qh, const bf16_t* Kh, const bf16_t* Vh, bf16_t* OB, const float* relb, const float* LOGF, int b, int h, int qb, LAS unsigned char* lds, int tid) {
    const int wid = __builtin_amdgcn_readfirstlane(tid >> 6), lane = tid & 63, r32 = lane & 31, hi = lane >> 5;
    const int g = VAR == 0 ? h : (VAR == 1 ? 12 + h : 22 + h);
    const size_t hb = (size_t)(b * NH + g) * S * HD;
    const bf16_t* Kp = Kh + hb; const bf16_t* Vp = Vh + hb;
    LAS unsigned char* V_lds = lds + OFF_V; LAS unsigned char* K_lds = lds + OFF_K;
    LAS float* wsf = (LAS float*)(lds + OFF_WS) + wid * 64; LAS float* li_l = wsf; LAS float* al_l = wsf + 32;
    LAS float* cumL = (LAS float*)(lds + OFF_CUM); LAS float* Rt = (LAS float*)(lds + OFF_RT); volatile LAS unsigned* flags = (volatile LAS unsigned*)(lds + OFF_MISC);
    const int P0 = qb * QB, qlo = P0 + wid * 32, qpos = qlo + r32;
    int NT, jlo = 0;
    if (VAR == 0) { jlo = 4 * qb - 8; if (jlo < 0) jlo = 0; NT = 4 * qb + 4 - jlo; } else NT = 4 * qb + 4;
    const int cw = 4 * qb + (wid >> 1);
#define AT_KBASE(t) (VAR == 1 ? (4 * qb + 3 - (t)) * KVB : (jlo + (t)) * KVB)
#define AT_ACT(t) (VAR == 0 ? ((jlo + (t)) >= cw - 8 && (jlo + (t)) <= cw) : (VAR == 1 ? (AT_KBASE(t) <= qlo + 30) : (AT_KBASE(t) <= qlo + 31)))
    if (VAR == 0) {
        const float* tab = relb + h * 257;
        for (int j = tid; j < 639; j += 512) { int rel = 575 - j; rel = rel < -128 ? -128 : (rel > 128 ? 128 : rel); Rt[j] = tab[rel + 128] * LOG2E; }
    }
    if (VAR == 2) {
        const float* lf = LOGF + (size_t)(b * 10 + h) * S; const int kend = P0 + QB;
        f32x4 v = (f32x4){0.f, 0.f, 0.f, 0.f};
        if (4 * tid < kend) v = *(const f32x4*)(lf + 4 * tid);
        v[1] += v[0]; v[2] += v[1]; v[3] += v[2];
        float tot = v[3];
#pragma unroll
        for (int o = 1; o < 64; o <<= 1) { const float t_ = lane_read(tot, lane >= o ? lane - o : lane); if (lane >= o) tot += t_; }
        if (lane == 63) li_l[0] = tot;
        __syncthreads();
        float base = tot - v[3];
        for (int w = 0; w < wid; ++w) base += ((LAS float*)(lds + OFF_WS))[w * 64];
        if (4 * tid < kend) *(LAS f32x4*)(cumL + 4 * tid) = (f32x4){(base + v[0]) * LOG2E, (base + v[1]) * LOG2E, (base + v[2]) * LOG2E, (base + v[3]) * LOG2E};
    }
    bf16x8 qr[8];
    { const bf16_t* qp = Qh + hb + (size_t)(qlo + r32) * HD + hi * 8;
#pragma unroll
      for (int d0 = 0; d0 < 8; ++d0) qr[d0] = *(const bf16x8*)(qp + d0 * 16); }
    const int sr = tid >> 4, sc = (tid & 15) * 8, vst0 = v_st(sr, sc), vst1 = v_st(32 + sr, sc), kws = AT_KSWZ(sr, sc * 2);
    const int vb0 = (int)(unsigned)(size_t)V_lds + v_rd_base(lane);
    bf16x8 st_k0, st_k1, st_v0, st_v1;
#define AT_SLOAD(k0) do { const bf16_t* kp_ = Kp + (size_t)((k0) + sr) * HD + sc; const bf16_t* vp_ = Vp + (size_t)((k0) + sr) * HD + sc; \
        st_k0 = *(const bf16x8*)kp_; st_k1 = *(const bf16x8*)(kp_ + 32 * HD); st_v0 = *(const bf16x8*)vp_; st_v1 = *(const bf16x8*)(vp_ + 32 * HD); } while (0)
#define AT_SWRITE(bf) do { *(LAS bf16x8*)(K_lds + (bf) * SHM_K + kws) = st_k0; *(LAS bf16x8*)(K_lds + (bf) * SHM_K + kws + 32 * 256) = st_k1; \
        *(LAS bf16x8*)(V_lds + (bf) * SHM_V + vst0) = st_v0; *(LAS bf16x8*)(V_lds + (bf) * SHM_V + vst1) = st_v1; } while (0)
    AT_SLOAD(AT_KBASE(0)); asm volatile("s_waitcnt vmcnt(0)" ::: "memory"); AT_SWRITE(0);
    __syncthreads();
    float m_reg = -1e30f, l_reg = 0.f, carry = 0.f;
    f32x16 o[4] = {};
#define AT_STEP(BUF, t) do { \
        const bool more_ = (t) + 1 < NT; \
        if (more_) AT_SLOAD(AT_KBASE((t) + 1)); \
        if (AT_ACT(t)) { \
            const int kb_ = AT_KBASE(t); f32x16 p0, p1; bf16x8 pa0, pa1, pa2, pa3; \
            qkt<BUF>(p0, p1, K_lds, r32, hi, qr); \
            tile_math(p0, p1, kb_, pa0, pa1, pa2, pa3); \
            pv_tile<BUF>(o, vb0, pa0, pa1, pa2, pa3); \
        } \
        if (more_) { asm volatile("s_waitcnt vmcnt(0)" ::: "memory"); AT_SWRITE((BUF) ^ 1); } \
        if (VAR == 1) { const bool done_ = __all(carry < SB_DONE); if (lane == 0) flags[((t) & 1) * 8 + wid] = done_ ? 1u : 0u; } \
        __syncthreads(); \
    } while (0)
    auto tile_math = [&](f32x16& p0, f32x16& p1, int kb, bf16x8& pa0, bf16x8& pa1, bf16x8& pa2, bf16x8& pa3) __attribute__((always_inline)) {
        const int dq = qpos - kb - 4 * hi;
        if (VAR == 1) {
            const bool need_mask = kb + 63 >= qlo;
            f32x16 n0, n1;
#pragma unroll
            for (int r = 0; r < 16; ++r) { const float z = p0[r]; const float lp = __builtin_amdgcn_logf(1.0f + __builtin_amdgcn_exp2f(-fabsf(z))); n0[r] = fminf(-z, 0.f) - lp;
                                           const float y = p1[r]; const float lq = __builtin_amdgcn_logf(1.0f + __builtin_amdgcn_exp2f(-fabsf(y))); n1[r] = fminf(-y, 0.f) - lq; }
            if (need_mask) {
#pragma unroll
                for (int r = 0; r < 16; ++r) { const int c = (r & 3) + 8 * (r >> 2);
                    if (dq - c <= 0) { n0[r] = 0.f; p0[r] = -__builtin_inff(); }
                    if (dq - c - 32 <= 0) { n1[r] = 0.f; p1[r] = -__builtin_inff(); } }
            }
            float A[8], Bp[8];
#pragma unroll
            for (int q = 0; q < 4; ++q) { A[q] = (n0[4 * q] + n0[4 * q + 1]) + (n0[4 * q + 2] + n0[4 * q + 3]); A[4 + q] = (n1[4 * q] + n1[4 * q + 1]) + (n1[4 * q + 2] + n1[4 * q + 3]); }
#pragma unroll
            for (int q = 0; q < 8; ++q) Bp[q] = partner(A[q], hi);
            float st = 0.f;
#pragma unroll
            for (int q = 7; q >= 0; --q) {
                const float after = carry + st + (hi == 0 ? Bp[q] : 0.f);
                if (q >= 4) { const int r0 = 4 * (q - 4);
                    float tl = after; p1[r0 + 3] = __builtin_amdgcn_exp2f(p1[r0 + 3] + n1[r0 + 3] + tl); tl += n1[r0 + 3]; p1[r0 + 2] = __builtin_amdgcn_exp2f(p1[r0 + 2] + n1[r0 + 2] + tl); tl += n1[r0 + 2];
                    p1[r0 + 1] = __builtin_amdgcn_exp2f(p1[r0 + 1] + n1[r0 + 1] + tl); tl += n1[r0 + 1]; p1[r0] = __builtin_amdgcn_exp2f(p1[r0] + n1[r0] + tl); }
                else { const int r0 = 4 * q;
                    float tl = after; p0[r0 + 3] = __builtin_amdgcn_exp2f(p0[r0 + 3] + n0[r0 + 3] + tl); tl += n0[r0 + 3]; p0[r0 + 2] = __builtin_amdgcn_exp2f(p0[r0 + 2] + n0[r0 + 2] + tl); tl += n0[r0 + 2];
                    p0[r0 + 1] = __builtin_amdgcn_exp2f(p0[r0 + 1] + n0[r0 + 1] + tl); tl += n0[r0 + 1]; p0[r0] = __builtin_amdgcn_exp2f(p0[r0] + n0[r0] + tl); }
                st += A[q] + Bp[q];
            }
            carry += st;
            pack_p(p0, p1, pa0, pa1, pa2, pa3);
        } else {
            if (VAR == 0) {
                const LAS float* rp = Rt + (575 - (qpos - kb) + 4 * hi);
#pragma unroll
                for (int r = 0; r < 16; ++r) { const int c = (r & 3) + 8 * (r >> 2); p0[r] += rp[c]; p1[r] += rp[c + 32]; }
            } else {
                const LAS float* cp = cumL + kb + 4 * hi;
#pragma unroll
                for (int q = 0; q < 4; ++q) { const f32x4 c0 = *(const LAS f32x4*)(cp + 8 * q), c1 = *(const LAS f32x4*)(cp + 32 + 8 * q);
                    p0[4 * q] -= c0[0]; p0[4 * q + 1] -= c0[1]; p0[4 * q + 2] -= c0[2]; p0[4 * q + 3] -= c0[3];
                    p1[4 * q] -= c1[0]; p1[4 * q + 1] -= c1[1]; p1[4 * q + 2] -= c1[2]; p1[4 * q + 3] -= c1[3]; }
                if (kb + 63 > qlo) {
#pragma unroll
                    for (int r = 0; r < 16; ++r) { const int c = (r & 3) + 8 * (r >> 2);
                        if (dq - c < 0) p0[r] = -__builtin_inff();
                        if (dq - c - 32 < 0) p1[r] = -__builtin_inff(); }
                }
            }
            float pmax = p0[0];
#pragma unroll
            for (int r = 1; r < 16; ++r) pmax = fmaxf(pmax, p0[r]);
#pragma unroll
            for (int r = 0; r < 16; ++r) pmax = fmaxf(pmax, p1[r]);
            pmax = xchg_max(pmax, hi);
            float mn, alpha;
            if (__all(pmax - m_reg <= THR2)) { mn = m_reg; alpha = 1.f; }
            else { mn = fmaxf(m_reg, pmax); alpha = __builtin_amdgcn_exp2f(m_reg - mn); m_reg = mn; }
            float ps = 0.f;
#pragma unroll
            for (int r = 0; r < 16; ++r) { p0[r] = __builtin_amdgcn_exp2f(p0[r] - mn); p1[r] = __builtin_amdgcn_exp2f(p1[r] - mn); ps += p0[r] + p1[r]; }
            ps = xchg_sum(ps, hi);
            l_reg = l_reg * alpha + ps;
            if (__any(alpha < 1.f)) {
                if (hi == 0) al_l[r32] = alpha;
                asm volatile("s_waitcnt lgkmcnt(0)" ::: "memory");
                float av[16];
#pragma unroll
                for (int r = 0; r < 16; ++r) av[r] = al_l[crow(r, hi)];
#pragma unroll
                for (int d = 0; d < 4; ++d)
#pragma unroll
                    for (int r = 0; r < 16; ++r) o[d][r] *= av[r];
            }
            pack_p(p0, p1, pa0, pa1, pa2, pa3);
        }
    };
    for (int t = 0; t < NT; t += 2) {
        AT_STEP(0, t);
        if (VAR == 1) { unsigned all_ = 1u; for (int w = 0; w < 8; ++w) all_ &= flags[(t & 1) * 8 + w]; if (all_) break; }
        if (t + 1 >= NT) break;
        AT_STEP(1, t + 1);
        if (VAR == 1) { unsigned all_ = 1u; for (int w = 0; w < 8; ++w) all_ &= flags[((t + 1) & 1) * 8 + w]; if (all_) break; }
    }
    float rli[16];
    if (VAR != 1) {
        if (hi == 0) li_l[r32] = l_reg;
        asm volatile("s_waitcnt lgkmcnt(0)" ::: "memory");
#pragma unroll
        for (int r = 0; r < 16; ++r) rli[r] = __builtin_amdgcn_rcpf(li_l[crow(r, hi)]);
    }
    unsigned char* Ow8 = (unsigned char*)OB + (size_t)(b * S + qlo) * D + g * HD;
    const unsigned bsel_ = (unsigned)(lane & 3) | ((4u + (unsigned)(lane & 3)) << 8);
#pragma unroll
    for (int r = 0; r < 16; ++r) { const int orow = crow(r, hi); const float sc_ = VAR != 1 ? rli[r] * 16.0f : 16.0f;
        const unsigned w = mk::pk4_fp8(o[0][r] * sc_, o[1][r] * sc_, o[2][r] * sc_, o[3][r] * sc_);
        const unsigned t0 = (unsigned)__builtin_amdgcn_update_dpp(0, (int)w, 0x00, 0xF, 0xF, false), t1 = (unsigned)__builtin_amdgcn_update_dpp(0, (int)w, 0x55, 0xF, 0xF, false),
                       t2 = (unsigned)__builtin_amdgcn_update_dpp(0, (int)w, 0xAA, 0xF, 0xF, false), t3 = (unsigned)__builtin_amdgcn_update_dpp(0, (int)w, 0xFF, 0xF, 0xF, false);
        const unsigned r01 = __builtin_amdgcn_perm(t1, t0, bsel_), r23 = __builtin_amdgcn_perm(t3, t2, bsel_);
        *(unsigned*)(Ow8 + (size_t)orow * D + (lane & 3) * 32 + (r32 & ~3)) = __builtin_amdgcn_perm(r23, r01, 0x05040100u); }
    __syncthreads();
#undef AT_STEP
#undef AT_SLOAD
#undef AT_SWRITE
#undef AT_KBASE
#undef AT_ACT
}

template <int VAR>
__device__ __forceinline__ void attn_queue(const bf16_t* Qh, const bf16_t* Kh, const bf16_t* Vh, bf16_t* OB, const float* relb, const float* LOGF, unsigned* qhead, LAS unsigned char* lds, int wave0) {
    FRESH_TID(); FRESH_LDS(lds);
    volatile LAS unsigned* qslot = (volatile LAS unsigned*)(lds + OFF_MISC) + 32;
    constexpr int NHV = VAR == 0 ? 12 : 10, NITEMS = 8 * NHV * 8;
    for (;;) {
        if (tid == 0) qslot[0] = __hip_atomic_fetch_add(qhead, 1u, __ATOMIC_RELAXED, __HIP_MEMORY_SCOPE_AGENT);
        __syncthreads();
        const int idx = (int)qslot[0];
        __syncthreads();
        if (idx >= NITEMS) break;
        const int qb = 7 - idx / (8 * NHV), bh = idx % (8 * NHV);
        attn_item<VAR>(Qh, Kh, Vh, OB, relb, LOGF, bh / NHV, bh % NHV, qb, lds, tid);
    }
}
__device__ __forceinline__ void attn_phase(const bf16_t* Qh, const bf16_t* Kh, const bf16_t* Vh, bf16_t* OB, const float* relb, const float* LOGF, unsigned* qheads, LAS unsigned char* lds, int wave0, mk::KArgsT ka, int conv_l) {
    int grp = (int)((blockIdx.x >> 3) & 3u); asm volatile("" : "+s"(grp));
    int cnt = 0; bool conv_done = conv_l < 0;
#pragma unroll 1
    for (int seg = 0; seg < 4; ++seg) {
        for (;;) {
            if (!conv_done && (cnt == grp || seg == 3)) { mk::conv_phase(ka, conv_l, lds, wave0); __syncthreads(); conv_done = true; }
            if (seg == 3) break;
            int idx;
            { FRESH_TID(); LAS unsigned char* l_ = lds; FRESH_LDS(l_); volatile LAS unsigned* qslot = (volatile LAS unsigned*)(l_ + OFF_MISC) + 32;
              if (tid == 0) qslot[0] = __hip_atomic_fetch_add(qheads + 64 * seg, 1u, __ATOMIC_RELAXED, __HIP_MEMORY_SCOPE_AGENT);
              __syncthreads();
              idx = (int)qslot[0];
              __syncthreads(); }
            const int NHV = seg == 1 ? 12 : 10;
            if (idx >= 64 * NHV) break;
            ++cnt;
            const int qb = 7 - idx / (8 * NHV), bh = idx % (8 * NHV);
            { FRESH_TID(); LAS unsigned char* l_ = lds; FRESH_LDS(l_);
              if (seg == 0) attn_item<2>(Qh, Kh, Vh, OB, relb, LOGF, bh / NHV, bh % NHV, qb, l_, tid);
              else if (seg == 1) attn_item<0>(Qh, Kh, Vh, OB, relb, LOGF, bh / NHV, bh % NHV, qb, l_, tid);
              else attn_item<1>(Qh, Kh, Vh, OB, relb, LOGF, bh / NHV, bh % NHV, qb, l_, tid); }
        }
    }
}
}
namespace mk {
#define XB_TMO      128
#define XB_XCNT(j)  (256  + 64 * (j))
#define XB_XSUB(j)  (1280 + 64 * (j))
#define XB_XGEN(j)  (2304 + 64 * (j))
#define XB_TOP      3328
#define XB_TOPGEN   3392
#define XCD_BAR_WORDS 3456
#define XB_SPIN_CAP (1u << 22)

__device__ __forceinline__ unsigned xb_ld(unsigned* p)              { return __hip_atomic_load(p, __ATOMIC_RELAXED, __HIP_MEMORY_SCOPE_AGENT); }
__device__ __forceinline__ unsigned xb_add(unsigned* p, unsigned v) { return __hip_atomic_fetch_add(p, v, __ATOMIC_RELAXED, __HIP_MEMORY_SCOPE_AGENT); }
__device__ __forceinline__ unsigned xb_xcc_id() { return (unsigned)__builtin_amdgcn_s_getreg((3 << 11) | 20) & 0xFu; }
#define XB_SPIN(cond, bar) do { unsigned _sp = 0; while (cond) { __builtin_amdgcn_s_sleep(1); \
    if ((++_sp & 255u) == 0u) { if (xb_ld(&(bar)[XB_TMO])) break; if (_sp > XB_SPIN_CAP) { atomicAdd(&(bar)[XB_TMO], 1u); break; } } } } while (0)

struct XcdBarrier {
    unsigned* bar; unsigned x;
    volatile LAS unsigned* st;
};

__device__ __forceinline__ XcdBarrier xcd_barrier_post(unsigned* bar, volatile LAS unsigned* st, bool is_t0) {
    XcdBarrier b; b.bar = bar; b.x = xb_xcc_id(); b.st = st;
    if (is_t0) (void)xb_add(&bar[XB_XCNT(b.x)], 1u);
    return b;
}
__device__ __forceinline__ void xcd_barrier_complete(unsigned* bar, unsigned x, unsigned& nloc, unsigned& nx) {
    const unsigned G = gridDim.x * gridDim.y * gridDim.z;
    unsigned sum, cnt, mine, sp = 0u;
    for (;;) {
        sum = 0u; cnt = 0u; mine = 0u;
#pragma unroll
        for (unsigned j = 0; j < 16; ++j) { const unsigned c = xb_ld(&bar[XB_XCNT(j)]); sum += c; cnt += (c > 0u) ? 1u : 0u; mine = (j == x) ? c : mine; }
        if (sum == G) break;
        __builtin_amdgcn_s_sleep(1);
        if ((++sp & 255u) == 0u) { if (xb_ld(&bar[XB_TMO])) break; if (sp > XB_SPIN_CAP) { atomicAdd(&bar[XB_TMO], 1u); break; } }
    }
    nloc = mine > 0u ? mine : 1u; nx = cnt > 0u ? cnt : 1u;
}

__device__ __forceinline__ void xcd_barrier(const XcdBarrier& b, bool is_t0) {
    asm volatile("s_waitcnt vmcnt(0)" ::: "memory");
    __syncthreads();
    if (is_t0) {
        unsigned* bar = b.bar;
        __builtin_amdgcn_s_waitcnt(0);
        unsigned nloc = b.st[0], nx = b.st[1];
        if (nloc == 0u) { xcd_barrier_complete(bar, b.x, nloc, nx); b.st[0] = nloc; b.st[1] = nx; }
        const unsigned old = xb_add(&bar[XB_XSUB(b.x)], 1u);
        const unsigned gen = old / nloc;
        if (old + 1u == (gen + 1u) * nloc) {
            __builtin_amdgcn_fence(__ATOMIC_RELEASE, "agent");
            asm volatile("s_waitcnt vmcnt(0)" ::: "memory");
            const unsigned og = xb_add(&bar[XB_TOP], 1u);
            const unsigned tg = og / nx;
            if (og + 1u == (tg + 1u) * nx) xb_add(&bar[XB_TOPGEN], 1u);
            else XB_SPIN(xb_ld(&bar[XB_TOPGEN]) == tg, bar);
            __builtin_amdgcn_fence(__ATOMIC_ACQUIRE, "agent");
            xb_add(&bar[XB_XGEN(b.x)], 1u);
            asm volatile("s_waitcnt vmcnt(0)" ::: "memory");
        } else {
            XB_SPIN(xb_ld(&bar[XB_XGEN(b.x)]) == gen, bar);
            __builtin_amdgcn_fence(__ATOMIC_ACQUIRE, "agent");
            asm volatile("s_waitcnt vmcnt(0)" ::: "memory");
        }
    }
    __syncthreads();
}

constexpr int PH_PER_LAYER = 8;
typedef const __attribute__((address_space(4))) Args* KArgs;
#define KARGS() ({ KArgs p_ = (KArgs)__builtin_amdgcn_kernarg_segment_ptr(); asm volatile("" : "+s"(p_)); p_; })
#define GRID_BAR() do { KArgs k_ = KARGS(); XcdBarrier b_; b_.bar = (unsigned*)(k_->ws + WS_CTL) + CW_BAR; b_.x = xb_xcc_id(); b_.st = (volatile LAS unsigned*)(lds + MISC_OFF) + 8; unsigned z_ = 0u; asm volatile("" : "+v"(z_)); const bool t0_ = (wave0 == 0) && (__builtin_amdgcn_mbcnt_hi(~0u, __builtin_amdgcn_mbcnt_lo(~0u, z_)) == 0u);     xcd_barrier(b_, t0_); } while (0)
__global__ void __launch_bounds__(NWAVES * 64, 2) mk_fwd(Args a_unused) {
    extern __shared__ __attribute__((aligned(16))) unsigned char lds_raw[];
    LAS unsigned char* lds = (LAS unsigned char*)lds_raw;
    const int wave0 = __builtin_amdgcn_readfirstlane((int)threadIdx.x >> 6);
    for (int u = threadIdx.x; u < (LDS_BYTES - LDSCTL_OFF) / 4; u += NWAVES * 64) ((LAS unsigned*)(lds + LDSCTL_OFF))[u] = 0u;
    __syncthreads();
    int lo, hi;
    { KArgs k = KARGS(); lo = k->ph_lo; hi = k->ph_hi;
      if (hi - lo > 1) (void)xcd_barrier_post((unsigned*)(k->ws + WS_CTL) + CW_BAR, (volatile LAS unsigned*)(lds + MISC_OFF) + 8, threadIdx.x == 0); }
#define IN(k) (lo <= (k) && (k) < hi)
#define BOTH(k) (IN(k) && IN((k) + 1))
#pragma unroll
    for (int l = 0; l < 2; ++l) {
        const int pb = PH_PER_LAYER * l;
        if (IN(pb + 0) && l == 0) { KArgs k = KARGS(); conv_phase(k, l, lds, wave0); }
        if (IN(pb + 1) && l == 0) {
            KArgs k = KARGS(); unsigned char* ws = k->ws;
            const float* xin = k->in[0];
            prep_phase<true>(xin, (bf16_t*)(ws + WS_XB8N), (float*)(ws + WS_RSTD), k->in[2] + (size_t)l * D * PW, k->in[1] + (size_t)l * D, k->in[3] + l * 10, (float*)(ws + WS_LOGF), lds, wave0);
            if (BOTH(pb + 1)) GRID_BAR();
        }
        if (IN(pb + 2)) {
            KArgs k = KARGS(); unsigned char* ws = k->ws;
            pg8::Gemm g{(const bf16_t*)(ws + WS_XB8N), (const bf16_t*)(ws + ws_win(l)), M, 12288, D}; pg8::StaticOrder So; FRESH_BID(); So.init(M, 12288, G, bid);
            pg8::EpiQKV4 E{(bf16_t*)(ws + WS_Q), (const float*)(ws + WS_RSTD), 0.08838834764831845f * 1.4426950408889634f, US_INV};
            { LAS unsigned char* lds_ = lds; FRESH_LDS(lds_); FRESH_TID(); pg8::gemm_phase<pg8::EpiQKV4, pg8::StaticOrder, true, true, true>(lds_, g, So, E, tid); }
            if (BOTH(pb + 2)) GRID_BAR();
        }
        if (IN(pb + 3)) {
            KArgs k = KARGS(); unsigned char* ws = k->ws;
            at::attn_phase((const bf16_t*)(ws + WS_Q), (const bf16_t*)(ws + WS_K), (const bf16_t*)(ws + WS_V), (bf16_t*)(ws + WS_OB), k->in[4] + (size_t)l * 12 * 257, (const float*)(ws + WS_LOGF),
                           (unsigned*)(ws + WS_CTL) + CW_QUEUE + 256 * l, lds, wave0, k, l == 0 ? 1 : -1);
            if (BOTH(pb + 3)) GRID_BAR();
        }
        if (IN(pb + 4)) {
            KArgs k = KARGS(); unsigned char* ws = k->ws;
            pg8::Gemm g{(const bf16_t*)(ws + WS_OB), (const bf16_t*)(ws + ws_wout(l)), M, D, D}; pg8::StaticOrder So; FRESH_BID(); So.init(M, D, G, bid);
            if (l == 0) { pg8::EpiResidB16<true> E{k->in[0], US_INV * (1.0f / 16.0f), (bf16_t*)(ws + WS_XB)};
                { LAS unsigned char* lds_ = lds; FRESH_LDS(lds_); FRESH_TID(); pg8::gemm_phase<pg8::EpiResidB16<true>, pg8::StaticOrder, false, true, true>(lds_, g, So, E, tid); } }
            else { pg8::EpiResidB16<false> E{ws + WS_X2, US_INV * (1.0f / 16.0f), (bf16_t*)(ws + WS_XB)};
                { LAS unsigned char* lds_ = lds; FRESH_LDS(lds_); FRESH_TID(); pg8::gemm_phase<pg8::EpiResidB16<false>, pg8::StaticOrder, false, true, true>(lds_, g, So, E, tid); } }
            if (BOTH(pb + 4)) GRID_BAR();
        }
        if (IN(pb + 5)) {
            KArgs k = KARGS(); unsigned char* ws = k->ws;
            pg8::Gemm g{(const bf16_t*)(ws + WS_XB), (const bf16_t*)(ws + ws_wqk(l)), M, 2048, D}; pg8::StaticOrder So; FRESH_BID(); So.init(M, 2048, G, bid);
            pg8::EpiPlainF32<2048> E{(float*)(ws + WS_SC)};
            { LAS unsigned char* lds_ = lds; FRESH_LDS(lds_); FRESH_TID(); pg8::gemm_phase<pg8::EpiPlainF32<2048>, pg8::StaticOrder, true, true>(lds_, g, So, E, tid); }
            if (BOTH(pb + 5)) GRID_BAR();
        }
        if (IN(pb + 6)) {
            KArgs k = KARGS(); unsigned char* ws = k->ws;
            if (l == 0) peer_uv_phase<false>((const float*)(ws + WS_SC), (const unsigned char*)(ws + ws_tab(l)), (const bf16_t*)(ws + WS_XB), ws + WS_X2, nullptr,
                                             ws + WS_XB8N, (float*)(ws + WS_RSTD), (float*)(ws + WS_LOGF), k->in[2] + (size_t)D * PW, k->in[1] + D, k->in[3] + 10, lds, wave0);
            else peer_uv_phase<true>((const float*)(ws + WS_SC), (const unsigned char*)(ws + ws_tab(l)), (const bf16_t*)(ws + WS_XB), k->out, k->in[12],
                                     nullptr, nullptr, nullptr, nullptr, nullptr, nullptr, lds, wave0);
            if (BOTH(pb + 7)) GRID_BAR();
        }
    }
#undef IN
#undef BOTH
}

static int g_grid = 0;
static void launch_phases(Args a, int lo, int hi, hipStream_t st) {
    a.ph_lo = lo; a.ph_hi = hi;
    hipLaunchKernelGGL(mk_fwd, dim3(g_grid), dim3(NWAVES * 64), LDS_BYTES, st, a);
}
}

extern "C" void kernel_launch(void* const* d_in, const int* in_sizes, int n_in, void* d_out, int out_size, void* d_ws, size_t ws_size, hipStream_t stream) {
    (void)in_sizes; (void)n_in; (void)out_size;
    using namespace mk;
    if (g_grid == 0) {
        if (ws_size < 2048 * MiB) { fprintf(stderr, "kernel_launch: workspace too small (%zu)\n", ws_size); g_grid = -1; return; }
        if (hipFuncSetAttribute((const void*)mk_fwd, hipFuncAttributeMaxDynamicSharedMemorySize, LDS_BYTES) != hipSuccess) { fprintf(stderr, "kernel_launch: hipFuncSetAttribute failed\n"); g_grid = -1; return; }
        int dev = 0, cus = 0; (void)hipGetDevice(&dev); (void)hipDeviceGetAttribute(&cus, hipDeviceAttributeMultiprocessorCount, dev);
        g_grid = cus > 0 ? cus : 256;
    }
    if (g_grid < 0) return;
    unsigned char* ws = (unsigned char*)d_ws; float* out = (float*)d_out;
    (void)hipMemsetAsync(ws + WS_CTL, 0, CTL_ZERO_BYTES, stream);
    Args a{};
    for (int i = 0; i < 13; ++i) a.in[i] = (const float*)d_in[i];
    a.out = out; a.ws = ws;
    launch_phases(a, 0, 2 * PH_PER_LAYER, stream);
}
```

```cpp
#include <hip/hip_runtime.h>
#include <cstdio>
#include <cstdint>
namespace pg8 {
#define PG8_LAS __attribute__((address_space(3)))
typedef unsigned short bf16_t;
typedef short bf16x8 __attribute__((ext_vector_type(8)));
typedef float f32x4 __attribute__((ext_vector_type(4)));
typedef unsigned u32x4 __attribute__((ext_vector_type(4)));
typedef unsigned u32x2 __attribute__((ext_vector_type(2)));
constexpr int BM = 256, BK = 64, HALF = 128, HTB = HALF * BK * 2  , STAGE_BYTES = 8 * HTB, NXCD = 8, WGM = 8;

__host__ __device__ __forceinline__ int lds_byte(int r, int c) { const int st = (r >> 4) * 2 + (c >> 5), rr = r & 15, cc = c & 31, ob = rr * 64 + cc * 2; return st * 1024 + (ob ^ (((ob >> 9) & 1) << 5)); }
__host__ __device__ __forceinline__ void stage_rc(int b, int& R, int& C) { const int st = b / 1024, sb = b % 1024, swz = sb ^ (((sb >> 9) & 1) << 5); R = (st >> 1) * 16 + swz / 64; C = (st & 1) * 32 + (swz % 64) / 2; }
__host__ __device__ __forceinline__ int perm32(int rho) { const int n = rho >> 4, i = rho & 15; return 8 * (i >> 2) + 4 * n + (i & 3); }

struct Unit { int pm, pn; };
struct Gemm { const bf16_t* A; const bf16_t* Bt; int M, N, K; };

struct StaticOrder {
    int nM, nN, nwg, G, c;
    __host__ __device__ void init(int M, int N, int G_, int c_) { nM = M / BM; nN = N / BM; nwg = nM * nN; G = G_; c = c_; }
    __host__ __device__ bool next(int i, Unit& u) const {
        const long L = (long)i * G + c; if (L >= nwg) return false;
        int wgid = (int)L; { const int q = nwg / NXCD, r = nwg % NXCD, xcd = wgid % NXCD, off = wgid / NXCD; wgid = (xcd < r ? xcd * (q + 1) : r * (q + 1) + (xcd - r) * q) + off; }
        const int nig = WGM * nN, gid = wgid / nig, fm = gid * WGM, gsz = (nM - fm) < WGM ? (nM - fm) : WGM;
        u.pm = fm + ((wgid % nig) % gsz); u.pn = (wgid % nig) / gsz; return true;
    }
    __device__ __forceinline__ void a_ready(const Unit&) const {}
    __device__ __forceinline__ void done(const Unit&) const {}
};
__device__ __forceinline__ unsigned cvt_pk_bf16(float lo, float hi) { unsigned r; asm volatile("v_cvt_pk_bf16_f32 %0, %1, %2" : "=v"(r) : "v"(lo), "v"(hi)); return r; }
typedef float f32x2 __attribute__((ext_vector_type(2)));
__device__ __forceinline__ f32x2 gelu_pk(f32x2 v) {
    const f32x2 av = __builtin_elementwise_abs(v), d = av * 0.2316418882f + 1.0f;
    f32x2 t; t.x = __builtin_amdgcn_rcpf(d.x); t.y = __builtin_amdgcn_rcpf(d.y);
    f32x2 q = t * 0.5307027145f + (-0.7265760135f); q = q * t + 0.7107068705f; q = q * t + (-0.142248368f); q = q * t + 0.127414796f; q = q * t;
    const f32x2 s = (v * v) * (-0.72134752044f);
    f32x2 e; e.x = __builtin_amdgcn_exp2f(s.x); e.y = __builtin_amdgcn_exp2f(s.y);
    const f32x2 m = v * (q * e), r = v - m;
    f32x2 o; o.x = v.x < 0.f ? m.x : r.x; o.y = v.y < 0.f ? m.y : r.y; return o;
}
#define EPI_FRESH_LANE() { unsigned z_ = 0u; asm volatile("" : "+v"(z_)); const int l_ = (int)__builtin_amdgcn_mbcnt_hi(~0u, __builtin_amdgcn_mbcnt_lo(~0u, z_)); fr = l_ & 15; fq = l_ >> 4; }
typedef __amdgpu_buffer_rsrc_t rsrc_t;
__device__ __forceinline__ rsrc_t mkrsrc(const void* p, unsigned bytes) { return __builtin_amdgcn_make_buffer_rsrc((void*)p, (short)0, (int)bytes, 0x00020000); }
template <int LDC> struct EpiPlainF32 {
    static constexpr bool PERM = false, AFTER_DRAIN = false;
    float* C;
    __device__ __forceinline__ void operator()(const f32x4 (&acc)[2][2][4][2], const Unit& u, int wr, int wc, int fr, int fq) const {
        EPI_FRESH_LANE();
        const rsrc_t rc = mkrsrc(C, 16384u * LDC * 4u);
        const int vo = ((wr * 64 + fr) * LDC + wc * 32 + 4 * fq) * 4, so = (u.pm * BM * LDC + u.pn * BM) * 4;
#pragma unroll
        for (int ai = 0; ai < 2; ++ai)
#pragma unroll
            for (int m = 0; m < 4; ++m)
#pragma unroll
                for (int bj = 0; bj < 2; ++bj)
#pragma unroll
                    for (int n = 0; n < 2; ++n) __builtin_amdgcn_raw_buffer_store_b128(__builtin_bit_cast(u32x4, acc[ai][bj][m][n]), rc, vo, so + ((ai * HALF + m * 16) * LDC + bj * HALF + n * 16) * 4, 0);
    }
};
template <int LDC> struct EpiRowScaleF32 {
    static constexpr bool PERM = false, AFTER_DRAIN = false;
    float* C; const float* rs;
    __device__ __forceinline__ void operator()(const f32x4 (&acc)[2][2][4][2], const Unit& u, int wr, int wc, int fr, int fq) const {
        const rsrc_t rc = mkrsrc(C, 16384u * LDC * 4u), rr = mkrsrc(rs, 16384u * 4u);
        const int vo = ((wr * 64 + fr) * LDC + wc * 32 + 4 * fq) * 4, vr = (wr * 64 + fr) * 4;
        const int so = (u.pm * BM * LDC + u.pn * BM) * 4, sr = u.pm * BM * 4;
#pragma unroll
        for (int ai = 0; ai < 2; ++ai)
#pragma unroll
            for (int m = 0; m < 4; ++m) { const float s = __builtin_bit_cast(float, __builtin_amdgcn_raw_buffer_load_b32(rr, vr, sr + (ai * HALF + m * 16) * 4, 0));
#pragma unroll
                for (int bj = 0; bj < 2; ++bj)
#pragma unroll
                    for (int n = 0; n < 2; ++n) { const f32x4 v = acc[ai][bj][m][n] * s; __builtin_amdgcn_raw_buffer_store_b128(__builtin_bit_cast(u32x4, v), rc, vo, so + ((ai * HALF + m * 16) * LDC + bj * HALF + n * 16) * 4, 0); } }
    }
};
__device__ __forceinline__ u32x4 widen_pair(unsigned x0, unsigned x1, unsigned y0, unsigned y1, int lane_, int fq_) {
    const bool odd = fq_ & 1; const int pa = (lane_ ^ 16) << 2;
    const unsigned r0 = (unsigned)__builtin_amdgcn_ds_bpermute(pa, (int)(odd ? x0 : y0)), r1 = (unsigned)__builtin_amdgcn_ds_bpermute(pa, (int)(odd ? x1 : y1));
    return odd ? (u32x4){r0, r1, y0, y1} : (u32x4){x0, x1, r0, r1};
}
template <bool BASE_F32> struct EpiResidB16 {
    static constexpr bool PERM = false, AFTER_DRAIN = false;
    const void* base; float ascale; bf16_t* xb;
    __device__ __forceinline__ void operator()(const f32x4 (&acc)[2][2][4][2], const Unit& u, int wr, int wc, int fr, int fq) const {
        EPI_FRESH_LANE();
        constexpr int LDC = 4096;
        const rsrc_t rb = mkrsrc(base, 16384u * LDC * (BASE_F32 ? 4u : 2u)), rx = mkrsrc(xb, 16384u * LDC * 2u);
        const int vo = ((wr * 64 + fr) * LDC + wc * 32 + 4 * fq) * 2;
        const int so = (u.pm * BM * LDC + u.pn * BM) * 2;
        const int vo8 = ((wr * 64 + fr) * LDC + wc * 32 + (fq & 1) * 16 + (fq >> 1) * 8) * 2;
        f32x4 ra[2][2], rb2[2][2];
#define EPI_LD(dst, g_) do { _Pragma("unroll") for (int bj = 0; bj < 2; ++bj) _Pragma("unroll") for (int n = 0; n < 2; ++n) { \
            const int o = so + ((((g_) >> 2) * HALF + ((g_) & 3) * 16) * LDC + bj * HALF + n * 16) * 2; \
            if constexpr (BASE_F32) dst[bj][n] = __builtin_bit_cast(f32x4, __builtin_amdgcn_raw_buffer_load_b128(rb, vo * 2, o * 2, 0)); \
            else { const u32x2 t_ = __builtin_amdgcn_raw_buffer_load_b64(rb, vo, o, 0); dst[bj][n] = (f32x4){__builtin_bit_cast(float, t_.x << 16), __builtin_bit_cast(float, t_.x & 0xffff0000u), __builtin_bit_cast(float, t_.y << 16), __builtin_bit_cast(float, t_.y & 0xffff0000u)}; } } } while (0)
#define EPI_ST(src, g_) do { _Pragma("unroll") for (int bj = 0; bj < 2; ++bj) { \
            const int o = so + ((((g_) >> 2) * HALF + ((g_) & 3) * 16) * LDC + bj * HALF) * 2; \
            const f32x4 v0 = src[bj][0] + acc[(g_) >> 2][bj][(g_) & 3][0] * ascale, v1 = src[bj][1] + acc[(g_) >> 2][bj][(g_) & 3][1] * ascale; \
            const u32x4 w16 = widen_pair(cvt_pk_bf16(v0[0], v0[1]), cvt_pk_bf16(v0[2], v0[3]), cvt_pk_bf16(v1[0], v1[1]), cvt_pk_bf16(v1[2], v1[3]), 16 * fq + fr, fq); \
            __builtin_amdgcn_raw_buffer_store_b128(w16, rx, vo8, o, 0); } } while (0)
        EPI_LD(ra, 0);
        EPI_LD(rb2, 1); EPI_ST(ra, 0);
        EPI_LD(ra, 2); EPI_ST(rb2, 1);
        EPI_LD(rb2, 3); EPI_ST(ra, 2);
        EPI_LD(ra, 4); EPI_ST(rb2, 3);
        EPI_LD(rb2, 5); EPI_ST(ra, 4);
        EPI_LD(ra, 6); EPI_ST(rb2, 5);
        EPI_LD(rb2, 7); EPI_ST(ra, 6);
        EPI_ST(rb2, 7);
#undef EPI_LD
#undef EPI_ST
    }
};
struct EpiQKV {
    static constexpr bool PERM = true, AFTER_DRAIN = false;
    bf16_t* Q; const float* rs; float qscale;
    __device__ __forceinline__ void operator()(const f32x4 (&acc)[2][2][4][2], const Unit& u, int wr, int wc, int fr, int fq) const {
        const rsrc_t rq = mkrsrc(Q, 3u * 16384u * 4096u * 2u), rr = mkrsrc(rs, 16384u * 4u);
        const int colt = u.pn * BM, which = colt >> 12, cw = colt & 4095, gt = cw >> 7;
        const int b = (u.pm * BM) >> 11, st = (u.pm * BM) & 2047;
        const float sc = which == 0 ? qscale : 1.f;
        const int so = (int)(((unsigned)which << 26) + (((unsigned)(b * 32 + gt) * 2048u + (unsigned)st) << 7)) * 2;
        const int vo = (((wr * 64 + fr) << 7) + wc * 32 + 8 * fq) * 2, vr = (wr * 64 + fr) * 4, sr = u.pm * BM * 4;
#pragma unroll
        for (int ai = 0; ai < 2; ++ai)
#pragma unroll
            for (int m = 0; m < 4; ++m) { const float f = sc * __builtin_bit_cast(float, __builtin_amdgcn_raw_buffer_load_b32(rr, vr, sr + (ai * HALF + m * 16) * 4, 0));
#pragma unroll
                for (int bj = 0; bj < 2; ++bj) {
                    const f32x4 v0 = acc[ai][bj][m][0] * f, v1 = acc[ai][bj][m][1] * f;
                    u32x4 w; w.x = cvt_pk_bf16(v0[0], v0[1]); w.y = cvt_pk_bf16(v0[2], v0[3]); w.z = cvt_pk_bf16(v1[0], v1[1]); w.w = cvt_pk_bf16(v1[2], v1[3]);
                    __builtin_amdgcn_raw_buffer_store_b128(w, rq, vo, so + ((bj * 2048 + ai * HALF + m * 16) << 7) * 2, 0); } }
    }
};

struct EpiQKV4 {
    static constexpr bool PERM = false, AFTER_DRAIN = false;
    bf16_t* Q; const float* rs; float qscale, wscale;
    __device__ __forceinline__ void operator()(const f32x4 (&acc)[2][2][4][2], const Unit& u, int wr, int wc, int fr, int fq) const {
        EPI_FRESH_LANE();
        const rsrc_t rq = mkrsrc(Q, 3u * 16384u * 4096u * 2u), rr = mkrsrc(rs, 16384u * 4u);
        const int colt = u.pn * BM, which = colt >> 12, cw = colt & 4095, gt = cw >> 7;
        const int b = (u.pm * BM) >> 11, st = (u.pm * BM) & 2047;
        const float sc = (which == 0 ? qscale : 1.f) * wscale;
        const int so = (int)(((unsigned)which << 26) + (((unsigned)(b * 32 + gt) * 2048u + (unsigned)st) << 7)) * 2;
        const int vo8 = (((wr * 64 + fr) << 7) + wc * 32 + (fq & 1) * 16 + (fq >> 1) * 8) * 2, vr = (wr * 64 + fr) * 4, sr = u.pm * BM * 4;
        unsigned rsv[2][4];
#pragma unroll
        for (int ai = 0; ai < 2; ++ai)
#pragma unroll
            for (int m = 0; m < 4; ++m) rsv[ai][m] = __builtin_amdgcn_raw_buffer_load_b32(rr, vr, sr + (ai * HALF + m * 16) * 4, 0);
#pragma unroll
        for (int ai = 0; ai < 2; ++ai)
#pragma unroll
            for (int m = 0; m < 4; ++m) { const float f = sc * __builtin_bit_cast(float, rsv[ai][m]);
#pragma unroll
                for (int bj = 0; bj < 2; ++bj) {
                    const f32x4 v0 = acc[ai][bj][m][0] * f, v1 = acc[ai][bj][m][1] * f;
                    const u32x4 w16 = widen_pair(cvt_pk_bf16(v0[0], v0[1]), cvt_pk_bf16(v0[2], v0[3]), cvt_pk_bf16(v1[0], v1[1]), cvt_pk_bf16(v1[2], v1[3]), 16 * fq + fr, fq);
                    __builtin_amdgcn_raw_buffer_store_b128(w16, rq, vo8, so + (((bj * 2048 + ai * HALF + m * 16) << 7)) * 2, 0); } }
    }
};

typedef int i32x8 __attribute__((ext_vector_type(8)));
template <bool F8> struct FragT { typedef bf16x8 type; };
template <> struct FragT<true> { typedef i32x8 type; };
__device__ __forceinline__ f32x4 mma_bf16(bf16x8 a, bf16x8 b, f32x4 c) { return __builtin_amdgcn_mfma_f32_16x16x32_bf16(a, b, c, 0, 0, 0); }
__device__ __forceinline__ f32x4 mma_bf16(i32x8, i32x8, f32x4 c) { return c; }
template <class Epi, class Sched, bool ALIGN_EPI = false, bool SP2 = false, bool F8 = false>
__device__ __forceinline__ void gemm_phase(PG8_LAS unsigned char* lds, const Gemm g, const Sched& S, const Epi& E, int tid_in) {
    int tid_ = tid_in;
    const int tid = tid_, wid = __builtin_amdgcn_readfirstlane(tid >> 6), lane = tid & 63, wr = wid >> 2, wc = wid & 3, fr = lane & 15, fq = lane >> 4;
    constexpr int EB = F8 ? 1 : 2;
    constexpr int K = 4096; constexpr int nt = (K * EB) / (BK * 2);
    unsigned voffA[2], voffB[2];
#pragma unroll
    for (int i = 0; i < 2; ++i) { int R, C; stage_rc(tid * 16 + i * 8192, R, C); const int Rb = Epi::PERM ? ((R & ~31) + perm32(R & 31)) : R;
        voffA[i] = (unsigned)(R * K * EB + C * 2); voffB[i] = (unsigned)(Rb * K * EB + C * 2); }
    const size_t kstep = (size_t)(BK * 2);
    const size_t hstep = (size_t)HALF * K * EB;
    const size_t tstep = 2 * hstep;
    const unsigned ldsw = (unsigned)wid * 1024u;
    const int aoff = F8 ? lds_byte(wr * 64 + fr, fq * 16) + (fq & 1) * 16 : lds_byte(wr * 64 + fr, fq * 8), boff = F8 ? lds_byte(wc * 32 + fr, fq * 16) + (fq & 1) * 16 : lds_byte(wc * 32 + fr, fq * 8);
    const int aoff1 = aoff + (F8 ? 16 - 32 * (fq & 1) : 0);
    const int f8o0_unused = 0; (void)f8o0_unused;
#define PG8_SA(b, h) (((b) * 2 + (h)) * HTB)
#define PG8_SB(b, h) ((4 + (b) * 2 + (h)) * HTB)
#define PG8_STAGE_X(bufoff, gbase, voff, rs_, base_) do { const int so_ = (int)((const char*)(gbase) - (const char*)(base_)); _Pragma("unroll") for (int _i = 0; _i < 2; ++_i) \
        __builtin_amdgcn_raw_ptr_buffer_load_lds(rs_, (PG8_LAS void*)(lds + (bufoff) + ldsw + _i * 8192), 16, (int)(voff)[_i], so_, 0, 0); } while (0)
#define PG8_LDA(dst, b, h) do { if constexpr (F8) { _Pragma("unroll") for (int m = 0; m < 4; ++m) { const u32x4 lo_ = *(const PG8_LAS u32x4*)(lds + PG8_SA(b, h) + aoff + m * 2048), hi_ = *(const PG8_LAS u32x4*)(lds + PG8_SA(b, h) + aoff1 + m * 2048); \
            dst[m][0] = (i32x8){(int)lo_[0], (int)lo_[1], (int)lo_[2], (int)lo_[3], (int)hi_[0], (int)hi_[1], (int)hi_[2], (int)hi_[3]}; } } \
        else { _Pragma("unroll") for (int m = 0; m < 4; ++m) _Pragma("unroll") for (int k = 0; k < 2; ++k) dst[m][k] = *(const PG8_LAS frag_t*)(lds + PG8_SA(b, h) + aoff + m * 2048 + k * 1024); } } while (0)
#define PG8_LDB(dst, b, h) do { if constexpr (F8) { _Pragma("unroll") for (int n = 0; n < 2; ++n) { const u32x4 lo_ = *(const PG8_LAS u32x4*)(lds + PG8_SB(b, h) + boff + n * 2048), hi_ = *(const PG8_LAS u32x4*)(lds + PG8_SB(b, h) + boff + (aoff1 - aoff) + n * 2048); \
            dst[n][0] = (i32x8){(int)lo_[0], (int)lo_[1], (int)lo_[2], (int)lo_[3], (int)hi_[0], (int)hi_[1], (int)hi_[2], (int)hi_[3]}; } } \
        else { _Pragma("unroll") for (int n = 0; n < 2; ++n) _Pragma("unroll") for (int k = 0; k < 2; ++k) dst[n][k] = *(const PG8_LAS frag_t*)(lds + PG8_SB(b, h) + boff + n * 2048 + k * 1024); } } while (0)
#define PG8_MMA(ai, bj, At, Bt) do { __builtin_amdgcn_s_setprio(1); _Pragma("unroll") for (int m = 0; m < 4; ++m) _Pragma("unroll") for (int n = 0; n < 2; ++n) { \
        if constexpr (F8) acc[ai][bj][m][n] = __builtin_amdgcn_mfma_scale_f32_16x16x128_f8f6f4(Bt[n][0], At[m][0], acc[ai][bj][m][n], 0, 0, 0, 0x7f7f7f7f, 0, 0x7f7f7f7f); \
        else { _Pragma("unroll") for (int k = 0; k < 2; ++k) acc[ai][bj][m][n] = mma_bf16(Bt[n][k], At[m][k], acc[ai][bj][m][n]); } } __builtin_amdgcn_s_setprio(0); } while (0)
#define PG8_WAIT_V(n) asm volatile("s_waitcnt vmcnt(" #n ")" ::: "memory")
#define PG8_WAIT_L(n) asm volatile("s_waitcnt lgkmcnt(" #n ")" ::: "memory")
#define PG8_BAR __builtin_amdgcn_s_barrier()
#define PG8_SCHED __builtin_amdgcn_sched_barrier(0)
    const __amdgpu_buffer_rsrc_t rsA = __builtin_amdgcn_make_buffer_rsrc((void*)g.A, (short)0, (int)((size_t)g.M * K * EB), 0x00020000), rsB = __builtin_amdgcn_make_buffer_rsrc((void*)g.Bt, (short)0, (int)((size_t)g.N * K * EB), 0x00020000);
    Unit cur, nxt; int ui = 0;
    if (!S.next(0, cur)) return;
    f32x4 acc[2][2][4][2];
#pragma unroll
    for (int a = 0; a < 2; ++a)
#pragma unroll
        for (int b = 0; b < 2; ++b)
#pragma unroll
            for (int m = 0; m < 4; ++m)
#pragma unroll
                for (int n = 0; n < 2; ++n) acc[a][b][m][n] = (f32x4){0.f, 0.f, 0.f, 0.f};
    typedef typename FragT<F8>::type frag_t;
    frag_t At[4][F8 ? 1 : 2], B0[2][F8 ? 1 : 2], B1[2][F8 ? 1 : 2];
    const char* cA = (const char*)g.A + (size_t)cur.pm * tstep; const char* cB = (const char*)g.Bt + (size_t)cur.pn * tstep;
    S.a_ready(cur);
    if constexpr (SP2) {
        PG8_STAGE_X(PG8_SB(0, 0), cB, voffB, rsB, g.Bt); PG8_STAGE_X(PG8_SB(0, 1), cB + hstep, voffB, rsB, g.Bt); PG8_STAGE_X(PG8_SA(0, 0), cA, voffA, rsA, g.A); PG8_STAGE_X(PG8_SA(0, 1), cA + hstep, voffA, rsA, g.A);
        if (wr == 1) PG8_BAR;
        PG8_WAIT_V(2); PG8_BAR;
        PG8_STAGE_X(PG8_SB(1, 0), cB + kstep, voffB, rsB, g.Bt); PG8_STAGE_X(PG8_SA(1, 0), cA + kstep, voffA, rsA, g.A); PG8_STAGE_X(PG8_SB(1, 1), cB + hstep + kstep, voffB, rsB, g.Bt);
        PG8_WAIT_V(6); PG8_BAR;
    } else {
        PG8_STAGE_X(PG8_SB(0, 0), cB, voffB, rsB, g.Bt); PG8_STAGE_X(PG8_SA(0, 0), cA, voffA, rsA, g.A); PG8_STAGE_X(PG8_SB(0, 1), cB + hstep, voffB, rsB, g.Bt); PG8_STAGE_X(PG8_SA(0, 1), cA + hstep, voffA, rsA, g.A);
        if (wr == 1) PG8_BAR;
        PG8_WAIT_V(4); PG8_BAR;
        PG8_STAGE_X(PG8_SB(1, 0), cB + kstep, voffB, rsB, g.Bt); PG8_STAGE_X(PG8_SA(1, 0), cA + kstep, voffA, rsA, g.A); PG8_STAGE_X(PG8_SB(1, 1), cB + hstep + kstep, voffB, rsB, g.Bt);
        PG8_WAIT_V(6); PG8_BAR;
    }
    for (;;) {
        const bool has_next = S.next(ui + 1, nxt);
        const char* nA = has_next ? (const char*)g.A + (size_t)nxt.pm * tstep : cA; const char* nB = has_next ? (const char*)g.Bt + (size_t)nxt.pn * tstep : cB;
        for (int t = 0; t < nt; t += 2) {
            const bool last = (t == nt - 2);
            const char* a1 = cA + (size_t)(t + 1) * kstep;
            const char* a2 = last ? nA : cA + (size_t)(t + 2) * kstep; const char* b2 = last ? nB : cB + (size_t)(t + 2) * kstep;
            const char* a3 = a2 + kstep; const char* b3 = b2 + kstep;
            if (last && has_next) S.a_ready(nxt);
            if constexpr (SP2) {
            PG8_LDB(B0, 0, 0); PG8_LDB(B1, 0, 1); PG8_SCHED; PG8_LDA(At, 0, 0); PG8_STAGE_X(PG8_SA(1, 1), a1 + hstep, voffA, rsA, g.A);
            PG8_WAIT_V(8); PG8_WAIT_L(0); PG8_BAR; PG8_MMA(0, 0, At, B0); PG8_MMA(0, 1, At, B1); PG8_BAR; PG8_SCHED;
            PG8_LDA(At, 0, 1); PG8_STAGE_X(PG8_SB(0, 0), b2, voffB, rsB, g.Bt); PG8_STAGE_X(PG8_SB(0, 1), b2 + hstep, voffB, rsB, g.Bt); PG8_STAGE_X(PG8_SA(0, 0), a2, voffA, rsA, g.A);
            PG8_WAIT_V(8); PG8_WAIT_L(0); PG8_BAR; PG8_MMA(1, 0, At, B0); PG8_MMA(1, 1, At, B1); PG8_BAR; PG8_SCHED;
            PG8_LDB(B0, 1, 0); PG8_LDB(B1, 1, 1); PG8_SCHED; PG8_LDA(At, 1, 0); PG8_STAGE_X(PG8_SA(0, 1), a2 + hstep, voffA, rsA, g.A);
            PG8_WAIT_V(8); PG8_WAIT_L(0); PG8_BAR; PG8_MMA(0, 0, At, B0); PG8_MMA(0, 1, At, B1); PG8_BAR; PG8_SCHED;
            PG8_LDA(At, 1, 1); PG8_STAGE_X(PG8_SB(1, 0), b3, voffB, rsB, g.Bt); PG8_STAGE_X(PG8_SB(1, 1), b3 + hstep, voffB, rsB, g.Bt); PG8_STAGE_X(PG8_SA(1, 0), a3, voffA, rsA, g.A);
            PG8_WAIT_V(8); PG8_WAIT_L(0); PG8_BAR; PG8_MMA(1, 0, At, B0); PG8_MMA(1, 1, At, B1); PG8_BAR; PG8_SCHED;
            } else {
            PG8_LDB(B0, 0, 0); PG8_SCHED; PG8_LDA(At, 0, 0); PG8_STAGE_X(PG8_SA(1, 1), a1 + hstep, voffA, rsA, g.A);
            PG8_WAIT_L(8); PG8_BAR; PG8_WAIT_L(0); PG8_MMA(0, 0, At, B0); PG8_BAR; PG8_SCHED;
            PG8_LDB(B1, 0, 1); PG8_STAGE_X(PG8_SB(0, 0), b2, voffB, rsB, g.Bt);
            PG8_BAR; PG8_WAIT_L(0); PG8_MMA(0, 1, At, B1); PG8_BAR;
            PG8_LDA(At, 0, 1); PG8_STAGE_X(PG8_SA(0, 0), a2, voffA, rsA, g.A);
            PG8_BAR; PG8_WAIT_L(0); PG8_MMA(1, 0, At, B0); PG8_BAR; PG8_SCHED;
            PG8_STAGE_X(PG8_SB(0, 1), b2 + hstep, voffB, rsB, g.Bt);
            PG8_WAIT_V(6); PG8_BAR; PG8_MMA(1, 1, At, B1); PG8_BAR;
            PG8_LDB(B0, 1, 0); PG8_SCHED; PG8_LDA(At, 1, 0); PG8_STAGE_X(PG8_SA(0, 1), a2 + hstep, voffA, rsA, g.A);
            PG8_WAIT_L(8); PG8_BAR; PG8_WAIT_L(0); PG8_MMA(0, 0, At, B0); PG8_BAR; PG8_SCHED;
            PG8_LDB(B1, 1, 1); PG8_STAGE_X(PG8_SB(1, 0), b3, voffB, rsB, g.Bt);
            PG8_BAR; PG8_WAIT_L(0); PG8_MMA(0, 1, At, B1); PG8_BAR;
            PG8_LDA(At, 1, 1); PG8_STAGE_X(PG8_SA(1, 0), a3, voffA, rsA, g.A);
            PG8_BAR; PG8_WAIT_L(0); PG8_MMA(1, 0, At, B0); PG8_BAR; PG8_SCHED;
            PG8_STAGE_X(PG8_SB(1, 1), b3 + hstep, voffB, rsB, g.Bt);
            PG8_WAIT_V(6); PG8_BAR; PG8_MMA(1, 1, At, B1); PG8_BAR;
            }
        }
        if constexpr (ALIGN_EPI) { if (wr == 0) PG8_BAR; }
        if constexpr (!Epi::AFTER_DRAIN) { E(acc, cur, wr, wc, fr, fq); S.done(cur); }
        if (!has_next) break;
#pragma unroll
        for (int a = 0; a < 2; ++a)
#pragma unroll
            for (int b = 0; b < 2; ++b)
#pragma unroll
                for (int m = 0; m < 4; ++m)
#pragma unroll
                    for (int n = 0; n < 2; ++n) acc[a][b][m][n] = (f32x4){0.f, 0.f, 0.f, 0.f};
        cur = nxt; cA = nA; cB = nB; ++ui;
        if constexpr (ALIGN_EPI) { if (wr == 1) PG8_BAR; }
    }
    PG8_WAIT_V(0);
    if constexpr (!ALIGN_EPI) { if (wr == 0) PG8_BAR; }
    PG8_BAR;
    if constexpr (Epi::AFTER_DRAIN) { E.fused(acc, cur, wr, wc, fr, fq, lds, wid, lane); S.done(cur); }
#undef PG8_SA
#undef PG8_SB
#undef PG8_STAGE_X
#undef PG8_LDA
#undef PG8_LDB
#undef PG8_MMA
#undef PG8_WAIT_V
#undef PG8_WAIT_L
#undef PG8_BAR
#undef PG8_SCHED
}
}
#define GAS __attribute__((address_space(1)))
#define LAS __attribute__((address_space(3)))
typedef unsigned short bf16_t;
typedef unsigned u32x4 __attribute__((ext_vector_type(4)));
typedef unsigned u32x2 __attribute__((ext_vector_type(2)));
typedef float f32x4 __attribute__((ext_vector_type(4)));
typedef float f32x2 __attribute__((ext_vector_type(2)));
typedef float f32x16 __attribute__((ext_vector_type(16)));
typedef short bf16x8 __attribute__((ext_vector_type(8)));
typedef short s16x4 __attribute__((ext_vector_type(4)));
typedef __bf16 bf16x2_t __attribute__((ext_vector_type(2)));
typedef unsigned u32x6 __attribute__((ext_vector_type(6)));
typedef int i32x8 __attribute__((ext_vector_type(8)));
typedef unsigned u32x16 __attribute__((ext_vector_type(16)));
typedef float f32x32 __attribute__((ext_vector_type(32)));
typedef _Float16 f16x32 __attribute__((ext_vector_type(32)));
typedef _Float16 f16x2 __attribute__((ext_vector_type(2)));

namespace mk {
constexpr int M = 16384, D = 4096, S = 2048, NB = 8, PW = 12298, NH = 32, NE = 16384;
constexpr int NWAVES = 8;
constexpr size_t MiB = 1u << 20;
constexpr size_t WS_CTL = 0, CTL_ZERO_BYTES = 1 * MiB;
constexpr size_t WS_RSTD = 2 * MiB, WS_LOGF = 3 * MiB, WS_WQK = 4 * MiB, WS_WOUT = 20 * MiB, WS_WIN = 52 * MiB, WS_U16 = 148 * MiB, WS_V16 = 276 * MiB,
                 WS_XB = 404 * MiB, WS_Q = 532 * MiB, WS_K = 660 * MiB, WS_V = 788 * MiB, WS_OB = 916 * MiB, WS_X2 = 1792 * MiB, WS_END = 2048 * MiB;
constexpr size_t WS_L1 = 1920 * MiB;
__host__ __device__ constexpr size_t ws_wqk(int l) { return l ? WS_L1 : WS_WQK; }
__host__ __device__ constexpr size_t ws_wout(int l) { return l ? WS_L1 + 16 * MiB : WS_WOUT; }
__host__ __device__ constexpr size_t ws_win(int l) { return l ? WS_L1 + 32 * MiB : WS_WIN; }
__host__ __device__ constexpr size_t ws_tab(int l) { return l ? WS_V16 : WS_U16; }
constexpr size_t WS_XB8N = WS_OB + 64 * MiB;
constexpr size_t WS_SC = WS_Q;
constexpr int CW_BAR = 4096;
constexpr int CW_QUEUE = 16384;
constexpr int RING_BYTES = 131072, LDSCTL_OFF = RING_BYTES, MISC_OFF = LDSCTL_OFF + 320, LDS_BYTES = 147456;

struct Args { const float* in[13]; float* out; unsigned char* ws; int ph_lo, ph_hi; };

__device__ __forceinline__ unsigned f2bf(float f) { unsigned u = __builtin_bit_cast(unsigned, f); return (u + 0x7fffu + ((u >> 16) & 1u)) >> 16; }
__device__ __forceinline__ unsigned pk2(float lo, float hi) { return f2bf(lo) | (f2bf(hi) << 16); }
__device__ __forceinline__ float bf_lo(unsigned w) { return __builtin_bit_cast(float, w << 16); }
__device__ __forceinline__ float bf_hi(unsigned w) { return __builtin_bit_cast(float, w & 0xffff0000u); }
__device__ __forceinline__ float lane_read(float v, int src_lane) { return __builtin_bit_cast(float, __builtin_amdgcn_ds_bpermute(src_lane << 2, __builtin_bit_cast(int, v))); }
__device__ __forceinline__ int lane_read(int v, int src_lane) { return __builtin_amdgcn_ds_bpermute(src_lane << 2, v); }
constexpr float US = 1024.0f, VS = 32.0f, US_INV = 1.0f / 1024.0f, VS_INV = 1.0f / 32.0f;
constexpr int REC4 = 4096;
constexpr int ROW4 = 2048;
#define FP4X_(j) ((j) < 16 ? a0[((j) & 15) >> 2][(j) & 3] : a1[((j) & 15) >> 2][(j) & 3])
__device__ __forceinline__ u32x4 pack_fp4(const f32x4 (&a0)[4], const f32x4 (&a1)[4], float inv) {
    unsigned o[4];
#pragma unroll
    for (int w = 0; w < 4; ++w) { unsigned v = 0u;
        v = __builtin_amdgcn_cvt_scalef32_pk_fp4_f32(v, FP4X_(8 * w + 0) * inv, FP4X_(8 * w + 1) * inv, 1.0f, 0); v = __builtin_amdgcn_cvt_scalef32_pk_fp4_f32(v, FP4X_(8 * w + 2) * inv, FP4X_(8 * w + 3) * inv, 1.0f, 1);
        v = __builtin_amdgcn_cvt_scalef32_pk_fp4_f32(v, FP4X_(8 * w + 4) * inv, FP4X_(8 * w + 5) * inv, 1.0f, 2); v = __builtin_amdgcn_cvt_scalef32_pk_fp4_f32(v, FP4X_(8 * w + 6) * inv, FP4X_(8 * w + 7) * inv, 1.0f, 3);
        o[w] = v; }
    return (u32x4){o[0], o[1], o[2], o[3]};
}
#undef FP4X_
__device__ __forceinline__ float clamp8(float x) { return fminf(fmaxf(x, -224.0f), 224.0f); }
__device__ __forceinline__ float logsig(float z) { return fminf(z, 0.f) - 0.6931471805599453f * __builtin_amdgcn_logf(1.0f + __builtin_amdgcn_exp2f(-fabsf(z) * 1.4426950408889634f)); }
__device__ __forceinline__ float gelu_erf(float v) {
    const float av = fabsf(v), t = __builtin_amdgcn_rcpf(av * 0.2316418882f + 1.0f);
    float q = t * 0.5307027145f + (-0.7265760135f); q = q * t + 0.7107068705f; q = q * t + (-0.142248368f); q = q * t + 0.127414796f; q = q * t;
    const float e = __builtin_amdgcn_exp2f((v * v) * (-0.72134752044f));
    const float m = v * (q * e);
    return v < 0.f ? m : v - m;
}
#define LDS_WAIT() asm volatile("s_waitcnt lgkmcnt(0)" ::: "memory")
#define FRESH_LDS(l) do { unsigned v_ = (unsigned)(size_t)(l); asm volatile("" : "+s"(v_)); (l) = (LAS unsigned char*)(size_t)v_; } while (0)
#define FRESH_BID() int bid = blockIdx.x, G = gridDim.x; asm volatile("" : "+s"(bid), "+s"(G))
#define FRESH_TID() int tid; { int w_ = wave0, l_; { unsigned z_ = 0u; asm volatile("" : "+v"(z_)); l_ = (int)__builtin_amdgcn_mbcnt_hi(~0u, __builtin_amdgcn_mbcnt_lo(~0u, z_)); } asm volatile("" : "+s"(w_)); tid = w_ * 64 + l_; } const int lane = tid & 63, wave = __builtin_amdgcn_readfirstlane(tid >> 6); (void)lane; (void)wave

__device__ __forceinline__ unsigned wave_max_u32(unsigned v) {
    v = max(v, (unsigned)__builtin_amdgcn_update_dpp(0, (int)v, 0x111, 0xF, 0xF, true));
    v = max(v, (unsigned)__builtin_amdgcn_update_dpp(0, (int)v, 0x112, 0xF, 0xF, true));
    v = max(v, (unsigned)__builtin_amdgcn_update_dpp(0, (int)v, 0x114, 0xF, 0xF, true));
    v = max(v, (unsigned)__builtin_amdgcn_update_dpp(0, (int)v, 0x118, 0xF, 0xF, true));
    v = max(v, (unsigned)__builtin_amdgcn_update_dpp((int)v, (int)v, 0x142, 0xA, 0xF, false));
    v = max(v, (unsigned)__builtin_amdgcn_update_dpp((int)v, (int)v, 0x143, 0xC, 0xF, false));
    return (unsigned)__builtin_amdgcn_readlane((int)v, 63);
}
__device__ __forceinline__ float wave_sum_dpp(float x) {
    int v = __builtin_bit_cast(int, x);
#define DPP_ADD(ctrl, rm, bc, oldv) v = __builtin_bit_cast(int, __builtin_bit_cast(float, v) + __builtin_bit_cast(float, __builtin_amdgcn_update_dpp(oldv, v, ctrl, rm, 0xF, bc)))
    DPP_ADD(0x111, 0xF, true, 0); DPP_ADD(0x112, 0xF, true, 0); DPP_ADD(0x114, 0xF, true, 0); DPP_ADD(0x118, 0xF, true, 0);
#undef DPP_ADD
    const float r0 = __builtin_bit_cast(float, __builtin_amdgcn_readlane(v, 15)), r1 = __builtin_bit_cast(float, __builtin_amdgcn_readlane(v, 31)), r2 = __builtin_bit_cast(float, __builtin_amdgcn_readlane(v, 47)), r3 = __builtin_bit_cast(float, __builtin_amdgcn_readlane(v, 63));
    return (r0 + r1) + (r2 + r3);
}
__device__ __forceinline__ float diag_sum_dpp(float x) {
    int v = __builtin_bit_cast(int, x);
#define DPP_ADD(ctrl) v = __builtin_bit_cast(int, __builtin_bit_cast(float, v) + __builtin_bit_cast(float, __builtin_amdgcn_update_dpp(0, v, ctrl, 0xF, 0xF, true)))
    DPP_ADD(0x111); DPP_ADD(0x112);
#undef DPP_ADD
    const float r0 = __builtin_bit_cast(float, __builtin_amdgcn_readlane(v, 3)), r1 = __builtin_bit_cast(float, __builtin_amdgcn_readlane(v, 23)), r2 = __builtin_bit_cast(float, __builtin_amdgcn_readlane(v, 43)), r3 = __builtin_bit_cast(float, __builtin_amdgcn_readlane(v, 63));
    return (r0 + r1) + (r2 + r3);
}
__device__ __forceinline__ unsigned ordkey(float x) { const unsigned u = __builtin_bit_cast(unsigned, x); return (u & 0x80000000u) ? ~u : (u | 0x80000000u); }
__device__ __forceinline__ void transpose_item(const float* W, int K, int ldw, int ncols, const float* gain, bf16_t* WT, LAS float* scr, int item, int lane) {
    const int nblk = ncols / 32, kb = item / nblk, nb = item % nblk, k0 = 64 * kb, n0 = 32 * nb;
#pragma unroll 8
    for (int i = 0; i < 32; ++i) { const int kk = 2 * i + (lane >> 5); float v = W[(size_t)(k0 + kk) * ldw + n0 + (lane & 31)]; if (gain) v *= gain[k0 + kk]; scr[kk * 33 + (lane & 31)] = v; }
    LDS_WAIT(); asm volatile("" ::: "memory");
    const int c = lane & 7;
#pragma unroll
    for (int j = 0; j < 4; ++j) { const int n = (lane >> 3) + 8 * j; const LAS float* s = scr + (8 * c) * 33 + n;
        u32x4 o; o.x = pk2(s[0 * 33], s[1 * 33]); o.y = pk2(s[2 * 33], s[3 * 33]); o.z = pk2(s[4 * 33], s[5 * 33]); o.w = pk2(s[6 * 33], s[7 * 33]);
        *(u32x4*)(WT + (size_t)(n0 + n) * K + k0 + 8 * c) = o; }
    LDS_WAIT(); asm volatile("" ::: "memory");
}

typedef const __attribute__((address_space(4))) Args* KArgsT;
__device__ __forceinline__ unsigned pk4_fp8(float a, float b, float c, float d) { int p = __builtin_amdgcn_cvt_pk_fp8_f32(clamp8(a), clamp8(b), 0, false); p = __builtin_amdgcn_cvt_pk_fp8_f32(clamp8(c), clamp8(d), p, true); return (unsigned)p; }
__device__ __forceinline__ void transpose_item8(const float* W, int K, int ldw, int ncols, const float* gain, float scale, unsigned char* WT, LAS float* scr, int item, int lane) {
    const int nblk = ncols / 32, kb = item / nblk, nb = item % nblk, k0 = 64 * kb, n0 = 32 * nb;
    const int kr = lane >> 3, nq = (lane & 7) * 4;
    f32x4 v[8];
#pragma unroll
    for (int i = 0; i < 8; ++i) { const float* p = W + (size_t)(k0 + 8 * i + kr) * ldw + n0 + nq; v[i] = (f32x4){p[0], p[1], p[2], p[3]}; }
#pragma unroll
    for (int i = 0; i < 8; ++i) { const int kk = 8 * i + kr; const float g = (gain ? gain[k0 + kk] : 1.0f) * scale; LAS float* d = scr + kk * 33 + nq; d[0] = v[i][0] * g; d[1] = v[i][1] * g; d[2] = v[i][2] * g; d[3] = v[i][3] * g; }
    LDS_WAIT(); asm volatile("" ::: "memory");
    const int c = lane & 7;
#pragma unroll
    for (int j = 0; j < 4; ++j) { const int n = (lane >> 3) + 8 * j; const LAS float* s = scr + (8 * c) * 33 + n;
        u32x2 o; o.x = pk4_fp8(s[0 * 33], s[1 * 33], s[2 * 33], s[3 * 33]); o.y = pk4_fp8(s[4 * 33], s[5 * 33], s[6 * 33], s[7 * 33]);
        *(u32x2*)(WT + (size_t)(n0 + n) * K + k0 + 8 * c) = o; }
    LDS_WAIT(); asm volatile("" ::: "memory");
}
__device__ __forceinline__ void conv_phase(KArgsT ka, int l, LAS unsigned char* lds, int wave0) {
    FRESH_TID(); FRESH_LDS(lds); FRESH_BID();
    unsigned char* ws = ka->ws;
    const float* ln1 = ka->in[1] + (size_t)l * D; const float* w_in = ka->in[2] + (size_t)l * D * PW; const float* w_out = ka->in[5] + (size_t)l * D * D;
    const float* ln2 = ka->in[6] + (size_t)l * D; const float* wq = ka->in[7] + (size_t)l * D * 2048;
    const float* k1 = ka->in[8] + (size_t)l * 8 * 128 * 128; const float* k2 = ka->in[9] + (size_t)l * 8 * 128 * 128;
    const float* pu = ka->in[10] + (size_t)l * NE * D; const float* pv = ka->in[11] + (size_t)l * NE * D;
    bf16_t* WQK = (bf16_t*)(ws + ws_wqk(l)); bf16_t* WOUT = (bf16_t*)(ws + ws_wout(l)); bf16_t* WIN = (bf16_t*)(ws + ws_win(l)); bf16_t* U16 = (bf16_t*)(ws + ws_tab(l));
    {
        LAS float* Ks = (LAS float*)lds;
        LAS float* Ws = (LAS float*)(lds + 128 * 132 * 4);
        const int IPB = (1024 + G - 1) / G, it0 = bid * IPB, it1 = min(1024, it0 + IPB);
        int gi_cur = -1; f32x4 pre[4];
        if (it0 < it1) {
#pragma unroll
            for (int m = 0; m < 4; ++m) { const int i = tid + 512 * m, r = i >> 5, c4 = (i & 31) * 4; pre[m] = *(const f32x4*)(wq + (size_t)((it0 & 63) * 64 + r) * 2048 + (it0 >> 6) * 128 + c4); } }
        for (int it = it0; it < it1; ++it) {
            const int gi = it >> 6, c0 = (it & 63) * 64;
            __syncthreads();
            if (gi != gi_cur) { gi_cur = gi;
                const float* key = ((gi & 1) ? k2 : k1) + (size_t)(gi >> 1) * 128 * 128;
                for (int i = tid; i < 4096; i += 512) { const int r = i >> 5, c4 = (i & 31) * 4; *(LAS f32x4*)(Ks + r * 132 + c4) = *(const f32x4*)(key + r * 128 + c4); } }
#pragma unroll
            for (int m = 0; m < 4; ++m) { const int i = tid + 512 * m, r = i >> 5, c4 = (i & 31) * 4; *(LAS f32x4*)(Ws + r * 132 + c4) = pre[m]; }
            __syncthreads();
            if (it + 1 < it1) {
#pragma unroll
                for (int m = 0; m < 4; ++m) { const int i = tid + 512 * m, r = i >> 5, c4 = (i & 31) * 4; pre[m] = *(const f32x4*)(wq + (size_t)(((it + 1) & 63) * 64 + r) * 2048 + ((it + 1) >> 6) * 128 + c4); } }
            const int ti = wave & 3, tj = wave >> 2, li = lane & 31, kh = lane >> 5;
            const LAS float* ap = Ks + (32 * ti + li) * 132 + 64 * kh; const LAS float* bp = Ws + (32 * tj + li) * 132 + 64 * kh;
            f32x16 acc;
#pragma unroll
            for (int r = 0; r < 16; ++r) acc[r] = 0.f;
#pragma unroll 4
            for (int s4 = 0; s4 < 16; ++s4) { const f32x4 a4 = *(const LAS f32x4*)(ap + 4 * s4), b4 = *(const LAS f32x4*)(bp + 4 * s4);
                acc = __builtin_amdgcn_mfma_f32_32x32x2f32(a4[0], b4[0], acc, 0, 0, 0); acc = __builtin_amdgcn_mfma_f32_32x32x2f32(a4[1], b4[1], acc, 0, 0, 0);
                acc = __builtin_amdgcn_mfma_f32_32x32x2f32(a4[2], b4[2], acc, 0, 0, 0); acc = __builtin_amdgcn_mfma_f32_32x32x2f32(a4[3], b4[3], acc, 0, 0, 0); }
            { const int c = c0 + 32 * tj + li; const float gg = ln2[c];
#pragma unroll
              for (int r = 0; r < 16; ++r) { const int n = 32 * ti + (r & 3) + 8 * (r >> 2) + 4 * kh; WQK[(size_t)(gi * 128 + n) * D + c] = (bf16_t)f2bf(acc[r] * gg); } }
        }
        __syncthreads();
    }
    const int gw = bid * NWAVES + wave, NGW = G * NWAVES;
    {
        unsigned char* U6 = (unsigned char*)U16; unsigned char* V4 = U6 + ROW4; float* SCU = (float*)(U6 + (size_t)NE * REC4); float* SCV = SCU + NE;
        f32x4 gq[4][4];
#pragma unroll
        for (int i = 0; i < 4; ++i)
#pragma unroll
            for (int m = 0; m < 4; ++m) gq[i][m] = *(const f32x4*)(ln2 + 1024 * i + 256 * m + 4 * lane);
        f32x4 uu[4][4], vv[4][4];
        const unsigned hm_ = (lane & 1) ? 65536u : 1u;
#define LDROW_(dst, src, rr) do { const float* p_ = (src) + (size_t)(rr) * D + 4 * lane; _Pragma("unroll") for (int i = 0; i < 4; ++i) _Pragma("unroll") for (int m = 0; m < 4; ++m) dst[i][m] = *(const f32x4*)(p_ + 1024 * i + 256 * m); } while (0)
#define H16_(v, inv) ((__builtin_amdgcn_cvt_scalef32_pk_fp4_f32(__builtin_amdgcn_cvt_scalef32_pk_fp4_f32(0u, (v)[0] * (inv), (v)[1] * (inv), 1.0f, 0), (v)[2] * (inv), (v)[3] * (inv), 1.0f, 1) & 0xffffu) * hm_)
#define QSWAP1_(x) ((unsigned)__builtin_amdgcn_update_dpp(0, (int)(x), 0xB1, 0xF, 0xF, false))
#define QSWAP2_(x) ((unsigned)__builtin_amdgcn_update_dpp(0, (int)(x), 0x4E, 0xF, 0xF, false))
#define PUTROW_(src, tab, rr, inv) do { _Pragma("unroll") for (int j = 0; j < 2; ++j) _Pragma("unroll") for (int m = 0; m < 4; ++m) { \
            unsigned da_ = H16_(src[2 * j][m], inv), db_ = H16_(src[2 * j + 1][m], inv); da_ |= QSWAP1_(da_); db_ |= QSWAP1_(db_); \
            const unsigned oa_ = QSWAP2_(da_), ob_ = QSWAP2_(db_); \
            if ((lane & 3) == 0) *(u32x4*)((tab) + (size_t)(rr) * REC4 + j * 1024 + 16 * (16 * m + (lane >> 2))) = (u32x4){da_, oa_, db_, ob_}; } } while (0)
        if (gw < NE) { LDROW_(uu, pu, gw); LDROW_(vv, pv, gw); }
        for (int r = gw; r < NE; r += NGW) {
            const int rn = r + NGW;
            { float au = 0.f;
#pragma unroll
              for (int i = 0; i < 4; ++i)
#pragma unroll
                  for (int m = 0; m < 4; ++m) { uu[i][m] *= gq[i][m]; au += (uu[i][m][0] * uu[i][m][0] + uu[i][m][1] * uu[i][m][1]) + (uu[i][m][2] * uu[i][m][2] + uu[i][m][3] * uu[i][m][3]); }
              au = sqrtf(wave_sum_dpp(au) * (1.0f / D)); const float iu = au > 0.f ? 2.0f / au : 0.f;
              if (lane == 0) SCU[r] = au * 0.5f;
              PUTROW_(uu, U6, r, iu); }
            if (rn < NE) LDROW_(uu, pu, rn);
            { float av = 0.f;
#pragma unroll
              for (int i = 0; i < 4; ++i)
#pragma unroll
                  for (int m = 0; m < 4; ++m) av += (vv[i][m][0] * vv[i][m][0] + vv[i][m][1] * vv[i][m][1]) + (vv[i][m][2] * vv[i][m][2] + vv[i][m][3] * vv[i][m][3]);
              av = sqrtf(wave_sum_dpp(av) * (1.0f / D)); const float iv = av > 0.f ? 2.0f / av : 0.f;
              if (lane == 0) SCV[r] = av * 0.5f;
              PUTROW_(vv, V4, r, iv); }
            if (rn < NE) LDROW_(vv, pv, rn);
        }
#undef LDROW_
#undef H16_
#undef QSWAP1_
#undef QSWAP2_
#undef PUTROW_
    }
    {
        LAS float* scr = (LAS float*)(lds + wave * 16384);
        constexpr int I_O = (D / 64) * (D / 32), I_IN = (D / 64) * (12288 / 32);
        for (int it = gw; it < I_O + I_IN; it += NGW) {
            if (it < I_O) transpose_item8(w_out, D, D, D, nullptr, US, (unsigned char*)WOUT, scr, it, lane);
            else transpose_item8(w_in, D, PW, 12288, ln1, US, (unsigned char*)WIN, scr, it - I_O, lane);
        }
    }
}

template <bool WITH_F>
__device__ __forceinline__ void prep_phase(const float* X, bf16_t* XB, float* RSTD, const float* w_in, const float* ln1, const float* bf, float* LOGF, LAS unsigned char* lds, int wave0) {
    FRESH_TID(); FRESH_LDS(lds); FRESH_BID();
    LAS unsigned short* gfs = (LAS unsigned short*)lds;
    if (WITH_F) {
        __syncthreads();
        for (int c = tid; c < D; c += 512) { const float g = ln1[c]; const float* wr = w_in + (size_t)c * PW + 12288;
#pragma unroll
            for (int j = 0; j < 10; ++j) gfs[j * D + c] = (unsigned short)f2bf(wr[j] * g); }
        __syncthreads();
    }
    const int gw = bid * NWAVES + wave, NGW = G * NWAVES;
    for (int m = gw; m < M; m += NGW) {
        const f32x4* xr = (const f32x4*)(X + (size_t)m * D) + lane;
        f32x4 v[16]; float ss = 0.f;
#pragma unroll
        for (int i = 0; i < 16; ++i) { v[i] = xr[64 * i]; ss += (v[i][0] * v[i][0] + v[i][1] * v[i][1]) + (v[i][2] * v[i][2] + v[i][3] * v[i][3]); }
        ss = wave_sum_dpp(ss);
        const float rstd = rsqrtf(ss * (1.0f / D) + 1e-6f);
        if (WITH_F) {
            unsigned* o8 = (unsigned*)((unsigned char*)XB + (size_t)m * D) + lane;
#pragma unroll
            for (int i = 0; i < 16; ++i) o8[64 * i] = pk4_fp8(v[i][0], v[i][1], v[i][2], v[i][3]);
        } else {
        u32x2* o = (u32x2*)(XB + (size_t)m * D) + lane;
#pragma unroll
        for (int i = 0; i < 16; ++i) { u32x2 w; w.x = pk2(v[i][0], v[i][1]); w.y = pk2(v[i][2], v[i][3]); o[64 * i] = w; }
        }
        if (lane == 0) RSTD[m] = rstd;
        if (WITH_F) {
            float mine = 0.f;
#pragma unroll 1
            for (int j = 0; j < 10; ++j) { float s = 0.f;
#pragma unroll
                for (int i = 0; i < 16; ++i) { const u32x2 gp = *(const LAS u32x2*)(gfs + j * D + 256 * i + 4 * lane);
                    s += (v[i][0] * bf_lo(gp.x) + v[i][1] * bf_hi(gp.x)) + (v[i][2] * bf_lo(gp.y) + v[i][3] * bf_hi(gp.y)); }
                s = wave_sum_dpp(s); if (lane == j) mine = s; }
            if (lane < 10) { const int b = m >> 11, s = m & 2047; LOGF[(size_t)(b * 10 + lane) * S + s] = logsig(mine * rstd + bf[lane]); }
        }
    }
}


__device__ __forceinline__ void load16_bf16(const bf16_t* p, float (&d)[16]) {
    const u32x4 a = *(const u32x4*)p, b = *(const u32x4*)(p + 8);
#pragma unroll
    for (int q = 0; q < 4; ++q) { d[2 * q] = bf_lo(a[q]); d[2 * q + 1] = bf_hi(a[q]); d[8 + 2 * q] = bf_lo(b[q]); d[8 + 2 * q + 1] = bf_hi(b[q]); }
}
#define RFL(x) __builtin_amdgcn_readfirstlane(x)
template <bool FINAL>
__device__ __forceinline__ void peer_uv_phase(const float* SC, const unsigned char* T4, const bf16_t* X1, void* XOv, const float* fg,
                                              unsigned char* XB8n, float* RSTDn, float* LOGFn, const float* w_in_n, const float* ln1_n, const float* bf_n, LAS unsigned char* lds, int wave0) {
    FRESH_TID(); FRESH_LDS(lds); FRESH_BID();
    LAS int* s_eid = (LAS int*)(lds + 81920 + wave * 1024); LAS f32x2* s_ws = (LAS f32x2*)(lds + 90112 + wave * 1024);
    const float* SCU = (const float*)(T4 + (size_t)NE * REC4); const float* SCV = SCU + NE;
    LAS unsigned short* gfs = (LAS unsigned short*)lds;
    if (!FINAL) {
        __syncthreads();
        for (int c = tid; c < D; c += 512) { const float g = ln1_n[c]; const float* wr = w_in_n + (size_t)c * PW + 12288;
#pragma unroll
            for (int j = 0; j < 10; ++j) gfs[j * D + c] = (unsigned short)f2bf(wr[j] * g); }
        __syncthreads();
    }
    const int gw = bid * NWAVES + wave, NGW = G * NWAVES;
    for (int tok = gw; tok < M; tok += NGW) {
        const bf16_t* x1 = X1 + (size_t)tok * D;
        i32x8 xq[2]; float rstd_tok;
        const float* sc = SC + (size_t)tok * 2048;
        float xn_[2][2][2];
#define LDSC_(hh) do { _Pragma("unroll") for (int u = 0; u < 2; ++u) _Pragma("unroll") for (int f = 0; f < 2; ++f) _Pragma("unroll") for (int r = 0; r < 2; ++r) xn_[u][f][r] = sc[((hh) + 4 * u) * 256 + f * 128 + r * 64 + lane]; } while (0)
        LDSC_(0);
        { const int sg_ = lane & 15, gp_ = lane >> 4; float t[2][2][16]; float ss_ = 0.f;
#pragma unroll
          for (int s2 = 0; s2 < 2; ++s2)
#pragma unroll
              for (int hf = 0; hf < 2; ++hf) { load16_bf16(x1 + 1024 * (2 * s2 + (gp_ & 1)) + 16 * (sg_ + 32 * hf + 16 * (gp_ >> 1)), t[s2][hf]);
#pragma unroll
                  for (int k = 0; k < 16; ++k) ss_ += t[s2][hf][k] * t[s2][hf][k]; }
          rstd_tok = rsqrtf(wave_sum_dpp(ss_) * (1.0f / D) + 1e-6f);
#pragma unroll
          for (int s2 = 0; s2 < 2; ++s2)
#pragma unroll
              for (int hf = 0; hf < 2; ++hf)
#pragma unroll
                  for (int q = 0; q < 4; ++q) xq[s2][4 * hf + q] = (int)pk4_fp8(t[s2][hf][4 * q] * rstd_tok, t[s2][hf][4 * q + 1] * rstd_tok, t[s2][hf][4 * q + 2] * rstd_tok, t[s2][hf][4 * q + 3] * rstd_tok); }
        LAS float* selv = (LAS float*)(lds + 98304 + wave * 512); LAS int* seli = (LAS int*)(lds + 98304 + wave * 512 + 256);
#define BALLOT(c) __builtin_amdgcn_ballot_w64(c)
#define MBCNT(m) ((int)__builtin_amdgcn_mbcnt_hi((unsigned)((m) >> 32), __builtin_amdgcn_mbcnt_lo((unsigned)(m), 0u)))
        for (int h = 0; h < 4; ++h) {
            float x[2][2][2]; unsigned kk[2][2][2];
#pragma unroll
            for (int u = 0; u < 2; ++u)
#pragma unroll
                for (int f = 0; f < 2; ++f)
#pragma unroll
                    for (int r = 0; r < 2; ++r) { const float v = xn_[u][f][r]; x[u][f][r] = v; kk[u][f][r] = (ordkey(v) & ~127u) | (unsigned)(127 - 64 * r - lane); }
            LDSC_(min(h + 1, 3));
            unsigned T[2][2] = {{0u, 0u}, {0u, 0u}}; int dn = 0;
            for (unsigned bm = 0x80000000u; bm != 0u && dn != 15; bm >>= 1) {
#pragma unroll
                for (int u = 0; u < 2; ++u)
#pragma unroll
                    for (int f = 0; f < 2; ++f) { const unsigned cand = T[u][f] | bm;
                        const int c = __builtin_popcountll(BALLOT(kk[u][f][0] >= cand)) + __builtin_popcountll(BALLOT(kk[u][f][1] >= cand));
                        T[u][f] = c >= 16 ? cand : T[u][f]; dn |= (c == 16) ? (1 << (2 * u + f)) : 0; }
            }
#pragma unroll
            for (int u = 0; u < 2; ++u)
#pragma unroll
                for (int f = 0; f < 2; ++f) { const bool s0 = kk[u][f][0] >= T[u][f], s1 = kk[u][f][1] >= T[u][f]; const unsigned long long m0 = BALLOT(s0), m1 = BALLOT(s1);
                    const int p0 = MBCNT(m0), p1 = __builtin_popcountll(m0) + MBCNT(m1);
                    if (s0) { selv[(2 * u + f) * 16 + (p0 & 15)] = x[u][f][0]; seli[(2 * u + f) * 16 + (p0 & 15)] = lane; }
                    if (s1) { selv[(2 * u + f) * 16 + (p1 & 15)] = x[u][f][1]; seli[(2 * u + f) * 16 + (p1 & 15)] = 64 + lane; } }
            asm volatile("" ::: "memory");
            float s4[2][4]; unsigned k4[2][4];
#pragma unroll
            for (int u = 0; u < 2; ++u) { const float va = selv[(2 * u) * 16 + (lane >> 2)]; const f32x4 vb = *(const LAS f32x4*)(selv + (2 * u + 1) * 16 + (lane & 3) * 4);
#pragma unroll
                for (int q = 0; q < 4; ++q) { s4[u][q] = va + vb[q]; k4[u][q] = (ordkey(s4[u][q]) & ~255u) | (unsigned)(255 - 4 * lane - q); } }
            unsigned T2[2] = {0u, 0u}; int d2 = 0;
            for (unsigned bm = 0x80000000u; bm != 0u && d2 != 3; bm >>= 1) {
#pragma unroll
                for (int u = 0; u < 2; ++u) { const unsigned cand = T2[u] | bm;
                    const int c = (__builtin_popcountll(BALLOT(k4[u][0] >= cand)) + __builtin_popcountll(BALLOT(k4[u][1] >= cand))) + (__builtin_popcountll(BALLOT(k4[u][2] >= cand)) + __builtin_popcountll(BALLOT(k4[u][3] >= cand)));
                    T2[u] = c >= 16 ? cand : T2[u]; d2 |= (c == 16) ? (1 << u) : 0; }
            }
#pragma unroll
            for (int u = 0; u < 2; ++u) {
                const unsigned mk = wave_max_u32(max(max(k4[u][0], k4[u][1]), max(k4[u][2], k4[u][3]))) & ~255u;
                const float mx = __builtin_bit_cast(float, (mk & 0x80000000u) ? (mk & 0x7fffffffu) : ~mk);
                const float cs = 1.4426950408889634f * rstd_tok;
                float p[4], ps = 0.f;
#pragma unroll
                for (int q = 0; q < 4; ++q) { p[q] = (k4[u][q] >= T2[u]) ? __builtin_amdgcn_exp2f((s4[u][q] - mx) * cs) : 0.f; ps += p[q]; }
                const float tot = wave_sum_dpp(ps);
                const int i1 = seli[(2 * u) * 16 + (lane >> 2)]; const u32x4 i2 = *(const LAS u32x4*)(seli + (2 * u + 1) * 16 + (lane & 3) * 4);
                int base = (h + 4 * u) * 16;
#pragma unroll
                for (int q = 0; q < 4; ++q) { const bool sl = k4[u][q] >= T2[u]; const unsigned long long m = BALLOT(sl); const int slot = base + (MBCNT(m) & 15); base += __builtin_popcountll(m);
                    if (sl) { const int e = ((i1 & 127) << 7) | (int)(i2[q] & 127u); s_eid[slot] = e; s_ws[slot] = (f32x2){p[q] / tot * SCV[e], SCU[e]}; } }
            }
            asm volatile("" ::: "memory");
        }
#undef BALLOT
#undef MBCNT
#undef LDSC_
        LDS_WAIT(); asm volatile("" ::: "memory");
        {
            f32x2 acc2[2][16];
#define ACC(i, k) acc2[(i) >> 1][((i) & 1) * 8 + ((k) >> 1)][(k) & 1]
#pragma unroll
            for (int g = 0; g < 2; ++g)
#pragma unroll
                for (int k = 0; k < 16; ++k) acc2[g][k] = (f32x2){0.f, 0.f};
            const bool dg_ = ((lane & 15) >> 2) == (lane >> 4);
            const float mk0_ = (dg_ && (lane & 3) == 0) ? 1.f : 0.f, mk1_ = (dg_ && (lane & 3) == 1) ? 1.f : 0.f, mk2_ = (dg_ && (lane & 3) == 2) ? 1.f : 0.f, mk3_ = (dg_ && (lane & 3) == 3) ? 1.f : 0.f;
#define LOADREC4(dst, e) do { const u32x4* p_ = (const u32x4*)(T4 + (size_t)(e) * REC4) + lane; dst[0] = p_[0]; dst[1] = p_[64]; dst[2] = p_[128]; dst[3] = p_[192]; } while (0)
#define PROW4(row, j) do { f32x4 ac_ = {0.f, 0.f, 0.f, 0.f}; \
            ac_ = __builtin_amdgcn_mfma_scale_f32_16x16x128_f8f6f4((i32x8){(int)row[0][0], (int)row[0][1], (int)row[0][2], (int)row[0][3], 0, 0, 0, 0}, xq[0], ac_, 4, 0, 0, 0x7f7f7f7f, 0, 0x7f7f7f7f); \
            ac_ = __builtin_amdgcn_mfma_scale_f32_16x16x128_f8f6f4((i32x8){(int)row[1][0], (int)row[1][1], (int)row[1][2], (int)row[1][3], 0, 0, 0, 0}, xq[1], ac_, 4, 0, 0, 0x7f7f7f7f, 0, 0x7f7f7f7f); \
            const float pv_ = (ac_[0] * mk0_ + ac_[1] * mk1_) + (ac_[2] * mk2_ + ac_[3] * mk3_); \
            const f32x2 ws_ = s_ws[j]; const float d_ = diag_sum_dpp(pv_) * ws_[1]; const float w_ = ws_[0] * gelu_erf(d_); const f32x2 w2_ = {w_, w_}; \
            _Pragma("unroll") for (int g_ = 0; g_ < 2; ++g_) { \
                u32x4 G_ = row[2 + g_]; asm volatile("" : "+v"(G_)); \
                _Pragma("unroll") for (int k_ = 0; k_ < 4; ++k_) { const unsigned d4_ = G_[k_]; \
                    acc2[g_][4 * k_] = __builtin_elementwise_fma(w2_, __builtin_amdgcn_cvt_scalef32_pk_f32_fp4(d4_, 1.0f, 0), acc2[g_][4 * k_]); acc2[g_][4 * k_ + 1] = __builtin_elementwise_fma(w2_, __builtin_amdgcn_cvt_scalef32_pk_f32_fp4(d4_, 1.0f, 1), acc2[g_][4 * k_ + 1]); \
                    acc2[g_][4 * k_ + 2] = __builtin_elementwise_fma(w2_, __builtin_amdgcn_cvt_scalef32_pk_f32_fp4(d4_, 1.0f, 2), acc2[g_][4 * k_ + 2]); acc2[g_][4 * k_ + 3] = __builtin_elementwise_fma(w2_, __builtin_amdgcn_cvt_scalef32_pk_f32_fp4(d4_, 1.0f, 3), acc2[g_][4 * k_ + 3]); } \
                asm volatile("" : "+v"(acc2[g_][0]), "+v"(acc2[g_][1]), "+v"(acc2[g_][2]), "+v"(acc2[g_][3]), "+v"(acc2[g_][4]), "+v"(acc2[g_][5]), "+v"(acc2[g_][6]), "+v"(acc2[g_][7]), \
                                  "+v"(acc2[g_][8]), "+v"(acc2[g_][9]), "+v"(acc2[g_][10]), "+v"(acc2[g_][11]), "+v"(acc2[g_][12]), "+v"(acc2[g_][13]), "+v"(acc2[g_][14]), "+v"(acc2[g_][15])); } } while (0)
            u32x4 r0[4], r1[4], r2[4], r3[4];
            { const int e_ = RFL(s_eid[0]); LOADREC4(r0, e_); } { const int e_ = RFL(s_eid[1]); LOADREC4(r1, e_); } { const int e_ = RFL(s_eid[2]); LOADREC4(r2, e_); } { const int e_ = RFL(s_eid[3]); LOADREC4(r3, e_); }
            for (int j = 0; j < 124; j += 4) {
                PROW4(r0, j + 0); { const int e_ = RFL(s_eid[j + 4]); LOADREC4(r0, e_); }
                PROW4(r1, j + 1); { const int e_ = RFL(s_eid[j + 5]); LOADREC4(r1, e_); }
                PROW4(r2, j + 2); { const int e_ = RFL(s_eid[j + 6]); LOADREC4(r2, e_); }
                PROW4(r3, j + 3); { const int e_ = RFL(s_eid[j + 7]); LOADREC4(r3, e_); }
            }
            PROW4(r0, 124); PROW4(r1, 125); PROW4(r2, 126); PROW4(r3, 127);
#undef PROW4
#undef LOADREC4
            float ss = 0.f;
#pragma unroll
            for (int i = 0; i < 4; ++i) { float t[16]; load16_bf16(x1 + 1024 * i + 16 * lane, t);
#pragma unroll
                for (int k = 0; k < 16; ++k) { ACC(i, k) += t[k]; ss += ACC(i, k) * ACC(i, k); } }
            ss = wave_sum_dpp(ss);
            const float rs = rsqrtf(ss * (1.0f / D) + 1e-6f);
            if (!FINAL) {
#pragma unroll
                for (int i = 0; i < 4; ++i) { u32x4 w8;
#pragma unroll
                    for (int q = 0; q < 4; ++q) w8[q] = pk4_fp8(ACC(i, 4 * q), ACC(i, 4 * q + 1), ACC(i, 4 * q + 2), ACC(i, 4 * q + 3));
                    *(u32x4*)(XB8n + (size_t)tok * D + 1024 * i + 16 * lane) = w8; }
                if (lane == 0) RSTDn[tok] = rs;
                float mine = 0.f;
#pragma unroll 1
                for (int j = 0; j < 10; ++j) { float s = 0.f;
#pragma unroll
                    for (int i = 0; i < 4; ++i) { const u32x4 g0 = *(const LAS u32x4*)(gfs + j * D + 1024 * i + 16 * lane), g1 = *(const LAS u32x4*)(gfs + j * D + 1024 * i + 16 * lane + 8);
#pragma unroll
                        for (int q = 0; q < 4; ++q) { s += ACC(i, 2 * q) * bf_lo(g0[q]) + ACC(i, 2 * q + 1) * bf_hi(g0[q]); s += ACC(i, 8 + 2 * q) * bf_lo(g1[q]) + ACC(i, 8 + 2 * q + 1) * bf_hi(g1[q]); } }
                    s = wave_sum_dpp(s); if (lane == j) mine = s; }
                if (lane < 10) { const int b_ = tok >> 11, s_ = tok & 2047; LOGFn[(size_t)(b_ * 10 + lane) * S + s_] = logsig(mine * rs + bf_n[lane]); }
            }
            if (FINAL) { float* xo = (float*)XOv + (size_t)tok * D;
#pragma unroll
                for (int i = 0; i < 4; ++i)
#pragma unroll
                    for (int q = 0; q < 4; ++q) { const int c = 1024 * i + 16 * lane + 4 * q; const f32x4 g_ = *(const f32x4*)(fg + c);
                        *(f32x4*)(xo + c) = (f32x4){ACC(i, 4 * q) * rs * g_[0], ACC(i, 4 * q + 1) * rs * g_[1], ACC(i, 4 * q + 2) * rs * g_[2], ACC(i, 4 * q + 3) * rs * g_[3]}; }
            } else { bf16_t* xo = (bf16_t*)XOv + (size_t)tok * D;
#pragma unroll
                for (int i = 0; i < 4; ++i) { u32x4 w0, w1;
#pragma unroll
                    for (int q = 0; q < 4; ++q) { w0[q] = pk2(ACC(i, 2 * q), ACC(i, 2 * q + 1)); w1[q] = pk2(ACC(i, 8 + 2 * q), ACC(i, 8 + 2 * q + 1)); }
                    *(u32x4*)(xo + 1024 * i + 16 * lane) = w0; *(u32x4*)(xo + 1024 * i + 16 * lane + 8) = w1; }
            }
        }
        LDS_WAIT(); asm volatile("" ::: "memory");
    }
#undef ACC
}
}
namespace at {
using namespace mk;
constexpr int QB = 256, KVB = 64, HD = 128;
constexpr int SHM_V = KVB * HD * 2, SHM_K = KVB * HD * 2;
constexpr int OFF_V = 0, OFF_K = 2 * SHM_V, OFF_WS = OFF_K + 2 * SHM_K, OFF_CUM = OFF_WS + 8 * 256, OFF_RT = OFF_CUM + 2048 * 4, OFF_MISC = OFF_RT + 640 * 4;
constexpr float LOG2E = 1.4426950408889634f;
constexpr float THR2 = 10.0f;
constexpr float SB_DONE = -100.0f;

#define AT_KSWZ(row, colB) ((row) * 256 + ((colB) ^ (((row) & 7) << 4)))
__device__ __forceinline__ int v_st(int k, int c) { const int kk = (k & ~0xC) | ((k & 4) << 1) | ((k & 8) >> 1); return ((kk >> 3) * 4 + (c >> 5)) * 512 + ((kk & 7) * 32 + (c & 31)) * 2; }
__device__ __forceinline__ int v_rd_base(int lane) { return ((lane & 3) << 3) | (((lane >> 2) & 3) << 6) | (((lane >> 4) & 1) << 5) | (((lane >> 5) & 1) << 8); }
constexpr int v_rd_off(int d0, int ks, int half) { return d0 * 512 + ks * 4096 + half * 2048; }
__device__ __forceinline__ int crow(int r, int hi) { return (r & 3) + 8 * (r >> 2) + 4 * hi; }
__device__ __forceinline__ unsigned cvtpk(float lo, float hi) { unsigned r; asm volatile("v_cvt_pk_bf16_f32 %0, %1, %2" : "=v"(r) : "v"(lo), "v"(hi)); return r; }
__device__ __forceinline__ float partner(float v, int hi) { auto rr = __builtin_amdgcn_permlane32_swap(__builtin_bit_cast(unsigned, v), __builtin_bit_cast(unsigned, v), false, false); return __builtin_bit_cast(float, hi ? rr[0] : rr[1]); }

__device__ __forceinline__ float xchg_max(float v, int hi) { return fmaxf(v, partner(v, hi)); }
__device__ __forceinline__ float xchg_sum(float v, int hi) { return v + partner(v, hi); }

__device__ __forceinline__ void pack_p(const f32x16& p0, const f32x16& p1, bf16x8& pa0, bf16x8& pa1, bf16x8& pa2, bf16x8& pa3) {
#define AT_PK4(P, B_, OUT) do { unsigned a0 = cvtpk(P[B_ + 0], P[B_ + 1]), a1 = cvtpk(P[B_ + 2], P[B_ + 3]); unsigned b0 = cvtpk(P[B_ + 4], P[B_ + 5]), b1 = cvtpk(P[B_ + 6], P[B_ + 7]); \
        auto r0 = __builtin_amdgcn_permlane32_swap(a0, b0, false, false); auto r1 = __builtin_amdgcn_permlane32_swap(a1, b1, false, false); \
        u32x4 w = {r0[0], r1[0], r0[1], r1[1]}; OUT = __builtin_bit_cast(bf16x8, w); } while (0)
    AT_PK4(p0, 0, pa0); AT_PK4(p0, 8, pa1); AT_PK4(p1, 0, pa2); AT_PK4(p1, 8, pa3);
#undef AT_PK4
}
template <int KBUF>
__device__ __forceinline__ void qkt(f32x16& p0, f32x16& p1, LAS unsigned char* K_lds, int r32, int hi, const bf16x8 (&qr)[8]) {
    p0 = f32x16{}; p1 = f32x16{};
    LAS unsigned char* kb[4];
#pragma unroll
    for (int dd = 0; dd < 4; ++dd) kb[dd] = K_lds + KBUF * SHM_K + AT_KSWZ(r32, (dd * 16 + hi * 8) * 2);
#pragma unroll
    for (int d0 = 0; d0 < 8; ++d0) { LAS unsigned char* a = kb[d0 & 3] + (d0 >> 2) * 128;
        const bf16x8 b0 = *(const LAS bf16x8*)a; const bf16x8 b1 = *(const LAS bf16x8*)(a + 32 * 256);
        p0 = __builtin_amdgcn_mfma_f32_32x32x16_bf16(b0, qr[d0], p0, 0, 0, 0);
        p1 = __builtin_amdgcn_mfma_f32_32x32x16_bf16(b1, qr[d0], p1, 0, 0, 0); }
}
template <int VBUF>
__device__ __forceinline__ void pv_tile(f32x16 (&o)[4], int vb0, bf16x8 pa0, bf16x8 pa1, bf16x8 pa2, bf16x8 pa3) {
#define AT_TRRD(dst, off) asm volatile("ds_read_b64_tr_b16 %0, %1 offset:%2" : "=&v"(dst) : "v"(vb0), "i"(off) : "memory")
#define AT_PV_D0(d0) do { s16x4 l0, l1, l2, l3, h0, h1, h2, h3; constexpr int b_ = VBUF * SHM_V + v_rd_off(d0, 0, 0); \
        AT_TRRD(l0, b_); AT_TRRD(h0, b_ + 2048); AT_TRRD(l1, b_ + 4096); AT_TRRD(h1, b_ + 6144); AT_TRRD(l2, b_ + 8192); AT_TRRD(h2, b_ + 10240); AT_TRRD(l3, b_ + 12288); AT_TRRD(h3, b_ + 14336); \
        asm volatile("s_waitcnt lgkmcnt(0)" ::: "memory"); __builtin_amdgcn_sched_barrier(0); \
        o[d0] = __builtin_amdgcn_mfma_f32_32x32x16_bf16(pa0, (bf16x8){l0[0], l0[1], l0[2], l0[3], h0[0], h0[1], h0[2], h0[3]}, o[d0], 0, 0, 0); \
        o[d0] = __builtin_amdgcn_mfma_f32_32x32x16_bf16(pa1, (bf16x8){l1[0], l1[1], l1[2], l1[3], h1[0], h1[1], h1[2], h1[3]}, o[d0], 0, 0, 0); \
        o[d0] = __builtin_amdgcn_mfma_f32_32x32x16_bf16(pa2, (bf16x8){l2[0], l2[1], l2[2], l2[3], h2[0], h2[1], h2[2], h2[3]}, o[d0], 0, 0, 0); \
        o[d0] = __builtin_amdgcn_mfma_f32_32x32x16_bf16(pa3, (bf16x8){l3[0], l3[1], l3[2], l3[3], h3[0], h3[1], h3[2], h3[3]}, o[d0], 0, 0, 0); } while (0)
    AT_PV_D0(0); AT_PV_D0(1); AT_PV_D0(2); AT_PV_D0(3);
#undef AT_PV_D0
#undef AT_TRRD
}

template <int VAR>
__device__ __forceinline__ void attn_item(const bf16_t* Qh, const bf16_t* Kh, const bf16_t* Vh, bf16_t* OB, const float* relb, const float* LOGF, int b, int h, int qb, LAS unsigned char* lds, int tid) {
    const int wid = __builtin_amdgcn_readfirstlane(tid >> 6), lane = tid & 63, r32 = lane & 31, hi = lane >> 5;
    const int g = VAR == 0 ? h : (VAR == 1 ? 12 + h : 22 + h);
    const size_t hb = (size_t)(b * NH + g) * S * HD;
    const bf16_t* Kp = Kh + hb; const bf16_t* Vp = Vh + hb;
    LAS unsigned char* V_lds = lds + OFF_V; LAS unsigned char* K_lds = lds + OFF_K;
    LAS float* wsf = (LAS float*)(lds + OFF_WS) + wid * 64; LAS float* li_l = wsf; LAS float* al_l = wsf + 32;
    LAS float* cumL = (LAS float*)(lds + OFF_CUM); LAS float* Rt = (LAS float*)(lds + OFF_RT); volatile LAS unsigned* flags = (volatile LAS unsigned*)(lds + OFF_MISC);
    const int P0 = qb * QB, qlo = P0 + wid * 32, qpos = qlo + r32;
    int NT, jlo = 0;
    if (VAR == 0) { jlo = 4 * qb - 8; if (jlo < 0) jlo = 0; NT = 4 * qb + 4 - jlo; } else NT = 4 * qb + 4;
    const int cw = 4 * qb + (wid >> 1);
#define AT_KBASE(t) (VAR == 1 ? (4 * qb + 3 - (t)) * KVB : (jlo + (t)) * KVB)
#define AT_ACT(t) (VAR == 0 ? ((jlo + (t)) >= cw - 8 && (jlo + (t)) <= cw) : (VAR == 1 ? (AT_KBASE(t) <= qlo + 30) : (AT_KBASE(t) <= qlo + 31)))
    if (VAR == 0) {
        const float* tab = relb + h * 257;
        for (int j = tid; j < 639; j += 512) { int rel = 575 - j; rel = rel < -128 ? -128 : (rel > 128 ? 128 : rel); Rt[j] = tab[rel + 128] * LOG2E; }
    }
    if (VAR == 2) {
        const float* lf = LOGF + (size_t)(b * 10 + h) * S; const int kend = P0 + QB;
        f32x4 v = (f32x4){0.f, 0.f, 0.f, 0.f};
        if (4 * tid < kend) v = *(const f32x4*)(lf + 4 * tid);
        v[1] += v[0]; v[2] += v[1]; v[3] += v[2];
        float tot = v[3];
#pragma unroll
        for (int o = 1; o < 64; o <<= 1) { const float t_ = lane_read(tot, lane >= o ? lane - o : lane); if (lane >= o) tot += t_; }
        if (lane == 63) li_l[0] = tot;
        __syncthreads();
        float base = tot - v[3];
        for (int w = 0; w < wid; ++w) base += ((LAS float*)(lds + OFF_WS))[w * 64];
        if (4 * tid < kend) *(LAS f32x4*)(cumL + 4 * tid) = (f32x4){(base + v[0]) * LOG2E, (base + v[1]) * LOG2E, (base + v[2]) * LOG2E, (base + v[3]) * LOG2E};
    }
    bf16x8 qr[8];
    { const bf16_t* qp = Qh + hb + (size_t)(qlo + r32) * HD + hi * 8;
#pragma unroll
      for (int d0 = 0; d0 < 8; ++d0) qr[d0] = *(const bf16x8*)(qp + d0 * 16); }
    const int sr = tid >> 4, sc = (tid & 15) * 8, vst0 = v_st(sr, sc), vst1 = v_st(32 + sr, sc), kws = AT_KSWZ(sr, sc * 2);
    const int vb0 = (int)(unsigned)(size_t)V_lds + v_rd_base(lane);
    bf16x8 st_k0, st_k1, st_v0, st_v1;
#define AT_SLOAD(k0) do { const bf16_t* kp_ = Kp + (size_t)((k0) + sr) * HD + sc; const bf16_t* vp_ = Vp + (size_t)((k0) + sr) * HD + sc; \
        st_k0 = *(const bf16x8*)kp_; st_k1 = *(const bf16x8*)(kp_ + 32 * HD); st_v0 = *(const bf16x8*)vp_; st_v1 = *(const bf16x8*)(vp_ + 32 * HD); } while (0)
#define AT_SWRITE(bf) do { *(LAS bf16x8*)(K_lds + (bf) * SHM_K + kws) = st_k0; *(LAS bf16x8*)(K_lds + (bf) * SHM_K + kws + 32 * 256) = st_k1; \
        *(LAS bf16x8*)(V_lds + (bf) * SHM_V + vst0) = st_v0; *(LAS bf16x8*)(V_lds + (bf) * SHM_V + vst1) = st_v1; } while (0)
    AT_SLOAD(AT_KBASE(0)); asm volatile("s_waitcnt vmcnt(0)" ::: "memory"); AT_SWRITE(0);
    __syncthreads();
    float m_reg = -1e30f, l_reg = 0.f, carry = 0.f;
    f32x16 o[4] = {};
#define AT_STEP(BUF, t) do { \
        const bool more_ = (t) + 1 < NT; \
        if (more_) AT_SLOAD(AT_KBASE((t) + 1)); \
        if (AT_ACT(t)) { \
            const int kb_ = AT_KBASE(t); f32x16 p0, p1; bf16x8 pa0, pa1, pa2, pa3; \
            qkt<BUF>(p0, p1, K_lds, r32, hi, qr); \
            tile_math(p0, p1, kb_, pa0, pa1, pa2, pa3); \
            pv_tile<BUF>(o, vb0, pa0, pa1, pa2, pa3); \
        } \
        if (more_) { asm volatile("s_waitcnt vmcnt(0)" ::: "memory"); AT_SWRITE((BUF) ^ 1); } \
        if (VAR == 1) { const bool done_ = __all(carry < SB_DONE); if (lane == 0) flags[((t) & 1) * 8 + wid] = done_ ? 1u : 0u; } \
        __syncthreads(); \
    } while (0)
    auto tile_math = [&](f32x16& p0, f32x16& p1, int kb, bf16x8& pa0, bf16x8& pa1, bf16x8& pa2, bf16x8& pa3) __attribute__((always_inline)) {
        const int dq = qpos - kb - 4 * hi;
        if (VAR == 1) {
            const bool need_mask = kb + 63 >= qlo;
            f32x16 n0, n1;
#pragma unroll
            for (int r = 0; r < 16; ++r) { const float z = p0[r]; const float lp = __builtin_amdgcn_logf(1.0f + __builtin_amdgcn_exp2f(-fabsf(z))); n0[r] = fminf(-z, 0.f) - lp;
                                           const float y = p1[r]; const float lq = __builtin_amdgcn_logf(1.0f + __builtin_amdgcn_exp2f(-fabsf(y))); n1[r] = fminf(-y, 0.f) - lq; }
            if (need_mask) {
#pragma unroll
                for (int r = 0; r < 16; ++r) { const int c = (r & 3) + 8 * (r >> 2);
                    if (dq - c <= 0) { n0[r] = 0.f; p0[r] = -__builtin_inff(); }
                    if (dq - c - 32 <= 0) { n1[r] = 0.f; p1[r] = -__builtin_inff(); } }
            }
            float A[8], Bp[8];
#pragma unroll
            for (int q = 0; q < 4; ++q) { A[q] = (n0[4 * q] + n0[4 * q + 1]) + (n0[4 * q + 2] + n0[4 * q + 3]); A[4 + q] = (n1[4 * q] + n1[4 * q + 1]) + (n1[4 * q + 2] + n1[4 * q + 3]); }
#pragma unroll
            for (int q = 0; q < 8; ++q) Bp[q] = partner(A[q], hi);
            float st = 0.f;
#pragma unroll
            for (int q = 7; q >= 0; --q) {
                const float after = carry + st + (hi == 0 ? Bp[q] : 0.f);
                if (q >= 4) { const int r0 = 4 * (q - 4);
                    float tl = after; p1[r0 + 3] = __builtin_amdgcn_exp2f(p1[r0 + 3] + n1[r0 + 3] + tl); tl += n1[r0 + 3]; p1[r0 + 2] = __builtin_amdgcn_exp2f(p1[r0 + 2] + n1[r0 + 2] + tl); tl += n1[r0 + 2];
                    p1[r0 + 1] = __builtin_amdgcn_exp2f(p1[r0 + 1] + n1[r0 + 1] + tl); tl += n1[r0 + 1]; p1[r0] = __builtin_amdgcn_exp2f(p1[r0] + n1[r0] + tl); }
                else { const int r0 = 4 * q;
                    float tl = after; p0[r0 + 3] = __builtin_amdgcn_exp2f(p0[r0 + 3] + n0[r0 + 3] + tl); tl += n0[r0 + 3]; p0[r0 + 2] = __builtin_amdgcn_exp2f(p0[r0 + 2] + n0[r0 + 2] + tl); tl += n0[r0 + 2];
                    p0[r0 + 1] = __builtin_amdgcn_exp2f(p0[r0 + 1] + n0[r0 + 1] + tl); tl += n0[r0 + 1]; p0[r0] = __builtin_amdgcn_exp2f(p0[r0] + n0[r0] + tl); }
                st += A[q] + Bp[q];
            }
            carry += st;
            pack_p(p0, p1, pa0, pa1, pa2, pa3);
        } else {
            if (VAR == 0) {
                const LAS float* rp = Rt + (575 - (qpos - kb) + 4 * hi);
#pragma unroll
                for (int r = 0; r < 16; ++r) { const int c = (r & 3) + 8 * (r >> 2); p0[r] += rp[c]; p1[r] += rp[c + 32]; }
            } else {
                const LAS float* cp = cumL + kb + 4 * hi;
#pragma unroll
                for (int q = 0; q < 4; ++q) { const f32x4 c0 = *(const LAS f32x4*)(cp + 8 * q), c1 = *(const LAS f32x4*)(cp + 32 + 8 * q);
                    p0[4 * q] -= c0[0]; p0[4 * q + 1] -= c0[1]; p0[4 * q + 2] -= c0[2]; p0[4 * q + 3] -= c0[3];
                    p1[4 * q] -= c1[0]; p1[4 * q + 1] -= c1[1]; p1[4 * q + 2] -= c1[2]; p1[4 * q + 3] -= c1[3]; }
                if (kb + 63 > qlo) {
#pragma unroll
                    for (int r = 0; r < 16; ++r) { const int c = (r & 3) + 8 * (r >> 2);
                        if (dq - c < 0) p0[r] = -__builtin_inff();
                        if (dq - c - 32 < 0) p1[r] = -__builtin_inff(); }
                }
            }
            float pmax = p0[0];
#pragma unroll
            for (int r = 1; r < 16; ++r) pmax = fmaxf(pmax, p0[r]);
#pragma unroll
            for (int r = 0; r < 16; ++r) pmax = fmaxf(pmax, p1[r]);
            pmax = xchg_max(pmax, hi);
            float mn, alpha;
            if (__all(pmax - m_reg <= THR2)) { mn = m_reg; alpha = 1.f; }
            else { mn = fmaxf(m_reg, pmax); alpha = __builtin_amdgcn_exp2f(m_reg - mn); m_reg = mn; }
            float ps = 0.f;
#pragma unroll
            for (int r = 0; r < 16; ++r) { p0[r] = __builtin_amdgcn_exp2f(p0[r] - mn); p1[r] = __builtin_amdgcn_exp2f(p1[r] - mn); ps += p0[r] + p1[r]; }
            ps = xchg_sum(ps, hi);
            l_reg = l_reg * alpha + ps;
            if (__any(alpha < 1.f)) {
                if (hi == 0) al_l[r32] = alpha;
                asm volatile("s_waitcnt lgkmcnt(0)" ::: "memory");
                float av[16];
#pragma unroll
                for (int r = 0; r < 16; ++r) av[r] = al_l[crow(r, hi)];
#pragma unroll
                for (int d = 0; d < 4; ++d)
#pragma unroll
                    for (int r = 0; r < 16; ++r) o[d][r] *= av[r];
            }
            pack_p(p0, p1, pa0, pa1, pa2, pa3);
        }
    };
    for (int t = 0; t < NT; t += 2) {
        AT_STEP(0, t);
        if (VAR == 1) { unsigned all_ = 1u; for (int w = 0; w < 8; ++w) all_ &= flags[(t & 1) * 8 + w]; if (all_) break; }
        if (t + 1 >= NT) break;
        AT_STEP(1, t + 1);
        if (VAR == 1) { unsigned all_ = 1u; for (int w = 0; w < 8; ++w) all_ &= flags[((t + 1) & 1) * 8 + w]; if (all_) break; }
    }
    float rli[16];
    if (VAR != 1) {
        if (hi == 0) li_l[r32] = l_reg;
        asm volatile("s_waitcnt lgkmcnt(0)" ::: "memory");
#pragma unroll
        for (int r = 0; r < 16; ++r) rli[r] = __builtin_amdgcn_rcpf(li_l[crow(r, hi)]);
    }
    unsigned char* Ow8 = (unsigned char*)OB + (size_t)(b * S + qlo) * D + g * HD;
    const unsigned bsel_ = (unsigned)(lane & 3) | ((4u + (unsigned)(lane & 3)) << 8);
#pragma unroll
    for (int r = 0; r < 16; ++r) { const int orow = crow(r, hi); const float sc_ = VAR != 1 ? rli[r] * 16.0f : 16.0f;
        const unsigned w = mk::pk4_fp8(o[0][r] * sc_, o[1][r] * sc_, o[2][r] * sc_, o[3][r] * sc_);
        const unsigned t0 = (unsigned)__builtin_amdgcn_update_dpp(0, (int)w, 0x00, 0xF, 0xF, false), t1 = (unsigned)__builtin_amdgcn_update_dpp(0, (int)w, 0x55, 0xF, 0xF, false),
                       t2 = (unsigned)__builtin_amdgcn_update_dpp(0, (int)w, 0xAA, 0xF, 0xF, false), t3 = (unsigned)__builtin_amdgcn_update_dpp(0, (int)w, 0xFF, 0xF, 0xF, false);
        const unsigned r01 = __builtin_amdgcn_perm(t1, t0, bsel_), r23 = __builtin_amdgcn_perm(t3, t2, bsel_);
        *(unsigned*)(Ow8 + (size_t)orow * D + (lane & 3) * 32 + (r32 & ~3)) = __builtin_amdgcn_perm(r23, r01, 0x05040100u); }
    __syncthreads();
#undef AT_STEP
#undef AT_SLOAD
#undef AT_SWRITE
#undef AT_KBASE
#undef AT_ACT
}

template <int VAR>
__device__ __forceinline__ void attn_queue(const bf16_t* Qh, const bf16_t* Kh, const bf16_t* Vh, bf16_t* OB, const float* relb, const float* LOGF, unsigned* qhead, LAS unsigned char* lds, int wave0) {
    FRESH_TID(); FRESH_LDS(lds);
    volatile LAS unsigned* qslot = (volatile LAS unsigned*)(lds + OFF_MISC) + 32;
    constexpr int NHV = VAR == 0 ? 12 : 10, NITEMS = 8 * NHV * 8;
    for (;;) {
        if (tid == 0) qslot[0] = __hip_atomic_fetch_add(qhead, 1u, __ATOMIC_RELAXED, __HIP_MEMORY_SCOPE_AGENT);
        __syncthreads();
        const int idx = (int)qslot[0];
        __syncthreads();
        if (idx >= NITEMS) break;
        const int qb = 7 - idx / (8 * NHV), bh = idx % (8 * NHV);
        attn_item<VAR>(Qh, Kh, Vh, OB, relb, LOGF, bh / NHV, bh % NHV, qb, lds, tid);
    }
}
__device__ __forceinline__ void attn_phase(const bf16_t* Qh, const bf16_t* Kh, const bf16_t* Vh, bf16_t* OB, const float* relb, const float* LOGF, unsigned* qheads, LAS unsigned char* lds, int wave0, mk::KArgsT ka, int conv_l) {
    int grp = (int)((blockIdx.x >> 3) & 3u); asm volatile("" : "+s"(grp));
    int cnt = 0; bool conv_done = conv_l < 0;
#pragma unroll 1
    for (int seg = 0; seg < 4; ++seg) {
        for (;;) {
            if (!conv_done && (cnt == grp || seg == 3)) { mk::conv_phase(ka, conv_l, lds, wave0); __syncthreads(); conv_done = true; }
            if (seg == 3) break;
            int idx;
            { FRESH_TID(); LAS unsigned char* l_ = lds; FRESH_LDS(l_); volatile LAS unsigned* qslot = (volatile LAS unsigned*)(l_ + OFF_MISC) + 32;
              if (tid == 0) qslot[0] = __hip_atomic_fetch_add(qheads + 64 * seg, 1u, __ATOMIC_RELAXED, __HIP_MEMORY_SCOPE_AGENT);
              __syncthreads();
              idx = (int)qslot[0];
              __syncthreads(); }
            const int NHV = seg == 1 ? 12 : 10;
            if (idx >= 64 * NHV) break;
            ++cnt;
            const int qb = 7 - idx / (8 * NHV), bh = idx % (8 * NHV);
            { FRESH_TID(); LAS unsigned char* l_ = lds; FRESH_LDS(l_);
              if (seg == 0) attn_item<2>(Qh, Kh, Vh, OB, relb, LOGF, bh / NHV, bh % NHV, qb, l_, tid);
              else if (seg == 1) attn_item<0>(Qh, Kh, Vh, OB, relb, LOGF, bh / NHV, bh % NHV, qb, l_, tid);
              else attn_item<1>(Qh, Kh, Vh, OB, relb, LOGF, bh / NHV, bh % NHV, qb, l_, tid); }
        }
    }
}
}
namespace mk {
#define XB_TMO      128
#define XB_XCNT(j)  (256  + 64 * (j))
#define XB_XSUB(j)  (1280 + 64 * (j))
#define XB_XGEN(j)  (2304 + 64 * (j))
#define XB_TOP      3328
#define XB_TOPGEN   3392
#define XCD_BAR_WORDS 3456
#define XB_SPIN_CAP (1u << 22)

__device__ __forceinline__ unsigned xb_ld(unsigned* p)              { return __hip_atomic_load(p, __ATOMIC_RELAXED, __HIP_MEMORY_SCOPE_AGENT); }
__device__ __forceinline__ unsigned xb_add(unsigned* p, unsigned v) { return __hip_atomic_fetch_add(p, v, __ATOMIC_RELAXED, __HIP_MEMORY_SCOPE_AGENT); }
__device__ __forceinline__ unsigned xb_xcc_id() { return (unsigned)__builtin_amdgcn_s_getreg((3 << 11) | 20) & 0xFu; }
#define XB_SPIN(cond, bar) do { unsigned _sp = 0; while (cond) { __builtin_amdgcn_s_sleep(1); \
    if ((++_sp & 255u) == 0u) { if (xb_ld(&(bar)[XB_TMO])) break; if (_sp > XB_SPIN_CAP) { atomicAdd(&(bar)[XB_TMO], 1u); break; } } } } while (0)

struct XcdBarrier {
    unsigned* bar; unsigned x;
    volatile LAS unsigned* st;
};

__device__ __forceinline__ XcdBarrier xcd_barrier_post(unsigned* bar, volatile LAS unsigned* st, bool is_t0) {
    XcdBarrier b; b.bar = bar; b.x = xb_xcc_id(); b.st = st;
    if (is_t0) (void)xb_add(&bar[XB_XCNT(b.x)], 1u);
    return b;
}
__device__ __forceinline__ void xcd_barrier_complete(unsigned* bar, unsigned x, unsigned& nloc, unsigned& nx) {
    const unsigned G = gridDim.x * gridDim.y * gridDim.z;
    unsigned sum, cnt, mine, sp = 0u;
    for (;;) {
        sum = 0u; cnt = 0u; mine = 0u;
#pragma unroll
        for (unsigned j = 0; j < 16; ++j) { const unsigned c = xb_ld(&bar[XB_XCNT(j)]); sum += c; cnt += (c > 0u) ? 1u : 0u; mine = (j == x) ? c : mine; }
        if (sum == G) break;
        __builtin_amdgcn_s_sleep(1);
        if ((++sp & 255u) == 0u) { if (xb_ld(&bar[XB_TMO])) break; if (sp > XB_SPIN_CAP) { atomicAdd(&bar[XB_TMO], 1u); break; } }
    }
    nloc = mine > 0u ? mine : 1u; nx = cnt > 0u ? cnt : 1u;
}

__device__ __forceinline__ void xcd_barrier(const XcdBarrier& b, bool is_t0) {
    asm volatile("s_waitcnt vmcnt(0)" ::: "memory");
    __syncthreads();
    if (is_t0) {
        unsigned* bar = b.bar;
        __builtin_amdgcn_s_waitcnt(0);
        unsigned nloc = b.st[0], nx = b.st[1];
        if (nloc == 0u) { xcd_barrier_complete(bar, b.x, nloc, nx); b.st[0] = nloc; b.st[1] = nx; }
        const unsigned old = xb_add(&bar[XB_XSUB(b.x)], 1u);
        const unsigned gen = old / nloc;
        if (old + 1u == (gen + 1u) * nloc) {
            __builtin_amdgcn_fence(__ATOMIC_RELEASE, "agent");
            asm volatile("s_waitcnt vmcnt(0)" ::: "memory");
            const unsigned og = xb_add(&bar[XB_TOP], 1u);
            const unsigned tg = og / nx;
            if (og + 1u == (tg + 1u) * nx) xb_add(&bar[XB_TOPGEN], 1u);
            else XB_SPIN(xb_ld(&bar[XB_TOPGEN]) == tg, bar);
            __builtin_amdgcn_fence(__ATOMIC_ACQUIRE, "agent");
            xb_add(&bar[XB_XGEN(b.x)], 1u);
            asm volatile("s_waitcnt vmcnt(0)" ::: "memory");
        } else {
            XB_SPIN(xb_ld(&bar[XB_XGEN(b.x)]) == gen, bar);
            __builtin_amdgcn_fence(__ATOMIC_ACQUIRE, "agent");
            asm volatile("s_waitcnt vmcnt(0)" ::: "memory");
        }
    }
    __syncthreads();
}

constexpr int PH_PER_LAYER = 8;
typedef const __attribute__((address_space(4))) Args* KArgs;
#define KARGS() ({ KArgs p_ = (KArgs)__builtin_amdgcn_kernarg_segment_ptr(); asm volatile("" : "+s"(p_)); p_; })
#define GRID_BAR() do { KArgs k_ = KARGS(); XcdBarrier b_; b_.bar = (unsigned*)(k_->ws + WS_CTL) + CW_BAR; b_.x = xb_xcc_id(); b_.st = (volatile LAS unsigned*)(lds + MISC_OFF) + 8; unsigned z_ = 0u; asm volatile("" : "+v"(z_)); const bool t0_ = (wave0 == 0) && (__builtin_amdgcn_mbcnt_hi(~0u, __builtin_amdgcn_mbcnt_lo(~0u, z_)) == 0u);     xcd_barrier(b_, t0_); } while (0)
__global__ void __launch_bounds__(NWAVES * 64, 2) mk_fwd(Args a_unused) {
    extern __shared__ __attribute__((aligned(16))) unsigned char lds_raw[];
    LAS unsigned char* lds = (LAS unsigned char*)lds_raw;
    const int wave0 = __builtin_amdgcn_readfirstlane((int)threadIdx.x >> 6);
    for (int u = threadIdx.x; u < (LDS_BYTES - LDSCTL_OFF) / 4; u += NWAVES * 64) ((LAS unsigned*)(lds + LDSCTL_OFF))[u] = 0u;
    __syncthreads();
    int lo, hi;
    { KArgs k = KARGS(); lo = k->ph_lo; hi = k->ph_hi;
      if (hi - lo > 1) (void)xcd_barrier_post((unsigned*)(k->ws + WS_CTL) + CW_BAR, (volatile LAS unsigned*)(lds + MISC_OFF) + 8, threadIdx.x == 0); }
#define IN(k) (lo <= (k) && (k) < hi)
#define BOTH(k) (IN(k) && IN((k) + 1))
#pragma unroll
    for (int l = 0; l < 2; ++l) {
        const int pb = PH_PER_LAYER * l;
        if (IN(pb + 0) && l == 0) { KArgs k = KARGS(); conv_phase(k, l, lds, wave0); }
        if (IN(pb + 1) && l == 0) {
            KArgs k = KARGS(); unsigned char* ws = k->ws;
            const float* xin = k->in[0];
            prep_phase<true>(xin, (bf16_t*)(ws + WS_XB8N), (float*)(ws + WS_RSTD), k->in[2] + (size_t)l * D * PW, k->in[1] + (size_t)l * D, k->in[3] + l * 10, (float*)(ws + WS_LOGF), lds, wave0);
            if (BOTH(pb + 1)) GRID_BAR();
        }
        if (IN(pb + 2)) {
            KArgs k = KARGS(); unsigned char* ws = k->ws;
            pg8::Gemm g{(const bf16_t*)(ws + WS_XB8N), (const bf16_t*)(ws + ws_win(l)), M, 12288, D}; pg8::StaticOrder So; FRESH_BID(); So.init(M, 12288, G, bid);
            pg8::EpiQKV4 E{(bf16_t*)(ws + WS_Q), (const float*)(ws + WS_RSTD), 0.08838834764831845f * 1.4426950408889634f, US_INV};
            { LAS unsigned char* lds_ = lds; FRESH_LDS(lds_); FRESH_TID(); pg8::gemm_phase<pg8::EpiQKV4, pg8::StaticOrder, true, true, true>(lds_, g, So, E, tid); }
            if (BOTH(pb + 2)) GRID_BAR();
        }
        if (IN(pb + 3)) {
            KArgs k = KARGS(); unsigned char* ws = k->ws;
            at::attn_phase((const bf16_t*)(ws + WS_Q), (const bf16_t*)(ws + WS_K), (const bf16_t*)(ws + WS_V), (bf16_t*)(ws + WS_OB), k->in[4] + (size_t)l * 12 * 257, (const float*)(ws + WS_LOGF),
                           (unsigned*)(ws + WS_CTL) + CW_QUEUE + 256 * l, lds, wave0, k, l == 0 ? 1 : -1);
            if (BOTH(pb + 3)) GRID_BAR();
        }
        if (IN(pb + 4)) {
            KArgs k = KARGS(); unsigned char* ws = k->ws;
            pg8::Gemm g{(const bf16_t*)(ws + WS_OB), (const bf16_t*)(ws + ws_wout(l)), M, D, D}; pg8::StaticOrder So; FRESH_BID(); So.init(M, D, G, bid);
            if (l == 0) { pg8::EpiResidB16<true> E{k->in[0], US_INV * (1.0f / 16.0f), (bf16_t*)(ws + WS_XB)};
                { LAS unsigned char* lds_ = lds; FRESH_LDS(lds_); FRESH_TID(); pg8::gemm_phase<pg8::EpiResidB16<true>, pg8::StaticOrder, false, true, true>(lds_, g, So, E, tid); } }
            else { pg8::EpiResidB16<false> E{ws + WS_X2, US_INV * (1.0f / 16.0f), (bf16_t*)(ws + WS_XB)};
                { LAS unsigned char* lds_ = lds; FRESH_LDS(lds_); FRESH_TID(); pg8::gemm_phase<pg8::EpiResidB16<false>, pg8::StaticOrder, false, true, true>(lds_, g, So, E, tid); } }
            if (BOTH(pb + 4)) GRID_BAR();
        }
        if (IN(pb + 5)) {
            KArgs k = KARGS(); unsigned char* ws = k->ws;
            pg8::Gemm g{(const bf16_t*)(ws + WS_XB), (const bf16_t*)(ws + ws_wqk(l)), M, 2048, D}; pg8::StaticOrder So; FRESH_BID(); So.init(M, 2048, G, bid);
            pg8::EpiPlainF32<2048> E{(float*)(ws + WS_SC)};
            { LAS unsigned char* lds_ = lds; FRESH_LDS(lds_); FRESH_TID(); pg8::gemm_phase<pg8::EpiPlainF32<2048>, pg8::StaticOrder, true, true>(lds_, g, So, E, tid); }
            if (BOTH(pb + 5)) GRID_BAR();
        }
        if (IN(pb + 6)) {
            KArgs k = KARGS(); unsigned char* ws = k->ws;
            if (l == 0) peer_uv_phase<false>((const float*)(ws + WS_SC), (const unsigned char*)(ws + ws_tab(l)), (const bf16_t*)(ws + WS_XB), ws + WS_X2, nullptr,
                                             ws + WS_XB8N, (float*)(ws + WS_RSTD), (float*)(ws + WS_LOGF), k->in[2] + (size_t)D * PW, k->in[1] + D, k->in[3] + 10, lds, wave0);
            else peer_uv_phase<true>((const float*)(ws + WS_SC), (const unsigned char*)(ws + ws_tab(l)), (const bf16_t*)(ws + WS_XB), k->out, k->in[12],
                                     nullptr, nullptr, nullptr, nullptr, nullptr, nullptr, lds, wave0);
            if (BOTH(pb + 7)) GRID_BAR();
        }
    }
#undef IN
#undef BOTH
}

static int g_grid = 0;
static void launch_phases(Args a, int lo, int hi, hipStream_t st) {
    a.ph_lo = lo; a.ph_hi = hi;
    hipLaunchKernelGGL(mk_fwd, dim3(g_grid), dim3(NWAVES * 64), LDS_BYTES, st, a);
}
}

extern "C" void kernel_launch(void* const* d_in, const int* in_sizes, int n_in, void* d_out, int out_size, void* d_ws, size_t ws_size, hipStream_t stream) {
    (void)in_sizes; (void)n_in; (void)out_size;
    using namespace mk;
    if (g_grid == 0) {
        if (ws_size < 2048 * MiB) { fprintf(stderr, "kernel_launch: workspace too small (%zu)\n", ws_size); g_grid = -1; return; }
        if (hipFuncSetAttribute((const void*)mk_fwd, hipFuncAttributeMaxDynamicSharedMemorySize, LDS_BYTES) != hipSuccess) { fprintf(stderr, "kernel_launch: hipFuncSetAttribute failed\n"); g_grid = -1; return; }
        int dev = 0, cus = 0; (void)hipGetDevice(&dev); (void)hipDeviceGetAttribute(&cus, hipDeviceAttributeMultiprocessorCount, dev);
        g_grid = cus > 0 ? cus : 256;
    }
    if (g_grid < 0) return;
    unsigned char* ws = (unsigned char*)d_ws; float* out = (float*)d_out;
    (void)hipMemsetAsync(ws + WS_CTL, 0, CTL_ZERO_BYTES, stream);
    Args a{};
    for (int i = 0; i < 13; ++i) a.in[i] = (const float*)d_in[i];
    a.out = out; a.ws = ws;
    launch_phases(a, 0, 2 * PH_PER_LAYER, stream);
}
```

```cpp
#include <hip/hip_runtime.h>
#include <cstdio>
#include <cstdint>
namespace pg8 {
#define PG8_LAS __attribute__((address_space(3)))
typedef unsigned short bf16_t;
typedef short bf16x8 __attribute__((ext_vector_type(8)));
typedef float f32x4 __attribute__((ext_vector_type(4)));
typedef unsigned u32x4 __attribute__((ext_vector_type(4)));
typedef unsigned u32x2 __attribute__((ext_vector_type(2)));
constexpr int BM = 256, BK = 64, HALF = 128, HTB = HALF * BK * 2  , STAGE_BYTES = 8 * HTB, NXCD = 8, WGM = 8;

__host__ __device__ __forceinline__ int lds_byte(int r, int c) { const int st = (r >> 4) * 2 + (c >> 5), rr = r & 15, cc = c & 31, ob = rr * 64 + cc * 2; return st * 1024 + (ob ^ (((ob >> 9) & 1) << 5)); }
__host__ __device__ __forceinline__ void stage_rc(int b, int& R, int& C) { const int st = b / 1024, sb = b % 1024, swz = sb ^ (((sb >> 9) & 1) << 5); R = (st >> 1) * 16 + swz / 64; C = (st & 1) * 32 + (swz % 64) / 2; }
__host__ __device__ __forceinline__ int perm32(int rho) { const int n = rho >> 4, i = rho & 15; return 8 * (i >> 2) + 4 * n + (i & 3); }

struct Unit { int pm, pn; };
struct Gemm { const bf16_t* A; const bf16_t* Bt; int M, N, K; };

struct StaticOrder {
    int nM, nN, nwg, G, c;
    __host__ __device__ void init(int M, int N, int G_, int c_) { nM = M / BM; nN = N / BM; nwg = nM * nN; G = G_; c = c_; }
    __host__ __device__ bool next(int i, Unit& u) const {
        const long L = (long)i * G + c; if (L >= nwg) return false;
        int wgid = (int)L; { const int q = nwg / NXCD, r = nwg % NXCD, xcd = wgid % NXCD, off = wgid / NXCD; wgid = (xcd < r ? xcd * (q + 1) : r * (q + 1) + (xcd - r) * q) + off; }
        const int nig = WGM * nN, gid = wgid / nig, fm = gid * WGM, gsz = (nM - fm) < WGM ? (nM - fm) : WGM;
        u.pm = fm + ((wgid % nig) % gsz); u.pn = (wgid % nig) / gsz; return true;
    }
    __device__ __forceinline__ void a_ready(const Unit&) const {}
    __device__ __forceinline__ void done(const Unit&) const {}
};
__device__ __forceinline__ unsigned cvt_pk_bf16(float lo, float hi) { unsigned r; asm volatile("v_cvt_pk_bf16_f32 %0, %1, %2" : "=v"(r) : "v"(lo), "v"(hi)); return r; }
typedef float f32x2 __attribute__((ext_vector_type(2)));
__device__ __forceinline__ f32x2 gelu_pk(f32x2 v) {
    const f32x2 av = __builtin_elementwise_abs(v), d = av * 0.2316418882f + 1.0f;
    f32x2 t; t.x = __builtin_amdgcn_rcpf(d.x); t.y = __builtin_amdgcn_rcpf(d.y);
    f32x2 q = t * 0.5307027145f + (-0.7265760135f); q = q * t + 0.7107068705f; q = q * t + (-0.142248368f); q = q * t + 0.127414796f; q = q * t;
    const f32x2 s = (v * v) * (-0.72134752044f);
    f32x2 e; e.x = __builtin_amdgcn_exp2f(s.x); e.y = __builtin_amdgcn_exp2f(s.y);
    const f32x2 m = v * (q * e), r = v - m;
    f32x2 o; o.x = v.x < 0.f ? m.x : r.x; o.y = v.y < 0.f ? m.y : r.y; return o;
}
#define EPI_FRESH_LANE() { unsigned z_ = 0u; asm volatile("" : "+v"(z_)); const int l_ = (int)__builtin_amdgcn_mbcnt_hi(~0u, __builtin_amdgcn_mbcnt_lo(~0u, z_)); fr = l_ & 15; fq = l_ >> 4; }
typedef __amdgpu_buffer_rsrc_t rsrc_t;
__device__ __forceinline__ rsrc_t mkrsrc(const void* p, unsigned bytes) { return __builtin_amdgcn_make_buffer_rsrc((void*)p, (short)0, (int)bytes, 0x00020000); }
template <int LDC> struct EpiPlainF32 {
    static constexpr bool PERM = false, AFTER_DRAIN = false;
    float* C;
    __device__ __forceinline__ void operator()(const f32x4 (&acc)[2][2][4][2], const Unit& u, int wr, int wc, int fr, int fq) const {
        EPI_FRESH_LANE();
        const rsrc_t rc = mkrsrc(C, 16384u * LDC * 4u);
        const int vo = ((wr * 64 + fr) * LDC + wc * 32 + 4 * fq) * 4, so = (u.pm * BM * LDC + u.pn * BM) * 4;
#pragma unroll
        for (int ai = 0; ai < 2; ++ai)
#pragma unroll
            for (int m = 0; m < 4; ++m)
#pragma unroll
                for (int bj = 0; bj < 2; ++bj)
#pragma unroll
                    for (int n = 0; n < 2; ++n) __builtin_amdgcn_raw_buffer_store_b128(__builtin_bit_cast(u32x4, acc[ai][bj][m][n]), rc, vo, so + ((ai * HALF + m * 16) * LDC + bj * HALF + n * 16) * 4, 0);
    }
};
template <int LDC> struct EpiRowScaleF32 {
    static constexpr bool PERM = false, AFTER_DRAIN = false;
    float* C; const float* rs;
    __device__ __forceinline__ void operator()(const f32x4 (&acc)[2][2][4][2], const Unit& u, int wr, int wc, int fr, int fq) const {
        const rsrc_t rc = mkrsrc(C, 16384u * LDC * 4u), rr = mkrsrc(rs, 16384u * 4u);
        const int vo = ((wr * 64 + fr) * LDC + wc * 32 + 4 * fq) * 4, vr = (wr * 64 + fr) * 4;
        const int so = (u.pm * BM * LDC + u.pn * BM) * 4, sr = u.pm * BM * 4;
#pragma unroll
        for (int ai = 0; ai < 2; ++ai)
#pragma unroll
            for (int m = 0; m < 4; ++m) { const float s = __builtin_bit_cast(float, __builtin_amdgcn_raw_buffer_load_b32(rr, vr, sr + (ai * HALF + m * 16) * 4, 0));
#pragma unroll
                for (int bj = 0; bj < 2; ++bj)
#pragma unroll
                    for (int n = 0; n < 2; ++n) { const f32x4 v = acc[ai][bj][m][n] * s; __builtin_amdgcn_raw_buffer_store_b128(__builtin_bit_cast(u32x4, v), rc, vo, so + ((ai * HALF + m * 16) * LDC + bj * HALF + n * 16) * 4, 0); } }
    }
};
__device__ __forceinline__ u32x4 widen_pair(unsigned x0, unsigned x1, unsigned y0, unsigned y1, int lane_, int fq_) {
    const bool odd = fq_ & 1; const int pa = (lane_ ^ 16) << 2;
    const unsigned r0 = (unsigned)__builtin_amdgcn_ds_bpermute(pa, (int)(odd ? x0 : y0)), r1 = (unsigned)__builtin_amdgcn_ds_bpermute(pa, (int)(odd ? x1 : y1));
    return odd ? (u32x4){r0, r1, y0, y1} : (u32x4){x0, x1, r0, r1};
}
template <bool BASE_F32> struct EpiResidB16 {
    static constexpr bool PERM = false, AFTER_DRAIN = false;
    const void* base; float ascale; bf16_t* xb;
    __device__ __forceinline__ void operator()(const f32x4 (&acc)[2][2][4][2], const Unit& u, int wr, int wc, int fr, int fq) const {
        EPI_FRESH_LANE();
        constexpr int LDC = 4096;
        const rsrc_t rb = mkrsrc(base, 16384u * LDC * (BASE_F32 ? 4u : 2u)), rx = mkrsrc(xb, 16384u * LDC * 2u);
        const int vo = ((wr * 64 + fr) * LDC + wc * 32 + 4 * fq) * 2;
        const int so = (u.pm * BM * LDC + u.pn * BM) * 2;
        const int vo8 = ((wr * 64 + fr) * LDC + wc * 32 + (fq & 1) * 16 + (fq >> 1) * 8) * 2;
        f32x4 ra[2][2], rb2[2][2];
#define EPI_LD(dst, g_) do { _Pragma("unroll") for (int bj = 0; bj < 2; ++bj) _Pragma("unroll") for (int n = 0; n < 2; ++n) { \
            const int o = so + ((((g_) >> 2) * HALF + ((g_) & 3) * 16) * LDC + bj * HALF + n * 16) * 2; \
            if constexpr (BASE_F32) dst[bj][n] = __builtin_bit_cast(f32x4, __builtin_amdgcn_raw_buffer_load_b128(rb, vo * 2, o * 2, 0)); \
            else { const u32x2 t_ = __builtin_amdgcn_raw_buffer_load_b64(rb, vo, o, 0); dst[bj][n] = (f32x4){__builtin_bit_cast(float, t_.x << 16), __builtin_bit_cast(float, t_.x & 0xffff0000u), __builtin_bit_cast(float, t_.y << 16), __builtin_bit_cast(float, t_.y & 0xffff0000u)}; } } } while (0)
#define EPI_ST(src, g_) do { _Pragma("unroll") for (int bj = 0; bj < 2; ++bj) { \
            const int o = so + ((((g_) >> 2) * HALF + ((g_) & 3) * 16) * LDC + bj * HALF) * 2; \
            const f32x4 v0 = src[bj][0] + acc[(g_) >> 2][bj][(g_) & 3][0] * ascale, v1 = src[bj][1] + acc[(g_) >> 2][bj][(g_) & 3][1] * ascale; \
            const u32x4 w16 = widen_pair(cvt_pk_bf16(v0[0], v0[1]), cvt_pk_bf16(v0[2], v0[3]), cvt_pk_bf16(v1[0], v1[1]), cvt_pk_bf16(v1[2], v1[3]), 16 * fq + fr, fq); \
            __builtin_amdgcn_raw_buffer_store_b128(w16, rx, vo8, o, 0); } } while (0)
        EPI_LD(ra, 0);
        EPI_LD(rb2, 1); EPI_ST(ra, 0);
        EPI_LD(ra, 2); EPI_ST(rb2, 1);
        EPI_LD(rb2, 3); EPI_ST(ra, 2);
        EPI_LD(ra, 4); EPI_ST(rb2, 3);
        EPI_LD(rb2, 5); EPI_ST(ra, 4);
        EPI_LD(ra, 6); EPI_ST(rb2, 5);
        EPI_LD(rb2, 7); EPI_ST(ra, 6);
        EPI_ST(rb2, 7);
#undef EPI_LD
#undef EPI_ST
    }
};
struct EpiQKV {
    static constexpr bool PERM = true, AFTER_DRAIN = false;
    bf16_t* Q; const float* rs; float qscale;
    __device__ __forceinline__ void operator()(const f32x4 (&acc)[2][2][4][2], const Unit& u, int wr, int wc, int fr, int fq) const {
        const rsrc_t rq = mkrsrc(Q, 3u * 16384u * 4096u * 2u), rr = mkrsrc(rs, 16384u * 4u);
        const int colt = u.pn * BM, which = colt >> 12, cw = colt & 4095, gt = cw >> 7;
        const int b = (u.pm * BM) >> 11, st = (u.pm * BM) & 2047;
        const float sc = which == 0 ? qscale : 1.f;
        const int so = (int)(((unsigned)which << 26) + (((unsigned)(b * 32 + gt) * 2048u + (unsigned)st) << 7)) * 2;
        const int vo = (((wr * 64 + fr) << 7) + wc * 32 + 8 * fq) * 2, vr = (wr * 64 + fr) * 4, sr = u.pm * BM * 4;
#pragma unroll
        for (int ai = 0; ai < 2; ++ai)
#pragma unroll
            for (int m = 0; m < 4; ++m) { const float f = sc * __builtin_bit_cast(float, __builtin_amdgcn_raw_buffer_load_b32(rr, vr, sr + (ai * HALF + m * 16) * 4, 0));
#pragma unroll
                for (int bj = 0; bj < 2; ++bj) {
                    const f32x4 v0 = acc[ai][bj][m][0] * f, v1 = acc[ai][bj][m][1] * f;
                    u32x4 w; w.x = cvt_pk_bf16(v0[0], v0[1]); w.y = cvt_pk_bf16(v0[2], v0[3]); w.z = cvt_pk_bf16(v1[0], v1[1]); w.w = cvt_pk_bf16(v1[2], v1[3]);
                    __builtin_amdgcn_raw_buffer_store_b128(w, rq, vo, so + ((bj * 2048 + ai * HALF + m * 16) << 7) * 2, 0); } }
    }
};

struct EpiQKV4 {
    static constexpr bool PERM = false, AFTER_DRAIN = false;
    bf16_t* Q; const float* rs; float qscale, wscale;
    __device__ __forceinline__ void operator()(const f32x4 (&acc)[2][2][4][2], const Unit& u, int wr, int wc, int fr, int fq) const {
        EPI_FRESH_LANE();
        const rsrc_t rq = mkrsrc(Q, 3u * 16384u * 4096u * 2u), rr = mkrsrc(rs, 16384u * 4u);
        const int colt = u.pn * BM, which = colt >> 12, cw = colt & 4095, gt = cw >> 7;
        const int b = (u.pm * BM) >> 11, st = (u.pm * BM) & 2047;
        const float sc = (which == 0 ? qscale : 1.f) * wscale;
        const int so = (int)(((unsigned)which << 26) + (((unsigned)(b * 32 + gt) * 2048u + (unsigned)st) << 7)) * 2;
        const int vo8 = (((wr * 64 + fr) << 7) + wc * 32 + (fq & 1) * 16 + (fq >> 1) * 8) * 2, vr = (wr * 64 + fr) * 4, sr = u.pm * BM * 4;
        unsigned rsv[2][4];
#pragma unroll
        for (int ai = 0; ai < 2; ++ai)
#pragma unroll
            for (int m = 0; m < 4; ++m) rsv[ai][m] = __builtin_amdgcn_raw_buffer_load_b32(rr, vr, sr + (ai * HALF + m * 16) * 4, 0);
#pragma unroll
        for (int ai = 0; ai < 2; ++ai)
#pragma unroll
            for (int m = 0; m < 4; ++m) { const float f = sc * __builtin_bit_cast(float, rsv[ai][m]);
#pragma unroll
                for (int bj = 0; bj < 2; ++bj) {
                    const f32x4 v0 = acc[ai][bj][m][0] * f, v1 = acc[ai][bj][m][1] * f;
                    const u32x4 w16 = widen_pair(cvt_pk_bf16(v0[0], v0[1]), cvt_pk_bf16(v0[2], v0[3]), cvt_pk_bf16(v1[0], v1[1]), cvt_pk_bf16(v1[2], v1[3]), 16 * fq + fr, fq);
                    __builtin_amdgcn_raw_buffer_store_b128(w16, rq, vo8, so + (((bj * 2048 + ai * HALF + m * 16) << 7)) * 2, 0); } }
    }
};

typedef int i32x8 __attribute__((ext_vector_type(8)));
template <bool F8> struct FragT { typedef bf16x8 type; };
template <> struct FragT<true> { typedef i32x8 type; };
__device__ __forceinline__ f32x4 mma_bf16(bf16x8 a, bf16x8 b, f32x4 c) { return __builtin_amdgcn_mfma_f32_16x16x32_bf16(a, b, c, 0, 0, 0); }
__device__ __forceinline__ f32x4 mma_bf16(i32x8, i32x8, f32x4 c) { return c; }
template <class Epi, class Sched, bool ALIGN_EPI = false, bool SP2 = false, bool F8 = false>
__device__ __forceinline__ void gemm_phase(PG8_LAS unsigned char* lds, const Gemm g, const Sched& S, const Epi& E, int tid_in) {
    int tid_ = tid_in;
    const int tid = tid_, wid = __builtin_amdgcn_readfirstlane(tid >> 6), lane = tid & 63, wr = wid >> 2, wc = wid & 3, fr = lane & 15, fq = lane >> 4;
    constexpr int EB = F8 ? 1 : 2;
    constexpr int K = 4096; constexpr int nt = (K * EB) / (BK * 2);
    unsigned voffA[2], voffB[2];
#pragma unroll
    for (int i = 0; i < 2; ++i) { int R, C; stage_rc(tid * 16 + i * 8192, R, C); const int Rb = Epi::PERM ? ((R & ~31) + perm32(R & 31)) : R;
        voffA[i] = (unsigned)(R * K * EB + C * 2); voffB[i] = (unsigned)(Rb * K * EB + C * 2); }
    const size_t kstep = (size_t)(BK * 2);
    const size_t hstep = (size_t)HALF * K * EB;
    const size_t tstep = 2 * hstep;
    const unsigned ldsw = (unsigned)wid * 1024u;
    const int aoff = F8 ? lds_byte(wr * 64 + fr, fq * 16) + (fq & 1) * 16 : lds_byte(wr * 64 + fr, fq * 8), boff = F8 ? lds_byte(wc * 32 + fr, fq * 16) + (fq & 1) * 16 : lds_byte(wc * 32 + fr, fq * 8);
    const int aoff1 = aoff + (F8 ? 16 - 32 * (fq & 1) : 0);
    const int f8o0_unused = 0; (void)f8o0_unused;
#define PG8_SA(b, h) (((b) * 2 + (h)) * HTB)
#define PG8_SB(b, h) ((4 + (b) * 2 + (h)) * HTB)
#define PG8_STAGE_X(bufoff, gbase, voff, rs_, base_) do { const int so_ = (int)((const char*)(gbase) - (const char*)(base_)); _Pragma("unroll") for (int _i = 0; _i < 2; ++_i) \
        __builtin_amdgcn_raw_ptr_buffer_load_lds(rs_, (PG8_LAS void*)(lds + (bufoff) + ldsw + _i * 8192), 16, (int)(voff)[_i], so_, 0, 0); } while (0)
#define PG8_LDA(dst, b, h) do { if constexpr (F8) { _Pragma("unroll") for (int m = 0; m < 4; ++m) { const u32x4 lo_ = *(const PG8_LAS u32x4*)(lds + PG8_SA(b, h) + aoff + m * 2048), hi_ = *(const PG8_LAS u32x4*)(lds + PG8_SA(b, h) + aoff1 + m * 2048); \
            dst[m][0] = (i32x8){(int)lo_[0], (int)lo_[1], (int)lo_[2], (int)lo_[3], (int)hi_[0], (int)hi_[1], (int)hi_[2], (int)hi_[3]}; } } \
        else { _Pragma("unroll") for (int m = 0; m < 4; ++m) _Pragma("unroll") for (int k = 0; k < 2; ++k) dst[m][k] = *(const PG8_LAS frag_t*)(lds + PG8_SA(b, h) + aoff + m * 2048 + k * 1024); } } while (0)
#define PG8_LDB(dst, b, h) do { if constexpr (F8) { _Pragma("unroll") for (int n = 0; n < 2; ++n) { const u32x4 lo_ = *(const PG8_LAS u32x4*)(lds + PG8_SB(b, h) + boff + n * 2048), hi_ = *(const PG8_LAS u32x4*)(lds + PG8_SB(b, h) + boff + (aoff1 - aoff) + n * 2048); \
            dst[n][0] = (i32x8){(int)lo_[0], (int)lo_[1], (int)lo_[2], (int)lo_[3], (int)hi_[0], (int)hi_[1], (int)hi_[2], (int)hi_[3]}; } } \
        else { _Pragma("unroll") for (int n = 0; n < 2; ++n) _Pragma("unroll") for (int k = 0; k < 2; ++k) dst[n][k] = *(const PG8_LAS frag_t*)(lds + PG8_SB(b, h) + boff + n * 2048 + k * 1024); } } while (0)
#define PG8_MMA(ai, bj, At, Bt) do { __builtin_amdgcn_s_setprio(1); _Pragma("unroll") for (int m = 0; m < 4; ++m) _Pragma("unroll") for (int n = 0; n < 2; ++n) { \
        if constexpr (F8) acc[ai][bj][m][n] = __builtin_amdgcn_mfma_scale_f32_16x16x128_f8f6f4(Bt[n][0], At[m][0], acc[ai][bj][m][n], 0, 0, 0, 0x7f7f7f7f, 0, 0x7f7f7f7f); \
        else { _Pragma("unroll") for (int k = 0; k < 2; ++k) acc[ai][bj][m][n] = mma_bf16(Bt[n][k], At[m][k], acc[ai][bj][m][n]); } } __builtin_amdgcn_s_setprio(0); } while (0)
#define PG8_WAIT_V(n) asm volatile("s_waitcnt vmcnt(" #n ")" ::: "memory")
#define PG8_WAIT_L(n) asm volatile("s_waitcnt lgkmcnt(" #n ")" ::: "memory")
#define PG8_BAR __builtin_amdgcn_s_barrier()
#define PG8_SCHED __builtin_amdgcn_sched_barrier(0)
    const __amdgpu_buffer_rsrc_t rsA = __builtin_amdgcn_make_buffer_rsrc((void*)g.A, (short)0, (int)((size_t)g.M * K * EB), 0x00020000), rsB = __builtin_amdgcn_make_buffer_rsrc((void*)g.Bt, (short)0, (int)((size_t)g.N * K * EB), 0x00020000);
    Unit cur, nxt; int ui = 0;
    if (!S.next(0, cur)) return;
    f32x4 acc[2][2][4][2];
#pragma unroll
    for (int a = 0; a < 2; ++a)
#pragma unroll
        for (int b = 0; b < 2; ++b)
#pragma unroll
            for (int m = 0; m < 4; ++m)
#pragma unroll
                for (int n = 0; n < 2; ++n) acc[a][b][m][n] = (f32x4){0.f, 0.f, 0.f, 0.f};
    typedef typename FragT<F8>::type frag_t;
    frag_t At[4][F8 ? 1 : 2], B0[2][F8 ? 1 : 2], B1[2][F8 ? 1 : 2];
    const char* cA = (const char*)g.A + (size_t)cur.pm * tstep; const char* cB = (const char*)g.Bt + (size_t)cur.pn * tstep;
    S.a_ready(cur);
    if constexpr (SP2) {
        PG8_STAGE_X(PG8_SB(0, 0), cB, voffB, rsB, g.Bt); PG8_STAGE_X(PG8_SB(0, 1), cB + hstep, voffB, rsB, g.Bt); PG8_STAGE_X(PG8_SA(0, 0), cA, voffA, rsA, g.A); PG8_STAGE_X(PG8_SA(0, 1), cA + hstep, voffA, rsA, g.A);
        if (wr == 1) PG8_BAR;
        PG8_WAIT_V(2); PG8_BAR;
        PG8_STAGE_X(PG8_SB(1, 0), cB + kstep, voffB, rsB, g.Bt); PG8_STAGE_X(PG8_SA(1, 0), cA + kstep, voffA, rsA, g.A); PG8_STAGE_X(PG8_SB(1, 1), cB + hstep + kstep, voffB, rsB, g.Bt);
        PG8_WAIT_V(6); PG8_BAR;
    } else {
        PG8_STAGE_X(PG8_SB(0, 0), cB, voffB, rsB, g.Bt); PG8_STAGE_X(PG8_SA(0, 0), cA, voffA, rsA, g.A); PG8_STAGE_X(PG8_SB(0, 1), cB + hstep, voffB, rsB, g.Bt); PG8_STAGE_X(PG8_SA(0, 1), cA + hstep, voffA, rsA, g.A);
        if (wr == 1) PG8_BAR;
        PG8_WAIT_V(4); PG8_BAR;
        PG8_STAGE_X(PG8_SB(1, 0), cB + kstep, voffB, rsB, g.Bt); PG8_STAGE_X(PG8_SA(1, 0), cA + kstep, voffA, rsA, g.A); PG8_STAGE_X(PG8_SB(1, 1), cB + hstep + kstep, voffB, rsB, g.Bt);
        PG8_WAIT_V(6); PG8_BAR;
    }
    for (;;) {
        const bool has_next = S.next(ui + 1, nxt);
        const char* nA = has_next ? (const char*)g.A + (size_t)nxt.pm * tstep : cA; const char* nB = has_next ? (const char*)g.Bt + (size_t)nxt.pn * tstep : cB;
        for (int t = 0; t < nt; t += 2) {
            const bool last = (t == nt - 2);
            const char* a1 = cA + (size_t)(t + 1) * kstep;
            const char* a2 = last ? nA : cA + (size_t)(t + 2) * kstep; const char* b2 = last ? nB : cB + (size_t)(t + 2) * kstep;
            const char* a3 = a2 + kstep; const char* b3 = b2 + kstep;
            if (last && has_next) S.a_ready(nxt);
            if constexpr (SP2) {
            PG8_LDB(B0, 0, 0); PG8_LDB(B1, 0, 1); PG8_SCHED; PG8_LDA(At, 0, 0); PG8_STAGE_X(PG8_SA(1, 1), a1 + hstep, voffA, rsA, g.A);
            PG8_WAIT_V(8); PG8_WAIT_L(0); PG8_BAR; PG8_MMA(0, 0, At, B0); PG8_MMA(0, 1, At, B1); PG8_BAR; PG8_SCHED;
            PG8_LDA(At, 0, 1); PG8_STAGE_X(PG8_SB(0, 0), b2, voffB, rsB, g.Bt); PG8_STAGE_X(PG8_SB(0, 1), b2 + hstep, voffB, rsB, g.Bt); PG8_STAGE_X(PG8_SA(0, 0), a2, voffA, rsA, g.A);
            PG8_WAIT_V(8); PG8_WAIT_L(0); PG8_BAR; PG8_MMA(1, 0, At, B0); PG8_MMA(1, 1, At, B1); PG8_BAR; PG8_SCHED;
            PG8_LDB(B0, 1, 0); PG8_LDB(B1, 1, 1); PG8_SCHED; PG8_LDA(At, 1, 0); PG8_STAGE_X(PG8_SA(0, 1), a2 + hstep, voffA, rsA, g.A);
            PG8_WAIT_V(8); PG8_WAIT_L(0); PG8_BAR; PG8_MMA(0, 0, At, B0); PG8_MMA(0, 1, At, B1); PG8_BAR; PG8_SCHED;
            PG8_LDA(At, 1, 1); PG8_STAGE_X(PG8_SB(1, 0), b3, voffB, rsB, g.Bt); PG8_STAGE_X(PG8_SB(1, 1), b3 + hstep, voffB, rsB, g.Bt); PG8_STAGE_X(PG8_SA(1, 0), a3, voffA, rsA, g.A);
            PG8_WAIT_V(8); PG8_WAIT_L(0); PG8_BAR; PG8_MMA(1, 0, At, B0); PG8_MMA(1, 1, At, B1); PG8_BAR; PG8_SCHED;
            } else {
            PG8_LDB(B0, 0, 0); PG8_SCHED; PG8_LDA(At, 0, 0); PG8_STAGE_X(PG8_SA(1, 1), a1 + hstep, voffA, rsA, g.A);
            PG8_WAIT_L(8); PG8_BAR; PG8_WAIT_L(0); PG8_MMA(0, 0, At, B0); PG8_BAR; PG8_SCHED;
            PG8_LDB(B1, 0, 1); PG8_STAGE_X(PG8_SB(0, 0), b2, voffB, rsB, g.Bt);
            PG8_BAR; PG8_WAIT_L(0); PG8_MMA(0, 1, At, B1); PG8_BAR;
            PG8_LDA(At, 0, 1); PG8_STAGE_X(PG8_SA(0, 0), a2, voffA, rsA, g.A);
            PG8_BAR; PG8_WAIT_L(0); PG8_MMA(1, 0, At, B0); PG8_BAR; PG8_SCHED;
            PG8_STAGE_X(PG8_SB(0, 1), b2 + hstep, voffB, rsB, g.Bt);
            PG8_WAIT_V(6); PG8_BAR; PG8_MMA(1, 1, At, B1); PG8_BAR;
            PG8_LDB(B0, 1, 0); PG8_SCHED; PG8_LDA(At, 1, 0); PG8_STAGE_X(PG8_SA(0, 1), a2 + hstep, voffA, rsA, g.A);
            PG8_WAIT_L(8); PG8_BAR; PG8_WAIT_L(0); PG8_MMA(0, 0, At, B0); PG8_BAR; PG8_SCHED;
            PG8_LDB(B1, 1, 1); PG8_STAGE_X(PG8_SB(1, 0), b3, voffB, rsB, g.Bt);
            PG8_BAR; PG8_WAIT_L(0); PG8_MMA(0, 1, At, B1); PG8_BAR;
            PG8_LDA(At, 1, 1); PG8_STAGE_X(PG8_SA(1, 0), a3, voffA, rsA, g.A);
            PG8_BAR; PG8_WAIT_L(0); PG8_MMA(1, 0, At, B0); PG8_BAR; PG8_SCHED;
            PG8_STAGE_X(PG8_SB(1, 1), b3 + hstep, voffB, rsB, g.Bt);
            PG8_WAIT_V(6); PG8_BAR; PG8_MMA(1, 1, At, B1); PG8_BAR;
            }
        }
        if constexpr (ALIGN_EPI) { if (wr == 0) PG8_BAR; }
        if constexpr (!Epi::AFTER_DRAIN) { E(acc, cur, wr, wc, fr, fq); S.done(cur); }
        if (!has_next) break;
#pragma unroll
        for (int a = 0; a < 2; ++a)
#pragma unroll
            for (int b = 0; b < 2; ++b)
#pragma unroll
                for (int m = 0; m < 4; ++m)
#pragma unroll
                    for (int n = 0; n < 2; ++n) acc[a][b][m][n] = (f32x4){0.f, 0.f, 0.f, 0.f};
        cur = nxt; cA = nA; cB = nB; ++ui;
        if constexpr (ALIGN_EPI) { if (wr == 1) PG8_BAR; }
    }
    PG8_WAIT_V(0);
    if constexpr (!ALIGN_EPI) { if (wr == 0) PG8_BAR; }
    PG8_BAR;
    if constexpr (Epi::AFTER_DRAIN) { E.fused(acc, cur, wr, wc, fr, fq, lds, wid, lane); S.done(cur); }
#undef PG8_SA
#undef PG8_SB
#undef PG8_STAGE_X
#undef PG8_LDA
#undef PG8_LDB
#undef PG8_MMA
#undef PG8_WAIT_V
#undef PG8_WAIT_L
#undef PG8_BAR
#undef PG8_SCHED
}
}
#define GAS __attribute__((address_space(1)))
#define LAS __attribute__((address_space(3)))
typedef unsigned short bf16_t;
typedef unsigned u32x4 __attribute__((ext_vector_type(4)));
typedef unsigned u32x2 __attribute__((ext_vector_type(2)));
typedef float f32x4 __attribute__((ext_vector_type(4)));
typedef float f32x2 __attribute__((ext_vector_type(2)));
typedef float f32x16 __attribute__((ext_vector_type(16)));
typedef short bf16x8 __attribute__((ext_vector_type(8)));
typedef short s16x4 __attribute__((ext_vector_type(4)));
typedef __bf16 bf16x2_t __attribute__((ext_vector_type(2)));
typedef unsigned u32x6 __attribute__((ext_vector_type(6)));
typedef int i32x8 __attribute__((ext_vector_type(8)));
typedef unsigned u32x16 __attribute__((ext_vector_type(16)));
typedef float f32x32 __attribute__((ext_vector_type(32)));
typedef _Float16 f16x32 __attribute__((ext_vector_type(32)));
typedef _Float16 f16x2 __attribute__((ext_vector_type(2)));

namespace mk {
constexpr int M = 16384, D = 4096, S = 2048, NB = 8, PW = 12298, NH = 32, NE = 16384;
constexpr int NWAVES = 8;
constexpr size_t MiB = 1u << 20;
constexpr size_t WS_CTL = 0, CTL_ZERO_BYTES = 1 * MiB;
constexpr size_t WS_RSTD = 2 * MiB, WS_LOGF = 3 * MiB, WS_WQK = 4 * MiB, WS_WOUT = 20 * MiB, WS_WIN = 52 * MiB, WS_U16 = 148 * MiB, WS_V16 = 276 * MiB,
                 WS_XB = 404 * MiB, WS_Q = 532 * MiB, WS_K = 660 * MiB, WS_V = 788 * MiB, WS_OB = 916 * MiB, WS_X2 = 1792 * MiB, WS_END = 2048 * MiB;
constexpr size_t WS_L1 = 1920 * MiB;
__host__ __device__ constexpr size_t ws_wqk(int l) { return l ? WS_L1 : WS_WQK; }
__host__ __device__ constexpr size_t ws_wout(int l) { return l ? WS_L1 + 16 * MiB : WS_WOUT; }
__host__ __device__ constexpr size_t ws_win(int l) { return l ? WS_L1 + 32 * MiB : WS_WIN; }
__host__ __device__ constexpr size_t ws_tab(int l) { return l ? WS_V16 : WS_U16; }
constexpr size_t WS_XB8N = WS_OB + 64 * MiB;
constexpr size_t WS_SC = WS_Q;
constexpr int CW_BAR = 4096;
constexpr int CW_QUEUE = 16384;
constexpr int RING_BYTES = 131072, LDSCTL_OFF = RING_BYTES, MISC_OFF = LDSCTL_OFF + 320, LDS_BYTES = 147456;

struct Args { const float* in[13]; float* out; unsigned char* ws; int ph_lo, ph_hi; };

__device__ __forceinline__ unsigned f2bf(float f) { unsigned u = __builtin_bit_cast(unsigned, f); return (u + 0x7fffu + ((u >> 16) & 1u)) >> 16; }
__device__ __forceinline__ unsigned pk2(float lo, float hi) { return f2bf(lo) | (f2bf(hi) << 16); }
__device__ __forceinline__ float bf_lo(unsigned w) { return __builtin_bit_cast(float, w << 16); }
__device__ __forceinline__ float bf_hi(unsigned w) { return __builtin_bit_cast(float, w & 0xffff0000u); }
__device__ __forceinline__ float lane_read(float v, int src_lane) { return __builtin_bit_cast(float, __builtin_amdgcn_ds_bpermute(src_lane << 2, __builtin_bit_cast(int, v))); }
__device__ __forceinline__ int lane_read(int v, int src_lane) { return __builtin_amdgcn_ds_bpermute(src_lane << 2, v); }
constexpr float US = 1024.0f, VS = 32.0f, US_INV = 1.0f / 1024.0f, VS_INV = 1.0f / 32.0f;
constexpr int REC4 = 4096;
constexpr int ROW4 = 2048;
#define FP4X_(j) ((j) < 16 ? a0[((j) & 15) >> 2][(j) & 3] : a1[((j) & 15) >> 2][(j) & 3])
__device__ __forceinline__ u32x4 pack_fp4(const f32x4 (&a0)[4], const f32x4 (&a1)[4], float inv) {
    unsigned o[4];
#pragma unroll
    for (int w = 0; w < 4; ++w) { unsigned v = 0u;
        v = __builtin_amdgcn_cvt_scalef32_pk_fp4_f32(v, FP4X_(8 * w + 0) * inv, FP4X_(8 * w + 1) * inv, 1.0f, 0); v = __builtin_amdgcn_cvt_scalef32_pk_fp4_f32(v, FP4X_(8 * w + 2) * inv, FP4X_(8 * w + 3) * inv, 1.0f, 1);
        v = __builtin_amdgcn_cvt_scalef32_pk_fp4_f32(v, FP4X_(8 * w + 4) * inv, FP4X_(8 * w + 5) * inv, 1.0f, 2); v = __builtin_amdgcn_cvt_scalef32_pk_fp4_f32(v, FP4X_(8 * w + 6) * inv, FP4X_(8 * w + 7) * inv, 1.0f, 3);
        o[w] = v; }
    return (u32x4){o[0], o[1], o[2], o[3]};
}
#undef FP4X_
__device__ __forceinline__ float clamp8(float x) { return fminf(fmaxf(x, -224.0f), 224.0f); }
__device__ __forceinline__ float logsig(float z) { return fminf(z, 0.f) - 0.6931471805599453f * __builtin_amdgcn_logf(1.0f + __builtin_amdgcn_exp2f(-fabsf(z) * 1.4426950408889634f)); }
__device__ __forceinline__ float gelu_erf(float v) {
    const float av = fabsf(v), t = __builtin_amdgcn_rcpf(av * 0.2316418882f + 1.0f);
    float q = t * 0.5307027145f + (-0.7265760135f); q = q * t + 0.7107068705f; q = q * t + (-0.142248368f); q = q * t + 0.127414796f; q = q * t;
    const float e = __builtin_amdgcn_exp2f((v * v) * (-0.72134752044f));
    const float m = v * (q * e);
    return v < 0.f ? m : v - m;
}
#define LDS_WAIT() asm volatile("s_waitcnt lgkmcnt(0)" ::: "memory")
#define FRESH_LDS(l) do { unsigned v_ = (unsigned)(size_t)(l); asm volatile("" : "+s"(v_)); (l) = (LAS unsigned char*)(size_t)v_; } while (0)
#define FRESH_BID() int bid = blockIdx.x, G = gridDim.x; asm volatile("" : "+s"(bid), "+s"(G))
#define FRESH_TID() int tid; { int w_ = wave0, l_; { unsigned z_ = 0u; asm volatile("" : "+v"(z_)); l_ = (int)__builtin_amdgcn_mbcnt_hi(~0u, __builtin_amdgcn_mbcnt_lo(~0u, z_)); } asm volatile("" : "+s"(w_)); tid = w_ * 64 + l_; } const int lane = tid & 63, wave = __builtin_amdgcn_readfirstlane(tid >> 6); (void)lane; (void)wave

__device__ __forceinline__ unsigned wave_max_u32(unsigned v) {
    v = max(v, (unsigned)__builtin_amdgcn_update_dpp(0, (int)v, 0x111, 0xF, 0xF, true));
    v = max(v, (unsigned)__builtin_amdgcn_update_dpp(0, (int)v, 0x112, 0xF, 0xF, true));
    v = max(v, (unsigned)__builtin_amdgcn_update_dpp(0, (int)v, 0x114, 0xF, 0xF, true));
    v = max(v, (unsigned)__builtin_amdgcn_update_dpp(0, (int)v, 0x118, 0xF, 0xF, true));
    v = max(v, (unsigned)__builtin_amdgcn_update_dpp((int)v, (int)v, 0x142, 0xA, 0xF, false));
    v = max(v, (unsigned)__builtin_amdgcn_update_dpp((int)v, (int)v, 0x143, 0xC, 0xF, false));
    return (unsigned)__builtin_amdgcn_readlane((int)v, 63);
}
__device__ __forceinline__ float wave_sum_dpp(float x) {
    int v = __builtin_bit_cast(int, x);
#define DPP_ADD(ctrl, rm, bc, oldv) v = __builtin_bit_cast(int, __builtin_bit_cast(float, v) + __builtin_bit_cast(float, __builtin_amdgcn_update_dpp(oldv, v, ctrl, rm, 0xF, bc)))
    DPP_ADD(0x111, 0xF, true, 0); DPP_ADD(0x112, 0xF, true, 0); DPP_ADD(0x114, 0xF, true, 0); DPP_ADD(0x118, 0xF, true, 0);
#undef DPP_ADD
    const float r0 = __builtin_bit_cast(float, __builtin_amdgcn_readlane(v, 15)), r1 = __builtin_bit_cast(float, __builtin_amdgcn_readlane(v, 31)), r2 = __builtin_bit_cast(float, __builtin_amdgcn_readlane(v, 47)), r3 = __builtin_bit_cast(float, __builtin_amdgcn_readlane(v, 63));
    return (r0 + r1) + (r2 + r3);
}
__device__ __forceinline__ float diag_sum_dpp(float x) {
    int v = __builtin_bit_cast(int, x);
#define DPP_ADD(ctrl) v = __builtin_bit_cast(int, __builtin_bit_cast(float, v) + __builtin_bit_cast(float, __builtin_amdgcn_update_dpp(0, v, ctrl, 0xF, 0xF, true)))
    DPP_ADD(0x111); DPP_ADD(0x112);
#undef DPP_ADD
    const float r0 = __builtin_bit_cast(float, __builtin_amdgcn_readlane(v, 3)), r1 = __builtin_bit_cast(float, __builtin_amdgcn_readlane(v, 23)), r2 = __builtin_bit_cast(float, __builtin_amdgcn_readlane(v, 43)), r3 = __builtin_bit_cast(float, __builtin_amdgcn_readlane(v, 63));
    return (r0 + r1) + (r2 + r3);
}
__device__ __forceinline__ unsigned ordkey(float x) { const unsigned u = __builtin_bit_cast(unsigned, x); return (u & 0x80000000u) ? ~u : (u | 0x80000000u); }
__device__ __forceinline__ void transpose_item(const float* W, int K, int ldw, int ncols, const float* gain, bf16_t* WT, LAS float* scr, int item, int lane) {
    const int nblk = ncols / 32, kb = item / nblk, nb = item % nblk, k0 = 64 * kb, n0 = 32 * nb;
#pragma unroll 8
    for (int i = 0; i < 32; ++i) { const int kk = 2 * i + (lane >> 5); float v = W[(size_t)(k0 + kk) * ldw + n0 + (lane & 31)]; if (gain) v *= gain[k0 + kk]; scr[kk * 33 + (lane & 31)] = v; }
    LDS_WAIT(); asm volatile("" ::: "memory");
    const int c = lane & 7;
#pragma unroll
    for (int j = 0; j < 4; ++j) { const int n = (lane >> 3) + 8 * j; const LAS float* s = scr + (8 * c) * 33 + n;
        u32x4 o; o.x = pk2(s[0 * 33], s[1 * 33]); o.y = pk2(s[2 * 33], s[3 * 33]); o.z = pk2(s[4 * 33], s[5 * 33]); o.w = pk2(s[6 * 33], s[7 * 33]);
        *(u32x4*)(WT + (size_t)(n0 + n) * K + k0 + 8 * c) = o; }
    LDS_WAIT(); asm volatile("" ::: "memory");
}

typedef const __attribute__((address_space(4))) Args* KArgsT;
__device__ __forceinline__ unsigned pk4_fp8(float a, float b, float c, float d) { int p = __builtin_amdgcn_cvt_pk_fp8_f32(clamp8(a), clamp8(b), 0, false); p = __builtin_amdgcn_cvt_pk_fp8_f32(clamp8(c), clamp8(d), p, true); return (unsigned)p; }
__device__ __forceinline__ void transpose_item8(const float* W, int K, int ldw, int ncols, const float* gain, float scale, unsigned char* WT, LAS float* scr, int item, int lane) {
    const int nblk = ncols / 32, kb = item / nblk, nb = item % nblk, k0 = 64 * kb, n0 = 32 * nb;
    const int kr = lane >> 3, nq = (lane & 7) * 4;
    f32x4 v[8];
#pragma unroll
    for (int i = 0; i < 8; ++i) { const float* p = W + (size_t)(k0 + 8 * i + kr) * ldw + n0 + nq; v[i] = (f32x4){p[0], p[1], p[2], p[3]}; }
#pragma unroll
    for (int i = 0; i < 8; ++i) { const int kk = 8 * i + kr; const float g = (gain ? gain[k0 + kk] : 1.0f) * scale; LAS float* d = scr + kk * 33 + nq; d[0] = v[i][0] * g; d[1] = v[i][1] * g; d[2] = v[i][2] * g; d[3] = v[i][3] * g; }
    LDS_WAIT(); asm volatile("" ::: "memory");
    const int c = lane & 7;
#pragma unroll
    for (int j = 0; j < 4; ++j) { const int n = (lane >> 3) + 8 * j; const LAS float* s = scr + (8 * c) * 33 + n;
        u32x2 o; o.x = pk4_fp8(s[0 * 33], s[1 * 33], s[2 * 33], s[3 * 33]); o.y = pk4_fp8(s[4 * 33], s[5 * 33], s[6 * 33], s[7 * 33]);
        *(u32x2*)(WT + (size_t)(n0 + n) * K + k0 + 8 * c) = o; }
    LDS_WAIT(); asm volatile("" ::: "memory");
}
__device__ __forceinline__ void conv_phase(KArgsT ka, int l, LAS unsigned char* lds, int wave0) {
    FRESH_TID(); FRESH_LDS(lds); FRESH_BID();
    unsigned char* ws = ka->ws;
    const float* ln1 = ka->in[1] + (size_t)l * D; const float* w_in = ka->in[2] + (size_t)l * D * PW; const float* w_out = ka->in[5] + (size_t)l * D * D;
    const float* ln2 = ka->in[6] + (size_t)l * D; const float* wq = ka->in[7] + (size_t)l * D * 2048;
    const float* k1 = ka->in[8] + (size_t)l * 8 * 128 * 128; const float* k2 = ka->in[9] + (size_t)l * 8 * 128 * 128;
    const float* pu = ka->in[10] + (size_t)l * NE * D; const float* pv = ka->in[11] + (size_t)l * NE * D;
    bf16_t* WQK = (bf16_t*)(ws + ws_wqk(l)); bf16_t* WOUT = (bf16_t*)(ws + ws_wout(l)); bf16_t* WIN = (bf16_t*)(ws + ws_win(l)); bf16_t* U16 = (bf16_t*)(ws + ws_tab(l));
    {
        LAS float* Ks = (LAS float*)lds;
        LAS float* Ws = (LAS float*)(lds + 128 * 132 * 4);
        const int IPB = (1024 + G - 1) / G, it0 = bid * IPB, it1 = min(1024, it0 + IPB);
        int gi_cur = -1; f32x4 pre[4];
        if (it0 < it1) {
#pragma unroll
            for (int m = 0; m < 4; ++m) { const int i = tid + 512 * m, r = i >> 5, c4 = (i & 31) * 4; pre[m] = *(const f32x4*)(wq + (size_t)((it0 & 63) * 64 + r) * 2048 + (it0 >> 6) * 128 + c4); } }
        for (int it = it0; it < it1; ++it) {
            const int gi = it >> 6, c0 = (it & 63) * 64;
            __syncthreads();
            if (gi != gi_cur) { gi_cur = gi;
                const float* key = ((gi & 1) ? k2 : k1) + (size_t)(gi >> 1) * 128 * 128;
                for (int i = tid; i < 4096; i += 512) { const int r = i >> 5, c4 = (i & 31) * 4; *(LAS f32x4*)(Ks + r * 132 + c4) = *(const f32x4*)(key + r * 128 + c4); } }
#pragma unroll
            for (int m = 0; m < 4; ++m) { const int i = tid + 512 * m, r = i >> 5, c4 = (i & 31) * 4; *(LAS f32x4*)(Ws + r * 132 + c4) = pre[m]; }
            __syncthreads();
            if (it + 1 < it1) {
#pragma unroll
                for (int m = 0; m < 4; ++m) { const int i = tid + 512 * m, r = i >> 5, c4 = (i & 31) * 4; pre[m] = *(const f32x4*)(wq + (size_t)(((it + 1) & 63) * 64 + r) * 2048 + ((it + 1) >> 6) * 128 + c4); } }
            const int ti = wave & 3, tj = wave >> 2, li = lane & 31, kh = lane >> 5;
            const LAS float* ap = Ks + (32 * ti + li) * 132 + 64 * kh; const LAS float* bp = Ws + (32 * tj + li) * 132 + 64 * kh;
            f32x16 acc;
#pragma unroll
            for (int r = 0; r < 16; ++r) acc[r] = 0.f;
#pragma unroll 4
            for (int s4 = 0; s4 < 16; ++s4) { const f32x4 a4 = *(const LAS f32x4*)(ap + 4 * s4), b4 = *(const LAS f32x4*)(bp + 4 * s4);
                acc = __builtin_amdgcn_mfma_f32_32x32x2f32(a4[0], b4[0], acc, 0, 0, 0); acc = __builtin_amdgcn_mfma_f32_32x32x2f32(a4[1], b4[1], acc, 0, 0, 0);
                acc = __builtin_amdgcn_mfma_f32_32x32x2f32(a4[2], b4[2], acc, 0, 0, 0); acc = __builtin_amdgcn_mfma_f32_32x32x2f32(a4[3], b4[3], acc, 0, 0, 0); }
            { const int c = c0 + 32 * tj + li; const float gg = ln2[c];
#pragma unroll
              for (int r = 0; r < 16; ++r) { const int n = 32 * ti + (r & 3) + 8 * (r >> 2) + 4 * kh; WQK[(size_t)(gi * 128 + n) * D + c] = (bf16_t)f2bf(acc[r] * gg); } }
        }
        __syncthreads();
    }
    const int gw = bid * NWAVES + wave, NGW = G * NWAVES;
    {
        unsigned char* U6 = (unsigned char*)U16; unsigned char* V4 = U6 + ROW4; float* SCU = (float*)(U6 + (size_t)NE * REC4); float* SCV = SCU + NE;
        f32x4 gq[4][4];
#pragma unroll
        for (int i = 0; i < 4; ++i)
#pragma unroll
            for (int m = 0; m < 4; ++m) gq[i][m] = *(const f32x4*)(ln2 + 1024 * i + 256 * m + 4 * lane);
        f32x4 uu[4][4], vv[4][4];
        const unsigned hm_ = (lane & 1) ? 65536u : 1u;
#define LDROW_(dst, src, rr) do { const float* p_ = (src) + (size_t)(rr) * D + 4 * lane; _Pragma("unroll") for (int i = 0; i < 4; ++i) _Pragma("unroll") for (int m = 0; m < 4; ++m) dst[i][m] = *(const f32x4*)(p_ + 1024 * i + 256 * m); } while (0)
#define H16_(v, inv) ((__builtin_amdgcn_cvt_scalef32_pk_fp4_f32(__builtin_amdgcn_cvt_scalef32_pk_fp4_f32(0u, (v)[0] * (inv), (v)[1] * (inv), 1.0f, 0), (v)[2] * (inv), (v)[3] * (inv), 1.0f, 1) & 0xffffu) * hm_)
#define QSWAP1_(x) ((unsigned)__builtin_amdgcn_update_dpp(0, (int)(x), 0xB1, 0xF, 0xF, false))
#define QSWAP2_(x) ((unsigned)__builtin_amdgcn_update_dpp(0, (int)(x), 0x4E, 0xF, 0xF, false))
#define PUTROW_(src, tab, rr, inv) do { _Pragma("unroll") for (int j = 0; j < 2; ++j) _Pragma("unroll") for (int m = 0; m < 4; ++m) { \
            unsigned da_ = H16_(src[2 * j][m], inv), db_ = H16_(src[2 * j + 1][m], inv); da_ |= QSWAP1_(da_); db_ |= QSWAP1_(db_); \
            const unsigned oa_ = QSWAP2_(da_), ob_ = QSWAP2_(db_); \
            if ((lane & 3) == 0) *(u32x4*)((tab) + (size_t)(rr) * REC4 + j * 1024 + 16 * (16 * m + (lane >> 2))) = (u32x4){da_, oa_, db_, ob_}; } } while (0)
        if (gw < NE) { LDROW_(uu, pu, gw); LDROW_(vv, pv, gw); }
        for (int r = gw; r < NE; r += NGW) {
            const int rn = r + NGW;
            { float au = 0.f;
#pragma unroll
              for (int i = 0; i < 4; ++i)
#pragma unroll
                  for (int m = 0; m < 4; ++m) { uu[i][m] *= gq[i][m]; au += (uu[i][m][0] * uu[i][m][0] + uu[i][m][1] * uu[i][m][1]) + (uu[i][m][2] * uu[i][m][2] + uu[i][m][3] * uu[i][m][3]); }
              au = sqrtf(wave_sum_dpp(au) * (1.0f / D)); const float iu = au > 0.f ? 2.0f / au : 0.f;
              if (lane == 0) SCU[r] = au * 0.5f;
              PUTROW_(uu, U6, r, iu); }
            if (rn < NE) LDROW_(uu, pu, rn);
            { float av = 0.f;
#pragma unroll
              for (int i = 0; i < 4; ++i)
#pragma unroll
                  for (int m = 0; m < 4; ++m) av += (vv[i][m][0] * vv[i][m][0] + vv[i][m][1] * vv[i][m][1]) + (vv[i][m][2] * vv[i][m][2] + vv[i][m][3] * vv[i][m][3]);
              av = sqrtf(wave_sum_dpp(av) * (1.0f / D)); const float iv = av > 0.f ? 2.0f / av : 0.f;
              if (lane == 0) SCV[r] = av * 0.5f;
              PUTROW_(vv, V4, r, iv); }
            if (rn < NE) LDROW_(vv, pv, rn);
        }
#undef LDROW_
#undef H16_
#undef QSWAP1_
#undef QSWAP2_
#undef PUTROW_
    }
    {
        LAS float* scr = (LAS float*)(lds + wave * 16384);
        constexpr int I_O = (D / 64) * (D / 32), I_IN = (D / 64) * (12288 / 32);
        for (int it = gw; it < I_O + I_IN; it += NGW) {
            if (it < I_O) transpose_item8(w_out, D, D, D, nullptr, US, (unsigned char*)WOUT, scr, it, lane);
            else transpose_item8(w_in, D, PW, 12288, ln1, US, (unsigned char*)WIN, scr, it - I_O, lane);
        }
    }
}

template <bool WITH_F>
__device__ __forceinline__ void prep_phase(const float* X, bf16_t* XB, float* RSTD, const float* w_in, const float* ln1, const float* bf, float* LOGF, LAS unsigned char* lds, int wave0) {
    FRESH_TID(); FRESH_LDS(lds); FRESH_BID();
    LAS unsigned short* gfs = (LAS unsigned short*)lds;
    if (WITH_F) {
        __syncthreads();
        for (int c = tid; c < D; c += 512) { const float g = ln1[c]; const float* wr = w_in + (size_t)c * PW + 12288;
#pragma unroll
            for (int j = 0; j < 10; ++j) gfs[j * D + c] = (unsigned short)f2bf(wr[j] * g); }
        __syncthreads();
    }
    const int gw = bid * NWAVES + wave, NGW = G * NWAVES;
    for (int m = gw; m < M; m += NGW) {
        const f32x4* xr = (const f32x4*)(X + (size_t)m * D) + lane;
        f32x4 v[16]; float ss = 0.f;
#pragma unroll
        for (int i = 0; i < 16; ++i) { v[i] = xr[64 * i]; ss += (v[i][0] * v[i][0] + v[i][1] * v[i][1]) + (v[i][2] * v[i][2] + v[i][3] * v[i][3]); }
        ss = wave_sum_dpp(ss);
        const float rstd = rsqrtf(ss * (1.0f / D) + 1e-6f);
        if (WITH_F) {
            unsigned* o8 = (unsigned*)((unsigned char*)XB + (size_t)m * D) + lane;
#pragma unroll
            for (int i = 0; i < 16; ++i) o8[64 * i] = pk4_fp8(v[i][0], v[i][1], v[i][2], v[i][3]);
        } else {
        u32x2* o = (u32x2*)(XB + (size_t)m * D) + lane;
#pragma unroll
        for (int i = 0; i < 16; ++i) { u32x2 w; w.x = pk2(v[i][0], v[i][1]); w.y = pk2(v[i][2], v[i][3]); o[64 * i] = w; }
        }
        if (lane == 0) RSTD[m] = rstd;
        if (WITH_F) {
            float mine = 0.f;
#pragma unroll 1
            for (int j = 0; j < 10; ++j) { float s = 0.f;
#pragma unroll
                for (int i = 0; i < 16; ++i) { const u32x2 gp = *(const LAS u32x2*)(gfs + j * D + 256 * i + 4 * lane);
                    s += (v[i][0] * bf_lo(gp.x) + v[i][1] * bf_hi(gp.x)) + (v[i][2] * bf_lo(gp.y) + v[i][3] * bf_hi(gp.y)); }
                s = wave_sum_dpp(s); if (lane == j) mine = s; }
            if (lane < 10) { const int b = m >> 11, s = m & 2047; LOGF[(size_t)(b * 10 + lane) * S + s] = logsig(mine * rstd + bf[lane]); }
        }
    }
}


__device__ __forceinline__ void load16_bf16(const bf16_t* p, float (&d)[16]) {
    const u32x4 a = *(const u32x4*)p, b = *(const u32x4*)(p + 8);
#pragma unroll
    for (int q = 0; q < 4; ++q) { d[2 * q] = bf_lo(a[q]); d[2 * q + 1] = bf_hi(a[q]); d[8 + 2 * q] = bf_lo(b[q]); d[8 + 2 * q + 1] = bf_hi(b[q]); }
}
#define RFL(x) __builtin_amdgcn_readfirstlane(x)
template <bool FINAL>
__device__ __forceinline__ void peer_uv_phase(const float* SC, const unsigned char* T4, const bf16_t* X1, void* XOv, const float* fg,
                                              unsigned char* XB8n, float* RSTDn, float* LOGFn, const float* w_in_n, const float* ln1_n, const float* bf_n, LAS unsigned char* lds, int wave0) {
    FRESH_TID(); FRESH_LDS(lds); FRESH_BID();
    LAS int* s_eid = (LAS int*)(lds + 81920 + wave * 1024); LAS f32x2* s_ws = (LAS f32x2*)(lds + 90112 + wave * 1024);
    const float* SCU = (const float*)(T4 + (size_t)NE * REC4); const float* SCV = SCU + NE;
    LAS unsigned short* gfs = (LAS unsigned short*)lds;
    if (!FINAL) {
        __syncthreads();
        for (int c = tid; c < D; c += 512) { const float g = ln1_n[c]; const float* wr = w_in_n + (size_t)c * PW + 12288;
#pragma unroll
            for (int j = 0; j < 10; ++j) gfs[j * D + c] = (unsigned short)f2bf(wr[j] * g); }
        __syncthreads();
    }
    const int gw = bid * NWAVES + wave, NGW = G * NWAVES;
    for (int tok = gw; tok < M; tok += NGW) {
        const bf16_t* x1 = X1 + (size_t)tok * D;
        i32x8 xq[2]; float rstd_tok;
        const float* sc = SC + (size_t)tok * 2048;
        float xn_[2][2][2];
#define LDSC_(hh) do { _Pragma("unroll") for (int u = 0; u < 2; ++u) _Pragma("unroll") for (int f = 0; f < 2; ++f) _Pragma("unroll") for (int r = 0; r < 2; ++r) xn_[u][f][r] = sc[((hh) + 4 * u) * 256 + f * 128 + r * 64 + lane]; } while (0)
        LDSC_(0);
        { const int sg_ = lane & 15, gp_ = lane >> 4; float t[2][2][16]; float ss_ = 0.f;
#pragma unroll
          for (int s2 = 0; s2 < 2; ++s2)
#pragma unroll
              for (int hf = 0; hf < 2; ++hf) { load16_bf16(x1 + 1024 * (2 * s2 + (gp_ & 1)) + 16 * (sg_ + 32 * hf + 16 * (gp_ >> 1)), t[s2][hf]);
#pragma unroll
                  for (int k = 0; k < 16; ++k) ss_ += t[s2][hf][k] * t[s2][hf][k]; }
          rstd_tok = rsqrtf(wave_sum_dpp(ss_) * (1.0f / D) + 1e-6f);
#pragma unroll
          for (int s2 = 0; s2 < 2; ++s2)
#pragma unroll
              for (int hf = 0; hf < 2; ++hf)
#pragma unroll
                  for (int q = 0; q < 4; ++q) xq[s2][4 * hf + q] = (int)pk4_fp8(t[s2][hf][4 * q] * rstd_tok, t[s2][hf][4 * q + 1] * rstd_tok, t[s2][hf][4 * q + 2] * rstd_tok, t[s2][hf][4 * q + 3] * rstd_tok); }
        LAS float* selv = (LAS float*)(lds + 98304 + wave * 512); LAS int* seli = (LAS int*)(lds + 98304 + wave * 512 + 256);
#define BALLOT(c) __builtin_amdgcn_ballot_w64(c)
#define MBCNT(m) ((int)__builtin_amdgcn_mbcnt_hi((unsigned)((m) >> 32), __builtin_amdgcn_mbcnt_lo((unsigned)(m), 0u)))
        for (int h = 0; h < 4; ++h) {
            float x[2][2][2]; unsigned kk[2][2][2];
#pragma unroll
            for (int u = 0; u < 2; ++u)
#pragma unroll
                for (int f = 0; f < 2; ++f)
#pragma unroll
                    for (int r = 0; r < 2; ++r) { const float v = xn_[u][f][r]; x[u][f][r] = v; kk[u][f][r] = (ordkey(v) & ~127u) | (unsigned)(127 - 64 * r - lane); }
            LDSC_(min(h + 1, 3));
            unsigned T[2][2] = {{0u, 0u}, {0u, 0u}}; int dn = 0;
            for (unsigned bm = 0x80000000u; bm != 0u && dn != 15; bm >>= 1) {
#pragma unroll
                for (int u = 0; u < 2; ++u)
#pragma unroll
                    for (int f = 0; f < 2; ++f) { const unsigned cand = T[u][f] | bm;
                        const int c = __builtin_popcountll(BALLOT(kk[u][f][0] >= cand)) + __builtin_popcountll(BALLOT(kk[u][f][1] >= cand));
                        T[u][f] = c >= 16 ? cand : T[u][f]; dn |= (c == 16) ? (1 << (2 * u + f)) : 0; }
            }
#pragma unroll
            for (int u = 0; u < 2; ++u)
#pragma unroll
                for (int f = 0; f < 2; ++f) { const bool s0 = kk[u][f][0] >= T[u][f], s1 = kk[u][f][1] >= T[u][f]; const unsigned long long m0 = BALLOT(s0), m1 = BALLOT(s1);
                    const int p0 = MBCNT(m0), p1 = __builtin_popcountll(m0) + MBCNT(m1);
                    if (s0) { selv[(2 * u + f) * 16 + (p0 & 15)] = x[u][f][0]; seli[(2 * u + f) * 16 + (p0 & 15)] = lane; }
                    if (s1) { selv[(2 * u + f) * 16 + (p1 & 15)] = x[u][f][1]; seli[(2 * u + f) * 16 + (p1 & 15)] = 64 + lane; } }
            asm volatile("" ::: "memory");
            float s4[2][4]; unsigned k4[2][4];
#pragma unroll
            for (int u = 0; u < 2; ++u) { const float va = selv[(2 * u) * 16 + (lane >> 2)]; const f32x4 vb = *(const LAS f32x4*)(selv + (2 * u + 1) * 16 + (lane & 3) * 4);
#pragma unroll
                for (int q = 0; q < 4; ++q) { s4[u][q] = va + vb[q]; k4[u][q] = (ordkey(s4[u][q]) & ~255u) | (unsigned)(255 - 4 * lane - q); } }
            unsigned T2[2] = {0u, 0u}; int d2 = 0;
            for (unsigned bm = 0x80000000u; bm != 0u && d2 != 3; bm >>= 1) {
#pragma unroll
                for (int u = 0; u < 2; ++u) { const unsigned cand = T2[u] | bm;
                    const int c = (__builtin_popcountll(BALLOT(k4[u][0] >= cand)) + __builtin_popcountll(BALLOT(k4[u][1] >= cand))) + (__builtin_popcountll(BALLOT(k4[u][2] >= cand)) + __builtin_popcountll(BALLOT(k4[u][3] >= cand)));
                    T2[u] = c >= 16 ? cand : T2[u]; d2 |= (c == 16) ? (1 << u) : 0; }
            }
#pragma unroll
            for (int u = 0; u < 2; ++u) {
                const unsigned mk = wave_max_u32(max(max(k4[u][0], k4[u][1]), max(k4[u][2], k4[u][3]))) & ~255u;
                const float mx = __builtin_bit_cast(float, (mk & 0x80000000u) ? (mk & 0x7fffffffu) : ~mk);
                const float cs = 1.4426950408889634f * rstd_tok;
                float p[4], ps = 0.f;
#pragma unroll
                for (int q = 0; q < 4; ++q) { p[q] = (k4[u][q] >= T2[u]) ? __builtin_amdgcn_exp2f((s4[u][q] - mx) * cs) : 0.f; ps += p[q]; }
                const float tot = wave_sum_dpp(ps);
                const int i1 = seli[(2 * u) * 16 + (lane >> 2)]; const u32x4 i2 = *(const LAS u32x4*)(seli + (2 * u + 1) * 16 + (lane & 3) * 4);
                int base = (h + 4 * u) * 16;
#pragma unroll
                for (int q = 0; q < 4; ++q) { const bool sl = k4[u][q] >= T2[u]; const unsigned long long m = BALLOT(sl); const int slot = base + (MBCNT(m) & 15); base += __builtin_popcountll(m);
                    if (sl) { const int e = ((i1 & 127) << 7) | (int)(i2[q] & 127u); s_eid[slot] = e; s_ws[slot] = (f32x2){p[q] / tot * SCV[e], SCU[e]}; } }
            }
            asm volatile("" ::: "memory");
        }
#undef BALLOT
#undef MBCNT
#undef LDSC_
        LDS_WAIT(); asm volatile("" ::: "memory");
        {
            f32x2 acc2[2][16];
#define ACC(i, k) acc2[(i) >> 1][((i) & 1) * 8 + ((k) >> 1)][(k) & 1]
#pragma unroll
            for (int g = 0; g < 2; ++g)
#pragma unroll
                for (int k = 0; k < 16; ++k) acc2[g][k] = (f32x2){0.f, 0.f};
            const bool dg_ = ((lane & 15) >> 2) == (lane >> 4);
            const float mk0_ = (dg_ && (lane & 3) == 0) ? 1.f : 0.f, mk1_ = (dg_ && (lane & 3) == 1) ? 1.f : 0.f, mk2_ = (dg_ && (lane & 3) == 2) ? 1.f : 0.f, mk3_ = (dg_ && (lane & 3) == 3) ? 1.f : 0.f;
#define LOADREC4(dst, e) do { const u32x4* p_ = (const u32x4*)(T4 + (size_t)(e) * REC4) + lane; dst[0] = p_[0]; dst[1] = p_[64]; dst[2] = p_[128]; dst[3] = p_[192]; } while (0)
#define PROW4(row, j, jn, EV) do { EV = s_eid[jn];     \
            f32x4 ac_ = {0.f, 0.f, 0.f, 0.f}; \
            ac_ = __builtin_amdgcn_mfma_scale_f32_16x16x128_f8f6f4((i32x8){(int)row[0][0], (int)row[0][1], (int)row[0][2], (int)row[0][3], 0, 0, 0, 0}, xq[0], ac_, 4, 0, 0, 0x7f7f7f7f, 0, 0x7f7f7f7f); \
            ac_ = __builtin_amdgcn_mfma_scale_f32_16x16x128_f8f6f4((i32x8){(int)row[1][0], (int)row[1][1], (int)row[1][2], (int)row[1][3], 0, 0, 0, 0}, xq[1], ac_, 4, 0, 0, 0x7f7f7f7f, 0, 0x7f7f7f7f); \
            const float pv_ = (ac_[0] * mk0_ + ac_[1] * mk1_) + (ac_[2] * mk2_ + ac_[3] * mk3_); \
            const f32x2 ws_ = s_ws[j]; const float d_ = diag_sum_dpp(pv_) * ws_[1]; const float w_ = ws_[0] * gelu_erf(d_); const f32x2 w2_ = {w_, w_}; \
            _Pragma("unroll") for (int g_ = 0; g_ < 2; ++g_) { \
                u32x4 G_ = row[2 + g_]; asm volatile("" : "+v"(G_)); \
                _Pragma("unroll") for (int k_ = 0; k_ < 4; ++k_) { const unsigned d4_ = G_[k_]; \
                    acc2[g_][4 * k_] = __builtin_elementwise_fma(w2_, __builtin_amdgcn_cvt_scalef32_pk_f32_fp4(d4_, 1.0f, 0), acc2[g_][4 * k_]); acc2[g_][4 * k_ + 1] = __builtin_elementwise_fma(w2_, __builtin_amdgcn_cvt_scalef32_pk_f32_fp4(d4_, 1.0f, 1), acc2[g_][4 * k_ + 1]); \
                    acc2[g_][4 * k_ + 2] = __builtin_elementwise_fma(w2_, __builtin_amdgcn_cvt_scalef32_pk_f32_fp4(d4_, 1.0f, 2), acc2[g_][4 * k_ + 2]); acc2[g_][4 * k_ + 3] = __builtin_elementwise_fma(w2_, __builtin_amdgcn_cvt_scalef32_pk_f32_fp4(d4_, 1.0f, 3), acc2[g_][4 * k_ + 3]); } \
                asm volatile("" : "+v"(acc2[g_][0]), "+v"(acc2[g_][1]), "+v"(acc2[g_][2]), "+v"(acc2[g_][3]), "+v"(acc2[g_][4]), "+v"(acc2[g_][5]), "+v"(acc2[g_][6]), "+v"(acc2[g_][7]), \
                                  "+v"(acc2[g_][8]), "+v"(acc2[g_][9]), "+v"(acc2[g_][10]), "+v"(acc2[g_][11]), "+v"(acc2[g_][12]), "+v"(acc2[g_][13]), "+v"(acc2[g_][14]), "+v"(acc2[g_][15])); } } while (0)
            u32x4 r0[4], r1[4], r2[4], r3[4];
            { const int e_ = RFL(s_eid[0]); LOADREC4(r0, e_); } { const int e_ = RFL(s_eid[1]); LOADREC4(r1, e_); } { const int e_ = RFL(s_eid[2]); LOADREC4(r2, e_); } { const int e_ = RFL(s_eid[3]); LOADREC4(r3, e_); }
            int ev_;
            for (int j = 0; j < 124; j += 4) {
                PROW4(r0, j + 0, j + 4, ev_); { const int e_ = RFL(ev_); LOADREC4(r0, e_); }
                PROW4(r1, j + 1, j + 5, ev_); { const int e_ = RFL(ev_); LOADREC4(r1, e_); }
                PROW4(r2, j + 2, j + 6, ev_); { const int e_ = RFL(ev_); LOADREC4(r2, e_); }
                PROW4(r3, j + 3, j + 7, ev_); { const int e_ = RFL(ev_); LOADREC4(r3, e_); }
            }
            PROW4(r0, 124, 0, ev_); PROW4(r1, 125, 0, ev_); PROW4(r2, 126, 0, ev_); PROW4(r3, 127, 0, ev_); (void)ev_;
#undef PROW4
#undef LOADREC4
            int lq = lane; asm volatile("" : "+v"(lq));
            float ss = 0.f;
#pragma unroll
            for (int i = 0; i < 4; ++i) { float t[16]; load16_bf16(x1 + 1024 * i + 16 * lq, t);
#pragma unroll
                for (int k = 0; k < 16; ++k) { ACC(i, k) += t[k]; ss += ACC(i, k) * ACC(i, k); } }
            ss = wave_sum_dpp(ss);
            const float rs = rsqrtf(ss * (1.0f / D) + 1e-6f);
            if (!FINAL) {
#pragma unroll
                for (int i = 0; i < 4; ++i) { u32x4 w8;
#pragma unroll
                    for (int q = 0; q < 4; ++q) w8[q] = pk4_fp8(ACC(i, 4 * q), ACC(i, 4 * q + 1), ACC(i, 4 * q + 2), ACC(i, 4 * q + 3));
                    *(u32x4*)(XB8n + (size_t)tok * D + 1024 * i + 16 * lq) = w8; }
                if (lq == 0) RSTDn[tok] = rs;
                float mine = 0.f;
#pragma unroll 1
                for (int j = 0; j < 10; ++j) { float s = 0.f;
#pragma unroll
                    for (int i = 0; i < 4; ++i) { const u32x4 g0 = *(const LAS u32x4*)(gfs + j * D + 1024 * i + 16 * lq), g1 = *(const LAS u32x4*)(gfs + j * D + 1024 * i + 16 * lq + 8);
#pragma unroll
                        for (int q = 0; q < 4; ++q) { s += ACC(i, 2 * q) * bf_lo(g0[q]) + ACC(i, 2 * q + 1) * bf_hi(g0[q]); s += ACC(i, 8 + 2 * q) * bf_lo(g1[q]) + ACC(i, 8 + 2 * q + 1) * bf_hi(g1[q]); } }
                    s = wave_sum_dpp(s); if (lq == j) mine = s; }
                if (lq < 10) { const int b_ = tok >> 11, s_ = tok & 2047; LOGFn[(size_t)(b_ * 10 + lq) * S + s_] = logsig(mine * rs + bf_n[lq]); }
            }
            if (FINAL) { float* xo = (float*)XOv + (size_t)tok * D;
#pragma unroll
                for (int i = 0; i < 4; ++i)
#pragma unroll
                    for (int q = 0; q < 4; ++q) { const int c = 1024 * i + 16 * lq + 4 * q; const f32x4 g_ = *(const f32x4*)(fg + c);
                        *(f32x4*)(xo + c) = (f32x4){ACC(i, 4 * q) * rs * g_[0], ACC(i, 4 * q + 1) * rs * g_[1], ACC(i, 4 * q + 2) * rs * g_[2], ACC(i, 4 * q + 3) * rs * g_[3]}; }
            } else { bf16_t* xo = (bf16_t*)XOv + (size_t)tok * D;
#pragma unroll
                for (int i = 0; i < 4; ++i) { u32x4 w0, w1;
#pragma unroll
                    for (int q = 0; q < 4; ++q) { w0[q] = pk2(ACC(i, 2 * q), ACC(i, 2 * q + 1)); w1[q] = pk2(ACC(i, 8 + 2 * q), ACC(i, 8 + 2 * q + 1)); }
                    *(u32x4*)(xo + 1024 * i + 16 * lq) = w0; *(u32x4*)(xo + 1024 * i + 16 * lq + 8) = w1; }
            }
        }
        LDS_WAIT(); asm volatile("" ::: "memory");
    }
#undef ACC
}
}
namespace at {
using namespace mk;
constexpr int QB = 256, KVB = 64, HD = 128;
constexpr int SHM_V = KVB * HD * 2, SHM_K = KVB * HD * 2;
constexpr int OFF_V = 0, OFF_K = 2 * SHM_V, OFF_WS = OFF_K + 2 * SHM_K, OFF_CUM = OFF_WS + 8 * 256, OFF_RT = OFF_CUM + 2048 * 4, OFF_MISC = OFF_RT + 640 * 4;
constexpr float LOG2E = 1.4426950408889634f;
constexpr float THR2 = 10.0f;
constexpr float SB_DONE = -100.0f;

#define AT_KSWZ(row, colB) ((row) * 256 + ((colB) ^ (((row) & 7) << 4)))
__device__ __forceinline__ int v_st(int k, int c) { const int kk = (k & ~0xC) | ((k & 4) << 1) | ((k & 8) >> 1); return ((kk >> 3) * 4 + (c >> 5)) * 512 + ((kk & 7) * 32 + (c & 31)) * 2; }
__device__ __forceinline__ int v_rd_base(int lane) { return ((lane & 3) << 3) | (((lane >> 2) & 3) << 6) | (((lane >> 4) & 1) << 5) | (((lane >> 5) & 1) << 8); }
constexpr int v_rd_off(int d0, int ks, int half) { return d0 * 512 + ks * 4096 + half * 2048; }
__device__ __forceinline__ int crow(int r, int hi) { return (r & 3) + 8 * (r >> 2) + 4 * hi; }
__device__ __forceinline__ unsigned cvtpk(float lo, float hi) { unsigned r; asm volatile("v_cvt_pk_bf16_f32 %0, %1, %2" : "=v"(r) : "v"(lo), "v"(hi)); return r; }
__device__ __forceinline__ float partner(float v, int hi) { auto rr = __builtin_amdgcn_permlane32_swap(__builtin_bit_cast(unsigned, v), __builtin_bit_cast(unsigned, v), false, false); return __builtin_bit_cast(float, hi ? rr[0] : rr[1]); }

__device__ __forceinline__ float xchg_max(float v, int hi) { return fmaxf(v, partner(v, hi)); }
__device__ __forceinline__ float xchg_sum(float v, int hi) { return v + partner(v, hi); }

__device__ __forceinline__ void pack_p(const f32x16& p0, const f32x16& p1, bf16x8& pa0, bf16x8& pa1, bf16x8& pa2, bf16x8& pa3) {
#define AT_PK4(P, B_, OUT) do { unsigned a0 = cvtpk(P[B_ + 0], P[B_ + 1]), a1 = cvtpk(P[B_ + 2], P[B_ + 3]); unsigned b0 = cvtpk(P[B_ + 4], P[B_ + 5]), b1 = cvtpk(P[B_ + 6], P[B_ + 7]); \
        auto r0 = __builtin_amdgcn_permlane32_swap(a0, b0, false, false); auto r1 = __builtin_amdgcn_permlane32_swap(a1, b1, false, false); \
        u32x4 w = {r0[0], r1[0], r0[1], r1[1]}; OUT = __builtin_bit_cast(bf16x8, w); } while (0)
    AT_PK4(p0, 0, pa0); AT_PK4(p0, 8, pa1); AT_PK4(p1, 0, pa2); AT_PK4(p1, 8, pa3);
#undef AT_PK4
}
template <int KBUF>
__device__ __forceinline__ void qkt(f32x16& p0, f32x16& p1, LAS unsigned char* K_lds, int r32, int hi, const bf16x8 (&qr)[8]) {
    p0 = f32x16{}; p1 = f32x16{};
    LAS unsigned char* kb[4];
#pragma unroll
    for (int dd = 0; dd < 4; ++dd) kb[dd] = K_lds + KBUF * SHM_K + AT_KSWZ(r32, (dd * 16 + hi * 8) * 2);
#pragma unroll
    for (int d0 = 0; d0 < 8; ++d0) { LAS unsigned char* a = kb[d0 & 3] + (d0 >> 2) * 128;
        const bf16x8 b0 = *(const LAS bf16x8*)a; const bf16x8 b1 = *(const LAS bf16x8*)(a + 32 * 256);
        p0 = __builtin_amdgcn_mfma_f32_32x32x16_bf16(b0, qr[d0], p0, 0, 0, 0);
        p1 = __builtin_amdgcn_mfma_f32_32x32x16_bf16(b1, qr[d0], p1, 0, 0, 0); }
}
template <int VBUF>
__device__ __forceinline__ void pv_tile(f32x16 (&o)[4], int vb0, bf16x8 pa0, bf16x8 pa1, bf16x8 pa2, bf16x8 pa3) {
#define AT_TRRD(dst, off) asm volatile("ds_read_b64_tr_b16 %0, %1 offset:%2" : "=&v"(dst) : "v"(vb0), "i"(off) : "memory")
#define AT_PV_D0(d0) do { s16x4 l0, l1, l2, l3, h0, h1, h2, h3; constexpr int b_ = VBUF * SHM_V + v_rd_off(d0, 0, 0); \
        AT_TRRD(l0, b_); AT_TRRD(h0, b_ + 2048); AT_TRRD(l1, b_ + 4096); AT_TRRD(h1, b_ + 6144); AT_TRRD(l2, b_ + 8192); AT_TRRD(h2, b_ + 10240); AT_TRRD(l3, b_ + 12288); AT_TRRD(h3, b_ + 14336); \
        asm volatile("s_waitcnt lgkmcnt(0)" ::: "memory"); __builtin_amdgcn_sched_barrier(0); \
        o[d0] = __builtin_amdgcn_mfma_f32_32x32x16_bf16(pa0, (bf16x8){l0[0], l0[1], l0[2], l0[3], h0[0], h0[1], h0[2], h0[3]}, o[d0], 0, 0, 0); \
        o[d0] = __builtin_amdgcn_mfma_f32_32x32x16_bf16(pa1, (bf16x8){l1[0], l1[1], l1[2], l1[3], h1[0], h1[1], h1[2], h1[3]}, o[d0], 0, 0, 0); \
        o[d0] = __builtin_amdgcn_mfma_f32_32x32x16_bf16(pa2, (bf16x8){l2[0], l2[1], l2[2], l2[3], h2[0], h2[1], h2[2], h2[3]}, o[d0], 0, 0, 0); \
        o[d0] = __builtin_amdgcn_mfma_f32_32x32x16_bf16(pa3, (bf16x8){l3[0], l3[1], l3[2], l3[3], h3[0], h3[1], h3[2], h3[3]}, o[d0], 0, 0, 0); } while (0)
    AT_PV_D0(0); AT_PV_D0(1); AT_PV_D0(2); AT_PV_D0(3);
#undef AT_PV_D0
#undef AT_TRRD
}

template <int VAR>
__device__ __forceinline__ void attn_item(const bf16_t* Qh, const bf16_t* Kh, const bf16_t* Vh, bf16_t* OB, const float* relb, const float* LOGF, int b, int h, int qb, LAS unsigned char* lds, int tid) {
    const int wid = __builtin_amdgcn_readfirstlane(tid >> 6), lane = tid & 63, r32 = lane & 31, hi = lane >> 5;
    const int g = VAR == 0 ? h : (VAR == 1 ? 12 + h : 22 + h);
    const size_t hb = (size_t)(b * NH + g) * S * HD;
    const bf16_t* Kp = Kh + hb; const bf16_t* Vp = Vh + hb;
    LAS unsigned char* V_lds = lds + OFF_V; LAS unsigned char* K_lds = lds + OFF_K;
    LAS float* wsf = (LAS float*)(lds + OFF_WS) + wid * 64; LAS float* li_l = wsf; LAS float* al_l = wsf + 32;
    LAS float* cumL = (LAS float*)(lds + OFF_CUM); LAS float* Rt = (LAS float*)(lds + OFF_RT); volatile LAS unsigned* flags = (volatile LAS unsigned*)(lds + OFF_MISC);
    const int P0 = qb * QB, qlo = P0 + wid * 32, qpos = qlo + r32;
    int NT, jlo = 0;
    if (VAR == 0) { jlo = 4 * qb - 8; if (jlo < 0) jlo = 0; NT = 4 * qb + 4 - jlo; } else NT = 4 * qb + 4;
    const int cw = 4 * qb + (wid >> 1);
#define AT_KBASE(t) (VAR == 1 ? (4 * qb + 3 - (t)) * KVB : (jlo + (t)) * KVB)
#define AT_ACT(t) (VAR == 0 ? ((jlo + (t)) >= cw - 8 && (jlo + (t)) <= cw) : (VAR == 1 ? (AT_KBASE(t) <= qlo + 30) : (AT_KBASE(t) <= qlo + 31)))
    if (VAR == 0) {
        const float* tab = relb + h * 257;
        for (int j = tid; j < 639; j += 512) { int rel = 575 - j; rel = rel < -128 ? -128 : (rel > 128 ? 128 : rel); Rt[j] = tab[rel + 128] * LOG2E; }
    }
    if (VAR == 2) {
        const float* lf = LOGF + (size_t)(b * 10 + h) * S; const int kend = P0 + QB;
        f32x4 v = (f32x4){0.f, 0.f, 0.f, 0.f};
        if (4 * tid < kend) v = *(const f32x4*)(lf + 4 * tid);
        v[1] += v[0]; v[2] += v[1]; v[3] += v[2];
        float tot = v[3];
#pragma unroll
        for (int o = 1; o < 64; o <<= 1) { const float t_ = lane_read(tot, lane >= o ? lane - o : lane); if (lane >= o) tot += t_; }
        if (lane == 63) li_l[0] = tot;
        __syncthreads();
        float base = tot - v[3];
        for (int w = 0; w < wid; ++w) base += ((LAS float*)(lds + OFF_WS))[w * 64];
        if (4 * tid < kend) *(LAS f32x4*)(cumL + 4 * tid) = (f32x4){(base + v[0]) * LOG2E, (base + v[1]) * LOG2E, (base + v[2]) * LOG2E, (base + v[3]) * LOG2E};
    }
    bf16x8 qr[8];
    { const bf16_t* qp = Qh + hb + (size_t)(qlo + r32) * HD + hi * 8;
#pragma unroll
      for (int d0 = 0; d0 < 8; ++d0) qr[d0] = *(const bf16x8*)(qp + d0 * 16); }
    const int sr = tid >> 4, sc = (tid & 15) * 8, vst0 = v_st(sr, sc), vst1 = v_st(32 + sr, sc), kws = AT_KSWZ(sr, sc * 2);
    const int vb0 = (int)(unsigned)(size_t)V_lds + v_rd_base(lane);
    bf16x8 st_k0, st_k1, st_v0, st_v1;
#define AT_SLOAD(k0) do { const bf16_t* kp_ = Kp + (size_t)((k0) + sr) * HD + sc; const bf16_t* vp_ = Vp + (size_t)((k0) + sr) * HD + sc; \
        st_k0 = *(const bf16x8*)kp_; st_k1 = *(const bf16x8*)(kp_ + 32 * HD); st_v0 = *(const bf16x8*)vp_; st_v1 = *(const bf16x8*)(vp_ + 32 * HD); } while (0)
#define AT_SWRITE(bf) do { *(LAS bf16x8*)(K_lds + (bf) * SHM_K + kws) = st_k0; *(LAS bf16x8*)(K_lds + (bf) * SHM_K + kws + 32 * 256) = st_k1; \
        *(LAS bf16x8*)(V_lds + (bf) * SHM_V + vst0) = st_v0; *(LAS bf16x8*)(V_lds + (bf) * SHM_V + vst1) = st_v1; } while (0)
    AT_SLOAD(AT_KBASE(0)); asm volatile("s_waitcnt vmcnt(0)" ::: "memory"); AT_SWRITE(0);
    __syncthreads();
    float m_reg = -1e30f, l_reg = 0.f, carry = 0.f;
    f32x16 o[4] = {};
#define AT_STEP(BUF, t) do { \
        const bool more_ = (t) + 1 < NT; \
        if (more_) AT_SLOAD(AT_KBASE((t) + 1)); \
        if (AT_ACT(t)) { \
            const int kb_ = AT_KBASE(t); f32x16 p0, p1; bf16x8 pa0, pa1, pa2, pa3; \
            qkt<BUF>(p0, p1, K_lds, r32, hi, qr); \
            tile_math(p0, p1, kb_, pa0, pa1, pa2, pa3); \
            pv_tile<BUF>(o, vb0, pa0, pa1, pa2, pa3); \
        } \
        if (more_) { asm volatile("s_waitcnt vmcnt(0)" ::: "memory"); AT_SWRITE((BUF) ^ 1); } \
        if (VAR == 1) { const bool done_ = __all(carry < SB_DONE); if (lane == 0) flags[((t) & 1) * 8 + wid] = done_ ? 1u : 0u; } \
        __syncthreads(); \
    } while (0)
    auto tile_math = [&](f32x16& p0, f32x16& p1, int kb, bf16x8& pa0, bf16x8& pa1, bf16x8& pa2, bf16x8& pa3) __attribute__((always_inline)) {
        const int dq = qpos - kb - 4 * hi;
        if (VAR == 1) {
            const bool need_mask = kb + 63 >= qlo;
            f32x16 n0, n1;
#pragma unroll
            for (int r = 0; r < 16; ++r) { const float z = p0[r]; const float lp = __builtin_amdgcn_logf(1.0f + __builtin_amdgcn_exp2f(-fabsf(z))); n0[r] = fminf(-z, 0.f) - lp;
                                           const float y = p1[r]; const float lq = __builtin_amdgcn_logf(1.0f + __builtin_amdgcn_exp2f(-fabsf(y))); n1[r] = fminf(-y, 0.f) - lq; }
            if (need_mask) {
#pragma unroll
                for (int r = 0; r < 16; ++r) { const int c = (r & 3) + 8 * (r >> 2);
                    if (dq - c <= 0) { n0[r] = 0.f; p0[r] = -__builtin_inff(); }
                    if (dq - c - 32 <= 0) { n1[r] = 0.f; p1[r] = -__builtin_inff(); } }
            }
            float A[8], Bp[8];
#pragma unroll
            for (int q = 0; q < 4; ++q) { A[q] = (n0[4 * q] + n0[4 * q + 1]) + (n0[4 * q + 2] + n0[4 * q + 3]); A[4 + q] = (n1[4 * q] + n1[4 * q + 1]) + (n1[4 * q + 2] + n1[4 * q + 3]); }
#pragma unroll
            for (int q = 0; q < 8; ++q) Bp[q] = partner(A[q], hi);
            float st = 0.f;
#pragma unroll
            for (int q = 7; q >= 0; --q) {
                const float after = carry + st + (hi == 0 ? Bp[q] : 0.f);
                if (q >= 4) { const int r0 = 4 * (q - 4);
                    float tl = after; p1[r0 + 3] = __builtin_amdgcn_exp2f(p1[r0 + 3] + n1[r0 + 3] + tl); tl += n1[r0 + 3]; p1[r0 + 2] = __builtin_amdgcn_exp2f(p1[r0 + 2] + n1[r0 + 2] + tl); tl += n1[r0 + 2];
                    p1[r0 + 1] = __builtin_amdgcn_exp2f(p1[r0 + 1] + n1[r0 + 1] + tl); tl += n1[r0 + 1]; p1[r0] = __builtin_amdgcn_exp2f(p1[r0] + n1[r0] + tl); }
                else { const int r0 = 4 * q;
                    float tl = after; p0[r0 + 3] = __builtin_amdgcn_exp2f(p0[r0 + 3] + n0[r0 + 3] + tl); tl += n0[r0 + 3]; p0[r0 + 2] = __builtin_amdgcn_exp2f(p0[r0 + 2] + n0[r0 + 2] + tl); tl += n0[r0 + 2];
                    p0[r0 + 1] = __builtin_amdgcn_exp2f(p0[r0 + 1] + n0[r0 + 1] + tl); tl += n0[r0 + 1]; p0[r0] = __builtin_amdgcn_exp2f(p0[r0] + n0[r0] + tl); }
                st += A[q] + Bp[q];
            }
            carry += st;
            pack_p(p0, p1, pa0, pa1, pa2, pa3);
        } else {
            if (VAR == 0) {
                const LAS float* rp = Rt + (575 - (qpos - kb) + 4 * hi);
#pragma unroll
                for (int r = 0; r < 16; ++r) { const int c = (r & 3) + 8 * (r >> 2); p0[r] += rp[c]; p1[r] += rp[c + 32]; }
            } else {
                const LAS float* cp = cumL + kb + 4 * hi;
#pragma unroll
                for (int q = 0; q < 4; ++q) { const f32x4 c0 = *(const LAS f32x4*)(cp + 8 * q), c1 = *(const LAS f32x4*)(cp + 32 + 8 * q);
                    p0[4 * q] -= c0[0]; p0[4 * q + 1] -= c0[1]; p0[4 * q + 2] -= c0[2]; p0[4 * q + 3] -= c0[3];
                    p1[4 * q] -= c1[0]; p1[4 * q + 1] -= c1[1]; p1[4 * q + 2] -= c1[2]; p1[4 * q + 3] -= c1[3]; }
                if (kb + 63 > qlo) {
#pragma unroll
                    for (int r = 0; r < 16; ++r) { const int c = (r & 3) + 8 * (r >> 2);
                        if (dq - c < 0) p0[r] = -__builtin_inff();
                        if (dq - c - 32 < 0) p1[r] = -__builtin_inff(); }
                }
            }
            float pmax = p0[0];
#pragma unroll
            for (int r = 1; r < 16; ++r) pmax = fmaxf(pmax, p0[r]);
#pragma unroll
            for (int r = 0; r < 16; ++r) pmax = fmaxf(pmax, p1[r]);
            pmax = xchg_max(pmax, hi);
            float mn, alpha;
            if (__all(pmax - m_reg <= THR2)) { mn = m_reg; alpha = 1.f; }
            else { mn = fmaxf(m_reg, pmax); alpha = __builtin_amdgcn_exp2f(m_reg - mn); m_reg = mn; }
            float ps = 0.f;
#pragma unroll
            for (int r = 0; r < 16; ++r) { p0[r] = __builtin_amdgcn_exp2f(p0[r] - mn); p1[r] = __builtin_amdgcn_exp2f(p1[r] - mn); ps += p0[r] + p1[r]; }
            ps = xchg_sum(ps, hi);
            l_reg = l_reg * alpha + ps;
            if (__any(alpha < 1.f)) {
                if (hi == 0) al_l[r32] = alpha;
                asm volatile("s_waitcnt lgkmcnt(0)" ::: "memory");
                float av[16];
#pragma unroll
                for (int r = 0; r < 16; ++r) av[r] = al_l[crow(r, hi)];
#pragma unroll
                for (int d = 0; d < 4; ++d)
#pragma unroll
                    for (int r = 0; r < 16; ++r) o[d][r] *= av[r];
            }
            pack_p(p0, p1, pa0, pa1, pa2, pa3);
        }
    };
    for (int t = 0; t < NT; t += 2) {
        AT_STEP(0, t);
        if (VAR == 1) { unsigned all_ = 1u; for (int w = 0; w < 8; ++w) all_ &= flags[(t & 1) * 8 + w]; if (all_) break; }
        if (t + 1 >= NT) break;
        AT_STEP(1, t + 1);
        if (VAR == 1) { unsigned all_ = 1u; for (int w = 0; w < 8; ++w) all_ &= flags[((t + 1) & 1) * 8 + w]; if (all_) break; }
    }
    float rli[16];
    if (VAR != 1) {
        if (hi == 0) li_l[r32] = l_reg;
        asm volatile("s_waitcnt lgkmcnt(0)" ::: "memory");
#pragma unroll
        for (int r = 0; r < 16; ++r) rli[r] = __builtin_amdgcn_rcpf(li_l[crow(r, hi)]);
    }
    unsigned char* Ow8 = (unsigned char*)OB + (size_t)(b * S + qlo) * D + g * HD;
    const unsigned bsel_ = (unsigned)(lane & 3) | ((4u + (unsigned)(lane & 3)) << 8);
#pragma unroll
    for (int r = 0; r < 16; ++r) { const int orow = crow(r, hi); const float sc_ = VAR != 1 ? rli[r] * 16.0f : 16.0f;
        const unsigned w = mk::pk4_fp8(o[0][r] * sc_, o[1][r] * sc_, o[2][r] * sc_, o[3][r] * sc_);
        const unsigned t0 = (unsigned)__builtin_amdgcn_update_dpp(0, (int)w, 0x00, 0xF, 0xF, false), t1 = (unsigned)__builtin_amdgcn_update_dpp(0, (int)w, 0x55, 0xF, 0xF, false),
                       t2 = (unsigned)__builtin_amdgcn_update_dpp(0, (int)w, 0xAA, 0xF, 0xF, false), t3 = (unsigned)__builtin_amdgcn_update_dpp(0, (int)w, 0xFF, 0xF, 0xF, false);
        const unsigned r01 = __builtin_amdgcn_perm(t1, t0, bsel_), r23 = __builtin_amdgcn_perm(t3, t2, bsel_);
        *(unsigned*)(Ow8 + (size_t)orow * D + (lane & 3) * 32 + (r32 & ~3)) = __builtin_amdgcn_perm(r23, r01, 0x05040100u); }
    __syncthreads();
#undef AT_STEP
#undef AT_SLOAD
#undef AT_SWRITE
#undef AT_KBASE
#undef AT_ACT
}

template <int VAR>
__device__ __forceinline__ void attn_queue(const bf16_t* Qh, const bf16_t* Kh, const bf16_t* Vh, bf16_t* OB, const float* relb, const float* LOGF, unsigned* qhead, LAS unsigned char* lds, int wave0) {
    FRESH_TID(); FRESH_LDS(lds);
    volatile LAS unsigned* qslot = (volatile LAS unsigned*)(lds + OFF_MISC) + 32;
    constexpr int NHV = VAR == 0 ? 12 : 10, NITEMS = 8 * NHV * 8;
    for (;;) {
        if (tid == 0) qslot[0] = __hip_atomic_fetch_add(qhead, 1u, __ATOMIC_RELAXED, __HIP_MEMORY_SCOPE_AGENT);
        __syncthreads();
        const int idx = (int)qslot[0];
        __syncthreads();
        if (idx >= NITEMS) break;
        const int qb = 7 - idx / (8 * NHV), bh = idx % (8 * NHV);
        attn_item<VAR>(Qh, Kh, Vh, OB, relb, LOGF, bh / NHV, bh % NHV, qb, lds, tid);
    }
}
__device__ __forceinline__ void attn_phase(const bf16_t* Qh, const bf16_t* Kh, const bf16_t* Vh, bf16_t* OB, const float* relb, const float* LOGF, unsigned* qheads, LAS unsigned char* lds, int wave0, mk::KArgsT ka, int conv_l) {
    int grp = (int)((blockIdx.x >> 3) & 3u); asm volatile("" : "+s"(grp));
    int cnt = 0; bool conv_done = conv_l < 0;
#pragma unroll 1
    for (int seg = 0; seg < 4; ++seg) {
        for (;;) {
            if (!conv_done && (cnt == grp || seg == 3)) { mk::conv_phase(ka, conv_l, lds, wave0); __syncthreads(); conv_done = true; }
            if (seg == 3) break;
            int idx;
            { FRESH_TID(); LAS unsigned char* l_ = lds; FRESH_LDS(l_); volatile LAS unsigned* qslot = (volatile LAS unsigned*)(l_ + OFF_MISC) + 32;
              if (tid == 0) qslot[0] = __hip_atomic_fetch_add(qheads + 64 * seg, 1u, __ATOMIC_RELAXED, __HIP_MEMORY_SCOPE_AGENT);
              __syncthreads();
              idx = (int)qslot[0];
              __syncthreads(); }
            const int NHV = seg == 1 ? 12 : 10;
            if (idx >= 64 * NHV) break;
            ++cnt;
            const int qb = 7 - idx / (8 * NHV), bh = idx % (8 * NHV);
            { FRESH_TID(); LAS unsigned char* l_ = lds; FRESH_LDS(l_);
              if (seg == 0) attn_item<2>(Qh, Kh, Vh, OB, relb, LOGF, bh / NHV, bh % NHV, qb, l_, tid);
              else if (seg == 1) attn_item<0>(Qh, Kh, Vh, OB, relb, LOGF, bh / NHV, bh % NHV, qb, l_, tid);
              else attn_item<1>(Qh, Kh, Vh, OB, relb, LOGF, bh / NHV, bh % NHV, qb, l_, tid); }
        }
    }
}
}
namespace mk {
#define XB_TMO      128
#define XB_XCNT(j)  (256  + 64 * (j))
#define XB_XSUB(j)  (1280 + 64 * (j))
#define XB_XGEN(j)  (2304 + 64 * (j))
#define XB_TOP      3328
#define XB_TOPGEN   3392
#define XCD_BAR_WORDS 3456
#define XB_SPIN_CAP (1u << 22)

__device__ __forceinline__ unsigned xb_ld(unsigned* p)              { return __hip_atomic_load(p, __ATOMIC_RELAXED, __HIP_MEMORY_SCOPE_AGENT); }
__device__ __forceinline__ unsigned xb_add(unsigned* p, unsigned v) { return __hip_atomic_fetch_add(p, v, __ATOMIC_RELAXED, __HIP_MEMORY_SCOPE_AGENT); }
__device__ __forceinline__ unsigned xb_xcc_id() { return (unsigned)__builtin_amdgcn_s_getreg((3 << 11) | 20) & 0xFu; }
#define XB_SPIN(cond, bar) do { unsigned _sp = 0; while (cond) { __builtin_amdgcn_s_sleep(1); \
    if ((++_sp & 255u) == 0u) { if (xb_ld(&(bar)[XB_TMO])) break; if (_sp > XB_SPIN_CAP) { atomicAdd(&(bar)[XB_TMO], 1u); break; } } } } while (0)

struct XcdBarrier {
    unsigned* bar; unsigned x;
    volatile LAS unsigned* st;
};

__device__ __forceinline__ XcdBarrier xcd_barrier_post(unsigned* bar, volatile LAS unsigned* st, bool is_t0) {
    XcdBarrier b; b.bar = bar; b.x = xb_xcc_id(); b.st = st;
    if (is_t0) (void)xb_add(&bar[XB_XCNT(b.x)], 1u);
    return b;
}
__device__ __forceinline__ void xcd_barrier_complete(unsigned* bar, unsigned x, unsigned& nloc, unsigned& nx) {
    const unsigned G = gridDim.x * gridDim.y * gridDim.z;
    unsigned sum, cnt, mine, sp = 0u;
    for (;;) {
        sum = 0u; cnt = 0u; mine = 0u;
#pragma unroll
        for (unsigned j = 0; j < 16; ++j) { const unsigned c = xb_ld(&bar[XB_XCNT(j)]); sum += c; cnt += (c > 0u) ? 1u : 0u; mine = (j == x) ? c : mine; }
        if (sum == G) break;
        __builtin_amdgcn_s_sleep(1);
        if ((++sp & 255u) == 0u) { if (xb_ld(&bar[XB_TMO])) break; if (sp > XB_SPIN_CAP) { atomicAdd(&bar[XB_TMO], 1u); break; } }
    }
    nloc = mine > 0u ? mine : 1u; nx = cnt > 0u ? cnt : 1u;
}

__device__ __forceinline__ void xcd_barrier(const XcdBarrier& b, bool is_t0) {
    asm volatile("s_waitcnt vmcnt(0)" ::: "memory");
    __syncthreads();
    if (is_t0) {
        unsigned* bar = b.bar;
        __builtin_amdgcn_s_waitcnt(0);
        unsigned nloc = b.st[0], nx = b.st[1];
        if (nloc == 0u) { xcd_barrier_complete(bar, b.x, nloc, nx); b.st[0] = nloc; b.st[1] = nx; }
        const unsigned old = xb_add(&bar[XB_XSUB(b.x)], 1u);
        const unsigned gen = old / nloc;
        if (old + 1u == (gen + 1u) * nloc) {
            __builtin_amdgcn_fence(__ATOMIC_RELEASE, "agent");
            asm volatile("s_waitcnt vmcnt(0)" ::: "memory");
            const unsigned og = xb_add(&bar[XB_TOP], 1u);
            const unsigned tg = og / nx;
            if (og + 1u == (tg + 1u) * nx) xb_add(&bar[XB_TOPGEN], 1u);
            else XB_SPIN(xb_ld(&bar[XB_TOPGEN]) == tg, bar);
            __builtin_amdgcn_fence(__ATOMIC_ACQUIRE, "agent");
            xb_add(&bar[XB_XGEN(b.x)], 1u);
            asm volatile("s_waitcnt vmcnt(0)" ::: "memory");
        } else {
            XB_SPIN(xb_ld(&bar[XB_XGEN(b.x)]) == gen, bar);
            __builtin_amdgcn_fence(__ATOMIC_ACQUIRE, "agent");
            asm volatile("s_waitcnt vmcnt(0)" ::: "memory");
        }
    }
    __syncthreads();
}

constexpr int PH_PER_LAYER = 8;
typedef const __attribute__((address_space(4))) Args* KArgs;
#define KARGS() ({ KArgs p_ = (KArgs)__builtin_amdgcn_kernarg_segment_ptr(); asm volatile("" : "+s"(p_)); p_; })
#define GRID_BAR() do { KArgs k_ = KARGS(); XcdBarrier b_; b_.bar = (unsigned*)(k_->ws + WS_CTL) + CW_BAR; b_.x = xb_xcc_id(); b_.st = (volatile LAS unsigned*)(lds + MISC_OFF) + 8; unsigned z_ = 0u; asm volatile("" : "+v"(z_)); const bool t0_ = (wave0 == 0) && (__builtin_amdgcn_mbcnt_hi(~0u, __builtin_amdgcn_mbcnt_lo(~0u, z_)) == 0u);     xcd_barrier(b_, t0_); } while (0)
__global__ void __launch_bounds__(NWAVES * 64, 2) mk_fwd(Args a_unused) {
    extern __shared__ __attribute__((aligned(16))) unsigned char lds_raw[];
    LAS unsigned char* lds = (LAS unsigned char*)lds_raw;
    const int wave0 = __builtin_amdgcn_readfirstlane((int)threadIdx.x >> 6);
    for (int u = threadIdx.x; u < (LDS_BYTES - LDSCTL_OFF) / 4; u += NWAVES * 64) ((LAS unsigned*)(lds + LDSCTL_OFF))[u] = 0u;
    __syncthreads();
    int lo, hi;
    { KArgs k = KARGS(); lo = k->ph_lo; hi = k->ph_hi;
      if (hi - lo > 1) (void)xcd_barrier_post((unsigned*)(k->ws + WS_CTL) + CW_BAR, (volatile LAS unsigned*)(lds + MISC_OFF) + 8, threadIdx.x == 0); }
#define IN(k) (lo <= (k) && (k) < hi)
#define BOTH(k) (IN(k) && IN((k) + 1))
#pragma unroll
    for (int l = 0; l < 2; ++l) {
        const int pb = PH_PER_LAYER * l;
        if (IN(pb + 0) && l == 0) { KArgs k = KARGS(); conv_phase(k, l, lds, wave0); }
        if (IN(pb + 1) && l == 0) {
            KArgs k = KARGS(); unsigned char* ws = k->ws;
            const float* xin = k->in[0];
            prep_phase<true>(xin, (bf16_t*)(ws + WS_XB8N), (float*)(ws + WS_RSTD), k->in[2] + (size_t)l * D * PW, k->in[1] + (size_t)l * D, k->in[3] + l * 10, (float*)(ws + WS_LOGF), lds, wave0);
            if (BOTH(pb + 1)) GRID_BAR();
        }
        if (IN(pb + 2)) {
            KArgs k = KARGS(); unsigned char* ws = k->ws;
            pg8::Gemm g{(const bf16_t*)(ws + WS_XB8N), (const bf16_t*)(ws + ws_win(l)), M, 12288, D}; pg8::StaticOrder So; FRESH_BID(); So.init(M, 12288, G, bid);
            pg8::EpiQKV4 E{(bf16_t*)(ws + WS_Q), (const float*)(ws + WS_RSTD), 0.08838834764831845f * 1.4426950408889634f, US_INV};
            { LAS unsigned char* lds_ = lds; FRESH_LDS(lds_); FRESH_TID(); pg8::gemm_phase<pg8::EpiQKV4, pg8::StaticOrder, true, true, true>(lds_, g, So, E, tid); }
            if (BOTH(pb + 2)) GRID_BAR();
        }
        if (IN(pb + 3)) {
            KArgs k = KARGS(); unsigned char* ws = k->ws;
            at::attn_phase((const bf16_t*)(ws + WS_Q), (const bf16_t*)(ws + WS_K), (const bf16_t*)(ws + WS_V), (bf16_t*)(ws + WS_OB), k->in[4] + (size_t)l * 12 * 257, (const float*)(ws + WS_LOGF),
                           (unsigned*)(ws + WS_CTL) + CW_QUEUE + 256 * l, lds, wave0, k, l == 0 ? 1 : -1);
            if (BOTH(pb + 3)) GRID_BAR();
        }
        if (IN(pb + 4)) {
            KArgs k = KARGS(); unsigned char* ws = k->ws;
            pg8::Gemm g{(const bf16_t*)(ws + WS_OB), (const bf16_t*)(ws + ws_wout(l)), M, D, D}; pg8::StaticOrder So; FRESH_BID(); So.init(M, D, G, bid);
            if (l == 0) { pg8::EpiResidB16<true> E{k->in[0], US_INV * (1.0f / 16.0f), (bf16_t*)(ws + WS_XB)};
                { LAS unsigned char* lds_ = lds; FRESH_LDS(lds_); FRESH_TID(); pg8::gemm_phase<pg8::EpiResidB16<true>, pg8::StaticOrder, false, true, true>(lds_, g, So, E, tid); } }
            else { pg8::EpiResidB16<false> E{ws + WS_X2, US_INV * (1.0f / 16.0f), (bf16_t*)(ws + WS_XB)};
                { LAS unsigned char* lds_ = lds; FRESH_LDS(lds_); FRESH_TID(); pg8::gemm_phase<pg8::EpiResidB16<false>, pg8::StaticOrder, false, true, true>(lds_, g, So, E, tid); } }
            if (BOTH(pb + 4)) GRID_BAR();
        }
        if (IN(pb + 5)) {
            KArgs k = KARGS(); unsigned char* ws = k->ws;
            pg8::Gemm g{(const bf16_t*)(ws + WS_XB), (const bf16_t*)(ws + ws_wqk(l)), M, 2048, D}; pg8::StaticOrder So; FRESH_BID(); So.init(M, 2048, G, bid);
            pg8::EpiPlainF32<2048> E{(float*)(ws + WS_SC)};
            { LAS unsigned char* lds_ = lds; FRESH_LDS(lds_); FRESH_TID(); pg8::gemm_phase<pg8::EpiPlainF32<2048>, pg8::StaticOrder, true, true>(lds_, g, So, E, tid); }
            if (BOTH(pb + 5)) GRID_BAR();
        }
        if (IN(pb + 6)) {
            KArgs k = KARGS(); unsigned char* ws = k->ws;
            if (l == 0) peer_uv_phase<false>((const float*)(ws + WS_SC), (const unsigned char*)(ws + ws_tab(l)), (const bf16_t*)(ws + WS_XB), ws + WS_X2, nullptr,
                                             ws + WS_XB8N, (float*)(ws + WS_RSTD), (float*)(ws + WS_LOGF), k->in[2] + (size_t)D * PW, k->in[1] + D, k->in[3] + 10, lds, wave0);
            else peer_uv_phase<true>((const float*)(ws + WS_SC), (const unsigned char*)(ws + ws_tab(l)), (const bf16_t*)(ws + WS_XB), k->out, k->in[12],
                                     nullptr, nullptr, nullptr, nullptr, nullptr, nullptr, lds, wave0);
            if (BOTH(pb + 7)) GRID_BAR();
        }
    }
#undef IN
#undef BOTH
}

static int g_grid = 0;
static void launch_phases(Args a, int lo, int hi, hipStream_t st) {
    a.ph_lo = lo; a.ph_hi = hi;
    hipLaunchKernelGGL(mk_fwd, dim3(g_grid), dim3(NWAVES * 64), LDS_BYTES, st, a);
}
}

extern "C" void kernel_launch(void* const* d_in, const int* in_sizes, int n_in, void* d_out, int out_size, void* d_ws, size_t ws_size, hipStream_t stream) {
    (void)in_sizes; (void)n_in; (void)out_size;
    using namespace mk;
    if (g_grid == 0) {
        if (ws_size < 2048 * MiB) { fprintf(stderr, "kernel_launch: workspace too small (%zu)\n", ws_size); g_grid = -1; return; }
        if (hipFuncSetAttribute((const void*)mk_fwd, hipFuncAttributeMaxDynamicSharedMemorySize, LDS_BYTES) != hipSuccess) { fprintf(stderr, "kernel_launch: hipFuncSetAttribute failed\n"); g_grid = -1; return; }
        int dev = 0, cus = 0; (void)hipGetDevice(&dev); (void)hipDeviceGetAttribute(&cus, hipDeviceAttributeMultiprocessorCount, dev);
        g_grid = cus > 0 ? cus : 256;
    }
    if (g_grid < 0) return;
    unsigned char* ws = (unsigned char*)d_ws; float* out = (float*)d_out;
    (void)hipMemsetAsync(ws + WS_CTL, 0, CTL_ZERO_BYTES, stream);
    Args a{};
    for (int i = 0; i < 13; ++i) a.in[i] = (const float*)d_in[i];
    a.out = out; a.ws = ws;
    launch_phases(a, 0, 2 * PH_PER_LAYER, stream);
}
```
